# Optimizing an MI355X kernel written in HIP

```python
import jax, jax.numpy as jnp
from jax import lax
import numpy as np

D_MODEL = 1024
BATCH = 4
SEQ = 4096
DEPTH = 2

GRID_W = 64
CTX_LEN = 256
GLA_HEADS = 4
GLA_DK = 64
GLA_DV = 128
GLA_RANK = 16
GLA_TAU = 16.0
NA_HEADS = 8
NA_DH = 64
NA_WIN_R = 8
NA_WIN_C = 16
WA_HEADS = 8
WA_KV_HEADS = 2
WA_DH = 64
WA_RADIUS = 128
WA_BLOCK = 128
ROPE_BASE = 10000.0
HG_HEADS = 4
HG_DK = 128
HG_DV = 128
CHUNK = 64
N_BRANCH = 4
BRANCH_W = 512
N_GROUPS = 4
EXPERTS_PER_GROUP = 8
EXPERT_HIDDEN = 256
TOP_K = 2
LN_EPS = 1e-5

IN_COLS = (
    ("a_q", GLA_HEADS * GLA_DK), ("a_k", GLA_HEADS * GLA_DK), ("a_v", GLA_HEADS * GLA_DV),
    ("a_g", GLA_HEADS * GLA_DV), ("a_lr", 2 * GLA_RANK),
    ("b_q", NA_HEADS * NA_DH), ("b_k", NA_HEADS * NA_DH), ("b_v", NA_HEADS * NA_DH),
    ("c_q", WA_HEADS * WA_DH), ("c_k", WA_KV_HEADS * WA_DH), ("c_v", WA_KV_HEADS * WA_DH),
    ("d_q", HG_HEADS * HG_DK), ("d_f", 2 * HG_HEADS * HG_DK), ("d_i", HG_HEADS * HG_DV),
    ("d_g", HG_HEADS * HG_DV), ("gate", N_BRANCH * D_MODEL),
)
D_IN = sum(s for _, s in IN_COLS)

kernel_name = "hybrid_gla_natten_swa_hgrn2_hmoe_dit"

F32 = jnp.float32


def _split_cols(z):
    offs = np.cumsum([s for _, s in IN_COLS])[:-1].tolist()
    return dict(zip([n for n, _ in IN_COLS], jnp.split(z, offs, axis=-1)))


def _heads(t, n):
    b, l, w = t.shape
    return t.reshape(b, l, n, w // n).transpose(0, 2, 1, 3)


def _merge(t):
    b, h, l, d = t.shape
    return t.transpose(0, 2, 1, 3).reshape(b, l, h * d)


def _layer_norm(t, g, b):
    tf = t.astype(F32)
    mu = tf.mean(-1, keepdims=True)
    var = jnp.square(tf - mu).mean(-1, keepdims=True)
    return ((tf - mu) * lax.rsqrt(var + LN_EPS) * g + b).astype(t.dtype)


def _head_rms(o):
    of = o.astype(F32)
    return of * lax.rsqrt(jnp.mean(of * of, -1, keepdims=True) + 1e-6)


def _rope_2d(t):
    l, dh = t.shape[2], t.shape[3]
    half = dh // 2
    nf = half // 2
    pos = jnp.arange(l)
    inv = ROPE_BASE ** (-jnp.arange(nf, dtype=F32) / nf)

    def rot(u, p):
        ang = p.astype(F32)[:, None] * inv
        cos, sin = jnp.cos(ang), jnp.sin(ang)
        u1, u2 = u[..., :nf], u[..., nf:]
        return jnp.concatenate([u1 * cos - u2 * sin, u1 * sin + u2 * cos], -1)

    out = jnp.concatenate([rot(t[..., :half], pos // GRID_W), rot(t[..., half:], pos % GRID_W)], -1)
    return out.astype(t.dtype)


def _chunked_gated_scan(q, k, v, g, s0):
    b, h, l, dk = q.shape
    n = l // CHUNK

    def to_chunks(t):
        return jnp.moveaxis(t.reshape(b, h, n, CHUNK, t.shape[-1]), 2, 0)

    causal = jnp.tril(jnp.ones((CHUNK, CHUNK), bool))

    def step(s, inp):
        qi, ki, vi, gi = inp
        bc = jnp.cumsum(gi.astype(F32), axis=2)
        diff = bc[:, :, :, None, :] - bc[:, :, None, :, :]
        decay = jnp.exp(jnp.where(causal[:, :, None], diff, -jnp.inf))
        a = jnp.einsum("bhid,bhjd,bhijd->bhij", qi, ki, decay)
        o = jnp.einsum("bhij,bhjv->bhiv", a, vi) + jnp.einsum("bhid,bhdv->bhiv", qi * jnp.exp(bc), s)
        b_last = bc[:, :, -1:, :]
        s_new = jnp.exp(b_last[:, :, 0, :])[..., None] * s + jnp.einsum(
            "bhjd,bhjv->bhdv", ki * jnp.exp(b_last - bc), vi)
        return s_new, o

    s_fin, oc = lax.scan(step, s0, (to_chunks(q), to_chunks(k), to_chunks(v), to_chunks(g)))
    return jnp.moveaxis(oc, 0, 2).reshape(b, h, l, v.shape[-1]), s_fin


def _bidir_scan(q, k_fb, v, g_fb, qc, kc_fb, vc, gc_fb):
    b, h, _, dk = q.shape
    s0 = jnp.zeros((b, h, dk, v.shape[-1]), F32)
    flip = lambda t: jnp.flip(t, axis=2)
    oc_f, sc_f = _chunked_gated_scan(qc, kc_fb[0], vc, gc_fb[0], s0)
    oc_b, sc_b = _chunked_gated_scan(flip(qc), flip(kc_fb[1]), flip(vc), flip(gc_fb[1]), s0)
    o_f, _ = _chunked_gated_scan(q, k_fb[0], v, g_fb[0], sc_f)
    o_b, _ = _chunked_gated_scan(flip(q), flip(k_fb[1]), flip(v), flip(g_fb[1]), sc_b)
    return o_f + flip(o_b), oc_f + flip(oc_b)


def _gla_branch(p, pc, lr_w, lr_b, with_ctx):
    def prep(pp):
        q = _heads(pp["a_q"], GLA_HEADS) * (GLA_DK ** -0.5)
        k = _heads(pp["a_k"], GLA_HEADS)
        v = _heads(pp["a_v"], GLA_HEADS)
        lr = pp["a_lr"]
        lr = lr.reshape(lr.shape[:-1] + (2, GLA_RANK))
        logit = jnp.einsum("blzr,zrk->zblk", lr, lr_w) + lr_b[:, None, None, :]
        g = jax.nn.log_sigmoid(logit.astype(F32)) / GLA_TAU
        return q, (k, k), v, (_heads(g[0], GLA_HEADS), _heads(g[1], GLA_HEADS))

    o, oc = _bidir_scan(*prep(p), *prep(pc))

    def out(oo, pp):
        return (_merge(_head_rms(oo)) * jax.nn.silu(pp["a_g"].astype(F32))).astype(pp["a_g"].dtype)

    return out(o, p), (out(oc, pc) if with_ctx else None)


def _hgrn2_branch(p, pc, lb, with_ctx):
    def prep(pp):
        q = jax.nn.silu(_heads(pp["d_q"], HG_HEADS))
        f = pp["d_f"]
        f = f.reshape(f.shape[:-1] + (2, HG_HEADS * HG_DK)).astype(F32)
        log_f = jnp.logaddexp(jnp.log(lb), jnp.log1p(-lb) + jax.nn.log_sigmoid(f))
        k = -jnp.expm1(log_f)
        v = _heads(pp["d_i"], HG_HEADS)
        kk = (_heads(k[:, :, 0], HG_HEADS), _heads(k[:, :, 1], HG_HEADS))
        gg = (_heads(log_f[:, :, 0], HG_HEADS), _heads(log_f[:, :, 1], HG_HEADS))
        return q, kk, v, gg

    o, oc = _bidir_scan(*prep(p), *prep(pc))

    def out(oo, pp):
        return (_merge(_head_rms(oo)) * jax.nn.silu(pp["d_g"].astype(F32))).astype(pp["d_g"].dtype)

    return out(o, p), (out(oc, pc) if with_ctx else None)


def _ctx_attention(q, k, v, sink=None):
    b, hq, lc, dh = q.shape
    g = k.shape[1]
    qg = q.reshape(b, g, hq // g, lc, dh) * (dh ** -0.5)
    s = jnp.einsum("bgrid,bgjd->bgrij", qg, k).astype(F32)
    if sink is not None:
        s_sink = jnp.broadcast_to(sink.reshape(1, g, hq // g, 1, 1).astype(F32), s.shape[:-1] + (1,))
        s = jnp.concatenate([s, s_sink], -1)
    pr = jax.nn.softmax(s, -1)[..., :lc]
    o = jnp.einsum("bgrij,bgjd->bgrid", pr, v)
    return o.reshape(b, hq, lc, dh).astype(q.dtype)


def _neighborhood_attention(q, k, v, kc, vc, rpb):
    b, h, l, dh = q.shape
    rows = l // GRID_W
    wr = min(NA_WIN_R, rows)
    qg = q.reshape(b, h, rows, GRID_W, dh) * (dh ** -0.5)
    kg = k.reshape(b, h, rows, GRID_W, dh)
    vg = v.reshape(b, h, rows, GRID_W, dh)
    cols = np.arange(GRID_W)
    cs = np.clip(cols - NA_WIN_C // 2, 0, GRID_W - NA_WIN_C)
    col_idx = cs[:, None] + np.arange(NA_WIN_C)[None, :]
    col_bias_idx = col_idx - cols[:, None] + NA_WIN_C - 1
    rpb_cols = rpb[:, :, col_bias_idx]
    n_loc = wr * NA_WIN_C

    def one_row(r):
        rs = jnp.clip(r - wr // 2, 0, rows - wr)
        k_win = lax.dynamic_slice_in_dim(kg, rs, wr, axis=2)[:, :, :, col_idx]
        v_win = lax.dynamic_slice_in_dim(vg, rs, wr, axis=2)[:, :, :, col_idx]
        q_r = lax.dynamic_index_in_dim(qg, r, axis=2, keepdims=False)
        row_off = rs + jnp.arange(wr) - r + NA_WIN_R - 1
        bias = jnp.transpose(jnp.take(rpb_cols, row_off, axis=1), (0, 2, 1, 3))
        s_loc = (jnp.einsum("bhcd,bhrcwd->bhcrw", q_r, k_win) + bias[None]).astype(F32)
        s_ctx = jnp.einsum("bhcd,bhnd->bhcn", q_r, kc).astype(F32)
        pr = jax.nn.softmax(jnp.concatenate([s_loc.reshape(b, h, GRID_W, n_loc), s_ctx], -1), -1)
        p_loc = pr[..., :n_loc].reshape(b, h, GRID_W, wr, NA_WIN_C)
        o = jnp.einsum("bhcrw,bhrcwd->bhcd", p_loc, v_win) + jnp.einsum("bhcn,bhnd->bhcd", pr[..., n_loc:], vc)
        return o.astype(q.dtype)

    out = lax.map(one_row, jnp.arange(rows))
    return jnp.transpose(out, (1, 2, 0, 3, 4)).reshape(b, h, l, dh)


def _window_attention(q, k, v, kc, vc, sink):
    b, hq, l, dh = q.shape
    g = k.shape[1]
    rep = hq // g
    nb = l // WA_BLOCK
    lc = kc.shape[2]
    qb = q.reshape(b, g, rep, nb, WA_BLOCK, dh) * (dh ** -0.5)

    def band(t):
        tb = t.reshape(b, g, nb, WA_BLOCK, dh)
        tp = jnp.pad(tb, ((0, 0), (0, 0), (1, 1), (0, 0), (0, 0)))
        return jnp.concatenate([tp[:, :, :-2], tp[:, :, 1:-1], tp[:, :, 2:]], axis=3)

    kb, vb = band(k), band(v)
    qpos = np.arange(l).reshape(nb, WA_BLOCK)
    kpos = (np.arange(nb)[:, None] - 1) * WA_BLOCK + np.arange(3 * WA_BLOCK)[None, :]
    valid = ((np.abs(kpos[:, None, :] - qpos[:, :, None]) <= WA_RADIUS)
             & (kpos[:, None, :] >= 0) & (kpos[:, None, :] < l))
    s_loc = jnp.where(valid, jnp.einsum("bgrnid,bgnjd->bgrnij", qb, kb).astype(F32), -jnp.inf)
    s_ctx = jnp.einsum("bgrnid,bgcd->bgrnic", qb, kc).astype(F32)
    s_sink = jnp.broadcast_to(sink.reshape(1, g, rep, 1, 1, 1).astype(F32), s_loc.shape[:-1] + (1,))
    pr = jax.nn.softmax(jnp.concatenate([s_loc, s_ctx, s_sink], -1), -1)
    n_loc = 3 * WA_BLOCK
    o = (jnp.einsum("bgrnij,bgnjd->bgrnid", pr[..., :n_loc], vb)
         + jnp.einsum("bgrnic,bgcd->bgrnid", pr[..., n_loc:n_loc + lc], vc))
    return o.reshape(b, hq, l, dh).astype(q.dtype)


def _na_branch(p, pc, rpb, with_ctx):
    q, k, v = (_heads(p[n], NA_HEADS) for n in ("b_q", "b_k", "b_v"))
    kc, vc = _heads(pc["b_k"], NA_HEADS), _heads(pc["b_v"], NA_HEADS)
    o = _merge(_neighborhood_attention(q, k, v, kc, vc, rpb))
    oc = _merge(_ctx_attention(_heads(pc["b_q"], NA_HEADS), kc, vc)) if with_ctx else None
    return o, oc


def _wa_branch(p, pc, sink, with_ctx):
    q = _rope_2d(_heads(p["c_q"], WA_HEADS))
    k = _rope_2d(_heads(p["c_k"], WA_KV_HEADS))
    v = _heads(p["c_v"], WA_KV_HEADS)
    kc, vc = _heads(pc["c_k"], WA_KV_HEADS), _heads(pc["c_v"], WA_KV_HEADS)
    o = _merge(_window_attention(q, k, v, kc, vc, sink))
    oc = _merge(_ctx_attention(_heads(pc["c_q"], WA_HEADS), kc, vc, sink)) if with_ctx else None
    return o, oc


def _merge_branches(gate_pre, branches, w_br):
    gates = jax.nn.sigmoid(gate_pre.astype(F32)).astype(gate_pre.dtype)
    out = gates[..., :D_MODEL] * (branches[0] @ w_br[0])
    for i in range(1, N_BRANCH):
        out = out + gates[..., i * D_MODEL:(i + 1) * D_MODEL] * (branches[i] @ w_br[i])
    return out


def _hier_moe(h, w_grp, b_grp, w_er, b_er, w_gate, w_up, w_down):
    g_logits = (h @ w_grp + b_grp).astype(F32)
    g_top, g_idx = lax.top_k(g_logits, 1)
    g_weight = jnp.exp(g_top[..., 0] - jax.nn.logsumexp(g_logits, -1))
    e_logits = (h @ w_er + b_er).astype(F32)
    e_logits = e_logits.reshape(e_logits.shape[:-1] + (N_GROUPS, EXPERTS_PER_GROUP))
    g_onehot = jax.nn.one_hot(g_idx[..., 0], N_GROUPS, dtype=F32)
    e_in = jnp.einsum("...ge,...g->...e", e_logits, g_onehot)
    e_top, e_idx = lax.top_k(e_in, TOP_K)
    e_w = jax.nn.softmax(e_top, -1)
    local = jnp.sum(e_w[..., None] * jax.nn.one_hot(e_idx, EXPERTS_PER_GROUP, dtype=F32), axis=-2)
    out = None
    for gi in range(N_GROUPS):
        wg = (jnp.where(g_idx[..., 0] == gi, g_weight, 0.0)[..., None] * local).astype(h.dtype)
        hid = (jax.nn.silu(jnp.einsum("bld,edf->blef", h, w_gate[gi]))
               * jnp.einsum("bld,edf->blef", h, w_up[gi]))
        y = jnp.einsum("blef,efd->bld", hid * wg[..., None], w_down[gi])
        out = y if out is None else out + y
    return out


def setup_inputs(seed: int = 0) -> dict:
    key = jax.random.key(seed)
    ks = jax.random.split(key, 24)
    d = D_MODEL
    beta = (8.0 * DEPTH) ** -0.25
    nrm = lambda k, shape, scale: jax.random.normal(k, shape, F32) * scale
    n_exp = N_GROUPS * EXPERTS_PER_GROUP
    return {
        "x": nrm(ks[0], (BATCH, SEQ, d), 1.0),
        "c": nrm(ks[1], (BATCH, d), 1.0),
        "ctx": nrm(ks[2], (BATCH, CTX_LEN, d), 1.0),
        "c_ctx": nrm(ks[3], (d,), 1.0),
        "w_mod": nrm(ks[4], (DEPTH, d, 6 * d), 0.5 * d ** -0.5),
        "b_mod": nrm(ks[5], (DEPTH, 6 * d), 0.01),
        "w_in": nrm(ks[6], (DEPTH, d, D_IN), d ** -0.5),
        "gla_lr_w": nrm(ks[7], (DEPTH, 2, GLA_RANK, GLA_HEADS * GLA_DK), GLA_RANK ** -0.5),
        "gla_lr_b": nrm(ks[8], (DEPTH, 2, GLA_HEADS * GLA_DK), 0.1),
        "hg_gamma": nrm(ks[9], (2, DEPTH, HG_HEADS * HG_DK), 0.5),
        "na_rpb": nrm(ks[10], (DEPTH, NA_HEADS, 2 * NA_WIN_R - 1, 2 * NA_WIN_C - 1), 0.02),
        "wa_sink": nrm(ks[11], (DEPTH, WA_HEADS), 0.5),
        "w_branch": nrm(ks[12], (DEPTH, N_BRANCH, BRANCH_W, d), BRANCH_W ** -0.5),
        "w_out": nrm(ks[13], (DEPTH, d, d), beta * d ** -0.5),
        "ln_g": 1.0 + nrm(ks[14], (DEPTH, 2, d), 0.01),
        "ln_b": nrm(ks[15], (DEPTH, 2, d), 0.01),
        "moe_w_group": nrm(ks[16], (DEPTH, d, N_GROUPS), d ** -0.5),
        "moe_b_group": nrm(ks[17], (DEPTH, N_GROUPS), 0.01),
        "moe_w_expert": nrm(ks[18], (DEPTH, d, n_exp), d ** -0.5),
        "moe_b_expert": nrm(ks[19], (DEPTH, n_exp), 0.01),
        "moe_w_gate": nrm(ks[20], (DEPTH, N_GROUPS, EXPERTS_PER_GROUP, d, EXPERT_HIDDEN), d ** -0.5),
        "moe_w_up": nrm(ks[21], (DEPTH, N_GROUPS, EXPERTS_PER_GROUP, d, EXPERT_HIDDEN), d ** -0.5),
        "moe_w_down": nrm(ks[22], (DEPTH, N_GROUPS, EXPERTS_PER_GROUP, EXPERT_HIDDEN, d),
                          beta * EXPERT_HIDDEN ** -0.5),
    }


def reference(x, c, ctx, c_ctx, w_mod, b_mod, w_in, gla_lr_w, gla_lr_b, hg_gamma, na_rpb, wa_sink,
              w_branch, w_out, ln_g, ln_b, moe_w_group, moe_b_group, moe_w_expert, moe_b_expert,
              moe_w_gate, moe_w_up, moe_w_down):
    alpha = (2.0 * DEPTH) ** 0.25
    cum = jnp.cumsum(jax.nn.softmax(hg_gamma.astype(F32), axis=1), axis=1)
    lower_bounds = cum - cum[:, :1]
    sc = jax.nn.silu(c)
    scc = jax.nn.silu(c_ctx)
    cx = ctx
    for l in range(DEPTH):
        with_ctx = l < DEPTH - 1
        mod = jnp.split(sc @ w_mod[l] + b_mod[l], 6, axis=-1)
        modc = jnp.split(scc @ w_mod[l] + b_mod[l], 6, axis=-1)
        hx = x * (1.0 + mod[1][:, None]) + mod[0][:, None]
        hc = cx * (1.0 + modc[1]) + modc[0]
        p = _split_cols(hx @ w_in[l])
        pc = _split_cols(hc @ w_in[l])
        o_a, oc_a = _gla_branch(p, pc, gla_lr_w[l], gla_lr_b[l], with_ctx)
        o_b, oc_b = _na_branch(p, pc, na_rpb[l], with_ctx)
        o_c, oc_c = _wa_branch(p, pc, wa_sink[l], with_ctx)
        o_d, oc_d = _hgrn2_branch(p, pc, lower_bounds[:, l], with_ctx)
        mix = _merge_branches(p["gate"], (o_a, o_b, o_c, o_d), w_branch[l]) @ w_out[l]
        x = _layer_norm(alpha * x + mod[2][:, None] * mix, ln_g[l, 0], ln_b[l, 0])
        if with_ctx:
            mix_c = _merge_branches(pc["gate"], (oc_a, oc_b, oc_c, oc_d), w_branch[l]) @ w_out[l]
            cx = _layer_norm(alpha * cx + modc[2] * mix_c, ln_g[l, 0], ln_b[l, 0])
        moe_args = (moe_w_group[l], moe_b_group[l], moe_w_expert[l], moe_b_expert[l],
                    moe_w_gate[l], moe_w_up[l], moe_w_down[l])
        hx = x * (1.0 + mod[4][:, None]) + mod[3][:, None]
        x = _layer_norm(alpha * x + mod[5][:, None] * _hier_moe(hx, *moe_args), ln_g[l, 1], ln_b[l, 1])
        if with_ctx:
            hc = cx * (1.0 + modc[4]) + modc[3]
            cx = _layer_norm(alpha * cx + modc[5] * _hier_moe(hc, *moe_args), ln_g[l, 1], ln_b[l, 1])
    return x
```

```cpp
#include <hip/hip_runtime.h>
#include <cstdio>
#include <cstdint>
#include <cstring>

typedef unsigned short bf16_t;
typedef float f32x4 __attribute__((ext_vector_type(4)));
typedef unsigned u32x4 __attribute__((ext_vector_type(4)));
typedef unsigned u32x2 __attribute__((ext_vector_type(2)));

constexpr int NB = 4, SEQ = 4096, LC = 256, DM = 1024, DEPTH = 2;
constexpr int NTOK = NB * SEQ, NCTX = NB * LC, NROW = NTOK + NCTX;
constexpr int DIN = 10528;
constexpr int O_AQ = 0, O_AK = 256, O_AV = 512, O_AG = 1024, O_ALR = 1536, O_BQ = 1568, O_BK = 2080, O_BV = 2592, O_CQ = 3104, O_CK = 3616,
              O_CV = 3744, O_DQ = 3872, O_DF = 4384, O_DI = 5408, O_DG = 5920, O_GATE = 6432;
constexpr int PC_AQ = 0, PC_AK = 256, PC_AV = 512, PC_ALR = 1024, PC_BQ = 1280, PC_BK = 1792, PC_CQ = 2304, PC_CK = 2816, PC_DQ = 3072,
              PC_DF = 3584, PC_DI = 4608, PC_AG = 5120, PC_DG = 5632, NP1 = 6144;
constexpr int NVT = 768;
constexpr int NVR = 640;
constexpr int NGATE = 4096;
constexpr int XS_ROWS = 40960;
constexpr float LN_EPS = 1e-5f;
constexpr float ALPHA = 1.41421356237f;

constexpr size_t al256(size_t x) { return (x + 255) & ~(size_t)255; }
constexpr size_t WS_CTL = 0;
constexpr size_t CTL_BYTES = 16384;
constexpr size_t CTL_CNT = 14336;
constexpr size_t WS_MODV = WS_CTL + CTL_BYTES;
constexpr size_t WS_LB = WS_MODV + al256((size_t)DEPTH * 5 * 6144 * 4);
constexpr size_t WS_TOKE = WS_LB + 4096;
constexpr size_t WS_TOKI = WS_TOKE + al256((size_t)2 * NROW * 4);
constexpr size_t WS_TOKW = WS_TOKI + al256((size_t)2 * NROW * 4);
constexpr size_t WS_RMAP = WS_TOKW + al256((size_t)2 * NROW * 4);
constexpr size_t WS_ROWW = WS_RMAP + al256((size_t)XS_ROWS * 4);
constexpr size_t WS_CXM = WS_ROWW + al256((size_t)XS_ROWS * 4);
constexpr size_t WS_CXO = WS_CXM + (size_t)NCTX * DM * 4;
constexpr size_t WS_WTA = WS_CXO + (size_t)NCTX * DM * 4;
constexpr size_t WTA_W1 = 0;
constexpr size_t WTA_WV = WTA_W1 + (size_t)NP1 * DM * 2;
constexpr size_t WTA_WG = WTA_WV + (size_t)NVT * DM * 2;
constexpr size_t WTA_WBR = WTA_WG + (size_t)NGATE * DM * 2;
constexpr size_t WTA_WO = WTA_WBR + (size_t)4 * DM * 512 * 2;
constexpr size_t WTA_BYTES = WTA_WO + (size_t)DM * DM * 2;
constexpr size_t WS_HX = WS_WTA + WTA_BYTES;
constexpr size_t WS_VT = WS_HX + (size_t)NROW * DM * 2;
constexpr size_t WS_OBA = WS_VT + (size_t)NVT * NROW * 2;
constexpr size_t WS_HX2 = WS_VT;
constexpr size_t WS_HID = WS_VT;
constexpr size_t WS_VR = WS_OBA + (size_t)NROW * 512 * 2;
constexpr size_t WS_BR = WS_VR + (size_t)NROW * NVR * 2;
constexpr size_t WS_P1 = WS_BR + (size_t)NROW * 2048 * 2;
constexpr size_t WS_G = WS_P1;
constexpr size_t WS_WGU = WS_P1 + (size_t)NROW * NGATE * 2;
constexpr size_t WS_WD = WS_WGU + (size_t)32 * 512 * DM * 2;
constexpr size_t WS_XS = WS_P1;
constexpr size_t WS_END = WS_P1 + (size_t)NROW * NP1 * 2;
static_assert(WS_WD + (size_t)32 * DM * 256 * 2 <= WS_END, "moe weights must fit in the P1 tail");
static_assert((size_t)XS_ROWS * DM * 2 <= (size_t)NROW * NGATE * 2, "XS must fit in the G region");
static_assert((size_t)NVT * NROW * 2 + (size_t)NROW * 512 * 2 >= (size_t)NROW * DM * 2, "HX2 alias");
static_assert(WS_END <= 434800000ull, "workspace budget");

constexpr int NTHR = 512;
constexpr int LDS_BYTES = 144 * 1024;

struct Params {
    const float *x, *c, *ctx, *c_ctx, *w_mod, *b_mod, *w_in, *gla_lr_w, *gla_lr_b, *hg_gamma, *na_rpb, *wa_sink, *w_branch, *w_out, *ln_g, *ln_b,
        *moe_w_group, *moe_b_group, *moe_w_expert, *moe_b_expert, *moe_w_gate, *moe_w_up, *moe_w_down;
    float* out;
    unsigned char* ws;
    int ph_lo, ph_hi;
};

__device__ __forceinline__ float bf2f(bf16_t b) { return __uint_as_float(((unsigned)b) << 16); }
__device__ __forceinline__ bf16_t f2bf(float f) { unsigned u = __float_as_uint(f); u += 0x7FFFu + ((u >> 16) & 1u); return (bf16_t)(u >> 16); }
__device__ __forceinline__ unsigned pk2(float lo, float hi) { return (unsigned)f2bf(lo) | ((unsigned)f2bf(hi) << 16); }
__device__ __forceinline__ void ld8(const bf16_t* p, float* f) {
    const u32x4 v = *(const u32x4*)p;
    f[0] = __uint_as_float(v.x << 16); f[1] = __uint_as_float(v.x & 0xffff0000u);
    f[2] = __uint_as_float(v.y << 16); f[3] = __uint_as_float(v.y & 0xffff0000u);
    f[4] = __uint_as_float(v.z << 16); f[5] = __uint_as_float(v.z & 0xffff0000u);
    f[6] = __uint_as_float(v.w << 16); f[7] = __uint_as_float(v.w & 0xffff0000u);
}
__device__ __forceinline__ void st8(bf16_t* p, const float* f) {
    u32x4 v; v.x = pk2(f[0], f[1]); v.y = pk2(f[2], f[3]); v.z = pk2(f[4], f[5]); v.w = pk2(f[6], f[7]);
    *(u32x4*)p = v;
}
__device__ __forceinline__ float sigmoidf_(float x) { return 1.f / (1.f + expf(-x)); }
__device__ __forceinline__ float siluf_(float x) { return x / (1.f + expf(-x)); }
__device__ __forceinline__ float wave_sum(float v) {
#pragma unroll
    for (int o = 1; o < 64; o <<= 1) v += __shfl_xor(v, o);
    return v;
}
__device__ __forceinline__ int row_batch(int row) { return row < NTOK ? (row >> 12) : 4; }

#define XB_TMO      128
#define XB_XCNT(j)  (256  + 64 * (j))
#define XB_XSUB(j)  (1280 + 64 * (j))
#define XB_XGEN(j)  (2304 + 64 * (j))
#define XB_TOP      3328
#define XB_TOPGEN   3392
#define XCD_BAR_WORDS 3456
#define XB_SPIN_CAP (1u << 18)
#define LAS __attribute__((address_space(3)))
__device__ __forceinline__ unsigned xb_ld(unsigned* p)              { return __hip_atomic_load(p, __ATOMIC_RELAXED, __HIP_MEMORY_SCOPE_AGENT); }
__device__ __forceinline__ unsigned xb_add(unsigned* p, unsigned v) { return __hip_atomic_fetch_add(p, v, __ATOMIC_RELAXED, __HIP_MEMORY_SCOPE_AGENT); }
__device__ __forceinline__ unsigned xb_xcc_id() { return (unsigned)__builtin_amdgcn_s_getreg((3 << 11) | 20) & 0xFu; }
#define XB_SPIN(cond, bar) do { unsigned _sp = 0; while (cond) { __builtin_amdgcn_s_sleep(1); \
    if ((++_sp & 255u) == 0u) { if (xb_ld(&(bar)[XB_TMO])) break; if (_sp > XB_SPIN_CAP) { atomicAdd(&(bar)[XB_TMO], 1u); break; } } } } while (0)
struct XcdBarrier { unsigned* bar; unsigned x; volatile LAS unsigned* st; };
__device__ __forceinline__ XcdBarrier xcd_barrier_post(unsigned* bar, volatile LAS unsigned* st) {
    XcdBarrier b; b.bar = bar; b.x = xb_xcc_id(); b.st = st;
    if (threadIdx.x == 0) (void)xb_add(&bar[XB_XCNT(b.x)], 1u);
    return b;
}
__device__ __forceinline__ void xcd_barrier_complete(unsigned* bar, unsigned x, unsigned& nloc, unsigned& nx) {
    const unsigned G = gridDim.x * gridDim.y * gridDim.z;
    unsigned sum, cnt, mine, sp = 0u;
    for (;;) {
        sum = 0u; cnt = 0u; mine = 0u;
#pragma unroll
        for (unsigned j = 0; j < 16; ++j) { const unsigned c = xb_ld(&bar[XB_XCNT(j)]); sum += c; cnt += (c > 0u) ? 1u : 0u; mine = (j == x) ? c : mine; }
        if (sum == G) break;
        __builtin_amdgcn_s_sleep(1);
        if ((++sp & 255u) == 0u) { if (xb_ld(&bar[XB_TMO])) break; if (sp > XB_SPIN_CAP) { atomicAdd(&bar[XB_TMO], 1u); break; } }
    }
    nloc = mine > 0u ? mine : 1u; nx = cnt > 0u ? cnt : 1u;
}
__device__ __forceinline__ void xcd_barrier(const XcdBarrier& b) {
    asm volatile("s_waitcnt vmcnt(0)" ::: "memory");
    __syncthreads();
    if (threadIdx.x == 0) {
        unsigned* bar = b.bar;
        __builtin_amdgcn_s_waitcnt(0);
        unsigned nloc = b.st[0], nx = b.st[1];
        if (nloc == 0u) { xcd_barrier_complete(bar, b.x, nloc, nx); b.st[0] = nloc; b.st[1] = nx; }
        const unsigned old = xb_add(&bar[XB_XSUB(b.x)], 1u);
        const unsigned gen = old / nloc;
        if (old + 1u == (gen + 1u) * nloc) {
            __builtin_amdgcn_fence(__ATOMIC_RELEASE, "agent");
            asm volatile("s_waitcnt vmcnt(0)" ::: "memory");
            const unsigned og = xb_add(&bar[XB_TOP], 1u);
            const unsigned tg = og / nx;
            if (og + 1u == (tg + 1u) * nx) xb_add(&bar[XB_TOPGEN], 1u);
            else XB_SPIN(xb_ld(&bar[XB_TOPGEN]) == tg, bar);
            __builtin_amdgcn_fence(__ATOMIC_ACQUIRE, "agent");
            xb_add(&bar[XB_XGEN(b.x)], 1u);
            asm volatile("s_waitcnt vmcnt(0)" ::: "memory");
        } else {
            XB_SPIN(xb_ld(&bar[XB_XGEN(b.x)]) == gen, bar);
            __builtin_amdgcn_fence(__ATOMIC_ACQUIRE, "agent");
            asm volatile("s_waitcnt vmcnt(0)" ::: "memory");
        }
    }
    __syncthreads();
}

struct Frame {
    Params p;
    int bid, nb, tid, lane, wave;
    float* smf;
    unsigned char* ws;
    __device__ __forceinline__ float* modv() const { return (float*)(ws + WS_MODV); }
    __device__ __forceinline__ float* lb() const { return (float*)(ws + WS_LB); }
    __device__ __forceinline__ int* tokE() const { return (int*)(ws + WS_TOKE); }
    __device__ __forceinline__ int* tokI() const { return (int*)(ws + WS_TOKI); }
    __device__ __forceinline__ float* tokW() const { return (float*)(ws + WS_TOKW); }
    __device__ __forceinline__ int* rmap() const { return (int*)(ws + WS_RMAP); }
    __device__ __forceinline__ float* roww() const { return (float*)(ws + WS_ROWW); }
    __device__ __forceinline__ float* cxm() const { return (float*)(ws + WS_CXM); }
    __device__ __forceinline__ float* cxo() const { return (float*)(ws + WS_CXO); }
    __device__ __forceinline__ bf16_t* W1t() const { return (bf16_t*)(ws + WS_WTA + WTA_W1); }
    __device__ __forceinline__ bf16_t* Wvt() const { return (bf16_t*)(ws + WS_WTA + WTA_WV); }
    __device__ __forceinline__ bf16_t* Wgt() const { return (bf16_t*)(ws + WS_WTA + WTA_WG); }
    __device__ __forceinline__ bf16_t* Wbrt() const { return (bf16_t*)(ws + WS_WTA + WTA_WBR); }
    __device__ __forceinline__ bf16_t* Woutt() const { return (bf16_t*)(ws + WS_WTA + WTA_WO); }
    __device__ __forceinline__ bf16_t* HX() const { return (bf16_t*)(ws + WS_HX); }
    __device__ __forceinline__ bf16_t* VT() const { return (bf16_t*)(ws + WS_VT); }
    __device__ __forceinline__ bf16_t* OBA() const { return (bf16_t*)(ws + WS_OBA); }
    __device__ __forceinline__ bf16_t* HX2() const { return (bf16_t*)(ws + WS_HX2); }
    __device__ __forceinline__ bf16_t* HID() const { return (bf16_t*)(ws + WS_HID); }
    __device__ __forceinline__ bf16_t* VR() const { return (bf16_t*)(ws + WS_VR); }
    __device__ __forceinline__ bf16_t* BR() const { return (bf16_t*)(ws + WS_BR); }
    __device__ __forceinline__ bf16_t* P1() const { return (bf16_t*)(ws + WS_P1); }
    __device__ __forceinline__ bf16_t* G() const { return (bf16_t*)(ws + WS_G); }
    __device__ __forceinline__ bf16_t* Wgu() const { return (bf16_t*)(ws + WS_WGU); }
    __device__ __forceinline__ bf16_t* Wd() const { return (bf16_t*)(ws + WS_WD); }
    __device__ __forceinline__ bf16_t* XS() const { return (bf16_t*)(ws + WS_XS); }
    __device__ __forceinline__ unsigned* cnt() const { return (unsigned*)(ws + WS_CTL + CTL_CNT); }
};


__device__ void phase_mod(Frame& F) {
    float* sc = F.smf;
    float* red = F.smf + 5 * 1024;
    bool have = false;
    for (int it = F.bid; it < DEPTH * 96; it += F.nb) {
        if (!have) {
            for (int i = F.tid; i < 5 * 1024; i += NTHR) { const float v = (i < 4096) ? F.p.c[i] : F.p.c_ctx[i - 4096]; sc[i] = siluf_(v); }
            __syncthreads(); have = true;
        }
        const int l = it / 96, n0 = (it % 96) * 64, col = F.tid & 63, kg = F.tid >> 6;
        const float* w = F.p.w_mod + (size_t)l * DM * 6144 + n0 + col;
        float a[5] = {0.f, 0.f, 0.f, 0.f, 0.f};
        for (int k = kg * 128; k < kg * 128 + 128; ++k) {
            const float wv = w[(size_t)k * 6144];
#pragma unroll
            for (int r = 0; r < 5; ++r) a[r] += sc[r * 1024 + k] * wv;
        }
#pragma unroll
        for (int r = 0; r < 5; ++r) red[(kg * 5 + r) * 64 + col] = a[r];
        __syncthreads();
        if (F.tid < 320) {
            const int r = F.tid >> 6, cc = F.tid & 63; float s = F.p.b_mod[l * 6144 + n0 + cc];
#pragma unroll
            for (int g = 0; g < 8; ++g) s += red[(g * 5 + r) * 64 + cc];
            F.modv()[((size_t)l * 5 + r) * 6144 + n0 + cc] = s;
        }
        __syncthreads();
    }
    if (F.bid == F.nb - 1) {
        for (int i = F.tid; i < 1024; i += NTHR) { const int z = i >> 9, f = i & 511;
            const float g0 = F.p.hg_gamma[(z * DEPTH + 0) * 512 + f], g1 = F.p.hg_gamma[(z * DEPTH + 1) * 512 + f];
            F.lb()[i] = 1.f / (1.f + expf(g0 - g1)); }
    }
}

__device__ __forceinline__ int p1_src(int n, float& scale) {
    scale = 1.f;
    if (n < 256) { scale = 0.125f; return O_AQ + n; }
    if (n < 512) return O_AK + (n - 256);
    if (n < 1024) return O_AV + (n - 512);
    if (n < 1056) return O_ALR + (n - 1024);
    if (n < 1280) return -1;
    if (n < 1792) { scale = 0.125f; return O_BQ + (n - 1280); }
    if (n < 2304) return O_BK + (n - 1792);
    if (n < 2816) { scale = 0.125f; return O_CQ + (n - 2304); }
    if (n < 2944) return O_CK + (n - 2816);
    if (n < 3072) return -1;
    if (n < 3584) return O_DQ + (n - 3072);
    if (n < 4608) return O_DF + (n - 3584);
    if (n < 5120) return O_DI + (n - 4608);
    if (n < 5632) return O_AG + (n - 5120);
    return O_DG + (n - 5632);
}
__device__ __forceinline__ void conv_tile(const float* src, int ldsrc, int srccol, float scale, bf16_t* dst, int K, int k0, float* tile, int tid) {
#pragma unroll
    for (int p = 0; p < 2; ++p) { const int kk = (tid >> 5) + 16 * p, nn = tid & 31;
        tile[kk * 33 + nn] = (srccol >= 0) ? src[(size_t)(k0 + kk) * ldsrc + srccol + nn] * scale : 0.f; }
    __syncthreads();
    { const int nn = tid >> 4, kp = (tid & 15) * 2;
      *(unsigned*)(dst + (size_t)nn * K + kp) = pk2(tile[kp * 33 + nn], tile[(kp + 1) * 33 + nn]); }
    __syncthreads();
}
constexpr int CONVA_TILES = 6144 + 768 + 4096 + 2048 + 1024;
__device__ void phase_conv_a(Frame& F, int l) {
    float* tile = F.smf;
    for (int ti0 = F.bid; ti0 < CONVA_TILES; ti0 += F.nb) {
        int ti = ti0;
        if (ti < 6144) { const int n0 = (ti >> 5) * 32, kt = ti & 31; float sc; const int s = p1_src(n0, sc);
            conv_tile(F.p.w_in + (size_t)l * DM * DIN, DIN, s, sc, F.W1t() + (size_t)n0 * DM + kt * 32, DM, kt * 32, tile, F.tid); continue; }
        ti -= 6144;
        if (ti < 768) { const int n0 = (ti >> 5) * 32, kt = ti & 31; const int s = n0 < 512 ? O_BV + n0 : (n0 < 640 ? O_CV + (n0 - 512) : -1);
            conv_tile(F.p.w_in + (size_t)l * DM * DIN, DIN, s, 1.f, F.Wvt() + (size_t)n0 * DM + kt * 32, DM, kt * 32, tile, F.tid); continue; }
        ti -= 768;
        if (ti < 4096) { const int n0 = (ti >> 5) * 32, kt = ti & 31;
            conv_tile(F.p.w_in + (size_t)l * DM * DIN, DIN, O_GATE + n0, 1.f, F.Wgt() + (size_t)n0 * DM + kt * 32, DM, kt * 32, tile, F.tid); continue; }
        ti -= 4096;
        if (ti < 2048) { const int i = ti >> 9, r = ti & 511, n0 = (r >> 4) * 32, kt = r & 15;
            conv_tile(F.p.w_branch + (size_t)(l * 4 + i) * 512 * DM, DM, n0, 1.f, F.Wbrt() + (size_t)i * DM * 512 + (size_t)n0 * 512 + kt * 32, 512, kt * 32, tile, F.tid); continue; }
        ti -= 2048;
        { const int n0 = (ti >> 5) * 32, kt = ti & 31;
          conv_tile(F.p.w_out + (size_t)l * DM * DM, DM, n0, 1.f, F.Woutt() + (size_t)n0 * DM + kt * 32, DM, kt * 32, tile, F.tid); }
    }
}
constexpr int CONVB_TILES = 16384 + 8192;
__device__ void phase_conv_b(Frame& F, int l) {
    float* tile = F.smf;
    for (int ti0 = F.bid; ti0 < CONVB_TILES; ti0 += F.nb) {
        int ti = ti0;
        if (ti < 16384) { const int e = ti >> 9, r = ti & 511, n0 = (r >> 5) * 32, kt = r & 31, j = n0 >> 8, rr = n0 & 255; const bool isup = rr >= 128; const int cc = 128 * j + (rr & 127);
            const float* src = (isup ? F.p.moe_w_up : F.p.moe_w_gate) + (size_t)(l * 32 + e) * DM * 256;
            conv_tile(src, 256, cc, 1.f, F.Wgu() + (size_t)e * 512 * DM + (size_t)n0 * DM + kt * 32, DM, kt * 32, tile, F.tid); continue; }
        ti -= 16384;
        { const int e = ti >> 8, r = ti & 255, n0 = (r >> 3) * 32, kt = r & 7;
          conv_tile(F.p.moe_w_down + (size_t)(l * 32 + e) * 256 * DM, DM, n0, 1.f, F.Wd() + (size_t)e * DM * 256 + (size_t)n0 * 256 + kt * 32, 256, kt * 32, tile, F.tid); }
    }
}

__device__ void phase_prep(Frame& F, int l, const float* xlat, const float* xctx) {
    const int gw = F.bid * 8 + F.wave, ngw = F.nb * 8;
    for (int row = gw; row < NROW; row += ngw) {
        const float* xr = row < NTOK ? xlat + (size_t)row * DM : xctx + (size_t)(row - NTOK) * DM;
        const float* mv = F.modv() + ((size_t)l * 5 + row_batch(row)) * 6144;
#pragma unroll
        for (int j = 0; j < 4; ++j) { const int d = j * 256 + F.lane * 4;
            const f32x4 v = *(const f32x4*)(xr + d), m0 = *(const f32x4*)(mv + d), m1 = *(const f32x4*)(mv + 1024 + d);
            u32x2 o; o.x = pk2(v.x * (1.f + m1.x) + m0.x, v.y * (1.f + m1.y) + m0.y); o.y = pk2(v.z * (1.f + m1.z) + m0.z, v.w * (1.f + m1.w) + m0.w);
            *(u32x2*)(F.HX() + (size_t)row * DM + d) = o; }
    }
}

__device__ __forceinline__ void gemm_s_acc(float (&acc)[8][4], const bf16_t* A, int lda, const bf16_t* Bt, int ldb, int K, int row0, int col0, float* sm, int tid) {
    float* As = sm; float* Bs = sm + 32 * 132;
    const int ty = tid >> 5, tx = tid & 31, lr = tid >> 2, lk = (tid & 3) * 8;
    for (int k0 = 0; k0 < K; k0 += 32) {
        float fa[8], fb[8];
        ld8(A + (size_t)(row0 + lr) * lda + k0 + lk, fa);
        ld8(Bt + (size_t)(col0 + lr) * ldb + k0 + lk, fb);
        __syncthreads();
#pragma unroll
        for (int j = 0; j < 8; ++j) { As[(lk + j) * 132 + lr] = fa[j]; Bs[(lk + j) * 132 + lr] = fb[j]; }
        __syncthreads();
#pragma unroll 4
        for (int k = 0; k < 32; ++k) {
            const f32x4 a0 = *(const f32x4*)&As[k * 132 + ty * 8], a1 = *(const f32x4*)&As[k * 132 + ty * 8 + 4], b = *(const f32x4*)&Bs[k * 132 + tx * 4];
            const float a[8] = {a0.x, a0.y, a0.z, a0.w, a1.x, a1.y, a1.z, a1.w}; const float bb[4] = {b.x, b.y, b.z, b.w};
#pragma unroll
            for (int i = 0; i < 8; ++i)
#pragma unroll
                for (int j = 0; j < 4; ++j) acc[i][j] += a[i] * bb[j];
        }
    }
    __syncthreads();
}
template <class Epi>
__device__ void gemm_s(Frame& F, const bf16_t* A, int lda, const bf16_t* Bt, int ldb, int M, int N, int K, const Epi& epi) {
    const int tn = N / 128, nt = (M / 128) * tn, ty = F.tid >> 5, tx = F.tid & 31;
    for (int t = F.bid; t < nt; t += F.nb) {
        const int row0 = (t / tn) * 128, col0 = (t % tn) * 128;
        float acc[8][4];
#pragma unroll
        for (int i = 0; i < 8; ++i)
#pragma unroll
            for (int j = 0; j < 4; ++j) acc[i][j] = 0.f;
        gemm_s_acc(acc, A, lda, Bt, ldb, K, row0, col0, F.smf, F.tid);
#pragma unroll
        for (int i = 0; i < 8; ++i)
#pragma unroll
            for (int j = 0; j < 4; ++j) epi(row0 + ty * 8 + i, col0 + tx * 4 + j, acc[i][j]);
    }
}

__device__ __forceinline__ void moe_offsets(Frame& F, int l, int* off) {
    if (F.tid == 0) { int a = 0; for (int e = 0; e < 32; ++e) { off[e] = a; a += ((int)F.cnt()[l * 32 + e] + 255) & ~255; } off[32] = a; }
    __syncthreads();
}

__device__ void phase_rope(Frame& F) {
    const size_t total = (size_t)NTOK * 320;
    for (size_t idx = (size_t)F.bid * NTHR + F.tid; idx < total; idx += (size_t)F.nb * NTHR) {
        const int row = (int)(idx / 320), r = (int)(idx % 320), h = r >> 5, half = (r >> 4) & 1, i = r & 15;
        const int pos = row & (SEQ - 1), pp = half ? (pos & 63) : (pos >> 6);
        const float inv = powf(10000.f, -(float)i / 16.f), ang = (float)pp * inv, cs = cosf(ang), sn = sinf(ang);
        bf16_t* base = F.P1() + (size_t)row * NP1 + (h < 8 ? PC_CQ + h * 64 : PC_CK + (h - 8) * 64) + half * 32 + i;
        const float u1 = bf2f(base[0]), u2 = bf2f(base[16]);
        base[0] = f2bf(u1 * cs - u2 * sn); base[16] = f2bf(u1 * sn + u2 * cs);
    }
}

__device__ __forceinline__ int seq_row(int s, int b, int z) {
    if (s < LC) { const int tc = z ? (LC - 1 - s) : s; return NTOK + b * LC + tc; }
    const int tl = s - LC, t = z ? (SEQ - 1 - tl) : tl; return b * SEQ + t;
}
template <int DK, bool HG>
__device__ void scan_simple(Frame& F, int l, int b, int h, int z) {
    constexpr int DPB = DK / 4;
    float* eg = F.smf; float* kk = eg + 16 * DK; float* qq = kk + 16 * DK; float* vv = qq + 16 * DK; float* op = vv + 16 * 128;
    const int tid = F.tid, v = tid & 127, db = tid >> 7;
    float S[DPB];
#pragma unroll
    for (int i = 0; i < DPB; ++i) S[i] = 0.f;
    for (int step = 0; step < (LC + SEQ) / 16; ++step) {
        for (int idx = tid; idx < 16 * DK; idx += NTHR) {
            const int i = idx / DK, d = idx % DK, row = seq_row(step * 16 + i, b, z);
            const bf16_t* pr = F.P1() + (size_t)row * NP1;
            float e, k, q;
            if (HG) {
                const float f = bf2f(pr[PC_DF + z * 512 + h * 128 + d]), sg = sigmoidf_(f), lbv = (l == 0) ? 0.f : F.lb()[z * 512 + h * 128 + d];
                const float fg = lbv + (1.f - lbv) * sg; e = fg; k = (1.f - lbv) * (1.f - sg);
                q = siluf_(bf2f(pr[PC_DQ + h * 128 + d]));
            } else {
                float lg = F.p.gla_lr_b[(l * 2 + z) * 256 + h * 64 + d];
#pragma unroll
                for (int r = 0; r < 16; ++r) lg += bf2f(pr[PC_ALR + z * 16 + r]) * F.p.gla_lr_w[((size_t)(l * 2 + z) * 16 + r) * 256 + h * 64 + d];
                const float ls = fminf(lg, 0.f) - log1pf(expf(-fabsf(lg)));
                e = expf(ls * (1.f / 16.f)); k = bf2f(pr[PC_AK + h * 64 + d]); q = bf2f(pr[PC_AQ + h * 64 + d]);
            }
            eg[idx] = e; kk[idx] = k; qq[idx] = q;
        }
        for (int idx = tid; idx < 16 * 128; idx += NTHR) {
            const int i = idx >> 7, c = idx & 127, row = seq_row(step * 16 + i, b, z);
            vv[idx] = bf2f(F.P1()[(size_t)row * NP1 + (HG ? PC_DI : PC_AV) + h * 128 + c]);
        }
        __syncthreads();
        for (int i = 0; i < 16; ++i) {
            const float vval = vv[i * 128 + v]; float o = 0.f;
#pragma unroll
            for (int dd = 0; dd < DPB; ++dd) { const int d = db * DPB + dd; S[dd] = eg[i * DK + d] * S[dd] + kk[i * DK + d] * vval; o += S[dd] * qq[i * DK + d]; }
            op[(i * 4 + db) * 128 + v] = o;
        }
        __syncthreads();
        for (int idx = tid; idx < 16 * 128; idx += NTHR) {
            const int i = idx >> 7, c = idx & 127, row = seq_row(step * 16 + i, b, z);
            const float o = op[(i * 4 + 0) * 128 + c] + op[(i * 4 + 1) * 128 + c] + op[(i * 4 + 2) * 128 + c] + op[(i * 4 + 3) * 128 + c];
            bf16_t* dst;
            if (HG) dst = F.P1() + (size_t)row * NP1 + PC_DF + z * 512 + h * 128 + c;
            else dst = (z == 0) ? F.BR() + (size_t)row * 2048 + h * 128 + c : F.OBA() + (size_t)row * 512 + h * 128 + c;
            *dst = f2bf(o);
        }
        __syncthreads();
    }
}

struct AttnAcc { float m, l; float o[64]; };
__device__ __forceinline__ void attn_key(const float (&q)[64], AttnAcc& a, const bf16_t* kp, const bf16_t* vp, float bias) {
    float s = bias;
#pragma unroll
    for (int c = 0; c < 8; ++c) { float f[8]; ld8(kp + c * 8, f);
#pragma unroll
        for (int j = 0; j < 8; ++j) s += q[c * 8 + j] * f[j]; }
    if (s > a.m) { const float sc = expf(a.m - s); a.l *= sc;
#pragma unroll
        for (int i = 0; i < 64; ++i) a.o[i] *= sc;
        a.m = s; }
    const float pr = expf(s - a.m); a.l += pr;
#pragma unroll
    for (int c = 0; c < 8; ++c) { float f[8]; ld8(vp + c * 8, f);
#pragma unroll
        for (int j = 0; j < 8; ++j) a.o[c * 8 + j] += pr * f[j]; }
}
__device__ __forceinline__ void attn_init(AttnAcc& a) { a.m = -1e30f; a.l = 0.f;
#pragma unroll
    for (int i = 0; i < 64; ++i) a.o[i] = 0.f; }
__device__ __forceinline__ void attn_loadq(float (&q)[64], const bf16_t* qp) {
#pragma unroll
    for (int c = 0; c < 8; ++c) ld8(qp + c * 8, &q[c * 8]); }
__device__ __forceinline__ void attn_store(const AttnAcc& a, bf16_t* op) {
    const float il = 1.f / a.l;
#pragma unroll
    for (int c = 0; c < 8; ++c) { float t[8];
#pragma unroll
        for (int j = 0; j < 8; ++j) t[j] = a.o[c * 8 + j] * il;
        st8(op + c * 8, t); } }

template <int kind>
__device__ void attn_simple(Frame& F, int l, int item) {
    const int c = F.tid & 63, h = F.tid >> 6;
    float q[64]; AttnAcc a; attn_init(a);
    if (kind == 0) {
        const int b = item >> 6, r = item & 63, row = b * SEQ + r * 64 + c;
        attn_loadq(q, F.P1() + (size_t)row * NP1 + PC_BQ + h * 64);
        const int rs = min(max(r - 4, 0), 56), cs = min(max(c - 8, 0), 48);
        for (int kr = rs; kr < rs + 8; ++kr) {
            const float* bp = F.p.na_rpb + ((size_t)(l * 8 + h) * 15 + (kr - r + 7)) * 31 + (cs - c + 15);
            for (int kc = 0; kc < 16; ++kc) { const int krow = b * SEQ + kr * 64 + cs + kc;
                attn_key(q, a, F.P1() + (size_t)krow * NP1 + PC_BK + h * 64, F.VR() + (size_t)krow * NVR + h * 64, bp[kc]); }
        }
        for (int n = 0; n < LC; ++n) { const int crow = NTOK + b * LC + n;
            attn_key(q, a, F.P1() + (size_t)crow * NP1 + PC_BK + h * 64, F.VR() + (size_t)crow * NVR + h * 64, 0.f); }
        attn_store(a, F.BR() + (size_t)row * 2048 + 512 + h * 64);
    } else if (kind == 1) {
        const int b = item >> 6, g = item & 63, t = g * 64 + c, row = b * SEQ + t, kvh = h >> 2;
        attn_loadq(q, F.P1() + (size_t)row * NP1 + PC_CQ + h * 64);
        const int j0 = max(t - 128, 0), j1 = min(t + 128, SEQ - 1);
        for (int j = j0; j <= j1; ++j) { const int krow = b * SEQ + j;
            attn_key(q, a, F.P1() + (size_t)krow * NP1 + PC_CK + kvh * 64, F.VR() + (size_t)krow * NVR + 512 + kvh * 64, 0.f); }
        for (int n = 0; n < LC; ++n) { const int crow = NTOK + b * LC + n;
            attn_key(q, a, F.P1() + (size_t)crow * NP1 + PC_CK + kvh * 64, F.VR() + (size_t)crow * NVR + 512 + kvh * 64, 0.f); }
        const float sk = F.p.wa_sink[l * 8 + h];
        if (sk > a.m) { const float sc = expf(a.m - sk); a.l *= sc;
#pragma unroll
            for (int i = 0; i < 64; ++i) a.o[i] *= sc;
            a.m = sk; }
        a.l += expf(sk - a.m);
        attn_store(a, F.BR() + (size_t)row * 2048 + 1024 + h * 64);
    } else {
        const int b = item >> 2, g = item & 3, qrow = NTOK + b * LC + g * 64 + c, kvh = h >> 2;
        const int qc = (kind == 2) ? PC_BQ + h * 64 : PC_CQ + h * 64, kc = (kind == 2) ? PC_BK + h * 64 : PC_CK + kvh * 64, vc = (kind == 2) ? h * 64 : 512 + kvh * 64;
        attn_loadq(q, F.P1() + (size_t)qrow * NP1 + qc);
        for (int n = 0; n < LC; ++n) { const int crow = NTOK + b * LC + n;
            attn_key(q, a, F.P1() + (size_t)crow * NP1 + kc, F.VR() + (size_t)crow * NVR + vc, 0.f); }
        if (kind == 3) { const float sk = F.p.wa_sink[l * 8 + h];
            if (sk > a.m) { const float sc = expf(a.m - sk); a.l *= sc;
#pragma unroll
                for (int i = 0; i < 64; ++i) a.o[i] *= sc;
                a.m = sk; }
            a.l += expf(sk - a.m); }
        attn_store(a, F.BR() + (size_t)qrow * 2048 + (kind == 2 ? 512 : 1024) + h * 64);
    }
}

__device__ void phase_mix(Frame& F, int l) {
    const int n_scan = 64, n_na = 256, n_wa = 256, n_ctx = (l == 0) ? 32 : 0, total = n_scan + n_na + n_wa + n_ctx;
    for (int it = F.bid; it < total; it += F.nb) {
        if (it < n_scan) {
            const int br = it >> 5, r = it & 31, b = r >> 3, h = (r >> 1) & 3, z = r & 1;
            if (br == 0) scan_simple<64, false>(F, l, b, h, z); else scan_simple<128, true>(F, l, b, h, z);
        } else if (it < n_scan + n_na) attn_simple<0>(F, l, it - n_scan);
        else if (it < n_scan + n_na + n_wa) attn_simple<1>(F, l, it - n_scan - n_na);
        else { const int j = it - n_scan - n_na - n_wa; if (j < 16) attn_simple<2>(F, l, j); else attn_simple<3>(F, l, j - 16); }
    }
}

__device__ void phase_prepad(Frame& F, int l) {
    const int gw = F.bid * 8 + F.wave, ngw = F.nb * 8, nrows = (l == 0) ? NROW : NTOK;
    for (int row = gw; row < nrows; row += ngw) {
        const int c0 = F.lane * 8;
        {   float a[8], b[8], g[8], o[8];
            ld8(F.BR() + (size_t)row * 2048 + c0, a); ld8(F.OBA() + (size_t)row * 512 + c0, b); ld8(F.P1() + (size_t)row * NP1 + PC_AG + c0, g);
            float ss = 0.f;
#pragma unroll
            for (int j = 0; j < 8; ++j) { o[j] = a[j] + b[j]; ss += o[j] * o[j]; }
            ss += __shfl_xor(ss, 1); ss += __shfl_xor(ss, 2); ss += __shfl_xor(ss, 4); ss += __shfl_xor(ss, 8);
            const float rs = rsqrtf(ss * (1.f / 128.f) + 1e-6f);
#pragma unroll
            for (int j = 0; j < 8; ++j) o[j] = o[j] * rs * siluf_(g[j]);
            st8(F.BR() + (size_t)row * 2048 + c0, o); }
        {   float a[8], b[8], g[8], o[8];
            ld8(F.P1() + (size_t)row * NP1 + PC_DF + c0, a); ld8(F.P1() + (size_t)row * NP1 + PC_DF + 512 + c0, b); ld8(F.P1() + (size_t)row * NP1 + PC_DG + c0, g);
            float ss = 0.f;
#pragma unroll
            for (int j = 0; j < 8; ++j) { o[j] = a[j] + b[j]; ss += o[j] * o[j]; }
            ss += __shfl_xor(ss, 1); ss += __shfl_xor(ss, 2); ss += __shfl_xor(ss, 4); ss += __shfl_xor(ss, 8);
            const float rs = rsqrtf(ss * (1.f / 128.f) + 1e-6f);
#pragma unroll
            for (int j = 0; j < 8; ++j) o[j] = o[j] * rs * siluf_(g[j]);
            st8(F.BR() + (size_t)row * 2048 + 1536 + c0, o); }
    }
}

__device__ void phase_merge_s(Frame& F, int l) {
    const int M = (l == 0) ? NROW : NTOK, tn = DM / 128, nt = (M / 128) * tn, ty = F.tid >> 5, tx = F.tid & 31;
    for (int t = F.bid; t < nt; t += F.nb) {
        const int row0 = (t / tn) * 128, col0 = (t % tn) * 128;
        float sum[8][4];
#pragma unroll
        for (int i = 0; i < 8; ++i)
#pragma unroll
            for (int j = 0; j < 4; ++j) sum[i][j] = 0.f;
#pragma unroll 1
        for (int br = 0; br < 4; ++br) {
            float acc[8][4];
#pragma unroll
            for (int i = 0; i < 8; ++i)
#pragma unroll
                for (int j = 0; j < 4; ++j) acc[i][j] = 0.f;
            gemm_s_acc(acc, F.BR() + br * 512, 2048, F.Wbrt() + (size_t)br * DM * 512, 512, 512, row0, col0, F.smf, F.tid);
#pragma unroll
            for (int i = 0; i < 8; ++i) { const u32x2 g2 = *(const u32x2*)(F.G() + (size_t)(row0 + ty * 8 + i) * NGATE + br * 1024 + col0 + tx * 4);
                sum[i][0] += __uint_as_float(g2.x << 16) * acc[i][0]; sum[i][1] += __uint_as_float(g2.x & 0xffff0000u) * acc[i][1];
                sum[i][2] += __uint_as_float(g2.y << 16) * acc[i][2]; sum[i][3] += __uint_as_float(g2.y & 0xffff0000u) * acc[i][3]; }
        }
#pragma unroll
        for (int i = 0; i < 8; ++i) { u32x2 o2; o2.x = pk2(sum[i][0], sum[i][1]); o2.y = pk2(sum[i][2], sum[i][3]);
            *(u32x2*)(F.HX() + (size_t)(row0 + ty * 8 + i) * DM + col0 + tx * 4) = o2; }
    }
}

__device__ void phase_ln1(Frame& F, int l) {
    const int gw = F.bid * 8 + F.wave, ngw = F.nb * 8, nrows = (l == 0) ? NROW : NTOK;
    const float* lg = F.p.ln_g + (size_t)(l * 2 + 0) * DM; const float* lbb = F.p.ln_b + (size_t)(l * 2 + 0) * DM;
    const float* wg = F.p.moe_w_group + (size_t)l * DM * 4; const float* we = F.p.moe_w_expert + (size_t)l * DM * 32;
    for (int row = gw; row < nrows; row += ngw) {
        float* xr = row < NTOK ? F.p.out + (size_t)row * DM : F.cxm() + (size_t)(row - NTOK) * DM;
        const float* mv = F.modv() + ((size_t)l * 5 + row_batch(row)) * 6144;
        f32x4 v[4]; float s = 0.f;
#pragma unroll
        for (int j = 0; j < 4; ++j) { v[j] = *(const f32x4*)(xr + j * 256 + F.lane * 4); s += (v[j].x + v[j].y) + (v[j].z + v[j].w); }
        const float mean = wave_sum(s) * (1.f / DM); float s2 = 0.f;
#pragma unroll
        for (int j = 0; j < 4; ++j) { v[j] = v[j] - mean; s2 += (v[j].x * v[j].x + v[j].y * v[j].y) + (v[j].z * v[j].z + v[j].w * v[j].w); }
        const float rstd = rsqrtf(wave_sum(s2) * (1.f / DM) + LN_EPS);
        float lgt[36];
#pragma unroll
        for (int o = 0; o < 36; ++o) lgt[o] = 0.f;
#pragma unroll
        for (int j = 0; j < 4; ++j) { const int d = j * 256 + F.lane * 4;
            const f32x4 g4 = *(const f32x4*)(lg + d), b4 = *(const f32x4*)(lbb + d), m3 = *(const f32x4*)(mv + 3 * 1024 + d), m4 = *(const f32x4*)(mv + 4 * 1024 + d);
            const f32x4 xn = v[j] * rstd * g4 + b4;
            *(f32x4*)(xr + d) = xn;
            const f32x4 h2 = xn * (1.f + m4) + m3;
            u32x2 o2; o2.x = pk2(h2.x, h2.y); o2.y = pk2(h2.z, h2.w);
            *(u32x2*)(F.HX2() + (size_t)row * DM + d) = o2;
            const float hh[4] = {h2.x, h2.y, h2.z, h2.w};
#pragma unroll
            for (int q = 0; q < 4; ++q) {
                const f32x4 w4 = *(const f32x4*)(wg + (size_t)(d + q) * 4);
                lgt[0] += hh[q] * w4.x; lgt[1] += hh[q] * w4.y; lgt[2] += hh[q] * w4.z; lgt[3] += hh[q] * w4.w;
#pragma unroll
                for (int o4 = 0; o4 < 8; ++o4) { const f32x4 e4 = *(const f32x4*)(we + (size_t)(d + q) * 32 + o4 * 4);
                    lgt[4 + o4 * 4 + 0] += hh[q] * e4.x; lgt[4 + o4 * 4 + 1] += hh[q] * e4.y; lgt[4 + o4 * 4 + 2] += hh[q] * e4.z; lgt[4 + o4 * 4 + 3] += hh[q] * e4.w; }
            }
        }
#pragma unroll
        for (int o = 0; o < 36; ++o) lgt[o] = wave_sum(lgt[o]);
        if (F.lane == 0) {
            float gl[4]; int gi = 0; float gm = -3.4e38f;
#pragma unroll
            for (int o = 0; o < 4; ++o) { gl[o] = lgt[o] + F.p.moe_b_group[l * 4 + o]; if (gl[o] > gm) { gm = gl[o]; gi = o; } }
            float gs = 0.f;
#pragma unroll
            for (int o = 0; o < 4; ++o) gs += expf(gl[o] - gm);
            const float gwt = 1.f / gs;
            float e1 = -3.4e38f, e2 = -3.4e38f; int i1 = 0, i2 = 0;
#pragma unroll
            for (int o = 0; o < 32; ++o) {
                if ((o >> 3) == gi) { const float ev = lgt[4 + o] + F.p.moe_b_expert[l * 32 + o];
                    if (ev > e1) { e2 = e1; i2 = i1; e1 = ev; i1 = o; } else if (ev > e2) { e2 = ev; i2 = o; } }
            }
            const float w1 = 1.f / (1.f + expf(e2 - e1)), w2 = 1.f - w1;
            const unsigned p1 = atomicAdd(&F.cnt()[l * 32 + i1], 1u), p2 = atomicAdd(&F.cnt()[l * 32 + i2], 1u);
            F.tokE()[row * 2] = i1; F.tokI()[row * 2] = (int)p1; F.tokW()[row * 2] = gwt * w1;
            F.tokE()[row * 2 + 1] = i2; F.tokI()[row * 2 + 1] = (int)p2; F.tokW()[row * 2 + 1] = gwt * w2;
        }
    }
}

__device__ void phase_gather(Frame& F, int l) {
    int* off = (int*)F.smf; moe_offsets(F, l, off);
    const int gw = F.bid * 8 + F.wave, ngw = F.nb * 8, nrows = (l == 0) ? NROW : NTOK;
    for (int s = gw; s < 2 * nrows; s += ngw) {
        const int e = F.tokE()[s], dst = off[e] + F.tokI()[s];
        const u32x4* src = (const u32x4*)(F.HX2() + (size_t)(s >> 1) * DM); u32x4* d = (u32x4*)(F.XS() + (size_t)dst * DM);
        d[F.lane] = src[F.lane]; d[F.lane + 64] = src[F.lane + 64];
        if (F.lane == 0) { F.rmap()[dst] = s; F.roww()[dst] = F.tokW()[s]; }
    }
    for (int e = 0; e < 32; ++e) {
        const int c = (int)F.cnt()[l * 32 + e], pc = (c + 255) & ~255;
        for (int j = c + gw; j < pc; j += ngw) { const int dst = off[e] + j; u32x4* d = (u32x4*)(F.XS() + (size_t)dst * DM);
            const u32x4 z = {0u, 0u, 0u, 0u}; d[F.lane] = z; d[F.lane + 64] = z;
            if (F.lane == 0) { F.rmap()[dst] = -1; F.roww()[dst] = 0.f; } }
    }
}
__device__ __forceinline__ int expert_of_row(const int* off, int row) { int e = 0;
#pragma unroll 1
    for (int i = 1; i < 32; ++i) if (row >= off[i]) e = i;
    return e; }

__device__ void phase_ln2(Frame& F, int l) {
    const int gw = F.bid * 8 + F.wave, ngw = F.nb * 8, nrows = (l == 0) ? NROW : NTOK;
    const float* lg = F.p.ln_g + (size_t)(l * 2 + 1) * DM; const float* lbb = F.p.ln_b + (size_t)(l * 2 + 1) * DM;
    const bf16_t* Y = F.BR();
    for (int row = gw; row < nrows; row += ngw) {
        const float* xm = row < NTOK ? F.p.out + (size_t)row * DM : F.cxm() + (size_t)(row - NTOK) * DM;
        float* xo = row < NTOK ? F.p.out + (size_t)row * DM : F.cxo() + (size_t)(row - NTOK) * DM;
        const float* mv = F.modv() + ((size_t)l * 5 + row_batch(row)) * 6144;
        f32x4 v[4]; float s = 0.f;
#pragma unroll
        for (int j = 0; j < 4; ++j) { const int d = j * 256 + F.lane * 4;
            const u32x2 y0 = *(const u32x2*)(Y + (size_t)(row * 2) * DM + d), y1 = *(const u32x2*)(Y + (size_t)(row * 2 + 1) * DM + d);
            f32x4 y; y.x = __uint_as_float(y0.x << 16) + __uint_as_float(y1.x << 16); y.y = __uint_as_float(y0.x & 0xffff0000u) + __uint_as_float(y1.x & 0xffff0000u);
            y.z = __uint_as_float(y0.y << 16) + __uint_as_float(y1.y << 16); y.w = __uint_as_float(y0.y & 0xffff0000u) + __uint_as_float(y1.y & 0xffff0000u);
            const f32x4 m5 = *(const f32x4*)(mv + 5 * 1024 + d);
            v[j] = ALPHA * *(const f32x4*)(xm + d) + m5 * y; s += (v[j].x + v[j].y) + (v[j].z + v[j].w); }
        const float mean = wave_sum(s) * (1.f / DM); float s2 = 0.f;
#pragma unroll
        for (int j = 0; j < 4; ++j) { v[j] = v[j] - mean; s2 += (v[j].x * v[j].x + v[j].y * v[j].y) + (v[j].z * v[j].z + v[j].w * v[j].w); }
        const float rstd = rsqrtf(wave_sum(s2) * (1.f / DM) + LN_EPS);
#pragma unroll
        for (int j = 0; j < 4; ++j) { const int d = j * 256 + F.lane * 4;
            const f32x4 g4 = *(const f32x4*)(lg + d), b4 = *(const f32x4*)(lbb + d);
            const f32x4 xn = v[j] * rstd * g4 + b4;
            *(f32x4*)(xo + d) = xn;
            if (l + 1 < DEPTH) { const float* mn = F.modv() + ((size_t)(l + 1) * 5 + row_batch(row)) * 6144;
                const f32x4 m0 = *(const f32x4*)(mn + d), m1 = *(const f32x4*)(mn + 1024 + d); const f32x4 h = xn * (1.f + m1) + m0;
                u32x2 o2; o2.x = pk2(h.x, h.y); o2.y = pk2(h.z, h.w); *(u32x2*)(F.HX() + (size_t)row * DM + d) = o2; }
        }
    }
}

constexpr int NPL = 14, NPH = 1 + DEPTH * NPL;
#define EN(i) (((PHMASK) >> (i)) & 1)
template <int PHMASK>
__global__ void __launch_bounds__(NTHR, 2) mega(Params p) {
    extern __shared__ __attribute__((aligned(16))) unsigned char smem[];
    Frame F; F.p = p; F.bid = blockIdx.x; F.nb = gridDim.x; F.tid = threadIdx.x; F.lane = threadIdx.x & 63; F.wave = threadIdx.x >> 6;
    F.smf = (float*)(smem + 16);
    unsigned char* ws = p.ws; F.ws = ws;

    if (threadIdx.x == 0) *(uint4*)smem = make_uint4(0u, 0u, 0u, 0u);
    __syncthreads();
    XcdBarrier bar; bar.bar = (unsigned*)(ws + WS_CTL); bar.x = 0; bar.st = (volatile LAS unsigned*)smem;
    const bool multi = (p.ph_hi - p.ph_lo) > 1;
    if (multi) bar = xcd_barrier_post((unsigned*)(ws + WS_CTL), (volatile LAS unsigned*)smem);
    const int lo = p.ph_lo, hi = p.ph_hi;
#define IN(k) (lo <= (k) && (k) < hi)
#define SEAM(k) do { if (IN(k) && IN((k) + 1)) xcd_barrier(bar); else __syncthreads(); } while (0)

    if (EN(14) && IN(0)) { phase_mod(F); __syncthreads(); phase_conv_a(F, 0); }
    SEAM(0);
#pragma unroll 1
    for (int l = 0; l < DEPTH; ++l) {
        const int pb = 1 + l * NPL;
        const float* xlat = (l == 0) ? p.x : p.out; const float* xctx = (l == 0) ? p.ctx : F.cxo();
        const int Mrows = (l == 0) ? NROW : NTOK;
        if (EN(0) && IN(pb + 0)) { if (l == 0) phase_prep(F, 0, p.x, p.ctx); else phase_conv_a(F, l); }
        SEAM(pb + 0);
        if (EN(1) && IN(pb + 1)) {
            bf16_t* P1 = F.P1(); bf16_t* VT = F.VT(); bf16_t* VR = F.VR();
            gemm_s(F, F.HX(), DM, F.W1t(), DM, NROW, NP1, DM, [=](int r, int c, float v) { P1[(size_t)r * NP1 + c] = f2bf(v); });
            gemm_s(F, F.Wvt(), DM, F.HX(), DM, NVT, NROW, DM, [=](int r, int c, float v) { VT[(size_t)r * NROW + c] = f2bf(v); });
            gemm_s(F, F.HX(), DM, F.Wvt(), DM, NROW, NVT, DM, [=](int r, int c, float v) { if (c < NVR) VR[(size_t)r * NVR + c] = f2bf(v); });
        }
        SEAM(pb + 1);
        if (EN(2) && IN(pb + 2)) phase_rope(F);
        SEAM(pb + 2);
        if (EN(3) && IN(pb + 3)) phase_mix(F, l);
        SEAM(pb + 3);
        if (EN(4) && IN(pb + 4)) phase_prepad(F, l);
        SEAM(pb + 4);
        if (EN(5) && IN(pb + 5)) {
            bf16_t* G = F.G();
            gemm_s(F, F.HX(), DM, F.Wgt(), DM, Mrows, NGATE, DM, [=](int r, int c, float v) { G[(size_t)r * NGATE + c] = f2bf(sigmoidf_(v)); });
            phase_conv_b(F, l);
        }
        SEAM(pb + 5);
        if (EN(6) && IN(pb + 6)) phase_merge_s(F, l);
        SEAM(pb + 6);
        if (EN(7) && IN(pb + 7)) {
            float* outp = p.out; float* cxm = F.cxm(); const float* modv = F.modv() + (size_t)l * 5 * 6144;
            gemm_s(F, F.HX(), DM, F.Woutt(), DM, Mrows, DM, DM, [=](int r, int c, float v) {
                const float m2 = modv[(size_t)row_batch(r) * 6144 + 2 * 1024 + c];
                if (r < NTOK) outp[(size_t)r * DM + c] = ALPHA * xlat[(size_t)r * DM + c] + m2 * v;
                else cxm[(size_t)(r - NTOK) * DM + c] = ALPHA * xctx[(size_t)(r - NTOK) * DM + c] + m2 * v; });
        }
        SEAM(pb + 7);
        if (EN(8) && IN(pb + 8)) phase_ln1(F, l);
        SEAM(pb + 8);
        if (EN(9) && IN(pb + 9)) phase_gather(F, l);
        SEAM(pb + 9);
        if (EN(10) && IN(pb + 10)) {
            int* off = (int*)(F.smf + 2 * 32 * 132); moe_offsets(F, l, off);
            const int Mtot = off[32], nt = (Mtot / 128) * 4, ty = F.tid >> 5, tx = F.tid & 31; bf16_t* GU = F.BR();
            for (int t = F.bid; t < nt; t += F.nb) {
                const int row0 = (t >> 2) * 128, col0 = (t & 3) * 128, e = expert_of_row(off, row0);
                float acc[8][4];
#pragma unroll
                for (int i = 0; i < 8; ++i)
#pragma unroll
                    for (int j = 0; j < 4; ++j) acc[i][j] = 0.f;
                gemm_s_acc(acc, F.XS(), DM, F.Wgu() + (size_t)e * 512 * DM, DM, DM, row0, col0, F.smf, F.tid);
#pragma unroll
                for (int i = 0; i < 8; ++i)
#pragma unroll
                    for (int j = 0; j < 4; ++j) GU[(size_t)(row0 + ty * 8 + i) * 512 + col0 + tx * 4 + j] = f2bf(acc[i][j]);
            }
        }
        SEAM(pb + 10);
        if (EN(11) && IN(pb + 11)) {
            int* off = (int*)F.smf; moe_offsets(F, l, off);
            const size_t total = (size_t)off[32] * 256; const bf16_t* GU = F.BR();
            for (size_t idx = (size_t)F.bid * NTHR + F.tid; idx < total; idx += (size_t)F.nb * NTHR) {
                const int r = (int)(idx >> 8), hc = (int)(idx & 255), j = hc >> 7, cc = hc & 127;
                const float g = bf2f(GU[(size_t)r * 512 + 256 * j + cc]), u = bf2f(GU[(size_t)r * 512 + 256 * j + 128 + cc]);
                F.HID()[(size_t)r * 256 + hc] = f2bf(siluf_(g) * u * F.roww()[r]);
            }
        }
        SEAM(pb + 11);
        if (EN(12) && IN(pb + 12)) {
            int* off = (int*)(F.smf + 2 * 32 * 132); moe_offsets(F, l, off);
            const int Mtot = off[32], nt = (Mtot / 128) * 8, ty = F.tid >> 5, tx = F.tid & 31; bf16_t* Y = F.BR();
            for (int t = F.bid; t < nt; t += F.nb) {
                const int row0 = (t >> 3) * 128, col0 = (t & 7) * 128, e = expert_of_row(off, row0);
                float acc[8][4];
#pragma unroll
                for (int i = 0; i < 8; ++i)
#pragma unroll
                    for (int j = 0; j < 4; ++j) acc[i][j] = 0.f;
                gemm_s_acc(acc, F.HID(), 256, F.Wd() + (size_t)e * DM * 256, 256, 256, row0, col0, F.smf, F.tid);
#pragma unroll
                for (int i = 0; i < 8; ++i) { const int s = F.rmap()[row0 + ty * 8 + i];
                    if (s >= 0) {
#pragma unroll
                        for (int j = 0; j < 4; ++j) Y[(size_t)s * DM + col0 + tx * 4 + j] = f2bf(acc[i][j]); } }
            }
        }
        SEAM(pb + 12);
        if (EN(13) && IN(pb + 13)) phase_ln2(F, l);
        SEAM(pb + 13);
    }
#undef IN
#undef SEAM
}

typedef void (*kern_t)(Params);
template <int I> struct KTab { static void fill(kern_t* t) { t[I] = mega<(1 << I)>; KTab<I - 1>::fill(t); } };
template <> struct KTab<-1> { static void fill(kern_t*) {} };

extern "C" void kernel_launch(void* const* d_in, const int* in_sizes, int n_in, void* d_out, int out_size, void* d_ws, size_t ws_size, hipStream_t stream) {
    static int grid = 0;
    static kern_t ktab[15];
    if (grid == 0) {
        if (n_in != 23 || out_size != NTOK * DM || ws_size < WS_END) { fprintf(stderr, "kernel_launch: unexpected shapes (n_in %d out %d ws %zu need %zu)\n", n_in, out_size, ws_size, (size_t)WS_END); grid = -1; return; }
        int dev = 0, cus = 0;
        if (hipGetDevice(&dev) != hipSuccess || hipDeviceGetAttribute(&cus, hipDeviceAttributeMultiprocessorCount, dev) != hipSuccess) { grid = -1; return; }
        KTab<14>::fill(ktab);
        for (int i = 0; i < 15; ++i)
            if (hipFuncSetAttribute((const void*)ktab[i], hipFuncAttributeMaxDynamicSharedMemorySize, LDS_BYTES) != hipSuccess) { fprintf(stderr, "kernel_launch: hipFuncSetAttribute failed\n"); grid = -1; return; }
        (void)hipGetLastError();
        grid = cus;
    }
    if (grid < 0) return;
    (void)hipMemsetAsync((char*)d_ws + WS_CTL, 0, CTL_BYTES, stream);
    Params p; memset(&p, 0, sizeof(p));
    const float** pp = (const float**)&p;
    for (int i = 0; i < 23; ++i) pp[i] = (const float*)d_in[i];
    p.out = (float*)d_out; p.ws = (unsigned char*)d_ws;
    for (int ph = 0; ph < NPH; ++ph) {
        p.ph_lo = ph; p.ph_hi = ph + 1;
        const int ki = (ph == 0) ? 14 : (ph - 1) % NPL;
        hipLaunchKernelGGL(ktab[ki], dim3(grid), dim3(NTHR), LDS_BYTES, stream, p);
    }
}
```

```cpp
#include <hip/hip_runtime.h>
#include <cstdio>
#include <cstdint>
#include <cstring>

typedef unsigned short bf16_t;
typedef float f32x4 __attribute__((ext_vector_type(4)));
typedef unsigned u32x4 __attribute__((ext_vector_type(4)));
typedef unsigned u32x2 __attribute__((ext_vector_type(2)));

constexpr int NB = 4, SEQ = 4096, LC = 256, DM = 1024, DEPTH = 2;
constexpr int NTOK = NB * SEQ, NCTX = NB * LC, NROW = NTOK + NCTX;
constexpr int DIN = 10528;
constexpr int O_AQ = 0, O_AK = 256, O_AV = 512, O_AG = 1024, O_ALR = 1536, O_BQ = 1568, O_BK = 2080, O_BV = 2592, O_CQ = 3104, O_CK = 3616,
              O_CV = 3744, O_DQ = 3872, O_DF = 4384, O_DI = 5408, O_DG = 5920, O_GATE = 6432;
constexpr int PC_AQ = 0, PC_AK = 256, PC_AV = 512, PC_ALR = 1024, PC_BQ = 1280, PC_BK = 1792, PC_CQ = 2304, PC_CK = 2816, PC_DQ = 3072,
              PC_DF = 3584, PC_DI = 4608, PC_AG = 5120, PC_DG = 5632, NP1 = 6144;
constexpr int NVT = 768;
constexpr int NVR = 640;
constexpr int NGATE = 4096;
constexpr int XS_ROWS = 40960;
constexpr float LN_EPS = 1e-5f;
constexpr float ALPHA = 1.41421356237f;

constexpr size_t al256(size_t x) { return (x + 255) & ~(size_t)255; }
constexpr size_t WS_CTL = 0;
constexpr size_t CTL_BYTES = 32768;
constexpr size_t CTL_CNT = 28672;
constexpr size_t WS_DUMP = WS_CTL + CTL_BYTES;
constexpr size_t WS_MODV = WS_DUMP + 4096;
constexpr size_t WS_LB = WS_MODV + al256((size_t)DEPTH * 5 * 6144 * 4);
constexpr size_t WS_TOKE = WS_LB + 4096;
constexpr size_t WS_TOKI = WS_TOKE + al256((size_t)2 * NROW * 4);
constexpr size_t WS_TOKW = WS_TOKI + al256((size_t)2 * NROW * 4);
constexpr size_t WS_RMAP = WS_TOKW + al256((size_t)2 * NROW * 4);
constexpr size_t WS_ROWW = WS_RMAP + al256((size_t)XS_ROWS * 4);
constexpr size_t WS_CXM = WS_ROWW + al256((size_t)XS_ROWS * 4);
constexpr size_t WS_CXO = WS_CXM + (size_t)NCTX * DM * 4;
constexpr size_t WS_WTA = WS_CXO + (size_t)NCTX * DM * 4;
constexpr size_t WTA_W1 = 0;
constexpr size_t WTA_WV = WTA_W1 + (size_t)NP1 * DM * 2;
constexpr size_t WTA_WG = WTA_WV + (size_t)NVT * DM * 2;
constexpr size_t WTA_WBR = WTA_WG + (size_t)NGATE * DM * 2;
constexpr size_t WTA_WO = WTA_WBR + (size_t)4 * DM * 512 * 2;
constexpr size_t WTA_BYTES = WTA_WO + (size_t)DM * DM * 2;
constexpr size_t WS_HX = WS_WTA + WTA_BYTES;
constexpr size_t WS_VT = WS_HX + (size_t)NROW * DM * 2;
constexpr size_t WS_OBA = WS_VT + (size_t)NVT * NROW * 2;
constexpr size_t WS_HX2 = WS_VT;
constexpr size_t WS_HID = WS_VT;
constexpr size_t WS_VR = WS_OBA + (size_t)NROW * 512 * 2;
constexpr size_t WS_BR = WS_VR + (size_t)NROW * NVR * 2;
constexpr size_t WS_P1 = WS_BR + (size_t)NROW * 2048 * 2;
constexpr size_t WS_G = WS_P1;
constexpr size_t WS_WGU = WS_P1 + (size_t)NROW * NGATE * 2;
constexpr size_t WS_WD = WS_WGU + (size_t)32 * 512 * DM * 2;
constexpr size_t WS_XS = WS_P1;
constexpr size_t WS_END = WS_P1 + (size_t)NROW * NP1 * 2;
static_assert(WS_WD + (size_t)32 * DM * 256 * 2 <= WS_END, "moe weights must fit in the P1 tail");
static_assert((size_t)XS_ROWS * DM * 2 <= (size_t)NROW * NGATE * 2, "XS must fit in the G region");
static_assert((size_t)NVT * NROW * 2 + (size_t)NROW * 512 * 2 >= (size_t)NROW * DM * 2, "HX2 alias");
static_assert(WS_END <= 434800000ull, "workspace budget");

constexpr int NTHR = 512;
constexpr bool MF_ATTN = true;
constexpr int LDS_BYTES = 144 * 1024;

struct Params {
    const float *x, *c, *ctx, *c_ctx, *w_mod, *b_mod, *w_in, *gla_lr_w, *gla_lr_b, *hg_gamma, *na_rpb, *wa_sink, *w_branch, *w_out, *ln_g, *ln_b,
        *moe_w_group, *moe_b_group, *moe_w_expert, *moe_b_expert, *moe_w_gate, *moe_w_up, *moe_w_down;
    float* out;
    unsigned char* ws;
    int ph_lo, ph_hi;
};

__device__ __forceinline__ float bf2f(bf16_t b) { return __uint_as_float(((unsigned)b) << 16); }
__device__ __forceinline__ bf16_t f2bf(float f) { unsigned u = __float_as_uint(f); u += 0x7FFFu + ((u >> 16) & 1u); return (bf16_t)(u >> 16); }
__device__ __forceinline__ unsigned pk2(float lo, float hi) { return (unsigned)f2bf(lo) | ((unsigned)f2bf(hi) << 16); }
__device__ __forceinline__ void ld8(const bf16_t* p, float* f) {
    const u32x4 v = *(const u32x4*)p;
    f[0] = __uint_as_float(v.x << 16); f[1] = __uint_as_float(v.x & 0xffff0000u);
    f[2] = __uint_as_float(v.y << 16); f[3] = __uint_as_float(v.y & 0xffff0000u);
    f[4] = __uint_as_float(v.z << 16); f[5] = __uint_as_float(v.z & 0xffff0000u);
    f[6] = __uint_as_float(v.w << 16); f[7] = __uint_as_float(v.w & 0xffff0000u);
}
__device__ __forceinline__ void st8(bf16_t* p, const float* f) {
    u32x4 v; v.x = pk2(f[0], f[1]); v.y = pk2(f[2], f[3]); v.z = pk2(f[4], f[5]); v.w = pk2(f[6], f[7]);
    *(u32x4*)p = v;
}
__device__ __forceinline__ float sigmoidf_(float x) { return 1.f / (1.f + expf(-x)); }
__device__ __forceinline__ float siluf_(float x) { return x / (1.f + expf(-x)); }
__device__ __forceinline__ float wave_sum(float v) {
#pragma unroll
    for (int o = 1; o < 64; o <<= 1) v += __shfl_xor(v, o);
    return v;
}
__device__ __forceinline__ int row_batch(int row) { return row < NTOK ? (row >> 12) : 4; }

#define XB_TMO      128
#define XB_XCNT(j)  (256  + 64 * (j))
#define XB_XSUB(j)  (1280 + 64 * (j))
#define XB_XGEN(j)  (2304 + 64 * (j))
#define XB_TOP      3328
#define XB_TOPGEN   3392
#define XCD_BAR_WORDS 3456
#define XB_SPIN_CAP (1u << 18)
#define LAS __attribute__((address_space(3)))
__device__ __forceinline__ unsigned xb_ld(unsigned* p)              { return __hip_atomic_load(p, __ATOMIC_RELAXED, __HIP_MEMORY_SCOPE_AGENT); }
__device__ __forceinline__ unsigned xb_add(unsigned* p, unsigned v) { return __hip_atomic_fetch_add(p, v, __ATOMIC_RELAXED, __HIP_MEMORY_SCOPE_AGENT); }
__device__ __forceinline__ unsigned xb_xcc_id() { return (unsigned)__builtin_amdgcn_s_getreg((3 << 11) | 20) & 0xFu; }
#define XB_SPIN(cond, bar) do { unsigned _sp = 0; while (cond) { __builtin_amdgcn_s_sleep(1); \
    if ((++_sp & 255u) == 0u) { if (xb_ld(&(bar)[XB_TMO])) break; if (_sp > XB_SPIN_CAP) { atomicAdd(&(bar)[XB_TMO], 1u); break; } } } } while (0)
struct XcdBarrier { unsigned* bar; unsigned x; volatile LAS unsigned* st; };
__device__ __forceinline__ XcdBarrier xcd_barrier_post(unsigned* bar, volatile LAS unsigned* st) {
    XcdBarrier b; b.bar = bar; b.x = xb_xcc_id(); b.st = st;
    if (threadIdx.x == 0) (void)xb_add(&bar[XB_XCNT(b.x)], 1u);
    return b;
}
__device__ __forceinline__ void xcd_barrier_complete(unsigned* bar, unsigned x, unsigned& nloc, unsigned& nx) {
    const unsigned G = gridDim.x * gridDim.y * gridDim.z;
    unsigned sum, cnt, mine, sp = 0u;
    for (;;) {
        sum = 0u; cnt = 0u; mine = 0u;
#pragma unroll
        for (unsigned j = 0; j < 16; ++j) { const unsigned c = xb_ld(&bar[XB_XCNT(j)]); sum += c; cnt += (c > 0u) ? 1u : 0u; mine = (j == x) ? c : mine; }
        if (sum == G) break;
        __builtin_amdgcn_s_sleep(1);
        if ((++sp & 255u) == 0u) { if (xb_ld(&bar[XB_TMO])) break; if (sp > XB_SPIN_CAP) { atomicAdd(&bar[XB_TMO], 1u); break; } }
    }
    nloc = mine > 0u ? mine : 1u; nx = cnt > 0u ? cnt : 1u;
}
__device__ __forceinline__ void xcd_barrier(const XcdBarrier& b) {
    asm volatile("s_waitcnt vmcnt(0)" ::: "memory");
    __syncthreads();
    if (threadIdx.x == 0) {
        unsigned* bar = b.bar;
        __builtin_amdgcn_s_waitcnt(0);
        unsigned nloc = b.st[0], nx = b.st[1];
        if (nloc == 0u) { xcd_barrier_complete(bar, b.x, nloc, nx); b.st[0] = nloc; b.st[1] = nx; }
        const unsigned old = xb_add(&bar[XB_XSUB(b.x)], 1u);
        const unsigned gen = old / nloc;
        if (old + 1u == (gen + 1u) * nloc) {
            __builtin_amdgcn_fence(__ATOMIC_RELEASE, "agent");
            asm volatile("s_waitcnt vmcnt(0)" ::: "memory");
            const unsigned og = xb_add(&bar[XB_TOP], 1u);
            const unsigned tg = og / nx;
            if (og + 1u == (tg + 1u) * nx) xb_add(&bar[XB_TOPGEN], 1u);
            else XB_SPIN(xb_ld(&bar[XB_TOPGEN]) == tg, bar);
            __builtin_amdgcn_fence(__ATOMIC_ACQUIRE, "agent");
            xb_add(&bar[XB_XGEN(b.x)], 1u);
            asm volatile("s_waitcnt vmcnt(0)" ::: "memory");
        } else {
            XB_SPIN(xb_ld(&bar[XB_XGEN(b.x)]) == gen, bar);
            __builtin_amdgcn_fence(__ATOMIC_ACQUIRE, "agent");
            asm volatile("s_waitcnt vmcnt(0)" ::: "memory");
        }
    }
    __syncthreads();
}

struct Frame {
    Params p;
    int bid, nb, tid, lane, wave;
    float* smf;
    unsigned char* ws;
    __device__ __forceinline__ float* modv() const { return (float*)(ws + WS_MODV); }
    __device__ __forceinline__ float* lb() const { return (float*)(ws + WS_LB); }
    __device__ __forceinline__ int* tokE() const { return (int*)(ws + WS_TOKE); }
    __device__ __forceinline__ int* tokI() const { return (int*)(ws + WS_TOKI); }
    __device__ __forceinline__ float* tokW() const { return (float*)(ws + WS_TOKW); }
    __device__ __forceinline__ int* rmap() const { return (int*)(ws + WS_RMAP); }
    __device__ __forceinline__ float* roww() const { return (float*)(ws + WS_ROWW); }
    __device__ __forceinline__ float* cxm() const { return (float*)(ws + WS_CXM); }
    __device__ __forceinline__ float* cxo() const { return (float*)(ws + WS_CXO); }
    __device__ __forceinline__ bf16_t* W1t() const { return (bf16_t*)(ws + WS_WTA + WTA_W1); }
    __device__ __forceinline__ bf16_t* Wvt() const { return (bf16_t*)(ws + WS_WTA + WTA_WV); }
    __device__ __forceinline__ bf16_t* Wgt() const { return (bf16_t*)(ws + WS_WTA + WTA_WG); }
    __device__ __forceinline__ bf16_t* Wbrt() const { return (bf16_t*)(ws + WS_WTA + WTA_WBR); }
    __device__ __forceinline__ bf16_t* Woutt() const { return (bf16_t*)(ws + WS_WTA + WTA_WO); }
    __device__ __forceinline__ bf16_t* HX() const { return (bf16_t*)(ws + WS_HX); }
    __device__ __forceinline__ bf16_t* VT() const { return (bf16_t*)(ws + WS_VT); }
    __device__ __forceinline__ bf16_t* OBA() const { return (bf16_t*)(ws + WS_OBA); }
    __device__ __forceinline__ bf16_t* HX2() const { return (bf16_t*)(ws + WS_HX2); }
    __device__ __forceinline__ bf16_t* HID() const { return (bf16_t*)(ws + WS_HID); }
    __device__ __forceinline__ bf16_t* VR() const { return (bf16_t*)(ws + WS_VR); }
    __device__ __forceinline__ bf16_t* BR() const { return (bf16_t*)(ws + WS_BR); }
    __device__ __forceinline__ bf16_t* P1() const { return (bf16_t*)(ws + WS_P1); }
    __device__ __forceinline__ bf16_t* G() const { return (bf16_t*)(ws + WS_G); }
    __device__ __forceinline__ bf16_t* Wgu() const { return (bf16_t*)(ws + WS_WGU); }
    __device__ __forceinline__ bf16_t* Wd() const { return (bf16_t*)(ws + WS_WD); }
    __device__ __forceinline__ bf16_t* XS() const { return (bf16_t*)(ws + WS_XS); }
    __device__ __forceinline__ unsigned* cnt() const { return (unsigned*)(ws + WS_CTL + CTL_CNT); }
};


#define REFRESH(F) do { int _t = threadIdx.x; asm volatile("" : "+v"(_t)); (F).tid = _t; (F).lane = _t & 63; (F).wave = _t >> 6; } while (0)

__device__ void phase_mod(Frame& F) {
    float* sc = F.smf;
    float* red = F.smf + 5 * 1024;
    bool have = false;
    for (int it = F.bid; it < DEPTH * 96; it += F.nb) {
        if (!have) {
            for (int i = F.tid; i < 5 * 1024; i += NTHR) { const float v = (i < 4096) ? F.p.c[i] : F.p.c_ctx[i - 4096]; sc[i] = siluf_(v); }
            __syncthreads(); have = true;
        }
        const int l = it / 96, n0 = (it % 96) * 64, col = F.tid & 63, kg = F.tid >> 6;
        const float* w = F.p.w_mod + (size_t)l * DM * 6144 + n0 + col;
        float a[5] = {0.f, 0.f, 0.f, 0.f, 0.f};
        for (int k = kg * 128; k < kg * 128 + 128; ++k) {
            const float wv = w[(size_t)k * 6144];
#pragma unroll
            for (int r = 0; r < 5; ++r) a[r] += sc[r * 1024 + k] * wv;
        }
#pragma unroll
        for (int r = 0; r < 5; ++r) red[(kg * 5 + r) * 64 + col] = a[r];
        __syncthreads();
        if (F.tid < 320) {
            const int r = F.tid >> 6, cc = F.tid & 63; float s = F.p.b_mod[l * 6144 + n0 + cc];
#pragma unroll
            for (int g = 0; g < 8; ++g) s += red[(g * 5 + r) * 64 + cc];
            F.modv()[((size_t)l * 5 + r) * 6144 + n0 + cc] = s;
        }
        __syncthreads();
    }
    if (F.bid == F.nb - 1) {
        for (int i = F.tid; i < 1024; i += NTHR) { const int z = i >> 9, f = i & 511;
            const float g0 = F.p.hg_gamma[(z * DEPTH + 0) * 512 + f], g1 = F.p.hg_gamma[(z * DEPTH + 1) * 512 + f];
            F.lb()[i] = 1.f / (1.f + expf(g0 - g1)); }
    }
}

__device__ __forceinline__ int p1_src(int n, float& scale) {
    scale = 1.f;
    if (n < 256) { scale = 0.125f; return O_AQ + n; }
    if (n < 512) return O_AK + (n - 256);
    if (n < 1024) return O_AV + (n - 512);
    if (n < 1056) return O_ALR + (n - 1024);
    if (n < 1280) return -1;
    if (n < 1792) { scale = 0.125f; return O_BQ + (n - 1280); }
    if (n < 2304) return O_BK + (n - 1792);
    if (n < 2816) { scale = 0.125f; return O_CQ + (n - 2304); }
    if (n < 2944) return O_CK + (n - 2816);
    if (n < 3072) return -1;
    if (n < 3584) return O_DQ + (n - 3072);
    if (n < 4608) return O_DF + (n - 3584);
    if (n < 5120) return O_DI + (n - 4608);
    if (n < 5632) return O_AG + (n - 5120);
    return O_DG + (n - 5632);
}
__device__ __forceinline__ void conv_tile(const float* src, int ldsrc, int srccol, float scale, bf16_t* dst, int K, int k0, float* tile, int tid) {
#pragma unroll
    for (int p = 0; p < 2; ++p) { const int kk = (tid >> 5) + 16 * p, nn = tid & 31;
        tile[kk * 33 + nn] = (srccol >= 0) ? src[(size_t)(k0 + kk) * ldsrc + srccol + nn] * scale : 0.f; }
    __syncthreads();
    { const int nn = tid >> 4, kp = (tid & 15) * 2;
      *(unsigned*)(dst + (size_t)nn * K + kp) = pk2(tile[kp * 33 + nn], tile[(kp + 1) * 33 + nn]); }
    __syncthreads();
}
constexpr int CONVA_TILES = 6144 + 768 + 4096 + 2048 + 1024;
__device__ void phase_conv_a(Frame& F, int l) {
    float* tile = F.smf;
    for (int ti0 = F.bid; ti0 < CONVA_TILES; ti0 += F.nb) {
        int ti = ti0;
        if (ti < 6144) { const int n0 = (ti >> 5) * 32, kt = ti & 31; float sc; const int s = p1_src(n0, sc);
            conv_tile(F.p.w_in + (size_t)l * DM * DIN, DIN, s, sc, F.W1t() + (size_t)n0 * DM + kt * 32, DM, kt * 32, tile, F.tid); continue; }
        ti -= 6144;
        if (ti < 768) { const int n0 = (ti >> 5) * 32, kt = ti & 31; const int s = n0 < 512 ? O_BV + n0 : (n0 < 640 ? O_CV + (n0 - 512) : -1);
            conv_tile(F.p.w_in + (size_t)l * DM * DIN, DIN, s, 1.f, F.Wvt() + (size_t)n0 * DM + kt * 32, DM, kt * 32, tile, F.tid); continue; }
        ti -= 768;
        if (ti < 4096) { const int n0 = (ti >> 5) * 32, kt = ti & 31;
            conv_tile(F.p.w_in + (size_t)l * DM * DIN, DIN, O_GATE + n0, 1.f, F.Wgt() + (size_t)n0 * DM + kt * 32, DM, kt * 32, tile, F.tid); continue; }
        ti -= 4096;
        if (ti < 2048) { const int i = ti >> 9, r = ti & 511, n0 = (r >> 4) * 32, kt = r & 15;
            conv_tile(F.p.w_branch + (size_t)(l * 4 + i) * 512 * DM, DM, n0, 1.f, F.Wbrt() + (size_t)i * DM * 512 + (size_t)n0 * 512 + kt * 32, 512, kt * 32, tile, F.tid); continue; }
        ti -= 2048;
        { const int n0 = (ti >> 5) * 32, kt = ti & 31;
          conv_tile(F.p.w_out + (size_t)l * DM * DM, DM, n0, 1.f, F.Woutt() + (size_t)n0 * DM + kt * 32, DM, kt * 32, tile, F.tid); }
    }
}
constexpr int CONVB_TILES = 16384 + 8192;
__device__ void phase_conv_b(Frame& F, int l) {
    float* tile = F.smf;
    for (int ti0 = F.bid; ti0 < CONVB_TILES; ti0 += F.nb) {
        int ti = ti0;
        if (ti < 16384) { const int e = ti >> 9, r = ti & 511, n0 = (r >> 5) * 32, kt = r & 31, j = n0 >> 8, rr = n0 & 255; const bool isup = rr >= 128; const int cc = 128 * j + (rr & 127);
            const float* src = (isup ? F.p.moe_w_up : F.p.moe_w_gate) + (size_t)(l * 32 + e) * DM * 256;
            conv_tile(src, 256, cc, 1.f, F.Wgu() + (size_t)e * 512 * DM + (size_t)n0 * DM + kt * 32, DM, kt * 32, tile, F.tid); continue; }
        ti -= 16384;
        { const int e = ti >> 8, r = ti & 255, n0 = (r >> 3) * 32, kt = r & 7;
          conv_tile(F.p.moe_w_down + (size_t)(l * 32 + e) * 256 * DM, DM, n0, 1.f, F.Wd() + (size_t)e * DM * 256 + (size_t)n0 * 256 + kt * 32, 256, kt * 32, tile, F.tid); }
    }
}

__device__ void phase_prep(Frame& F, int l, const float* xlat, const float* xctx) {
    const int gw = F.bid * 8 + F.wave, ngw = F.nb * 8;
    for (int row = gw; row < NROW; row += ngw) {
        const float* xr = row < NTOK ? xlat + (size_t)row * DM : xctx + (size_t)(row - NTOK) * DM;
        const float* mv = F.modv() + ((size_t)l * 5 + row_batch(row)) * 6144;
#pragma unroll
        for (int j = 0; j < 4; ++j) { const int d = j * 256 + F.lane * 4;
            const f32x4 v = *(const f32x4*)(xr + d), m0 = *(const f32x4*)(mv + d), m1 = *(const f32x4*)(mv + 1024 + d);
            u32x2 o; o.x = pk2(v.x * (1.f + m1.x) + m0.x, v.y * (1.f + m1.y) + m0.y); o.y = pk2(v.z * (1.f + m1.z) + m0.z, v.w * (1.f + m1.w) + m0.w);
            *(u32x2*)(F.HX() + (size_t)row * DM + d) = o; }
    }
}

__device__ __forceinline__ void gemm_s_acc(float (&acc)[8][4], const bf16_t* A, int lda, const bf16_t* Bt, int ldb, int K, int row0, int col0, float* sm, int tid) {
    float* As = sm; float* Bs = sm + 32 * 132;
    const int ty = tid >> 5, tx = tid & 31, lr = tid >> 2, lk = (tid & 3) * 8;
    for (int k0 = 0; k0 < K; k0 += 32) {
        float fa[8], fb[8];
        ld8(A + (size_t)(row0 + lr) * lda + k0 + lk, fa);
        ld8(Bt + (size_t)(col0 + lr) * ldb + k0 + lk, fb);
        __syncthreads();
#pragma unroll
        for (int j = 0; j < 8; ++j) { As[(lk + j) * 132 + lr] = fa[j]; Bs[(lk + j) * 132 + lr] = fb[j]; }
        __syncthreads();
#pragma unroll 4
        for (int k = 0; k < 32; ++k) {
            const f32x4 a0 = *(const f32x4*)&As[k * 132 + ty * 8], a1 = *(const f32x4*)&As[k * 132 + ty * 8 + 4], b = *(const f32x4*)&Bs[k * 132 + tx * 4];
            const float a[8] = {a0.x, a0.y, a0.z, a0.w, a1.x, a1.y, a1.z, a1.w}; const float bb[4] = {b.x, b.y, b.z, b.w};
#pragma unroll
            for (int i = 0; i < 8; ++i)
#pragma unroll
                for (int j = 0; j < 4; ++j) acc[i][j] += a[i] * bb[j];
        }
    }
    __syncthreads();
}
template <class Epi>
__device__ void gemm_s(Frame& F, const bf16_t* A, int lda, const bf16_t* Bt, int ldb, int M, int N, int K, const Epi& epi) {
    const int tn = N / 128, nt = (M / 128) * tn, ty = F.tid >> 5, tx = F.tid & 31;
    for (int t = F.bid; t < nt; t += F.nb) {
        const int row0 = (t / tn) * 128, col0 = (t % tn) * 128;
        float acc[8][4];
#pragma unroll
        for (int i = 0; i < 8; ++i)
#pragma unroll
            for (int j = 0; j < 4; ++j) acc[i][j] = 0.f;
        gemm_s_acc(acc, A, lda, Bt, ldb, K, row0, col0, F.smf, F.tid);
#pragma unroll
        for (int i = 0; i < 8; ++i)
#pragma unroll
            for (int j = 0; j < 4; ++j) epi(row0 + ty * 8 + i, col0 + tx * 4 + j, acc[i][j]);
    }
}


namespace pg {
typedef short bf16x8 __attribute__((ext_vector_type(8)));
constexpr int BM = 256, BK = 64, HALF = 128, HTB = HALF * BK * 2, STAGE_BYTES = 8 * HTB, NXCD = 8, WGM = 8;
__device__ __forceinline__ int lds_byte(int r, int c) { const int st = (r >> 4) * 2 + (c >> 5), rr = r & 15, cc = c & 31, ob = rr * 64 + cc * 2; return st * 1024 + (ob ^ (((ob >> 9) & 1) << 5)); }
__device__ __forceinline__ void stage_rc(int b, int& R, int& C) { const int st = b / 1024, sb = b % 1024, swz = sb ^ (((sb >> 9) & 1) << 5); R = (st >> 1) * 16 + swz / 64; C = (st & 1) * 32 + (swz % 64) / 2; }
struct Unit { const char* a; const char* b; int pm, pn, aux; };
__device__ __forceinline__ void static_map(int L, int nM, int nN, int& pm, int& pn) {
    const int nwg = nM * nN; int wgid = L; { const int q = nwg / NXCD, r = nwg % NXCD, xcd = wgid % NXCD, off = wgid / NXCD; wgid = (xcd < r ? xcd * (q + 1) : r * (q + 1) + (xcd - r) * q) + off; }
    const int nig = WGM * nN, gid = wgid / nig, fm = gid * WGM, gsz = (nM - fm) < WGM ? (nM - fm) : WGM;
    pm = fm + ((wgid % nig) % gsz); pn = (wgid % nig) / gsz;
}
template <class Epi, class Sched>
__device__ __forceinline__ void gemm_phase(LAS unsigned char* lds, const int lda, const int ldb, const int K, const Sched& S, const Epi& E) {
    int tid = threadIdx.x; asm volatile("" : "+v"(tid));
    const int wid = __builtin_amdgcn_readfirstlane(tid >> 6), lane = tid & 63, wr = wid >> 2, wc = wid & 3, fr = lane & 15, fq = lane >> 4;
    int nt = K / BK; asm volatile("" : "+s"(nt));
    unsigned voffA[2], voffB[2];
#pragma unroll
    for (int i = 0; i < 2; ++i) { int R, C; stage_rc(tid * 16 + i * 8192, R, C); voffA[i] = (unsigned)(R * lda + C) * 2u; voffB[i] = (unsigned)(R * ldb + C) * 2u; }
    const size_t kstep = (size_t)(BK * 2);
    const size_t hstepA = (size_t)HALF * lda * 2, hstepB = (size_t)HALF * ldb * 2;
    const unsigned ldsw = (unsigned)wid * 1024u;
    const int aoff = lds_byte(wr * 64 + fr, fq * 8), boff = lds_byte(wc * 32 + fr, fq * 8);
#define PG_SA(b, h) (((b) * 2 + (h)) * HTB)
#define PG_SB(b, h) ((4 + (b) * 2 + (h)) * HTB)
#define PG_STAGE(bufoff, gbase, voff) do { _Pragma("unroll") for (int _i = 0; _i < 2; ++_i) \
        __builtin_amdgcn_global_load_lds((const unsigned*)((const char*)(gbase) + (voff)[_i]), (LAS unsigned*)(lds + (bufoff) + ldsw + _i * 8192), 16, 0, 0); } while (0)
#define PG_LDA(dst, b, h) do { _Pragma("unroll") for (int m = 0; m < 4; ++m) _Pragma("unroll") for (int k = 0; k < 2; ++k) dst[m][k] = *(const LAS bf16x8*)(lds + PG_SA(b, h) + aoff + m * 2048 + k * 1024); } while (0)
#define PG_LDB(dst, b, h) do { _Pragma("unroll") for (int n = 0; n < 2; ++n) _Pragma("unroll") for (int k = 0; k < 2; ++k) dst[n][k] = *(const LAS bf16x8*)(lds + PG_SB(b, h) + boff + n * 2048 + k * 1024); } while (0)
#define PG_MMA(ai, bj, At, Bt) do { __builtin_amdgcn_s_setprio(1); _Pragma("unroll") for (int m = 0; m < 4; ++m) _Pragma("unroll") for (int n = 0; n < 2; ++n) _Pragma("unroll") for (int k = 0; k < 2; ++k) \
        acc[ai][bj][m][n] = __builtin_amdgcn_mfma_f32_16x16x32_bf16(Bt[n][k], At[m][k], acc[ai][bj][m][n], 0, 0, 0); __builtin_amdgcn_s_setprio(0); } while (0)
#define PG_WAIT_V(n) asm volatile("s_waitcnt vmcnt(" #n ")" ::: "memory")
#define PG_WAIT_L(n) asm volatile("s_waitcnt lgkmcnt(" #n ")" ::: "memory")
#define PG_BAR __builtin_amdgcn_s_barrier()
#define PG_SCHED __builtin_amdgcn_sched_barrier(0)
    Unit cur, nxt; int ui = 0;
    if (!S.next(0, cur)) return;
    f32x4 acc[2][2][4][2];
#pragma unroll
    for (int a = 0; a < 2; ++a)
#pragma unroll
        for (int b = 0; b < 2; ++b)
#pragma unroll
            for (int m = 0; m < 4; ++m)
#pragma unroll
                for (int n = 0; n < 2; ++n) acc[a][b][m][n] = (f32x4){0.f, 0.f, 0.f, 0.f};
    bf16x8 At[4][2], B0[2][2], B1[2][2];
    const char* cA = cur.a; const char* cB = cur.b;
    PG_STAGE(PG_SB(0, 0), cB, voffB); PG_STAGE(PG_SA(0, 0), cA, voffA); PG_STAGE(PG_SB(0, 1), cB + hstepB, voffB); PG_STAGE(PG_SA(0, 1), cA + hstepA, voffA);
    if (wr == 1) PG_BAR;
    PG_WAIT_V(4); PG_BAR;
    PG_STAGE(PG_SB(1, 0), cB + kstep, voffB); PG_STAGE(PG_SA(1, 0), cA + kstep, voffA); PG_STAGE(PG_SB(1, 1), cB + hstepB + kstep, voffB);
    PG_WAIT_V(6); PG_BAR;
    for (;;) {
        const bool has_next = S.next(ui + 1, nxt);
        const char* nA = has_next ? nxt.a : cA; const char* nB = has_next ? nxt.b : cB;
        for (int t = 0; t < nt; t += 2) {
            const bool last = (t == nt - 2);
            const char* a1 = cA + (size_t)(t + 1) * kstep;
            const char* a2 = last ? nA : cA + (size_t)(t + 2) * kstep; const char* b2 = last ? nB : cB + (size_t)(t + 2) * kstep;
            const char* a3 = a2 + kstep; const char* b3 = b2 + kstep;
            PG_LDB(B0, 0, 0); PG_SCHED; PG_LDA(At, 0, 0); PG_STAGE(PG_SA(1, 1), a1 + hstepA, voffA);
            PG_WAIT_L(8); PG_BAR; PG_WAIT_L(0); PG_MMA(0, 0, At, B0); PG_BAR; PG_SCHED;
            PG_LDB(B1, 0, 1); PG_STAGE(PG_SB(0, 0), b2, voffB);
            PG_BAR; PG_WAIT_L(0); PG_MMA(0, 1, At, B1); PG_BAR;
            PG_LDA(At, 0, 1); PG_STAGE(PG_SA(0, 0), a2, voffA);
            PG_BAR; PG_WAIT_L(0); PG_MMA(1, 0, At, B0); PG_BAR; PG_SCHED;
            PG_STAGE(PG_SB(0, 1), b2 + hstepB, voffB);
            PG_WAIT_V(6); PG_BAR; PG_MMA(1, 1, At, B1); PG_BAR;
            PG_LDB(B0, 1, 0); PG_SCHED; PG_LDA(At, 1, 0); PG_STAGE(PG_SA(0, 1), a2 + hstepA, voffA);
            PG_WAIT_L(8); PG_BAR; PG_WAIT_L(0); PG_MMA(0, 0, At, B0); PG_BAR; PG_SCHED;
            PG_LDB(B1, 1, 1); PG_STAGE(PG_SB(1, 0), b3, voffB);
            PG_BAR; PG_WAIT_L(0); PG_MMA(0, 1, At, B1); PG_BAR;
            PG_LDA(At, 1, 1); PG_STAGE(PG_SA(1, 0), a3, voffA);
            PG_BAR; PG_WAIT_L(0); PG_MMA(1, 0, At, B0); PG_BAR; PG_SCHED;
            PG_STAGE(PG_SB(1, 1), b3 + hstepB, voffB);
            PG_WAIT_V(6); PG_BAR; PG_MMA(1, 1, At, B1); PG_BAR;
        }
        E(acc, cur, wr, wc, fr, fq);
        if (!has_next) break;
#pragma unroll
        for (int a = 0; a < 2; ++a)
#pragma unroll
            for (int b = 0; b < 2; ++b)
#pragma unroll
                for (int m = 0; m < 4; ++m)
#pragma unroll
                    for (int n = 0; n < 2; ++n) acc[a][b][m][n] = (f32x4){0.f, 0.f, 0.f, 0.f};
        cur = nxt; cA = nA; cB = nB; ++ui;
    }
    PG_WAIT_V(0);
    if (wr == 0) PG_BAR;
    PG_BAR;
#undef PG_SA
#undef PG_SB
#undef PG_STAGE
#undef PG_LDA
#undef PG_LDB
#undef PG_MMA
#undef PG_WAIT_V
#undef PG_WAIT_L
#undef PG_BAR
#undef PG_SCHED
}

struct SchedG1 {
    const char *HX, *W1, *WV; int G, c;
    __device__ __forceinline__ bool next(int i, Unit& u) const {
        const int L = i * G + c, nmain = (NROW / 256) * (NP1 / 256);
        if (L < nmain) { static_map(L, NROW / 256, NP1 / 256, u.pm, u.pn); u.a = HX + (size_t)u.pm * 256 * DM * 2; u.b = W1 + (size_t)u.pn * 256 * DM * 2; u.aux = 0; return true; }
        const int idx = L - nmain; if (idx >= 3 * (NROW / 256)) return false;
        u.pm = idx % 3; u.pn = idx / 3; u.a = WV + (size_t)u.pm * 256 * DM * 2; u.b = HX + (size_t)u.pn * 256 * DM * 2; u.aux = 1; return true;
    }
};
struct SchedStatic {
    const char *A, *B; size_t tA, tB; int nM, nN, G, c;
    __device__ __forceinline__ bool next(int i, Unit& u) const {
        const int L = i * G + c; if (L >= nM * nN) return false;
        static_map(L, nM, nN, u.pm, u.pn); u.a = A + (size_t)u.pm * tA; u.b = B + (size_t)u.pn * tB; u.aux = 0; return true;
    }
};
struct SchedMerge {
    const char *BR, *W; int ntile, G, c;
    __device__ __forceinline__ bool next(int i, Unit& u) const {
        const int t = c + (i >> 2) * G; if (t >= ntile) return false;
        const int br = i & 3; u.pm = t >> 2; u.pn = t & 3; u.aux = br;
        u.a = BR + (size_t)u.pm * 256 * 2048 * 2 + (size_t)br * 512 * 2; u.b = W + (size_t)br * DM * 512 * 2 + (size_t)u.pn * 256 * 512 * 2; return true;
    }
};
struct SchedMoe {
    const char *A, *W; const int* off; size_t tA, wE, wT; int npan, NJ, G, c;
    __device__ __forceinline__ bool next(int i, Unit& u) const {
        const int L = i * G + c; if (L >= npan * NJ) return false;
        const int p = L / NJ, j = L % NJ; int e = 0;
#pragma unroll 1
        for (int q = 1; q < 32; ++q) if (p * 256 >= off[q]) e = q;
        e = __builtin_amdgcn_readfirstlane(e);
        u.pm = p; u.pn = j; u.aux = e; u.a = A + (size_t)p * tA; u.b = W + (size_t)e * wE + (size_t)j * wT; return true;
    }
};

#define PG_ROWCOL const int row0 = u.pm * BM + wr * 64 + fr, col0 = u.pn * BM + wc * 32 + 4 * fq
struct EpiG1 { bf16_t *P1, *VT;
    __device__ __forceinline__ void operator()(const f32x4 (&acc)[2][2][4][2], const Unit& u, int wr, int wc, int fr, int fq) const {
        PG_ROWCOL; bf16_t* base = u.aux ? VT : P1; const size_t ld = u.aux ? (size_t)NROW : (size_t)NP1;
#pragma unroll
        for (int ai = 0; ai < 2; ++ai)
#pragma unroll
            for (int m = 0; m < 4; ++m) { bf16_t* rowp = base + (size_t)(row0 + ai * HALF + m * 16) * ld + col0;
#pragma unroll
                for (int bj = 0; bj < 2; ++bj)
#pragma unroll
                    for (int n = 0; n < 2; ++n) { const f32x4 v = acc[ai][bj][m][n]; u32x2 o; o.x = pk2(v.x, v.y); o.y = pk2(v.z, v.w); *(u32x2*)(rowp + bj * HALF + n * 16) = o; } }
    }
};
struct EpiGate { bf16_t* G;
    __device__ __forceinline__ void operator()(const f32x4 (&acc)[2][2][4][2], const Unit& u, int wr, int wc, int fr, int fq) const {
        PG_ROWCOL;
#pragma unroll
        for (int ai = 0; ai < 2; ++ai)
#pragma unroll
            for (int m = 0; m < 4; ++m) { bf16_t* rowp = G + (size_t)(row0 + ai * HALF + m * 16) * NGATE + col0;
#pragma unroll
                for (int bj = 0; bj < 2; ++bj)
#pragma unroll
                    for (int n = 0; n < 2; ++n) { const f32x4 v = acc[ai][bj][m][n]; u32x2 o; o.x = pk2(sigmoidf_(v.x), sigmoidf_(v.y)); o.y = pk2(sigmoidf_(v.z), sigmoidf_(v.w)); *(u32x2*)(rowp + bj * HALF + n * 16) = o; } }
    }
};
struct EpiMerge { const bf16_t* G; bf16_t* O;
    __device__ __forceinline__ void operator()(const f32x4 (&acc)[2][2][4][2], const Unit& u, int wr, int wc, int fr, int fq) const {
        PG_ROWCOL; const int br = u.aux;
#pragma unroll
        for (int ai = 0; ai < 2; ++ai)
#pragma unroll
            for (int m = 0; m < 4; ++m) { const size_t r = (size_t)(row0 + ai * HALF + m * 16); bf16_t* rowp = O + r * DM + col0; const bf16_t* gp = G + r * NGATE + br * 1024 + col0;
#pragma unroll
                for (int bj = 0; bj < 2; ++bj)
#pragma unroll
                    for (int n = 0; n < 2; ++n) { const f32x4 v = acc[ai][bj][m][n]; const u32x2 g2 = *(const u32x2*)(gp + bj * HALF + n * 16);
                        f32x4 w; w.x = __uint_as_float(g2.x << 16) * v.x; w.y = __uint_as_float(g2.x & 0xffff0000u) * v.y; w.z = __uint_as_float(g2.y << 16) * v.z; w.w = __uint_as_float(g2.y & 0xffff0000u) * v.w;
                        if (br != 0) { const u32x2 o2 = *(const u32x2*)(rowp + bj * HALF + n * 16);
                            w.x += __uint_as_float(o2.x << 16); w.y += __uint_as_float(o2.x & 0xffff0000u); w.z += __uint_as_float(o2.y << 16); w.w += __uint_as_float(o2.y & 0xffff0000u); }
                        u32x2 o; o.x = pk2(w.x, w.y); o.y = pk2(w.z, w.w); *(u32x2*)(rowp + bj * HALF + n * 16) = o; }
                asm volatile("" ::: "memory"); }
    }
};
struct EpiWout { const float *xlat, *xctx; float *olat, *octx; const float* modl;
    __device__ __forceinline__ void operator()(const f32x4 (&acc)[2][2][4][2], const Unit& u, int wr, int wc, int fr, int fq) const {
        PG_ROWCOL; const bool lat = u.pm < NTOK / 256; const int rb = lat ? (u.pm >> 4) : 4;
        const float* xin = lat ? xlat : xctx - (size_t)NTOK * DM; float* xo = lat ? olat : octx - (size_t)NTOK * DM; const float* m2 = modl + (size_t)rb * 6144 + 2 * 1024 + col0;
        f32x4 mv[2][2];
#pragma unroll
        for (int bj = 0; bj < 2; ++bj)
#pragma unroll
            for (int n = 0; n < 2; ++n) mv[bj][n] = *(const f32x4*)(m2 + bj * HALF + n * 16);
#pragma unroll
        for (int ai = 0; ai < 2; ++ai)
#pragma unroll
            for (int m = 0; m < 4; ++m) { const size_t o = (size_t)(row0 + ai * HALF + m * 16) * DM + col0;
#pragma unroll
                for (int bj = 0; bj < 2; ++bj)
#pragma unroll
                    for (int n = 0; n < 2; ++n) { const f32x4 xv = *(const f32x4*)(xin + o + bj * HALF + n * 16); *(f32x4*)(xo + o + bj * HALF + n * 16) = ALPHA * xv + mv[bj][n] * acc[ai][bj][m][n]; }
                asm volatile("" ::: "memory"); }
    }
};
struct EpiMoe1 { bf16_t* HID; const float* roww;
    __device__ __forceinline__ void operator()(const f32x4 (&acc)[2][2][4][2], const Unit& u, int wr, int wc, int fr, int fq) const {
        const int row0 = u.pm * BM + wr * 64 + fr, hc0 = u.pn * 128 + wc * 32 + 4 * fq;
#pragma unroll
        for (int ai = 0; ai < 2; ++ai)
#pragma unroll
            for (int m = 0; m < 4; ++m) { const int r = row0 + ai * HALF + m * 16; const float w = roww[r];
#pragma unroll
                for (int n = 0; n < 2; ++n) { const f32x4 g = acc[ai][0][m][n], up = acc[ai][1][m][n]; u32x2 o;
                    o.x = pk2(siluf_(g.x) * up.x * w, siluf_(g.y) * up.y * w); o.y = pk2(siluf_(g.z) * up.z * w, siluf_(g.w) * up.w * w);
                    *(u32x2*)(HID + (size_t)r * 256 + hc0 + n * 16) = o; } }
    }
};
struct EpiMoe2 { bf16_t* Y; const int* rmap; bf16_t* dump;
    __device__ __forceinline__ void operator()(const f32x4 (&acc)[2][2][4][2], const Unit& u, int wr, int wc, int fr, int fq) const {
        PG_ROWCOL;
#pragma unroll
        for (int ai = 0; ai < 2; ++ai)
#pragma unroll
            for (int m = 0; m < 4; ++m) { const int s = rmap[row0 + ai * HALF + m * 16];
                bf16_t* rowp = (s >= 0 ? Y + (size_t)s * DM : dump) + col0;
#pragma unroll
                for (int bj = 0; bj < 2; ++bj)
#pragma unroll
                    for (int n = 0; n < 2; ++n) { const f32x4 v = acc[ai][bj][m][n]; u32x2 o; o.x = pk2(v.x, v.y); o.y = pk2(v.z, v.w); *(u32x2*)(rowp + bj * HALF + n * 16) = o; } }
    }
};
#undef PG_ROWCOL
}

__device__ __forceinline__ void moe_offsets(Frame& F, int l, int* off) {
    if (F.tid == 0) { int a = 0; for (int e = 0; e < 32; ++e) { off[e] = a; a += ((int)F.cnt()[l * 32 + e] + 255) & ~255; } off[32] = a; }
    __syncthreads();
}

__device__ void phase_rope(Frame& F) {
    const size_t total = (size_t)NTOK * 320;
    for (size_t idx = (size_t)F.bid * NTHR + F.tid; idx < total; idx += (size_t)F.nb * NTHR) {
        const int row = (int)(idx / 320), r = (int)(idx % 320), h = r >> 5, half = (r >> 4) & 1, i = r & 15;
        const int pos = row & (SEQ - 1), pp = half ? (pos & 63) : (pos >> 6);
        const float inv = powf(10000.f, -(float)i / 16.f), ang = (float)pp * inv, cs = cosf(ang), sn = sinf(ang);
        bf16_t* base = F.P1() + (size_t)row * NP1 + (h < 8 ? PC_CQ + h * 64 : PC_CK + (h - 8) * 64) + half * 32 + i;
        const float u1 = bf2f(base[0]), u2 = bf2f(base[16]);
        base[0] = f2bf(u1 * cs - u2 * sn); base[16] = f2bf(u1 * sn + u2 * cs);
    }
}

__device__ __forceinline__ int seq_row(int s, int b, int z) {
    if (s < LC) { const int tc = z ? (LC - 1 - s) : s; return NTOK + b * LC + tc; }
    const int tl = s - LC, t = z ? (SEQ - 1 - tl) : tl; return b * SEQ + t;
}
template <int DK, bool HG>
__device__ void scan_simple(Frame& F, int l, int b, int h, int z) {
    constexpr int DPB = DK / 4;
    float* eg = F.smf; float* kk = eg + 16 * DK; float* qq = kk + 16 * DK; float* vv = qq + 16 * DK; float* op = vv + 16 * 128;
    const int tid = F.tid, v = tid & 127, db = tid >> 7;
    float S[DPB];
#pragma unroll
    for (int i = 0; i < DPB; ++i) S[i] = 0.f;
    for (int step = 0; step < (LC + SEQ) / 16; ++step) {
        for (int idx = tid; idx < 16 * DK; idx += NTHR) {
            const int i = idx / DK, d = idx % DK, row = seq_row(step * 16 + i, b, z);
            const bf16_t* pr = F.P1() + (size_t)row * NP1;
            float e, k, q;
            if (HG) {
                const float f = bf2f(pr[PC_DF + z * 512 + h * 128 + d]), sg = sigmoidf_(f), lbv = (l == 0) ? 0.f : F.lb()[z * 512 + h * 128 + d];
                const float fg = lbv + (1.f - lbv) * sg; e = fg; k = (1.f - lbv) * (1.f - sg);
                q = siluf_(bf2f(pr[PC_DQ + h * 128 + d]));
            } else {
                float lg = F.p.gla_lr_b[(l * 2 + z) * 256 + h * 64 + d];
#pragma unroll
                for (int r = 0; r < 16; ++r) lg += bf2f(pr[PC_ALR + z * 16 + r]) * F.p.gla_lr_w[((size_t)(l * 2 + z) * 16 + r) * 256 + h * 64 + d];
                const float ls = fminf(lg, 0.f) - log1pf(expf(-fabsf(lg)));
                e = expf(ls * (1.f / 16.f)); k = bf2f(pr[PC_AK + h * 64 + d]); q = bf2f(pr[PC_AQ + h * 64 + d]);
            }
            eg[idx] = e; kk[idx] = k; qq[idx] = q;
        }
        for (int idx = tid; idx < 16 * 128; idx += NTHR) {
            const int i = idx >> 7, c = idx & 127, row = seq_row(step * 16 + i, b, z);
            vv[idx] = bf2f(F.P1()[(size_t)row * NP1 + (HG ? PC_DI : PC_AV) + h * 128 + c]);
        }
        __syncthreads();
        for (int i = 0; i < 16; ++i) {
            const float vval = vv[i * 128 + v]; float o = 0.f;
#pragma unroll
            for (int dd = 0; dd < DPB; ++dd) { const int d = db * DPB + dd; S[dd] = eg[i * DK + d] * S[dd] + kk[i * DK + d] * vval; o += S[dd] * qq[i * DK + d]; }
            op[(i * 4 + db) * 128 + v] = o;
        }
        __syncthreads();
        for (int idx = tid; idx < 16 * 128; idx += NTHR) {
            const int i = idx >> 7, c = idx & 127, row = seq_row(step * 16 + i, b, z);
            const float o = op[(i * 4 + 0) * 128 + c] + op[(i * 4 + 1) * 128 + c] + op[(i * 4 + 2) * 128 + c] + op[(i * 4 + 3) * 128 + c];
            bf16_t* dst;
            if (HG) dst = F.P1() + (size_t)row * NP1 + PC_DF + z * 512 + h * 128 + c;
            else dst = (z == 0) ? F.BR() + (size_t)row * 2048 + h * 128 + c : F.OBA() + (size_t)row * 512 + h * 128 + c;
            *dst = f2bf(o);
        }
        __syncthreads();
    }
}

struct AttnAcc { float m, l; float o[64]; };
__device__ __forceinline__ void attn_key(const float (&q)[64], AttnAcc& a, const bf16_t* kp, const bf16_t* vp, float bias) {
    float s = bias;
#pragma unroll
    for (int c = 0; c < 8; ++c) { float f[8]; ld8(kp + c * 8, f);
#pragma unroll
        for (int j = 0; j < 8; ++j) s += q[c * 8 + j] * f[j]; }
    if (s > a.m) { const float sc = expf(a.m - s); a.l *= sc;
#pragma unroll
        for (int i = 0; i < 64; ++i) a.o[i] *= sc;
        a.m = s; }
    const float pr = expf(s - a.m); a.l += pr;
#pragma unroll
    for (int c = 0; c < 8; ++c) { float f[8]; ld8(vp + c * 8, f);
#pragma unroll
        for (int j = 0; j < 8; ++j) a.o[c * 8 + j] += pr * f[j]; }
}
__device__ __forceinline__ void attn_init(AttnAcc& a) { a.m = -1e30f; a.l = 0.f;
#pragma unroll
    for (int i = 0; i < 64; ++i) a.o[i] = 0.f; }
__device__ __forceinline__ void attn_loadq(float (&q)[64], const bf16_t* qp) {
#pragma unroll
    for (int c = 0; c < 8; ++c) ld8(qp + c * 8, &q[c * 8]); }
__device__ __forceinline__ void attn_store(const AttnAcc& a, bf16_t* op) {
    const float il = 1.f / a.l;
#pragma unroll
    for (int c = 0; c < 8; ++c) { float t[8];
#pragma unroll
        for (int j = 0; j < 8; ++j) t[j] = a.o[c * 8 + j] * il;
        st8(op + c * 8, t); } }

template <int kind>
__device__ void attn_simple(Frame& F, int l, int item) {
    const int c = F.tid & 63, h = F.tid >> 6;
    float q[64]; AttnAcc a; attn_init(a);
    if (kind == 0) {
        const int b = item >> 6, r = item & 63, row = b * SEQ + r * 64 + c;
        attn_loadq(q, F.P1() + (size_t)row * NP1 + PC_BQ + h * 64);
        const int rs = min(max(r - 4, 0), 56), cs = min(max(c - 8, 0), 48);
        for (int kr = rs; kr < rs + 8; ++kr) {
            const float* bp = F.p.na_rpb + ((size_t)(l * 8 + h) * 15 + (kr - r + 7)) * 31 + (cs - c + 15);
            for (int kc = 0; kc < 16; ++kc) { const int krow = b * SEQ + kr * 64 + cs + kc;
                attn_key(q, a, F.P1() + (size_t)krow * NP1 + PC_BK + h * 64, F.VR() + (size_t)krow * NVR + h * 64, bp[kc]); }
        }
        for (int n = 0; n < LC; ++n) { const int crow = NTOK + b * LC + n;
            attn_key(q, a, F.P1() + (size_t)crow * NP1 + PC_BK + h * 64, F.VR() + (size_t)crow * NVR + h * 64, 0.f); }
        attn_store(a, F.BR() + (size_t)row * 2048 + 512 + h * 64);
    } else if (kind == 1) {
        const int b = item >> 6, g = item & 63, t = g * 64 + c, row = b * SEQ + t, kvh = h >> 2;
        attn_loadq(q, F.P1() + (size_t)row * NP1 + PC_CQ + h * 64);
        const int j0 = max(t - 128, 0), j1 = min(t + 128, SEQ - 1);
        for (int j = j0; j <= j1; ++j) { const int krow = b * SEQ + j;
            attn_key(q, a, F.P1() + (size_t)krow * NP1 + PC_CK + kvh * 64, F.VR() + (size_t)krow * NVR + 512 + kvh * 64, 0.f); }
        for (int n = 0; n < LC; ++n) { const int crow = NTOK + b * LC + n;
            attn_key(q, a, F.P1() + (size_t)crow * NP1 + PC_CK + kvh * 64, F.VR() + (size_t)crow * NVR + 512 + kvh * 64, 0.f); }
        const float sk = F.p.wa_sink[l * 8 + h];
        if (sk > a.m) { const float sc = expf(a.m - sk); a.l *= sc;
#pragma unroll
            for (int i = 0; i < 64; ++i) a.o[i] *= sc;
            a.m = sk; }
        a.l += expf(sk - a.m);
        attn_store(a, F.BR() + (size_t)row * 2048 + 1024 + h * 64);
    } else {
        const int b = item >> 2, g = item & 3, qrow = NTOK + b * LC + g * 64 + c, kvh = h >> 2;
        const int qc = (kind == 2) ? PC_BQ + h * 64 : PC_CQ + h * 64, kc = (kind == 2) ? PC_BK + h * 64 : PC_CK + kvh * 64, vc = (kind == 2) ? h * 64 : 512 + kvh * 64;
        attn_loadq(q, F.P1() + (size_t)qrow * NP1 + qc);
        for (int n = 0; n < LC; ++n) { const int crow = NTOK + b * LC + n;
            attn_key(q, a, F.P1() + (size_t)crow * NP1 + kc, F.VR() + (size_t)crow * NVR + vc, 0.f); }
        if (kind == 3) { const float sk = F.p.wa_sink[l * 8 + h];
            if (sk > a.m) { const float sc = expf(a.m - sk); a.l *= sc;
#pragma unroll
                for (int i = 0; i < 64; ++i) a.o[i] *= sc;
                a.m = sk; }
            a.l += expf(sk - a.m); }
        attn_store(a, F.BR() + (size_t)qrow * 2048 + (kind == 2 ? 512 : 1024) + h * 64);
    }
}


typedef short bf16x8_t __attribute__((ext_vector_type(8)));
typedef short bf16x4_t __attribute__((ext_vector_type(4)));
struct AttW { float m, l; f32x4 o[4]; };
template <class MaskF>
__device__ __forceinline__ void attn_step(AttW& a, const bf16x8_t (&qb)[2], const bf16_t* kp0, const bf16_t* kp1, const bf16_t* vp0, const bf16_t* vp1, const MaskF& maskf) {
    const bf16x8_t ka0 = *(const bf16x8_t*)kp0, ka1 = *(const bf16x8_t*)(kp0 + 32), kb0 = *(const bf16x8_t*)kp1, kb1 = *(const bf16x8_t*)(kp1 + 32);
    bf16x4_t va[4][2];
#pragma unroll
    for (int t = 0; t < 4; ++t) { va[t][0] = *(const bf16x4_t*)(vp0 + (size_t)t * 16 * NROW); va[t][1] = *(const bf16x4_t*)(vp1 + (size_t)t * 16 * NROW); }
    f32x4 s0 = {0.f, 0.f, 0.f, 0.f}, s1 = {0.f, 0.f, 0.f, 0.f};
    s0 = __builtin_amdgcn_mfma_f32_16x16x32_bf16(ka0, qb[0], s0, 0, 0, 0); s0 = __builtin_amdgcn_mfma_f32_16x16x32_bf16(ka1, qb[1], s0, 0, 0, 0);
    s1 = __builtin_amdgcn_mfma_f32_16x16x32_bf16(kb0, qb[0], s1, 0, 0, 0); s1 = __builtin_amdgcn_mfma_f32_16x16x32_bf16(kb1, qb[1], s1, 0, 0, 0);
    maskf(s0, s1);
    float mx = fmaxf(fmaxf(fmaxf(s0.x, s0.y), fmaxf(s0.z, s0.w)), fmaxf(fmaxf(s1.x, s1.y), fmaxf(s1.z, s1.w)));
    mx = fmaxf(mx, __shfl_xor(mx, 16)); mx = fmaxf(mx, __shfl_xor(mx, 32));
    const float mn = fmaxf(a.m, mx), alpha = __expf(a.m - mn); a.m = mn;
    f32x4 p0, p1;
    p0.x = __expf(s0.x - mn); p0.y = __expf(s0.y - mn); p0.z = __expf(s0.z - mn); p0.w = __expf(s0.w - mn);
    p1.x = __expf(s1.x - mn); p1.y = __expf(s1.y - mn); p1.z = __expf(s1.z - mn); p1.w = __expf(s1.w - mn);
    a.l = a.l * alpha + ((p0.x + p0.y) + (p0.z + p0.w)) + ((p1.x + p1.y) + (p1.z + p1.w));
    union { bf16x8_t v; unsigned u[4]; } pb;
    pb.u[0] = pk2(p0.x, p0.y); pb.u[1] = pk2(p0.z, p0.w); pb.u[2] = pk2(p1.x, p1.y); pb.u[3] = pk2(p1.z, p1.w);
#pragma unroll
    for (int t = 0; t < 4; ++t) {
        union { bf16x8_t v; bf16x4_t h[2]; } av; av.h[0] = va[t][0]; av.h[1] = va[t][1];
        a.o[t] = a.o[t] * alpha;
        a.o[t] = __builtin_amdgcn_mfma_f32_16x16x32_bf16(av.v, pb.v, a.o[t], 0, 0, 0);
    }
}
struct MaskNone { __device__ __forceinline__ void operator()(f32x4&, f32x4&) const {} };
struct MaskNA { int c, csq, kc0; const float* brow;
    __device__ __forceinline__ void operator()(f32x4& s0, f32x4& s1) const {
        float v[8] = {s0.x, s0.y, s0.z, s0.w, s1.x, s1.y, s1.z, s1.w};
#pragma unroll
        for (int T = 0; T < 2; ++T)
#pragma unroll
            for (int rr = 0; rr < 4; ++rr) { const int kc = kc0 + 16 * T + rr; const bool ok = (kc >= csq) && (kc <= csq + 15);
                const float bias = brow[min(max(kc - c + 15, 0), 30)]; v[T * 4 + rr] = ok ? v[T * 4 + rr] + bias : -INFINITY; }
        s0 = (f32x4){v[0], v[1], v[2], v[3]}; s1 = (f32x4){v[4], v[5], v[6], v[7]};
    }
};
struct MaskWA { int i, j0;
    __device__ __forceinline__ void operator()(f32x4& s0, f32x4& s1) const {
        float v[8] = {s0.x, s0.y, s0.z, s0.w, s1.x, s1.y, s1.z, s1.w};
#pragma unroll
        for (int T = 0; T < 2; ++T)
#pragma unroll
            for (int rr = 0; rr < 4; ++rr) { const int j = j0 + 16 * T + rr; const bool ok = (j >= 0) && (j < SEQ) && (i - j <= 128) && (j - i <= 128);
                v[T * 4 + rr] = ok ? v[T * 4 + rr] : -INFINITY; }
        s0 = (f32x4){v[0], v[1], v[2], v[3]}; s1 = (f32x4){v[4], v[5], v[6], v[7]};
    }
};
template <int kind>
__device__ __forceinline__ void attn_wave(Frame& F, int l, int item, const float* rpb_s) {
    const int lane = F.lane, n = lane & 15, g = lane >> 4;
    const bf16_t* P1 = F.P1(); const bf16_t* VT = F.VT();
    int b, h, qrow0, kcol, vrow, qcol, brcol;
    int r = 0, cb = 0, t0 = 0;
    if (kind == 0) { cb = item & 3; r = (item >> 2) & 63; h = (item >> 8) & 7; b = item >> 11; qrow0 = b * SEQ + r * 64 + cb * 16; qcol = PC_BQ + h * 64; kcol = PC_BK + h * 64; vrow = h * 64; brcol = 512 + h * 64; }
    else if (kind == 1) { const int hq = item & 3, qt = (item >> 2) & 255, kvh = (item >> 10) & 1; b = item >> 11; h = kvh * 4 + hq; t0 = qt * 16; qrow0 = b * SEQ + t0; qcol = PC_CQ + h * 64; kcol = PC_CK + kvh * 64; vrow = 512 + kvh * 64; brcol = 1024 + h * 64; }
    else if (kind == 2) { const int qt = item & 15; h = (item >> 4) & 7; b = item >> 7; qrow0 = NTOK + b * LC + qt * 16; qcol = PC_BQ + h * 64; kcol = PC_BK + h * 64; vrow = h * 64; brcol = 512 + h * 64; }
    else { const int hq = item & 3, qt = (item >> 2) & 15, kvh = (item >> 6) & 1; b = item >> 7; h = kvh * 4 + hq; qrow0 = NTOK + b * LC + qt * 16; qcol = PC_CQ + h * 64; kcol = PC_CK + kvh * 64; vrow = 512 + kvh * 64; brcol = 1024 + h * 64; }
    bf16x8_t qb[2];
    { const bf16_t* qp = P1 + (size_t)(qrow0 + n) * NP1 + qcol + 8 * g; qb[0] = *(const bf16x8_t*)qp; qb[1] = *(const bf16x8_t*)(qp + 32); }
    AttW a; a.m = -1e30f; a.l = 0.f;
#pragma unroll
    for (int t = 0; t < 4; ++t) a.o[t] = (f32x4){0.f, 0.f, 0.f, 0.f};
    const bf16_t* vbase = VT + (size_t)(vrow + n) * NROW + 4 * g;
    {   const int crow0 = NTOK + b * LC;
#pragma unroll 2
        for (int s = 0; s < 8; ++s) {
            const bf16_t* kp0 = P1 + (size_t)(crow0 + 32 * s + n) * NP1 + kcol + 8 * g;
            attn_step(a, qb, kp0, kp0 + (size_t)16 * NP1, vbase + crow0 + 32 * s, vbase + crow0 + 32 * s + 16, MaskNone());
        }
    }
    if (kind == 0) {
        const int c = cb * 16 + n, csq = min(max(c - 8, 0), 48), w0 = (cb == 0) ? 0 : (cb == 1 ? 8 : (cb == 2 ? 24 : 32)), rs = min(max(r - 4, 0), 56);
#pragma unroll 2
        for (int kr = rs; kr < rs + 8; ++kr) {
            const int tok0 = b * SEQ + kr * 64 + w0;
            const bf16_t* kp0 = P1 + (size_t)(tok0 + n) * NP1 + kcol + 8 * g;
            MaskNA mk{c, csq, w0 + 4 * g, rpb_s + (h * 15 + (kr - r + 7)) * 31};
            attn_step(a, qb, kp0, kp0 + (size_t)16 * NP1, vbase + tok0, vbase + tok0 + 16, mk);
        }
    } else if (kind == 1) {
#pragma unroll 2
        for (int s = 0; s < 9; ++s) {
            const int kb = t0 - 128 + 32 * s;
            const int ja = min(max(kb + n, 0), SEQ - 1), jb = min(max(kb + 16 + n, 0), SEQ - 1);
            const int va = min(max(kb + 4 * g, 0), SEQ - 4), vb = min(max(kb + 16 + 4 * g, 0), SEQ - 4);
            const bf16_t* kp0 = P1 + (size_t)(b * SEQ + ja) * NP1 + kcol + 8 * g; const bf16_t* kp1 = P1 + (size_t)(b * SEQ + jb) * NP1 + kcol + 8 * g;
            const bf16_t* vb0 = VT + (size_t)(vrow + n) * NROW + b * SEQ;
            MaskWA mk{t0 + n, kb + 4 * g};
            attn_step(a, qb, kp0, kp1, vb0 + va, vb0 + vb, mk);
        }
    }
    float lt = a.l; lt += __shfl_xor(lt, 16); lt += __shfl_xor(lt, 32);
    float osc = 1.f;
    if (kind == 1 || kind == 3) { const float sk = F.p.wa_sink[l * 8 + h], mf = fmaxf(a.m, sk); osc = __expf(a.m - mf); lt = lt * osc + __expf(sk - mf); }
    const float inv = osc / lt;
    bf16_t* op = F.BR() + (size_t)(qrow0 + n) * 2048 + brcol + 4 * g;
#pragma unroll
    for (int t = 0; t < 4; ++t) { const f32x4 v = a.o[t] * inv; u32x2 o2; o2.x = pk2(v.x, v.y); o2.y = pk2(v.z, v.w); *(u32x2*)(op + 16 * t) = o2; }
}


template <int DK, bool HG>
__device__ void scan_mfma(Frame& F, int l, int b, int h, int z, unsigned char* lds) {
    constexpr int NDP = DK / 2, NTG = NTHR / NDP, TPT = 64 / NTG, QS = DK + 8, TS = 72, NDT = DK / 16;
    bf16_t* QD = (bf16_t*)lds; bf16_t* KD = QD + 64 * QS; bf16_t* KDT = KD + 64 * QS; bf16_t* VTs = KDT + DK * TS; bf16_t* AM = VTs + 128 * TS; bf16_t* ST = AM + 64 * TS;
    float* TOT = (float*)(ST + 128 * QS); float* E1s = TOT + NTG * DK; float* E2s = E1s + DK;
    REFRESH(F);
    const int tid = F.tid, lane = F.lane, w = F.wave, n = lane & 15, g = lane >> 4;
    const int dp = tid % NDP, tg = tid / NDP, vp = tid & 63, vg = tid >> 6;
    const bf16_t* P1 = F.P1();
    float lw[HG ? 2 : 32], lbias[2] = {0.f, 0.f}, lbv[2] = {0.f, 0.f};
    if (!HG) {
#pragma unroll
        for (int r = 0; r < 16; ++r) { const float* wp = F.p.gla_lr_w + ((size_t)(l * 2 + z) * 16 + r) * 256 + h * 64 + 2 * dp; lw[2 * r] = wp[0]; lw[2 * r + 1] = wp[1]; }
        lbias[0] = F.p.gla_lr_b[(l * 2 + z) * 256 + h * 64 + 2 * dp]; lbias[1] = F.p.gla_lr_b[(l * 2 + z) * 256 + h * 64 + 2 * dp + 1];
    } else { lw[0] = lw[1] = 0.f; if (l != 0) { lbv[0] = F.lb()[z * 512 + h * 128 + 2 * dp]; lbv[1] = F.lb()[z * 512 + h * 128 + 2 * dp + 1]; } }
    f32x4 accS[NDT];
#pragma unroll
    for (int i = 0; i < NDT; ++i) accS[i] = (f32x4){0.f, 0.f, 0.f, 0.f};
    unsigned rq[TPT], rk[TPT], rv[8]; u32x4 rl[HG ? 1 : TPT][2];
    const int qcol = HG ? PC_DQ + h * 128 + 2 * dp : PC_AQ + h * 64 + 2 * dp, kcol = HG ? PC_DF + z * 512 + h * 128 + 2 * dp : PC_AK + h * 64 + 2 * dp;
    const int vcol = (HG ? PC_DI : PC_AV) + h * 128 + 2 * vp;
#define SCAN_LOAD(c) do { _Pragma("unroll") for (int tt = 0; tt < TPT; ++tt) { const bf16_t* base = P1 + (size_t)seq_row((c) * 64 + tg * TPT + tt, b, z) * NP1; \
            rq[tt] = *(const unsigned*)(base + qcol); rk[tt] = *(const unsigned*)(base + kcol); \
            if (!HG) { rl[tt][0] = *(const u32x4*)(base + PC_ALR + z * 16); rl[tt][1] = *(const u32x4*)(base + PC_ALR + z * 16 + 8); } } \
        _Pragma("unroll") for (int tt = 0; tt < 8; ++tt) rv[tt] = *(const unsigned*)(P1 + (size_t)seq_row((c) * 64 + vg * 8 + tt, b, z) * NP1 + vcol); } while (0)
    SCAN_LOAD(0);
    constexpr int NCH = (LC + SEQ) / 64;
#pragma unroll 1
    for (int c = 0; c < NCH; ++c) {
        float qv[TPT][2], kv[TPT][2], cs[TPT][2];
#pragma unroll
        for (int tt = 0; tt < TPT; ++tt)
#pragma unroll
            for (int e = 0; e < 2; ++e) {
                const float qr = __uint_as_float(e ? (rq[tt] & 0xffff0000u) : (rq[tt] << 16)), kr = __uint_as_float(e ? (rk[tt] & 0xffff0000u) : (rk[tt] << 16));
                float gg;
                if (HG) {
                    const float ls = fminf(kr, 0.f) - __logf(1.f + __expf(-fabsf(kr)));
                    gg = (lbv[e] > 0.f) ? __logf(lbv[e] + (1.f - lbv[e]) * __expf(ls)) : ls;
                    kv[tt][e] = (1.f - lbv[e]) * __expf(ls - kr);
                    qv[tt][e] = qr / (1.f + __expf(-qr));
                } else {
                    float lg = lbias[e];
                    const unsigned lr8[8] = {rl[tt][0].x, rl[tt][0].y, rl[tt][0].z, rl[tt][0].w, rl[tt][1].x, rl[tt][1].y, rl[tt][1].z, rl[tt][1].w};
#pragma unroll
                    for (int r2 = 0; r2 < 8; ++r2) { lg += __uint_as_float(lr8[r2] << 16) * lw[(2 * r2) * 2 + e]; lg += __uint_as_float(lr8[r2] & 0xffff0000u) * lw[(2 * r2 + 1) * 2 + e]; }
                    gg = (fminf(lg, 0.f) - __logf(1.f + __expf(-fabsf(lg)))) * (1.f / 16.f);
                    kv[tt][e] = kr; qv[tt][e] = qr;
                }
                cs[tt][e] = gg + (tt ? cs[tt ? tt - 1 : 0][e] : 0.f);
                __builtin_amdgcn_sched_barrier(0);
            }
        TOT[tg * DK + 2 * dp] = cs[TPT - 1][0]; TOT[tg * DK + 2 * dp + 1] = cs[TPT - 1][1];
        __syncthreads();
        float offs[2] = {0.f, 0.f}, mid[2] = {0.f, 0.f}, lastv[2] = {0.f, 0.f};
#pragma unroll
        for (int t2 = 0; t2 < NTG; ++t2)
#pragma unroll
            for (int e = 0; e < 2; ++e) { const float tv = TOT[t2 * DK + 2 * dp + e]; if (t2 < tg) offs[e] += tv; if (t2 < NTG / 2) mid[e] += tv; lastv[e] += tv; }
        unsigned kdt[2][TPT / 2];
#pragma unroll
        for (int tt = 0; tt < TPT; ++tt) {
            float qd[2], kd[2];
#pragma unroll
            for (int e = 0; e < 2; ++e) { const float bc = cs[tt][e] + offs[e]; qd[e] = qv[tt][e] * __expf(fminf(bc - mid[e], 80.f)); kd[e] = kv[tt][e] * __expf(fminf(mid[e] - bc, 80.f)); }
            const int tok = tg * TPT + tt;
            *(unsigned*)(QD + tok * QS + 2 * dp) = pk2(qd[0], qd[1]); *(unsigned*)(KD + tok * QS + 2 * dp) = pk2(kd[0], kd[1]);
#pragma unroll
            for (int e = 0; e < 2; ++e) { const unsigned hb = (unsigned)f2bf(kd[e]); if (tt & 1) kdt[e][tt >> 1] |= hb << 16; else kdt[e][tt >> 1] = hb; }
            __builtin_amdgcn_sched_barrier(0);
        }
#pragma unroll
        for (int e = 0; e < 2; ++e) {
            bf16_t* dst = KDT + (2 * dp + e) * TS + tg * TPT;
            if (TPT == 8) { u32x4 o; o.x = kdt[e][0]; o.y = kdt[e][1]; o.z = kdt[e][TPT / 2 - 2]; o.w = kdt[e][TPT / 2 - 1]; *(u32x4*)dst = o; }
            else { u32x2 o; o.x = kdt[e][0]; o.y = kdt[e][1]; *(u32x2*)dst = o; }
        }
        if (tg == 0) { E1s[2 * dp] = __expf(mid[0]); E1s[2 * dp + 1] = __expf(mid[1]); E2s[2 * dp] = __expf(lastv[0] - mid[0]); E2s[2 * dp + 1] = __expf(lastv[1] - mid[1]); }
        {   u32x4 o0, o1;
            o0.x = (rv[0] & 0xffffu) | (rv[1] << 16); o0.y = (rv[2] & 0xffffu) | (rv[3] << 16); o0.z = (rv[4] & 0xffffu) | (rv[5] << 16); o0.w = (rv[6] & 0xffffu) | (rv[7] << 16);
            o1.x = (rv[0] >> 16) | (rv[1] & 0xffff0000u); o1.y = (rv[2] >> 16) | (rv[3] & 0xffff0000u); o1.z = (rv[4] >> 16) | (rv[5] & 0xffff0000u); o1.w = (rv[6] >> 16) | (rv[7] & 0xffff0000u);
            *(u32x4*)(VTs + (2 * vp) * TS + vg * 8) = o0; *(u32x4*)(VTs + (2 * vp + 1) * TS + vg * 8) = o1; }
        if (c + 1 < NCH) SCAN_LOAD(c + 1);
        __syncthreads();
#pragma unroll
        for (int dt = 0; dt < NDT; ++dt) { accS[dt] = accS[dt] * *(const f32x4*)&E1s[16 * dt + 4 * g];
            u32x2 o; o.x = pk2(accS[dt].x, accS[dt].y); o.y = pk2(accS[dt].z, accS[dt].w); *(u32x2*)(ST + (16 * w + n) * QS + 16 * dt + 4 * g) = o; }
        {   const int it = w >> 1;
#pragma unroll
            for (int jj = 0; jj < 2; ++jj) { const int jt = 2 * (w & 1) + jj; f32x4 d = {0.f, 0.f, 0.f, 0.f};
                if (jt <= it) {
#pragma unroll
                    for (int ks = 0; ks < DK / 32; ++ks) d = __builtin_amdgcn_mfma_f32_16x16x32_bf16(*(const bf16x8_t*)(KD + (16 * jt + n) * QS + 32 * ks + 8 * g), *(const bf16x8_t*)(QD + (16 * it + n) * QS + 32 * ks + 8 * g), d, 0, 0, 0);
                    const int i = 16 * it + n, j0 = 16 * jt + 4 * g;
                    d.x = (j0 + 0 <= i) ? d.x : 0.f; d.y = (j0 + 1 <= i) ? d.y : 0.f; d.z = (j0 + 2 <= i) ? d.z : 0.f; d.w = (j0 + 3 <= i) ? d.w : 0.f;
                }
                u32x2 o; o.x = pk2(d.x, d.y); o.y = pk2(d.z, d.w); *(u32x2*)(AM + (16 * it + n) * TS + 16 * jt + 4 * g) = o; }
        }
        __syncthreads();
#pragma unroll
        for (int it = 0; it < 4; ++it) { f32x4 o = {0.f, 0.f, 0.f, 0.f};
#pragma unroll
            for (int ks = 0; ks < 2; ++ks) o = __builtin_amdgcn_mfma_f32_16x16x32_bf16(*(const bf16x8_t*)(VTs + (16 * w + n) * TS + 32 * ks + 8 * g), *(const bf16x8_t*)(AM + (16 * it + n) * TS + 32 * ks + 8 * g), o, 0, 0, 0);
#pragma unroll
            for (int ks = 0; ks < DK / 32; ++ks) o = __builtin_amdgcn_mfma_f32_16x16x32_bf16(*(const bf16x8_t*)(ST + (16 * w + n) * QS + 32 * ks + 8 * g), *(const bf16x8_t*)(QD + (16 * it + n) * QS + 32 * ks + 8 * g), o, 0, 0, 0);
            const int row = seq_row(c * 64 + 16 * it + n, b, z); bf16_t* dst;
            if (HG) dst = F.P1() + (size_t)row * NP1 + PC_DF + z * 512 + h * 128; else dst = (z == 0) ? F.BR() + (size_t)row * 2048 + h * 128 : F.OBA() + (size_t)row * 512 + h * 128;
            u32x2 o2; o2.x = pk2(o.x, o.y); o2.y = pk2(o.z, o.w); *(u32x2*)(dst + 16 * w + 4 * g) = o2; }
#pragma unroll
        for (int dt = 0; dt < NDT; ++dt) {
#pragma unroll
            for (int ks = 0; ks < 2; ++ks) accS[dt] = __builtin_amdgcn_mfma_f32_16x16x32_bf16(*(const bf16x8_t*)(KDT + (16 * dt + n) * TS + 32 * ks + 8 * g), *(const bf16x8_t*)(VTs + (16 * w + n) * TS + 32 * ks + 8 * g), accS[dt], 0, 0, 0);
            accS[dt] = accS[dt] * *(const f32x4*)&E2s[16 * dt + 4 * g]; }
        __syncthreads();
    }
#undef SCAN_LOAD
}

constexpr bool MF_SCAN = true;
__device__ void phase_mix(Frame& F, int l) {
    const int n_scan = 64;
    if (MF_ATTN) {
        const int nsb = (F.nb > 128) ? 64 : 0;
        if (nsb == 0 || F.bid < nsb) {
            for (int it = F.bid; it < n_scan; it += (nsb ? nsb : F.nb)) {
                const int br = it >> 5, r = it & 31, b = r >> 3, h = (r >> 1) & 3, z = r & 1;
                if (MF_SCAN) { if (br == 0) scan_mfma<64, false>(F, l, b, h, z, (unsigned char*)F.smf); else scan_mfma<128, true>(F, l, b, h, z, (unsigned char*)F.smf); }
                else { if (br == 0) scan_simple<64, false>(F, l, b, h, z); else scan_simple<128, true>(F, l, b, h, z); }
            }
        }
        if (nsb == 0 || F.bid >= nsb) {
            float* rpb_s = F.smf;
            __syncthreads();
            for (int i = F.tid; i < 8 * 465; i += NTHR) rpb_s[i] = F.p.na_rpb[(size_t)l * 8 * 465 + i];
            __syncthreads();
            const int gw = (F.bid - nsb) * 8 + F.wave, ngw = (F.nb - nsb) * 8;
            for (int it = gw; it < 8192; it += ngw) attn_wave<1>(F, l, it, rpb_s);
            for (int it = gw; it < 8192; it += ngw) attn_wave<0>(F, l, it, rpb_s);
            if (l == 0) { for (int it = gw; it < 512; it += ngw) attn_wave<2>(F, l, it, rpb_s);
                          for (int it = gw; it < 512; it += ngw) attn_wave<3>(F, l, it, rpb_s); }
        }
        return;
    }
    const int n_na = 256, n_wa = 256, n_ctx = (l == 0) ? 32 : 0, total = n_scan + n_na + n_wa + n_ctx;
    for (int it = F.bid; it < total; it += F.nb) {
        if (it < n_scan) {
            const int br = it >> 5, r = it & 31, b = r >> 3, h = (r >> 1) & 3, z = r & 1;
            if (br == 0) scan_simple<64, false>(F, l, b, h, z); else scan_simple<128, true>(F, l, b, h, z);
        } else if (it < n_scan + n_na) attn_simple<0>(F, l, it - n_scan);
        else if (it < n_scan + n_na + n_wa) attn_simple<1>(F, l, it - n_scan - n_na);
        else { const int j = it - n_scan - n_na - n_wa; if (j < 16) attn_simple<2>(F, l, j); else attn_simple<3>(F, l, j - 16); }
    }
}

__device__ void phase_prepad(Frame& F, int l) {
    const int gw = F.bid * 8 + F.wave, ngw = F.nb * 8, nrows = (l == 0) ? NROW : NTOK;
    for (int row = gw; row < nrows; row += ngw) {
        const int c0 = F.lane * 8;
        {   float a[8], b[8], g[8], o[8];
            ld8(F.BR() + (size_t)row * 2048 + c0, a); ld8(F.OBA() + (size_t)row * 512 + c0, b); ld8(F.P1() + (size_t)row * NP1 + PC_AG + c0, g);
            float ss = 0.f;
#pragma unroll
            for (int j = 0; j < 8; ++j) { o[j] = a[j] + b[j]; ss += o[j] * o[j]; }
            ss += __shfl_xor(ss, 1); ss += __shfl_xor(ss, 2); ss += __shfl_xor(ss, 4); ss += __shfl_xor(ss, 8);
            const float rs = rsqrtf(ss * (1.f / 128.f) + 1e-6f);
#pragma unroll
            for (int j = 0; j < 8; ++j) o[j] = o[j] * rs * siluf_(g[j]);
            st8(F.BR() + (size_t)row * 2048 + c0, o); }
        {   float a[8], b[8], g[8], o[8];
            ld8(F.P1() + (size_t)row * NP1 + PC_DF + c0, a); ld8(F.P1() + (size_t)row * NP1 + PC_DF + 512 + c0, b); ld8(F.P1() + (size_t)row * NP1 + PC_DG + c0, g);
            float ss = 0.f;
#pragma unroll
            for (int j = 0; j < 8; ++j) { o[j] = a[j] + b[j]; ss += o[j] * o[j]; }
            ss += __shfl_xor(ss, 1); ss += __shfl_xor(ss, 2); ss += __shfl_xor(ss, 4); ss += __shfl_xor(ss, 8);
            const float rs = rsqrtf(ss * (1.f / 128.f) + 1e-6f);
#pragma unroll
            for (int j = 0; j < 8; ++j) o[j] = o[j] * rs * siluf_(g[j]);
            st8(F.BR() + (size_t)row * 2048 + 1536 + c0, o); }
    }
}

__device__ void phase_merge_s(Frame& F, int l) {
    const int M = (l == 0) ? NROW : NTOK, tn = DM / 128, nt = (M / 128) * tn, ty = F.tid >> 5, tx = F.tid & 31;
    for (int t = F.bid; t < nt; t += F.nb) {
        const int row0 = (t / tn) * 128, col0 = (t % tn) * 128;
        float sum[8][4];
#pragma unroll
        for (int i = 0; i < 8; ++i)
#pragma unroll
            for (int j = 0; j < 4; ++j) sum[i][j] = 0.f;
#pragma unroll 1
        for (int br = 0; br < 4; ++br) {
            float acc[8][4];
#pragma unroll
            for (int i = 0; i < 8; ++i)
#pragma unroll
                for (int j = 0; j < 4; ++j) acc[i][j] = 0.f;
            gemm_s_acc(acc, F.BR() + br * 512, 2048, F.Wbrt() + (size_t)br * DM * 512, 512, 512, row0, col0, F.smf, F.tid);
#pragma unroll
            for (int i = 0; i < 8; ++i) { const u32x2 g2 = *(const u32x2*)(F.G() + (size_t)(row0 + ty * 8 + i) * NGATE + br * 1024 + col0 + tx * 4);
                sum[i][0] += __uint_as_float(g2.x << 16) * acc[i][0]; sum[i][1] += __uint_as_float(g2.x & 0xffff0000u) * acc[i][1];
                sum[i][2] += __uint_as_float(g2.y << 16) * acc[i][2]; sum[i][3] += __uint_as_float(g2.y & 0xffff0000u) * acc[i][3]; }
        }
#pragma unroll
        for (int i = 0; i < 8; ++i) { u32x2 o2; o2.x = pk2(sum[i][0], sum[i][1]); o2.y = pk2(sum[i][2], sum[i][3]);
            *(u32x2*)(F.HX() + (size_t)(row0 + ty * 8 + i) * DM + col0 + tx * 4) = o2; }
    }
}

__device__ void phase_ln1(Frame& F, int l) {
    const int gw = F.bid * 8 + F.wave, ngw = F.nb * 8, nrows = (l == 0) ? NROW : NTOK;
    const float* lg = F.p.ln_g + (size_t)(l * 2 + 0) * DM; const float* lbb = F.p.ln_b + (size_t)(l * 2 + 0) * DM;
    const float* wg = F.p.moe_w_group + (size_t)l * DM * 4; const float* we = F.p.moe_w_expert + (size_t)l * DM * 32;
    for (int row = gw; row < nrows; row += ngw) {
        float* xr = row < NTOK ? F.p.out + (size_t)row * DM : F.cxm() + (size_t)(row - NTOK) * DM;
        const float* mv = F.modv() + ((size_t)l * 5 + row_batch(row)) * 6144;
        f32x4 v[4]; float s = 0.f;
#pragma unroll
        for (int j = 0; j < 4; ++j) { v[j] = *(const f32x4*)(xr + j * 256 + F.lane * 4); s += (v[j].x + v[j].y) + (v[j].z + v[j].w); }
        const float mean = wave_sum(s) * (1.f / DM); float s2 = 0.f;
#pragma unroll
        for (int j = 0; j < 4; ++j) { v[j] = v[j] - mean; s2 += (v[j].x * v[j].x + v[j].y * v[j].y) + (v[j].z * v[j].z + v[j].w * v[j].w); }
        const float rstd = rsqrtf(wave_sum(s2) * (1.f / DM) + LN_EPS);
        float lgt[36];
#pragma unroll
        for (int o = 0; o < 36; ++o) lgt[o] = 0.f;
#pragma unroll
        for (int j = 0; j < 4; ++j) { const int d = j * 256 + F.lane * 4;
            const f32x4 g4 = *(const f32x4*)(lg + d), b4 = *(const f32x4*)(lbb + d), m3 = *(const f32x4*)(mv + 3 * 1024 + d), m4 = *(const f32x4*)(mv + 4 * 1024 + d);
            const f32x4 xn = v[j] * rstd * g4 + b4;
            *(f32x4*)(xr + d) = xn;
            const f32x4 h2 = xn * (1.f + m4) + m3;
            u32x2 o2; o2.x = pk2(h2.x, h2.y); o2.y = pk2(h2.z, h2.w);
            *(u32x2*)(F.HX2() + (size_t)row * DM + d) = o2;
            const float hh[4] = {h2.x, h2.y, h2.z, h2.w};
#pragma unroll
            for (int q = 0; q < 4; ++q) {
                const f32x4 w4 = *(const f32x4*)(wg + (size_t)(d + q) * 4);
                lgt[0] += hh[q] * w4.x; lgt[1] += hh[q] * w4.y; lgt[2] += hh[q] * w4.z; lgt[3] += hh[q] * w4.w;
#pragma unroll
                for (int o4 = 0; o4 < 8; ++o4) { const f32x4 e4 = *(const f32x4*)(we + (size_t)(d + q) * 32 + o4 * 4);
                    lgt[4 + o4 * 4 + 0] += hh[q] * e4.x; lgt[4 + o4 * 4 + 1] += hh[q] * e4.y; lgt[4 + o4 * 4 + 2] += hh[q] * e4.z; lgt[4 + o4 * 4 + 3] += hh[q] * e4.w; }
            }
        }
#pragma unroll
        for (int o = 0; o < 36; ++o) lgt[o] = wave_sum(lgt[o]);
        if (F.lane == 0) {
            float gl[4]; int gi = 0; float gm = -3.4e38f;
#pragma unroll
            for (int o = 0; o < 4; ++o) { gl[o] = lgt[o] + F.p.moe_b_group[l * 4 + o]; if (gl[o] > gm) { gm = gl[o]; gi = o; } }
            float gs = 0.f;
#pragma unroll
            for (int o = 0; o < 4; ++o) gs += expf(gl[o] - gm);
            const float gwt = 1.f / gs;
            float e1 = -3.4e38f, e2 = -3.4e38f; int i1 = 0, i2 = 0;
#pragma unroll
            for (int o = 0; o < 32; ++o) {
                if ((o >> 3) == gi) { const float ev = lgt[4 + o] + F.p.moe_b_expert[l * 32 + o];
                    if (ev > e1) { e2 = e1; i2 = i1; e1 = ev; i1 = o; } else if (ev > e2) { e2 = ev; i2 = o; } }
            }
            const float w1 = 1.f / (1.f + expf(e2 - e1)), w2 = 1.f - w1;
            const unsigned p1 = atomicAdd(&F.cnt()[l * 32 + i1], 1u), p2 = atomicAdd(&F.cnt()[l * 32 + i2], 1u);
            F.tokE()[row * 2] = i1; F.tokI()[row * 2] = (int)p1; F.tokW()[row * 2] = gwt * w1;
            F.tokE()[row * 2 + 1] = i2; F.tokI()[row * 2 + 1] = (int)p2; F.tokW()[row * 2 + 1] = gwt * w2;
        }
    }
}

__device__ void phase_gather(Frame& F, int l) {
    int* off = (int*)F.smf; moe_offsets(F, l, off);
    const int gw = F.bid * 8 + F.wave, ngw = F.nb * 8, nrows = (l == 0) ? NROW : NTOK;
    for (int s = gw; s < 2 * nrows; s += ngw) {
        const int e = F.tokE()[s], dst = off[e] + F.tokI()[s];
        const u32x4* src = (const u32x4*)(F.HX2() + (size_t)(s >> 1) * DM); u32x4* d = (u32x4*)(F.XS() + (size_t)dst * DM);
        d[F.lane] = src[F.lane]; d[F.lane + 64] = src[F.lane + 64];
        if (F.lane == 0) { F.rmap()[dst] = s; F.roww()[dst] = F.tokW()[s]; }
    }
    for (int e = 0; e < 32; ++e) {
        const int c = (int)F.cnt()[l * 32 + e], pc = (c + 255) & ~255;
        for (int j = c + gw; j < pc; j += ngw) { const int dst = off[e] + j; u32x4* d = (u32x4*)(F.XS() + (size_t)dst * DM);
            const u32x4 z = {0u, 0u, 0u, 0u}; d[F.lane] = z; d[F.lane + 64] = z;
            if (F.lane == 0) { F.rmap()[dst] = -1; F.roww()[dst] = 0.f; } }
    }
}
__device__ __forceinline__ int expert_of_row(const int* off, int row) { int e = 0;
#pragma unroll 1
    for (int i = 1; i < 32; ++i) if (row >= off[i]) e = i;
    return e; }

__device__ void phase_ln2(Frame& F, int l) {
    const int gw = F.bid * 8 + F.wave, ngw = F.nb * 8, nrows = (l == 0) ? NROW : NTOK;
    const float* lg = F.p.ln_g + (size_t)(l * 2 + 1) * DM; const float* lbb = F.p.ln_b + (size_t)(l * 2 + 1) * DM;
    const bf16_t* Y = F.BR();
    const bool tmo_set = (l == DEPTH - 1) && ((__hip_atomic_load((unsigned*)(F.ws + WS_CTL) + XB_TMO, __ATOMIC_RELAXED, __HIP_MEMORY_SCOPE_AGENT) | __hip_atomic_load((unsigned*)(F.ws + WS_CTL) + XCD_BAR_WORDS + XB_TMO, __ATOMIC_RELAXED, __HIP_MEMORY_SCOPE_AGENT)) != 0u);
    for (int row = gw; row < nrows; row += ngw) {
        const float* xm = row < NTOK ? F.p.out + (size_t)row * DM : F.cxm() + (size_t)(row - NTOK) * DM;
        float* xo = row < NTOK ? F.p.out + (size_t)row * DM : F.cxo() + (size_t)(row - NTOK) * DM;
        const float* mv = F.modv() + ((size_t)l * 5 + row_batch(row)) * 6144;
        f32x4 v[4]; float s = 0.f;
#pragma unroll
        for (int j = 0; j < 4; ++j) { const int d = j * 256 + F.lane * 4;
            const u32x2 y0 = *(const u32x2*)(Y + (size_t)(row * 2) * DM + d), y1 = *(const u32x2*)(Y + (size_t)(row * 2 + 1) * DM + d);
            f32x4 y; y.x = __uint_as_float(y0.x << 16) + __uint_as_float(y1.x << 16); y.y = __uint_as_float(y0.x & 0xffff0000u) + __uint_as_float(y1.x & 0xffff0000u);
            y.z = __uint_as_float(y0.y << 16) + __uint_as_float(y1.y << 16); y.w = __uint_as_float(y0.y & 0xffff0000u) + __uint_as_float(y1.y & 0xffff0000u);
            const f32x4 m5 = *(const f32x4*)(mv + 5 * 1024 + d);
            v[j] = ALPHA * *(const f32x4*)(xm + d) + m5 * y; s += (v[j].x + v[j].y) + (v[j].z + v[j].w); }
        const float mean = wave_sum(s) * (1.f / DM); float s2 = 0.f;
#pragma unroll
        for (int j = 0; j < 4; ++j) { v[j] = v[j] - mean; s2 += (v[j].x * v[j].x + v[j].y * v[j].y) + (v[j].z * v[j].z + v[j].w * v[j].w); }
        const float rstd = rsqrtf(wave_sum(s2) * (1.f / DM) + LN_EPS);
#pragma unroll
        for (int j = 0; j < 4; ++j) { const int d = j * 256 + F.lane * 4;
            const f32x4 g4 = *(const f32x4*)(lg + d), b4 = *(const f32x4*)(lbb + d);
            f32x4 xn = v[j] * rstd * g4 + b4;
            if (tmo_set) xn = xn * __uint_as_float(0x7fc00000u);
            *(f32x4*)(xo + d) = xn;
            if (l + 1 < DEPTH) { const float* mn = F.modv() + ((size_t)(l + 1) * 5 + row_batch(row)) * 6144;
                const f32x4 m0 = *(const f32x4*)(mn + d), m1 = *(const f32x4*)(mn + 1024 + d); const f32x4 h = xn * (1.f + m1) + m0;
                u32x2 o2; o2.x = pk2(h.x, h.y); o2.y = pk2(h.z, h.w); *(u32x2*)(F.HX() + (size_t)row * DM + d) = o2; }
        }
    }
}

constexpr int NPL = 14, NPH = 1 + DEPTH * NPL;
constexpr bool MF_G1 = true, MF_GATE = true, MF_MERGE = true, MF_WOUT = true, MF_MOE1 = true, MF_MOE2 = true;
constexpr int LDS_STAGE = 1024;
#define EN(i) (((PHMASK) >> (i)) & 1)
template <int PHMASK>
__global__ void __launch_bounds__(NTHR, 2) mega(Params p) {
    extern __shared__ __attribute__((aligned(16))) unsigned char smem[];
    Frame F; F.p = p; F.bid = blockIdx.x; F.nb = gridDim.x; F.tid = threadIdx.x; F.lane = threadIdx.x & 63; F.wave = threadIdx.x >> 6;
    F.smf = (float*)(smem + LDS_STAGE);
    LAS unsigned char* stage = (LAS unsigned char*)smem + LDS_STAGE; int* offt = (int*)(smem + 64);
    unsigned char* ws = p.ws; F.ws = ws;

    if (threadIdx.x == 0) *(uint4*)smem = make_uint4(0u, 0u, 0u, 0u);
    __syncthreads();
    unsigned* barw = (unsigned*)(ws + WS_CTL) + (p.ph_lo == 0 ? 0 : XCD_BAR_WORDS);
    XcdBarrier bar; bar.bar = barw; bar.x = 0; bar.st = (volatile LAS unsigned*)smem;
    const bool multi = (p.ph_hi - p.ph_lo) > 1;
    if (multi) bar = xcd_barrier_post(barw, (volatile LAS unsigned*)smem);
    const int lo = p.ph_lo, hi = p.ph_hi;
#define IN(k) (lo <= (k) && (k) < hi)
#define SEAM(k) do { if (IN(k) && IN((k) + 1)) xcd_barrier(bar); else __syncthreads(); } while (0)

    if (EN(14) && IN(0)) { REFRESH(F); phase_mod(F); __syncthreads(); phase_conv_a(F, 0); }
    SEAM(0);
#pragma unroll 1
    for (int l = 0; l < DEPTH; ++l) {
        const int pb = 1 + l * NPL;
        const float* xlat = (l == 0) ? p.x : p.out; const float* xctx = (l == 0) ? p.ctx : F.cxo();
        const int Mrows = (l == 0) ? NROW : NTOK;
        if (EN(0) && IN(pb + 0)) { REFRESH(F); if (l == 0) phase_prep(F, 0, p.x, p.ctx); else phase_conv_a(F, l); }
        SEAM(pb + 0);
        if (EN(1) && IN(pb + 1)) { REFRESH(F);
            bf16_t* P1 = F.P1(); bf16_t* VT = F.VT(); bf16_t* VR = F.VR();
            if (MF_G1) {
                pg::SchedG1 S{(const char*)F.HX(), (const char*)F.W1t(), (const char*)F.Wvt(), F.nb, F.bid}; pg::EpiG1 E{P1, VT};
                pg::gemm_phase(stage, DM, DM, DM, S, E);
                __syncthreads();
            } else {
            gemm_s(F, F.HX(), DM, F.W1t(), DM, NROW, NP1, DM, [=](int r, int c, float v) { P1[(size_t)r * NP1 + c] = f2bf(v); });
            gemm_s(F, F.Wvt(), DM, F.HX(), DM, NVT, NROW, DM, [=](int r, int c, float v) { VT[(size_t)r * NROW + c] = f2bf(v); });
            }
            if (!MF_ATTN) gemm_s(F, F.HX(), DM, F.Wvt(), DM, NROW, NVT, DM, [=](int r, int c, float v) { if (c < NVR) VR[(size_t)r * NVR + c] = f2bf(v); });
        }
        SEAM(pb + 1);
        if (EN(2) && IN(pb + 2)) { REFRESH(F); phase_rope(F); }
        SEAM(pb + 2);
        if (EN(3) && IN(pb + 3)) { REFRESH(F); phase_mix(F, l); }
        SEAM(pb + 3);
        if (EN(4) && IN(pb + 4)) { REFRESH(F); phase_prepad(F, l); }
        SEAM(pb + 4);
        if (EN(5) && IN(pb + 5)) { REFRESH(F);
            bf16_t* G = F.G();
            if (MF_GATE) {
                pg::SchedStatic S{(const char*)F.HX(), (const char*)F.Wgt(), (size_t)256 * DM * 2, (size_t)256 * DM * 2, Mrows / 256, NGATE / 256, F.nb, F.bid}; pg::EpiGate E{G};
                pg::gemm_phase(stage, DM, DM, DM, S, E);
                __syncthreads();
            } else
            gemm_s(F, F.HX(), DM, F.Wgt(), DM, Mrows, NGATE, DM, [=](int r, int c, float v) { G[(size_t)r * NGATE + c] = f2bf(sigmoidf_(v)); });
            phase_conv_b(F, l);
        }
        SEAM(pb + 5);
        if (EN(6) && IN(pb + 6)) { REFRESH(F);
            if (MF_MERGE) {
                pg::SchedMerge S{(const char*)F.BR(), (const char*)F.Wbrt(), (Mrows / 256) * 4, F.nb, F.bid}; pg::EpiMerge E{F.G(), F.HX()};
                pg::gemm_phase(stage, 2048, 512, 512, S, E);
            } else phase_merge_s(F, l);
        }
        SEAM(pb + 6);
        if (EN(7) && IN(pb + 7)) { REFRESH(F);
            float* outp = p.out; float* cxm = F.cxm(); const float* modv = F.modv() + (size_t)l * 5 * 6144;
            if (MF_WOUT) {
                pg::SchedStatic S{(const char*)F.HX(), (const char*)F.Woutt(), (size_t)256 * DM * 2, (size_t)256 * DM * 2, Mrows / 256, DM / 256, F.nb, F.bid};
                pg::EpiWout E{xlat, xctx, outp, cxm, modv};
                pg::gemm_phase(stage, DM, DM, DM, S, E);
            } else
            gemm_s(F, F.HX(), DM, F.Woutt(), DM, Mrows, DM, DM, [=](int r, int c, float v) {
                const float m2 = modv[(size_t)row_batch(r) * 6144 + 2 * 1024 + c];
                if (r < NTOK) outp[(size_t)r * DM + c] = ALPHA * xlat[(size_t)r * DM + c] + m2 * v;
                else cxm[(size_t)(r - NTOK) * DM + c] = ALPHA * xctx[(size_t)(r - NTOK) * DM + c] + m2 * v; });
        }
        SEAM(pb + 7);
        if (EN(8) && IN(pb + 8)) { REFRESH(F); phase_ln1(F, l); }
        SEAM(pb + 8);
        if (EN(9) && IN(pb + 9)) { REFRESH(F); phase_gather(F, l); }
        SEAM(pb + 9);
        if (EN(10) && IN(pb + 10)) { REFRESH(F);
            int* off = offt; moe_offsets(F, l, off);
            const int Mtot = off[32], nt = (Mtot / 128) * 4, ty = F.tid >> 5, tx = F.tid & 31; bf16_t* GU = F.BR();
            if (MF_MOE1) {
                pg::SchedMoe S{(const char*)F.XS(), (const char*)F.Wgu(), off, (size_t)256 * DM * 2, (size_t)512 * DM * 2, (size_t)256 * DM * 2, Mtot / 256, 2, F.nb, F.bid};
                pg::EpiMoe1 E{F.HID(), F.roww()};
                pg::gemm_phase(stage, DM, DM, DM, S, E);
            } else
            for (int t = F.bid; t < nt; t += F.nb) {
                const int row0 = (t >> 2) * 128, col0 = (t & 3) * 128, e = expert_of_row(off, row0);
                float acc[8][4];
#pragma unroll
                for (int i = 0; i < 8; ++i)
#pragma unroll
                    for (int j = 0; j < 4; ++j) acc[i][j] = 0.f;
                gemm_s_acc(acc, F.XS(), DM, F.Wgu() + (size_t)e * 512 * DM, DM, DM, row0, col0, F.smf, F.tid);
#pragma unroll
                for (int i = 0; i < 8; ++i)
#pragma unroll
                    for (int j = 0; j < 4; ++j) GU[(size_t)(row0 + ty * 8 + i) * 512 + col0 + tx * 4 + j] = f2bf(acc[i][j]);
            }
        }
        SEAM(pb + 10);
        if (EN(11) && IN(pb + 11) && !MF_MOE1) { REFRESH(F);
            int* off = (int*)F.smf; moe_offsets(F, l, off);
            const size_t total = (size_t)off[32] * 256; const bf16_t* GU = F.BR();
            for (size_t idx = (size_t)F.bid * NTHR + F.tid; idx < total; idx += (size_t)F.nb * NTHR) {
                const int r = (int)(idx >> 8), hc = (int)(idx & 255), j = hc >> 7, cc = hc & 127;
                const float g = bf2f(GU[(size_t)r * 512 + 256 * j + cc]), u = bf2f(GU[(size_t)r * 512 + 256 * j + 128 + cc]);
                F.HID()[(size_t)r * 256 + hc] = f2bf(siluf_(g) * u * F.roww()[r]);
            }
        }
        if (!MF_MOE1) SEAM(pb + 11);
        if (EN(12) && IN(pb + 12)) { REFRESH(F);
            int* off = offt; moe_offsets(F, l, off);
            const int Mtot = off[32], nt = (Mtot / 128) * 8, ty = F.tid >> 5, tx = F.tid & 31; bf16_t* Y = F.BR();
            if (MF_MOE2) {
                pg::SchedMoe S{(const char*)F.HID(), (const char*)F.Wd(), off, (size_t)256 * 256 * 2, (size_t)DM * 256 * 2, (size_t)256 * 256 * 2, Mtot / 256, 4, F.nb, F.bid};
                pg::EpiMoe2 E{Y, F.rmap(), (bf16_t*)(F.ws + WS_DUMP)};
                pg::gemm_phase(stage, 256, 256, 256, S, E);
            } else
            for (int t = F.bid; t < nt; t += F.nb) {
                const int row0 = (t >> 3) * 128, col0 = (t & 7) * 128, e = expert_of_row(off, row0);
                float acc[8][4];
#pragma unroll
                for (int i = 0; i < 8; ++i)
#pragma unroll
                    for (int j = 0; j < 4; ++j) acc[i][j] = 0.f;
                gemm_s_acc(acc, F.HID(), 256, F.Wd() + (size_t)e * DM * 256, 256, 256, row0, col0, F.smf, F.tid);
#pragma unroll
                for (int i = 0; i < 8; ++i) { const int s = F.rmap()[row0 + ty * 8 + i];
                    if (s >= 0) {
#pragma unroll
                        for (int j = 0; j < 4; ++j) Y[(size_t)s * DM + col0 + tx * 4 + j] = f2bf(acc[i][j]); } }
            }
        }
        SEAM(pb + 12);
        if (EN(13) && IN(pb + 13)) { REFRESH(F); phase_ln2(F, l); }
        SEAM(pb + 13);
    }
#undef IN
#undef SEAM
}

constexpr bool ONE_LAUNCH = true;
typedef void (*kern_t)(Params);
template <int I> struct KTab { static void fill(kern_t* t) { t[I] = mega<(1 << I)>; KTab<I - 1>::fill(t); } };
constexpr int GROUP_A = 0x4007;
template <> struct KTab<-1> { static void fill(kern_t*) {} };

extern "C" void kernel_launch(void* const* d_in, const int* in_sizes, int n_in, void* d_out, int out_size, void* d_ws, size_t ws_size, hipStream_t stream) {
    static int grid = 0;
    static kern_t ktab[16]; static kern_t kall = nullptr;
    if (grid == 0) {
        if (n_in != 23 || out_size != NTOK * DM || ws_size < WS_END) { fprintf(stderr, "kernel_launch: unexpected shapes (n_in %d out %d ws %zu need %zu)\n", n_in, out_size, ws_size, (size_t)WS_END); grid = -1; return; }
        int dev = 0, cus = 0;
        if (hipGetDevice(&dev) != hipSuccess || hipDeviceGetAttribute(&cus, hipDeviceAttributeMultiprocessorCount, dev) != hipSuccess) { grid = -1; return; }
        if (ONE_LAUNCH) {
            kall = mega<0x7FFF>;
            if (hipFuncSetAttribute((const void*)kall, hipFuncAttributeMaxDynamicSharedMemorySize, LDS_BYTES) != hipSuccess) { fprintf(stderr, "kernel_launch: hipFuncSetAttribute failed\n"); grid = -1; return; }
            int per_cu = 0;
            if (hipOccupancyMaxActiveBlocksPerMultiprocessor(&per_cu, (const void*)kall, NTHR, LDS_BYTES) != hipSuccess || per_cu < 1) { fprintf(stderr, "kernel_launch: occupancy query reports %d blocks per CU\n", per_cu); }
        } else {
            if constexpr (!ONE_LAUNCH) KTab<14>::fill(ktab);
            for (int i = 0; i < 15; ++i)
                if (hipFuncSetAttribute((const void*)ktab[i], hipFuncAttributeMaxDynamicSharedMemorySize, LDS_BYTES) != hipSuccess) { fprintf(stderr, "kernel_launch: hipFuncSetAttribute failed\n"); grid = -1; return; }
        }
        (void)hipGetLastError();
        grid = cus;
    }
    if (grid < 0) return;
    (void)hipMemsetAsync((char*)d_ws + WS_CTL, 0, CTL_BYTES, stream);
    Params p; memset(&p, 0, sizeof(p));
    const float** pp = (const float**)&p;
    for (int i = 0; i < 23; ++i) pp[i] = (const float*)d_in[i];
    p.out = (float*)d_out; p.ws = (unsigned char*)d_ws;
    if (ONE_LAUNCH) {
        p.ph_lo = 0; p.ph_hi = NPH;
        hipLaunchKernelGGL(kall, dim3(grid), dim3(NTHR), LDS_BYTES, stream, p);
    } else {
        for (int ph = 0; ph < NPH; ++ph) {
            p.ph_lo = ph; p.ph_hi = ph + 1;
            const int ki = (ph == 0) ? 14 : (ph - 1) % NPL;
            if (ki == 11 && MF_MOE1) continue;
            hipLaunchKernelGGL(ktab[ki], dim3(grid), dim3(NTHR), LDS_BYTES, stream, p);
        }
    }
}
```

```cpp
#include <hip/hip_runtime.h>
#include <cstdio>
#include <cstdint>
#include <cstring>

typedef unsigned short bf16_t;
typedef float f32x4 __attribute__((ext_vector_type(4)));
typedef unsigned u32x4 __attribute__((ext_vector_type(4)));
typedef unsigned u32x2 __attribute__((ext_vector_type(2)));

constexpr int NB = 4, SEQ = 4096, LC = 256, DM = 1024, DEPTH = 2;
constexpr int NTOK = NB * SEQ, NCTX = NB * LC, NROW = NTOK + NCTX;
constexpr int DIN = 10528;
constexpr int O_AQ = 0, O_AK = 256, O_AV = 512, O_AG = 1024, O_ALR = 1536, O_BQ = 1568, O_BK = 2080, O_BV = 2592, O_CQ = 3104, O_CK = 3616,
              O_CV = 3744, O_DQ = 3872, O_DF = 4384, O_DI = 5408, O_DG = 5920, O_GATE = 6432;
constexpr int PC_AQ = 0, PC_AK = 256, PC_AV = 512, PC_ALR = 1024, PC_BQ = 1280, PC_BK = 1792, PC_CQ = 2304, PC_CK = 2816, PC_DQ = 3072,
              PC_DF = 3584, PC_DI = 4608, PC_AG = 5120, PC_DG = 5632, NP1 = 6144;
constexpr int NVT = 768;
constexpr int NVR = 640;
constexpr int NGATE = 4096;
constexpr int XS_ROWS = 40960;
constexpr float LN_EPS = 1e-5f;
constexpr float ALPHA = 1.41421356237f;

constexpr size_t al256(size_t x) { return (x + 255) & ~(size_t)255; }
constexpr size_t WS_CTL = 0;
constexpr size_t CTL_BYTES = 32768;
constexpr size_t CTL_CNT = 28672;
constexpr size_t WS_DUMP = WS_CTL + CTL_BYTES;
constexpr size_t WS_MODV = WS_DUMP + 4096;
constexpr size_t WS_LB = WS_MODV + al256((size_t)DEPTH * 5 * 6144 * 4);
constexpr size_t WS_TOKE = WS_LB + 4096;
constexpr size_t WS_TOKI = WS_TOKE + al256((size_t)2 * NROW * 4);
constexpr size_t WS_TOKW = WS_TOKI + al256((size_t)2 * NROW * 4);
constexpr size_t WS_RMAP = WS_TOKW + al256((size_t)2 * NROW * 4);
constexpr size_t WS_ROWW = WS_RMAP + al256((size_t)XS_ROWS * 4);
constexpr size_t WS_CXM = WS_ROWW + al256((size_t)XS_ROWS * 4);
constexpr size_t WS_CXO = WS_CXM + (size_t)NCTX * DM * 4;
constexpr size_t WS_WTA = WS_CXO + (size_t)NCTX * DM * 4;
constexpr size_t WTA_W1 = 0;
constexpr size_t WTA_WV = WTA_W1 + (size_t)NP1 * DM * 2;
constexpr size_t WTA_WG = WTA_WV + (size_t)NVT * DM * 2;
constexpr size_t WTA_WBR = WTA_WG + (size_t)NGATE * DM * 2;
constexpr size_t WTA_WO = WTA_WBR + (size_t)4 * DM * 512 * 2;
constexpr size_t WTA_BYTES = WTA_WO + (size_t)DM * DM * 2;
constexpr size_t WS_HX = WS_WTA + WTA_BYTES;
constexpr size_t WS_VT = WS_HX + (size_t)NROW * DM * 2;
constexpr size_t WS_OBA = WS_VT + (size_t)NVT * NROW * 2;
constexpr size_t WS_HX2 = WS_VT;
constexpr size_t WS_HID = WS_VT;
constexpr size_t WS_VR = WS_OBA + (size_t)NROW * 512 * 2;
constexpr size_t WS_BR = WS_VR + (size_t)NROW * NVR * 2;
constexpr size_t WS_P1 = WS_BR + (size_t)NROW * 2048 * 2;
constexpr size_t WS_G = WS_P1;
constexpr size_t WS_WGU = WS_P1 + (size_t)NROW * NGATE * 2;
constexpr size_t WS_WD = WS_WGU + (size_t)32 * 512 * DM * 2;
constexpr size_t WS_XS = WS_P1;
constexpr size_t WS_END = WS_P1 + (size_t)NROW * NP1 * 2;
static_assert(WS_WD + (size_t)32 * DM * 256 * 2 <= WS_END, "moe weights must fit in the P1 tail");
static_assert((size_t)XS_ROWS * DM * 2 <= (size_t)NROW * NGATE * 2, "XS must fit in the G region");
static_assert((size_t)NVT * NROW * 2 + (size_t)NROW * 512 * 2 >= (size_t)NROW * DM * 2, "HX2 alias");
static_assert(WS_END <= 434800000ull, "workspace budget");

constexpr int NTHR = 512;
constexpr bool MF_ATTN = true;
constexpr int LDS_BYTES = 144 * 1024;

struct Params {
    const float *x, *c, *ctx, *c_ctx, *w_mod, *b_mod, *w_in, *gla_lr_w, *gla_lr_b, *hg_gamma, *na_rpb, *wa_sink, *w_branch, *w_out, *ln_g, *ln_b,
        *moe_w_group, *moe_b_group, *moe_w_expert, *moe_b_expert, *moe_w_gate, *moe_w_up, *moe_w_down;
    float* out;
    unsigned char* ws;
    int ph_lo, ph_hi;
};

__device__ __forceinline__ float bf2f(bf16_t b) { return __uint_as_float(((unsigned)b) << 16); }
__device__ __forceinline__ bf16_t f2bf(float f) { unsigned u = __float_as_uint(f); u += 0x7FFFu + ((u >> 16) & 1u); return (bf16_t)(u >> 16); }
typedef float f32x2_t __attribute__((ext_vector_type(2)));
typedef __bf16 bf16x2_t __attribute__((ext_vector_type(2)));
__device__ __forceinline__ unsigned pk2(float lo, float hi) {
    const f32x2_t v = {lo, hi}; const bf16x2_t b = __builtin_convertvector(v, bf16x2_t); return __builtin_bit_cast(unsigned, b); }
__device__ __forceinline__ void ld8(const bf16_t* p, float* f) {
    const u32x4 v = *(const u32x4*)p;
    f[0] = __uint_as_float(v.x << 16); f[1] = __uint_as_float(v.x & 0xffff0000u);
    f[2] = __uint_as_float(v.y << 16); f[3] = __uint_as_float(v.y & 0xffff0000u);
    f[4] = __uint_as_float(v.z << 16); f[5] = __uint_as_float(v.z & 0xffff0000u);
    f[6] = __uint_as_float(v.w << 16); f[7] = __uint_as_float(v.w & 0xffff0000u);
}
__device__ __forceinline__ void st8(bf16_t* p, const float* f) {
    u32x4 v; v.x = pk2(f[0], f[1]); v.y = pk2(f[2], f[3]); v.z = pk2(f[4], f[5]); v.w = pk2(f[6], f[7]);
    *(u32x4*)p = v;
}
__device__ __forceinline__ float sigmoidf_(float x) { return 1.f / (1.f + expf(-x)); }
__device__ __forceinline__ float siluf_(float x) { return x / (1.f + expf(-x)); }
__device__ __forceinline__ float wave_sum(float v) {
#pragma unroll
    for (int o = 1; o < 64; o <<= 1) v += __shfl_xor(v, o);
    return v;
}
__device__ __forceinline__ int row_batch(int row) { return row < NTOK ? (row >> 12) : 4; }

#define XB_TMO      128
#define XB_XCNT(j)  (256  + 64 * (j))
#define XB_XSUB(j)  (1280 + 64 * (j))
#define XB_XGEN(j)  (2304 + 64 * (j))
#define XB_TOP      3328
#define XB_TOPGEN   3392
#define XCD_BAR_WORDS 3456
#define XB_SPIN_CAP (1u << 18)
#define LAS __attribute__((address_space(3)))
__device__ __forceinline__ unsigned xb_ld(unsigned* p)              { return __hip_atomic_load(p, __ATOMIC_RELAXED, __HIP_MEMORY_SCOPE_AGENT); }
__device__ __forceinline__ unsigned xb_add(unsigned* p, unsigned v) { return __hip_atomic_fetch_add(p, v, __ATOMIC_RELAXED, __HIP_MEMORY_SCOPE_AGENT); }
__device__ __forceinline__ unsigned xb_xcc_id() { return (unsigned)__builtin_amdgcn_s_getreg((3 << 11) | 20) & 0xFu; }
#define XB_SPIN(cond, bar) do { unsigned _sp = 0; while (cond) { __builtin_amdgcn_s_sleep(1); \
    if ((++_sp & 255u) == 0u) { if (xb_ld(&(bar)[XB_TMO])) break; if (_sp > XB_SPIN_CAP) { atomicAdd(&(bar)[XB_TMO], 1u); break; } } } } while (0)
struct XcdBarrier { unsigned* bar; unsigned x; volatile LAS unsigned* st; };
__device__ __forceinline__ XcdBarrier xcd_barrier_post(unsigned* bar, volatile LAS unsigned* st) {
    XcdBarrier b; b.bar = bar; b.x = xb_xcc_id(); b.st = st;
    if (threadIdx.x == 0) (void)xb_add(&bar[XB_XCNT(b.x)], 1u);
    return b;
}
__device__ __forceinline__ void xcd_barrier_complete(unsigned* bar, unsigned x, unsigned& nloc, unsigned& nx) {
    const unsigned G = gridDim.x * gridDim.y * gridDim.z;
    unsigned sum, cnt, mine, sp = 0u;
    for (;;) {
        sum = 0u; cnt = 0u; mine = 0u;
#pragma unroll
        for (unsigned j = 0; j < 16; ++j) { const unsigned c = xb_ld(&bar[XB_XCNT(j)]); sum += c; cnt += (c > 0u) ? 1u : 0u; mine = (j == x) ? c : mine; }
        if (sum == G) break;
        __builtin_amdgcn_s_sleep(1);
        if ((++sp & 255u) == 0u) { if (xb_ld(&bar[XB_TMO])) break; if (sp > XB_SPIN_CAP) { atomicAdd(&bar[XB_TMO], 1u); break; } }
    }
    nloc = mine > 0u ? mine : 1u; nx = cnt > 0u ? cnt : 1u;
}
__device__ __forceinline__ void xcd_barrier(const XcdBarrier& b) {
    asm volatile("s_waitcnt vmcnt(0)" ::: "memory");
    __syncthreads();
    if (threadIdx.x == 0) {
        unsigned* bar = b.bar;
        __builtin_amdgcn_s_waitcnt(0);
        unsigned nloc = b.st[0], nx = b.st[1];
        if (nloc == 0u) { xcd_barrier_complete(bar, b.x, nloc, nx); b.st[0] = nloc; b.st[1] = nx; }
        const unsigned old = xb_add(&bar[XB_XSUB(b.x)], 1u);
        const unsigned gen = old / nloc;
        if (old + 1u == (gen + 1u) * nloc) {
            __builtin_amdgcn_fence(__ATOMIC_RELEASE, "agent");
            asm volatile("s_waitcnt vmcnt(0)" ::: "memory");
            const unsigned og = xb_add(&bar[XB_TOP], 1u);
            const unsigned tg = og / nx;
            if (og + 1u == (tg + 1u) * nx) xb_add(&bar[XB_TOPGEN], 1u);
            else XB_SPIN(xb_ld(&bar[XB_TOPGEN]) == tg, bar);
            __builtin_amdgcn_fence(__ATOMIC_ACQUIRE, "agent");
            xb_add(&bar[XB_XGEN(b.x)], 1u);
            asm volatile("s_waitcnt vmcnt(0)" ::: "memory");
        } else {
            XB_SPIN(xb_ld(&bar[XB_XGEN(b.x)]) == gen, bar);
            __builtin_amdgcn_fence(__ATOMIC_ACQUIRE, "agent");
            asm volatile("s_waitcnt vmcnt(0)" ::: "memory");
        }
    }
    __syncthreads();
}

struct Frame {
    Params p;
    int bid, nb, tid, lane, wave;
    float* smf;
    unsigned char* ws;
    __device__ __forceinline__ float* modv() const { return (float*)(ws + WS_MODV); }
    __device__ __forceinline__ float* lb() const { return (float*)(ws + WS_LB); }
    __device__ __forceinline__ int* tokE() const { return (int*)(ws + WS_TOKE); }
    __device__ __forceinline__ int* tokI() const { return (int*)(ws + WS_TOKI); }
    __device__ __forceinline__ float* tokW() const { return (float*)(ws + WS_TOKW); }
    __device__ __forceinline__ int* rmap() const { return (int*)(ws + WS_RMAP); }
    __device__ __forceinline__ float* roww() const { return (float*)(ws + WS_ROWW); }
    __device__ __forceinline__ float* cxm() const { return (float*)(ws + WS_CXM); }
    __device__ __forceinline__ float* cxo() const { return (float*)(ws + WS_CXO); }
    __device__ __forceinline__ bf16_t* W1t() const { return (bf16_t*)(ws + WS_WTA + WTA_W1); }
    __device__ __forceinline__ bf16_t* Wvt() const { return (bf16_t*)(ws + WS_WTA + WTA_WV); }
    __device__ __forceinline__ bf16_t* Wgt() const { return (bf16_t*)(ws + WS_WTA + WTA_WG); }
    __device__ __forceinline__ bf16_t* Wbrt() const { return (bf16_t*)(ws + WS_WTA + WTA_WBR); }
    __device__ __forceinline__ bf16_t* Woutt() const { return (bf16_t*)(ws + WS_WTA + WTA_WO); }
    __device__ __forceinline__ bf16_t* HX() const { return (bf16_t*)(ws + WS_HX); }
    __device__ __forceinline__ bf16_t* VT() const { return (bf16_t*)(ws + WS_VT); }
    __device__ __forceinline__ bf16_t* OBA() const { return (bf16_t*)(ws + WS_OBA); }
    __device__ __forceinline__ bf16_t* HX2() const { return (bf16_t*)(ws + WS_HX2); }
    __device__ __forceinline__ bf16_t* HID() const { return (bf16_t*)(ws + WS_HID); }
    __device__ __forceinline__ bf16_t* VR() const { return (bf16_t*)(ws + WS_VR); }
    __device__ __forceinline__ bf16_t* BR() const { return (bf16_t*)(ws + WS_BR); }
    __device__ __forceinline__ bf16_t* P1() const { return (bf16_t*)(ws + WS_P1); }
    __device__ __forceinline__ bf16_t* G() const { return (bf16_t*)(ws + WS_G); }
    __device__ __forceinline__ bf16_t* Wgu() const { return (bf16_t*)(ws + WS_WGU); }
    __device__ __forceinline__ bf16_t* Wd() const { return (bf16_t*)(ws + WS_WD); }
    __device__ __forceinline__ bf16_t* XS() const { return (bf16_t*)(ws + WS_XS); }
    __device__ __forceinline__ unsigned* cnt() const { return (unsigned*)(ws + WS_CTL + CTL_CNT); }
};


#define REFRESH(F) do { int _t = threadIdx.x; asm volatile("" : "+v"(_t)); (F).tid = _t; (F).lane = _t & 63; (F).wave = _t >> 6; } while (0)

__device__ __forceinline__ void phase_mod(Frame& F) {
    float* sc = F.smf;
    float* red = F.smf + 5 * 1024;
    bool have = false;
    for (int it = F.bid; it < DEPTH * 96; it += F.nb) {
        if (!have) {
            for (int i = F.tid; i < 5 * 1024; i += NTHR) { const float v = (i < 4096) ? F.p.c[i] : F.p.c_ctx[i - 4096]; sc[i] = siluf_(v); }
            __syncthreads(); have = true;
        }
        const int l = it / 96, n0 = (it % 96) * 64, col = F.tid & 63, kg = F.tid >> 6;
        const float* w = F.p.w_mod + (size_t)l * DM * 6144 + n0 + col;
        float a[5] = {0.f, 0.f, 0.f, 0.f, 0.f};
        for (int k = kg * 128; k < kg * 128 + 128; ++k) {
            const float wv = w[(size_t)k * 6144];
#pragma unroll
            for (int r = 0; r < 5; ++r) a[r] += sc[r * 1024 + k] * wv;
        }
#pragma unroll
        for (int r = 0; r < 5; ++r) red[(kg * 5 + r) * 64 + col] = a[r];
        __syncthreads();
        if (F.tid < 320) {
            const int r = F.tid >> 6, cc = F.tid & 63; float s = F.p.b_mod[l * 6144 + n0 + cc];
#pragma unroll
            for (int g = 0; g < 8; ++g) s += red[(g * 5 + r) * 64 + cc];
            F.modv()[((size_t)l * 5 + r) * 6144 + n0 + cc] = s;
        }
        __syncthreads();
    }
    if (F.bid == F.nb - 1) {
        for (int i = F.tid; i < 1024; i += NTHR) { const int z = i >> 9, f = i & 511;
            const float g0 = F.p.hg_gamma[(z * DEPTH + 0) * 512 + f], g1 = F.p.hg_gamma[(z * DEPTH + 1) * 512 + f];
            F.lb()[i] = 1.f / (1.f + expf(g0 - g1)); }
    }
}

__device__ __forceinline__ int p1_src(int n, float& scale) {
    scale = 1.f;
    if (n < 256) { scale = 0.125f; return O_AQ + n; }
    if (n < 512) return O_AK + (n - 256);
    if (n < 1024) return O_AV + (n - 512);
    if (n < 1056) return O_ALR + (n - 1024);
    if (n < 1280) return -1;
    if (n < 1792) { scale = 0.125f; return O_BQ + (n - 1280); }
    if (n < 2304) return O_BK + (n - 1792);
    if (n < 2816) { scale = 0.125f; return O_CQ + (n - 2304); }
    if (n < 2944) return O_CK + (n - 2816);
    if (n < 3072) return -1;
    if (n < 3584) return O_DQ + (n - 3072);
    if (n < 4608) return O_DF + (n - 3584);
    if (n < 5120) return O_DI + (n - 4608);
    if (n < 5632) return O_AG + (n - 5120);
    return O_DG + (n - 5632);
}
__device__ __forceinline__ void conv_item(const float* src, int ldsrc, int srccol, float scale, bf16_t* dst, int K, int k0, float* scr, int lane) {
    if (srccol >= 0) {
#pragma unroll 8
        for (int i = 0; i < 32; ++i) { const int kk = 2 * i + (lane >> 5); scr[kk * 33 + (lane & 31)] = src[(size_t)(k0 + kk) * ldsrc + srccol + (lane & 31)] * scale; }
    } else {
#pragma unroll 8
        for (int i = 0; i < 32; ++i) { const int kk = 2 * i + (lane >> 5); scr[kk * 33 + (lane & 31)] = 0.f; }
    }
    asm volatile("s_waitcnt lgkmcnt(0)" ::: "memory");
    const int c = lane & 7;
#pragma unroll
    for (int j = 0; j < 4; ++j) { const int nn = (lane >> 3) + 8 * j; const float* sp = scr + (8 * c) * 33 + nn;
        u32x4 o; o.x = pk2(sp[0 * 33], sp[1 * 33]); o.y = pk2(sp[2 * 33], sp[3 * 33]); o.z = pk2(sp[4 * 33], sp[5 * 33]); o.w = pk2(sp[6 * 33], sp[7 * 33]);
        *(u32x4*)(dst + (size_t)nn * K + 8 * c) = o; }
    asm volatile("s_waitcnt lgkmcnt(0)" ::: "memory");
}
constexpr int CONVA_ITEMS = 3072 + 384 + 2048 + 1024 + 512;
__device__ __forceinline__ void phase_conv_a(Frame& F, int l) {
    float* scr = F.smf + F.wave * (64 * 33);
    const int gw = F.bid * 8 + F.wave, ngw = F.nb * 8;
    for (int it0 = gw; it0 < CONVA_ITEMS; it0 += ngw) {
        int ti = it0;
        if (ti < 3072) { const int n0 = (ti >> 4) * 32, kt = ti & 15; float sc; const int sx = p1_src(n0, sc);
            conv_item(F.p.w_in + (size_t)l * DM * DIN, DIN, sx, sc, F.W1t() + (size_t)n0 * DM + kt * 64, DM, kt * 64, scr, F.lane); continue; }
        ti -= 3072;
        if (ti < 384) { const int n0 = (ti >> 4) * 32, kt = ti & 15; const int sx = n0 < 512 ? O_BV + n0 : (n0 < 640 ? O_CV + (n0 - 512) : -1);
            conv_item(F.p.w_in + (size_t)l * DM * DIN, DIN, sx, 1.f, F.Wvt() + (size_t)n0 * DM + kt * 64, DM, kt * 64, scr, F.lane); continue; }
        ti -= 384;
        if (ti < 2048) { const int n0 = (ti >> 4) * 32, kt = ti & 15;
            conv_item(F.p.w_in + (size_t)l * DM * DIN, DIN, O_GATE + n0, 1.f, F.Wgt() + (size_t)n0 * DM + kt * 64, DM, kt * 64, scr, F.lane); continue; }
        ti -= 2048;
        if (ti < 1024) { const int i = ti >> 8, r = ti & 255, n0 = (r >> 3) * 32, kt = r & 7;
            conv_item(F.p.w_branch + (size_t)(l * 4 + i) * 512 * DM, DM, n0, 1.f, F.Wbrt() + (size_t)i * DM * 512 + (size_t)n0 * 512 + kt * 64, 512, kt * 64, scr, F.lane); continue; }
        ti -= 1024;
        { const int n0 = (ti >> 4) * 32, kt = ti & 15;
          conv_item(F.p.w_out + (size_t)l * DM * DM, DM, n0, 1.f, F.Woutt() + (size_t)n0 * DM + kt * 64, DM, kt * 64, scr, F.lane); }
    }
}
constexpr int CONVB_ITEMS = 8192 + 4096;
__device__ __forceinline__ void phase_conv_b(Frame& F, int l) {
    float* scr = F.smf + F.wave * (64 * 33);
    const int gw = F.bid * 8 + F.wave, ngw = F.nb * 8;
    for (int it0 = gw; it0 < CONVB_ITEMS; it0 += ngw) {
        int ti = it0;
        if (ti < 8192) { const int e = ti >> 8, r = ti & 255, n0 = (r >> 4) * 32, kt = r & 15, j = n0 >> 8, rr = n0 & 255; const bool isup = rr >= 128; const int cc = 128 * j + (rr & 127);
            const float* src = (isup ? F.p.moe_w_up : F.p.moe_w_gate) + (size_t)(l * 32 + e) * DM * 256;
            conv_item(src, 256, cc, 1.f, F.Wgu() + (size_t)e * 512 * DM + (size_t)n0 * DM + kt * 64, DM, kt * 64, scr, F.lane); continue; }
        ti -= 8192;
        { const int e = ti >> 7, r = ti & 127, n0 = (r >> 2) * 32, kt = r & 3;
          conv_item(F.p.moe_w_down + (size_t)(l * 32 + e) * 256 * DM, DM, n0, 1.f, F.Wd() + (size_t)e * DM * 256 + (size_t)n0 * 256 + kt * 64, 256, kt * 64, scr, F.lane); }
    }
}

__device__ __forceinline__ void phase_prep(Frame& F, int l, const float* xlat, const float* xctx) {
    const int gw = F.bid * 8 + F.wave, ngw = F.nb * 8;
    for (int row = gw; row < NROW; row += ngw) {
        const float* xr = row < NTOK ? xlat + (size_t)row * DM : xctx + (size_t)(row - NTOK) * DM;
        const float* mv = F.modv() + ((size_t)l * 5 + row_batch(row)) * 6144;
#pragma unroll
        for (int j = 0; j < 4; ++j) { const int d = j * 256 + F.lane * 4;
            const f32x4 v = *(const f32x4*)(xr + d), m0 = *(const f32x4*)(mv + d), m1 = *(const f32x4*)(mv + 1024 + d);
            u32x2 o; o.x = pk2(v.x * (1.f + m1.x) + m0.x, v.y * (1.f + m1.y) + m0.y); o.y = pk2(v.z * (1.f + m1.z) + m0.z, v.w * (1.f + m1.w) + m0.w);
            *(u32x2*)(F.HX() + (size_t)row * DM + d) = o; }
    }
}

__device__ __forceinline__ void gemm_s_acc(float (&acc)[8][4], const bf16_t* A, int lda, const bf16_t* Bt, int ldb, int K, int row0, int col0, float* sm, int tid) {
    float* As = sm; float* Bs = sm + 32 * 132;
    const int ty = tid >> 5, tx = tid & 31, lr = tid >> 2, lk = (tid & 3) * 8;
    for (int k0 = 0; k0 < K; k0 += 32) {
        float fa[8], fb[8];
        ld8(A + (size_t)(row0 + lr) * lda + k0 + lk, fa);
        ld8(Bt + (size_t)(col0 + lr) * ldb + k0 + lk, fb);
        __syncthreads();
#pragma unroll
        for (int j = 0; j < 8; ++j) { As[(lk + j) * 132 + lr] = fa[j]; Bs[(lk + j) * 132 + lr] = fb[j]; }
        __syncthreads();
#pragma unroll 4
        for (int k = 0; k < 32; ++k) {
            const f32x4 a0 = *(const f32x4*)&As[k * 132 + ty * 8], a1 = *(const f32x4*)&As[k * 132 + ty * 8 + 4], b = *(const f32x4*)&Bs[k * 132 + tx * 4];
            const float a[8] = {a0.x, a0.y, a0.z, a0.w, a1.x, a1.y, a1.z, a1.w}; const float bb[4] = {b.x, b.y, b.z, b.w};
#pragma unroll
            for (int i = 0; i < 8; ++i)
#pragma unroll
                for (int j = 0; j < 4; ++j) acc[i][j] += a[i] * bb[j];
        }
    }
    __syncthreads();
}
template <class Epi>
__device__ __forceinline__ void gemm_s(Frame& F, const bf16_t* A, int lda, const bf16_t* Bt, int ldb, int M, int N, int K, const Epi& epi) {
    const int tn = N / 128, nt = (M / 128) * tn, ty = F.tid >> 5, tx = F.tid & 31;
    for (int t = F.bid; t < nt; t += F.nb) {
        const int row0 = (t / tn) * 128, col0 = (t % tn) * 128;
        float acc[8][4];
#pragma unroll
        for (int i = 0; i < 8; ++i)
#pragma unroll
            for (int j = 0; j < 4; ++j) acc[i][j] = 0.f;
        gemm_s_acc(acc, A, lda, Bt, ldb, K, row0, col0, F.smf, F.tid);
#pragma unroll
        for (int i = 0; i < 8; ++i)
#pragma unroll
            for (int j = 0; j < 4; ++j) epi(row0 + ty * 8 + i, col0 + tx * 4 + j, acc[i][j]);
    }
}


namespace pg {
typedef short bf16x8 __attribute__((ext_vector_type(8)));
constexpr int BM = 256, BK = 64, HALF = 128, HTB = HALF * BK * 2, STAGE_BYTES = 8 * HTB, NXCD = 8, WGM = 8;
__device__ __forceinline__ int lds_byte(int r, int c) { const int st = (r >> 4) * 2 + (c >> 5), rr = r & 15, cc = c & 31, ob = rr * 64 + cc * 2; return st * 1024 + (ob ^ (((ob >> 9) & 1) << 5)); }
__device__ __forceinline__ void stage_rc(int b, int& R, int& C) { const int st = b / 1024, sb = b % 1024, swz = sb ^ (((sb >> 9) & 1) << 5); R = (st >> 1) * 16 + swz / 64; C = (st & 1) * 32 + (swz % 64) / 2; }
struct Unit { const char* a; const char* b; int pm, pn, aux; };
__device__ __forceinline__ void static_map(int L, int nM, int nN, int& pm, int& pn) {
    const int nwg = nM * nN; int wgid = L; { const int q = nwg / NXCD, r = nwg % NXCD, xcd = wgid % NXCD, off = wgid / NXCD; wgid = (xcd < r ? xcd * (q + 1) : r * (q + 1) + (xcd - r) * q) + off; }
    const int nig = WGM * nN, gid = wgid / nig, fm = gid * WGM, gsz = (nM - fm) < WGM ? (nM - fm) : WGM;
    pm = fm + ((wgid % nig) % gsz); pn = (wgid % nig) / gsz;
}
template <class Epi, class Sched>
__device__ __forceinline__ void gemm_phase(LAS unsigned char* lds, const int lda, const int ldb, const int K, const Sched& S, const Epi& E) {
    int tid = threadIdx.x; asm volatile("" : "+v"(tid));
    const int wid = __builtin_amdgcn_readfirstlane(tid >> 6), lane = tid & 63, wr = wid >> 2, wc = wid & 3, fr = lane & 15, fq = lane >> 4;
    int nt = K / BK; asm volatile("" : "+s"(nt));
    unsigned voffA[2], voffB[2];
#pragma unroll
    for (int i = 0; i < 2; ++i) { int R, C; stage_rc(tid * 16 + i * 8192, R, C); voffA[i] = (unsigned)(R * lda + C) * 2u; voffB[i] = (unsigned)(R * ldb + C) * 2u; }
    const size_t kstep = (size_t)(BK * 2);
    const size_t hstepA = (size_t)HALF * lda * 2, hstepB = (size_t)HALF * ldb * 2;
    const unsigned ldsw = (unsigned)wid * 1024u;
    const int aoff = lds_byte(wr * 64 + fr, fq * 8), boff = lds_byte(wc * 32 + fr, fq * 8);
#define PG_SA(b, h) (((b) * 2 + (h)) * HTB)
#define PG_SB(b, h) ((4 + (b) * 2 + (h)) * HTB)
#define PG_STAGE(bufoff, gbase, voff) do { _Pragma("unroll") for (int _i = 0; _i < 2; ++_i) \
        __builtin_amdgcn_global_load_lds((const unsigned*)((const char*)(gbase) + (voff)[_i]), (LAS unsigned*)(lds + (bufoff) + ldsw + _i * 8192), 16, 0, 0); } while (0)
#define PG_LDA(dst, b, h) do { _Pragma("unroll") for (int m = 0; m < 4; ++m) _Pragma("unroll") for (int k = 0; k < 2; ++k) dst[m][k] = *(const LAS bf16x8*)(lds + PG_SA(b, h) + aoff + m * 2048 + k * 1024); } while (0)
#define PG_LDB(dst, b, h) do { _Pragma("unroll") for (int n = 0; n < 2; ++n) _Pragma("unroll") for (int k = 0; k < 2; ++k) dst[n][k] = *(const LAS bf16x8*)(lds + PG_SB(b, h) + boff + n * 2048 + k * 1024); } while (0)
#define PG_MMA(ai, bj, At, Bt) do { __builtin_amdgcn_s_setprio(1); _Pragma("unroll") for (int m = 0; m < 4; ++m) _Pragma("unroll") for (int n = 0; n < 2; ++n) _Pragma("unroll") for (int k = 0; k < 2; ++k) \
        acc[ai][bj][m][n] = __builtin_amdgcn_mfma_f32_16x16x32_bf16(Bt[n][k], At[m][k], acc[ai][bj][m][n], 0, 0, 0); __builtin_amdgcn_s_setprio(0); } while (0)
#define PG_WAIT_V(n) asm volatile("s_waitcnt vmcnt(" #n ")" ::: "memory")
#define PG_WAIT_L(n) asm volatile("s_waitcnt lgkmcnt(" #n ")" ::: "memory")
#define PG_BAR __builtin_amdgcn_s_barrier()
#define PG_SCHED __builtin_amdgcn_sched_barrier(0)
    Unit cur, nxt; int ui = 0;
    if (!S.next(0, cur)) return;
    f32x4 acc[2][2][4][2];
#pragma unroll
    for (int a = 0; a < 2; ++a)
#pragma unroll
        for (int b = 0; b < 2; ++b)
#pragma unroll
            for (int m = 0; m < 4; ++m)
#pragma unroll
                for (int n = 0; n < 2; ++n) acc[a][b][m][n] = (f32x4){0.f, 0.f, 0.f, 0.f};
    bf16x8 At[4][2], B0[2][2], B1[2][2];
    const char* cA = cur.a; const char* cB = cur.b;
    PG_STAGE(PG_SB(0, 0), cB, voffB); PG_STAGE(PG_SA(0, 0), cA, voffA); PG_STAGE(PG_SB(0, 1), cB + hstepB, voffB); PG_STAGE(PG_SA(0, 1), cA + hstepA, voffA);
    if (wr == 1) PG_BAR;
    PG_WAIT_V(4); PG_BAR;
    PG_STAGE(PG_SB(1, 0), cB + kstep, voffB); PG_STAGE(PG_SA(1, 0), cA + kstep, voffA); PG_STAGE(PG_SB(1, 1), cB + hstepB + kstep, voffB);
    PG_WAIT_V(6); PG_BAR;
    for (;;) {
        const bool has_next = S.next(ui + 1, nxt);
        const char* nA = has_next ? nxt.a : cA; const char* nB = has_next ? nxt.b : cB;
        for (int t = 0; t < nt; t += 2) {
            const bool last = (t == nt - 2);
            const char* a1 = cA + (size_t)(t + 1) * kstep;
            const char* a2 = last ? nA : cA + (size_t)(t + 2) * kstep; const char* b2 = last ? nB : cB + (size_t)(t + 2) * kstep;
            const char* a3 = a2 + kstep; const char* b3 = b2 + kstep;
            PG_LDB(B0, 0, 0); PG_SCHED; PG_LDA(At, 0, 0); PG_STAGE(PG_SA(1, 1), a1 + hstepA, voffA);
            PG_WAIT_L(8); PG_BAR; PG_WAIT_L(0); PG_MMA(0, 0, At, B0); PG_BAR; PG_SCHED;
            PG_LDB(B1, 0, 1); PG_STAGE(PG_SB(0, 0), b2, voffB);
            PG_BAR; PG_WAIT_L(0); PG_MMA(0, 1, At, B1); PG_BAR;
            PG_LDA(At, 0, 1); PG_STAGE(PG_SA(0, 0), a2, voffA);
            PG_BAR; PG_WAIT_L(0); PG_MMA(1, 0, At, B0); PG_BAR; PG_SCHED;
            PG_STAGE(PG_SB(0, 1), b2 + hstepB, voffB);
            PG_WAIT_V(6); PG_BAR; PG_MMA(1, 1, At, B1); PG_BAR;
            PG_LDB(B0, 1, 0); PG_SCHED; PG_LDA(At, 1, 0); PG_STAGE(PG_SA(0, 1), a2 + hstepA, voffA);
            PG_WAIT_L(8); PG_BAR; PG_WAIT_L(0); PG_MMA(0, 0, At, B0); PG_BAR; PG_SCHED;
            PG_LDB(B1, 1, 1); PG_STAGE(PG_SB(1, 0), b3, voffB);
            PG_BAR; PG_WAIT_L(0); PG_MMA(0, 1, At, B1); PG_BAR;
            PG_LDA(At, 1, 1); PG_STAGE(PG_SA(1, 0), a3, voffA);
            PG_BAR; PG_WAIT_L(0); PG_MMA(1, 0, At, B0); PG_BAR; PG_SCHED;
            PG_STAGE(PG_SB(1, 1), b3 + hstepB, voffB);
            PG_WAIT_V(6); PG_BAR; PG_MMA(1, 1, At, B1); PG_BAR;
        }
        E(acc, cur, wr, wc, fr, fq);
        if (!has_next) break;
#pragma unroll
        for (int a = 0; a < 2; ++a)
#pragma unroll
            for (int b = 0; b < 2; ++b)
#pragma unroll
                for (int m = 0; m < 4; ++m)
#pragma unroll
                    for (int n = 0; n < 2; ++n) acc[a][b][m][n] = (f32x4){0.f, 0.f, 0.f, 0.f};
        cur = nxt; cA = nA; cB = nB; ++ui;
    }
    PG_WAIT_V(0);
    if (wr == 0) PG_BAR;
    PG_BAR;
#undef PG_SA
#undef PG_SB
#undef PG_STAGE
#undef PG_LDA
#undef PG_LDB
#undef PG_MMA
#undef PG_WAIT_V
#undef PG_WAIT_L
#undef PG_BAR
#undef PG_SCHED
}

struct SchedG1 {
    const char *HX, *W1, *WV; int G, c;
    __device__ __forceinline__ bool next(int i, Unit& u) const {
        const int L = i * G + c, nmain = (NROW / 256) * (NP1 / 256);
        if (L < nmain) { static_map(L, NROW / 256, NP1 / 256, u.pm, u.pn); u.a = HX + (size_t)u.pm * 256 * DM * 2; u.b = W1 + (size_t)u.pn * 256 * DM * 2; u.aux = 0; return true; }
        const int idx = L - nmain; if (idx >= 3 * (NROW / 256)) return false;
        u.pm = idx % 3; u.pn = idx / 3; u.a = WV + (size_t)u.pm * 256 * DM * 2; u.b = HX + (size_t)u.pn * 256 * DM * 2; u.aux = 1; return true;
    }
};
struct SchedStatic {
    const char *A, *B; size_t tA, tB; int nM, nN, G, c;
    __device__ __forceinline__ bool next(int i, Unit& u) const {
        const int L = i * G + c; if (L >= nM * nN) return false;
        static_map(L, nM, nN, u.pm, u.pn); u.a = A + (size_t)u.pm * tA; u.b = B + (size_t)u.pn * tB; u.aux = 0; return true;
    }
};
struct SchedMerge {
    const char *BR, *W; int ntile, G, c;
    __device__ __forceinline__ bool next(int i, Unit& u) const {
        const int t = c + (i >> 2) * G; if (t >= ntile) return false;
        const int br = i & 3; u.pm = t >> 2; u.pn = t & 3; u.aux = br;
        u.a = BR + (size_t)u.pm * 256 * 2048 * 2 + (size_t)br * 512 * 2; u.b = W + (size_t)br * DM * 512 * 2 + (size_t)u.pn * 256 * 512 * 2; return true;
    }
};
struct SchedMoe {
    const char *A, *W; const int* off; size_t tA, wE, wT; int npan, NJ, G, c;
    __device__ __forceinline__ bool next(int i, Unit& u) const {
        const int L = i * G + c; if (L >= npan * NJ) return false;
        const int p = L / NJ, j = L % NJ; int e = 0;
#pragma unroll 1
        for (int q = 1; q < 32; ++q) if (p * 256 >= off[q]) e = q;
        e = __builtin_amdgcn_readfirstlane(e);
        u.pm = p; u.pn = j; u.aux = e; u.a = A + (size_t)p * tA; u.b = W + (size_t)e * wE + (size_t)j * wT; return true;
    }
};

#define PG_ROWCOL const int row0 = u.pm * BM + wr * 64 + fr, col0 = u.pn * BM + wc * 32 + 4 * fq
struct EpiG1 { bf16_t *P1, *VT;
    __device__ __forceinline__ void operator()(const f32x4 (&acc)[2][2][4][2], const Unit& u, int wr, int wc, int fr, int fq) const {
        PG_ROWCOL; bf16_t* base = u.aux ? VT : P1; const size_t ld = u.aux ? (size_t)NROW : (size_t)NP1;
#pragma unroll
        for (int ai = 0; ai < 2; ++ai)
#pragma unroll
            for (int m = 0; m < 4; ++m) { bf16_t* rowp = base + (size_t)(row0 + ai * HALF + m * 16) * ld + col0;
#pragma unroll
                for (int bj = 0; bj < 2; ++bj)
#pragma unroll
                    for (int n = 0; n < 2; ++n) { const f32x4 v = acc[ai][bj][m][n]; u32x2 o; o.x = pk2(v.x, v.y); o.y = pk2(v.z, v.w); *(u32x2*)(rowp + bj * HALF + n * 16) = o; } }
    }
};
struct EpiGate { bf16_t* G;
    __device__ __forceinline__ void operator()(const f32x4 (&acc)[2][2][4][2], const Unit& u, int wr, int wc, int fr, int fq) const {
        PG_ROWCOL;
#pragma unroll
        for (int ai = 0; ai < 2; ++ai)
#pragma unroll
            for (int m = 0; m < 4; ++m) { bf16_t* rowp = G + (size_t)(row0 + ai * HALF + m * 16) * NGATE + col0;
#pragma unroll
                for (int bj = 0; bj < 2; ++bj)
#pragma unroll
                    for (int n = 0; n < 2; ++n) { const f32x4 v = acc[ai][bj][m][n]; u32x2 o; o.x = pk2(sigmoidf_(v.x), sigmoidf_(v.y)); o.y = pk2(sigmoidf_(v.z), sigmoidf_(v.w)); *(u32x2*)(rowp + bj * HALF + n * 16) = o; } }
    }
};
struct EpiMerge { const bf16_t* G; bf16_t* O;
    __device__ __forceinline__ void operator()(const f32x4 (&acc)[2][2][4][2], const Unit& u, int wr, int wc, int fr, int fq) const {
        PG_ROWCOL; const int br = u.aux;
#pragma unroll
        for (int ai = 0; ai < 2; ++ai)
#pragma unroll
            for (int m = 0; m < 4; ++m) { const size_t r = (size_t)(row0 + ai * HALF + m * 16); bf16_t* rowp = O + r * DM + col0; const bf16_t* gp = G + r * NGATE + br * 1024 + col0;
#pragma unroll
                for (int bj = 0; bj < 2; ++bj)
#pragma unroll
                    for (int n = 0; n < 2; ++n) { const f32x4 v = acc[ai][bj][m][n]; const u32x2 g2 = *(const u32x2*)(gp + bj * HALF + n * 16);
                        f32x4 w; w.x = __uint_as_float(g2.x << 16) * v.x; w.y = __uint_as_float(g2.x & 0xffff0000u) * v.y; w.z = __uint_as_float(g2.y << 16) * v.z; w.w = __uint_as_float(g2.y & 0xffff0000u) * v.w;
                        if (br != 0) { const u32x2 o2 = *(const u32x2*)(rowp + bj * HALF + n * 16);
                            w.x += __uint_as_float(o2.x << 16); w.y += __uint_as_float(o2.x & 0xffff0000u); w.z += __uint_as_float(o2.y << 16); w.w += __uint_as_float(o2.y & 0xffff0000u); }
                        u32x2 o; o.x = pk2(w.x, w.y); o.y = pk2(w.z, w.w); *(u32x2*)(rowp + bj * HALF + n * 16) = o; }
                asm volatile("" ::: "memory"); }
    }
};
struct EpiWout { const float *xlat, *xctx; float *olat, *octx; const float* modl;
    __device__ __forceinline__ void operator()(const f32x4 (&acc)[2][2][4][2], const Unit& u, int wr, int wc, int fr, int fq) const {
        PG_ROWCOL; const bool lat = u.pm < NTOK / 256; const int rb = lat ? (u.pm >> 4) : 4;
        const float* xin = lat ? xlat : xctx - (size_t)NTOK * DM; float* xo = lat ? olat : octx - (size_t)NTOK * DM; const float* m2 = modl + (size_t)rb * 6144 + 2 * 1024 + col0;
        f32x4 mv[2][2];
#pragma unroll
        for (int bj = 0; bj < 2; ++bj)
#pragma unroll
            for (int n = 0; n < 2; ++n) mv[bj][n] = *(const f32x4*)(m2 + bj * HALF + n * 16);
#pragma unroll
        for (int ai = 0; ai < 2; ++ai)
#pragma unroll
            for (int m = 0; m < 4; ++m) { const size_t o = (size_t)(row0 + ai * HALF + m * 16) * DM + col0;
#pragma unroll
                for (int bj = 0; bj < 2; ++bj)
#pragma unroll
                    for (int n = 0; n < 2; ++n) { const f32x4 xv = *(const f32x4*)(xin + o + bj * HALF + n * 16); *(f32x4*)(xo + o + bj * HALF + n * 16) = ALPHA * xv + mv[bj][n] * acc[ai][bj][m][n]; }
                asm volatile("" ::: "memory"); }
    }
};
struct EpiMoe1 { bf16_t* HID; const float* roww;
    __device__ __forceinline__ void operator()(const f32x4 (&acc)[2][2][4][2], const Unit& u, int wr, int wc, int fr, int fq) const {
        const int row0 = u.pm * BM + wr * 64 + fr, hc0 = u.pn * 128 + wc * 32 + 4 * fq;
#pragma unroll
        for (int ai = 0; ai < 2; ++ai)
#pragma unroll
            for (int m = 0; m < 4; ++m) { const int r = row0 + ai * HALF + m * 16; const float w = roww[r];
#pragma unroll
                for (int n = 0; n < 2; ++n) { const f32x4 g = acc[ai][0][m][n], up = acc[ai][1][m][n]; u32x2 o;
                    o.x = pk2(siluf_(g.x) * up.x * w, siluf_(g.y) * up.y * w); o.y = pk2(siluf_(g.z) * up.z * w, siluf_(g.w) * up.w * w);
                    *(u32x2*)(HID + (size_t)r * 256 + hc0 + n * 16) = o; } }
    }
};
struct EpiMoe2 { bf16_t* Y; const int* rmap; bf16_t* dump;
    __device__ __forceinline__ void operator()(const f32x4 (&acc)[2][2][4][2], const Unit& u, int wr, int wc, int fr, int fq) const {
        PG_ROWCOL;
#pragma unroll
        for (int ai = 0; ai < 2; ++ai)
#pragma unroll
            for (int m = 0; m < 4; ++m) { const int s = rmap[row0 + ai * HALF + m * 16];
                bf16_t* rowp = (s >= 0 ? Y + (size_t)s * DM : dump) + col0;
#pragma unroll
                for (int bj = 0; bj < 2; ++bj)
#pragma unroll
                    for (int n = 0; n < 2; ++n) { const f32x4 v = acc[ai][bj][m][n]; u32x2 o; o.x = pk2(v.x, v.y); o.y = pk2(v.z, v.w); *(u32x2*)(rowp + bj * HALF + n * 16) = o; } }
    }
};
#undef PG_ROWCOL
}

__device__ __forceinline__ void moe_offsets(Frame& F, int l, int* off) {
    if (F.tid == 0) { int a = 0; for (int e = 0; e < 32; ++e) { off[e] = a; a += ((int)F.cnt()[l * 32 + e] + 255) & ~255; } off[32] = a; }
    __syncthreads();
}

__device__ __forceinline__ void phase_rope(Frame& F) {
    float* tab = F.smf;
    for (int e = F.tid; e < 1024; e += NTHR) { const int pp = e >> 4, i = e & 15; const float inv = powf(10000.f, -(float)i / 16.f), ang = (float)pp * inv; tab[2 * e] = cosf(ang); tab[2 * e + 1] = sinf(ang); }
    __syncthreads();
    const size_t total = (size_t)NTOK * 320;
    for (size_t idx = (size_t)F.bid * NTHR + F.tid; idx < total; idx += (size_t)F.nb * NTHR) {
        const int row = (int)(idx / 320), r = (int)(idx % 320), h = r >> 5, half = (r >> 4) & 1, i = r & 15;
        const int pos = row & (SEQ - 1), pp = half ? (pos & 63) : (pos >> 6);
        const float cs = tab[2 * (pp * 16 + i)], sn = tab[2 * (pp * 16 + i) + 1];
        bf16_t* base = F.P1() + (size_t)row * NP1 + (h < 8 ? PC_CQ + h * 64 : PC_CK + (h - 8) * 64) + half * 32 + i;
        const float u1 = bf2f(base[0]), u2 = bf2f(base[16]);
        base[0] = f2bf(u1 * cs - u2 * sn); base[16] = f2bf(u1 * sn + u2 * cs);
    }
}

__device__ __forceinline__ int seq_row(int s, int b, int z) {
    if (s < LC) { const int tc = z ? (LC - 1 - s) : s; return NTOK + b * LC + tc; }
    const int tl = s - LC, t = z ? (SEQ - 1 - tl) : tl; return b * SEQ + t;
}
template <int DK, bool HG>
__device__ __forceinline__ void scan_simple(Frame& F, int l, int b, int h, int z) {
    constexpr int DPB = DK / 4;
    float* eg = F.smf; float* kk = eg + 16 * DK; float* qq = kk + 16 * DK; float* vv = qq + 16 * DK; float* op = vv + 16 * 128;
    const int tid = F.tid, v = tid & 127, db = tid >> 7;
    float S[DPB];
#pragma unroll
    for (int i = 0; i < DPB; ++i) S[i] = 0.f;
    for (int step = 0; step < (LC + SEQ) / 16; ++step) {
        for (int idx = tid; idx < 16 * DK; idx += NTHR) {
            const int i = idx / DK, d = idx % DK, row = seq_row(step * 16 + i, b, z);
            const bf16_t* pr = F.P1() + (size_t)row * NP1;
            float e, k, q;
            if (HG) {
                const float f = bf2f(pr[PC_DF + z * 512 + h * 128 + d]), sg = sigmoidf_(f), lbv = (l == 0) ? 0.f : F.lb()[z * 512 + h * 128 + d];
                const float fg = lbv + (1.f - lbv) * sg; e = fg; k = (1.f - lbv) * (1.f - sg);
                q = siluf_(bf2f(pr[PC_DQ + h * 128 + d]));
            } else {
                float lg = F.p.gla_lr_b[(l * 2 + z) * 256 + h * 64 + d];
#pragma unroll
                for (int r = 0; r < 16; ++r) lg += bf2f(pr[PC_ALR + z * 16 + r]) * F.p.gla_lr_w[((size_t)(l * 2 + z) * 16 + r) * 256 + h * 64 + d];
                const float ls = fminf(lg, 0.f) - log1pf(expf(-fabsf(lg)));
                e = expf(ls * (1.f / 16.f)); k = bf2f(pr[PC_AK + h * 64 + d]); q = bf2f(pr[PC_AQ + h * 64 + d]);
            }
            eg[idx] = e; kk[idx] = k; qq[idx] = q;
        }
        for (int idx = tid; idx < 16 * 128; idx += NTHR) {
            const int i = idx >> 7, c = idx & 127, row = seq_row(step * 16 + i, b, z);
            vv[idx] = bf2f(F.P1()[(size_t)row * NP1 + (HG ? PC_DI : PC_AV) + h * 128 + c]);
        }
        __syncthreads();
        for (int i = 0; i < 16; ++i) {
            const float vval = vv[i * 128 + v]; float o = 0.f;
#pragma unroll
            for (int dd = 0; dd < DPB; ++dd) { const int d = db * DPB + dd; S[dd] = eg[i * DK + d] * S[dd] + kk[i * DK + d] * vval; o += S[dd] * qq[i * DK + d]; }
            op[(i * 4 + db) * 128 + v] = o;
        }
        __syncthreads();
        for (int idx = tid; idx < 16 * 128; idx += NTHR) {
            const int i = idx >> 7, c = idx & 127, row = seq_row(step * 16 + i, b, z);
            const float o = op[(i * 4 + 0) * 128 + c] + op[(i * 4 + 1) * 128 + c] + op[(i * 4 + 2) * 128 + c] + op[(i * 4 + 3) * 128 + c];
            bf16_t* dst;
            if (HG) dst = F.P1() + (size_t)row * NP1 + PC_DF + z * 512 + h * 128 + c;
            else dst = (z == 0) ? F.BR() + (size_t)row * 2048 + h * 128 + c : F.OBA() + (size_t)row * 512 + h * 128 + c;
            *dst = f2bf(o);
        }
        __syncthreads();
    }
}

struct AttnAcc { float m, l; float o[64]; };
__device__ __forceinline__ void attn_key(const float (&q)[64], AttnAcc& a, const bf16_t* kp, const bf16_t* vp, float bias) {
    float s = bias;
#pragma unroll
    for (int c = 0; c < 8; ++c) { float f[8]; ld8(kp + c * 8, f);
#pragma unroll
        for (int j = 0; j < 8; ++j) s += q[c * 8 + j] * f[j]; }
    if (s > a.m) { const float sc = expf(a.m - s); a.l *= sc;
#pragma unroll
        for (int i = 0; i < 64; ++i) a.o[i] *= sc;
        a.m = s; }
    const float pr = expf(s - a.m); a.l += pr;
#pragma unroll
    for (int c = 0; c < 8; ++c) { float f[8]; ld8(vp + c * 8, f);
#pragma unroll
        for (int j = 0; j < 8; ++j) a.o[c * 8 + j] += pr * f[j]; }
}
__device__ __forceinline__ void attn_init(AttnAcc& a) { a.m = -1e30f; a.l = 0.f;
#pragma unroll
    for (int i = 0; i < 64; ++i) a.o[i] = 0.f; }
__device__ __forceinline__ void attn_loadq(float (&q)[64], const bf16_t* qp) {
#pragma unroll
    for (int c = 0; c < 8; ++c) ld8(qp + c * 8, &q[c * 8]); }
__device__ __forceinline__ void attn_store(const AttnAcc& a, bf16_t* op) {
    const float il = 1.f / a.l;
#pragma unroll
    for (int c = 0; c < 8; ++c) { float t[8];
#pragma unroll
        for (int j = 0; j < 8; ++j) t[j] = a.o[c * 8 + j] * il;
        st8(op + c * 8, t); } }

template <int kind>
__device__ __forceinline__ void attn_simple(Frame& F, int l, int item) {
    const int c = F.tid & 63, h = F.tid >> 6;
    float q[64]; AttnAcc a; attn_init(a);
    if (kind == 0) {
        const int b = item >> 6, r = item & 63, row = b * SEQ + r * 64 + c;
        attn_loadq(q, F.P1() + (size_t)row * NP1 + PC_BQ + h * 64);
        const int rs = min(max(r - 4, 0), 56), cs = min(max(c - 8, 0), 48);
        for (int kr = rs; kr < rs + 8; ++kr) {
            const float* bp = F.p.na_rpb + ((size_t)(l * 8 + h) * 15 + (kr - r + 7)) * 31 + (cs - c + 15);
            for (int kc = 0; kc < 16; ++kc) { const int krow = b * SEQ + kr * 64 + cs + kc;
                attn_key(q, a, F.P1() + (size_t)krow * NP1 + PC_BK + h * 64, F.VR() + (size_t)krow * NVR + h * 64, bp[kc]); }
        }
        for (int n = 0; n < LC; ++n) { const int crow = NTOK + b * LC + n;
            attn_key(q, a, F.P1() + (size_t)crow * NP1 + PC_BK + h * 64, F.VR() + (size_t)crow * NVR + h * 64, 0.f); }
        attn_store(a, F.BR() + (size_t)row * 2048 + 512 + h * 64);
    } else if (kind == 1) {
        const int b = item >> 6, g = item & 63, t = g * 64 + c, row = b * SEQ + t, kvh = h >> 2;
        attn_loadq(q, F.P1() + (size_t)row * NP1 + PC_CQ + h * 64);
        const int j0 = max(t - 128, 0), j1 = min(t + 128, SEQ - 1);
        for (int j = j0; j <= j1; ++j) { const int krow = b * SEQ + j;
            attn_key(q, a, F.P1() + (size_t)krow * NP1 + PC_CK + kvh * 64, F.VR() + (size_t)krow * NVR + 512 + kvh * 64, 0.f); }
        for (int n = 0; n < LC; ++n) { const int crow = NTOK + b * LC + n;
            attn_key(q, a, F.P1() + (size_t)crow * NP1 + PC_CK + kvh * 64, F.VR() + (size_t)crow * NVR + 512 + kvh * 64, 0.f); }
        const float sk = F.p.wa_sink[l * 8 + h];
        if (sk > a.m) { const float sc = expf(a.m - sk); a.l *= sc;
#pragma unroll
            for (int i = 0; i < 64; ++i) a.o[i] *= sc;
            a.m = sk; }
        a.l += expf(sk - a.m);
        attn_store(a, F.BR() + (size_t)row * 2048 + 1024 + h * 64);
    } else {
        const int b = item >> 2, g = item & 3, qrow = NTOK + b * LC + g * 64 + c, kvh = h >> 2;
        const int qc = (kind == 2) ? PC_BQ + h * 64 : PC_CQ + h * 64, kc = (kind == 2) ? PC_BK + h * 64 : PC_CK + kvh * 64, vc = (kind == 2) ? h * 64 : 512 + kvh * 64;
        attn_loadq(q, F.P1() + (size_t)qrow * NP1 + qc);
        for (int n = 0; n < LC; ++n) { const int crow = NTOK + b * LC + n;
            attn_key(q, a, F.P1() + (size_t)crow * NP1 + kc, F.VR() + (size_t)crow * NVR + vc, 0.f); }
        if (kind == 3) { const float sk = F.p.wa_sink[l * 8 + h];
            if (sk > a.m) { const float sc = expf(a.m - sk); a.l *= sc;
#pragma unroll
                for (int i = 0; i < 64; ++i) a.o[i] *= sc;
                a.m = sk; }
            a.l += expf(sk - a.m); }
        attn_store(a, F.BR() + (size_t)qrow * 2048 + (kind == 2 ? 512 : 1024) + h * 64);
    }
}


typedef short bf16x8_t __attribute__((ext_vector_type(8)));
typedef short bf16x4_t __attribute__((ext_vector_type(4)));
struct AttW { float m, l; f32x4 o[4]; };
template <class MaskF>
__device__ __forceinline__ void attn_step(AttW& a, const bf16x8_t (&qb)[2], const bf16_t* kp0, const bf16_t* kp1, const bf16_t* vp0, const bf16_t* vp1, const MaskF& maskf) {
    const bf16x8_t ka0 = *(const bf16x8_t*)kp0, ka1 = *(const bf16x8_t*)(kp0 + 32), kb0 = *(const bf16x8_t*)kp1, kb1 = *(const bf16x8_t*)(kp1 + 32);
    bf16x4_t va[4][2];
#pragma unroll
    for (int t = 0; t < 4; ++t) { va[t][0] = *(const bf16x4_t*)(vp0 + (size_t)t * 16 * NROW); va[t][1] = *(const bf16x4_t*)(vp1 + (size_t)t * 16 * NROW); }
    f32x4 s0 = {0.f, 0.f, 0.f, 0.f}, s1 = {0.f, 0.f, 0.f, 0.f};
    s0 = __builtin_amdgcn_mfma_f32_16x16x32_bf16(ka0, qb[0], s0, 0, 0, 0); s0 = __builtin_amdgcn_mfma_f32_16x16x32_bf16(ka1, qb[1], s0, 0, 0, 0);
    s1 = __builtin_amdgcn_mfma_f32_16x16x32_bf16(kb0, qb[0], s1, 0, 0, 0); s1 = __builtin_amdgcn_mfma_f32_16x16x32_bf16(kb1, qb[1], s1, 0, 0, 0);
    maskf(s0, s1);
    float mx = fmaxf(fmaxf(fmaxf(s0.x, s0.y), fmaxf(s0.z, s0.w)), fmaxf(fmaxf(s1.x, s1.y), fmaxf(s1.z, s1.w)));
    mx = fmaxf(mx, __shfl_xor(mx, 16)); mx = fmaxf(mx, __shfl_xor(mx, 32));
    const float mn = fmaxf(a.m, mx), alpha = __expf(a.m - mn); a.m = mn;
    f32x4 p0, p1;
    p0.x = __expf(s0.x - mn); p0.y = __expf(s0.y - mn); p0.z = __expf(s0.z - mn); p0.w = __expf(s0.w - mn);
    p1.x = __expf(s1.x - mn); p1.y = __expf(s1.y - mn); p1.z = __expf(s1.z - mn); p1.w = __expf(s1.w - mn);
    a.l = a.l * alpha + ((p0.x + p0.y) + (p0.z + p0.w)) + ((p1.x + p1.y) + (p1.z + p1.w));
    union { bf16x8_t v; unsigned u[4]; } pb;
    pb.u[0] = pk2(p0.x, p0.y); pb.u[1] = pk2(p0.z, p0.w); pb.u[2] = pk2(p1.x, p1.y); pb.u[3] = pk2(p1.z, p1.w);
#pragma unroll
    for (int t = 0; t < 4; ++t) {
        union { bf16x8_t v; bf16x4_t h[2]; } av; av.h[0] = va[t][0]; av.h[1] = va[t][1];
        a.o[t] = a.o[t] * alpha;
        a.o[t] = __builtin_amdgcn_mfma_f32_16x16x32_bf16(av.v, pb.v, a.o[t], 0, 0, 0);
    }
}
struct MaskNone { __device__ __forceinline__ void operator()(f32x4&, f32x4&) const {} };
struct MaskNA { int c, csq, kc0; const float* brow;
    __device__ __forceinline__ void operator()(f32x4& s0, f32x4& s1) const {
        float v[8] = {s0.x, s0.y, s0.z, s0.w, s1.x, s1.y, s1.z, s1.w};
#pragma unroll
        for (int T = 0; T < 2; ++T)
#pragma unroll
            for (int rr = 0; rr < 4; ++rr) { const int kc = kc0 + 16 * T + rr; const bool ok = (kc >= csq) && (kc <= csq + 15);
                const float bias = brow[min(max(kc - c + 15, 0), 30)]; v[T * 4 + rr] = ok ? v[T * 4 + rr] + bias : -INFINITY; }
        s0 = (f32x4){v[0], v[1], v[2], v[3]}; s1 = (f32x4){v[4], v[5], v[6], v[7]};
    }
};
struct MaskWA { int i, j0;
    __device__ __forceinline__ void operator()(f32x4& s0, f32x4& s1) const {
        float v[8] = {s0.x, s0.y, s0.z, s0.w, s1.x, s1.y, s1.z, s1.w};
#pragma unroll
        for (int T = 0; T < 2; ++T)
#pragma unroll
            for (int rr = 0; rr < 4; ++rr) { const int j = j0 + 16 * T + rr; const bool ok = (j >= 0) && (j < SEQ) && (i - j <= 128) && (j - i <= 128);
                v[T * 4 + rr] = ok ? v[T * 4 + rr] : -INFINITY; }
        s0 = (f32x4){v[0], v[1], v[2], v[3]}; s1 = (f32x4){v[4], v[5], v[6], v[7]};
    }
};
template <int kind>
__device__ __forceinline__ void attn_wave(Frame& F, int l, int item, const float* rpb_s) {
    const int lane = F.lane, n = lane & 15, g = lane >> 4;
    const bf16_t* P1 = F.P1(); const bf16_t* VT = F.VT();
    int b, h, qrow0, kcol, vrow, qcol, brcol;
    int r = 0, cb = 0, t0 = 0;
    if (kind == 0) { cb = item & 3; r = (item >> 2) & 63; h = (item >> 8) & 7; b = item >> 11; qrow0 = b * SEQ + r * 64 + cb * 16; qcol = PC_BQ + h * 64; kcol = PC_BK + h * 64; vrow = h * 64; brcol = 512 + h * 64; }
    else if (kind == 1) { const int hq = item & 3, qt = (item >> 2) & 255, kvh = (item >> 10) & 1; b = item >> 11; h = kvh * 4 + hq; t0 = qt * 16; qrow0 = b * SEQ + t0; qcol = PC_CQ + h * 64; kcol = PC_CK + kvh * 64; vrow = 512 + kvh * 64; brcol = 1024 + h * 64; }
    else if (kind == 2) { const int qt = item & 15; h = (item >> 4) & 7; b = item >> 7; qrow0 = NTOK + b * LC + qt * 16; qcol = PC_BQ + h * 64; kcol = PC_BK + h * 64; vrow = h * 64; brcol = 512 + h * 64; }
    else { const int hq = item & 3, qt = (item >> 2) & 15, kvh = (item >> 6) & 1; b = item >> 7; h = kvh * 4 + hq; qrow0 = NTOK + b * LC + qt * 16; qcol = PC_CQ + h * 64; kcol = PC_CK + kvh * 64; vrow = 512 + kvh * 64; brcol = 1024 + h * 64; }
    bf16x8_t qb[2];
    { const bf16_t* qp = P1 + (size_t)(qrow0 + n) * NP1 + qcol + 8 * g; qb[0] = *(const bf16x8_t*)qp; qb[1] = *(const bf16x8_t*)(qp + 32); }
    AttW a; a.m = -1e30f; a.l = 0.f;
#pragma unroll
    for (int t = 0; t < 4; ++t) a.o[t] = (f32x4){0.f, 0.f, 0.f, 0.f};
    const bf16_t* vbase = VT + (size_t)(vrow + n) * NROW + 4 * g;
    {   const int crow0 = NTOK + b * LC;
#pragma unroll 2
        for (int s = 0; s < 8; ++s) {
            const bf16_t* kp0 = P1 + (size_t)(crow0 + 32 * s + n) * NP1 + kcol + 8 * g;
            attn_step(a, qb, kp0, kp0 + (size_t)16 * NP1, vbase + crow0 + 32 * s, vbase + crow0 + 32 * s + 16, MaskNone());
        }
    }
    if (kind == 0) {
        const int c = cb * 16 + n, csq = min(max(c - 8, 0), 48), w0 = (cb == 0) ? 0 : (cb == 1 ? 8 : (cb == 2 ? 24 : 32)), rs = min(max(r - 4, 0), 56);
#pragma unroll 2
        for (int kr = rs; kr < rs + 8; ++kr) {
            const int tok0 = b * SEQ + kr * 64 + w0;
            const bf16_t* kp0 = P1 + (size_t)(tok0 + n) * NP1 + kcol + 8 * g;
            MaskNA mk{c, csq, w0 + 4 * g, rpb_s + (h * 15 + (kr - r + 7)) * 31};
            attn_step(a, qb, kp0, kp0 + (size_t)16 * NP1, vbase + tok0, vbase + tok0 + 16, mk);
        }
    } else if (kind == 1) {
#pragma unroll 2
        for (int s = 0; s < 9; ++s) {
            const int kb = t0 - 128 + 32 * s;
            const int ja = min(max(kb + n, 0), SEQ - 1), jb = min(max(kb + 16 + n, 0), SEQ - 1);
            const int va = min(max(kb + 4 * g, 0), SEQ - 4), vb = min(max(kb + 16 + 4 * g, 0), SEQ - 4);
            const bf16_t* kp0 = P1 + (size_t)(b * SEQ + ja) * NP1 + kcol + 8 * g; const bf16_t* kp1 = P1 + (size_t)(b * SEQ + jb) * NP1 + kcol + 8 * g;
            const bf16_t* vb0 = VT + (size_t)(vrow + n) * NROW + b * SEQ;
            MaskWA mk{t0 + n, kb + 4 * g};
            attn_step(a, qb, kp0, kp1, vb0 + va, vb0 + vb, mk);
        }
    }
    float lt = a.l; lt += __shfl_xor(lt, 16); lt += __shfl_xor(lt, 32);
    float osc = 1.f;
    if (kind == 1 || kind == 3) { const float sk = F.p.wa_sink[l * 8 + h], mf = fmaxf(a.m, sk); osc = __expf(a.m - mf); lt = lt * osc + __expf(sk - mf); }
    const float inv = osc / lt;
    bf16_t* op = F.BR() + (size_t)(qrow0 + n) * 2048 + brcol + 4 * g;
#pragma unroll
    for (int t = 0; t < 4; ++t) { const f32x4 v = a.o[t] * inv; u32x2 o2; o2.x = pk2(v.x, v.y); o2.y = pk2(v.z, v.w); *(u32x2*)(op + 16 * t) = o2; }
}


struct KVF { bf16x8_t k[4]; bf16x4_t v[4][2]; };
__device__ __forceinline__ void kv_load(KVF& f, const char* kbase, unsigned ko0, unsigned ko1, const char* vbase, unsigned vo0, unsigned vo1) {
    f.k[0] = *(const bf16x8_t*)(kbase + ko0); f.k[1] = *(const bf16x8_t*)(kbase + ko0 + 64); f.k[2] = *(const bf16x8_t*)(kbase + ko1); f.k[3] = *(const bf16x8_t*)(kbase + ko1 + 64);
#pragma unroll
    for (int t = 0; t < 4; ++t) { f.v[t][0] = *(const bf16x4_t*)(vbase + vo0 + (unsigned)t * 16u * NROW * 2u); f.v[t][1] = *(const bf16x4_t*)(vbase + vo1 + (unsigned)t * 16u * NROW * 2u); }
}
template <class MaskF>
__device__ __forceinline__ void attn_tile(float& am, float& al, f32x4 (&ao)[4], const bf16x8_t (&qb)[2], const KVF& f, const MaskF& maskf) {
    f32x4 s0 = {0.f, 0.f, 0.f, 0.f}, s1 = {0.f, 0.f, 0.f, 0.f};
    s0 = __builtin_amdgcn_mfma_f32_16x16x32_bf16(f.k[0], qb[0], s0, 0, 0, 0); s0 = __builtin_amdgcn_mfma_f32_16x16x32_bf16(f.k[1], qb[1], s0, 0, 0, 0);
    s1 = __builtin_amdgcn_mfma_f32_16x16x32_bf16(f.k[2], qb[0], s1, 0, 0, 0); s1 = __builtin_amdgcn_mfma_f32_16x16x32_bf16(f.k[3], qb[1], s1, 0, 0, 0);
    maskf(s0, s1);
    float mx = fmaxf(fmaxf(fmaxf(s0.x, s0.y), fmaxf(s0.z, s0.w)), fmaxf(fmaxf(s1.x, s1.y), fmaxf(s1.z, s1.w)));
    mx = fmaxf(mx, __shfl_xor(mx, 16)); mx = fmaxf(mx, __shfl_xor(mx, 32));
    const float mn = fmaxf(am, mx), alpha = __expf(am - mn); am = mn;
    f32x4 p0, p1;
    p0.x = __expf(s0.x - mn); p0.y = __expf(s0.y - mn); p0.z = __expf(s0.z - mn); p0.w = __expf(s0.w - mn);
    p1.x = __expf(s1.x - mn); p1.y = __expf(s1.y - mn); p1.z = __expf(s1.z - mn); p1.w = __expf(s1.w - mn);
    al = al * alpha + ((p0.x + p0.y) + (p0.z + p0.w)) + ((p1.x + p1.y) + (p1.z + p1.w));
    union { bf16x8_t v; unsigned u[4]; } pb;
    pb.u[0] = pk2(p0.x, p0.y); pb.u[1] = pk2(p0.z, p0.w); pb.u[2] = pk2(p1.x, p1.y); pb.u[3] = pk2(p1.z, p1.w);
#pragma unroll
    for (int t = 0; t < 4; ++t) {
        union { bf16x8_t v; bf16x4_t h[2]; } av; av.h[0] = f.v[t][0]; av.h[1] = f.v[t][1];
        ao[t] = ao[t] * alpha;
        ao[t] = __builtin_amdgcn_mfma_f32_16x16x32_bf16(av.v, pb.v, ao[t], 0, 0, 0);
    }
}
template <int kind>
__device__ __forceinline__ void attn_multi(Frame& F, int l, int item, const float* rpb_s) {
    constexpr int NQ = 2;
    constexpr int NLOC = (kind == 0) ? 9 : (kind == 1 ? 9 : 0), NS = 8 + NLOC;
    const int lane = F.lane, n = lane & 15, g = lane >> 4;
    const bf16_t* P1 = F.P1(); const bf16_t* VT = F.VT();
    int b, h0, kvh = 0, kcol, vrow, r = 0, cb = 0, t0 = 0, qrow0, qcol0, brcol0;
    constexpr int QRS = (kind == 0) ? 64 : (kind == 2 ? 16 : 0), QCS = (kind == 1 || kind == 3) ? 64 : 0;
    if (kind == 0) { cb = item & 3; r = ((item >> 2) & 31) * 2; h0 = (item >> 7) & 7; b = item >> 10; kcol = PC_BK + h0 * 64; vrow = h0 * 64; qrow0 = b * SEQ + r * 64 + cb * 16; qcol0 = PC_BQ + h0 * 64; brcol0 = 512 + h0 * 64; }
    else if (kind == 1) { const int hp = item & 1, qt = (item >> 1) & 255; kvh = (item >> 9) & 1; b = item >> 10; h0 = kvh * 4 + hp * 2; t0 = qt * 16; kcol = PC_CK + kvh * 64; vrow = 512 + kvh * 64; qrow0 = b * SEQ + t0; qcol0 = PC_CQ + h0 * 64; brcol0 = 1024 + h0 * 64; }
    else if (kind == 2) { const int qp = item & 7; h0 = (item >> 3) & 7; b = item >> 6; kcol = PC_BK + h0 * 64; vrow = h0 * 64; qrow0 = NTOK + b * LC + qp * 32; qcol0 = PC_BQ + h0 * 64; brcol0 = 512 + h0 * 64; }
    else { const int hp = item & 1, qt = (item >> 1) & 15; kvh = (item >> 5) & 1; b = item >> 6; h0 = kvh * 4 + hp * 2; kcol = PC_CK + kvh * 64; vrow = 512 + kvh * 64; qrow0 = NTOK + b * LC + qt * 16; qcol0 = PC_CQ + h0 * 64; brcol0 = 1024 + h0 * 64; }
    bf16x8_t qb[NQ][2]; float am[NQ], al[NQ]; f32x4 ao[NQ][4];
    { const char* qbase = (const char*)P1; const unsigned qo = (unsigned)(qrow0 + n) * (unsigned)(NP1 * 2) + (unsigned)(qcol0 + 8 * g) * 2u;
#pragma unroll
      for (int q = 0; q < NQ; ++q) { const unsigned o = qo + (unsigned)q * (unsigned)(QRS * NP1 * 2 + QCS * 2); qb[q][0] = *(const bf16x8_t*)(qbase + o); qb[q][1] = *(const bf16x8_t*)(qbase + o + 64);
        am[q] = -1e30f; al[q] = 0.f;
#pragma unroll
        for (int t = 0; t < 4; ++t) ao[q][t] = (f32x4){0.f, 0.f, 0.f, 0.f}; } }
    const int crow0 = NTOK + b * LC;
    const int w0 = (cb == 0) ? 0 : (cb == 1 ? 8 : (cb == 2 ? 24 : 32)), ru = min(max(r - 4, 0), 56);
    const char* kbase = (const char*)P1; const char* vbase = (const char*)VT;
    const unsigned kl = (unsigned)(kcol + 8 * g) * 2u, vl = (unsigned)(vrow + n) * (unsigned)NROW * 2u;
    auto load_step = [&](KVF& f, int s) {
        if (s < 8) { const unsigned ko = (unsigned)(crow0 + 32 * s + n) * (unsigned)(NP1 * 2) + kl, vo = vl + (unsigned)(crow0 + 32 * s + 4 * g) * 2u;
            kv_load(f, kbase, ko, ko + 16u * NP1 * 2u, vbase, vo, vo + 32u); }
        else if (kind == 0) { const int tok0 = b * SEQ + min(ru + (s - 8), 63) * 64 + w0; const unsigned ko = (unsigned)(tok0 + n) * (unsigned)(NP1 * 2) + kl, vo = vl + (unsigned)(tok0 + 4 * g) * 2u;
            kv_load(f, kbase, ko, ko + 16u * NP1 * 2u, vbase, vo, vo + 32u); }
        else if (kind == 1) { const int kb = t0 - 128 + 32 * (s - 8);
            const int ja = min(max(kb + n, 0), SEQ - 1), jb = min(max(kb + 16 + n, 0), SEQ - 1), va = min(max(kb + 4 * g, 0), SEQ - 4), vb = min(max(kb + 16 + 4 * g, 0), SEQ - 4);
            kv_load(f, kbase, (unsigned)(b * SEQ + ja) * (unsigned)(NP1 * 2) + kl, (unsigned)(b * SEQ + jb) * (unsigned)(NP1 * 2) + kl, vbase, vl + (unsigned)(b * SEQ + va) * 2u, vl + (unsigned)(b * SEQ + vb) * 2u); }
    };
    auto compute_step = [&](const KVF& f, int s) {
        if (s < 8) {
#pragma unroll
            for (int q = 0; q < NQ; ++q) { attn_tile(am[q], al[q], ao[q], qb[q], f, MaskNone()); if (NQ == 4) __builtin_amdgcn_sched_barrier(0); }
        } else if (kind == 0) {
            const int kr = ru + (s - 8);
#pragma unroll
            for (int q = 0; q < NQ; ++q) { const int rq = r + q, rsq = min(max(rq - 4, 0), 56);
                if (kr >= rsq && kr <= rsq + 7) { const int c = cb * 16 + n, csq = min(max(c - 8, 0), 48);
                    MaskNA mk{c, csq, w0 + 4 * g, rpb_s + (h0 * 15 + (kr - rq + 7)) * 31}; attn_tile(am[q], al[q], ao[q], qb[q], f, mk); } }
        } else if (kind == 1) {
            MaskWA mk{t0 + n, t0 - 128 + 32 * (s - 8) + 4 * g};
#pragma unroll
            for (int q = 0; q < NQ; ++q) { attn_tile(am[q], al[q], ao[q], qb[q], f, mk); if (NQ == 4) __builtin_amdgcn_sched_barrier(0); }
        }
    };
    if (NQ == 2) {
        KVF fa, fb;
        load_step(fa, 0);
#pragma unroll 1
        for (int s = 0; s < NS; s += 2) {
            if (s + 1 < NS) load_step(fb, s + 1);
            compute_step(fa, s);
            if (s + 1 < NS) { if (s + 2 < NS) load_step(fa, s + 2); compute_step(fb, s + 1); }
        }
    } else {
        KVF fa;
#pragma unroll 1
        for (int s = 0; s < NS; ++s) { load_step(fa, s); compute_step(fa, s); }
    }
#pragma unroll
    for (int q = 0; q < NQ; ++q) {
        float lt = al[q]; lt += __shfl_xor(lt, 16); lt += __shfl_xor(lt, 32);
        float osc = 1.f;
        if (kind == 1 || kind == 3) { const float sk = F.p.wa_sink[l * 8 + h0 + q], mf = fmaxf(am[q], sk); osc = __expf(am[q] - mf); lt = lt * osc + __expf(sk - mf); }
        const float inv = osc / lt;
        char* obase = (char*)F.BR(); const unsigned oo = (unsigned)(qrow0 + q * QRS + n) * 4096u + (unsigned)(brcol0 + q * QCS + 4 * g) * 2u;
#pragma unroll
        for (int t = 0; t < 4; ++t) { const f32x4 v = ao[q][t] * inv; u32x2 o2; o2.x = pk2(v.x, v.y); o2.y = pk2(v.z, v.w); *(u32x2*)(obase + oo + 32u * t) = o2; }
    }
}

template <int DK, bool HG>
__device__ __forceinline__ void scan_mfma(Frame& F, int l, int b, int h, int z, unsigned char* lds) {
    constexpr int NDP = DK / 2, NTG = NTHR / NDP, TPT = 64 / NTG, QS = DK + 8, TS = 72, NDT = DK / 16;
    bf16_t* QD = (bf16_t*)lds; bf16_t* KD = QD + 64 * QS; bf16_t* KDT = KD + 64 * QS; bf16_t* VTs = KDT + DK * TS; bf16_t* AM = VTs + 128 * TS; bf16_t* ST = AM + 64 * TS;
    float* TOT = (float*)(ST + 128 * QS); float* E1s = TOT + NTG * DK; float* E2s = E1s + DK;
    REFRESH(F);
    const int tid = F.tid, lane = F.lane, w = F.wave, n = lane & 15, g = lane >> 4;
    const int dp = tid % NDP, tg = tid / NDP, vp = tid & 63, vg = tid >> 6;
    const bf16_t* P1 = F.P1();
    float lw[HG ? 2 : 32], lbias[2] = {0.f, 0.f}, lbv[2] = {0.f, 0.f};
    if (!HG) {
#pragma unroll
        for (int r = 0; r < 16; ++r) { const float* wp = F.p.gla_lr_w + ((size_t)(l * 2 + z) * 16 + r) * 256 + h * 64 + 2 * dp; lw[2 * r] = wp[0]; lw[2 * r + 1] = wp[1]; }
        lbias[0] = F.p.gla_lr_b[(l * 2 + z) * 256 + h * 64 + 2 * dp]; lbias[1] = F.p.gla_lr_b[(l * 2 + z) * 256 + h * 64 + 2 * dp + 1];
    } else { lw[0] = lw[1] = 0.f; if (l != 0) { lbv[0] = F.lb()[z * 512 + h * 128 + 2 * dp]; lbv[1] = F.lb()[z * 512 + h * 128 + 2 * dp + 1]; } }
    f32x4 accS[NDT];
#pragma unroll
    for (int i = 0; i < NDT; ++i) accS[i] = (f32x4){0.f, 0.f, 0.f, 0.f};
    unsigned rq[TPT], rk[TPT], rv[8]; u32x4 rl[HG ? 1 : TPT][2];
    const int qcol = HG ? PC_DQ + h * 128 + 2 * dp : PC_AQ + h * 64 + 2 * dp, kcol = HG ? PC_DF + z * 512 + h * 128 + 2 * dp : PC_AK + h * 64 + 2 * dp;
    const int vcol = (HG ? PC_DI : PC_AV) + h * 128 + 2 * vp;
#define SCAN_LOAD(c) do { _Pragma("unroll") for (int tt = 0; tt < TPT; ++tt) { const bf16_t* base = P1 + (size_t)seq_row((c) * 64 + tg * TPT + tt, b, z) * NP1; \
            rq[tt] = *(const unsigned*)(base + qcol); rk[tt] = *(const unsigned*)(base + kcol); \
            if (!HG) { rl[tt][0] = *(const u32x4*)(base + PC_ALR + z * 16); rl[tt][1] = *(const u32x4*)(base + PC_ALR + z * 16 + 8); } } \
        _Pragma("unroll") for (int tt = 0; tt < 8; ++tt) rv[tt] = *(const unsigned*)(P1 + (size_t)seq_row((c) * 64 + vg * 8 + tt, b, z) * NP1 + vcol); } while (0)
    SCAN_LOAD(0);
    constexpr int NCH = (LC + SEQ) / 64;
#pragma unroll 1
    for (int c = 0; c < NCH; ++c) {
        float qv[TPT][2], kv[TPT][2], cs[TPT][2];
#pragma unroll
        for (int tt = 0; tt < TPT; ++tt)
#pragma unroll
            for (int e = 0; e < 2; ++e) {
                const float qr = __uint_as_float(e ? (rq[tt] & 0xffff0000u) : (rq[tt] << 16)), kr = __uint_as_float(e ? (rk[tt] & 0xffff0000u) : (rk[tt] << 16));
                float gg;
                if (HG) {
                    const float ls = fminf(kr, 0.f) - __logf(1.f + __expf(-fabsf(kr)));
                    gg = (lbv[e] > 0.f) ? __logf(lbv[e] + (1.f - lbv[e]) * __expf(ls)) : ls;
                    kv[tt][e] = (1.f - lbv[e]) * __expf(ls - kr);
                    qv[tt][e] = qr / (1.f + __expf(-qr));
                } else {
                    float lg = lbias[e];
                    const unsigned lr8[8] = {rl[tt][0].x, rl[tt][0].y, rl[tt][0].z, rl[tt][0].w, rl[tt][1].x, rl[tt][1].y, rl[tt][1].z, rl[tt][1].w};
#pragma unroll
                    for (int r2 = 0; r2 < 8; ++r2) { lg += __uint_as_float(lr8[r2] << 16) * lw[(2 * r2) * 2 + e]; lg += __uint_as_float(lr8[r2] & 0xffff0000u) * lw[(2 * r2 + 1) * 2 + e]; }
                    gg = (fminf(lg, 0.f) - __logf(1.f + __expf(-fabsf(lg)))) * (1.f / 16.f);
                    kv[tt][e] = kr; qv[tt][e] = qr;
                }
                cs[tt][e] = gg + (tt ? cs[tt ? tt - 1 : 0][e] : 0.f);
                __builtin_amdgcn_sched_barrier(0);
            }
        TOT[tg * DK + 2 * dp] = cs[TPT - 1][0]; TOT[tg * DK + 2 * dp + 1] = cs[TPT - 1][1];
        __syncthreads();
        float offs[2] = {0.f, 0.f}, mid[2] = {0.f, 0.f}, lastv[2] = {0.f, 0.f};
#pragma unroll
        for (int t2 = 0; t2 < NTG; ++t2)
#pragma unroll
            for (int e = 0; e < 2; ++e) { const float tv = TOT[t2 * DK + 2 * dp + e]; if (t2 < tg) offs[e] += tv; if (t2 < NTG / 2) mid[e] += tv; lastv[e] += tv; }
        unsigned kdt[2][TPT / 2];
#pragma unroll
        for (int tt = 0; tt < TPT; ++tt) {
            float qd[2], kd[2];
#pragma unroll
            for (int e = 0; e < 2; ++e) { const float bc = cs[tt][e] + offs[e]; qd[e] = qv[tt][e] * __expf(fminf(bc - mid[e], 80.f)); kd[e] = kv[tt][e] * __expf(fminf(mid[e] - bc, 80.f)); }
            const int tok = tg * TPT + tt;
            *(unsigned*)(QD + tok * QS + 2 * dp) = pk2(qd[0], qd[1]); *(unsigned*)(KD + tok * QS + 2 * dp) = pk2(kd[0], kd[1]);
#pragma unroll
            for (int e = 0; e < 2; ++e) { const unsigned hb = (unsigned)f2bf(kd[e]); if (tt & 1) kdt[e][tt >> 1] |= hb << 16; else kdt[e][tt >> 1] = hb; }
            __builtin_amdgcn_sched_barrier(0);
        }
#pragma unroll
        for (int e = 0; e < 2; ++e) {
            bf16_t* dst = KDT + (2 * dp + e) * TS + tg * TPT;
            if (TPT == 8) { u32x4 o; o.x = kdt[e][0]; o.y = kdt[e][1]; o.z = kdt[e][TPT / 2 - 2]; o.w = kdt[e][TPT / 2 - 1]; *(u32x4*)dst = o; }
            else { u32x2 o; o.x = kdt[e][0]; o.y = kdt[e][1]; *(u32x2*)dst = o; }
        }
        if (tg == 0) { E1s[2 * dp] = __expf(mid[0]); E1s[2 * dp + 1] = __expf(mid[1]); E2s[2 * dp] = __expf(lastv[0] - mid[0]); E2s[2 * dp + 1] = __expf(lastv[1] - mid[1]); }
        {   u32x4 o0, o1;
            o0.x = (rv[0] & 0xffffu) | (rv[1] << 16); o0.y = (rv[2] & 0xffffu) | (rv[3] << 16); o0.z = (rv[4] & 0xffffu) | (rv[5] << 16); o0.w = (rv[6] & 0xffffu) | (rv[7] << 16);
            o1.x = (rv[0] >> 16) | (rv[1] & 0xffff0000u); o1.y = (rv[2] >> 16) | (rv[3] & 0xffff0000u); o1.z = (rv[4] >> 16) | (rv[5] & 0xffff0000u); o1.w = (rv[6] >> 16) | (rv[7] & 0xffff0000u);
            *(u32x4*)(VTs + (2 * vp) * TS + vg * 8) = o0; *(u32x4*)(VTs + (2 * vp + 1) * TS + vg * 8) = o1; }
        if (c + 1 < NCH) SCAN_LOAD(c + 1);
        __syncthreads();
#pragma unroll
        for (int dt = 0; dt < NDT; ++dt) { accS[dt] = accS[dt] * *(const f32x4*)&E1s[16 * dt + 4 * g];
            u32x2 o; o.x = pk2(accS[dt].x, accS[dt].y); o.y = pk2(accS[dt].z, accS[dt].w); *(u32x2*)(ST + (16 * w + n) * QS + 16 * dt + 4 * g) = o; }
        {   const int it = w >> 1;
#pragma unroll
            for (int jj = 0; jj < 2; ++jj) { const int jt = 2 * (w & 1) + jj; f32x4 d = {0.f, 0.f, 0.f, 0.f};
                if (jt <= it) {
#pragma unroll
                    for (int ks = 0; ks < DK / 32; ++ks) d = __builtin_amdgcn_mfma_f32_16x16x32_bf16(*(const bf16x8_t*)(KD + (16 * jt + n) * QS + 32 * ks + 8 * g), *(const bf16x8_t*)(QD + (16 * it + n) * QS + 32 * ks + 8 * g), d, 0, 0, 0);
                    const int i = 16 * it + n, j0 = 16 * jt + 4 * g;
                    d.x = (j0 + 0 <= i) ? d.x : 0.f; d.y = (j0 + 1 <= i) ? d.y : 0.f; d.z = (j0 + 2 <= i) ? d.z : 0.f; d.w = (j0 + 3 <= i) ? d.w : 0.f;
                }
                u32x2 o; o.x = pk2(d.x, d.y); o.y = pk2(d.z, d.w); *(u32x2*)(AM + (16 * it + n) * TS + 16 * jt + 4 * g) = o; }
        }
        __syncthreads();
#pragma unroll
        for (int it = 0; it < 4; ++it) { f32x4 o = {0.f, 0.f, 0.f, 0.f};
#pragma unroll
            for (int ks = 0; ks < 2; ++ks) o = __builtin_amdgcn_mfma_f32_16x16x32_bf16(*(const bf16x8_t*)(VTs + (16 * w + n) * TS + 32 * ks + 8 * g), *(const bf16x8_t*)(AM + (16 * it + n) * TS + 32 * ks + 8 * g), o, 0, 0, 0);
#pragma unroll
            for (int ks = 0; ks < DK / 32; ++ks) o = __builtin_amdgcn_mfma_f32_16x16x32_bf16(*(const bf16x8_t*)(ST + (16 * w + n) * QS + 32 * ks + 8 * g), *(const bf16x8_t*)(QD + (16 * it + n) * QS + 32 * ks + 8 * g), o, 0, 0, 0);
            const int row = seq_row(c * 64 + 16 * it + n, b, z); bf16_t* dst;
            if (HG) dst = F.P1() + (size_t)row * NP1 + PC_DF + z * 512 + h * 128; else dst = (z == 0) ? F.BR() + (size_t)row * 2048 + h * 128 : F.OBA() + (size_t)row * 512 + h * 128;
            u32x2 o2; o2.x = pk2(o.x, o.y); o2.y = pk2(o.z, o.w); *(u32x2*)(dst + 16 * w + 4 * g) = o2; }
#pragma unroll
        for (int dt = 0; dt < NDT; ++dt) {
#pragma unroll
            for (int ks = 0; ks < 2; ++ks) accS[dt] = __builtin_amdgcn_mfma_f32_16x16x32_bf16(*(const bf16x8_t*)(KDT + (16 * dt + n) * TS + 32 * ks + 8 * g), *(const bf16x8_t*)(VTs + (16 * w + n) * TS + 32 * ks + 8 * g), accS[dt], 0, 0, 0);
            accS[dt] = accS[dt] * *(const f32x4*)&E2s[16 * dt + 4 * g]; }
        __syncthreads();
    }
#undef SCAN_LOAD
}

constexpr bool MF_SCAN = true;
__device__ __forceinline__ void phase_mix(Frame& F, int l) {
    const int n_scan = 64;
    const int nsb = (F.nb > 128) ? 64 : 0;
    if (nsb == 0 || F.bid < nsb) {
        for (int it = F.bid; it < n_scan; it += (nsb ? nsb : F.nb)) {
            const int br = it >> 5, r = it & 31, b = r >> 3, h = (r >> 1) & 3, z = r & 1;
            if (br == 0) scan_mfma<64, false>(F, l, b, h, z, (unsigned char*)F.smf); else scan_mfma<128, true>(F, l, b, h, z, (unsigned char*)F.smf);
        }
        __syncthreads();
    }
    float* rpb_s = F.smf;
    for (int i = F.tid; i < 8 * 465; i += NTHR) rpb_s[i] = F.p.na_rpb[(size_t)l * 8 * 465 + i];
    __syncthreads();
    unsigned* qhead = F.cnt() + 64 + l * 16;
    const int n_wa = 4096, n_na = 4096, n_cna = (l == 0) ? 256 : 0, n_cwa = (l == 0) ? 256 : 0, total = n_wa + n_na + n_cna + n_cwa;
    for (;;) {
        int it = 0; if (F.lane == 0) it = (int)atomicAdd(qhead, 1u);
        it = __builtin_amdgcn_readfirstlane(it);
        if (it >= total) break;
        if (it < n_wa) attn_multi<1>(F, l, it, rpb_s);
        else if (it < n_wa + n_na) attn_multi<0>(F, l, it - n_wa, rpb_s);
        else if (it < n_wa + n_na + n_cna) attn_multi<2>(F, l, it - n_wa - n_na, rpb_s);
        else attn_multi<3>(F, l, it - n_wa - n_na - n_cna, rpb_s);
    }
}

__device__ __forceinline__ void phase_prepad(Frame& F, int l) {
    const int gw = F.bid * 8 + F.wave, ngw = F.nb * 8, nrows = (l == 0) ? NROW : NTOK;
    for (int row = gw; row < nrows; row += ngw) {
        const int c0 = F.lane * 8;
        {   float a[8], b[8], g[8], o[8];
            ld8(F.BR() + (size_t)row * 2048 + c0, a); ld8(F.OBA() + (size_t)row * 512 + c0, b); ld8(F.P1() + (size_t)row * NP1 + PC_AG + c0, g);
            float ss = 0.f;
#pragma unroll
            for (int j = 0; j < 8; ++j) { o[j] = a[j] + b[j]; ss += o[j] * o[j]; }
            ss += __shfl_xor(ss, 1); ss += __shfl_xor(ss, 2); ss += __shfl_xor(ss, 4); ss += __shfl_xor(ss, 8);
            const float rs = rsqrtf(ss * (1.f / 128.f) + 1e-6f);
#pragma unroll
            for (int j = 0; j < 8; ++j) o[j] = o[j] * rs * siluf_(g[j]);
            st8(F.BR() + (size_t)row * 2048 + c0, o); }
        {   float a[8], b[8], g[8], o[8];
            ld8(F.P1() + (size_t)row * NP1 + PC_DF + c0, a); ld8(F.P1() + (size_t)row * NP1 + PC_DF + 512 + c0, b); ld8(F.P1() + (size_t)row * NP1 + PC_DG + c0, g);
            float ss = 0.f;
#pragma unroll
            for (int j = 0; j < 8; ++j) { o[j] = a[j] + b[j]; ss += o[j] * o[j]; }
            ss += __shfl_xor(ss, 1); ss += __shfl_xor(ss, 2); ss += __shfl_xor(ss, 4); ss += __shfl_xor(ss, 8);
            const float rs = rsqrtf(ss * (1.f / 128.f) + 1e-6f);
#pragma unroll
            for (int j = 0; j < 8; ++j) o[j] = o[j] * rs * siluf_(g[j]);
            st8(F.BR() + (size_t)row * 2048 + 1536 + c0, o); }
    }
}

__device__ __forceinline__ void phase_merge_s(Frame& F, int l) {
    const int M = (l == 0) ? NROW : NTOK, tn = DM / 128, nt = (M / 128) * tn, ty = F.tid >> 5, tx = F.tid & 31;
    for (int t = F.bid; t < nt; t += F.nb) {
        const int row0 = (t / tn) * 128, col0 = (t % tn) * 128;
        float sum[8][4];
#pragma unroll
        for (int i = 0; i < 8; ++i)
#pragma unroll
            for (int j = 0; j < 4; ++j) sum[i][j] = 0.f;
#pragma unroll 1
        for (int br = 0; br < 4; ++br) {
            float acc[8][4];
#pragma unroll
            for (int i = 0; i < 8; ++i)
#pragma unroll
                for (int j = 0; j < 4; ++j) acc[i][j] = 0.f;
            gemm_s_acc(acc, F.BR() + br * 512, 2048, F.Wbrt() + (size_t)br * DM * 512, 512, 512, row0, col0, F.smf, F.tid);
#pragma unroll
            for (int i = 0; i < 8; ++i) { const u32x2 g2 = *(const u32x2*)(F.G() + (size_t)(row0 + ty * 8 + i) * NGATE + br * 1024 + col0 + tx * 4);
                sum[i][0] += __uint_as_float(g2.x << 16) * acc[i][0]; sum[i][1] += __uint_as_float(g2.x & 0xffff0000u) * acc[i][1];
                sum[i][2] += __uint_as_float(g2.y << 16) * acc[i][2]; sum[i][3] += __uint_as_float(g2.y & 0xffff0000u) * acc[i][3]; }
        }
#pragma unroll
        for (int i = 0; i < 8; ++i) { u32x2 o2; o2.x = pk2(sum[i][0], sum[i][1]); o2.y = pk2(sum[i][2], sum[i][3]);
            *(u32x2*)(F.HX() + (size_t)(row0 + ty * 8 + i) * DM + col0 + tx * 4) = o2; }
    }
}

__device__ __forceinline__ void phase_ln1(Frame& F, int l) {
    const int nrows = (l == 0) ? NROW : NTOK, ngroups = nrows / 64;
    const float* lg = F.p.ln_g + (size_t)(l * 2 + 0) * DM; const float* lbb = F.p.ln_b + (size_t)(l * 2 + 0) * DM;
    float* part = F.smf;
    const int wv = __builtin_amdgcn_readfirstlane(F.wave);
    for (int grp = F.bid; grp < ngroups; grp += F.nb) {
        const int row0 = grp * 64, rb = row_batch(row0);
        const float* mv = F.modv() + ((size_t)l * 5 + rb) * 6144;
        float* xg = row0 < NTOK ? F.p.out + (size_t)row0 * DM : F.cxm() + (size_t)(row0 - NTOK) * DM;
#pragma unroll 1
        for (int rr = 0; rr < 8; ++rr) {
            const int lr = wv * 8 + rr; float* xr = xg + (size_t)lr * DM;
            f32x4 v[4]; float s = 0.f;
#pragma unroll
            for (int j = 0; j < 4; ++j) { v[j] = *(const f32x4*)(xr + j * 256 + F.lane * 4); s += (v[j].x + v[j].y) + (v[j].z + v[j].w); }
            const float mean = wave_sum(s) * (1.f / DM); float s2 = 0.f;
#pragma unroll
            for (int j = 0; j < 4; ++j) { v[j] = v[j] - mean; s2 += (v[j].x * v[j].x + v[j].y * v[j].y) + (v[j].z * v[j].z + v[j].w * v[j].w); }
            const float rstd = rsqrtf(wave_sum(s2) * (1.f / DM) + LN_EPS);
#pragma unroll
            for (int j = 0; j < 4; ++j) { const int d = j * 256 + F.lane * 4;
                const f32x4 g4 = *(const f32x4*)(lg + d), b4 = *(const f32x4*)(lbb + d), m3 = *(const f32x4*)(mv + 3 * 1024 + d), m4 = *(const f32x4*)(mv + 4 * 1024 + d);
                const f32x4 xn = v[j] * rstd * g4 + b4;
                *(f32x4*)(xr + d) = xn;
                const f32x4 h2 = xn * (1.f + m4) + m3;
                u32x2 o2; o2.x = pk2(h2.x, h2.y); o2.y = pk2(h2.z, h2.w);
                *(u32x2*)(F.HX2() + (size_t)(row0 + lr) * DM + d) = o2; }
        }
        __syncthreads();
        {   float acc[36];
#pragma unroll
            for (int o = 0; o < 36; ++o) acc[o] = 0.f;
            const float* xr = xg + (size_t)F.lane * DM + wv * 128;
            const float* wgp = F.p.moe_w_group + ((size_t)l * DM + wv * 128) * 4; const float* wep = F.p.moe_w_expert + ((size_t)l * DM + wv * 128) * 32;
            const float* m3p = mv + 3 * 1024 + wv * 128; const float* m4p = mv + 4 * 1024 + wv * 128;
#pragma unroll 1
            for (int dc = 0; dc < 128; dc += 4) {
                const f32x4 xv = *(const f32x4*)(xr + dc); const float xs[4] = {xv.x, xv.y, xv.z, xv.w};
#pragma unroll
                for (int q = 0; q < 4; ++q) { const int d = dc + q; const float hh = xs[q] * (1.f + m4p[d]) + m3p[d];
#pragma unroll
                    for (int o = 0; o < 4; ++o) acc[o] += hh * wgp[d * 4 + o];
#pragma unroll
                    for (int o = 0; o < 32; ++o) acc[4 + o] += hh * wep[d * 32 + o]; }
            }
#pragma unroll
            for (int o = 0; o < 36; ++o) part[(wv * 36 + o) * 64 + F.lane] = acc[o];
        }
        __syncthreads();
        if (wv == 0) {
            const int row = row0 + F.lane;
            float gl[4]; int gi = 0; float gm = -3.4e38f;
#pragma unroll
            for (int o = 0; o < 4; ++o) { float t = F.p.moe_b_group[l * 4 + o];
#pragma unroll
                for (int w2 = 0; w2 < 8; ++w2) t += part[(w2 * 36 + o) * 64 + F.lane];
                gl[o] = t; if (t > gm) { gm = t; gi = o; } }
            float gs = 0.f;
#pragma unroll
            for (int o = 0; o < 4; ++o) gs += expf(gl[o] - gm);
            const float gwt = 1.f / gs;
            float e1 = -3.4e38f, e2 = -3.4e38f; int i1 = 0, i2 = 0;
#pragma unroll
            for (int o8 = 0; o8 < 8; ++o8) { const int o = gi * 8 + o8; float ev = F.p.moe_b_expert[l * 32 + o];
#pragma unroll
                for (int w2 = 0; w2 < 8; ++w2) ev += part[(w2 * 36 + 4 + o) * 64 + F.lane];
                if (ev > e1) { e2 = e1; i2 = i1; e1 = ev; i1 = o; } else if (ev > e2) { e2 = ev; i2 = o; } }
            const float w1 = 1.f / (1.f + expf(e2 - e1)), w2v = 1.f - w1;
            const unsigned p1 = atomicAdd(&F.cnt()[l * 32 + i1], 1u), p2 = atomicAdd(&F.cnt()[l * 32 + i2], 1u);
            F.tokE()[row * 2] = i1; F.tokI()[row * 2] = (int)p1; F.tokW()[row * 2] = gwt * w1;
            F.tokE()[row * 2 + 1] = i2; F.tokI()[row * 2 + 1] = (int)p2; F.tokW()[row * 2 + 1] = gwt * w2v;
        }
        __syncthreads();
    }
}

__device__ __forceinline__ void phase_gather(Frame& F, int l) {
    int* off = (int*)F.smf; moe_offsets(F, l, off);
    const int gw = F.bid * 8 + F.wave, ngw = F.nb * 8, nrows = (l == 0) ? NROW : NTOK;
    for (int s = gw; s < 2 * nrows; s += ngw) {
        const int e = F.tokE()[s], dst = off[e] + F.tokI()[s];
        const u32x4* src = (const u32x4*)(F.HX2() + (size_t)(s >> 1) * DM); u32x4* d = (u32x4*)(F.XS() + (size_t)dst * DM);
        d[F.lane] = src[F.lane]; d[F.lane + 64] = src[F.lane + 64];
        if (F.lane == 0) { F.rmap()[dst] = s; F.roww()[dst] = F.tokW()[s]; }
    }
    for (int e = 0; e < 32; ++e) {
        const int c = (int)F.cnt()[l * 32 + e], pc = (c + 255) & ~255;
        for (int j = c + gw; j < pc; j += ngw) { const int dst = off[e] + j; u32x4* d = (u32x4*)(F.XS() + (size_t)dst * DM);
            const u32x4 z = {0u, 0u, 0u, 0u}; d[F.lane] = z; d[F.lane + 64] = z;
            if (F.lane == 0) { F.rmap()[dst] = -1; F.roww()[dst] = 0.f; } }
    }
}
__device__ __forceinline__ int expert_of_row(const int* off, int row) { int e = 0;
#pragma unroll 1
    for (int i = 1; i < 32; ++i) if (row >= off[i]) e = i;
    return e; }

__device__ __forceinline__ void phase_ln2(Frame& F, int l) {
    const int gw = F.bid * 8 + F.wave, ngw = F.nb * 8, nrows = (l == 0) ? NROW : NTOK;
    const float* lg = F.p.ln_g + (size_t)(l * 2 + 1) * DM; const float* lbb = F.p.ln_b + (size_t)(l * 2 + 1) * DM;
    const bf16_t* Y = F.BR();
    const bool tmo_set = (l == DEPTH - 1) && ((__hip_atomic_load((unsigned*)(F.ws + WS_CTL) + XB_TMO, __ATOMIC_RELAXED, __HIP_MEMORY_SCOPE_AGENT) | __hip_atomic_load((unsigned*)(F.ws + WS_CTL) + XCD_BAR_WORDS + XB_TMO, __ATOMIC_RELAXED, __HIP_MEMORY_SCOPE_AGENT)) != 0u);
    for (int row = gw; row < nrows; row += ngw) {
        const float* xm = row < NTOK ? F.p.out + (size_t)row * DM : F.cxm() + (size_t)(row - NTOK) * DM;
        float* xo = row < NTOK ? F.p.out + (size_t)row * DM : F.cxo() + (size_t)(row - NTOK) * DM;
        const float* mv = F.modv() + ((size_t)l * 5 + row_batch(row)) * 6144;
        f32x4 v[4]; float s = 0.f;
#pragma unroll
        for (int j = 0; j < 4; ++j) { const int d = j * 256 + F.lane * 4;
            const u32x2 y0 = *(const u32x2*)(Y + (size_t)(row * 2) * DM + d), y1 = *(const u32x2*)(Y + (size_t)(row * 2 + 1) * DM + d);
            f32x4 y; y.x = __uint_as_float(y0.x << 16) + __uint_as_float(y1.x << 16); y.y = __uint_as_float(y0.x & 0xffff0000u) + __uint_as_float(y1.x & 0xffff0000u);
            y.z = __uint_as_float(y0.y << 16) + __uint_as_float(y1.y << 16); y.w = __uint_as_float(y0.y & 0xffff0000u) + __uint_as_float(y1.y & 0xffff0000u);
            const f32x4 m5 = *(const f32x4*)(mv + 5 * 1024 + d);
            v[j] = ALPHA * *(const f32x4*)(xm + d) + m5 * y; s += (v[j].x + v[j].y) + (v[j].z + v[j].w); }
        const float mean = wave_sum(s) * (1.f / DM); float s2 = 0.f;
#pragma unroll
        for (int j = 0; j < 4; ++j) { v[j] = v[j] - mean; s2 += (v[j].x * v[j].x + v[j].y * v[j].y) + (v[j].z * v[j].z + v[j].w * v[j].w); }
        const float rstd = rsqrtf(wave_sum(s2) * (1.f / DM) + LN_EPS);
#pragma unroll
        for (int j = 0; j < 4; ++j) { const int d = j * 256 + F.lane * 4;
            const f32x4 g4 = *(const f32x4*)(lg + d), b4 = *(const f32x4*)(lbb + d);
            f32x4 xn = v[j] * rstd * g4 + b4;
            if (tmo_set) xn = xn * __uint_as_float(0x7fc00000u);
            *(f32x4*)(xo + d) = xn;
            if (l + 1 < DEPTH) { const float* mn = F.modv() + ((size_t)(l + 1) * 5 + row_batch(row)) * 6144;
                const f32x4 m0 = *(const f32x4*)(mn + d), m1 = *(const f32x4*)(mn + 1024 + d); const f32x4 h = xn * (1.f + m1) + m0;
                u32x2 o2; o2.x = pk2(h.x, h.y); o2.y = pk2(h.z, h.w); *(u32x2*)(F.HX() + (size_t)row * DM + d) = o2; }
        }
    }
}

constexpr int NPL = 14, NPH = 1 + DEPTH * NPL;
constexpr bool MF_G1 = true, MF_GATE = true, MF_MERGE = true, MF_WOUT = true, MF_MOE1 = true, MF_MOE2 = true;
constexpr int LDS_STAGE = 1024;
#define EN(i) (((PHMASK) >> (i)) & 1)
template <int PHMASK>
__global__ void __launch_bounds__(NTHR, 2) mega(Params p) {
    extern __shared__ __attribute__((aligned(16))) unsigned char smem[];
    Frame F; F.p = p; F.bid = blockIdx.x; F.nb = gridDim.x; F.tid = threadIdx.x; F.lane = threadIdx.x & 63; F.wave = threadIdx.x >> 6;
    F.smf = (float*)(smem + LDS_STAGE);
    LAS unsigned char* stage = (LAS unsigned char*)smem + LDS_STAGE; int* offt = (int*)(smem + 64);
    unsigned char* ws = p.ws; F.ws = ws;

    if (threadIdx.x == 0) *(uint4*)smem = make_uint4(0u, 0u, 0u, 0u);
    __syncthreads();
    unsigned* barw = (unsigned*)(ws + WS_CTL) + (p.ph_lo == 0 ? 0 : XCD_BAR_WORDS);
    XcdBarrier bar; bar.bar = barw; bar.x = 0; bar.st = (volatile LAS unsigned*)smem;
    const bool multi = (p.ph_hi - p.ph_lo) > 1;
    if (multi) bar = xcd_barrier_post(barw, (volatile LAS unsigned*)smem);
    const int lo = p.ph_lo, hi = p.ph_hi;
#define IN(k) (lo <= (k) && (k) < hi)
#define SEAM(k) do { if (IN(k) && IN((k) + 1)) xcd_barrier(bar); else __syncthreads(); } while (0)

    if (EN(14) && IN(0)) { REFRESH(F); phase_mod(F); __syncthreads(); phase_conv_a(F, 0); }
    SEAM(0);
#pragma unroll 1
    for (int l = 0; l < DEPTH; ++l) {
        const int pb = 1 + l * NPL;
        const float* xlat = (l == 0) ? p.x : p.out; const float* xctx = (l == 0) ? p.ctx : F.cxo();
        const int Mrows = (l == 0) ? NROW : NTOK;
        if (EN(0) && IN(pb + 0)) { REFRESH(F); if (l == 0) phase_prep(F, 0, p.x, p.ctx); else phase_conv_a(F, l); }
        SEAM(pb + 0);
        if (EN(1) && IN(pb + 1)) { REFRESH(F);
            bf16_t* P1 = F.P1(); bf16_t* VT = F.VT(); bf16_t* VR = F.VR();
            if (MF_G1) {
                pg::SchedG1 S{(const char*)F.HX(), (const char*)F.W1t(), (const char*)F.Wvt(), F.nb, F.bid}; pg::EpiG1 E{P1, VT};
                pg::gemm_phase(stage, DM, DM, DM, S, E);
                __syncthreads();
            } else {
            gemm_s(F, F.HX(), DM, F.W1t(), DM, NROW, NP1, DM, [=](int r, int c, float v) { P1[(size_t)r * NP1 + c] = f2bf(v); });
            gemm_s(F, F.Wvt(), DM, F.HX(), DM, NVT, NROW, DM, [=](int r, int c, float v) { VT[(size_t)r * NROW + c] = f2bf(v); });
            }
            if (!MF_ATTN) gemm_s(F, F.HX(), DM, F.Wvt(), DM, NROW, NVT, DM, [=](int r, int c, float v) { if (c < NVR) VR[(size_t)r * NVR + c] = f2bf(v); });
        }
        SEAM(pb + 1);
        if (EN(2) && IN(pb + 2)) { REFRESH(F); phase_rope(F); }
        SEAM(pb + 2);
        if (EN(3) && IN(pb + 3)) { REFRESH(F); phase_mix(F, l); }
        SEAM(pb + 3);
        if (EN(4) && IN(pb + 4)) { REFRESH(F); phase_prepad(F, l); }
        SEAM(pb + 4);
        if (EN(5) && IN(pb + 5)) { REFRESH(F);
            bf16_t* G = F.G();
            if (MF_GATE) {
                pg::SchedStatic S{(const char*)F.HX(), (const char*)F.Wgt(), (size_t)256 * DM * 2, (size_t)256 * DM * 2, Mrows / 256, NGATE / 256, F.nb, F.bid}; pg::EpiGate E{G};
                pg::gemm_phase(stage, DM, DM, DM, S, E);
                __syncthreads();
            } else
            gemm_s(F, F.HX(), DM, F.Wgt(), DM, Mrows, NGATE, DM, [=](int r, int c, float v) { G[(size_t)r * NGATE + c] = f2bf(sigmoidf_(v)); });
            phase_conv_b(F, l);
        }
        SEAM(pb + 5);
        if (EN(6) && IN(pb + 6)) { REFRESH(F);
            if (MF_MERGE) {
                pg::SchedMerge S{(const char*)F.BR(), (const char*)F.Wbrt(), (Mrows / 256) * 4, F.nb, F.bid}; pg::EpiMerge E{F.G(), F.HX()};
                pg::gemm_phase(stage, 2048, 512, 512, S, E);
            } else phase_merge_s(F, l);
        }
        SEAM(pb + 6);
        if (EN(7) && IN(pb + 7)) { REFRESH(F);
            float* outp = p.out; float* cxm = F.cxm(); const float* modv = F.modv() + (size_t)l * 5 * 6144;
            if (MF_WOUT) {
                pg::SchedStatic S{(const char*)F.HX(), (const char*)F.Woutt(), (size_t)256 * DM * 2, (size_t)256 * DM * 2, Mrows / 256, DM / 256, F.nb, F.bid};
                pg::EpiWout E{xlat, xctx, outp, cxm, modv};
                pg::gemm_phase(stage, DM, DM, DM, S, E);
            } else
            gemm_s(F, F.HX(), DM, F.Woutt(), DM, Mrows, DM, DM, [=](int r, int c, float v) {
                const float m2 = modv[(size_t)row_batch(r) * 6144 + 2 * 1024 + c];
                if (r < NTOK) outp[(size_t)r * DM + c] = ALPHA * xlat[(size_t)r * DM + c] + m2 * v;
                else cxm[(size_t)(r - NTOK) * DM + c] = ALPHA * xctx[(size_t)(r - NTOK) * DM + c] + m2 * v; });
        }
        SEAM(pb + 7);
        if (EN(8) && IN(pb + 8)) { REFRESH(F); phase_ln1(F, l); }
        SEAM(pb + 8);
        if (EN(9) && IN(pb + 9)) { REFRESH(F); phase_gather(F, l); }
        SEAM(pb + 9);
        if (EN(10) && IN(pb + 10)) { REFRESH(F);
            int* off = offt; moe_offsets(F, l, off);
            const int Mtot = off[32], nt = (Mtot / 128) * 4, ty = F.tid >> 5, tx = F.tid & 31; bf16_t* GU = F.BR();
            if (MF_MOE1) {
                pg::SchedMoe S{(const char*)F.XS(), (const char*)F.Wgu(), off, (size_t)256 * DM * 2, (size_t)512 * DM * 2, (size_t)256 * DM * 2, Mtot / 256, 2, F.nb, F.bid};
                pg::EpiMoe1 E{F.HID(), F.roww()};
                pg::gemm_phase(stage, DM, DM, DM, S, E);
            } else
            for (int t = F.bid; t < nt; t += F.nb) {
                const int row0 = (t >> 2) * 128, col0 = (t & 3) * 128, e = expert_of_row(off, row0);
                float acc[8][4];
#pragma unroll
                for (int i = 0; i < 8; ++i)
#pragma unroll
                    for (int j = 0; j < 4; ++j) acc[i][j] = 0.f;
                gemm_s_acc(acc, F.XS(), DM, F.Wgu() + (size_t)e * 512 * DM, DM, DM, row0, col0, F.smf, F.tid);
#pragma unroll
                for (int i = 0; i < 8; ++i)
#pragma unroll
                    for (int j = 0; j < 4; ++j) GU[(size_t)(row0 + ty * 8 + i) * 512 + col0 + tx * 4 + j] = f2bf(acc[i][j]);
            }
        }
        SEAM(pb + 10);
        if (EN(11) && IN(pb + 11) && !MF_MOE1) { REFRESH(F);
            int* off = (int*)F.smf; moe_offsets(F, l, off);
            const size_t total = (size_t)off[32] * 256; const bf16_t* GU = F.BR();
            for (size_t idx = (size_t)F.bid * NTHR + F.tid; idx < total; idx += (size_t)F.nb * NTHR) {
                const int r = (int)(idx >> 8), hc = (int)(idx & 255), j = hc >> 7, cc = hc & 127;
                const float g = bf2f(GU[(size_t)r * 512 + 256 * j + cc]), u = bf2f(GU[(size_t)r * 512 + 256 * j + 128 + cc]);
                F.HID()[(size_t)r * 256 + hc] = f2bf(siluf_(g) * u * F.roww()[r]);
            }
        }
        if (!MF_MOE1) SEAM(pb + 11);
        if (EN(12) && IN(pb + 12)) { REFRESH(F);
            int* off = offt; moe_offsets(F, l, off);
            const int Mtot = off[32], nt = (Mtot / 128) * 8, ty = F.tid >> 5, tx = F.tid & 31; bf16_t* Y = F.BR();
            if (MF_MOE2) {
                pg::SchedMoe S{(const char*)F.HID(), (const char*)F.Wd(), off, (size_t)256 * 256 * 2, (size_t)DM * 256 * 2, (size_t)256 * 256 * 2, Mtot / 256, 4, F.nb, F.bid};
                pg::EpiMoe2 E{Y, F.rmap(), (bf16_t*)(F.ws + WS_DUMP)};
                pg::gemm_phase(stage, 256, 256, 256, S, E);
            } else
            for (int t = F.bid; t < nt; t += F.nb) {
                const int row0 = (t >> 3) * 128, col0 = (t & 7) * 128, e = expert_of_row(off, row0);
                float acc[8][4];
#pragma unroll
                for (int i = 0; i < 8; ++i)
#pragma unroll
                    for (int j = 0; j < 4; ++j) acc[i][j] = 0.f;
                gemm_s_acc(acc, F.HID(), 256, F.Wd() + (size_t)e * DM * 256, 256, 256, row0, col0, F.smf, F.tid);
#pragma unroll
                for (int i = 0; i < 8; ++i) { const int s = F.rmap()[row0 + ty * 8 + i];
                    if (s >= 0) {
#pragma unroll
                        for (int j = 0; j < 4; ++j) Y[(size_t)s * DM + col0 + tx * 4 + j] = f2bf(acc[i][j]); } }
            }
        }
        SEAM(pb + 12);
        if (EN(13) && IN(pb + 13)) { REFRESH(F); phase_ln2(F, l); }
        SEAM(pb + 13);
    }
#undef IN
#undef SEAM
}

constexpr bool ONE_LAUNCH = true;
typedef void (*kern_t)(Params);
template <int I> struct KTab { static void fill(kern_t* t) { t[I] = mega<(1 << I)>; KTab<I - 1>::fill(t); } };
constexpr int GROUP_A = 0x4007;
template <> struct KTab<-1> { static void fill(kern_t*) {} };

extern "C" void kernel_launch(void* const* d_in, const int* in_sizes, int n_in, void* d_out, int out_size, void* d_ws, size_t ws_size, hipStream_t stream) {
    static int grid = 0;
    static kern_t ktab[16]; static kern_t kall = nullptr;
    if (grid == 0) {
        if (n_in != 23 || out_size != NTOK * DM || ws_size < WS_END) { fprintf(stderr, "kernel_launch: unexpected shapes (n_in %d out %d ws %zu need %zu)\n", n_in, out_size, ws_size, (size_t)WS_END); grid = -1; return; }
        int dev = 0, cus = 0;
        if (hipGetDevice(&dev) != hipSuccess || hipDeviceGetAttribute(&cus, hipDeviceAttributeMultiprocessorCount, dev) != hipSuccess) { grid = -1; return; }
        if (ONE_LAUNCH) {
            kall = mega<0x7FFF>;
            if (hipFuncSetAttribute((const void*)kall, hipFuncAttributeMaxDynamicSharedMemorySize, LDS_BYTES) != hipSuccess) { fprintf(stderr, "kernel_launch: hipFuncSetAttribute failed\n"); grid = -1; return; }
            int per_cu = 0;
            if (hipOccupancyMaxActiveBlocksPerMultiprocessor(&per_cu, (const void*)kall, NTHR, LDS_BYTES) != hipSuccess || per_cu < 1) { fprintf(stderr, "kernel_launch: occupancy query reports %d blocks per CU\n", per_cu); }
        } else {
            if constexpr (!ONE_LAUNCH) KTab<14>::fill(ktab);
            for (int i = 0; i < 15; ++i)
                if (hipFuncSetAttribute((const void*)ktab[i], hipFuncAttributeMaxDynamicSharedMemorySize, LDS_BYTES) != hipSuccess) { fprintf(stderr, "kernel_launch: hipFuncSetAttribute failed\n"); grid = -1; return; }
        }
        (void)hipGetLastError();
        grid = cus;
    }
    if (grid < 0) return;
    (void)hipMemsetAsync((char*)d_ws + WS_CTL, 0, CTL_BYTES, stream);
    Params p; memset(&p, 0, sizeof(p));
    const float** pp = (const float**)&p;
    for (int i = 0; i < 23; ++i) pp[i] = (const float*)d_in[i];
    p.out = (float*)d_out; p.ws = (unsigned char*)d_ws;
    if (ONE_LAUNCH) {
        p.ph_lo = 0; p.ph_hi = NPH;
        hipLaunchKernelGGL(kall, dim3(grid), dim3(NTHR), LDS_BYTES, stream, p);
    } else {
        for (int ph = 0; ph < NPH; ++ph) {
            p.ph_lo = ph; p.ph_hi = ph + 1;
            const int ki = (ph == 0) ? 14 : (ph - 1) % NPL;
            if (ki == 11 && MF_MOE1) continue;
            hipLaunchKernelGGL(ktab[ki], dim3(grid), dim3(NTHR), LDS_BYTES, stream, p);
        }
    }
}
```

```cpp
#include <hip/hip_runtime.h>
#include <cstdio>
#include <cstdint>
#include <cstring>

typedef unsigned short bf16_t;
typedef float f32x4 __attribute__((ext_vector_type(4)));
typedef unsigned u32x4 __attribute__((ext_vector_type(4)));
typedef unsigned u32x2 __attribute__((ext_vector_type(2)));

constexpr int NB = 4, SEQ = 4096, LC = 256, DM = 1024, DEPTH = 2;
constexpr int NTOK = NB * SEQ, NCTX = NB * LC, NROW = NTOK + NCTX;
constexpr int DIN = 10528;
constexpr int O_AQ = 0, O_AK = 256, O_AV = 512, O_AG = 1024, O_ALR = 1536, O_BQ = 1568, O_BK = 2080, O_BV = 2592, O_CQ = 3104, O_CK = 3616,
              O_CV = 3744, O_DQ = 3872, O_DF = 4384, O_DI = 5408, O_DG = 5920, O_GATE = 6432;
constexpr int PC_AQ = 0, PC_AK = 256, PC_AV = 512, PC_ALR = 1024, PC_BQ = 1280, PC_BK = 1792, PC_CQ = 2304, PC_CK = 2816, PC_DQ = 3072,
              PC_DF = 3584, PC_DI = 4608, PC_AG = 5120, PC_DG = 5632, NP1 = 6144;
constexpr int NVT = 768;
constexpr int NVR = 640;
constexpr int NGATE = 4096;
constexpr int XS_ROWS = 40960;
constexpr float LN_EPS = 1e-5f;
constexpr float ALPHA = 1.41421356237f;

constexpr size_t al256(size_t x) { return (x + 255) & ~(size_t)255; }
constexpr size_t WS_CTL = 0;
constexpr size_t CTL_BYTES = 32768;
constexpr size_t CTL_CNT = 28672;
constexpr size_t WS_DUMP = WS_CTL + CTL_BYTES;
constexpr size_t WS_MODV = WS_DUMP + 4096;
constexpr size_t WS_LB = WS_MODV + al256((size_t)DEPTH * 5 * 6144 * 4);
constexpr size_t WS_TOKE = WS_LB + 4096;
constexpr size_t WS_TOKI = WS_TOKE + al256((size_t)2 * NROW * 4);
constexpr size_t WS_TOKW = WS_TOKI + al256((size_t)2 * NROW * 4);
constexpr size_t WS_RMAP = WS_TOKW + al256((size_t)2 * NROW * 4);
constexpr size_t WS_ROWW = WS_RMAP + al256((size_t)XS_ROWS * 4);
constexpr size_t WS_CXM = WS_ROWW + al256((size_t)XS_ROWS * 4);
constexpr size_t WS_CXO = WS_CXM + (size_t)NCTX * DM * 4;
constexpr size_t WS_WTA = WS_CXO + (size_t)NCTX * DM * 4;
constexpr size_t WTA_W1 = 0;
constexpr size_t WTA_WV = WTA_W1 + (size_t)NP1 * DM * 2;
constexpr size_t WTA_WG = WTA_WV + (size_t)NVT * DM * 2;
constexpr size_t WTA_WBR = WTA_WG + (size_t)NGATE * DM * 2;
constexpr size_t WTA_WO = WTA_WBR + (size_t)4 * DM * 512 * 2;
constexpr size_t WTA_BYTES = WTA_WO + (size_t)DM * DM * 2;
constexpr size_t WS_HX = WS_WTA + WTA_BYTES;
constexpr size_t WS_VT = WS_HX + (size_t)NROW * DM * 2;
constexpr size_t WS_OBA = WS_VT + (size_t)NVT * NROW * 2;
constexpr size_t WS_HX2 = WS_VT;
constexpr size_t WS_HID = WS_VT;
constexpr size_t WS_VR = WS_OBA + (size_t)NROW * 512 * 2;
constexpr size_t WS_BR = WS_VR + (size_t)NROW * NVR * 2;
constexpr size_t WS_P1 = WS_BR + (size_t)NROW * 2048 * 2;
constexpr size_t WS_G = WS_P1;
constexpr size_t WS_WGU = WS_P1 + (size_t)NROW * NGATE * 2;
constexpr size_t WS_WD = WS_WGU + (size_t)32 * 512 * DM * 2;
constexpr size_t WS_XS = WS_P1;
constexpr size_t WS_END = WS_P1 + (size_t)NROW * NP1 * 2;
static_assert(WS_WD + (size_t)32 * DM * 256 * 2 <= WS_END, "moe weights must fit in the P1 tail");
static_assert((size_t)XS_ROWS * DM * 2 <= (size_t)NROW * NGATE * 2, "XS must fit in the G region");
static_assert((size_t)NVT * NROW * 2 + (size_t)NROW * 512 * 2 >= (size_t)NROW * DM * 2, "HX2 alias");
static_assert(WS_END <= 434800000ull, "workspace budget");

constexpr int NTHR = 512;
constexpr bool MF_ATTN = true;
constexpr int LDS_BYTES = 144 * 1024;

struct Params {
    const float *x, *c, *ctx, *c_ctx, *w_mod, *b_mod, *w_in, *gla_lr_w, *gla_lr_b, *hg_gamma, *na_rpb, *wa_sink, *w_branch, *w_out, *ln_g, *ln_b,
        *moe_w_group, *moe_b_group, *moe_w_expert, *moe_b_expert, *moe_w_gate, *moe_w_up, *moe_w_down;
    float* out;
    unsigned char* ws;
    int ph_lo, ph_hi;
};

__device__ __forceinline__ float bf2f(bf16_t b) { return __uint_as_float(((unsigned)b) << 16); }
__device__ __forceinline__ bf16_t f2bf(float f) { unsigned u = __float_as_uint(f); u += 0x7FFFu + ((u >> 16) & 1u); return (bf16_t)(u >> 16); }
typedef float f32x2_t __attribute__((ext_vector_type(2)));
typedef __bf16 bf16x2_t __attribute__((ext_vector_type(2)));
__device__ __forceinline__ unsigned pk2(float lo, float hi) {
    const f32x2_t v = {lo, hi}; const bf16x2_t b = __builtin_convertvector(v, bf16x2_t); return __builtin_bit_cast(unsigned, b); }
__device__ __forceinline__ void ld8(const bf16_t* p, float* f) {
    const u32x4 v = *(const u32x4*)p;
    f[0] = __uint_as_float(v.x << 16); f[1] = __uint_as_float(v.x & 0xffff0000u);
    f[2] = __uint_as_float(v.y << 16); f[3] = __uint_as_float(v.y & 0xffff0000u);
    f[4] = __uint_as_float(v.z << 16); f[5] = __uint_as_float(v.z & 0xffff0000u);
    f[6] = __uint_as_float(v.w << 16); f[7] = __uint_as_float(v.w & 0xffff0000u);
}
__device__ __forceinline__ void st8(bf16_t* p, const float* f) {
    u32x4 v; v.x = pk2(f[0], f[1]); v.y = pk2(f[2], f[3]); v.z = pk2(f[4], f[5]); v.w = pk2(f[6], f[7]);
    *(u32x4*)p = v;
}
__device__ __forceinline__ float sigmoidf_(float x) { return 1.f / (1.f + expf(-x)); }
__device__ __forceinline__ float siluf_(float x) { return x / (1.f + expf(-x)); }
__device__ __forceinline__ float wave_sum(float v) {
#pragma unroll
    for (int o = 1; o < 64; o <<= 1) v += __shfl_xor(v, o);
    return v;
}
__device__ __forceinline__ int row_batch(int row) { return row < NTOK ? (row >> 12) : 4; }

#define XB_TMO      128
#define XB_XCNT(j)  (256  + 64 * (j))
#define XB_XSUB(j)  (1280 + 64 * (j))
#define XB_XGEN(j)  (2304 + 64 * (j))
#define XB_TOP      3328
#define XB_TOPGEN   3392
#define XCD_BAR_WORDS 3456
#define XB_SPIN_CAP (1u << 18)
#define LAS __attribute__((address_space(3)))
__device__ __forceinline__ unsigned xb_ld(unsigned* p)              { return __hip_atomic_load(p, __ATOMIC_RELAXED, __HIP_MEMORY_SCOPE_AGENT); }
__device__ __forceinline__ unsigned xb_add(unsigned* p, unsigned v) { return __hip_atomic_fetch_add(p, v, __ATOMIC_RELAXED, __HIP_MEMORY_SCOPE_AGENT); }
__device__ __forceinline__ unsigned xb_xcc_id() { return (unsigned)__builtin_amdgcn_s_getreg((3 << 11) | 20) & 0xFu; }
#define XB_SPIN(cond, bar) do { unsigned _sp = 0; while (cond) { __builtin_amdgcn_s_sleep(1); \
    if ((++_sp & 255u) == 0u) { if (xb_ld(&(bar)[XB_TMO])) break; if (_sp > XB_SPIN_CAP) { atomicAdd(&(bar)[XB_TMO], 1u); break; } } } } while (0)
struct XcdBarrier { unsigned* bar; unsigned x; volatile LAS unsigned* st; };
__device__ __forceinline__ XcdBarrier xcd_barrier_post(unsigned* bar, volatile LAS unsigned* st) {
    XcdBarrier b; b.bar = bar; b.x = xb_xcc_id(); b.st = st;
    if (threadIdx.x == 0) (void)xb_add(&bar[XB_XCNT(b.x)], 1u);
    return b;
}
__device__ __forceinline__ void xcd_barrier_complete(unsigned* bar, unsigned x, unsigned& nloc, unsigned& nx) {
    const unsigned G = gridDim.x * gridDim.y * gridDim.z;
    unsigned sum, cnt, mine, sp = 0u;
    for (;;) {
        sum = 0u; cnt = 0u; mine = 0u;
#pragma unroll
        for (unsigned j = 0; j < 16; ++j) { const unsigned c = xb_ld(&bar[XB_XCNT(j)]); sum += c; cnt += (c > 0u) ? 1u : 0u; mine = (j == x) ? c : mine; }
        if (sum == G) break;
        __builtin_amdgcn_s_sleep(1);
        if ((++sp & 255u) == 0u) { if (xb_ld(&bar[XB_TMO])) break; if (sp > XB_SPIN_CAP) { atomicAdd(&bar[XB_TMO], 1u); break; } }
    }
    nloc = mine > 0u ? mine : 1u; nx = cnt > 0u ? cnt : 1u;
}
__device__ __forceinline__ void xcd_barrier(const XcdBarrier& b) {
    asm volatile("s_waitcnt vmcnt(0)" ::: "memory");
    __syncthreads();
    if (threadIdx.x == 0) {
        unsigned* bar = b.bar;
        __builtin_amdgcn_s_waitcnt(0);
        unsigned nloc = b.st[0], nx = b.st[1];
        if (nloc == 0u) { xcd_barrier_complete(bar, b.x, nloc, nx); b.st[0] = nloc; b.st[1] = nx; }
        const unsigned old = xb_add(&bar[XB_XSUB(b.x)], 1u);
        const unsigned gen = old / nloc;
        if (old + 1u == (gen + 1u) * nloc) {
            __builtin_amdgcn_fence(__ATOMIC_RELEASE, "agent");
            asm volatile("s_waitcnt vmcnt(0)" ::: "memory");
            const unsigned og = xb_add(&bar[XB_TOP], 1u);
            const unsigned tg = og / nx;
            if (og + 1u == (tg + 1u) * nx) xb_add(&bar[XB_TOPGEN], 1u);
            else XB_SPIN(xb_ld(&bar[XB_TOPGEN]) == tg, bar);
            __builtin_amdgcn_fence(__ATOMIC_ACQUIRE, "agent");
            xb_add(&bar[XB_XGEN(b.x)], 1u);
            asm volatile("s_waitcnt vmcnt(0)" ::: "memory");
        } else {
            XB_SPIN(xb_ld(&bar[XB_XGEN(b.x)]) == gen, bar);
            __builtin_amdgcn_fence(__ATOMIC_ACQUIRE, "agent");
            asm volatile("s_waitcnt vmcnt(0)" ::: "memory");
        }
    }
    __syncthreads();
}

struct Frame {
    Params p;
    int bid, nb, tid, lane, wave;
    float* smf;
    unsigned char* ws;
    __device__ __forceinline__ float* modv() const { return (float*)(ws + WS_MODV); }
    __device__ __forceinline__ float* lb() const { return (float*)(ws + WS_LB); }
    __device__ __forceinline__ int* tokE() const { return (int*)(ws + WS_TOKE); }
    __device__ __forceinline__ int* tokI() const { return (int*)(ws + WS_TOKI); }
    __device__ __forceinline__ float* tokW() const { return (float*)(ws + WS_TOKW); }
    __device__ __forceinline__ int* rmap() const { return (int*)(ws + WS_RMAP); }
    __device__ __forceinline__ float* roww() const { return (float*)(ws + WS_ROWW); }
    __device__ __forceinline__ float* cxm() const { return (float*)(ws + WS_CXM); }
    __device__ __forceinline__ float* cxo() const { return (float*)(ws + WS_CXO); }
    __device__ __forceinline__ bf16_t* W1t() const { return (bf16_t*)(ws + WS_WTA + WTA_W1); }
    __device__ __forceinline__ bf16_t* Wvt() const { return (bf16_t*)(ws + WS_WTA + WTA_WV); }
    __device__ __forceinline__ bf16_t* Wgt() const { return (bf16_t*)(ws + WS_WTA + WTA_WG); }
    __device__ __forceinline__ bf16_t* Wbrt() const { return (bf16_t*)(ws + WS_WTA + WTA_WBR); }
    __device__ __forceinline__ bf16_t* Woutt() const { return (bf16_t*)(ws + WS_WTA + WTA_WO); }
    __device__ __forceinline__ bf16_t* HX() const { return (bf16_t*)(ws + WS_HX); }
    __device__ __forceinline__ bf16_t* VT() const { return (bf16_t*)(ws + WS_VT); }
    __device__ __forceinline__ bf16_t* OBA() const { return (bf16_t*)(ws + WS_OBA); }
    __device__ __forceinline__ bf16_t* HX2() const { return (bf16_t*)(ws + WS_HX2); }
    __device__ __forceinline__ bf16_t* HID() const { return (bf16_t*)(ws + WS_HID); }
    __device__ __forceinline__ bf16_t* VR() const { return (bf16_t*)(ws + WS_VR); }
    __device__ __forceinline__ bf16_t* BR() const { return (bf16_t*)(ws + WS_BR); }
    __device__ __forceinline__ bf16_t* P1() const { return (bf16_t*)(ws + WS_P1); }
    __device__ __forceinline__ bf16_t* G() const { return (bf16_t*)(ws + WS_G); }
    __device__ __forceinline__ bf16_t* Wgu() const { return (bf16_t*)(ws + WS_WGU); }
    __device__ __forceinline__ bf16_t* Wd() const { return (bf16_t*)(ws + WS_WD); }
    __device__ __forceinline__ bf16_t* XS() const { return (bf16_t*)(ws + WS_XS); }
    __device__ __forceinline__ unsigned* cnt() const { return (unsigned*)(ws + WS_CTL + CTL_CNT); }
};


#define REFRESH(F) do { int _t = threadIdx.x; asm volatile("" : "+v"(_t)); (F).tid = _t; (F).lane = _t & 63; (F).wave = _t >> 6; } while (0)

__device__ __forceinline__ void phase_mod(Frame& F) {
    float* sc = F.smf;
    float* red = F.smf + 5 * 1024;
    bool have = false;
    for (int it = F.bid; it < DEPTH * 96; it += F.nb) {
        if (!have) {
            for (int i = F.tid; i < 5 * 1024; i += NTHR) { const float v = (i < 4096) ? F.p.c[i] : F.p.c_ctx[i - 4096]; sc[i] = siluf_(v); }
            __syncthreads(); have = true;
        }
        const int l = it / 96, n0 = (it % 96) * 64, col = F.tid & 63, kg = F.tid >> 6;
        const float* w = F.p.w_mod + (size_t)l * DM * 6144 + n0 + col;
        float a[5] = {0.f, 0.f, 0.f, 0.f, 0.f};
        for (int k = kg * 128; k < kg * 128 + 128; ++k) {
            const float wv = w[(size_t)k * 6144];
#pragma unroll
            for (int r = 0; r < 5; ++r) a[r] += sc[r * 1024 + k] * wv;
        }
#pragma unroll
        for (int r = 0; r < 5; ++r) red[(kg * 5 + r) * 64 + col] = a[r];
        __syncthreads();
        if (F.tid < 320) {
            const int r = F.tid >> 6, cc = F.tid & 63; float s = F.p.b_mod[l * 6144 + n0 + cc];
#pragma unroll
            for (int g = 0; g < 8; ++g) s += red[(g * 5 + r) * 64 + cc];
            F.modv()[((size_t)l * 5 + r) * 6144 + n0 + cc] = s;
        }
        __syncthreads();
    }
    if (F.bid == F.nb - 1) {
        for (int i = F.tid; i < 1024; i += NTHR) { const int z = i >> 9, f = i & 511;
            const float g0 = F.p.hg_gamma[(z * DEPTH + 0) * 512 + f], g1 = F.p.hg_gamma[(z * DEPTH + 1) * 512 + f];
            F.lb()[i] = 1.f / (1.f + expf(g0 - g1)); }
    }
}

__device__ __forceinline__ int p1_src(int n, float& scale) {
    scale = 1.f;
    if (n < 256) { scale = 0.125f; return O_AQ + n; }
    if (n < 512) return O_AK + (n - 256);
    if (n < 1024) return O_AV + (n - 512);
    if (n < 1056) return O_ALR + (n - 1024);
    if (n < 1280) return -1;
    if (n < 1792) { scale = 0.125f; return O_BQ + (n - 1280); }
    if (n < 2304) return O_BK + (n - 1792);
    if (n < 2816) { scale = 0.125f; return O_CQ + (n - 2304); }
    if (n < 2944) return O_CK + (n - 2816);
    if (n < 3072) return -1;
    if (n < 3584) return O_DQ + (n - 3072);
    if (n < 4608) return O_DF + (n - 3584);
    if (n < 5120) return O_DI + (n - 4608);
    if (n < 5632) return O_AG + (n - 5120);
    return O_DG + (n - 5632);
}
__device__ __forceinline__ void conv_item(const float* src, int ldsrc, int srccol, float scale, bf16_t* dst, int K, int k0, float* scr, int lane) {
    if (srccol >= 0) {
#pragma unroll 8
        for (int i = 0; i < 32; ++i) { const int kk = 2 * i + (lane >> 5); scr[kk * 33 + (lane & 31)] = src[(size_t)(k0 + kk) * ldsrc + srccol + (lane & 31)] * scale; }
    } else {
#pragma unroll 8
        for (int i = 0; i < 32; ++i) { const int kk = 2 * i + (lane >> 5); scr[kk * 33 + (lane & 31)] = 0.f; }
    }
    asm volatile("s_waitcnt lgkmcnt(0)" ::: "memory");
    const int c = lane & 7;
#pragma unroll
    for (int j = 0; j < 4; ++j) { const int nn = (lane >> 3) + 8 * j; const float* sp = scr + (8 * c) * 33 + nn;
        u32x4 o; o.x = pk2(sp[0 * 33], sp[1 * 33]); o.y = pk2(sp[2 * 33], sp[3 * 33]); o.z = pk2(sp[4 * 33], sp[5 * 33]); o.w = pk2(sp[6 * 33], sp[7 * 33]);
        *(u32x4*)(dst + (size_t)nn * K + 8 * c) = o; }
    asm volatile("s_waitcnt lgkmcnt(0)" ::: "memory");
}
constexpr int CONVA_ITEMS = 3072 + 384 + 2048 + 1024 + 512;
__device__ __forceinline__ void phase_conv_a(Frame& F, int l) {
    float* scr = F.smf + F.wave * (64 * 33);
    const int gw = F.bid * 8 + F.wave, ngw = F.nb * 8;
    for (int it0 = gw; it0 < CONVA_ITEMS; it0 += ngw) {
        int ti = it0;
        if (ti < 3072) { const int n0 = (ti >> 4) * 32, kt = ti & 15; float sc; const int sx = p1_src(n0, sc);
            conv_item(F.p.w_in + (size_t)l * DM * DIN, DIN, sx, sc, F.W1t() + (size_t)n0 * DM + kt * 64, DM, kt * 64, scr, F.lane); continue; }
        ti -= 3072;
        if (ti < 384) { const int n0 = (ti >> 4) * 32, kt = ti & 15; const int sx = n0 < 512 ? O_BV + n0 : (n0 < 640 ? O_CV + (n0 - 512) : -1);
            conv_item(F.p.w_in + (size_t)l * DM * DIN, DIN, sx, 1.f, F.Wvt() + (size_t)n0 * DM + kt * 64, DM, kt * 64, scr, F.lane); continue; }
        ti -= 384;
        if (ti < 2048) { const int n0 = (ti >> 4) * 32, kt = ti & 15;
            conv_item(F.p.w_in + (size_t)l * DM * DIN, DIN, O_GATE + n0, 1.f, F.Wgt() + (size_t)n0 * DM + kt * 64, DM, kt * 64, scr, F.lane); continue; }
        ti -= 2048;
        if (ti < 1024) { const int i = ti >> 8, r = ti & 255, n0 = (r >> 3) * 32, kt = r & 7;
            conv_item(F.p.w_branch + (size_t)(l * 4 + i) * 512 * DM, DM, n0, 1.f, F.Wbrt() + (size_t)i * DM * 512 + (size_t)n0 * 512 + kt * 64, 512, kt * 64, scr, F.lane); continue; }
        ti -= 1024;
        { const int n0 = (ti >> 4) * 32, kt = ti & 15;
          conv_item(F.p.w_out + (size_t)l * DM * DM, DM, n0, 1.f, F.Woutt() + (size_t)n0 * DM + kt * 64, DM, kt * 64, scr, F.lane); }
    }
}
constexpr int CONVB_ITEMS = 8192 + 4096;
__device__ __forceinline__ void phase_conv_b(Frame& F, int l) {
    float* scr = F.smf + F.wave * (64 * 33);
    const int gw = F.bid * 8 + F.wave, ngw = F.nb * 8;
    for (int it0 = gw; it0 < CONVB_ITEMS; it0 += ngw) {
        int ti = it0;
        if (ti < 8192) { const int e = ti >> 8, r = ti & 255, n0 = (r >> 4) * 32, kt = r & 15, j = n0 >> 8, rr = n0 & 255; const bool isup = rr >= 128; const int cc = 128 * j + (rr & 127);
            const float* src = (isup ? F.p.moe_w_up : F.p.moe_w_gate) + (size_t)(l * 32 + e) * DM * 256;
            conv_item(src, 256, cc, 1.f, F.Wgu() + (size_t)e * 512 * DM + (size_t)n0 * DM + kt * 64, DM, kt * 64, scr, F.lane); continue; }
        ti -= 8192;
        { const int e = ti >> 7, r = ti & 127, n0 = (r >> 2) * 32, kt = r & 3;
          conv_item(F.p.moe_w_down + (size_t)(l * 32 + e) * 256 * DM, DM, n0, 1.f, F.Wd() + (size_t)e * DM * 256 + (size_t)n0 * 256 + kt * 64, 256, kt * 64, scr, F.lane); }
    }
}

__device__ __forceinline__ void phase_prep(Frame& F, int l, const float* xlat, const float* xctx) {
    const int gw = F.bid * 8 + F.wave, ngw = F.nb * 8;
    for (int row = gw; row < NROW; row += ngw) {
        const float* xr = row < NTOK ? xlat + (size_t)row * DM : xctx + (size_t)(row - NTOK) * DM;
        const float* mv = F.modv() + ((size_t)l * 5 + row_batch(row)) * 6144;
#pragma unroll
        for (int j = 0; j < 4; ++j) { const int d = j * 256 + F.lane * 4;
            const f32x4 v = *(const f32x4*)(xr + d), m0 = *(const f32x4*)(mv + d), m1 = *(const f32x4*)(mv + 1024 + d);
            u32x2 o; o.x = pk2(v.x * (1.f + m1.x) + m0.x, v.y * (1.f + m1.y) + m0.y); o.y = pk2(v.z * (1.f + m1.z) + m0.z, v.w * (1.f + m1.w) + m0.w);
            *(u32x2*)(F.HX() + (size_t)row * DM + d) = o; }
    }
}

__device__ __forceinline__ void gemm_s_acc(float (&acc)[8][4], const bf16_t* A, int lda, const bf16_t* Bt, int ldb, int K, int row0, int col0, float* sm, int tid) {
    float* As = sm; float* Bs = sm + 32 * 132;
    const int ty = tid >> 5, tx = tid & 31, lr = tid >> 2, lk = (tid & 3) * 8;
    for (int k0 = 0; k0 < K; k0 += 32) {
        float fa[8], fb[8];
        ld8(A + (size_t)(row0 + lr) * lda + k0 + lk, fa);
        ld8(Bt + (size_t)(col0 + lr) * ldb + k0 + lk, fb);
        __syncthreads();
#pragma unroll
        for (int j = 0; j < 8; ++j) { As[(lk + j) * 132 + lr] = fa[j]; Bs[(lk + j) * 132 + lr] = fb[j]; }
        __syncthreads();
#pragma unroll 4
        for (int k = 0; k < 32; ++k) {
            const f32x4 a0 = *(const f32x4*)&As[k * 132 + ty * 8], a1 = *(const f32x4*)&As[k * 132 + ty * 8 + 4], b = *(const f32x4*)&Bs[k * 132 + tx * 4];
            const float a[8] = {a0.x, a0.y, a0.z, a0.w, a1.x, a1.y, a1.z, a1.w}; const float bb[4] = {b.x, b.y, b.z, b.w};
#pragma unroll
            for (int i = 0; i < 8; ++i)
#pragma unroll
                for (int j = 0; j < 4; ++j) acc[i][j] += a[i] * bb[j];
        }
    }
    __syncthreads();
}
template <class Epi>
__device__ __forceinline__ void gemm_s(Frame& F, const bf16_t* A, int lda, const bf16_t* Bt, int ldb, int M, int N, int K, const Epi& epi) {
    const int tn = N / 128, nt = (M / 128) * tn, ty = F.tid >> 5, tx = F.tid & 31;
    for (int t = F.bid; t < nt; t += F.nb) {
        const int row0 = (t / tn) * 128, col0 = (t % tn) * 128;
        float acc[8][4];
#pragma unroll
        for (int i = 0; i < 8; ++i)
#pragma unroll
            for (int j = 0; j < 4; ++j) acc[i][j] = 0.f;
        gemm_s_acc(acc, A, lda, Bt, ldb, K, row0, col0, F.smf, F.tid);
#pragma unroll
        for (int i = 0; i < 8; ++i)
#pragma unroll
            for (int j = 0; j < 4; ++j) epi(row0 + ty * 8 + i, col0 + tx * 4 + j, acc[i][j]);
    }
}


namespace pg {
typedef short bf16x8 __attribute__((ext_vector_type(8)));
constexpr int BM = 256, BK = 64, HALF = 128, HTB = HALF * BK * 2, STAGE_BYTES = 8 * HTB, NXCD = 8, WGM = 8;
__device__ __forceinline__ int lds_byte(int r, int c) { const int st = (r >> 4) * 2 + (c >> 5), rr = r & 15, cc = c & 31, ob = rr * 64 + cc * 2; return st * 1024 + (ob ^ (((ob >> 9) & 1) << 5)); }
__device__ __forceinline__ void stage_rc(int b, int& R, int& C) { const int st = b / 1024, sb = b % 1024, swz = sb ^ (((sb >> 9) & 1) << 5); R = (st >> 1) * 16 + swz / 64; C = (st & 1) * 32 + (swz % 64) / 2; }
struct Unit { const char* a; const char* b; int pm, pn, aux; };
__device__ __forceinline__ void static_map(int L, int nM, int nN, int& pm, int& pn) {
    const int nwg = nM * nN; int wgid = L; { const int q = nwg / NXCD, r = nwg % NXCD, xcd = wgid % NXCD, off = wgid / NXCD; wgid = (xcd < r ? xcd * (q + 1) : r * (q + 1) + (xcd - r) * q) + off; }
    const int nig = WGM * nN, gid = wgid / nig, fm = gid * WGM, gsz = (nM - fm) < WGM ? (nM - fm) : WGM;
    pm = fm + ((wgid % nig) % gsz); pn = (wgid % nig) / gsz;
}
template <class Epi, class Sched>
__device__ __forceinline__ void gemm_phase(LAS unsigned char* lds, const int lda, const int ldb, const int K, const Sched& S, const Epi& E) {
    int tid = threadIdx.x; asm volatile("" : "+v"(tid));
    const int wid = __builtin_amdgcn_readfirstlane(tid >> 6), lane = tid & 63, wr = wid >> 2, wc = wid & 3, fr = lane & 15, fq = lane >> 4;
    int nt = K / BK; asm volatile("" : "+s"(nt));
    unsigned voffA[2], voffB[2];
#pragma unroll
    for (int i = 0; i < 2; ++i) { int R, C; stage_rc(tid * 16 + i * 8192, R, C); voffA[i] = (unsigned)(R * lda + C) * 2u; voffB[i] = (unsigned)(R * ldb + C) * 2u; }
    const size_t kstep = (size_t)(BK * 2);
    const size_t hstepA = (size_t)HALF * lda * 2, hstepB = (size_t)HALF * ldb * 2;
    const unsigned ldsw = (unsigned)wid * 1024u;
    const int aoff = lds_byte(wr * 64 + fr, fq * 8), boff = lds_byte(wc * 32 + fr, fq * 8);
#define PG_SA(b, h) (((b) * 2 + (h)) * HTB)
#define PG_SB(b, h) ((4 + (b) * 2 + (h)) * HTB)
#define PG_STAGE(bufoff, gbase, voff) do { _Pragma("unroll") for (int _i = 0; _i < 2; ++_i) \
        __builtin_amdgcn_global_load_lds((const unsigned*)((const char*)(gbase) + (voff)[_i]), (LAS unsigned*)(lds + (bufoff) + ldsw + _i * 8192), 16, 0, 0); } while (0)
#define PG_LDA(dst, b, h) do { _Pragma("unroll") for (int m = 0; m < 4; ++m) _Pragma("unroll") for (int k = 0; k < 2; ++k) dst[m][k] = *(const LAS bf16x8*)(lds + PG_SA(b, h) + aoff + m * 2048 + k * 1024); } while (0)
#define PG_LDB(dst, b, h) do { _Pragma("unroll") for (int n = 0; n < 2; ++n) _Pragma("unroll") for (int k = 0; k < 2; ++k) dst[n][k] = *(const LAS bf16x8*)(lds + PG_SB(b, h) + boff + n * 2048 + k * 1024); } while (0)
#define PG_MMA(ai, bj, At, Bt) do { __builtin_amdgcn_s_setprio(1); _Pragma("unroll") for (int m = 0; m < 4; ++m) _Pragma("unroll") for (int n = 0; n < 2; ++n) _Pragma("unroll") for (int k = 0; k < 2; ++k) \
        acc[ai][bj][m][n] = __builtin_amdgcn_mfma_f32_16x16x32_bf16(Bt[n][k], At[m][k], acc[ai][bj][m][n], 0, 0, 0); __builtin_amdgcn_s_setprio(0); } while (0)
#define PG_WAIT_V(n) asm volatile("s_waitcnt vmcnt(" #n ")" ::: "memory")
#define PG_WAIT_L(n) asm volatile("s_waitcnt lgkmcnt(" #n ")" ::: "memory")
#define PG_BAR __builtin_amdgcn_s_barrier()
#define PG_SCHED __builtin_amdgcn_sched_barrier(0)
    Unit cur, nxt; int ui = 0;
    if (!S.next(0, cur)) return;
    f32x4 acc[2][2][4][2];
#pragma unroll
    for (int a = 0; a < 2; ++a)
#pragma unroll
        for (int b = 0; b < 2; ++b)
#pragma unroll
            for (int m = 0; m < 4; ++m)
#pragma unroll
                for (int n = 0; n < 2; ++n) acc[a][b][m][n] = (f32x4){0.f, 0.f, 0.f, 0.f};
    bf16x8 At[4][2], B0[2][2], B1[2][2];
    const char* cA = cur.a; const char* cB = cur.b;
    PG_STAGE(PG_SB(0, 0), cB, voffB); PG_STAGE(PG_SA(0, 0), cA, voffA); PG_STAGE(PG_SB(0, 1), cB + hstepB, voffB); PG_STAGE(PG_SA(0, 1), cA + hstepA, voffA);
    if (wr == 1) PG_BAR;
    PG_WAIT_V(4); PG_BAR;
    PG_STAGE(PG_SB(1, 0), cB + kstep, voffB); PG_STAGE(PG_SA(1, 0), cA + kstep, voffA); PG_STAGE(PG_SB(1, 1), cB + hstepB + kstep, voffB);
    PG_WAIT_V(6); PG_BAR;
    for (;;) {
        const bool has_next = S.next(ui + 1, nxt);
        const char* nA = has_next ? nxt.a : cA; const char* nB = has_next ? nxt.b : cB;
        for (int t = 0; t < nt; t += 2) {
            const bool last = (t == nt - 2);
            const char* a1 = cA + (size_t)(t + 1) * kstep;
            const char* a2 = last ? nA : cA + (size_t)(t + 2) * kstep; const char* b2 = last ? nB : cB + (size_t)(t + 2) * kstep;
            const char* a3 = a2 + kstep; const char* b3 = b2 + kstep;
            PG_LDB(B0, 0, 0); PG_SCHED; PG_LDA(At, 0, 0); PG_STAGE(PG_SA(1, 1), a1 + hstepA, voffA);
            PG_WAIT_L(8); PG_BAR; PG_WAIT_L(0); PG_MMA(0, 0, At, B0); PG_BAR; PG_SCHED;
            PG_LDB(B1, 0, 1); PG_STAGE(PG_SB(0, 0), b2, voffB);
            PG_BAR; PG_WAIT_L(0); PG_MMA(0, 1, At, B1); PG_BAR;
            PG_LDA(At, 0, 1); PG_STAGE(PG_SA(0, 0), a2, voffA);
            PG_BAR; PG_WAIT_L(0); PG_MMA(1, 0, At, B0); PG_BAR; PG_SCHED;
            PG_STAGE(PG_SB(0, 1), b2 + hstepB, voffB);
            PG_WAIT_V(6); PG_BAR; PG_MMA(1, 1, At, B1); PG_BAR;
            PG_LDB(B0, 1, 0); PG_SCHED; PG_LDA(At, 1, 0); PG_STAGE(PG_SA(0, 1), a2 + hstepA, voffA);
            PG_WAIT_L(8); PG_BAR; PG_WAIT_L(0); PG_MMA(0, 0, At, B0); PG_BAR; PG_SCHED;
            PG_LDB(B1, 1, 1); PG_STAGE(PG_SB(1, 0), b3, voffB);
            PG_BAR; PG_WAIT_L(0); PG_MMA(0, 1, At, B1); PG_BAR;
            PG_LDA(At, 1, 1); PG_STAGE(PG_SA(1, 0), a3, voffA);
            PG_BAR; PG_WAIT_L(0); PG_MMA(1, 0, At, B0); PG_BAR; PG_SCHED;
            PG_STAGE(PG_SB(1, 1), b3 + hstepB, voffB);
            PG_WAIT_V(6); PG_BAR; PG_MMA(1, 1, At, B1); PG_BAR;
        }
        E(acc, cur, wr, wc, fr, fq);
        if (!has_next) break;
#pragma unroll
        for (int a = 0; a < 2; ++a)
#pragma unroll
            for (int b = 0; b < 2; ++b)
#pragma unroll
                for (int m = 0; m < 4; ++m)
#pragma unroll
                    for (int n = 0; n < 2; ++n) acc[a][b][m][n] = (f32x4){0.f, 0.f, 0.f, 0.f};
        cur = nxt; cA = nA; cB = nB; ++ui;
    }
    PG_WAIT_V(0);
    if (wr == 0) PG_BAR;
    PG_BAR;
#undef PG_SA
#undef PG_SB
#undef PG_STAGE
#undef PG_LDA
#undef PG_LDB
#undef PG_MMA
#undef PG_WAIT_V
#undef PG_WAIT_L
#undef PG_BAR
#undef PG_SCHED
}

struct SchedG1 {
    const char *HX, *W1, *WV; int G, c;
    __device__ __forceinline__ bool next(int i, Unit& u) const {
        const int L = i * G + c, nmain = (NROW / 256) * (NP1 / 256);
        if (L < nmain) { static_map(L, NROW / 256, NP1 / 256, u.pm, u.pn); u.a = HX + (size_t)u.pm * 256 * DM * 2; u.b = W1 + (size_t)u.pn * 256 * DM * 2; u.aux = 0; return true; }
        const int idx = L - nmain; if (idx >= 3 * (NROW / 256)) return false;
        u.pm = idx % 3; u.pn = idx / 3; u.a = WV + (size_t)u.pm * 256 * DM * 2; u.b = HX + (size_t)u.pn * 256 * DM * 2; u.aux = 1; return true;
    }
};
struct SchedStatic {
    const char *A, *B; size_t tA, tB; int nM, nN, G, c;
    __device__ __forceinline__ bool next(int i, Unit& u) const {
        const int L = i * G + c; if (L >= nM * nN) return false;
        static_map(L, nM, nN, u.pm, u.pn); u.a = A + (size_t)u.pm * tA; u.b = B + (size_t)u.pn * tB; u.aux = 0; return true;
    }
};
struct SchedMerge {
    const char *BR, *W; int ntile, G, c;
    __device__ __forceinline__ bool next(int i, Unit& u) const {
        const int t = c + (i >> 2) * G; if (t >= ntile) return false;
        const int br = i & 3; u.pm = t >> 2; u.pn = t & 3; u.aux = br;
        u.a = BR + (size_t)u.pm * 256 * 2048 * 2 + (size_t)br * 512 * 2; u.b = W + (size_t)br * DM * 512 * 2 + (size_t)u.pn * 256 * 512 * 2; return true;
    }
};
struct SchedMoe {
    const char *A, *W; const int* off; size_t tA, wE, wT; int npan, NJ, G, c;
    __device__ __forceinline__ bool next(int i, Unit& u) const {
        const int L = i * G + c; if (L >= npan * NJ) return false;
        const int p = L / NJ, j = L % NJ; int e = 0;
#pragma unroll 1
        for (int q = 1; q < 32; ++q) if (p * 256 >= off[q]) e = q;
        e = __builtin_amdgcn_readfirstlane(e);
        u.pm = p; u.pn = j; u.aux = e; u.a = A + (size_t)p * tA; u.b = W + (size_t)e * wE + (size_t)j * wT; return true;
    }
};

#define PG_ROWCOL const int row0 = u.pm * BM + wr * 64 + fr, col0 = u.pn * BM + wc * 32 + 4 * fq
struct EpiG1 { bf16_t *P1, *VT; const float* rtab; const float* lbp; int layer;
    __device__ __forceinline__ void operator()(const f32x4 (&acc)[2][2][4][2], const Unit& u, int wr, int wc, int fr, int fq) const {
        PG_ROWCOL; bf16_t* base = u.aux ? VT : P1; const size_t ld = u.aux ? (size_t)NROW : (size_t)NP1;
        const int mode = u.aux ? 0 : ((u.pn >= 9 && u.pn <= 11) ? ((u.pm < NTOK / 256) ? 1 : 0) : ((u.pn == 12 || u.pn == 13) ? 2 : ((u.pn >= 14 && u.pn <= 17) ? 3 : 0)));
#pragma unroll
        for (int ai = 0; ai < 2; ++ai)
#pragma unroll
            for (int m = 0; m < 4; ++m) { const int r = row0 + ai * HALF + m * 16; bf16_t* rowp = base + (size_t)r * ld + col0;
#pragma unroll
                for (int bj = 0; bj < 2; ++bj) {
                    f32x4 v0 = acc[ai][bj][m][0], v1 = acc[ai][bj][m][1];
                    if (mode == 1) {
                        const int pos = r & (SEQ - 1), pp = (wc & 1) ? (pos & 63) : (pos >> 6); const float* tp = rtab + (pp * 16 + 4 * fq) * 2;
                        const f32x4 t0 = *(const f32x4*)tp, t1 = *(const f32x4*)(tp + 4);
                        const f32x4 a = v0, b = v1;
                        v0.x = a.x * t0.x - b.x * t0.y; v1.x = a.x * t0.y + b.x * t0.x; v0.y = a.y * t0.z - b.y * t0.w; v1.y = a.y * t0.w + b.y * t0.z;
                        v0.z = a.z * t1.x - b.z * t1.y; v1.z = a.z * t1.y + b.z * t1.x; v0.w = a.w * t1.z - b.w * t1.w; v1.w = a.w * t1.w + b.w * t1.z;
                    } else if (mode == 2) {
#pragma unroll
                        for (int j = 0; j < 4; ++j) { v0[j] = v0[j] * __builtin_amdgcn_rcpf(1.f + __expf(-v0[j])); v1[j] = v1[j] * __builtin_amdgcn_rcpf(1.f + __expf(-v1[j])); }
                    } else if (mode == 3) {
                        const int z = (u.pn - 14) >> 1, cb = z * 512 + ((u.pn - 14) & 1) * 256 + bj * HALF + wc * 32 + 4 * fq;
#pragma unroll
                        for (int n = 0; n < 2; ++n)
#pragma unroll
                            for (int j = 0; j < 4; ++j) { const float f = n ? v1[j] : v0[j]; const float t = __expf(-fabsf(f)), rr = __builtin_amdgcn_rcpf(1.f + t); float gq;
                                if (layer == 0) gq = fminf(f, 0.f) + __logf(rr);
                                else { const float lb = lbp[cb + 16 * n + j]; gq = __logf(lb + (1.f - lb) * ((f >= 0.f) ? rr : t * rr)); }
                                if (n) v1[j] = gq; else v0[j] = gq; }
                    }
                    u32x2 o; o.x = pk2(v0.x, v0.y); o.y = pk2(v0.z, v0.w); *(u32x2*)(rowp + bj * HALF) = o;
                    o.x = pk2(v1.x, v1.y); o.y = pk2(v1.z, v1.w); *(u32x2*)(rowp + bj * HALF + 16) = o; } }
    }
};
struct EpiGate { bf16_t* G;
    __device__ __forceinline__ void operator()(const f32x4 (&acc)[2][2][4][2], const Unit& u, int wr, int wc, int fr, int fq) const {
        PG_ROWCOL;
#pragma unroll
        for (int ai = 0; ai < 2; ++ai)
#pragma unroll
            for (int m = 0; m < 4; ++m) { bf16_t* rowp = G + (size_t)(row0 + ai * HALF + m * 16) * NGATE + col0;
#pragma unroll
                for (int bj = 0; bj < 2; ++bj)
#pragma unroll
                    for (int n = 0; n < 2; ++n) { const f32x4 v = acc[ai][bj][m][n]; u32x2 o; o.x = pk2(sigmoidf_(v.x), sigmoidf_(v.y)); o.y = pk2(sigmoidf_(v.z), sigmoidf_(v.w)); *(u32x2*)(rowp + bj * HALF + n * 16) = o; } }
    }
};
struct EpiMerge { const bf16_t* G; bf16_t* O;
    __device__ __forceinline__ void operator()(const f32x4 (&acc)[2][2][4][2], const Unit& u, int wr, int wc, int fr, int fq) const {
        PG_ROWCOL; const int br = u.aux;
#pragma unroll
        for (int ai = 0; ai < 2; ++ai)
#pragma unroll
            for (int m = 0; m < 4; ++m) { const size_t r = (size_t)(row0 + ai * HALF + m * 16); bf16_t* rowp = O + r * DM + col0; const bf16_t* gp = G + r * NGATE + br * 1024 + col0;
#pragma unroll
                for (int bj = 0; bj < 2; ++bj)
#pragma unroll
                    for (int n = 0; n < 2; ++n) { const f32x4 v = acc[ai][bj][m][n]; const u32x2 g2 = *(const u32x2*)(gp + bj * HALF + n * 16);
                        f32x4 w; w.x = __uint_as_float(g2.x << 16) * v.x; w.y = __uint_as_float(g2.x & 0xffff0000u) * v.y; w.z = __uint_as_float(g2.y << 16) * v.z; w.w = __uint_as_float(g2.y & 0xffff0000u) * v.w;
                        if (br != 0) { const u32x2 o2 = *(const u32x2*)(rowp + bj * HALF + n * 16);
                            w.x += __uint_as_float(o2.x << 16); w.y += __uint_as_float(o2.x & 0xffff0000u); w.z += __uint_as_float(o2.y << 16); w.w += __uint_as_float(o2.y & 0xffff0000u); }
                        u32x2 o; o.x = pk2(w.x, w.y); o.y = pk2(w.z, w.w); *(u32x2*)(rowp + bj * HALF + n * 16) = o; }
                asm volatile("" ::: "memory"); }
    }
};
struct EpiWout { const float *xlat, *xctx; float *olat, *octx; const float* modl;
    __device__ __forceinline__ void operator()(const f32x4 (&acc)[2][2][4][2], const Unit& u, int wr, int wc, int fr, int fq) const {
        PG_ROWCOL; const bool lat = u.pm < NTOK / 256; const int rb = lat ? (u.pm >> 4) : 4;
        const float* xin = lat ? xlat : xctx - (size_t)NTOK * DM; float* xo = lat ? olat : octx - (size_t)NTOK * DM; const float* m2 = modl + (size_t)rb * 6144 + 2 * 1024 + col0;
        f32x4 mv[2][2];
#pragma unroll
        for (int bj = 0; bj < 2; ++bj)
#pragma unroll
            for (int n = 0; n < 2; ++n) mv[bj][n] = *(const f32x4*)(m2 + bj * HALF + n * 16);
#pragma unroll
        for (int ai = 0; ai < 2; ++ai)
#pragma unroll
            for (int m = 0; m < 4; ++m) { const size_t o = (size_t)(row0 + ai * HALF + m * 16) * DM + col0;
#pragma unroll
                for (int bj = 0; bj < 2; ++bj)
#pragma unroll
                    for (int n = 0; n < 2; ++n) { const f32x4 xv = *(const f32x4*)(xin + o + bj * HALF + n * 16); *(f32x4*)(xo + o + bj * HALF + n * 16) = ALPHA * xv + mv[bj][n] * acc[ai][bj][m][n]; }
                asm volatile("" ::: "memory"); }
    }
};
struct EpiMoe1 { bf16_t* HID; const float* roww;
    __device__ __forceinline__ void operator()(const f32x4 (&acc)[2][2][4][2], const Unit& u, int wr, int wc, int fr, int fq) const {
        const int row0 = u.pm * BM + wr * 64 + fr, hc0 = u.pn * 128 + wc * 32 + 4 * fq;
#pragma unroll
        for (int ai = 0; ai < 2; ++ai)
#pragma unroll
            for (int m = 0; m < 4; ++m) { const int r = row0 + ai * HALF + m * 16; const float w = roww[r];
#pragma unroll
                for (int n = 0; n < 2; ++n) { const f32x4 g = acc[ai][0][m][n], up = acc[ai][1][m][n]; u32x2 o;
                    o.x = pk2(siluf_(g.x) * up.x * w, siluf_(g.y) * up.y * w); o.y = pk2(siluf_(g.z) * up.z * w, siluf_(g.w) * up.w * w);
                    *(u32x2*)(HID + (size_t)r * 256 + hc0 + n * 16) = o; } }
    }
};
struct EpiMoe2 { bf16_t* Y; const int* rmap; bf16_t* dump;
    __device__ __forceinline__ void operator()(const f32x4 (&acc)[2][2][4][2], const Unit& u, int wr, int wc, int fr, int fq) const {
        PG_ROWCOL;
#pragma unroll
        for (int ai = 0; ai < 2; ++ai)
#pragma unroll
            for (int m = 0; m < 4; ++m) { const int s = rmap[row0 + ai * HALF + m * 16];
                bf16_t* rowp = (s >= 0 ? Y + (size_t)s * DM : dump) + col0;
#pragma unroll
                for (int bj = 0; bj < 2; ++bj)
#pragma unroll
                    for (int n = 0; n < 2; ++n) { const f32x4 v = acc[ai][bj][m][n]; u32x2 o; o.x = pk2(v.x, v.y); o.y = pk2(v.z, v.w); *(u32x2*)(rowp + bj * HALF + n * 16) = o; } }
    }
};
#undef PG_ROWCOL
}

__device__ __forceinline__ void moe_offsets(Frame& F, int l, int* off) {
    if (F.tid == 0) { int a = 0; for (int e = 0; e < 32; ++e) { off[e] = a; a += ((int)F.cnt()[l * 32 + e] + 255) & ~255; } off[32] = a; }
    __syncthreads();
}

__device__ __forceinline__ void phase_rope(Frame& F) {
    float* tab = F.smf;
    for (int e = F.tid; e < 1024; e += NTHR) { const int pp = e >> 4, i = e & 15; const float inv = powf(10000.f, -(float)i / 16.f), ang = (float)pp * inv; tab[2 * e] = cosf(ang); tab[2 * e + 1] = sinf(ang); }
    __syncthreads();
    const size_t total = (size_t)NTOK * 320;
    for (size_t idx = (size_t)F.bid * NTHR + F.tid; idx < total; idx += (size_t)F.nb * NTHR) {
        const int row = (int)(idx / 320), r = (int)(idx % 320), h = r >> 5, half = (r >> 4) & 1, i = r & 15;
        const int pos = row & (SEQ - 1), pp = half ? (pos & 63) : (pos >> 6);
        const float cs = tab[2 * (pp * 16 + i)], sn = tab[2 * (pp * 16 + i) + 1];
        bf16_t* base = F.P1() + (size_t)row * NP1 + (h < 8 ? PC_CQ + h * 64 : PC_CK + (h - 8) * 64) + half * 32 + i;
        const float u1 = bf2f(base[0]), u2 = bf2f(base[16]);
        base[0] = f2bf(u1 * cs - u2 * sn); base[16] = f2bf(u1 * sn + u2 * cs);
    }
}

__device__ __forceinline__ int seq_row(int s, int b, int z) {
    if (s < LC) { const int tc = z ? (LC - 1 - s) : s; return NTOK + b * LC + tc; }
    const int tl = s - LC, t = z ? (SEQ - 1 - tl) : tl; return b * SEQ + t;
}
template <int DK, bool HG>
__device__ __forceinline__ void scan_simple(Frame& F, int l, int b, int h, int z) {
    constexpr int DPB = DK / 4;
    float* eg = F.smf; float* kk = eg + 16 * DK; float* qq = kk + 16 * DK; float* vv = qq + 16 * DK; float* op = vv + 16 * 128;
    const int tid = F.tid, v = tid & 127, db = tid >> 7;
    float S[DPB];
#pragma unroll
    for (int i = 0; i < DPB; ++i) S[i] = 0.f;
    for (int step = 0; step < (LC + SEQ) / 16; ++step) {
        for (int idx = tid; idx < 16 * DK; idx += NTHR) {
            const int i = idx / DK, d = idx % DK, row = seq_row(step * 16 + i, b, z);
            const bf16_t* pr = F.P1() + (size_t)row * NP1;
            float e, k, q;
            if (HG) {
                const float f = bf2f(pr[PC_DF + z * 512 + h * 128 + d]), sg = sigmoidf_(f), lbv = (l == 0) ? 0.f : F.lb()[z * 512 + h * 128 + d];
                const float fg = lbv + (1.f - lbv) * sg; e = fg; k = (1.f - lbv) * (1.f - sg);
                q = siluf_(bf2f(pr[PC_DQ + h * 128 + d]));
            } else {
                float lg = F.p.gla_lr_b[(l * 2 + z) * 256 + h * 64 + d];
#pragma unroll
                for (int r = 0; r < 16; ++r) lg += bf2f(pr[PC_ALR + z * 16 + r]) * F.p.gla_lr_w[((size_t)(l * 2 + z) * 16 + r) * 256 + h * 64 + d];
                const float ls = fminf(lg, 0.f) - log1pf(expf(-fabsf(lg)));
                e = expf(ls * (1.f / 16.f)); k = bf2f(pr[PC_AK + h * 64 + d]); q = bf2f(pr[PC_AQ + h * 64 + d]);
            }
            eg[idx] = e; kk[idx] = k; qq[idx] = q;
        }
        for (int idx = tid; idx < 16 * 128; idx += NTHR) {
            const int i = idx >> 7, c = idx & 127, row = seq_row(step * 16 + i, b, z);
            vv[idx] = bf2f(F.P1()[(size_t)row * NP1 + (HG ? PC_DI : PC_AV) + h * 128 + c]);
        }
        __syncthreads();
        for (int i = 0; i < 16; ++i) {
            const float vval = vv[i * 128 + v]; float o = 0.f;
#pragma unroll
            for (int dd = 0; dd < DPB; ++dd) { const int d = db * DPB + dd; S[dd] = eg[i * DK + d] * S[dd] + kk[i * DK + d] * vval; o += S[dd] * qq[i * DK + d]; }
            op[(i * 4 + db) * 128 + v] = o;
        }
        __syncthreads();
        for (int idx = tid; idx < 16 * 128; idx += NTHR) {
            const int i = idx >> 7, c = idx & 127, row = seq_row(step * 16 + i, b, z);
            const float o = op[(i * 4 + 0) * 128 + c] + op[(i * 4 + 1) * 128 + c] + op[(i * 4 + 2) * 128 + c] + op[(i * 4 + 3) * 128 + c];
            bf16_t* dst;
            if (HG) dst = F.P1() + (size_t)row * NP1 + PC_DF + z * 512 + h * 128 + c;
            else dst = (z == 0) ? F.BR() + (size_t)row * 2048 + h * 128 + c : F.OBA() + (size_t)row * 512 + h * 128 + c;
            *dst = f2bf(o);
        }
        __syncthreads();
    }
}

struct AttnAcc { float m, l; float o[64]; };
__device__ __forceinline__ void attn_key(const float (&q)[64], AttnAcc& a, const bf16_t* kp, const bf16_t* vp, float bias) {
    float s = bias;
#pragma unroll
    for (int c = 0; c < 8; ++c) { float f[8]; ld8(kp + c * 8, f);
#pragma unroll
        for (int j = 0; j < 8; ++j) s += q[c * 8 + j] * f[j]; }
    if (s > a.m) { const float sc = expf(a.m - s); a.l *= sc;
#pragma unroll
        for (int i = 0; i < 64; ++i) a.o[i] *= sc;
        a.m = s; }
    const float pr = expf(s - a.m); a.l += pr;
#pragma unroll
    for (int c = 0; c < 8; ++c) { float f[8]; ld8(vp + c * 8, f);
#pragma unroll
        for (int j = 0; j < 8; ++j) a.o[c * 8 + j] += pr * f[j]; }
}
__device__ __forceinline__ void attn_init(AttnAcc& a) { a.m = -1e30f; a.l = 0.f;
#pragma unroll
    for (int i = 0; i < 64; ++i) a.o[i] = 0.f; }
__device__ __forceinline__ void attn_loadq(float (&q)[64], const bf16_t* qp) {
#pragma unroll
    for (int c = 0; c < 8; ++c) ld8(qp + c * 8, &q[c * 8]); }
__device__ __forceinline__ void attn_store(const AttnAcc& a, bf16_t* op) {
    const float il = 1.f / a.l;
#pragma unroll
    for (int c = 0; c < 8; ++c) { float t[8];
#pragma unroll
        for (int j = 0; j < 8; ++j) t[j] = a.o[c * 8 + j] * il;
        st8(op + c * 8, t); } }

template <int kind>
__device__ __forceinline__ void attn_simple(Frame& F, int l, int item) {
    const int c = F.tid & 63, h = F.tid >> 6;
    float q[64]; AttnAcc a; attn_init(a);
    if (kind == 0) {
        const int b = item >> 6, r = item & 63, row = b * SEQ + r * 64 + c;
        attn_loadq(q, F.P1() + (size_t)row * NP1 + PC_BQ + h * 64);
        const int rs = min(max(r - 4, 0), 56), cs = min(max(c - 8, 0), 48);
        for (int kr = rs; kr < rs + 8; ++kr) {
            const float* bp = F.p.na_rpb + ((size_t)(l * 8 + h) * 15 + (kr - r + 7)) * 31 + (cs - c + 15);
            for (int kc = 0; kc < 16; ++kc) { const int krow = b * SEQ + kr * 64 + cs + kc;
                attn_key(q, a, F.P1() + (size_t)krow * NP1 + PC_BK + h * 64, F.VR() + (size_t)krow * NVR + h * 64, bp[kc]); }
        }
        for (int n = 0; n < LC; ++n) { const int crow = NTOK + b * LC + n;
            attn_key(q, a, F.P1() + (size_t)crow * NP1 + PC_BK + h * 64, F.VR() + (size_t)crow * NVR + h * 64, 0.f); }
        attn_store(a, F.BR() + (size_t)row * 2048 + 512 + h * 64);
    } else if (kind == 1) {
        const int b = item >> 6, g = item & 63, t = g * 64 + c, row = b * SEQ + t, kvh = h >> 2;
        attn_loadq(q, F.P1() + (size_t)row * NP1 + PC_CQ + h * 64);
        const int j0 = max(t - 128, 0), j1 = min(t + 128, SEQ - 1);
        for (int j = j0; j <= j1; ++j) { const int krow = b * SEQ + j;
            attn_key(q, a, F.P1() + (size_t)krow * NP1 + PC_CK + kvh * 64, F.VR() + (size_t)krow * NVR + 512 + kvh * 64, 0.f); }
        for (int n = 0; n < LC; ++n) { const int crow = NTOK + b * LC + n;
            attn_key(q, a, F.P1() + (size_t)crow * NP1 + PC_CK + kvh * 64, F.VR() + (size_t)crow * NVR + 512 + kvh * 64, 0.f); }
        const float sk = F.p.wa_sink[l * 8 + h];
        if (sk > a.m) { const float sc = expf(a.m - sk); a.l *= sc;
#pragma unroll
            for (int i = 0; i < 64; ++i) a.o[i] *= sc;
            a.m = sk; }
        a.l += expf(sk - a.m);
        attn_store(a, F.BR() + (size_t)row * 2048 + 1024 + h * 64);
    } else {
        const int b = item >> 2, g = item & 3, qrow = NTOK + b * LC + g * 64 + c, kvh = h >> 2;
        const int qc = (kind == 2) ? PC_BQ + h * 64 : PC_CQ + h * 64, kc = (kind == 2) ? PC_BK + h * 64 : PC_CK + kvh * 64, vc = (kind == 2) ? h * 64 : 512 + kvh * 64;
        attn_loadq(q, F.P1() + (size_t)qrow * NP1 + qc);
        for (int n = 0; n < LC; ++n) { const int crow = NTOK + b * LC + n;
            attn_key(q, a, F.P1() + (size_t)crow * NP1 + kc, F.VR() + (size_t)crow * NVR + vc, 0.f); }
        if (kind == 3) { const float sk = F.p.wa_sink[l * 8 + h];
            if (sk > a.m) { const float sc = expf(a.m - sk); a.l *= sc;
#pragma unroll
                for (int i = 0; i < 64; ++i) a.o[i] *= sc;
                a.m = sk; }
            a.l += expf(sk - a.m); }
        attn_store(a, F.BR() + (size_t)qrow * 2048 + (kind == 2 ? 512 : 1024) + h * 64);
    }
}


typedef short bf16x8_t __attribute__((ext_vector_type(8)));
typedef short bf16x4_t __attribute__((ext_vector_type(4)));
struct AttW { float m, l; f32x4 o[4]; };
template <class MaskF>
__device__ __forceinline__ void attn_step(AttW& a, const bf16x8_t (&qb)[2], const bf16_t* kp0, const bf16_t* kp1, const bf16_t* vp0, const bf16_t* vp1, const MaskF& maskf) {
    const bf16x8_t ka0 = *(const bf16x8_t*)kp0, ka1 = *(const bf16x8_t*)(kp0 + 32), kb0 = *(const bf16x8_t*)kp1, kb1 = *(const bf16x8_t*)(kp1 + 32);
    bf16x4_t va[4][2];
#pragma unroll
    for (int t = 0; t < 4; ++t) { va[t][0] = *(const bf16x4_t*)(vp0 + (size_t)t * 16 * NROW); va[t][1] = *(const bf16x4_t*)(vp1 + (size_t)t * 16 * NROW); }
    f32x4 s0 = {0.f, 0.f, 0.f, 0.f}, s1 = {0.f, 0.f, 0.f, 0.f};
    s0 = __builtin_amdgcn_mfma_f32_16x16x32_bf16(ka0, qb[0], s0, 0, 0, 0); s0 = __builtin_amdgcn_mfma_f32_16x16x32_bf16(ka1, qb[1], s0, 0, 0, 0);
    s1 = __builtin_amdgcn_mfma_f32_16x16x32_bf16(kb0, qb[0], s1, 0, 0, 0); s1 = __builtin_amdgcn_mfma_f32_16x16x32_bf16(kb1, qb[1], s1, 0, 0, 0);
    maskf(s0, s1);
    float mx = fmaxf(fmaxf(fmaxf(s0.x, s0.y), fmaxf(s0.z, s0.w)), fmaxf(fmaxf(s1.x, s1.y), fmaxf(s1.z, s1.w)));
    mx = fmaxf(mx, __shfl_xor(mx, 16)); mx = fmaxf(mx, __shfl_xor(mx, 32));
    const float mn = fmaxf(a.m, mx), alpha = __expf(a.m - mn); a.m = mn;
    f32x4 p0, p1;
    p0.x = __expf(s0.x - mn); p0.y = __expf(s0.y - mn); p0.z = __expf(s0.z - mn); p0.w = __expf(s0.w - mn);
    p1.x = __expf(s1.x - mn); p1.y = __expf(s1.y - mn); p1.z = __expf(s1.z - mn); p1.w = __expf(s1.w - mn);
    a.l = a.l * alpha + ((p0.x + p0.y) + (p0.z + p0.w)) + ((p1.x + p1.y) + (p1.z + p1.w));
    union { bf16x8_t v; unsigned u[4]; } pb;
    pb.u[0] = pk2(p0.x, p0.y); pb.u[1] = pk2(p0.z, p0.w); pb.u[2] = pk2(p1.x, p1.y); pb.u[3] = pk2(p1.z, p1.w);
#pragma unroll
    for (int t = 0; t < 4; ++t) {
        union { bf16x8_t v; bf16x4_t h[2]; } av; av.h[0] = va[t][0]; av.h[1] = va[t][1];
        a.o[t] = a.o[t] * alpha;
        a.o[t] = __builtin_amdgcn_mfma_f32_16x16x32_bf16(av.v, pb.v, a.o[t], 0, 0, 0);
    }
}
struct MaskNone { __device__ __forceinline__ void operator()(f32x4&, f32x4&) const {} };
struct MaskNA { int c, csq, kc0; const float* brow;
    __device__ __forceinline__ void operator()(f32x4& s0, f32x4& s1) const {
        float v[8] = {s0.x, s0.y, s0.z, s0.w, s1.x, s1.y, s1.z, s1.w};
#pragma unroll
        for (int T = 0; T < 2; ++T)
#pragma unroll
            for (int rr = 0; rr < 4; ++rr) { const int kc = kc0 + 16 * T + rr; const bool ok = (kc >= csq) && (kc <= csq + 15);
                const float bias = brow[min(max(kc - c + 15, 0), 30)]; v[T * 4 + rr] = ok ? v[T * 4 + rr] + bias : -INFINITY; }
        s0 = (f32x4){v[0], v[1], v[2], v[3]}; s1 = (f32x4){v[4], v[5], v[6], v[7]};
    }
};
struct MaskWA { int i, j0;
    __device__ __forceinline__ void operator()(f32x4& s0, f32x4& s1) const {
        float v[8] = {s0.x, s0.y, s0.z, s0.w, s1.x, s1.y, s1.z, s1.w};
#pragma unroll
        for (int T = 0; T < 2; ++T)
#pragma unroll
            for (int rr = 0; rr < 4; ++rr) { const int j = j0 + 16 * T + rr; const bool ok = (j >= 0) && (j < SEQ) && (i - j <= 128) && (j - i <= 128);
                v[T * 4 + rr] = ok ? v[T * 4 + rr] : -INFINITY; }
        s0 = (f32x4){v[0], v[1], v[2], v[3]}; s1 = (f32x4){v[4], v[5], v[6], v[7]};
    }
};
template <int kind>
__device__ __forceinline__ void attn_wave(Frame& F, int l, int item, const float* rpb_s) {
    const int lane = F.lane, n = lane & 15, g = lane >> 4;
    const bf16_t* P1 = F.P1(); const bf16_t* VT = F.VT();
    int b, h, qrow0, kcol, vrow, qcol, brcol;
    int r = 0, cb = 0, t0 = 0;
    if (kind == 0) { cb = item & 3; r = (item >> 2) & 63; h = (item >> 8) & 7; b = item >> 11; qrow0 = b * SEQ + r * 64 + cb * 16; qcol = PC_BQ + h * 64; kcol = PC_BK + h * 64; vrow = h * 64; brcol = 512 + h * 64; }
    else if (kind == 1) { const int hq = item & 3, qt = (item >> 2) & 255, kvh = (item >> 10) & 1; b = item >> 11; h = kvh * 4 + hq; t0 = qt * 16; qrow0 = b * SEQ + t0; qcol = PC_CQ + h * 64; kcol = PC_CK + kvh * 64; vrow = 512 + kvh * 64; brcol = 1024 + h * 64; }
    else if (kind == 2) { const int qt = item & 15; h = (item >> 4) & 7; b = item >> 7; qrow0 = NTOK + b * LC + qt * 16; qcol = PC_BQ + h * 64; kcol = PC_BK + h * 64; vrow = h * 64; brcol = 512 + h * 64; }
    else { const int hq = item & 3, qt = (item >> 2) & 15, kvh = (item >> 6) & 1; b = item >> 7; h = kvh * 4 + hq; qrow0 = NTOK + b * LC + qt * 16; qcol = PC_CQ + h * 64; kcol = PC_CK + kvh * 64; vrow = 512 + kvh * 64; brcol = 1024 + h * 64; }
    bf16x8_t qb[2];
    { const bf16_t* qp = P1 + (size_t)(qrow0 + n) * NP1 + qcol + 8 * g; qb[0] = *(const bf16x8_t*)qp; qb[1] = *(const bf16x8_t*)(qp + 32); }
    AttW a; a.m = -1e30f; a.l = 0.f;
#pragma unroll
    for (int t = 0; t < 4; ++t) a.o[t] = (f32x4){0.f, 0.f, 0.f, 0.f};
    const bf16_t* vbase = VT + (size_t)(vrow + n) * NROW + 4 * g;
    {   const int crow0 = NTOK + b * LC;
#pragma unroll 2
        for (int s = 0; s < 8; ++s) {
            const bf16_t* kp0 = P1 + (size_t)(crow0 + 32 * s + n) * NP1 + kcol + 8 * g;
            attn_step(a, qb, kp0, kp0 + (size_t)16 * NP1, vbase + crow0 + 32 * s, vbase + crow0 + 32 * s + 16, MaskNone());
        }
    }
    if (kind == 0) {
        const int c = cb * 16 + n, csq = min(max(c - 8, 0), 48), w0 = (cb == 0) ? 0 : (cb == 1 ? 8 : (cb == 2 ? 24 : 32)), rs = min(max(r - 4, 0), 56);
#pragma unroll 2
        for (int kr = rs; kr < rs + 8; ++kr) {
            const int tok0 = b * SEQ + kr * 64 + w0;
            const bf16_t* kp0 = P1 + (size_t)(tok0 + n) * NP1 + kcol + 8 * g;
            MaskNA mk{c, csq, w0 + 4 * g, rpb_s + (h * 15 + (kr - r + 7)) * 31};
            attn_step(a, qb, kp0, kp0 + (size_t)16 * NP1, vbase + tok0, vbase + tok0 + 16, mk);
        }
    } else if (kind == 1) {
#pragma unroll 2
        for (int s = 0; s < 9; ++s) {
            const int kb = t0 - 128 + 32 * s;
            const int ja = min(max(kb + n, 0), SEQ - 1), jb = min(max(kb + 16 + n, 0), SEQ - 1);
            const int va = min(max(kb + 4 * g, 0), SEQ - 4), vb = min(max(kb + 16 + 4 * g, 0), SEQ - 4);
            const bf16_t* kp0 = P1 + (size_t)(b * SEQ + ja) * NP1 + kcol + 8 * g; const bf16_t* kp1 = P1 + (size_t)(b * SEQ + jb) * NP1 + kcol + 8 * g;
            const bf16_t* vb0 = VT + (size_t)(vrow + n) * NROW + b * SEQ;
            MaskWA mk{t0 + n, kb + 4 * g};
            attn_step(a, qb, kp0, kp1, vb0 + va, vb0 + vb, mk);
        }
    }
    float lt = a.l; lt += __shfl_xor(lt, 16); lt += __shfl_xor(lt, 32);
    float osc = 1.f;
    if (kind == 1 || kind == 3) { const float sk = F.p.wa_sink[l * 8 + h], mf = fmaxf(a.m, sk); osc = __expf(a.m - mf); lt = lt * osc + __expf(sk - mf); }
    const float inv = osc / lt;
    bf16_t* op = F.BR() + (size_t)(qrow0 + n) * 2048 + brcol + 4 * g;
#pragma unroll
    for (int t = 0; t < 4; ++t) { const f32x4 v = a.o[t] * inv; u32x2 o2; o2.x = pk2(v.x, v.y); o2.y = pk2(v.z, v.w); *(u32x2*)(op + 16 * t) = o2; }
}


struct KVF { bf16x8_t k[4]; bf16x4_t v[4][2]; };
__device__ __forceinline__ void kv_load(KVF& f, const char* kbase, unsigned ko0, unsigned ko1, const char* vbase, unsigned vo0, unsigned vo1) {
    f.k[0] = *(const bf16x8_t*)(kbase + ko0); f.k[1] = *(const bf16x8_t*)(kbase + ko0 + 64); f.k[2] = *(const bf16x8_t*)(kbase + ko1); f.k[3] = *(const bf16x8_t*)(kbase + ko1 + 64);
#pragma unroll
    for (int t = 0; t < 4; ++t) { f.v[t][0] = *(const bf16x4_t*)(vbase + vo0 + (unsigned)t * 16u * NROW * 2u); f.v[t][1] = *(const bf16x4_t*)(vbase + vo1 + (unsigned)t * 16u * NROW * 2u); }
}
template <class MaskF>
__device__ __forceinline__ void attn_tile(float& am, float& al, f32x4 (&ao)[4], const bf16x8_t (&qb)[2], const KVF& f, const MaskF& maskf) {
    f32x4 s0 = {0.f, 0.f, 0.f, 0.f}, s1 = {0.f, 0.f, 0.f, 0.f};
    s0 = __builtin_amdgcn_mfma_f32_16x16x32_bf16(f.k[0], qb[0], s0, 0, 0, 0); s0 = __builtin_amdgcn_mfma_f32_16x16x32_bf16(f.k[1], qb[1], s0, 0, 0, 0);
    s1 = __builtin_amdgcn_mfma_f32_16x16x32_bf16(f.k[2], qb[0], s1, 0, 0, 0); s1 = __builtin_amdgcn_mfma_f32_16x16x32_bf16(f.k[3], qb[1], s1, 0, 0, 0);
    maskf(s0, s1);
    float mx = fmaxf(fmaxf(fmaxf(s0.x, s0.y), fmaxf(s0.z, s0.w)), fmaxf(fmaxf(s1.x, s1.y), fmaxf(s1.z, s1.w)));
    mx = fmaxf(mx, __shfl_xor(mx, 16)); mx = fmaxf(mx, __shfl_xor(mx, 32));
    const float mn = fmaxf(am, mx), alpha = __expf(am - mn); am = mn;
    f32x4 p0, p1;
    p0.x = __expf(s0.x - mn); p0.y = __expf(s0.y - mn); p0.z = __expf(s0.z - mn); p0.w = __expf(s0.w - mn);
    p1.x = __expf(s1.x - mn); p1.y = __expf(s1.y - mn); p1.z = __expf(s1.z - mn); p1.w = __expf(s1.w - mn);
    al = al * alpha + ((p0.x + p0.y) + (p0.z + p0.w)) + ((p1.x + p1.y) + (p1.z + p1.w));
    union { bf16x8_t v; unsigned u[4]; } pb;
    pb.u[0] = pk2(p0.x, p0.y); pb.u[1] = pk2(p0.z, p0.w); pb.u[2] = pk2(p1.x, p1.y); pb.u[3] = pk2(p1.z, p1.w);
#pragma unroll
    for (int t = 0; t < 4; ++t) {
        union { bf16x8_t v; bf16x4_t h[2]; } av; av.h[0] = f.v[t][0]; av.h[1] = f.v[t][1];
        ao[t] = ao[t] * alpha;
        ao[t] = __builtin_amdgcn_mfma_f32_16x16x32_bf16(av.v, pb.v, ao[t], 0, 0, 0);
    }
}
template <int kind>
__device__ __forceinline__ void attn_multi(Frame& F, int l, int item, const float* rpb_s) {
    constexpr int NQ = 2;
    constexpr int NLOC = (kind == 0) ? 9 : (kind == 1 ? 9 : 0), NS = 8 + NLOC;
    const int lane = F.lane, n = lane & 15, g = lane >> 4;
    const bf16_t* P1 = F.P1(); const bf16_t* VT = F.VT();
    int b, h0, kvh = 0, kcol, vrow, r = 0, cb = 0, t0 = 0, qrow0, qcol0, brcol0;
    constexpr int QRS = (kind == 0) ? 64 : (kind == 2 ? 16 : 0), QCS = (kind == 1 || kind == 3) ? 64 : 0;
    if (kind == 0) { cb = item & 3; r = ((item >> 2) & 31) * 2; h0 = (item >> 7) & 7; b = item >> 10; kcol = PC_BK + h0 * 64; vrow = h0 * 64; qrow0 = b * SEQ + r * 64 + cb * 16; qcol0 = PC_BQ + h0 * 64; brcol0 = 512 + h0 * 64; }
    else if (kind == 1) { const int hp = item & 1, qt = (item >> 1) & 255; kvh = (item >> 9) & 1; b = item >> 10; h0 = kvh * 4 + hp * 2; t0 = qt * 16; kcol = PC_CK + kvh * 64; vrow = 512 + kvh * 64; qrow0 = b * SEQ + t0; qcol0 = PC_CQ + h0 * 64; brcol0 = 1024 + h0 * 64; }
    else if (kind == 2) { const int qp = item & 7; h0 = (item >> 3) & 7; b = item >> 6; kcol = PC_BK + h0 * 64; vrow = h0 * 64; qrow0 = NTOK + b * LC + qp * 32; qcol0 = PC_BQ + h0 * 64; brcol0 = 512 + h0 * 64; }
    else { const int hp = item & 1, qt = (item >> 1) & 15; kvh = (item >> 5) & 1; b = item >> 6; h0 = kvh * 4 + hp * 2; kcol = PC_CK + kvh * 64; vrow = 512 + kvh * 64; qrow0 = NTOK + b * LC + qt * 16; qcol0 = PC_CQ + h0 * 64; brcol0 = 1024 + h0 * 64; }
    bf16x8_t qb[NQ][2]; float am[NQ], al[NQ]; f32x4 ao[NQ][4];
    { const char* qbase = (const char*)P1; const unsigned qo = (unsigned)(qrow0 + n) * (unsigned)(NP1 * 2) + (unsigned)(qcol0 + 8 * g) * 2u;
#pragma unroll
      for (int q = 0; q < NQ; ++q) { const unsigned o = qo + (unsigned)q * (unsigned)(QRS * NP1 * 2 + QCS * 2); qb[q][0] = *(const bf16x8_t*)(qbase + o); qb[q][1] = *(const bf16x8_t*)(qbase + o + 64);
        am[q] = -1e30f; al[q] = 0.f;
#pragma unroll
        for (int t = 0; t < 4; ++t) ao[q][t] = (f32x4){0.f, 0.f, 0.f, 0.f}; } }
    const int crow0 = NTOK + b * LC;
    const int w0 = (cb == 0) ? 0 : (cb == 1 ? 8 : (cb == 2 ? 24 : 32)), ru = min(max(r - 4, 0), 56);
    const char* kbase = (const char*)P1; const char* vbase = (const char*)VT;
    const unsigned kl = (unsigned)(kcol + 8 * g) * 2u, vl = (unsigned)(vrow + n) * (unsigned)NROW * 2u;
    auto load_step = [&](KVF& f, int s) {
        if (s < 8) { const unsigned ko = (unsigned)(crow0 + 32 * s + n) * (unsigned)(NP1 * 2) + kl, vo = vl + (unsigned)(crow0 + 32 * s + 4 * g) * 2u;
            kv_load(f, kbase, ko, ko + 16u * NP1 * 2u, vbase, vo, vo + 32u); }
        else if (kind == 0) { const int tok0 = b * SEQ + min(ru + (s - 8), 63) * 64 + w0; const unsigned ko = (unsigned)(tok0 + n) * (unsigned)(NP1 * 2) + kl, vo = vl + (unsigned)(tok0 + 4 * g) * 2u;
            kv_load(f, kbase, ko, ko + 16u * NP1 * 2u, vbase, vo, vo + 32u); }
        else if (kind == 1) { const int kb = t0 - 128 + 32 * (s - 8);
            const int ja = min(max(kb + n, 0), SEQ - 1), jb = min(max(kb + 16 + n, 0), SEQ - 1), va = min(max(kb + 4 * g, 0), SEQ - 4), vb = min(max(kb + 16 + 4 * g, 0), SEQ - 4);
            kv_load(f, kbase, (unsigned)(b * SEQ + ja) * (unsigned)(NP1 * 2) + kl, (unsigned)(b * SEQ + jb) * (unsigned)(NP1 * 2) + kl, vbase, vl + (unsigned)(b * SEQ + va) * 2u, vl + (unsigned)(b * SEQ + vb) * 2u); }
    };
    auto compute_step = [&](const KVF& f, int s) {
        if (s < 8) {
#pragma unroll
            for (int q = 0; q < NQ; ++q) { attn_tile(am[q], al[q], ao[q], qb[q], f, MaskNone()); if (NQ == 4) __builtin_amdgcn_sched_barrier(0); }
        } else if (kind == 0) {
            const int kr = ru + (s - 8);
#pragma unroll
            for (int q = 0; q < NQ; ++q) { const int rq = r + q, rsq = min(max(rq - 4, 0), 56);
                if (kr >= rsq && kr <= rsq + 7) { const int c = cb * 16 + n, csq = min(max(c - 8, 0), 48);
                    MaskNA mk{c, csq, w0 + 4 * g, rpb_s + (h0 * 15 + (kr - rq + 7)) * 31}; attn_tile(am[q], al[q], ao[q], qb[q], f, mk); } }
        } else if (kind == 1) {
            MaskWA mk{t0 + n, t0 - 128 + 32 * (s - 8) + 4 * g};
#pragma unroll
            for (int q = 0; q < NQ; ++q) { attn_tile(am[q], al[q], ao[q], qb[q], f, mk); if (NQ == 4) __builtin_amdgcn_sched_barrier(0); }
        }
    };
    if (NQ == 2) {
        KVF fa, fb;
        load_step(fa, 0);
#pragma unroll 1
        for (int s = 0; s < NS; s += 2) {
            if (s + 1 < NS) load_step(fb, s + 1);
            compute_step(fa, s);
            if (s + 1 < NS) { if (s + 2 < NS) load_step(fa, s + 2); compute_step(fb, s + 1); }
        }
    } else {
        KVF fa;
#pragma unroll 1
        for (int s = 0; s < NS; ++s) { load_step(fa, s); compute_step(fa, s); }
    }
#pragma unroll
    for (int q = 0; q < NQ; ++q) {
        float lt = al[q]; lt += __shfl_xor(lt, 16); lt += __shfl_xor(lt, 32);
        float osc = 1.f;
        if (kind == 1 || kind == 3) { const float sk = F.p.wa_sink[l * 8 + h0 + q], mf = fmaxf(am[q], sk); osc = __expf(am[q] - mf); lt = lt * osc + __expf(sk - mf); }
        const float inv = osc / lt;
        char* obase = (char*)F.BR(); const unsigned oo = (unsigned)(qrow0 + q * QRS + n) * 4096u + (unsigned)(brcol0 + q * QCS + 4 * g) * 2u;
#pragma unroll
        for (int t = 0; t < 4; ++t) { const f32x4 v = ao[q][t] * inv; u32x2 o2; o2.x = pk2(v.x, v.y); o2.y = pk2(v.z, v.w); *(u32x2*)(obase + oo + 32u * t) = o2; }
    }
}

template <int DK, bool HG>
__device__ __forceinline__ void scan_mfma(Frame& F, int l, int b, int h, int z, unsigned char* lds) {
    constexpr int NDP = DK / 2, NTG = NTHR / NDP, TPT = 64 / NTG, QS = DK + 8, TS = 72, NDT = DK / 16;
    bf16_t* QD = (bf16_t*)lds; bf16_t* KD = QD + 64 * QS; bf16_t* KDT = KD + 64 * QS; bf16_t* VTs = KDT + DK * TS; bf16_t* AM = VTs + 128 * TS; bf16_t* ST = AM + 64 * TS;
    float* TOT = (float*)(ST + 128 * QS); float* E1s = TOT + NTG * DK; float* E2s = E1s + DK;
    REFRESH(F);
    const int tid = F.tid, lane = F.lane, w = F.wave, n = lane & 15, g = lane >> 4;
    const int dp = tid % NDP, tg = tid / NDP, vp = tid & 63, vg = tid >> 6;
    const bf16_t* P1 = F.P1();
    float lw[HG ? 2 : 32], lbias[2] = {0.f, 0.f}, lbv[2] = {0.f, 0.f};
    if (!HG) {
#pragma unroll
        for (int r = 0; r < 16; ++r) { const float* wp = F.p.gla_lr_w + ((size_t)(l * 2 + z) * 16 + r) * 256 + h * 64 + 2 * dp; lw[2 * r] = wp[0]; lw[2 * r + 1] = wp[1]; }
        lbias[0] = F.p.gla_lr_b[(l * 2 + z) * 256 + h * 64 + 2 * dp]; lbias[1] = F.p.gla_lr_b[(l * 2 + z) * 256 + h * 64 + 2 * dp + 1];
    } else { lw[0] = lw[1] = 0.f; if (l != 0) { lbv[0] = F.lb()[z * 512 + h * 128 + 2 * dp]; lbv[1] = F.lb()[z * 512 + h * 128 + 2 * dp + 1]; } }
    f32x4 accS[NDT];
#pragma unroll
    for (int i = 0; i < NDT; ++i) accS[i] = (f32x4){0.f, 0.f, 0.f, 0.f};
    unsigned rq[TPT], rk[TPT], rv[8]; u32x4 rl[HG ? 1 : TPT][2];
    const int qcol = HG ? PC_DQ + h * 128 + 2 * dp : PC_AQ + h * 64 + 2 * dp, kcol = HG ? PC_DF + z * 512 + h * 128 + 2 * dp : PC_AK + h * 64 + 2 * dp;
    const int vcol = (HG ? PC_DI : PC_AV) + h * 128 + 2 * vp;
    const char* p1b = (const char*)P1; const int sgn = z ? -1 : 1; const int rstep = sgn * NP1 * 2;
#define SCAN_LOAD(c) do { const int row0_ = seq_row((c) * 64, b, z); \
        int o_ = (row0_ + sgn * tg * TPT) * (NP1 * 2); \
        _Pragma("unroll") for (int tt = 0; tt < TPT; ++tt) { rq[tt] = *(const unsigned*)(p1b + (unsigned)(o_ + qcol * 2)); rk[tt] = *(const unsigned*)(p1b + (unsigned)(o_ + kcol * 2)); \
            if (!HG) { rl[tt][0] = *(const u32x4*)(p1b + (unsigned)(o_ + (PC_ALR + z * 16) * 2)); rl[tt][1] = *(const u32x4*)(p1b + (unsigned)(o_ + (PC_ALR + z * 16 + 8) * 2)); } o_ += rstep; } \
        int ov_ = (row0_ + sgn * vg * 8) * (NP1 * 2) + vcol * 2; \
        _Pragma("unroll") for (int tt = 0; tt < 8; ++tt) { rv[tt] = *(const unsigned*)(p1b + (unsigned)ov_); ov_ += rstep; } } while (0)
    SCAN_LOAD(0);
    constexpr int NCH = (LC + SEQ) / 64;
#pragma unroll 1
    for (int c = 0; c < NCH; ++c) {
        float qv[TPT][2], kv[TPT][2], cs[TPT][2];
#pragma unroll
        for (int tt = 0; tt < TPT; ++tt)
#pragma unroll
            for (int e = 0; e < 2; ++e) {
                const float qr = __uint_as_float(e ? (rq[tt] & 0xffff0000u) : (rq[tt] << 16)), kr = __uint_as_float(e ? (rk[tt] & 0xffff0000u) : (rk[tt] << 16));
                float gg;
                if (HG) {
                    gg = kr;
                    kv[tt][e] = 1.f - __expf(kr);
                    qv[tt][e] = qr;
                } else {
                    float lg = lbias[e];
                    const unsigned lr8[8] = {rl[tt][0].x, rl[tt][0].y, rl[tt][0].z, rl[tt][0].w, rl[tt][1].x, rl[tt][1].y, rl[tt][1].z, rl[tt][1].w};
#pragma unroll
                    for (int r2 = 0; r2 < 8; ++r2) { lg += __uint_as_float(lr8[r2] << 16) * lw[(2 * r2) * 2 + e]; lg += __uint_as_float(lr8[r2] & 0xffff0000u) * lw[(2 * r2 + 1) * 2 + e]; }
                    const float t = __expf(-fabsf(lg)), r = __builtin_amdgcn_rcpf(1.f + t);
                    gg = (fminf(lg, 0.f) + __logf(r)) * (1.f / 16.f);
                    kv[tt][e] = kr; qv[tt][e] = qr;
                }
                cs[tt][e] = gg + (tt ? cs[tt ? tt - 1 : 0][e] : 0.f);
            }
        TOT[tg * DK + 2 * dp] = cs[TPT - 1][0]; TOT[tg * DK + 2 * dp + 1] = cs[TPT - 1][1];
        __syncthreads();
        float offs[2] = {0.f, 0.f}, mid[2] = {0.f, 0.f}, lastv[2] = {0.f, 0.f};
#pragma unroll
        for (int t2 = 0; t2 < NTG; ++t2)
#pragma unroll
            for (int e = 0; e < 2; ++e) { const float tv = TOT[t2 * DK + 2 * dp + e]; if (t2 < tg) offs[e] += tv; if (t2 < NTG / 2) mid[e] += tv; lastv[e] += tv; }
        unsigned kdt[2][TPT / 2]; float kprev[2] = {0.f, 0.f};
#pragma unroll
        for (int tt = 0; tt < TPT; ++tt) {
            float qd[2], kd[2];
#pragma unroll
            for (int e = 0; e < 2; ++e) { const float x = fminf(fmaxf(cs[tt][e] + offs[e] - mid[e], -80.f), 80.f); qd[e] = qv[tt][e] * __expf(x); kd[e] = kv[tt][e] * __expf(-x); }
            const int tok = tg * TPT + tt;
            *(unsigned*)(QD + tok * QS + 2 * dp) = pk2(qd[0], qd[1]); *(unsigned*)(KD + tok * QS + 2 * dp) = pk2(kd[0], kd[1]);
            if (tt & 1) { kdt[0][tt >> 1] = pk2(kprev[0], kd[0]); kdt[1][tt >> 1] = pk2(kprev[1], kd[1]); } else { kprev[0] = kd[0]; kprev[1] = kd[1]; }
        }
#pragma unroll
        for (int e = 0; e < 2; ++e) {
            bf16_t* dst = KDT + (2 * dp + e) * TS + tg * TPT;
            if (TPT == 8) { u32x4 o; o.x = kdt[e][0]; o.y = kdt[e][1]; o.z = kdt[e][TPT / 2 - 2]; o.w = kdt[e][TPT / 2 - 1]; *(u32x4*)dst = o; }
            else { u32x2 o; o.x = kdt[e][0]; o.y = kdt[e][1]; *(u32x2*)dst = o; }
        }
        if (tg == 0) { E1s[2 * dp] = __expf(mid[0]); E1s[2 * dp + 1] = __expf(mid[1]); E2s[2 * dp] = __expf(lastv[0] - mid[0]); E2s[2 * dp + 1] = __expf(lastv[1] - mid[1]); }
        {   u32x4 o0, o1;
            o0.x = (rv[0] & 0xffffu) | (rv[1] << 16); o0.y = (rv[2] & 0xffffu) | (rv[3] << 16); o0.z = (rv[4] & 0xffffu) | (rv[5] << 16); o0.w = (rv[6] & 0xffffu) | (rv[7] << 16);
            o1.x = (rv[0] >> 16) | (rv[1] & 0xffff0000u); o1.y = (rv[2] >> 16) | (rv[3] & 0xffff0000u); o1.z = (rv[4] >> 16) | (rv[5] & 0xffff0000u); o1.w = (rv[6] >> 16) | (rv[7] & 0xffff0000u);
            *(u32x4*)(VTs + (2 * vp) * TS + vg * 8) = o0; *(u32x4*)(VTs + (2 * vp + 1) * TS + vg * 8) = o1; }
        if (c + 1 < NCH) SCAN_LOAD(c + 1);
        __syncthreads();
#pragma unroll
        for (int dt = 0; dt < NDT; ++dt) { accS[dt] = accS[dt] * *(const f32x4*)&E1s[16 * dt + 4 * g];
            u32x2 o; o.x = pk2(accS[dt].x, accS[dt].y); o.y = pk2(accS[dt].z, accS[dt].w); *(u32x2*)(ST + (16 * w + n) * QS + 16 * dt + 4 * g) = o; }
        {   const int it = w >> 1, jt0 = 2 * (w & 1);
            f32x4 d0 = {0.f, 0.f, 0.f, 0.f}, d1 = {0.f, 0.f, 0.f, 0.f};
            if (jt0 <= it) {
                bf16x8_t qf[DK / 32], k0f[DK / 32], k1f[DK / 32];
#pragma unroll
                for (int ks = 0; ks < DK / 32; ++ks) { qf[ks] = *(const bf16x8_t*)(QD + (16 * it + n) * QS + 32 * ks + 8 * g); k0f[ks] = *(const bf16x8_t*)(KD + (16 * jt0 + n) * QS + 32 * ks + 8 * g); k1f[ks] = *(const bf16x8_t*)(KD + (16 * (jt0 + 1) + n) * QS + 32 * ks + 8 * g); }
#pragma unroll
                for (int ks = 0; ks < DK / 32; ++ks) { d0 = __builtin_amdgcn_mfma_f32_16x16x32_bf16(k0f[ks], qf[ks], d0, 0, 0, 0); d1 = __builtin_amdgcn_mfma_f32_16x16x32_bf16(k1f[ks], qf[ks], d1, 0, 0, 0); }
                const int i = 16 * it + n, j0 = 16 * jt0 + 4 * g, j1 = j0 + 16;
                d0.x = (j0 + 0 <= i) ? d0.x : 0.f; d0.y = (j0 + 1 <= i) ? d0.y : 0.f; d0.z = (j0 + 2 <= i) ? d0.z : 0.f; d0.w = (j0 + 3 <= i) ? d0.w : 0.f;
                d1.x = (j1 + 0 <= i) ? d1.x : 0.f; d1.y = (j1 + 1 <= i) ? d1.y : 0.f; d1.z = (j1 + 2 <= i) ? d1.z : 0.f; d1.w = (j1 + 3 <= i) ? d1.w : 0.f;
            }
            u32x2 o; o.x = pk2(d0.x, d0.y); o.y = pk2(d0.z, d0.w); *(u32x2*)(AM + (16 * it + n) * TS + 16 * jt0 + 4 * g) = o;
            o.x = pk2(d1.x, d1.y); o.y = pk2(d1.z, d1.w); *(u32x2*)(AM + (16 * it + n) * TS + 16 * (jt0 + 1) + 4 * g) = o;
        }
        __syncthreads();
        {   f32x4 o[4];
#pragma unroll
            for (int it = 0; it < 4; ++it) o[it] = (f32x4){0.f, 0.f, 0.f, 0.f};
#pragma unroll
            for (int ks = 0; ks < 2; ++ks) { const bf16x8_t af = *(const bf16x8_t*)(VTs + (16 * w + n) * TS + 32 * ks + 8 * g); bf16x8_t bf[4];
#pragma unroll
                for (int it = 0; it < 4; ++it) bf[it] = *(const bf16x8_t*)(AM + (16 * it + n) * TS + 32 * ks + 8 * g);
#pragma unroll
                for (int it = 0; it < 4; ++it) o[it] = __builtin_amdgcn_mfma_f32_16x16x32_bf16(af, bf[it], o[it], 0, 0, 0); }
#pragma unroll
            for (int ks = 0; ks < DK / 32; ++ks) { const bf16x8_t af = *(const bf16x8_t*)(ST + (16 * w + n) * QS + 32 * ks + 8 * g); bf16x8_t bf[4];
#pragma unroll
                for (int it = 0; it < 4; ++it) bf[it] = *(const bf16x8_t*)(QD + (16 * it + n) * QS + 32 * ks + 8 * g);
#pragma unroll
                for (int it = 0; it < 4; ++it) o[it] = __builtin_amdgcn_mfma_f32_16x16x32_bf16(af, bf[it], o[it], 0, 0, 0); }
            const int row0 = seq_row(c * 64, b, z) + sgn * n;
            char* dstb; unsigned doff; int dstride;
            if (HG) { dstb = (char*)F.P1(); doff = (unsigned)row0 * (unsigned)(NP1 * 2) + (unsigned)(PC_DF + z * 512 + h * 128 + 16 * w + 4 * g) * 2u; dstride = sgn * 16 * NP1 * 2; }
            else if (z == 0) { dstb = (char*)F.BR(); doff = (unsigned)row0 * 4096u + (unsigned)(h * 128 + 16 * w + 4 * g) * 2u; dstride = sgn * 16 * 4096; }
            else { dstb = (char*)F.OBA(); doff = (unsigned)row0 * 1024u + (unsigned)(h * 128 + 16 * w + 4 * g) * 2u; dstride = sgn * 16 * 1024; }
#pragma unroll
            for (int it = 0; it < 4; ++it) { u32x2 o2; o2.x = pk2(o[it].x, o[it].y); o2.y = pk2(o[it].z, o[it].w); *(u32x2*)(dstb + (unsigned)((int)doff + it * dstride)) = o2; }
        }
#pragma unroll
        for (int ks = 0; ks < 2; ++ks) { const bf16x8_t bv = *(const bf16x8_t*)(VTs + (16 * w + n) * TS + 32 * ks + 8 * g); bf16x8_t af[NDT];
#pragma unroll
            for (int dt = 0; dt < NDT; ++dt) af[dt] = *(const bf16x8_t*)(KDT + (16 * dt + n) * TS + 32 * ks + 8 * g);
#pragma unroll
            for (int dt = 0; dt < NDT; ++dt) accS[dt] = __builtin_amdgcn_mfma_f32_16x16x32_bf16(af[dt], bv, accS[dt], 0, 0, 0); }
#pragma unroll
        for (int dt = 0; dt < NDT; ++dt) accS[dt] = accS[dt] * *(const f32x4*)&E2s[16 * dt + 4 * g];
        __syncthreads();
    }
#undef SCAN_LOAD
}

constexpr bool MF_SCAN = true;
__device__ __forceinline__ void phase_mix(Frame& F, int l) {
    const int n_scan = 64;
    const int nsb = (F.nb > 128) ? 64 : 0;
    if (nsb == 0 || F.bid < nsb) {
        for (int it = F.bid; it < n_scan; it += (nsb ? nsb : F.nb)) {
            const int br = it >> 5, r = it & 31, b = r >> 3, h = (r >> 1) & 3, z = r & 1;
            if (br == 0) scan_mfma<64, false>(F, l, b, h, z, (unsigned char*)F.smf); else scan_mfma<128, true>(F, l, b, h, z, (unsigned char*)F.smf);
        }
        __syncthreads();
    }
    float* rpb_s = F.smf;
    for (int i = F.tid; i < 8 * 465; i += NTHR) rpb_s[i] = F.p.na_rpb[(size_t)l * 8 * 465 + i];
    __syncthreads();
    unsigned* qhead = F.cnt() + 64 + l * 16;
    const int n_wa = 4096, n_na = 4096, n_cna = (l == 0) ? 256 : 0, n_cwa = (l == 0) ? 256 : 0, total = n_wa + n_na + n_cna + n_cwa;
    for (;;) {
        int it = 0; if (F.lane == 0) it = (int)atomicAdd(qhead, 1u);
        it = __builtin_amdgcn_readfirstlane(it);
        if (it >= total) break;
        if (it < n_wa) attn_multi<1>(F, l, it, rpb_s);
        else if (it < n_wa + n_na) attn_multi<0>(F, l, it - n_wa, rpb_s);
        else if (it < n_wa + n_na + n_cna) attn_multi<2>(F, l, it - n_wa - n_na, rpb_s);
        else attn_multi<3>(F, l, it - n_wa - n_na - n_cna, rpb_s);
    }
}

__device__ __forceinline__ void phase_prepad(Frame& F, int l) {
    const int gw = F.bid * 8 + F.wave, ngw = F.nb * 8, nrows = (l == 0) ? NROW : NTOK;
    for (int row = gw; row < nrows; row += ngw) {
        const int c0 = F.lane * 8;
        {   float a[8], b[8], g[8], o[8];
            ld8(F.BR() + (size_t)row * 2048 + c0, a); ld8(F.OBA() + (size_t)row * 512 + c0, b); ld8(F.P1() + (size_t)row * NP1 + PC_AG + c0, g);
            float ss = 0.f;
#pragma unroll
            for (int j = 0; j < 8; ++j) { o[j] = a[j] + b[j]; ss += o[j] * o[j]; }
            ss += __shfl_xor(ss, 1); ss += __shfl_xor(ss, 2); ss += __shfl_xor(ss, 4); ss += __shfl_xor(ss, 8);
            const float rs = rsqrtf(ss * (1.f / 128.f) + 1e-6f);
#pragma unroll
            for (int j = 0; j < 8; ++j) o[j] = o[j] * rs * siluf_(g[j]);
            st8(F.BR() + (size_t)row * 2048 + c0, o); }
        {   float a[8], b[8], g[8], o[8];
            ld8(F.P1() + (size_t)row * NP1 + PC_DF + c0, a); ld8(F.P1() + (size_t)row * NP1 + PC_DF + 512 + c0, b); ld8(F.P1() + (size_t)row * NP1 + PC_DG + c0, g);
            float ss = 0.f;
#pragma unroll
            for (int j = 0; j < 8; ++j) { o[j] = a[j] + b[j]; ss += o[j] * o[j]; }
            ss += __shfl_xor(ss, 1); ss += __shfl_xor(ss, 2); ss += __shfl_xor(ss, 4); ss += __shfl_xor(ss, 8);
            const float rs = rsqrtf(ss * (1.f / 128.f) + 1e-6f);
#pragma unroll
            for (int j = 0; j < 8; ++j) o[j] = o[j] * rs * siluf_(g[j]);
            st8(F.BR() + (size_t)row * 2048 + 1536 + c0, o); }
    }
}

__device__ __forceinline__ void phase_merge_s(Frame& F, int l) {
    const int M = (l == 0) ? NROW : NTOK, tn = DM / 128, nt = (M / 128) * tn, ty = F.tid >> 5, tx = F.tid & 31;
    for (int t = F.bid; t < nt; t += F.nb) {
        const int row0 = (t / tn) * 128, col0 = (t % tn) * 128;
        float sum[8][4];
#pragma unroll
        for (int i = 0; i < 8; ++i)
#pragma unroll
            for (int j = 0; j < 4; ++j) sum[i][j] = 0.f;
#pragma unroll 1
        for (int br = 0; br < 4; ++br) {
            float acc[8][4];
#pragma unroll
            for (int i = 0; i < 8; ++i)
#pragma unroll
                for (int j = 0; j < 4; ++j) acc[i][j] = 0.f;
            gemm_s_acc(acc, F.BR() + br * 512, 2048, F.Wbrt() + (size_t)br * DM * 512, 512, 512, row0, col0, F.smf, F.tid);
#pragma unroll
            for (int i = 0; i < 8; ++i) { const u32x2 g2 = *(const u32x2*)(F.G() + (size_t)(row0 + ty * 8 + i) * NGATE + br * 1024 + col0 + tx * 4);
                sum[i][0] += __uint_as_float(g2.x << 16) * acc[i][0]; sum[i][1] += __uint_as_float(g2.x & 0xffff0000u) * acc[i][1];
                sum[i][2] += __uint_as_float(g2.y << 16) * acc[i][2]; sum[i][3] += __uint_as_float(g2.y & 0xffff0000u) * acc[i][3]; }
        }
#pragma unroll
        for (int i = 0; i < 8; ++i) { u32x2 o2; o2.x = pk2(sum[i][0], sum[i][1]); o2.y = pk2(sum[i][2], sum[i][3]);
            *(u32x2*)(F.HX() + (size_t)(row0 + ty * 8 + i) * DM + col0 + tx * 4) = o2; }
    }
}

__device__ __forceinline__ void phase_ln1(Frame& F, int l) {
    const int nrows = (l == 0) ? NROW : NTOK, ngroups = nrows / 64;
    const float* lg = F.p.ln_g + (size_t)(l * 2 + 0) * DM; const float* lbb = F.p.ln_b + (size_t)(l * 2 + 0) * DM;
    float* part = F.smf;
    const int wv = __builtin_amdgcn_readfirstlane(F.wave);
    for (int grp = F.bid; grp < ngroups; grp += F.nb) {
        const int row0 = grp * 64, rb = row_batch(row0);
        const float* mv = F.modv() + ((size_t)l * 5 + rb) * 6144;
        float* xg = row0 < NTOK ? F.p.out + (size_t)row0 * DM : F.cxm() + (size_t)(row0 - NTOK) * DM;
#pragma unroll 1
        for (int rr = 0; rr < 8; ++rr) {
            const int lr = wv * 8 + rr; float* xr = xg + (size_t)lr * DM;
            f32x4 v[4]; float s = 0.f;
#pragma unroll
            for (int j = 0; j < 4; ++j) { v[j] = *(const f32x4*)(xr + j * 256 + F.lane * 4); s += (v[j].x + v[j].y) + (v[j].z + v[j].w); }
            const float mean = wave_sum(s) * (1.f / DM); float s2 = 0.f;
#pragma unroll
            for (int j = 0; j < 4; ++j) { v[j] = v[j] - mean; s2 += (v[j].x * v[j].x + v[j].y * v[j].y) + (v[j].z * v[j].z + v[j].w * v[j].w); }
            const float rstd = rsqrtf(wave_sum(s2) * (1.f / DM) + LN_EPS);
#pragma unroll
            for (int j = 0; j < 4; ++j) { const int d = j * 256 + F.lane * 4;
                const f32x4 g4 = *(const f32x4*)(lg + d), b4 = *(const f32x4*)(lbb + d), m3 = *(const f32x4*)(mv + 3 * 1024 + d), m4 = *(const f32x4*)(mv + 4 * 1024 + d);
                const f32x4 xn = v[j] * rstd * g4 + b4;
                *(f32x4*)(xr + d) = xn;
                const f32x4 h2 = xn * (1.f + m4) + m3;
                u32x2 o2; o2.x = pk2(h2.x, h2.y); o2.y = pk2(h2.z, h2.w);
                *(u32x2*)(F.HX2() + (size_t)(row0 + lr) * DM + d) = o2; }
        }
        __syncthreads();
        {   float acc[36];
#pragma unroll
            for (int o = 0; o < 36; ++o) acc[o] = 0.f;
            const float* xr = xg + (size_t)F.lane * DM + wv * 128;
            const float* wgp = F.p.moe_w_group + ((size_t)l * DM + wv * 128) * 4; const float* wep = F.p.moe_w_expert + ((size_t)l * DM + wv * 128) * 32;
            const float* m3p = mv + 3 * 1024 + wv * 128; const float* m4p = mv + 4 * 1024 + wv * 128;
#pragma unroll 1
            for (int dc = 0; dc < 128; dc += 4) {
                const f32x4 xv = *(const f32x4*)(xr + dc); const float xs[4] = {xv.x, xv.y, xv.z, xv.w};
#pragma unroll
                for (int q = 0; q < 4; ++q) { const int d = dc + q; const float hh = xs[q] * (1.f + m4p[d]) + m3p[d];
#pragma unroll
                    for (int o = 0; o < 4; ++o) acc[o] += hh * wgp[d * 4 + o];
#pragma unroll
                    for (int o = 0; o < 32; ++o) acc[4 + o] += hh * wep[d * 32 + o]; }
            }
#pragma unroll
            for (int o = 0; o < 36; ++o) part[(wv * 36 + o) * 64 + F.lane] = acc[o];
        }
        __syncthreads();
        if (wv == 0) {
            const int row = row0 + F.lane;
            float gl[4]; int gi = 0; float gm = -3.4e38f;
#pragma unroll
            for (int o = 0; o < 4; ++o) { float t = F.p.moe_b_group[l * 4 + o];
#pragma unroll
                for (int w2 = 0; w2 < 8; ++w2) t += part[(w2 * 36 + o) * 64 + F.lane];
                gl[o] = t; if (t > gm) { gm = t; gi = o; } }
            float gs = 0.f;
#pragma unroll
            for (int o = 0; o < 4; ++o) gs += expf(gl[o] - gm);
            const float gwt = 1.f / gs;
            float e1 = -3.4e38f, e2 = -3.4e38f; int i1 = 0, i2 = 0;
#pragma unroll
            for (int o8 = 0; o8 < 8; ++o8) { const int o = gi * 8 + o8; float ev = F.p.moe_b_expert[l * 32 + o];
#pragma unroll
                for (int w2 = 0; w2 < 8; ++w2) ev += part[(w2 * 36 + 4 + o) * 64 + F.lane];
                if (ev > e1) { e2 = e1; i2 = i1; e1 = ev; i1 = o; } else if (ev > e2) { e2 = ev; i2 = o; } }
            const float w1 = 1.f / (1.f + expf(e2 - e1)), w2v = 1.f - w1;
            const unsigned p1 = atomicAdd(&F.cnt()[l * 32 + i1], 1u), p2 = atomicAdd(&F.cnt()[l * 32 + i2], 1u);
            F.tokE()[row * 2] = i1; F.tokI()[row * 2] = (int)p1; F.tokW()[row * 2] = gwt * w1;
            F.tokE()[row * 2 + 1] = i2; F.tokI()[row * 2 + 1] = (int)p2; F.tokW()[row * 2 + 1] = gwt * w2v;
        }
        __syncthreads();
    }
}

__device__ __forceinline__ void phase_gather(Frame& F, int l) {
    int* off = (int*)F.smf; moe_offsets(F, l, off);
    const int gw = F.bid * 8 + F.wave, ngw = F.nb * 8, nrows = (l == 0) ? NROW : NTOK;
    for (int s = gw; s < 2 * nrows; s += ngw) {
        const int e = F.tokE()[s], dst = off[e] + F.tokI()[s];
        const u32x4* src = (const u32x4*)(F.HX2() + (size_t)(s >> 1) * DM); u32x4* d = (u32x4*)(F.XS() + (size_t)dst * DM);
        d[F.lane] = src[F.lane]; d[F.lane + 64] = src[F.lane + 64];
        if (F.lane == 0) { F.rmap()[dst] = s; F.roww()[dst] = F.tokW()[s]; }
    }
    for (int e = 0; e < 32; ++e) {
        const int c = (int)F.cnt()[l * 32 + e], pc = (c + 255) & ~255;
        for (int j = c + gw; j < pc; j += ngw) { const int dst = off[e] + j; u32x4* d = (u32x4*)(F.XS() + (size_t)dst * DM);
            const u32x4 z = {0u, 0u, 0u, 0u}; d[F.lane] = z; d[F.lane + 64] = z;
            if (F.lane == 0) { F.rmap()[dst] = -1; F.roww()[dst] = 0.f; } }
    }
}
__device__ __forceinline__ int expert_of_row(const int* off, int row) { int e = 0;
#pragma unroll 1
    for (int i = 1; i < 32; ++i) if (row >= off[i]) e = i;
    return e; }

__device__ __forceinline__ void phase_ln2(Frame& F, int l) {
    const int gw = F.bid * 8 + F.wave, ngw = F.nb * 8, nrows = (l == 0) ? NROW : NTOK;
    const float* lg = F.p.ln_g + (size_t)(l * 2 + 1) * DM; const float* lbb = F.p.ln_b + (size_t)(l * 2 + 1) * DM;
    const bf16_t* Y = F.BR();
    const bool tmo_set = (l == DEPTH - 1) && ((__hip_atomic_load((unsigned*)(F.ws + WS_CTL) + XB_TMO, __ATOMIC_RELAXED, __HIP_MEMORY_SCOPE_AGENT) | __hip_atomic_load((unsigned*)(F.ws + WS_CTL) + XCD_BAR_WORDS + XB_TMO, __ATOMIC_RELAXED, __HIP_MEMORY_SCOPE_AGENT)) != 0u);
    for (int row = gw; row < nrows; row += ngw) {
        const float* xm = row < NTOK ? F.p.out + (size_t)row * DM : F.cxm() + (size_t)(row - NTOK) * DM;
        float* xo = row < NTOK ? F.p.out + (size_t)row * DM : F.cxo() + (size_t)(row - NTOK) * DM;
        const float* mv = F.modv() + ((size_t)l * 5 + row_batch(row)) * 6144;
        f32x4 v[4]; float s = 0.f;
#pragma unroll
        for (int j = 0; j < 4; ++j) { const int d = j * 256 + F.lane * 4;
            const u32x2 y0 = *(const u32x2*)(Y + (size_t)(row * 2) * DM + d), y1 = *(const u32x2*)(Y + (size_t)(row * 2 + 1) * DM + d);
            f32x4 y; y.x = __uint_as_float(y0.x << 16) + __uint_as_float(y1.x << 16); y.y = __uint_as_float(y0.x & 0xffff0000u) + __uint_as_float(y1.x & 0xffff0000u);
            y.z = __uint_as_float(y0.y << 16) + __uint_as_float(y1.y << 16); y.w = __uint_as_float(y0.y & 0xffff0000u) + __uint_as_float(y1.y & 0xffff0000u);
            const f32x4 m5 = *(const f32x4*)(mv + 5 * 1024 + d);
            v[j] = ALPHA * *(const f32x4*)(xm + d) + m5 * y; s += (v[j].x + v[j].y) + (v[j].z + v[j].w); }
        const float mean = wave_sum(s) * (1.f / DM); float s2 = 0.f;
#pragma unroll
        for (int j = 0; j < 4; ++j) { v[j] = v[j] - mean; s2 += (v[j].x * v[j].x + v[j].y * v[j].y) + (v[j].z * v[j].z + v[j].w * v[j].w); }
        const float rstd = rsqrtf(wave_sum(s2) * (1.f / DM) + LN_EPS);
#pragma unroll
        for (int j = 0; j < 4; ++j) { const int d = j * 256 + F.lane * 4;
            const f32x4 g4 = *(const f32x4*)(lg + d), b4 = *(const f32x4*)(lbb + d);
            f32x4 xn = v[j] * rstd * g4 + b4;
            if (tmo_set) xn = xn * __uint_as_float(0x7fc00000u);
            *(f32x4*)(xo + d) = xn;
            if (l + 1 < DEPTH) { const float* mn = F.modv() + ((size_t)(l + 1) * 5 + row_batch(row)) * 6144;
                const f32x4 m0 = *(const f32x4*)(mn + d), m1 = *(const f32x4*)(mn + 1024 + d); const f32x4 h = xn * (1.f + m1) + m0;
                u32x2 o2; o2.x = pk2(h.x, h.y); o2.y = pk2(h.z, h.w); *(u32x2*)(F.HX() + (size_t)row * DM + d) = o2; }
        }
    }
}

constexpr int NPL = 14, NPH = 1 + DEPTH * NPL;
constexpr bool MF_G1 = true, MF_GATE = true, MF_MERGE = true, MF_WOUT = true, MF_MOE1 = true, MF_MOE2 = true;
constexpr int LDS_ROPE = 1024 + 131072 + 1024;
constexpr int LDS_STAGE = 1024;
#define EN(i) (((PHMASK) >> (i)) & 1)
template <int PHMASK>
__global__ void __launch_bounds__(NTHR, 2) mega(Params p) {
    extern __shared__ __attribute__((aligned(16))) unsigned char smem[];
    Frame F; F.p = p; F.bid = blockIdx.x; F.nb = gridDim.x; F.tid = threadIdx.x; F.lane = threadIdx.x & 63; F.wave = threadIdx.x >> 6;
    F.smf = (float*)(smem + LDS_STAGE);
    LAS unsigned char* stage = (LAS unsigned char*)smem + LDS_STAGE; int* offt = (int*)(smem + 64);
    unsigned char* ws = p.ws; F.ws = ws;

    if (threadIdx.x == 0) *(uint4*)smem = make_uint4(0u, 0u, 0u, 0u);
    __syncthreads();
    unsigned* barw = (unsigned*)(ws + WS_CTL) + (p.ph_lo == 0 ? 0 : XCD_BAR_WORDS);
    XcdBarrier bar; bar.bar = barw; bar.x = 0; bar.st = (volatile LAS unsigned*)smem;
    const bool multi = (p.ph_hi - p.ph_lo) > 1;
    if (multi) bar = xcd_barrier_post(barw, (volatile LAS unsigned*)smem);
    const int lo = p.ph_lo, hi = p.ph_hi;
#define IN(k) (lo <= (k) && (k) < hi)
#define SEAM(k) do { if (IN(k) && IN((k) + 1)) xcd_barrier(bar); else __syncthreads(); } while (0)

    if (EN(14) && IN(0)) { REFRESH(F); phase_mod(F); __syncthreads(); phase_conv_a(F, 0); }
    SEAM(0);
#pragma unroll 1
    for (int l = 0; l < DEPTH; ++l) {
        const int pb = 1 + l * NPL;
        const float* xlat = (l == 0) ? p.x : p.out; const float* xctx = (l == 0) ? p.ctx : F.cxo();
        const int Mrows = (l == 0) ? NROW : NTOK;
        if (EN(0) && IN(pb + 0)) { REFRESH(F); if (l == 0) phase_prep(F, 0, p.x, p.ctx); else phase_conv_a(F, l); }
        SEAM(pb + 0);
        if (EN(1) && IN(pb + 1)) { REFRESH(F);
            bf16_t* P1 = F.P1(); bf16_t* VT = F.VT(); bf16_t* VR = F.VR();
            if (MF_G1) {
                float* rtab = (float*)(smem + LDS_ROPE);
                for (int e = F.tid; e < 1024; e += NTHR) { const int pp = e >> 4, i = e & 15; const float inv = powf(10000.f, -(float)i / 16.f), ang = (float)pp * inv; rtab[2 * e] = cosf(ang); rtab[2 * e + 1] = sinf(ang); }
                __syncthreads();
                pg::SchedG1 S{(const char*)F.HX(), (const char*)F.W1t(), (const char*)F.Wvt(), F.nb, F.bid}; pg::EpiG1 E{P1, VT, rtab, F.lb(), l};
                pg::gemm_phase(stage, DM, DM, DM, S, E);
                __syncthreads();
            } else {
            gemm_s(F, F.HX(), DM, F.W1t(), DM, NROW, NP1, DM, [=](int r, int c, float v) { P1[(size_t)r * NP1 + c] = f2bf(v); });
            gemm_s(F, F.Wvt(), DM, F.HX(), DM, NVT, NROW, DM, [=](int r, int c, float v) { VT[(size_t)r * NROW + c] = f2bf(v); });
            }
            if (!MF_ATTN) gemm_s(F, F.HX(), DM, F.Wvt(), DM, NROW, NVT, DM, [=](int r, int c, float v) { if (c < NVR) VR[(size_t)r * NVR + c] = f2bf(v); });
        }
        SEAM(pb + 1);
        if (EN(3) && IN(pb + 3)) { REFRESH(F); phase_mix(F, l); }
        SEAM(pb + 3);
        if (EN(4) && IN(pb + 4)) { REFRESH(F); phase_prepad(F, l); }
        SEAM(pb + 4);
        if (EN(5) && IN(pb + 5)) { REFRESH(F);
            bf16_t* G = F.G();
            if (MF_GATE) {
                pg::SchedStatic S{(const char*)F.HX(), (const char*)F.Wgt(), (size_t)256 * DM * 2, (size_t)256 * DM * 2, Mrows / 256, NGATE / 256, F.nb, F.bid}; pg::EpiGate E{G};
                pg::gemm_phase(stage, DM, DM, DM, S, E);
                __syncthreads();
            } else
            gemm_s(F, F.HX(), DM, F.Wgt(), DM, Mrows, NGATE, DM, [=](int r, int c, float v) { G[(size_t)r * NGATE + c] = f2bf(sigmoidf_(v)); });
            phase_conv_b(F, l);
        }
        SEAM(pb + 5);
        if (EN(6) && IN(pb + 6)) { REFRESH(F);
            if (MF_MERGE) {
                pg::SchedMerge S{(const char*)F.BR(), (const char*)F.Wbrt(), (Mrows / 256) * 4, F.nb, F.bid}; pg::EpiMerge E{F.G(), F.HX()};
                pg::gemm_phase(stage, 2048, 512, 512, S, E);
            } else phase_merge_s(F, l);
        }
        SEAM(pb + 6);
        if (EN(7) && IN(pb + 7)) { REFRESH(F);
            float* outp = p.out; float* cxm = F.cxm(); const float* modv = F.modv() + (size_t)l * 5 * 6144;
            if (MF_WOUT) {
                pg::SchedStatic S{(const char*)F.HX(), (const char*)F.Woutt(), (size_t)256 * DM * 2, (size_t)256 * DM * 2, Mrows / 256, DM / 256, F.nb, F.bid};
                pg::EpiWout E{xlat, xctx, outp, cxm, modv};
                pg::gemm_phase(stage, DM, DM, DM, S, E);
            } else
            gemm_s(F, F.HX(), DM, F.Woutt(), DM, Mrows, DM, DM, [=](int r, int c, float v) {
                const float m2 = modv[(size_t)row_batch(r) * 6144 + 2 * 1024 + c];
                if (r < NTOK) outp[(size_t)r * DM + c] = ALPHA * xlat[(size_t)r * DM + c] + m2 * v;
                else cxm[(size_t)(r - NTOK) * DM + c] = ALPHA * xctx[(size_t)(r - NTOK) * DM + c] + m2 * v; });
        }
        SEAM(pb + 7);
        if (EN(8) && IN(pb + 8)) { REFRESH(F); phase_ln1(F, l); }
        SEAM(pb + 8);
        if (EN(9) && IN(pb + 9)) { REFRESH(F); phase_gather(F, l); }
        SEAM(pb + 9);
        if (EN(10) && IN(pb + 10)) { REFRESH(F);
            int* off = offt; moe_offsets(F, l, off);
            const int Mtot = off[32], nt = (Mtot / 128) * 4, ty = F.tid >> 5, tx = F.tid & 31; bf16_t* GU = F.BR();
            if (MF_MOE1) {
                pg::SchedMoe S{(const char*)F.XS(), (const char*)F.Wgu(), off, (size_t)256 * DM * 2, (size_t)512 * DM * 2, (size_t)256 * DM * 2, Mtot / 256, 2, F.nb, F.bid};
                pg::EpiMoe1 E{F.HID(), F.roww()};
                pg::gemm_phase(stage, DM, DM, DM, S, E);
            } else
            for (int t = F.bid; t < nt; t += F.nb) {
                const int row0 = (t >> 2) * 128, col0 = (t & 3) * 128, e = expert_of_row(off, row0);
                float acc[8][4];
#pragma unroll
                for (int i = 0; i < 8; ++i)
#pragma unroll
                    for (int j = 0; j < 4; ++j) acc[i][j] = 0.f;
                gemm_s_acc(acc, F.XS(), DM, F.Wgu() + (size_t)e * 512 * DM, DM, DM, row0, col0, F.smf, F.tid);
#pragma unroll
                for (int i = 0; i < 8; ++i)
#pragma unroll
                    for (int j = 0; j < 4; ++j) GU[(size_t)(row0 + ty * 8 + i) * 512 + col0 + tx * 4 + j] = f2bf(acc[i][j]);
            }
        }
        SEAM(pb + 10);
        if (EN(11) && IN(pb + 11) && !MF_MOE1) { REFRESH(F);
            int* off = (int*)F.smf; moe_offsets(F, l, off);
            const size_t total = (size_t)off[32] * 256; const bf16_t* GU = F.BR();
            for (size_t idx = (size_t)F.bid * NTHR + F.tid; idx < total; idx += (size_t)F.nb * NTHR) {
                const int r = (int)(idx >> 8), hc = (int)(idx & 255), j = hc >> 7, cc = hc & 127;
                const float g = bf2f(GU[(size_t)r * 512 + 256 * j + cc]), u = bf2f(GU[(size_t)r * 512 + 256 * j + 128 + cc]);
                F.HID()[(size_t)r * 256 + hc] = f2bf(siluf_(g) * u * F.roww()[r]);
            }
        }
        if (!MF_MOE1) SEAM(pb + 11);
        if (EN(12) && IN(pb + 12)) { REFRESH(F);
            int* off = offt; moe_offsets(F, l, off);
            const int Mtot = off[32], nt = (Mtot / 128) * 8, ty = F.tid >> 5, tx = F.tid & 31; bf16_t* Y = F.BR();
            if (MF_MOE2) {
                pg::SchedMoe S{(const char*)F.HID(), (const char*)F.Wd(), off, (size_t)256 * 256 * 2, (size_t)DM * 256 * 2, (size_t)256 * 256 * 2, Mtot / 256, 4, F.nb, F.bid};
                pg::EpiMoe2 E{Y, F.rmap(), (bf16_t*)(F.ws + WS_DUMP)};
                pg::gemm_phase(stage, 256, 256, 256, S, E);
            } else
            for (int t = F.bid; t < nt; t += F.nb) {
                const int row0 = (t >> 3) * 128, col0 = (t & 7) * 128, e = expert_of_row(off, row0);
                float acc[8][4];
#pragma unroll
                for (int i = 0; i < 8; ++i)
#pragma unroll
                    for (int j = 0; j < 4; ++j) acc[i][j] = 0.f;
                gemm_s_acc(acc, F.HID(), 256, F.Wd() + (size_t)e * DM * 256, 256, 256, row0, col0, F.smf, F.tid);
#pragma unroll
                for (int i = 0; i < 8; ++i) { const int s = F.rmap()[row0 + ty * 8 + i];
                    if (s >= 0) {
#pragma unroll
                        for (int j = 0; j < 4; ++j) Y[(size_t)s * DM + col0 + tx * 4 + j] = f2bf(acc[i][j]); } }
            }
        }
        SEAM(pb + 12);
        if (EN(13) && IN(pb + 13)) { REFRESH(F); phase_ln2(F, l); }
        SEAM(pb + 13);
    }
#undef IN
#undef SEAM
}

constexpr bool ONE_LAUNCH = true;
typedef void (*kern_t)(Params);
template <int I> struct KTab { static void fill(kern_t* t) { t[I] = mega<(1 << I)>; KTab<I - 1>::fill(t); } };
constexpr int GROUP_A = 0x4007;
template <> struct KTab<-1> { static void fill(kern_t*) {} };

extern "C" void kernel_launch(void* const* d_in, const int* in_sizes, int n_in, void* d_out, int out_size, void* d_ws, size_t ws_size, hipStream_t stream) {
    static int grid = 0;
    static kern_t ktab[16]; static kern_t kall = nullptr;
    if (grid == 0) {
        if (n_in != 23 || out_size != NTOK * DM || ws_size < WS_END) { fprintf(stderr, "kernel_launch: unexpected shapes (n_in %d out %d ws %zu need %zu)\n", n_in, out_size, ws_size, (size_t)WS_END); grid = -1; return; }
        int dev = 0, cus = 0;
        if (hipGetDevice(&dev) != hipSuccess || hipDeviceGetAttribute(&cus, hipDeviceAttributeMultiprocessorCount, dev) != hipSuccess) { grid = -1; return; }
        if (ONE_LAUNCH) {
            kall = mega<0x7FFF>;
            if (hipFuncSetAttribute((const void*)kall, hipFuncAttributeMaxDynamicSharedMemorySize, LDS_BYTES) != hipSuccess) { fprintf(stderr, "kernel_launch: hipFuncSetAttribute failed\n"); grid = -1; return; }
            int per_cu = 0;
            if (hipOccupancyMaxActiveBlocksPerMultiprocessor(&per_cu, (const void*)kall, NTHR, LDS_BYTES) != hipSuccess || per_cu < 1) { fprintf(stderr, "kernel_launch: occupancy query reports %d blocks per CU\n", per_cu); }
        } else {
            if constexpr (!ONE_LAUNCH) KTab<14>::fill(ktab);
            for (int i = 0; i < 15; ++i)
                if (hipFuncSetAttribute((const void*)ktab[i], hipFuncAttributeMaxDynamicSharedMemorySize, LDS_BYTES) != hipSuccess) { fprintf(stderr, "kernel_launch: hipFuncSetAttribute failed\n"); grid = -1; return; }
        }
        (void)hipGetLastError();
        grid = cus;
    }
    if (grid < 0) return;
    (void)hipMemsetAsync((char*)d_ws + WS_CTL, 0, CTL_BYTES, stream);
    Params p; memset(&p, 0, sizeof(p));
    const float** pp = (const float**)&p;
    for (int i = 0; i < 23; ++i) pp[i] = (const float*)d_in[i];
    p.out = (float*)d_out; p.ws = (unsigned char*)d_ws;
    if (ONE_LAUNCH) {
        p.ph_lo = 0; p.ph_hi = NPH;
        hipLaunchKernelGGL(kall, dim3(grid), dim3(NTHR), LDS_BYTES, stream, p);
    } else {
        for (int ph = 0; ph < NPH; ++ph) {
            p.ph_lo = ph; p.ph_hi = ph + 1;
            const int ki = (ph == 0) ? 14 : (ph - 1) % NPL;
            if (ki == 11 && MF_MOE1) continue;
            hipLaunchKernelGGL(ktab[ki], dim3(grid), dim3(NTHR), LDS_BYTES, stream, p);
        }
    }
}
```

```cpp
#include <hip/hip_runtime.h>
#include <cstdio>
#include <cstdint>
#include <cstring>

typedef unsigned short bf16_t;
typedef float f32x4 __attribute__((ext_vector_type(4)));
typedef unsigned u32x4 __attribute__((ext_vector_type(4)));
typedef unsigned u32x2 __attribute__((ext_vector_type(2)));

constexpr int NB = 4, SEQ = 4096, LC = 256, DM = 1024, DEPTH = 2;
constexpr int NTOK = NB * SEQ, NCTX = NB * LC, NROW = NTOK + NCTX;
constexpr int DIN = 10528;
constexpr int O_AQ = 0, O_AK = 256, O_AV = 512, O_AG = 1024, O_ALR = 1536, O_BQ = 1568, O_BK = 2080, O_BV = 2592, O_CQ = 3104, O_CK = 3616,
              O_CV = 3744, O_DQ = 3872, O_DF = 4384, O_DI = 5408, O_DG = 5920, O_GATE = 6432;
constexpr int PC_AQ = 0, PC_AK = 256, PC_AV = 512, PC_BQ = 1024, PC_BK = 1536, PC_CQ = 2048, PC_CK = 2560, PC_ALR = 2688, PC_DQ = 2816,
              PC_DF = 3328, PC_DI = 4352, PC_AG = 4864, PC_DG = 5376, NP1 = 5888;
constexpr float QSCALE = 0.125f * 1.44269504089f;
constexpr int NVT = 768;
constexpr int NVR = 640;
constexpr int NGATE = 4096;
constexpr int XS_ROWS = 40960;
constexpr float LN_EPS = 1e-5f;
constexpr float ALPHA = 1.41421356237f;

constexpr size_t al256(size_t x) { return (x + 255) & ~(size_t)255; }
constexpr size_t WS_CTL = 0;
constexpr size_t CTL_BYTES = 32768;
constexpr size_t CTL_CNT = 28672;
constexpr size_t WS_DUMP = WS_CTL + CTL_BYTES;
constexpr size_t WS_MODV = WS_DUMP + 4096;
constexpr size_t WS_LB = WS_MODV + al256((size_t)DEPTH * 5 * 6144 * 4);
constexpr size_t WS_TOKE = WS_LB + 4096;
constexpr size_t WS_TOKI = WS_TOKE + al256((size_t)2 * NROW * 4);
constexpr size_t WS_TOKW = WS_TOKI + al256((size_t)2 * NROW * 4);
constexpr size_t WS_RMAP = WS_TOKW + al256((size_t)2 * NROW * 4);
constexpr size_t WS_ROWW = WS_RMAP + al256((size_t)XS_ROWS * 4);
constexpr size_t WS_CXM = WS_ROWW + al256((size_t)XS_ROWS * 4);
constexpr size_t WS_CXO = WS_CXM + (size_t)NCTX * DM * 4;
constexpr size_t WS_WTA = WS_CXO + (size_t)NCTX * DM * 4;
constexpr size_t WTA_W1 = 0;
constexpr size_t WTA_WV = WTA_W1 + (size_t)NP1 * DM * 2;
constexpr size_t WTA_WG = WTA_WV + (size_t)NVT * DM * 2;
constexpr size_t WTA_WBR = WTA_WG + (size_t)NGATE * DM * 2;
constexpr size_t WTA_WO = WTA_WBR + (size_t)4 * DM * 512 * 2;
constexpr size_t WTA_BYTES = WTA_WO + (size_t)DM * DM * 2;
constexpr size_t WS_HX = WS_WTA + WTA_BYTES;
constexpr size_t WS_VT = WS_HX + (size_t)NROW * DM * 2;
constexpr size_t WS_OBA = WS_VT + (size_t)NVT * NROW * 2;
constexpr size_t WS_HX2 = WS_VT;
constexpr size_t WS_HID = WS_VT;
constexpr size_t WS_VR = WS_OBA + (size_t)NROW * 512 * 2;
constexpr size_t WS_BR = WS_VR + (size_t)NROW * NVR * 2;
constexpr size_t WS_P1 = WS_BR + (size_t)NROW * 2048 * 2;
constexpr size_t WS_G = WS_P1;
constexpr size_t WS_WGU = WS_P1 + (size_t)NROW * NGATE * 2;
constexpr size_t WS_WD = WS_WGU + (size_t)32 * 512 * DM * 2;
constexpr size_t WS_XS = WS_P1;
constexpr size_t WS_END = WS_P1 + (size_t)NROW * NP1 * 2;
static_assert(WS_WD + (size_t)32 * DM * 256 * 2 <= WS_END, "moe weights must fit in the P1 tail");
static_assert((size_t)XS_ROWS * DM * 2 <= (size_t)NROW * NGATE * 2, "XS must fit in the G region");
static_assert((size_t)NVT * NROW * 2 + (size_t)NROW * 512 * 2 >= (size_t)NROW * DM * 2, "HX2 alias");
static_assert(WS_END <= 434800000ull, "workspace budget");

constexpr int NTHR = 512;
constexpr int LDS_STAGE = 1024;
constexpr int LDS_ROPE = 1024 + 131072 + 1024;
constexpr int LDS_BYTES = 144 * 1024;

struct Params {
    const float *x, *c, *ctx, *c_ctx, *w_mod, *b_mod, *w_in, *gla_lr_w, *gla_lr_b, *hg_gamma, *na_rpb, *wa_sink, *w_branch, *w_out, *ln_g, *ln_b,
        *moe_w_group, *moe_b_group, *moe_w_expert, *moe_b_expert, *moe_w_gate, *moe_w_up, *moe_w_down;
    float* out;
    unsigned char* ws;
    int ph_lo, ph_hi;
};

__device__ __forceinline__ float bf2f(bf16_t b) { return __uint_as_float(((unsigned)b) << 16); }
__device__ __forceinline__ bf16_t f2bf(float f) { unsigned u = __float_as_uint(f); u += 0x7FFFu + ((u >> 16) & 1u); return (bf16_t)(u >> 16); }
typedef float f32x2_t __attribute__((ext_vector_type(2)));
typedef __bf16 bf16x2_t __attribute__((ext_vector_type(2)));
__device__ __forceinline__ unsigned pk2(float lo, float hi) {
    const f32x2_t v = {lo, hi}; const bf16x2_t b = __builtin_convertvector(v, bf16x2_t); return __builtin_bit_cast(unsigned, b); }
__device__ __forceinline__ void ld8(const bf16_t* p, float* f) {
    const u32x4 v = *(const u32x4*)p;
    f[0] = __uint_as_float(v.x << 16); f[1] = __uint_as_float(v.x & 0xffff0000u);
    f[2] = __uint_as_float(v.y << 16); f[3] = __uint_as_float(v.y & 0xffff0000u);
    f[4] = __uint_as_float(v.z << 16); f[5] = __uint_as_float(v.z & 0xffff0000u);
    f[6] = __uint_as_float(v.w << 16); f[7] = __uint_as_float(v.w & 0xffff0000u);
}
__device__ __forceinline__ void st8(bf16_t* p, const float* f) {
    u32x4 v; v.x = pk2(f[0], f[1]); v.y = pk2(f[2], f[3]); v.z = pk2(f[4], f[5]); v.w = pk2(f[6], f[7]);
    *(u32x4*)p = v;
}
__device__ __forceinline__ float sigmoidf_(float x) { return __builtin_amdgcn_rcpf(1.f + __expf(-x)); }
__device__ __forceinline__ float siluf_(float x) { return x * __builtin_amdgcn_rcpf(1.f + __expf(-x)); }
__device__ __forceinline__ float wave_sum(float v) {
#pragma unroll
    for (int o = 1; o < 64; o <<= 1) v += __shfl_xor(v, o);
    return v;
}
__device__ __forceinline__ int row_batch(int row) { return row < NTOK ? (row >> 12) : 4; }

#define XB_TMO      128
#define XB_XCNT(j)  (256  + 64 * (j))
#define XB_XSUB(j)  (1280 + 64 * (j))
#define XB_XGEN(j)  (2304 + 64 * (j))
#define XB_TOP      3328
#define XB_TOPGEN   3392
#define XCD_BAR_WORDS 3456
#define XB_SPIN_CAP (1u << 18)
#define LAS __attribute__((address_space(3)))
__device__ __forceinline__ unsigned xb_ld(unsigned* p)              { return __hip_atomic_load(p, __ATOMIC_RELAXED, __HIP_MEMORY_SCOPE_AGENT); }
__device__ __forceinline__ unsigned xb_add(unsigned* p, unsigned v) { return __hip_atomic_fetch_add(p, v, __ATOMIC_RELAXED, __HIP_MEMORY_SCOPE_AGENT); }
__device__ __forceinline__ unsigned xb_xcc_id() { return (unsigned)__builtin_amdgcn_s_getreg((3 << 11) | 20) & 0xFu; }
#define XB_SPIN(cond, bar) do { unsigned _sp = 0; while (cond) { __builtin_amdgcn_s_sleep(1); \
    if ((++_sp & 255u) == 0u) { if (xb_ld(&(bar)[XB_TMO])) break; if (_sp > XB_SPIN_CAP) { atomicAdd(&(bar)[XB_TMO], 1u); break; } } } } while (0)
struct XcdBarrier { unsigned* bar; unsigned x; volatile LAS unsigned* st; };
__device__ __forceinline__ XcdBarrier xcd_barrier_post(unsigned* bar, volatile LAS unsigned* st) {
    XcdBarrier b; b.bar = bar; b.x = xb_xcc_id(); b.st = st;
    if (threadIdx.x == 0) (void)xb_add(&bar[XB_XCNT(b.x)], 1u);
    return b;
}
__device__ __forceinline__ void xcd_barrier_complete(unsigned* bar, unsigned x, unsigned& nloc, unsigned& nx) {
    const unsigned G = gridDim.x * gridDim.y * gridDim.z;
    unsigned sum, cnt, mine, sp = 0u;
    for (;;) {
        sum = 0u; cnt = 0u; mine = 0u;
#pragma unroll
        for (unsigned j = 0; j < 16; ++j) { const unsigned c = xb_ld(&bar[XB_XCNT(j)]); sum += c; cnt += (c > 0u) ? 1u : 0u; mine = (j == x) ? c : mine; }
        if (sum == G) break;
        __builtin_amdgcn_s_sleep(1);
        if ((++sp & 255u) == 0u) { if (xb_ld(&bar[XB_TMO])) break; if (sp > XB_SPIN_CAP) { atomicAdd(&bar[XB_TMO], 1u); break; } }
    }
    nloc = mine > 0u ? mine : 1u; nx = cnt > 0u ? cnt : 1u;
}
__device__ __forceinline__ void xcd_barrier(const XcdBarrier& b) {
    asm volatile("s_waitcnt vmcnt(0)" ::: "memory");
    __syncthreads();
    if (threadIdx.x == 0) {
        unsigned* bar = b.bar;
        __builtin_amdgcn_s_waitcnt(0);
        unsigned nloc = b.st[0], nx = b.st[1];
        if (nloc == 0u) { xcd_barrier_complete(bar, b.x, nloc, nx); b.st[0] = nloc; b.st[1] = nx; }
        const unsigned old = xb_add(&bar[XB_XSUB(b.x)], 1u);
        const unsigned gen = old / nloc;
        if (old + 1u == (gen + 1u) * nloc) {
            __builtin_amdgcn_fence(__ATOMIC_RELEASE, "agent");
            asm volatile("s_waitcnt vmcnt(0)" ::: "memory");
            const unsigned og = xb_add(&bar[XB_TOP], 1u);
            const unsigned tg = og / nx;
            if (og + 1u == (tg + 1u) * nx) xb_add(&bar[XB_TOPGEN], 1u);
            else XB_SPIN(xb_ld(&bar[XB_TOPGEN]) == tg, bar);
            __builtin_amdgcn_fence(__ATOMIC_ACQUIRE, "agent");
            xb_add(&bar[XB_XGEN(b.x)], 1u);
            asm volatile("s_waitcnt vmcnt(0)" ::: "memory");
        } else {
            XB_SPIN(xb_ld(&bar[XB_XGEN(b.x)]) == gen, bar);
            __builtin_amdgcn_fence(__ATOMIC_ACQUIRE, "agent");
            asm volatile("s_waitcnt vmcnt(0)" ::: "memory");
        }
    }
    __syncthreads();
}

struct Frame {
    Params p;
    int bid, nb, tid, lane, wave, wid_s;
    float* smf;
    unsigned char* ws;
    __device__ __forceinline__ float* modv() const { return (float*)(ws + WS_MODV); }
    __device__ __forceinline__ float* lb() const { return (float*)(ws + WS_LB); }
    __device__ __forceinline__ int* tokE() const { return (int*)(ws + WS_TOKE); }
    __device__ __forceinline__ int* tokI() const { return (int*)(ws + WS_TOKI); }
    __device__ __forceinline__ float* tokW() const { return (float*)(ws + WS_TOKW); }
    __device__ __forceinline__ int* rmap() const { return (int*)(ws + WS_RMAP); }
    __device__ __forceinline__ float* roww() const { return (float*)(ws + WS_ROWW); }
    __device__ __forceinline__ float* cxm() const { return (float*)(ws + WS_CXM); }
    __device__ __forceinline__ float* cxo() const { return (float*)(ws + WS_CXO); }
    __device__ __forceinline__ bf16_t* W1t() const { return (bf16_t*)(ws + WS_WTA + WTA_W1); }
    __device__ __forceinline__ bf16_t* Wvt() const { return (bf16_t*)(ws + WS_WTA + WTA_WV); }
    __device__ __forceinline__ bf16_t* Wgt() const { return (bf16_t*)(ws + WS_WTA + WTA_WG); }
    __device__ __forceinline__ bf16_t* Wbrt() const { return (bf16_t*)(ws + WS_WTA + WTA_WBR); }
    __device__ __forceinline__ bf16_t* Woutt() const { return (bf16_t*)(ws + WS_WTA + WTA_WO); }
    __device__ __forceinline__ bf16_t* HX() const { return (bf16_t*)(ws + WS_HX); }
    __device__ __forceinline__ bf16_t* VT() const { return (bf16_t*)(ws + WS_VT); }
    __device__ __forceinline__ bf16_t* OBA() const { return (bf16_t*)(ws + WS_OBA); }
    __device__ __forceinline__ bf16_t* HX2() const { return (bf16_t*)(ws + WS_HX2); }
    __device__ __forceinline__ bf16_t* HID() const { return (bf16_t*)(ws + WS_HID); }
    __device__ __forceinline__ bf16_t* VR() const { return (bf16_t*)(ws + WS_VR); }
    __device__ __forceinline__ bf16_t* BR() const { return (bf16_t*)(ws + WS_BR); }
    __device__ __forceinline__ bf16_t* P1() const { return (bf16_t*)(ws + WS_P1); }
    __device__ __forceinline__ bf16_t* G() const { return (bf16_t*)(ws + WS_G); }
    __device__ __forceinline__ bf16_t* Wgu() const { return (bf16_t*)(ws + WS_WGU); }
    __device__ __forceinline__ bf16_t* Wd() const { return (bf16_t*)(ws + WS_WD); }
    __device__ __forceinline__ bf16_t* XS() const { return (bf16_t*)(ws + WS_XS); }
    __device__ __forceinline__ unsigned* cnt() const { return (unsigned*)(ws + WS_CTL + CTL_CNT); }
};


#define REFRESH(F) do { int _t = threadIdx.x; asm volatile("" : "+v"(_t)); (F).tid = _t; (F).lane = _t & 63; (F).wave = _t >> 6; } while (0)

__device__ __forceinline__ void phase_mod(Frame& F) {
    float* sc = F.smf;
    float* red = F.smf + 5 * 1024;
    bool have = false;
    for (int it = F.bid; it < DEPTH * 96; it += F.nb) {
        if (!have) {
            for (int i = F.tid; i < 5 * 1024; i += NTHR) { const float v = (i < 4096) ? F.p.c[i] : F.p.c_ctx[i - 4096]; sc[i] = siluf_(v); }
            __syncthreads(); have = true;
        }
        const int l = it / 96, n0 = (it % 96) * 64, col = F.tid & 63, kg = F.tid >> 6;
        const float* w = F.p.w_mod + (size_t)l * DM * 6144 + n0 + col;
        float a[5] = {0.f, 0.f, 0.f, 0.f, 0.f};
        for (int k = kg * 128; k < kg * 128 + 128; ++k) {
            const float wv = w[(size_t)k * 6144];
#pragma unroll
            for (int r = 0; r < 5; ++r) a[r] += sc[r * 1024 + k] * wv;
        }
#pragma unroll
        for (int r = 0; r < 5; ++r) red[(kg * 5 + r) * 64 + col] = a[r];
        __syncthreads();
        if (F.tid < 320) {
            const int r = F.tid >> 6, cc = F.tid & 63; float s = F.p.b_mod[l * 6144 + n0 + cc];
#pragma unroll
            for (int g = 0; g < 8; ++g) s += red[(g * 5 + r) * 64 + cc];
            F.modv()[((size_t)l * 5 + r) * 6144 + n0 + cc] = s;
        }
        __syncthreads();
    }
    if (F.bid == F.nb - 1) {
        for (int i = F.tid; i < 1024; i += NTHR) { const int z = i >> 9, f = i & 511;
            const float g0 = F.p.hg_gamma[(z * DEPTH + 0) * 512 + f], g1 = F.p.hg_gamma[(z * DEPTH + 1) * 512 + f];
            F.lb()[i] = 1.f / (1.f + expf(g0 - g1)); }
    }
}

__device__ __forceinline__ int p1_src(int n, float& scale) {
    scale = 1.f;
    if (n < 256) { scale = 0.125f; return O_AQ + n; }
    if (n < 512) return O_AK + (n - 256);
    if (n < 1024) return O_AV + (n - 512);
    if (n < 1536) { scale = QSCALE; return O_BQ + (n - 1024); }
    if (n < 2048) return O_BK + (n - 1536);
    if (n < 2560) { scale = QSCALE; return O_CQ + (n - 2048); }
    if (n < 2688) return O_CK + (n - 2560);
    if (n < 2720) return O_ALR + (n - 2688);
    if (n < 2816) return -1;
    if (n < 3328) return O_DQ + (n - 2816);
    if (n < 4352) return O_DF + (n - 3328);
    if (n < 4864) return O_DI + (n - 4352);
    if (n < 5376) return O_AG + (n - 4864);
    return O_DG + (n - 5376);
}
__device__ __forceinline__ void conv_item(const float* src, int ldsrc, int srccol, float scale, bf16_t* dst, int K, int k0, float* scr, int lane) {
    if (srccol >= 0) {
#pragma unroll 8
        for (int i = 0; i < 32; ++i) { const int kk = 2 * i + (lane >> 5); scr[kk * 33 + (lane & 31)] = src[(size_t)(k0 + kk) * ldsrc + srccol + (lane & 31)] * scale; }
    } else {
#pragma unroll 8
        for (int i = 0; i < 32; ++i) { const int kk = 2 * i + (lane >> 5); scr[kk * 33 + (lane & 31)] = 0.f; }
    }
    asm volatile("s_waitcnt lgkmcnt(0)" ::: "memory");
    const int c = lane & 7;
#pragma unroll
    for (int j = 0; j < 4; ++j) { const int nn = (lane >> 3) + 8 * j; const float* sp = scr + (8 * c) * 33 + nn;
        u32x4 o; o.x = pk2(sp[0 * 33], sp[1 * 33]); o.y = pk2(sp[2 * 33], sp[3 * 33]); o.z = pk2(sp[4 * 33], sp[5 * 33]); o.w = pk2(sp[6 * 33], sp[7 * 33]);
        *(u32x4*)(dst + (size_t)nn * K + 8 * c) = o; }
    asm volatile("s_waitcnt lgkmcnt(0)" ::: "memory");
}
constexpr int CONVA_W1 = (NP1 / 32) * 16;
constexpr int CONVA_ITEMS = CONVA_W1 + 384 + 2048 + 1024 + 512;
__device__ __forceinline__ void phase_conv_a(Frame& F, int l) {
    float* scr = F.smf + F.wave * (64 * 33);
    const int gw = F.bid * 8 + F.wave, ngw = F.nb * 8;
    for (int it0 = gw; it0 < CONVA_ITEMS; it0 += ngw) {
        int ti = it0;
        if (ti < CONVA_W1) { const int n0 = (ti >> 4) * 32, kt = ti & 15; float sc; const int sx = p1_src(n0, sc);
            conv_item(F.p.w_in + (size_t)l * DM * DIN, DIN, sx, sc, F.W1t() + (size_t)n0 * DM + kt * 64, DM, kt * 64, scr, F.lane); continue; }
        ti -= CONVA_W1;
        if (ti < 384) { const int n0 = (ti >> 4) * 32, kt = ti & 15; const int sx = n0 < 512 ? O_BV + n0 : (n0 < 640 ? O_CV + (n0 - 512) : -1);
            conv_item(F.p.w_in + (size_t)l * DM * DIN, DIN, sx, 1.f, F.Wvt() + (size_t)n0 * DM + kt * 64, DM, kt * 64, scr, F.lane); continue; }
        ti -= 384;
        if (ti < 2048) { const int n0 = (ti >> 4) * 32, kt = ti & 15;
            conv_item(F.p.w_in + (size_t)l * DM * DIN, DIN, O_GATE + n0, 1.f, F.Wgt() + (size_t)n0 * DM + kt * 64, DM, kt * 64, scr, F.lane); continue; }
        ti -= 2048;
        if (ti < 1024) { const int i = ti >> 8, r = ti & 255, n0 = (r >> 3) * 32, kt = r & 7;
            conv_item(F.p.w_branch + (size_t)(l * 4 + i) * 512 * DM, DM, n0, 1.f, F.Wbrt() + (size_t)i * DM * 512 + (size_t)n0 * 512 + kt * 64, 512, kt * 64, scr, F.lane); continue; }
        ti -= 1024;
        { const int n0 = (ti >> 4) * 32, kt = ti & 15;
          conv_item(F.p.w_out + (size_t)l * DM * DM, DM, n0, 1.f, F.Woutt() + (size_t)n0 * DM + kt * 64, DM, kt * 64, scr, F.lane); }
    }
}
constexpr int CONVB_ITEMS = 8192 + 4096;
__device__ __forceinline__ void phase_conv_b(Frame& F, int l) {
    float* scr = F.smf + F.wave * (64 * 33);
    const int gw = F.bid * 8 + F.wave, ngw = F.nb * 8;
    for (int it0 = gw; it0 < CONVB_ITEMS; it0 += ngw) {
        int ti = it0;
        if (ti < 8192) { const int e = ti >> 8, r = ti & 255, n0 = (r >> 4) * 32, kt = r & 15, j = n0 >> 8, rr = n0 & 255; const bool isup = rr >= 128; const int cc = 128 * j + (rr & 127);
            const float* src = (isup ? F.p.moe_w_up : F.p.moe_w_gate) + (size_t)(l * 32 + e) * DM * 256;
            conv_item(src, 256, cc, 1.f, F.Wgu() + (size_t)e * 512 * DM + (size_t)n0 * DM + kt * 64, DM, kt * 64, scr, F.lane); continue; }
        ti -= 8192;
        { const int e = ti >> 7, r = ti & 127, n0 = (r >> 2) * 32, kt = r & 3;
          conv_item(F.p.moe_w_down + (size_t)(l * 32 + e) * 256 * DM, DM, n0, 1.f, F.Wd() + (size_t)e * DM * 256 + (size_t)n0 * 256 + kt * 64, 256, kt * 64, scr, F.lane); }
    }
}

__device__ __forceinline__ void phase_prep(Frame& F, int l, const float* xlat, const float* xctx) {
    const int gw = F.bid * 8 + F.wave, ngw = F.nb * 8;
    for (int row = gw; row < NROW; row += ngw) {
        const float* xr = row < NTOK ? xlat + (size_t)row * DM : xctx + (size_t)(row - NTOK) * DM;
        const float* mv = F.modv() + ((size_t)l * 5 + row_batch(row)) * 6144;
#pragma unroll
        for (int j = 0; j < 4; ++j) { const int d = j * 256 + F.lane * 4;
            const f32x4 v = *(const f32x4*)(xr + d), m0 = *(const f32x4*)(mv + d), m1 = *(const f32x4*)(mv + 1024 + d);
            u32x2 o; o.x = pk2(v.x * (1.f + m1.x) + m0.x, v.y * (1.f + m1.y) + m0.y); o.y = pk2(v.z * (1.f + m1.z) + m0.z, v.w * (1.f + m1.w) + m0.w);
            *(u32x2*)(F.HX() + (size_t)row * DM + d) = o; }
    }
}


namespace pg {
typedef short bf16x8 __attribute__((ext_vector_type(8)));
constexpr int BM = 256, BK = 64, HALF = 128, HTB = HALF * BK * 2, STAGE_BYTES = 8 * HTB, NXCD = 8, WGM = 8;
__device__ __forceinline__ int lds_byte(int r, int c) { const int st = (r >> 4) * 2 + (c >> 5), rr = r & 15, cc = c & 31, ob = rr * 64 + cc * 2; return st * 1024 + (ob ^ (((ob >> 9) & 1) << 5)); }
__device__ __forceinline__ void stage_rc(int b, int& R, int& C) { const int st = b / 1024, sb = b % 1024, swz = sb ^ (((sb >> 9) & 1) << 5); R = (st >> 1) * 16 + swz / 64; C = (st & 1) * 32 + (swz % 64) / 2; }
struct Unit { const char* a; const char* b; int pm, pn, aux; };
__device__ __forceinline__ void static_map(int L, int nM, int nN, int& pm, int& pn) {
    const int nwg = nM * nN; int wgid = L; { const int q = nwg / NXCD, r = nwg % NXCD, xcd = wgid % NXCD, off = wgid / NXCD; wgid = (xcd < r ? xcd * (q + 1) : r * (q + 1) + (xcd - r) * q) + off; }
    const int nig = WGM * nN, gid = wgid / nig, fm = gid * WGM, gsz = (nM - fm) < WGM ? (nM - fm) : WGM;
    pm = fm + ((wgid % nig) % gsz); pn = (wgid % nig) / gsz;
}
template <class Epi, class Sched>
__device__ __forceinline__ void gemm_phase(LAS unsigned char* lds, const int lda, const int ldb, const int K, const Sched& S, const Epi& E) {
    int tid = threadIdx.x; asm volatile("" : "+v"(tid));
    const int wid = __builtin_amdgcn_readfirstlane(tid >> 6), lane = tid & 63, wr = wid >> 2, wc = wid & 3, fr = lane & 15, fq = lane >> 4;
    int nt = K / BK; asm volatile("" : "+s"(nt));
    unsigned voffA[2], voffB[2];
#pragma unroll
    for (int i = 0; i < 2; ++i) { int R, C; stage_rc(tid * 16 + i * 8192, R, C); voffA[i] = (unsigned)(R * lda + C) * 2u; voffB[i] = (unsigned)(R * ldb + C) * 2u; }
    const size_t kstep = (size_t)(BK * 2);
    const size_t hstepA = (size_t)HALF * lda * 2, hstepB = (size_t)HALF * ldb * 2;
    const unsigned ldsw = (unsigned)wid * 1024u;
    const int aoff = lds_byte(wr * 64 + fr, fq * 8), boff = lds_byte(wc * 32 + fr, fq * 8);
#define PG_SA(b, h) (((b) * 2 + (h)) * HTB)
#define PG_SB(b, h) ((4 + (b) * 2 + (h)) * HTB)
#define PG_STAGE(bufoff, gbase, voff) do { _Pragma("unroll") for (int _i = 0; _i < 2; ++_i) \
        __builtin_amdgcn_global_load_lds((const unsigned*)((const char*)(gbase) + (voff)[_i]), (LAS unsigned*)(lds + (bufoff) + ldsw + _i * 8192), 16, 0, 0); } while (0)
#define PG_LDA(dst, b, h) do { _Pragma("unroll") for (int m = 0; m < 4; ++m) _Pragma("unroll") for (int k = 0; k < 2; ++k) dst[m][k] = *(const LAS bf16x8*)(lds + PG_SA(b, h) + aoff + m * 2048 + k * 1024); } while (0)
#define PG_LDB(dst, b, h) do { _Pragma("unroll") for (int n = 0; n < 2; ++n) _Pragma("unroll") for (int k = 0; k < 2; ++k) dst[n][k] = *(const LAS bf16x8*)(lds + PG_SB(b, h) + boff + n * 2048 + k * 1024); } while (0)
#define PG_MMA(ai, bj, At, Bt) do { __builtin_amdgcn_s_setprio(1); _Pragma("unroll") for (int m = 0; m < 4; ++m) _Pragma("unroll") for (int n = 0; n < 2; ++n) _Pragma("unroll") for (int k = 0; k < 2; ++k) \
        acc[ai][bj][m][n] = __builtin_amdgcn_mfma_f32_16x16x32_bf16(Bt[n][k], At[m][k], acc[ai][bj][m][n], 0, 0, 0); __builtin_amdgcn_s_setprio(0); } while (0)
#define PG_WAIT_V(n) asm volatile("s_waitcnt vmcnt(" #n ")" ::: "memory")
#define PG_WAIT_L(n) asm volatile("s_waitcnt lgkmcnt(" #n ")" ::: "memory")
#define PG_BAR __builtin_amdgcn_s_barrier()
#define PG_SCHED __builtin_amdgcn_sched_barrier(0)
    Unit cur, nxt; int ui = 0;
    if (!S.next(0, cur)) return;
    f32x4 acc[2][2][4][2];
#pragma unroll
    for (int a = 0; a < 2; ++a)
#pragma unroll
        for (int b = 0; b < 2; ++b)
#pragma unroll
            for (int m = 0; m < 4; ++m)
#pragma unroll
                for (int n = 0; n < 2; ++n) acc[a][b][m][n] = (f32x4){0.f, 0.f, 0.f, 0.f};
    bf16x8 At[4][2], B0[2][2], B1[2][2];
    const char* cA = cur.a; const char* cB = cur.b;
    PG_STAGE(PG_SB(0, 0), cB, voffB); PG_STAGE(PG_SA(0, 0), cA, voffA); PG_STAGE(PG_SB(0, 1), cB + hstepB, voffB); PG_STAGE(PG_SA(0, 1), cA + hstepA, voffA);
    if (wr == 1) PG_BAR;
    PG_WAIT_V(4); PG_BAR;
    PG_STAGE(PG_SB(1, 0), cB + kstep, voffB); PG_STAGE(PG_SA(1, 0), cA + kstep, voffA); PG_STAGE(PG_SB(1, 1), cB + hstepB + kstep, voffB);
    PG_WAIT_V(6); PG_BAR;
    for (;;) {
        const bool has_next = S.next(ui + 1, nxt);
        const char* nA = has_next ? nxt.a : cA; const char* nB = has_next ? nxt.b : cB;
        for (int t = 0; t < nt; t += 2) {
            const bool last = (t == nt - 2);
            const char* a1 = cA + (size_t)(t + 1) * kstep;
            const char* a2 = last ? nA : cA + (size_t)(t + 2) * kstep; const char* b2 = last ? nB : cB + (size_t)(t + 2) * kstep;
            const char* a3 = a2 + kstep; const char* b3 = b2 + kstep;
            PG_LDB(B0, 0, 0); PG_SCHED; PG_LDA(At, 0, 0); PG_STAGE(PG_SA(1, 1), a1 + hstepA, voffA);
            PG_WAIT_L(8); PG_BAR; PG_WAIT_L(0); PG_MMA(0, 0, At, B0); PG_BAR; PG_SCHED;
            PG_LDB(B1, 0, 1); PG_STAGE(PG_SB(0, 0), b2, voffB);
            PG_BAR; PG_WAIT_L(0); PG_MMA(0, 1, At, B1); PG_BAR;
            PG_LDA(At, 0, 1); PG_STAGE(PG_SA(0, 0), a2, voffA);
            PG_BAR; PG_WAIT_L(0); PG_MMA(1, 0, At, B0); PG_BAR; PG_SCHED;
            PG_STAGE(PG_SB(0, 1), b2 + hstepB, voffB);
            PG_WAIT_V(6); PG_BAR; PG_MMA(1, 1, At, B1); PG_BAR;
            PG_LDB(B0, 1, 0); PG_SCHED; PG_LDA(At, 1, 0); PG_STAGE(PG_SA(0, 1), a2 + hstepA, voffA);
            PG_WAIT_L(8); PG_BAR; PG_WAIT_L(0); PG_MMA(0, 0, At, B0); PG_BAR; PG_SCHED;
            PG_LDB(B1, 1, 1); PG_STAGE(PG_SB(1, 0), b3, voffB);
            PG_BAR; PG_WAIT_L(0); PG_MMA(0, 1, At, B1); PG_BAR;
            PG_LDA(At, 1, 1); PG_STAGE(PG_SA(1, 0), a3, voffA);
            PG_BAR; PG_WAIT_L(0); PG_MMA(1, 0, At, B0); PG_BAR; PG_SCHED;
            PG_STAGE(PG_SB(1, 1), b3 + hstepB, voffB);
            PG_WAIT_V(6); PG_BAR; PG_MMA(1, 1, At, B1); PG_BAR;
        }
        E(acc, cur, wr, wc, fr, fq);
        if (!has_next) break;
#pragma unroll
        for (int a = 0; a < 2; ++a)
#pragma unroll
            for (int b = 0; b < 2; ++b)
#pragma unroll
                for (int m = 0; m < 4; ++m)
#pragma unroll
                    for (int n = 0; n < 2; ++n) acc[a][b][m][n] = (f32x4){0.f, 0.f, 0.f, 0.f};
        cur = nxt; cA = nA; cB = nB; ++ui;
    }
    PG_WAIT_V(0);
    if (wr == 0) PG_BAR;
    PG_BAR;
#undef PG_SA
#undef PG_SB
#undef PG_STAGE
#undef PG_LDA
#undef PG_LDB
#undef PG_MMA
#undef PG_WAIT_V
#undef PG_WAIT_L
#undef PG_BAR
#undef PG_SCHED
}

struct SchedG1 {
    const char *HX, *W1, *WV; int G, c;
    __device__ __forceinline__ bool next(int i, Unit& u) const {
        const int L = i * G + c, nmain = (NROW / 256) * (NP1 / 256);
        if (L < nmain) { static_map(L, NROW / 256, NP1 / 256, u.pm, u.pn); u.a = HX + (size_t)u.pm * 256 * DM * 2; u.b = W1 + (size_t)u.pn * 256 * DM * 2; u.aux = 0; return true; }
        const int idx = L - nmain; if (idx >= 3 * (NROW / 256)) return false;
        u.pm = idx % 3; u.pn = idx / 3; u.a = WV + (size_t)u.pm * 256 * DM * 2; u.b = HX + (size_t)u.pn * 256 * DM * 2; u.aux = 1; return true;
    }
};
struct SchedStatic {
    const char *A, *B; size_t tA, tB; int nM, nN, G, c;
    __device__ __forceinline__ bool next(int i, Unit& u) const {
        const int L = i * G + c; if (L >= nM * nN) return false;
        static_map(L, nM, nN, u.pm, u.pn); u.a = A + (size_t)u.pm * tA; u.b = B + (size_t)u.pn * tB; u.aux = 0; return true;
    }
};
struct SchedMerge {
    const char *BR, *W; int ntile, G, c;
    __device__ __forceinline__ bool next(int i, Unit& u) const {
        const int t = c + (i >> 2) * G; if (t >= ntile) return false;
        const int br = i & 3; u.pm = t >> 2; u.pn = t & 3; u.aux = br;
        u.a = BR + (size_t)u.pm * 256 * 2048 * 2 + (size_t)br * 512 * 2; u.b = W + (size_t)br * DM * 512 * 2 + (size_t)u.pn * 256 * 512 * 2; return true;
    }
};
struct SchedMoe {
    const char *A, *W; const int* off; size_t tA, wE, wT; int npan, NJ, G, c;
    __device__ __forceinline__ bool next(int i, Unit& u) const {
        const int L = i * G + c; if (L >= npan * NJ) return false;
        const int p = L / NJ, j = L % NJ; int e = 0;
#pragma unroll 1
        for (int q = 1; q < 32; ++q) if (p * 256 >= off[q]) e = q;
        e = __builtin_amdgcn_readfirstlane(e);
        u.pm = p; u.pn = j; u.aux = e; u.a = A + (size_t)p * tA; u.b = W + (size_t)e * wE + (size_t)j * wT; return true;
    }
};

#define PG_ROWCOL const int row0 = u.pm * BM + wr * 64 + fr, col0 = u.pn * BM + wc * 32 + 4 * fq
struct EpiG1 { bf16_t *P1, *VT; const float* rtab; const float* lbp; int layer;
    __device__ __forceinline__ void operator()(const f32x4 (&acc)[2][2][4][2], const Unit& u, int wr, int wc, int fr, int fq) const {
        PG_ROWCOL; bf16_t* base = u.aux ? VT : P1; const size_t ld = u.aux ? (size_t)NROW : (size_t)NP1;
        const int mode = u.aux ? 0 : ((u.pn >= 8 && u.pn <= 10) ? ((u.pm < NTOK / 256) ? 1 : 0) : ((u.pn == 11 || u.pn == 12) ? 2 : ((u.pn >= 13 && u.pn <= 16) ? 3 : 0)));
#pragma unroll
        for (int ai = 0; ai < 2; ++ai)
#pragma unroll
            for (int m = 0; m < 4; ++m) { const int r = row0 + ai * HALF + m * 16; bf16_t* rowp = base + (size_t)r * ld + col0;
#pragma unroll
                for (int bj = 0; bj < 2; ++bj) {
                    f32x4 v0 = acc[ai][bj][m][0], v1 = acc[ai][bj][m][1];
                    if (mode == 1 && !(u.pn == 10 && bj == 1)) {
                        const int pos = r & (SEQ - 1), pp = (wc & 1) ? (pos & 63) : (pos >> 6); const float* tp = rtab + (pp * 16 + 4 * fq) * 2;
                        const f32x4 t0 = *(const f32x4*)tp, t1 = *(const f32x4*)(tp + 4);
                        const f32x4 a = v0, b = v1;
                        v0.x = a.x * t0.x - b.x * t0.y; v1.x = a.x * t0.y + b.x * t0.x; v0.y = a.y * t0.z - b.y * t0.w; v1.y = a.y * t0.w + b.y * t0.z;
                        v0.z = a.z * t1.x - b.z * t1.y; v1.z = a.z * t1.y + b.z * t1.x; v0.w = a.w * t1.z - b.w * t1.w; v1.w = a.w * t1.w + b.w * t1.z;
                    } else if (mode == 2) {
#pragma unroll
                        for (int j = 0; j < 4; ++j) { v0[j] = v0[j] * __builtin_amdgcn_rcpf(1.f + __expf(-v0[j])); v1[j] = v1[j] * __builtin_amdgcn_rcpf(1.f + __expf(-v1[j])); }
                    } else if (mode == 3) {
                        const int z = (u.pn - 13) >> 1, cb = z * 512 + ((u.pn - 13) & 1) * 256 + bj * HALF + wc * 32 + 4 * fq;
#pragma unroll
                        for (int n = 0; n < 2; ++n)
#pragma unroll
                            for (int j = 0; j < 4; ++j) { const float f = n ? v1[j] : v0[j]; const float t = __expf(-fabsf(f)), rr = __builtin_amdgcn_rcpf(1.f + t); float gq;
                                if (layer == 0) gq = fminf(f, 0.f) + __logf(rr);
                                else { const float lb = lbp[cb + 16 * n + j]; gq = __logf(lb + (1.f - lb) * ((f >= 0.f) ? rr : t * rr)); }
                                if (n) v1[j] = gq; else v0[j] = gq; }
                    }
                    u32x2 o; o.x = pk2(v0.x, v0.y); o.y = pk2(v0.z, v0.w); *(u32x2*)(rowp + bj * HALF) = o;
                    o.x = pk2(v1.x, v1.y); o.y = pk2(v1.z, v1.w); *(u32x2*)(rowp + bj * HALF + 16) = o; } }
    }
};
struct EpiGate { bf16_t* G;
    __device__ __forceinline__ void operator()(const f32x4 (&acc)[2][2][4][2], const Unit& u, int wr, int wc, int fr, int fq) const {
        PG_ROWCOL;
#pragma unroll
        for (int ai = 0; ai < 2; ++ai)
#pragma unroll
            for (int m = 0; m < 4; ++m) { bf16_t* rowp = G + (size_t)(row0 + ai * HALF + m * 16) * NGATE + col0;
#pragma unroll
                for (int bj = 0; bj < 2; ++bj)
#pragma unroll
                    for (int n = 0; n < 2; ++n) { const f32x4 v = acc[ai][bj][m][n]; u32x2 o; o.x = pk2(sigmoidf_(v.x), sigmoidf_(v.y)); o.y = pk2(sigmoidf_(v.z), sigmoidf_(v.w)); *(u32x2*)(rowp + bj * HALF + n * 16) = o; } }
    }
};
struct EpiMerge { const bf16_t* G; bf16_t* O;
    __device__ __forceinline__ void operator()(const f32x4 (&acc)[2][2][4][2], const Unit& u, int wr, int wc, int fr, int fq) const {
        PG_ROWCOL; const int br = u.aux;
#pragma unroll
        for (int aq = 0; aq < 4; ++aq) { const int ai = aq >> 1, m0 = (aq & 1) * 2;
            u32x2 g2[4][2][2], o2[4][2][2];
#pragma unroll
            for (int m = m0; m < m0 + 2; ++m) { const size_t r = (size_t)(row0 + ai * HALF + m * 16); const bf16_t* gp = G + r * NGATE + br * 1024 + col0; const bf16_t* rowp = O + r * DM + col0;
#pragma unroll
                for (int bj = 0; bj < 2; ++bj)
#pragma unroll
                    for (int n = 0; n < 2; ++n) { g2[m][bj][n] = *(const u32x2*)(gp + bj * HALF + n * 16); if (br != 0) o2[m][bj][n] = *(const u32x2*)(rowp + bj * HALF + n * 16); } }
#pragma unroll
            for (int m = m0; m < m0 + 2; ++m) { bf16_t* rowp = O + (size_t)(row0 + ai * HALF + m * 16) * DM + col0;
#pragma unroll
                for (int bj = 0; bj < 2; ++bj)
#pragma unroll
                    for (int n = 0; n < 2; ++n) { const f32x4 v = acc[ai][bj][m][n]; const u32x2 gg = g2[m][bj][n];
                        f32x4 w; w.x = __uint_as_float(gg.x << 16) * v.x; w.y = __uint_as_float(gg.x & 0xffff0000u) * v.y; w.z = __uint_as_float(gg.y << 16) * v.z; w.w = __uint_as_float(gg.y & 0xffff0000u) * v.w;
                        if (br != 0) { const u32x2 oo = o2[m][bj][n];
                            w.x += __uint_as_float(oo.x << 16); w.y += __uint_as_float(oo.x & 0xffff0000u); w.z += __uint_as_float(oo.y << 16); w.w += __uint_as_float(oo.y & 0xffff0000u); }
                        u32x2 o; o.x = pk2(w.x, w.y); o.y = pk2(w.z, w.w); *(u32x2*)(rowp + bj * HALF + n * 16) = o; } }
            asm volatile("" ::: "memory");
        }
    }
};
struct EpiWout { const float *xlat, *xctx; float *olat, *octx; const float* modl;
    __device__ __forceinline__ void operator()(const f32x4 (&acc)[2][2][4][2], const Unit& u, int wr, int wc, int fr, int fq) const {
        PG_ROWCOL; const bool lat = u.pm < NTOK / 256; const int rb = lat ? (u.pm >> 4) : 4;
        const float* xin = lat ? xlat : xctx - (size_t)NTOK * DM; float* xo = lat ? olat : octx - (size_t)NTOK * DM; const float* m2 = modl + (size_t)rb * 6144 + 2 * 1024 + col0;
        f32x4 mv[2][2];
#pragma unroll
        for (int bj = 0; bj < 2; ++bj)
#pragma unroll
            for (int n = 0; n < 2; ++n) mv[bj][n] = *(const f32x4*)(m2 + bj * HALF + n * 16);
#pragma unroll
        for (int aq = 0; aq < 4; ++aq) { const int ai = aq >> 1, m0 = (aq & 1) * 2;
            f32x4 xv[4][2][2];
#pragma unroll
            for (int m = m0; m < m0 + 2; ++m) { const size_t o = (size_t)(row0 + ai * HALF + m * 16) * DM + col0;
#pragma unroll
                for (int bj = 0; bj < 2; ++bj)
#pragma unroll
                    for (int n = 0; n < 2; ++n) xv[m][bj][n] = *(const f32x4*)(xin + o + bj * HALF + n * 16); }
#pragma unroll
            for (int m = m0; m < m0 + 2; ++m) { const size_t o = (size_t)(row0 + ai * HALF + m * 16) * DM + col0;
#pragma unroll
                for (int bj = 0; bj < 2; ++bj)
#pragma unroll
                    for (int n = 0; n < 2; ++n) *(f32x4*)(xo + o + bj * HALF + n * 16) = ALPHA * xv[m][bj][n] + mv[bj][n] * acc[ai][bj][m][n]; }
            asm volatile("" ::: "memory");
        }
    }
};
struct EpiMoe1 { bf16_t* HID; const float* roww;
    __device__ __forceinline__ void operator()(const f32x4 (&acc)[2][2][4][2], const Unit& u, int wr, int wc, int fr, int fq) const {
        const int row0 = u.pm * BM + wr * 64 + fr, hc0 = u.pn * 128 + wc * 32 + 4 * fq;
#pragma unroll
        for (int ai = 0; ai < 2; ++ai)
#pragma unroll
            for (int m = 0; m < 4; ++m) { const int r = row0 + ai * HALF + m * 16; const float w = roww[r];
#pragma unroll
                for (int n = 0; n < 2; ++n) { const f32x4 g = acc[ai][0][m][n], up = acc[ai][1][m][n]; u32x2 o;
                    o.x = pk2(siluf_(g.x) * up.x * w, siluf_(g.y) * up.y * w); o.y = pk2(siluf_(g.z) * up.z * w, siluf_(g.w) * up.w * w);
                    *(u32x2*)(HID + (size_t)r * 256 + hc0 + n * 16) = o; } }
    }
};
struct EpiMoe2 { bf16_t* Y; const int* rmap; bf16_t* dump;
    __device__ __forceinline__ void operator()(const f32x4 (&acc)[2][2][4][2], const Unit& u, int wr, int wc, int fr, int fq) const {
        PG_ROWCOL;
#pragma unroll
        for (int ai = 0; ai < 2; ++ai)
#pragma unroll
            for (int m = 0; m < 4; ++m) { const int s = rmap[row0 + ai * HALF + m * 16];
                bf16_t* rowp = (s >= 0 ? Y + (size_t)s * DM : dump) + col0;
#pragma unroll
                for (int bj = 0; bj < 2; ++bj)
#pragma unroll
                    for (int n = 0; n < 2; ++n) { const f32x4 v = acc[ai][bj][m][n]; u32x2 o; o.x = pk2(v.x, v.y); o.y = pk2(v.z, v.w); *(u32x2*)(rowp + bj * HALF + n * 16) = o; } }
    }
};
#undef PG_ROWCOL
}

__device__ __forceinline__ void moe_offsets(Frame& F, int l, int* off) {
    if (F.tid == 0) { int a = 0; for (int e = 0; e < 32; ++e) { off[e] = a; a += ((int)F.cnt()[l * 32 + e] + 255) & ~255; } off[32] = a; }
    __syncthreads();
}

__device__ __forceinline__ void phase_rope(Frame& F) {
    float* tab = F.smf;
    for (int e = F.tid; e < 1024; e += NTHR) { const int pp = e >> 4, i = e & 15; const float inv = powf(10000.f, -(float)i / 16.f), ang = (float)pp * inv; tab[2 * e] = cosf(ang); tab[2 * e + 1] = sinf(ang); }
    __syncthreads();
    const size_t total = (size_t)NTOK * 320;
    for (size_t idx = (size_t)F.bid * NTHR + F.tid; idx < total; idx += (size_t)F.nb * NTHR) {
        const int row = (int)(idx / 320), r = (int)(idx % 320), h = r >> 5, half = (r >> 4) & 1, i = r & 15;
        const int pos = row & (SEQ - 1), pp = half ? (pos & 63) : (pos >> 6);
        const float cs = tab[2 * (pp * 16 + i)], sn = tab[2 * (pp * 16 + i) + 1];
        bf16_t* base = F.P1() + (size_t)row * NP1 + (h < 8 ? PC_CQ + h * 64 : PC_CK + (h - 8) * 64) + half * 32 + i;
        const float u1 = bf2f(base[0]), u2 = bf2f(base[16]);
        base[0] = f2bf(u1 * cs - u2 * sn); base[16] = f2bf(u1 * sn + u2 * cs);
    }
}

__device__ __forceinline__ int seq_row(int s, int b, int z) {
    if (s < LC) { const int tc = z ? (LC - 1 - s) : s; return NTOK + b * LC + tc; }
    const int tl = s - LC, t = z ? (SEQ - 1 - tl) : tl; return b * SEQ + t;
}
typedef short bf16x8_t __attribute__((ext_vector_type(8)));
typedef short bf16x4_t __attribute__((ext_vector_type(4)));
struct MaskNone { __device__ __forceinline__ void operator()(f32x4&, f32x4&) const {} };
struct MaskNA { int u0; const float* brow;
    __device__ __forceinline__ void operator()(f32x4& s0, f32x4& s1) const {
        float v[8] = {s0.x, s0.y, s0.z, s0.w, s1.x, s1.y, s1.z, s1.w};
#pragma unroll
        for (int T = 0; T < 2; ++T)
#pragma unroll
            for (int rr = 0; rr < 4; ++rr) v[T * 4 + rr] = ((unsigned)(u0 + 16 * T + rr) < 16u) ? v[T * 4 + rr] + brow[16 * T + rr] : -INFINITY;
        s0 = (f32x4){v[0], v[1], v[2], v[3]}; s1 = (f32x4){v[4], v[5], v[6], v[7]};
    }
};
struct MaskWA { int i, j0;
    __device__ __forceinline__ void operator()(f32x4& s0, f32x4& s1) const {
        float v[8] = {s0.x, s0.y, s0.z, s0.w, s1.x, s1.y, s1.z, s1.w};
#pragma unroll
        for (int T = 0; T < 2; ++T)
#pragma unroll
            for (int rr = 0; rr < 4; ++rr) { const int j = j0 + 16 * T + rr; const bool ok = (j >= 0) && (j < SEQ) && (i - j <= 128) && (j - i <= 128);
                v[T * 4 + rr] = ok ? v[T * 4 + rr] : -INFINITY; }
        s0 = (f32x4){v[0], v[1], v[2], v[3]}; s1 = (f32x4){v[4], v[5], v[6], v[7]};
    }
};
struct KVF { bf16x8_t k[4]; bf16x4_t v[4][2]; };
__device__ __forceinline__ void kv_load(KVF& f, const char* kbase, unsigned ko0, unsigned ko1, const char* vbase, unsigned vo0, unsigned vo1) {
    f.k[0] = *(const bf16x8_t*)(kbase + ko0); f.k[1] = *(const bf16x8_t*)(kbase + ko0 + 64); f.k[2] = *(const bf16x8_t*)(kbase + ko1); f.k[3] = *(const bf16x8_t*)(kbase + ko1 + 64);
#pragma unroll
    for (int t = 0; t < 4; ++t) { f.v[t][0] = *(const bf16x4_t*)(vbase + vo0 + (unsigned)t * 16u * NROW * 2u); f.v[t][1] = *(const bf16x4_t*)(vbase + vo1 + (unsigned)t * 16u * NROW * 2u); }
}
__device__ __forceinline__ float xmax_g(float x) {
    auto r = __builtin_amdgcn_permlane16_swap(__float_as_uint(x), __float_as_uint(x), false, false); x = fmaxf(__uint_as_float(r[0]), __uint_as_float(r[1]));
    auto q = __builtin_amdgcn_permlane32_swap(__float_as_uint(x), __float_as_uint(x), false, false); return fmaxf(__uint_as_float(q[0]), __uint_as_float(q[1])); }
__device__ __forceinline__ float xsum_g(float x) {
    auto r = __builtin_amdgcn_permlane16_swap(__float_as_uint(x), __float_as_uint(x), false, false); x = __uint_as_float(r[0]) + __uint_as_float(r[1]);
    auto q = __builtin_amdgcn_permlane32_swap(__float_as_uint(x), __float_as_uint(x), false, false); return __uint_as_float(q[0]) + __uint_as_float(q[1]); }
template <class MaskF>
__device__ __forceinline__ void attn_tile(float& am, float& al, f32x4 (&ao)[4], const bf16x8_t (&qb)[2], const KVF& f, const MaskF& maskf) {
    f32x4 s0 = {0.f, 0.f, 0.f, 0.f}, s1 = {0.f, 0.f, 0.f, 0.f};
    s0 = __builtin_amdgcn_mfma_f32_16x16x32_bf16(f.k[0], qb[0], s0, 0, 0, 0); s0 = __builtin_amdgcn_mfma_f32_16x16x32_bf16(f.k[1], qb[1], s0, 0, 0, 0);
    s1 = __builtin_amdgcn_mfma_f32_16x16x32_bf16(f.k[2], qb[0], s1, 0, 0, 0); s1 = __builtin_amdgcn_mfma_f32_16x16x32_bf16(f.k[3], qb[1], s1, 0, 0, 0);
    maskf(s0, s1);
    const float mx = xmax_g(fmaxf(fmaxf(fmaxf(s0.x, s0.y), fmaxf(s0.z, s0.w)), fmaxf(fmaxf(s1.x, s1.y), fmaxf(s1.z, s1.w))));
    const float mn = fmaxf(am, mx);
    if (__any(mn != am)) {
        const float alpha = __builtin_amdgcn_exp2f(am - mn); am = mn; al *= alpha;
#pragma unroll
        for (int t = 0; t < 4; ++t) ao[t] = ao[t] * alpha;
    }
    f32x4 p0, p1;
    p0.x = __builtin_amdgcn_exp2f(s0.x - am); p0.y = __builtin_amdgcn_exp2f(s0.y - am); p0.z = __builtin_amdgcn_exp2f(s0.z - am); p0.w = __builtin_amdgcn_exp2f(s0.w - am);
    p1.x = __builtin_amdgcn_exp2f(s1.x - am); p1.y = __builtin_amdgcn_exp2f(s1.y - am); p1.z = __builtin_amdgcn_exp2f(s1.z - am); p1.w = __builtin_amdgcn_exp2f(s1.w - am);
    al += ((p0.x + p0.y) + (p0.z + p0.w)) + ((p1.x + p1.y) + (p1.z + p1.w));
    union { bf16x8_t v; unsigned u[4]; } pb;
    pb.u[0] = pk2(p0.x, p0.y); pb.u[1] = pk2(p0.z, p0.w); pb.u[2] = pk2(p1.x, p1.y); pb.u[3] = pk2(p1.z, p1.w);
#pragma unroll
    for (int t = 0; t < 4; ++t) {
        union { bf16x8_t v; bf16x4_t h[2]; } av; av.h[0] = f.v[t][0]; av.h[1] = f.v[t][1];
        ao[t] = __builtin_amdgcn_mfma_f32_16x16x32_bf16(av.v, pb.v, ao[t], 0, 0, 0);
    }
}
template <int kind>
__device__ __forceinline__ void attn_multi(Frame& F, int l, int item, const float* rpb_s) {
    constexpr int NQ = 2;
    constexpr int NLOC = (kind == 0) ? 9 : (kind == 1 ? 9 : 0), NS = 8 + NLOC;
    const int lane = F.lane, n = lane & 15, g = lane >> 4;
    const bf16_t* P1 = F.P1(); const bf16_t* VT = F.VT();
    int b, h0, kvh = 0, kcol, vrow, r = 0, cb = 0, t0 = 0, qrow0, qcol0, brcol0;
    constexpr int QRS = (kind == 0) ? 64 : (kind == 2 ? 16 : 0), QCS = (kind == 1 || kind == 3) ? 64 : 0;
    if (kind == 0) { cb = item & 3; r = ((item >> 2) & 31) * 2; h0 = (item >> 7) & 7; b = item >> 10; kcol = PC_BK + h0 * 64; vrow = h0 * 64; qrow0 = b * SEQ + r * 64 + cb * 16; qcol0 = PC_BQ + h0 * 64; brcol0 = 512 + h0 * 64; }
    else if (kind == 1) { const int hp = item & 1, qt = (item >> 1) & 255; kvh = (item >> 9) & 1; b = item >> 10; h0 = kvh * 4 + hp * 2; t0 = qt * 16; kcol = PC_CK + kvh * 64; vrow = 512 + kvh * 64; qrow0 = b * SEQ + t0; qcol0 = PC_CQ + h0 * 64; brcol0 = 1024 + h0 * 64; }
    else if (kind == 2) { const int qp = item & 7; h0 = (item >> 3) & 7; b = item >> 6; kcol = PC_BK + h0 * 64; vrow = h0 * 64; qrow0 = NTOK + b * LC + qp * 32; qcol0 = PC_BQ + h0 * 64; brcol0 = 512 + h0 * 64; }
    else { const int hp = item & 1, qt = (item >> 1) & 15; kvh = (item >> 5) & 1; b = item >> 6; h0 = kvh * 4 + hp * 2; kcol = PC_CK + kvh * 64; vrow = 512 + kvh * 64; qrow0 = NTOK + b * LC + qt * 16; qcol0 = PC_CQ + h0 * 64; brcol0 = 1024 + h0 * 64; }
    bf16x8_t qb[NQ][2]; float am[NQ], al[NQ]; f32x4 ao[NQ][4];
    { const char* qbase = (const char*)P1; const unsigned qo = (unsigned)(qrow0 + n) * (unsigned)(NP1 * 2) + (unsigned)(qcol0 + 8 * g) * 2u;
#pragma unroll
      for (int q = 0; q < NQ; ++q) { const unsigned o = qo + (unsigned)q * (unsigned)(QRS * NP1 * 2 + QCS * 2); qb[q][0] = *(const bf16x8_t*)(qbase + o); qb[q][1] = *(const bf16x8_t*)(qbase + o + 64);
        am[q] = -1e30f; al[q] = 0.f;
#pragma unroll
        for (int t = 0; t < 4; ++t) ao[q][t] = (f32x4){0.f, 0.f, 0.f, 0.f}; } }
    const int crow0 = NTOK + b * LC;
    const int w0 = (cb == 0) ? 0 : (cb == 1 ? 8 : (cb == 2 ? 24 : 32)), ru = min(max(r - 4, 0), 56);
    const char* kbase = (const char*)P1; const char* vbase = (const char*)VT;
    const unsigned kl = (unsigned)(kcol + 8 * g) * 2u, vl = (unsigned)(vrow + n) * (unsigned)NROW * 2u;
    auto load_step = [&](KVF& f, int s) {
        if (s < 8) { const unsigned ko = (unsigned)(crow0 + 32 * s + n) * (unsigned)(NP1 * 2) + kl, vo = vl + (unsigned)(crow0 + 32 * s + 4 * g) * 2u;
            kv_load(f, kbase, ko, ko + 16u * NP1 * 2u, vbase, vo, vo + 32u); }
        else if (kind == 0) { const int tok0 = b * SEQ + min(ru + (s - 8), 63) * 64 + w0; const unsigned ko = (unsigned)(tok0 + n) * (unsigned)(NP1 * 2) + kl, vo = vl + (unsigned)(tok0 + 4 * g) * 2u;
            kv_load(f, kbase, ko, ko + 16u * NP1 * 2u, vbase, vo, vo + 32u); }
        else if (kind == 1) { const int kb = t0 - 128 + 32 * (s - 8);
            const int ja = min(max(kb + n, 0), SEQ - 1), jb = min(max(kb + 16 + n, 0), SEQ - 1), va = min(max(kb + 4 * g, 0), SEQ - 4), vb = min(max(kb + 16 + 4 * g, 0), SEQ - 4);
            kv_load(f, kbase, (unsigned)(b * SEQ + ja) * (unsigned)(NP1 * 2) + kl, (unsigned)(b * SEQ + jb) * (unsigned)(NP1 * 2) + kl, vbase, vl + (unsigned)(b * SEQ + va) * 2u, vl + (unsigned)(b * SEQ + vb) * 2u); }
    };
    auto compute_step = [&](const KVF& f, int s) {
        if (s < 8) {
#pragma unroll
            for (int q = 0; q < NQ; ++q) { attn_tile(am[q], al[q], ao[q], qb[q], f, MaskNone()); if (NQ == 4) __builtin_amdgcn_sched_barrier(0); }
        } else if (kind == 0) {
            const int kr = ru + (s - 8);
#pragma unroll
            for (int q = 0; q < NQ; ++q) { const int rq = r + q, rsq = min(max(rq - 4, 0), 56);
                if (kr >= rsq && kr <= rsq + 7) { const int c = cb * 16 + n, csq = min(max(c - 8, 0), 48), kc0 = w0 + 4 * g;
                    MaskNA mk{kc0 - csq, rpb_s + (h0 * 15 + (kr - rq + 7)) * 64 + (kc0 - c + 15 + 16)}; attn_tile(am[q], al[q], ao[q], qb[q], f, mk); } }
        } else if (kind == 1) {
            const int ls = s - 8, kb = t0 - 128 + 32 * ls;
            if (ls >= 1 && ls <= 7 && kb >= 0 && kb + 31 < SEQ) {
#pragma unroll
                for (int q = 0; q < NQ; ++q) attn_tile(am[q], al[q], ao[q], qb[q], f, MaskNone());
            } else {
                MaskWA mk{t0 + n, kb + 4 * g};
#pragma unroll
                for (int q = 0; q < NQ; ++q) attn_tile(am[q], al[q], ao[q], qb[q], f, mk);
            }
        }
    };
    if (NQ == 2) {
        KVF fa, fb;
        load_step(fa, 0);
#pragma unroll 1
        for (int s = 0; s < NS; s += 2) {
            if (s + 1 < NS) load_step(fb, s + 1);
            compute_step(fa, s);
            if (s + 1 < NS) { if (s + 2 < NS) load_step(fa, s + 2); compute_step(fb, s + 1); }
        }
    } else {
        KVF fa;
#pragma unroll 1
        for (int s = 0; s < NS; ++s) { load_step(fa, s); compute_step(fa, s); }
    }
#pragma unroll
    for (int q = 0; q < NQ; ++q) {
        float lt = xsum_g(al[q]);
        float osc = 1.f;
        if (kind == 1 || kind == 3) { const float sk = F.p.wa_sink[l * 8 + h0 + q] * 1.44269504089f, mf = fmaxf(am[q], sk); osc = __builtin_amdgcn_exp2f(am[q] - mf); lt = lt * osc + __builtin_amdgcn_exp2f(sk - mf); }
        const float inv = osc / lt;
        char* obase = (char*)F.BR(); const unsigned oo = (unsigned)(qrow0 + q * QRS + n) * 4096u + (unsigned)(brcol0 + q * QCS + 4 * g) * 2u;
#pragma unroll
        for (int t = 0; t < 4; ++t) { const f32x4 v = ao[q][t] * inv; u32x2 o2; o2.x = pk2(v.x, v.y); o2.y = pk2(v.z, v.w); *(u32x2*)(obase + oo + 32u * t) = o2; }
    }
}

template <int DK, bool HG>
__device__ __forceinline__ void scan_mfma(Frame& F, int l, int b, int h, int z, unsigned char* lds) {
    constexpr int NDP = DK / 2, NTG = NTHR / NDP, TPT = 64 / NTG, QS = DK + 8, TS = 72, NDT = DK / 16;
    bf16_t* QD = (bf16_t*)lds; bf16_t* KD = QD + 64 * QS; bf16_t* KDT = KD + 64 * QS; bf16_t* VTs = KDT + DK * TS; bf16_t* AM = VTs + 128 * TS; bf16_t* ST = AM + 64 * TS;
    float* TOT = (float*)(ST + 128 * QS); float* E1s = TOT + NTG * DK; float* E2s = E1s + DK;
    REFRESH(F);
    const int tid = F.tid, lane = F.lane, w = F.wave, n = lane & 15, g = lane >> 4;
    const int dp = tid % NDP, tg = tid / NDP, vp = tid & 63, vg = tid >> 6;
    const bf16_t* P1 = F.P1();
    float lw[HG ? 2 : 32], lbias[2] = {0.f, 0.f}, lbv[2] = {0.f, 0.f};
    if (!HG) {
#pragma unroll
        for (int r = 0; r < 16; ++r) { const float* wp = F.p.gla_lr_w + ((size_t)(l * 2 + z) * 16 + r) * 256 + h * 64 + 2 * dp; lw[2 * r] = wp[0]; lw[2 * r + 1] = wp[1]; }
        lbias[0] = F.p.gla_lr_b[(l * 2 + z) * 256 + h * 64 + 2 * dp]; lbias[1] = F.p.gla_lr_b[(l * 2 + z) * 256 + h * 64 + 2 * dp + 1];
    } else { lw[0] = lw[1] = 0.f; if (l != 0) { lbv[0] = F.lb()[z * 512 + h * 128 + 2 * dp]; lbv[1] = F.lb()[z * 512 + h * 128 + 2 * dp + 1]; } }
    f32x4 accS[NDT];
#pragma unroll
    for (int i = 0; i < NDT; ++i) accS[i] = (f32x4){0.f, 0.f, 0.f, 0.f};
    unsigned rq[TPT], rk[TPT], rv[8]; u32x4 rl[HG ? 1 : TPT][2];
    const int qcol = HG ? PC_DQ + h * 128 + 2 * dp : PC_AQ + h * 64 + 2 * dp, kcol = HG ? PC_DF + z * 512 + h * 128 + 2 * dp : PC_AK + h * 64 + 2 * dp;
    const int vcol = (HG ? PC_DI : PC_AV) + h * 128 + 2 * vp;
    const char* p1b = (const char*)P1; const int sgn = z ? -1 : 1; const int rstep = sgn * NP1 * 2;
#define SCAN_LOAD(c) do { const int row0_ = seq_row((c) * 64, b, z); \
        int o_ = (row0_ + sgn * tg * TPT) * (NP1 * 2); \
        _Pragma("unroll") for (int tt = 0; tt < TPT; ++tt) { rq[tt] = *(const unsigned*)(p1b + (unsigned)(o_ + qcol * 2)); rk[tt] = *(const unsigned*)(p1b + (unsigned)(o_ + kcol * 2)); \
            if (!HG) { rl[tt][0] = *(const u32x4*)(p1b + (unsigned)(o_ + (PC_ALR + z * 16) * 2)); rl[tt][1] = *(const u32x4*)(p1b + (unsigned)(o_ + (PC_ALR + z * 16 + 8) * 2)); } o_ += rstep; } \
        int ov_ = (row0_ + sgn * vg * 8) * (NP1 * 2) + vcol * 2; \
        _Pragma("unroll") for (int tt = 0; tt < 8; ++tt) { rv[tt] = *(const unsigned*)(p1b + (unsigned)ov_); ov_ += rstep; } } while (0)
    SCAN_LOAD(0);
    constexpr int NCH = (LC + SEQ) / 64;
#pragma unroll 1
    for (int c = 0; c < NCH; ++c) {
        float qv[TPT][2], kv[TPT][2], cs[TPT][2];
#pragma unroll
        for (int tt = 0; tt < TPT; ++tt)
#pragma unroll
            for (int e = 0; e < 2; ++e) {
                const float qr = __uint_as_float(e ? (rq[tt] & 0xffff0000u) : (rq[tt] << 16)), kr = __uint_as_float(e ? (rk[tt] & 0xffff0000u) : (rk[tt] << 16));
                float gg;
                if (HG) {
                    gg = kr;
                    kv[tt][e] = 1.f - __expf(kr);
                    qv[tt][e] = qr;
                } else {
                    float lg = lbias[e];
                    const unsigned lr8[8] = {rl[tt][0].x, rl[tt][0].y, rl[tt][0].z, rl[tt][0].w, rl[tt][1].x, rl[tt][1].y, rl[tt][1].z, rl[tt][1].w};
#pragma unroll
                    for (int r2 = 0; r2 < 8; ++r2) { lg += __uint_as_float(lr8[r2] << 16) * lw[(2 * r2) * 2 + e]; lg += __uint_as_float(lr8[r2] & 0xffff0000u) * lw[(2 * r2 + 1) * 2 + e]; }
                    const float t = __expf(-fabsf(lg)), r = __builtin_amdgcn_rcpf(1.f + t);
                    gg = (fminf(lg, 0.f) + __logf(r)) * (1.f / 16.f);
                    kv[tt][e] = kr; qv[tt][e] = qr;
                }
                cs[tt][e] = gg + (tt ? cs[tt ? tt - 1 : 0][e] : 0.f);
            }
        TOT[tg * DK + 2 * dp] = cs[TPT - 1][0]; TOT[tg * DK + 2 * dp + 1] = cs[TPT - 1][1];
        __syncthreads();
        float offs[2] = {0.f, 0.f}, mid[2] = {0.f, 0.f}, lastv[2] = {0.f, 0.f};
#pragma unroll
        for (int t2 = 0; t2 < NTG; ++t2)
#pragma unroll
            for (int e = 0; e < 2; ++e) { const float tv = TOT[t2 * DK + 2 * dp + e]; if (t2 < tg) offs[e] += tv; if (t2 < NTG / 2) mid[e] += tv; lastv[e] += tv; }
        unsigned kdt[2][TPT / 2]; float kprev[2] = {0.f, 0.f};
#pragma unroll
        for (int tt = 0; tt < TPT; ++tt) {
            float qd[2], kd[2];
#pragma unroll
            for (int e = 0; e < 2; ++e) { const float x = fminf(fmaxf(cs[tt][e] + offs[e] - mid[e], -80.f), 80.f); qd[e] = qv[tt][e] * __expf(x); kd[e] = kv[tt][e] * __expf(-x); }
            const int tok = tg * TPT + tt;
            *(unsigned*)(QD + tok * QS + 2 * dp) = pk2(qd[0], qd[1]); *(unsigned*)(KD + tok * QS + 2 * dp) = pk2(kd[0], kd[1]);
            if (tt & 1) { kdt[0][tt >> 1] = pk2(kprev[0], kd[0]); kdt[1][tt >> 1] = pk2(kprev[1], kd[1]); } else { kprev[0] = kd[0]; kprev[1] = kd[1]; }
        }
#pragma unroll
        for (int e = 0; e < 2; ++e) {
            bf16_t* dst = KDT + (2 * dp + e) * TS + tg * TPT;
            if (TPT == 8) { u32x4 o; o.x = kdt[e][0]; o.y = kdt[e][1]; o.z = kdt[e][TPT / 2 - 2]; o.w = kdt[e][TPT / 2 - 1]; *(u32x4*)dst = o; }
            else { u32x2 o; o.x = kdt[e][0]; o.y = kdt[e][1]; *(u32x2*)dst = o; }
        }
        if (tg == 0) { E1s[2 * dp] = __expf(mid[0]); E1s[2 * dp + 1] = __expf(mid[1]); E2s[2 * dp] = __expf(lastv[0] - mid[0]); E2s[2 * dp + 1] = __expf(lastv[1] - mid[1]); }
        {   u32x4 o0, o1;
            o0.x = (rv[0] & 0xffffu) | (rv[1] << 16); o0.y = (rv[2] & 0xffffu) | (rv[3] << 16); o0.z = (rv[4] & 0xffffu) | (rv[5] << 16); o0.w = (rv[6] & 0xffffu) | (rv[7] << 16);
            o1.x = (rv[0] >> 16) | (rv[1] & 0xffff0000u); o1.y = (rv[2] >> 16) | (rv[3] & 0xffff0000u); o1.z = (rv[4] >> 16) | (rv[5] & 0xffff0000u); o1.w = (rv[6] >> 16) | (rv[7] & 0xffff0000u);
            *(u32x4*)(VTs + (2 * vp) * TS + vg * 8) = o0; *(u32x4*)(VTs + (2 * vp + 1) * TS + vg * 8) = o1; }
        if (c + 1 < NCH) SCAN_LOAD(c + 1);
        __syncthreads();
#pragma unroll
        for (int dt = 0; dt < NDT; ++dt) { accS[dt] = accS[dt] * *(const f32x4*)&E1s[16 * dt + 4 * g];
            u32x2 o; o.x = pk2(accS[dt].x, accS[dt].y); o.y = pk2(accS[dt].z, accS[dt].w); *(u32x2*)(ST + (16 * w + n) * QS + 16 * dt + 4 * g) = o; }
        {   const int it = w >> 1, jt0 = 2 * (w & 1);
            f32x4 d0 = {0.f, 0.f, 0.f, 0.f}, d1 = {0.f, 0.f, 0.f, 0.f};
            if (jt0 <= it) {
                bf16x8_t qf[DK / 32], k0f[DK / 32], k1f[DK / 32];
#pragma unroll
                for (int ks = 0; ks < DK / 32; ++ks) { qf[ks] = *(const bf16x8_t*)(QD + (16 * it + n) * QS + 32 * ks + 8 * g); k0f[ks] = *(const bf16x8_t*)(KD + (16 * jt0 + n) * QS + 32 * ks + 8 * g); k1f[ks] = *(const bf16x8_t*)(KD + (16 * (jt0 + 1) + n) * QS + 32 * ks + 8 * g); }
#pragma unroll
                for (int ks = 0; ks < DK / 32; ++ks) { d0 = __builtin_amdgcn_mfma_f32_16x16x32_bf16(k0f[ks], qf[ks], d0, 0, 0, 0); d1 = __builtin_amdgcn_mfma_f32_16x16x32_bf16(k1f[ks], qf[ks], d1, 0, 0, 0); }
                const int i = 16 * it + n, j0 = 16 * jt0 + 4 * g, j1 = j0 + 16;
                d0.x = (j0 + 0 <= i) ? d0.x : 0.f; d0.y = (j0 + 1 <= i) ? d0.y : 0.f; d0.z = (j0 + 2 <= i) ? d0.z : 0.f; d0.w = (j0 + 3 <= i) ? d0.w : 0.f;
                d1.x = (j1 + 0 <= i) ? d1.x : 0.f; d1.y = (j1 + 1 <= i) ? d1.y : 0.f; d1.z = (j1 + 2 <= i) ? d1.z : 0.f; d1.w = (j1 + 3 <= i) ? d1.w : 0.f;
            }
            u32x2 o; o.x = pk2(d0.x, d0.y); o.y = pk2(d0.z, d0.w); *(u32x2*)(AM + (16 * it + n) * TS + 16 * jt0 + 4 * g) = o;
            o.x = pk2(d1.x, d1.y); o.y = pk2(d1.z, d1.w); *(u32x2*)(AM + (16 * it + n) * TS + 16 * (jt0 + 1) + 4 * g) = o;
        }
        __syncthreads();
        {   f32x4 o[4];
#pragma unroll
            for (int it = 0; it < 4; ++it) o[it] = (f32x4){0.f, 0.f, 0.f, 0.f};
#pragma unroll
            for (int ks = 0; ks < 2; ++ks) { const bf16x8_t af = *(const bf16x8_t*)(VTs + (16 * w + n) * TS + 32 * ks + 8 * g); bf16x8_t bf[4];
#pragma unroll
                for (int it = 0; it < 4; ++it) bf[it] = *(const bf16x8_t*)(AM + (16 * it + n) * TS + 32 * ks + 8 * g);
#pragma unroll
                for (int it = 0; it < 4; ++it) o[it] = __builtin_amdgcn_mfma_f32_16x16x32_bf16(af, bf[it], o[it], 0, 0, 0); }
#pragma unroll
            for (int ks = 0; ks < DK / 32; ++ks) { const bf16x8_t af = *(const bf16x8_t*)(ST + (16 * w + n) * QS + 32 * ks + 8 * g); bf16x8_t bf[4];
#pragma unroll
                for (int it = 0; it < 4; ++it) bf[it] = *(const bf16x8_t*)(QD + (16 * it + n) * QS + 32 * ks + 8 * g);
#pragma unroll
                for (int it = 0; it < 4; ++it) o[it] = __builtin_amdgcn_mfma_f32_16x16x32_bf16(af, bf[it], o[it], 0, 0, 0); }
            const int row0 = seq_row(c * 64, b, z) + sgn * n;
            char* dstb; unsigned doff; int dstride;
            if (HG) { dstb = (char*)F.P1(); doff = (unsigned)row0 * (unsigned)(NP1 * 2) + (unsigned)(PC_DF + z * 512 + h * 128 + 16 * w + 4 * g) * 2u; dstride = sgn * 16 * NP1 * 2; }
            else if (z == 0) { dstb = (char*)F.BR(); doff = (unsigned)row0 * 4096u + (unsigned)(h * 128 + 16 * w + 4 * g) * 2u; dstride = sgn * 16 * 4096; }
            else { dstb = (char*)F.OBA(); doff = (unsigned)row0 * 1024u + (unsigned)(h * 128 + 16 * w + 4 * g) * 2u; dstride = sgn * 16 * 1024; }
#pragma unroll
            for (int it = 0; it < 4; ++it) { u32x2 o2; o2.x = pk2(o[it].x, o[it].y); o2.y = pk2(o[it].z, o[it].w); *(u32x2*)(dstb + (unsigned)((int)doff + it * dstride)) = o2; }
        }
#pragma unroll
        for (int ks = 0; ks < 2; ++ks) { const bf16x8_t bv = *(const bf16x8_t*)(VTs + (16 * w + n) * TS + 32 * ks + 8 * g); bf16x8_t af[NDT];
#pragma unroll
            for (int dt = 0; dt < NDT; ++dt) af[dt] = *(const bf16x8_t*)(KDT + (16 * dt + n) * TS + 32 * ks + 8 * g);
#pragma unroll
            for (int dt = 0; dt < NDT; ++dt) accS[dt] = __builtin_amdgcn_mfma_f32_16x16x32_bf16(af[dt], bv, accS[dt], 0, 0, 0); }
#pragma unroll
        for (int dt = 0; dt < NDT; ++dt) accS[dt] = accS[dt] * *(const f32x4*)&E2s[16 * dt + 4 * g];
        __syncthreads();
    }
#undef SCAN_LOAD
}

__device__ __forceinline__ void phase_mix(Frame& F, int l) {
    const int n_scan = 64;
    const int nsb = (F.nb > 128) ? 64 : 0;
    if (nsb == 0 || F.bid < nsb) {
        for (int it = F.bid; it < n_scan; it += (nsb ? nsb : F.nb)) {
            const int br = it >> 5, r = it & 31, b = r >> 3, h = (r >> 1) & 3, z = r & 1;
            if (br == 0) scan_mfma<64, false>(F, l, b, h, z, (unsigned char*)F.smf); else scan_mfma<128, true>(F, l, b, h, z, (unsigned char*)F.smf);
        }
        __syncthreads();
    }
    float* rpb_s = F.smf;
    for (int i = F.tid; i < 8 * 15 * 64; i += NTHR) { const int dcp = i & 63, hr = i >> 6; rpb_s[i] = (dcp >= 16 && dcp < 47) ? F.p.na_rpb[(size_t)l * 8 * 465 + hr * 31 + (dcp - 16)] * 1.44269504089f : 0.f; }
    __syncthreads();
    unsigned* qhead = F.cnt() + 64 + l * 16;
    const int n_wa = 4096, n_na = 4096, n_cna = (l == 0) ? 256 : 0, n_cwa = (l == 0) ? 256 : 0, total = n_wa + n_na + n_cna + n_cwa;
    for (;;) {
        int it = 0; if (F.lane == 0) it = (int)atomicAdd(qhead, 1u);
        it = __builtin_amdgcn_readfirstlane(it);
        if (it >= total) break;
        if (it < n_wa) attn_multi<1>(F, l, it, rpb_s);
        else if (it < n_wa + n_na) attn_multi<0>(F, l, it - n_wa, rpb_s);
        else if (it < n_wa + n_na + n_cna) attn_multi<2>(F, l, it - n_wa - n_na, rpb_s);
        else attn_multi<3>(F, l, it - n_wa - n_na - n_cna, rpb_s);
    }
}

__device__ __forceinline__ void phase_prepad(Frame& F, int l) {
    const int gw = F.bid * 8 + F.wave, ngw = F.nb * 8, npairs = ((l == 0) ? NROW : NTOK) / 2, c0 = F.lane * 8;
    for (int pi = gw; pi < npairs; pi += ngw) {
        u32x4 ra[2][2], rb[2][2], rg[2][2];
#pragma unroll
        for (int q = 0; q < 2; ++q) { const size_t row = (size_t)pi * 2 + q;
            ra[q][0] = *(const u32x4*)(F.BR() + row * 2048 + c0); rb[q][0] = *(const u32x4*)(F.OBA() + row * 512 + c0); rg[q][0] = *(const u32x4*)(F.P1() + row * NP1 + PC_AG + c0);
            ra[q][1] = *(const u32x4*)(F.P1() + row * NP1 + PC_DF + c0); rb[q][1] = *(const u32x4*)(F.P1() + row * NP1 + PC_DF + 512 + c0); rg[q][1] = *(const u32x4*)(F.P1() + row * NP1 + PC_DG + c0); }
#pragma unroll
        for (int q = 0; q < 2; ++q)
#pragma unroll
            for (int br = 0; br < 2; ++br) {
                const unsigned ua[4] = {ra[q][br].x, ra[q][br].y, ra[q][br].z, ra[q][br].w}, ub[4] = {rb[q][br].x, rb[q][br].y, rb[q][br].z, rb[q][br].w}, ug[4] = {rg[q][br].x, rg[q][br].y, rg[q][br].z, rg[q][br].w};
                float o[8], g[8]; float ss = 0.f;
#pragma unroll
                for (int j = 0; j < 4; ++j) { o[2 * j] = __uint_as_float(ua[j] << 16) + __uint_as_float(ub[j] << 16); o[2 * j + 1] = __uint_as_float(ua[j] & 0xffff0000u) + __uint_as_float(ub[j] & 0xffff0000u);
                    g[2 * j] = __uint_as_float(ug[j] << 16); g[2 * j + 1] = __uint_as_float(ug[j] & 0xffff0000u); ss += o[2 * j] * o[2 * j] + o[2 * j + 1] * o[2 * j + 1]; }
                ss += __shfl_xor(ss, 1); ss += __shfl_xor(ss, 2); ss += __shfl_xor(ss, 4); ss += __shfl_xor(ss, 8);
                const float rs = rsqrtf(ss * (1.f / 128.f) + 1e-6f);
#pragma unroll
                for (int j = 0; j < 8; ++j) o[j] = o[j] * rs * siluf_(g[j]);
                st8(F.BR() + ((size_t)pi * 2 + q) * 2048 + (br ? 1536 : 0) + c0, o);
            }
    }
}

__device__ __forceinline__ void phase_ln1(Frame& F, int l) {
    const int nrows = (l == 0) ? NROW : NTOK, ngroups = nrows / 64;
    const float* lg = F.p.ln_g + (size_t)(l * 2 + 0) * DM; const float* lbb = F.p.ln_b + (size_t)(l * 2 + 0) * DM;
    float* part = F.smf;
    const int wv = __builtin_amdgcn_readfirstlane(F.wave);
    float* stg = F.smf + 8 * 36 * 64 + wv * (64 * 17 + 16 * 40);
    float* wl = stg + 64 * 17;
    for (int grp = F.bid; grp < ngroups; grp += F.nb) {
        const int row0 = grp * 64, rb = row_batch(row0);
        const float* mv = F.modv() + ((size_t)l * 5 + rb) * 6144;
        float* xg = row0 < NTOK ? F.p.out + (size_t)row0 * DM : F.cxm() + (size_t)(row0 - NTOK) * DM;
#pragma unroll 1
        for (int rr = 0; rr < 8; rr += 2) {
            const int lr = wv * 8 + rr; float* xr = xg + (size_t)lr * DM;
            f32x4 v[2][4]; float s[2] = {0.f, 0.f};
#pragma unroll
            for (int q = 0; q < 2; ++q)
#pragma unroll
                for (int j = 0; j < 4; ++j) v[q][j] = *(const f32x4*)(xr + (size_t)q * DM + j * 256 + F.lane * 4);
#pragma unroll
            for (int q = 0; q < 2; ++q)
#pragma unroll
                for (int j = 0; j < 4; ++j) s[q] += (v[q][j].x + v[q][j].y) + (v[q][j].z + v[q][j].w);
#pragma unroll
            for (int o = 1; o < 64; o <<= 1) { s[0] += __shfl_xor(s[0], o); s[1] += __shfl_xor(s[1], o); }
            float s2[2] = {0.f, 0.f};
#pragma unroll
            for (int q = 0; q < 2; ++q) { const float mean = s[q] * (1.f / DM);
#pragma unroll
                for (int j = 0; j < 4; ++j) { v[q][j] = v[q][j] - mean; s2[q] += (v[q][j].x * v[q][j].x + v[q][j].y * v[q][j].y) + (v[q][j].z * v[q][j].z + v[q][j].w * v[q][j].w); } }
#pragma unroll
            for (int o = 1; o < 64; o <<= 1) { s2[0] += __shfl_xor(s2[0], o); s2[1] += __shfl_xor(s2[1], o); }
#pragma unroll
            for (int j = 0; j < 4; ++j) { const int d = j * 256 + F.lane * 4;
                const f32x4 g4 = *(const f32x4*)(lg + d), b4 = *(const f32x4*)(lbb + d), m3 = *(const f32x4*)(mv + 3 * 1024 + d), m4 = *(const f32x4*)(mv + 4 * 1024 + d);
#pragma unroll
                for (int q = 0; q < 2; ++q) { const float rstd = rsqrtf(s2[q] * (1.f / DM) + LN_EPS);
                    const f32x4 xn = v[q][j] * rstd * g4 + b4;
                    *(f32x4*)(xr + (size_t)q * DM + d) = xn;
                    const f32x4 h2 = xn * (1.f + m4) + m3;
                    u32x2 o2; o2.x = pk2(h2.x, h2.y); o2.y = pk2(h2.z, h2.w);
                    *(u32x2*)(F.HX2() + (size_t)(row0 + lr + q) * DM + d) = o2; } }
        }
        __syncthreads();
        {   float acc[36];
#pragma unroll
            for (int o = 0; o < 36; ++o) acc[o] = 0.f;
            const float* wgp = F.p.moe_w_group + ((size_t)l * DM + wv * 128) * 4; const float* wep = F.p.moe_w_expert + ((size_t)l * DM + wv * 128) * 32;
            const float* m3p = mv + 3 * 1024 + wv * 128; const float* m4p = mv + 4 * 1024 + wv * 128;
#pragma unroll 1
            for (int dc = 0; dc < 128; dc += 16) {
                f32x4 t[4], we0, we1, wg4 = {0.f, 0.f, 0.f, 0.f}; float m3v = 0.f, m4v = 0.f;
#pragma unroll
                for (int i = 0; i < 4; ++i) t[i] = *(const f32x4*)(xg + (size_t)(16 * i + (F.lane >> 2)) * DM + wv * 128 + dc + (F.lane & 3) * 4);
                we0 = *(const f32x4*)(wep + (size_t)dc * 32 + F.lane * 4); we1 = *(const f32x4*)(wep + (size_t)dc * 32 + (F.lane + 64) * 4);
                if (F.lane < 16) { wg4 = *(const f32x4*)(wgp + (size_t)(dc + F.lane) * 4); m3v = m3p[dc + F.lane]; m4v = 1.f + m4p[dc + F.lane]; }
#pragma unroll
                for (int i = 0; i < 4; ++i) { float* sp = stg + (16 * i + (F.lane >> 2)) * 17 + (F.lane & 3) * 4; sp[0] = t[i].x; sp[1] = t[i].y; sp[2] = t[i].z; sp[3] = t[i].w; }
                *(f32x4*)(wl + (F.lane >> 3) * 40 + 4 + (F.lane & 7) * 4) = we0; *(f32x4*)(wl + ((F.lane + 64) >> 3) * 40 + 4 + (F.lane & 7) * 4) = we1;
                if (F.lane < 16) { *(f32x4*)(wl + F.lane * 40) = wg4; wl[F.lane * 40 + 36] = m3v; wl[F.lane * 40 + 37] = m4v; }
                asm volatile("s_waitcnt lgkmcnt(0)" ::: "memory");
#pragma unroll 4
                for (int q = 0; q < 16; ++q) { const float* wq = wl + q * 40; const float hh = stg[F.lane * 17 + q] * wq[37] + wq[36];
#pragma unroll
                    for (int o4 = 0; o4 < 9; ++o4) { const f32x4 w4 = *(const f32x4*)(wq + 4 * o4);
                        acc[4 * o4] += hh * w4.x; acc[4 * o4 + 1] += hh * w4.y; acc[4 * o4 + 2] += hh * w4.z; acc[4 * o4 + 3] += hh * w4.w; } }
                asm volatile("s_waitcnt lgkmcnt(0)" ::: "memory");
            }
#pragma unroll
            for (int o = 0; o < 36; ++o) part[(wv * 36 + o) * 64 + F.lane] = acc[o];
        }
        __syncthreads();
        if (wv == 0) {
            const int row = row0 + F.lane;
            float gl[4]; int gi = 0; float gm = -3.4e38f;
#pragma unroll
            for (int o = 0; o < 4; ++o) { float t = F.p.moe_b_group[l * 4 + o];
#pragma unroll
                for (int w2 = 0; w2 < 8; ++w2) t += part[(w2 * 36 + o) * 64 + F.lane];
                gl[o] = t; if (t > gm) { gm = t; gi = o; } }
            float gs = 0.f;
#pragma unroll
            for (int o = 0; o < 4; ++o) gs += expf(gl[o] - gm);
            const float gwt = 1.f / gs;
            float e1 = -3.4e38f, e2 = -3.4e38f; int i1 = 0, i2 = 0;
#pragma unroll
            for (int o8 = 0; o8 < 8; ++o8) { const int o = gi * 8 + o8; float ev = F.p.moe_b_expert[l * 32 + o];
#pragma unroll
                for (int w2 = 0; w2 < 8; ++w2) ev += part[(w2 * 36 + 4 + o) * 64 + F.lane];
                if (ev > e1) { e2 = e1; i2 = i1; e1 = ev; i1 = o; } else if (ev > e2) { e2 = ev; i2 = o; } }
            const float w1 = 1.f / (1.f + expf(e2 - e1)), w2v = 1.f - w1;
            unsigned* lh = (unsigned*)(stg + 64 * 17 + 16 * 40 - 64);
            if (F.lane < 32) lh[F.lane] = 0u;
            asm volatile("s_waitcnt lgkmcnt(0)" ::: "memory");
            const unsigned r1 = atomicAdd(&lh[i1], 1u), r2 = atomicAdd(&lh[i2], 1u);
            asm volatile("s_waitcnt lgkmcnt(0)" ::: "memory");
            if (F.lane < 32) { const unsigned c = lh[F.lane]; lh[32 + F.lane] = c ? atomicAdd(&F.cnt()[l * 32 + F.lane], c) : 0u; }
            asm volatile("s_waitcnt vmcnt(0) lgkmcnt(0)" ::: "memory");
            const unsigned p1 = lh[32 + i1] + r1, p2 = lh[32 + i2] + r2;
            F.tokE()[row * 2] = i1; F.tokI()[row * 2] = (int)p1; F.tokW()[row * 2] = gwt * w1;
            F.tokE()[row * 2 + 1] = i2; F.tokI()[row * 2 + 1] = (int)p2; F.tokW()[row * 2 + 1] = gwt * w2v;
        }
        __syncthreads();
    }
}

__device__ __forceinline__ void phase_gather(Frame& F, int l) {
    int* off = (int*)F.smf; moe_offsets(F, l, off);
    const int gw = F.bid * 8 + F.wave, ngw = F.nb * 8, nrows = (l == 0) ? NROW : NTOK;
    for (int s = gw; s < 2 * nrows; s += ngw) {
        const int e = F.tokE()[s], dst = off[e] + F.tokI()[s];
        const u32x4* src = (const u32x4*)(F.HX2() + (size_t)(s >> 1) * DM); u32x4* d = (u32x4*)(F.XS() + (size_t)dst * DM);
        d[F.lane] = src[F.lane]; d[F.lane + 64] = src[F.lane + 64];
        if (F.lane == 0) { F.rmap()[dst] = s; F.roww()[dst] = F.tokW()[s]; }
    }
    for (int e = 0; e < 32; ++e) {
        const int c = (int)F.cnt()[l * 32 + e], pc = (c + 255) & ~255;
        for (int j = c + gw; j < pc; j += ngw) { const int dst = off[e] + j; u32x4* d = (u32x4*)(F.XS() + (size_t)dst * DM);
            const u32x4 z = {0u, 0u, 0u, 0u}; d[F.lane] = z; d[F.lane + 64] = z;
            if (F.lane == 0) { F.rmap()[dst] = -1; F.roww()[dst] = 0.f; } }
    }
}
__device__ __forceinline__ int expert_of_row(const int* off, int row) { int e = 0;
#pragma unroll 1
    for (int i = 1; i < 32; ++i) if (row >= off[i]) e = i;
    return e; }

__device__ __forceinline__ void phase_ln2(Frame& F, int l) {
    const int gw = F.bid * 8 + F.wave, ngw = F.nb * 8, npairs = ((l == 0) ? NROW : NTOK) / 2;
    const float* lg = F.p.ln_g + (size_t)(l * 2 + 1) * DM; const float* lbb = F.p.ln_b + (size_t)(l * 2 + 1) * DM;
    const bf16_t* Y = F.BR();
    const bool tmo_set = (l == DEPTH - 1) && (__hip_atomic_load((unsigned*)(F.ws + WS_CTL) + XB_TMO, __ATOMIC_RELAXED, __HIP_MEMORY_SCOPE_AGENT) != 0u);
    for (int pi = gw; pi < npairs; pi += ngw) {
        const int row0 = pi * 2, rb = row_batch(row0);
        const float* xm = row0 < NTOK ? F.p.out + (size_t)row0 * DM : F.cxm() + (size_t)(row0 - NTOK) * DM;
        float* xo = row0 < NTOK ? F.p.out + (size_t)row0 * DM : F.cxo() + (size_t)(row0 - NTOK) * DM;
        const float* mv = F.modv() + ((size_t)l * 5 + rb) * 6144;
        u32x2 y0[2][4], y1[2][4]; f32x4 xv[2][4], m5[4];
#pragma unroll
        for (int j = 0; j < 4; ++j) { const int d = j * 256 + F.lane * 4; m5[j] = *(const f32x4*)(mv + 5 * 1024 + d);
#pragma unroll
            for (int q = 0; q < 2; ++q) { y0[q][j] = *(const u32x2*)(Y + (size_t)((row0 + q) * 2) * DM + d); y1[q][j] = *(const u32x2*)(Y + (size_t)((row0 + q) * 2 + 1) * DM + d); xv[q][j] = *(const f32x4*)(xm + (size_t)q * DM + d); } }
        f32x4 v[2][4]; float s[2] = {0.f, 0.f};
#pragma unroll
        for (int q = 0; q < 2; ++q)
#pragma unroll
            for (int j = 0; j < 4; ++j) { f32x4 y; y.x = __uint_as_float(y0[q][j].x << 16) + __uint_as_float(y1[q][j].x << 16); y.y = __uint_as_float(y0[q][j].x & 0xffff0000u) + __uint_as_float(y1[q][j].x & 0xffff0000u);
                y.z = __uint_as_float(y0[q][j].y << 16) + __uint_as_float(y1[q][j].y << 16); y.w = __uint_as_float(y0[q][j].y & 0xffff0000u) + __uint_as_float(y1[q][j].y & 0xffff0000u);
                v[q][j] = ALPHA * xv[q][j] + m5[j] * y; s[q] += (v[q][j].x + v[q][j].y) + (v[q][j].z + v[q][j].w); }
#pragma unroll
        for (int o = 1; o < 64; o <<= 1) { s[0] += __shfl_xor(s[0], o); s[1] += __shfl_xor(s[1], o); }
        float s2[2] = {0.f, 0.f};
#pragma unroll
        for (int q = 0; q < 2; ++q) { const float mean = s[q] * (1.f / DM);
#pragma unroll
            for (int j = 0; j < 4; ++j) { v[q][j] = v[q][j] - mean; s2[q] += (v[q][j].x * v[q][j].x + v[q][j].y * v[q][j].y) + (v[q][j].z * v[q][j].z + v[q][j].w * v[q][j].w); } }
#pragma unroll
        for (int o = 1; o < 64; o <<= 1) { s2[0] += __shfl_xor(s2[0], o); s2[1] += __shfl_xor(s2[1], o); }
        const float* mn = F.modv() + ((size_t)((l + 1 < DEPTH) ? l + 1 : l) * 5 + rb) * 6144;
#pragma unroll
        for (int j = 0; j < 4; ++j) { const int d = j * 256 + F.lane * 4;
            const f32x4 g4 = *(const f32x4*)(lg + d), b4 = *(const f32x4*)(lbb + d), m0 = *(const f32x4*)(mn + d), m1 = *(const f32x4*)(mn + 1024 + d);
#pragma unroll
            for (int q = 0; q < 2; ++q) { const float rstd = rsqrtf(s2[q] * (1.f / DM) + LN_EPS);
                f32x4 xn = v[q][j] * rstd * g4 + b4;
                if (tmo_set) xn = xn * __uint_as_float(0x7fc00000u);
                *(f32x4*)(xo + (size_t)q * DM + d) = xn;
                if (l + 1 < DEPTH) { const f32x4 h = xn * (1.f + m1) + m0; u32x2 o2; o2.x = pk2(h.x, h.y); o2.y = pk2(h.z, h.w); *(u32x2*)(F.HX() + (size_t)(row0 + q) * DM + d) = o2; } }
        }
    }
}

constexpr int NPL = 12, NPH = 1 + DEPTH * NPL;
__global__ void __launch_bounds__(NTHR, 2) mega(Params p) {
    extern __shared__ __attribute__((aligned(16))) unsigned char smem[];
    Frame F; F.p = p; F.bid = blockIdx.x; F.nb = gridDim.x; F.tid = threadIdx.x; F.lane = threadIdx.x & 63; F.wave = threadIdx.x >> 6; F.wid_s = __builtin_amdgcn_readfirstlane(threadIdx.x >> 6);
    F.smf = (float*)(smem + LDS_STAGE);
    LAS unsigned char* stage = (LAS unsigned char*)smem + LDS_STAGE; int* offt = (int*)(smem + 64);
    unsigned char* ws = p.ws; F.ws = ws;

    if (threadIdx.x == 0) *(uint4*)smem = make_uint4(0u, 0u, 0u, 0u);
    __syncthreads();
    unsigned* barw = (unsigned*)(ws + WS_CTL);
    XcdBarrier bar; bar.bar = barw; bar.x = 0; bar.st = (volatile LAS unsigned*)smem;
    const bool multi = (p.ph_hi - p.ph_lo) > 1;
    if (multi) bar = xcd_barrier_post(barw, (volatile LAS unsigned*)smem);
    const int lo = p.ph_lo, hi = p.ph_hi;
#define IN(k) (lo <= (k) && (k) < hi)
#define SEAM(k) do { if (IN(k) && IN((k) + 1)) xcd_barrier(bar); else __syncthreads(); } while (0)

    if (IN(0)) { REFRESH(F); phase_mod(F); __syncthreads(); phase_conv_a(F, 0); }
    SEAM(0);
#pragma unroll 1
    for (int l = 0; l < DEPTH; ++l) {
        const int pb = 1 + l * NPL;
        const float* xlat = (l == 0) ? p.x : p.out; const float* xctx = (l == 0) ? p.ctx : F.cxo();
        const int Mrows = (l == 0) ? NROW : NTOK;
        if (IN(pb + 0)) { REFRESH(F); if (l == 0) phase_prep(F, 0, p.x, p.ctx); else phase_conv_a(F, l); }
        SEAM(pb + 0);
        if (IN(pb + 1)) { REFRESH(F);
            float* rtab = (float*)(smem + LDS_ROPE);
            for (int e = F.tid; e < 1024; e += NTHR) { const int pp = e >> 4, i = e & 15; const float inv = powf(10000.f, -(float)i / 16.f), ang = (float)pp * inv; rtab[2 * e] = cosf(ang); rtab[2 * e + 1] = sinf(ang); }
            __syncthreads();
            pg::SchedG1 S{(const char*)F.HX(), (const char*)F.W1t(), (const char*)F.Wvt(), F.nb, F.bid}; pg::EpiG1 E{F.P1(), F.VT(), rtab, F.lb(), l};
            pg::gemm_phase(stage, DM, DM, DM, S, E);
        }
        SEAM(pb + 1);
        if (IN(pb + 2)) { REFRESH(F); phase_mix(F, l); }
        SEAM(pb + 2);
        if (IN(pb + 3)) { REFRESH(F); phase_prepad(F, l); }
        SEAM(pb + 3);
        if (IN(pb + 4)) { REFRESH(F);
            pg::SchedStatic S{(const char*)F.HX(), (const char*)F.Wgt(), (size_t)256 * DM * 2, (size_t)256 * DM * 2, Mrows / 256, NGATE / 256, F.nb, F.bid}; pg::EpiGate E{F.G()};
            pg::gemm_phase(stage, DM, DM, DM, S, E);
            __syncthreads();
            phase_conv_b(F, l);
        }
        SEAM(pb + 4);
        if (IN(pb + 5)) { REFRESH(F);
            pg::SchedMerge S{(const char*)F.BR(), (const char*)F.Wbrt(), (Mrows / 256) * 4, F.nb, F.bid}; pg::EpiMerge E{F.G(), F.HX()};
            pg::gemm_phase(stage, 2048, 512, 512, S, E);
        }
        SEAM(pb + 5);
        if (IN(pb + 6)) { REFRESH(F);
            pg::SchedStatic S{(const char*)F.HX(), (const char*)F.Woutt(), (size_t)256 * DM * 2, (size_t)256 * DM * 2, Mrows / 256, DM / 256, F.nb, F.bid};
            pg::EpiWout E{xlat, xctx, p.out, F.cxm(), F.modv() + (size_t)l * 5 * 6144};
            pg::gemm_phase(stage, DM, DM, DM, S, E);
        }
        SEAM(pb + 6);
        if (IN(pb + 7)) { REFRESH(F); phase_ln1(F, l); }
        SEAM(pb + 7);
        if (IN(pb + 8)) { REFRESH(F); phase_gather(F, l); }
        SEAM(pb + 8);
        if (IN(pb + 9)) { REFRESH(F);
            moe_offsets(F, l, offt);
            pg::SchedMoe S{(const char*)F.XS(), (const char*)F.Wgu(), offt, (size_t)256 * DM * 2, (size_t)512 * DM * 2, (size_t)256 * DM * 2, offt[32] / 256, 2, F.nb, F.bid};
            pg::EpiMoe1 E{F.HID(), F.roww()};
            pg::gemm_phase(stage, DM, DM, DM, S, E);
        }
        SEAM(pb + 9);
        if (IN(pb + 10)) { REFRESH(F);
            moe_offsets(F, l, offt);
            pg::SchedMoe S{(const char*)F.HID(), (const char*)F.Wd(), offt, (size_t)256 * 256 * 2, (size_t)DM * 256 * 2, (size_t)256 * 256 * 2, offt[32] / 256, 4, F.nb, F.bid};
            pg::EpiMoe2 E{F.BR(), F.rmap(), (bf16_t*)(F.ws + WS_DUMP)};
            pg::gemm_phase(stage, 256, 256, 256, S, E);
        }
        SEAM(pb + 10);
        if (IN(pb + 11)) { REFRESH(F); phase_ln2(F, l); }
        SEAM(pb + 11);
    }
#undef IN
#undef SEAM
}

extern "C" void kernel_launch(void* const* d_in, const int* in_sizes, int n_in, void* d_out, int out_size, void* d_ws, size_t ws_size, hipStream_t stream) {
    static int grid = 0;
    if (grid == 0) {
        if (n_in != 23 || out_size != NTOK * DM || ws_size < WS_END) { fprintf(stderr, "kernel_launch: unexpected shapes (n_in %d out %d ws %zu need %zu)\n", n_in, out_size, ws_size, (size_t)WS_END); grid = -1; return; }
        int dev = 0, cus = 0;
        if (hipGetDevice(&dev) != hipSuccess || hipDeviceGetAttribute(&cus, hipDeviceAttributeMultiprocessorCount, dev) != hipSuccess) { grid = -1; return; }
        if (hipFuncSetAttribute((const void*)mega, hipFuncAttributeMaxDynamicSharedMemorySize, LDS_BYTES) != hipSuccess) { fprintf(stderr, "kernel_launch: hipFuncSetAttribute failed\n"); grid = -1; return; }
        int per_cu = 0;
        if (hipOccupancyMaxActiveBlocksPerMultiprocessor(&per_cu, (const void*)mega, NTHR, LDS_BYTES) != hipSuccess || per_cu < 1) fprintf(stderr, "kernel_launch: occupancy query reports %d blocks per CU\n", per_cu);
        (void)hipGetLastError();
        grid = cus;
    }
    if (grid < 0) return;
    (void)hipMemsetAsync((char*)d_ws + WS_CTL, 0, CTL_BYTES, stream);
    Params p; memset(&p, 0, sizeof(p));
    const float** pp = (const float**)&p;
    for (int i = 0; i < 23; ++i) pp[i] = (const float*)d_in[i];
    p.out = (float*)d_out; p.ws = (unsigned char*)d_ws;
    p.ph_lo = 0; p.ph_hi = NPH;
    hipLaunchKernelGGL(mega, dim3(grid), dim3(NTHR), LDS_BYTES, stream, p);
}
```

```cpp
#include <hip/hip_runtime.h>
#include <cstdio>
#include <cstdint>
#include <cstring>

typedef unsigned short bf16_t;
typedef float f32x4 __attribute__((ext_vector_type(4)));
typedef unsigned u32x4 __attribute__((ext_vector_type(4)));
typedef unsigned u32x2 __attribute__((ext_vector_type(2)));

constexpr int NB = 4, SEQ = 4096, LC = 256, DM = 1024, DEPTH = 2;
constexpr int NTOK = NB * SEQ, NCTX = NB * LC, NROW = NTOK + NCTX;
constexpr int DIN = 10528;
constexpr int O_AQ = 0, O_AK = 256, O_AV = 512, O_AG = 1024, O_ALR = 1536, O_BQ = 1568, O_BK = 2080, O_BV = 2592, O_CQ = 3104, O_CK = 3616,
              O_CV = 3744, O_DQ = 3872, O_DF = 4384, O_DI = 5408, O_DG = 5920, O_GATE = 6432;
constexpr int PC_AQ = 0, PC_AK = 256, PC_AV = 512, PC_BQ = 1024, PC_BK = 1536, PC_CQ = 2048, PC_CK = 2560, PC_ALR = 2688, PC_DQ = 2816,
              PC_DF = 3328, PC_DI = 4352, PC_AG = 4864, PC_DG = 5376, NP1 = 5888;
constexpr float QSCALE = 0.125f * 1.44269504089f;
constexpr int NVT = 768;
constexpr int NVR = 640;
constexpr int NGATE = 4096;
constexpr int XS_ROWS = 40960;
constexpr float LN_EPS = 1e-5f;
constexpr float ALPHA = 1.41421356237f;

constexpr size_t al256(size_t x) { return (x + 255) & ~(size_t)255; }
constexpr size_t WS_CTL = 0;
constexpr size_t CTL_BYTES = 32768;
constexpr size_t CTL_CNT = 28672;
constexpr size_t WS_DUMP = WS_CTL + CTL_BYTES;
constexpr size_t WS_MODV = WS_DUMP + 4096;
constexpr size_t WS_LB = WS_MODV + al256((size_t)DEPTH * 5 * 6144 * 4);
constexpr size_t WS_TOKE = WS_LB + 4096;
constexpr size_t WS_TOKI = WS_TOKE + al256((size_t)2 * NROW * 4);
constexpr size_t WS_TOKW = WS_TOKI + al256((size_t)2 * NROW * 4);
constexpr size_t WS_RMAP = WS_TOKW + al256((size_t)2 * NROW * 4);
constexpr size_t WS_ROWW = WS_RMAP + al256((size_t)XS_ROWS * 4);
constexpr size_t WS_CXM = WS_ROWW + al256((size_t)XS_ROWS * 4);
constexpr size_t WS_CXO = WS_CXM + (size_t)NCTX * DM * 4;
constexpr size_t WS_WTA = WS_CXO + (size_t)NCTX * DM * 4;
constexpr size_t WTA_W1 = 0;
constexpr size_t WTA_WV = WTA_W1 + (size_t)NP1 * DM * 2;
constexpr size_t WTA_WG = WTA_WV + (size_t)NVT * DM * 2;
constexpr size_t WTA_WBR = WTA_WG + (size_t)NGATE * DM * 2;
constexpr size_t WTA_WO = WTA_WBR + (size_t)4 * DM * 512 * 2;
constexpr size_t WTA_BYTES = WTA_WO + (size_t)DM * DM * 2;
constexpr size_t WS_HX = WS_WTA + WTA_BYTES;
constexpr size_t WS_VT = WS_HX + (size_t)NROW * DM * 2;
constexpr size_t WS_OBA = WS_VT + (size_t)NVT * NROW * 2;
constexpr size_t WS_HX2 = WS_VT;
constexpr size_t WS_HID = WS_VT;
constexpr size_t WS_VR = WS_OBA + (size_t)NROW * 512 * 2;
constexpr size_t WS_BR = WS_VR + (size_t)NROW * NVR * 2;
constexpr size_t WS_P1 = WS_BR + (size_t)NROW * 2048 * 2;
constexpr size_t WS_G = WS_P1;
constexpr size_t WS_WGU = WS_P1 + (size_t)NROW * NGATE * 2;
constexpr size_t WS_WD = WS_WGU + (size_t)32 * 512 * DM * 2;
constexpr size_t WS_XS = WS_P1;
constexpr size_t WS_END = WS_P1 + (size_t)NROW * NP1 * 2;
static_assert(WS_WD + (size_t)32 * DM * 256 * 2 <= WS_END, "moe weights must fit in the P1 tail");
static_assert((size_t)XS_ROWS * DM * 2 <= (size_t)NROW * NGATE * 2, "XS must fit in the G region");
static_assert((size_t)NVT * NROW * 2 + (size_t)NROW * 512 * 2 >= (size_t)NROW * DM * 2, "HX2 alias");
static_assert(WS_END <= 434800000ull, "workspace budget");

constexpr int NTHR = 512;
constexpr int LDS_STAGE = 1024;
constexpr int LDS_ROPE = 1024 + 131072 + 1024;
constexpr int LDS_BYTES = 144 * 1024;

struct Params {
    const float *x, *c, *ctx, *c_ctx, *w_mod, *b_mod, *w_in, *gla_lr_w, *gla_lr_b, *hg_gamma, *na_rpb, *wa_sink, *w_branch, *w_out, *ln_g, *ln_b,
        *moe_w_group, *moe_b_group, *moe_w_expert, *moe_b_expert, *moe_w_gate, *moe_w_up, *moe_w_down;
    float* out;
    unsigned char* ws;
    int ph_lo, ph_hi;
};

__device__ __forceinline__ float bf2f(bf16_t b) { return __uint_as_float(((unsigned)b) << 16); }
__device__ __forceinline__ bf16_t f2bf(float f) { unsigned u = __float_as_uint(f); u += 0x7FFFu + ((u >> 16) & 1u); return (bf16_t)(u >> 16); }
typedef float f32x2_t __attribute__((ext_vector_type(2)));
typedef __bf16 bf16x2_t __attribute__((ext_vector_type(2)));
__device__ __forceinline__ unsigned pk2(float lo, float hi) {
    const f32x2_t v = {lo, hi}; const bf16x2_t b = __builtin_convertvector(v, bf16x2_t); return __builtin_bit_cast(unsigned, b); }
__device__ __forceinline__ void ld8(const bf16_t* p, float* f) {
    const u32x4 v = *(const u32x4*)p;
    f[0] = __uint_as_float(v.x << 16); f[1] = __uint_as_float(v.x & 0xffff0000u);
    f[2] = __uint_as_float(v.y << 16); f[3] = __uint_as_float(v.y & 0xffff0000u);
    f[4] = __uint_as_float(v.z << 16); f[5] = __uint_as_float(v.z & 0xffff0000u);
    f[6] = __uint_as_float(v.w << 16); f[7] = __uint_as_float(v.w & 0xffff0000u);
}
__device__ __forceinline__ void st8(bf16_t* p, const float* f) {
    u32x4 v; v.x = pk2(f[0], f[1]); v.y = pk2(f[2], f[3]); v.z = pk2(f[4], f[5]); v.w = pk2(f[6], f[7]);
    *(u32x4*)p = v;
}
__device__ __forceinline__ float sigmoidf_(float x) { return __builtin_amdgcn_rcpf(1.f + __expf(-x)); }
__device__ __forceinline__ float siluf_(float x) { return x * __builtin_amdgcn_rcpf(1.f + __expf(-x)); }
__device__ __forceinline__ float wave_sum(float v) {
#pragma unroll
    for (int o = 1; o < 64; o <<= 1) v += __shfl_xor(v, o);
    return v;
}
__device__ __forceinline__ int row_batch(int row) { return row < NTOK ? (row >> 12) : 4; }

#define XB_TMO      128
#define XB_XCNT(j)  (256  + 64 * (j))
#define XB_XSUB(j)  (1280 + 64 * (j))
#define XB_XGEN(j)  (2304 + 64 * (j))
#define XB_TOP      3328
#define XB_TOPGEN   3392
#define XCD_BAR_WORDS 3456
#define XB_SPIN_CAP (1u << 18)
#define LAS __attribute__((address_space(3)))
__device__ __forceinline__ unsigned xb_ld(unsigned* p)              { return __hip_atomic_load(p, __ATOMIC_RELAXED, __HIP_MEMORY_SCOPE_AGENT); }
__device__ __forceinline__ unsigned xb_add(unsigned* p, unsigned v) { return __hip_atomic_fetch_add(p, v, __ATOMIC_RELAXED, __HIP_MEMORY_SCOPE_AGENT); }
__device__ __forceinline__ unsigned xb_xcc_id() { return (unsigned)__builtin_amdgcn_s_getreg((3 << 11) | 20) & 0xFu; }
#define XB_SPIN(cond, bar) do { unsigned _sp = 0; while (cond) { __builtin_amdgcn_s_sleep(1); \
    if ((++_sp & 255u) == 0u) { if (xb_ld(&(bar)[XB_TMO])) break; if (_sp > XB_SPIN_CAP) { atomicAdd(&(bar)[XB_TMO], 1u); break; } } } } while (0)
struct XcdBarrier { unsigned* bar; unsigned x; volatile LAS unsigned* st; };
__device__ __forceinline__ XcdBarrier xcd_barrier_post(unsigned* bar, volatile LAS unsigned* st) {
    XcdBarrier b; b.bar = bar; b.x = xb_xcc_id(); b.st = st;
    if (threadIdx.x == 0) (void)xb_add(&bar[XB_XCNT(b.x)], 1u);
    return b;
}
__device__ __forceinline__ void xcd_barrier_complete(unsigned* bar, unsigned x, unsigned& nloc, unsigned& nx) {
    const unsigned G = gridDim.x * gridDim.y * gridDim.z;
    unsigned sum, cnt, mine, sp = 0u;
    for (;;) {
        sum = 0u; cnt = 0u; mine = 0u;
#pragma unroll
        for (unsigned j = 0; j < 16; ++j) { const unsigned c = xb_ld(&bar[XB_XCNT(j)]); sum += c; cnt += (c > 0u) ? 1u : 0u; mine = (j == x) ? c : mine; }
        if (sum == G) break;
        __builtin_amdgcn_s_sleep(1);
        if ((++sp & 255u) == 0u) { if (xb_ld(&bar[XB_TMO])) break; if (sp > XB_SPIN_CAP) { atomicAdd(&bar[XB_TMO], 1u); break; } }
    }
    nloc = mine > 0u ? mine : 1u; nx = cnt > 0u ? cnt : 1u;
}
__device__ __forceinline__ void xcd_barrier(const XcdBarrier& b) {
    asm volatile("s_waitcnt vmcnt(0)" ::: "memory");
    __syncthreads();
    if (threadIdx.x == 0) {
        unsigned* bar = b.bar;
        __builtin_amdgcn_s_waitcnt(0);
        unsigned nloc = b.st[0], nx = b.st[1];
        if (nloc == 0u) { xcd_barrier_complete(bar, b.x, nloc, nx); b.st[0] = nloc; b.st[1] = nx; }
        const unsigned old = xb_add(&bar[XB_XSUB(b.x)], 1u);
        const unsigned gen = old / nloc;
        if (old + 1u == (gen + 1u) * nloc) {
            __builtin_amdgcn_fence(__ATOMIC_RELEASE, "agent");
            asm volatile("s_waitcnt vmcnt(0)" ::: "memory");
            const unsigned og = xb_add(&bar[XB_TOP], 1u);
            const unsigned tg = og / nx;
            if (og + 1u == (tg + 1u) * nx) xb_add(&bar[XB_TOPGEN], 1u);
            else XB_SPIN(xb_ld(&bar[XB_TOPGEN]) == tg, bar);
            __builtin_amdgcn_fence(__ATOMIC_ACQUIRE, "agent");
            xb_add(&bar[XB_XGEN(b.x)], 1u);
            asm volatile("s_waitcnt vmcnt(0)" ::: "memory");
        } else {
            XB_SPIN(xb_ld(&bar[XB_XGEN(b.x)]) == gen, bar);
            __builtin_amdgcn_fence(__ATOMIC_ACQUIRE, "agent");
            asm volatile("s_waitcnt vmcnt(0)" ::: "memory");
        }
    }
    __syncthreads();
}

struct Frame {
    Params p;
    int bid, nb, tid, lane, wave, wid_s;
    float* smf;
    unsigned char* ws;
    __device__ __forceinline__ float* modv() const { return (float*)(ws + WS_MODV); }
    __device__ __forceinline__ float* lb() const { return (float*)(ws + WS_LB); }
    __device__ __forceinline__ int* tokE() const { return (int*)(ws + WS_TOKE); }
    __device__ __forceinline__ int* tokI() const { return (int*)(ws + WS_TOKI); }
    __device__ __forceinline__ float* tokW() const { return (float*)(ws + WS_TOKW); }
    __device__ __forceinline__ int* rmap() const { return (int*)(ws + WS_RMAP); }
    __device__ __forceinline__ float* roww() const { return (float*)(ws + WS_ROWW); }
    __device__ __forceinline__ float* cxm() const { return (float*)(ws + WS_CXM); }
    __device__ __forceinline__ float* cxo() const { return (float*)(ws + WS_CXO); }
    __device__ __forceinline__ bf16_t* W1t() const { return (bf16_t*)(ws + WS_WTA + WTA_W1); }
    __device__ __forceinline__ bf16_t* Wvt() const { return (bf16_t*)(ws + WS_WTA + WTA_WV); }
    __device__ __forceinline__ bf16_t* Wgt() const { return (bf16_t*)(ws + WS_WTA + WTA_WG); }
    __device__ __forceinline__ bf16_t* Wbrt() const { return (bf16_t*)(ws + WS_WTA + WTA_WBR); }
    __device__ __forceinline__ bf16_t* Woutt() const { return (bf16_t*)(ws + WS_WTA + WTA_WO); }
    __device__ __forceinline__ bf16_t* HX() const { return (bf16_t*)(ws + WS_HX); }
    __device__ __forceinline__ bf16_t* VT() const { return (bf16_t*)(ws + WS_VT); }
    __device__ __forceinline__ bf16_t* OBA() const { return (bf16_t*)(ws + WS_OBA); }
    __device__ __forceinline__ bf16_t* HX2() const { return (bf16_t*)(ws + WS_HX2); }
    __device__ __forceinline__ bf16_t* HID() const { return (bf16_t*)(ws + WS_HID); }
    __device__ __forceinline__ bf16_t* VR() const { return (bf16_t*)(ws + WS_VR); }
    __device__ __forceinline__ bf16_t* BR() const { return (bf16_t*)(ws + WS_BR); }
    __device__ __forceinline__ bf16_t* P1() const { return (bf16_t*)(ws + WS_P1); }
    __device__ __forceinline__ bf16_t* G() const { return (bf16_t*)(ws + WS_G); }
    __device__ __forceinline__ bf16_t* Wgu() const { return (bf16_t*)(ws + WS_WGU); }
    __device__ __forceinline__ bf16_t* Wd() const { return (bf16_t*)(ws + WS_WD); }
    __device__ __forceinline__ bf16_t* XS() const { return (bf16_t*)(ws + WS_XS); }
    __device__ __forceinline__ unsigned* cnt() const { return (unsigned*)(ws + WS_CTL + CTL_CNT); }
};


#define REFRESH(F) do { int _t = threadIdx.x; asm volatile("" : "+v"(_t)); (F).tid = _t; (F).lane = _t & 63; (F).wave = _t >> 6; } while (0)

__device__ __forceinline__ void phase_mod(Frame& F) {
    float* sc = F.smf;
    float* red = F.smf + 5 * 1024;
    bool have = false;
    for (int it = F.bid; it < DEPTH * 96; it += F.nb) {
        if (!have) {
            for (int i = F.tid; i < 5 * 1024; i += NTHR) { const float v = (i < 4096) ? F.p.c[i] : F.p.c_ctx[i - 4096]; sc[i] = siluf_(v); }
            __syncthreads(); have = true;
        }
        const int l = it / 96, n0 = (it % 96) * 64, col = F.tid & 63, kg = F.tid >> 6;
        const float* w = F.p.w_mod + (size_t)l * DM * 6144 + n0 + col;
        float a[5] = {0.f, 0.f, 0.f, 0.f, 0.f};
        for (int k = kg * 128; k < kg * 128 + 128; ++k) {
            const float wv = w[(size_t)k * 6144];
#pragma unroll
            for (int r = 0; r < 5; ++r) a[r] += sc[r * 1024 + k] * wv;
        }
#pragma unroll
        for (int r = 0; r < 5; ++r) red[(kg * 5 + r) * 64 + col] = a[r];
        __syncthreads();
        if (F.tid < 320) {
            const int r = F.tid >> 6, cc = F.tid & 63; float s = F.p.b_mod[l * 6144 + n0 + cc];
#pragma unroll
            for (int g = 0; g < 8; ++g) s += red[(g * 5 + r) * 64 + cc];
            F.modv()[((size_t)l * 5 + r) * 6144 + n0 + cc] = s;
        }
        __syncthreads();
    }
    if (F.bid == F.nb - 1) {
        for (int i = F.tid; i < 1024; i += NTHR) { const int z = i >> 9, f = i & 511;
            const float g0 = F.p.hg_gamma[(z * DEPTH + 0) * 512 + f], g1 = F.p.hg_gamma[(z * DEPTH + 1) * 512 + f];
            F.lb()[i] = 1.f / (1.f + expf(g0 - g1)); }
    }
}

__device__ __forceinline__ int p1_src(int n, float& scale) {
    scale = 1.f;
    if (n < 256) { scale = 0.125f; return O_AQ + n; }
    if (n < 512) return O_AK + (n - 256);
    if (n < 1024) return O_AV + (n - 512);
    if (n < 1536) { scale = QSCALE; return O_BQ + (n - 1024); }
    if (n < 2048) return O_BK + (n - 1536);
    if (n < 2560) { scale = QSCALE; return O_CQ + (n - 2048); }
    if (n < 2688) return O_CK + (n - 2560);
    if (n < 2720) return O_ALR + (n - 2688);
    if (n < 2816) return -1;
    if (n < 3328) return O_DQ + (n - 2816);
    if (n < 4352) return O_DF + (n - 3328);
    if (n < 4864) return O_DI + (n - 4352);
    if (n < 5376) return O_AG + (n - 4864);
    return O_DG + (n - 5376);
}
__device__ __forceinline__ void conv_item(const float* src, int ldsrc, int srccol, float scale, bf16_t* dst, int K, int k0, float* scr, int lane, bool perm) {
    if (srccol >= 0) {
#pragma unroll 8
        for (int i = 0; i < 32; ++i) { const int kk = 2 * i + (lane >> 5); scr[kk * 33 + (lane & 31)] = src[(size_t)(k0 + kk) * ldsrc + srccol + (lane & 31)] * scale; }
    } else {
#pragma unroll 8
        for (int i = 0; i < 32; ++i) { const int kk = 2 * i + (lane >> 5); scr[kk * 33 + (lane & 31)] = 0.f; }
    }
    asm volatile("s_waitcnt lgkmcnt(0)" ::: "memory");
    const int c = lane & 7;
#pragma unroll
    for (int j = 0; j < 4; ++j) { const int nn = (lane >> 3) + 8 * j; const float* sp = scr + (8 * c) * 33 + (perm ? (8 * ((nn & 15) >> 2) + 4 * (nn >> 4) + (nn & 3)) : nn);
        u32x4 o; o.x = pk2(sp[0 * 33], sp[1 * 33]); o.y = pk2(sp[2 * 33], sp[3 * 33]); o.z = pk2(sp[4 * 33], sp[5 * 33]); o.w = pk2(sp[6 * 33], sp[7 * 33]);
        *(u32x4*)(dst + (size_t)nn * K + 8 * c) = o; }
    asm volatile("s_waitcnt lgkmcnt(0)" ::: "memory");
}
constexpr int CONVA_W1 = (NP1 / 32) * 16;
constexpr int CONVA_ITEMS = CONVA_W1 + 384 + 2048 + 1024 + 512;
__device__ __forceinline__ void phase_conv_a(Frame& F, int l) {
    float* scr = F.smf + F.wave * (64 * 33);
    const int gw = F.bid * 8 + F.wave, ngw = F.nb * 8;
    for (int it0 = gw; it0 < CONVA_ITEMS; it0 += ngw) {
        int ti = it0;
        if (ti < CONVA_W1) { const int n0 = (ti >> 4) * 32, kt = ti & 15; float sc; const int sx = p1_src(n0, sc);
            conv_item(F.p.w_in + (size_t)l * DM * DIN, DIN, sx, sc, F.W1t() + (size_t)n0 * DM + kt * 64, DM, kt * 64, scr, F.lane, !(n0 >= 2048 && n0 < 2816)); continue; }
        ti -= CONVA_W1;
        if (ti < 384) { const int n0 = (ti >> 4) * 32, kt = ti & 15; const int sx = n0 < 512 ? O_BV + n0 : (n0 < 640 ? O_CV + (n0 - 512) : -1);
            conv_item(F.p.w_in + (size_t)l * DM * DIN, DIN, sx, 1.f, F.Wvt() + (size_t)n0 * DM + kt * 64, DM, kt * 64, scr, F.lane, false); continue; }
        ti -= 384;
        if (ti < 2048) { const int n0 = (ti >> 4) * 32, kt = ti & 15;
            conv_item(F.p.w_in + (size_t)l * DM * DIN, DIN, O_GATE + n0, 1.f, F.Wgt() + (size_t)n0 * DM + kt * 64, DM, kt * 64, scr, F.lane, true); continue; }
        ti -= 2048;
        if (ti < 1024) { const int i = ti >> 8, r = ti & 255, n0 = (r >> 3) * 32, kt = r & 7;
            conv_item(F.p.w_branch + (size_t)(l * 4 + i) * 512 * DM, DM, n0, 1.f, F.Wbrt() + (size_t)i * DM * 512 + (size_t)n0 * 512 + kt * 64, 512, kt * 64, scr, F.lane, true); continue; }
        ti -= 1024;
        { const int n0 = (ti >> 4) * 32, kt = ti & 15;
          conv_item(F.p.w_out + (size_t)l * DM * DM, DM, n0, 1.f, F.Woutt() + (size_t)n0 * DM + kt * 64, DM, kt * 64, scr, F.lane, false); }
    }
}
constexpr int CONVB_ITEMS = 8192 + 4096;
__device__ __forceinline__ void phase_conv_b(Frame& F, int l) {
    float* scr = F.smf + F.wave * (64 * 33);
    const int gw = F.bid * 8 + F.wave, ngw = F.nb * 8;
    for (int it0 = gw; it0 < CONVB_ITEMS; it0 += ngw) {
        int ti = it0;
        if (ti < 8192) { const int e = ti >> 8, r = ti & 255, n0 = (r >> 4) * 32, kt = r & 15, j = n0 >> 8, rr = n0 & 255; const bool isup = rr >= 128; const int cc = 128 * j + (rr & 127);
            const float* src = (isup ? F.p.moe_w_up : F.p.moe_w_gate) + (size_t)(l * 32 + e) * DM * 256;
            conv_item(src, 256, cc, 1.f, F.Wgu() + (size_t)e * 512 * DM + (size_t)n0 * DM + kt * 64, DM, kt * 64, scr, F.lane, true); continue; }
        ti -= 8192;
        { const int e = ti >> 7, r = ti & 127, n0 = (r >> 2) * 32, kt = r & 3;
          conv_item(F.p.moe_w_down + (size_t)(l * 32 + e) * 256 * DM, DM, n0, 1.f, F.Wd() + (size_t)e * DM * 256 + (size_t)n0 * 256 + kt * 64, 256, kt * 64, scr, F.lane, true); }
    }
}

__device__ __forceinline__ void phase_prep(Frame& F, int l, const float* xlat, const float* xctx) {
    const int gw = F.bid * 8 + F.wave, ngw = F.nb * 8;
    for (int row = gw; row < NROW; row += ngw) {
        const float* xr = row < NTOK ? xlat + (size_t)row * DM : xctx + (size_t)(row - NTOK) * DM;
        const float* mv = F.modv() + ((size_t)l * 5 + row_batch(row)) * 6144;
#pragma unroll
        for (int j = 0; j < 4; ++j) { const int d = j * 256 + F.lane * 4;
            const f32x4 v = *(const f32x4*)(xr + d), m0 = *(const f32x4*)(mv + d), m1 = *(const f32x4*)(mv + 1024 + d);
            u32x2 o; o.x = pk2(v.x * (1.f + m1.x) + m0.x, v.y * (1.f + m1.y) + m0.y); o.y = pk2(v.z * (1.f + m1.z) + m0.z, v.w * (1.f + m1.w) + m0.w);
            *(u32x2*)(F.HX() + (size_t)row * DM + d) = o; }
    }
}


namespace pg {
typedef short bf16x8 __attribute__((ext_vector_type(8)));
constexpr int BM = 256, BK = 64, HALF = 128, HTB = HALF * BK * 2, STAGE_BYTES = 8 * HTB, NXCD = 8, WGM = 8;
__device__ __forceinline__ int lds_byte(int r, int c) { const int st = (r >> 4) * 2 + (c >> 5), rr = r & 15, cc = c & 31, ob = rr * 64 + cc * 2; return st * 1024 + (ob ^ (((ob >> 9) & 1) << 5)); }
__device__ __forceinline__ void stage_rc(int b, int& R, int& C) { const int st = b / 1024, sb = b % 1024, swz = sb ^ (((sb >> 9) & 1) << 5); R = (st >> 1) * 16 + swz / 64; C = (st & 1) * 32 + (swz % 64) / 2; }
struct Unit { const char* a; const char* b; int pm, pn, aux; };
__device__ __forceinline__ void static_map(int L, int nM, int nN, int& pm, int& pn) {
    const int nwg = nM * nN; int wgid = L; { const int q = nwg / NXCD, r = nwg % NXCD, xcd = wgid % NXCD, off = wgid / NXCD; wgid = (xcd < r ? xcd * (q + 1) : r * (q + 1) + (xcd - r) * q) + off; }
    const int nig = WGM * nN, gid = wgid / nig, fm = gid * WGM, gsz = (nM - fm) < WGM ? (nM - fm) : WGM;
    pm = fm + ((wgid % nig) % gsz); pn = (wgid % nig) / gsz;
}
template <class Epi, class Sched>
__device__ __forceinline__ void gemm_phase(LAS unsigned char* lds, const int lda, const int ldb, const int K, const Sched& S, const Epi& E) {
    int tid = threadIdx.x; asm volatile("" : "+v"(tid));
    const int wid = __builtin_amdgcn_readfirstlane(tid >> 6), lane = tid & 63, wr = wid >> 2, wc = wid & 3, fr = lane & 15, fq = lane >> 4;
    int nt = K / BK; asm volatile("" : "+s"(nt));
    unsigned voffA[2], voffB[2];
#pragma unroll
    for (int i = 0; i < 2; ++i) { int R, C; stage_rc(tid * 16 + i * 8192, R, C); voffA[i] = (unsigned)(R * lda + C) * 2u; voffB[i] = (unsigned)(R * ldb + C) * 2u; }
    const size_t kstep = (size_t)(BK * 2);
    const size_t hstepA = (size_t)HALF * lda * 2, hstepB = (size_t)HALF * ldb * 2;
    const unsigned ldsw = (unsigned)wid * 1024u;
    const int aoff = lds_byte(wr * 64 + fr, fq * 8), boff = lds_byte(wc * 32 + fr, fq * 8);
#define PG_SA(b, h) (((b) * 2 + (h)) * HTB)
#define PG_SB(b, h) ((4 + (b) * 2 + (h)) * HTB)
#define PG_STAGE(bufoff, gbase, voff) do { _Pragma("unroll") for (int _i = 0; _i < 2; ++_i) \
        __builtin_amdgcn_global_load_lds((const unsigned*)((const char*)(gbase) + (voff)[_i]), (LAS unsigned*)(lds + (bufoff) + ldsw + _i * 8192), 16, 0, 0); } while (0)
#define PG_LDA(dst, b, h) do { _Pragma("unroll") for (int m = 0; m < 4; ++m) _Pragma("unroll") for (int k = 0; k < 2; ++k) dst[m][k] = *(const LAS bf16x8*)(lds + PG_SA(b, h) + aoff + m * 2048 + k * 1024); } while (0)
#define PG_LDB(dst, b, h) do { _Pragma("unroll") for (int n = 0; n < 2; ++n) _Pragma("unroll") for (int k = 0; k < 2; ++k) dst[n][k] = *(const LAS bf16x8*)(lds + PG_SB(b, h) + boff + n * 2048 + k * 1024); } while (0)
#define PG_MMA(ai, bj, At, Bt) do { __builtin_amdgcn_s_setprio(1); _Pragma("unroll") for (int m = 0; m < 4; ++m) _Pragma("unroll") for (int n = 0; n < 2; ++n) _Pragma("unroll") for (int k = 0; k < 2; ++k) \
        acc[ai][bj][m][n] = __builtin_amdgcn_mfma_f32_16x16x32_bf16(Bt[n][k], At[m][k], acc[ai][bj][m][n], 0, 0, 0); __builtin_amdgcn_s_setprio(0); } while (0)
#define PG_WAIT_V(n) asm volatile("s_waitcnt vmcnt(" #n ")" ::: "memory")
#define PG_WAIT_L(n) asm volatile("s_waitcnt lgkmcnt(" #n ")" ::: "memory")
#define PG_BAR __builtin_amdgcn_s_barrier()
#define PG_SCHED __builtin_amdgcn_sched_barrier(0)
    Unit cur, nxt; int ui = 0;
    if (!S.next(0, cur)) return;
    f32x4 acc[2][2][4][2];
#pragma unroll
    for (int a = 0; a < 2; ++a)
#pragma unroll
        for (int b = 0; b < 2; ++b)
#pragma unroll
            for (int m = 0; m < 4; ++m)
#pragma unroll
                for (int n = 0; n < 2; ++n) acc[a][b][m][n] = (f32x4){0.f, 0.f, 0.f, 0.f};
    bf16x8 At[4][2], B0[2][2], B1[2][2];
    const char* cA = cur.a; const char* cB = cur.b;
    PG_STAGE(PG_SB(0, 0), cB, voffB); PG_STAGE(PG_SA(0, 0), cA, voffA); PG_STAGE(PG_SB(0, 1), cB + hstepB, voffB); PG_STAGE(PG_SA(0, 1), cA + hstepA, voffA);
    if (wr == 1) PG_BAR;
    PG_WAIT_V(4); PG_BAR;
    PG_STAGE(PG_SB(1, 0), cB + kstep, voffB); PG_STAGE(PG_SA(1, 0), cA + kstep, voffA); PG_STAGE(PG_SB(1, 1), cB + hstepB + kstep, voffB);
    PG_WAIT_V(6); PG_BAR;
    for (;;) {
        const bool has_next = S.next(ui + 1, nxt);
        const char* nA = has_next ? nxt.a : cA; const char* nB = has_next ? nxt.b : cB;
        for (int t = 0; t < nt; t += 2) {
            const bool last = (t == nt - 2);
            const char* a1 = cA + (size_t)(t + 1) * kstep;
            const char* a2 = last ? nA : cA + (size_t)(t + 2) * kstep; const char* b2 = last ? nB : cB + (size_t)(t + 2) * kstep;
            const char* a3 = a2 + kstep; const char* b3 = b2 + kstep;
            PG_LDB(B0, 0, 0); PG_SCHED; PG_LDA(At, 0, 0); PG_STAGE(PG_SA(1, 1), a1 + hstepA, voffA);
            PG_WAIT_L(8); PG_BAR; PG_WAIT_L(0); PG_MMA(0, 0, At, B0); PG_BAR; PG_SCHED;
            PG_LDB(B1, 0, 1); PG_STAGE(PG_SB(0, 0), b2, voffB);
            PG_BAR; PG_WAIT_L(0); PG_MMA(0, 1, At, B1); PG_BAR;
            PG_LDA(At, 0, 1); PG_STAGE(PG_SA(0, 0), a2, voffA);
            PG_BAR; PG_WAIT_L(0); PG_MMA(1, 0, At, B0); PG_BAR; PG_SCHED;
            PG_STAGE(PG_SB(0, 1), b2 + hstepB, voffB);
            PG_WAIT_V(6); PG_BAR; PG_MMA(1, 1, At, B1); PG_BAR;
            PG_LDB(B0, 1, 0); PG_SCHED; PG_LDA(At, 1, 0); PG_STAGE(PG_SA(0, 1), a2 + hstepA, voffA);
            PG_WAIT_L(8); PG_BAR; PG_WAIT_L(0); PG_MMA(0, 0, At, B0); PG_BAR; PG_SCHED;
            PG_LDB(B1, 1, 1); PG_STAGE(PG_SB(1, 0), b3, voffB);
            PG_BAR; PG_WAIT_L(0); PG_MMA(0, 1, At, B1); PG_BAR;
            PG_LDA(At, 1, 1); PG_STAGE(PG_SA(1, 0), a3, voffA);
            PG_BAR; PG_WAIT_L(0); PG_MMA(1, 0, At, B0); PG_BAR; PG_SCHED;
            PG_STAGE(PG_SB(1, 1), b3 + hstepB, voffB);
            PG_WAIT_V(6); PG_BAR; PG_MMA(1, 1, At, B1); PG_BAR;
        }
        E(acc, cur, wr, wc, fr, fq);
        if (!has_next) break;
#pragma unroll
        for (int a = 0; a < 2; ++a)
#pragma unroll
            for (int b = 0; b < 2; ++b)
#pragma unroll
                for (int m = 0; m < 4; ++m)
#pragma unroll
                    for (int n = 0; n < 2; ++n) acc[a][b][m][n] = (f32x4){0.f, 0.f, 0.f, 0.f};
        cur = nxt; cA = nA; cB = nB; ++ui;
    }
    PG_WAIT_V(0);
    if (wr == 0) PG_BAR;
    PG_BAR;
#undef PG_SA
#undef PG_SB
#undef PG_STAGE
#undef PG_LDA
#undef PG_LDB
#undef PG_MMA
#undef PG_WAIT_V
#undef PG_WAIT_L
#undef PG_BAR
#undef PG_SCHED
}

struct SchedG1 {
    const char *HX, *W1, *WV; int G, c;
    __device__ __forceinline__ bool next(int i, Unit& u) const {
        const int L = i * G + c, nmain = (NROW / 256) * (NP1 / 256);
        if (L < nmain) { static_map(L, NROW / 256, NP1 / 256, u.pm, u.pn); u.a = HX + (size_t)u.pm * 256 * DM * 2; u.b = W1 + (size_t)u.pn * 256 * DM * 2; u.aux = 0; return true; }
        const int idx = L - nmain; if (idx >= 3 * (NROW / 256)) return false;
        u.pm = idx % 3; u.pn = idx / 3; u.a = WV + (size_t)u.pm * 256 * DM * 2; u.b = HX + (size_t)u.pn * 256 * DM * 2; u.aux = 1; return true;
    }
};
struct SchedStatic {
    const char *A, *B; size_t tA, tB; int nM, nN, G, c;
    __device__ __forceinline__ bool next(int i, Unit& u) const {
        const int L = i * G + c; if (L >= nM * nN) return false;
        static_map(L, nM, nN, u.pm, u.pn); u.a = A + (size_t)u.pm * tA; u.b = B + (size_t)u.pn * tB; u.aux = 0; return true;
    }
};
struct SchedMerge {
    const char *BR, *W; int ntile, G, c;
    __device__ __forceinline__ bool next(int i, Unit& u) const {
        const int t = c + (i >> 2) * G; if (t >= ntile) return false;
        const int br = i & 3; u.pm = t >> 2; u.pn = t & 3; u.aux = br;
        u.a = BR + (size_t)u.pm * 256 * 2048 * 2 + (size_t)br * 512 * 2; u.b = W + (size_t)br * DM * 512 * 2 + (size_t)u.pn * 256 * 512 * 2; return true;
    }
};
struct SchedMoe {
    const char *A, *W; const int* off; size_t tA, wE, wT; int npan, NJ, G, c;
    __device__ __forceinline__ bool next(int i, Unit& u) const {
        const int L = i * G + c; if (L >= npan * NJ) return false;
        const int p = L / NJ, j = L % NJ; int e = 0;
#pragma unroll 1
        for (int q = 1; q < 32; ++q) if (p * 256 >= off[q]) e = q;
        e = __builtin_amdgcn_readfirstlane(e);
        u.pm = p; u.pn = j; u.aux = e; u.a = A + (size_t)p * tA; u.b = W + (size_t)e * wE + (size_t)j * wT; return true;
    }
};

#define PG_ROWCOL const int row0 = u.pm * BM + wr * 64 + fr, col0 = u.pn * BM + wc * 32 + 4 * fq
struct EpiG1 { bf16_t *P1, *VT; const float* rtab; const float* lbp; int layer;
    __device__ __forceinline__ void operator()(const f32x4 (&acc)[2][2][4][2], const Unit& u, int wr, int wc, int fr, int fq) const {
        const int row0 = u.pm * BM + wr * 64 + fr;
        if (u.aux || (u.pn >= 8 && u.pn <= 10)) {
            const int col0 = u.pn * BM + wc * 32 + 4 * fq; bf16_t* base = u.aux ? VT : P1; const size_t ld = u.aux ? (size_t)NROW : (size_t)NP1;
            const bool rope = !u.aux && (u.pm < NTOK / 256);
#pragma unroll
            for (int ai = 0; ai < 2; ++ai)
#pragma unroll
                for (int m = 0; m < 4; ++m) { const int r = row0 + ai * HALF + m * 16; bf16_t* rowp = base + (size_t)r * ld + col0;
#pragma unroll
                    for (int bj = 0; bj < 2; ++bj) {
                        f32x4 v0 = acc[ai][bj][m][0], v1 = acc[ai][bj][m][1];
                        if (rope && !(u.pn == 10 && bj == 1)) {
                            const int pos = r & (SEQ - 1), pp = (wc & 1) ? (pos & 63) : (pos >> 6); const float* tp = rtab + (pp * 16 + 4 * fq) * 2;
                            const f32x4 t0 = *(const f32x4*)tp, t1 = *(const f32x4*)(tp + 4);
                            const f32x4 a = v0, b = v1;
                            v0.x = a.x * t0.x - b.x * t0.y; v1.x = a.x * t0.y + b.x * t0.x; v0.y = a.y * t0.z - b.y * t0.w; v1.y = a.y * t0.w + b.y * t0.z;
                            v0.z = a.z * t1.x - b.z * t1.y; v1.z = a.z * t1.y + b.z * t1.x; v0.w = a.w * t1.z - b.w * t1.w; v1.w = a.w * t1.w + b.w * t1.z;
                        }
                        u32x2 o; o.x = pk2(v0.x, v0.y); o.y = pk2(v0.z, v0.w); *(u32x2*)(rowp + bj * HALF) = o;
                        o.x = pk2(v1.x, v1.y); o.y = pk2(v1.z, v1.w); *(u32x2*)(rowp + bj * HALF + 16) = o; } }
            return;
        }
        const int col0 = u.pn * BM + wc * 32 + 8 * fq;
        const int mode = (u.pn == 11 || u.pn == 12) ? 2 : ((u.pn >= 13 && u.pn <= 16) ? 3 : 0);
#pragma unroll
        for (int ai = 0; ai < 2; ++ai)
#pragma unroll
            for (int m = 0; m < 4; ++m) { bf16_t* rowp = P1 + (size_t)(row0 + ai * HALF + m * 16) * NP1 + col0;
#pragma unroll
                for (int bj = 0; bj < 2; ++bj) {
                    f32x4 v0 = acc[ai][bj][m][0], v1 = acc[ai][bj][m][1];
                    if (mode == 2) {
#pragma unroll
                        for (int j = 0; j < 4; ++j) { v0[j] = v0[j] * __builtin_amdgcn_rcpf(1.f + __expf(-v0[j])); v1[j] = v1[j] * __builtin_amdgcn_rcpf(1.f + __expf(-v1[j])); }
                    } else if (mode == 3) {
                        const int z = (u.pn - 13) >> 1, cb = z * 512 + ((u.pn - 13) & 1) * 256 + bj * HALF + wc * 32 + 8 * fq;
#pragma unroll
                        for (int n = 0; n < 2; ++n)
#pragma unroll
                            for (int j = 0; j < 4; ++j) { const float f = n ? v1[j] : v0[j]; const float t = __expf(-fabsf(f)), rr = __builtin_amdgcn_rcpf(1.f + t); float gq;
                                if (layer == 0) gq = fminf(f, 0.f) + __logf(rr);
                                else { const float lb = lbp[cb + 4 * n + j]; gq = __logf(lb + (1.f - lb) * ((f >= 0.f) ? rr : t * rr)); }
                                if (n) v1[j] = gq; else v0[j] = gq; }
                    }
                    u32x4 o; o.x = pk2(v0.x, v0.y); o.y = pk2(v0.z, v0.w); o.z = pk2(v1.x, v1.y); o.w = pk2(v1.z, v1.w); *(u32x4*)(rowp + bj * HALF) = o; } }
    }
};
#define PG_ROWCOL8 const int row0 = u.pm * BM + wr * 64 + fr, col0 = u.pn * BM + wc * 32 + 8 * fq
struct EpiGate { bf16_t* G;
    __device__ __forceinline__ void operator()(const f32x4 (&acc)[2][2][4][2], const Unit& u, int wr, int wc, int fr, int fq) const {
        PG_ROWCOL8;
#pragma unroll
        for (int ai = 0; ai < 2; ++ai)
#pragma unroll
            for (int m = 0; m < 4; ++m) { bf16_t* rowp = G + (size_t)(row0 + ai * HALF + m * 16) * NGATE + col0;
#pragma unroll
                for (int bj = 0; bj < 2; ++bj) { const f32x4 v0 = acc[ai][bj][m][0], v1 = acc[ai][bj][m][1]; u32x4 o;
                    o.x = pk2(sigmoidf_(v0.x), sigmoidf_(v0.y)); o.y = pk2(sigmoidf_(v0.z), sigmoidf_(v0.w)); o.z = pk2(sigmoidf_(v1.x), sigmoidf_(v1.y)); o.w = pk2(sigmoidf_(v1.z), sigmoidf_(v1.w));
                    *(u32x4*)(rowp + bj * HALF) = o; } }
    }
};
struct EpiMerge { const bf16_t* G; bf16_t* O;
    __device__ __forceinline__ void operator()(const f32x4 (&acc)[2][2][4][2], const Unit& u, int wr, int wc, int fr, int fq) const {
        PG_ROWCOL8; const int br = u.aux;
#pragma unroll
        for (int ai = 0; ai < 2; ++ai) {
            u32x4 g4[4][2], o4[4][2];
#pragma unroll
            for (int m = 0; m < 4; ++m) { const size_t r = (size_t)(row0 + ai * HALF + m * 16); const bf16_t* gp = G + r * NGATE + br * 1024 + col0; const bf16_t* rowp = O + r * DM + col0;
#pragma unroll
                for (int bj = 0; bj < 2; ++bj) { g4[m][bj] = *(const u32x4*)(gp + bj * HALF); if (br != 0) o4[m][bj] = *(const u32x4*)(rowp + bj * HALF); } }
#pragma unroll
            for (int m = 0; m < 4; ++m) { bf16_t* rowp = O + (size_t)(row0 + ai * HALF + m * 16) * DM + col0;
#pragma unroll
                for (int bj = 0; bj < 2; ++bj) { const f32x4 v0 = acc[ai][bj][m][0], v1 = acc[ai][bj][m][1]; const u32x4 gg = g4[m][bj];
                    float w[8] = {__uint_as_float(gg.x << 16) * v0.x, __uint_as_float(gg.x & 0xffff0000u) * v0.y, __uint_as_float(gg.y << 16) * v0.z, __uint_as_float(gg.y & 0xffff0000u) * v0.w,
                                  __uint_as_float(gg.z << 16) * v1.x, __uint_as_float(gg.z & 0xffff0000u) * v1.y, __uint_as_float(gg.w << 16) * v1.z, __uint_as_float(gg.w & 0xffff0000u) * v1.w};
                    if (br != 0) { const u32x4 oo = o4[m][bj];
                        w[0] += __uint_as_float(oo.x << 16); w[1] += __uint_as_float(oo.x & 0xffff0000u); w[2] += __uint_as_float(oo.y << 16); w[3] += __uint_as_float(oo.y & 0xffff0000u);
                        w[4] += __uint_as_float(oo.z << 16); w[5] += __uint_as_float(oo.z & 0xffff0000u); w[6] += __uint_as_float(oo.w << 16); w[7] += __uint_as_float(oo.w & 0xffff0000u); }
                    u32x4 o; o.x = pk2(w[0], w[1]); o.y = pk2(w[2], w[3]); o.z = pk2(w[4], w[5]); o.w = pk2(w[6], w[7]); *(u32x4*)(rowp + bj * HALF) = o; } }
            asm volatile("" ::: "memory");
        }
    }
};
struct EpiWout { const float *xlat, *xctx; float *olat, *octx; const float* modl;
    __device__ __forceinline__ void operator()(const f32x4 (&acc)[2][2][4][2], const Unit& u, int wr, int wc, int fr, int fq) const {
        PG_ROWCOL; const bool lat = u.pm < NTOK / 256; const int rb = lat ? (u.pm >> 4) : 4;
        const float* xin = lat ? xlat : xctx - (size_t)NTOK * DM; float* xo = lat ? olat : octx - (size_t)NTOK * DM; const float* m2 = modl + (size_t)rb * 6144 + 2 * 1024 + col0;
        f32x4 mv[2][2];
#pragma unroll
        for (int bj = 0; bj < 2; ++bj)
#pragma unroll
            for (int n = 0; n < 2; ++n) mv[bj][n] = *(const f32x4*)(m2 + bj * HALF + n * 16);
#pragma unroll
        for (int aq = 0; aq < 4; ++aq) { const int ai = aq >> 1, m0 = (aq & 1) * 2;
            f32x4 xv[4][2][2];
#pragma unroll
            for (int m = m0; m < m0 + 2; ++m) { const size_t o = (size_t)(row0 + ai * HALF + m * 16) * DM + col0;
#pragma unroll
                for (int bj = 0; bj < 2; ++bj)
#pragma unroll
                    for (int n = 0; n < 2; ++n) xv[m][bj][n] = *(const f32x4*)(xin + o + bj * HALF + n * 16); }
#pragma unroll
            for (int m = m0; m < m0 + 2; ++m) { const size_t o = (size_t)(row0 + ai * HALF + m * 16) * DM + col0;
#pragma unroll
                for (int bj = 0; bj < 2; ++bj)
#pragma unroll
                    for (int n = 0; n < 2; ++n) *(f32x4*)(xo + o + bj * HALF + n * 16) = ALPHA * xv[m][bj][n] + mv[bj][n] * acc[ai][bj][m][n]; }
            asm volatile("" ::: "memory");
        }
    }
};
struct EpiMoe1 { bf16_t* HID; const float* roww;
    __device__ __forceinline__ void operator()(const f32x4 (&acc)[2][2][4][2], const Unit& u, int wr, int wc, int fr, int fq) const {
        const int row0 = u.pm * BM + wr * 64 + fr, hc0 = u.pn * 128 + wc * 32 + 8 * fq;
#pragma unroll
        for (int ai = 0; ai < 2; ++ai)
#pragma unroll
            for (int m = 0; m < 4; ++m) { const int r = row0 + ai * HALF + m * 16; const float w = roww[r];
                const f32x4 g0 = acc[ai][0][m][0], g1 = acc[ai][0][m][1], u0 = acc[ai][1][m][0], u1 = acc[ai][1][m][1]; u32x4 o;
                o.x = pk2(siluf_(g0.x) * u0.x * w, siluf_(g0.y) * u0.y * w); o.y = pk2(siluf_(g0.z) * u0.z * w, siluf_(g0.w) * u0.w * w);
                o.z = pk2(siluf_(g1.x) * u1.x * w, siluf_(g1.y) * u1.y * w); o.w = pk2(siluf_(g1.z) * u1.z * w, siluf_(g1.w) * u1.w * w);
                *(u32x4*)(HID + (size_t)r * 256 + hc0) = o; }
    }
};
struct EpiMoe2 { bf16_t* Y; const int* rmap; bf16_t* dump;
    __device__ __forceinline__ void operator()(const f32x4 (&acc)[2][2][4][2], const Unit& u, int wr, int wc, int fr, int fq) const {
        PG_ROWCOL8;
#pragma unroll
        for (int ai = 0; ai < 2; ++ai)
#pragma unroll
            for (int m = 0; m < 4; ++m) { const int s = rmap[row0 + ai * HALF + m * 16];
                bf16_t* rowp = (s >= 0 ? Y + (size_t)s * DM : dump) + col0;
#pragma unroll
                for (int bj = 0; bj < 2; ++bj) { const f32x4 v0 = acc[ai][bj][m][0], v1 = acc[ai][bj][m][1]; u32x4 o; o.x = pk2(v0.x, v0.y); o.y = pk2(v0.z, v0.w); o.z = pk2(v1.x, v1.y); o.w = pk2(v1.z, v1.w); *(u32x4*)(rowp + bj * HALF) = o; } }
    }
};
#undef PG_ROWCOL8
#undef PG_ROWCOL
}

__device__ __forceinline__ void moe_offsets(Frame& F, int l, int* off) {
    if (F.tid < 64) {
        int v = (F.tid < 32) ? (((int)F.cnt()[l * 32 + F.tid] + 255) & ~255) : 0;
#pragma unroll
        for (int o = 1; o < 32; o <<= 1) { const int t = __shfl_up(v, o); if ((F.tid & 63) >= o) v += t; }
        if (F.tid < 32) off[F.tid + 1] = v;
        if (F.tid == 0) off[0] = 0;
    }
    __syncthreads();
}

__device__ __forceinline__ void phase_rope(Frame& F) {
    float* tab = F.smf;
    for (int e = F.tid; e < 1024; e += NTHR) { const int pp = e >> 4, i = e & 15; const float inv = powf(10000.f, -(float)i / 16.f), ang = (float)pp * inv; tab[2 * e] = cosf(ang); tab[2 * e + 1] = sinf(ang); }
    __syncthreads();
    const size_t total = (size_t)NTOK * 320;
    for (size_t idx = (size_t)F.bid * NTHR + F.tid; idx < total; idx += (size_t)F.nb * NTHR) {
        const int row = (int)(idx / 320), r = (int)(idx % 320), h = r >> 5, half = (r >> 4) & 1, i = r & 15;
        const int pos = row & (SEQ - 1), pp = half ? (pos & 63) : (pos >> 6);
        const float cs = tab[2 * (pp * 16 + i)], sn = tab[2 * (pp * 16 + i) + 1];
        bf16_t* base = F.P1() + (size_t)row * NP1 + (h < 8 ? PC_CQ + h * 64 : PC_CK + (h - 8) * 64) + half * 32 + i;
        const float u1 = bf2f(base[0]), u2 = bf2f(base[16]);
        base[0] = f2bf(u1 * cs - u2 * sn); base[16] = f2bf(u1 * sn + u2 * cs);
    }
}

__device__ __forceinline__ int seq_row(int s, int b, int z) {
    if (s < LC) { const int tc = z ? (LC - 1 - s) : s; return NTOK + b * LC + tc; }
    const int tl = s - LC, t = z ? (SEQ - 1 - tl) : tl; return b * SEQ + t;
}
typedef short bf16x8_t __attribute__((ext_vector_type(8)));
typedef short bf16x4_t __attribute__((ext_vector_type(4)));
struct MaskNone { __device__ __forceinline__ void operator()(f32x4&, f32x4&) const {} };
struct MaskNA { int u0; const float* brow;
    __device__ __forceinline__ void operator()(f32x4& s0, f32x4& s1) const {
        float v[8] = {s0.x, s0.y, s0.z, s0.w, s1.x, s1.y, s1.z, s1.w};
#pragma unroll
        for (int T = 0; T < 2; ++T)
#pragma unroll
            for (int rr = 0; rr < 4; ++rr) v[T * 4 + rr] = ((unsigned)(u0 + 16 * T + rr) < 16u) ? v[T * 4 + rr] + brow[16 * T + rr] : -INFINITY;
        s0 = (f32x4){v[0], v[1], v[2], v[3]}; s1 = (f32x4){v[4], v[5], v[6], v[7]};
    }
};
struct MaskWA { int i, j0;
    __device__ __forceinline__ void operator()(f32x4& s0, f32x4& s1) const {
        float v[8] = {s0.x, s0.y, s0.z, s0.w, s1.x, s1.y, s1.z, s1.w};
#pragma unroll
        for (int T = 0; T < 2; ++T)
#pragma unroll
            for (int rr = 0; rr < 4; ++rr) { const int j = j0 + 16 * T + rr; const bool ok = (j >= 0) && (j < SEQ) && (i - j <= 128) && (j - i <= 128);
                v[T * 4 + rr] = ok ? v[T * 4 + rr] : -INFINITY; }
        s0 = (f32x4){v[0], v[1], v[2], v[3]}; s1 = (f32x4){v[4], v[5], v[6], v[7]};
    }
};
struct KVF { bf16x8_t k[4]; bf16x4_t v[4][2]; };
__device__ __forceinline__ void kv_load(KVF& f, const char* kbase, unsigned ko0, unsigned ko1, const char* vbase, unsigned vo0, unsigned vo1) {
    f.k[0] = *(const bf16x8_t*)(kbase + ko0); f.k[1] = *(const bf16x8_t*)(kbase + ko0 + 64); f.k[2] = *(const bf16x8_t*)(kbase + ko1); f.k[3] = *(const bf16x8_t*)(kbase + ko1 + 64);
#pragma unroll
    for (int t = 0; t < 4; ++t) { f.v[t][0] = *(const bf16x4_t*)(vbase + vo0 + (unsigned)t * 16u * NROW * 2u); f.v[t][1] = *(const bf16x4_t*)(vbase + vo1 + (unsigned)t * 16u * NROW * 2u); }
}
__device__ __forceinline__ float xmax_g(float x) {
    auto r = __builtin_amdgcn_permlane16_swap(__float_as_uint(x), __float_as_uint(x), false, false); x = fmaxf(__uint_as_float(r[0]), __uint_as_float(r[1]));
    auto q = __builtin_amdgcn_permlane32_swap(__float_as_uint(x), __float_as_uint(x), false, false); return fmaxf(__uint_as_float(q[0]), __uint_as_float(q[1])); }
__device__ __forceinline__ float xsum_g(float x) {
    auto r = __builtin_amdgcn_permlane16_swap(__float_as_uint(x), __float_as_uint(x), false, false); x = __uint_as_float(r[0]) + __uint_as_float(r[1]);
    auto q = __builtin_amdgcn_permlane32_swap(__float_as_uint(x), __float_as_uint(x), false, false); return __uint_as_float(q[0]) + __uint_as_float(q[1]); }
template <class MaskF>
__device__ __forceinline__ void attn_tile(float& am, float& al, f32x4 (&ao)[4], const bf16x8_t (&qb)[2], const KVF& f, const MaskF& maskf) {
    f32x4 s0 = {0.f, 0.f, 0.f, 0.f}, s1 = {0.f, 0.f, 0.f, 0.f};
    s0 = __builtin_amdgcn_mfma_f32_16x16x32_bf16(f.k[0], qb[0], s0, 0, 0, 0); s0 = __builtin_amdgcn_mfma_f32_16x16x32_bf16(f.k[1], qb[1], s0, 0, 0, 0);
    s1 = __builtin_amdgcn_mfma_f32_16x16x32_bf16(f.k[2], qb[0], s1, 0, 0, 0); s1 = __builtin_amdgcn_mfma_f32_16x16x32_bf16(f.k[3], qb[1], s1, 0, 0, 0);
    maskf(s0, s1);
    const float mx = xmax_g(fmaxf(fmaxf(fmaxf(s0.x, s0.y), fmaxf(s0.z, s0.w)), fmaxf(fmaxf(s1.x, s1.y), fmaxf(s1.z, s1.w))));
    const float mn = fmaxf(am, mx);
    if (__any(mn != am)) {
        const float alpha = __builtin_amdgcn_exp2f(am - mn); am = mn; al *= alpha;
#pragma unroll
        for (int t = 0; t < 4; ++t) ao[t] = ao[t] * alpha;
    }
    f32x4 p0, p1;
    p0.x = __builtin_amdgcn_exp2f(s0.x - am); p0.y = __builtin_amdgcn_exp2f(s0.y - am); p0.z = __builtin_amdgcn_exp2f(s0.z - am); p0.w = __builtin_amdgcn_exp2f(s0.w - am);
    p1.x = __builtin_amdgcn_exp2f(s1.x - am); p1.y = __builtin_amdgcn_exp2f(s1.y - am); p1.z = __builtin_amdgcn_exp2f(s1.z - am); p1.w = __builtin_amdgcn_exp2f(s1.w - am);
    al += ((p0.x + p0.y) + (p0.z + p0.w)) + ((p1.x + p1.y) + (p1.z + p1.w));
    union { bf16x8_t v; unsigned u[4]; } pb;
    pb.u[0] = pk2(p0.x, p0.y); pb.u[1] = pk2(p0.z, p0.w); pb.u[2] = pk2(p1.x, p1.y); pb.u[3] = pk2(p1.z, p1.w);
#pragma unroll
    for (int t = 0; t < 4; ++t) {
        union { bf16x8_t v; bf16x4_t h[2]; } av; av.h[0] = f.v[t][0]; av.h[1] = f.v[t][1];
        ao[t] = __builtin_amdgcn_mfma_f32_16x16x32_bf16(av.v, pb.v, ao[t], 0, 0, 0);
    }
}
template <int kind>
__device__ __forceinline__ void attn_multi(Frame& F, int l, int item, const float* rpb_s) {
    constexpr int NQ = 2;
    constexpr int NLOC = (kind == 0) ? 9 : (kind == 1 ? 9 : 0), NS = 8 + NLOC;
    const int lane = F.lane, n = lane & 15, g = lane >> 4;
    const bf16_t* P1 = F.P1(); const bf16_t* VT = F.VT();
    int b, h0, kvh = 0, kcol, vrow, r = 0, cb = 0, t0 = 0, qrow0, qcol0, brcol0;
    constexpr int QRS = (kind == 0) ? 64 : (kind == 2 ? 16 : 0), QCS = (kind == 1 || kind == 3) ? 64 : 0;
    if (kind == 0) { cb = item & 3; r = ((item >> 2) & 31) * 2; h0 = (item >> 7) & 7; b = item >> 10; kcol = PC_BK + h0 * 64; vrow = h0 * 64; qrow0 = b * SEQ + r * 64 + cb * 16; qcol0 = PC_BQ + h0 * 64; brcol0 = 512 + h0 * 64; }
    else if (kind == 1) { const int hp = item & 1, qt = (item >> 1) & 255; kvh = (item >> 9) & 1; b = item >> 10; h0 = kvh * 4 + hp * 2; t0 = qt * 16; kcol = PC_CK + kvh * 64; vrow = 512 + kvh * 64; qrow0 = b * SEQ + t0; qcol0 = PC_CQ + h0 * 64; brcol0 = 1024 + h0 * 64; }
    else if (kind == 2) { const int qp = item & 7; h0 = (item >> 3) & 7; b = item >> 6; kcol = PC_BK + h0 * 64; vrow = h0 * 64; qrow0 = NTOK + b * LC + qp * 32; qcol0 = PC_BQ + h0 * 64; brcol0 = 512 + h0 * 64; }
    else { const int hp = item & 1, qt = (item >> 1) & 15; kvh = (item >> 5) & 1; b = item >> 6; h0 = kvh * 4 + hp * 2; kcol = PC_CK + kvh * 64; vrow = 512 + kvh * 64; qrow0 = NTOK + b * LC + qt * 16; qcol0 = PC_CQ + h0 * 64; brcol0 = 1024 + h0 * 64; }
    bf16x8_t qb[NQ][2]; float am[NQ], al[NQ]; f32x4 ao[NQ][4];
    { const char* qbase = (const char*)P1; const unsigned qo = (unsigned)(qrow0 + n) * (unsigned)(NP1 * 2) + (unsigned)(qcol0 + 8 * g) * 2u;
#pragma unroll
      for (int q = 0; q < NQ; ++q) { const unsigned o = qo + (unsigned)q * (unsigned)(QRS * NP1 * 2 + QCS * 2); qb[q][0] = *(const bf16x8_t*)(qbase + o); qb[q][1] = *(const bf16x8_t*)(qbase + o + 64);
        am[q] = -1e30f; al[q] = 0.f;
#pragma unroll
        for (int t = 0; t < 4; ++t) ao[q][t] = (f32x4){0.f, 0.f, 0.f, 0.f}; } }
    const int crow0 = NTOK + b * LC;
    const int w0 = (cb == 0) ? 0 : (cb == 1 ? 8 : (cb == 2 ? 24 : 32)), ru = min(max(r - 4, 0), 56);
    const char* kbase = (const char*)P1; const char* vbase = (const char*)VT;
    const unsigned kl = (unsigned)(kcol + 8 * g) * 2u, vl = (unsigned)(vrow + n) * (unsigned)NROW * 2u;
    auto load_step = [&](KVF& f, int s) {
        if (s < 8) { const unsigned ko = (unsigned)(crow0 + 32 * s + n) * (unsigned)(NP1 * 2) + kl, vo = vl + (unsigned)(crow0 + 32 * s + 4 * g) * 2u;
            kv_load(f, kbase, ko, ko + 16u * NP1 * 2u, vbase, vo, vo + 32u); }
        else if (kind == 0) { const int tok0 = b * SEQ + min(ru + (s - 8), 63) * 64 + w0; const unsigned ko = (unsigned)(tok0 + n) * (unsigned)(NP1 * 2) + kl, vo = vl + (unsigned)(tok0 + 4 * g) * 2u;
            kv_load(f, kbase, ko, ko + 16u * NP1 * 2u, vbase, vo, vo + 32u); }
        else if (kind == 1) { const int kb = t0 - 128 + 32 * (s - 8);
            const int ja = min(max(kb + n, 0), SEQ - 1), jb = min(max(kb + 16 + n, 0), SEQ - 1), va = min(max(kb + 4 * g, 0), SEQ - 4), vb = min(max(kb + 16 + 4 * g, 0), SEQ - 4);
            kv_load(f, kbase, (unsigned)(b * SEQ + ja) * (unsigned)(NP1 * 2) + kl, (unsigned)(b * SEQ + jb) * (unsigned)(NP1 * 2) + kl, vbase, vl + (unsigned)(b * SEQ + va) * 2u, vl + (unsigned)(b * SEQ + vb) * 2u); }
    };
    auto compute_step = [&](const KVF& f, int s) {
        if (s < 8) {
#pragma unroll
            for (int q = 0; q < NQ; ++q) { attn_tile(am[q], al[q], ao[q], qb[q], f, MaskNone()); if (NQ == 4) __builtin_amdgcn_sched_barrier(0); }
        } else if (kind == 0) {
            const int kr = ru + (s - 8);
#pragma unroll
            for (int q = 0; q < NQ; ++q) { const int rq = r + q, rsq = min(max(rq - 4, 0), 56);
                if (kr >= rsq && kr <= rsq + 7) { const int c = cb * 16 + n, csq = min(max(c - 8, 0), 48), kc0 = w0 + 4 * g;
                    MaskNA mk{kc0 - csq, rpb_s + (h0 * 15 + (kr - rq + 7)) * 64 + (kc0 - c + 15 + 16)}; attn_tile(am[q], al[q], ao[q], qb[q], f, mk); } }
        } else if (kind == 1) {
            const int ls = s - 8, kb = t0 - 128 + 32 * ls;
            if (ls >= 1 && ls <= 7 && kb >= 0 && kb + 31 < SEQ) {
#pragma unroll
                for (int q = 0; q < NQ; ++q) attn_tile(am[q], al[q], ao[q], qb[q], f, MaskNone());
            } else {
                MaskWA mk{t0 + n, kb + 4 * g};
#pragma unroll
                for (int q = 0; q < NQ; ++q) attn_tile(am[q], al[q], ao[q], qb[q], f, mk);
            }
        }
    };
    if (NQ == 2) {
        KVF fa, fb;
        load_step(fa, 0);
#pragma unroll 1
        for (int s = 0; s < NS; s += 2) {
            if (s + 1 < NS) load_step(fb, s + 1);
            compute_step(fa, s);
            if (s + 1 < NS) { if (s + 2 < NS) load_step(fa, s + 2); compute_step(fb, s + 1); }
        }
    } else {
        KVF fa;
#pragma unroll 1
        for (int s = 0; s < NS; ++s) { load_step(fa, s); compute_step(fa, s); }
    }
#pragma unroll
    for (int q = 0; q < NQ; ++q) {
        float lt = xsum_g(al[q]);
        float osc = 1.f;
        if (kind == 1 || kind == 3) { const float sk = F.p.wa_sink[l * 8 + h0 + q] * 1.44269504089f, mf = fmaxf(am[q], sk); osc = __builtin_amdgcn_exp2f(am[q] - mf); lt = lt * osc + __builtin_amdgcn_exp2f(sk - mf); }
        const float inv = osc / lt;
        char* obase = (char*)F.BR(); const unsigned oo = (unsigned)(qrow0 + q * QRS + n) * 4096u + (unsigned)(brcol0 + q * QCS + 4 * g) * 2u;
#pragma unroll
        for (int t = 0; t < 4; ++t) { const f32x4 v = ao[q][t] * inv; u32x2 o2; o2.x = pk2(v.x, v.y); o2.y = pk2(v.z, v.w); *(u32x2*)(obase + oo + 32u * t) = o2; }
    }
}

template <int DK, bool HG>
__device__ __forceinline__ void scan_mfma(Frame& F, int l, int b, int h, int z, unsigned char* lds) {
    constexpr int NDP = DK / 2, NTG = NTHR / NDP, TPT = 64 / NTG, QS = DK + 8, TS = 72, NDT = DK / 16;
    bf16_t* QD = (bf16_t*)lds; bf16_t* KD = QD + 64 * QS; bf16_t* KDT = KD + 64 * QS; bf16_t* VTs = KDT + DK * TS; bf16_t* AM = VTs + 128 * TS; bf16_t* ST = AM + 64 * TS;
    float* TOT = (float*)(ST + 128 * QS); float* E1s = TOT + NTG * DK; float* E2s = E1s + DK;
    REFRESH(F);
    const int tid = F.tid, lane = F.lane, w = F.wave, n = lane & 15, g = lane >> 4;
    const int dp = tid % NDP, tg = tid / NDP, vp = tid & 63, vg = tid >> 6;
    const bf16_t* P1 = F.P1();
    float lw[HG ? 2 : 32], lbias[2] = {0.f, 0.f}, lbv[2] = {0.f, 0.f};
    if (!HG) {
#pragma unroll
        for (int r = 0; r < 16; ++r) { const float* wp = F.p.gla_lr_w + ((size_t)(l * 2 + z) * 16 + r) * 256 + h * 64 + 2 * dp; lw[2 * r] = wp[0]; lw[2 * r + 1] = wp[1]; }
        lbias[0] = F.p.gla_lr_b[(l * 2 + z) * 256 + h * 64 + 2 * dp]; lbias[1] = F.p.gla_lr_b[(l * 2 + z) * 256 + h * 64 + 2 * dp + 1];
    } else { lw[0] = lw[1] = 0.f; if (l != 0) { lbv[0] = F.lb()[z * 512 + h * 128 + 2 * dp]; lbv[1] = F.lb()[z * 512 + h * 128 + 2 * dp + 1]; } }
    f32x4 accS[NDT];
#pragma unroll
    for (int i = 0; i < NDT; ++i) accS[i] = (f32x4){0.f, 0.f, 0.f, 0.f};
    unsigned rq[TPT], rk[TPT], rv[8]; u32x4 rl[HG ? 1 : TPT][2];
    const int qcol = HG ? PC_DQ + h * 128 + 2 * dp : PC_AQ + h * 64 + 2 * dp, kcol = HG ? PC_DF + z * 512 + h * 128 + 2 * dp : PC_AK + h * 64 + 2 * dp;
    const int vcol = (HG ? PC_DI : PC_AV) + h * 128 + 2 * vp;
    const char* p1b = (const char*)P1; const int sgn = z ? -1 : 1; const int rstep = sgn * NP1 * 2;
#define SCAN_LOAD(c) do { const int row0_ = seq_row((c) * 64, b, z); \
        int o_ = (row0_ + sgn * tg * TPT) * (NP1 * 2); \
        _Pragma("unroll") for (int tt = 0; tt < TPT; ++tt) { rq[tt] = *(const unsigned*)(p1b + (unsigned)(o_ + qcol * 2)); rk[tt] = *(const unsigned*)(p1b + (unsigned)(o_ + kcol * 2)); \
            if (!HG) { rl[tt][0] = *(const u32x4*)(p1b + (unsigned)(o_ + (PC_ALR + z * 16) * 2)); rl[tt][1] = *(const u32x4*)(p1b + (unsigned)(o_ + (PC_ALR + z * 16 + 8) * 2)); } o_ += rstep; } \
        int ov_ = (row0_ + sgn * vg * 8) * (NP1 * 2) + vcol * 2; \
        _Pragma("unroll") for (int tt = 0; tt < 8; ++tt) { rv[tt] = *(const unsigned*)(p1b + (unsigned)ov_); ov_ += rstep; } } while (0)
    SCAN_LOAD(0);
    constexpr int NCH = (LC + SEQ) / 64;
#pragma unroll 1
    for (int c = 0; c < NCH; ++c) {
        float qv[TPT][2], kv[TPT][2], cs[TPT][2];
#pragma unroll
        for (int tt = 0; tt < TPT; ++tt)
#pragma unroll
            for (int e = 0; e < 2; ++e) {
                const float qr = __uint_as_float(e ? (rq[tt] & 0xffff0000u) : (rq[tt] << 16)), kr = __uint_as_float(e ? (rk[tt] & 0xffff0000u) : (rk[tt] << 16));
                float gg;
                if (HG) {
                    gg = kr;
                    kv[tt][e] = 1.f - __expf(kr);
                    qv[tt][e] = qr;
                } else {
                    float lg = lbias[e];
                    const unsigned lr8[8] = {rl[tt][0].x, rl[tt][0].y, rl[tt][0].z, rl[tt][0].w, rl[tt][1].x, rl[tt][1].y, rl[tt][1].z, rl[tt][1].w};
#pragma unroll
                    for (int r2 = 0; r2 < 8; ++r2) { lg += __uint_as_float(lr8[r2] << 16) * lw[(2 * r2) * 2 + e]; lg += __uint_as_float(lr8[r2] & 0xffff0000u) * lw[(2 * r2 + 1) * 2 + e]; }
                    const float t = __expf(-fabsf(lg)), r = __builtin_amdgcn_rcpf(1.f + t);
                    gg = (fminf(lg, 0.f) + __logf(r)) * (1.f / 16.f);
                    kv[tt][e] = kr; qv[tt][e] = qr;
                }
                cs[tt][e] = gg + (tt ? cs[tt ? tt - 1 : 0][e] : 0.f);
            }
        TOT[tg * DK + 2 * dp] = cs[TPT - 1][0]; TOT[tg * DK + 2 * dp + 1] = cs[TPT - 1][1];
        __syncthreads();
        float offs[2] = {0.f, 0.f}, mid[2] = {0.f, 0.f}, lastv[2] = {0.f, 0.f};
#pragma unroll
        for (int t2 = 0; t2 < NTG; ++t2)
#pragma unroll
            for (int e = 0; e < 2; ++e) { const float tv = TOT[t2 * DK + 2 * dp + e]; if (t2 < tg) offs[e] += tv; if (t2 < NTG / 2) mid[e] += tv; lastv[e] += tv; }
        unsigned kdt[2][TPT / 2]; float kprev[2] = {0.f, 0.f};
#pragma unroll
        for (int tt = 0; tt < TPT; ++tt) {
            float qd[2], kd[2];
#pragma unroll
            for (int e = 0; e < 2; ++e) { const float x = fminf(fmaxf(cs[tt][e] + offs[e] - mid[e], -80.f), 80.f); qd[e] = qv[tt][e] * __expf(x); kd[e] = kv[tt][e] * __expf(-x); }
            const int tok = tg * TPT + tt;
            *(unsigned*)(QD + tok * QS + 2 * dp) = pk2(qd[0], qd[1]); *(unsigned*)(KD + tok * QS + 2 * dp) = pk2(kd[0], kd[1]);
            if (tt & 1) { kdt[0][tt >> 1] = pk2(kprev[0], kd[0]); kdt[1][tt >> 1] = pk2(kprev[1], kd[1]); } else { kprev[0] = kd[0]; kprev[1] = kd[1]; }
        }
#pragma unroll
        for (int e = 0; e < 2; ++e) {
            bf16_t* dst = KDT + (2 * dp + e) * TS + tg * TPT;
            if (TPT == 8) { u32x4 o; o.x = kdt[e][0]; o.y = kdt[e][1]; o.z = kdt[e][TPT / 2 - 2]; o.w = kdt[e][TPT / 2 - 1]; *(u32x4*)dst = o; }
            else { u32x2 o; o.x = kdt[e][0]; o.y = kdt[e][1]; *(u32x2*)dst = o; }
        }
        if (tg == 0) { E1s[2 * dp] = __expf(mid[0]); E1s[2 * dp + 1] = __expf(mid[1]); E2s[2 * dp] = __expf(lastv[0] - mid[0]); E2s[2 * dp + 1] = __expf(lastv[1] - mid[1]); }
        {   u32x4 o0, o1;
            o0.x = (rv[0] & 0xffffu) | (rv[1] << 16); o0.y = (rv[2] & 0xffffu) | (rv[3] << 16); o0.z = (rv[4] & 0xffffu) | (rv[5] << 16); o0.w = (rv[6] & 0xffffu) | (rv[7] << 16);
            o1.x = (rv[0] >> 16) | (rv[1] & 0xffff0000u); o1.y = (rv[2] >> 16) | (rv[3] & 0xffff0000u); o1.z = (rv[4] >> 16) | (rv[5] & 0xffff0000u); o1.w = (rv[6] >> 16) | (rv[7] & 0xffff0000u);
            *(u32x4*)(VTs + (2 * vp) * TS + vg * 8) = o0; *(u32x4*)(VTs + (2 * vp + 1) * TS + vg * 8) = o1; }
        if (c + 1 < NCH) SCAN_LOAD(c + 1);
        __syncthreads();
#pragma unroll
        for (int dt = 0; dt < NDT; ++dt) { accS[dt] = accS[dt] * *(const f32x4*)&E1s[16 * dt + 4 * g];
            u32x2 o; o.x = pk2(accS[dt].x, accS[dt].y); o.y = pk2(accS[dt].z, accS[dt].w); *(u32x2*)(ST + (16 * w + n) * QS + 16 * dt + 4 * g) = o; }
        {   const int it = w >> 1, jt0 = 2 * (w & 1);
            f32x4 d0 = {0.f, 0.f, 0.f, 0.f}, d1 = {0.f, 0.f, 0.f, 0.f};
            if (jt0 <= it) {
                bf16x8_t qf[DK / 32], k0f[DK / 32], k1f[DK / 32];
#pragma unroll
                for (int ks = 0; ks < DK / 32; ++ks) { qf[ks] = *(const bf16x8_t*)(QD + (16 * it + n) * QS + 32 * ks + 8 * g); k0f[ks] = *(const bf16x8_t*)(KD + (16 * jt0 + n) * QS + 32 * ks + 8 * g); k1f[ks] = *(const bf16x8_t*)(KD + (16 * (jt0 + 1) + n) * QS + 32 * ks + 8 * g); }
#pragma unroll
                for (int ks = 0; ks < DK / 32; ++ks) { d0 = __builtin_amdgcn_mfma_f32_16x16x32_bf16(k0f[ks], qf[ks], d0, 0, 0, 0); d1 = __builtin_amdgcn_mfma_f32_16x16x32_bf16(k1f[ks], qf[ks], d1, 0, 0, 0); }
                const int i = 16 * it + n, j0 = 16 * jt0 + 4 * g, j1 = j0 + 16;
                d0.x = (j0 + 0 <= i) ? d0.x : 0.f; d0.y = (j0 + 1 <= i) ? d0.y : 0.f; d0.z = (j0 + 2 <= i) ? d0.z : 0.f; d0.w = (j0 + 3 <= i) ? d0.w : 0.f;
                d1.x = (j1 + 0 <= i) ? d1.x : 0.f; d1.y = (j1 + 1 <= i) ? d1.y : 0.f; d1.z = (j1 + 2 <= i) ? d1.z : 0.f; d1.w = (j1 + 3 <= i) ? d1.w : 0.f;
            }
            u32x2 o; o.x = pk2(d0.x, d0.y); o.y = pk2(d0.z, d0.w); *(u32x2*)(AM + (16 * it + n) * TS + 16 * jt0 + 4 * g) = o;
            o.x = pk2(d1.x, d1.y); o.y = pk2(d1.z, d1.w); *(u32x2*)(AM + (16 * it + n) * TS + 16 * (jt0 + 1) + 4 * g) = o;
        }
        __syncthreads();
        {   f32x4 o[4];
#pragma unroll
            for (int it = 0; it < 4; ++it) o[it] = (f32x4){0.f, 0.f, 0.f, 0.f};
#pragma unroll
            for (int ks = 0; ks < 2; ++ks) { const bf16x8_t af = *(const bf16x8_t*)(VTs + (16 * w + n) * TS + 32 * ks + 8 * g); bf16x8_t bf[4];
#pragma unroll
                for (int it = 0; it < 4; ++it) bf[it] = *(const bf16x8_t*)(AM + (16 * it + n) * TS + 32 * ks + 8 * g);
#pragma unroll
                for (int it = 0; it < 4; ++it) o[it] = __builtin_amdgcn_mfma_f32_16x16x32_bf16(af, bf[it], o[it], 0, 0, 0); }
#pragma unroll
            for (int ks = 0; ks < DK / 32; ++ks) { const bf16x8_t af = *(const bf16x8_t*)(ST + (16 * w + n) * QS + 32 * ks + 8 * g); bf16x8_t bf[4];
#pragma unroll
                for (int it = 0; it < 4; ++it) bf[it] = *(const bf16x8_t*)(QD + (16 * it + n) * QS + 32 * ks + 8 * g);
#pragma unroll
                for (int it = 0; it < 4; ++it) o[it] = __builtin_amdgcn_mfma_f32_16x16x32_bf16(af, bf[it], o[it], 0, 0, 0); }
            const int row0 = seq_row(c * 64, b, z) + sgn * n;
            char* dstb; unsigned doff; int dstride;
            if (HG) { dstb = (char*)F.P1(); doff = (unsigned)row0 * (unsigned)(NP1 * 2) + (unsigned)(PC_DF + z * 512 + h * 128 + 16 * w + 4 * g) * 2u; dstride = sgn * 16 * NP1 * 2; }
            else if (z == 0) { dstb = (char*)F.BR(); doff = (unsigned)row0 * 4096u + (unsigned)(h * 128 + 16 * w + 4 * g) * 2u; dstride = sgn * 16 * 4096; }
            else { dstb = (char*)F.OBA(); doff = (unsigned)row0 * 1024u + (unsigned)(h * 128 + 16 * w + 4 * g) * 2u; dstride = sgn * 16 * 1024; }
#pragma unroll
            for (int it = 0; it < 4; ++it) { u32x2 o2; o2.x = pk2(o[it].x, o[it].y); o2.y = pk2(o[it].z, o[it].w); *(u32x2*)(dstb + (unsigned)((int)doff + it * dstride)) = o2; }
        }
#pragma unroll
        for (int ks = 0; ks < 2; ++ks) { const bf16x8_t bv = *(const bf16x8_t*)(VTs + (16 * w + n) * TS + 32 * ks + 8 * g); bf16x8_t af[NDT];
#pragma unroll
            for (int dt = 0; dt < NDT; ++dt) af[dt] = *(const bf16x8_t*)(KDT + (16 * dt + n) * TS + 32 * ks + 8 * g);
#pragma unroll
            for (int dt = 0; dt < NDT; ++dt) accS[dt] = __builtin_amdgcn_mfma_f32_16x16x32_bf16(af[dt], bv, accS[dt], 0, 0, 0); }
#pragma unroll
        for (int dt = 0; dt < NDT; ++dt) accS[dt] = accS[dt] * *(const f32x4*)&E2s[16 * dt + 4 * g];
        __syncthreads();
    }
#undef SCAN_LOAD
}

__device__ __forceinline__ void phase_mix(Frame& F, int l) {
    const int n_scan = 64;
    const int nsb = (F.nb > 128) ? 64 : 0;
    if (nsb == 0 || F.bid < nsb) {
        for (int it = F.bid; it < n_scan; it += (nsb ? nsb : F.nb)) {
            const int br = it >> 5, r = it & 31, b = r >> 3, h = (r >> 1) & 3, z = r & 1;
            if (br == 0) scan_mfma<64, false>(F, l, b, h, z, (unsigned char*)F.smf); else scan_mfma<128, true>(F, l, b, h, z, (unsigned char*)F.smf);
        }
        __syncthreads();
    }
    float* rpb_s = F.smf;
    for (int i = F.tid; i < 8 * 15 * 64; i += NTHR) { const int dcp = i & 63, hr = i >> 6; rpb_s[i] = (dcp >= 16 && dcp < 47) ? F.p.na_rpb[(size_t)l * 8 * 465 + hr * 31 + (dcp - 16)] * 1.44269504089f : 0.f; }
    __syncthreads();
    unsigned* qhead = F.cnt() + 64 + l * 16;
    const int n_wa = 4096, n_na = 4096, n_cna = (l == 0) ? 256 : 0, n_cwa = (l == 0) ? 256 : 0, total = n_wa + n_na + n_cna + n_cwa;
    for (;;) {
        int it = 0; if (F.lane == 0) it = (int)atomicAdd(qhead, 1u);
        it = __builtin_amdgcn_readfirstlane(it);
        if (it >= total) break;
        if (it < n_wa) attn_multi<1>(F, l, it, rpb_s);
        else if (it < n_wa + n_na) attn_multi<0>(F, l, it - n_wa, rpb_s);
        else if (it < n_wa + n_na + n_cna) attn_multi<2>(F, l, it - n_wa - n_na, rpb_s);
        else attn_multi<3>(F, l, it - n_wa - n_na - n_cna, rpb_s);
    }
}

__device__ __forceinline__ void phase_prepad(Frame& F, int l) {
    const int gw = F.bid * 8 + F.wave, ngw = F.nb * 8, npairs = ((l == 0) ? NROW : NTOK) / 2, c0 = F.lane * 8;
    for (int pi = gw; pi < npairs; pi += ngw) {
        u32x4 ra[2][2], rb[2][2], rg[2][2];
#pragma unroll
        for (int q = 0; q < 2; ++q) { const size_t row = (size_t)pi * 2 + q;
            ra[q][0] = *(const u32x4*)(F.BR() + row * 2048 + c0); rb[q][0] = *(const u32x4*)(F.OBA() + row * 512 + c0); rg[q][0] = *(const u32x4*)(F.P1() + row * NP1 + PC_AG + c0);
            ra[q][1] = *(const u32x4*)(F.P1() + row * NP1 + PC_DF + c0); rb[q][1] = *(const u32x4*)(F.P1() + row * NP1 + PC_DF + 512 + c0); rg[q][1] = *(const u32x4*)(F.P1() + row * NP1 + PC_DG + c0); }
#pragma unroll
        for (int q = 0; q < 2; ++q)
#pragma unroll
            for (int br = 0; br < 2; ++br) {
                const unsigned ua[4] = {ra[q][br].x, ra[q][br].y, ra[q][br].z, ra[q][br].w}, ub[4] = {rb[q][br].x, rb[q][br].y, rb[q][br].z, rb[q][br].w}, ug[4] = {rg[q][br].x, rg[q][br].y, rg[q][br].z, rg[q][br].w};
                float o[8], g[8]; float ss = 0.f;
#pragma unroll
                for (int j = 0; j < 4; ++j) { o[2 * j] = __uint_as_float(ua[j] << 16) + __uint_as_float(ub[j] << 16); o[2 * j + 1] = __uint_as_float(ua[j] & 0xffff0000u) + __uint_as_float(ub[j] & 0xffff0000u);
                    g[2 * j] = __uint_as_float(ug[j] << 16); g[2 * j + 1] = __uint_as_float(ug[j] & 0xffff0000u); ss += o[2 * j] * o[2 * j] + o[2 * j + 1] * o[2 * j + 1]; }
                ss += __shfl_xor(ss, 1); ss += __shfl_xor(ss, 2); ss += __shfl_xor(ss, 4); ss += __shfl_xor(ss, 8);
                const float rs = rsqrtf(ss * (1.f / 128.f) + 1e-6f);
#pragma unroll
                for (int j = 0; j < 8; ++j) o[j] = o[j] * rs * siluf_(g[j]);
                st8(F.BR() + ((size_t)pi * 2 + q) * 2048 + (br ? 1536 : 0) + c0, o);
            }
    }
}

__device__ __forceinline__ void phase_ln1(Frame& F, int l) {
    const int nrows = (l == 0) ? NROW : NTOK, ngroups = nrows / 64;
    const float* lg = F.p.ln_g + (size_t)(l * 2 + 0) * DM; const float* lbb = F.p.ln_b + (size_t)(l * 2 + 0) * DM;
    float* part = F.smf;
    const int wv = __builtin_amdgcn_readfirstlane(F.wave);
    float* stg = F.smf + 8 * 36 * 64 + wv * (64 * 17 + 16 * 40);
    float* wl = stg + 64 * 17;
    for (int grp = F.bid; grp < ngroups; grp += F.nb) {
        const int row0 = grp * 64, rb = row_batch(row0);
        const float* mv = F.modv() + ((size_t)l * 5 + rb) * 6144;
        float* xg = row0 < NTOK ? F.p.out + (size_t)row0 * DM : F.cxm() + (size_t)(row0 - NTOK) * DM;
#pragma unroll 1
        for (int rr = 0; rr < 8; rr += 2) {
            const int lr = wv * 8 + rr; float* xr = xg + (size_t)lr * DM;
            f32x4 v[2][4]; float s[2] = {0.f, 0.f};
#pragma unroll
            for (int q = 0; q < 2; ++q)
#pragma unroll
                for (int j = 0; j < 4; ++j) v[q][j] = *(const f32x4*)(xr + (size_t)q * DM + j * 256 + F.lane * 4);
#pragma unroll
            for (int q = 0; q < 2; ++q)
#pragma unroll
                for (int j = 0; j < 4; ++j) s[q] += (v[q][j].x + v[q][j].y) + (v[q][j].z + v[q][j].w);
#pragma unroll
            for (int o = 1; o < 64; o <<= 1) { s[0] += __shfl_xor(s[0], o); s[1] += __shfl_xor(s[1], o); }
            float s2[2] = {0.f, 0.f};
#pragma unroll
            for (int q = 0; q < 2; ++q) { const float mean = s[q] * (1.f / DM);
#pragma unroll
                for (int j = 0; j < 4; ++j) { v[q][j] = v[q][j] - mean; s2[q] += (v[q][j].x * v[q][j].x + v[q][j].y * v[q][j].y) + (v[q][j].z * v[q][j].z + v[q][j].w * v[q][j].w); } }
#pragma unroll
            for (int o = 1; o < 64; o <<= 1) { s2[0] += __shfl_xor(s2[0], o); s2[1] += __shfl_xor(s2[1], o); }
#pragma unroll
            for (int j = 0; j < 4; ++j) { const int d = j * 256 + F.lane * 4;
                const f32x4 g4 = *(const f32x4*)(lg + d), b4 = *(const f32x4*)(lbb + d), m3 = *(const f32x4*)(mv + 3 * 1024 + d), m4 = *(const f32x4*)(mv + 4 * 1024 + d);
#pragma unroll
                for (int q = 0; q < 2; ++q) { const float rstd = rsqrtf(s2[q] * (1.f / DM) + LN_EPS);
                    const f32x4 xn = v[q][j] * rstd * g4 + b4;
                    *(f32x4*)(xr + (size_t)q * DM + d) = xn;
                    const f32x4 h2 = xn * (1.f + m4) + m3;
                    u32x2 o2; o2.x = pk2(h2.x, h2.y); o2.y = pk2(h2.z, h2.w);
                    *(u32x2*)(F.HX2() + (size_t)(row0 + lr + q) * DM + d) = o2; } }
        }
        __syncthreads();
        {   float acc[36];
#pragma unroll
            for (int o = 0; o < 36; ++o) acc[o] = 0.f;
            const float* wgp = F.p.moe_w_group + ((size_t)l * DM + wv * 128) * 4; const float* wep = F.p.moe_w_expert + ((size_t)l * DM + wv * 128) * 32;
            const float* m3p = mv + 3 * 1024 + wv * 128; const float* m4p = mv + 4 * 1024 + wv * 128;
#pragma unroll 1
            for (int dc = 0; dc < 128; dc += 16) {
                f32x4 t[4], we0, we1, wg4 = {0.f, 0.f, 0.f, 0.f}; float m3v = 0.f, m4v = 0.f;
#pragma unroll
                for (int i = 0; i < 4; ++i) t[i] = *(const f32x4*)(xg + (size_t)(16 * i + (F.lane >> 2)) * DM + wv * 128 + dc + (F.lane & 3) * 4);
                we0 = *(const f32x4*)(wep + (size_t)dc * 32 + F.lane * 4); we1 = *(const f32x4*)(wep + (size_t)dc * 32 + (F.lane + 64) * 4);
                if (F.lane < 16) { wg4 = *(const f32x4*)(wgp + (size_t)(dc + F.lane) * 4); m3v = m3p[dc + F.lane]; m4v = 1.f + m4p[dc + F.lane]; }
#pragma unroll
                for (int i = 0; i < 4; ++i) { float* sp = stg + (16 * i + (F.lane >> 2)) * 17 + (F.lane & 3) * 4; sp[0] = t[i].x; sp[1] = t[i].y; sp[2] = t[i].z; sp[3] = t[i].w; }
                *(f32x4*)(wl + (F.lane >> 3) * 40 + 4 + (F.lane & 7) * 4) = we0; *(f32x4*)(wl + ((F.lane + 64) >> 3) * 40 + 4 + (F.lane & 7) * 4) = we1;
                if (F.lane < 16) { *(f32x4*)(wl + F.lane * 40) = wg4; wl[F.lane * 40 + 36] = m3v; wl[F.lane * 40 + 37] = m4v; }
                asm volatile("s_waitcnt lgkmcnt(0)" ::: "memory");
#pragma unroll 4
                for (int q = 0; q < 16; ++q) { const float* wq = wl + q * 40; const float hh = stg[F.lane * 17 + q] * wq[37] + wq[36];
#pragma unroll
                    for (int o4 = 0; o4 < 9; ++o4) { const f32x4 w4 = *(const f32x4*)(wq + 4 * o4);
                        acc[4 * o4] += hh * w4.x; acc[4 * o4 + 1] += hh * w4.y; acc[4 * o4 + 2] += hh * w4.z; acc[4 * o4 + 3] += hh * w4.w; } }
                asm volatile("s_waitcnt lgkmcnt(0)" ::: "memory");
            }
#pragma unroll
            for (int o = 0; o < 36; ++o) part[(wv * 36 + o) * 64 + F.lane] = acc[o];
        }
        __syncthreads();
        if (wv == 0) {
            const int row = row0 + F.lane;
            float gl[4]; int gi = 0; float gm = -3.4e38f;
#pragma unroll
            for (int o = 0; o < 4; ++o) { float t = F.p.moe_b_group[l * 4 + o];
#pragma unroll
                for (int w2 = 0; w2 < 8; ++w2) t += part[(w2 * 36 + o) * 64 + F.lane];
                gl[o] = t; if (t > gm) { gm = t; gi = o; } }
            float gs = 0.f;
#pragma unroll
            for (int o = 0; o < 4; ++o) gs += expf(gl[o] - gm);
            const float gwt = 1.f / gs;
            float e1 = -3.4e38f, e2 = -3.4e38f; int i1 = 0, i2 = 0;
#pragma unroll
            for (int o8 = 0; o8 < 8; ++o8) { const int o = gi * 8 + o8; float ev = F.p.moe_b_expert[l * 32 + o];
#pragma unroll
                for (int w2 = 0; w2 < 8; ++w2) ev += part[(w2 * 36 + 4 + o) * 64 + F.lane];
                if (ev > e1) { e2 = e1; i2 = i1; e1 = ev; i1 = o; } else if (ev > e2) { e2 = ev; i2 = o; } }
            const float w1 = 1.f / (1.f + expf(e2 - e1)), w2v = 1.f - w1;
            unsigned* lh = (unsigned*)(stg + 64 * 17 + 16 * 40 - 64);
            if (F.lane < 32) lh[F.lane] = 0u;
            asm volatile("s_waitcnt lgkmcnt(0)" ::: "memory");
            const unsigned r1 = atomicAdd(&lh[i1], 1u), r2 = atomicAdd(&lh[i2], 1u);
            asm volatile("s_waitcnt lgkmcnt(0)" ::: "memory");
            if (F.lane < 32) { const unsigned c = lh[F.lane]; lh[32 + F.lane] = c ? atomicAdd(&F.cnt()[l * 32 + F.lane], c) : 0u; }
            asm volatile("s_waitcnt vmcnt(0) lgkmcnt(0)" ::: "memory");
            const unsigned p1 = lh[32 + i1] + r1, p2 = lh[32 + i2] + r2;
            F.tokE()[row * 2] = i1; F.tokI()[row * 2] = (int)p1; F.tokW()[row * 2] = gwt * w1;
            F.tokE()[row * 2 + 1] = i2; F.tokI()[row * 2 + 1] = (int)p2; F.tokW()[row * 2 + 1] = gwt * w2v;
        }
        __syncthreads();
    }
}

__device__ __forceinline__ void phase_gather(Frame& F, int l) {
    int* off = (int*)F.smf; moe_offsets(F, l, off);
    const int gw = F.bid * 8 + F.wave, ngw = F.nb * 8, nrows = (l == 0) ? NROW : NTOK;
    for (int s0 = gw; s0 < 2 * nrows; s0 += 4 * ngw) {
        int sl[4], e[4], ti[4]; float tw[4]; u32x4 a0[4], a1[4];
#pragma unroll
        for (int q = 0; q < 4; ++q) { sl[q] = min(s0 + q * ngw, 2 * nrows - 1); e[q] = F.tokE()[sl[q]]; ti[q] = F.tokI()[sl[q]]; tw[q] = F.tokW()[sl[q]];
            const u32x4* src = (const u32x4*)(F.HX2() + (size_t)(sl[q] >> 1) * DM); a0[q] = src[F.lane]; a1[q] = src[F.lane + 64]; }
#pragma unroll
        for (int q = 0; q < 4; ++q) if (s0 + q * ngw < 2 * nrows) { const int dst = off[e[q]] + ti[q]; u32x4* d = (u32x4*)(F.XS() + (size_t)dst * DM);
            d[F.lane] = a0[q]; d[F.lane + 64] = a1[q];
            if (F.lane == 0) { F.rmap()[dst] = sl[q]; F.roww()[dst] = tw[q]; } }
    }
    for (int e = 0; e < 32; ++e) {
        const int c = (int)F.cnt()[l * 32 + e], pc = (c + 255) & ~255;
        for (int j = c + gw; j < pc; j += ngw) { const int dst = off[e] + j; u32x4* d = (u32x4*)(F.XS() + (size_t)dst * DM);
            const u32x4 z = {0u, 0u, 0u, 0u}; d[F.lane] = z; d[F.lane + 64] = z;
            if (F.lane == 0) { F.rmap()[dst] = -1; F.roww()[dst] = 0.f; } }
    }
}
__device__ __forceinline__ int expert_of_row(const int* off, int row) { int e = 0;
#pragma unroll 1
    for (int i = 1; i < 32; ++i) if (row >= off[i]) e = i;
    return e; }

__device__ __forceinline__ void phase_ln2(Frame& F, int l) {
    const int gw = F.bid * 8 + F.wave, ngw = F.nb * 8, npairs = ((l == 0) ? NROW : NTOK) / 2;
    const float* lg = F.p.ln_g + (size_t)(l * 2 + 1) * DM; const float* lbb = F.p.ln_b + (size_t)(l * 2 + 1) * DM;
    const bf16_t* Y = F.BR();
    const bool tmo_set = (l == DEPTH - 1) && (__hip_atomic_load((unsigned*)(F.ws + WS_CTL) + XB_TMO, __ATOMIC_RELAXED, __HIP_MEMORY_SCOPE_AGENT) != 0u);
    for (int pi = gw; pi < npairs; pi += ngw) {
        const int row0 = pi * 2, rb = row_batch(row0);
        const float* xm = row0 < NTOK ? F.p.out + (size_t)row0 * DM : F.cxm() + (size_t)(row0 - NTOK) * DM;
        float* xo = row0 < NTOK ? F.p.out + (size_t)row0 * DM : F.cxo() + (size_t)(row0 - NTOK) * DM;
        const float* mv = F.modv() + ((size_t)l * 5 + rb) * 6144;
        u32x2 y0[2][4], y1[2][4]; f32x4 xv[2][4], m5[4];
#pragma unroll
        for (int j = 0; j < 4; ++j) { const int d = j * 256 + F.lane * 4; m5[j] = *(const f32x4*)(mv + 5 * 1024 + d);
#pragma unroll
            for (int q = 0; q < 2; ++q) { y0[q][j] = *(const u32x2*)(Y + (size_t)((row0 + q) * 2) * DM + d); y1[q][j] = *(const u32x2*)(Y + (size_t)((row0 + q) * 2 + 1) * DM + d); xv[q][j] = *(const f32x4*)(xm + (size_t)q * DM + d); } }
        f32x4 v[2][4]; float s[2] = {0.f, 0.f};
#pragma unroll
        for (int q = 0; q < 2; ++q)
#pragma unroll
            for (int j = 0; j < 4; ++j) { f32x4 y; y.x = __uint_as_float(y0[q][j].x << 16) + __uint_as_float(y1[q][j].x << 16); y.y = __uint_as_float(y0[q][j].x & 0xffff0000u) + __uint_as_float(y1[q][j].x & 0xffff0000u);
                y.z = __uint_as_float(y0[q][j].y << 16) + __uint_as_float(y1[q][j].y << 16); y.w = __uint_as_float(y0[q][j].y & 0xffff0000u) + __uint_as_float(y1[q][j].y & 0xffff0000u);
                v[q][j] = ALPHA * xv[q][j] + m5[j] * y; s[q] += (v[q][j].x + v[q][j].y) + (v[q][j].z + v[q][j].w); }
#pragma unroll
        for (int o = 1; o < 64; o <<= 1) { s[0] += __shfl_xor(s[0], o); s[1] += __shfl_xor(s[1], o); }
        float s2[2] = {0.f, 0.f};
#pragma unroll
        for (int q = 0; q < 2; ++q) { const float mean = s[q] * (1.f / DM);
#pragma unroll
            for (int j = 0; j < 4; ++j) { v[q][j] = v[q][j] - mean; s2[q] += (v[q][j].x * v[q][j].x + v[q][j].y * v[q][j].y) + (v[q][j].z * v[q][j].z + v[q][j].w * v[q][j].w); } }
#pragma unroll
        for (int o = 1; o < 64; o <<= 1) { s2[0] += __shfl_xor(s2[0], o); s2[1] += __shfl_xor(s2[1], o); }
        const float* mn = F.modv() + ((size_t)((l + 1 < DEPTH) ? l + 1 : l) * 5 + rb) * 6144;
#pragma unroll
        for (int j = 0; j < 4; ++j) { const int d = j * 256 + F.lane * 4;
            const f32x4 g4 = *(const f32x4*)(lg + d), b4 = *(const f32x4*)(lbb + d), m0 = *(const f32x4*)(mn + d), m1 = *(const f32x4*)(mn + 1024 + d);
#pragma unroll
            for (int q = 0; q < 2; ++q) { const float rstd = rsqrtf(s2[q] * (1.f / DM) + LN_EPS);
                f32x4 xn = v[q][j] * rstd * g4 + b4;
                if (tmo_set) xn = xn * __uint_as_float(0x7fc00000u);
                *(f32x4*)(xo + (size_t)q * DM + d) = xn;
                if (l + 1 < DEPTH) { const f32x4 h = xn * (1.f + m1) + m0; u32x2 o2; o2.x = pk2(h.x, h.y); o2.y = pk2(h.z, h.w); *(u32x2*)(F.HX() + (size_t)(row0 + q) * DM + d) = o2; } }
        }
    }
}

constexpr int NPL = 12, NPH = 1 + DEPTH * NPL;
__global__ void __launch_bounds__(NTHR, 2) mega(Params p) {
    extern __shared__ __attribute__((aligned(16))) unsigned char smem[];
    Frame F; F.p = p; F.bid = blockIdx.x; F.nb = gridDim.x; F.tid = threadIdx.x; F.lane = threadIdx.x & 63; F.wave = threadIdx.x >> 6; F.wid_s = __builtin_amdgcn_readfirstlane(threadIdx.x >> 6);
    F.smf = (float*)(smem + LDS_STAGE);
    LAS unsigned char* stage = (LAS unsigned char*)smem + LDS_STAGE; int* offt = (int*)(smem + 64);
    unsigned char* ws = p.ws; F.ws = ws;

    if (threadIdx.x == 0) *(uint4*)smem = make_uint4(0u, 0u, 0u, 0u);
    __syncthreads();
    unsigned* barw = (unsigned*)(ws + WS_CTL);
    XcdBarrier bar; bar.bar = barw; bar.x = 0; bar.st = (volatile LAS unsigned*)smem;
    const bool multi = (p.ph_hi - p.ph_lo) > 1;
    if (multi) bar = xcd_barrier_post(barw, (volatile LAS unsigned*)smem);
    const int lo = p.ph_lo, hi = p.ph_hi;
#define IN(k) (lo <= (k) && (k) < hi)
#define SEAM(k) do { if (IN(k) && IN((k) + 1)) xcd_barrier(bar); else __syncthreads(); } while (0)

    if (IN(0)) { REFRESH(F); phase_mod(F); __syncthreads(); phase_conv_a(F, 0); }
    SEAM(0);
#pragma unroll 1
    for (int l = 0; l < DEPTH; ++l) {
        const int pb = 1 + l * NPL;
        const float* xlat = (l == 0) ? p.x : p.out; const float* xctx = (l == 0) ? p.ctx : F.cxo();
        const int Mrows = (l == 0) ? NROW : NTOK;
        if (IN(pb + 0)) { REFRESH(F); if (l == 0) phase_prep(F, 0, p.x, p.ctx); else phase_conv_a(F, l); }
        SEAM(pb + 0);
        if (IN(pb + 1)) { REFRESH(F);
            float* rtab = (float*)(smem + LDS_ROPE);
            for (int e = F.tid; e < 1024; e += NTHR) { const int pp = e >> 4, i = e & 15; const float inv = powf(10000.f, -(float)i / 16.f), ang = (float)pp * inv; rtab[2 * e] = cosf(ang); rtab[2 * e + 1] = sinf(ang); }
            __syncthreads();
            pg::SchedG1 S{(const char*)F.HX(), (const char*)F.W1t(), (const char*)F.Wvt(), F.nb, F.bid}; pg::EpiG1 E{F.P1(), F.VT(), rtab, F.lb(), l};
            pg::gemm_phase(stage, DM, DM, DM, S, E);
        }
        SEAM(pb + 1);
        if (IN(pb + 2)) { REFRESH(F); phase_mix(F, l); }
        SEAM(pb + 2);
        if (IN(pb + 3)) { REFRESH(F); phase_prepad(F, l); }
        SEAM(pb + 3);
        if (IN(pb + 4)) { REFRESH(F);
            pg::SchedStatic S{(const char*)F.HX(), (const char*)F.Wgt(), (size_t)256 * DM * 2, (size_t)256 * DM * 2, Mrows / 256, NGATE / 256, F.nb, F.bid}; pg::EpiGate E{F.G()};
            pg::gemm_phase(stage, DM, DM, DM, S, E);
            __syncthreads();
            phase_conv_b(F, l);
        }
        SEAM(pb + 4);
        if (IN(pb + 5)) { REFRESH(F);
            pg::SchedMerge S{(const char*)F.BR(), (const char*)F.Wbrt(), (Mrows / 256) * 4, F.nb, F.bid}; pg::EpiMerge E{F.G(), F.HX()};
            pg::gemm_phase(stage, 2048, 512, 512, S, E);
        }
        SEAM(pb + 5);
        if (IN(pb + 6)) { REFRESH(F);
            pg::SchedStatic S{(const char*)F.HX(), (const char*)F.Woutt(), (size_t)256 * DM * 2, (size_t)256 * DM * 2, Mrows / 256, DM / 256, F.nb, F.bid};
            pg::EpiWout E{xlat, xctx, p.out, F.cxm(), F.modv() + (size_t)l * 5 * 6144};
            pg::gemm_phase(stage, DM, DM, DM, S, E);
        }
        SEAM(pb + 6);
        if (IN(pb + 7)) { REFRESH(F); phase_ln1(F, l); }
        SEAM(pb + 7);
        if (IN(pb + 8)) { REFRESH(F); phase_gather(F, l); }
        SEAM(pb + 8);
        if (IN(pb + 9)) { REFRESH(F);
            moe_offsets(F, l, offt);
            pg::SchedMoe S{(const char*)F.XS(), (const char*)F.Wgu(), offt, (size_t)256 * DM * 2, (size_t)512 * DM * 2, (size_t)256 * DM * 2, offt[32] / 256, 2, F.nb, F.bid};
            pg::EpiMoe1 E{F.HID(), F.roww()};
            pg::gemm_phase(stage, DM, DM, DM, S, E);
        }
        SEAM(pb + 9);
        if (IN(pb + 10)) { REFRESH(F);
            moe_offsets(F, l, offt);
            pg::SchedMoe S{(const char*)F.HID(), (const char*)F.Wd(), offt, (size_t)256 * 256 * 2, (size_t)DM * 256 * 2, (size_t)256 * 256 * 2, offt[32] / 256, 4, F.nb, F.bid};
            pg::EpiMoe2 E{F.BR(), F.rmap(), (bf16_t*)(F.ws + WS_DUMP)};
            pg::gemm_phase(stage, 256, 256, 256, S, E);
        }
        SEAM(pb + 10);
        if (IN(pb + 11)) { REFRESH(F); phase_ln2(F, l); }
        SEAM(pb + 11);
    }
#undef IN
#undef SEAM
}

extern "C" void kernel_launch(void* const* d_in, const int* in_sizes, int n_in, void* d_out, int out_size, void* d_ws, size_t ws_size, hipStream_t stream) {
    static int grid = 0;
    if (grid == 0) {
        if (n_in != 23 || out_size != NTOK * DM || ws_size < WS_END) { fprintf(stderr, "kernel_launch: unexpected shapes (n_in %d out %d ws %zu need %zu)\n", n_in, out_size, ws_size, (size_t)WS_END); grid = -1; return; }
        int dev = 0, cus = 0;
        if (hipGetDevice(&dev) != hipSuccess || hipDeviceGetAttribute(&cus, hipDeviceAttributeMultiprocessorCount, dev) != hipSuccess) { grid = -1; return; }
        if (hipFuncSetAttribute((const void*)mega, hipFuncAttributeMaxDynamicSharedMemorySize, LDS_BYTES) != hipSuccess) { fprintf(stderr, "kernel_launch: hipFuncSetAttribute failed\n"); grid = -1; return; }
        int per_cu = 0;
        if (hipOccupancyMaxActiveBlocksPerMultiprocessor(&per_cu, (const void*)mega, NTHR, LDS_BYTES) != hipSuccess || per_cu < 1) fprintf(stderr, "kernel_launch: occupancy query reports %d blocks per CU\n", per_cu);
        (void)hipGetLastError();
        grid = cus;
    }
    if (grid < 0) return;
    (void)hipMemsetAsync((char*)d_ws + WS_CTL, 0, CTL_BYTES, stream);
    Params p; memset(&p, 0, sizeof(p));
    const float** pp = (const float**)&p;
    for (int i = 0; i < 23; ++i) pp[i] = (const float*)d_in[i];
    p.out = (float*)d_out; p.ws = (unsigned char*)d_ws;
    p.ph_lo = 0; p.ph_hi = NPH;
    hipLaunchKernelGGL(mega, dim3(grid), dim3(NTHR), LDS_BYTES, stream, p);
}
```

```cpp
#include <hip/hip_runtime.h>
#include <cstdio>
#include <cstdint>
#include <cstring>

typedef unsigned short bf16_t;
typedef float f32x4 __attribute__((ext_vector_type(4)));
typedef unsigned u32x4 __attribute__((ext_vector_type(4)));
typedef unsigned u32x2 __attribute__((ext_vector_type(2)));

constexpr int NB = 4, SEQ = 4096, LC = 256, DM = 1024, DEPTH = 2;
constexpr int NTOK = NB * SEQ, NCTX = NB * LC, NROW = NTOK + NCTX;
constexpr int DIN = 10528;
constexpr int O_AQ = 0, O_AK = 256, O_AV = 512, O_AG = 1024, O_ALR = 1536, O_BQ = 1568, O_BK = 2080, O_BV = 2592, O_CQ = 3104, O_CK = 3616,
              O_CV = 3744, O_DQ = 3872, O_DF = 4384, O_DI = 5408, O_DG = 5920, O_GATE = 6432;
constexpr int PC_AQ = 0, PC_AK = 256, PC_AV = 512, PC_BQ = 1024, PC_BK = 1536, PC_CQ = 2048, PC_CK = 2560, PC_ALR = 2688, PC_DQ = 2816,
              PC_DF = 3328, PC_DI = 4352, PC_AG = 4864, PC_DG = 5376, NP1 = 5888;
constexpr float QSCALE = 0.125f * 1.44269504089f;
constexpr int NVT = 768;
constexpr int NVR = 640;
constexpr int NGATE = 4096;
constexpr int XS_ROWS = 43008;
constexpr float LN_EPS = 1e-5f;
constexpr float ALPHA = 1.41421356237f;

constexpr size_t al256(size_t x) { return (x + 255) & ~(size_t)255; }
constexpr size_t WS_CTL = 0;
constexpr size_t CTL_BYTES = 32768;
constexpr size_t CTL_CNT = 28672;
constexpr size_t WS_DUMP = WS_CTL + CTL_BYTES;
constexpr size_t WS_MODV = WS_DUMP + 4096;
constexpr size_t WS_LB = WS_MODV + al256((size_t)DEPTH * 5 * 6144 * 4);
constexpr size_t WS_TOKE = WS_LB + 4096;
constexpr size_t WS_TOKI = WS_TOKE + al256((size_t)2 * NROW * 4);
constexpr size_t WS_TOKW = WS_TOKI + al256((size_t)2 * NROW * 4);
constexpr size_t WS_RMAP = WS_TOKW + al256((size_t)2 * NROW * 4);
constexpr size_t WS_ROWW = WS_RMAP + al256((size_t)XS_ROWS * 4);
constexpr size_t WS_CXM = WS_ROWW + al256((size_t)XS_ROWS * 4);
constexpr size_t WS_CXO = WS_CXM + (size_t)NCTX * DM * 4;
constexpr size_t WS_WTA = WS_CXO + (size_t)NCTX * DM * 4;
constexpr size_t WTA_W1 = 0;
constexpr size_t WTA_WV = WTA_W1 + (size_t)NP1 * DM * 2;
constexpr size_t WTA_WG = WTA_WV + (size_t)NVT * DM * 2;
constexpr size_t WTA_WBR = WTA_WG + (size_t)NGATE * DM * 2;
constexpr size_t WTA_WO = WTA_WBR + (size_t)4 * DM * 512 * 2;
constexpr size_t WTA_BYTES = WTA_WO + (size_t)DM * DM * 2;
constexpr size_t WS_HX = WS_WTA + WTA_BYTES;
constexpr size_t WS_VT = WS_HX + (size_t)NROW * DM * 2;
constexpr size_t WS_OBA = WS_VT + (size_t)NVT * NROW * 2;
constexpr size_t WS_HX2 = WS_VT;
constexpr size_t WS_HID = WS_VT;
constexpr size_t WS_VR = WS_OBA + (size_t)NROW * 512 * 2;
constexpr size_t WS_BR = WS_VR + (size_t)NROW * NVR * 2;
constexpr size_t WS_P1 = WS_BR + (size_t)NROW * 2048 * 2;
constexpr size_t WS_G = WS_P1;
constexpr size_t WS_WGU = WS_P1 + (size_t)NROW * NGATE * 2;
constexpr size_t WS_WD = WS_WGU + (size_t)32 * 512 * DM * 2;
constexpr size_t WS_XS = WS_P1;
constexpr size_t WS_END = WS_P1 + (size_t)NROW * NP1 * 2;
static_assert(WS_WD + (size_t)32 * DM * 256 * 2 <= WS_END, "moe weights must fit in the P1 tail");
static_assert((size_t)XS_ROWS * DM * 2 <= (size_t)NROW * NGATE * 2, "XS must fit in the G region");
static_assert((size_t)NVT * NROW * 2 + (size_t)NROW * 512 * 2 >= (size_t)NROW * DM * 2, "HX2 alias");
static_assert(WS_END <= 434800000ull, "workspace budget");

constexpr int NTHR = 512;
constexpr int LDS_STAGE = 1024;
constexpr int LDS_ROPE = 1024 + 131072 + 1024;
constexpr int LDS_BYTES = 144 * 1024;

struct Params {
    const float *x, *c, *ctx, *c_ctx, *w_mod, *b_mod, *w_in, *gla_lr_w, *gla_lr_b, *hg_gamma, *na_rpb, *wa_sink, *w_branch, *w_out, *ln_g, *ln_b,
        *moe_w_group, *moe_b_group, *moe_w_expert, *moe_b_expert, *moe_w_gate, *moe_w_up, *moe_w_down;
    float* out;
    unsigned char* ws;
    int ph_lo, ph_hi;
};

__device__ __forceinline__ float bf2f(bf16_t b) { return __uint_as_float(((unsigned)b) << 16); }
__device__ __forceinline__ bf16_t f2bf(float f) { unsigned u = __float_as_uint(f); u += 0x7FFFu + ((u >> 16) & 1u); return (bf16_t)(u >> 16); }
typedef float f32x2_t __attribute__((ext_vector_type(2)));
typedef __bf16 bf16x2_t __attribute__((ext_vector_type(2)));
__device__ __forceinline__ unsigned pk2(float lo, float hi) {
    const f32x2_t v = {lo, hi}; const bf16x2_t b = __builtin_convertvector(v, bf16x2_t); return __builtin_bit_cast(unsigned, b); }
__device__ __forceinline__ void ld8(const bf16_t* p, float* f) {
    const u32x4 v = *(const u32x4*)p;
    f[0] = __uint_as_float(v.x << 16); f[1] = __uint_as_float(v.x & 0xffff0000u);
    f[2] = __uint_as_float(v.y << 16); f[3] = __uint_as_float(v.y & 0xffff0000u);
    f[4] = __uint_as_float(v.z << 16); f[5] = __uint_as_float(v.z & 0xffff0000u);
    f[6] = __uint_as_float(v.w << 16); f[7] = __uint_as_float(v.w & 0xffff0000u);
}
__device__ __forceinline__ void st8(bf16_t* p, const float* f) {
    u32x4 v; v.x = pk2(f[0], f[1]); v.y = pk2(f[2], f[3]); v.z = pk2(f[4], f[5]); v.w = pk2(f[6], f[7]);
    *(u32x4*)p = v;
}
__device__ __forceinline__ float sigmoidf_(float x) { return __builtin_amdgcn_rcpf(1.f + __expf(-x)); }
__device__ __forceinline__ float siluf_(float x) { return x * __builtin_amdgcn_rcpf(1.f + __expf(-x)); }
__device__ __forceinline__ float wave_sum(float v) {
#pragma unroll
    for (int o = 1; o < 64; o <<= 1) v += __shfl_xor(v, o);
    return v;
}
__device__ __forceinline__ int row_batch(int row) { return row < NTOK ? (row >> 12) : 4; }

#define XB_TMO      128
#define XB_XCNT(j)  (256  + 64 * (j))
#define XB_XSUB(j)  (1280 + 64 * (j))
#define XB_XGEN(j)  (2304 + 64 * (j))
#define XB_TOP      3328
#define XB_TOPGEN   3392
#define XCD_BAR_WORDS 3456
#define XB_SPIN_CAP (1u << 18)
#define LAS __attribute__((address_space(3)))
__device__ __forceinline__ unsigned xb_ld(unsigned* p)              { return __hip_atomic_load(p, __ATOMIC_RELAXED, __HIP_MEMORY_SCOPE_AGENT); }
__device__ __forceinline__ unsigned xb_add(unsigned* p, unsigned v) { return __hip_atomic_fetch_add(p, v, __ATOMIC_RELAXED, __HIP_MEMORY_SCOPE_AGENT); }
__device__ __forceinline__ unsigned xb_xcc_id() { return (unsigned)__builtin_amdgcn_s_getreg((3 << 11) | 20) & 0xFu; }
#define XB_SPIN(cond, bar) do { unsigned _sp = 0; while (cond) { __builtin_amdgcn_s_sleep(1); \
    if ((++_sp & 255u) == 0u) { if (xb_ld(&(bar)[XB_TMO])) break; if (_sp > XB_SPIN_CAP) { atomicAdd(&(bar)[XB_TMO], 1u); break; } } } } while (0)
struct XcdBarrier { unsigned* bar; unsigned x; volatile LAS unsigned* st; };
__device__ __forceinline__ XcdBarrier xcd_barrier_post(unsigned* bar, volatile LAS unsigned* st) {
    XcdBarrier b; b.bar = bar; b.x = xb_xcc_id(); b.st = st;
    if (threadIdx.x == 0) (void)xb_add(&bar[XB_XCNT(b.x)], 1u);
    return b;
}
__device__ __forceinline__ void xcd_barrier_complete(unsigned* bar, unsigned x, unsigned& nloc, unsigned& nx) {
    const unsigned G = gridDim.x * gridDim.y * gridDim.z;
    unsigned sum, cnt, mine, sp = 0u;
    for (;;) {
        sum = 0u; cnt = 0u; mine = 0u;
#pragma unroll
        for (unsigned j = 0; j < 16; ++j) { const unsigned c = xb_ld(&bar[XB_XCNT(j)]); sum += c; cnt += (c > 0u) ? 1u : 0u; mine = (j == x) ? c : mine; }
        if (sum == G) break;
        __builtin_amdgcn_s_sleep(1);
        if ((++sp & 255u) == 0u) { if (xb_ld(&bar[XB_TMO])) break; if (sp > XB_SPIN_CAP) { atomicAdd(&bar[XB_TMO], 1u); break; } }
    }
    nloc = mine > 0u ? mine : 1u; nx = cnt > 0u ? cnt : 1u;
}
__device__ __forceinline__ void xcd_barrier(const XcdBarrier& b) {
    asm volatile("s_waitcnt vmcnt(0)" ::: "memory");
    __syncthreads();
    if (threadIdx.x == 0) {
        unsigned* bar = b.bar;
        __builtin_amdgcn_s_waitcnt(0);
        unsigned nloc = b.st[0], nx = b.st[1];
        if (nloc == 0u) { xcd_barrier_complete(bar, b.x, nloc, nx); b.st[0] = nloc; b.st[1] = nx; }
        const unsigned old = xb_add(&bar[XB_XSUB(b.x)], 1u);
        const unsigned gen = old / nloc;
        if (old + 1u == (gen + 1u) * nloc) {
            __builtin_amdgcn_fence(__ATOMIC_RELEASE, "agent");
            asm volatile("s_waitcnt vmcnt(0)" ::: "memory");
            const unsigned og = xb_add(&bar[XB_TOP], 1u);
            const unsigned tg = og / nx;
            if (og + 1u == (tg + 1u) * nx) xb_add(&bar[XB_TOPGEN], 1u);
            else XB_SPIN(xb_ld(&bar[XB_TOPGEN]) == tg, bar);
            __builtin_amdgcn_fence(__ATOMIC_ACQUIRE, "agent");
            xb_add(&bar[XB_XGEN(b.x)], 1u);
            asm volatile("s_waitcnt vmcnt(0)" ::: "memory");
        } else {
            XB_SPIN(xb_ld(&bar[XB_XGEN(b.x)]) == gen, bar);
            __builtin_amdgcn_fence(__ATOMIC_ACQUIRE, "agent");
            asm volatile("s_waitcnt vmcnt(0)" ::: "memory");
        }
    }
    __syncthreads();
}

struct Frame {
    Params p;
    int bid, nb, tid, lane, wave, wid_s;
    float* smf;
    unsigned char* ws;
    __device__ __forceinline__ float* modv() const { return (float*)(ws + WS_MODV); }
    __device__ __forceinline__ float* lb() const { return (float*)(ws + WS_LB); }
    __device__ __forceinline__ int* tokE() const { return (int*)(ws + WS_TOKE); }
    __device__ __forceinline__ int* tokI() const { return (int*)(ws + WS_TOKI); }
    __device__ __forceinline__ float* tokW() const { return (float*)(ws + WS_TOKW); }
    __device__ __forceinline__ int* rmap() const { return (int*)(ws + WS_RMAP); }
    __device__ __forceinline__ float* roww() const { return (float*)(ws + WS_ROWW); }
    __device__ __forceinline__ float* cxm() const { return (float*)(ws + WS_CXM); }
    __device__ __forceinline__ float* cxo() const { return (float*)(ws + WS_CXO); }
    __device__ __forceinline__ bf16_t* W1t() const { return (bf16_t*)(ws + WS_WTA + WTA_W1); }
    __device__ __forceinline__ bf16_t* Wvt() const { return (bf16_t*)(ws + WS_WTA + WTA_WV); }
    __device__ __forceinline__ bf16_t* Wgt() const { return (bf16_t*)(ws + WS_WTA + WTA_WG); }
    __device__ __forceinline__ bf16_t* Wbrt() const { return (bf16_t*)(ws + WS_WTA + WTA_WBR); }
    __device__ __forceinline__ bf16_t* Woutt() const { return (bf16_t*)(ws + WS_WTA + WTA_WO); }
    __device__ __forceinline__ bf16_t* HX() const { return (bf16_t*)(ws + WS_HX); }
    __device__ __forceinline__ bf16_t* VT() const { return (bf16_t*)(ws + WS_VT); }
    __device__ __forceinline__ bf16_t* OBA() const { return (bf16_t*)(ws + WS_OBA); }
    __device__ __forceinline__ bf16_t* HX2() const { return (bf16_t*)(ws + WS_HX2); }
    __device__ __forceinline__ bf16_t* HID() const { return (bf16_t*)(ws + WS_HID); }
    __device__ __forceinline__ bf16_t* VR() const { return (bf16_t*)(ws + WS_VR); }
    __device__ __forceinline__ bf16_t* BR() const { return (bf16_t*)(ws + WS_BR); }
    __device__ __forceinline__ bf16_t* P1() const { return (bf16_t*)(ws + WS_P1); }
    __device__ __forceinline__ bf16_t* G() const { return (bf16_t*)(ws + WS_G); }
    __device__ __forceinline__ bf16_t* Wgu() const { return (bf16_t*)(ws + WS_WGU); }
    __device__ __forceinline__ bf16_t* Wd() const { return (bf16_t*)(ws + WS_WD); }
    __device__ __forceinline__ bf16_t* XS() const { return (bf16_t*)(ws + WS_XS); }
    __device__ __forceinline__ unsigned* cnt() const { return (unsigned*)(ws + WS_CTL + CTL_CNT); }
};


#define REFRESH(F) do { int _t = threadIdx.x; asm volatile("" : "+v"(_t)); (F).tid = _t; (F).lane = _t & 63; (F).wave = _t >> 6; } while (0)

__device__ __forceinline__ void phase_mod(Frame& F) {
    float* sc = F.smf;
    float* red = F.smf + 5 * 1024;
    bool have = false;
    for (int it = F.bid; it < DEPTH * 96; it += F.nb) {
        if (!have) {
            for (int i = F.tid; i < 5 * 1024; i += NTHR) { const float v = (i < 4096) ? F.p.c[i] : F.p.c_ctx[i - 4096]; sc[i] = siluf_(v); }
            __syncthreads(); have = true;
        }
        const int l = it / 96, n0 = (it % 96) * 64, col = F.tid & 63, kg = F.tid >> 6;
        const float* w = F.p.w_mod + (size_t)l * DM * 6144 + n0 + col;
        float a[5] = {0.f, 0.f, 0.f, 0.f, 0.f};
        for (int k = kg * 128; k < kg * 128 + 128; ++k) {
            const float wv = w[(size_t)k * 6144];
#pragma unroll
            for (int r = 0; r < 5; ++r) a[r] += sc[r * 1024 + k] * wv;
        }
#pragma unroll
        for (int r = 0; r < 5; ++r) red[(kg * 5 + r) * 64 + col] = a[r];
        __syncthreads();
        if (F.tid < 320) {
            const int r = F.tid >> 6, cc = F.tid & 63; float s = F.p.b_mod[l * 6144 + n0 + cc];
#pragma unroll
            for (int g = 0; g < 8; ++g) s += red[(g * 5 + r) * 64 + cc];
            F.modv()[((size_t)l * 5 + r) * 6144 + n0 + cc] = s;
        }
        __syncthreads();
    }
    if (F.bid == F.nb - 1) {
        for (int i = F.tid; i < 1024; i += NTHR) { const int z = i >> 9, f = i & 511;
            const float g0 = F.p.hg_gamma[(z * DEPTH + 0) * 512 + f], g1 = F.p.hg_gamma[(z * DEPTH + 1) * 512 + f];
            F.lb()[i] = 1.f / (1.f + expf(g0 - g1)); }
    }
}

__device__ __forceinline__ int p1_src(int n, float& scale) {
    scale = 1.f;
    if (n < 256) { scale = 0.125f; return O_AQ + n; }
    if (n < 512) return O_AK + (n - 256);
    if (n < 1024) return O_AV + (n - 512);
    if (n < 1536) { scale = QSCALE; return O_BQ + (n - 1024); }
    if (n < 2048) return O_BK + (n - 1536);
    if (n < 2560) { scale = QSCALE; return O_CQ + (n - 2048); }
    if (n < 2688) return O_CK + (n - 2560);
    if (n < 2720) return O_ALR + (n - 2688);
    if (n < 2816) return -1;
    if (n < 3328) return O_DQ + (n - 2816);
    if (n < 4352) return O_DF + (n - 3328);
    if (n < 4864) return O_DI + (n - 4352);
    if (n < 5376) return O_AG + (n - 4864);
    return O_DG + (n - 5376);
}
__device__ __forceinline__ void conv_item(const float* src, int ldsrc, int srccol, float scale, bf16_t* dst, int K, int k0, float* scr, int lane, bool perm) {
    if (srccol >= 0) {
#pragma unroll 8
        for (int i = 0; i < 32; ++i) { const int kk = 2 * i + (lane >> 5); scr[kk * 33 + (lane & 31)] = src[(size_t)(k0 + kk) * ldsrc + srccol + (lane & 31)] * scale; }
    } else {
#pragma unroll 8
        for (int i = 0; i < 32; ++i) { const int kk = 2 * i + (lane >> 5); scr[kk * 33 + (lane & 31)] = 0.f; }
    }
    asm volatile("s_waitcnt lgkmcnt(0)" ::: "memory");
    const int c = lane & 7;
#pragma unroll
    for (int j = 0; j < 4; ++j) { const int nn = (lane >> 3) + 8 * j; const float* sp = scr + (8 * c) * 33 + (perm ? (8 * ((nn & 15) >> 2) + 4 * (nn >> 4) + (nn & 3)) : nn);
        u32x4 o; o.x = pk2(sp[0 * 33], sp[1 * 33]); o.y = pk2(sp[2 * 33], sp[3 * 33]); o.z = pk2(sp[4 * 33], sp[5 * 33]); o.w = pk2(sp[6 * 33], sp[7 * 33]);
        *(u32x4*)(dst + (size_t)nn * K + 8 * c) = o; }
    asm volatile("s_waitcnt lgkmcnt(0)" ::: "memory");
}
constexpr int CONVA_W1 = (NP1 / 32) * 16;
constexpr int CONVA_ITEMS = CONVA_W1 + 384 + 2048 + 1024 + 512;
__device__ __forceinline__ void phase_conv_a(Frame& F, int l) {
    float* scr = F.smf + F.wave * (64 * 33);
    const int gw = F.bid * 8 + F.wave, ngw = F.nb * 8;
    for (int it0 = gw; it0 < CONVA_ITEMS; it0 += ngw) {
        int ti = it0;
        if (ti < CONVA_W1) { const int n0 = (ti >> 4) * 32, kt = ti & 15; float sc; const int sx = p1_src(n0, sc);
            conv_item(F.p.w_in + (size_t)l * DM * DIN, DIN, sx, sc, F.W1t() + (size_t)n0 * DM + kt * 64, DM, kt * 64, scr, F.lane, !(n0 >= 2048 && n0 < 2816)); continue; }
        ti -= CONVA_W1;
        if (ti < 384) { const int n0 = (ti >> 4) * 32, kt = ti & 15; const int sx = n0 < 512 ? O_BV + n0 : (n0 < 640 ? O_CV + (n0 - 512) : -1);
            conv_item(F.p.w_in + (size_t)l * DM * DIN, DIN, sx, 1.f, F.Wvt() + (size_t)n0 * DM + kt * 64, DM, kt * 64, scr, F.lane, false); continue; }
        ti -= 384;
        if (ti < 2048) { const int n0 = (ti >> 4) * 32, kt = ti & 15;
            conv_item(F.p.w_in + (size_t)l * DM * DIN, DIN, O_GATE + n0, 1.f, F.Wgt() + (size_t)n0 * DM + kt * 64, DM, kt * 64, scr, F.lane, true); continue; }
        ti -= 2048;
        if (ti < 1024) { const int i = ti >> 8, r = ti & 255, n0 = (r >> 3) * 32, kt = r & 7;
            conv_item(F.p.w_branch + (size_t)(l * 4 + i) * 512 * DM, DM, n0, 1.f, F.Wbrt() + (size_t)i * DM * 512 + (size_t)n0 * 512 + kt * 64, 512, kt * 64, scr, F.lane, true); continue; }
        ti -= 1024;
        { const int n0 = (ti >> 4) * 32, kt = ti & 15;
          conv_item(F.p.w_out + (size_t)l * DM * DM, DM, n0, 1.f, F.Woutt() + (size_t)n0 * DM + kt * 64, DM, kt * 64, scr, F.lane, false); }
    }
}
constexpr int CONVB_ITEMS = 8192 + 4096;
__device__ __forceinline__ void phase_conv_b(Frame& F, int l) {
    float* scr = F.smf + F.wave * (64 * 33);
    const int gw = F.bid * 8 + F.wave, ngw = F.nb * 8;
    for (int it0 = gw; it0 < CONVB_ITEMS; it0 += ngw) {
        int ti = it0;
        if (ti < 8192) { const int e = ti >> 8, r = ti & 255, n0 = (r >> 4) * 32, kt = r & 15, j = n0 >> 8, rr = n0 & 255; const bool isup = rr >= 128; const int cc = 128 * j + (rr & 127);
            const float* src = (isup ? F.p.moe_w_up : F.p.moe_w_gate) + (size_t)(l * 32 + e) * DM * 256;
            conv_item(src, 256, cc, 1.f, F.Wgu() + (size_t)e * 512 * DM + (size_t)n0 * DM + kt * 64, DM, kt * 64, scr, F.lane, true); continue; }
        ti -= 8192;
        { const int e = ti >> 7, r = ti & 127, n0 = (r >> 2) * 32, kt = r & 3;
          conv_item(F.p.moe_w_down + (size_t)(l * 32 + e) * 256 * DM, DM, n0, 1.f, F.Wd() + (size_t)e * DM * 256 + (size_t)n0 * 256 + kt * 64, 256, kt * 64, scr, F.lane, true); }
    }
}

__device__ __forceinline__ void phase_prep(Frame& F, int l, const float* xlat, const float* xctx) {
    const int gw = F.bid * 8 + F.wave, ngw = F.nb * 8;
    for (int row = gw; row < NROW; row += ngw) {
        const float* xr = row < NTOK ? xlat + (size_t)row * DM : xctx + (size_t)(row - NTOK) * DM;
        const float* mv = F.modv() + ((size_t)l * 5 + row_batch(row)) * 6144;
#pragma unroll
        for (int j = 0; j < 4; ++j) { const int d = j * 256 + F.lane * 4;
            const f32x4 v = *(const f32x4*)(xr + d), m0 = *(const f32x4*)(mv + d), m1 = *(const f32x4*)(mv + 1024 + d);
            u32x2 o; o.x = pk2(v.x * (1.f + m1.x) + m0.x, v.y * (1.f + m1.y) + m0.y); o.y = pk2(v.z * (1.f + m1.z) + m0.z, v.w * (1.f + m1.w) + m0.w);
            *(u32x2*)(F.HX() + (size_t)row * DM + d) = o; }
    }
}


namespace pg {
typedef short bf16x8 __attribute__((ext_vector_type(8)));
constexpr int BM = 256, BK = 64, HALF = 128, HTB = HALF * BK * 2, STAGE_BYTES = 8 * HTB, NXCD = 8, WGM = 8;
__device__ __forceinline__ int lds_byte(int r, int c) { const int st = (r >> 4) * 2 + (c >> 5), rr = r & 15, cc = c & 31, ob = rr * 64 + cc * 2; return st * 1024 + (ob ^ (((ob >> 9) & 1) << 5)); }
__device__ __forceinline__ void stage_rc(int b, int& R, int& C) { const int st = b / 1024, sb = b % 1024, swz = sb ^ (((sb >> 9) & 1) << 5); R = (st >> 1) * 16 + swz / 64; C = (st & 1) * 32 + (swz % 64) / 2; }
struct Unit { const char* a; const char* b; int pm, pn, aux; };
__device__ __forceinline__ void static_map(int L, int nM, int nN, int& pm, int& pn) {
    const int nwg = nM * nN; int wgid = L; { const int q = nwg / NXCD, r = nwg % NXCD, xcd = wgid % NXCD, off = wgid / NXCD; wgid = (xcd < r ? xcd * (q + 1) : r * (q + 1) + (xcd - r) * q) + off; }
    const int nig = WGM * nN, gid = wgid / nig, fm = gid * WGM, gsz = (nM - fm) < WGM ? (nM - fm) : WGM;
    pm = fm + ((wgid % nig) % gsz); pn = (wgid % nig) / gsz;
}
template <class Epi, class Sched>
__device__ __forceinline__ void gemm_phase(LAS unsigned char* lds, const int lda, const int ldb, const int K, const Sched& S, const Epi& E) {
    int tid = threadIdx.x; asm volatile("" : "+v"(tid));
    const int wid = __builtin_amdgcn_readfirstlane(tid >> 6), lane = tid & 63, wr = wid >> 2, wc = wid & 3, fr = lane & 15, fq = lane >> 4;
    int nt = K / BK; asm volatile("" : "+s"(nt));
    unsigned voffA[2], voffB[2];
#pragma unroll
    for (int i = 0; i < 2; ++i) { int R, C; stage_rc(tid * 16 + i * 8192, R, C); voffA[i] = (unsigned)(R * lda + C) * 2u; voffB[i] = (unsigned)(R * ldb + C) * 2u; }
    const size_t kstep = (size_t)(BK * 2);
    const size_t hstepA = (size_t)HALF * lda * 2, hstepB = (size_t)HALF * ldb * 2;
    const unsigned ldsw = (unsigned)wid * 1024u;
    const int aoff = lds_byte(wr * 64 + fr, fq * 8), boff = lds_byte(wc * 32 + fr, fq * 8);
#define PG_SA(b, h) (((b) * 2 + (h)) * HTB)
#define PG_SB(b, h) ((4 + (b) * 2 + (h)) * HTB)
#define PG_STAGE(bufoff, gbase, voff) do { _Pragma("unroll") for (int _i = 0; _i < 2; ++_i) \
        __builtin_amdgcn_global_load_lds((const unsigned*)((const char*)(gbase) + (voff)[_i]), (LAS unsigned*)(lds + (bufoff) + ldsw + _i * 8192), 16, 0, 0); } while (0)
#define PG_LDA(dst, b, h) do { _Pragma("unroll") for (int m = 0; m < 4; ++m) _Pragma("unroll") for (int k = 0; k < 2; ++k) dst[m][k] = *(const LAS bf16x8*)(lds + PG_SA(b, h) + aoff + m * 2048 + k * 1024); } while (0)
#define PG_LDB(dst, b, h) do { _Pragma("unroll") for (int n = 0; n < 2; ++n) _Pragma("unroll") for (int k = 0; k < 2; ++k) dst[n][k] = *(const LAS bf16x8*)(lds + PG_SB(b, h) + boff + n * 2048 + k * 1024); } while (0)
#define PG_MMA(ai, bj, At, Bt) do { __builtin_amdgcn_s_setprio(1); _Pragma("unroll") for (int m = 0; m < 4; ++m) _Pragma("unroll") for (int n = 0; n < 2; ++n) _Pragma("unroll") for (int k = 0; k < 2; ++k) \
        acc[ai][bj][m][n] = __builtin_amdgcn_mfma_f32_16x16x32_bf16(Bt[n][k], At[m][k], acc[ai][bj][m][n], 0, 0, 0); __builtin_amdgcn_s_setprio(0); } while (0)
#define PG_WAIT_V(n) asm volatile("s_waitcnt vmcnt(" #n ")" ::: "memory")
#define PG_WAIT_L(n) asm volatile("s_waitcnt lgkmcnt(" #n ")" ::: "memory")
#define PG_BAR __builtin_amdgcn_s_barrier()
#define PG_SCHED __builtin_amdgcn_sched_barrier(0)
    Unit cur, nxt; int ui = 0;
    if (!S.next(0, cur)) return;
    f32x4 acc[2][2][4][2];
#pragma unroll
    for (int a = 0; a < 2; ++a)
#pragma unroll
        for (int b = 0; b < 2; ++b)
#pragma unroll
            for (int m = 0; m < 4; ++m)
#pragma unroll
                for (int n = 0; n < 2; ++n) acc[a][b][m][n] = (f32x4){0.f, 0.f, 0.f, 0.f};
    bf16x8 At[4][2], B0[2][2], B1[2][2];
    const char* cA = cur.a; const char* cB = cur.b;
    PG_STAGE(PG_SB(0, 0), cB, voffB); PG_STAGE(PG_SA(0, 0), cA, voffA); PG_STAGE(PG_SB(0, 1), cB + hstepB, voffB); PG_STAGE(PG_SA(0, 1), cA + hstepA, voffA);
    if (wr == 1) PG_BAR;
    PG_WAIT_V(4); PG_BAR;
    PG_STAGE(PG_SB(1, 0), cB + kstep, voffB); PG_STAGE(PG_SA(1, 0), cA + kstep, voffA); PG_STAGE(PG_SB(1, 1), cB + hstepB + kstep, voffB);
    PG_WAIT_V(6); PG_BAR;
    for (;;) {
        const bool has_next = S.next(ui + 1, nxt);
        const char* nA = has_next ? nxt.a : cA; const char* nB = has_next ? nxt.b : cB;
        for (int t = 0; t < nt; t += 2) {
            const bool last = (t == nt - 2);
            const char* a1 = cA + (size_t)(t + 1) * kstep;
            const char* a2 = last ? nA : cA + (size_t)(t + 2) * kstep; const char* b2 = last ? nB : cB + (size_t)(t + 2) * kstep;
            const char* a3 = a2 + kstep; const char* b3 = b2 + kstep;
            PG_LDB(B0, 0, 0); PG_SCHED; PG_LDA(At, 0, 0); PG_STAGE(PG_SA(1, 1), a1 + hstepA, voffA);
            PG_WAIT_L(8); PG_BAR; PG_WAIT_L(0); PG_MMA(0, 0, At, B0); PG_BAR; PG_SCHED;
            PG_LDB(B1, 0, 1); PG_STAGE(PG_SB(0, 0), b2, voffB);
            PG_BAR; PG_WAIT_L(0); PG_MMA(0, 1, At, B1); PG_BAR;
            PG_LDA(At, 0, 1); PG_STAGE(PG_SA(0, 0), a2, voffA);
            PG_BAR; PG_WAIT_L(0); PG_MMA(1, 0, At, B0); PG_BAR; PG_SCHED;
            PG_STAGE(PG_SB(0, 1), b2 + hstepB, voffB);
            PG_WAIT_V(6); PG_BAR; PG_MMA(1, 1, At, B1); PG_BAR;
            PG_LDB(B0, 1, 0); PG_SCHED; PG_LDA(At, 1, 0); PG_STAGE(PG_SA(0, 1), a2 + hstepA, voffA);
            PG_WAIT_L(8); PG_BAR; PG_WAIT_L(0); PG_MMA(0, 0, At, B0); PG_BAR; PG_SCHED;
            PG_LDB(B1, 1, 1); PG_STAGE(PG_SB(1, 0), b3, voffB);
            PG_BAR; PG_WAIT_L(0); PG_MMA(0, 1, At, B1); PG_BAR;
            PG_LDA(At, 1, 1); PG_STAGE(PG_SA(1, 0), a3, voffA);
            PG_BAR; PG_WAIT_L(0); PG_MMA(1, 0, At, B0); PG_BAR; PG_SCHED;
            PG_STAGE(PG_SB(1, 1), b3 + hstepB, voffB);
            PG_WAIT_V(6); PG_BAR; PG_MMA(1, 1, At, B1); PG_BAR;
        }
        E(acc, cur, wr, wc, fr, fq);
        if (!has_next) break;
#pragma unroll
        for (int a = 0; a < 2; ++a)
#pragma unroll
            for (int b = 0; b < 2; ++b)
#pragma unroll
                for (int m = 0; m < 4; ++m)
#pragma unroll
                    for (int n = 0; n < 2; ++n) acc[a][b][m][n] = (f32x4){0.f, 0.f, 0.f, 0.f};
        cur = nxt; cA = nA; cB = nB; ++ui;
    }
    PG_WAIT_V(0);
    if (wr == 0) PG_BAR;
    PG_BAR;
#undef PG_SA
#undef PG_SB
#undef PG_STAGE
#undef PG_LDA
#undef PG_LDB
#undef PG_MMA
#undef PG_WAIT_V
#undef PG_WAIT_L
#undef PG_BAR
#undef PG_SCHED
}

struct SchedG1 {
    const char *HX, *W1, *WV; int G, c;
    __device__ __forceinline__ bool next(int i, Unit& u) const {
        const int L = i * G + c, nmain = (NROW / 256) * (NP1 / 256);
        if (L < nmain) { static_map(L, NROW / 256, NP1 / 256, u.pm, u.pn); u.a = HX + (size_t)u.pm * 256 * DM * 2; u.b = W1 + (size_t)u.pn * 256 * DM * 2; u.aux = 0; return true; }
        const int idx = L - nmain; if (idx >= 3 * (NROW / 256)) return false;
        u.pm = idx % 3; u.pn = idx / 3; u.a = WV + (size_t)u.pm * 256 * DM * 2; u.b = HX + (size_t)u.pn * 256 * DM * 2; u.aux = 1; return true;
    }
};
struct SchedStatic {
    const char *A, *B; size_t tA, tB; int nM, nN, G, c;
    __device__ __forceinline__ bool next(int i, Unit& u) const {
        const int L = i * G + c; if (L >= nM * nN) return false;
        static_map(L, nM, nN, u.pm, u.pn); u.a = A + (size_t)u.pm * tA; u.b = B + (size_t)u.pn * tB; u.aux = 0; return true;
    }
};
struct SchedMerge {
    const char *BR, *W; int ntile, G, c;
    __device__ __forceinline__ bool next(int i, Unit& u) const {
        const int t = c + (i >> 2) * G; if (t >= ntile) return false;
        const int br = i & 3; u.pm = t >> 2; u.pn = t & 3; u.aux = br;
        u.a = BR + (size_t)u.pm * 256 * 2048 * 2 + (size_t)br * 512 * 2; u.b = W + (size_t)br * DM * 512 * 2 + (size_t)u.pn * 256 * 512 * 2; return true;
    }
};
struct SchedMoe {
    const char *A, *W; const int* off; size_t tA, wE, wT; int npan, NJ, G, c;
    __device__ __forceinline__ bool next(int i, Unit& u) const {
        const int L = i * G + c; if (L >= npan * NJ) return false;
        const int p = L / NJ, j = L % NJ; int e = 0;
#pragma unroll 1
        for (int q = 1; q < 32; ++q) if (p * 256 >= off[q]) e = q;
        e = __builtin_amdgcn_readfirstlane(e);
        u.pm = p; u.pn = j; u.aux = e; u.a = A + (size_t)p * tA; u.b = W + (size_t)e * wE + (size_t)j * wT; return true;
    }
};

#define PG_ROWCOL const int row0 = u.pm * BM + wr * 64 + fr, col0 = u.pn * BM + wc * 32 + 4 * fq
struct EpiG1 { bf16_t *P1, *VT; const float* rtab; const float* lbp; int layer;
    __device__ __forceinline__ void operator()(const f32x4 (&acc)[2][2][4][2], const Unit& u, int wr, int wc, int fr, int fq) const {
        const int row0 = u.pm * BM + wr * 64 + fr;
        if (u.aux || (u.pn >= 8 && u.pn <= 10)) {
            const int col0 = u.pn * BM + wc * 32 + 4 * fq; bf16_t* base = u.aux ? VT : P1; const size_t ld = u.aux ? (size_t)NROW : (size_t)NP1;
            const bool rope = !u.aux && (u.pm < NTOK / 256);
#pragma unroll
            for (int ai = 0; ai < 2; ++ai)
#pragma unroll
                for (int m = 0; m < 4; ++m) { const int r = row0 + ai * HALF + m * 16; bf16_t* rowp = base + (size_t)r * ld + col0;
#pragma unroll
                    for (int bj = 0; bj < 2; ++bj) {
                        f32x4 v0 = acc[ai][bj][m][0], v1 = acc[ai][bj][m][1];
                        if (rope && !(u.pn == 10 && bj == 1)) {
                            const int pos = r & (SEQ - 1), pp = (wc & 1) ? (pos & 63) : (pos >> 6); const float* tp = rtab + (pp * 16 + 4 * fq) * 2;
                            const f32x4 t0 = *(const f32x4*)tp, t1 = *(const f32x4*)(tp + 4);
                            const f32x4 a = v0, b = v1;
                            v0.x = a.x * t0.x - b.x * t0.y; v1.x = a.x * t0.y + b.x * t0.x; v0.y = a.y * t0.z - b.y * t0.w; v1.y = a.y * t0.w + b.y * t0.z;
                            v0.z = a.z * t1.x - b.z * t1.y; v1.z = a.z * t1.y + b.z * t1.x; v0.w = a.w * t1.z - b.w * t1.w; v1.w = a.w * t1.w + b.w * t1.z;
                        }
                        u32x2 o; o.x = pk2(v0.x, v0.y); o.y = pk2(v0.z, v0.w); *(u32x2*)(rowp + bj * HALF) = o;
                        o.x = pk2(v1.x, v1.y); o.y = pk2(v1.z, v1.w); *(u32x2*)(rowp + bj * HALF + 16) = o; } }
            return;
        }
        const int col0 = u.pn * BM + wc * 32 + 8 * fq;
        const int mode = (u.pn == 11 || u.pn == 12) ? 2 : ((u.pn >= 13 && u.pn <= 16) ? 3 : 0);
#pragma unroll
        for (int ai = 0; ai < 2; ++ai)
#pragma unroll
            for (int m = 0; m < 4; ++m) { bf16_t* rowp = P1 + (size_t)(row0 + ai * HALF + m * 16) * NP1 + col0;
#pragma unroll
                for (int bj = 0; bj < 2; ++bj) {
                    f32x4 v0 = acc[ai][bj][m][0], v1 = acc[ai][bj][m][1];
                    if (mode == 2) {
#pragma unroll
                        for (int j = 0; j < 4; ++j) { v0[j] = v0[j] * __builtin_amdgcn_rcpf(1.f + __expf(-v0[j])); v1[j] = v1[j] * __builtin_amdgcn_rcpf(1.f + __expf(-v1[j])); }
                    } else if (mode == 3) {
                        const int z = (u.pn - 13) >> 1, cb = z * 512 + ((u.pn - 13) & 1) * 256 + bj * HALF + wc * 32 + 8 * fq;
#pragma unroll
                        for (int n = 0; n < 2; ++n)
#pragma unroll
                            for (int j = 0; j < 4; ++j) { const float f = n ? v1[j] : v0[j]; const float t = __expf(-fabsf(f)), rr = __builtin_amdgcn_rcpf(1.f + t); float gq;
                                if (layer == 0) gq = fminf(f, 0.f) + __logf(rr);
                                else { const float lb = lbp[cb + 4 * n + j]; gq = __logf(lb + (1.f - lb) * ((f >= 0.f) ? rr : t * rr)); }
                                if (n) v1[j] = gq; else v0[j] = gq; }
                    }
                    u32x4 o; o.x = pk2(v0.x, v0.y); o.y = pk2(v0.z, v0.w); o.z = pk2(v1.x, v1.y); o.w = pk2(v1.z, v1.w); *(u32x4*)(rowp + bj * HALF) = o; } }
    }
};
#define PG_ROWCOL8 const int row0 = u.pm * BM + wr * 64 + fr, col0 = u.pn * BM + wc * 32 + 8 * fq
struct EpiGate { bf16_t* G;
    __device__ __forceinline__ void operator()(const f32x4 (&acc)[2][2][4][2], const Unit& u, int wr, int wc, int fr, int fq) const {
        PG_ROWCOL8;
#pragma unroll
        for (int ai = 0; ai < 2; ++ai)
#pragma unroll
            for (int m = 0; m < 4; ++m) { bf16_t* rowp = G + (size_t)(row0 + ai * HALF + m * 16) * NGATE + col0;
#pragma unroll
                for (int bj = 0; bj < 2; ++bj) { const f32x4 v0 = acc[ai][bj][m][0], v1 = acc[ai][bj][m][1]; u32x4 o;
                    o.x = pk2(sigmoidf_(v0.x), sigmoidf_(v0.y)); o.y = pk2(sigmoidf_(v0.z), sigmoidf_(v0.w)); o.z = pk2(sigmoidf_(v1.x), sigmoidf_(v1.y)); o.w = pk2(sigmoidf_(v1.z), sigmoidf_(v1.w));
                    *(u32x4*)(rowp + bj * HALF) = o; } }
    }
};
struct EpiMerge { const bf16_t* G; bf16_t* O;
    __device__ __forceinline__ void operator()(const f32x4 (&acc)[2][2][4][2], const Unit& u, int wr, int wc, int fr, int fq) const {
        PG_ROWCOL8; const int br = u.aux;
#pragma unroll
        for (int ai = 0; ai < 2; ++ai) {
            u32x4 g4[4][2], o4[4][2];
#pragma unroll
            for (int m = 0; m < 4; ++m) { const size_t r = (size_t)(row0 + ai * HALF + m * 16); const bf16_t* gp = G + r * NGATE + br * 1024 + col0; const bf16_t* rowp = O + r * DM + col0;
#pragma unroll
                for (int bj = 0; bj < 2; ++bj) { g4[m][bj] = *(const u32x4*)(gp + bj * HALF); if (br != 0) o4[m][bj] = *(const u32x4*)(rowp + bj * HALF); } }
#pragma unroll
            for (int m = 0; m < 4; ++m) { bf16_t* rowp = O + (size_t)(row0 + ai * HALF + m * 16) * DM + col0;
#pragma unroll
                for (int bj = 0; bj < 2; ++bj) { const f32x4 v0 = acc[ai][bj][m][0], v1 = acc[ai][bj][m][1]; const u32x4 gg = g4[m][bj];
                    float w[8] = {__uint_as_float(gg.x << 16) * v0.x, __uint_as_float(gg.x & 0xffff0000u) * v0.y, __uint_as_float(gg.y << 16) * v0.z, __uint_as_float(gg.y & 0xffff0000u) * v0.w,
                                  __uint_as_float(gg.z << 16) * v1.x, __uint_as_float(gg.z & 0xffff0000u) * v1.y, __uint_as_float(gg.w << 16) * v1.z, __uint_as_float(gg.w & 0xffff0000u) * v1.w};
                    if (br != 0) { const u32x4 oo = o4[m][bj];
                        w[0] += __uint_as_float(oo.x << 16); w[1] += __uint_as_float(oo.x & 0xffff0000u); w[2] += __uint_as_float(oo.y << 16); w[3] += __uint_as_float(oo.y & 0xffff0000u);
                        w[4] += __uint_as_float(oo.z << 16); w[5] += __uint_as_float(oo.z & 0xffff0000u); w[6] += __uint_as_float(oo.w << 16); w[7] += __uint_as_float(oo.w & 0xffff0000u); }
                    u32x4 o; o.x = pk2(w[0], w[1]); o.y = pk2(w[2], w[3]); o.z = pk2(w[4], w[5]); o.w = pk2(w[6], w[7]); *(u32x4*)(rowp + bj * HALF) = o; } }
            asm volatile("" ::: "memory");
        }
    }
};
struct EpiWout { const float *xlat, *xctx; float *olat, *octx; const float* modl;
    __device__ __forceinline__ void operator()(const f32x4 (&acc)[2][2][4][2], const Unit& u, int wr, int wc, int fr, int fq) const {
        PG_ROWCOL; const bool lat = u.pm < NTOK / 256; const int rb = lat ? (u.pm >> 4) : 4;
        const float* xin = lat ? xlat : xctx - (size_t)NTOK * DM; float* xo = lat ? olat : octx - (size_t)NTOK * DM; const float* m2 = modl + (size_t)rb * 6144 + 2 * 1024 + col0;
        f32x4 mv[2][2];
#pragma unroll
        for (int bj = 0; bj < 2; ++bj)
#pragma unroll
            for (int n = 0; n < 2; ++n) mv[bj][n] = *(const f32x4*)(m2 + bj * HALF + n * 16);
#pragma unroll
        for (int aq = 0; aq < 4; ++aq) { const int ai = aq >> 1, m0 = (aq & 1) * 2;
            f32x4 xv[4][2][2];
#pragma unroll
            for (int m = m0; m < m0 + 2; ++m) { const size_t o = (size_t)(row0 + ai * HALF + m * 16) * DM + col0;
#pragma unroll
                for (int bj = 0; bj < 2; ++bj)
#pragma unroll
                    for (int n = 0; n < 2; ++n) xv[m][bj][n] = *(const f32x4*)(xin + o + bj * HALF + n * 16); }
#pragma unroll
            for (int m = m0; m < m0 + 2; ++m) { const size_t o = (size_t)(row0 + ai * HALF + m * 16) * DM + col0;
#pragma unroll
                for (int bj = 0; bj < 2; ++bj)
#pragma unroll
                    for (int n = 0; n < 2; ++n) *(f32x4*)(xo + o + bj * HALF + n * 16) = ALPHA * xv[m][bj][n] + mv[bj][n] * acc[ai][bj][m][n]; }
            asm volatile("" ::: "memory");
        }
    }
};
struct EpiMoe1 { bf16_t* HID; const float* roww;
    __device__ __forceinline__ void operator()(const f32x4 (&acc)[2][2][4][2], const Unit& u, int wr, int wc, int fr, int fq) const {
        const int row0 = u.pm * BM + wr * 64 + fr, hc0 = u.pn * 128 + wc * 32 + 8 * fq;
#pragma unroll
        for (int ai = 0; ai < 2; ++ai)
#pragma unroll
            for (int m = 0; m < 4; ++m) { const int r = row0 + ai * HALF + m * 16; const float w = roww[r];
                const f32x4 g0 = acc[ai][0][m][0], g1 = acc[ai][0][m][1], u0 = acc[ai][1][m][0], u1 = acc[ai][1][m][1]; u32x4 o;
                o.x = pk2(siluf_(g0.x) * u0.x * w, siluf_(g0.y) * u0.y * w); o.y = pk2(siluf_(g0.z) * u0.z * w, siluf_(g0.w) * u0.w * w);
                o.z = pk2(siluf_(g1.x) * u1.x * w, siluf_(g1.y) * u1.y * w); o.w = pk2(siluf_(g1.z) * u1.z * w, siluf_(g1.w) * u1.w * w);
                *(u32x4*)(HID + (size_t)r * 256 + hc0) = o; }
    }
};
struct EpiMoe2 { bf16_t* Y; const int* rmap; bf16_t* dump;
    __device__ __forceinline__ void operator()(const f32x4 (&acc)[2][2][4][2], const Unit& u, int wr, int wc, int fr, int fq) const {
        PG_ROWCOL8;
#pragma unroll
        for (int ai = 0; ai < 2; ++ai)
#pragma unroll
            for (int m = 0; m < 4; ++m) { const int s = rmap[row0 + ai * HALF + m * 16];
                bf16_t* rowp = (s >= 0 ? Y + (size_t)s * DM : dump) + col0;
#pragma unroll
                for (int bj = 0; bj < 2; ++bj) { const f32x4 v0 = acc[ai][bj][m][0], v1 = acc[ai][bj][m][1]; u32x4 o; o.x = pk2(v0.x, v0.y); o.y = pk2(v0.z, v0.w); o.z = pk2(v1.x, v1.y); o.w = pk2(v1.z, v1.w); *(u32x4*)(rowp + bj * HALF) = o; } }
    }
};
#undef PG_ROWCOL8
#undef PG_ROWCOL
}

__device__ __forceinline__ void moe_offsets(Frame& F, int l, int* off) {
    if (F.tid < 64) {
        int v = (F.tid < 32) ? (((int)F.cnt()[l * 32 + F.tid] + 255) & ~255) : 0;
#pragma unroll
        for (int o = 1; o < 32; o <<= 1) { const int t = __shfl_up(v, o); if ((F.tid & 63) >= o) v += t; }
        if (F.tid < 32) off[F.tid + 1] = v;
        if (F.tid == 0) off[0] = 0;
    }
    __syncthreads();
}

__device__ __forceinline__ void phase_rope(Frame& F) {
    float* tab = F.smf;
    for (int e = F.tid; e < 1024; e += NTHR) { const int pp = e >> 4, i = e & 15; const float inv = powf(10000.f, -(float)i / 16.f), ang = (float)pp * inv; tab[2 * e] = cosf(ang); tab[2 * e + 1] = sinf(ang); }
    __syncthreads();
    const size_t total = (size_t)NTOK * 320;
    for (size_t idx = (size_t)F.bid * NTHR + F.tid; idx < total; idx += (size_t)F.nb * NTHR) {
        const int row = (int)(idx / 320), r = (int)(idx % 320), h = r >> 5, half = (r >> 4) & 1, i = r & 15;
        const int pos = row & (SEQ - 1), pp = half ? (pos & 63) : (pos >> 6);
        const float cs = tab[2 * (pp * 16 + i)], sn = tab[2 * (pp * 16 + i) + 1];
        bf16_t* base = F.P1() + (size_t)row * NP1 + (h < 8 ? PC_CQ + h * 64 : PC_CK + (h - 8) * 64) + half * 32 + i;
        const float u1 = bf2f(base[0]), u2 = bf2f(base[16]);
        base[0] = f2bf(u1 * cs - u2 * sn); base[16] = f2bf(u1 * sn + u2 * cs);
    }
}

__device__ __forceinline__ int seq_row(int s, int b, int z) {
    if (s < LC) { const int tc = z ? (LC - 1 - s) : s; return NTOK + b * LC + tc; }
    const int tl = s - LC, t = z ? (SEQ - 1 - tl) : tl; return b * SEQ + t;
}
typedef short bf16x8_t __attribute__((ext_vector_type(8)));
typedef short bf16x4_t __attribute__((ext_vector_type(4)));
struct MaskNone { __device__ __forceinline__ void operator()(f32x4&, f32x4&) const {} };
struct MaskNA { int u0; const float* brow;
    __device__ __forceinline__ void operator()(f32x4& s0, f32x4& s1) const {
        float v[8] = {s0.x, s0.y, s0.z, s0.w, s1.x, s1.y, s1.z, s1.w};
#pragma unroll
        for (int T = 0; T < 2; ++T)
#pragma unroll
            for (int rr = 0; rr < 4; ++rr) v[T * 4 + rr] = ((unsigned)(u0 + 16 * T + rr) < 16u) ? v[T * 4 + rr] + brow[16 * T + rr] : -INFINITY;
        s0 = (f32x4){v[0], v[1], v[2], v[3]}; s1 = (f32x4){v[4], v[5], v[6], v[7]};
    }
};
struct MaskWA { int i, j0;
    __device__ __forceinline__ void operator()(f32x4& s0, f32x4& s1) const {
        float v[8] = {s0.x, s0.y, s0.z, s0.w, s1.x, s1.y, s1.z, s1.w};
#pragma unroll
        for (int T = 0; T < 2; ++T)
#pragma unroll
            for (int rr = 0; rr < 4; ++rr) { const int j = j0 + 16 * T + rr; const bool ok = (j >= 0) && (j < SEQ) && (i - j <= 128) && (j - i <= 128);
                v[T * 4 + rr] = ok ? v[T * 4 + rr] : -INFINITY; }
        s0 = (f32x4){v[0], v[1], v[2], v[3]}; s1 = (f32x4){v[4], v[5], v[6], v[7]};
    }
};
struct KVF { bf16x8_t k[4]; bf16x4_t v[4][2]; };
__device__ __forceinline__ void kv_load(KVF& f, const char* kbase, unsigned ko0, unsigned ko1, const char* vbase, unsigned vo0, unsigned vo1) {
    f.k[0] = *(const bf16x8_t*)(kbase + ko0); f.k[1] = *(const bf16x8_t*)(kbase + ko0 + 64); f.k[2] = *(const bf16x8_t*)(kbase + ko1); f.k[3] = *(const bf16x8_t*)(kbase + ko1 + 64);
#pragma unroll
    for (int t = 0; t < 4; ++t) { f.v[t][0] = *(const bf16x4_t*)(vbase + vo0 + (unsigned)t * 16u * NROW * 2u); f.v[t][1] = *(const bf16x4_t*)(vbase + vo1 + (unsigned)t * 16u * NROW * 2u); }
}
__device__ __forceinline__ float xmax_g(float x) {
    auto r = __builtin_amdgcn_permlane16_swap(__float_as_uint(x), __float_as_uint(x), false, false); x = fmaxf(__uint_as_float(r[0]), __uint_as_float(r[1]));
    auto q = __builtin_amdgcn_permlane32_swap(__float_as_uint(x), __float_as_uint(x), false, false); return fmaxf(__uint_as_float(q[0]), __uint_as_float(q[1])); }
__device__ __forceinline__ float xsum_g(float x) {
    auto r = __builtin_amdgcn_permlane16_swap(__float_as_uint(x), __float_as_uint(x), false, false); x = __uint_as_float(r[0]) + __uint_as_float(r[1]);
    auto q = __builtin_amdgcn_permlane32_swap(__float_as_uint(x), __float_as_uint(x), false, false); return __uint_as_float(q[0]) + __uint_as_float(q[1]); }
template <class MaskF>
__device__ __forceinline__ void attn_tile(float& am, float& al, f32x4 (&ao)[4], const bf16x8_t (&qb)[2], const KVF& f, const MaskF& maskf) {
    f32x4 s0 = {0.f, 0.f, 0.f, 0.f}, s1 = {0.f, 0.f, 0.f, 0.f};
    s0 = __builtin_amdgcn_mfma_f32_16x16x32_bf16(f.k[0], qb[0], s0, 0, 0, 0); s0 = __builtin_amdgcn_mfma_f32_16x16x32_bf16(f.k[1], qb[1], s0, 0, 0, 0);
    s1 = __builtin_amdgcn_mfma_f32_16x16x32_bf16(f.k[2], qb[0], s1, 0, 0, 0); s1 = __builtin_amdgcn_mfma_f32_16x16x32_bf16(f.k[3], qb[1], s1, 0, 0, 0);
    maskf(s0, s1);
    const float mx = xmax_g(fmaxf(fmaxf(fmaxf(s0.x, s0.y), fmaxf(s0.z, s0.w)), fmaxf(fmaxf(s1.x, s1.y), fmaxf(s1.z, s1.w))));
    const float mn = fmaxf(am, mx);
    if (__any(mn != am)) {
        const float alpha = __builtin_amdgcn_exp2f(am - mn); am = mn; al *= alpha;
#pragma unroll
        for (int t = 0; t < 4; ++t) ao[t] = ao[t] * alpha;
    }
    f32x4 p0, p1;
    p0.x = __builtin_amdgcn_exp2f(s0.x - am); p0.y = __builtin_amdgcn_exp2f(s0.y - am); p0.z = __builtin_amdgcn_exp2f(s0.z - am); p0.w = __builtin_amdgcn_exp2f(s0.w - am);
    p1.x = __builtin_amdgcn_exp2f(s1.x - am); p1.y = __builtin_amdgcn_exp2f(s1.y - am); p1.z = __builtin_amdgcn_exp2f(s1.z - am); p1.w = __builtin_amdgcn_exp2f(s1.w - am);
    al += ((p0.x + p0.y) + (p0.z + p0.w)) + ((p1.x + p1.y) + (p1.z + p1.w));
    union { bf16x8_t v; unsigned u[4]; } pb;
    pb.u[0] = pk2(p0.x, p0.y); pb.u[1] = pk2(p0.z, p0.w); pb.u[2] = pk2(p1.x, p1.y); pb.u[3] = pk2(p1.z, p1.w);
#pragma unroll
    for (int t = 0; t < 4; ++t) {
        union { bf16x8_t v; bf16x4_t h[2]; } av; av.h[0] = f.v[t][0]; av.h[1] = f.v[t][1];
        ao[t] = __builtin_amdgcn_mfma_f32_16x16x32_bf16(av.v, pb.v, ao[t], 0, 0, 0);
    }
}
template <int kind>
__device__ __forceinline__ void attn_multi(Frame& F, int l, int item, const float* rpb_s) {
    constexpr int NQ = 2;
    constexpr int NLOC = (kind == 0) ? 9 : (kind == 1 ? 9 : 0), NS = 8 + NLOC;
    const int lane = F.lane, n = lane & 15, g = lane >> 4;
    const bf16_t* P1 = F.P1(); const bf16_t* VT = F.VT();
    int b, h0, kvh = 0, kcol, vrow, r = 0, cb = 0, t0 = 0, qrow0, qcol0, brcol0;
    constexpr int QRS = (kind == 0) ? 64 : (kind == 2 ? 16 : 0), QCS = (kind == 1 || kind == 3) ? 64 : 0;
    if (kind == 0) { cb = item & 3; r = ((item >> 2) & 31) * 2; h0 = (item >> 7) & 7; b = item >> 10; kcol = PC_BK + h0 * 64; vrow = h0 * 64; qrow0 = b * SEQ + r * 64 + cb * 16; qcol0 = PC_BQ + h0 * 64; brcol0 = 512 + h0 * 64; }
    else if (kind == 1) { const int hp = item & 1, qt = (item >> 1) & 255; kvh = (item >> 9) & 1; b = item >> 10; h0 = kvh * 4 + hp * 2; t0 = qt * 16; kcol = PC_CK + kvh * 64; vrow = 512 + kvh * 64; qrow0 = b * SEQ + t0; qcol0 = PC_CQ + h0 * 64; brcol0 = 1024 + h0 * 64; }
    else if (kind == 2) { const int qp = item & 7; h0 = (item >> 3) & 7; b = item >> 6; kcol = PC_BK + h0 * 64; vrow = h0 * 64; qrow0 = NTOK + b * LC + qp * 32; qcol0 = PC_BQ + h0 * 64; brcol0 = 512 + h0 * 64; }
    else { const int hp = item & 1, qt = (item >> 1) & 15; kvh = (item >> 5) & 1; b = item >> 6; h0 = kvh * 4 + hp * 2; kcol = PC_CK + kvh * 64; vrow = 512 + kvh * 64; qrow0 = NTOK + b * LC + qt * 16; qcol0 = PC_CQ + h0 * 64; brcol0 = 1024 + h0 * 64; }
    bf16x8_t qb[NQ][2]; float am[NQ], al[NQ]; f32x4 ao[NQ][4];
    { const char* qbase = (const char*)P1; const unsigned qo = (unsigned)(qrow0 + n) * (unsigned)(NP1 * 2) + (unsigned)(qcol0 + 8 * g) * 2u;
#pragma unroll
      for (int q = 0; q < NQ; ++q) { const unsigned o = qo + (unsigned)q * (unsigned)(QRS * NP1 * 2 + QCS * 2); qb[q][0] = *(const bf16x8_t*)(qbase + o); qb[q][1] = *(const bf16x8_t*)(qbase + o + 64);
        am[q] = -1e30f; al[q] = 0.f;
#pragma unroll
        for (int t = 0; t < 4; ++t) ao[q][t] = (f32x4){0.f, 0.f, 0.f, 0.f}; } }
    const int crow0 = NTOK + b * LC;
    const int w0 = (cb == 0) ? 0 : (cb == 1 ? 8 : (cb == 2 ? 24 : 32)), ru = min(max(r - 4, 0), 56);
    const char* kbase = (const char*)P1; const char* vbase = (const char*)VT;
    const unsigned kl = (unsigned)(kcol + 8 * g) * 2u, vl = (unsigned)(vrow + n) * (unsigned)NROW * 2u;
    auto load_step = [&](KVF& f, int s) {
        if (s < 8) { const unsigned ko = (unsigned)(crow0 + 32 * s + n) * (unsigned)(NP1 * 2) + kl, vo = vl + (unsigned)(crow0 + 32 * s + 4 * g) * 2u;
            kv_load(f, kbase, ko, ko + 16u * NP1 * 2u, vbase, vo, vo + 32u); }
        else if (kind == 0) { const int tok0 = b * SEQ + min(ru + (s - 8), 63) * 64 + w0; const unsigned ko = (unsigned)(tok0 + n) * (unsigned)(NP1 * 2) + kl, vo = vl + (unsigned)(tok0 + 4 * g) * 2u;
            kv_load(f, kbase, ko, ko + 16u * NP1 * 2u, vbase, vo, vo + 32u); }
        else if (kind == 1) { const int kb = t0 - 128 + 32 * (s - 8);
            const int ja = min(max(kb + n, 0), SEQ - 1), jb = min(max(kb + 16 + n, 0), SEQ - 1), va = min(max(kb + 4 * g, 0), SEQ - 4), vb = min(max(kb + 16 + 4 * g, 0), SEQ - 4);
            kv_load(f, kbase, (unsigned)(b * SEQ + ja) * (unsigned)(NP1 * 2) + kl, (unsigned)(b * SEQ + jb) * (unsigned)(NP1 * 2) + kl, vbase, vl + (unsigned)(b * SEQ + va) * 2u, vl + (unsigned)(b * SEQ + vb) * 2u); }
    };
    auto compute_step = [&](const KVF& f, int s) {
        if (s < 8) {
#pragma unroll
            for (int q = 0; q < NQ; ++q) { attn_tile(am[q], al[q], ao[q], qb[q], f, MaskNone()); if (NQ == 4) __builtin_amdgcn_sched_barrier(0); }
        } else if (kind == 0) {
            const int kr = ru + (s - 8);
#pragma unroll
            for (int q = 0; q < NQ; ++q) { const int rq = r + q, rsq = min(max(rq - 4, 0), 56);
                if (kr >= rsq && kr <= rsq + 7) { const int c = cb * 16 + n, csq = min(max(c - 8, 0), 48), kc0 = w0 + 4 * g;
                    MaskNA mk{kc0 - csq, rpb_s + (h0 * 15 + (kr - rq + 7)) * 64 + (kc0 - c + 15 + 16)}; attn_tile(am[q], al[q], ao[q], qb[q], f, mk); } }
        } else if (kind == 1) {
            const int ls = s - 8, kb = t0 - 128 + 32 * ls;
            if (ls >= 1 && ls <= 7 && kb >= 0 && kb + 31 < SEQ) {
#pragma unroll
                for (int q = 0; q < NQ; ++q) attn_tile(am[q], al[q], ao[q], qb[q], f, MaskNone());
            } else {
                MaskWA mk{t0 + n, kb + 4 * g};
#pragma unroll
                for (int q = 0; q < NQ; ++q) attn_tile(am[q], al[q], ao[q], qb[q], f, mk);
            }
        }
    };
    if (NQ == 2) {
        KVF fa, fb;
        load_step(fa, 0);
#pragma unroll 1
        for (int s = 0; s < NS; s += 2) {
            if (s + 1 < NS) load_step(fb, s + 1);
            compute_step(fa, s);
            if (s + 1 < NS) { if (s + 2 < NS) load_step(fa, s + 2); compute_step(fb, s + 1); }
        }
    } else {
        KVF fa;
#pragma unroll 1
        for (int s = 0; s < NS; ++s) { load_step(fa, s); compute_step(fa, s); }
    }
#pragma unroll
    for (int q = 0; q < NQ; ++q) {
        float lt = xsum_g(al[q]);
        float osc = 1.f;
        if (kind == 1 || kind == 3) { const float sk = F.p.wa_sink[l * 8 + h0 + q] * 1.44269504089f, mf = fmaxf(am[q], sk); osc = __builtin_amdgcn_exp2f(am[q] - mf); lt = lt * osc + __builtin_amdgcn_exp2f(sk - mf); }
        const float inv = osc / lt;
        char* obase = (char*)F.BR(); const unsigned oo = (unsigned)(qrow0 + q * QRS + n) * 4096u + (unsigned)(brcol0 + q * QCS + 4 * g) * 2u;
#pragma unroll
        for (int t = 0; t < 4; ++t) { const f32x4 v = ao[q][t] * inv; u32x2 o2; o2.x = pk2(v.x, v.y); o2.y = pk2(v.z, v.w); *(u32x2*)(obase + oo + 32u * t) = o2; }
    }
}

template <int DK, bool HG>
__device__ __forceinline__ void scan_mfma(Frame& F, int l, int b, int h, int z, unsigned char* lds) {
    constexpr int NDP = DK / 2, NTG = NTHR / NDP, TPT = 64 / NTG, QS = DK + 8, TS = 72, NDT = DK / 16;
    bf16_t* QD = (bf16_t*)lds; bf16_t* KD = QD + 64 * QS; bf16_t* KDT = KD + 64 * QS; bf16_t* VTs = KDT + DK * TS; bf16_t* AM = VTs + 128 * TS; bf16_t* ST = AM + 64 * TS;
    float* TOT = (float*)(ST + 128 * QS); float* E1s = TOT + NTG * DK; float* E2s = E1s + DK;
    REFRESH(F);
    const int tid = F.tid, lane = F.lane, w = F.wave, n = lane & 15, g = lane >> 4;
    const int dp = tid % NDP, tg = tid / NDP, vp = tid & 63, vg = tid >> 6;
    const bf16_t* P1 = F.P1();
    float lw[HG ? 2 : 32], lbias[2] = {0.f, 0.f}, lbv[2] = {0.f, 0.f};
    if (!HG) {
#pragma unroll
        for (int r = 0; r < 16; ++r) { const float* wp = F.p.gla_lr_w + ((size_t)(l * 2 + z) * 16 + r) * 256 + h * 64 + 2 * dp; lw[2 * r] = wp[0]; lw[2 * r + 1] = wp[1]; }
        lbias[0] = F.p.gla_lr_b[(l * 2 + z) * 256 + h * 64 + 2 * dp]; lbias[1] = F.p.gla_lr_b[(l * 2 + z) * 256 + h * 64 + 2 * dp + 1];
    } else { lw[0] = lw[1] = 0.f; if (l != 0) { lbv[0] = F.lb()[z * 512 + h * 128 + 2 * dp]; lbv[1] = F.lb()[z * 512 + h * 128 + 2 * dp + 1]; } }
    f32x4 accS[NDT];
#pragma unroll
    for (int i = 0; i < NDT; ++i) accS[i] = (f32x4){0.f, 0.f, 0.f, 0.f};
    unsigned rq[TPT], rk[TPT], rv[8]; u32x4 rl[HG ? 1 : TPT][2];
    const int qcol = HG ? PC_DQ + h * 128 + 2 * dp : PC_AQ + h * 64 + 2 * dp, kcol = HG ? PC_DF + z * 512 + h * 128 + 2 * dp : PC_AK + h * 64 + 2 * dp;
    const int vcol = (HG ? PC_DI : PC_AV) + h * 128 + 2 * vp;
    const char* p1b = (const char*)P1; const int sgn = z ? -1 : 1; const int rstep = sgn * NP1 * 2;
#define SCAN_LOAD(c) do { const int row0_ = seq_row((c) * 64, b, z); \
        int o_ = (row0_ + sgn * tg * TPT) * (NP1 * 2); \
        _Pragma("unroll") for (int tt = 0; tt < TPT; ++tt) { rq[tt] = *(const unsigned*)(p1b + (unsigned)(o_ + qcol * 2)); rk[tt] = *(const unsigned*)(p1b + (unsigned)(o_ + kcol * 2)); \
            if (!HG) { rl[tt][0] = *(const u32x4*)(p1b + (unsigned)(o_ + (PC_ALR + z * 16) * 2)); rl[tt][1] = *(const u32x4*)(p1b + (unsigned)(o_ + (PC_ALR + z * 16 + 8) * 2)); } o_ += rstep; } \
        int ov_ = (row0_ + sgn * vg * 8) * (NP1 * 2) + vcol * 2; \
        _Pragma("unroll") for (int tt = 0; tt < 8; ++tt) { rv[tt] = *(const unsigned*)(p1b + (unsigned)ov_); ov_ += rstep; } } while (0)
    SCAN_LOAD(0);
    constexpr int NCH = (LC + SEQ) / 64;
#pragma unroll 1
    for (int c = 0; c < NCH; ++c) {
        float qv[TPT][2], kv[TPT][2], cs[TPT][2];
#pragma unroll
        for (int tt = 0; tt < TPT; ++tt)
#pragma unroll
            for (int e = 0; e < 2; ++e) {
                const float qr = __uint_as_float(e ? (rq[tt] & 0xffff0000u) : (rq[tt] << 16)), kr = __uint_as_float(e ? (rk[tt] & 0xffff0000u) : (rk[tt] << 16));
                float gg;
                if (HG) {
                    gg = kr;
                    kv[tt][e] = 1.f - __expf(kr);
                    qv[tt][e] = qr;
                } else {
                    float lg = lbias[e];
                    const unsigned lr8[8] = {rl[tt][0].x, rl[tt][0].y, rl[tt][0].z, rl[tt][0].w, rl[tt][1].x, rl[tt][1].y, rl[tt][1].z, rl[tt][1].w};
#pragma unroll
                    for (int r2 = 0; r2 < 8; ++r2) { lg += __uint_as_float(lr8[r2] << 16) * lw[(2 * r2) * 2 + e]; lg += __uint_as_float(lr8[r2] & 0xffff0000u) * lw[(2 * r2 + 1) * 2 + e]; }
                    const float t = __expf(-fabsf(lg)), r = __builtin_amdgcn_rcpf(1.f + t);
                    gg = (fminf(lg, 0.f) + __logf(r)) * (1.f / 16.f);
                    kv[tt][e] = kr; qv[tt][e] = qr;
                }
                cs[tt][e] = gg + (tt ? cs[tt ? tt - 1 : 0][e] : 0.f);
            }
        TOT[tg * DK + 2 * dp] = cs[TPT - 1][0]; TOT[tg * DK + 2 * dp + 1] = cs[TPT - 1][1];
        __syncthreads();
        float offs[2] = {0.f, 0.f}, mid[2] = {0.f, 0.f}, lastv[2] = {0.f, 0.f};
#pragma unroll
        for (int t2 = 0; t2 < NTG; ++t2)
#pragma unroll
            for (int e = 0; e < 2; ++e) { const float tv = TOT[t2 * DK + 2 * dp + e]; if (t2 < tg) offs[e] += tv; if (t2 < NTG / 2) mid[e] += tv; lastv[e] += tv; }
        unsigned kdt[2][TPT / 2]; float kprev[2] = {0.f, 0.f};
#pragma unroll
        for (int tt = 0; tt < TPT; ++tt) {
            float qd[2], kd[2];
#pragma unroll
            for (int e = 0; e < 2; ++e) { const float x = fminf(fmaxf(cs[tt][e] + offs[e] - mid[e], -80.f), 80.f); qd[e] = qv[tt][e] * __expf(x); kd[e] = kv[tt][e] * __expf(-x); }
            const int tok = tg * TPT + tt;
            *(unsigned*)(QD + tok * QS + 2 * dp) = pk2(qd[0], qd[1]); *(unsigned*)(KD + tok * QS + 2 * dp) = pk2(kd[0], kd[1]);
            if (tt & 1) { kdt[0][tt >> 1] = pk2(kprev[0], kd[0]); kdt[1][tt >> 1] = pk2(kprev[1], kd[1]); } else { kprev[0] = kd[0]; kprev[1] = kd[1]; }
        }
#pragma unroll
        for (int e = 0; e < 2; ++e) {
            bf16_t* dst = KDT + (2 * dp + e) * TS + tg * TPT;
            if (TPT == 8) { u32x4 o; o.x = kdt[e][0]; o.y = kdt[e][1]; o.z = kdt[e][TPT / 2 - 2]; o.w = kdt[e][TPT / 2 - 1]; *(u32x4*)dst = o; }
            else { u32x2 o; o.x = kdt[e][0]; o.y = kdt[e][1]; *(u32x2*)dst = o; }
        }
        if (tg == 0) { E1s[2 * dp] = __expf(mid[0]); E1s[2 * dp + 1] = __expf(mid[1]); E2s[2 * dp] = __expf(lastv[0] - mid[0]); E2s[2 * dp + 1] = __expf(lastv[1] - mid[1]); }
        {   u32x4 o0, o1;
            o0.x = (rv[0] & 0xffffu) | (rv[1] << 16); o0.y = (rv[2] & 0xffffu) | (rv[3] << 16); o0.z = (rv[4] & 0xffffu) | (rv[5] << 16); o0.w = (rv[6] & 0xffffu) | (rv[7] << 16);
            o1.x = (rv[0] >> 16) | (rv[1] & 0xffff0000u); o1.y = (rv[2] >> 16) | (rv[3] & 0xffff0000u); o1.z = (rv[4] >> 16) | (rv[5] & 0xffff0000u); o1.w = (rv[6] >> 16) | (rv[7] & 0xffff0000u);
            *(u32x4*)(VTs + (2 * vp) * TS + vg * 8) = o0; *(u32x4*)(VTs + (2 * vp + 1) * TS + vg * 8) = o1; }
        if (c + 1 < NCH) SCAN_LOAD(c + 1);
        __syncthreads();
#pragma unroll
        for (int dt = 0; dt < NDT; ++dt) { accS[dt] = accS[dt] * *(const f32x4*)&E1s[16 * dt + 4 * g];
            u32x2 o; o.x = pk2(accS[dt].x, accS[dt].y); o.y = pk2(accS[dt].z, accS[dt].w); *(u32x2*)(ST + (16 * w + n) * QS + 16 * dt + 4 * g) = o; }
        {   const int it = w >> 1, jt0 = 2 * (w & 1);
            f32x4 d0 = {0.f, 0.f, 0.f, 0.f}, d1 = {0.f, 0.f, 0.f, 0.f};
            if (jt0 <= it) {
                bf16x8_t qf[DK / 32], k0f[DK / 32], k1f[DK / 32];
#pragma unroll
                for (int ks = 0; ks < DK / 32; ++ks) { qf[ks] = *(const bf16x8_t*)(QD + (16 * it + n) * QS + 32 * ks + 8 * g); k0f[ks] = *(const bf16x8_t*)(KD + (16 * jt0 + n) * QS + 32 * ks + 8 * g); k1f[ks] = *(const bf16x8_t*)(KD + (16 * (jt0 + 1) + n) * QS + 32 * ks + 8 * g); }
#pragma unroll
                for (int ks = 0; ks < DK / 32; ++ks) { d0 = __builtin_amdgcn_mfma_f32_16x16x32_bf16(k0f[ks], qf[ks], d0, 0, 0, 0); d1 = __builtin_amdgcn_mfma_f32_16x16x32_bf16(k1f[ks], qf[ks], d1, 0, 0, 0); }
                const int i = 16 * it + n, j0 = 16 * jt0 + 4 * g, j1 = j0 + 16;
                d0.x = (j0 + 0 <= i) ? d0.x : 0.f; d0.y = (j0 + 1 <= i) ? d0.y : 0.f; d0.z = (j0 + 2 <= i) ? d0.z : 0.f; d0.w = (j0 + 3 <= i) ? d0.w : 0.f;
                d1.x = (j1 + 0 <= i) ? d1.x : 0.f; d1.y = (j1 + 1 <= i) ? d1.y : 0.f; d1.z = (j1 + 2 <= i) ? d1.z : 0.f; d1.w = (j1 + 3 <= i) ? d1.w : 0.f;
            }
            u32x2 o; o.x = pk2(d0.x, d0.y); o.y = pk2(d0.z, d0.w); *(u32x2*)(AM + (16 * it + n) * TS + 16 * jt0 + 4 * g) = o;
            o.x = pk2(d1.x, d1.y); o.y = pk2(d1.z, d1.w); *(u32x2*)(AM + (16 * it + n) * TS + 16 * (jt0 + 1) + 4 * g) = o;
        }
        __syncthreads();
        {   f32x4 o[4];
#pragma unroll
            for (int it = 0; it < 4; ++it) o[it] = (f32x4){0.f, 0.f, 0.f, 0.f};
#pragma unroll
            for (int ks = 0; ks < 2; ++ks) { const bf16x8_t af = *(const bf16x8_t*)(VTs + (16 * w + n) * TS + 32 * ks + 8 * g); bf16x8_t bf[4];
#pragma unroll
                for (int it = 0; it < 4; ++it) bf[it] = *(const bf16x8_t*)(AM + (16 * it + n) * TS + 32 * ks + 8 * g);
#pragma unroll
                for (int it = 0; it < 4; ++it) o[it] = __builtin_amdgcn_mfma_f32_16x16x32_bf16(af, bf[it], o[it], 0, 0, 0); }
#pragma unroll
            for (int ks = 0; ks < DK / 32; ++ks) { const bf16x8_t af = *(const bf16x8_t*)(ST + (16 * w + n) * QS + 32 * ks + 8 * g); bf16x8_t bf[4];
#pragma unroll
                for (int it = 0; it < 4; ++it) bf[it] = *(const bf16x8_t*)(QD + (16 * it + n) * QS + 32 * ks + 8 * g);
#pragma unroll
                for (int it = 0; it < 4; ++it) o[it] = __builtin_amdgcn_mfma_f32_16x16x32_bf16(af, bf[it], o[it], 0, 0, 0); }
            const int row0 = seq_row(c * 64, b, z) + sgn * n;
            char* dstb; unsigned doff; int dstride;
            if (HG) { dstb = (char*)F.P1(); doff = (unsigned)row0 * (unsigned)(NP1 * 2) + (unsigned)(PC_DF + z * 512 + h * 128 + 16 * w + 4 * g) * 2u; dstride = sgn * 16 * NP1 * 2; }
            else if (z == 0) { dstb = (char*)F.BR(); doff = (unsigned)row0 * 4096u + (unsigned)(h * 128 + 16 * w + 4 * g) * 2u; dstride = sgn * 16 * 4096; }
            else { dstb = (char*)F.OBA(); doff = (unsigned)row0 * 1024u + (unsigned)(h * 128 + 16 * w + 4 * g) * 2u; dstride = sgn * 16 * 1024; }
#pragma unroll
            for (int it = 0; it < 4; ++it) { u32x2 o2; o2.x = pk2(o[it].x, o[it].y); o2.y = pk2(o[it].z, o[it].w); *(u32x2*)(dstb + (unsigned)((int)doff + it * dstride)) = o2; }
        }
#pragma unroll
        for (int ks = 0; ks < 2; ++ks) { const bf16x8_t bv = *(const bf16x8_t*)(VTs + (16 * w + n) * TS + 32 * ks + 8 * g); bf16x8_t af[NDT];
#pragma unroll
            for (int dt = 0; dt < NDT; ++dt) af[dt] = *(const bf16x8_t*)(KDT + (16 * dt + n) * TS + 32 * ks + 8 * g);
#pragma unroll
            for (int dt = 0; dt < NDT; ++dt) accS[dt] = __builtin_amdgcn_mfma_f32_16x16x32_bf16(af[dt], bv, accS[dt], 0, 0, 0); }
#pragma unroll
        for (int dt = 0; dt < NDT; ++dt) accS[dt] = accS[dt] * *(const f32x4*)&E2s[16 * dt + 4 * g];
        __syncthreads();
    }
#undef SCAN_LOAD
}

__device__ __forceinline__ void phase_mix(Frame& F, int l) {
    const int n_scan = 64;
    const int nsb = (F.nb > 128) ? 64 : 0;
    if (nsb == 0 || F.bid < nsb) {
        for (int it = F.bid; it < n_scan; it += (nsb ? nsb : F.nb)) {
            const int br = it >> 5, r = it & 31, b = r >> 3, h = (r >> 1) & 3, z = r & 1;
            if (br == 0) scan_mfma<64, false>(F, l, b, h, z, (unsigned char*)F.smf); else scan_mfma<128, true>(F, l, b, h, z, (unsigned char*)F.smf);
        }
        __syncthreads();
    }
    float* rpb_s = F.smf;
    for (int i = F.tid; i < 8 * 15 * 64; i += NTHR) { const int dcp = i & 63, hr = i >> 6; rpb_s[i] = (dcp >= 16 && dcp < 47) ? F.p.na_rpb[(size_t)l * 8 * 465 + hr * 31 + (dcp - 16)] * 1.44269504089f : 0.f; }
    __syncthreads();
    unsigned* qhead = F.cnt() + 64 + l * 16;
    const int n_wa = 4096, n_na = 4096, n_cna = (l == 0) ? 256 : 0, n_cwa = (l == 0) ? 256 : 0, total = n_wa + n_na + n_cna + n_cwa;
    for (;;) {
        int it = 0; if (F.lane == 0) it = (int)atomicAdd(qhead, 1u);
        it = __builtin_amdgcn_readfirstlane(it);
        if (it >= total) break;
        if (it < n_wa) attn_multi<1>(F, l, it, rpb_s);
        else if (it < n_wa + n_na) attn_multi<0>(F, l, it - n_wa, rpb_s);
        else if (it < n_wa + n_na + n_cna) attn_multi<2>(F, l, it - n_wa - n_na, rpb_s);
        else attn_multi<3>(F, l, it - n_wa - n_na - n_cna, rpb_s);
    }
}

__device__ __forceinline__ void phase_prepad(Frame& F, int l) {
    const int gw = F.bid * 8 + F.wave, ngw = F.nb * 8, npairs = ((l == 0) ? NROW : NTOK) / 2, c0 = F.lane * 8;
    for (int pi = gw; pi < npairs; pi += ngw) {
        u32x4 ra[2][2], rb[2][2], rg[2][2];
#pragma unroll
        for (int q = 0; q < 2; ++q) { const size_t row = (size_t)pi * 2 + q;
            ra[q][0] = *(const u32x4*)(F.BR() + row * 2048 + c0); rb[q][0] = *(const u32x4*)(F.OBA() + row * 512 + c0); rg[q][0] = *(const u32x4*)(F.P1() + row * NP1 + PC_AG + c0);
            ra[q][1] = *(const u32x4*)(F.P1() + row * NP1 + PC_DF + c0); rb[q][1] = *(const u32x4*)(F.P1() + row * NP1 + PC_DF + 512 + c0); rg[q][1] = *(const u32x4*)(F.P1() + row * NP1 + PC_DG + c0); }
#pragma unroll
        for (int q = 0; q < 2; ++q)
#pragma unroll
            for (int br = 0; br < 2; ++br) {
                const unsigned ua[4] = {ra[q][br].x, ra[q][br].y, ra[q][br].z, ra[q][br].w}, ub[4] = {rb[q][br].x, rb[q][br].y, rb[q][br].z, rb[q][br].w}, ug[4] = {rg[q][br].x, rg[q][br].y, rg[q][br].z, rg[q][br].w};
                float o[8], g[8]; float ss = 0.f;
#pragma unroll
                for (int j = 0; j < 4; ++j) { o[2 * j] = __uint_as_float(ua[j] << 16) + __uint_as_float(ub[j] << 16); o[2 * j + 1] = __uint_as_float(ua[j] & 0xffff0000u) + __uint_as_float(ub[j] & 0xffff0000u);
                    g[2 * j] = __uint_as_float(ug[j] << 16); g[2 * j + 1] = __uint_as_float(ug[j] & 0xffff0000u); ss += o[2 * j] * o[2 * j] + o[2 * j + 1] * o[2 * j + 1]; }
                ss += __shfl_xor(ss, 1); ss += __shfl_xor(ss, 2); ss += __shfl_xor(ss, 4); ss += __shfl_xor(ss, 8);
                const float rs = rsqrtf(ss * (1.f / 128.f) + 1e-6f);
#pragma unroll
                for (int j = 0; j < 8; ++j) o[j] = o[j] * rs * siluf_(g[j]);
                st8(F.BR() + ((size_t)pi * 2 + q) * 2048 + (br ? 1536 : 0) + c0, o);
            }
    }
}

__device__ __forceinline__ void phase_ln1(Frame& F, int l) {
    const int nrows = (l == 0) ? NROW : NTOK, ngroups = nrows / 64;
    const float* lg = F.p.ln_g + (size_t)(l * 2 + 0) * DM; const float* lbb = F.p.ln_b + (size_t)(l * 2 + 0) * DM;
    float* part = F.smf;
    const int wv = __builtin_amdgcn_readfirstlane(F.wave);
    float* stg = F.smf + 8 * 36 * 64 + wv * (64 * 17 + 16 * 40);
    float* wl = stg + 64 * 17;
    for (int grp = F.bid; grp < ngroups; grp += F.nb) {
        const int row0 = grp * 64, rb = row_batch(row0);
        const float* mv = F.modv() + ((size_t)l * 5 + rb) * 6144;
        float* xg = row0 < NTOK ? F.p.out + (size_t)row0 * DM : F.cxm() + (size_t)(row0 - NTOK) * DM;
#pragma unroll 1
        for (int rr = 0; rr < 8; rr += 2) {
            const int lr = wv * 8 + rr; float* xr = xg + (size_t)lr * DM;
            f32x4 v[2][4]; float s[2] = {0.f, 0.f};
#pragma unroll
            for (int q = 0; q < 2; ++q)
#pragma unroll
                for (int j = 0; j < 4; ++j) v[q][j] = *(const f32x4*)(xr + (size_t)q * DM + j * 256 + F.lane * 4);
#pragma unroll
            for (int q = 0; q < 2; ++q)
#pragma unroll
                for (int j = 0; j < 4; ++j) s[q] += (v[q][j].x + v[q][j].y) + (v[q][j].z + v[q][j].w);
#pragma unroll
            for (int o = 1; o < 64; o <<= 1) { s[0] += __shfl_xor(s[0], o); s[1] += __shfl_xor(s[1], o); }
            float s2[2] = {0.f, 0.f};
#pragma unroll
            for (int q = 0; q < 2; ++q) { const float mean = s[q] * (1.f / DM);
#pragma unroll
                for (int j = 0; j < 4; ++j) { v[q][j] = v[q][j] - mean; s2[q] += (v[q][j].x * v[q][j].x + v[q][j].y * v[q][j].y) + (v[q][j].z * v[q][j].z + v[q][j].w * v[q][j].w); } }
#pragma unroll
            for (int o = 1; o < 64; o <<= 1) { s2[0] += __shfl_xor(s2[0], o); s2[1] += __shfl_xor(s2[1], o); }
#pragma unroll
            for (int j = 0; j < 4; ++j) { const int d = j * 256 + F.lane * 4;
                const f32x4 g4 = *(const f32x4*)(lg + d), b4 = *(const f32x4*)(lbb + d), m3 = *(const f32x4*)(mv + 3 * 1024 + d), m4 = *(const f32x4*)(mv + 4 * 1024 + d);
#pragma unroll
                for (int q = 0; q < 2; ++q) { const float rstd = rsqrtf(s2[q] * (1.f / DM) + LN_EPS);
                    const f32x4 xn = v[q][j] * rstd * g4 + b4;
                    *(f32x4*)(xr + (size_t)q * DM + d) = xn;
                    const f32x4 h2 = xn * (1.f + m4) + m3;
                    u32x2 o2; o2.x = pk2(h2.x, h2.y); o2.y = pk2(h2.z, h2.w);
                    *(u32x2*)(F.HX2() + (size_t)(row0 + lr + q) * DM + d) = o2; } }
        }
        __syncthreads();
        {   f32x4 acc[4][3];
#pragma unroll
            for (int mt = 0; mt < 4; ++mt)
#pragma unroll
                for (int nt = 0; nt < 3; ++nt) acc[mt][nt] = (f32x4){0.f, 0.f, 0.f, 0.f};
            const float* wgp = F.p.moe_w_group + ((size_t)l * DM + wv * 128) * 4; const float* wep = F.p.moe_w_expert + ((size_t)l * DM + wv * 128) * 32;
            const float* m3p = mv + 3 * 1024 + wv * 128; const float* m4p = mv + 4 * 1024 + wv * 128;
            const int ln = F.lane & 15, lk = F.lane >> 4;
#pragma unroll 1
            for (int dc = 0; dc < 128; dc += 16) {
                f32x4 t[4]; float bw[4][3];
#pragma unroll
                for (int i = 0; i < 4; ++i) t[i] = *(const f32x4*)(xg + (size_t)(16 * i + (F.lane >> 2)) * DM + wv * 128 + dc + (F.lane & 3) * 4);
                const f32x4 m3v = *(const f32x4*)(m3p + dc + (F.lane & 3) * 4), m4v = *(const f32x4*)(m4p + dc + (F.lane & 3) * 4);
#pragma unroll
                for (int ks = 0; ks < 4; ++ks) { const int d = dc + 4 * ks + lk; bw[ks][0] = wep[(size_t)d * 32 + ln]; bw[ks][1] = wep[(size_t)d * 32 + 16 + ln]; bw[ks][2] = (ln < 4) ? wgp[(size_t)d * 4 + ln] : 0.f; }
#pragma unroll
                for (int i = 0; i < 4; ++i) { float* sp = stg + (16 * i + (F.lane >> 2)) * 17 + (F.lane & 3) * 4;
                    sp[0] = t[i].x * (1.f + m4v.x) + m3v.x; sp[1] = t[i].y * (1.f + m4v.y) + m3v.y; sp[2] = t[i].z * (1.f + m4v.z) + m3v.z; sp[3] = t[i].w * (1.f + m4v.w) + m3v.w; }
                asm volatile("s_waitcnt lgkmcnt(0)" ::: "memory");
#pragma unroll
                for (int ks = 0; ks < 4; ++ks)
#pragma unroll
                    for (int mt = 0; mt < 4; ++mt) { const float av = stg[(16 * mt + ln) * 17 + 4 * ks + lk];
#pragma unroll
                        for (int nt = 0; nt < 3; ++nt) acc[mt][nt] = __builtin_amdgcn_mfma_f32_16x16x4f32(av, bw[ks][nt], acc[mt][nt], 0, 0, 0); }
                asm volatile("s_waitcnt lgkmcnt(0)" ::: "memory");
            }
#pragma unroll
            for (int mt = 0; mt < 4; ++mt)
#pragma unroll
                for (int nt = 0; nt < 3; ++nt) { const int oi = (nt == 2) ? ln : 4 + 16 * nt + ln;
                    if (nt < 2 || ln < 4) {
#pragma unroll
                        for (int r = 0; r < 4; ++r) part[(wv * 36 + oi) * 64 + 16 * mt + 4 * lk + r] = acc[mt][nt][r]; } }
        }
        __syncthreads();
        if (wv == 0) {
            const int row = row0 + F.lane;
            float gl[4]; int gi = 0; float gm = -3.4e38f;
#pragma unroll
            for (int o = 0; o < 4; ++o) { float t = F.p.moe_b_group[l * 4 + o];
#pragma unroll
                for (int w2 = 0; w2 < 8; ++w2) t += part[(w2 * 36 + o) * 64 + F.lane];
                gl[o] = t; if (t > gm) { gm = t; gi = o; } }
            float gs = 0.f;
#pragma unroll
            for (int o = 0; o < 4; ++o) gs += expf(gl[o] - gm);
            const float gwt = 1.f / gs;
            float e1 = -3.4e38f, e2 = -3.4e38f; int i1 = 0, i2 = 0;
#pragma unroll
            for (int o8 = 0; o8 < 8; ++o8) { const int o = gi * 8 + o8; float ev = F.p.moe_b_expert[l * 32 + o];
#pragma unroll
                for (int w2 = 0; w2 < 8; ++w2) ev += part[(w2 * 36 + 4 + o) * 64 + F.lane];
                if (ev > e1) { e2 = e1; i2 = i1; e1 = ev; i1 = o; } else if (ev > e2) { e2 = ev; i2 = o; } }
            const float w1 = 1.f / (1.f + expf(e2 - e1)), w2v = 1.f - w1;
            unsigned* lh = (unsigned*)(stg + 64 * 17 + 16 * 40 - 64);
            if (F.lane < 32) lh[F.lane] = 0u;
            asm volatile("s_waitcnt lgkmcnt(0)" ::: "memory");
            const unsigned r1 = atomicAdd(&lh[i1], 1u), r2 = atomicAdd(&lh[i2], 1u);
            asm volatile("s_waitcnt lgkmcnt(0)" ::: "memory");
            if (F.lane < 32) { const unsigned c = lh[F.lane]; lh[32 + F.lane] = c ? atomicAdd(&F.cnt()[l * 32 + F.lane], c) : 0u; }
            asm volatile("s_waitcnt vmcnt(0) lgkmcnt(0)" ::: "memory");
            const unsigned p1 = lh[32 + i1] + r1, p2 = lh[32 + i2] + r2;
            F.tokE()[row * 2] = i1; F.tokI()[row * 2] = (int)p1; F.tokW()[row * 2] = gwt * w1;
            F.tokE()[row * 2 + 1] = i2; F.tokI()[row * 2 + 1] = (int)p2; F.tokW()[row * 2 + 1] = gwt * w2v;
        }
        __syncthreads();
    }
}

__device__ __forceinline__ void phase_gather(Frame& F, int l) {
    int* off = (int*)F.smf; moe_offsets(F, l, off);
    const int gw = F.bid * 8 + F.wave, ngw = F.nb * 8, nrows = (l == 0) ? NROW : NTOK;
    for (int s0 = gw; s0 < 2 * nrows; s0 += 4 * ngw) {
        int sl[4], e[4], ti[4]; float tw[4]; u32x4 a0[4], a1[4];
#pragma unroll
        for (int q = 0; q < 4; ++q) { sl[q] = min(s0 + q * ngw, 2 * nrows - 1); e[q] = F.tokE()[sl[q]]; ti[q] = F.tokI()[sl[q]]; tw[q] = F.tokW()[sl[q]];
            const u32x4* src = (const u32x4*)(F.HX2() + (size_t)(sl[q] >> 1) * DM); a0[q] = src[F.lane]; a1[q] = src[F.lane + 64]; }
#pragma unroll
        for (int q = 0; q < 4; ++q) if (s0 + q * ngw < 2 * nrows) { const int dst = off[e[q]] + ti[q]; u32x4* d = (u32x4*)(F.XS() + (size_t)dst * DM);
            d[F.lane] = a0[q]; d[F.lane + 64] = a1[q];
            if (F.lane == 0) { F.rmap()[dst] = sl[q]; F.roww()[dst] = tw[q]; } }
    }
    for (int e = 0; e < 32; ++e) {
        const int c = (int)F.cnt()[l * 32 + e], pc = (c + 255) & ~255;
        for (int j = c + gw; j < pc; j += ngw) { const int dst = off[e] + j; u32x4* d = (u32x4*)(F.XS() + (size_t)dst * DM);
            const u32x4 z = {0u, 0u, 0u, 0u}; d[F.lane] = z; d[F.lane + 64] = z;
            if (F.lane == 0) { F.rmap()[dst] = -1; F.roww()[dst] = 0.f; } }
    }
}
__device__ __forceinline__ int expert_of_row(const int* off, int row) { int e = 0;
#pragma unroll 1
    for (int i = 1; i < 32; ++i) if (row >= off[i]) e = i;
    return e; }

__device__ __forceinline__ void phase_ln2(Frame& F, int l) {
    const int gw = F.bid * 8 + F.wave, ngw = F.nb * 8, npairs = ((l == 0) ? NROW : NTOK) / 2;
    const float* lg = F.p.ln_g + (size_t)(l * 2 + 1) * DM; const float* lbb = F.p.ln_b + (size_t)(l * 2 + 1) * DM;
    const bf16_t* Y = F.BR();
    const bool tmo_set = (l == DEPTH - 1) && (__hip_atomic_load((unsigned*)(F.ws + WS_CTL) + XB_TMO, __ATOMIC_RELAXED, __HIP_MEMORY_SCOPE_AGENT) != 0u);
    for (int pi = gw; pi < npairs; pi += ngw) {
        const int row0 = pi * 2, rb = row_batch(row0);
        const float* xm = row0 < NTOK ? F.p.out + (size_t)row0 * DM : F.cxm() + (size_t)(row0 - NTOK) * DM;
        float* xo = row0 < NTOK ? F.p.out + (size_t)row0 * DM : F.cxo() + (size_t)(row0 - NTOK) * DM;
        const float* mv = F.modv() + ((size_t)l * 5 + rb) * 6144;
        u32x2 y0[2][4], y1[2][4]; f32x4 xv[2][4], m5[4];
#pragma unroll
        for (int j = 0; j < 4; ++j) { const int d = j * 256 + F.lane * 4; m5[j] = *(const f32x4*)(mv + 5 * 1024 + d);
#pragma unroll
            for (int q = 0; q < 2; ++q) { y0[q][j] = *(const u32x2*)(Y + (size_t)((row0 + q) * 2) * DM + d); y1[q][j] = *(const u32x2*)(Y + (size_t)((row0 + q) * 2 + 1) * DM + d); xv[q][j] = *(const f32x4*)(xm + (size_t)q * DM + d); } }
        f32x4 v[2][4]; float s[2] = {0.f, 0.f};
#pragma unroll
        for (int q = 0; q < 2; ++q)
#pragma unroll
            for (int j = 0; j < 4; ++j) { f32x4 y; y.x = __uint_as_float(y0[q][j].x << 16) + __uint_as_float(y1[q][j].x << 16); y.y = __uint_as_float(y0[q][j].x & 0xffff0000u) + __uint_as_float(y1[q][j].x & 0xffff0000u);
                y.z = __uint_as_float(y0[q][j].y << 16) + __uint_as_float(y1[q][j].y << 16); y.w = __uint_as_float(y0[q][j].y & 0xffff0000u) + __uint_as_float(y1[q][j].y & 0xffff0000u);
                v[q][j] = ALPHA * xv[q][j] + m5[j] * y; s[q] += (v[q][j].x + v[q][j].y) + (v[q][j].z + v[q][j].w); }
#pragma unroll
        for (int o = 1; o < 64; o <<= 1) { s[0] += __shfl_xor(s[0], o); s[1] += __shfl_xor(s[1], o); }
        float s2[2] = {0.f, 0.f};
#pragma unroll
        for (int q = 0; q < 2; ++q) { const float mean = s[q] * (1.f / DM);
#pragma unroll
            for (int j = 0; j < 4; ++j) { v[q][j] = v[q][j] - mean; s2[q] += (v[q][j].x * v[q][j].x + v[q][j].y * v[q][j].y) + (v[q][j].z * v[q][j].z + v[q][j].w * v[q][j].w); } }
#pragma unroll
        for (int o = 1; o < 64; o <<= 1) { s2[0] += __shfl_xor(s2[0], o); s2[1] += __shfl_xor(s2[1], o); }
        const float* mn = F.modv() + ((size_t)((l + 1 < DEPTH) ? l + 1 : l) * 5 + rb) * 6144;
#pragma unroll
        for (int j = 0; j < 4; ++j) { const int d = j * 256 + F.lane * 4;
            const f32x4 g4 = *(const f32x4*)(lg + d), b4 = *(const f32x4*)(lbb + d), m0 = *(const f32x4*)(mn + d), m1 = *(const f32x4*)(mn + 1024 + d);
#pragma unroll
            for (int q = 0; q < 2; ++q) { const float rstd = rsqrtf(s2[q] * (1.f / DM) + LN_EPS);
                f32x4 xn = v[q][j] * rstd * g4 + b4;
                if (tmo_set) xn = xn * __uint_as_float(0x7fc00000u);
                *(f32x4*)(xo + (size_t)q * DM + d) = xn;
                if (l + 1 < DEPTH) { const f32x4 h = xn * (1.f + m1) + m0; u32x2 o2; o2.x = pk2(h.x, h.y); o2.y = pk2(h.z, h.w); *(u32x2*)(F.HX() + (size_t)(row0 + q) * DM + d) = o2; } }
        }
    }
}

constexpr int NPL = 12, NPH = 1 + DEPTH * NPL;
__global__ void __launch_bounds__(NTHR, 2) mega(Params p) {
    extern __shared__ __attribute__((aligned(16))) unsigned char smem[];
    Frame F; F.p = p; F.bid = blockIdx.x; F.nb = gridDim.x; F.tid = threadIdx.x; F.lane = threadIdx.x & 63; F.wave = threadIdx.x >> 6; F.wid_s = __builtin_amdgcn_readfirstlane(threadIdx.x >> 6);
    F.smf = (float*)(smem + LDS_STAGE);
    LAS unsigned char* stage = (LAS unsigned char*)smem + LDS_STAGE; int* offt = (int*)(smem + 64);
    unsigned char* ws = p.ws; F.ws = ws;

    if (threadIdx.x == 0) *(uint4*)smem = make_uint4(0u, 0u, 0u, 0u);
    __syncthreads();
    unsigned* barw = (unsigned*)(ws + WS_CTL);
    XcdBarrier bar; bar.bar = barw; bar.x = 0; bar.st = (volatile LAS unsigned*)smem;
    const bool multi = (p.ph_hi - p.ph_lo) > 1;
    if (multi) bar = xcd_barrier_post(barw, (volatile LAS unsigned*)smem);
    const int lo = p.ph_lo, hi = p.ph_hi;
#define IN(k) (lo <= (k) && (k) < hi)
#define SEAM(k) do { if (IN(k) && IN((k) + 1)) xcd_barrier(bar); else __syncthreads(); } while (0)

    if (IN(0)) { REFRESH(F); phase_mod(F); __syncthreads(); phase_conv_a(F, 0); }
    SEAM(0);
#pragma unroll 1
    for (int l = 0; l < DEPTH; ++l) {
        const int pb = 1 + l * NPL;
        const float* xlat = (l == 0) ? p.x : p.out; const float* xctx = (l == 0) ? p.ctx : F.cxo();
        const int Mrows = (l == 0) ? NROW : NTOK;
        if (IN(pb + 0)) { REFRESH(F); if (l == 0) phase_prep(F, 0, p.x, p.ctx); else phase_conv_a(F, l); }
        SEAM(pb + 0);
        if (IN(pb + 1)) { REFRESH(F);
            float* rtab = (float*)(smem + LDS_ROPE);
            for (int e = F.tid; e < 1024; e += NTHR) { const int pp = e >> 4, i = e & 15; const float inv = powf(10000.f, -(float)i / 16.f), ang = (float)pp * inv; rtab[2 * e] = cosf(ang); rtab[2 * e + 1] = sinf(ang); }
            __syncthreads();
            pg::SchedG1 S{(const char*)F.HX(), (const char*)F.W1t(), (const char*)F.Wvt(), F.nb, F.bid}; pg::EpiG1 E{F.P1(), F.VT(), rtab, F.lb(), l};
            pg::gemm_phase(stage, DM, DM, DM, S, E);
        }
        SEAM(pb + 1);
        if (IN(pb + 2)) { REFRESH(F); phase_mix(F, l); }
        SEAM(pb + 2);
        if (IN(pb + 3)) { REFRESH(F); phase_prepad(F, l); }
        SEAM(pb + 3);
        if (IN(pb + 4)) { REFRESH(F);
            pg::SchedStatic S{(const char*)F.HX(), (const char*)F.Wgt(), (size_t)256 * DM * 2, (size_t)256 * DM * 2, Mrows / 256, NGATE / 256, F.nb, F.bid}; pg::EpiGate E{F.G()};
            pg::gemm_phase(stage, DM, DM, DM, S, E);
            __syncthreads();
            phase_conv_b(F, l);
        }
        SEAM(pb + 4);
        if (IN(pb + 5)) { REFRESH(F);
            pg::SchedMerge S{(const char*)F.BR(), (const char*)F.Wbrt(), (Mrows / 256) * 4, F.nb, F.bid}; pg::EpiMerge E{F.G(), F.HX()};
            pg::gemm_phase(stage, 2048, 512, 512, S, E);
        }
        SEAM(pb + 5);
        if (IN(pb + 6)) { REFRESH(F);
            pg::SchedStatic S{(const char*)F.HX(), (const char*)F.Woutt(), (size_t)256 * DM * 2, (size_t)256 * DM * 2, Mrows / 256, DM / 256, F.nb, F.bid};
            pg::EpiWout E{xlat, xctx, p.out, F.cxm(), F.modv() + (size_t)l * 5 * 6144};
            pg::gemm_phase(stage, DM, DM, DM, S, E);
        }
        SEAM(pb + 6);
        if (IN(pb + 7)) { REFRESH(F); phase_ln1(F, l); }
        SEAM(pb + 7);
        if (IN(pb + 8)) { REFRESH(F); phase_gather(F, l); }
        SEAM(pb + 8);
        if (IN(pb + 9)) { REFRESH(F);
            moe_offsets(F, l, offt);
            pg::SchedMoe S{(const char*)F.XS(), (const char*)F.Wgu(), offt, (size_t)256 * DM * 2, (size_t)512 * DM * 2, (size_t)256 * DM * 2, offt[32] / 256, 2, F.nb, F.bid};
            pg::EpiMoe1 E{F.HID(), F.roww()};
            pg::gemm_phase(stage, DM, DM, DM, S, E);
        }
        SEAM(pb + 9);
        if (IN(pb + 10)) { REFRESH(F);
            moe_offsets(F, l, offt);
            pg::SchedMoe S{(const char*)F.HID(), (const char*)F.Wd(), offt, (size_t)256 * 256 * 2, (size_t)DM * 256 * 2, (size_t)256 * 256 * 2, offt[32] / 256, 4, F.nb, F.bid};
            pg::EpiMoe2 E{F.BR(), F.rmap(), (bf16_t*)(F.ws + WS_DUMP)};
            pg::gemm_phase(stage, 256, 256, 256, S, E);
        }
        SEAM(pb + 10);
        if (IN(pb + 11)) { REFRESH(F); phase_ln2(F, l); }
        SEAM(pb + 11);
    }
#undef IN
#undef SEAM
}

extern "C" void kernel_launch(void* const* d_in, const int* in_sizes, int n_in, void* d_out, int out_size, void* d_ws, size_t ws_size, hipStream_t stream) {
    static int grid = 0;
    if (grid == 0) {
        if (n_in != 23 || out_size != NTOK * DM || ws_size < WS_END) { fprintf(stderr, "kernel_launch: unexpected shapes (n_in %d out %d ws %zu need %zu)\n", n_in, out_size, ws_size, (size_t)WS_END); grid = -1; return; }
        int dev = 0, cus = 0;
        if (hipGetDevice(&dev) != hipSuccess || hipDeviceGetAttribute(&cus, hipDeviceAttributeMultiprocessorCount, dev) != hipSuccess) { grid = -1; return; }
        if (hipFuncSetAttribute((const void*)mega, hipFuncAttributeMaxDynamicSharedMemorySize, LDS_BYTES) != hipSuccess) { fprintf(stderr, "kernel_launch: hipFuncSetAttribute failed\n"); grid = -1; return; }
        int per_cu = 0;
        if (hipOccupancyMaxActiveBlocksPerMultiprocessor(&per_cu, (const void*)mega, NTHR, LDS_BYTES) != hipSuccess || per_cu < 1) fprintf(stderr, "kernel_launch: occupancy query reports %d blocks per CU\n", per_cu);
        (void)hipGetLastError();
        grid = cus;
    }
    if (grid < 0) return;
    (void)hipMemsetAsync((char*)d_ws + WS_CTL, 0, CTL_BYTES, stream);
    Params p; memset(&p, 0, sizeof(p));
    const float** pp = (const float**)&p;
    for (int i = 0; i < 23; ++i) pp[i] = (const float*)d_in[i];
    p.out = (float*)d_out; p.ws = (unsigned char*)d_ws;
    p.ph_lo = 0; p.ph_hi = NPH;
    hipLaunchKernelGGL(mega, dim3(grid), dim3(NTHR), LDS_BYTES, stream, p);
}
```

```cpp
#include <hip/hip_runtime.h>
#include <cstdio>
#include <cstdint>
#include <cstring>

typedef unsigned short bf16_t;
typedef float f32x4 __attribute__((ext_vector_type(4)));
typedef unsigned u32x4 __attribute__((ext_vector_type(4)));
typedef unsigned u32x2 __attribute__((ext_vector_type(2)));

constexpr int NB = 4, SEQ = 4096, LC = 256, DM = 1024, DEPTH = 2;
constexpr int NTOK = NB * SEQ, NCTX = NB * LC, NROW = NTOK + NCTX;
constexpr int DIN = 10528;
constexpr int O_AQ = 0, O_AK = 256, O_AV = 512, O_AG = 1024, O_ALR = 1536, O_BQ = 1568, O_BK = 2080, O_BV = 2592, O_CQ = 3104, O_CK = 3616,
              O_CV = 3744, O_DQ = 3872, O_DF = 4384, O_DI = 5408, O_DG = 5920, O_GATE = 6432;
constexpr int PC_AQ = 0, PC_AK = 256, PC_AV = 512, PC_BQ = 1024, PC_BK = 1536, PC_CQ = 2048, PC_CK = 2560, PC_ALR = 2688, PC_DQ = 2816,
              PC_DF = 3328, PC_DI = 4352, PC_AG = 4864, PC_DG = 5376, NP1 = 5888;
constexpr float QSCALE = 0.125f * 1.44269504089f;
constexpr int NVT = 768;
constexpr int NVR = 640;
constexpr int NGATE = 4096;
constexpr int XS_ROWS = 43008;
constexpr float LN_EPS = 1e-5f;
constexpr float ALPHA = 1.41421356237f;

constexpr size_t al256(size_t x) { return (x + 255) & ~(size_t)255; }
constexpr size_t WS_CTL = 0;
constexpr size_t CTL_BYTES = 32768;
constexpr size_t CTL_CNT = 28672;
constexpr size_t WS_DUMP = WS_CTL + CTL_BYTES;
constexpr size_t WS_MODV = WS_DUMP + 4096;
constexpr size_t WS_LB = WS_MODV + al256((size_t)DEPTH * 5 * 6144 * 4);
constexpr size_t WS_TOKE = WS_LB + 4096;
constexpr size_t WS_TOKI = WS_TOKE + al256((size_t)2 * NROW * 4);
constexpr size_t WS_TOKW = WS_TOKI + al256((size_t)2 * NROW * 4);
constexpr size_t WS_RMAP = WS_TOKW + al256((size_t)2 * NROW * 4);
constexpr size_t WS_ROWW = WS_RMAP + al256((size_t)XS_ROWS * 4);
constexpr size_t WS_CXM = WS_ROWW + al256((size_t)XS_ROWS * 4);
constexpr size_t WS_CXO = WS_CXM + (size_t)NCTX * DM * 4;
constexpr size_t WS_WTA = WS_CXO + (size_t)NCTX * DM * 4;
constexpr size_t WTA_W1 = 0;
constexpr size_t WTA_WV = WTA_W1 + (size_t)NP1 * DM * 2;
constexpr size_t WTA_WG = WTA_WV + (size_t)NVT * DM * 2;
constexpr size_t WTA_WBR = WTA_WG + (size_t)NGATE * DM * 2;
constexpr size_t WTA_WO = WTA_WBR + (size_t)4 * DM * 512 * 2;
constexpr size_t WTA_BYTES = WTA_WO + (size_t)DM * DM * 2;
constexpr size_t WS_HX = WS_WTA + WTA_BYTES;
constexpr size_t WS_VT = WS_HX + (size_t)NROW * DM * 2;
constexpr size_t WS_OBA = WS_VT + (size_t)NVT * NROW * 2;
constexpr size_t WS_HX2 = WS_VT;
constexpr size_t WS_HID = WS_VT;
constexpr size_t WS_VR = WS_OBA + (size_t)NROW * 512 * 2;
constexpr size_t WS_BR = WS_VR + (size_t)NROW * NVR * 2;
constexpr size_t WS_P1 = WS_BR + (size_t)NROW * 2048 * 2;
constexpr size_t WS_G = WS_P1;
constexpr size_t WS_WGU = WS_P1 + (size_t)NROW * NGATE * 2;
constexpr size_t WS_WD = WS_WGU + (size_t)32 * 512 * DM * 2;
constexpr size_t WS_XS = WS_P1;
constexpr size_t WS_END = WS_P1 + (size_t)NROW * NP1 * 2;
static_assert(WS_WD + (size_t)32 * DM * 256 * 2 <= WS_END, "moe weights must fit in the P1 tail");
static_assert((size_t)XS_ROWS * DM * 2 <= (size_t)NROW * NGATE * 2, "XS must fit in the G region");
static_assert((size_t)NVT * NROW * 2 + (size_t)NROW * 512 * 2 >= (size_t)NROW * DM * 2, "HX2 alias");
static_assert(WS_END <= 434800000ull, "workspace budget");

constexpr int NTHR = 512;
constexpr int LDS_STAGE = 1024;
constexpr int LDS_ROPE = 1024 + 131072 + 1024;
constexpr int LDS_BYTES = 144 * 1024;

struct Params {
    const float *x, *c, *ctx, *c_ctx, *w_mod, *b_mod, *w_in, *gla_lr_w, *gla_lr_b, *hg_gamma, *na_rpb, *wa_sink, *w_branch, *w_out, *ln_g, *ln_b,
        *moe_w_group, *moe_b_group, *moe_w_expert, *moe_b_expert, *moe_w_gate, *moe_w_up, *moe_w_down;
    float* out;
    unsigned char* ws;
    int ph_lo, ph_hi;
};

__device__ __forceinline__ float bf2f(bf16_t b) { return __uint_as_float(((unsigned)b) << 16); }
__device__ __forceinline__ bf16_t f2bf(float f) { unsigned u = __float_as_uint(f); u += 0x7FFFu + ((u >> 16) & 1u); return (bf16_t)(u >> 16); }
typedef float f32x2_t __attribute__((ext_vector_type(2)));
typedef __bf16 bf16x2_t __attribute__((ext_vector_type(2)));
__device__ __forceinline__ unsigned pk2(float lo, float hi) {
    const f32x2_t v = {lo, hi}; const bf16x2_t b = __builtin_convertvector(v, bf16x2_t); return __builtin_bit_cast(unsigned, b); }
__device__ __forceinline__ void ld8(const bf16_t* p, float* f) {
    const u32x4 v = *(const u32x4*)p;
    f[0] = __uint_as_float(v.x << 16); f[1] = __uint_as_float(v.x & 0xffff0000u);
    f[2] = __uint_as_float(v.y << 16); f[3] = __uint_as_float(v.y & 0xffff0000u);
    f[4] = __uint_as_float(v.z << 16); f[5] = __uint_as_float(v.z & 0xffff0000u);
    f[6] = __uint_as_float(v.w << 16); f[7] = __uint_as_float(v.w & 0xffff0000u);
}
__device__ __forceinline__ void st8(bf16_t* p, const float* f) {
    u32x4 v; v.x = pk2(f[0], f[1]); v.y = pk2(f[2], f[3]); v.z = pk2(f[4], f[5]); v.w = pk2(f[6], f[7]);
    *(u32x4*)p = v;
}
__device__ __forceinline__ float sigmoidf_(float x) { return __builtin_amdgcn_rcpf(1.f + __expf(-x)); }
__device__ __forceinline__ float siluf_(float x) { return x * __builtin_amdgcn_rcpf(1.f + __expf(-x)); }
__device__ __forceinline__ float wave_sum(float v) {
#pragma unroll
    for (int o = 1; o < 64; o <<= 1) v += __shfl_xor(v, o);
    return v;
}
__device__ __forceinline__ int row_batch(int row) { return row < NTOK ? (row >> 12) : 4; }

#define XB_TMO      128
#define XB_XCNT(j)  (256  + 64 * (j))
#define XB_XSUB(j)  (1280 + 64 * (j))
#define XB_XGEN(j)  (2304 + 64 * (j))
#define XB_TOP      3328
#define XB_TOPGEN   3392
#define XCD_BAR_WORDS 3456
#define XB_SPIN_CAP (1u << 18)
#define LAS __attribute__((address_space(3)))
__device__ __forceinline__ unsigned xb_ld(unsigned* p)              { return __hip_atomic_load(p, __ATOMIC_RELAXED, __HIP_MEMORY_SCOPE_AGENT); }
__device__ __forceinline__ unsigned xb_add(unsigned* p, unsigned v) { return __hip_atomic_fetch_add(p, v, __ATOMIC_RELAXED, __HIP_MEMORY_SCOPE_AGENT); }
__device__ __forceinline__ unsigned xb_xcc_id() { return (unsigned)__builtin_amdgcn_s_getreg((3 << 11) | 20) & 0xFu; }
#define XB_SPIN(cond, bar) do { unsigned _sp = 0; while (cond) { __builtin_amdgcn_s_sleep(1); \
    if ((++_sp & 255u) == 0u) { if (xb_ld(&(bar)[XB_TMO])) break; if (_sp > XB_SPIN_CAP) { atomicAdd(&(bar)[XB_TMO], 1u); break; } } } } while (0)
struct XcdBarrier { unsigned* bar; unsigned x; volatile LAS unsigned* st; };
__device__ __forceinline__ XcdBarrier xcd_barrier_post(unsigned* bar, volatile LAS unsigned* st) {
    XcdBarrier b; b.bar = bar; b.x = xb_xcc_id(); b.st = st;
    if (threadIdx.x == 0) (void)xb_add(&bar[XB_XCNT(b.x)], 1u);
    return b;
}
__device__ __forceinline__ void xcd_barrier_complete(unsigned* bar, unsigned x, unsigned& nloc, unsigned& nx) {
    const unsigned G = gridDim.x * gridDim.y * gridDim.z;
    unsigned sum, cnt, mine, sp = 0u;
    for (;;) {
        sum = 0u; cnt = 0u; mine = 0u;
#pragma unroll
        for (unsigned j = 0; j < 16; ++j) { const unsigned c = xb_ld(&bar[XB_XCNT(j)]); sum += c; cnt += (c > 0u) ? 1u : 0u; mine = (j == x) ? c : mine; }
        if (sum == G) break;
        __builtin_amdgcn_s_sleep(1);
        if ((++sp & 255u) == 0u) { if (xb_ld(&bar[XB_TMO])) break; if (sp > XB_SPIN_CAP) { atomicAdd(&bar[XB_TMO], 1u); break; } }
    }
    nloc = mine > 0u ? mine : 1u; nx = cnt > 0u ? cnt : 1u;
}
__device__ __forceinline__ void xcd_barrier(const XcdBarrier& b) {
    asm volatile("s_waitcnt vmcnt(0)" ::: "memory");
    __syncthreads();
    if (threadIdx.x == 0) {
        unsigned* bar = b.bar;
        __builtin_amdgcn_s_waitcnt(0);
        unsigned nloc = b.st[0], nx = b.st[1];
        if (nloc == 0u) { xcd_barrier_complete(bar, b.x, nloc, nx); b.st[0] = nloc; b.st[1] = nx; }
        const unsigned old = xb_add(&bar[XB_XSUB(b.x)], 1u);
        const unsigned gen = old / nloc;
        if (old + 1u == (gen + 1u) * nloc) {
            __builtin_amdgcn_fence(__ATOMIC_RELEASE, "agent");
            asm volatile("s_waitcnt vmcnt(0)" ::: "memory");
            const unsigned og = xb_add(&bar[XB_TOP], 1u);
            const unsigned tg = og / nx;
            if (og + 1u == (tg + 1u) * nx) xb_add(&bar[XB_TOPGEN], 1u);
            else XB_SPIN(xb_ld(&bar[XB_TOPGEN]) == tg, bar);
            __builtin_amdgcn_fence(__ATOMIC_ACQUIRE, "agent");
            xb_add(&bar[XB_XGEN(b.x)], 1u);
            asm volatile("s_waitcnt vmcnt(0)" ::: "memory");
        } else {
            XB_SPIN(xb_ld(&bar[XB_XGEN(b.x)]) == gen, bar);
            __builtin_amdgcn_fence(__ATOMIC_ACQUIRE, "agent");
            asm volatile("s_waitcnt vmcnt(0)" ::: "memory");
        }
    }
    __syncthreads();
}

struct Frame {
    Params p;
    int bid, nb, tid, lane, wave, wid_s;
    float* smf;
    unsigned char* ws;
    __device__ __forceinline__ float* modv() const { return (float*)(ws + WS_MODV); }
    __device__ __forceinline__ float* lb() const { return (float*)(ws + WS_LB); }
    __device__ __forceinline__ int* tokE() const { return (int*)(ws + WS_TOKE); }
    __device__ __forceinline__ int* tokI() const { return (int*)(ws + WS_TOKI); }
    __device__ __forceinline__ float* tokW() const { return (float*)(ws + WS_TOKW); }
    __device__ __forceinline__ int* rmap() const { return (int*)(ws + WS_RMAP); }
    __device__ __forceinline__ float* roww() const { return (float*)(ws + WS_ROWW); }
    __device__ __forceinline__ float* cxm() const { return (float*)(ws + WS_CXM); }
    __device__ __forceinline__ float* cxo() const { return (float*)(ws + WS_CXO); }
    __device__ __forceinline__ bf16_t* W1t() const { return (bf16_t*)(ws + WS_WTA + WTA_W1); }
    __device__ __forceinline__ bf16_t* Wvt() const { return (bf16_t*)(ws + WS_WTA + WTA_WV); }
    __device__ __forceinline__ bf16_t* Wgt() const { return (bf16_t*)(ws + WS_WTA + WTA_WG); }
    __device__ __forceinline__ bf16_t* Wbrt() const { return (bf16_t*)(ws + WS_WTA + WTA_WBR); }
    __device__ __forceinline__ bf16_t* Woutt() const { return (bf16_t*)(ws + WS_WTA + WTA_WO); }
    __device__ __forceinline__ bf16_t* HX() const { return (bf16_t*)(ws + WS_HX); }
    __device__ __forceinline__ bf16_t* VT() const { return (bf16_t*)(ws + WS_VT); }
    __device__ __forceinline__ bf16_t* OBA() const { return (bf16_t*)(ws + WS_OBA); }
    __device__ __forceinline__ bf16_t* HX2() const { return (bf16_t*)(ws + WS_HX2); }
    __device__ __forceinline__ bf16_t* HID() const { return (bf16_t*)(ws + WS_HID); }
    __device__ __forceinline__ bf16_t* VR() const { return (bf16_t*)(ws + WS_VR); }
    __device__ __forceinline__ bf16_t* BR() const { return (bf16_t*)(ws + WS_BR); }
    __device__ __forceinline__ bf16_t* P1() const { return (bf16_t*)(ws + WS_P1); }
    __device__ __forceinline__ bf16_t* G() const { return (bf16_t*)(ws + WS_G); }
    __device__ __forceinline__ bf16_t* Wgu() const { return (bf16_t*)(ws + WS_WGU); }
    __device__ __forceinline__ bf16_t* Wd() const { return (bf16_t*)(ws + WS_WD); }
    __device__ __forceinline__ bf16_t* XS() const { return (bf16_t*)(ws + WS_XS); }
    __device__ __forceinline__ unsigned* cnt() const { return (unsigned*)(ws + WS_CTL + CTL_CNT); }
};


#define REFRESH(F) do { int _t = threadIdx.x; asm volatile("" : "+v"(_t)); (F).tid = _t; (F).lane = _t & 63; (F).wave = _t >> 6; } while (0)

__device__ __forceinline__ void phase_mod(Frame& F) {
    float* sc = F.smf;
    float* red = F.smf + 5 * 1024;
    bool have = false;
    for (int it = F.bid; it < DEPTH * 96; it += F.nb) {
        if (!have) {
            for (int i = F.tid; i < 5 * 1024; i += NTHR) { const float v = (i < 4096) ? F.p.c[i] : F.p.c_ctx[i - 4096]; sc[i] = siluf_(v); }
            __syncthreads(); have = true;
        }
        const int l = it / 96, n0 = (it % 96) * 64, col = F.tid & 63, kg = F.tid >> 6;
        const float* w = F.p.w_mod + (size_t)l * DM * 6144 + n0 + col;
        float a[5] = {0.f, 0.f, 0.f, 0.f, 0.f};
        for (int k = kg * 128; k < kg * 128 + 128; ++k) {
            const float wv = w[(size_t)k * 6144];
#pragma unroll
            for (int r = 0; r < 5; ++r) a[r] += sc[r * 1024 + k] * wv;
        }
#pragma unroll
        for (int r = 0; r < 5; ++r) red[(kg * 5 + r) * 64 + col] = a[r];
        __syncthreads();
        if (F.tid < 320) {
            const int r = F.tid >> 6, cc = F.tid & 63; float s = F.p.b_mod[l * 6144 + n0 + cc];
#pragma unroll
            for (int g = 0; g < 8; ++g) s += red[(g * 5 + r) * 64 + cc];
            F.modv()[((size_t)l * 5 + r) * 6144 + n0 + cc] = s;
        }
        __syncthreads();
    }
    if (F.bid == F.nb - 1) {
        for (int i = F.tid; i < 1024; i += NTHR) { const int z = i >> 9, f = i & 511;
            const float g0 = F.p.hg_gamma[(z * DEPTH + 0) * 512 + f], g1 = F.p.hg_gamma[(z * DEPTH + 1) * 512 + f];
            F.lb()[i] = 1.f / (1.f + expf(g0 - g1)); }
    }
}

__device__ __forceinline__ int p1_src(int n, float& scale) {
    scale = 1.f;
    if (n < 256) { scale = 0.125f; return O_AQ + n; }
    if (n < 512) return O_AK + (n - 256);
    if (n < 1024) return O_AV + (n - 512);
    if (n < 1536) { scale = QSCALE; return O_BQ + (n - 1024); }
    if (n < 2048) return O_BK + (n - 1536);
    if (n < 2560) { scale = QSCALE; return O_CQ + (n - 2048); }
    if (n < 2688) return O_CK + (n - 2560);
    if (n < 2720) return O_ALR + (n - 2688);
    if (n < 2816) return -1;
    if (n < 3328) return O_DQ + (n - 2816);
    if (n < 4352) return O_DF + (n - 3328);
    if (n < 4864) return O_DI + (n - 4352);
    if (n < 5376) return O_AG + (n - 4864);
    return O_DG + (n - 5376);
}
__device__ __forceinline__ void conv_item(const float* src, int ldsrc, int srccol, float scale, bf16_t* dst, int K, int k0, float* scr, int lane, bool perm) {
    if (srccol >= 0) {
#pragma unroll 8
        for (int i = 0; i < 32; ++i) { const int kk = 2 * i + (lane >> 5); scr[kk * 33 + (lane & 31)] = src[(size_t)(k0 + kk) * ldsrc + srccol + (lane & 31)] * scale; }
    } else {
#pragma unroll 8
        for (int i = 0; i < 32; ++i) { const int kk = 2 * i + (lane >> 5); scr[kk * 33 + (lane & 31)] = 0.f; }
    }
    asm volatile("s_waitcnt lgkmcnt(0)" ::: "memory");
    const int c = lane & 7;
#pragma unroll
    for (int j = 0; j < 4; ++j) { const int nn = (lane >> 3) + 8 * j; const float* sp = scr + (8 * c) * 33 + (perm ? (8 * ((nn & 15) >> 2) + 4 * (nn >> 4) + (nn & 3)) : nn);
        u32x4 o; o.x = pk2(sp[0 * 33], sp[1 * 33]); o.y = pk2(sp[2 * 33], sp[3 * 33]); o.z = pk2(sp[4 * 33], sp[5 * 33]); o.w = pk2(sp[6 * 33], sp[7 * 33]);
        *(u32x4*)(dst + (size_t)nn * K + 8 * c) = o; }
    asm volatile("s_waitcnt lgkmcnt(0)" ::: "memory");
}
constexpr int CONVA_W1 = (NP1 / 32) * 16;
constexpr int CONVA_ITEMS = CONVA_W1 + 384 + 2048 + 1024 + 512;
__device__ __forceinline__ void phase_conv_a(Frame& F, int l) {
    float* scr = F.smf + F.wave * (64 * 33);
    const int gw = F.bid * 8 + F.wave, ngw = F.nb * 8;
    for (int it0 = gw; it0 < CONVA_ITEMS; it0 += ngw) {
        int ti = it0;
        if (ti < CONVA_W1) { const int n0 = (ti >> 4) * 32, kt = ti & 15; float sc; const int sx = p1_src(n0, sc);
            conv_item(F.p.w_in + (size_t)l * DM * DIN, DIN, sx, sc, F.W1t() + (size_t)n0 * DM + kt * 64, DM, kt * 64, scr, F.lane, !(n0 >= 2048 && n0 < 2816)); continue; }
        ti -= CONVA_W1;
        if (ti < 384) { const int n0 = (ti >> 4) * 32, kt = ti & 15; const int sx = n0 < 512 ? O_BV + n0 : (n0 < 640 ? O_CV + (n0 - 512) : -1);
            conv_item(F.p.w_in + (size_t)l * DM * DIN, DIN, sx, 1.f, F.Wvt() + (size_t)n0 * DM + kt * 64, DM, kt * 64, scr, F.lane, false); continue; }
        ti -= 384;
        if (ti < 2048) { const int n0 = (ti >> 4) * 32, kt = ti & 15;
            conv_item(F.p.w_in + (size_t)l * DM * DIN, DIN, O_GATE + n0, 1.f, F.Wgt() + (size_t)n0 * DM + kt * 64, DM, kt * 64, scr, F.lane, true); continue; }
        ti -= 2048;
        if (ti < 1024) { const int i = ti >> 8, r = ti & 255, n0 = (r >> 3) * 32, kt = r & 7;
            conv_item(F.p.w_branch + (size_t)(l * 4 + i) * 512 * DM, DM, n0, 1.f, F.Wbrt() + (size_t)i * DM * 512 + (size_t)n0 * 512 + kt * 64, 512, kt * 64, scr, F.lane, true); continue; }
        ti -= 1024;
        { const int n0 = (ti >> 4) * 32, kt = ti & 15;
          conv_item(F.p.w_out + (size_t)l * DM * DM, DM, n0, 1.f, F.Woutt() + (size_t)n0 * DM + kt * 64, DM, kt * 64, scr, F.lane, false); }
    }
}
constexpr int CONVB_ITEMS = 8192 + 4096;
__device__ __forceinline__ void phase_conv_b(Frame& F, int l) {
    float* scr = F.smf + F.wave * (64 * 33);
    const int gw = F.bid * 8 + F.wave, ngw = F.nb * 8;
    for (int it0 = gw; it0 < CONVB_ITEMS; it0 += ngw) {
        int ti = it0;
        if (ti < 8192) { const int e = ti >> 8, r = ti & 255, n0 = (r >> 4) * 32, kt = r & 15, j = n0 >> 8, rr = n0 & 255; const bool isup = rr >= 128; const int cc = 128 * j + (rr & 127);
            const float* src = (isup ? F.p.moe_w_up : F.p.moe_w_gate) + (size_t)(l * 32 + e) * DM * 256;
            conv_item(src, 256, cc, 1.f, F.Wgu() + (size_t)e * 512 * DM + (size_t)n0 * DM + kt * 64, DM, kt * 64, scr, F.lane, true); continue; }
        ti -= 8192;
        { const int e = ti >> 7, r = ti & 127, n0 = (r >> 2) * 32, kt = r & 3;
          conv_item(F.p.moe_w_down + (size_t)(l * 32 + e) * 256 * DM, DM, n0, 1.f, F.Wd() + (size_t)e * DM * 256 + (size_t)n0 * 256 + kt * 64, 256, kt * 64, scr, F.lane, true); }
    }
}

__device__ __forceinline__ void phase_prep(Frame& F, int l, const float* xlat, const float* xctx) {
    const int gw = F.bid * 8 + F.wave, ngw = F.nb * 8;
    for (int row = gw; row < NROW; row += ngw) {
        const float* xr = row < NTOK ? xlat + (size_t)row * DM : xctx + (size_t)(row - NTOK) * DM;
        const float* mv = F.modv() + ((size_t)l * 5 + row_batch(row)) * 6144;
#pragma unroll
        for (int j = 0; j < 4; ++j) { const int d = j * 256 + F.lane * 4;
            const f32x4 v = *(const f32x4*)(xr + d), m0 = *(const f32x4*)(mv + d), m1 = *(const f32x4*)(mv + 1024 + d);
            u32x2 o; o.x = pk2(v.x * (1.f + m1.x) + m0.x, v.y * (1.f + m1.y) + m0.y); o.y = pk2(v.z * (1.f + m1.z) + m0.z, v.w * (1.f + m1.w) + m0.w);
            *(u32x2*)(F.HX() + (size_t)row * DM + d) = o; }
    }
}


namespace pg {
typedef short bf16x8 __attribute__((ext_vector_type(8)));
constexpr int BM = 256, BK = 64, HALF = 128, HTB = HALF * BK * 2, STAGE_BYTES = 8 * HTB, NXCD = 8, WGM = 8;
__device__ __forceinline__ int lds_byte(int r, int c) { const int st = (r >> 4) * 2 + (c >> 5), rr = r & 15, cc = c & 31, ob = rr * 64 + cc * 2; return st * 1024 + (ob ^ (((ob >> 9) & 1) << 5)); }
__device__ __forceinline__ void stage_rc(int b, int& R, int& C) { const int st = b / 1024, sb = b % 1024, swz = sb ^ (((sb >> 9) & 1) << 5); R = (st >> 1) * 16 + swz / 64; C = (st & 1) * 32 + (swz % 64) / 2; }
struct Unit { const char* a; const char* b; int pm, pn, aux; };
__device__ __forceinline__ void static_map(int L, int nM, int nN, int& pm, int& pn) {
    const int nwg = nM * nN; int wgid = L; { const int q = nwg / NXCD, r = nwg % NXCD, xcd = wgid % NXCD, off = wgid / NXCD; wgid = (xcd < r ? xcd * (q + 1) : r * (q + 1) + (xcd - r) * q) + off; }
    const int nig = WGM * nN, gid = wgid / nig, fm = gid * WGM, gsz = (nM - fm) < WGM ? (nM - fm) : WGM;
    pm = fm + ((wgid % nig) % gsz); pn = (wgid % nig) / gsz;
}
template <class Epi, class Sched>
__device__ __forceinline__ void gemm_phase(LAS unsigned char* lds, const int lda, const int ldb, const int K, const Sched& S, const Epi& E) {
    int tid = threadIdx.x; asm volatile("" : "+v"(tid));
    const int wid = __builtin_amdgcn_readfirstlane(tid >> 6), lane = tid & 63, wr = wid >> 2, wc = wid & 3, fr = lane & 15, fq = lane >> 4;
    int nt = K / BK; asm volatile("" : "+s"(nt));
    unsigned voffA[2], voffB[2];
#pragma unroll
    for (int i = 0; i < 2; ++i) { int R, C; stage_rc(tid * 16 + i * 8192, R, C); voffA[i] = (unsigned)(R * lda + C) * 2u; voffB[i] = (unsigned)(R * ldb + C) * 2u; }
    const size_t kstep = (size_t)(BK * 2);
    const size_t hstepA = (size_t)HALF * lda * 2, hstepB = (size_t)HALF * ldb * 2;
    const unsigned ldsw = (unsigned)wid * 1024u;
    const int aoff = lds_byte(wr * 64 + fr, fq * 8), boff = lds_byte(wc * 32 + fr, fq * 8);
#define PG_SA(b, h) (((b) * 2 + (h)) * HTB)
#define PG_SB(b, h) ((4 + (b) * 2 + (h)) * HTB)
#define PG_STAGE(bufoff, gbase, voff) do { _Pragma("unroll") for (int _i = 0; _i < 2; ++_i) \
        __builtin_amdgcn_global_load_lds((const unsigned*)((const char*)(gbase) + (voff)[_i]), (LAS unsigned*)(lds + (bufoff) + ldsw + _i * 8192), 16, 0, 0); } while (0)
#define PG_LDA(dst, b, h) do { _Pragma("unroll") for (int m = 0; m < 4; ++m) _Pragma("unroll") for (int k = 0; k < 2; ++k) dst[m][k] = *(const LAS bf16x8*)(lds + PG_SA(b, h) + aoff + m * 2048 + k * 1024); } while (0)
#define PG_LDB(dst, b, h) do { _Pragma("unroll") for (int n = 0; n < 2; ++n) _Pragma("unroll") for (int k = 0; k < 2; ++k) dst[n][k] = *(const LAS bf16x8*)(lds + PG_SB(b, h) + boff + n * 2048 + k * 1024); } while (0)
#define PG_MMA(ai, bj, At, Bt) do { __builtin_amdgcn_s_setprio(1); _Pragma("unroll") for (int m = 0; m < 4; ++m) _Pragma("unroll") for (int n = 0; n < 2; ++n) _Pragma("unroll") for (int k = 0; k < 2; ++k) \
        acc[ai][bj][m][n] = __builtin_amdgcn_mfma_f32_16x16x32_bf16(Bt[n][k], At[m][k], acc[ai][bj][m][n], 0, 0, 0); __builtin_amdgcn_s_setprio(0); } while (0)
#define PG_WAIT_V(n) asm volatile("s_waitcnt vmcnt(" #n ")" ::: "memory")
#define PG_WAIT_L(n) asm volatile("s_waitcnt lgkmcnt(" #n ")" ::: "memory")
#define PG_BAR __builtin_amdgcn_s_barrier()
#define PG_SCHED __builtin_amdgcn_sched_barrier(0)
    Unit cur, nxt; int ui = 0;
    if (!S.next(0, cur)) return;
    f32x4 acc[2][2][4][2];
#pragma unroll
    for (int a = 0; a < 2; ++a)
#pragma unroll
        for (int b = 0; b < 2; ++b)
#pragma unroll
            for (int m = 0; m < 4; ++m)
#pragma unroll
                for (int n = 0; n < 2; ++n) acc[a][b][m][n] = (f32x4){0.f, 0.f, 0.f, 0.f};
    bf16x8 At[4][2], B0[2][2], B1[2][2];
    const char* cA = cur.a; const char* cB = cur.b;
    PG_STAGE(PG_SB(0, 0), cB, voffB); PG_STAGE(PG_SA(0, 0), cA, voffA); PG_STAGE(PG_SB(0, 1), cB + hstepB, voffB); PG_STAGE(PG_SA(0, 1), cA + hstepA, voffA);
    if (wr == 1) PG_BAR;
    PG_WAIT_V(4); PG_BAR;
    PG_STAGE(PG_SB(1, 0), cB + kstep, voffB); PG_STAGE(PG_SA(1, 0), cA + kstep, voffA); PG_STAGE(PG_SB(1, 1), cB + hstepB + kstep, voffB);
    PG_WAIT_V(6); PG_BAR;
    for (;;) {
        const bool has_next = S.next(ui + 1, nxt);
        const char* nA = has_next ? nxt.a : cA; const char* nB = has_next ? nxt.b : cB;
        for (int t = 0; t < nt; t += 2) {
            const bool last = (t == nt - 2);
            const char* a1 = cA + (size_t)(t + 1) * kstep;
            const char* a2 = last ? nA : cA + (size_t)(t + 2) * kstep; const char* b2 = last ? nB : cB + (size_t)(t + 2) * kstep;
            const char* a3 = a2 + kstep; const char* b3 = b2 + kstep;
            PG_LDB(B0, 0, 0); PG_SCHED; PG_LDA(At, 0, 0); PG_STAGE(PG_SA(1, 1), a1 + hstepA, voffA);
            PG_WAIT_L(8); PG_BAR; PG_WAIT_L(0); PG_MMA(0, 0, At, B0); PG_BAR; PG_SCHED;
            PG_LDB(B1, 0, 1); PG_STAGE(PG_SB(0, 0), b2, voffB);
            PG_BAR; PG_WAIT_L(0); PG_MMA(0, 1, At, B1); PG_BAR;
            PG_LDA(At, 0, 1); PG_STAGE(PG_SA(0, 0), a2, voffA);
            PG_BAR; PG_WAIT_L(0); PG_MMA(1, 0, At, B0); PG_BAR; PG_SCHED;
            PG_STAGE(PG_SB(0, 1), b2 + hstepB, voffB);
            PG_WAIT_V(6); PG_BAR; PG_MMA(1, 1, At, B1); PG_BAR;
            PG_LDB(B0, 1, 0); PG_SCHED; PG_LDA(At, 1, 0); PG_STAGE(PG_SA(0, 1), a2 + hstepA, voffA);
            PG_WAIT_L(8); PG_BAR; PG_WAIT_L(0); PG_MMA(0, 0, At, B0); PG_BAR; PG_SCHED;
            PG_LDB(B1, 1, 1); PG_STAGE(PG_SB(1, 0), b3, voffB);
            PG_BAR; PG_WAIT_L(0); PG_MMA(0, 1, At, B1); PG_BAR;
            PG_LDA(At, 1, 1); PG_STAGE(PG_SA(1, 0), a3, voffA);
            PG_BAR; PG_WAIT_L(0); PG_MMA(1, 0, At, B0); PG_BAR; PG_SCHED;
            PG_STAGE(PG_SB(1, 1), b3 + hstepB, voffB);
            PG_WAIT_V(6); PG_BAR; PG_MMA(1, 1, At, B1); PG_BAR;
        }
        E(acc, cur, wr, wc, fr, fq);
        if (!has_next) break;
#pragma unroll
        for (int a = 0; a < 2; ++a)
#pragma unroll
            for (int b = 0; b < 2; ++b)
#pragma unroll
                for (int m = 0; m < 4; ++m)
#pragma unroll
                    for (int n = 0; n < 2; ++n) acc[a][b][m][n] = (f32x4){0.f, 0.f, 0.f, 0.f};
        cur = nxt; cA = nA; cB = nB; ++ui;
    }
    PG_WAIT_V(0);
    if (wr == 0) PG_BAR;
    PG_BAR;
#undef PG_SA
#undef PG_SB
#undef PG_STAGE
#undef PG_LDA
#undef PG_LDB
#undef PG_MMA
#undef PG_WAIT_V
#undef PG_WAIT_L
#undef PG_BAR
#undef PG_SCHED
}

struct SchedG1 {
    const char *HX, *W1, *WV; int G, c;
    __device__ __forceinline__ bool next(int i, Unit& u) const {
        const int L = i * G + c, nmain = (NROW / 256) * (NP1 / 256);
        if (L < nmain) { static_map(L, NROW / 256, NP1 / 256, u.pm, u.pn); u.a = HX + (size_t)u.pm * 256 * DM * 2; u.b = W1 + (size_t)u.pn * 256 * DM * 2; u.aux = 0; return true; }
        const int idx = L - nmain; if (idx >= 3 * (NROW / 256)) return false;
        u.pm = idx % 3; u.pn = idx / 3; u.a = WV + (size_t)u.pm * 256 * DM * 2; u.b = HX + (size_t)u.pn * 256 * DM * 2; u.aux = 1; return true;
    }
};
struct SchedStatic {
    const char *A, *B; size_t tA, tB; int nM, nN, G, c;
    __device__ __forceinline__ bool next(int i, Unit& u) const {
        const int L = i * G + c; if (L >= nM * nN) return false;
        static_map(L, nM, nN, u.pm, u.pn); u.a = A + (size_t)u.pm * tA; u.b = B + (size_t)u.pn * tB; u.aux = 0; return true;
    }
};
struct SchedMerge {
    const char *BR, *W; int ntile, G, c;
    __device__ __forceinline__ bool next(int i, Unit& u) const {
        const int t = c + (i >> 2) * G; if (t >= ntile) return false;
        const int br = i & 3; u.pm = t >> 2; u.pn = t & 3; u.aux = br;
        u.a = BR + (size_t)u.pm * 256 * 2048 * 2 + (size_t)br * 512 * 2; u.b = W + (size_t)br * DM * 512 * 2 + (size_t)u.pn * 256 * 512 * 2; return true;
    }
};
struct SchedMoe {
    const char *A, *W; const int* off; size_t tA, wE, wT; int npan, NJ, G, c;
    __device__ __forceinline__ bool next(int i, Unit& u) const {
        const int L = i * G + c; if (L >= npan * NJ) return false;
        const int p = L / NJ, j = L % NJ; int e = 0;
#pragma unroll 1
        for (int q = 1; q < 32; ++q) if (p * 256 >= off[q]) e = q;
        e = __builtin_amdgcn_readfirstlane(e);
        u.pm = p; u.pn = j; u.aux = e; u.a = A + (size_t)p * tA; u.b = W + (size_t)e * wE + (size_t)j * wT; return true;
    }
};

#define PG_ROWCOL const int row0 = u.pm * BM + wr * 64 + fr, col0 = u.pn * BM + wc * 32 + 4 * fq
struct EpiG1 { bf16_t *P1, *VT; const float* rtab; const float* lbp; int layer;
    __device__ __forceinline__ void operator()(const f32x4 (&acc)[2][2][4][2], const Unit& u, int wr, int wc, int fr, int fq) const {
        const int row0 = u.pm * BM + wr * 64 + fr;
        if (u.aux || (u.pn >= 8 && u.pn <= 10)) {
            const int col0 = u.pn * BM + wc * 32 + 4 * fq; bf16_t* base = u.aux ? VT : P1; const size_t ld = u.aux ? (size_t)NROW : (size_t)NP1;
            const bool rope = !u.aux && (u.pm < NTOK / 256);
#pragma unroll
            for (int ai = 0; ai < 2; ++ai)
#pragma unroll
                for (int m = 0; m < 4; ++m) { const int r = row0 + ai * HALF + m * 16; bf16_t* rowp = base + (size_t)r * ld + col0;
#pragma unroll
                    for (int bj = 0; bj < 2; ++bj) {
                        f32x4 v0 = acc[ai][bj][m][0], v1 = acc[ai][bj][m][1];
                        if (rope && !(u.pn == 10 && bj == 1)) {
                            const int pos = r & (SEQ - 1), pp = (wc & 1) ? (pos & 63) : (pos >> 6); const float* tp = rtab + (pp * 16 + 4 * fq) * 2;
                            const f32x4 t0 = *(const f32x4*)tp, t1 = *(const f32x4*)(tp + 4);
                            const f32x4 a = v0, b = v1;
                            v0.x = a.x * t0.x - b.x * t0.y; v1.x = a.x * t0.y + b.x * t0.x; v0.y = a.y * t0.z - b.y * t0.w; v1.y = a.y * t0.w + b.y * t0.z;
                            v0.z = a.z * t1.x - b.z * t1.y; v1.z = a.z * t1.y + b.z * t1.x; v0.w = a.w * t1.z - b.w * t1.w; v1.w = a.w * t1.w + b.w * t1.z;
                        }
                        u32x2 o; o.x = pk2(v0.x, v0.y); o.y = pk2(v0.z, v0.w); *(u32x2*)(rowp + bj * HALF) = o;
                        o.x = pk2(v1.x, v1.y); o.y = pk2(v1.z, v1.w); *(u32x2*)(rowp + bj * HALF + 16) = o; } }
            return;
        }
        const int col0 = u.pn * BM + wc * 32 + 8 * fq;
        const int mode = (u.pn == 11 || u.pn == 12) ? 2 : ((u.pn >= 13 && u.pn <= 16) ? 3 : 0);
        if (mode == 3) {
            f32x4 lb4[2][2];
            const int z = (u.pn - 13) >> 1, cb = z * 512 + ((u.pn - 13) & 1) * 256 + wc * 32 + 8 * fq;
#pragma unroll
            for (int bj = 0; bj < 2; ++bj)
#pragma unroll
                for (int n = 0; n < 2; ++n) lb4[bj][n] = (layer == 0) ? (f32x4){0.f, 0.f, 0.f, 0.f} : *(const f32x4*)(lbp + cb + bj * HALF + 4 * n);
#pragma unroll
            for (int ai = 0; ai < 2; ++ai)
#pragma unroll
                for (int m = 0; m < 4; ++m) { bf16_t* rowp = P1 + (size_t)(row0 + ai * HALF + m * 16) * NP1 + col0;
#pragma unroll
                    for (int bj = 0; bj < 2; ++bj) { float gq[8];
#pragma unroll
                        for (int n = 0; n < 2; ++n)
#pragma unroll
                            for (int j = 0; j < 4; ++j) { const float f = acc[ai][bj][m][n][j], lb = lb4[bj][n][j]; const float t = __expf(-fabsf(f)), rr = __builtin_amdgcn_rcpf(1.f + t);
                                gq[4 * n + j] = __logf(fmaxf(lb + (1.f - lb) * ((f >= 0.f) ? rr : t * rr), 1e-37f)); }
                        u32x4 o; o.x = pk2(gq[0], gq[1]); o.y = pk2(gq[2], gq[3]); o.z = pk2(gq[4], gq[5]); o.w = pk2(gq[6], gq[7]); *(u32x4*)(rowp + bj * HALF) = o; } }
            return;
        }
#pragma unroll
        for (int ai = 0; ai < 2; ++ai)
#pragma unroll
            for (int m = 0; m < 4; ++m) { bf16_t* rowp = P1 + (size_t)(row0 + ai * HALF + m * 16) * NP1 + col0;
#pragma unroll
                for (int bj = 0; bj < 2; ++bj) {
                    f32x4 v0 = acc[ai][bj][m][0], v1 = acc[ai][bj][m][1];
                    if (mode == 2) {
#pragma unroll
                        for (int j = 0; j < 4; ++j) { v0[j] = v0[j] * __builtin_amdgcn_rcpf(1.f + __expf(-v0[j])); v1[j] = v1[j] * __builtin_amdgcn_rcpf(1.f + __expf(-v1[j])); }
                    }
                    u32x4 o; o.x = pk2(v0.x, v0.y); o.y = pk2(v0.z, v0.w); o.z = pk2(v1.x, v1.y); o.w = pk2(v1.z, v1.w); *(u32x4*)(rowp + bj * HALF) = o; } }
    }
};
#define PG_ROWCOL8 const int row0 = u.pm * BM + wr * 64 + fr, col0 = u.pn * BM + wc * 32 + 8 * fq
struct EpiGate { bf16_t* G;
    __device__ __forceinline__ void operator()(const f32x4 (&acc)[2][2][4][2], const Unit& u, int wr, int wc, int fr, int fq) const {
        PG_ROWCOL8;
#pragma unroll
        for (int ai = 0; ai < 2; ++ai)
#pragma unroll
            for (int m = 0; m < 4; ++m) { bf16_t* rowp = G + (size_t)(row0 + ai * HALF + m * 16) * NGATE + col0;
#pragma unroll
                for (int bj = 0; bj < 2; ++bj) { const f32x4 v0 = acc[ai][bj][m][0], v1 = acc[ai][bj][m][1]; u32x4 o;
                    o.x = pk2(sigmoidf_(v0.x), sigmoidf_(v0.y)); o.y = pk2(sigmoidf_(v0.z), sigmoidf_(v0.w)); o.z = pk2(sigmoidf_(v1.x), sigmoidf_(v1.y)); o.w = pk2(sigmoidf_(v1.z), sigmoidf_(v1.w));
                    *(u32x4*)(rowp + bj * HALF) = o; } }
    }
};
struct EpiMerge { const bf16_t* G; bf16_t* O;
    __device__ __forceinline__ void operator()(const f32x4 (&acc)[2][2][4][2], const Unit& u, int wr, int wc, int fr, int fq) const {
        PG_ROWCOL8; const int br = u.aux;
#pragma unroll
        for (int ai = 0; ai < 2; ++ai) {
            u32x4 g4[4][2], o4[4][2];
#pragma unroll
            for (int m = 0; m < 4; ++m) { const size_t r = (size_t)(row0 + ai * HALF + m * 16); const bf16_t* gp = G + r * NGATE + br * 1024 + col0; const bf16_t* rowp = O + r * DM + col0;
#pragma unroll
                for (int bj = 0; bj < 2; ++bj) { g4[m][bj] = *(const u32x4*)(gp + bj * HALF); if (br != 0) o4[m][bj] = *(const u32x4*)(rowp + bj * HALF); } }
#pragma unroll
            for (int m = 0; m < 4; ++m) { bf16_t* rowp = O + (size_t)(row0 + ai * HALF + m * 16) * DM + col0;
#pragma unroll
                for (int bj = 0; bj < 2; ++bj) { const f32x4 v0 = acc[ai][bj][m][0], v1 = acc[ai][bj][m][1]; const u32x4 gg = g4[m][bj];
                    float w[8] = {__uint_as_float(gg.x << 16) * v0.x, __uint_as_float(gg.x & 0xffff0000u) * v0.y, __uint_as_float(gg.y << 16) * v0.z, __uint_as_float(gg.y & 0xffff0000u) * v0.w,
                                  __uint_as_float(gg.z << 16) * v1.x, __uint_as_float(gg.z & 0xffff0000u) * v1.y, __uint_as_float(gg.w << 16) * v1.z, __uint_as_float(gg.w & 0xffff0000u) * v1.w};
                    if (br != 0) { const u32x4 oo = o4[m][bj];
                        w[0] += __uint_as_float(oo.x << 16); w[1] += __uint_as_float(oo.x & 0xffff0000u); w[2] += __uint_as_float(oo.y << 16); w[3] += __uint_as_float(oo.y & 0xffff0000u);
                        w[4] += __uint_as_float(oo.z << 16); w[5] += __uint_as_float(oo.z & 0xffff0000u); w[6] += __uint_as_float(oo.w << 16); w[7] += __uint_as_float(oo.w & 0xffff0000u); }
                    u32x4 o; o.x = pk2(w[0], w[1]); o.y = pk2(w[2], w[3]); o.z = pk2(w[4], w[5]); o.w = pk2(w[6], w[7]); *(u32x4*)(rowp + bj * HALF) = o; } }
            asm volatile("" ::: "memory");
        }
    }
};
struct EpiWout { const float *xlat, *xctx; float *olat, *octx; const float* modl;
    __device__ __forceinline__ void operator()(const f32x4 (&acc)[2][2][4][2], const Unit& u, int wr, int wc, int fr, int fq) const {
        PG_ROWCOL; const bool lat = u.pm < NTOK / 256; const int rb = lat ? (u.pm >> 4) : 4;
        const float* xin = lat ? xlat : xctx - (size_t)NTOK * DM; float* xo = lat ? olat : octx - (size_t)NTOK * DM; const float* m2 = modl + (size_t)rb * 6144 + 2 * 1024 + col0;
        f32x4 mv[2][2];
#pragma unroll
        for (int bj = 0; bj < 2; ++bj)
#pragma unroll
            for (int n = 0; n < 2; ++n) mv[bj][n] = *(const f32x4*)(m2 + bj * HALF + n * 16);
#pragma unroll
        for (int aq = 0; aq < 4; ++aq) { const int ai = aq >> 1, m0 = (aq & 1) * 2;
            f32x4 xv[4][2][2];
#pragma unroll
            for (int m = m0; m < m0 + 2; ++m) { const size_t o = (size_t)(row0 + ai * HALF + m * 16) * DM + col0;
#pragma unroll
                for (int bj = 0; bj < 2; ++bj)
#pragma unroll
                    for (int n = 0; n < 2; ++n) xv[m][bj][n] = *(const f32x4*)(xin + o + bj * HALF + n * 16); }
#pragma unroll
            for (int m = m0; m < m0 + 2; ++m) { const size_t o = (size_t)(row0 + ai * HALF + m * 16) * DM + col0;
#pragma unroll
                for (int bj = 0; bj < 2; ++bj)
#pragma unroll
                    for (int n = 0; n < 2; ++n) *(f32x4*)(xo + o + bj * HALF + n * 16) = ALPHA * xv[m][bj][n] + mv[bj][n] * acc[ai][bj][m][n]; }
            asm volatile("" ::: "memory");
        }
    }
};
struct EpiMoe1 { bf16_t* HID; const float* roww;
    __device__ __forceinline__ void operator()(const f32x4 (&acc)[2][2][4][2], const Unit& u, int wr, int wc, int fr, int fq) const {
        const int row0 = u.pm * BM + wr * 64 + fr, hc0 = u.pn * 128 + wc * 32 + 8 * fq;
#pragma unroll
        for (int ai = 0; ai < 2; ++ai)
#pragma unroll
            for (int m = 0; m < 4; ++m) { const int r = row0 + ai * HALF + m * 16; const float w = roww[r];
                const f32x4 g0 = acc[ai][0][m][0], g1 = acc[ai][0][m][1], u0 = acc[ai][1][m][0], u1 = acc[ai][1][m][1]; u32x4 o;
                o.x = pk2(siluf_(g0.x) * u0.x * w, siluf_(g0.y) * u0.y * w); o.y = pk2(siluf_(g0.z) * u0.z * w, siluf_(g0.w) * u0.w * w);
                o.z = pk2(siluf_(g1.x) * u1.x * w, siluf_(g1.y) * u1.y * w); o.w = pk2(siluf_(g1.z) * u1.z * w, siluf_(g1.w) * u1.w * w);
                *(u32x4*)(HID + (size_t)r * 256 + hc0) = o; }
    }
};
struct EpiMoe2 { bf16_t* Y; const int* rmap; bf16_t* dump;
    __device__ __forceinline__ void operator()(const f32x4 (&acc)[2][2][4][2], const Unit& u, int wr, int wc, int fr, int fq) const {
        PG_ROWCOL8;
#pragma unroll
        for (int ai = 0; ai < 2; ++ai)
#pragma unroll
            for (int m = 0; m < 4; ++m) { const int s = rmap[row0 + ai * HALF + m * 16];
                bf16_t* rowp = (s >= 0 ? Y + (size_t)s * DM : dump) + col0;
#pragma unroll
                for (int bj = 0; bj < 2; ++bj) { const f32x4 v0 = acc[ai][bj][m][0], v1 = acc[ai][bj][m][1]; u32x4 o; o.x = pk2(v0.x, v0.y); o.y = pk2(v0.z, v0.w); o.z = pk2(v1.x, v1.y); o.w = pk2(v1.z, v1.w); *(u32x4*)(rowp + bj * HALF) = o; } }
    }
};
#undef PG_ROWCOL8
#undef PG_ROWCOL
}

__device__ __forceinline__ void moe_offsets(Frame& F, int l, int* off) {
    if (F.tid < 64) {
        int v = (F.tid < 32) ? (((int)F.cnt()[l * 32 + F.tid] + 255) & ~255) : 0;
#pragma unroll
        for (int o = 1; o < 32; o <<= 1) { const int t = __shfl_up(v, o); if ((F.tid & 63) >= o) v += t; }
        if (F.tid < 32) off[F.tid + 1] = v;
        if (F.tid == 0) off[0] = 0;
    }
    __syncthreads();
}

__device__ __forceinline__ void phase_rope(Frame& F) {
    float* tab = F.smf;
    for (int e = F.tid; e < 1024; e += NTHR) { const int pp = e >> 4, i = e & 15; const float inv = powf(10000.f, -(float)i / 16.f), ang = (float)pp * inv; tab[2 * e] = cosf(ang); tab[2 * e + 1] = sinf(ang); }
    __syncthreads();
    const size_t total = (size_t)NTOK * 320;
    for (size_t idx = (size_t)F.bid * NTHR + F.tid; idx < total; idx += (size_t)F.nb * NTHR) {
        const int row = (int)(idx / 320), r = (int)(idx % 320), h = r >> 5, half = (r >> 4) & 1, i = r & 15;
        const int pos = row & (SEQ - 1), pp = half ? (pos & 63) : (pos >> 6);
        const float cs = tab[2 * (pp * 16 + i)], sn = tab[2 * (pp * 16 + i) + 1];
        bf16_t* base = F.P1() + (size_t)row * NP1 + (h < 8 ? PC_CQ + h * 64 : PC_CK + (h - 8) * 64) + half * 32 + i;
        const float u1 = bf2f(base[0]), u2 = bf2f(base[16]);
        base[0] = f2bf(u1 * cs - u2 * sn); base[16] = f2bf(u1 * sn + u2 * cs);
    }
}

__device__ __forceinline__ int seq_row(int s, int b, int z) {
    if (s < LC) { const int tc = z ? (LC - 1 - s) : s; return NTOK + b * LC + tc; }
    const int tl = s - LC, t = z ? (SEQ - 1 - tl) : tl; return b * SEQ + t;
}
typedef short bf16x8_t __attribute__((ext_vector_type(8)));
typedef short bf16x4_t __attribute__((ext_vector_type(4)));
struct MaskNone { __device__ __forceinline__ void operator()(f32x4&, f32x4&) const {} };
struct MaskNA { int u0; const float* brow;
    __device__ __forceinline__ void operator()(f32x4& s0, f32x4& s1) const {
        float v[8] = {s0.x, s0.y, s0.z, s0.w, s1.x, s1.y, s1.z, s1.w};
#pragma unroll
        for (int T = 0; T < 2; ++T)
#pragma unroll
            for (int rr = 0; rr < 4; ++rr) v[T * 4 + rr] = ((unsigned)(u0 + 16 * T + rr) < 16u) ? v[T * 4 + rr] + brow[16 * T + rr] : -INFINITY;
        s0 = (f32x4){v[0], v[1], v[2], v[3]}; s1 = (f32x4){v[4], v[5], v[6], v[7]};
    }
};
struct MaskWA { int i, j0;
    __device__ __forceinline__ void operator()(f32x4& s0, f32x4& s1) const {
        float v[8] = {s0.x, s0.y, s0.z, s0.w, s1.x, s1.y, s1.z, s1.w};
#pragma unroll
        for (int T = 0; T < 2; ++T)
#pragma unroll
            for (int rr = 0; rr < 4; ++rr) { const int j = j0 + 16 * T + rr; const bool ok = (j >= 0) && (j < SEQ) && (i - j <= 128) && (j - i <= 128);
                v[T * 4 + rr] = ok ? v[T * 4 + rr] : -INFINITY; }
        s0 = (f32x4){v[0], v[1], v[2], v[3]}; s1 = (f32x4){v[4], v[5], v[6], v[7]};
    }
};
struct KVF { bf16x8_t k[4]; bf16x4_t v[4][2]; };
__device__ __forceinline__ void kv_load(KVF& f, const char* kbase, unsigned ko0, unsigned ko1, const char* vbase, unsigned vo0, unsigned vo1) {
    f.k[0] = *(const bf16x8_t*)(kbase + ko0); f.k[1] = *(const bf16x8_t*)(kbase + ko0 + 64); f.k[2] = *(const bf16x8_t*)(kbase + ko1); f.k[3] = *(const bf16x8_t*)(kbase + ko1 + 64);
#pragma unroll
    for (int t = 0; t < 4; ++t) { f.v[t][0] = *(const bf16x4_t*)(vbase + vo0 + (unsigned)t * 16u * NROW * 2u); f.v[t][1] = *(const bf16x4_t*)(vbase + vo1 + (unsigned)t * 16u * NROW * 2u); }
}
__device__ __forceinline__ float xmax_g(float x) {
    auto r = __builtin_amdgcn_permlane16_swap(__float_as_uint(x), __float_as_uint(x), false, false); x = fmaxf(__uint_as_float(r[0]), __uint_as_float(r[1]));
    auto q = __builtin_amdgcn_permlane32_swap(__float_as_uint(x), __float_as_uint(x), false, false); return fmaxf(__uint_as_float(q[0]), __uint_as_float(q[1])); }
__device__ __forceinline__ float xsum_g(float x) {
    auto r = __builtin_amdgcn_permlane16_swap(__float_as_uint(x), __float_as_uint(x), false, false); x = __uint_as_float(r[0]) + __uint_as_float(r[1]);
    auto q = __builtin_amdgcn_permlane32_swap(__float_as_uint(x), __float_as_uint(x), false, false); return __uint_as_float(q[0]) + __uint_as_float(q[1]); }
template <class MaskF>
__device__ __forceinline__ void attn_tile(float& am, float& al, f32x4 (&ao)[4], const bf16x8_t (&qb)[2], const KVF& f, const MaskF& maskf) {
    f32x4 s0 = {0.f, 0.f, 0.f, 0.f}, s1 = {0.f, 0.f, 0.f, 0.f};
    s0 = __builtin_amdgcn_mfma_f32_16x16x32_bf16(f.k[0], qb[0], s0, 0, 0, 0); s0 = __builtin_amdgcn_mfma_f32_16x16x32_bf16(f.k[1], qb[1], s0, 0, 0, 0);
    s1 = __builtin_amdgcn_mfma_f32_16x16x32_bf16(f.k[2], qb[0], s1, 0, 0, 0); s1 = __builtin_amdgcn_mfma_f32_16x16x32_bf16(f.k[3], qb[1], s1, 0, 0, 0);
    maskf(s0, s1);
    const float mx = xmax_g(fmaxf(fmaxf(fmaxf(s0.x, s0.y), fmaxf(s0.z, s0.w)), fmaxf(fmaxf(s1.x, s1.y), fmaxf(s1.z, s1.w))));
    const float mn = fmaxf(am, mx);
    if (__any(mn != am)) {
        const float alpha = __builtin_amdgcn_exp2f(am - mn); am = mn; al *= alpha;
#pragma unroll
        for (int t = 0; t < 4; ++t) ao[t] = ao[t] * alpha;
    }
    f32x4 p0, p1;
    p0.x = __builtin_amdgcn_exp2f(s0.x - am); p0.y = __builtin_amdgcn_exp2f(s0.y - am); p0.z = __builtin_amdgcn_exp2f(s0.z - am); p0.w = __builtin_amdgcn_exp2f(s0.w - am);
    p1.x = __builtin_amdgcn_exp2f(s1.x - am); p1.y = __builtin_amdgcn_exp2f(s1.y - am); p1.z = __builtin_amdgcn_exp2f(s1.z - am); p1.w = __builtin_amdgcn_exp2f(s1.w - am);
    al += ((p0.x + p0.y) + (p0.z + p0.w)) + ((p1.x + p1.y) + (p1.z + p1.w));
    union { bf16x8_t v; unsigned u[4]; } pb;
    pb.u[0] = pk2(p0.x, p0.y); pb.u[1] = pk2(p0.z, p0.w); pb.u[2] = pk2(p1.x, p1.y); pb.u[3] = pk2(p1.z, p1.w);
#pragma unroll
    for (int t = 0; t < 4; ++t) {
        union { bf16x8_t v; bf16x4_t h[2]; } av; av.h[0] = f.v[t][0]; av.h[1] = f.v[t][1];
        ao[t] = __builtin_amdgcn_mfma_f32_16x16x32_bf16(av.v, pb.v, ao[t], 0, 0, 0);
    }
}
template <int kind>
__device__ __forceinline__ void attn_multi(Frame& F, int l, int item, const float* rpb_s) {
    constexpr int NQ = 2;
    constexpr int NLOC = (kind == 0) ? 9 : (kind == 1 ? 9 : 0), NS = 8 + NLOC;
    const int lane = F.lane, n = lane & 15, g = lane >> 4;
    const bf16_t* P1 = F.P1(); const bf16_t* VT = F.VT();
    int b, h0, kvh = 0, kcol, vrow, r = 0, cb = 0, t0 = 0, qrow0, qcol0, brcol0;
    constexpr int QRS = (kind == 0) ? 64 : (kind == 2 ? 16 : 0), QCS = (kind == 1 || kind == 3) ? 64 : 0;
    if (kind == 0) { cb = item & 3; r = ((item >> 2) & 31) * 2; h0 = (item >> 7) & 7; b = item >> 10; kcol = PC_BK + h0 * 64; vrow = h0 * 64; qrow0 = b * SEQ + r * 64 + cb * 16; qcol0 = PC_BQ + h0 * 64; brcol0 = 512 + h0 * 64; }
    else if (kind == 1) { const int hp = item & 1, qt = (item >> 1) & 255; kvh = (item >> 9) & 1; b = item >> 10; h0 = kvh * 4 + hp * 2; t0 = qt * 16; kcol = PC_CK + kvh * 64; vrow = 512 + kvh * 64; qrow0 = b * SEQ + t0; qcol0 = PC_CQ + h0 * 64; brcol0 = 1024 + h0 * 64; }
    else if (kind == 2) { const int qp = item & 7; h0 = (item >> 3) & 7; b = item >> 6; kcol = PC_BK + h0 * 64; vrow = h0 * 64; qrow0 = NTOK + b * LC + qp * 32; qcol0 = PC_BQ + h0 * 64; brcol0 = 512 + h0 * 64; }
    else { const int hp = item & 1, qt = (item >> 1) & 15; kvh = (item >> 5) & 1; b = item >> 6; h0 = kvh * 4 + hp * 2; kcol = PC_CK + kvh * 64; vrow = 512 + kvh * 64; qrow0 = NTOK + b * LC + qt * 16; qcol0 = PC_CQ + h0 * 64; brcol0 = 1024 + h0 * 64; }
    bf16x8_t qb[NQ][2]; float am[NQ], al[NQ]; f32x4 ao[NQ][4];
    { const char* qbase = (const char*)P1; const unsigned qo = (unsigned)(qrow0 + n) * (unsigned)(NP1 * 2) + (unsigned)(qcol0 + 8 * g) * 2u;
#pragma unroll
      for (int q = 0; q < NQ; ++q) { const unsigned o = qo + (unsigned)q * (unsigned)(QRS * NP1 * 2 + QCS * 2); qb[q][0] = *(const bf16x8_t*)(qbase + o); qb[q][1] = *(const bf16x8_t*)(qbase + o + 64);
        am[q] = -1e30f; al[q] = 0.f;
#pragma unroll
        for (int t = 0; t < 4; ++t) ao[q][t] = (f32x4){0.f, 0.f, 0.f, 0.f}; } }
    const int crow0 = NTOK + b * LC;
    const int w0 = (cb == 0) ? 0 : (cb == 1 ? 8 : (cb == 2 ? 24 : 32)), ru = min(max(r - 4, 0), 56);
    const char* kbase = (const char*)P1; const char* vbase = (const char*)VT;
    const unsigned kl = (unsigned)(kcol + 8 * g) * 2u, vl = (unsigned)(vrow + n) * (unsigned)NROW * 2u;
    auto load_step = [&](KVF& f, int s) {
        if (s < 8) { const unsigned ko = (unsigned)(crow0 + 32 * s + n) * (unsigned)(NP1 * 2) + kl, vo = vl + (unsigned)(crow0 + 32 * s + 4 * g) * 2u;
            kv_load(f, kbase, ko, ko + 16u * NP1 * 2u, vbase, vo, vo + 32u); }
        else if (kind == 0) { const int tok0 = b * SEQ + min(ru + (s - 8), 63) * 64 + w0; const unsigned ko = (unsigned)(tok0 + n) * (unsigned)(NP1 * 2) + kl, vo = vl + (unsigned)(tok0 + 4 * g) * 2u;
            kv_load(f, kbase, ko, ko + 16u * NP1 * 2u, vbase, vo, vo + 32u); }
        else if (kind == 1) { const int kb = t0 - 128 + 32 * (s - 8);
            const int ja = min(max(kb + n, 0), SEQ - 1), jb = min(max(kb + 16 + n, 0), SEQ - 1), va = min(max(kb + 4 * g, 0), SEQ - 4), vb = min(max(kb + 16 + 4 * g, 0), SEQ - 4);
            kv_load(f, kbase, (unsigned)(b * SEQ + ja) * (unsigned)(NP1 * 2) + kl, (unsigned)(b * SEQ + jb) * (unsigned)(NP1 * 2) + kl, vbase, vl + (unsigned)(b * SEQ + va) * 2u, vl + (unsigned)(b * SEQ + vb) * 2u); }
    };
    auto compute_step = [&](const KVF& f, int s) {
        if (s < 8) {
#pragma unroll
            for (int q = 0; q < NQ; ++q) { attn_tile(am[q], al[q], ao[q], qb[q], f, MaskNone()); if (NQ == 4) __builtin_amdgcn_sched_barrier(0); }
        } else if (kind == 0) {
            const int kr = ru + (s - 8);
#pragma unroll
            for (int q = 0; q < NQ; ++q) { const int rq = r + q, rsq = min(max(rq - 4, 0), 56);
                if (kr >= rsq && kr <= rsq + 7) { const int c = cb * 16 + n, csq = min(max(c - 8, 0), 48), kc0 = w0 + 4 * g;
                    MaskNA mk{kc0 - csq, rpb_s + (h0 * 15 + (kr - rq + 7)) * 64 + (kc0 - c + 15 + 16)}; attn_tile(am[q], al[q], ao[q], qb[q], f, mk); } }
        } else if (kind == 1) {
            const int ls = s - 8, kb = t0 - 128 + 32 * ls;
            if (ls >= 1 && ls <= 7 && kb >= 0 && kb + 31 < SEQ) {
#pragma unroll
                for (int q = 0; q < NQ; ++q) attn_tile(am[q], al[q], ao[q], qb[q], f, MaskNone());
            } else {
                MaskWA mk{t0 + n, kb + 4 * g};
#pragma unroll
                for (int q = 0; q < NQ; ++q) attn_tile(am[q], al[q], ao[q], qb[q], f, mk);
            }
        }
    };
    if (NQ == 2) {
        KVF fa, fb;
        load_step(fa, 0);
#pragma unroll 1
        for (int s = 0; s < NS; s += 2) {
            if (s + 1 < NS) load_step(fb, s + 1);
            compute_step(fa, s);
            if (s + 1 < NS) { if (s + 2 < NS) load_step(fa, s + 2); compute_step(fb, s + 1); }
        }
    } else {
        KVF fa;
#pragma unroll 1
        for (int s = 0; s < NS; ++s) { load_step(fa, s); compute_step(fa, s); }
    }
#pragma unroll
    for (int q = 0; q < NQ; ++q) {
        float lt = xsum_g(al[q]);
        float osc = 1.f;
        if (kind == 1 || kind == 3) { const float sk = F.p.wa_sink[l * 8 + h0 + q] * 1.44269504089f, mf = fmaxf(am[q], sk); osc = __builtin_amdgcn_exp2f(am[q] - mf); lt = lt * osc + __builtin_amdgcn_exp2f(sk - mf); }
        const float inv = osc / lt;
        char* obase = (char*)F.BR(); const unsigned oo = (unsigned)(qrow0 + q * QRS + n) * 4096u + (unsigned)(brcol0 + q * QCS + 4 * g) * 2u;
#pragma unroll
        for (int t = 0; t < 4; ++t) { const f32x4 v = ao[q][t] * inv; u32x2 o2; o2.x = pk2(v.x, v.y); o2.y = pk2(v.z, v.w); *(u32x2*)(obase + oo + 32u * t) = o2; }
    }
}

template <int DK, bool HG>
__device__ __forceinline__ void scan_mfma(Frame& F, int l, int b, int h, int z, unsigned char* lds) {
    constexpr int NDP = DK / 2, NTG = NTHR / NDP, TPT = 64 / NTG, QS = DK + 8, TS = 72, NDT = DK / 16;
    bf16_t* QD = (bf16_t*)lds; bf16_t* KD = QD + 64 * QS; bf16_t* KDT = KD + 64 * QS; bf16_t* VTs = KDT + DK * TS; bf16_t* AM = VTs + 128 * TS; bf16_t* ST = AM + 64 * TS;
    float* TOT = (float*)(ST + 128 * QS); float* E1s = TOT + NTG * DK; float* E2s = E1s + DK;
    REFRESH(F);
    const int tid = F.tid, lane = F.lane, w = F.wave, n = lane & 15, g = lane >> 4;
    const int dp = tid % NDP, tg = tid / NDP, vp = tid & 63, vg = tid >> 6;
    const bf16_t* P1 = F.P1();
    float lw[HG ? 2 : 32], lbias[2] = {0.f, 0.f}, lbv[2] = {0.f, 0.f};
    if (!HG) {
#pragma unroll
        for (int r = 0; r < 16; ++r) { const float* wp = F.p.gla_lr_w + ((size_t)(l * 2 + z) * 16 + r) * 256 + h * 64 + 2 * dp; lw[2 * r] = wp[0]; lw[2 * r + 1] = wp[1]; }
        lbias[0] = F.p.gla_lr_b[(l * 2 + z) * 256 + h * 64 + 2 * dp]; lbias[1] = F.p.gla_lr_b[(l * 2 + z) * 256 + h * 64 + 2 * dp + 1];
    } else { lw[0] = lw[1] = 0.f; if (l != 0) { lbv[0] = F.lb()[z * 512 + h * 128 + 2 * dp]; lbv[1] = F.lb()[z * 512 + h * 128 + 2 * dp + 1]; } }
    f32x4 accS[NDT];
#pragma unroll
    for (int i = 0; i < NDT; ++i) accS[i] = (f32x4){0.f, 0.f, 0.f, 0.f};
    unsigned rq[TPT], rk[TPT], rv[8]; u32x4 rl[HG ? 1 : TPT][2];
    const int qcol = HG ? PC_DQ + h * 128 + 2 * dp : PC_AQ + h * 64 + 2 * dp, kcol = HG ? PC_DF + z * 512 + h * 128 + 2 * dp : PC_AK + h * 64 + 2 * dp;
    const int vcol = (HG ? PC_DI : PC_AV) + h * 128 + 2 * vp;
    const char* p1b = (const char*)P1; const int sgn = z ? -1 : 1; const int rstep = sgn * NP1 * 2;
#define SCAN_LOAD(c) do { const int row0_ = seq_row((c) * 64, b, z); \
        int o_ = (row0_ + sgn * tg * TPT) * (NP1 * 2); \
        _Pragma("unroll") for (int tt = 0; tt < TPT; ++tt) { rq[tt] = *(const unsigned*)(p1b + (unsigned)(o_ + qcol * 2)); rk[tt] = *(const unsigned*)(p1b + (unsigned)(o_ + kcol * 2)); \
            if (!HG) { rl[tt][0] = *(const u32x4*)(p1b + (unsigned)(o_ + (PC_ALR + z * 16) * 2)); rl[tt][1] = *(const u32x4*)(p1b + (unsigned)(o_ + (PC_ALR + z * 16 + 8) * 2)); } o_ += rstep; } \
        int ov_ = (row0_ + sgn * vg * 8) * (NP1 * 2) + vcol * 2; \
        _Pragma("unroll") for (int tt = 0; tt < 8; ++tt) { rv[tt] = *(const unsigned*)(p1b + (unsigned)ov_); ov_ += rstep; } } while (0)
    SCAN_LOAD(0);
    constexpr int NCH = (LC + SEQ) / 64;
#pragma unroll 1
    for (int c = 0; c < NCH; ++c) {
        float qv[TPT][2], kv[TPT][2], cs[TPT][2];
#pragma unroll
        for (int tt = 0; tt < TPT; ++tt)
#pragma unroll
            for (int e = 0; e < 2; ++e) {
                const float qr = __uint_as_float(e ? (rq[tt] & 0xffff0000u) : (rq[tt] << 16)), kr = __uint_as_float(e ? (rk[tt] & 0xffff0000u) : (rk[tt] << 16));
                float gg;
                if (HG) {
                    gg = kr;
                    kv[tt][e] = 1.f - __expf(kr);
                    qv[tt][e] = qr;
                } else {
                    float lg = lbias[e];
                    const unsigned lr8[8] = {rl[tt][0].x, rl[tt][0].y, rl[tt][0].z, rl[tt][0].w, rl[tt][1].x, rl[tt][1].y, rl[tt][1].z, rl[tt][1].w};
#pragma unroll
                    for (int r2 = 0; r2 < 8; ++r2) { lg += __uint_as_float(lr8[r2] << 16) * lw[(2 * r2) * 2 + e]; lg += __uint_as_float(lr8[r2] & 0xffff0000u) * lw[(2 * r2 + 1) * 2 + e]; }
                    const float t = __expf(-fabsf(lg)), r = __builtin_amdgcn_rcpf(1.f + t);
                    gg = (fminf(lg, 0.f) + __logf(r)) * (1.f / 16.f);
                    kv[tt][e] = kr; qv[tt][e] = qr;
                }
                cs[tt][e] = gg + (tt ? cs[tt ? tt - 1 : 0][e] : 0.f);
            }
        TOT[tg * DK + 2 * dp] = cs[TPT - 1][0]; TOT[tg * DK + 2 * dp + 1] = cs[TPT - 1][1];
        __syncthreads();
        float offs[2] = {0.f, 0.f}, mid[2] = {0.f, 0.f}, lastv[2] = {0.f, 0.f};
#pragma unroll
        for (int t2 = 0; t2 < NTG; ++t2)
#pragma unroll
            for (int e = 0; e < 2; ++e) { const float tv = TOT[t2 * DK + 2 * dp + e]; if (t2 < tg) offs[e] += tv; if (t2 < NTG / 2) mid[e] += tv; lastv[e] += tv; }
        unsigned kdt[2][TPT / 2]; float kprev[2] = {0.f, 0.f};
#pragma unroll
        for (int tt = 0; tt < TPT; ++tt) {
            float qd[2], kd[2];
#pragma unroll
            for (int e = 0; e < 2; ++e) { const float x = fminf(fmaxf(cs[tt][e] + offs[e] - mid[e], -80.f), 80.f); qd[e] = qv[tt][e] * __expf(x); kd[e] = kv[tt][e] * __expf(-x); }
            const int tok = tg * TPT + tt;
            *(unsigned*)(QD + tok * QS + 2 * dp) = pk2(qd[0], qd[1]); *(unsigned*)(KD + tok * QS + 2 * dp) = pk2(kd[0], kd[1]);
            if (tt & 1) { kdt[0][tt >> 1] = pk2(kprev[0], kd[0]); kdt[1][tt >> 1] = pk2(kprev[1], kd[1]); } else { kprev[0] = kd[0]; kprev[1] = kd[1]; }
        }
#pragma unroll
        for (int e = 0; e < 2; ++e) {
            bf16_t* dst = KDT + (2 * dp + e) * TS + tg * TPT;
            if (TPT == 8) { u32x4 o; o.x = kdt[e][0]; o.y = kdt[e][1]; o.z = kdt[e][TPT / 2 - 2]; o.w = kdt[e][TPT / 2 - 1]; *(u32x4*)dst = o; }
            else { u32x2 o; o.x = kdt[e][0]; o.y = kdt[e][1]; *(u32x2*)dst = o; }
        }
        if (tg == 0) { E1s[2 * dp] = __expf(mid[0]); E1s[2 * dp + 1] = __expf(mid[1]); E2s[2 * dp] = __expf(lastv[0] - mid[0]); E2s[2 * dp + 1] = __expf(lastv[1] - mid[1]); }
        {   u32x4 o0, o1;
            o0.x = (rv[0] & 0xffffu) | (rv[1] << 16); o0.y = (rv[2] & 0xffffu) | (rv[3] << 16); o0.z = (rv[4] & 0xffffu) | (rv[5] << 16); o0.w = (rv[6] & 0xffffu) | (rv[7] << 16);
            o1.x = (rv[0] >> 16) | (rv[1] & 0xffff0000u); o1.y = (rv[2] >> 16) | (rv[3] & 0xffff0000u); o1.z = (rv[4] >> 16) | (rv[5] & 0xffff0000u); o1.w = (rv[6] >> 16) | (rv[7] & 0xffff0000u);
            *(u32x4*)(VTs + (2 * vp) * TS + vg * 8) = o0; *(u32x4*)(VTs + (2 * vp + 1) * TS + vg * 8) = o1; }
        if (c + 1 < NCH) SCAN_LOAD(c + 1);
        __syncthreads();
#pragma unroll
        for (int dt = 0; dt < NDT; ++dt) { accS[dt] = accS[dt] * *(const f32x4*)&E1s[16 * dt + 4 * g];
            u32x2 o; o.x = pk2(accS[dt].x, accS[dt].y); o.y = pk2(accS[dt].z, accS[dt].w); *(u32x2*)(ST + (16 * w + n) * QS + 16 * dt + 4 * g) = o; }
        {   const int it = w >> 1, jt0 = 2 * (w & 1);
            f32x4 d0 = {0.f, 0.f, 0.f, 0.f}, d1 = {0.f, 0.f, 0.f, 0.f};
            if (jt0 <= it) {
                bf16x8_t qf[DK / 32], k0f[DK / 32], k1f[DK / 32];
#pragma unroll
                for (int ks = 0; ks < DK / 32; ++ks) { qf[ks] = *(const bf16x8_t*)(QD + (16 * it + n) * QS + 32 * ks + 8 * g); k0f[ks] = *(const bf16x8_t*)(KD + (16 * jt0 + n) * QS + 32 * ks + 8 * g); k1f[ks] = *(const bf16x8_t*)(KD + (16 * (jt0 + 1) + n) * QS + 32 * ks + 8 * g); }
#pragma unroll
                for (int ks = 0; ks < DK / 32; ++ks) { d0 = __builtin_amdgcn_mfma_f32_16x16x32_bf16(k0f[ks], qf[ks], d0, 0, 0, 0); d1 = __builtin_amdgcn_mfma_f32_16x16x32_bf16(k1f[ks], qf[ks], d1, 0, 0, 0); }
                const int i = 16 * it + n, j0 = 16 * jt0 + 4 * g, j1 = j0 + 16;
                d0.x = (j0 + 0 <= i) ? d0.x : 0.f; d0.y = (j0 + 1 <= i) ? d0.y : 0.f; d0.z = (j0 + 2 <= i) ? d0.z : 0.f; d0.w = (j0 + 3 <= i) ? d0.w : 0.f;
                d1.x = (j1 + 0 <= i) ? d1.x : 0.f; d1.y = (j1 + 1 <= i) ? d1.y : 0.f; d1.z = (j1 + 2 <= i) ? d1.z : 0.f; d1.w = (j1 + 3 <= i) ? d1.w : 0.f;
            }
            u32x2 o; o.x = pk2(d0.x, d0.y); o.y = pk2(d0.z, d0.w); *(u32x2*)(AM + (16 * it + n) * TS + 16 * jt0 + 4 * g) = o;
            o.x = pk2(d1.x, d1.y); o.y = pk2(d1.z, d1.w); *(u32x2*)(AM + (16 * it + n) * TS + 16 * (jt0 + 1) + 4 * g) = o;
        }
        __syncthreads();
        {   f32x4 o[4];
#pragma unroll
            for (int it = 0; it < 4; ++it) o[it] = (f32x4){0.f, 0.f, 0.f, 0.f};
#pragma unroll
            for (int ks = 0; ks < 2; ++ks) { const bf16x8_t af = *(const bf16x8_t*)(VTs + (16 * w + n) * TS + 32 * ks + 8 * g); bf16x8_t bf[4];
#pragma unroll
                for (int it = 0; it < 4; ++it) bf[it] = *(const bf16x8_t*)(AM + (16 * it + n) * TS + 32 * ks + 8 * g);
#pragma unroll
                for (int it = 0; it < 4; ++it) o[it] = __builtin_amdgcn_mfma_f32_16x16x32_bf16(af, bf[it], o[it], 0, 0, 0); }
#pragma unroll
            for (int ks = 0; ks < DK / 32; ++ks) { const bf16x8_t af = *(const bf16x8_t*)(ST + (16 * w + n) * QS + 32 * ks + 8 * g); bf16x8_t bf[4];
#pragma unroll
                for (int it = 0; it < 4; ++it) bf[it] = *(const bf16x8_t*)(QD + (16 * it + n) * QS + 32 * ks + 8 * g);
#pragma unroll
                for (int it = 0; it < 4; ++it) o[it] = __builtin_amdgcn_mfma_f32_16x16x32_bf16(af, bf[it], o[it], 0, 0, 0); }
            const int row0 = seq_row(c * 64, b, z) + sgn * n;
            char* dstb; unsigned doff; int dstride;
            if (HG) { dstb = (char*)F.P1(); doff = (unsigned)row0 * (unsigned)(NP1 * 2) + (unsigned)(PC_DF + z * 512 + h * 128 + 16 * w + 4 * g) * 2u; dstride = sgn * 16 * NP1 * 2; }
            else if (z == 0) { dstb = (char*)F.BR(); doff = (unsigned)row0 * 4096u + (unsigned)(h * 128 + 16 * w + 4 * g) * 2u; dstride = sgn * 16 * 4096; }
            else { dstb = (char*)F.OBA(); doff = (unsigned)row0 * 1024u + (unsigned)(h * 128 + 16 * w + 4 * g) * 2u; dstride = sgn * 16 * 1024; }
#pragma unroll
            for (int it = 0; it < 4; ++it) { u32x2 o2; o2.x = pk2(o[it].x, o[it].y); o2.y = pk2(o[it].z, o[it].w); *(u32x2*)(dstb + (unsigned)((int)doff + it * dstride)) = o2; }
        }
#pragma unroll
        for (int ks = 0; ks < 2; ++ks) { const bf16x8_t bv = *(const bf16x8_t*)(VTs + (16 * w + n) * TS + 32 * ks + 8 * g); bf16x8_t af[NDT];
#pragma unroll
            for (int dt = 0; dt < NDT; ++dt) af[dt] = *(const bf16x8_t*)(KDT + (16 * dt + n) * TS + 32 * ks + 8 * g);
#pragma unroll
            for (int dt = 0; dt < NDT; ++dt) accS[dt] = __builtin_amdgcn_mfma_f32_16x16x32_bf16(af[dt], bv, accS[dt], 0, 0, 0); }
#pragma unroll
        for (int dt = 0; dt < NDT; ++dt) accS[dt] = accS[dt] * *(const f32x4*)&E2s[16 * dt + 4 * g];
        __syncthreads();
    }
#undef SCAN_LOAD
}

__device__ __forceinline__ void phase_mix(Frame& F, int l) {
    const int n_scan = 64;
    const int nsb = (F.nb > 128) ? 64 : 0;
    if (nsb == 0 || F.bid < nsb) {
        for (int it = F.bid; it < n_scan; it += (nsb ? nsb : F.nb)) {
            const int br = it >> 5, r = it & 31, b = r >> 3, h = (r >> 1) & 3, z = r & 1;
            if (br == 0) scan_mfma<64, false>(F, l, b, h, z, (unsigned char*)F.smf); else scan_mfma<128, true>(F, l, b, h, z, (unsigned char*)F.smf);
        }
        __syncthreads();
    }
    float* rpb_s = F.smf;
    for (int i = F.tid; i < 8 * 15 * 64; i += NTHR) { const int dcp = i & 63, hr = i >> 6; rpb_s[i] = (dcp >= 16 && dcp < 47) ? F.p.na_rpb[(size_t)l * 8 * 465 + hr * 31 + (dcp - 16)] * 1.44269504089f : 0.f; }
    __syncthreads();
    unsigned* qhead = F.cnt() + 64 + l * 16;
    const int n_wa = 4096, n_na = 4096, n_cna = (l == 0) ? 256 : 0, n_cwa = (l == 0) ? 256 : 0, total = n_wa + n_na + n_cna + n_cwa;
    for (;;) {
        int it = 0; if (F.lane == 0) it = (int)atomicAdd(qhead, 1u);
        it = __builtin_amdgcn_readfirstlane(it);
        if (it >= total) break;
        if (it < n_wa) attn_multi<1>(F, l, it, rpb_s);
        else if (it < n_wa + n_na) attn_multi<0>(F, l, it - n_wa, rpb_s);
        else if (it < n_wa + n_na + n_cna) attn_multi<2>(F, l, it - n_wa - n_na, rpb_s);
        else attn_multi<3>(F, l, it - n_wa - n_na - n_cna, rpb_s);
    }
}

__device__ __forceinline__ void phase_prepad(Frame& F, int l) {
    const int gw = F.bid * 8 + F.wave, ngw = F.nb * 8, npairs = ((l == 0) ? NROW : NTOK) / 2, c0 = F.lane * 8;
    for (int pi = gw; pi < npairs; pi += ngw) {
        u32x4 ra[2][2], rb[2][2], rg[2][2];
#pragma unroll
        for (int q = 0; q < 2; ++q) { const size_t row = (size_t)pi * 2 + q;
            ra[q][0] = *(const u32x4*)(F.BR() + row * 2048 + c0); rb[q][0] = *(const u32x4*)(F.OBA() + row * 512 + c0); rg[q][0] = *(const u32x4*)(F.P1() + row * NP1 + PC_AG + c0);
            ra[q][1] = *(const u32x4*)(F.P1() + row * NP1 + PC_DF + c0); rb[q][1] = *(const u32x4*)(F.P1() + row * NP1 + PC_DF + 512 + c0); rg[q][1] = *(const u32x4*)(F.P1() + row * NP1 + PC_DG + c0); }
#pragma unroll
        for (int q = 0; q < 2; ++q)
#pragma unroll
            for (int br = 0; br < 2; ++br) {
                const unsigned ua[4] = {ra[q][br].x, ra[q][br].y, ra[q][br].z, ra[q][br].w}, ub[4] = {rb[q][br].x, rb[q][br].y, rb[q][br].z, rb[q][br].w}, ug[4] = {rg[q][br].x, rg[q][br].y, rg[q][br].z, rg[q][br].w};
                float o[8], g[8]; float ss = 0.f;
#pragma unroll
                for (int j = 0; j < 4; ++j) { o[2 * j] = __uint_as_float(ua[j] << 16) + __uint_as_float(ub[j] << 16); o[2 * j + 1] = __uint_as_float(ua[j] & 0xffff0000u) + __uint_as_float(ub[j] & 0xffff0000u);
                    g[2 * j] = __uint_as_float(ug[j] << 16); g[2 * j + 1] = __uint_as_float(ug[j] & 0xffff0000u); ss += o[2 * j] * o[2 * j] + o[2 * j + 1] * o[2 * j + 1]; }
                ss += __shfl_xor(ss, 1); ss += __shfl_xor(ss, 2); ss += __shfl_xor(ss, 4); ss += __shfl_xor(ss, 8);
                const float rs = rsqrtf(ss * (1.f / 128.f) + 1e-6f);
#pragma unroll
                for (int j = 0; j < 8; ++j) o[j] = o[j] * rs * siluf_(g[j]);
                st8(F.BR() + ((size_t)pi * 2 + q) * 2048 + (br ? 1536 : 0) + c0, o);
            }
    }
}

__device__ __forceinline__ void phase_ln1(Frame& F, int l) {
    const int nrows = (l == 0) ? NROW : NTOK, ngroups = nrows / 64;
    const float* lg = F.p.ln_g + (size_t)(l * 2 + 0) * DM; const float* lbb = F.p.ln_b + (size_t)(l * 2 + 0) * DM;
    float* part = F.smf;
    const int wv = __builtin_amdgcn_readfirstlane(F.wave);
    float* stg = F.smf + 8 * 36 * 64 + wv * (64 * 17 + 16 * 40);
    float* wl = stg + 64 * 17;
    for (int grp = F.bid; grp < ngroups; grp += F.nb) {
        const int row0 = grp * 64, rb = row_batch(row0);
        const float* mv = F.modv() + ((size_t)l * 5 + rb) * 6144;
        float* xg = row0 < NTOK ? F.p.out + (size_t)row0 * DM : F.cxm() + (size_t)(row0 - NTOK) * DM;
#pragma unroll 1
        for (int rr = 0; rr < 8; rr += 2) {
            const int lr = wv * 8 + rr; float* xr = xg + (size_t)lr * DM;
            f32x4 v[2][4]; float s[2] = {0.f, 0.f};
#pragma unroll
            for (int q = 0; q < 2; ++q)
#pragma unroll
                for (int j = 0; j < 4; ++j) v[q][j] = *(const f32x4*)(xr + (size_t)q * DM + j * 256 + F.lane * 4);
#pragma unroll
            for (int q = 0; q < 2; ++q)
#pragma unroll
                for (int j = 0; j < 4; ++j) s[q] += (v[q][j].x + v[q][j].y) + (v[q][j].z + v[q][j].w);
#pragma unroll
            for (int o = 1; o < 64; o <<= 1) { s[0] += __shfl_xor(s[0], o); s[1] += __shfl_xor(s[1], o); }
            float s2[2] = {0.f, 0.f};
#pragma unroll
            for (int q = 0; q < 2; ++q) { const float mean = s[q] * (1.f / DM);
#pragma unroll
                for (int j = 0; j < 4; ++j) { v[q][j] = v[q][j] - mean; s2[q] += (v[q][j].x * v[q][j].x + v[q][j].y * v[q][j].y) + (v[q][j].z * v[q][j].z + v[q][j].w * v[q][j].w); } }
#pragma unroll
            for (int o = 1; o < 64; o <<= 1) { s2[0] += __shfl_xor(s2[0], o); s2[1] += __shfl_xor(s2[1], o); }
#pragma unroll
            for (int j = 0; j < 4; ++j) { const int d = j * 256 + F.lane * 4;
                const f32x4 g4 = *(const f32x4*)(lg + d), b4 = *(const f32x4*)(lbb + d), m3 = *(const f32x4*)(mv + 3 * 1024 + d), m4 = *(const f32x4*)(mv + 4 * 1024 + d);
#pragma unroll
                for (int q = 0; q < 2; ++q) { const float rstd = rsqrtf(s2[q] * (1.f / DM) + LN_EPS);
                    const f32x4 xn = v[q][j] * rstd * g4 + b4;
                    *(f32x4*)(xr + (size_t)q * DM + d) = xn;
                    const f32x4 h2 = xn * (1.f + m4) + m3;
                    u32x2 o2; o2.x = pk2(h2.x, h2.y); o2.y = pk2(h2.z, h2.w);
                    *(u32x2*)(F.HX2() + (size_t)(row0 + lr + q) * DM + d) = o2; } }
        }
        __syncthreads();
        {   f32x4 acc[4][3];
#pragma unroll
            for (int mt = 0; mt < 4; ++mt)
#pragma unroll
                for (int nt = 0; nt < 3; ++nt) acc[mt][nt] = (f32x4){0.f, 0.f, 0.f, 0.f};
            const float* wgp = F.p.moe_w_group + ((size_t)l * DM + wv * 128) * 4; const float* wep = F.p.moe_w_expert + ((size_t)l * DM + wv * 128) * 32;
            const float* m3p = mv + 3 * 1024 + wv * 128; const float* m4p = mv + 4 * 1024 + wv * 128;
            const int ln = F.lane & 15, lk = F.lane >> 4;
#pragma unroll 1
            for (int dc = 0; dc < 128; dc += 16) {
                f32x4 t[4]; float bw[4][3];
#pragma unroll
                for (int i = 0; i < 4; ++i) t[i] = *(const f32x4*)(xg + (size_t)(16 * i + (F.lane >> 2)) * DM + wv * 128 + dc + (F.lane & 3) * 4);
                const f32x4 m3v = *(const f32x4*)(m3p + dc + (F.lane & 3) * 4), m4v = *(const f32x4*)(m4p + dc + (F.lane & 3) * 4);
#pragma unroll
                for (int ks = 0; ks < 4; ++ks) { const int d = dc + 4 * ks + lk; bw[ks][0] = wep[(size_t)d * 32 + ln]; bw[ks][1] = wep[(size_t)d * 32 + 16 + ln]; bw[ks][2] = (ln < 4) ? wgp[(size_t)d * 4 + ln] : 0.f; }
#pragma unroll
                for (int i = 0; i < 4; ++i) { float* sp = stg + (16 * i + (F.lane >> 2)) * 17 + (F.lane & 3) * 4;
                    sp[0] = t[i].x * (1.f + m4v.x) + m3v.x; sp[1] = t[i].y * (1.f + m4v.y) + m3v.y; sp[2] = t[i].z * (1.f + m4v.z) + m3v.z; sp[3] = t[i].w * (1.f + m4v.w) + m3v.w; }
                asm volatile("s_waitcnt lgkmcnt(0)" ::: "memory");
#pragma unroll
                for (int ks = 0; ks < 4; ++ks)
#pragma unroll
                    for (int mt = 0; mt < 4; ++mt) { const float av = stg[(16 * mt + ln) * 17 + 4 * ks + lk];
#pragma unroll
                        for (int nt = 0; nt < 3; ++nt) acc[mt][nt] = __builtin_amdgcn_mfma_f32_16x16x4f32(av, bw[ks][nt], acc[mt][nt], 0, 0, 0); }
                asm volatile("s_waitcnt lgkmcnt(0)" ::: "memory");
            }
#pragma unroll
            for (int mt = 0; mt < 4; ++mt)
#pragma unroll
                for (int nt = 0; nt < 3; ++nt) { const int oi = (nt == 2) ? ln : 4 + 16 * nt + ln;
                    if (nt < 2 || ln < 4) {
#pragma unroll
                        for (int r = 0; r < 4; ++r) part[(wv * 36 + oi) * 64 + 16 * mt + 4 * lk + r] = acc[mt][nt][r]; } }
        }
        __syncthreads();
        if (wv == 0) {
            const int row = row0 + F.lane;
            float gl[4]; int gi = 0; float gm = -3.4e38f;
#pragma unroll
            for (int o = 0; o < 4; ++o) { float t = F.p.moe_b_group[l * 4 + o];
#pragma unroll
                for (int w2 = 0; w2 < 8; ++w2) t += part[(w2 * 36 + o) * 64 + F.lane];
                gl[o] = t; if (t > gm) { gm = t; gi = o; } }
            float gs = 0.f;
#pragma unroll
            for (int o = 0; o < 4; ++o) gs += expf(gl[o] - gm);
            const float gwt = 1.f / gs;
            float e1 = -3.4e38f, e2 = -3.4e38f; int i1 = 0, i2 = 0;
#pragma unroll
            for (int o8 = 0; o8 < 8; ++o8) { const int o = gi * 8 + o8; float ev = F.p.moe_b_expert[l * 32 + o];
#pragma unroll
                for (int w2 = 0; w2 < 8; ++w2) ev += part[(w2 * 36 + 4 + o) * 64 + F.lane];
                if (ev > e1) { e2 = e1; i2 = i1; e1 = ev; i1 = o; } else if (ev > e2) { e2 = ev; i2 = o; } }
            const float w1 = 1.f / (1.f + expf(e2 - e1)), w2v = 1.f - w1;
            unsigned* lh = (unsigned*)(stg + 64 * 17 + 16 * 40 - 64);
            if (F.lane < 32) lh[F.lane] = 0u;
            asm volatile("s_waitcnt lgkmcnt(0)" ::: "memory");
            const unsigned r1 = atomicAdd(&lh[i1], 1u), r2 = atomicAdd(&lh[i2], 1u);
            asm volatile("s_waitcnt lgkmcnt(0)" ::: "memory");
            if (F.lane < 32) { const unsigned c = lh[F.lane]; lh[32 + F.lane] = c ? atomicAdd(&F.cnt()[l * 32 + F.lane], c) : 0u; }
            asm volatile("s_waitcnt vmcnt(0) lgkmcnt(0)" ::: "memory");
            const unsigned p1 = lh[32 + i1] + r1, p2 = lh[32 + i2] + r2;
            F.tokE()[row * 2] = i1; F.tokI()[row * 2] = (int)p1; F.tokW()[row * 2] = gwt * w1;
            F.tokE()[row * 2 + 1] = i2; F.tokI()[row * 2 + 1] = (int)p2; F.tokW()[row * 2 + 1] = gwt * w2v;
        }
        __syncthreads();
    }
}

__device__ __forceinline__ void phase_gather(Frame& F, int l) {
    int* off = (int*)F.smf; moe_offsets(F, l, off);
    const int gw = F.bid * 8 + F.wave, ngw = F.nb * 8, nrows = (l == 0) ? NROW : NTOK;
    for (int s0 = gw; s0 < 2 * nrows; s0 += 4 * ngw) {
        int sl[4], e[4], ti[4]; float tw[4]; u32x4 a0[4], a1[4];
#pragma unroll
        for (int q = 0; q < 4; ++q) { sl[q] = min(s0 + q * ngw, 2 * nrows - 1); e[q] = F.tokE()[sl[q]]; ti[q] = F.tokI()[sl[q]]; tw[q] = F.tokW()[sl[q]];
            const u32x4* src = (const u32x4*)(F.HX2() + (size_t)(sl[q] >> 1) * DM); a0[q] = src[F.lane]; a1[q] = src[F.lane + 64]; }
#pragma unroll
        for (int q = 0; q < 4; ++q) if (s0 + q * ngw < 2 * nrows) { const int dst = off[e[q]] + ti[q]; u32x4* d = (u32x4*)(F.XS() + (size_t)dst * DM);
            d[F.lane] = a0[q]; d[F.lane + 64] = a1[q];
            if (F.lane == 0) { F.rmap()[dst] = sl[q]; F.roww()[dst] = tw[q]; } }
    }
    for (int e = 0; e < 32; ++e) {
        const int c = (int)F.cnt()[l * 32 + e], pc = (c + 255) & ~255;
        for (int j = c + gw; j < pc; j += ngw) { const int dst = off[e] + j; u32x4* d = (u32x4*)(F.XS() + (size_t)dst * DM);
            const u32x4 z = {0u, 0u, 0u, 0u}; d[F.lane] = z; d[F.lane + 64] = z;
            if (F.lane == 0) { F.rmap()[dst] = -1; F.roww()[dst] = 0.f; } }
    }
}
__device__ __forceinline__ int expert_of_row(const int* off, int row) { int e = 0;
#pragma unroll 1
    for (int i = 1; i < 32; ++i) if (row >= off[i]) e = i;
    return e; }

__device__ __forceinline__ void phase_ln2(Frame& F, int l) {
    const int gw = F.bid * 8 + F.wave, ngw = F.nb * 8, npairs = ((l == 0) ? NROW : NTOK) / 2;
    const float* lg = F.p.ln_g + (size_t)(l * 2 + 1) * DM; const float* lbb = F.p.ln_b + (size_t)(l * 2 + 1) * DM;
    const bf16_t* Y = F.BR();
    const bool tmo_set = (l == DEPTH - 1) && (__hip_atomic_load((unsigned*)(F.ws + WS_CTL) + XB_TMO, __ATOMIC_RELAXED, __HIP_MEMORY_SCOPE_AGENT) != 0u);
    for (int pi = gw; pi < npairs; pi += ngw) {
        const int row0 = pi * 2, rb = row_batch(row0);
        const float* xm = row0 < NTOK ? F.p.out + (size_t)row0 * DM : F.cxm() + (size_t)(row0 - NTOK) * DM;
        float* xo = row0 < NTOK ? F.p.out + (size_t)row0 * DM : F.cxo() + (size_t)(row0 - NTOK) * DM;
        const float* mv = F.modv() + ((size_t)l * 5 + rb) * 6144;
        u32x2 y0[2][4], y1[2][4]; f32x4 xv[2][4], m5[4];
#pragma unroll
        for (int j = 0; j < 4; ++j) { const int d = j * 256 + F.lane * 4; m5[j] = *(const f32x4*)(mv + 5 * 1024 + d);
#pragma unroll
            for (int q = 0; q < 2; ++q) { y0[q][j] = *(const u32x2*)(Y + (size_t)((row0 + q) * 2) * DM + d); y1[q][j] = *(const u32x2*)(Y + (size_t)((row0 + q) * 2 + 1) * DM + d); xv[q][j] = *(const f32x4*)(xm + (size_t)q * DM + d); } }
        f32x4 v[2][4]; float s[2] = {0.f, 0.f};
#pragma unroll
        for (int q = 0; q < 2; ++q)
#pragma unroll
            for (int j = 0; j < 4; ++j) { f32x4 y; y.x = __uint_as_float(y0[q][j].x << 16) + __uint_as_float(y1[q][j].x << 16); y.y = __uint_as_float(y0[q][j].x & 0xffff0000u) + __uint_as_float(y1[q][j].x & 0xffff0000u);
                y.z = __uint_as_float(y0[q][j].y << 16) + __uint_as_float(y1[q][j].y << 16); y.w = __uint_as_float(y0[q][j].y & 0xffff0000u) + __uint_as_float(y1[q][j].y & 0xffff0000u);
                v[q][j] = ALPHA * xv[q][j] + m5[j] * y; s[q] += (v[q][j].x + v[q][j].y) + (v[q][j].z + v[q][j].w); }
#pragma unroll
        for (int o = 1; o < 64; o <<= 1) { s[0] += __shfl_xor(s[0], o); s[1] += __shfl_xor(s[1], o); }
        float s2[2] = {0.f, 0.f};
#pragma unroll
        for (int q = 0; q < 2; ++q) { const float mean = s[q] * (1.f / DM);
#pragma unroll
            for (int j = 0; j < 4; ++j) { v[q][j] = v[q][j] - mean; s2[q] += (v[q][j].x * v[q][j].x + v[q][j].y * v[q][j].y) + (v[q][j].z * v[q][j].z + v[q][j].w * v[q][j].w); } }
#pragma unroll
        for (int o = 1; o < 64; o <<= 1) { s2[0] += __shfl_xor(s2[0], o); s2[1] += __shfl_xor(s2[1], o); }
        const float* mn = F.modv() + ((size_t)((l + 1 < DEPTH) ? l + 1 : l) * 5 + rb) * 6144;
#pragma unroll
        for (int j = 0; j < 4; ++j) { const int d = j * 256 + F.lane * 4;
            const f32x4 g4 = *(const f32x4*)(lg + d), b4 = *(const f32x4*)(lbb + d), m0 = *(const f32x4*)(mn + d), m1 = *(const f32x4*)(mn + 1024 + d);
#pragma unroll
            for (int q = 0; q < 2; ++q) { const float rstd = rsqrtf(s2[q] * (1.f / DM) + LN_EPS);
                f32x4 xn = v[q][j] * rstd * g4 + b4;
                if (tmo_set) xn = xn * __uint_as_float(0x7fc00000u);
                *(f32x4*)(xo + (size_t)q * DM + d) = xn;
                if (l + 1 < DEPTH) { const f32x4 h = xn * (1.f + m1) + m0; u32x2 o2; o2.x = pk2(h.x, h.y); o2.y = pk2(h.z, h.w); *(u32x2*)(F.HX() + (size_t)(row0 + q) * DM + d) = o2; } }
        }
    }
}

constexpr int NPL = 12, NPH = 1 + DEPTH * NPL;
__global__ void __launch_bounds__(NTHR, 2) mega(Params p) {
    extern __shared__ __attribute__((aligned(16))) unsigned char smem[];
    Frame F; F.p = p; F.bid = blockIdx.x; F.nb = gridDim.x; F.tid = threadIdx.x; F.lane = threadIdx.x & 63; F.wave = threadIdx.x >> 6; F.wid_s = __builtin_amdgcn_readfirstlane(threadIdx.x >> 6);
    F.smf = (float*)(smem + LDS_STAGE);
    LAS unsigned char* stage = (LAS unsigned char*)smem + LDS_STAGE; int* offt = (int*)(smem + 64);
    unsigned char* ws = p.ws; F.ws = ws;

    if (threadIdx.x == 0) *(uint4*)smem = make_uint4(0u, 0u, 0u, 0u);
    __syncthreads();
    unsigned* barw = (unsigned*)(ws + WS_CTL);
    XcdBarrier bar; bar.bar = barw; bar.x = 0; bar.st = (volatile LAS unsigned*)smem;
    const bool multi = (p.ph_hi - p.ph_lo) > 1;
    if (multi) bar = xcd_barrier_post(barw, (volatile LAS unsigned*)smem);
    const int lo = p.ph_lo, hi = p.ph_hi;
#define IN(k) (lo <= (k) && (k) < hi)
#define SEAM(k) do { if (IN(k) && IN((k) + 1)) xcd_barrier(bar); else __syncthreads(); } while (0)

    if (IN(0)) { REFRESH(F); phase_mod(F); __syncthreads(); phase_conv_a(F, 0); }
    SEAM(0);
#pragma unroll 1
    for (int l = 0; l < DEPTH; ++l) {
        const int pb = 1 + l * NPL;
        const float* xlat = (l == 0) ? p.x : p.out; const float* xctx = (l == 0) ? p.ctx : F.cxo();
        const int Mrows = (l == 0) ? NROW : NTOK;
        if (IN(pb + 0)) { REFRESH(F); if (l == 0) phase_prep(F, 0, p.x, p.ctx); else phase_conv_a(F, l); }
        SEAM(pb + 0);
        if (IN(pb + 1)) { REFRESH(F);
            float* rtab = (float*)(smem + LDS_ROPE);
            for (int e = F.tid; e < 1024; e += NTHR) { const int pp = e >> 4, i = e & 15; const float inv = powf(10000.f, -(float)i / 16.f), ang = (float)pp * inv; rtab[2 * e] = cosf(ang); rtab[2 * e + 1] = sinf(ang); }
            __syncthreads();
            pg::SchedG1 S{(const char*)F.HX(), (const char*)F.W1t(), (const char*)F.Wvt(), F.nb, F.bid}; pg::EpiG1 E{F.P1(), F.VT(), rtab, F.lb(), l};
            pg::gemm_phase(stage, DM, DM, DM, S, E);
        }
        SEAM(pb + 1);
        if (IN(pb + 2)) { REFRESH(F); phase_mix(F, l); }
        SEAM(pb + 2);
        if (IN(pb + 3)) { REFRESH(F); phase_prepad(F, l); }
        SEAM(pb + 3);
        if (IN(pb + 4)) { REFRESH(F);
            pg::SchedStatic S{(const char*)F.HX(), (const char*)F.Wgt(), (size_t)256 * DM * 2, (size_t)256 * DM * 2, Mrows / 256, NGATE / 256, F.nb, F.bid}; pg::EpiGate E{F.G()};
            pg::gemm_phase(stage, DM, DM, DM, S, E);
            __syncthreads();
            phase_conv_b(F, l);
        }
        SEAM(pb + 4);
        if (IN(pb + 5)) { REFRESH(F);
            pg::SchedMerge S{(const char*)F.BR(), (const char*)F.Wbrt(), (Mrows / 256) * 4, F.nb, F.bid}; pg::EpiMerge E{F.G(), F.HX()};
            pg::gemm_phase(stage, 2048, 512, 512, S, E);
        }
        SEAM(pb + 5);
        if (IN(pb + 6)) { REFRESH(F);
            pg::SchedStatic S{(const char*)F.HX(), (const char*)F.Woutt(), (size_t)256 * DM * 2, (size_t)256 * DM * 2, Mrows / 256, DM / 256, F.nb, F.bid};
            pg::EpiWout E{xlat, xctx, p.out, F.cxm(), F.modv() + (size_t)l * 5 * 6144};
            pg::gemm_phase(stage, DM, DM, DM, S, E);
        }
        SEAM(pb + 6);
        if (IN(pb + 7)) { REFRESH(F); phase_ln1(F, l); }
        SEAM(pb + 7);
        if (IN(pb + 8)) { REFRESH(F); phase_gather(F, l); }
        SEAM(pb + 8);
        if (IN(pb + 9)) { REFRESH(F);
            moe_offsets(F, l, offt);
            pg::SchedMoe S{(const char*)F.XS(), (const char*)F.Wgu(), offt, (size_t)256 * DM * 2, (size_t)512 * DM * 2, (size_t)256 * DM * 2, offt[32] / 256, 2, F.nb, F.bid};
            pg::EpiMoe1 E{F.HID(), F.roww()};
            pg::gemm_phase(stage, DM, DM, DM, S, E);
        }
        SEAM(pb + 9);
        if (IN(pb + 10)) { REFRESH(F);
            moe_offsets(F, l, offt);
            pg::SchedMoe S{(const char*)F.HID(), (const char*)F.Wd(), offt, (size_t)256 * 256 * 2, (size_t)DM * 256 * 2, (size_t)256 * 256 * 2, offt[32] / 256, 4, F.nb, F.bid};
            pg::EpiMoe2 E{F.BR(), F.rmap(), (bf16_t*)(F.ws + WS_DUMP)};
            pg::gemm_phase(stage, 256, 256, 256, S, E);
        }
        SEAM(pb + 10);
        if (IN(pb + 11)) { REFRESH(F); phase_ln2(F, l); }
        SEAM(pb + 11);
    }
#undef IN
#undef SEAM
}

extern "C" void kernel_launch(void* const* d_in, const int* in_sizes, int n_in, void* d_out, int out_size, void* d_ws, size_t ws_size, hipStream_t stream) {
    static int grid = 0;
    if (grid == 0) {
        if (n_in != 23 || out_size != NTOK * DM || ws_size < WS_END) { fprintf(stderr, "kernel_launch: unexpected shapes (n_in %d out %d ws %zu need %zu)\n", n_in, out_size, ws_size, (size_t)WS_END); grid = -1; return; }
        int dev = 0, cus = 0;
        if (hipGetDevice(&dev) != hipSuccess || hipDeviceGetAttribute(&cus, hipDeviceAttributeMultiprocessorCount, dev) != hipSuccess) { grid = -1; return; }
        if (hipFuncSetAttribute((const void*)mega, hipFuncAttributeMaxDynamicSharedMemorySize, LDS_BYTES) != hipSuccess) { fprintf(stderr, "kernel_launch: hipFuncSetAttribute failed\n"); grid = -1; return; }
        int per_cu = 0;
        if (hipOccupancyMaxActiveBlocksPerMultiprocessor(&per_cu, (const void*)mega, NTHR, LDS_BYTES) != hipSuccess || per_cu < 1) fprintf(stderr, "kernel_launch: occupancy query reports %d blocks per CU\n", per_cu);
        (void)hipGetLastError();
        grid = cus;
    }
    if (grid < 0) return;
    (void)hipMemsetAsync((char*)d_ws + WS_CTL, 0, CTL_BYTES, stream);
    Params p; memset(&p, 0, sizeof(p));
    const float** pp = (const float**)&p;
    for (int i = 0; i < 23; ++i) pp[i] = (const float*)d_in[i];
    p.out = (float*)d_out; p.ws = (unsigned char*)d_ws;
    p.ph_lo = 0; p.ph_hi = NPH;
    hipLaunchKernelGGL(mega, dim3(grid), dim3(NTHR), LDS_BYTES, stream, p);
}
```

```cpp
#include <hip/hip_runtime.h>
#include <cstdio>
#include <cstdint>
#include <cstring>

typedef unsigned short bf16_t;
typedef float f32x4 __attribute__((ext_vector_type(4)));
typedef unsigned u32x4 __attribute__((ext_vector_type(4)));
typedef unsigned u32x2 __attribute__((ext_vector_type(2)));

constexpr int NB = 4, SEQ = 4096, LC = 256, DM = 1024, DEPTH = 2;
constexpr int NTOK = NB * SEQ, NCTX = NB * LC, NROW = NTOK + NCTX;
constexpr int DIN = 10528;
constexpr int O_AQ = 0, O_AK = 256, O_AV = 512, O_AG = 1024, O_ALR = 1536, O_BQ = 1568, O_BK = 2080, O_BV = 2592, O_CQ = 3104, O_CK = 3616,
              O_CV = 3744, O_DQ = 3872, O_DF = 4384, O_DI = 5408, O_DG = 5920, O_GATE = 6432;
constexpr int PC_AQ = 0, PC_AK = 256, PC_AV = 512, PC_BQ = 1024, PC_BK = 1536, PC_CQ = 2048, PC_CK = 2560, PC_ALR = 2688, PC_DQ = 2816,
              PC_DF = 3328, PC_DI = 4352, PC_AG = 4864, PC_DG = 5376, NP1 = 5888;
constexpr float QSCALE = 0.125f * 1.44269504089f;
constexpr int NVT = 768;
constexpr int NGATE = 4096;
constexpr int XS_ROWS = 43008;
constexpr float LN_EPS = 1e-5f;
constexpr float ALPHA = 1.41421356237f;

constexpr size_t al256(size_t x) { return (x + 255) & ~(size_t)255; }
constexpr size_t WS_CTL = 0;
constexpr size_t CTL_BYTES = 32768;
constexpr size_t CTL_CNT = 28672;
constexpr size_t WS_DUMP = WS_CTL + CTL_BYTES;
constexpr size_t WS_MODV = WS_DUMP + 4096;
constexpr size_t WS_LB = WS_MODV + al256((size_t)DEPTH * 5 * 6144 * 4);
constexpr size_t WS_TOKE = WS_LB + 4096;
constexpr size_t WS_TOKI = WS_TOKE + al256((size_t)2 * NROW * 4);
constexpr size_t WS_TOKW = WS_TOKI + al256((size_t)2 * NROW * 4);
constexpr size_t WS_RMAP = WS_TOKW + al256((size_t)2 * NROW * 4);
constexpr size_t WS_ROWW = WS_RMAP + al256((size_t)XS_ROWS * 4);
constexpr size_t WS_CXM = WS_ROWW + al256((size_t)XS_ROWS * 4);
constexpr size_t WS_CXO = WS_CXM + (size_t)NCTX * DM * 4;
constexpr size_t WS_WTA = WS_CXO + (size_t)NCTX * DM * 4;
constexpr size_t WTA_W1 = 0;
constexpr size_t WTA_WV = WTA_W1 + (size_t)NP1 * DM * 2;
constexpr size_t WTA_WG = WTA_WV + (size_t)NVT * DM * 2;
constexpr size_t WTA_WBR = WTA_WG + (size_t)NGATE * DM * 2;
constexpr size_t WTA_WO = WTA_WBR + (size_t)4 * DM * 512 * 2;
constexpr size_t WTA_BYTES = WTA_WO + (size_t)DM * DM * 2;
constexpr size_t WS_HX = WS_WTA + WTA_BYTES;
constexpr size_t WS_VT = WS_HX + (size_t)NROW * DM * 2;
constexpr size_t WS_OBA = WS_VT + (size_t)NVT * NROW * 2;
constexpr size_t WS_HX2 = WS_VT;
constexpr size_t WS_HID = WS_VT;
constexpr size_t WS_ODH = WS_OBA + (size_t)NROW * 512 * 2;
constexpr size_t WS_BR = WS_ODH + (size_t)NROW * 1024 * 2;
constexpr size_t WS_P1 = WS_BR + (size_t)NROW * 2048 * 2;
constexpr size_t WS_G = WS_P1;
constexpr size_t WS_WGU = WS_P1 + (size_t)NROW * NGATE * 2;
constexpr size_t WS_WD = WS_WGU + (size_t)32 * 512 * DM * 2;
constexpr size_t WS_XS = WS_P1;
constexpr size_t WS_END = WS_P1 + (size_t)NROW * NP1 * 2;
static_assert(WS_WD + (size_t)32 * DM * 256 * 2 <= WS_END, "moe weights must fit in the P1 tail");
static_assert((size_t)XS_ROWS * DM * 2 <= (size_t)NROW * NGATE * 2, "XS must fit in the G region");
static_assert((size_t)NVT * NROW * 2 + (size_t)NROW * 512 * 2 >= (size_t)NROW * DM * 2, "HX2 alias");
static_assert(WS_END <= 434800000ull, "workspace budget");

constexpr int NTHR = 512;
constexpr int LDS_STAGE = 1024;
constexpr int LDS_ROPE = 1024 + 131072 + 1024;
constexpr int LDS_BYTES = 144 * 1024;

struct Params {
    const float *x, *c, *ctx, *c_ctx, *w_mod, *b_mod, *w_in, *gla_lr_w, *gla_lr_b, *hg_gamma, *na_rpb, *wa_sink, *w_branch, *w_out, *ln_g, *ln_b,
        *moe_w_group, *moe_b_group, *moe_w_expert, *moe_b_expert, *moe_w_gate, *moe_w_up, *moe_w_down;
    float* out;
    unsigned char* ws;
    int ph_lo, ph_hi;
};

__device__ __forceinline__ float bf2f(bf16_t b) { return __uint_as_float(((unsigned)b) << 16); }
__device__ __forceinline__ bf16_t f2bf(float f) { unsigned u = __float_as_uint(f); u += 0x7FFFu + ((u >> 16) & 1u); return (bf16_t)(u >> 16); }
typedef float f32x2_t __attribute__((ext_vector_type(2)));
typedef __bf16 bf16x2_t __attribute__((ext_vector_type(2)));
__device__ __forceinline__ unsigned pk2(float lo, float hi) {
    const f32x2_t v = {lo, hi}; const bf16x2_t b = __builtin_convertvector(v, bf16x2_t); return __builtin_bit_cast(unsigned, b); }
__device__ __forceinline__ void ld8(const bf16_t* p, float* f) {
    const u32x4 v = *(const u32x4*)p;
    f[0] = __uint_as_float(v.x << 16); f[1] = __uint_as_float(v.x & 0xffff0000u);
    f[2] = __uint_as_float(v.y << 16); f[3] = __uint_as_float(v.y & 0xffff0000u);
    f[4] = __uint_as_float(v.z << 16); f[5] = __uint_as_float(v.z & 0xffff0000u);
    f[6] = __uint_as_float(v.w << 16); f[7] = __uint_as_float(v.w & 0xffff0000u);
}
__device__ __forceinline__ void st8(bf16_t* p, const float* f) {
    u32x4 v; v.x = pk2(f[0], f[1]); v.y = pk2(f[2], f[3]); v.z = pk2(f[4], f[5]); v.w = pk2(f[6], f[7]);
    *(u32x4*)p = v;
}
__device__ __forceinline__ float sigmoidf_(float x) { return __builtin_amdgcn_rcpf(1.f + __expf(-x)); }
__device__ __forceinline__ float siluf_(float x) { return x * __builtin_amdgcn_rcpf(1.f + __expf(-x)); }
__device__ __forceinline__ float wave_sum(float v) {
#pragma unroll
    for (int o = 1; o < 64; o <<= 1) v += __shfl_xor(v, o);
    return v;
}
__device__ __forceinline__ int row_batch(int row) { return row < NTOK ? (row >> 12) : 4; }

#define XB_TMO      128
#define XB_XCNT(j)  (256  + 64 * (j))
#define XB_XSUB(j)  (1280 + 64 * (j))
#define XB_XGEN(j)  (2304 + 64 * (j))
#define XB_TOP      3328
#define XB_TOPGEN   3392
#define XCD_BAR_WORDS 3456
#define XB_SPIN_CAP (1u << 18)
#define LAS __attribute__((address_space(3)))
__device__ __forceinline__ unsigned xb_ld(unsigned* p)              { return __hip_atomic_load(p, __ATOMIC_RELAXED, __HIP_MEMORY_SCOPE_AGENT); }
__device__ __forceinline__ unsigned xb_add(unsigned* p, unsigned v) { return __hip_atomic_fetch_add(p, v, __ATOMIC_RELAXED, __HIP_MEMORY_SCOPE_AGENT); }
__device__ __forceinline__ unsigned xb_xcc_id() { return (unsigned)__builtin_amdgcn_s_getreg((3 << 11) | 20) & 0xFu; }
#define XB_SPIN(cond, bar) do { unsigned _sp = 0; while (cond) { __builtin_amdgcn_s_sleep(1); \
    if ((++_sp & 255u) == 0u) { if (xb_ld(&(bar)[XB_TMO])) break; if (_sp > XB_SPIN_CAP) { atomicAdd(&(bar)[XB_TMO], 1u); break; } } } } while (0)
struct XcdBarrier { unsigned* bar; unsigned x; volatile LAS unsigned* st; };
__device__ __forceinline__ XcdBarrier xcd_barrier_post(unsigned* bar, volatile LAS unsigned* st) {
    XcdBarrier b; b.bar = bar; b.x = xb_xcc_id(); b.st = st;
    if (threadIdx.x == 0) (void)xb_add(&bar[XB_XCNT(b.x)], 1u);
    return b;
}
__device__ __forceinline__ void xcd_barrier_complete(unsigned* bar, unsigned x, unsigned& nloc, unsigned& nx) {
    const unsigned G = gridDim.x * gridDim.y * gridDim.z;
    unsigned sum, cnt, mine, sp = 0u;
    for (;;) {
        sum = 0u; cnt = 0u; mine = 0u;
#pragma unroll
        for (unsigned j = 0; j < 16; ++j) { const unsigned c = xb_ld(&bar[XB_XCNT(j)]); sum += c; cnt += (c > 0u) ? 1u : 0u; mine = (j == x) ? c : mine; }
        if (sum == G) break;
        __builtin_amdgcn_s_sleep(1);
        if ((++sp & 255u) == 0u) { if (xb_ld(&bar[XB_TMO])) break; if (sp > XB_SPIN_CAP) { atomicAdd(&bar[XB_TMO], 1u); break; } }
    }
    nloc = mine > 0u ? mine : 1u; nx = cnt > 0u ? cnt : 1u;
}
__device__ __forceinline__ void xcd_barrier(const XcdBarrier& b) {
    asm volatile("s_waitcnt vmcnt(0)" ::: "memory");
    __syncthreads();
    if (threadIdx.x == 0) {
        unsigned* bar = b.bar;
        __builtin_amdgcn_s_waitcnt(0);
        unsigned nloc = b.st[0], nx = b.st[1];
        if (nloc == 0u) { xcd_barrier_complete(bar, b.x, nloc, nx); b.st[0] = nloc; b.st[1] = nx; }
        const unsigned old = xb_add(&bar[XB_XSUB(b.x)], 1u);
        const unsigned gen = old / nloc;
        if (old + 1u == (gen + 1u) * nloc) {
            __builtin_amdgcn_fence(__ATOMIC_RELEASE, "agent");
            asm volatile("s_waitcnt vmcnt(0)" ::: "memory");
            const unsigned og = xb_add(&bar[XB_TOP], 1u);
            const unsigned tg = og / nx;
            if (og + 1u == (tg + 1u) * nx) xb_add(&bar[XB_TOPGEN], 1u);
            else XB_SPIN(xb_ld(&bar[XB_TOPGEN]) == tg, bar);
            __builtin_amdgcn_fence(__ATOMIC_ACQUIRE, "agent");
            xb_add(&bar[XB_XGEN(b.x)], 1u);
            asm volatile("s_waitcnt vmcnt(0)" ::: "memory");
        } else {
            XB_SPIN(xb_ld(&bar[XB_XGEN(b.x)]) == gen, bar);
            __builtin_amdgcn_fence(__ATOMIC_ACQUIRE, "agent");
            asm volatile("s_waitcnt vmcnt(0)" ::: "memory");
        }
    }
    __syncthreads();
}

struct Frame {
    Params p;
    int bid, nb, tid, lane, wave, wid_s;
    float* smf;
    unsigned char* ws;
    __device__ __forceinline__ float* modv() const { return (float*)(ws + WS_MODV); }
    __device__ __forceinline__ float* lb() const { return (float*)(ws + WS_LB); }
    __device__ __forceinline__ int* tokE() const { return (int*)(ws + WS_TOKE); }
    __device__ __forceinline__ int* tokI() const { return (int*)(ws + WS_TOKI); }
    __device__ __forceinline__ float* tokW() const { return (float*)(ws + WS_TOKW); }
    __device__ __forceinline__ int* rmap() const { return (int*)(ws + WS_RMAP); }
    __device__ __forceinline__ float* roww() const { return (float*)(ws + WS_ROWW); }
    __device__ __forceinline__ float* cxm() const { return (float*)(ws + WS_CXM); }
    __device__ __forceinline__ float* cxo() const { return (float*)(ws + WS_CXO); }
    __device__ __forceinline__ bf16_t* W1t() const { return (bf16_t*)(ws + WS_WTA + WTA_W1); }
    __device__ __forceinline__ bf16_t* Wvt() const { return (bf16_t*)(ws + WS_WTA + WTA_WV); }
    __device__ __forceinline__ bf16_t* Wgt() const { return (bf16_t*)(ws + WS_WTA + WTA_WG); }
    __device__ __forceinline__ bf16_t* Wbrt() const { return (bf16_t*)(ws + WS_WTA + WTA_WBR); }
    __device__ __forceinline__ bf16_t* Woutt() const { return (bf16_t*)(ws + WS_WTA + WTA_WO); }
    __device__ __forceinline__ bf16_t* HX() const { return (bf16_t*)(ws + WS_HX); }
    __device__ __forceinline__ bf16_t* VT() const { return (bf16_t*)(ws + WS_VT); }
    __device__ __forceinline__ bf16_t* OBA() const { return (bf16_t*)(ws + WS_OBA); }
    __device__ __forceinline__ bf16_t* HX2() const { return (bf16_t*)(ws + WS_HX2); }
    __device__ __forceinline__ bf16_t* HID() const { return (bf16_t*)(ws + WS_HID); }
    __device__ __forceinline__ bf16_t* ODH() const { return (bf16_t*)(ws + WS_ODH); }
    __device__ __forceinline__ bf16_t* BR() const { return (bf16_t*)(ws + WS_BR); }
    __device__ __forceinline__ bf16_t* P1() const { return (bf16_t*)(ws + WS_P1); }
    __device__ __forceinline__ bf16_t* G() const { return (bf16_t*)(ws + WS_G); }
    __device__ __forceinline__ bf16_t* Wgu() const { return (bf16_t*)(ws + WS_WGU); }
    __device__ __forceinline__ bf16_t* Wd() const { return (bf16_t*)(ws + WS_WD); }
    __device__ __forceinline__ bf16_t* XS() const { return (bf16_t*)(ws + WS_XS); }
    __device__ __forceinline__ unsigned* cnt() const { return (unsigned*)(ws + WS_CTL + CTL_CNT); }
};


#define REFRESH(F) do { int _t = threadIdx.x; asm volatile("" : "+v"(_t)); (F).tid = _t; (F).lane = _t & 63; (F).wave = _t >> 6; } while (0)

__device__ __forceinline__ void phase_mod(Frame& F) {
    float* sc = F.smf;
    float* red = F.smf + 5 * 1024;
    bool have = false;
    for (int it = F.bid; it < DEPTH * 96; it += F.nb) {
        if (!have) {
            for (int i = F.tid; i < 5 * 1024; i += NTHR) { const float v = (i < 4096) ? F.p.c[i] : F.p.c_ctx[i - 4096]; sc[i] = siluf_(v); }
            __syncthreads(); have = true;
        }
        const int l = it / 96, n0 = (it % 96) * 64, col = F.tid & 63, kg = F.tid >> 6;
        const float* w = F.p.w_mod + (size_t)l * DM * 6144 + n0 + col;
        float a[5] = {0.f, 0.f, 0.f, 0.f, 0.f};
        for (int k = kg * 128; k < kg * 128 + 128; ++k) {
            const float wv = w[(size_t)k * 6144];
#pragma unroll
            for (int r = 0; r < 5; ++r) a[r] += sc[r * 1024 + k] * wv;
        }
#pragma unroll
        for (int r = 0; r < 5; ++r) red[(kg * 5 + r) * 64 + col] = a[r];
        __syncthreads();
        if (F.tid < 320) {
            const int r = F.tid >> 6, cc = F.tid & 63; float s = F.p.b_mod[l * 6144 + n0 + cc];
#pragma unroll
            for (int g = 0; g < 8; ++g) s += red[(g * 5 + r) * 64 + cc];
            F.modv()[((size_t)l * 5 + r) * 6144 + n0 + cc] = s;
        }
        __syncthreads();
    }
    if (F.bid == F.nb - 1) {
        for (int i = F.tid; i < 1024; i += NTHR) { const int z = i >> 9, f = i & 511;
            const float g0 = F.p.hg_gamma[(z * DEPTH + 0) * 512 + f], g1 = F.p.hg_gamma[(z * DEPTH + 1) * 512 + f];
            F.lb()[i] = 1.f / (1.f + expf(g0 - g1)); }
    }
}

__device__ __forceinline__ int p1_src(int n, float& scale) {
    scale = 1.f;
    if (n < 256) { scale = 0.125f; return O_AQ + n; }
    if (n < 512) return O_AK + (n - 256);
    if (n < 1024) return O_AV + (n - 512);
    if (n < 1536) { scale = QSCALE; return O_BQ + (n - 1024); }
    if (n < 2048) return O_BK + (n - 1536);
    if (n < 2560) { scale = QSCALE; return O_CQ + (n - 2048); }
    if (n < 2688) return O_CK + (n - 2560);
    if (n < 2720) return O_ALR + (n - 2688);
    if (n < 2816) return -1;
    if (n < 3328) return O_DQ + (n - 2816);
    if (n < 4352) return O_DF + (n - 3328);
    if (n < 4864) return O_DI + (n - 4352);
    if (n < 5376) return O_AG + (n - 4864);
    return O_DG + (n - 5376);
}
__device__ __forceinline__ void conv_item(const float* src, int ldsrc, int srccol, float scale, bf16_t* dst, int K, int k0, float* scr, int lane, bool perm) {
    if (srccol >= 0) {
#pragma unroll 8
        for (int i = 0; i < 32; ++i) { const int kk = 2 * i + (lane >> 5); scr[kk * 33 + (lane & 31)] = src[(size_t)(k0 + kk) * ldsrc + srccol + (lane & 31)] * scale; }
    } else {
#pragma unroll 8
        for (int i = 0; i < 32; ++i) { const int kk = 2 * i + (lane >> 5); scr[kk * 33 + (lane & 31)] = 0.f; }
    }
    asm volatile("s_waitcnt lgkmcnt(0)" ::: "memory");
    const int c = lane & 7;
#pragma unroll
    for (int j = 0; j < 4; ++j) { const int nn = (lane >> 3) + 8 * j; const float* sp = scr + (8 * c) * 33 + (perm ? (8 * ((nn & 15) >> 2) + 4 * (nn >> 4) + (nn & 3)) : nn);
        u32x4 o; o.x = pk2(sp[0 * 33], sp[1 * 33]); o.y = pk2(sp[2 * 33], sp[3 * 33]); o.z = pk2(sp[4 * 33], sp[5 * 33]); o.w = pk2(sp[6 * 33], sp[7 * 33]);
        *(u32x4*)(dst + (size_t)nn * K + 8 * c) = o; }
    asm volatile("s_waitcnt lgkmcnt(0)" ::: "memory");
}
constexpr int CONVA_W1 = (NP1 / 32) * 16;
constexpr int CONVA_ITEMS = CONVA_W1 + 384 + 2048 + 1024 + 512;
__device__ __forceinline__ void phase_conv_a(Frame& F, int l) {
    float* scr = F.smf + F.wave * (64 * 33);
    const int gw = F.bid * 8 + F.wave, ngw = F.nb * 8;
    for (int it0 = gw; it0 < CONVA_ITEMS; it0 += ngw) {
        int ti = it0;
        if (ti < CONVA_W1) { const int n0 = (ti >> 4) * 32, kt = ti & 15; float sc; const int sx = p1_src(n0, sc);
            conv_item(F.p.w_in + (size_t)l * DM * DIN, DIN, sx, sc, F.W1t() + (size_t)n0 * DM + kt * 64, DM, kt * 64, scr, F.lane, !(n0 >= 2048 && n0 < 2816)); continue; }
        ti -= CONVA_W1;
        if (ti < 384) { const int n0 = (ti >> 4) * 32, kt = ti & 15; const int sx = n0 < 512 ? O_BV + n0 : (n0 < 640 ? O_CV + (n0 - 512) : -1);
            conv_item(F.p.w_in + (size_t)l * DM * DIN, DIN, sx, 1.f, F.Wvt() + (size_t)n0 * DM + kt * 64, DM, kt * 64, scr, F.lane, false); continue; }
        ti -= 384;
        if (ti < 2048) { const int n0 = (ti >> 4) * 32, kt = ti & 15;
            conv_item(F.p.w_in + (size_t)l * DM * DIN, DIN, O_GATE + n0, 1.f, F.Wgt() + (size_t)n0 * DM + kt * 64, DM, kt * 64, scr, F.lane, true); continue; }
        ti -= 2048;
        if (ti < 1024) { const int i = ti >> 8, r = ti & 255, n0 = (r >> 3) * 32, kt = r & 7;
            conv_item(F.p.w_branch + (size_t)(l * 4 + i) * 512 * DM, DM, n0, 1.f, F.Wbrt() + (size_t)i * DM * 512 + (size_t)n0 * 512 + kt * 64, 512, kt * 64, scr, F.lane, true); continue; }
        ti -= 1024;
        { const int n0 = (ti >> 4) * 32, kt = ti & 15;
          conv_item(F.p.w_out + (size_t)l * DM * DM, DM, n0, 1.f, F.Woutt() + (size_t)n0 * DM + kt * 64, DM, kt * 64, scr, F.lane, false); }
    }
}
constexpr int CONVB_ITEMS = 8192 + 4096;
__device__ __forceinline__ void phase_conv_b(Frame& F, int l) {
    float* scr = F.smf + F.wave * (64 * 33);
    const int gw = F.bid * 8 + F.wave, ngw = F.nb * 8;
    for (int it0 = gw; it0 < CONVB_ITEMS; it0 += ngw) {
        int ti = it0;
        if (ti < 8192) { const int e = ti >> 8, r = ti & 255, n0 = (r >> 4) * 32, kt = r & 15, j = n0 >> 8, rr = n0 & 255; const bool isup = rr >= 128; const int cc = 128 * j + (rr & 127);
            const float* src = (isup ? F.p.moe_w_up : F.p.moe_w_gate) + (size_t)(l * 32 + e) * DM * 256;
            conv_item(src, 256, cc, 1.f, F.Wgu() + (size_t)e * 512 * DM + (size_t)n0 * DM + kt * 64, DM, kt * 64, scr, F.lane, true); continue; }
        ti -= 8192;
        { const int e = ti >> 7, r = ti & 127, n0 = (r >> 2) * 32, kt = r & 3;
          conv_item(F.p.moe_w_down + (size_t)(l * 32 + e) * 256 * DM, DM, n0, 1.f, F.Wd() + (size_t)e * DM * 256 + (size_t)n0 * 256 + kt * 64, 256, kt * 64, scr, F.lane, true); }
    }
}

__device__ __forceinline__ void phase_prep(Frame& F, int l, const float* xlat, const float* xctx) {
    const int gw = F.bid * 8 + F.wave, ngw = F.nb * 8;
    for (int row = gw; row < NROW; row += ngw) {
        const float* xr = row < NTOK ? xlat + (size_t)row * DM : xctx + (size_t)(row - NTOK) * DM;
        const float* mv = F.modv() + ((size_t)l * 5 + row_batch(row)) * 6144;
#pragma unroll
        for (int j = 0; j < 4; ++j) { const int d = j * 256 + F.lane * 4;
            const f32x4 v = *(const f32x4*)(xr + d), m0 = *(const f32x4*)(mv + d), m1 = *(const f32x4*)(mv + 1024 + d);
            u32x2 o; o.x = pk2(v.x * (1.f + m1.x) + m0.x, v.y * (1.f + m1.y) + m0.y); o.y = pk2(v.z * (1.f + m1.z) + m0.z, v.w * (1.f + m1.w) + m0.w);
            *(u32x2*)(F.HX() + (size_t)row * DM + d) = o; }
    }
}


namespace pg {
typedef short bf16x8 __attribute__((ext_vector_type(8)));
constexpr int BM = 256, BK = 64, HALF = 128, HTB = HALF * BK * 2, STAGE_BYTES = 8 * HTB, NXCD = 8, WGM = 8;
__device__ __forceinline__ int lds_byte(int r, int c) { const int st = (r >> 4) * 2 + (c >> 5), rr = r & 15, cc = c & 31, ob = rr * 64 + cc * 2; return st * 1024 + (ob ^ (((ob >> 9) & 1) << 5)); }
__device__ __forceinline__ void stage_rc(int b, int& R, int& C) { const int st = b / 1024, sb = b % 1024, swz = sb ^ (((sb >> 9) & 1) << 5); R = (st >> 1) * 16 + swz / 64; C = (st & 1) * 32 + (swz % 64) / 2; }
struct Unit { const char* a; const char* b; int pm, pn, aux; };
__device__ __forceinline__ void static_map(int L, int nM, int nN, int& pm, int& pn) {
    const int nwg = nM * nN; int wgid = L; { const int q = nwg / NXCD, r = nwg % NXCD, xcd = wgid % NXCD, off = wgid / NXCD; wgid = (xcd < r ? xcd * (q + 1) : r * (q + 1) + (xcd - r) * q) + off; }
    const int nig = WGM * nN, gid = wgid / nig, fm = gid * WGM, gsz = (nM - fm) < WGM ? (nM - fm) : WGM;
    pm = fm + ((wgid % nig) % gsz); pn = (wgid % nig) / gsz;
}
template <class Epi, class Sched>
__device__ __forceinline__ void gemm_phase(LAS unsigned char* lds, const int lda, const int ldb, const int K, const Sched& S, const Epi& E) {
    int tid = threadIdx.x; asm volatile("" : "+v"(tid));
    const int wid = __builtin_amdgcn_readfirstlane(tid >> 6), lane = tid & 63, wr = wid >> 2, wc = wid & 3, fr = lane & 15, fq = lane >> 4;
    int nt = K / BK; asm volatile("" : "+s"(nt));
    unsigned voffA[2], voffB[2];
#pragma unroll
    for (int i = 0; i < 2; ++i) { int R, C; stage_rc(tid * 16 + i * 8192, R, C); voffA[i] = (unsigned)(R * lda + C) * 2u; voffB[i] = (unsigned)(R * ldb + C) * 2u; }
    const size_t kstep = (size_t)(BK * 2);
    const size_t hstepA = (size_t)HALF * lda * 2, hstepB = (size_t)HALF * ldb * 2;
    const unsigned ldsw = (unsigned)wid * 1024u;
    const int aoff = lds_byte(wr * 64 + fr, fq * 8), boff = lds_byte(wc * 32 + fr, fq * 8);
#define PG_SA(b, h) (((b) * 2 + (h)) * HTB)
#define PG_SB(b, h) ((4 + (b) * 2 + (h)) * HTB)
#define PG_STAGE(bufoff, gbase, voff) do { _Pragma("unroll") for (int _i = 0; _i < 2; ++_i) \
        __builtin_amdgcn_global_load_lds((const unsigned*)((const char*)(gbase) + (voff)[_i]), (LAS unsigned*)(lds + (bufoff) + ldsw + _i * 8192), 16, 0, 0); } while (0)
#define PG_LDA(dst, b, h) do { _Pragma("unroll") for (int m = 0; m < 4; ++m) _Pragma("unroll") for (int k = 0; k < 2; ++k) dst[m][k] = *(const LAS bf16x8*)(lds + PG_SA(b, h) + aoff + m * 2048 + k * 1024); } while (0)
#define PG_LDB(dst, b, h) do { _Pragma("unroll") for (int n = 0; n < 2; ++n) _Pragma("unroll") for (int k = 0; k < 2; ++k) dst[n][k] = *(const LAS bf16x8*)(lds + PG_SB(b, h) + boff + n * 2048 + k * 1024); } while (0)
#define PG_MMA(ai, bj, At, Bt) do { __builtin_amdgcn_s_setprio(1); _Pragma("unroll") for (int m = 0; m < 4; ++m) _Pragma("unroll") for (int n = 0; n < 2; ++n) _Pragma("unroll") for (int k = 0; k < 2; ++k) \
        acc[ai][bj][m][n] = __builtin_amdgcn_mfma_f32_16x16x32_bf16(Bt[n][k], At[m][k], acc[ai][bj][m][n], 0, 0, 0); __builtin_amdgcn_s_setprio(0); } while (0)
#define PG_WAIT_V(n) asm volatile("s_waitcnt vmcnt(" #n ")" ::: "memory")
#define PG_WAIT_L(n) asm volatile("s_waitcnt lgkmcnt(" #n ")" ::: "memory")
#define PG_BAR __builtin_amdgcn_s_barrier()
#define PG_SCHED __builtin_amdgcn_sched_barrier(0)
    Unit cur, nxt; int ui = 0;
    if (!S.next(0, cur)) return;
    f32x4 acc[2][2][4][2];
#pragma unroll
    for (int a = 0; a < 2; ++a)
#pragma unroll
        for (int b = 0; b < 2; ++b)
#pragma unroll
            for (int m = 0; m < 4; ++m)
#pragma unroll
                for (int n = 0; n < 2; ++n) acc[a][b][m][n] = (f32x4){0.f, 0.f, 0.f, 0.f};
    bf16x8 At[4][2], B0[2][2], B1[2][2];
    const char* cA = cur.a; const char* cB = cur.b;
    PG_STAGE(PG_SB(0, 0), cB, voffB); PG_STAGE(PG_SA(0, 0), cA, voffA); PG_STAGE(PG_SB(0, 1), cB + hstepB, voffB); PG_STAGE(PG_SA(0, 1), cA + hstepA, voffA);
    if (wr == 1) PG_BAR;
    PG_WAIT_V(4); PG_BAR;
    PG_STAGE(PG_SB(1, 0), cB + kstep, voffB); PG_STAGE(PG_SA(1, 0), cA + kstep, voffA); PG_STAGE(PG_SB(1, 1), cB + hstepB + kstep, voffB);
    PG_WAIT_V(6); PG_BAR;
    for (;;) {
        const bool has_next = S.next(ui + 1, nxt);
        const char* nA = has_next ? nxt.a : cA; const char* nB = has_next ? nxt.b : cB;
        for (int t = 0; t < nt; t += 2) {
            const bool last = (t == nt - 2);
            const char* a1 = cA + (size_t)(t + 1) * kstep;
            const char* a2 = last ? nA : cA + (size_t)(t + 2) * kstep; const char* b2 = last ? nB : cB + (size_t)(t + 2) * kstep;
            const char* a3 = a2 + kstep; const char* b3 = b2 + kstep;
            PG_LDB(B0, 0, 0); PG_SCHED; PG_LDA(At, 0, 0); PG_STAGE(PG_SA(1, 1), a1 + hstepA, voffA);
            PG_WAIT_L(8); PG_BAR; PG_WAIT_L(0); PG_MMA(0, 0, At, B0); PG_BAR; PG_SCHED;
            PG_LDB(B1, 0, 1); PG_STAGE(PG_SB(0, 0), b2, voffB);
            PG_BAR; PG_WAIT_L(0); PG_MMA(0, 1, At, B1); PG_BAR;
            PG_LDA(At, 0, 1); PG_STAGE(PG_SA(0, 0), a2, voffA);
            PG_BAR; PG_WAIT_L(0); PG_MMA(1, 0, At, B0); PG_BAR; PG_SCHED;
            PG_STAGE(PG_SB(0, 1), b2 + hstepB, voffB);
            PG_WAIT_V(6); PG_BAR; PG_MMA(1, 1, At, B1); PG_BAR;
            PG_LDB(B0, 1, 0); PG_SCHED; PG_LDA(At, 1, 0); PG_STAGE(PG_SA(0, 1), a2 + hstepA, voffA);
            PG_WAIT_L(8); PG_BAR; PG_WAIT_L(0); PG_MMA(0, 0, At, B0); PG_BAR; PG_SCHED;
            PG_LDB(B1, 1, 1); PG_STAGE(PG_SB(1, 0), b3, voffB);
            PG_BAR; PG_WAIT_L(0); PG_MMA(0, 1, At, B1); PG_BAR;
            PG_LDA(At, 1, 1); PG_STAGE(PG_SA(1, 0), a3, voffA);
            PG_BAR; PG_WAIT_L(0); PG_MMA(1, 0, At, B0); PG_BAR; PG_SCHED;
            PG_STAGE(PG_SB(1, 1), b3 + hstepB, voffB);
            PG_WAIT_V(6); PG_BAR; PG_MMA(1, 1, At, B1); PG_BAR;
        }
        E(acc, cur, wr, wc, fr, fq);
        if (!has_next) break;
#pragma unroll
        for (int a = 0; a < 2; ++a)
#pragma unroll
            for (int b = 0; b < 2; ++b)
#pragma unroll
                for (int m = 0; m < 4; ++m)
#pragma unroll
                    for (int n = 0; n < 2; ++n) acc[a][b][m][n] = (f32x4){0.f, 0.f, 0.f, 0.f};
        cur = nxt; cA = nA; cB = nB; ++ui;
    }
    PG_WAIT_V(0);
    if (wr == 0) PG_BAR;
    PG_BAR;
#undef PG_SA
#undef PG_SB
#undef PG_STAGE
#undef PG_LDA
#undef PG_LDB
#undef PG_MMA
#undef PG_WAIT_V
#undef PG_WAIT_L
#undef PG_BAR
#undef PG_SCHED
}

struct SchedG1 {
    const char *HX, *W1, *WV; int G, c;
    __device__ __forceinline__ bool next(int i, Unit& u) const {
        const int L = i * G + c, nmain = (NROW / 256) * (NP1 / 256);
        if (L < nmain) { static_map(L, NROW / 256, NP1 / 256, u.pm, u.pn); u.a = HX + (size_t)u.pm * 256 * DM * 2; u.b = W1 + (size_t)u.pn * 256 * DM * 2; u.aux = 0; return true; }
        const int idx = L - nmain; if (idx >= 3 * (NROW / 256)) return false;
        u.pm = idx % 3; u.pn = idx / 3; u.a = WV + (size_t)u.pm * 256 * DM * 2; u.b = HX + (size_t)u.pn * 256 * DM * 2; u.aux = 1; return true;
    }
};
struct SchedStatic {
    const char *A, *B; size_t tA, tB; int nM, nN, G, c;
    __device__ __forceinline__ bool next(int i, Unit& u) const {
        const int L = i * G + c; if (L >= nM * nN) return false;
        static_map(L, nM, nN, u.pm, u.pn); u.a = A + (size_t)u.pm * tA; u.b = B + (size_t)u.pn * tB; u.aux = 0; return true;
    }
};
struct SchedMerge {
    const char *BR, *W; int ntile, G, c;
    __device__ __forceinline__ bool next(int i, Unit& u) const {
        const int t = c + (i >> 2) * G; if (t >= ntile) return false;
        const int br = i & 3; u.pm = t >> 2; u.pn = t & 3; u.aux = br;
        u.a = BR + (size_t)u.pm * 256 * 2048 * 2 + (size_t)br * 512 * 2; u.b = W + (size_t)br * DM * 512 * 2 + (size_t)u.pn * 256 * 512 * 2; return true;
    }
};
struct SchedMoe {
    const char *A, *W; const int* off; size_t tA, wE, wT; int npan, NJ, G, c;
    __device__ __forceinline__ bool next(int i, Unit& u) const {
        const int L = i * G + c; if (L >= npan * NJ) return false;
        const int p = L / NJ, j = L % NJ; int e = 0;
#pragma unroll 1
        for (int q = 1; q < 32; ++q) if (p * 256 >= off[q]) e = q;
        e = __builtin_amdgcn_readfirstlane(e);
        u.pm = p; u.pn = j; u.aux = e; u.a = A + (size_t)p * tA; u.b = W + (size_t)e * wE + (size_t)j * wT; return true;
    }
};

#define PG_ROWCOL const int row0 = u.pm * BM + wr * 64 + fr, col0 = u.pn * BM + wc * 32 + 4 * fq
struct EpiG1 { bf16_t *P1, *VT; const float* rtab; const float* lbp; int layer;
    __device__ __forceinline__ void operator()(const f32x4 (&acc)[2][2][4][2], const Unit& u, int wr, int wc, int fr, int fq) const {
        const int row0 = u.pm * BM + wr * 64 + fr;
        if (u.aux || (u.pn >= 8 && u.pn <= 10)) {
            const int col0 = u.pn * BM + wc * 32 + 4 * fq; bf16_t* base = u.aux ? VT : P1; const size_t ld = u.aux ? (size_t)NROW : (size_t)NP1;
            const bool rope = !u.aux && (u.pm < NTOK / 256);
#pragma unroll
            for (int ai = 0; ai < 2; ++ai)
#pragma unroll
                for (int m = 0; m < 4; ++m) { const int r = row0 + ai * HALF + m * 16; bf16_t* rowp = base + (size_t)r * ld + col0;
#pragma unroll
                    for (int bj = 0; bj < 2; ++bj) {
                        f32x4 v0 = acc[ai][bj][m][0], v1 = acc[ai][bj][m][1];
                        if (rope && !(u.pn == 10 && bj == 1)) {
                            const int pos = r & (SEQ - 1), pp = (wc & 1) ? (pos & 63) : (pos >> 6); const float* tp = rtab + (pp * 16 + 4 * fq) * 2;
                            const f32x4 t0 = *(const f32x4*)tp, t1 = *(const f32x4*)(tp + 4);
                            const f32x4 a = v0, b = v1;
                            v0.x = a.x * t0.x - b.x * t0.y; v1.x = a.x * t0.y + b.x * t0.x; v0.y = a.y * t0.z - b.y * t0.w; v1.y = a.y * t0.w + b.y * t0.z;
                            v0.z = a.z * t1.x - b.z * t1.y; v1.z = a.z * t1.y + b.z * t1.x; v0.w = a.w * t1.z - b.w * t1.w; v1.w = a.w * t1.w + b.w * t1.z;
                        }
                        u32x2 o; o.x = pk2(v0.x, v0.y); o.y = pk2(v0.z, v0.w); *(u32x2*)(rowp + bj * HALF) = o;
                        o.x = pk2(v1.x, v1.y); o.y = pk2(v1.z, v1.w); *(u32x2*)(rowp + bj * HALF + 16) = o; } }
            return;
        }
        const int col0 = u.pn * BM + wc * 32 + 8 * fq;
        const int mode = (u.pn == 11 || u.pn == 12) ? 2 : ((u.pn >= 13 && u.pn <= 16) ? 3 : 0);
        if (mode == 3) {
            f32x4 lb4[2][2];
            const int z = (u.pn - 13) >> 1, cb = z * 512 + ((u.pn - 13) & 1) * 256 + wc * 32 + 8 * fq;
#pragma unroll
            for (int bj = 0; bj < 2; ++bj)
#pragma unroll
                for (int n = 0; n < 2; ++n) lb4[bj][n] = (layer == 0) ? (f32x4){0.f, 0.f, 0.f, 0.f} : *(const f32x4*)(lbp + cb + bj * HALF + 4 * n);
#pragma unroll
            for (int ai = 0; ai < 2; ++ai)
#pragma unroll
                for (int m = 0; m < 4; ++m) { bf16_t* rowp = P1 + (size_t)(row0 + ai * HALF + m * 16) * NP1 + col0;
#pragma unroll
                    for (int bj = 0; bj < 2; ++bj) { float gq[8];
#pragma unroll
                        for (int n = 0; n < 2; ++n)
#pragma unroll
                            for (int j = 0; j < 4; ++j) { const float f = acc[ai][bj][m][n][j], lb = lb4[bj][n][j]; const float t = __expf(-fabsf(f)), rr = __builtin_amdgcn_rcpf(1.f + t);
                                gq[4 * n + j] = __logf(fmaxf(lb + (1.f - lb) * ((f >= 0.f) ? rr : t * rr), 1e-37f)); }
                        u32x4 o; o.x = pk2(gq[0], gq[1]); o.y = pk2(gq[2], gq[3]); o.z = pk2(gq[4], gq[5]); o.w = pk2(gq[6], gq[7]); *(u32x4*)(rowp + bj * HALF) = o; } }
            return;
        }
#pragma unroll
        for (int ai = 0; ai < 2; ++ai)
#pragma unroll
            for (int m = 0; m < 4; ++m) { bf16_t* rowp = P1 + (size_t)(row0 + ai * HALF + m * 16) * NP1 + col0;
#pragma unroll
                for (int bj = 0; bj < 2; ++bj) {
                    f32x4 v0 = acc[ai][bj][m][0], v1 = acc[ai][bj][m][1];
                    if (mode == 2) {
#pragma unroll
                        for (int j = 0; j < 4; ++j) { v0[j] = v0[j] * __builtin_amdgcn_rcpf(1.f + __expf(-v0[j])); v1[j] = v1[j] * __builtin_amdgcn_rcpf(1.f + __expf(-v1[j])); }
                    }
                    u32x4 o; o.x = pk2(v0.x, v0.y); o.y = pk2(v0.z, v0.w); o.z = pk2(v1.x, v1.y); o.w = pk2(v1.z, v1.w); *(u32x4*)(rowp + bj * HALF) = o; } }
    }
};
#define PG_ROWCOL8 const int row0 = u.pm * BM + wr * 64 + fr, col0 = u.pn * BM + wc * 32 + 8 * fq
struct EpiGate { bf16_t* G;
    __device__ __forceinline__ void operator()(const f32x4 (&acc)[2][2][4][2], const Unit& u, int wr, int wc, int fr, int fq) const {
        PG_ROWCOL8;
#pragma unroll
        for (int ai = 0; ai < 2; ++ai)
#pragma unroll
            for (int m = 0; m < 4; ++m) { bf16_t* rowp = G + (size_t)(row0 + ai * HALF + m * 16) * NGATE + col0;
#pragma unroll
                for (int bj = 0; bj < 2; ++bj) { const f32x4 v0 = acc[ai][bj][m][0], v1 = acc[ai][bj][m][1]; u32x4 o;
                    o.x = pk2(sigmoidf_(v0.x), sigmoidf_(v0.y)); o.y = pk2(sigmoidf_(v0.z), sigmoidf_(v0.w)); o.z = pk2(sigmoidf_(v1.x), sigmoidf_(v1.y)); o.w = pk2(sigmoidf_(v1.z), sigmoidf_(v1.w));
                    *(u32x4*)(rowp + bj * HALF) = o; } }
    }
};
struct EpiMerge { const bf16_t* G; bf16_t* O;
    __device__ __forceinline__ void operator()(const f32x4 (&acc)[2][2][4][2], const Unit& u, int wr, int wc, int fr, int fq) const {
        PG_ROWCOL8; const int br = u.aux;
#pragma unroll
        for (int ai = 0; ai < 2; ++ai) {
            u32x4 g4[4][2], o4[4][2];
#pragma unroll
            for (int m = 0; m < 4; ++m) { const size_t r = (size_t)(row0 + ai * HALF + m * 16); const bf16_t* gp = G + r * NGATE + br * 1024 + col0; const bf16_t* rowp = O + r * DM + col0;
#pragma unroll
                for (int bj = 0; bj < 2; ++bj) { g4[m][bj] = *(const u32x4*)(gp + bj * HALF); if (br != 0) o4[m][bj] = *(const u32x4*)(rowp + bj * HALF); } }
#pragma unroll
            for (int m = 0; m < 4; ++m) { bf16_t* rowp = O + (size_t)(row0 + ai * HALF + m * 16) * DM + col0;
#pragma unroll
                for (int bj = 0; bj < 2; ++bj) { const f32x4 v0 = acc[ai][bj][m][0], v1 = acc[ai][bj][m][1]; const u32x4 gg = g4[m][bj];
                    float w[8] = {__uint_as_float(gg.x << 16) * v0.x, __uint_as_float(gg.x & 0xffff0000u) * v0.y, __uint_as_float(gg.y << 16) * v0.z, __uint_as_float(gg.y & 0xffff0000u) * v0.w,
                                  __uint_as_float(gg.z << 16) * v1.x, __uint_as_float(gg.z & 0xffff0000u) * v1.y, __uint_as_float(gg.w << 16) * v1.z, __uint_as_float(gg.w & 0xffff0000u) * v1.w};
                    if (br != 0) { const u32x4 oo = o4[m][bj];
                        w[0] += __uint_as_float(oo.x << 16); w[1] += __uint_as_float(oo.x & 0xffff0000u); w[2] += __uint_as_float(oo.y << 16); w[3] += __uint_as_float(oo.y & 0xffff0000u);
                        w[4] += __uint_as_float(oo.z << 16); w[5] += __uint_as_float(oo.z & 0xffff0000u); w[6] += __uint_as_float(oo.w << 16); w[7] += __uint_as_float(oo.w & 0xffff0000u); }
                    u32x4 o; o.x = pk2(w[0], w[1]); o.y = pk2(w[2], w[3]); o.z = pk2(w[4], w[5]); o.w = pk2(w[6], w[7]); *(u32x4*)(rowp + bj * HALF) = o; } }
            asm volatile("" ::: "memory");
        }
    }
};
struct EpiWout { const float *xlat, *xctx; float *olat, *octx; const float* modl;
    __device__ __forceinline__ void operator()(const f32x4 (&acc)[2][2][4][2], const Unit& u, int wr, int wc, int fr, int fq) const {
        PG_ROWCOL; const bool lat = u.pm < NTOK / 256; const int rb = lat ? (u.pm >> 4) : 4;
        const float* xin = lat ? xlat : xctx - (size_t)NTOK * DM; float* xo = lat ? olat : octx - (size_t)NTOK * DM; const float* m2 = modl + (size_t)rb * 6144 + 2 * 1024 + col0;
        f32x4 mv[2][2];
#pragma unroll
        for (int bj = 0; bj < 2; ++bj)
#pragma unroll
            for (int n = 0; n < 2; ++n) mv[bj][n] = *(const f32x4*)(m2 + bj * HALF + n * 16);
#pragma unroll
        for (int aq = 0; aq < 4; ++aq) { const int ai = aq >> 1, m0 = (aq & 1) * 2;
            f32x4 xv[4][2][2];
#pragma unroll
            for (int m = m0; m < m0 + 2; ++m) { const size_t o = (size_t)(row0 + ai * HALF + m * 16) * DM + col0;
#pragma unroll
                for (int bj = 0; bj < 2; ++bj)
#pragma unroll
                    for (int n = 0; n < 2; ++n) xv[m][bj][n] = *(const f32x4*)(xin + o + bj * HALF + n * 16); }
#pragma unroll
            for (int m = m0; m < m0 + 2; ++m) { const size_t o = (size_t)(row0 + ai * HALF + m * 16) * DM + col0;
#pragma unroll
                for (int bj = 0; bj < 2; ++bj)
#pragma unroll
                    for (int n = 0; n < 2; ++n) *(f32x4*)(xo + o + bj * HALF + n * 16) = ALPHA * xv[m][bj][n] + mv[bj][n] * acc[ai][bj][m][n]; }
            asm volatile("" ::: "memory");
        }
    }
};
struct EpiMoe1 { bf16_t* HID; const float* roww;
    __device__ __forceinline__ void operator()(const f32x4 (&acc)[2][2][4][2], const Unit& u, int wr, int wc, int fr, int fq) const {
        const int row0 = u.pm * BM + wr * 64 + fr, hc0 = u.pn * 128 + wc * 32 + 8 * fq;
#pragma unroll
        for (int ai = 0; ai < 2; ++ai)
#pragma unroll
            for (int m = 0; m < 4; ++m) { const int r = row0 + ai * HALF + m * 16; const float w = roww[r];
                const f32x4 g0 = acc[ai][0][m][0], g1 = acc[ai][0][m][1], u0 = acc[ai][1][m][0], u1 = acc[ai][1][m][1]; u32x4 o;
                o.x = pk2(siluf_(g0.x) * u0.x * w, siluf_(g0.y) * u0.y * w); o.y = pk2(siluf_(g0.z) * u0.z * w, siluf_(g0.w) * u0.w * w);
                o.z = pk2(siluf_(g1.x) * u1.x * w, siluf_(g1.y) * u1.y * w); o.w = pk2(siluf_(g1.z) * u1.z * w, siluf_(g1.w) * u1.w * w);
                *(u32x4*)(HID + (size_t)r * 256 + hc0) = o; }
    }
};
struct EpiMoe2 { bf16_t* Y; const int* rmap; bf16_t* dump;
    __device__ __forceinline__ void operator()(const f32x4 (&acc)[2][2][4][2], const Unit& u, int wr, int wc, int fr, int fq) const {
        PG_ROWCOL8;
#pragma unroll
        for (int ai = 0; ai < 2; ++ai)
#pragma unroll
            for (int m = 0; m < 4; ++m) { const int s = rmap[row0 + ai * HALF + m * 16];
                bf16_t* rowp = (s >= 0 ? Y + (size_t)s * DM : dump) + col0;
#pragma unroll
                for (int bj = 0; bj < 2; ++bj) { const f32x4 v0 = acc[ai][bj][m][0], v1 = acc[ai][bj][m][1]; u32x4 o; o.x = pk2(v0.x, v0.y); o.y = pk2(v0.z, v0.w); o.z = pk2(v1.x, v1.y); o.w = pk2(v1.z, v1.w); *(u32x4*)(rowp + bj * HALF) = o; } }
    }
};
#undef PG_ROWCOL8
#undef PG_ROWCOL
}

__device__ __forceinline__ void moe_offsets(Frame& F, int l, int* off) {
    if (F.tid < 64) {
        int v = (F.tid < 32) ? (((int)F.cnt()[l * 32 + F.tid] + 255) & ~255) : 0;
#pragma unroll
        for (int o = 1; o < 32; o <<= 1) { const int t = __shfl_up(v, o); if ((F.tid & 63) >= o) v += t; }
        if (F.tid < 32) off[F.tid + 1] = v;
        if (F.tid == 0) off[0] = 0;
    }
    __syncthreads();
}

__device__ __forceinline__ void phase_rope(Frame& F) {
    float* tab = F.smf;
    for (int e = F.tid; e < 1024; e += NTHR) { const int pp = e >> 4, i = e & 15; const float inv = powf(10000.f, -(float)i / 16.f), ang = (float)pp * inv; tab[2 * e] = cosf(ang); tab[2 * e + 1] = sinf(ang); }
    __syncthreads();
    const size_t total = (size_t)NTOK * 320;
    for (size_t idx = (size_t)F.bid * NTHR + F.tid; idx < total; idx += (size_t)F.nb * NTHR) {
        const int row = (int)(idx / 320), r = (int)(idx % 320), h = r >> 5, half = (r >> 4) & 1, i = r & 15;
        const int pos = row & (SEQ - 1), pp = half ? (pos & 63) : (pos >> 6);
        const float cs = tab[2 * (pp * 16 + i)], sn = tab[2 * (pp * 16 + i) + 1];
        bf16_t* base = F.P1() + (size_t)row * NP1 + (h < 8 ? PC_CQ + h * 64 : PC_CK + (h - 8) * 64) + half * 32 + i;
        const float u1 = bf2f(base[0]), u2 = bf2f(base[16]);
        base[0] = f2bf(u1 * cs - u2 * sn); base[16] = f2bf(u1 * sn + u2 * cs);
    }
}

__device__ __forceinline__ int seq_row(int s, int b, int z) {
    if (s < LC) { const int tc = z ? (LC - 1 - s) : s; return NTOK + b * LC + tc; }
    const int tl = s - LC, t = z ? (SEQ - 1 - tl) : tl; return b * SEQ + t;
}
typedef short bf16x8_t __attribute__((ext_vector_type(8)));
typedef short bf16x4_t __attribute__((ext_vector_type(4)));
struct MaskNone { __device__ __forceinline__ void operator()(f32x4&, f32x4&) const {} };
struct MaskNA { int u0; const float* brow;
    __device__ __forceinline__ void operator()(f32x4& s0, f32x4& s1) const {
        float v[8] = {s0.x, s0.y, s0.z, s0.w, s1.x, s1.y, s1.z, s1.w};
#pragma unroll
        for (int T = 0; T < 2; ++T)
#pragma unroll
            for (int rr = 0; rr < 4; ++rr) v[T * 4 + rr] = ((unsigned)(u0 + 16 * T + rr) < 16u) ? v[T * 4 + rr] + brow[16 * T + rr] : -INFINITY;
        s0 = (f32x4){v[0], v[1], v[2], v[3]}; s1 = (f32x4){v[4], v[5], v[6], v[7]};
    }
};
struct MaskWA { int i, j0;
    __device__ __forceinline__ void operator()(f32x4& s0, f32x4& s1) const {
        float v[8] = {s0.x, s0.y, s0.z, s0.w, s1.x, s1.y, s1.z, s1.w};
#pragma unroll
        for (int T = 0; T < 2; ++T)
#pragma unroll
            for (int rr = 0; rr < 4; ++rr) { const int j = j0 + 16 * T + rr; const bool ok = (j >= 0) && (j < SEQ) && (i - j <= 128) && (j - i <= 128);
                v[T * 4 + rr] = ok ? v[T * 4 + rr] : -INFINITY; }
        s0 = (f32x4){v[0], v[1], v[2], v[3]}; s1 = (f32x4){v[4], v[5], v[6], v[7]};
    }
};
struct KVF { bf16x8_t k[4]; bf16x4_t v[4][2]; };
__device__ __forceinline__ void kv_load(KVF& f, const char* kbase, unsigned ko0, unsigned ko1, const char* vbase, unsigned vo0, unsigned vo1) {
    f.k[0] = *(const bf16x8_t*)(kbase + ko0); f.k[1] = *(const bf16x8_t*)(kbase + ko0 + 64); f.k[2] = *(const bf16x8_t*)(kbase + ko1); f.k[3] = *(const bf16x8_t*)(kbase + ko1 + 64);
#pragma unroll
    for (int t = 0; t < 4; ++t) { f.v[t][0] = *(const bf16x4_t*)(vbase + vo0 + (unsigned)t * 16u * NROW * 2u); f.v[t][1] = *(const bf16x4_t*)(vbase + vo1 + (unsigned)t * 16u * NROW * 2u); }
}
__device__ __forceinline__ float xmax_g(float x) {
    auto r = __builtin_amdgcn_permlane16_swap(__float_as_uint(x), __float_as_uint(x), false, false); x = fmaxf(__uint_as_float(r[0]), __uint_as_float(r[1]));
    auto q = __builtin_amdgcn_permlane32_swap(__float_as_uint(x), __float_as_uint(x), false, false); return fmaxf(__uint_as_float(q[0]), __uint_as_float(q[1])); }
__device__ __forceinline__ float xsum_g(float x) {
    auto r = __builtin_amdgcn_permlane16_swap(__float_as_uint(x), __float_as_uint(x), false, false); x = __uint_as_float(r[0]) + __uint_as_float(r[1]);
    auto q = __builtin_amdgcn_permlane32_swap(__float_as_uint(x), __float_as_uint(x), false, false); return __uint_as_float(q[0]) + __uint_as_float(q[1]); }
template <class MaskF>
__device__ __forceinline__ void attn_tile(float& am, float& al, f32x4 (&ao)[4], const bf16x8_t (&qb)[2], const KVF& f, const MaskF& maskf) {
    f32x4 s0 = {0.f, 0.f, 0.f, 0.f}, s1 = {0.f, 0.f, 0.f, 0.f};
    s0 = __builtin_amdgcn_mfma_f32_16x16x32_bf16(f.k[0], qb[0], s0, 0, 0, 0); s0 = __builtin_amdgcn_mfma_f32_16x16x32_bf16(f.k[1], qb[1], s0, 0, 0, 0);
    s1 = __builtin_amdgcn_mfma_f32_16x16x32_bf16(f.k[2], qb[0], s1, 0, 0, 0); s1 = __builtin_amdgcn_mfma_f32_16x16x32_bf16(f.k[3], qb[1], s1, 0, 0, 0);
    maskf(s0, s1);
    const float mx = xmax_g(fmaxf(fmaxf(fmaxf(s0.x, s0.y), fmaxf(s0.z, s0.w)), fmaxf(fmaxf(s1.x, s1.y), fmaxf(s1.z, s1.w))));
    const float mn = fmaxf(am, mx);
    if (__any(mn != am)) {
        const float alpha = __builtin_amdgcn_exp2f(am - mn); am = mn; al *= alpha;
#pragma unroll
        for (int t = 0; t < 4; ++t) ao[t] = ao[t] * alpha;
    }
    f32x4 p0, p1;
    p0.x = __builtin_amdgcn_exp2f(s0.x - am); p0.y = __builtin_amdgcn_exp2f(s0.y - am); p0.z = __builtin_amdgcn_exp2f(s0.z - am); p0.w = __builtin_amdgcn_exp2f(s0.w - am);
    p1.x = __builtin_amdgcn_exp2f(s1.x - am); p1.y = __builtin_amdgcn_exp2f(s1.y - am); p1.z = __builtin_amdgcn_exp2f(s1.z - am); p1.w = __builtin_amdgcn_exp2f(s1.w - am);
    al += ((p0.x + p0.y) + (p0.z + p0.w)) + ((p1.x + p1.y) + (p1.z + p1.w));
    union { bf16x8_t v; unsigned u[4]; } pb;
    pb.u[0] = pk2(p0.x, p0.y); pb.u[1] = pk2(p0.z, p0.w); pb.u[2] = pk2(p1.x, p1.y); pb.u[3] = pk2(p1.z, p1.w);
#pragma unroll
    for (int t = 0; t < 4; ++t) {
        union { bf16x8_t v; bf16x4_t h[2]; } av; av.h[0] = f.v[t][0]; av.h[1] = f.v[t][1];
        ao[t] = __builtin_amdgcn_mfma_f32_16x16x32_bf16(av.v, pb.v, ao[t], 0, 0, 0);
    }
}
template <int kind>
__device__ __forceinline__ void attn_multi(Frame& F, int l, int item, const float* rpb_s) {
    constexpr int NQ = 2;
    constexpr int NLOC = (kind == 0) ? 9 : (kind == 1 ? 9 : 0), NS = 8 + NLOC;
    const int lane = F.lane, n = lane & 15, g = lane >> 4;
    const bf16_t* P1 = F.P1(); const bf16_t* VT = F.VT();
    int b, h0, kvh = 0, kcol, vrow, r = 0, cb = 0, t0 = 0, qrow0, qcol0, brcol0;
    constexpr int QRS = (kind == 0) ? 64 : (kind == 2 ? 16 : 0), QCS = (kind == 1 || kind == 3) ? 64 : 0;
    if (kind == 0) { cb = item & 3; r = ((item >> 2) & 31) * 2; h0 = (item >> 7) & 7; b = item >> 10; kcol = PC_BK + h0 * 64; vrow = h0 * 64; qrow0 = b * SEQ + r * 64 + cb * 16; qcol0 = PC_BQ + h0 * 64; brcol0 = 512 + h0 * 64; }
    else if (kind == 1) { const int hp = item & 1, qt = (item >> 1) & 255; kvh = (item >> 9) & 1; b = item >> 10; h0 = kvh * 4 + hp * 2; t0 = qt * 16; kcol = PC_CK + kvh * 64; vrow = 512 + kvh * 64; qrow0 = b * SEQ + t0; qcol0 = PC_CQ + h0 * 64; brcol0 = 1024 + h0 * 64; }
    else if (kind == 2) { const int qp = item & 7; h0 = (item >> 3) & 7; b = item >> 6; kcol = PC_BK + h0 * 64; vrow = h0 * 64; qrow0 = NTOK + b * LC + qp * 32; qcol0 = PC_BQ + h0 * 64; brcol0 = 512 + h0 * 64; }
    else { const int hp = item & 1, qt = (item >> 1) & 15; kvh = (item >> 5) & 1; b = item >> 6; h0 = kvh * 4 + hp * 2; kcol = PC_CK + kvh * 64; vrow = 512 + kvh * 64; qrow0 = NTOK + b * LC + qt * 16; qcol0 = PC_CQ + h0 * 64; brcol0 = 1024 + h0 * 64; }
    bf16x8_t qb[NQ][2]; float am[NQ], al[NQ]; f32x4 ao[NQ][4];
    { const char* qbase = (const char*)P1; const unsigned qo = (unsigned)(qrow0 + n) * (unsigned)(NP1 * 2) + (unsigned)(qcol0 + 8 * g) * 2u;
#pragma unroll
      for (int q = 0; q < NQ; ++q) { const unsigned o = qo + (unsigned)q * (unsigned)(QRS * NP1 * 2 + QCS * 2); qb[q][0] = *(const bf16x8_t*)(qbase + o); qb[q][1] = *(const bf16x8_t*)(qbase + o + 64);
        am[q] = -1e30f; al[q] = 0.f;
#pragma unroll
        for (int t = 0; t < 4; ++t) ao[q][t] = (f32x4){0.f, 0.f, 0.f, 0.f}; } }
    const int crow0 = NTOK + b * LC;
    const int w0 = (cb == 0) ? 0 : (cb == 1 ? 8 : (cb == 2 ? 24 : 32)), ru = min(max(r - 4, 0), 56);
    const char* kbase = (const char*)P1; const char* vbase = (const char*)VT;
    const unsigned kl = (unsigned)(kcol + 8 * g) * 2u, vl = (unsigned)(vrow + n) * (unsigned)NROW * 2u;
    auto load_step = [&](KVF& f, int s) {
        if (s < 8) { const unsigned ko = (unsigned)(crow0 + 32 * s + n) * (unsigned)(NP1 * 2) + kl, vo = vl + (unsigned)(crow0 + 32 * s + 4 * g) * 2u;
            kv_load(f, kbase, ko, ko + 16u * NP1 * 2u, vbase, vo, vo + 32u); }
        else if (kind == 0) { const int tok0 = b * SEQ + min(ru + (s - 8), 63) * 64 + w0; const unsigned ko = (unsigned)(tok0 + n) * (unsigned)(NP1 * 2) + kl, vo = vl + (unsigned)(tok0 + 4 * g) * 2u;
            kv_load(f, kbase, ko, ko + 16u * NP1 * 2u, vbase, vo, vo + 32u); }
        else if (kind == 1) { const int kb = t0 - 128 + 32 * (s - 8);
            const int ja = min(max(kb + n, 0), SEQ - 1), jb = min(max(kb + 16 + n, 0), SEQ - 1), va = min(max(kb + 4 * g, 0), SEQ - 4), vb = min(max(kb + 16 + 4 * g, 0), SEQ - 4);
            kv_load(f, kbase, (unsigned)(b * SEQ + ja) * (unsigned)(NP1 * 2) + kl, (unsigned)(b * SEQ + jb) * (unsigned)(NP1 * 2) + kl, vbase, vl + (unsigned)(b * SEQ + va) * 2u, vl + (unsigned)(b * SEQ + vb) * 2u); }
    };
    auto compute_step = [&](const KVF& f, int s) {
        if (s < 8) {
#pragma unroll
            for (int q = 0; q < NQ; ++q) { attn_tile(am[q], al[q], ao[q], qb[q], f, MaskNone()); if (NQ == 4) __builtin_amdgcn_sched_barrier(0); }
        } else if (kind == 0) {
            const int kr = ru + (s - 8);
#pragma unroll
            for (int q = 0; q < NQ; ++q) { const int rq = r + q, rsq = min(max(rq - 4, 0), 56);
                if (kr >= rsq && kr <= rsq + 7) { const int c = cb * 16 + n, csq = min(max(c - 8, 0), 48), kc0 = w0 + 4 * g;
                    MaskNA mk{kc0 - csq, rpb_s + (h0 * 15 + (kr - rq + 7)) * 64 + (kc0 - c + 15 + 16)}; attn_tile(am[q], al[q], ao[q], qb[q], f, mk); } }
        } else if (kind == 1) {
            const int ls = s - 8, kb = t0 - 128 + 32 * ls;
            if (ls >= 1 && ls <= 7 && kb >= 0 && kb + 31 < SEQ) {
#pragma unroll
                for (int q = 0; q < NQ; ++q) attn_tile(am[q], al[q], ao[q], qb[q], f, MaskNone());
            } else {
                MaskWA mk{t0 + n, kb + 4 * g};
#pragma unroll
                for (int q = 0; q < NQ; ++q) attn_tile(am[q], al[q], ao[q], qb[q], f, mk);
            }
        }
    };
    if (NQ == 2) {
        KVF fa, fb;
        load_step(fa, 0);
#pragma unroll 1
        for (int s = 0; s < NS; s += 2) {
            if (s + 1 < NS) load_step(fb, s + 1);
            compute_step(fa, s);
            if (s + 1 < NS) { if (s + 2 < NS) load_step(fa, s + 2); compute_step(fb, s + 1); }
        }
    } else {
        KVF fa;
#pragma unroll 1
        for (int s = 0; s < NS; ++s) { load_step(fa, s); compute_step(fa, s); }
    }
#pragma unroll
    for (int q = 0; q < NQ; ++q) {
        float lt = xsum_g(al[q]);
        float osc = 1.f;
        if (kind == 1 || kind == 3) { const float sk = F.p.wa_sink[l * 8 + h0 + q] * 1.44269504089f, mf = fmaxf(am[q], sk); osc = __builtin_amdgcn_exp2f(am[q] - mf); lt = lt * osc + __builtin_amdgcn_exp2f(sk - mf); }
        const float inv = osc / lt;
        char* obase = (char*)F.BR(); const unsigned oo = (unsigned)(qrow0 + q * QRS + n) * 4096u + (unsigned)(brcol0 + q * QCS + 4 * g) * 2u;
#pragma unroll
        for (int t = 0; t < 4; ++t) { const f32x4 v = ao[q][t] * inv; u32x2 o2; o2.x = pk2(v.x, v.y); o2.y = pk2(v.z, v.w); *(u32x2*)(obase + oo + 32u * t) = o2; }
    }
}


template <int kind>
__device__ __forceinline__ void attn_block(Frame& F, int l, int item, const float* rpb_s, bf16_t* sbuf) {
    constexpr int NQ = 2, NLOC = (kind == 0) ? 11 : (kind == 1 ? 10 : 0), NS = 8 + NLOC, SROW = 72;
    const int tid = F.tid, lane = F.lane, n = lane & 15, g = lane >> 4, w = __builtin_amdgcn_readfirstlane(F.wave);
    const bf16_t* P1 = F.P1(); const bf16_t* VT = F.VT();
    int b, h0, kvh = 0, kcol, vrow, r = 0, cb = 0, t0 = 0, t0g = 0, r0 = 0, qrow0, qcol0, brcol0;
    constexpr int QRS = (kind == 0) ? 64 : (kind == 2 ? 16 : 0), QCS = (kind == 1 || kind == 3) ? 64 : 0;
    if (kind == 0) { const int rq = item & 15, hb = (item >> 4) & 7; b = item >> 7; r0 = 4 * rq; cb = w & 3; r = r0 + 2 * (w >> 2); h0 = hb; kcol = PC_BK + hb * 64; vrow = hb * 64;
        qrow0 = b * SEQ + r * 64 + cb * 16; qcol0 = PC_BQ + hb * 64; brcol0 = 512 + hb * 64; }
    else if (kind == 1) { const int qg = item & 63; kvh = (item >> 6) & 1; b = item >> 7; t0g = 64 * qg; t0 = t0g + 16 * (w & 3); h0 = kvh * 4 + 2 * (w >> 2); kcol = PC_CK + kvh * 64; vrow = 512 + kvh * 64;
        qrow0 = b * SEQ + t0; qcol0 = PC_CQ + h0 * 64; brcol0 = 1024 + h0 * 64; }
    else if (kind == 2) { const int hb = item & 7; b = item >> 3; h0 = hb; kcol = PC_BK + hb * 64; vrow = hb * 64; qrow0 = NTOK + b * LC + 32 * w; qcol0 = PC_BQ + hb * 64; brcol0 = 512 + hb * 64; }
    else { const int qh = item & 3; kvh = (item >> 2) & 1; b = item >> 3; h0 = kvh * 4 + 2 * (w >> 2); kcol = PC_CK + kvh * 64; vrow = 512 + kvh * 64;
        qrow0 = NTOK + b * LC + 16 * (4 * qh + (w & 3)); qcol0 = PC_CQ + h0 * 64; brcol0 = 1024 + h0 * 64; }
    bf16x8_t qb[NQ][2]; float am[NQ], al[NQ]; f32x4 ao[NQ][4];
    { const char* qbase = (const char*)P1; const unsigned qo = (unsigned)(qrow0 + n) * (unsigned)(NP1 * 2) + (unsigned)(qcol0 + 8 * g) * 2u;
#pragma unroll
      for (int q = 0; q < NQ; ++q) { const unsigned o = qo + (unsigned)q * (unsigned)(QRS * NP1 * 2 + QCS * 2); qb[q][0] = *(const bf16x8_t*)(qbase + o); qb[q][1] = *(const bf16x8_t*)(qbase + o + 64);
        am[q] = -1e30f; al[q] = 0.f;
#pragma unroll
        for (int t = 0; t < 4; ++t) ao[q][t] = (f32x4){0.f, 0.f, 0.f, 0.f}; } }
    const int crow0 = NTOK + b * LC, ru0 = min(max(r0 - 4, 0), 56);
    const int w0 = (cb == 0) ? 0 : (cb == 1 ? 8 : (cb == 2 ? 24 : 32));
    const int srow = tid >> 3, sch = tid & 7;
    const char* kbase = (const char*)P1; const char* vbase = (const char*)VT;
    u32x4 kreg = {0u, 0u, 0u, 0u}, vreg = {0u, 0u, 0u, 0u};
    auto stage_load = [&](int s) {
        int krow, vcol; bool kon, von;
        if (s < 8) { krow = crow0 + 32 * s + srow; vcol = crow0 + 32 * s + 8 * sch; kon = srow < 32; von = sch < 4; }
        else if (kind == 0) { const int kr = min(ru0 + (s - 8), 63); krow = b * SEQ + kr * 64 + srow; vcol = b * SEQ + kr * 64 + 8 * sch; kon = true; von = true; }
        else { const int kb = t0g - 128 + 32 * (s - 8); krow = b * SEQ + min(max(kb + srow, 0), SEQ - 1); vcol = b * SEQ + min(max(kb + 8 * sch, 0), SEQ - 8); kon = srow < 32; von = sch < 4; }
        if (kon) kreg = *(const u32x4*)(kbase + (unsigned)krow * (unsigned)(NP1 * 2) + (unsigned)(kcol * 2 + sch * 16));
        if (von) vreg = *(const u32x4*)(vbase + (unsigned)(vrow + srow) * (unsigned)(NROW * 2) + (unsigned)vcol * 2u);
    };
    auto stage_store = [&](int s) { bf16_t* Ks = sbuf + (s & 1) * (2 * 64 * SROW); bf16_t* Vs = Ks + 64 * SROW;
        *(u32x4*)(Ks + srow * SROW + sch * 8) = kreg; *(u32x4*)(Vs + srow * SROW + sch * 8) = vreg; };
    stage_load(0); stage_store(0);
    __syncthreads();
#pragma unroll 1
    for (int s = 0; s < NS; ++s) {
        if (s + 1 < NS) stage_load(s + 1);
        bool act[NQ]; int kofs = 0;
        if (s < 8) { act[0] = act[1] = true; }
        else if (kind == 0) { const int kr = ru0 + (s - 8); kofs = w0;
#pragma unroll
            for (int q = 0; q < NQ; ++q) { const int rsq = min(max(r + q - 4, 0), 56); act[q] = (kr <= 63) && (kr >= rsq) && (kr <= rsq + 7); } }
        else { const int kb = t0g - 128 + 32 * (s - 8); act[0] = act[1] = (kb + 31 >= t0 - 128) && (kb <= t0 + 143); }
        if (act[0] || act[1]) {
            const bf16_t* Ks = sbuf + (s & 1) * (2 * 64 * SROW); const bf16_t* Vs = Ks + 64 * SROW;
            KVF f;
            f.k[0] = *(const bf16x8_t*)(Ks + (kofs + n) * SROW + 8 * g); f.k[1] = *(const bf16x8_t*)(Ks + (kofs + n) * SROW + 32 + 8 * g);
            f.k[2] = *(const bf16x8_t*)(Ks + (kofs + 16 + n) * SROW + 8 * g); f.k[3] = *(const bf16x8_t*)(Ks + (kofs + 16 + n) * SROW + 32 + 8 * g);
#pragma unroll
            for (int t = 0; t < 4; ++t) { f.v[t][0] = *(const bf16x4_t*)(Vs + (16 * t + n) * SROW + kofs + 4 * g); f.v[t][1] = *(const bf16x4_t*)(Vs + (16 * t + n) * SROW + kofs + 16 + 4 * g); }
            if (s < 8) {
#pragma unroll
                for (int q = 0; q < NQ; ++q) attn_tile(am[q], al[q], ao[q], qb[q], f, MaskNone());
            } else if (kind == 0) { const int kr = ru0 + (s - 8);
#pragma unroll
                for (int q = 0; q < NQ; ++q) if (act[q]) { const int c = cb * 16 + n, csq = min(max(c - 8, 0), 48), kc0 = w0 + 4 * g;
                    MaskNA mk{kc0 - csq, rpb_s + (h0 * 15 + (kr - (r + q) + 7)) * 64 + (kc0 - c + 15 + 16)}; attn_tile(am[q], al[q], ao[q], qb[q], f, mk); }
            } else if (kind == 1) { const int kb = t0g - 128 + 32 * (s - 8);
                if (kb >= t0 - 113 && kb + 31 <= t0 + 128 && kb >= 0 && kb + 31 < SEQ) {
#pragma unroll
                    for (int q = 0; q < NQ; ++q) attn_tile(am[q], al[q], ao[q], qb[q], f, MaskNone());
                } else { MaskWA mk{t0 + n, kb + 4 * g};
#pragma unroll
                    for (int q = 0; q < NQ; ++q) attn_tile(am[q], al[q], ao[q], qb[q], f, mk); }
            }
        }
        if (s + 1 < NS) stage_store(s + 1);
        __syncthreads();
    }
#pragma unroll
    for (int q = 0; q < NQ; ++q) {
        float lt = xsum_g(al[q]);
        float osc = 1.f;
        if (kind == 1 || kind == 3) { const float sk = F.p.wa_sink[l * 8 + h0 + q] * 1.44269504089f, mf = fmaxf(am[q], sk); osc = __builtin_amdgcn_exp2f(am[q] - mf); lt = lt * osc + __builtin_amdgcn_exp2f(sk - mf); }
        const float inv = osc / lt;
        char* obase = (char*)F.BR(); const unsigned oo = (unsigned)(qrow0 + q * QRS + n) * 4096u + (unsigned)(brcol0 + q * QCS + 4 * g) * 2u;
#pragma unroll
        for (int t = 0; t < 4; ++t) { const f32x4 v = ao[q][t] * inv; u32x2 o2; o2.x = pk2(v.x, v.y); o2.y = pk2(v.z, v.w); *(u32x2*)(obase + oo + 32u * t) = o2; }
    }
}

template <int DK, bool HG>
__device__ __forceinline__ void scan_mfma(Frame& F, int l, int b, int h, int z, int vh, unsigned char* lds) {
    constexpr int NDP = DK / 2, NTG = NTHR / NDP, TPT = 64 / NTG, QS = DK + 8, TS = 72, NDT = DK / 16;
    bf16_t* QD = (bf16_t*)lds; bf16_t* KD = QD + 64 * QS; bf16_t* KDT = KD + 64 * QS; bf16_t* VTs = KDT + DK * TS; bf16_t* AM = VTs + 64 * TS; bf16_t* ST = AM + 64 * TS;
    float* TOT = (float*)(ST + 64 * QS); float* E1s = TOT + NTG * DK; float* E2s = E1s + DK;
    REFRESH(F);
    const int tid = F.tid, lane = F.lane, w = F.wave, n = lane & 15, g = lane >> 4;
    const int dp = tid % NDP, tg = tid / NDP, vp = tid & 31, vg = tid >> 5;
    const int vt = w & 3, wh = w >> 2;
    const bf16_t* P1 = F.P1();
    float lw[HG ? 2 : 32], lbias[2] = {0.f, 0.f}, lbv[2] = {0.f, 0.f};
    if (!HG) {
#pragma unroll
        for (int r = 0; r < 16; ++r) { const float* wp = F.p.gla_lr_w + ((size_t)(l * 2 + z) * 16 + r) * 256 + h * 64 + 2 * dp; lw[2 * r] = wp[0]; lw[2 * r + 1] = wp[1]; }
        lbias[0] = F.p.gla_lr_b[(l * 2 + z) * 256 + h * 64 + 2 * dp]; lbias[1] = F.p.gla_lr_b[(l * 2 + z) * 256 + h * 64 + 2 * dp + 1];
    } else { lw[0] = lw[1] = 0.f; if (l != 0) { lbv[0] = F.lb()[z * 512 + h * 128 + 2 * dp]; lbv[1] = F.lb()[z * 512 + h * 128 + 2 * dp + 1]; } }
    f32x4 accS[NDT / 2];
#pragma unroll
    for (int i = 0; i < NDT / 2; ++i) accS[i] = (f32x4){0.f, 0.f, 0.f, 0.f};
    unsigned rq[TPT], rk[TPT], rv[4]; u32x4 rl[HG ? 1 : TPT][2];
    const int qcol = HG ? PC_DQ + h * 128 + 2 * dp : PC_AQ + h * 64 + 2 * dp, kcol = HG ? PC_DF + z * 512 + h * 128 + 2 * dp : PC_AK + h * 64 + 2 * dp;
    const int vcol = (HG ? PC_DI : PC_AV) + h * 128 + 64 * vh + 2 * vp;
    const char* p1b = (const char*)P1; const int sgn = z ? -1 : 1; const int rstep = sgn * NP1 * 2;
#define SCAN_LOAD(c) do { const int row0_ = seq_row((c) * 64, b, z); \
        int o_ = (row0_ + sgn * tg * TPT) * (NP1 * 2); \
        _Pragma("unroll") for (int tt = 0; tt < TPT; ++tt) { rq[tt] = *(const unsigned*)(p1b + (unsigned)(o_ + qcol * 2)); rk[tt] = *(const unsigned*)(p1b + (unsigned)(o_ + kcol * 2)); \
            if (!HG) { rl[tt][0] = *(const u32x4*)(p1b + (unsigned)(o_ + (PC_ALR + z * 16) * 2)); rl[tt][1] = *(const u32x4*)(p1b + (unsigned)(o_ + (PC_ALR + z * 16 + 8) * 2)); } o_ += rstep; } \
        int ov_ = (row0_ + sgn * vg * 4) * (NP1 * 2) + vcol * 2; \
        _Pragma("unroll") for (int tt = 0; tt < 4; ++tt) { rv[tt] = *(const unsigned*)(p1b + (unsigned)ov_); ov_ += rstep; } } while (0)
    SCAN_LOAD(0);
    constexpr int NCH = (LC + SEQ) / 64;
#pragma unroll 1
    for (int c = 0; c < NCH; ++c) {
        float qv[TPT][2], kv[TPT][2], cs[TPT][2];
#pragma unroll
        for (int tt = 0; tt < TPT; ++tt)
#pragma unroll
            for (int e = 0; e < 2; ++e) {
                const float qr = __uint_as_float(e ? (rq[tt] & 0xffff0000u) : (rq[tt] << 16)), kr = __uint_as_float(e ? (rk[tt] & 0xffff0000u) : (rk[tt] << 16));
                float gg;
                if (HG) {
                    gg = kr;
                    kv[tt][e] = 1.f - __expf(kr);
                    qv[tt][e] = qr;
                } else {
                    float lg = lbias[e];
                    const unsigned lr8[8] = {rl[tt][0].x, rl[tt][0].y, rl[tt][0].z, rl[tt][0].w, rl[tt][1].x, rl[tt][1].y, rl[tt][1].z, rl[tt][1].w};
#pragma unroll
                    for (int r2 = 0; r2 < 8; ++r2) { lg += __uint_as_float(lr8[r2] << 16) * lw[(2 * r2) * 2 + e]; lg += __uint_as_float(lr8[r2] & 0xffff0000u) * lw[(2 * r2 + 1) * 2 + e]; }
                    const float t = __expf(-fabsf(lg)), r = __builtin_amdgcn_rcpf(1.f + t);
                    gg = (fminf(lg, 0.f) + __logf(r)) * (1.f / 16.f);
                    kv[tt][e] = kr; qv[tt][e] = qr;
                }
                cs[tt][e] = gg + (tt ? cs[tt ? tt - 1 : 0][e] : 0.f);
            }
        TOT[tg * DK + 2 * dp] = cs[TPT - 1][0]; TOT[tg * DK + 2 * dp + 1] = cs[TPT - 1][1];
        __syncthreads();
        float offs[2] = {0.f, 0.f}, mid[2] = {0.f, 0.f}, lastv[2] = {0.f, 0.f};
#pragma unroll
        for (int t2 = 0; t2 < NTG; ++t2)
#pragma unroll
            for (int e = 0; e < 2; ++e) { const float tv = TOT[t2 * DK + 2 * dp + e]; if (t2 < tg) offs[e] += tv; if (t2 < NTG / 2) mid[e] += tv; lastv[e] += tv; }
        unsigned kdt[2][TPT / 2]; float kprev[2] = {0.f, 0.f};
#pragma unroll
        for (int tt = 0; tt < TPT; ++tt) {
            float qd[2], kd[2];
#pragma unroll
            for (int e = 0; e < 2; ++e) { const float x = fminf(fmaxf(cs[tt][e] + offs[e] - mid[e], -80.f), 80.f); qd[e] = qv[tt][e] * __expf(x); kd[e] = kv[tt][e] * __expf(-x); }
            const int tok = tg * TPT + tt;
            *(unsigned*)(QD + tok * QS + 2 * dp) = pk2(qd[0], qd[1]); *(unsigned*)(KD + tok * QS + 2 * dp) = pk2(kd[0], kd[1]);
            if (tt & 1) { kdt[0][tt >> 1] = pk2(kprev[0], kd[0]); kdt[1][tt >> 1] = pk2(kprev[1], kd[1]); } else { kprev[0] = kd[0]; kprev[1] = kd[1]; }
        }
#pragma unroll
        for (int e = 0; e < 2; ++e) {
            bf16_t* dst = KDT + (2 * dp + e) * TS + tg * TPT;
            if (TPT == 8) { u32x4 o; o.x = kdt[e][0]; o.y = kdt[e][1]; o.z = kdt[e][TPT / 2 - 2]; o.w = kdt[e][TPT / 2 - 1]; *(u32x4*)dst = o; }
            else { u32x2 o; o.x = kdt[e][0]; o.y = kdt[e][1]; *(u32x2*)dst = o; }
        }
        if (tg == 0) { E1s[2 * dp] = __expf(mid[0]); E1s[2 * dp + 1] = __expf(mid[1]); E2s[2 * dp] = __expf(lastv[0] - mid[0]); E2s[2 * dp + 1] = __expf(lastv[1] - mid[1]); }
        {   u32x2 o0, o1;
            o0.x = (rv[0] & 0xffffu) | (rv[1] << 16); o0.y = (rv[2] & 0xffffu) | (rv[3] << 16);
            o1.x = (rv[0] >> 16) | (rv[1] & 0xffff0000u); o1.y = (rv[2] >> 16) | (rv[3] & 0xffff0000u);
            *(u32x2*)(VTs + (2 * vp) * TS + vg * 4) = o0; *(u32x2*)(VTs + (2 * vp + 1) * TS + vg * 4) = o1; }
        if (c + 1 < NCH) SCAN_LOAD(c + 1);
        __syncthreads();
#pragma unroll
        for (int i = 0; i < NDT / 2; ++i) { const int dt = wh * (NDT / 2) + i; accS[i] = accS[i] * *(const f32x4*)&E1s[16 * dt + 4 * g];
            u32x2 o; o.x = pk2(accS[i].x, accS[i].y); o.y = pk2(accS[i].z, accS[i].w); *(u32x2*)(ST + (16 * vt + n) * QS + 16 * dt + 4 * g) = o; }
        {   const int it = w >> 1, jt0 = 2 * (w & 1);
            f32x4 d0 = {0.f, 0.f, 0.f, 0.f}, d1 = {0.f, 0.f, 0.f, 0.f};
            if (jt0 <= it) {
                bf16x8_t qf[DK / 32], k0f[DK / 32], k1f[DK / 32];
#pragma unroll
                for (int ks = 0; ks < DK / 32; ++ks) { qf[ks] = *(const bf16x8_t*)(QD + (16 * it + n) * QS + 32 * ks + 8 * g); k0f[ks] = *(const bf16x8_t*)(KD + (16 * jt0 + n) * QS + 32 * ks + 8 * g); k1f[ks] = *(const bf16x8_t*)(KD + (16 * (jt0 + 1) + n) * QS + 32 * ks + 8 * g); }
#pragma unroll
                for (int ks = 0; ks < DK / 32; ++ks) { d0 = __builtin_amdgcn_mfma_f32_16x16x32_bf16(k0f[ks], qf[ks], d0, 0, 0, 0); d1 = __builtin_amdgcn_mfma_f32_16x16x32_bf16(k1f[ks], qf[ks], d1, 0, 0, 0); }
                const int i = 16 * it + n, j0 = 16 * jt0 + 4 * g, j1 = j0 + 16;
                d0.x = (j0 + 0 <= i) ? d0.x : 0.f; d0.y = (j0 + 1 <= i) ? d0.y : 0.f; d0.z = (j0 + 2 <= i) ? d0.z : 0.f; d0.w = (j0 + 3 <= i) ? d0.w : 0.f;
                d1.x = (j1 + 0 <= i) ? d1.x : 0.f; d1.y = (j1 + 1 <= i) ? d1.y : 0.f; d1.z = (j1 + 2 <= i) ? d1.z : 0.f; d1.w = (j1 + 3 <= i) ? d1.w : 0.f;
            }
            u32x2 o; o.x = pk2(d0.x, d0.y); o.y = pk2(d0.z, d0.w); *(u32x2*)(AM + (16 * it + n) * TS + 16 * jt0 + 4 * g) = o;
            o.x = pk2(d1.x, d1.y); o.y = pk2(d1.z, d1.w); *(u32x2*)(AM + (16 * it + n) * TS + 16 * (jt0 + 1) + 4 * g) = o;
        }
        __syncthreads();
        {   f32x4 o[2];
#pragma unroll
            for (int ii = 0; ii < 2; ++ii) o[ii] = (f32x4){0.f, 0.f, 0.f, 0.f};
#pragma unroll
            for (int ks = 0; ks < 2; ++ks) { const bf16x8_t af = *(const bf16x8_t*)(VTs + (16 * vt + n) * TS + 32 * ks + 8 * g); bf16x8_t bf[2];
#pragma unroll
                for (int ii = 0; ii < 2; ++ii) bf[ii] = *(const bf16x8_t*)(AM + (16 * (2 * wh + ii) + n) * TS + 32 * ks + 8 * g);
#pragma unroll
                for (int ii = 0; ii < 2; ++ii) o[ii] = __builtin_amdgcn_mfma_f32_16x16x32_bf16(af, bf[ii], o[ii], 0, 0, 0); }
#pragma unroll
            for (int ks = 0; ks < DK / 32; ++ks) { const bf16x8_t af = *(const bf16x8_t*)(ST + (16 * vt + n) * QS + 32 * ks + 8 * g); bf16x8_t bf[2];
#pragma unroll
                for (int ii = 0; ii < 2; ++ii) bf[ii] = *(const bf16x8_t*)(QD + (16 * (2 * wh + ii) + n) * QS + 32 * ks + 8 * g);
#pragma unroll
                for (int ii = 0; ii < 2; ++ii) o[ii] = __builtin_amdgcn_mfma_f32_16x16x32_bf16(af, bf[ii], o[ii], 0, 0, 0); }
            const int row0 = seq_row(c * 64, b, z) + sgn * (32 * wh + n), vc = h * 128 + 64 * vh + 16 * vt + 4 * g;
            char* dstb; unsigned doff; int dstride;
            if (HG) { dstb = (char*)F.ODH(); doff = (unsigned)row0 * 2048u + (unsigned)(z * 512 + vc) * 2u; dstride = sgn * 16 * 2048; }
            else if (z == 0) { dstb = (char*)F.BR(); doff = (unsigned)row0 * 4096u + (unsigned)vc * 2u; dstride = sgn * 16 * 4096; }
            else { dstb = (char*)F.OBA(); doff = (unsigned)row0 * 1024u + (unsigned)vc * 2u; dstride = sgn * 16 * 1024; }
#pragma unroll
            for (int ii = 0; ii < 2; ++ii) { u32x2 o2; o2.x = pk2(o[ii].x, o[ii].y); o2.y = pk2(o[ii].z, o[ii].w); *(u32x2*)(dstb + (unsigned)((int)doff + ii * dstride)) = o2; }
        }
#pragma unroll
        for (int ks = 0; ks < 2; ++ks) { const bf16x8_t bv = *(const bf16x8_t*)(VTs + (16 * vt + n) * TS + 32 * ks + 8 * g); bf16x8_t af[NDT / 2];
#pragma unroll
            for (int i = 0; i < NDT / 2; ++i) af[i] = *(const bf16x8_t*)(KDT + (16 * (wh * (NDT / 2) + i) + n) * TS + 32 * ks + 8 * g);
#pragma unroll
            for (int i = 0; i < NDT / 2; ++i) accS[i] = __builtin_amdgcn_mfma_f32_16x16x32_bf16(af[i], bv, accS[i], 0, 0, 0); }
#pragma unroll
        for (int i = 0; i < NDT / 2; ++i) accS[i] = accS[i] * *(const f32x4*)&E2s[16 * (wh * (NDT / 2) + i) + 4 * g];
        __syncthreads();
    }
#undef SCAN_LOAD
}

__device__ __forceinline__ void phase_mix(Frame& F, int l) {
    const int n_scan = 128;
    const int nsb = (F.nb > 192) ? 128 : 0;
    if (nsb == 0 || F.bid < nsb) {
        for (int it = F.bid; it < n_scan; it += (nsb ? nsb : F.nb)) {
            const int br = it >> 6, r = (it >> 1) & 31, vh = it & 1, b = r >> 3, h = (r >> 1) & 3, z = r & 1;
            if (br == 0) scan_mfma<64, false>(F, l, b, h, z, vh, (unsigned char*)F.smf); else scan_mfma<128, true>(F, l, b, h, z, vh, (unsigned char*)F.smf);
        }
        __syncthreads();
    }
    float* rpb_s = F.smf;
    for (int i = F.tid; i < 8 * 15 * 64; i += NTHR) { const int dcp = i & 63, hr = i >> 6; rpb_s[i] = (dcp >= 16 && dcp < 47) ? F.p.na_rpb[(size_t)l * 8 * 465 + hr * 31 + (dcp - 16)] * 1.44269504089f : 0.f; }
    bf16_t* sbuf = (bf16_t*)(F.smf + 8 * 15 * 64);
    unsigned* qhead = F.cnt() + 64 + l * 16;
    int* cur = (int*)((unsigned char*)F.smf - LDS_STAGE + 32);
    const int n_wa = 512, n_na = 512, n_cna = (l == 0) ? 32 : 0, n_cwa = (l == 0) ? 32 : 0, total = n_wa + n_na + n_cna + n_cwa;
    for (;;) {
        __syncthreads();
        if (F.tid == 0) *cur = (int)atomicAdd(qhead, 1u);
        __syncthreads();
        const int it = *cur;
        if (it >= total) break;
        if (it < n_wa) attn_block<1>(F, l, it, rpb_s, sbuf);
        else if (it < n_wa + n_na) attn_block<0>(F, l, it - n_wa, rpb_s, sbuf);
        else if (it < n_wa + n_na + n_cna) attn_block<2>(F, l, it - n_wa - n_na, rpb_s, sbuf);
        else attn_block<3>(F, l, it - n_wa - n_na - n_cna, rpb_s, sbuf);
    }
}

__device__ __forceinline__ void phase_prepad(Frame& F, int l) {
    const int gw = F.bid * 8 + F.wave, ngw = F.nb * 8, npairs = ((l == 0) ? NROW : NTOK) / 2, c0 = F.lane * 8;
    for (int pi = gw; pi < npairs; pi += ngw) {
        u32x4 ra[2][2], rb[2][2], rg[2][2];
#pragma unroll
        for (int q = 0; q < 2; ++q) { const size_t row = (size_t)pi * 2 + q;
            ra[q][0] = *(const u32x4*)(F.BR() + row * 2048 + c0); rb[q][0] = *(const u32x4*)(F.OBA() + row * 512 + c0); rg[q][0] = *(const u32x4*)(F.P1() + row * NP1 + PC_AG + c0);
            ra[q][1] = *(const u32x4*)(F.ODH() + row * 1024 + c0); rb[q][1] = *(const u32x4*)(F.ODH() + row * 1024 + 512 + c0); rg[q][1] = *(const u32x4*)(F.P1() + row * NP1 + PC_DG + c0); }
#pragma unroll
        for (int q = 0; q < 2; ++q)
#pragma unroll
            for (int br = 0; br < 2; ++br) {
                const unsigned ua[4] = {ra[q][br].x, ra[q][br].y, ra[q][br].z, ra[q][br].w}, ub[4] = {rb[q][br].x, rb[q][br].y, rb[q][br].z, rb[q][br].w}, ug[4] = {rg[q][br].x, rg[q][br].y, rg[q][br].z, rg[q][br].w};
                float o[8], g[8]; float ss = 0.f;
#pragma unroll
                for (int j = 0; j < 4; ++j) { o[2 * j] = __uint_as_float(ua[j] << 16) + __uint_as_float(ub[j] << 16); o[2 * j + 1] = __uint_as_float(ua[j] & 0xffff0000u) + __uint_as_float(ub[j] & 0xffff0000u);
                    g[2 * j] = __uint_as_float(ug[j] << 16); g[2 * j + 1] = __uint_as_float(ug[j] & 0xffff0000u); ss += o[2 * j] * o[2 * j] + o[2 * j + 1] * o[2 * j + 1]; }
                ss += __shfl_xor(ss, 1); ss += __shfl_xor(ss, 2); ss += __shfl_xor(ss, 4); ss += __shfl_xor(ss, 8);
                const float rs = rsqrtf(ss * (1.f / 128.f) + 1e-6f);
#pragma unroll
                for (int j = 0; j < 8; ++j) o[j] = o[j] * rs * siluf_(g[j]);
                st8(F.BR() + ((size_t)pi * 2 + q) * 2048 + (br ? 1536 : 0) + c0, o);
            }
    }
}

__device__ __forceinline__ void phase_ln1(Frame& F, int l) {
    const int nrows = (l == 0) ? NROW : NTOK, ngroups = nrows / 64;
    const float* lg = F.p.ln_g + (size_t)(l * 2 + 0) * DM; const float* lbb = F.p.ln_b + (size_t)(l * 2 + 0) * DM;
    float* part = F.smf;
    const int wv = __builtin_amdgcn_readfirstlane(F.wave);
    float* stg = F.smf + 8 * 36 * 64 + wv * (64 * 17 + 16 * 40);
    float* wl = stg + 64 * 17;
    for (int grp = F.bid; grp < ngroups; grp += F.nb) {
        const int row0 = grp * 64, rb = row_batch(row0);
        const float* mv = F.modv() + ((size_t)l * 5 + rb) * 6144;
        float* xg = row0 < NTOK ? F.p.out + (size_t)row0 * DM : F.cxm() + (size_t)(row0 - NTOK) * DM;
#pragma unroll 1
        for (int rr = 0; rr < 8; rr += 2) {
            const int lr = wv * 8 + rr; float* xr = xg + (size_t)lr * DM;
            f32x4 v[2][4]; float s[2] = {0.f, 0.f};
#pragma unroll
            for (int q = 0; q < 2; ++q)
#pragma unroll
                for (int j = 0; j < 4; ++j) v[q][j] = *(const f32x4*)(xr + (size_t)q * DM + j * 256 + F.lane * 4);
#pragma unroll
            for (int q = 0; q < 2; ++q)
#pragma unroll
                for (int j = 0; j < 4; ++j) s[q] += (v[q][j].x + v[q][j].y) + (v[q][j].z + v[q][j].w);
#pragma unroll
            for (int o = 1; o < 64; o <<= 1) { s[0] += __shfl_xor(s[0], o); s[1] += __shfl_xor(s[1], o); }
            float s2[2] = {0.f, 0.f};
#pragma unroll
            for (int q = 0; q < 2; ++q) { const float mean = s[q] * (1.f / DM);
#pragma unroll
                for (int j = 0; j < 4; ++j) { v[q][j] = v[q][j] - mean; s2[q] += (v[q][j].x * v[q][j].x + v[q][j].y * v[q][j].y) + (v[q][j].z * v[q][j].z + v[q][j].w * v[q][j].w); } }
#pragma unroll
            for (int o = 1; o < 64; o <<= 1) { s2[0] += __shfl_xor(s2[0], o); s2[1] += __shfl_xor(s2[1], o); }
#pragma unroll
            for (int j = 0; j < 4; ++j) { const int d = j * 256 + F.lane * 4;
                const f32x4 g4 = *(const f32x4*)(lg + d), b4 = *(const f32x4*)(lbb + d), m3 = *(const f32x4*)(mv + 3 * 1024 + d), m4 = *(const f32x4*)(mv + 4 * 1024 + d);
#pragma unroll
                for (int q = 0; q < 2; ++q) { const float rstd = rsqrtf(s2[q] * (1.f / DM) + LN_EPS);
                    const f32x4 xn = v[q][j] * rstd * g4 + b4;
                    *(f32x4*)(xr + (size_t)q * DM + d) = xn;
                    const f32x4 h2 = xn * (1.f + m4) + m3;
                    u32x2 o2; o2.x = pk2(h2.x, h2.y); o2.y = pk2(h2.z, h2.w);
                    *(u32x2*)(F.HX2() + (size_t)(row0 + lr + q) * DM + d) = o2; } }
        }
        __syncthreads();
        {   f32x4 acc[4][3];
#pragma unroll
            for (int mt = 0; mt < 4; ++mt)
#pragma unroll
                for (int nt = 0; nt < 3; ++nt) acc[mt][nt] = (f32x4){0.f, 0.f, 0.f, 0.f};
            const float* wgp = F.p.moe_w_group + ((size_t)l * DM + wv * 128) * 4; const float* wep = F.p.moe_w_expert + ((size_t)l * DM + wv * 128) * 32;
            const float* m3p = mv + 3 * 1024 + wv * 128; const float* m4p = mv + 4 * 1024 + wv * 128;
            const int ln = F.lane & 15, lk = F.lane >> 4;
#pragma unroll 1
            for (int dc = 0; dc < 128; dc += 16) {
                f32x4 t[4]; float bw[4][3];
#pragma unroll
                for (int i = 0; i < 4; ++i) t[i] = *(const f32x4*)(xg + (size_t)(16 * i + (F.lane >> 2)) * DM + wv * 128 + dc + (F.lane & 3) * 4);
                const f32x4 m3v = *(const f32x4*)(m3p + dc + (F.lane & 3) * 4), m4v = *(const f32x4*)(m4p + dc + (F.lane & 3) * 4);
#pragma unroll
                for (int ks = 0; ks < 4; ++ks) { const int d = dc + 4 * ks + lk; bw[ks][0] = wep[(size_t)d * 32 + ln]; bw[ks][1] = wep[(size_t)d * 32 + 16 + ln]; bw[ks][2] = (ln < 4) ? wgp[(size_t)d * 4 + ln] : 0.f; }
#pragma unroll
                for (int i = 0; i < 4; ++i) { float* sp = stg + (16 * i + (F.lane >> 2)) * 17 + (F.lane & 3) * 4;
                    sp[0] = t[i].x * (1.f + m4v.x) + m3v.x; sp[1] = t[i].y * (1.f + m4v.y) + m3v.y; sp[2] = t[i].z * (1.f + m4v.z) + m3v.z; sp[3] = t[i].w * (1.f + m4v.w) + m3v.w; }
                asm volatile("s_waitcnt lgkmcnt(0)" ::: "memory");
#pragma unroll
                for (int ks = 0; ks < 4; ++ks)
#pragma unroll
                    for (int mt = 0; mt < 4; ++mt) { const float av = stg[(16 * mt + ln) * 17 + 4 * ks + lk];
#pragma unroll
                        for (int nt = 0; nt < 3; ++nt) acc[mt][nt] = __builtin_amdgcn_mfma_f32_16x16x4f32(av, bw[ks][nt], acc[mt][nt], 0, 0, 0); }
                asm volatile("s_waitcnt lgkmcnt(0)" ::: "memory");
            }
#pragma unroll
            for (int mt = 0; mt < 4; ++mt)
#pragma unroll
                for (int nt = 0; nt < 3; ++nt) { const int oi = (nt == 2) ? ln : 4 + 16 * nt + ln;
                    if (nt < 2 || ln < 4) {
#pragma unroll
                        for (int r = 0; r < 4; ++r) part[(wv * 36 + oi) * 64 + 16 * mt + 4 * lk + r] = acc[mt][nt][r]; } }
        }
        __syncthreads();
        if (wv == 0) {
            const int row = row0 + F.lane;
            float gl[4]; int gi = 0; float gm = -3.4e38f;
#pragma unroll
            for (int o = 0; o < 4; ++o) { float t = F.p.moe_b_group[l * 4 + o];
#pragma unroll
                for (int w2 = 0; w2 < 8; ++w2) t += part[(w2 * 36 + o) * 64 + F.lane];
                gl[o] = t; if (t > gm) { gm = t; gi = o; } }
            float gs = 0.f;
#pragma unroll
            for (int o = 0; o < 4; ++o) gs += expf(gl[o] - gm);
            const float gwt = 1.f / gs;
            float e1 = -3.4e38f, e2 = -3.4e38f; int i1 = 0, i2 = 0;
#pragma unroll
            for (int o8 = 0; o8 < 8; ++o8) { const int o = gi * 8 + o8; float ev = F.p.moe_b_expert[l * 32 + o];
#pragma unroll
                for (int w2 = 0; w2 < 8; ++w2) ev += part[(w2 * 36 + 4 + o) * 64 + F.lane];
                if (ev > e1) { e2 = e1; i2 = i1; e1 = ev; i1 = o; } else if (ev > e2) { e2 = ev; i2 = o; } }
            const float w1 = 1.f / (1.f + expf(e2 - e1)), w2v = 1.f - w1;
            unsigned* lh = (unsigned*)(stg + 64 * 17 + 16 * 40 - 64);
            if (F.lane < 32) lh[F.lane] = 0u;
            asm volatile("s_waitcnt lgkmcnt(0)" ::: "memory");
            const unsigned r1 = atomicAdd(&lh[i1], 1u), r2 = atomicAdd(&lh[i2], 1u);
            asm volatile("s_waitcnt lgkmcnt(0)" ::: "memory");
            if (F.lane < 32) { const unsigned c = lh[F.lane]; lh[32 + F.lane] = c ? atomicAdd(&F.cnt()[l * 32 + F.lane], c) : 0u; }
            asm volatile("s_waitcnt vmcnt(0) lgkmcnt(0)" ::: "memory");
            const unsigned p1 = lh[32 + i1] + r1, p2 = lh[32 + i2] + r2;
            F.tokE()[row * 2] = i1; F.tokI()[row * 2] = (int)p1; F.tokW()[row * 2] = gwt * w1;
            F.tokE()[row * 2 + 1] = i2; F.tokI()[row * 2 + 1] = (int)p2; F.tokW()[row * 2 + 1] = gwt * w2v;
        }
        __syncthreads();
    }
}

__device__ __forceinline__ void phase_gather(Frame& F, int l) {
    int* off = (int*)F.smf; moe_offsets(F, l, off);
    const int gw = F.bid * 8 + F.wave, ngw = F.nb * 8, nrows = (l == 0) ? NROW : NTOK;
    for (int s0 = gw; s0 < 2 * nrows; s0 += 4 * ngw) {
        int sl[4], e[4], ti[4]; float tw[4]; u32x4 a0[4], a1[4];
#pragma unroll
        for (int q = 0; q < 4; ++q) { sl[q] = min(s0 + q * ngw, 2 * nrows - 1); e[q] = F.tokE()[sl[q]]; ti[q] = F.tokI()[sl[q]]; tw[q] = F.tokW()[sl[q]];
            const u32x4* src = (const u32x4*)(F.HX2() + (size_t)(sl[q] >> 1) * DM); a0[q] = src[F.lane]; a1[q] = src[F.lane + 64]; }
#pragma unroll
        for (int q = 0; q < 4; ++q) if (s0 + q * ngw < 2 * nrows) { const int dst = off[e[q]] + ti[q]; u32x4* d = (u32x4*)(F.XS() + (size_t)dst * DM);
            d[F.lane] = a0[q]; d[F.lane + 64] = a1[q];
            if (F.lane == 0) { F.rmap()[dst] = sl[q]; F.roww()[dst] = tw[q]; } }
    }
    for (int e = 0; e < 32; ++e) {
        const int c = (int)F.cnt()[l * 32 + e], pc = (c + 255) & ~255;
        for (int j = c + gw; j < pc; j += ngw) { const int dst = off[e] + j; u32x4* d = (u32x4*)(F.XS() + (size_t)dst * DM);
            const u32x4 z = {0u, 0u, 0u, 0u}; d[F.lane] = z; d[F.lane + 64] = z;
            if (F.lane == 0) { F.rmap()[dst] = -1; F.roww()[dst] = 0.f; } }
    }
}
__device__ __forceinline__ int expert_of_row(const int* off, int row) { int e = 0;
#pragma unroll 1
    for (int i = 1; i < 32; ++i) if (row >= off[i]) e = i;
    return e; }

__device__ __forceinline__ void phase_ln2(Frame& F, int l) {
    const int gw = F.bid * 8 + F.wave, ngw = F.nb * 8, npairs = ((l == 0) ? NROW : NTOK) / 2;
    const float* lg = F.p.ln_g + (size_t)(l * 2 + 1) * DM; const float* lbb = F.p.ln_b + (size_t)(l * 2 + 1) * DM;
    const bf16_t* Y = F.BR();
    const bool tmo_set = (l == DEPTH - 1) && (__hip_atomic_load((unsigned*)(F.ws + WS_CTL) + XB_TMO, __ATOMIC_RELAXED, __HIP_MEMORY_SCOPE_AGENT) != 0u);
    for (int pi = gw; pi < npairs; pi += ngw) {
        const int row0 = pi * 2, rb = row_batch(row0);
        const float* xm = row0 < NTOK ? F.p.out + (size_t)row0 * DM : F.cxm() + (size_t)(row0 - NTOK) * DM;
        float* xo = row0 < NTOK ? F.p.out + (size_t)row0 * DM : F.cxo() + (size_t)(row0 - NTOK) * DM;
        const float* mv = F.modv() + ((size_t)l * 5 + rb) * 6144;
        u32x2 y0[2][4], y1[2][4]; f32x4 xv[2][4], m5[4];
#pragma unroll
        for (int j = 0; j < 4; ++j) { const int d = j * 256 + F.lane * 4; m5[j] = *(const f32x4*)(mv + 5 * 1024 + d);
#pragma unroll
            for (int q = 0; q < 2; ++q) { y0[q][j] = *(const u32x2*)(Y + (size_t)((row0 + q) * 2) * DM + d); y1[q][j] = *(const u32x2*)(Y + (size_t)((row0 + q) * 2 + 1) * DM + d); xv[q][j] = *(const f32x4*)(xm + (size_t)q * DM + d); } }
        f32x4 v[2][4]; float s[2] = {0.f, 0.f};
#pragma unroll
        for (int q = 0; q < 2; ++q)
#pragma unroll
            for (int j = 0; j < 4; ++j) { f32x4 y; y.x = __uint_as_float(y0[q][j].x << 16) + __uint_as_float(y1[q][j].x << 16); y.y = __uint_as_float(y0[q][j].x & 0xffff0000u) + __uint_as_float(y1[q][j].x & 0xffff0000u);
                y.z = __uint_as_float(y0[q][j].y << 16) + __uint_as_float(y1[q][j].y << 16); y.w = __uint_as_float(y0[q][j].y & 0xffff0000u) + __uint_as_float(y1[q][j].y & 0xffff0000u);
                v[q][j] = ALPHA * xv[q][j] + m5[j] * y; s[q] += (v[q][j].x + v[q][j].y) + (v[q][j].z + v[q][j].w); }
#pragma unroll
        for (int o = 1; o < 64; o <<= 1) { s[0] += __shfl_xor(s[0], o); s[1] += __shfl_xor(s[1], o); }
        float s2[2] = {0.f, 0.f};
#pragma unroll
        for (int q = 0; q < 2; ++q) { const float mean = s[q] * (1.f / DM);
#pragma unroll
            for (int j = 0; j < 4; ++j) { v[q][j] = v[q][j] - mean; s2[q] += (v[q][j].x * v[q][j].x + v[q][j].y * v[q][j].y) + (v[q][j].z * v[q][j].z + v[q][j].w * v[q][j].w); } }
#pragma unroll
        for (int o = 1; o < 64; o <<= 1) { s2[0] += __shfl_xor(s2[0], o); s2[1] += __shfl_xor(s2[1], o); }
        const float* mn = F.modv() + ((size_t)((l + 1 < DEPTH) ? l + 1 : l) * 5 + rb) * 6144;
#pragma unroll
        for (int j = 0; j < 4; ++j) { const int d = j * 256 + F.lane * 4;
            const f32x4 g4 = *(const f32x4*)(lg + d), b4 = *(const f32x4*)(lbb + d), m0 = *(const f32x4*)(mn + d), m1 = *(const f32x4*)(mn + 1024 + d);
#pragma unroll
            for (int q = 0; q < 2; ++q) { const float rstd = rsqrtf(s2[q] * (1.f / DM) + LN_EPS);
                f32x4 xn = v[q][j] * rstd * g4 + b4;
                if (tmo_set) xn = xn * __uint_as_float(0x7fc00000u);
                *(f32x4*)(xo + (size_t)q * DM + d) = xn;
                if (l + 1 < DEPTH) { const f32x4 h = xn * (1.f + m1) + m0; u32x2 o2; o2.x = pk2(h.x, h.y); o2.y = pk2(h.z, h.w); *(u32x2*)(F.HX() + (size_t)(row0 + q) * DM + d) = o2; } }
        }
    }
}

constexpr int NPL = 12, NPH = 1 + DEPTH * NPL;
__global__ void __launch_bounds__(NTHR, 2) mega(Params p) {
    extern __shared__ __attribute__((aligned(16))) unsigned char smem[];
    Frame F; F.p = p; F.bid = blockIdx.x; F.nb = gridDim.x; F.tid = threadIdx.x; F.lane = threadIdx.x & 63; F.wave = threadIdx.x >> 6; F.wid_s = __builtin_amdgcn_readfirstlane(threadIdx.x >> 6);
    F.smf = (float*)(smem + LDS_STAGE);
    LAS unsigned char* stage = (LAS unsigned char*)smem + LDS_STAGE; int* offt = (int*)(smem + 64);
    unsigned char* ws = p.ws; F.ws = ws;

    if (threadIdx.x == 0) *(uint4*)smem = make_uint4(0u, 0u, 0u, 0u);
    __syncthreads();
    unsigned* barw = (unsigned*)(ws + WS_CTL);
    XcdBarrier bar; bar.bar = barw; bar.x = 0; bar.st = (volatile LAS unsigned*)smem;
    const bool multi = (p.ph_hi - p.ph_lo) > 1;
    if (multi) bar = xcd_barrier_post(barw, (volatile LAS unsigned*)smem);
    const int lo = p.ph_lo, hi = p.ph_hi;
#define IN(k) (lo <= (k) && (k) < hi)
#define SEAM(k) do { if (IN(k) && IN((k) + 1)) xcd_barrier(bar); else __syncthreads(); } while (0)

    if (IN(0)) { REFRESH(F); phase_mod(F); __syncthreads(); phase_conv_a(F, 0); }
    SEAM(0);
#pragma unroll 1
    for (int l = 0; l < DEPTH; ++l) {
        const int pb = 1 + l * NPL;
        const float* xlat = (l == 0) ? p.x : p.out; const float* xctx = (l == 0) ? p.ctx : F.cxo();
        const int Mrows = (l == 0) ? NROW : NTOK;
        if (IN(pb + 0)) { REFRESH(F); if (l == 0) phase_prep(F, 0, p.x, p.ctx); else phase_conv_a(F, l); }
        SEAM(pb + 0);
        if (IN(pb + 1)) { REFRESH(F);
            float* rtab = (float*)(smem + LDS_ROPE);
            for (int e = F.tid; e < 1024; e += NTHR) { const int pp = e >> 4, i = e & 15; const float inv = powf(10000.f, -(float)i / 16.f), ang = (float)pp * inv; rtab[2 * e] = cosf(ang); rtab[2 * e + 1] = sinf(ang); }
            __syncthreads();
            pg::SchedG1 S{(const char*)F.HX(), (const char*)F.W1t(), (const char*)F.Wvt(), F.nb, F.bid}; pg::EpiG1 E{F.P1(), F.VT(), rtab, F.lb(), l};
            pg::gemm_phase(stage, DM, DM, DM, S, E);
        }
        SEAM(pb + 1);
        if (IN(pb + 2)) { REFRESH(F); phase_mix(F, l); }
        SEAM(pb + 2);
        if (IN(pb + 3)) { REFRESH(F); phase_prepad(F, l); }
        SEAM(pb + 3);
        if (IN(pb + 4)) { REFRESH(F);
            pg::SchedStatic S{(const char*)F.HX(), (const char*)F.Wgt(), (size_t)256 * DM * 2, (size_t)256 * DM * 2, Mrows / 256, NGATE / 256, F.nb, F.bid}; pg::EpiGate E{F.G()};
            pg::gemm_phase(stage, DM, DM, DM, S, E);
            __syncthreads();
            phase_conv_b(F, l);
        }
        SEAM(pb + 4);
        if (IN(pb + 5)) { REFRESH(F);
            pg::SchedMerge S{(const char*)F.BR(), (const char*)F.Wbrt(), (Mrows / 256) * 4, F.nb, F.bid}; pg::EpiMerge E{F.G(), F.HX()};
            pg::gemm_phase(stage, 2048, 512, 512, S, E);
        }
        SEAM(pb + 5);
        if (IN(pb + 6)) { REFRESH(F);
            pg::SchedStatic S{(const char*)F.HX(), (const char*)F.Woutt(), (size_t)256 * DM * 2, (size_t)256 * DM * 2, Mrows / 256, DM / 256, F.nb, F.bid};
            pg::EpiWout E{xlat, xctx, p.out, F.cxm(), F.modv() + (size_t)l * 5 * 6144};
            pg::gemm_phase(stage, DM, DM, DM, S, E);
        }
        SEAM(pb + 6);
        if (IN(pb + 7)) { REFRESH(F); phase_ln1(F, l); }
        SEAM(pb + 7);
        if (IN(pb + 8)) { REFRESH(F); phase_gather(F, l); }
        SEAM(pb + 8);
        if (IN(pb + 9)) { REFRESH(F);
            moe_offsets(F, l, offt);
            pg::SchedMoe S{(const char*)F.XS(), (const char*)F.Wgu(), offt, (size_t)256 * DM * 2, (size_t)512 * DM * 2, (size_t)256 * DM * 2, offt[32] / 256, 2, F.nb, F.bid};
            pg::EpiMoe1 E{F.HID(), F.roww()};
            pg::gemm_phase(stage, DM, DM, DM, S, E);
        }
        SEAM(pb + 9);
        if (IN(pb + 10)) { REFRESH(F);
            moe_offsets(F, l, offt);
            pg::SchedMoe S{(const char*)F.HID(), (const char*)F.Wd(), offt, (size_t)256 * 256 * 2, (size_t)DM * 256 * 2, (size_t)256 * 256 * 2, offt[32] / 256, 4, F.nb, F.bid};
            pg::EpiMoe2 E{F.BR(), F.rmap(), (bf16_t*)(F.ws + WS_DUMP)};
            pg::gemm_phase(stage, 256, 256, 256, S, E);
        }
        SEAM(pb + 10);
        if (IN(pb + 11)) { REFRESH(F); phase_ln2(F, l); }
        SEAM(pb + 11);
    }
#undef IN
#undef SEAM
}

extern "C" void kernel_launch(void* const* d_in, const int* in_sizes, int n_in, void* d_out, int out_size, void* d_ws, size_t ws_size, hipStream_t stream) {
    static int grid = 0;
    if (grid == 0) {
        if (n_in != 23 || out_size != NTOK * DM || ws_size < WS_END) { fprintf(stderr, "kernel_launch: unexpected shapes (n_in %d out %d ws %zu need %zu)\n", n_in, out_size, ws_size, (size_t)WS_END); grid = -1; return; }
        int dev = 0, cus = 0;
        if (hipGetDevice(&dev) != hipSuccess || hipDeviceGetAttribute(&cus, hipDeviceAttributeMultiprocessorCount, dev) != hipSuccess) { grid = -1; return; }
        if (hipFuncSetAttribute((const void*)mega, hipFuncAttributeMaxDynamicSharedMemorySize, LDS_BYTES) != hipSuccess) { fprintf(stderr, "kernel_launch: hipFuncSetAttribute failed\n"); grid = -1; return; }
        int per_cu = 0;
        if (hipOccupancyMaxActiveBlocksPerMultiprocessor(&per_cu, (const void*)mega, NTHR, LDS_BYTES) != hipSuccess || per_cu < 1) fprintf(stderr, "kernel_launch: occupancy query reports %d blocks per CU\n", per_cu);
        (void)hipGetLastError();
        grid = cus;
    }
    if (grid < 0) return;
    (void)hipMemsetAsync((char*)d_ws + WS_CTL, 0, CTL_BYTES, stream);
    Params p; memset(&p, 0, sizeof(p));
    const float** pp = (const float**)&p;
    for (int i = 0; i < 23; ++i) pp[i] = (const float*)d_in[i];
    p.out = (float*)d_out; p.ws = (unsigned char*)d_ws;
    p.ph_lo = 0; p.ph_hi = NPH;
    hipLaunchKernelGGL(mega, dim3(grid), dim3(NTHR), LDS_BYTES, stream, p);
}
```

```cpp
#include <hip/hip_runtime.h>
#include <cstdio>
#include <cstdint>
#include <cstring>

typedef unsigned short bf16_t;
typedef float f32x4 __attribute__((ext_vector_type(4)));
typedef unsigned u32x4 __attribute__((ext_vector_type(4)));
typedef unsigned u32x2 __attribute__((ext_vector_type(2)));

constexpr int NB = 4, SEQ = 4096, LC = 256, DM = 1024, DEPTH = 2;
constexpr int NTOK = NB * SEQ, NCTX = NB * LC, NROW = NTOK + NCTX;
constexpr int DIN = 10528;
constexpr int O_AQ = 0, O_AK = 256, O_AV = 512, O_AG = 1024, O_ALR = 1536, O_BQ = 1568, O_BK = 2080, O_BV = 2592, O_CQ = 3104, O_CK = 3616,
              O_CV = 3744, O_DQ = 3872, O_DF = 4384, O_DI = 5408, O_DG = 5920, O_GATE = 6432;
constexpr int PC_AQ = 0, PC_AK = 256, PC_AV = 512, PC_BQ = 1024, PC_BK = 1536, PC_CQ = 2048, PC_CK = 2560, PC_ALR = 2688, PC_DQ = 2816,
              PC_DF = 3328, PC_DI = 4352, PC_AG = 4864, PC_DG = 5376, NP1 = 5888;
constexpr float QSCALE = 0.125f * 1.44269504089f;
constexpr int NVT = 768;
constexpr int NGATE = 4096;
constexpr int XS_ROWS = 43008;
constexpr float LN_EPS = 1e-5f;
constexpr float ALPHA = 1.41421356237f;

constexpr size_t al256(size_t x) { return (x + 255) & ~(size_t)255; }
constexpr size_t WS_CTL = 0;
constexpr size_t CTL_BYTES = 32768;
constexpr size_t CTL_CNT = 28672;
constexpr size_t WS_DUMP = WS_CTL + CTL_BYTES;
constexpr size_t WS_MODV = WS_DUMP + 4096;
constexpr size_t WS_LB = WS_MODV + al256((size_t)DEPTH * 5 * 6144 * 4);
constexpr size_t WS_TOKE = WS_LB + 4096;
constexpr size_t WS_TOKI = WS_TOKE + al256((size_t)2 * NROW * 4);
constexpr size_t WS_TOKW = WS_TOKI + al256((size_t)2 * NROW * 4);
constexpr size_t WS_RMAP = WS_TOKW + al256((size_t)2 * NROW * 4);
constexpr size_t WS_ROWW = WS_RMAP + al256((size_t)XS_ROWS * 4);
constexpr size_t WS_CXM = WS_ROWW + al256((size_t)XS_ROWS * 4);
constexpr size_t WS_CXO = WS_CXM + (size_t)NCTX * DM * 4;
constexpr size_t WS_WTA = WS_CXO + (size_t)NCTX * DM * 4;
constexpr size_t WTA_W1 = 0;
constexpr size_t WTA_WV = WTA_W1 + (size_t)NP1 * DM * 2;
constexpr size_t WTA_WBR = WTA_WV + (size_t)NVT * DM * 2;
constexpr size_t WTA_WO = WTA_WBR + (size_t)4 * DM * 512 * 2;
constexpr size_t WTA_WG = WTA_WO + (size_t)DM * DM * 2;
constexpr size_t WTA_BYTES = WTA_WG + (size_t)NGATE * DM * 2;
constexpr size_t WS_SC1 = WS_WTA;
static_assert((size_t)NROW * 512 * 2 <= WTA_WG, "scan scratch must fit in front of the gate weights");
constexpr size_t WS_HX = WS_WTA + WTA_BYTES;
constexpr size_t WS_VT = WS_HX + (size_t)NROW * DM * 2;
constexpr size_t WS_OBA = WS_VT + (size_t)NVT * NROW * 2;
constexpr size_t WS_HX2 = WS_VT;
constexpr size_t WS_HID = WS_VT;
constexpr size_t WS_ODH = WS_OBA + (size_t)NROW * 512 * 2;
constexpr size_t WS_BR = WS_ODH + (size_t)NROW * 1024 * 2;
constexpr size_t WS_P1 = WS_BR + (size_t)NROW * 2048 * 2;
constexpr size_t WS_G = WS_P1;
constexpr size_t WS_WGU = WS_P1 + (size_t)NROW * NGATE * 2;
constexpr size_t WS_WD = WS_WGU + (size_t)32 * 512 * DM * 2;
constexpr size_t WS_XS = WS_P1;
constexpr size_t WS_ESC = WS_P1 + (size_t)NROW * NP1 * 2;
constexpr size_t WS_END = WS_ESC + (size_t)32 * 68 * 384 * 4;
static_assert(WS_WD + (size_t)32 * DM * 256 * 2 <= WS_ESC, "moe weights must fit in the P1 tail");
static_assert((size_t)XS_ROWS * DM * 2 <= (size_t)NROW * NGATE * 2, "XS must fit in the G region");
static_assert((size_t)NVT * NROW * 2 + (size_t)NROW * 512 * 2 >= (size_t)NROW * DM * 2, "HX2 alias");
static_assert(WS_END <= 434800000ull, "workspace budget");

constexpr int NTHR = 512;
constexpr int LDS_STAGE = 1024;
constexpr int LDS_ROPE = 1024 + 131072 + 1024;
constexpr int LDS_BYTES = 144 * 1024;

struct Params {
    const float *x, *c, *ctx, *c_ctx, *w_mod, *b_mod, *w_in, *gla_lr_w, *gla_lr_b, *hg_gamma, *na_rpb, *wa_sink, *w_branch, *w_out, *ln_g, *ln_b,
        *moe_w_group, *moe_b_group, *moe_w_expert, *moe_b_expert, *moe_w_gate, *moe_w_up, *moe_w_down;
    float* out;
    unsigned char* ws;
    int ph_lo, ph_hi;
};

__device__ __forceinline__ float bf2f(bf16_t b) { return __uint_as_float(((unsigned)b) << 16); }
__device__ __forceinline__ bf16_t f2bf(float f) { unsigned u = __float_as_uint(f); u += 0x7FFFu + ((u >> 16) & 1u); return (bf16_t)(u >> 16); }
typedef float f32x2_t __attribute__((ext_vector_type(2)));
typedef __bf16 bf16x2_t __attribute__((ext_vector_type(2)));
__device__ __forceinline__ unsigned pk2(float lo, float hi) {
    const f32x2_t v = {lo, hi}; const bf16x2_t b = __builtin_convertvector(v, bf16x2_t); return __builtin_bit_cast(unsigned, b); }
__device__ __forceinline__ void ld8(const bf16_t* p, float* f) {
    const u32x4 v = *(const u32x4*)p;
    f[0] = __uint_as_float(v.x << 16); f[1] = __uint_as_float(v.x & 0xffff0000u);
    f[2] = __uint_as_float(v.y << 16); f[3] = __uint_as_float(v.y & 0xffff0000u);
    f[4] = __uint_as_float(v.z << 16); f[5] = __uint_as_float(v.z & 0xffff0000u);
    f[6] = __uint_as_float(v.w << 16); f[7] = __uint_as_float(v.w & 0xffff0000u);
}
__device__ __forceinline__ void st8(bf16_t* p, const float* f) {
    u32x4 v; v.x = pk2(f[0], f[1]); v.y = pk2(f[2], f[3]); v.z = pk2(f[4], f[5]); v.w = pk2(f[6], f[7]);
    *(u32x4*)p = v;
}
__device__ __forceinline__ float sigmoidf_(float x) { return __builtin_amdgcn_rcpf(1.f + __expf(-x)); }
__device__ __forceinline__ float siluf_(float x) { return x * __builtin_amdgcn_rcpf(1.f + __expf(-x)); }
__device__ __forceinline__ float wave_sum(float v) {
#pragma unroll
    for (int o = 1; o < 64; o <<= 1) v += __shfl_xor(v, o);
    return v;
}
__device__ __forceinline__ int row_batch(int row) { return row < NTOK ? (row >> 12) : 4; }

#define XB_TMO      128
#define XB_XCNT(j)  (256  + 64 * (j))
#define XB_XSUB(j)  (1280 + 64 * (j))
#define XB_XGEN(j)  (2304 + 64 * (j))
#define XB_TOP      3328
#define XB_TOPGEN   3392
#define XCD_BAR_WORDS 3456
#define XB_SPIN_CAP (1u << 18)
#define LAS __attribute__((address_space(3)))
__device__ __forceinline__ unsigned xb_ld(unsigned* p)              { return __hip_atomic_load(p, __ATOMIC_RELAXED, __HIP_MEMORY_SCOPE_AGENT); }
__device__ __forceinline__ unsigned xb_add(unsigned* p, unsigned v) { return __hip_atomic_fetch_add(p, v, __ATOMIC_RELAXED, __HIP_MEMORY_SCOPE_AGENT); }
__device__ __forceinline__ unsigned xb_xcc_id() { return (unsigned)__builtin_amdgcn_s_getreg((3 << 11) | 20) & 0xFu; }
#define XB_SPIN(cond, bar) do { unsigned _sp = 0; while (cond) { __builtin_amdgcn_s_sleep(1); \
    if ((++_sp & 255u) == 0u) { if (xb_ld(&(bar)[XB_TMO])) break; if (_sp > XB_SPIN_CAP) { atomicAdd(&(bar)[XB_TMO], 1u); break; } } } } while (0)
struct XcdBarrier { unsigned* bar; unsigned x; volatile LAS unsigned* st; };
__device__ __forceinline__ XcdBarrier xcd_barrier_post(unsigned* bar, volatile LAS unsigned* st) {
    XcdBarrier b; b.bar = bar; b.x = xb_xcc_id(); b.st = st;
    if (threadIdx.x == 0) (void)xb_add(&bar[XB_XCNT(b.x)], 1u);
    return b;
}
__device__ __forceinline__ void xcd_barrier_complete(unsigned* bar, unsigned x, unsigned& nloc, unsigned& nx) {
    const unsigned G = gridDim.x * gridDim.y * gridDim.z;
    unsigned sum, cnt, mine, sp = 0u;
    for (;;) {
        sum = 0u; cnt = 0u; mine = 0u;
#pragma unroll
        for (unsigned j = 0; j < 16; ++j) { const unsigned c = xb_ld(&bar[XB_XCNT(j)]); sum += c; cnt += (c > 0u) ? 1u : 0u; mine = (j == x) ? c : mine; }
        if (sum == G) break;
        __builtin_amdgcn_s_sleep(1);
        if ((++sp & 255u) == 0u) { if (xb_ld(&bar[XB_TMO])) break; if (sp > XB_SPIN_CAP) { atomicAdd(&bar[XB_TMO], 1u); break; } }
    }
    nloc = mine > 0u ? mine : 1u; nx = cnt > 0u ? cnt : 1u;
}
__device__ __forceinline__ void xcd_barrier(const XcdBarrier& b) {
    asm volatile("s_waitcnt vmcnt(0)" ::: "memory");
    __syncthreads();
    if (threadIdx.x == 0) {
        unsigned* bar = b.bar;
        __builtin_amdgcn_s_waitcnt(0);
        unsigned nloc = b.st[0], nx = b.st[1];
        if (nloc == 0u) { xcd_barrier_complete(bar, b.x, nloc, nx); b.st[0] = nloc; b.st[1] = nx; }
        const unsigned old = xb_add(&bar[XB_XSUB(b.x)], 1u);
        const unsigned gen = old / nloc;
        if (old + 1u == (gen + 1u) * nloc) {
            __builtin_amdgcn_fence(__ATOMIC_RELEASE, "agent");
            asm volatile("s_waitcnt vmcnt(0)" ::: "memory");
            const unsigned og = xb_add(&bar[XB_TOP], 1u);
            const unsigned tg = og / nx;
            if (og + 1u == (tg + 1u) * nx) xb_add(&bar[XB_TOPGEN], 1u);
            else XB_SPIN(xb_ld(&bar[XB_TOPGEN]) == tg, bar);
            __builtin_amdgcn_fence(__ATOMIC_ACQUIRE, "agent");
            xb_add(&bar[XB_XGEN(b.x)], 1u);
            asm volatile("s_waitcnt vmcnt(0)" ::: "memory");
        } else {
            XB_SPIN(xb_ld(&bar[XB_XGEN(b.x)]) == gen, bar);
            __builtin_amdgcn_fence(__ATOMIC_ACQUIRE, "agent");
            asm volatile("s_waitcnt vmcnt(0)" ::: "memory");
        }
    }
    __syncthreads();
}

struct Frame {
    Params p;
    int bid, nb, tid, lane, wave, wid_s;
    float* smf;
    unsigned char* ws;
    __device__ __forceinline__ float* modv() const { return (float*)(ws + WS_MODV); }
    __device__ __forceinline__ float* lb() const { return (float*)(ws + WS_LB); }
    __device__ __forceinline__ int* tokE() const { return (int*)(ws + WS_TOKE); }
    __device__ __forceinline__ int* tokI() const { return (int*)(ws + WS_TOKI); }
    __device__ __forceinline__ float* tokW() const { return (float*)(ws + WS_TOKW); }
    __device__ __forceinline__ int* rmap() const { return (int*)(ws + WS_RMAP); }
    __device__ __forceinline__ float* roww() const { return (float*)(ws + WS_ROWW); }
    __device__ __forceinline__ float* cxm() const { return (float*)(ws + WS_CXM); }
    __device__ __forceinline__ float* cxo() const { return (float*)(ws + WS_CXO); }
    __device__ __forceinline__ bf16_t* W1t() const { return (bf16_t*)(ws + WS_WTA + WTA_W1); }
    __device__ __forceinline__ bf16_t* Wvt() const { return (bf16_t*)(ws + WS_WTA + WTA_WV); }
    __device__ __forceinline__ bf16_t* Wgt() const { return (bf16_t*)(ws + WS_WTA + WTA_WG); }
    __device__ __forceinline__ bf16_t* Wbrt() const { return (bf16_t*)(ws + WS_WTA + WTA_WBR); }
    __device__ __forceinline__ bf16_t* Woutt() const { return (bf16_t*)(ws + WS_WTA + WTA_WO); }
    __device__ __forceinline__ bf16_t* SC1() const { return (bf16_t*)(ws + WS_SC1); }
    __device__ __forceinline__ float* ESC() const { return (float*)(ws + WS_ESC); }
    __device__ __forceinline__ bf16_t* HX() const { return (bf16_t*)(ws + WS_HX); }
    __device__ __forceinline__ bf16_t* VT() const { return (bf16_t*)(ws + WS_VT); }
    __device__ __forceinline__ bf16_t* OBA() const { return (bf16_t*)(ws + WS_OBA); }
    __device__ __forceinline__ bf16_t* HX2() const { return (bf16_t*)(ws + WS_HX2); }
    __device__ __forceinline__ bf16_t* HID() const { return (bf16_t*)(ws + WS_HID); }
    __device__ __forceinline__ bf16_t* ODH() const { return (bf16_t*)(ws + WS_ODH); }
    __device__ __forceinline__ bf16_t* BR() const { return (bf16_t*)(ws + WS_BR); }
    __device__ __forceinline__ bf16_t* P1() const { return (bf16_t*)(ws + WS_P1); }
    __device__ __forceinline__ bf16_t* G() const { return (bf16_t*)(ws + WS_G); }
    __device__ __forceinline__ bf16_t* Wgu() const { return (bf16_t*)(ws + WS_WGU); }
    __device__ __forceinline__ bf16_t* Wd() const { return (bf16_t*)(ws + WS_WD); }
    __device__ __forceinline__ bf16_t* XS() const { return (bf16_t*)(ws + WS_XS); }
    __device__ __forceinline__ unsigned* cnt() const { return (unsigned*)(ws + WS_CTL + CTL_CNT); }
};


#define REFRESH(F) do { int _t = threadIdx.x; asm volatile("" : "+v"(_t)); (F).tid = _t; (F).lane = _t & 63; (F).wave = _t >> 6; } while (0)

__device__ __forceinline__ void phase_mod(Frame& F) {
    float* sc = F.smf;
    float* red = F.smf + 5 * 1024;
    bool have = false;
    for (int it = F.bid; it < DEPTH * 96; it += F.nb) {
        if (!have) {
            for (int i = F.tid; i < 5 * 1024; i += NTHR) { const float v = (i < 4096) ? F.p.c[i] : F.p.c_ctx[i - 4096]; sc[i] = siluf_(v); }
            __syncthreads(); have = true;
        }
        const int l = it / 96, n0 = (it % 96) * 64, col = F.tid & 63, kg = F.tid >> 6;
        const float* w = F.p.w_mod + (size_t)l * DM * 6144 + n0 + col;
        float a[5] = {0.f, 0.f, 0.f, 0.f, 0.f};
        for (int k = kg * 128; k < kg * 128 + 128; ++k) {
            const float wv = w[(size_t)k * 6144];
#pragma unroll
            for (int r = 0; r < 5; ++r) a[r] += sc[r * 1024 + k] * wv;
        }
#pragma unroll
        for (int r = 0; r < 5; ++r) red[(kg * 5 + r) * 64 + col] = a[r];
        __syncthreads();
        if (F.tid < 320) {
            const int r = F.tid >> 6, cc = F.tid & 63; float s = F.p.b_mod[l * 6144 + n0 + cc];
#pragma unroll
            for (int g = 0; g < 8; ++g) s += red[(g * 5 + r) * 64 + cc];
            F.modv()[((size_t)l * 5 + r) * 6144 + n0 + cc] = s;
        }
        __syncthreads();
    }
    if (F.bid == F.nb - 1) {
        for (int i = F.tid; i < 1024; i += NTHR) { const int z = i >> 9, f = i & 511;
            const float g0 = F.p.hg_gamma[(z * DEPTH + 0) * 512 + f], g1 = F.p.hg_gamma[(z * DEPTH + 1) * 512 + f];
            F.lb()[i] = 1.f / (1.f + expf(g0 - g1)); }
    }
}

__device__ __forceinline__ int p1_src(int n, float& scale) {
    scale = 1.f;
    if (n < 256) { scale = 0.125f; return O_AQ + n; }
    if (n < 512) return O_AK + (n - 256);
    if (n < 1024) return O_AV + (n - 512);
    if (n < 1536) { scale = QSCALE; return O_BQ + (n - 1024); }
    if (n < 2048) return O_BK + (n - 1536);
    if (n < 2560) { scale = QSCALE; return O_CQ + (n - 2048); }
    if (n < 2688) return O_CK + (n - 2560);
    if (n < 2720) return O_ALR + (n - 2688);
    if (n < 2816) return -1;
    if (n < 3328) return O_DQ + (n - 2816);
    if (n < 4352) return O_DF + (n - 3328);
    if (n < 4864) return O_DI + (n - 4352);
    if (n < 5376) return O_AG + (n - 4864);
    return O_DG + (n - 5376);
}
__device__ __forceinline__ void conv_item(const float* src, int ldsrc, int srccol, float scale, bf16_t* dst, int K, int k0, float* scr, int lane, bool perm) {
    if (srccol >= 0) {
#pragma unroll 8
        for (int i = 0; i < 32; ++i) { const int kk = 2 * i + (lane >> 5); scr[kk * 33 + (lane & 31)] = src[(size_t)(k0 + kk) * ldsrc + srccol + (lane & 31)] * scale; }
    } else {
#pragma unroll 8
        for (int i = 0; i < 32; ++i) { const int kk = 2 * i + (lane >> 5); scr[kk * 33 + (lane & 31)] = 0.f; }
    }
    asm volatile("s_waitcnt lgkmcnt(0)" ::: "memory");
    const int c = lane & 7;
#pragma unroll
    for (int j = 0; j < 4; ++j) { const int nn = (lane >> 3) + 8 * j; const float* sp = scr + (8 * c) * 33 + (perm ? (8 * ((nn & 15) >> 2) + 4 * (nn >> 4) + (nn & 3)) : nn);
        u32x4 o; o.x = pk2(sp[0 * 33], sp[1 * 33]); o.y = pk2(sp[2 * 33], sp[3 * 33]); o.z = pk2(sp[4 * 33], sp[5 * 33]); o.w = pk2(sp[6 * 33], sp[7 * 33]);
        *(u32x4*)(dst + (size_t)nn * K + 8 * c) = o; }
    asm volatile("s_waitcnt lgkmcnt(0)" ::: "memory");
}
constexpr int CONVA_W1 = (NP1 / 32) * 16;
constexpr int CONVA_ITEMS = CONVA_W1 + 384 + 2048;
__device__ __forceinline__ void phase_conv_a(Frame& F, int l) {
    float* scr = F.smf + F.wave * (64 * 33);
    const int gw = F.bid * 8 + F.wave, ngw = F.nb * 8;
    for (int it0 = gw; it0 < CONVA_ITEMS; it0 += ngw) {
        int ti = it0;
        if (ti < CONVA_W1) { const int n0 = (ti >> 4) * 32, kt = ti & 15; float sc; const int sx = p1_src(n0, sc);
            conv_item(F.p.w_in + (size_t)l * DM * DIN, DIN, sx, sc, F.W1t() + (size_t)n0 * DM + kt * 64, DM, kt * 64, scr, F.lane, !(n0 >= 2048 && n0 < 2816)); continue; }
        ti -= CONVA_W1;
        if (ti < 384) { const int n0 = (ti >> 4) * 32, kt = ti & 15; const int sx = n0 < 512 ? O_BV + n0 : (n0 < 640 ? O_CV + (n0 - 512) : -1);
            conv_item(F.p.w_in + (size_t)l * DM * DIN, DIN, sx, 1.f, F.Wvt() + (size_t)n0 * DM + kt * 64, DM, kt * 64, scr, F.lane, false); continue; }
        ti -= 384;
        { const int n0 = (ti >> 4) * 32, kt = ti & 15;
          conv_item(F.p.w_in + (size_t)l * DM * DIN, DIN, O_GATE + n0, 1.f, F.Wgt() + (size_t)n0 * DM + kt * 64, DM, kt * 64, scr, F.lane, true); }
    }
}
constexpr int CONVB_ITEMS = 8192 + 4096 + 1024 + 512;
__device__ __forceinline__ void phase_conv_b(Frame& F, int l) {
    float* scr = F.smf + F.wave * (64 * 33);
    const int gw = F.bid * 8 + F.wave, ngw = F.nb * 8;
    for (int it0 = gw; it0 < CONVB_ITEMS; it0 += ngw) {
        int ti = it0;
        if (ti < 8192) { const int e = ti >> 8, r = ti & 255, n0 = (r >> 4) * 32, kt = r & 15, j = n0 >> 8, rr = n0 & 255; const bool isup = rr >= 128; const int cc = 128 * j + (rr & 127);
            const float* src = (isup ? F.p.moe_w_up : F.p.moe_w_gate) + (size_t)(l * 32 + e) * DM * 256;
            conv_item(src, 256, cc, 1.f, F.Wgu() + (size_t)e * 512 * DM + (size_t)n0 * DM + kt * 64, DM, kt * 64, scr, F.lane, true); continue; }
        ti -= 8192;
        if (ti < 4096) { const int e = ti >> 7, r = ti & 127, n0 = (r >> 2) * 32, kt = r & 3;
          conv_item(F.p.moe_w_down + (size_t)(l * 32 + e) * 256 * DM, DM, n0, 1.f, F.Wd() + (size_t)e * DM * 256 + (size_t)n0 * 256 + kt * 64, 256, kt * 64, scr, F.lane, true); continue; }
        ti -= 4096;
        if (ti < 1024) { const int i = ti >> 8, r = ti & 255, n0 = (r >> 3) * 32, kt = r & 7;
            conv_item(F.p.w_branch + (size_t)(l * 4 + i) * 512 * DM, DM, n0, 1.f, F.Wbrt() + (size_t)i * DM * 512 + (size_t)n0 * 512 + kt * 64, 512, kt * 64, scr, F.lane, true); continue; }
        ti -= 1024;
        { const int n0 = (ti >> 4) * 32, kt = ti & 15;
          conv_item(F.p.w_out + (size_t)l * DM * DM, DM, n0, 1.f, F.Woutt() + (size_t)n0 * DM + kt * 64, DM, kt * 64, scr, F.lane, false); }
    }
}

__device__ __forceinline__ void phase_prep(Frame& F, int l, const float* xlat, const float* xctx) {
    const int gw = F.bid * 8 + F.wave, ngw = F.nb * 8;
    for (int row = gw; row < NROW; row += ngw) {
        const float* xr = row < NTOK ? xlat + (size_t)row * DM : xctx + (size_t)(row - NTOK) * DM;
        const float* mv = F.modv() + ((size_t)l * 5 + row_batch(row)) * 6144;
#pragma unroll
        for (int j = 0; j < 4; ++j) { const int d = j * 256 + F.lane * 4;
            const f32x4 v = *(const f32x4*)(xr + d), m0 = *(const f32x4*)(mv + d), m1 = *(const f32x4*)(mv + 1024 + d);
            u32x2 o; o.x = pk2(v.x * (1.f + m1.x) + m0.x, v.y * (1.f + m1.y) + m0.y); o.y = pk2(v.z * (1.f + m1.z) + m0.z, v.w * (1.f + m1.w) + m0.w);
            *(u32x2*)(F.HX() + (size_t)row * DM + d) = o; }
    }
}


namespace pg {
typedef short bf16x8 __attribute__((ext_vector_type(8)));
constexpr int BM = 256, BK = 64, HALF = 128, HTB = HALF * BK * 2, STAGE_BYTES = 8 * HTB, NXCD = 8, WGM = 8;
__device__ __forceinline__ int lds_byte(int r, int c) { const int st = (r >> 4) * 2 + (c >> 5), rr = r & 15, cc = c & 31, ob = rr * 64 + cc * 2; return st * 1024 + (ob ^ (((ob >> 9) & 1) << 5)); }
__device__ __forceinline__ void stage_rc(int b, int& R, int& C) { const int st = b / 1024, sb = b % 1024, swz = sb ^ (((sb >> 9) & 1) << 5); R = (st >> 1) * 16 + swz / 64; C = (st & 1) * 32 + (swz % 64) / 2; }
struct Unit { const char* a; const char* b; int pm, pn, aux; };
__device__ __forceinline__ void static_map(int L, int nM, int nN, int& pm, int& pn) {
    const int nwg = nM * nN; int wgid = L; { const int q = nwg / NXCD, r = nwg % NXCD, xcd = wgid % NXCD, off = wgid / NXCD; wgid = (xcd < r ? xcd * (q + 1) : r * (q + 1) + (xcd - r) * q) + off; }
    const int nig = WGM * nN, gid = wgid / nig, fm = gid * WGM, gsz = (nM - fm) < WGM ? (nM - fm) : WGM;
    pm = fm + ((wgid % nig) % gsz); pn = (wgid % nig) / gsz;
}
template <class Epi, class Sched>
__device__ __forceinline__ void gemm_phase(LAS unsigned char* lds, const int lda, const int ldb, const int K, const Sched& S, const Epi& E) {
    int tid = threadIdx.x; asm volatile("" : "+v"(tid));
    const int wid = __builtin_amdgcn_readfirstlane(tid >> 6), lane = tid & 63, wr = wid >> 2, wc = wid & 3, fr = lane & 15, fq = lane >> 4;
    int nt = K / BK; asm volatile("" : "+s"(nt));
    unsigned voffA[2], voffB[2];
#pragma unroll
    for (int i = 0; i < 2; ++i) { int R, C; stage_rc(tid * 16 + i * 8192, R, C); voffA[i] = (unsigned)(R * lda + C) * 2u; voffB[i] = (unsigned)(R * ldb + C) * 2u; }
    const size_t kstep = (size_t)(BK * 2);
    const size_t hstepA = (size_t)HALF * lda * 2, hstepB = (size_t)HALF * ldb * 2;
    const unsigned ldsw = (unsigned)wid * 1024u;
    const int aoff = lds_byte(wr * 64 + fr, fq * 8), boff = lds_byte(wc * 32 + fr, fq * 8);
#define PG_SA(b, h) (((b) * 2 + (h)) * HTB)
#define PG_SB(b, h) ((4 + (b) * 2 + (h)) * HTB)
#define PG_STAGE(bufoff, gbase, voff) do { _Pragma("unroll") for (int _i = 0; _i < 2; ++_i) \
        __builtin_amdgcn_global_load_lds((const unsigned*)((const char*)(gbase) + (voff)[_i]), (LAS unsigned*)(lds + (bufoff) + ldsw + _i * 8192), 16, 0, 0); } while (0)
#define PG_LDA(dst, b, h) do { _Pragma("unroll") for (int m = 0; m < 4; ++m) _Pragma("unroll") for (int k = 0; k < 2; ++k) dst[m][k] = *(const LAS bf16x8*)(lds + PG_SA(b, h) + aoff + m * 2048 + k * 1024); } while (0)
#define PG_LDB(dst, b, h) do { _Pragma("unroll") for (int n = 0; n < 2; ++n) _Pragma("unroll") for (int k = 0; k < 2; ++k) dst[n][k] = *(const LAS bf16x8*)(lds + PG_SB(b, h) + boff + n * 2048 + k * 1024); } while (0)
#define PG_MMA(ai, bj, At, Bt) do { __builtin_amdgcn_s_setprio(1); _Pragma("unroll") for (int m = 0; m < 4; ++m) _Pragma("unroll") for (int n = 0; n < 2; ++n) _Pragma("unroll") for (int k = 0; k < 2; ++k) \
        acc[ai][bj][m][n] = __builtin_amdgcn_mfma_f32_16x16x32_bf16(Bt[n][k], At[m][k], acc[ai][bj][m][n], 0, 0, 0); __builtin_amdgcn_s_setprio(0); } while (0)
#define PG_WAIT_V(n) asm volatile("s_waitcnt vmcnt(" #n ")" ::: "memory")
#define PG_WAIT_L(n) asm volatile("s_waitcnt lgkmcnt(" #n ")" ::: "memory")
#define PG_BAR __builtin_amdgcn_s_barrier()
#define PG_SCHED __builtin_amdgcn_sched_barrier(0)
    Unit cur, nxt; int ui = 0;
    if (!S.next(0, cur)) return;
    f32x4 acc[2][2][4][2];
#pragma unroll
    for (int a = 0; a < 2; ++a)
#pragma unroll
        for (int b = 0; b < 2; ++b)
#pragma unroll
            for (int m = 0; m < 4; ++m)
#pragma unroll
                for (int n = 0; n < 2; ++n) acc[a][b][m][n] = (f32x4){0.f, 0.f, 0.f, 0.f};
    bf16x8 At[4][2], B0[2][2], B1[2][2];
    const char* cA = cur.a; const char* cB = cur.b;
    PG_STAGE(PG_SB(0, 0), cB, voffB); PG_STAGE(PG_SA(0, 0), cA, voffA); PG_STAGE(PG_SB(0, 1), cB + hstepB, voffB); PG_STAGE(PG_SA(0, 1), cA + hstepA, voffA);
    if (wr == 1) PG_BAR;
    PG_WAIT_V(4); PG_BAR;
    PG_STAGE(PG_SB(1, 0), cB + kstep, voffB); PG_STAGE(PG_SA(1, 0), cA + kstep, voffA); PG_STAGE(PG_SB(1, 1), cB + hstepB + kstep, voffB);
    PG_WAIT_V(6); PG_BAR;
    for (;;) {
        const bool has_next = S.next(ui + 1, nxt);
        const char* nA = has_next ? nxt.a : cA; const char* nB = has_next ? nxt.b : cB;
        for (int t = 0; t < nt; t += 2) {
            const bool last = (t == nt - 2);
            const char* a1 = cA + (size_t)(t + 1) * kstep;
            const char* a2 = last ? nA : cA + (size_t)(t + 2) * kstep; const char* b2 = last ? nB : cB + (size_t)(t + 2) * kstep;
            const char* a3 = a2 + kstep; const char* b3 = b2 + kstep;
            PG_LDB(B0, 0, 0); PG_SCHED; PG_LDA(At, 0, 0); PG_STAGE(PG_SA(1, 1), a1 + hstepA, voffA);
            PG_WAIT_L(8); PG_BAR; PG_WAIT_L(0); PG_MMA(0, 0, At, B0); PG_BAR; PG_SCHED;
            PG_LDB(B1, 0, 1); PG_STAGE(PG_SB(0, 0), b2, voffB);
            PG_BAR; PG_WAIT_L(0); PG_MMA(0, 1, At, B1); PG_BAR;
            PG_LDA(At, 0, 1); PG_STAGE(PG_SA(0, 0), a2, voffA);
            PG_BAR; PG_WAIT_L(0); PG_MMA(1, 0, At, B0); PG_BAR; PG_SCHED;
            PG_STAGE(PG_SB(0, 1), b2 + hstepB, voffB);
            PG_WAIT_V(6); PG_BAR; PG_MMA(1, 1, At, B1); PG_BAR;
            PG_LDB(B0, 1, 0); PG_SCHED; PG_LDA(At, 1, 0); PG_STAGE(PG_SA(0, 1), a2 + hstepA, voffA);
            PG_WAIT_L(8); PG_BAR; PG_WAIT_L(0); PG_MMA(0, 0, At, B0); PG_BAR; PG_SCHED;
            PG_LDB(B1, 1, 1); PG_STAGE(PG_SB(1, 0), b3, voffB);
            PG_BAR; PG_WAIT_L(0); PG_MMA(0, 1, At, B1); PG_BAR;
            PG_LDA(At, 1, 1); PG_STAGE(PG_SA(1, 0), a3, voffA);
            PG_BAR; PG_WAIT_L(0); PG_MMA(1, 0, At, B0); PG_BAR; PG_SCHED;
            PG_STAGE(PG_SB(1, 1), b3 + hstepB, voffB);
            PG_WAIT_V(6); PG_BAR; PG_MMA(1, 1, At, B1); PG_BAR;
        }
        E(acc, cur, wr, wc, fr, fq);
        if (!has_next) break;
#pragma unroll
        for (int a = 0; a < 2; ++a)
#pragma unroll
            for (int b = 0; b < 2; ++b)
#pragma unroll
                for (int m = 0; m < 4; ++m)
#pragma unroll
                    for (int n = 0; n < 2; ++n) acc[a][b][m][n] = (f32x4){0.f, 0.f, 0.f, 0.f};
        cur = nxt; cA = nA; cB = nB; ++ui;
    }
    PG_WAIT_V(0);
    if (wr == 0) PG_BAR;
    PG_BAR;
#undef PG_SA
#undef PG_SB
#undef PG_STAGE
#undef PG_LDA
#undef PG_LDB
#undef PG_MMA
#undef PG_WAIT_V
#undef PG_WAIT_L
#undef PG_BAR
#undef PG_SCHED
}

struct SchedG1 {
    const char *HX, *W1, *WV; int G, c;
    __device__ __forceinline__ bool next(int i, Unit& u) const {
        const int L = i * G + c, nmain = (NROW / 256) * (NP1 / 256);
        if (L < nmain) { static_map(L, NROW / 256, NP1 / 256, u.pm, u.pn); u.a = HX + (size_t)u.pm * 256 * DM * 2; u.b = W1 + (size_t)u.pn * 256 * DM * 2; u.aux = 0; return true; }
        const int idx = L - nmain; if (idx >= 3 * (NROW / 256)) return false;
        u.pm = idx % 3; u.pn = idx / 3; u.a = WV + (size_t)u.pm * 256 * DM * 2; u.b = HX + (size_t)u.pn * 256 * DM * 2; u.aux = 1; return true;
    }
};
struct SchedStatic {
    const char *A, *B; size_t tA, tB; int nM, nN, G, c;
    __device__ __forceinline__ bool next(int i, Unit& u) const {
        const int L = i * G + c; if (L >= nM * nN) return false;
        static_map(L, nM, nN, u.pm, u.pn); u.a = A + (size_t)u.pm * tA; u.b = B + (size_t)u.pn * tB; u.aux = 0; return true;
    }
};
struct SchedMerge {
    const char *BR, *W; int ntile, G, c;
    __device__ __forceinline__ bool next(int i, Unit& u) const {
        const int t = c + (i >> 2) * G; if (t >= ntile) return false;
        const int br = i & 3; u.pm = t >> 2; u.pn = t & 3; u.aux = br;
        u.a = BR + (size_t)u.pm * 256 * 2048 * 2 + (size_t)br * 512 * 2; u.b = W + (size_t)br * DM * 512 * 2 + (size_t)u.pn * 256 * 512 * 2; return true;
    }
};
struct SchedMoe {
    const char *A, *W; const int* off; size_t tA, wE, wT; int npan, NJ, G, c;
    __device__ __forceinline__ bool next(int i, Unit& u) const {
        const int L = i * G + c; if (L >= npan * NJ) return false;
        const int p = L / NJ, j = L % NJ; int e = 0;
#pragma unroll 1
        for (int q = 1; q < 32; ++q) if (p * 256 >= off[q]) e = q;
        e = __builtin_amdgcn_readfirstlane(e);
        u.pm = p; u.pn = j; u.aux = e; u.a = A + (size_t)p * tA; u.b = W + (size_t)e * wE + (size_t)j * wT; return true;
    }
};

#define PG_ROWCOL const int row0 = u.pm * BM + wr * 64 + fr, col0 = u.pn * BM + wc * 32 + 4 * fq
struct EpiG1 { bf16_t *P1, *VT; const float* rtab; const float* lbp; int layer;
    __device__ __forceinline__ void operator()(const f32x4 (&acc)[2][2][4][2], const Unit& u, int wr, int wc, int fr, int fq) const {
        const int row0 = u.pm * BM + wr * 64 + fr;
        if (u.aux || (u.pn >= 8 && u.pn <= 10)) {
            const int col0 = u.pn * BM + wc * 32 + 4 * fq; bf16_t* base = u.aux ? VT : P1; const size_t ld = u.aux ? (size_t)NROW : (size_t)NP1;
            const bool rope = !u.aux && (u.pm < NTOK / 256);
#pragma unroll
            for (int ai = 0; ai < 2; ++ai)
#pragma unroll
                for (int m = 0; m < 4; ++m) { const int r = row0 + ai * HALF + m * 16; bf16_t* rowp = base + (size_t)r * ld + col0;
#pragma unroll
                    for (int bj = 0; bj < 2; ++bj) {
                        f32x4 v0 = acc[ai][bj][m][0], v1 = acc[ai][bj][m][1];
                        if (rope && !(u.pn == 10 && bj == 1)) {
                            const int pos = r & (SEQ - 1), pp = (wc & 1) ? (pos & 63) : (pos >> 6); const float* tp = rtab + (pp * 16 + 4 * fq) * 2;
                            const f32x4 t0 = *(const f32x4*)tp, t1 = *(const f32x4*)(tp + 4);
                            const f32x4 a = v0, b = v1;
                            v0.x = a.x * t0.x - b.x * t0.y; v1.x = a.x * t0.y + b.x * t0.x; v0.y = a.y * t0.z - b.y * t0.w; v1.y = a.y * t0.w + b.y * t0.z;
                            v0.z = a.z * t1.x - b.z * t1.y; v1.z = a.z * t1.y + b.z * t1.x; v0.w = a.w * t1.z - b.w * t1.w; v1.w = a.w * t1.w + b.w * t1.z;
                        }
                        u32x2 o; o.x = pk2(v0.x, v0.y); o.y = pk2(v0.z, v0.w); *(u32x2*)(rowp + bj * HALF) = o;
                        o.x = pk2(v1.x, v1.y); o.y = pk2(v1.z, v1.w); *(u32x2*)(rowp + bj * HALF + 16) = o; } }
            return;
        }
        const int col0 = u.pn * BM + wc * 32 + 8 * fq;
        const int mode = (u.pn == 11 || u.pn == 12) ? 2 : ((u.pn >= 13 && u.pn <= 16) ? 3 : 0);
        if (mode == 3) {
            f32x4 lb4[2][2];
            const int z = (u.pn - 13) >> 1, cb = z * 512 + ((u.pn - 13) & 1) * 256 + wc * 32 + 8 * fq;
#pragma unroll
            for (int bj = 0; bj < 2; ++bj)
#pragma unroll
                for (int n = 0; n < 2; ++n) lb4[bj][n] = (layer == 0) ? (f32x4){0.f, 0.f, 0.f, 0.f} : *(const f32x4*)(lbp + cb + bj * HALF + 4 * n);
#pragma unroll
            for (int ai = 0; ai < 2; ++ai)
#pragma unroll
                for (int m = 0; m < 4; ++m) { bf16_t* rowp = P1 + (size_t)(row0 + ai * HALF + m * 16) * NP1 + col0;
#pragma unroll
                    for (int bj = 0; bj < 2; ++bj) { float gq[8];
#pragma unroll
                        for (int n = 0; n < 2; ++n)
#pragma unroll
                            for (int j = 0; j < 4; ++j) { const float f = acc[ai][bj][m][n][j], lb = lb4[bj][n][j]; const float t = __expf(-fabsf(f)), rr = __builtin_amdgcn_rcpf(1.f + t);
                                gq[4 * n + j] = __logf(fmaxf(lb + (1.f - lb) * ((f >= 0.f) ? rr : t * rr), 1e-37f)); }
                        u32x4 o; o.x = pk2(gq[0], gq[1]); o.y = pk2(gq[2], gq[3]); o.z = pk2(gq[4], gq[5]); o.w = pk2(gq[6], gq[7]); *(u32x4*)(rowp + bj * HALF) = o; } }
            return;
        }
#pragma unroll
        for (int ai = 0; ai < 2; ++ai)
#pragma unroll
            for (int m = 0; m < 4; ++m) { bf16_t* rowp = P1 + (size_t)(row0 + ai * HALF + m * 16) * NP1 + col0;
#pragma unroll
                for (int bj = 0; bj < 2; ++bj) {
                    f32x4 v0 = acc[ai][bj][m][0], v1 = acc[ai][bj][m][1];
                    if (mode == 2) {
#pragma unroll
                        for (int j = 0; j < 4; ++j) { v0[j] = v0[j] * __builtin_amdgcn_rcpf(1.f + __expf(-v0[j])); v1[j] = v1[j] * __builtin_amdgcn_rcpf(1.f + __expf(-v1[j])); }
                    }
                    u32x4 o; o.x = pk2(v0.x, v0.y); o.y = pk2(v0.z, v0.w); o.z = pk2(v1.x, v1.y); o.w = pk2(v1.z, v1.w); *(u32x4*)(rowp + bj * HALF) = o; } }
    }
};
#define PG_ROWCOL8 const int row0 = u.pm * BM + wr * 64 + fr, col0 = u.pn * BM + wc * 32 + 8 * fq
struct EpiGate { bf16_t* G;
    __device__ __forceinline__ void operator()(const f32x4 (&acc)[2][2][4][2], const Unit& u, int wr, int wc, int fr, int fq) const {
        PG_ROWCOL8;
#pragma unroll
        for (int ai = 0; ai < 2; ++ai)
#pragma unroll
            for (int m = 0; m < 4; ++m) { bf16_t* rowp = G + (size_t)(row0 + ai * HALF + m * 16) * NGATE + col0;
#pragma unroll
                for (int bj = 0; bj < 2; ++bj) { const f32x4 v0 = acc[ai][bj][m][0], v1 = acc[ai][bj][m][1]; u32x4 o;
                    o.x = pk2(sigmoidf_(v0.x), sigmoidf_(v0.y)); o.y = pk2(sigmoidf_(v0.z), sigmoidf_(v0.w)); o.z = pk2(sigmoidf_(v1.x), sigmoidf_(v1.y)); o.w = pk2(sigmoidf_(v1.z), sigmoidf_(v1.w));
                    *(u32x4*)(rowp + bj * HALF) = o; } }
    }
};
struct EpiMerge { const bf16_t* G; bf16_t* O;
    __device__ __forceinline__ void operator()(const f32x4 (&acc)[2][2][4][2], const Unit& u, int wr, int wc, int fr, int fq) const {
        PG_ROWCOL8; const int br = u.aux;
#pragma unroll
        for (int ai = 0; ai < 2; ++ai) {
            u32x4 g4[4][2], o4[4][2];
#pragma unroll
            for (int m = 0; m < 4; ++m) { const size_t r = (size_t)(row0 + ai * HALF + m * 16); const bf16_t* gp = G + r * NGATE + br * 1024 + col0; const bf16_t* rowp = O + r * DM + col0;
#pragma unroll
                for (int bj = 0; bj < 2; ++bj) { g4[m][bj] = *(const u32x4*)(gp + bj * HALF); if (br != 0) o4[m][bj] = *(const u32x4*)(rowp + bj * HALF); } }
#pragma unroll
            for (int m = 0; m < 4; ++m) { bf16_t* rowp = O + (size_t)(row0 + ai * HALF + m * 16) * DM + col0;
#pragma unroll
                for (int bj = 0; bj < 2; ++bj) { const f32x4 v0 = acc[ai][bj][m][0], v1 = acc[ai][bj][m][1]; const u32x4 gg = g4[m][bj];
                    float w[8] = {__uint_as_float(gg.x << 16) * v0.x, __uint_as_float(gg.x & 0xffff0000u) * v0.y, __uint_as_float(gg.y << 16) * v0.z, __uint_as_float(gg.y & 0xffff0000u) * v0.w,
                                  __uint_as_float(gg.z << 16) * v1.x, __uint_as_float(gg.z & 0xffff0000u) * v1.y, __uint_as_float(gg.w << 16) * v1.z, __uint_as_float(gg.w & 0xffff0000u) * v1.w};
                    if (br != 0) { const u32x4 oo = o4[m][bj];
                        w[0] += __uint_as_float(oo.x << 16); w[1] += __uint_as_float(oo.x & 0xffff0000u); w[2] += __uint_as_float(oo.y << 16); w[3] += __uint_as_float(oo.y & 0xffff0000u);
                        w[4] += __uint_as_float(oo.z << 16); w[5] += __uint_as_float(oo.z & 0xffff0000u); w[6] += __uint_as_float(oo.w << 16); w[7] += __uint_as_float(oo.w & 0xffff0000u); }
                    u32x4 o; o.x = pk2(w[0], w[1]); o.y = pk2(w[2], w[3]); o.z = pk2(w[4], w[5]); o.w = pk2(w[6], w[7]); *(u32x4*)(rowp + bj * HALF) = o; } }
            asm volatile("" ::: "memory");
        }
    }
};
struct EpiWout { const float *xlat, *xctx; float *olat, *octx; const float* modl;
    __device__ __forceinline__ void operator()(const f32x4 (&acc)[2][2][4][2], const Unit& u, int wr, int wc, int fr, int fq) const {
        PG_ROWCOL; const bool lat = u.pm < NTOK / 256; const int rb = lat ? (u.pm >> 4) : 4;
        const float* xin = lat ? xlat : xctx - (size_t)NTOK * DM; float* xo = lat ? olat : octx - (size_t)NTOK * DM; const float* m2 = modl + (size_t)rb * 6144 + 2 * 1024 + col0;
        f32x4 mv[2][2];
#pragma unroll
        for (int bj = 0; bj < 2; ++bj)
#pragma unroll
            for (int n = 0; n < 2; ++n) mv[bj][n] = *(const f32x4*)(m2 + bj * HALF + n * 16);
#pragma unroll
        for (int aq = 0; aq < 4; ++aq) { const int ai = aq >> 1, m0 = (aq & 1) * 2;
            f32x4 xv[4][2][2];
#pragma unroll
            for (int m = m0; m < m0 + 2; ++m) { const size_t o = (size_t)(row0 + ai * HALF + m * 16) * DM + col0;
#pragma unroll
                for (int bj = 0; bj < 2; ++bj)
#pragma unroll
                    for (int n = 0; n < 2; ++n) xv[m][bj][n] = *(const f32x4*)(xin + o + bj * HALF + n * 16); }
#pragma unroll
            for (int m = m0; m < m0 + 2; ++m) { const size_t o = (size_t)(row0 + ai * HALF + m * 16) * DM + col0;
#pragma unroll
                for (int bj = 0; bj < 2; ++bj)
#pragma unroll
                    for (int n = 0; n < 2; ++n) *(f32x4*)(xo + o + bj * HALF + n * 16) = ALPHA * xv[m][bj][n] + mv[bj][n] * acc[ai][bj][m][n]; }
            asm volatile("" ::: "memory");
        }
    }
};
struct EpiMoe1 { bf16_t* HID; const float* roww;
    __device__ __forceinline__ void operator()(const f32x4 (&acc)[2][2][4][2], const Unit& u, int wr, int wc, int fr, int fq) const {
        const int row0 = u.pm * BM + wr * 64 + fr, hc0 = u.pn * 128 + wc * 32 + 8 * fq;
#pragma unroll
        for (int ai = 0; ai < 2; ++ai)
#pragma unroll
            for (int m = 0; m < 4; ++m) { const int r = row0 + ai * HALF + m * 16; const float w = roww[r];
                const f32x4 g0 = acc[ai][0][m][0], g1 = acc[ai][0][m][1], u0 = acc[ai][1][m][0], u1 = acc[ai][1][m][1]; u32x4 o;
                o.x = pk2(siluf_(g0.x) * u0.x * w, siluf_(g0.y) * u0.y * w); o.y = pk2(siluf_(g0.z) * u0.z * w, siluf_(g0.w) * u0.w * w);
                o.z = pk2(siluf_(g1.x) * u1.x * w, siluf_(g1.y) * u1.y * w); o.w = pk2(siluf_(g1.z) * u1.z * w, siluf_(g1.w) * u1.w * w);
                *(u32x4*)(HID + (size_t)r * 256 + hc0) = o; }
    }
};
struct EpiMoe2 { bf16_t* Y; const int* rmap; bf16_t* dump;
    __device__ __forceinline__ void operator()(const f32x4 (&acc)[2][2][4][2], const Unit& u, int wr, int wc, int fr, int fq) const {
        PG_ROWCOL8;
#pragma unroll
        for (int ai = 0; ai < 2; ++ai)
#pragma unroll
            for (int m = 0; m < 4; ++m) { const int s = rmap[row0 + ai * HALF + m * 16];
                bf16_t* rowp = (s >= 0 ? Y + (size_t)s * DM : dump) + col0;
#pragma unroll
                for (int bj = 0; bj < 2; ++bj) { const f32x4 v0 = acc[ai][bj][m][0], v1 = acc[ai][bj][m][1]; u32x4 o; o.x = pk2(v0.x, v0.y); o.y = pk2(v0.z, v0.w); o.z = pk2(v1.x, v1.y); o.w = pk2(v1.z, v1.w); *(u32x4*)(rowp + bj * HALF) = o; } }
    }
};
#undef PG_ROWCOL8
#undef PG_ROWCOL
}

__device__ __forceinline__ void moe_offsets(Frame& F, int l, int* off) {
    if (F.tid < 64) {
        int v = (F.tid < 32) ? (((int)F.cnt()[l * 32 + F.tid] + 255) & ~255) : 0;
#pragma unroll
        for (int o = 1; o < 32; o <<= 1) { const int t = __shfl_up(v, o); if ((F.tid & 63) >= o) v += t; }
        if (F.tid < 32) off[F.tid + 1] = v;
        if (F.tid == 0) off[0] = 0;
    }
    __syncthreads();
}

__device__ __forceinline__ void phase_rope(Frame& F) {
    float* tab = F.smf;
    for (int e = F.tid; e < 1024; e += NTHR) { const int pp = e >> 4, i = e & 15; const float inv = powf(10000.f, -(float)i / 16.f), ang = (float)pp * inv; tab[2 * e] = cosf(ang); tab[2 * e + 1] = sinf(ang); }
    __syncthreads();
    const size_t total = (size_t)NTOK * 320;
    for (size_t idx = (size_t)F.bid * NTHR + F.tid; idx < total; idx += (size_t)F.nb * NTHR) {
        const int row = (int)(idx / 320), r = (int)(idx % 320), h = r >> 5, half = (r >> 4) & 1, i = r & 15;
        const int pos = row & (SEQ - 1), pp = half ? (pos & 63) : (pos >> 6);
        const float cs = tab[2 * (pp * 16 + i)], sn = tab[2 * (pp * 16 + i) + 1];
        bf16_t* base = F.P1() + (size_t)row * NP1 + (h < 8 ? PC_CQ + h * 64 : PC_CK + (h - 8) * 64) + half * 32 + i;
        const float u1 = bf2f(base[0]), u2 = bf2f(base[16]);
        base[0] = f2bf(u1 * cs - u2 * sn); base[16] = f2bf(u1 * sn + u2 * cs);
    }
}

__device__ __forceinline__ int seq_row(int s, int b, int z) {
    if (s < LC) { const int tc = z ? (LC - 1 - s) : s; return NTOK + b * LC + tc; }
    const int tl = s - LC, t = z ? (SEQ - 1 - tl) : tl; return b * SEQ + t;
}
typedef short bf16x8_t __attribute__((ext_vector_type(8)));
typedef short bf16x4_t __attribute__((ext_vector_type(4)));
struct MaskNone { __device__ __forceinline__ void operator()(f32x4&, f32x4&) const {} };
struct MaskNA { int u0; const float* brow;
    __device__ __forceinline__ void operator()(f32x4& s0, f32x4& s1) const {
        float v[8] = {s0.x, s0.y, s0.z, s0.w, s1.x, s1.y, s1.z, s1.w};
#pragma unroll
        for (int T = 0; T < 2; ++T)
#pragma unroll
            for (int rr = 0; rr < 4; ++rr) v[T * 4 + rr] = ((unsigned)(u0 + 16 * T + rr) < 16u) ? v[T * 4 + rr] + brow[16 * T + rr] : -INFINITY;
        s0 = (f32x4){v[0], v[1], v[2], v[3]}; s1 = (f32x4){v[4], v[5], v[6], v[7]};
    }
};
struct MaskWA { int i, j0;
    __device__ __forceinline__ void operator()(f32x4& s0, f32x4& s1) const {
        float v[8] = {s0.x, s0.y, s0.z, s0.w, s1.x, s1.y, s1.z, s1.w};
#pragma unroll
        for (int T = 0; T < 2; ++T)
#pragma unroll
            for (int rr = 0; rr < 4; ++rr) { const int j = j0 + 16 * T + rr; const bool ok = (j >= 0) && (j < SEQ) && (i - j <= 128) && (j - i <= 128);
                v[T * 4 + rr] = ok ? v[T * 4 + rr] : -INFINITY; }
        s0 = (f32x4){v[0], v[1], v[2], v[3]}; s1 = (f32x4){v[4], v[5], v[6], v[7]};
    }
};
struct KVF { bf16x8_t k[4]; bf16x4_t v[4][2]; };
__device__ __forceinline__ void kv_load(KVF& f, const char* kbase, unsigned ko0, unsigned ko1, const char* vbase, unsigned vo0, unsigned vo1) {
    f.k[0] = *(const bf16x8_t*)(kbase + ko0); f.k[1] = *(const bf16x8_t*)(kbase + ko0 + 64); f.k[2] = *(const bf16x8_t*)(kbase + ko1); f.k[3] = *(const bf16x8_t*)(kbase + ko1 + 64);
#pragma unroll
    for (int t = 0; t < 4; ++t) { f.v[t][0] = *(const bf16x4_t*)(vbase + vo0 + (unsigned)t * 16u * NROW * 2u); f.v[t][1] = *(const bf16x4_t*)(vbase + vo1 + (unsigned)t * 16u * NROW * 2u); }
}
__device__ __forceinline__ float xmax_g(float x) {
    auto r = __builtin_amdgcn_permlane16_swap(__float_as_uint(x), __float_as_uint(x), false, false); x = fmaxf(__uint_as_float(r[0]), __uint_as_float(r[1]));
    auto q = __builtin_amdgcn_permlane32_swap(__float_as_uint(x), __float_as_uint(x), false, false); return fmaxf(__uint_as_float(q[0]), __uint_as_float(q[1])); }
__device__ __forceinline__ float xsum_g(float x) {
    auto r = __builtin_amdgcn_permlane16_swap(__float_as_uint(x), __float_as_uint(x), false, false); x = __uint_as_float(r[0]) + __uint_as_float(r[1]);
    auto q = __builtin_amdgcn_permlane32_swap(__float_as_uint(x), __float_as_uint(x), false, false); return __uint_as_float(q[0]) + __uint_as_float(q[1]); }
template <class MaskF>
__device__ __forceinline__ void attn_tile(float& am, float& al, f32x4 (&ao)[4], const bf16x8_t (&qb)[2], const KVF& f, const MaskF& maskf) {
    f32x4 s0 = {0.f, 0.f, 0.f, 0.f}, s1 = {0.f, 0.f, 0.f, 0.f};
    s0 = __builtin_amdgcn_mfma_f32_16x16x32_bf16(f.k[0], qb[0], s0, 0, 0, 0); s0 = __builtin_amdgcn_mfma_f32_16x16x32_bf16(f.k[1], qb[1], s0, 0, 0, 0);
    s1 = __builtin_amdgcn_mfma_f32_16x16x32_bf16(f.k[2], qb[0], s1, 0, 0, 0); s1 = __builtin_amdgcn_mfma_f32_16x16x32_bf16(f.k[3], qb[1], s1, 0, 0, 0);
    maskf(s0, s1);
    const float mx = xmax_g(fmaxf(fmaxf(fmaxf(s0.x, s0.y), fmaxf(s0.z, s0.w)), fmaxf(fmaxf(s1.x, s1.y), fmaxf(s1.z, s1.w))));
    const float mn = fmaxf(am, mx);
    if (__any(mn != am)) {
        const float alpha = __builtin_amdgcn_exp2f(am - mn); am = mn; al *= alpha;
#pragma unroll
        for (int t = 0; t < 4; ++t) ao[t] = ao[t] * alpha;
    }
    f32x4 p0, p1;
    p0.x = __builtin_amdgcn_exp2f(s0.x - am); p0.y = __builtin_amdgcn_exp2f(s0.y - am); p0.z = __builtin_amdgcn_exp2f(s0.z - am); p0.w = __builtin_amdgcn_exp2f(s0.w - am);
    p1.x = __builtin_amdgcn_exp2f(s1.x - am); p1.y = __builtin_amdgcn_exp2f(s1.y - am); p1.z = __builtin_amdgcn_exp2f(s1.z - am); p1.w = __builtin_amdgcn_exp2f(s1.w - am);
    al += ((p0.x + p0.y) + (p0.z + p0.w)) + ((p1.x + p1.y) + (p1.z + p1.w));
    union { bf16x8_t v; unsigned u[4]; } pb;
    pb.u[0] = pk2(p0.x, p0.y); pb.u[1] = pk2(p0.z, p0.w); pb.u[2] = pk2(p1.x, p1.y); pb.u[3] = pk2(p1.z, p1.w);
#pragma unroll
    for (int t = 0; t < 4; ++t) {
        union { bf16x8_t v; bf16x4_t h[2]; } av; av.h[0] = f.v[t][0]; av.h[1] = f.v[t][1];
        ao[t] = __builtin_amdgcn_mfma_f32_16x16x32_bf16(av.v, pb.v, ao[t], 0, 0, 0);
    }
}
template <int kind>
__device__ __forceinline__ void attn_multi(Frame& F, int l, int item, const float* rpb_s) {
    constexpr int NQ = 2;
    constexpr int NLOC = (kind == 0) ? 9 : (kind == 1 ? 9 : 0), NS = 8 + NLOC;
    const int lane = F.lane, n = lane & 15, g = lane >> 4;
    const bf16_t* P1 = F.P1(); const bf16_t* VT = F.VT();
    int b, h0, kvh = 0, kcol, vrow, r = 0, cb = 0, t0 = 0, qrow0, qcol0, brcol0;
    constexpr int QRS = (kind == 0) ? 64 : (kind == 2 ? 16 : 0), QCS = (kind == 1 || kind == 3) ? 64 : 0;
    if (kind == 0) { cb = item & 3; r = ((item >> 2) & 31) * 2; h0 = (item >> 7) & 7; b = item >> 10; kcol = PC_BK + h0 * 64; vrow = h0 * 64; qrow0 = b * SEQ + r * 64 + cb * 16; qcol0 = PC_BQ + h0 * 64; brcol0 = 512 + h0 * 64; }
    else if (kind == 1) { const int hp = item & 1, qt = (item >> 1) & 255; kvh = (item >> 9) & 1; b = item >> 10; h0 = kvh * 4 + hp * 2; t0 = qt * 16; kcol = PC_CK + kvh * 64; vrow = 512 + kvh * 64; qrow0 = b * SEQ + t0; qcol0 = PC_CQ + h0 * 64; brcol0 = 1024 + h0 * 64; }
    else if (kind == 2) { const int qp = item & 7; h0 = (item >> 3) & 7; b = item >> 6; kcol = PC_BK + h0 * 64; vrow = h0 * 64; qrow0 = NTOK + b * LC + qp * 32; qcol0 = PC_BQ + h0 * 64; brcol0 = 512 + h0 * 64; }
    else { const int hp = item & 1, qt = (item >> 1) & 15; kvh = (item >> 5) & 1; b = item >> 6; h0 = kvh * 4 + hp * 2; kcol = PC_CK + kvh * 64; vrow = 512 + kvh * 64; qrow0 = NTOK + b * LC + qt * 16; qcol0 = PC_CQ + h0 * 64; brcol0 = 1024 + h0 * 64; }
    bf16x8_t qb[NQ][2]; float am[NQ], al[NQ]; f32x4 ao[NQ][4];
    { const char* qbase = (const char*)P1; const unsigned qo = (unsigned)(qrow0 + n) * (unsigned)(NP1 * 2) + (unsigned)(qcol0 + 8 * g) * 2u;
#pragma unroll
      for (int q = 0; q < NQ; ++q) { const unsigned o = qo + (unsigned)q * (unsigned)(QRS * NP1 * 2 + QCS * 2); qb[q][0] = *(const bf16x8_t*)(qbase + o); qb[q][1] = *(const bf16x8_t*)(qbase + o + 64);
        am[q] = -1e30f; al[q] = 0.f;
#pragma unroll
        for (int t = 0; t < 4; ++t) ao[q][t] = (f32x4){0.f, 0.f, 0.f, 0.f}; } }
    const int crow0 = NTOK + b * LC;
    const int w0 = (cb == 0) ? 0 : (cb == 1 ? 8 : (cb == 2 ? 24 : 32)), ru = min(max(r - 4, 0), 56);
    const char* kbase = (const char*)P1; const char* vbase = (const char*)VT;
    const unsigned kl = (unsigned)(kcol + 8 * g) * 2u, vl = (unsigned)(vrow + n) * (unsigned)NROW * 2u;
    auto load_step = [&](KVF& f, int s) {
        if (s < 8) { const unsigned ko = (unsigned)(crow0 + 32 * s + n) * (unsigned)(NP1 * 2) + kl, vo = vl + (unsigned)(crow0 + 32 * s + 4 * g) * 2u;
            kv_load(f, kbase, ko, ko + 16u * NP1 * 2u, vbase, vo, vo + 32u); }
        else if (kind == 0) { const int tok0 = b * SEQ + min(ru + (s - 8), 63) * 64 + w0; const unsigned ko = (unsigned)(tok0 + n) * (unsigned)(NP1 * 2) + kl, vo = vl + (unsigned)(tok0 + 4 * g) * 2u;
            kv_load(f, kbase, ko, ko + 16u * NP1 * 2u, vbase, vo, vo + 32u); }
        else if (kind == 1) { const int kb = t0 - 128 + 32 * (s - 8);
            const int ja = min(max(kb + n, 0), SEQ - 1), jb = min(max(kb + 16 + n, 0), SEQ - 1), va = min(max(kb + 4 * g, 0), SEQ - 4), vb = min(max(kb + 16 + 4 * g, 0), SEQ - 4);
            kv_load(f, kbase, (unsigned)(b * SEQ + ja) * (unsigned)(NP1 * 2) + kl, (unsigned)(b * SEQ + jb) * (unsigned)(NP1 * 2) + kl, vbase, vl + (unsigned)(b * SEQ + va) * 2u, vl + (unsigned)(b * SEQ + vb) * 2u); }
    };
    auto compute_step = [&](const KVF& f, int s) {
        if (s < 8) {
#pragma unroll
            for (int q = 0; q < NQ; ++q) { attn_tile(am[q], al[q], ao[q], qb[q], f, MaskNone()); if (NQ == 4) __builtin_amdgcn_sched_barrier(0); }
        } else if (kind == 0) {
            const int kr = ru + (s - 8);
#pragma unroll
            for (int q = 0; q < NQ; ++q) { const int rq = r + q, rsq = min(max(rq - 4, 0), 56);
                if (kr >= rsq && kr <= rsq + 7) { const int c = cb * 16 + n, csq = min(max(c - 8, 0), 48), kc0 = w0 + 4 * g;
                    MaskNA mk{kc0 - csq, rpb_s + (h0 * 15 + (kr - rq + 7)) * 64 + (kc0 - c + 15 + 16)}; attn_tile(am[q], al[q], ao[q], qb[q], f, mk); } }
        } else if (kind == 1) {
            const int ls = s - 8, kb = t0 - 128 + 32 * ls;
            if (ls >= 1 && ls <= 7 && kb >= 0 && kb + 31 < SEQ) {
#pragma unroll
                for (int q = 0; q < NQ; ++q) attn_tile(am[q], al[q], ao[q], qb[q], f, MaskNone());
            } else {
                MaskWA mk{t0 + n, kb + 4 * g};
#pragma unroll
                for (int q = 0; q < NQ; ++q) attn_tile(am[q], al[q], ao[q], qb[q], f, mk);
            }
        }
    };
    if (NQ == 2) {
        KVF fa, fb;
        load_step(fa, 0);
#pragma unroll 1
        for (int s = 0; s < NS; s += 2) {
            if (s + 1 < NS) load_step(fb, s + 1);
            compute_step(fa, s);
            if (s + 1 < NS) { if (s + 2 < NS) load_step(fa, s + 2); compute_step(fb, s + 1); }
        }
    } else {
        KVF fa;
#pragma unroll 1
        for (int s = 0; s < NS; ++s) { load_step(fa, s); compute_step(fa, s); }
    }
#pragma unroll
    for (int q = 0; q < NQ; ++q) {
        float lt = xsum_g(al[q]);
        float osc = 1.f;
        if (kind == 1 || kind == 3) { const float sk = F.p.wa_sink[l * 8 + h0 + q] * 1.44269504089f, mf = fmaxf(am[q], sk); osc = __builtin_amdgcn_exp2f(am[q] - mf); lt = lt * osc + __builtin_amdgcn_exp2f(sk - mf); }
        const float inv = osc / lt;
        char* obase = (char*)F.BR(); const unsigned oo = (unsigned)(qrow0 + q * QRS + n) * 4096u + (unsigned)(brcol0 + q * QCS + 4 * g) * 2u;
#pragma unroll
        for (int t = 0; t < 4; ++t) { const f32x4 v = ao[q][t] * inv; u32x2 o2; o2.x = pk2(v.x, v.y); o2.y = pk2(v.z, v.w); *(u32x2*)(obase + oo + 32u * t) = o2; }
    }
}


template <int kind>
__device__ __forceinline__ void attn_block(Frame& F, int l, int item, const float* rpb_s, bf16_t* sbuf) {
    constexpr int NQ = 2, NLOC = (kind == 0) ? 11 : (kind == 1 ? 10 : 0), NS = 8 + NLOC, SROW = 72;
    const int tid = F.tid, lane = F.lane, n = lane & 15, g = lane >> 4, w = __builtin_amdgcn_readfirstlane(F.wave);
    const bf16_t* P1 = F.P1(); const bf16_t* VT = F.VT();
    int b, h0, kvh = 0, kcol, vrow, r = 0, cb = 0, t0 = 0, t0g = 0, r0 = 0, qrow0, qcol0, brcol0;
    constexpr int QRS = (kind == 0) ? 64 : (kind == 2 ? 16 : 0), QCS = (kind == 1 || kind == 3) ? 64 : 0;
    if (kind == 0) { const int rq = item & 15, hb = (item >> 4) & 7; b = item >> 7; r0 = 4 * rq; cb = w & 3; r = r0 + 2 * (w >> 2); h0 = hb; kcol = PC_BK + hb * 64; vrow = hb * 64;
        qrow0 = b * SEQ + r * 64 + cb * 16; qcol0 = PC_BQ + hb * 64; brcol0 = 512 + hb * 64; }
    else if (kind == 1) { const int qg = item & 63; kvh = (item >> 6) & 1; b = item >> 7; t0g = 64 * qg; t0 = t0g + 16 * (w & 3); h0 = kvh * 4 + 2 * (w >> 2); kcol = PC_CK + kvh * 64; vrow = 512 + kvh * 64;
        qrow0 = b * SEQ + t0; qcol0 = PC_CQ + h0 * 64; brcol0 = 1024 + h0 * 64; }
    else if (kind == 2) { const int hb = item & 7; b = item >> 3; h0 = hb; kcol = PC_BK + hb * 64; vrow = hb * 64; qrow0 = NTOK + b * LC + 32 * w; qcol0 = PC_BQ + hb * 64; brcol0 = 512 + hb * 64; }
    else { const int qh = item & 3; kvh = (item >> 2) & 1; b = item >> 3; h0 = kvh * 4 + 2 * (w >> 2); kcol = PC_CK + kvh * 64; vrow = 512 + kvh * 64;
        qrow0 = NTOK + b * LC + 16 * (4 * qh + (w & 3)); qcol0 = PC_CQ + h0 * 64; brcol0 = 1024 + h0 * 64; }
    bf16x8_t qb[NQ][2]; float am[NQ], al[NQ]; f32x4 ao[NQ][4];
    { const char* qbase = (const char*)P1; const unsigned qo = (unsigned)(qrow0 + n) * (unsigned)(NP1 * 2) + (unsigned)(qcol0 + 8 * g) * 2u;
#pragma unroll
      for (int q = 0; q < NQ; ++q) { const unsigned o = qo + (unsigned)q * (unsigned)(QRS * NP1 * 2 + QCS * 2); qb[q][0] = *(const bf16x8_t*)(qbase + o); qb[q][1] = *(const bf16x8_t*)(qbase + o + 64);
        am[q] = -1e30f; al[q] = 0.f;
#pragma unroll
        for (int t = 0; t < 4; ++t) ao[q][t] = (f32x4){0.f, 0.f, 0.f, 0.f}; } }
    const int crow0 = NTOK + b * LC, ru0 = min(max(r0 - 4, 0), 56);
    const int w0 = (cb == 0) ? 0 : (cb == 1 ? 8 : (cb == 2 ? 24 : 32));
    const int srow = tid >> 3, sch = tid & 7;
    const char* kbase = (const char*)P1; const char* vbase = (const char*)VT;
    u32x4 kreg = {0u, 0u, 0u, 0u}, vreg = {0u, 0u, 0u, 0u};
    auto stage_load = [&](int s) {
        int krow, vcol; bool kon, von;
        if (s < 8) { krow = crow0 + 32 * s + srow; vcol = crow0 + 32 * s + 8 * sch; kon = srow < 32; von = sch < 4; }
        else if (kind == 0) { const int kr = min(ru0 + (s - 8), 63); krow = b * SEQ + kr * 64 + srow; vcol = b * SEQ + kr * 64 + 8 * sch; kon = true; von = true; }
        else { const int kb = t0g - 128 + 32 * (s - 8); krow = b * SEQ + min(max(kb + srow, 0), SEQ - 1); vcol = b * SEQ + min(max(kb + 8 * sch, 0), SEQ - 8); kon = srow < 32; von = sch < 4; }
        if (kon) kreg = *(const u32x4*)(kbase + (unsigned)krow * (unsigned)(NP1 * 2) + (unsigned)(kcol * 2 + sch * 16));
        if (von) vreg = *(const u32x4*)(vbase + (unsigned)(vrow + srow) * (unsigned)(NROW * 2) + (unsigned)vcol * 2u);
    };
    auto stage_store = [&](int s) { bf16_t* Ks = sbuf + (s & 1) * (2 * 64 * SROW); bf16_t* Vs = Ks + 64 * SROW;
        *(u32x4*)(Ks + srow * SROW + sch * 8) = kreg; *(u32x4*)(Vs + srow * SROW + sch * 8) = vreg; };
    stage_load(0); stage_store(0);
    __syncthreads();
#pragma unroll 1
    for (int s = 0; s < NS; ++s) {
        if (s + 1 < NS) stage_load(s + 1);
        bool act[NQ]; int kofs = 0;
        if (s < 8) { act[0] = act[1] = true; }
        else if (kind == 0) { const int kr = ru0 + (s - 8); kofs = w0;
#pragma unroll
            for (int q = 0; q < NQ; ++q) { const int rsq = min(max(r + q - 4, 0), 56); act[q] = (kr <= 63) && (kr >= rsq) && (kr <= rsq + 7); } }
        else { const int kb = t0g - 128 + 32 * (s - 8); act[0] = act[1] = (kb + 31 >= t0 - 128) && (kb <= t0 + 143); }
        if (act[0] || act[1]) {
            const bf16_t* Ks = sbuf + (s & 1) * (2 * 64 * SROW); const bf16_t* Vs = Ks + 64 * SROW;
            KVF f;
            f.k[0] = *(const bf16x8_t*)(Ks + (kofs + n) * SROW + 8 * g); f.k[1] = *(const bf16x8_t*)(Ks + (kofs + n) * SROW + 32 + 8 * g);
            f.k[2] = *(const bf16x8_t*)(Ks + (kofs + 16 + n) * SROW + 8 * g); f.k[3] = *(const bf16x8_t*)(Ks + (kofs + 16 + n) * SROW + 32 + 8 * g);
#pragma unroll
            for (int t = 0; t < 4; ++t) { f.v[t][0] = *(const bf16x4_t*)(Vs + (16 * t + n) * SROW + kofs + 4 * g); f.v[t][1] = *(const bf16x4_t*)(Vs + (16 * t + n) * SROW + kofs + 16 + 4 * g); }
            if (s < 8) {
#pragma unroll
                for (int q = 0; q < NQ; ++q) attn_tile(am[q], al[q], ao[q], qb[q], f, MaskNone());
            } else if (kind == 0) { const int kr = ru0 + (s - 8);
#pragma unroll
                for (int q = 0; q < NQ; ++q) if (act[q]) { const int c = cb * 16 + n, csq = min(max(c - 8, 0), 48), kc0 = w0 + 4 * g;
                    MaskNA mk{kc0 - csq, rpb_s + (h0 * 15 + (kr - (r + q) + 7)) * 64 + (kc0 - c + 15 + 16)}; attn_tile(am[q], al[q], ao[q], qb[q], f, mk); }
            } else if (kind == 1) { const int kb = t0g - 128 + 32 * (s - 8);
                if (kb >= t0 - 113 && kb + 31 <= t0 + 128 && kb >= 0 && kb + 31 < SEQ) {
#pragma unroll
                    for (int q = 0; q < NQ; ++q) attn_tile(am[q], al[q], ao[q], qb[q], f, MaskNone());
                } else { MaskWA mk{t0 + n, kb + 4 * g};
#pragma unroll
                    for (int q = 0; q < NQ; ++q) attn_tile(am[q], al[q], ao[q], qb[q], f, mk); }
            }
        }
        if (s + 1 < NS) stage_store(s + 1);
        __syncthreads();
    }
#pragma unroll
    for (int q = 0; q < NQ; ++q) {
        float lt = xsum_g(al[q]);
        float osc = 1.f;
        if (kind == 1 || kind == 3) { const float sk = F.p.wa_sink[l * 8 + h0 + q] * 1.44269504089f, mf = fmaxf(am[q], sk); osc = __builtin_amdgcn_exp2f(am[q] - mf); lt = lt * osc + __builtin_amdgcn_exp2f(sk - mf); }
        const float inv = osc / lt;
        char* obase = (char*)F.BR(); const unsigned oo = (unsigned)(qrow0 + q * QRS + n) * 4096u + (unsigned)(brcol0 + q * QCS + 4 * g) * 2u;
#pragma unroll
        for (int t = 0; t < 4; ++t) { const f32x4 v = ao[q][t] * inv; u32x2 o2; o2.x = pk2(v.x, v.y); o2.y = pk2(v.z, v.w); *(u32x2*)(obase + oo + 32u * t) = o2; }
    }
}

template <int DK, bool HG>
__device__ __forceinline__ void prescan_combo(Frame& F, int l, int b, int h, int first, int step) {
    constexpr int NDP = DK / 2, NTG = NTHR / NDP, TPT = 64 / NTG;
    REFRESH(F);
    const int tid = F.tid, dp = tid % NDP, tg = tid / NDP;
    float* TOT = F.smf;
    bf16_t* LRS = (bf16_t*)(F.smf + 2 * 2 * NTG * DK);
    char* p1b = (char*)F.P1();
    f32x2_t lw2[HG ? 1 : 32], lb2[2];
    lb2[0] = (f32x2_t){0.f, 0.f}; lb2[1] = lb2[0]; lw2[0] = lb2[0];
    if (!HG) {
#pragma unroll
        for (int zr = 0; zr < 32; ++zr) { const float* wp = F.p.gla_lr_w + ((size_t)(l * 2 + (zr >> 4)) * 16 + (zr & 15)) * 256 + h * 64 + 2 * dp; lw2[HG ? 0 : zr] = (f32x2_t){wp[0], wp[1]}; }
#pragma unroll
        for (int z = 0; z < 2; ++z) { const float* bp = F.p.gla_lr_b + (l * 2 + z) * 256 + h * 64 + 2 * dp; lb2[z] = (f32x2_t){bp[0], bp[1]}; }
    }
    const int qcol = HG ? PC_DQ + h * 128 + 2 * dp : PC_AQ + h * 64 + 2 * dp, kcol = HG ? PC_DF + h * 128 + 2 * dp : PC_AK + h * 64 + 2 * dp;
    float* ebase = F.ESC() + (HG ? 32 * 68 * 128 : 0);
    unsigned rq[TPT], rk[TPT], rk1[HG ? TPT : 1]; u32x4 rlp = {0u, 0u, 0u, 0u};
    rk1[0] = 0u;
#define PS_LOAD(nbk_) do { const int row0_ = seq_row((nbk_) * 64, b, 0); unsigned o_ = (unsigned)(row0_ + tg * TPT) * (unsigned)(NP1 * 2); \
        _Pragma("unroll") for (int tt = 0; tt < TPT; ++tt) { rq[tt] = *(const unsigned*)(p1b + (o_ + (unsigned)(qcol * 2))); rk[tt] = *(const unsigned*)(p1b + (o_ + (unsigned)(kcol * 2))); \
            if (HG) rk1[HG ? tt : 0] = *(const unsigned*)(p1b + (o_ + (unsigned)((kcol + 512) * 2))); o_ += (unsigned)(NP1 * 2); } \
        if (!HG && tid < 256) rlp = *(const u32x4*)(p1b + ((unsigned)(row0_ + (tid >> 2)) * (unsigned)(NP1 * 2) + (unsigned)((PC_ALR + (tid & 3) * 8) * 2))); } while (0)
    int nbk = first, par = 0;
    if (nbk < 68) PS_LOAD(nbk);
#pragma unroll 1
    for (; nbk < 68; nbk += step, par ^= 1) {
        float* tot = TOT + par * (2 * NTG * DK);
        bf16_t* lrs = LRS + par * (64 * 32);
        if (!HG) { if (tid < 256) *(u32x4*)(lrs + (tid >> 2) * 32 + (tid & 3) * 8) = rlp; __syncthreads(); }
        const int row0 = seq_row(nbk * 64, b, 0);
        f32x2_t qv[TPT], kv0[TPT], kv1[HG ? TPT : 1], cs0[TPT], cs1[TPT];
#pragma unroll
        for (int tt = 0; tt < TPT; ++tt) {
            qv[tt] = (f32x2_t){__uint_as_float(rq[tt] << 16), __uint_as_float(rq[tt] & 0xffff0000u)};
            const f32x2_t kr = {__uint_as_float(rk[tt] << 16), __uint_as_float(rk[tt] & 0xffff0000u)};
            if (HG) { const unsigned r1 = rk1[HG ? tt : 0]; const f32x2_t k1 = {__uint_as_float(r1 << 16), __uint_as_float(r1 & 0xffff0000u)};
                cs0[tt] = kr; cs1[tt] = k1;
                kv0[tt] = (f32x2_t){1.f - __expf(kr.x), 1.f - __expf(kr.y)}; kv1[HG ? tt : 0] = (f32x2_t){1.f - __expf(k1.x), 1.f - __expf(k1.y)}; }
            else kv0[tt] = kr;
        }
        if (nbk + step < 68) PS_LOAD(nbk + step);
        if (!HG) {
#pragma unroll
            for (int tt = 0; tt < TPT; ++tt) {
                const u32x4* lp = (const u32x4*)(lrs + (tg * TPT + tt) * 32);
                f32x2_t lg[2] = {lb2[0], lb2[1]};
#pragma unroll
                for (int z = 0; z < 2; ++z) { const u32x4 a0 = lp[2 * z], a1 = lp[2 * z + 1]; const unsigned u8[8] = {a0.x, a0.y, a0.z, a0.w, a1.x, a1.y, a1.z, a1.w};
#pragma unroll
                    for (int r2 = 0; r2 < 8; ++r2) { const float v0 = __uint_as_float(u8[r2] << 16), v1 = __uint_as_float(u8[r2] & 0xffff0000u);
                        lg[z] += (f32x2_t){v0, v0} * lw2[HG ? 0 : z * 16 + 2 * r2]; lg[z] += (f32x2_t){v1, v1} * lw2[HG ? 0 : z * 16 + 2 * r2 + 1]; } }
#pragma unroll
                for (int z = 0; z < 2; ++z) {
                    const f32x2_t gz = {(fminf(lg[z].x, 0.f) - __logf(1.f + __expf(-fabsf(lg[z].x)))) * (1.f / 16.f), (fminf(lg[z].y, 0.f) - __logf(1.f + __expf(-fabsf(lg[z].y)))) * (1.f / 16.f)};
                    if (z == 0) cs0[tt] = gz; else cs1[tt] = gz; }
            }
        }
#pragma unroll
        for (int tt = 1; tt < TPT; ++tt) { cs0[tt] += cs0[tt - 1]; cs1[TPT - 1 - tt] += cs1[TPT - tt]; }
        *(f32x2_t*)(tot + (0 * NTG + tg) * DK + 2 * dp) = cs0[TPT - 1];
        *(f32x2_t*)(tot + (1 * NTG + tg) * DK + 2 * dp) = cs1[0];
        __syncthreads();
        f32x2_t offs0 = {0.f, 0.f}, mid0 = offs0, last0 = offs0, offs1 = offs0, mid1 = offs0, last1 = offs0;
#pragma unroll
        for (int t2 = 0; t2 < NTG; ++t2) { const f32x2_t v0 = *(const f32x2_t*)(tot + (0 * NTG + t2) * DK + 2 * dp), v1 = *(const f32x2_t*)(tot + (1 * NTG + t2) * DK + 2 * dp);
            if (t2 < tg) offs0 += v0; if (t2 < NTG / 2) mid0 += v0; last0 += v0;
            if (t2 > tg) offs1 += v1; if (t2 >= NTG / 2) mid1 += v1; last1 += v1; }
        const f32x2_t d0 = offs0 - mid0, d1 = offs1 - mid1;
        unsigned ro = (unsigned)(row0 + tg * TPT);
#pragma unroll
        for (int tt = 0; tt < TPT; ++tt, ++ro) {
            const float x00 = fminf(fmaxf(cs0[tt].x + d0.x, -80.f), 80.f), x01 = fminf(fmaxf(cs0[tt].y + d0.y, -80.f), 80.f);
            const float x10 = fminf(fmaxf(cs1[tt].x + d1.x, -80.f), 80.f), x11 = fminf(fmaxf(cs1[tt].y + d1.y, -80.f), 80.f);
            const f32x2_t k1v = kv1[HG ? tt : 0], k1 = HG ? k1v : kv0[tt];
            const unsigned qd0 = pk2(qv[tt].x * __expf(x00), qv[tt].y * __expf(x01)), kd0 = pk2(kv0[tt].x * __expf(-x00), kv0[tt].y * __expf(-x01));
            const unsigned qd1 = pk2(qv[tt].x * __expf(x10), qv[tt].y * __expf(x11)), kd1 = pk2(k1.x * __expf(-x10), k1.y * __expf(-x11));
            const unsigned o_ = ro * (unsigned)(NP1 * 2);
            *(unsigned*)(p1b + (o_ + (unsigned)(qcol * 2))) = qd0; *(unsigned*)(p1b + (o_ + (unsigned)(kcol * 2))) = kd0;
            if (HG) { *(unsigned*)(p1b + (o_ + (unsigned)((kcol + 512) * 2))) = kd1; *(unsigned*)((char*)F.BR() + (ro * 4096u + (unsigned)((1536 + h * 128 + 2 * dp) * 2))) = qd1; }
            else { *(unsigned*)((char*)F.SC1() + (ro * 1024u + (unsigned)((h * 64 + 2 * dp) * 2))) = qd1; *(unsigned*)((char*)F.SC1() + (ro * 1024u + (unsigned)((256 + h * 64 + 2 * dp) * 2))) = kd1; }
        }
        if (tg == 0) {
            float* e0 = ebase + (size_t)(((b * 4 + h) * 2 + 0) * 68 + nbk) * (2 * DK), *e1 = ebase + (size_t)(((b * 4 + h) * 2 + 1) * 68 + (nbk < 4 ? 3 - nbk : 71 - nbk)) * (2 * DK);
            *(f32x2_t*)(e0 + 2 * dp) = (f32x2_t){__expf(mid0.x), __expf(mid0.y)}; *(f32x2_t*)(e0 + DK + 2 * dp) = (f32x2_t){__expf(last0.x - mid0.x), __expf(last0.y - mid0.y)};
            *(f32x2_t*)(e1 + 2 * dp) = (f32x2_t){__expf(mid1.x), __expf(mid1.y)}; *(f32x2_t*)(e1 + DK + 2 * dp) = (f32x2_t){__expf(last1.x - mid1.x), __expf(last1.y - mid1.y)};
        }
    }
    __syncthreads();
#undef PS_LOAD
}
__device__ __forceinline__ void phase_prescan(Frame& F, int l) {
    if (F.nb >= 32) { const int combo = F.bid & 31, b = (combo >> 2) & 3, h = combo & 3;
        if ((combo >> 4) == 0) prescan_combo<64, false>(F, l, b, h, F.bid >> 5, F.nb >> 5); else prescan_combo<128, true>(F, l, b, h, F.bid >> 5, F.nb >> 5);
    } else {
        for (int combo = F.bid; combo < 32; combo += F.nb) { const int b = (combo >> 2) & 3, h = combo & 3;
            if ((combo >> 4) == 0) prescan_combo<64, false>(F, l, b, h, 0, 1); else prescan_combo<128, true>(F, l, b, h, 0, 1); }
    }
}

template <int DK, bool HG>
__device__ __forceinline__ void scan_mfma(Frame& F, int l, int b, int h, int z, int vh, unsigned char* lds) {
    constexpr int NDP = DK / 2, NTG = NTHR / NDP, TPT = 64 / NTG, QS = DK + 8, TS = 72, NDT = DK / 16, PPR = DK / 8, NQP = (64 * PPR) / NTHR;
    bf16_t* QD = (bf16_t*)lds; bf16_t* KD = QD + 64 * QS; bf16_t* KDT = KD + 64 * QS; bf16_t* VTs = KDT + DK * TS; bf16_t* AM = VTs + 64 * TS; bf16_t* ST = AM + 64 * TS;
    float* E1s = (float*)(ST + 64 * QS); float* E2s = E1s + DK;
    REFRESH(F);
    const int tid = F.tid, lane = F.lane, w = F.wave, n = lane & 15, g = lane >> 4;
    const int dp = tid % NDP, tg = tid / NDP, vp = tid & 31, vg = tid >> 5;
    const int vt = w & 3, wh = w >> 2;
    const char* p1b = (const char*)F.P1();
    const char* qb; const char* kb; unsigned qstr, kstr, qoff, koff;
    if (HG) { kb = p1b; kstr = NP1 * 2; koff = (unsigned)((PC_DF + z * 512 + h * 128) * 2);
        if (z == 0) { qb = p1b; qstr = NP1 * 2; qoff = (unsigned)((PC_DQ + h * 128) * 2); } else { qb = (const char*)F.BR(); qstr = 4096u; qoff = (unsigned)((1536 + h * 128) * 2); } }
    else if (z == 0) { qb = p1b; kb = p1b; qstr = kstr = NP1 * 2; qoff = (unsigned)((PC_AQ + h * 64) * 2); koff = (unsigned)((PC_AK + h * 64) * 2); }
    else { qb = (const char*)F.SC1(); kb = qb; qstr = kstr = 1024u; qoff = (unsigned)(h * 64 * 2); koff = (unsigned)((256 + h * 64) * 2); }
    const float* eb = F.ESC() + (HG ? 32 * 68 * 128 : 0) + (size_t)(((b * 4 + h) * 2 + z) * 68) * (2 * DK);
    f32x4 accS[NDT / 2];
#pragma unroll
    for (int i = 0; i < NDT / 2; ++i) accS[i] = (f32x4){0.f, 0.f, 0.f, 0.f};
    u32x4 rqp[NQP]; unsigned rk[TPT], rv[4]; float re = 0.f;
    const int vcol = (HG ? PC_DI : PC_AV) + h * 128 + 64 * vh + 2 * vp;
    const int sgn = z ? -1 : 1; const int rstep = sgn * NP1 * 2;
#define SCAN_LOAD(c) do { const int row0_ = seq_row((c) * 64, b, z); \
        _Pragma("unroll") for (int j = 0; j < NQP; ++j) { const int pi_ = tid + NTHR * j; rqp[j] = *(const u32x4*)(qb + ((unsigned)(row0_ + sgn * (pi_ / PPR)) * qstr + qoff + (unsigned)((pi_ % PPR) * 16))); } \
        _Pragma("unroll") for (int tt = 0; tt < TPT; ++tt) rk[tt] = *(const unsigned*)(kb + ((unsigned)(row0_ + sgn * (tg * TPT + tt)) * kstr + koff + (unsigned)(dp * 4))); \
        int ov_ = (row0_ + sgn * vg * 4) * (NP1 * 2) + vcol * 2; \
        _Pragma("unroll") for (int tt = 0; tt < 4; ++tt) { rv[tt] = *(const unsigned*)(p1b + (unsigned)ov_); ov_ += rstep; } \
        if (tid < 2 * DK) re = eb[(c) * (2 * DK) + tid]; } while (0)
    SCAN_LOAD(0);
    constexpr int NCH = (LC + SEQ) / 64;
#pragma unroll 1
    for (int c = 0; c < NCH; ++c) {
        __syncthreads();
#pragma unroll
        for (int j = 0; j < NQP; ++j) { const int pi_ = tid + NTHR * j; *(u32x4*)(QD + (pi_ / PPR) * QS + (pi_ % PPR) * 8) = rqp[j]; }
#pragma unroll
        for (int tt = 0; tt < TPT; ++tt) *(unsigned*)(KD + (tg * TPT + tt) * QS + 2 * dp) = rk[tt];
        {   unsigned kdt[2][TPT / 2];
#pragma unroll
            for (int t2 = 0; t2 < TPT / 2; ++t2) { kdt[0][t2] = (rk[2 * t2] & 0xffffu) | (rk[2 * t2 + 1] << 16); kdt[1][t2] = (rk[2 * t2] >> 16) | (rk[2 * t2 + 1] & 0xffff0000u); }
#pragma unroll
            for (int e = 0; e < 2; ++e) {
                bf16_t* dst = KDT + (2 * dp + e) * TS + tg * TPT;
                if (TPT == 8) { u32x4 o; o.x = kdt[e][0]; o.y = kdt[e][1]; o.z = kdt[e][TPT / 2 - 2]; o.w = kdt[e][TPT / 2 - 1]; *(u32x4*)dst = o; }
                else { u32x2 o; o.x = kdt[e][0]; o.y = kdt[e][1]; *(u32x2*)dst = o; }
            }
        }
        if (tid < 2 * DK) E1s[tid] = re;
        {   u32x2 o0, o1;
            o0.x = (rv[0] & 0xffffu) | (rv[1] << 16); o0.y = (rv[2] & 0xffffu) | (rv[3] << 16);
            o1.x = (rv[0] >> 16) | (rv[1] & 0xffff0000u); o1.y = (rv[2] >> 16) | (rv[3] & 0xffff0000u);
            *(u32x2*)(VTs + (2 * vp) * TS + vg * 4) = o0; *(u32x2*)(VTs + (2 * vp + 1) * TS + vg * 4) = o1; }
        if (c + 1 < NCH) SCAN_LOAD(c + 1);
        __syncthreads();
#pragma unroll
        for (int i = 0; i < NDT / 2; ++i) { const int dt = wh * (NDT / 2) + i; accS[i] = accS[i] * *(const f32x4*)&E1s[16 * dt + 4 * g];
            u32x2 o; o.x = pk2(accS[i].x, accS[i].y); o.y = pk2(accS[i].z, accS[i].w); *(u32x2*)(ST + (16 * vt + n) * QS + 16 * dt + 4 * g) = o; }
        {   const int it = w >> 1, jt0 = 2 * (w & 1);
            f32x4 d0 = {0.f, 0.f, 0.f, 0.f}, d1 = {0.f, 0.f, 0.f, 0.f};
            if (jt0 <= it) {
                bf16x8_t qf[DK / 32], k0f[DK / 32], k1f[DK / 32];
#pragma unroll
                for (int ks = 0; ks < DK / 32; ++ks) { qf[ks] = *(const bf16x8_t*)(QD + (16 * it + n) * QS + 32 * ks + 8 * g); k0f[ks] = *(const bf16x8_t*)(KD + (16 * jt0 + n) * QS + 32 * ks + 8 * g); k1f[ks] = *(const bf16x8_t*)(KD + (16 * (jt0 + 1) + n) * QS + 32 * ks + 8 * g); }
#pragma unroll
                for (int ks = 0; ks < DK / 32; ++ks) { d0 = __builtin_amdgcn_mfma_f32_16x16x32_bf16(k0f[ks], qf[ks], d0, 0, 0, 0); d1 = __builtin_amdgcn_mfma_f32_16x16x32_bf16(k1f[ks], qf[ks], d1, 0, 0, 0); }
                const int i = 16 * it + n, j0 = 16 * jt0 + 4 * g, j1 = j0 + 16;
                d0.x = (j0 + 0 <= i) ? d0.x : 0.f; d0.y = (j0 + 1 <= i) ? d0.y : 0.f; d0.z = (j0 + 2 <= i) ? d0.z : 0.f; d0.w = (j0 + 3 <= i) ? d0.w : 0.f;
                d1.x = (j1 + 0 <= i) ? d1.x : 0.f; d1.y = (j1 + 1 <= i) ? d1.y : 0.f; d1.z = (j1 + 2 <= i) ? d1.z : 0.f; d1.w = (j1 + 3 <= i) ? d1.w : 0.f;
            }
            u32x2 o; o.x = pk2(d0.x, d0.y); o.y = pk2(d0.z, d0.w); *(u32x2*)(AM + (16 * it + n) * TS + 16 * jt0 + 4 * g) = o;
            o.x = pk2(d1.x, d1.y); o.y = pk2(d1.z, d1.w); *(u32x2*)(AM + (16 * it + n) * TS + 16 * (jt0 + 1) + 4 * g) = o;
        }
        __syncthreads();
        {   f32x4 o[2];
#pragma unroll
            for (int ii = 0; ii < 2; ++ii) o[ii] = (f32x4){0.f, 0.f, 0.f, 0.f};
#pragma unroll
            for (int ks = 0; ks < 2; ++ks) { const bf16x8_t af = *(const bf16x8_t*)(VTs + (16 * vt + n) * TS + 32 * ks + 8 * g); bf16x8_t bf[2];
#pragma unroll
                for (int ii = 0; ii < 2; ++ii) bf[ii] = *(const bf16x8_t*)(AM + (16 * (2 * wh + ii) + n) * TS + 32 * ks + 8 * g);
#pragma unroll
                for (int ii = 0; ii < 2; ++ii) o[ii] = __builtin_amdgcn_mfma_f32_16x16x32_bf16(af, bf[ii], o[ii], 0, 0, 0); }
#pragma unroll
            for (int ks = 0; ks < DK / 32; ++ks) { const bf16x8_t af = *(const bf16x8_t*)(ST + (16 * vt + n) * QS + 32 * ks + 8 * g); bf16x8_t bf[2];
#pragma unroll
                for (int ii = 0; ii < 2; ++ii) bf[ii] = *(const bf16x8_t*)(QD + (16 * (2 * wh + ii) + n) * QS + 32 * ks + 8 * g);
#pragma unroll
                for (int ii = 0; ii < 2; ++ii) o[ii] = __builtin_amdgcn_mfma_f32_16x16x32_bf16(af, bf[ii], o[ii], 0, 0, 0); }
            const int row0 = seq_row(c * 64, b, z) + sgn * (32 * wh + n), vc = h * 128 + 64 * vh + 16 * vt + 4 * g;
            char* dstb; unsigned doff; int dstride;
            if (HG) { dstb = (char*)F.ODH(); doff = (unsigned)row0 * 2048u + (unsigned)(z * 512 + vc) * 2u; dstride = sgn * 16 * 2048; }
            else if (z == 0) { dstb = (char*)F.BR(); doff = (unsigned)row0 * 4096u + (unsigned)vc * 2u; dstride = sgn * 16 * 4096; }
            else { dstb = (char*)F.OBA(); doff = (unsigned)row0 * 1024u + (unsigned)vc * 2u; dstride = sgn * 16 * 1024; }
#pragma unroll
            for (int ii = 0; ii < 2; ++ii) { u32x2 o2; o2.x = pk2(o[ii].x, o[ii].y); o2.y = pk2(o[ii].z, o[ii].w); *(u32x2*)(dstb + (unsigned)((int)doff + ii * dstride)) = o2; }
        }
#pragma unroll
        for (int ks = 0; ks < 2; ++ks) { const bf16x8_t bv = *(const bf16x8_t*)(VTs + (16 * vt + n) * TS + 32 * ks + 8 * g); bf16x8_t af[NDT / 2];
#pragma unroll
            for (int i = 0; i < NDT / 2; ++i) af[i] = *(const bf16x8_t*)(KDT + (16 * (wh * (NDT / 2) + i) + n) * TS + 32 * ks + 8 * g);
#pragma unroll
            for (int i = 0; i < NDT / 2; ++i) accS[i] = __builtin_amdgcn_mfma_f32_16x16x32_bf16(af[i], bv, accS[i], 0, 0, 0); }
#pragma unroll
        for (int i = 0; i < NDT / 2; ++i) accS[i] = accS[i] * *(const f32x4*)&E2s[16 * (wh * (NDT / 2) + i) + 4 * g];
    }
    __syncthreads();
#undef SCAN_LOAD
}

__device__ __forceinline__ void phase_mix(Frame& F, int l) {
    const int n_scan = 128;
    const int nsb = (F.nb > 192) ? 128 : 0;
    if (nsb == 0 || F.bid < nsb) {
        for (int it = F.bid; it < n_scan; it += (nsb ? nsb : F.nb)) {
            const int br = it >> 6, r = (it >> 1) & 31, vh = it & 1, b = r >> 3, h = (r >> 1) & 3, z = r & 1;
            if (br == 0) scan_mfma<64, false>(F, l, b, h, z, vh, (unsigned char*)F.smf); else scan_mfma<128, true>(F, l, b, h, z, vh, (unsigned char*)F.smf);
        }
        __syncthreads();
    }
    float* rpb_s = F.smf;
    for (int i = F.tid; i < 8 * 15 * 64; i += NTHR) { const int dcp = i & 63, hr = i >> 6; rpb_s[i] = (dcp >= 16 && dcp < 47) ? F.p.na_rpb[(size_t)l * 8 * 465 + hr * 31 + (dcp - 16)] * 1.44269504089f : 0.f; }
    bf16_t* sbuf = (bf16_t*)(F.smf + 8 * 15 * 64);
    unsigned* qhead = F.cnt() + 64 + l * 16;
    int* cur = (int*)((unsigned char*)F.smf - LDS_STAGE + 32);
    const int n_wa = 512, n_na = 512, n_cna = (l == 0) ? 32 : 0, n_cwa = (l == 0) ? 32 : 0, total = n_wa + n_na + n_cna + n_cwa;
    for (;;) {
        __syncthreads();
        if (F.tid == 0) *cur = (int)atomicAdd(qhead, 1u);
        __syncthreads();
        const int it = *cur;
        if (it >= total) break;
        if (it < n_wa) attn_block<1>(F, l, it, rpb_s, sbuf);
        else if (it < n_wa + n_na) attn_block<0>(F, l, it - n_wa, rpb_s, sbuf);
        else if (it < n_wa + n_na + n_cna) attn_block<2>(F, l, it - n_wa - n_na, rpb_s, sbuf);
        else attn_block<3>(F, l, it - n_wa - n_na - n_cna, rpb_s, sbuf);
    }
}

__device__ __forceinline__ void phase_prepad(Frame& F, int l) {
    const int gw = F.bid * 8 + F.wave, ngw = F.nb * 8, npairs = ((l == 0) ? NROW : NTOK) / 2, c0 = F.lane * 8;
    for (int pi = gw; pi < npairs; pi += ngw) {
        u32x4 ra[2][2], rb[2][2], rg[2][2];
#pragma unroll
        for (int q = 0; q < 2; ++q) { const size_t row = (size_t)pi * 2 + q;
            ra[q][0] = *(const u32x4*)(F.BR() + row * 2048 + c0); rb[q][0] = *(const u32x4*)(F.OBA() + row * 512 + c0); rg[q][0] = *(const u32x4*)(F.P1() + row * NP1 + PC_AG + c0);
            ra[q][1] = *(const u32x4*)(F.ODH() + row * 1024 + c0); rb[q][1] = *(const u32x4*)(F.ODH() + row * 1024 + 512 + c0); rg[q][1] = *(const u32x4*)(F.P1() + row * NP1 + PC_DG + c0); }
#pragma unroll
        for (int q = 0; q < 2; ++q)
#pragma unroll
            for (int br = 0; br < 2; ++br) {
                const unsigned ua[4] = {ra[q][br].x, ra[q][br].y, ra[q][br].z, ra[q][br].w}, ub[4] = {rb[q][br].x, rb[q][br].y, rb[q][br].z, rb[q][br].w}, ug[4] = {rg[q][br].x, rg[q][br].y, rg[q][br].z, rg[q][br].w};
                float o[8], g[8]; float ss = 0.f;
#pragma unroll
                for (int j = 0; j < 4; ++j) { o[2 * j] = __uint_as_float(ua[j] << 16) + __uint_as_float(ub[j] << 16); o[2 * j + 1] = __uint_as_float(ua[j] & 0xffff0000u) + __uint_as_float(ub[j] & 0xffff0000u);
                    g[2 * j] = __uint_as_float(ug[j] << 16); g[2 * j + 1] = __uint_as_float(ug[j] & 0xffff0000u); ss += o[2 * j] * o[2 * j] + o[2 * j + 1] * o[2 * j + 1]; }
                ss += __shfl_xor(ss, 1); ss += __shfl_xor(ss, 2); ss += __shfl_xor(ss, 4); ss += __shfl_xor(ss, 8);
                const float rs = rsqrtf(ss * (1.f / 128.f) + 1e-6f);
#pragma unroll
                for (int j = 0; j < 8; ++j) o[j] = o[j] * rs * siluf_(g[j]);
                st8(F.BR() + ((size_t)pi * 2 + q) * 2048 + (br ? 1536 : 0) + c0, o);
            }
    }
}

__device__ __forceinline__ void phase_ln1(Frame& F, int l) {
    const int nrows = (l == 0) ? NROW : NTOK, ngroups = nrows / 64;
    const float* lg = F.p.ln_g + (size_t)(l * 2 + 0) * DM; const float* lbb = F.p.ln_b + (size_t)(l * 2 + 0) * DM;
    float* part = F.smf;
    const int wv = __builtin_amdgcn_readfirstlane(F.wave);
    float* stg = F.smf + 8 * 36 * 64 + wv * (64 * 17 + 16 * 40);
    float* wl = stg + 64 * 17;
    for (int grp = F.bid; grp < ngroups; grp += F.nb) {
        const int row0 = grp * 64, rb = row_batch(row0);
        const float* mv = F.modv() + ((size_t)l * 5 + rb) * 6144;
        float* xg = row0 < NTOK ? F.p.out + (size_t)row0 * DM : F.cxm() + (size_t)(row0 - NTOK) * DM;
#pragma unroll 1
        for (int rr = 0; rr < 8; rr += 2) {
            const int lr = wv * 8 + rr; float* xr = xg + (size_t)lr * DM;
            f32x4 v[2][4]; float s[2] = {0.f, 0.f};
#pragma unroll
            for (int q = 0; q < 2; ++q)
#pragma unroll
                for (int j = 0; j < 4; ++j) v[q][j] = *(const f32x4*)(xr + (size_t)q * DM + j * 256 + F.lane * 4);
#pragma unroll
            for (int q = 0; q < 2; ++q)
#pragma unroll
                for (int j = 0; j < 4; ++j) s[q] += (v[q][j].x + v[q][j].y) + (v[q][j].z + v[q][j].w);
#pragma unroll
            for (int o = 1; o < 64; o <<= 1) { s[0] += __shfl_xor(s[0], o); s[1] += __shfl_xor(s[1], o); }
            float s2[2] = {0.f, 0.f};
#pragma unroll
            for (int q = 0; q < 2; ++q) { const float mean = s[q] * (1.f / DM);
#pragma unroll
                for (int j = 0; j < 4; ++j) { v[q][j] = v[q][j] - mean; s2[q] += (v[q][j].x * v[q][j].x + v[q][j].y * v[q][j].y) + (v[q][j].z * v[q][j].z + v[q][j].w * v[q][j].w); } }
#pragma unroll
            for (int o = 1; o < 64; o <<= 1) { s2[0] += __shfl_xor(s2[0], o); s2[1] += __shfl_xor(s2[1], o); }
#pragma unroll
            for (int j = 0; j < 4; ++j) { const int d = j * 256 + F.lane * 4;
                const f32x4 g4 = *(const f32x4*)(lg + d), b4 = *(const f32x4*)(lbb + d), m3 = *(const f32x4*)(mv + 3 * 1024 + d), m4 = *(const f32x4*)(mv + 4 * 1024 + d);
#pragma unroll
                for (int q = 0; q < 2; ++q) { const float rstd = rsqrtf(s2[q] * (1.f / DM) + LN_EPS);
                    const f32x4 xn = v[q][j] * rstd * g4 + b4;
                    *(f32x4*)(xr + (size_t)q * DM + d) = xn;
                    const f32x4 h2 = xn * (1.f + m4) + m3;
                    u32x2 o2; o2.x = pk2(h2.x, h2.y); o2.y = pk2(h2.z, h2.w);
                    *(u32x2*)(F.HX2() + (size_t)(row0 + lr + q) * DM + d) = o2; } }
        }
        __syncthreads();
        {   f32x4 acc[4][3];
#pragma unroll
            for (int mt = 0; mt < 4; ++mt)
#pragma unroll
                for (int nt = 0; nt < 3; ++nt) acc[mt][nt] = (f32x4){0.f, 0.f, 0.f, 0.f};
            const float* wgp = F.p.moe_w_group + ((size_t)l * DM + wv * 128) * 4; const float* wep = F.p.moe_w_expert + ((size_t)l * DM + wv * 128) * 32;
            const float* m3p = mv + 3 * 1024 + wv * 128; const float* m4p = mv + 4 * 1024 + wv * 128;
            const int ln = F.lane & 15, lk = F.lane >> 4;
#pragma unroll 1
            for (int dc = 0; dc < 128; dc += 16) {
                f32x4 t[4]; float bw[4][3];
#pragma unroll
                for (int i = 0; i < 4; ++i) t[i] = *(const f32x4*)(xg + (size_t)(16 * i + (F.lane >> 2)) * DM + wv * 128 + dc + (F.lane & 3) * 4);
                const f32x4 m3v = *(const f32x4*)(m3p + dc + (F.lane & 3) * 4), m4v = *(const f32x4*)(m4p + dc + (F.lane & 3) * 4);
#pragma unroll
                for (int ks = 0; ks < 4; ++ks) { const int d = dc + 4 * ks + lk; bw[ks][0] = wep[(size_t)d * 32 + ln]; bw[ks][1] = wep[(size_t)d * 32 + 16 + ln]; bw[ks][2] = (ln < 4) ? wgp[(size_t)d * 4 + ln] : 0.f; }
#pragma unroll
                for (int i = 0; i < 4; ++i) { float* sp = stg + (16 * i + (F.lane >> 2)) * 17 + (F.lane & 3) * 4;
                    sp[0] = t[i].x * (1.f + m4v.x) + m3v.x; sp[1] = t[i].y * (1.f + m4v.y) + m3v.y; sp[2] = t[i].z * (1.f + m4v.z) + m3v.z; sp[3] = t[i].w * (1.f + m4v.w) + m3v.w; }
                asm volatile("s_waitcnt lgkmcnt(0)" ::: "memory");
#pragma unroll
                for (int ks = 0; ks < 4; ++ks)
#pragma unroll
                    for (int mt = 0; mt < 4; ++mt) { const float av = stg[(16 * mt + ln) * 17 + 4 * ks + lk];
#pragma unroll
                        for (int nt = 0; nt < 3; ++nt) acc[mt][nt] = __builtin_amdgcn_mfma_f32_16x16x4f32(av, bw[ks][nt], acc[mt][nt], 0, 0, 0); }
                asm volatile("s_waitcnt lgkmcnt(0)" ::: "memory");
            }
#pragma unroll
            for (int mt = 0; mt < 4; ++mt)
#pragma unroll
                for (int nt = 0; nt < 3; ++nt) { const int oi = (nt == 2) ? ln : 4 + 16 * nt + ln;
                    if (nt < 2 || ln < 4) {
#pragma unroll
                        for (int r = 0; r < 4; ++r) part[(wv * 36 + oi) * 64 + 16 * mt + 4 * lk + r] = acc[mt][nt][r]; } }
        }
        __syncthreads();
        if (wv == 0) {
            const int row = row0 + F.lane;
            float gl[4]; int gi = 0; float gm = -3.4e38f;
#pragma unroll
            for (int o = 0; o < 4; ++o) { float t = F.p.moe_b_group[l * 4 + o];
#pragma unroll
                for (int w2 = 0; w2 < 8; ++w2) t += part[(w2 * 36 + o) * 64 + F.lane];
                gl[o] = t; if (t > gm) { gm = t; gi = o; } }
            float gs = 0.f;
#pragma unroll
            for (int o = 0; o < 4; ++o) gs += expf(gl[o] - gm);
            const float gwt = 1.f / gs;
            float e1 = -3.4e38f, e2 = -3.4e38f; int i1 = 0, i2 = 0;
#pragma unroll
            for (int o8 = 0; o8 < 8; ++o8) { const int o = gi * 8 + o8; float ev = F.p.moe_b_expert[l * 32 + o];
#pragma unroll
                for (int w2 = 0; w2 < 8; ++w2) ev += part[(w2 * 36 + 4 + o) * 64 + F.lane];
                if (ev > e1) { e2 = e1; i2 = i1; e1 = ev; i1 = o; } else if (ev > e2) { e2 = ev; i2 = o; } }
            const float w1 = 1.f / (1.f + expf(e2 - e1)), w2v = 1.f - w1;
            unsigned* lh = (unsigned*)(stg + 64 * 17 + 16 * 40 - 64);
            if (F.lane < 32) lh[F.lane] = 0u;
            asm volatile("s_waitcnt lgkmcnt(0)" ::: "memory");
            const unsigned r1 = atomicAdd(&lh[i1], 1u), r2 = atomicAdd(&lh[i2], 1u);
            asm volatile("s_waitcnt lgkmcnt(0)" ::: "memory");
            if (F.lane < 32) { const unsigned c = lh[F.lane]; lh[32 + F.lane] = c ? atomicAdd(&F.cnt()[l * 32 + F.lane], c) : 0u; }
            asm volatile("s_waitcnt vmcnt(0) lgkmcnt(0)" ::: "memory");
            const unsigned p1 = lh[32 + i1] + r1, p2 = lh[32 + i2] + r2;
            F.tokE()[row * 2] = i1; F.tokI()[row * 2] = (int)p1; F.tokW()[row * 2] = gwt * w1;
            F.tokE()[row * 2 + 1] = i2; F.tokI()[row * 2 + 1] = (int)p2; F.tokW()[row * 2 + 1] = gwt * w2v;
        }
        __syncthreads();
    }
}

__device__ __forceinline__ void phase_gather(Frame& F, int l) {
    int* off = (int*)F.smf; moe_offsets(F, l, off);
    const int gw = F.bid * 8 + F.wave, ngw = F.nb * 8, nrows = (l == 0) ? NROW : NTOK;
    for (int s0 = gw; s0 < 2 * nrows; s0 += 4 * ngw) {
        int sl[4], e[4], ti[4]; float tw[4]; u32x4 a0[4], a1[4];
#pragma unroll
        for (int q = 0; q < 4; ++q) { sl[q] = min(s0 + q * ngw, 2 * nrows - 1); e[q] = F.tokE()[sl[q]]; ti[q] = F.tokI()[sl[q]]; tw[q] = F.tokW()[sl[q]];
            const u32x4* src = (const u32x4*)(F.HX2() + (size_t)(sl[q] >> 1) * DM); a0[q] = src[F.lane]; a1[q] = src[F.lane + 64]; }
#pragma unroll
        for (int q = 0; q < 4; ++q) if (s0 + q * ngw < 2 * nrows) { const int dst = off[e[q]] + ti[q]; u32x4* d = (u32x4*)(F.XS() + (size_t)dst * DM);
            d[F.lane] = a0[q]; d[F.lane + 64] = a1[q];
            if (F.lane == 0) { F.rmap()[dst] = sl[q]; F.roww()[dst] = tw[q]; } }
    }
    for (int e = 0; e < 32; ++e) {
        const int c = (int)F.cnt()[l * 32 + e], pc = (c + 255) & ~255;
        for (int j = c + gw; j < pc; j += ngw) { const int dst = off[e] + j; u32x4* d = (u32x4*)(F.XS() + (size_t)dst * DM);
            const u32x4 z = {0u, 0u, 0u, 0u}; d[F.lane] = z; d[F.lane + 64] = z;
            if (F.lane == 0) { F.rmap()[dst] = -1; F.roww()[dst] = 0.f; } }
    }
}
__device__ __forceinline__ int expert_of_row(const int* off, int row) { int e = 0;
#pragma unroll 1
    for (int i = 1; i < 32; ++i) if (row >= off[i]) e = i;
    return e; }

__device__ __forceinline__ void phase_ln2(Frame& F, int l) {
    const int gw = F.bid * 8 + F.wave, ngw = F.nb * 8, npairs = ((l == 0) ? NROW : NTOK) / 2;
    const float* lg = F.p.ln_g + (size_t)(l * 2 + 1) * DM; const float* lbb = F.p.ln_b + (size_t)(l * 2 + 1) * DM;
    const bf16_t* Y = F.BR();
    const bool tmo_set = (l == DEPTH - 1) && (__hip_atomic_load((unsigned*)(F.ws + WS_CTL) + XB_TMO, __ATOMIC_RELAXED, __HIP_MEMORY_SCOPE_AGENT) != 0u);
    for (int pi = gw; pi < npairs; pi += ngw) {
        const int row0 = pi * 2, rb = row_batch(row0);
        const float* xm = row0 < NTOK ? F.p.out + (size_t)row0 * DM : F.cxm() + (size_t)(row0 - NTOK) * DM;
        float* xo = row0 < NTOK ? F.p.out + (size_t)row0 * DM : F.cxo() + (size_t)(row0 - NTOK) * DM;
        const float* mv = F.modv() + ((size_t)l * 5 + rb) * 6144;
        u32x2 y0[2][4], y1[2][4]; f32x4 xv[2][4], m5[4];
#pragma unroll
        for (int j = 0; j < 4; ++j) { const int d = j * 256 + F.lane * 4; m5[j] = *(const f32x4*)(mv + 5 * 1024 + d);
#pragma unroll
            for (int q = 0; q < 2; ++q) { y0[q][j] = *(const u32x2*)(Y + (size_t)((row0 + q) * 2) * DM + d); y1[q][j] = *(const u32x2*)(Y + (size_t)((row0 + q) * 2 + 1) * DM + d); xv[q][j] = *(const f32x4*)(xm + (size_t)q * DM + d); } }
        f32x4 v[2][4]; float s[2] = {0.f, 0.f};
#pragma unroll
        for (int q = 0; q < 2; ++q)
#pragma unroll
            for (int j = 0; j < 4; ++j) { f32x4 y; y.x = __uint_as_float(y0[q][j].x << 16) + __uint_as_float(y1[q][j].x << 16); y.y = __uint_as_float(y0[q][j].x & 0xffff0000u) + __uint_as_float(y1[q][j].x & 0xffff0000u);
                y.z = __uint_as_float(y0[q][j].y << 16) + __uint_as_float(y1[q][j].y << 16); y.w = __uint_as_float(y0[q][j].y & 0xffff0000u) + __uint_as_float(y1[q][j].y & 0xffff0000u);
                v[q][j] = ALPHA * xv[q][j] + m5[j] * y; s[q] += (v[q][j].x + v[q][j].y) + (v[q][j].z + v[q][j].w); }
#pragma unroll
        for (int o = 1; o < 64; o <<= 1) { s[0] += __shfl_xor(s[0], o); s[1] += __shfl_xor(s[1], o); }
        float s2[2] = {0.f, 0.f};
#pragma unroll
        for (int q = 0; q < 2; ++q) { const float mean = s[q] * (1.f / DM);
#pragma unroll
            for (int j = 0; j < 4; ++j) { v[q][j] = v[q][j] - mean; s2[q] += (v[q][j].x * v[q][j].x + v[q][j].y * v[q][j].y) + (v[q][j].z * v[q][j].z + v[q][j].w * v[q][j].w); } }
#pragma unroll
        for (int o = 1; o < 64; o <<= 1) { s2[0] += __shfl_xor(s2[0], o); s2[1] += __shfl_xor(s2[1], o); }
        const float* mn = F.modv() + ((size_t)((l + 1 < DEPTH) ? l + 1 : l) * 5 + rb) * 6144;
#pragma unroll
        for (int j = 0; j < 4; ++j) { const int d = j * 256 + F.lane * 4;
            const f32x4 g4 = *(const f32x4*)(lg + d), b4 = *(const f32x4*)(lbb + d), m0 = *(const f32x4*)(mn + d), m1 = *(const f32x4*)(mn + 1024 + d);
#pragma unroll
            for (int q = 0; q < 2; ++q) { const float rstd = rsqrtf(s2[q] * (1.f / DM) + LN_EPS);
                f32x4 xn = v[q][j] * rstd * g4 + b4;
                if (tmo_set) xn = xn * __uint_as_float(0x7fc00000u);
                *(f32x4*)(xo + (size_t)q * DM + d) = xn;
                if (l + 1 < DEPTH) { const f32x4 h = xn * (1.f + m1) + m0; u32x2 o2; o2.x = pk2(h.x, h.y); o2.y = pk2(h.z, h.w); *(u32x2*)(F.HX() + (size_t)(row0 + q) * DM + d) = o2; } }
        }
    }
}

constexpr int NPL = 13, NPH = 1 + DEPTH * NPL;
__global__ void __launch_bounds__(NTHR, 2) mega(Params p) {
    extern __shared__ __attribute__((aligned(16))) unsigned char smem[];
    Frame F; F.p = p; F.bid = blockIdx.x; F.nb = gridDim.x; F.tid = threadIdx.x; F.lane = threadIdx.x & 63; F.wave = threadIdx.x >> 6; F.wid_s = __builtin_amdgcn_readfirstlane(threadIdx.x >> 6);
    F.smf = (float*)(smem + LDS_STAGE);
    LAS unsigned char* stage = (LAS unsigned char*)smem + LDS_STAGE; int* offt = (int*)(smem + 64);
    unsigned char* ws = p.ws; F.ws = ws;

    if (threadIdx.x == 0) *(uint4*)smem = make_uint4(0u, 0u, 0u, 0u);
    __syncthreads();
    unsigned* barw = (unsigned*)(ws + WS_CTL);
    XcdBarrier bar; bar.bar = barw; bar.x = 0; bar.st = (volatile LAS unsigned*)smem;
    const bool multi = (p.ph_hi - p.ph_lo) > 1;
    if (multi) bar = xcd_barrier_post(barw, (volatile LAS unsigned*)smem);
    const int lo = p.ph_lo, hi = p.ph_hi;
#define IN(k) (lo <= (k) && (k) < hi)
#define SEAM(k) do { if (IN(k) && IN((k) + 1)) xcd_barrier(bar); else __syncthreads(); } while (0)

    if (IN(0)) { REFRESH(F); phase_mod(F); __syncthreads(); phase_conv_a(F, 0); }
    SEAM(0);
#pragma unroll 1
    for (int l = 0; l < DEPTH; ++l) {
        const int pb = 1 + l * NPL;
        const float* xlat = (l == 0) ? p.x : p.out; const float* xctx = (l == 0) ? p.ctx : F.cxo();
        const int Mrows = (l == 0) ? NROW : NTOK;
        if (IN(pb + 0)) { REFRESH(F); if (l == 0) phase_prep(F, 0, p.x, p.ctx); else phase_conv_a(F, l); }
        SEAM(pb + 0);
        if (IN(pb + 1)) { REFRESH(F);
            float* rtab = (float*)(smem + LDS_ROPE);
            for (int e = F.tid; e < 1024; e += NTHR) { const int pp = e >> 4, i = e & 15; const float inv = powf(10000.f, -(float)i / 16.f), ang = (float)pp * inv; rtab[2 * e] = cosf(ang); rtab[2 * e + 1] = sinf(ang); }
            __syncthreads();
            pg::SchedG1 S{(const char*)F.HX(), (const char*)F.W1t(), (const char*)F.Wvt(), F.nb, F.bid}; pg::EpiG1 E{F.P1(), F.VT(), rtab, F.lb(), l};
            pg::gemm_phase(stage, DM, DM, DM, S, E);
        }
        SEAM(pb + 1);
        if (IN(pb + 2)) { REFRESH(F); phase_prescan(F, l); }
        SEAM(pb + 2);
        if (IN(pb + 3)) { REFRESH(F); phase_mix(F, l); }
        SEAM(pb + 3);
        if (IN(pb + 4)) { REFRESH(F); phase_prepad(F, l); }
        SEAM(pb + 4);
        if (IN(pb + 5)) { REFRESH(F);
            pg::SchedStatic S{(const char*)F.HX(), (const char*)F.Wgt(), (size_t)256 * DM * 2, (size_t)256 * DM * 2, Mrows / 256, NGATE / 256, F.nb, F.bid}; pg::EpiGate E{F.G()};
            pg::gemm_phase(stage, DM, DM, DM, S, E);
            __syncthreads();
            phase_conv_b(F, l);
        }
        SEAM(pb + 5);
        if (IN(pb + 6)) { REFRESH(F);
            pg::SchedMerge S{(const char*)F.BR(), (const char*)F.Wbrt(), (Mrows / 256) * 4, F.nb, F.bid}; pg::EpiMerge E{F.G(), F.HX()};
            pg::gemm_phase(stage, 2048, 512, 512, S, E);
        }
        SEAM(pb + 6);
        if (IN(pb + 7)) { REFRESH(F);
            pg::SchedStatic S{(const char*)F.HX(), (const char*)F.Woutt(), (size_t)256 * DM * 2, (size_t)256 * DM * 2, Mrows / 256, DM / 256, F.nb, F.bid};
            pg::EpiWout E{xlat, xctx, p.out, F.cxm(), F.modv() + (size_t)l * 5 * 6144};
            pg::gemm_phase(stage, DM, DM, DM, S, E);
        }
        SEAM(pb + 7);
        if (IN(pb + 8)) { REFRESH(F); phase_ln1(F, l); }
        SEAM(pb + 8);
        if (IN(pb + 9)) { REFRESH(F); phase_gather(F, l); }
        SEAM(pb + 9);
        if (IN(pb + 10)) { REFRESH(F);
            moe_offsets(F, l, offt);
            pg::SchedMoe S{(const char*)F.XS(), (const char*)F.Wgu(), offt, (size_t)256 * DM * 2, (size_t)512 * DM * 2, (size_t)256 * DM * 2, offt[32] / 256, 2, F.nb, F.bid};
            pg::EpiMoe1 E{F.HID(), F.roww()};
            pg::gemm_phase(stage, DM, DM, DM, S, E);
        }
        SEAM(pb + 10);
        if (IN(pb + 11)) { REFRESH(F);
            moe_offsets(F, l, offt);
            pg::SchedMoe S{(const char*)F.HID(), (const char*)F.Wd(), offt, (size_t)256 * 256 * 2, (size_t)DM * 256 * 2, (size_t)256 * 256 * 2, offt[32] / 256, 4, F.nb, F.bid};
            pg::EpiMoe2 E{F.BR(), F.rmap(), (bf16_t*)(F.ws + WS_DUMP)};
            pg::gemm_phase(stage, 256, 256, 256, S, E);
        }
        SEAM(pb + 11);
        if (IN(pb + 12)) { REFRESH(F); phase_ln2(F, l); }
        SEAM(pb + 12);
    }
#undef IN
#undef SEAM
}

extern "C" void kernel_launch(void* const* d_in, const int* in_sizes, int n_in, void* d_out, int out_size, void* d_ws, size_t ws_size, hipStream_t stream) {
    static int grid = 0;
    if (grid == 0) {
        if (n_in != 23 || out_size != NTOK * DM || ws_size < WS_END) { fprintf(stderr, "kernel_launch: unexpected shapes (n_in %d out %d ws %zu need %zu)\n", n_in, out_size, ws_size, (size_t)WS_END); grid = -1; return; }
        int dev = 0, cus = 0;
        if (hipGetDevice(&dev) != hipSuccess || hipDeviceGetAttribute(&cus, hipDeviceAttributeMultiprocessorCount, dev) != hipSuccess) { grid = -1; return; }
        if (hipFuncSetAttribute((const void*)mega, hipFuncAttributeMaxDynamicSharedMemorySize, LDS_BYTES) != hipSuccess) { fprintf(stderr, "kernel_launch: hipFuncSetAttribute failed\n"); grid = -1; return; }
        int per_cu = 0;
        if (hipOccupancyMaxActiveBlocksPerMultiprocessor(&per_cu, (const void*)mega, NTHR, LDS_BYTES) != hipSuccess || per_cu < 1) fprintf(stderr, "kernel_launch: occupancy query reports %d blocks per CU\n", per_cu);
        (void)hipGetLastError();
        grid = cus >= 32 ? (cus & ~31) : cus;
    }
    if (grid < 0) return;
    (void)hipMemsetAsync((char*)d_ws + WS_CTL, 0, CTL_BYTES, stream);
    Params p; memset(&p, 0, sizeof(p));
    const float** pp = (const float**)&p;
    for (int i = 0; i < 23; ++i) pp[i] = (const float*)d_in[i];
    p.out = (float*)d_out; p.ws = (unsigned char*)d_ws;
    p.ph_lo = 0; p.ph_hi = NPH;
    hipLaunchKernelGGL(mega, dim3(grid), dim3(NTHR), LDS_BYTES, stream, p);
}
```

```cpp
#include <hip/hip_runtime.h>
#include <cstdio>
#include <cstdint>
#include <cstring>

typedef unsigned short bf16_t;
typedef float f32x4 __attribute__((ext_vector_type(4)));
typedef unsigned u32x4 __attribute__((ext_vector_type(4)));
typedef unsigned u32x2 __attribute__((ext_vector_type(2)));

constexpr int NB = 4, SEQ = 4096, LC = 256, DM = 1024, DEPTH = 2;
constexpr int NTOK = NB * SEQ, NCTX = NB * LC, NROW = NTOK + NCTX;
constexpr int DIN = 10528;
constexpr int O_AQ = 0, O_AK = 256, O_AV = 512, O_AG = 1024, O_ALR = 1536, O_BQ = 1568, O_BK = 2080, O_BV = 2592, O_CQ = 3104, O_CK = 3616,
              O_CV = 3744, O_DQ = 3872, O_DF = 4384, O_DI = 5408, O_DG = 5920, O_GATE = 6432;
constexpr int PC_AQ = 0, PC_AK = 256, PC_AV = 512, PC_BQ = 1024, PC_BK = 1536, PC_CQ = 2048, PC_CK = 2560, PC_ALR = 2688, PC_DQ = 2816,
              PC_DF = 3328, PC_DI = 4352, PC_AG = 4864, PC_DG = 5376, NP1 = 5888;
constexpr float QSCALE = 0.125f * 1.44269504089f;
constexpr int NVT = 768;
constexpr int NGATE = 4096;
constexpr int XS_ROWS = 43008;
constexpr float LN_EPS = 1e-5f;
constexpr float ALPHA = 1.41421356237f;

constexpr size_t al256(size_t x) { return (x + 255) & ~(size_t)255; }
constexpr size_t WS_CTL = 0;
constexpr size_t CTL_BYTES = 32768;
constexpr size_t CTL_CNT = 28672;
constexpr size_t WS_DUMP = WS_CTL + CTL_BYTES;
constexpr size_t WS_MODV = WS_DUMP + 4096;
constexpr size_t WS_LB = WS_MODV + al256((size_t)DEPTH * 5 * 6144 * 4);
constexpr size_t WS_TOKE = WS_LB + 4096;
constexpr size_t WS_TOKI = WS_TOKE + al256((size_t)2 * NROW * 4);
constexpr size_t WS_TOKW = WS_TOKI + al256((size_t)2 * NROW * 4);
constexpr size_t WS_RMAP = WS_TOKW + al256((size_t)2 * NROW * 4);
constexpr size_t WS_ROWW = WS_RMAP + al256((size_t)XS_ROWS * 4);
constexpr size_t WS_CXM = WS_ROWW + al256((size_t)XS_ROWS * 4);
constexpr size_t WS_CXO = WS_CXM + (size_t)NCTX * DM * 4;
constexpr size_t WS_WTA = WS_CXO + (size_t)NCTX * DM * 4;
constexpr size_t WTA_W1 = 0;
constexpr size_t WTA_WV = WTA_W1 + (size_t)NP1 * DM * 2;
constexpr size_t WTA_WBR = WTA_WV + (size_t)NVT * DM * 2;
constexpr size_t WTA_WO = WTA_WBR + (size_t)4 * DM * 512 * 2;
constexpr size_t WTA_WG = WTA_WO + (size_t)DM * DM * 2;
constexpr size_t WTA_BYTES = WTA_WG + (size_t)NGATE * DM * 2;
constexpr size_t WS_SC1 = WS_WTA;
static_assert((size_t)NROW * 512 * 2 <= WTA_WG, "scan scratch must fit in front of the gate weights");
constexpr size_t WS_HX = WS_WTA + WTA_BYTES;
constexpr size_t WS_VT = WS_HX + (size_t)NROW * DM * 2;
constexpr size_t WS_OBA = WS_VT + (size_t)NVT * NROW * 2;
constexpr size_t WS_HX2 = WS_VT;
constexpr size_t WS_HID = WS_VT;
constexpr size_t WS_ODH = WS_OBA + (size_t)NROW * 512 * 2;
constexpr size_t WS_BR = WS_ODH + (size_t)NROW * 1024 * 2;
constexpr size_t WS_P1 = WS_BR + (size_t)NROW * 2048 * 2;
constexpr size_t WS_G = WS_P1;
constexpr size_t WS_WGU = WS_P1 + (size_t)NROW * NGATE * 2;
constexpr size_t WS_WD = WS_WGU + (size_t)32 * 512 * DM * 2;
constexpr size_t WS_XS = WS_P1;
constexpr size_t WS_ESC = WS_P1 + (size_t)NROW * NP1 * 2;
constexpr size_t WS_END = WS_ESC + (size_t)32 * 68 * 384 * 4;
static_assert(WS_WD + (size_t)32 * DM * 256 * 2 <= WS_ESC, "moe weights must fit in the P1 tail");
static_assert((size_t)XS_ROWS * DM * 2 <= (size_t)NROW * NGATE * 2, "XS must fit in the G region");
static_assert((size_t)NVT * NROW * 2 + (size_t)NROW * 512 * 2 >= (size_t)NROW * DM * 2, "HX2 alias");
static_assert(WS_END <= 434800000ull, "workspace budget");

constexpr int NTHR = 512;
constexpr int LDS_STAGE = 1024;
constexpr int LDS_ROPE = 1024 + 131072 + 1024;
constexpr int LDS_BYTES = 144 * 1024;

struct Params {
    const float *x, *c, *ctx, *c_ctx, *w_mod, *b_mod, *w_in, *gla_lr_w, *gla_lr_b, *hg_gamma, *na_rpb, *wa_sink, *w_branch, *w_out, *ln_g, *ln_b,
        *moe_w_group, *moe_b_group, *moe_w_expert, *moe_b_expert, *moe_w_gate, *moe_w_up, *moe_w_down;
    float* out;
    unsigned char* ws;
    int ph_lo, ph_hi;
};

__device__ __forceinline__ float bf2f(bf16_t b) { return __uint_as_float(((unsigned)b) << 16); }
__device__ __forceinline__ bf16_t f2bf(float f) { unsigned u = __float_as_uint(f); u += 0x7FFFu + ((u >> 16) & 1u); return (bf16_t)(u >> 16); }
typedef float f32x2_t __attribute__((ext_vector_type(2)));
typedef __bf16 bf16x2_t __attribute__((ext_vector_type(2)));
__device__ __forceinline__ unsigned pk2(float lo, float hi) {
    const f32x2_t v = {lo, hi}; const bf16x2_t b = __builtin_convertvector(v, bf16x2_t); return __builtin_bit_cast(unsigned, b); }
__device__ __forceinline__ void ld8(const bf16_t* p, float* f) {
    const u32x4 v = *(const u32x4*)p;
    f[0] = __uint_as_float(v.x << 16); f[1] = __uint_as_float(v.x & 0xffff0000u);
    f[2] = __uint_as_float(v.y << 16); f[3] = __uint_as_float(v.y & 0xffff0000u);
    f[4] = __uint_as_float(v.z << 16); f[5] = __uint_as_float(v.z & 0xffff0000u);
    f[6] = __uint_as_float(v.w << 16); f[7] = __uint_as_float(v.w & 0xffff0000u);
}
__device__ __forceinline__ void st8(bf16_t* p, const float* f) {
    u32x4 v; v.x = pk2(f[0], f[1]); v.y = pk2(f[2], f[3]); v.z = pk2(f[4], f[5]); v.w = pk2(f[6], f[7]);
    *(u32x4*)p = v;
}
__device__ __forceinline__ float sigmoidf_(float x) { return __builtin_amdgcn_rcpf(1.f + __expf(-x)); }
__device__ __forceinline__ float siluf_(float x) { return x * __builtin_amdgcn_rcpf(1.f + __expf(-x)); }
__device__ __forceinline__ float wave_sum(float v) {
#pragma unroll
    for (int o = 1; o < 64; o <<= 1) v += __shfl_xor(v, o);
    return v;
}
__device__ __forceinline__ int row_batch(int row) { return row < NTOK ? (row >> 12) : 4; }

#define XB_TMO      128
#define XB_XCNT(j)  (256  + 64 * (j))
#define XB_XSUB(j)  (1280 + 64 * (j))
#define XB_XGEN(j)  (2304 + 64 * (j))
#define XB_TOP      3328
#define XB_TOPGEN   3392
#define XCD_BAR_WORDS 3456
#define XB_SPIN_CAP (1u << 18)
#define LAS __attribute__((address_space(3)))
__device__ __forceinline__ unsigned xb_ld(unsigned* p)              { return __hip_atomic_load(p, __ATOMIC_RELAXED, __HIP_MEMORY_SCOPE_AGENT); }
__device__ __forceinline__ unsigned xb_add(unsigned* p, unsigned v) { return __hip_atomic_fetch_add(p, v, __ATOMIC_RELAXED, __HIP_MEMORY_SCOPE_AGENT); }
__device__ __forceinline__ unsigned xb_xcc_id() { return (unsigned)__builtin_amdgcn_s_getreg((3 << 11) | 20) & 0xFu; }
#define XB_SPIN(cond, bar) do { unsigned _sp = 0; while (cond) { __builtin_amdgcn_s_sleep(1); \
    if ((++_sp & 255u) == 0u) { if (xb_ld(&(bar)[XB_TMO])) break; if (_sp > XB_SPIN_CAP) { atomicAdd(&(bar)[XB_TMO], 1u); break; } } } } while (0)
struct XcdBarrier { unsigned* bar; unsigned x; volatile LAS unsigned* st; };
__device__ __forceinline__ XcdBarrier xcd_barrier_post(unsigned* bar, volatile LAS unsigned* st) {
    XcdBarrier b; b.bar = bar; b.x = xb_xcc_id(); b.st = st;
    if (threadIdx.x == 0) (void)xb_add(&bar[XB_XCNT(b.x)], 1u);
    return b;
}
__device__ __forceinline__ void xcd_barrier_complete(unsigned* bar, unsigned x, unsigned& nloc, unsigned& nx) {
    const unsigned G = gridDim.x * gridDim.y * gridDim.z;
    unsigned sum, cnt, mine, sp = 0u;
    for (;;) {
        sum = 0u; cnt = 0u; mine = 0u;
#pragma unroll
        for (unsigned j = 0; j < 16; ++j) { const unsigned c = xb_ld(&bar[XB_XCNT(j)]); sum += c; cnt += (c > 0u) ? 1u : 0u; mine = (j == x) ? c : mine; }
        if (sum == G) break;
        __builtin_amdgcn_s_sleep(1);
        if ((++sp & 255u) == 0u) { if (xb_ld(&bar[XB_TMO])) break; if (sp > XB_SPIN_CAP) { atomicAdd(&bar[XB_TMO], 1u); break; } }
    }
    nloc = mine > 0u ? mine : 1u; nx = cnt > 0u ? cnt : 1u;
}
__device__ __forceinline__ void xcd_barrier(const XcdBarrier& b) {
    asm volatile("s_waitcnt vmcnt(0)" ::: "memory");
    __syncthreads();
    if (threadIdx.x == 0) {
        unsigned* bar = b.bar;
        __builtin_amdgcn_s_waitcnt(0);
        unsigned nloc = b.st[0], nx = b.st[1];
        if (nloc == 0u) { xcd_barrier_complete(bar, b.x, nloc, nx); b.st[0] = nloc; b.st[1] = nx; }
        const unsigned old = xb_add(&bar[XB_XSUB(b.x)], 1u);
        const unsigned gen = old / nloc;
        if (old + 1u == (gen + 1u) * nloc) {
            __builtin_amdgcn_fence(__ATOMIC_RELEASE, "agent");
            asm volatile("s_waitcnt vmcnt(0)" ::: "memory");
            const unsigned og = xb_add(&bar[XB_TOP], 1u);
            const unsigned tg = og / nx;
            if (og + 1u == (tg + 1u) * nx) xb_add(&bar[XB_TOPGEN], 1u);
            else XB_SPIN(xb_ld(&bar[XB_TOPGEN]) == tg, bar);
            __builtin_amdgcn_fence(__ATOMIC_ACQUIRE, "agent");
            xb_add(&bar[XB_XGEN(b.x)], 1u);
            asm volatile("s_waitcnt vmcnt(0)" ::: "memory");
        } else {
            XB_SPIN(xb_ld(&bar[XB_XGEN(b.x)]) == gen, bar);
            __builtin_amdgcn_fence(__ATOMIC_ACQUIRE, "agent");
            asm volatile("s_waitcnt vmcnt(0)" ::: "memory");
        }
    }
    __syncthreads();
}

struct Frame {
    Params p;
    int bid, nb, tid, lane, wave, wid_s;
    float* smf;
    unsigned char* ws;
    __device__ __forceinline__ float* modv() const { return (float*)(ws + WS_MODV); }
    __device__ __forceinline__ float* lb() const { return (float*)(ws + WS_LB); }
    __device__ __forceinline__ int* tokE() const { return (int*)(ws + WS_TOKE); }
    __device__ __forceinline__ int* tokI() const { return (int*)(ws + WS_TOKI); }
    __device__ __forceinline__ float* tokW() const { return (float*)(ws + WS_TOKW); }
    __device__ __forceinline__ int* rmap() const { return (int*)(ws + WS_RMAP); }
    __device__ __forceinline__ float* roww() const { return (float*)(ws + WS_ROWW); }
    __device__ __forceinline__ float* cxm() const { return (float*)(ws + WS_CXM); }
    __device__ __forceinline__ float* cxo() const { return (float*)(ws + WS_CXO); }
    __device__ __forceinline__ bf16_t* W1t() const { return (bf16_t*)(ws + WS_WTA + WTA_W1); }
    __device__ __forceinline__ bf16_t* Wvt() const { return (bf16_t*)(ws + WS_WTA + WTA_WV); }
    __device__ __forceinline__ bf16_t* Wgt() const { return (bf16_t*)(ws + WS_WTA + WTA_WG); }
    __device__ __forceinline__ bf16_t* Wbrt() const { return (bf16_t*)(ws + WS_WTA + WTA_WBR); }
    __device__ __forceinline__ bf16_t* Woutt() const { return (bf16_t*)(ws + WS_WTA + WTA_WO); }
    __device__ __forceinline__ bf16_t* SC1() const { return (bf16_t*)(ws + WS_SC1); }
    __device__ __forceinline__ float* ESC() const { return (float*)(ws + WS_ESC); }
    __device__ __forceinline__ bf16_t* HX() const { return (bf16_t*)(ws + WS_HX); }
    __device__ __forceinline__ bf16_t* VT() const { return (bf16_t*)(ws + WS_VT); }
    __device__ __forceinline__ bf16_t* OBA() const { return (bf16_t*)(ws + WS_OBA); }
    __device__ __forceinline__ bf16_t* HX2() const { return (bf16_t*)(ws + WS_HX2); }
    __device__ __forceinline__ bf16_t* HID() const { return (bf16_t*)(ws + WS_HID); }
    __device__ __forceinline__ bf16_t* ODH() const { return (bf16_t*)(ws + WS_ODH); }
    __device__ __forceinline__ bf16_t* BR() const { return (bf16_t*)(ws + WS_BR); }
    __device__ __forceinline__ bf16_t* P1() const { return (bf16_t*)(ws + WS_P1); }
    __device__ __forceinline__ bf16_t* G() const { return (bf16_t*)(ws + WS_G); }
    __device__ __forceinline__ bf16_t* Wgu() const { return (bf16_t*)(ws + WS_WGU); }
    __device__ __forceinline__ bf16_t* Wd() const { return (bf16_t*)(ws + WS_WD); }
    __device__ __forceinline__ bf16_t* XS() const { return (bf16_t*)(ws + WS_XS); }
    __device__ __forceinline__ unsigned* cnt() const { return (unsigned*)(ws + WS_CTL + CTL_CNT); }
};


#define REFRESH(F) do { int _t = threadIdx.x; asm volatile("" : "+v"(_t)); (F).tid = _t; (F).lane = _t & 63; (F).wave = _t >> 6; } while (0)

__device__ __forceinline__ void phase_mod(Frame& F) {
    float* sc = F.smf;
    float* red = F.smf + 5 * 1024;
    bool have = false;
    for (int it = F.bid; it < DEPTH * 96; it += F.nb) {
        if (!have) {
            for (int i = F.tid; i < 5 * 1024; i += NTHR) { const float v = (i < 4096) ? F.p.c[i] : F.p.c_ctx[i - 4096]; sc[i] = siluf_(v); }
            __syncthreads(); have = true;
        }
        const int l = it / 96, n0 = (it % 96) * 64, col = F.tid & 63, kg = F.tid >> 6;
        const float* w = F.p.w_mod + (size_t)l * DM * 6144 + n0 + col;
        float a[5] = {0.f, 0.f, 0.f, 0.f, 0.f};
        for (int k = kg * 128; k < kg * 128 + 128; ++k) {
            const float wv = w[(size_t)k * 6144];
#pragma unroll
            for (int r = 0; r < 5; ++r) a[r] += sc[r * 1024 + k] * wv;
        }
#pragma unroll
        for (int r = 0; r < 5; ++r) red[(kg * 5 + r) * 64 + col] = a[r];
        __syncthreads();
        if (F.tid < 320) {
            const int r = F.tid >> 6, cc = F.tid & 63; float s = F.p.b_mod[l * 6144 + n0 + cc];
#pragma unroll
            for (int g = 0; g < 8; ++g) s += red[(g * 5 + r) * 64 + cc];
            F.modv()[((size_t)l * 5 + r) * 6144 + n0 + cc] = s;
        }
        __syncthreads();
    }
    if (F.bid == F.nb - 1) {
        for (int i = F.tid; i < 1024; i += NTHR) { const int z = i >> 9, f = i & 511;
            const float g0 = F.p.hg_gamma[(z * DEPTH + 0) * 512 + f], g1 = F.p.hg_gamma[(z * DEPTH + 1) * 512 + f];
            F.lb()[i] = 1.f / (1.f + expf(g0 - g1)); }
    }
}

__device__ __forceinline__ int p1_src(int n, float& scale) {
    scale = 1.f;
    if (n < 256) { scale = 0.125f; return O_AQ + n; }
    if (n < 512) return O_AK + (n - 256);
    if (n < 1024) return O_AV + (n - 512);
    if (n < 1536) { scale = QSCALE; return O_BQ + (n - 1024); }
    if (n < 2048) return O_BK + (n - 1536);
    if (n < 2560) { scale = QSCALE; return O_CQ + (n - 2048); }
    if (n < 2688) return O_CK + (n - 2560);
    if (n < 2720) return O_ALR + (n - 2688);
    if (n < 2816) return -1;
    if (n < 3328) return O_DQ + (n - 2816);
    if (n < 4352) return O_DF + (n - 3328);
    if (n < 4864) return O_DI + (n - 4352);
    if (n < 5376) return O_AG + (n - 4864);
    return O_DG + (n - 5376);
}
__device__ __forceinline__ void conv_item(const float* src, int ldsrc, int srccol, float scale, bf16_t* dst, int K, int k0, float* scr, int lane, bool perm) {
    if (srccol >= 0) {
#pragma unroll 8
        for (int i = 0; i < 32; ++i) { const int kk = 2 * i + (lane >> 5); scr[kk * 33 + (lane & 31)] = src[(size_t)(k0 + kk) * ldsrc + srccol + (lane & 31)] * scale; }
    } else {
#pragma unroll 8
        for (int i = 0; i < 32; ++i) { const int kk = 2 * i + (lane >> 5); scr[kk * 33 + (lane & 31)] = 0.f; }
    }
    asm volatile("s_waitcnt lgkmcnt(0)" ::: "memory");
    const int c = lane & 7;
#pragma unroll
    for (int j = 0; j < 4; ++j) { const int nn = (lane >> 3) + 8 * j; const float* sp = scr + (8 * c) * 33 + (perm ? (8 * ((nn & 15) >> 2) + 4 * (nn >> 4) + (nn & 3)) : nn);
        u32x4 o; o.x = pk2(sp[0 * 33], sp[1 * 33]); o.y = pk2(sp[2 * 33], sp[3 * 33]); o.z = pk2(sp[4 * 33], sp[5 * 33]); o.w = pk2(sp[6 * 33], sp[7 * 33]);
        *(u32x4*)(dst + (size_t)nn * K + 8 * c) = o; }
    asm volatile("s_waitcnt lgkmcnt(0)" ::: "memory");
}
constexpr int CONVA_W1 = (NP1 / 32) * 16;
constexpr int CONVA_ITEMS = CONVA_W1 + 384 + 2048;
__device__ __forceinline__ void phase_conv_a(Frame& F, int l) {
    float* scr = F.smf + F.wave * (64 * 33);
    const int gw = F.bid * 8 + F.wave, ngw = F.nb * 8;
    for (int it0 = gw; it0 < CONVA_ITEMS; it0 += ngw) {
        int ti = it0;
        if (ti < CONVA_W1) { const int n0 = (ti >> 4) * 32, kt = ti & 15; float sc; const int sx = p1_src(n0, sc);
            conv_item(F.p.w_in + (size_t)l * DM * DIN, DIN, sx, sc, F.W1t() + (size_t)n0 * DM + kt * 64, DM, kt * 64, scr, F.lane, !(n0 >= 2048 && n0 < 2816)); continue; }
        ti -= CONVA_W1;
        if (ti < 384) { const int n0 = (ti >> 4) * 32, kt = ti & 15; const int sx = n0 < 512 ? O_BV + n0 : (n0 < 640 ? O_CV + (n0 - 512) : -1);
            conv_item(F.p.w_in + (size_t)l * DM * DIN, DIN, sx, 1.f, F.Wvt() + (size_t)n0 * DM + kt * 64, DM, kt * 64, scr, F.lane, false); continue; }
        ti -= 384;
        { const int n0 = (ti >> 4) * 32, kt = ti & 15;
          conv_item(F.p.w_in + (size_t)l * DM * DIN, DIN, O_GATE + n0, 1.f, F.Wgt() + (size_t)n0 * DM + kt * 64, DM, kt * 64, scr, F.lane, true); }
    }
}
constexpr int CONVB_ITEMS = 8192 + 4096 + 1024 + 512;
__device__ __forceinline__ void phase_conv_b(Frame& F, int l) {
    float* scr = F.smf + F.wave * (64 * 33);
    const int gw = F.bid * 8 + F.wave, ngw = F.nb * 8;
    for (int it0 = gw; it0 < CONVB_ITEMS; it0 += ngw) {
        int ti = it0;
        if (ti < 8192) { const int e = ti >> 8, r = ti & 255, n0 = (r >> 4) * 32, kt = r & 15, j = n0 >> 8, rr = n0 & 255; const bool isup = rr >= 128; const int cc = 128 * j + (rr & 127);
            const float* src = (isup ? F.p.moe_w_up : F.p.moe_w_gate) + (size_t)(l * 32 + e) * DM * 256;
            conv_item(src, 256, cc, 1.f, F.Wgu() + (size_t)e * 512 * DM + (size_t)n0 * DM + kt * 64, DM, kt * 64, scr, F.lane, true); continue; }
        ti -= 8192;
        if (ti < 4096) { const int e = ti >> 7, r = ti & 127, n0 = (r >> 2) * 32, kt = r & 3;
          conv_item(F.p.moe_w_down + (size_t)(l * 32 + e) * 256 * DM, DM, n0, 1.f, F.Wd() + (size_t)e * DM * 256 + (size_t)n0 * 256 + kt * 64, 256, kt * 64, scr, F.lane, true); continue; }
        ti -= 4096;
        if (ti < 1024) { const int i = ti >> 8, r = ti & 255, n0 = (r >> 3) * 32, kt = r & 7;
            conv_item(F.p.w_branch + (size_t)(l * 4 + i) * 512 * DM, DM, n0, 1.f, F.Wbrt() + (size_t)i * DM * 512 + (size_t)n0 * 512 + kt * 64, 512, kt * 64, scr, F.lane, true); continue; }
        ti -= 1024;
        { const int n0 = (ti >> 4) * 32, kt = ti & 15;
          conv_item(F.p.w_out + (size_t)l * DM * DM, DM, n0, 1.f, F.Woutt() + (size_t)n0 * DM + kt * 64, DM, kt * 64, scr, F.lane, false); }
    }
}

__device__ __forceinline__ void phase_prep(Frame& F, int l, const float* xlat, const float* xctx) {
    const int gw = F.bid * 8 + F.wave, ngw = F.nb * 8;
    for (int row = gw; row < NROW; row += ngw) {
        const float* xr = row < NTOK ? xlat + (size_t)row * DM : xctx + (size_t)(row - NTOK) * DM;
        const float* mv = F.modv() + ((size_t)l * 5 + row_batch(row)) * 6144;
#pragma unroll
        for (int j = 0; j < 4; ++j) { const int d = j * 256 + F.lane * 4;
            const f32x4 v = *(const f32x4*)(xr + d), m0 = *(const f32x4*)(mv + d), m1 = *(const f32x4*)(mv + 1024 + d);
            u32x2 o; o.x = pk2(v.x * (1.f + m1.x) + m0.x, v.y * (1.f + m1.y) + m0.y); o.y = pk2(v.z * (1.f + m1.z) + m0.z, v.w * (1.f + m1.w) + m0.w);
            *(u32x2*)(F.HX() + (size_t)row * DM + d) = o; }
    }
}


namespace pg {
typedef short bf16x8 __attribute__((ext_vector_type(8)));
constexpr int BM = 256, BK = 64, HALF = 128, HTB = HALF * BK * 2, STAGE_BYTES = 8 * HTB, NXCD = 8, WGM = 8;
__device__ __forceinline__ int lds_byte(int r, int c) { const int st = (r >> 4) * 2 + (c >> 5), rr = r & 15, cc = c & 31, ob = rr * 64 + cc * 2; return st * 1024 + (ob ^ (((ob >> 9) & 1) << 5)); }
__device__ __forceinline__ void stage_rc(int b, int& R, int& C) { const int st = b / 1024, sb = b % 1024, swz = sb ^ (((sb >> 9) & 1) << 5); R = (st >> 1) * 16 + swz / 64; C = (st & 1) * 32 + (swz % 64) / 2; }
struct Unit { const char* a; const char* b; int pm, pn, aux; };
__device__ __forceinline__ void static_map(int L, int nM, int nN, int& pm, int& pn) {
    const int nwg = nM * nN; int wgid = L; { const int q = nwg / NXCD, r = nwg % NXCD, xcd = wgid % NXCD, off = wgid / NXCD; wgid = (xcd < r ? xcd * (q + 1) : r * (q + 1) + (xcd - r) * q) + off; }
    const int nig = WGM * nN, gid = wgid / nig, fm = gid * WGM, gsz = (nM - fm) < WGM ? (nM - fm) : WGM;
    pm = fm + ((wgid % nig) % gsz); pn = (wgid % nig) / gsz;
}
template <class Epi, class Sched>
__device__ __forceinline__ void gemm_phase(LAS unsigned char* lds, const int lda, const int ldb, const int K, const Sched& S, const Epi& E) {
    int tid = threadIdx.x; asm volatile("" : "+v"(tid));
    const int wid = __builtin_amdgcn_readfirstlane(tid >> 6), lane = tid & 63, wr = wid >> 2, wc = wid & 3, fr = lane & 15, fq = lane >> 4;
    int nt = K / BK; asm volatile("" : "+s"(nt));
    unsigned voffA[2], voffB[2];
#pragma unroll
    for (int i = 0; i < 2; ++i) { int R, C; stage_rc(tid * 16 + i * 8192, R, C); voffA[i] = (unsigned)(R * lda + C) * 2u; voffB[i] = (unsigned)(R * ldb + C) * 2u; }
    const size_t kstep = (size_t)(BK * 2);
    const size_t hstepA = (size_t)HALF * lda * 2, hstepB = (size_t)HALF * ldb * 2;
    const unsigned ldsw = (unsigned)wid * 1024u;
    const int aoff = lds_byte(wr * 64 + fr, fq * 8), boff = lds_byte(wc * 32 + fr, fq * 8);
#define PG_SA(b, h) (((b) * 2 + (h)) * HTB)
#define PG_SB(b, h) ((4 + (b) * 2 + (h)) * HTB)
#define PG_STAGE(bufoff, gbase, voff) do { _Pragma("unroll") for (int _i = 0; _i < 2; ++_i) \
        __builtin_amdgcn_global_load_lds((const unsigned*)((const char*)(gbase) + (voff)[_i]), (LAS unsigned*)(lds + (bufoff) + ldsw + _i * 8192), 16, 0, 0); } while (0)
#define PG_LDA(dst, b, h) do { _Pragma("unroll") for (int m = 0; m < 4; ++m) _Pragma("unroll") for (int k = 0; k < 2; ++k) dst[m][k] = *(const LAS bf16x8*)(lds + PG_SA(b, h) + aoff + m * 2048 + k * 1024); } while (0)
#define PG_LDB(dst, b, h) do { _Pragma("unroll") for (int n = 0; n < 2; ++n) _Pragma("unroll") for (int k = 0; k < 2; ++k) dst[n][k] = *(const LAS bf16x8*)(lds + PG_SB(b, h) + boff + n * 2048 + k * 1024); } while (0)
#define PG_MMA(ai, bj, At, Bt) do { __builtin_amdgcn_s_setprio(1); _Pragma("unroll") for (int m = 0; m < 4; ++m) _Pragma("unroll") for (int n = 0; n < 2; ++n) _Pragma("unroll") for (int k = 0; k < 2; ++k) \
        acc[ai][bj][m][n] = __builtin_amdgcn_mfma_f32_16x16x32_bf16(Bt[n][k], At[m][k], acc[ai][bj][m][n], 0, 0, 0); __builtin_amdgcn_s_setprio(0); } while (0)
#define PG_WAIT_V(n) asm volatile("s_waitcnt vmcnt(" #n ")" ::: "memory")
#define PG_WAIT_L(n) asm volatile("s_waitcnt lgkmcnt(" #n ")" ::: "memory")
#define PG_BAR __builtin_amdgcn_s_barrier()
#define PG_SCHED __builtin_amdgcn_sched_barrier(0)
    Unit cur, nxt; int ui = 0;
    if (!S.next(0, cur)) return;
    f32x4 acc[2][2][4][2];
#pragma unroll
    for (int a = 0; a < 2; ++a)
#pragma unroll
        for (int b = 0; b < 2; ++b)
#pragma unroll
            for (int m = 0; m < 4; ++m)
#pragma unroll
                for (int n = 0; n < 2; ++n) acc[a][b][m][n] = (f32x4){0.f, 0.f, 0.f, 0.f};
    bf16x8 At[4][2], B0[2][2], B1[2][2];
    const char* cA = cur.a; const char* cB = cur.b;
    PG_STAGE(PG_SB(0, 0), cB, voffB); PG_STAGE(PG_SA(0, 0), cA, voffA); PG_STAGE(PG_SB(0, 1), cB + hstepB, voffB); PG_STAGE(PG_SA(0, 1), cA + hstepA, voffA);
    if (wr == 1) PG_BAR;
    PG_WAIT_V(4); PG_BAR;
    PG_STAGE(PG_SB(1, 0), cB + kstep, voffB); PG_STAGE(PG_SA(1, 0), cA + kstep, voffA); PG_STAGE(PG_SB(1, 1), cB + hstepB + kstep, voffB);
    PG_WAIT_V(6); PG_BAR;
    for (;;) {
        const bool has_next = S.next(ui + 1, nxt);
        const char* nA = has_next ? nxt.a : cA; const char* nB = has_next ? nxt.b : cB;
        for (int t = 0; t < nt; t += 2) {
            const bool last = (t == nt - 2);
            const char* a1 = cA + (size_t)(t + 1) * kstep;
            const char* a2 = last ? nA : cA + (size_t)(t + 2) * kstep; const char* b2 = last ? nB : cB + (size_t)(t + 2) * kstep;
            const char* a3 = a2 + kstep; const char* b3 = b2 + kstep;
            PG_LDB(B0, 0, 0); PG_SCHED; PG_LDA(At, 0, 0); PG_STAGE(PG_SA(1, 1), a1 + hstepA, voffA);
            PG_WAIT_L(8); PG_BAR; PG_WAIT_L(0); PG_MMA(0, 0, At, B0); PG_BAR; PG_SCHED;
            PG_LDB(B1, 0, 1); PG_STAGE(PG_SB(0, 0), b2, voffB);
            PG_BAR; PG_WAIT_L(0); PG_MMA(0, 1, At, B1); PG_BAR;
            PG_LDA(At, 0, 1); PG_STAGE(PG_SA(0, 0), a2, voffA);
            PG_BAR; PG_WAIT_L(0); PG_MMA(1, 0, At, B0); PG_BAR; PG_SCHED;
            PG_STAGE(PG_SB(0, 1), b2 + hstepB, voffB);
            PG_WAIT_V(6); PG_BAR; PG_MMA(1, 1, At, B1); PG_BAR;
            PG_LDB(B0, 1, 0); PG_SCHED; PG_LDA(At, 1, 0); PG_STAGE(PG_SA(0, 1), a2 + hstepA, voffA);
            PG_WAIT_L(8); PG_BAR; PG_WAIT_L(0); PG_MMA(0, 0, At, B0); PG_BAR; PG_SCHED;
            PG_LDB(B1, 1, 1); PG_STAGE(PG_SB(1, 0), b3, voffB);
            PG_BAR; PG_WAIT_L(0); PG_MMA(0, 1, At, B1); PG_BAR;
            PG_LDA(At, 1, 1); PG_STAGE(PG_SA(1, 0), a3, voffA);
            PG_BAR; PG_WAIT_L(0); PG_MMA(1, 0, At, B0); PG_BAR; PG_SCHED;
            PG_STAGE(PG_SB(1, 1), b3 + hstepB, voffB);
            PG_WAIT_V(6); PG_BAR; PG_MMA(1, 1, At, B1); PG_BAR;
        }
        E(acc, cur, wr, wc, fr, fq);
        if (!has_next) break;
#pragma unroll
        for (int a = 0; a < 2; ++a)
#pragma unroll
            for (int b = 0; b < 2; ++b)
#pragma unroll
                for (int m = 0; m < 4; ++m)
#pragma unroll
                    for (int n = 0; n < 2; ++n) acc[a][b][m][n] = (f32x4){0.f, 0.f, 0.f, 0.f};
        cur = nxt; cA = nA; cB = nB; ++ui;
    }
    PG_WAIT_V(0);
    if (wr == 0) PG_BAR;
    PG_BAR;
#undef PG_SA
#undef PG_SB
#undef PG_STAGE
#undef PG_LDA
#undef PG_LDB
#undef PG_MMA
#undef PG_WAIT_V
#undef PG_WAIT_L
#undef PG_BAR
#undef PG_SCHED
}

struct SchedG1 {
    const char *HX, *W1, *WV; int G, c;
    __device__ __forceinline__ bool next(int i, Unit& u) const {
        const int L = i * G + c, nmain = (NROW / 256) * (NP1 / 256);
        if (L < nmain) { static_map(L, NROW / 256, NP1 / 256, u.pm, u.pn); u.a = HX + (size_t)u.pm * 256 * DM * 2; u.b = W1 + (size_t)u.pn * 256 * DM * 2; u.aux = 0; return true; }
        const int idx = L - nmain; if (idx >= 3 * (NROW / 256)) return false;
        u.pm = idx % 3; u.pn = idx / 3; u.a = WV + (size_t)u.pm * 256 * DM * 2; u.b = HX + (size_t)u.pn * 256 * DM * 2; u.aux = 1; return true;
    }
};
struct SchedStatic {
    const char *A, *B; size_t tA, tB; int nM, nN, G, c;
    __device__ __forceinline__ bool next(int i, Unit& u) const {
        const int L = i * G + c; if (L >= nM * nN) return false;
        static_map(L, nM, nN, u.pm, u.pn); u.a = A + (size_t)u.pm * tA; u.b = B + (size_t)u.pn * tB; u.aux = 0; return true;
    }
};
struct SchedMerge {
    const char *BR, *W; int ntile, G, c;
    __device__ __forceinline__ bool next(int i, Unit& u) const {
        const int t = c + (i >> 2) * G; if (t >= ntile) return false;
        const int br = i & 3; u.pm = t >> 2; u.pn = t & 3; u.aux = br;
        u.a = BR + (size_t)u.pm * 256 * 2048 * 2 + (size_t)br * 512 * 2; u.b = W + (size_t)br * DM * 512 * 2 + (size_t)u.pn * 256 * 512 * 2; return true;
    }
};
struct SchedMoe {
    const char *A, *W; const int* off; size_t tA, wE, wT; int npan, NJ, G, c;
    __device__ __forceinline__ bool next(int i, Unit& u) const {
        const int L = i * G + c; if (L >= npan * NJ) return false;
        const int p = L / NJ, j = L % NJ; int e = 0;
#pragma unroll 1
        for (int q = 1; q < 32; ++q) if (p * 256 >= off[q]) e = q;
        e = __builtin_amdgcn_readfirstlane(e);
        u.pm = p; u.pn = j; u.aux = e; u.a = A + (size_t)p * tA; u.b = W + (size_t)e * wE + (size_t)j * wT; return true;
    }
};

#define PG_ROWCOL const int row0 = u.pm * BM + wr * 64 + fr, col0 = u.pn * BM + wc * 32 + 4 * fq
struct EpiG1 { bf16_t *P1, *VT; const float* rtab; const float* lbp; int layer;
    __device__ __forceinline__ void operator()(const f32x4 (&acc)[2][2][4][2], const Unit& u, int wr, int wc, int fr, int fq) const {
        const int row0 = u.pm * BM + wr * 64 + fr;
        if (u.aux || (u.pn >= 8 && u.pn <= 10)) {
            const int col0 = u.pn * BM + wc * 32 + 4 * fq; bf16_t* base = u.aux ? VT : P1; const size_t ld = u.aux ? (size_t)NROW : (size_t)NP1;
            const bool rope = !u.aux && (u.pm < NTOK / 256);
#pragma unroll
            for (int ai = 0; ai < 2; ++ai)
#pragma unroll
                for (int m = 0; m < 4; ++m) { const int r = row0 + ai * HALF + m * 16; bf16_t* rowp = base + (size_t)r * ld + col0;
#pragma unroll
                    for (int bj = 0; bj < 2; ++bj) {
                        f32x4 v0 = acc[ai][bj][m][0], v1 = acc[ai][bj][m][1];
                        if (rope && !(u.pn == 10 && bj == 1)) {
                            const int pos = r & (SEQ - 1), pp = (wc & 1) ? (pos & 63) : (pos >> 6); const float* tp = rtab + (pp * 16 + 4 * fq) * 2;
                            const f32x4 t0 = *(const f32x4*)tp, t1 = *(const f32x4*)(tp + 4);
                            const f32x4 a = v0, b = v1;
                            v0.x = a.x * t0.x - b.x * t0.y; v1.x = a.x * t0.y + b.x * t0.x; v0.y = a.y * t0.z - b.y * t0.w; v1.y = a.y * t0.w + b.y * t0.z;
                            v0.z = a.z * t1.x - b.z * t1.y; v1.z = a.z * t1.y + b.z * t1.x; v0.w = a.w * t1.z - b.w * t1.w; v1.w = a.w * t1.w + b.w * t1.z;
                        }
                        u32x2 o; o.x = pk2(v0.x, v0.y); o.y = pk2(v0.z, v0.w); *(u32x2*)(rowp + bj * HALF) = o;
                        o.x = pk2(v1.x, v1.y); o.y = pk2(v1.z, v1.w); *(u32x2*)(rowp + bj * HALF + 16) = o; } }
            return;
        }
        const int col0 = u.pn * BM + wc * 32 + 8 * fq;
        const int mode = (u.pn == 11 || u.pn == 12) ? 2 : ((u.pn >= 13 && u.pn <= 16) ? 3 : 0);
        if (mode == 3) {
            f32x4 lb4[2][2];
            const int z = (u.pn - 13) >> 1, cb = z * 512 + ((u.pn - 13) & 1) * 256 + wc * 32 + 8 * fq;
#pragma unroll
            for (int bj = 0; bj < 2; ++bj)
#pragma unroll
                for (int n = 0; n < 2; ++n) lb4[bj][n] = (layer == 0) ? (f32x4){0.f, 0.f, 0.f, 0.f} : *(const f32x4*)(lbp + cb + bj * HALF + 4 * n);
#pragma unroll
            for (int ai = 0; ai < 2; ++ai)
#pragma unroll
                for (int m = 0; m < 4; ++m) { bf16_t* rowp = P1 + (size_t)(row0 + ai * HALF + m * 16) * NP1 + col0;
#pragma unroll
                    for (int bj = 0; bj < 2; ++bj) { float gq[8];
#pragma unroll
                        for (int n = 0; n < 2; ++n)
#pragma unroll
                            for (int j = 0; j < 4; ++j) { const float f = acc[ai][bj][m][n][j], lb = lb4[bj][n][j]; const float t = __expf(-fabsf(f)), rr = __builtin_amdgcn_rcpf(1.f + t);
                                gq[4 * n + j] = __logf(fmaxf(lb + (1.f - lb) * ((f >= 0.f) ? rr : t * rr), 1e-37f)); }
                        u32x4 o; o.x = pk2(gq[0], gq[1]); o.y = pk2(gq[2], gq[3]); o.z = pk2(gq[4], gq[5]); o.w = pk2(gq[6], gq[7]); *(u32x4*)(rowp + bj * HALF) = o; } }
            return;
        }
#pragma unroll
        for (int ai = 0; ai < 2; ++ai)
#pragma unroll
            for (int m = 0; m < 4; ++m) { bf16_t* rowp = P1 + (size_t)(row0 + ai * HALF + m * 16) * NP1 + col0;
#pragma unroll
                for (int bj = 0; bj < 2; ++bj) {
                    f32x4 v0 = acc[ai][bj][m][0], v1 = acc[ai][bj][m][1];
                    if (mode == 2) {
#pragma unroll
                        for (int j = 0; j < 4; ++j) { v0[j] = v0[j] * __builtin_amdgcn_rcpf(1.f + __expf(-v0[j])); v1[j] = v1[j] * __builtin_amdgcn_rcpf(1.f + __expf(-v1[j])); }
                    }
                    u32x4 o; o.x = pk2(v0.x, v0.y); o.y = pk2(v0.z, v0.w); o.z = pk2(v1.x, v1.y); o.w = pk2(v1.z, v1.w); *(u32x4*)(rowp + bj * HALF) = o; } }
    }
};
#define PG_ROWCOL8 const int row0 = u.pm * BM + wr * 64 + fr, col0 = u.pn * BM + wc * 32 + 8 * fq
struct EpiGate { bf16_t* G;
    __device__ __forceinline__ void operator()(const f32x4 (&acc)[2][2][4][2], const Unit& u, int wr, int wc, int fr, int fq) const {
        PG_ROWCOL8;
#pragma unroll
        for (int ai = 0; ai < 2; ++ai)
#pragma unroll
            for (int m = 0; m < 4; ++m) { bf16_t* rowp = G + (size_t)(row0 + ai * HALF + m * 16) * NGATE + col0;
#pragma unroll
                for (int bj = 0; bj < 2; ++bj) { const f32x4 v0 = acc[ai][bj][m][0], v1 = acc[ai][bj][m][1]; u32x4 o;
                    o.x = pk2(sigmoidf_(v0.x), sigmoidf_(v0.y)); o.y = pk2(sigmoidf_(v0.z), sigmoidf_(v0.w)); o.z = pk2(sigmoidf_(v1.x), sigmoidf_(v1.y)); o.w = pk2(sigmoidf_(v1.z), sigmoidf_(v1.w));
                    *(u32x4*)(rowp + bj * HALF) = o; } }
    }
};
struct EpiMerge { const bf16_t* G; bf16_t* O;
    __device__ __forceinline__ void operator()(const f32x4 (&acc)[2][2][4][2], const Unit& u, int wr, int wc, int fr, int fq) const {
        PG_ROWCOL8; const int br = u.aux;
#pragma unroll
        for (int ai = 0; ai < 2; ++ai) {
            u32x4 g4[4][2], o4[4][2];
#pragma unroll
            for (int m = 0; m < 4; ++m) { const size_t r = (size_t)(row0 + ai * HALF + m * 16); const bf16_t* gp = G + r * NGATE + br * 1024 + col0; const bf16_t* rowp = O + r * DM + col0;
#pragma unroll
                for (int bj = 0; bj < 2; ++bj) { g4[m][bj] = *(const u32x4*)(gp + bj * HALF); if (br != 0) o4[m][bj] = *(const u32x4*)(rowp + bj * HALF); } }
#pragma unroll
            for (int m = 0; m < 4; ++m) { bf16_t* rowp = O + (size_t)(row0 + ai * HALF + m * 16) * DM + col0;
#pragma unroll
                for (int bj = 0; bj < 2; ++bj) { const f32x4 v0 = acc[ai][bj][m][0], v1 = acc[ai][bj][m][1]; const u32x4 gg = g4[m][bj];
                    float w[8] = {__uint_as_float(gg.x << 16) * v0.x, __uint_as_float(gg.x & 0xffff0000u) * v0.y, __uint_as_float(gg.y << 16) * v0.z, __uint_as_float(gg.y & 0xffff0000u) * v0.w,
                                  __uint_as_float(gg.z << 16) * v1.x, __uint_as_float(gg.z & 0xffff0000u) * v1.y, __uint_as_float(gg.w << 16) * v1.z, __uint_as_float(gg.w & 0xffff0000u) * v1.w};
                    if (br != 0) { const u32x4 oo = o4[m][bj];
                        w[0] += __uint_as_float(oo.x << 16); w[1] += __uint_as_float(oo.x & 0xffff0000u); w[2] += __uint_as_float(oo.y << 16); w[3] += __uint_as_float(oo.y & 0xffff0000u);
                        w[4] += __uint_as_float(oo.z << 16); w[5] += __uint_as_float(oo.z & 0xffff0000u); w[6] += __uint_as_float(oo.w << 16); w[7] += __uint_as_float(oo.w & 0xffff0000u); }
                    u32x4 o; o.x = pk2(w[0], w[1]); o.y = pk2(w[2], w[3]); o.z = pk2(w[4], w[5]); o.w = pk2(w[6], w[7]); *(u32x4*)(rowp + bj * HALF) = o; } }
            asm volatile("" ::: "memory");
        }
    }
};
struct EpiWout { const float *xlat, *xctx; float *olat, *octx; const float* modl;
    __device__ __forceinline__ void operator()(const f32x4 (&acc)[2][2][4][2], const Unit& u, int wr, int wc, int fr, int fq) const {
        PG_ROWCOL; const bool lat = u.pm < NTOK / 256; const int rb = lat ? (u.pm >> 4) : 4;
        const float* xin = lat ? xlat : xctx - (size_t)NTOK * DM; float* xo = lat ? olat : octx - (size_t)NTOK * DM; const float* m2 = modl + (size_t)rb * 6144 + 2 * 1024 + col0;
        f32x4 mv[2][2];
#pragma unroll
        for (int bj = 0; bj < 2; ++bj)
#pragma unroll
            for (int n = 0; n < 2; ++n) mv[bj][n] = *(const f32x4*)(m2 + bj * HALF + n * 16);
#pragma unroll
        for (int aq = 0; aq < 4; ++aq) { const int ai = aq >> 1, m0 = (aq & 1) * 2;
            f32x4 xv[4][2][2];
#pragma unroll
            for (int m = m0; m < m0 + 2; ++m) { const size_t o = (size_t)(row0 + ai * HALF + m * 16) * DM + col0;
#pragma unroll
                for (int bj = 0; bj < 2; ++bj)
#pragma unroll
                    for (int n = 0; n < 2; ++n) xv[m][bj][n] = *(const f32x4*)(xin + o + bj * HALF + n * 16); }
#pragma unroll
            for (int m = m0; m < m0 + 2; ++m) { const size_t o = (size_t)(row0 + ai * HALF + m * 16) * DM + col0;
#pragma unroll
                for (int bj = 0; bj < 2; ++bj)
#pragma unroll
                    for (int n = 0; n < 2; ++n) *(f32x4*)(xo + o + bj * HALF + n * 16) = ALPHA * xv[m][bj][n] + mv[bj][n] * acc[ai][bj][m][n]; }
            asm volatile("" ::: "memory");
        }
    }
};
struct EpiMoe1 { bf16_t* HID; const float* roww;
    __device__ __forceinline__ void operator()(const f32x4 (&acc)[2][2][4][2], const Unit& u, int wr, int wc, int fr, int fq) const {
        const int row0 = u.pm * BM + wr * 64 + fr, hc0 = u.pn * 128 + wc * 32 + 8 * fq;
#pragma unroll
        for (int ai = 0; ai < 2; ++ai)
#pragma unroll
            for (int m = 0; m < 4; ++m) { const int r = row0 + ai * HALF + m * 16; const float w = roww[r];
                const f32x4 g0 = acc[ai][0][m][0], g1 = acc[ai][0][m][1], u0 = acc[ai][1][m][0], u1 = acc[ai][1][m][1]; u32x4 o;
                o.x = pk2(siluf_(g0.x) * u0.x * w, siluf_(g0.y) * u0.y * w); o.y = pk2(siluf_(g0.z) * u0.z * w, siluf_(g0.w) * u0.w * w);
                o.z = pk2(siluf_(g1.x) * u1.x * w, siluf_(g1.y) * u1.y * w); o.w = pk2(siluf_(g1.z) * u1.z * w, siluf_(g1.w) * u1.w * w);
                *(u32x4*)(HID + (size_t)r * 256 + hc0) = o; }
    }
};
struct EpiMoe2 { bf16_t* Y; const int* rmap; bf16_t* dump;
    __device__ __forceinline__ void operator()(const f32x4 (&acc)[2][2][4][2], const Unit& u, int wr, int wc, int fr, int fq) const {
        PG_ROWCOL8;
#pragma unroll
        for (int ai = 0; ai < 2; ++ai)
#pragma unroll
            for (int m = 0; m < 4; ++m) { const int s = rmap[row0 + ai * HALF + m * 16];
                bf16_t* rowp = (s >= 0 ? Y + (size_t)s * DM : dump) + col0;
#pragma unroll
                for (int bj = 0; bj < 2; ++bj) { const f32x4 v0 = acc[ai][bj][m][0], v1 = acc[ai][bj][m][1]; u32x4 o; o.x = pk2(v0.x, v0.y); o.y = pk2(v0.z, v0.w); o.z = pk2(v1.x, v1.y); o.w = pk2(v1.z, v1.w); *(u32x4*)(rowp + bj * HALF) = o; } }
    }
};
#undef PG_ROWCOL8
#undef PG_ROWCOL
}

__device__ __forceinline__ void moe_offsets(Frame& F, int l, int* off) {
    if (F.tid < 64) {
        int v = (F.tid < 32) ? (((int)F.cnt()[l * 32 + F.tid] + 255) & ~255) : 0;
#pragma unroll
        for (int o = 1; o < 32; o <<= 1) { const int t = __shfl_up(v, o); if ((F.tid & 63) >= o) v += t; }
        if (F.tid < 32) off[F.tid + 1] = v;
        if (F.tid == 0) off[0] = 0;
    }
    __syncthreads();
}

__device__ __forceinline__ void phase_rope(Frame& F) {
    float* tab = F.smf;
    for (int e = F.tid; e < 1024; e += NTHR) { const int pp = e >> 4, i = e & 15; const float inv = powf(10000.f, -(float)i / 16.f), ang = (float)pp * inv; tab[2 * e] = cosf(ang); tab[2 * e + 1] = sinf(ang); }
    __syncthreads();
    const size_t total = (size_t)NTOK * 320;
    for (size_t idx = (size_t)F.bid * NTHR + F.tid; idx < total; idx += (size_t)F.nb * NTHR) {
        const int row = (int)(idx / 320), r = (int)(idx % 320), h = r >> 5, half = (r >> 4) & 1, i = r & 15;
        const int pos = row & (SEQ - 1), pp = half ? (pos & 63) : (pos >> 6);
        const float cs = tab[2 * (pp * 16 + i)], sn = tab[2 * (pp * 16 + i) + 1];
        bf16_t* base = F.P1() + (size_t)row * NP1 + (h < 8 ? PC_CQ + h * 64 : PC_CK + (h - 8) * 64) + half * 32 + i;
        const float u1 = bf2f(base[0]), u2 = bf2f(base[16]);
        base[0] = f2bf(u1 * cs - u2 * sn); base[16] = f2bf(u1 * sn + u2 * cs);
    }
}

__device__ __forceinline__ int seq_row(int s, int b, int z) {
    if (s < LC) { const int tc = z ? (LC - 1 - s) : s; return NTOK + b * LC + tc; }
    const int tl = s - LC, t = z ? (SEQ - 1 - tl) : tl; return b * SEQ + t;
}
typedef short bf16x8_t __attribute__((ext_vector_type(8)));
typedef short bf16x4_t __attribute__((ext_vector_type(4)));
struct MaskNone { __device__ __forceinline__ void operator()(f32x4&, f32x4&) const {} };
struct MaskNA { int u0; const float* brow;
    __device__ __forceinline__ void operator()(f32x4& s0, f32x4& s1) const {
        float v[8] = {s0.x, s0.y, s0.z, s0.w, s1.x, s1.y, s1.z, s1.w};
#pragma unroll
        for (int T = 0; T < 2; ++T)
#pragma unroll
            for (int rr = 0; rr < 4; ++rr) v[T * 4 + rr] = ((unsigned)(u0 + 16 * T + rr) < 16u) ? v[T * 4 + rr] + brow[16 * T + rr] : -INFINITY;
        s0 = (f32x4){v[0], v[1], v[2], v[3]}; s1 = (f32x4){v[4], v[5], v[6], v[7]};
    }
};
struct MaskWA { int i, j0;
    __device__ __forceinline__ void operator()(f32x4& s0, f32x4& s1) const {
        float v[8] = {s0.x, s0.y, s0.z, s0.w, s1.x, s1.y, s1.z, s1.w};
#pragma unroll
        for (int T = 0; T < 2; ++T)
#pragma unroll
            for (int rr = 0; rr < 4; ++rr) { const int j = j0 + 16 * T + rr; const bool ok = (j >= 0) && (j < SEQ) && (i - j <= 128) && (j - i <= 128);
                v[T * 4 + rr] = ok ? v[T * 4 + rr] : -INFINITY; }
        s0 = (f32x4){v[0], v[1], v[2], v[3]}; s1 = (f32x4){v[4], v[5], v[6], v[7]};
    }
};
struct KVF { bf16x8_t k[4]; bf16x4_t v[4][2]; };
__device__ __forceinline__ void kv_load(KVF& f, const char* kbase, unsigned ko0, unsigned ko1, const char* vbase, unsigned vo0, unsigned vo1) {
    f.k[0] = *(const bf16x8_t*)(kbase + ko0); f.k[1] = *(const bf16x8_t*)(kbase + ko0 + 64); f.k[2] = *(const bf16x8_t*)(kbase + ko1); f.k[3] = *(const bf16x8_t*)(kbase + ko1 + 64);
#pragma unroll
    for (int t = 0; t < 4; ++t) { f.v[t][0] = *(const bf16x4_t*)(vbase + vo0 + (unsigned)t * 16u * NROW * 2u); f.v[t][1] = *(const bf16x4_t*)(vbase + vo1 + (unsigned)t * 16u * NROW * 2u); }
}
__device__ __forceinline__ float xmax_g(float x) {
    auto r = __builtin_amdgcn_permlane16_swap(__float_as_uint(x), __float_as_uint(x), false, false); x = fmaxf(__uint_as_float(r[0]), __uint_as_float(r[1]));
    auto q = __builtin_amdgcn_permlane32_swap(__float_as_uint(x), __float_as_uint(x), false, false); return fmaxf(__uint_as_float(q[0]), __uint_as_float(q[1])); }
__device__ __forceinline__ float xsum_g(float x) {
    auto r = __builtin_amdgcn_permlane16_swap(__float_as_uint(x), __float_as_uint(x), false, false); x = __uint_as_float(r[0]) + __uint_as_float(r[1]);
    auto q = __builtin_amdgcn_permlane32_swap(__float_as_uint(x), __float_as_uint(x), false, false); return __uint_as_float(q[0]) + __uint_as_float(q[1]); }
template <class MaskF>
__device__ __forceinline__ void attn_tile(float& am, f32x4& asum, f32x4 (&ao)[4], const bf16x8_t (&qb)[2], const KVF& f, const MaskF& maskf) {
    f32x4 s0 = {0.f, 0.f, 0.f, 0.f}, s1 = {0.f, 0.f, 0.f, 0.f};
    s0 = __builtin_amdgcn_mfma_f32_16x16x32_bf16(f.k[0], qb[0], s0, 0, 0, 0); s0 = __builtin_amdgcn_mfma_f32_16x16x32_bf16(f.k[1], qb[1], s0, 0, 0, 0);
    s1 = __builtin_amdgcn_mfma_f32_16x16x32_bf16(f.k[2], qb[0], s1, 0, 0, 0); s1 = __builtin_amdgcn_mfma_f32_16x16x32_bf16(f.k[3], qb[1], s1, 0, 0, 0);
    maskf(s0, s1);
    const float ml = fmaxf(fmaxf(fmaxf(s0.x, s0.y), fmaxf(s0.z, s0.w)), fmaxf(fmaxf(s1.x, s1.y), fmaxf(s1.z, s1.w)));
    if (__any(ml > am)) {
        const float mn = fmaxf(am, xmax_g(ml)), alpha = __builtin_amdgcn_exp2f(am - mn); am = mn; asum = asum * alpha;
#pragma unroll
        for (int t = 0; t < 4; ++t) ao[t] = ao[t] * alpha;
    }
    f32x4 p0, p1;
    p0.x = __builtin_amdgcn_exp2f(s0.x - am); p0.y = __builtin_amdgcn_exp2f(s0.y - am); p0.z = __builtin_amdgcn_exp2f(s0.z - am); p0.w = __builtin_amdgcn_exp2f(s0.w - am);
    p1.x = __builtin_amdgcn_exp2f(s1.x - am); p1.y = __builtin_amdgcn_exp2f(s1.y - am); p1.z = __builtin_amdgcn_exp2f(s1.z - am); p1.w = __builtin_amdgcn_exp2f(s1.w - am);
    union { bf16x8_t v; unsigned u[4]; } pb, ones;
    pb.u[0] = pk2(p0.x, p0.y); pb.u[1] = pk2(p0.z, p0.w); pb.u[2] = pk2(p1.x, p1.y); pb.u[3] = pk2(p1.z, p1.w);
    ones.u[0] = ones.u[1] = ones.u[2] = ones.u[3] = 0x3f803f80u;
#pragma unroll
    for (int t = 0; t < 4; ++t) {
        union { bf16x8_t v; bf16x4_t h[2]; } av; av.h[0] = f.v[t][0]; av.h[1] = f.v[t][1];
        ao[t] = __builtin_amdgcn_mfma_f32_16x16x32_bf16(av.v, pb.v, ao[t], 0, 0, 0);
    }
    asum = __builtin_amdgcn_mfma_f32_16x16x32_bf16(ones.v, pb.v, asum, 0, 0, 0);
}
template <int kind>
__device__ __forceinline__ void attn_block(Frame& F, int l, int item, const float* rpb_s, bf16_t* sbuf) {
    constexpr int NQ = 2, NCS = 4, NLOC = (kind == 0) ? 11 : (kind == 1 ? 5 : 0), NS = NCS + NLOC, SROW = 72;
    const int tid = F.tid, lane = F.lane, n = lane & 15, g = lane >> 4, w = __builtin_amdgcn_readfirstlane(F.wave);
    const bf16_t* P1 = F.P1(); const bf16_t* VT = F.VT();
    int b, h0, kvh = 0, kcol, vrow, r = 0, cb = 0, t0 = 0, t0g = 0, r0 = 0, qrow0, qcol0, brcol0;
    constexpr int QRS = (kind == 0) ? 64 : (kind == 2 ? 16 : 0), QCS = (kind == 1 || kind == 3) ? 64 : 0;
    if (kind == 0) { const int rq = item & 15, hb = (item >> 4) & 7; b = item >> 7; r0 = 4 * rq; cb = w & 3; r = r0 + 2 * (w >> 2); h0 = hb; kcol = PC_BK + hb * 64; vrow = hb * 64;
        qrow0 = b * SEQ + r * 64 + cb * 16; qcol0 = PC_BQ + hb * 64; brcol0 = 512 + hb * 64; }
    else if (kind == 1) { const int qg = item & 63; kvh = (item >> 6) & 1; b = item >> 7; t0g = 64 * qg; t0 = t0g + 16 * (w & 3); h0 = kvh * 4 + 2 * (w >> 2); kcol = PC_CK + kvh * 64; vrow = 512 + kvh * 64;
        qrow0 = b * SEQ + t0; qcol0 = PC_CQ + h0 * 64; brcol0 = 1024 + h0 * 64; }
    else if (kind == 2) { const int hb = item & 7; b = item >> 3; h0 = hb; kcol = PC_BK + hb * 64; vrow = hb * 64; qrow0 = NTOK + b * LC + 32 * w; qcol0 = PC_BQ + hb * 64; brcol0 = 512 + hb * 64; }
    else { const int qh = item & 3; kvh = (item >> 2) & 1; b = item >> 3; h0 = kvh * 4 + 2 * (w >> 2); kcol = PC_CK + kvh * 64; vrow = 512 + kvh * 64;
        qrow0 = NTOK + b * LC + 16 * (4 * qh + (w & 3)); qcol0 = PC_CQ + h0 * 64; brcol0 = 1024 + h0 * 64; }
    bf16x8_t qb[NQ][2]; float am[NQ]; f32x4 asum[NQ], ao[NQ][4];
    { const char* qbase = (const char*)P1; const unsigned qo = (unsigned)(qrow0 + n) * (unsigned)(NP1 * 2) + (unsigned)(qcol0 + 8 * g) * 2u;
#pragma unroll
      for (int q = 0; q < NQ; ++q) { const unsigned o = qo + (unsigned)q * (unsigned)(QRS * NP1 * 2 + QCS * 2); qb[q][0] = *(const bf16x8_t*)(qbase + o); qb[q][1] = *(const bf16x8_t*)(qbase + o + 64);
        am[q] = -1e30f; asum[q] = (f32x4){0.f, 0.f, 0.f, 0.f};
#pragma unroll
        for (int t = 0; t < 4; ++t) ao[q][t] = (f32x4){0.f, 0.f, 0.f, 0.f}; } }
    const int crow0 = NTOK + b * LC, ru0 = min(max(r0 - 4, 0), 56);
    const int w0 = (cb == 0) ? 0 : (cb == 1 ? 8 : (cb == 2 ? 24 : 32));
    const int srow = tid >> 3, sch = tid & 7;
    const char* kbase = (const char*)P1; const char* vbase = (const char*)VT;
    u32x4 kr0 = {0u, 0u, 0u, 0u}, vr0 = kr0, kr1 = kr0, vr1 = kr0;
    auto stage_load = [&](int s, u32x4& kreg, u32x4& vreg) {
        int krow, vcol;
        if (s < NCS) { krow = crow0 + 64 * s + srow; vcol = crow0 + 64 * s + 8 * sch; }
        else if (kind == 0) { const int kr = min(ru0 + (s - NCS), 63); krow = b * SEQ + kr * 64 + srow; vcol = b * SEQ + kr * 64 + 8 * sch; }
        else { const int kb = t0g - 128 + 64 * (s - NCS); krow = b * SEQ + min(max(kb + srow, 0), SEQ - 1); vcol = b * SEQ + min(max(kb + 8 * sch, 0), SEQ - 8); }
        kreg = *(const u32x4*)(kbase + (unsigned)krow * (unsigned)(NP1 * 2) + (unsigned)(kcol * 2 + sch * 16));
        vreg = *(const u32x4*)(vbase + (unsigned)(vrow + srow) * (unsigned)(NROW * 2) + (unsigned)vcol * 2u);
    };
    auto stage_store = [&](int s, const u32x4& kreg, const u32x4& vreg) { bf16_t* Ks = sbuf + (s & 1) * (2 * 64 * SROW); bf16_t* Vs = Ks + 64 * SROW;
        *(u32x4*)(Ks + srow * SROW + sch * 8) = kreg; *(u32x4*)(Vs + srow * SROW + sch * 8) = vreg; };
    stage_load(0, kr1, vr1); stage_store(0, kr1, vr1); stage_load(1, kr0, vr0);
    __syncthreads();
    auto do_step = [&](int s, const u32x4& kst, const u32x4& vst, u32x4& kld, u32x4& vld) {
        if (s + 2 < NS) stage_load(s + 2, kld, vld);
#pragma unroll
        for (int hh = 0; hh < 2; ++hh) {
            bool act[NQ]; int kofs = 32 * hh;
            if (s < NCS) { act[0] = act[1] = true; }
            else if (kind == 0) { const int kr = ru0 + (s - NCS); kofs = w0;
#pragma unroll
                for (int q = 0; q < NQ; ++q) { const int rsq = min(max(r + q - 4, 0), 56); act[q] = (hh == 0) && (kr <= 63) && (kr >= rsq) && (kr <= rsq + 7); } }
            else { const int kb = t0g - 128 + 64 * (s - NCS) + 32 * hh; act[0] = act[1] = (kb + 31 >= t0 - 128) && (kb <= t0 + 143); }
            if (act[0] || act[1]) {
                const bf16_t* Ks = sbuf + (s & 1) * (2 * 64 * SROW); const bf16_t* Vs = Ks + 64 * SROW;
                KVF f;
                f.k[0] = *(const bf16x8_t*)(Ks + (kofs + n) * SROW + 8 * g); f.k[1] = *(const bf16x8_t*)(Ks + (kofs + n) * SROW + 32 + 8 * g);
                f.k[2] = *(const bf16x8_t*)(Ks + (kofs + 16 + n) * SROW + 8 * g); f.k[3] = *(const bf16x8_t*)(Ks + (kofs + 16 + n) * SROW + 32 + 8 * g);
#pragma unroll
                for (int t = 0; t < 4; ++t) { f.v[t][0] = *(const bf16x4_t*)(Vs + (16 * t + n) * SROW + kofs + 4 * g); f.v[t][1] = *(const bf16x4_t*)(Vs + (16 * t + n) * SROW + kofs + 16 + 4 * g); }
                if (s < NCS) {
#pragma unroll
                    for (int q = 0; q < NQ; ++q) attn_tile(am[q], asum[q], ao[q], qb[q], f, MaskNone());
                } else if (kind == 0) { const int kr = ru0 + (s - NCS);
#pragma unroll
                    for (int q = 0; q < NQ; ++q) if (act[q]) { const int c = cb * 16 + n, csq = min(max(c - 8, 0), 48), kc0 = w0 + 4 * g;
                        MaskNA mk{kc0 - csq, rpb_s + (h0 * 15 + (kr - (r + q) + 7)) * 64 + (kc0 - c + 15 + 16)}; attn_tile(am[q], asum[q], ao[q], qb[q], f, mk); }
                } else if (kind == 1) { const int kb = t0g - 128 + 64 * (s - NCS) + 32 * hh;
                    if (kb >= t0 - 113 && kb + 31 <= t0 + 128 && kb >= 0 && kb + 31 < SEQ) {
#pragma unroll
                        for (int q = 0; q < NQ; ++q) attn_tile(am[q], asum[q], ao[q], qb[q], f, MaskNone());
                    } else { MaskWA mk{t0 + n, kb + 4 * g};
#pragma unroll
                        for (int q = 0; q < NQ; ++q) attn_tile(am[q], asum[q], ao[q], qb[q], f, mk); }
                }
            }
        }
        if (s + 1 < NS) stage_store(s + 1, kst, vst);
        __syncthreads();
    };
#pragma unroll 1
    for (int s = 0; s < NS; s += 2) { do_step(s, kr0, vr0, kr1, vr1); if (s + 1 < NS) do_step(s + 1, kr1, vr1, kr0, vr0); }
#pragma unroll
    for (int q = 0; q < NQ; ++q) {
        float lt = asum[q].x;
        float osc = 1.f;
        if (kind == 1 || kind == 3) { const float sk = F.p.wa_sink[l * 8 + h0 + q] * 1.44269504089f, mf = fmaxf(am[q], sk); osc = __builtin_amdgcn_exp2f(am[q] - mf); lt = lt * osc + __builtin_amdgcn_exp2f(sk - mf); }
        const float inv = osc / lt;
        char* obase = (char*)F.BR(); const unsigned oo = (unsigned)(qrow0 + q * QRS + n) * 4096u + (unsigned)(brcol0 + q * QCS + 4 * g) * 2u;
#pragma unroll
        for (int t = 0; t < 4; ++t) { const f32x4 v = ao[q][t] * inv; u32x2 o2; o2.x = pk2(v.x, v.y); o2.y = pk2(v.z, v.w); *(u32x2*)(obase + oo + 32u * t) = o2; }
    }
}

template <int DK, bool HG>
__device__ __forceinline__ void prescan_combo(Frame& F, int l, int b, int h, int first, int step) {
    constexpr int NDP = DK / 2, NTG = NTHR / NDP, TPT = 64 / NTG;
    REFRESH(F);
    const int tid = F.tid, dp = tid % NDP, tg = tid / NDP;
    float* TOT = F.smf;
    bf16_t* LRS = (bf16_t*)(F.smf + 2 * 2 * NTG * DK);
    char* p1b = (char*)F.P1();
    f32x2_t lw2[HG ? 1 : 32], lb2[2];
    lb2[0] = (f32x2_t){0.f, 0.f}; lb2[1] = lb2[0]; lw2[0] = lb2[0];
    if (!HG) {
#pragma unroll
        for (int zr = 0; zr < 32; ++zr) { const float* wp = F.p.gla_lr_w + ((size_t)(l * 2 + (zr >> 4)) * 16 + (zr & 15)) * 256 + h * 64 + 2 * dp; lw2[HG ? 0 : zr] = (f32x2_t){wp[0], wp[1]}; }
#pragma unroll
        for (int z = 0; z < 2; ++z) { const float* bp = F.p.gla_lr_b + (l * 2 + z) * 256 + h * 64 + 2 * dp; lb2[z] = (f32x2_t){bp[0], bp[1]}; }
    }
    const int qcol = HG ? PC_DQ + h * 128 + 2 * dp : PC_AQ + h * 64 + 2 * dp, kcol = HG ? PC_DF + h * 128 + 2 * dp : PC_AK + h * 64 + 2 * dp;
    float* ebase = F.ESC() + (HG ? 32 * 68 * 128 : 0);
    unsigned rq[TPT], rk[TPT], rk1[HG ? TPT : 1]; u32x4 rlp = {0u, 0u, 0u, 0u};
    rk1[0] = 0u;
#define PS_LOAD(nbk_) do { const int row0_ = seq_row((nbk_) * 64, b, 0); unsigned o_ = (unsigned)(row0_ + tg * TPT) * (unsigned)(NP1 * 2); \
        _Pragma("unroll") for (int tt = 0; tt < TPT; ++tt) { rq[tt] = *(const unsigned*)(p1b + (o_ + (unsigned)(qcol * 2))); rk[tt] = *(const unsigned*)(p1b + (o_ + (unsigned)(kcol * 2))); \
            if (HG) rk1[HG ? tt : 0] = *(const unsigned*)(p1b + (o_ + (unsigned)((kcol + 512) * 2))); o_ += (unsigned)(NP1 * 2); } \
        if (!HG && tid < 256) rlp = *(const u32x4*)(p1b + ((unsigned)(row0_ + (tid >> 2)) * (unsigned)(NP1 * 2) + (unsigned)((PC_ALR + (tid & 3) * 8) * 2))); } while (0)
    int nbk = first, par = 0;
    if (nbk < 68) PS_LOAD(nbk);
#pragma unroll 1
    for (; nbk < 68; nbk += step, par ^= 1) {
        float* tot = TOT + par * (2 * NTG * DK);
        bf16_t* lrs = LRS + par * (64 * 32);
        if (!HG) { if (tid < 256) *(u32x4*)(lrs + (tid >> 2) * 32 + (tid & 3) * 8) = rlp; __syncthreads(); }
        const int row0 = seq_row(nbk * 64, b, 0);
        f32x2_t qv[TPT], kv0[TPT], kv1[HG ? TPT : 1], cs0[TPT], cs1[TPT];
#pragma unroll
        for (int tt = 0; tt < TPT; ++tt) {
            qv[tt] = (f32x2_t){__uint_as_float(rq[tt] << 16), __uint_as_float(rq[tt] & 0xffff0000u)};
            const f32x2_t kr = {__uint_as_float(rk[tt] << 16), __uint_as_float(rk[tt] & 0xffff0000u)};
            if (HG) { const unsigned r1 = rk1[HG ? tt : 0]; const f32x2_t k1 = {__uint_as_float(r1 << 16), __uint_as_float(r1 & 0xffff0000u)};
                cs0[tt] = kr; cs1[tt] = k1;
                kv0[tt] = (f32x2_t){1.f - __expf(kr.x), 1.f - __expf(kr.y)}; kv1[HG ? tt : 0] = (f32x2_t){1.f - __expf(k1.x), 1.f - __expf(k1.y)}; }
            else kv0[tt] = kr;
        }
        if (nbk + step < 68) PS_LOAD(nbk + step);
        if (!HG) {
#pragma unroll
            for (int tt = 0; tt < TPT; ++tt) {
                const u32x4* lp = (const u32x4*)(lrs + (tg * TPT + tt) * 32);
                f32x2_t lg[2] = {lb2[0], lb2[1]};
#pragma unroll
                for (int z = 0; z < 2; ++z) { const u32x4 a0 = lp[2 * z], a1 = lp[2 * z + 1]; const unsigned u8[8] = {a0.x, a0.y, a0.z, a0.w, a1.x, a1.y, a1.z, a1.w};
#pragma unroll
                    for (int r2 = 0; r2 < 8; ++r2) { const float v0 = __uint_as_float(u8[r2] << 16), v1 = __uint_as_float(u8[r2] & 0xffff0000u);
                        lg[z] += (f32x2_t){v0, v0} * lw2[HG ? 0 : z * 16 + 2 * r2]; lg[z] += (f32x2_t){v1, v1} * lw2[HG ? 0 : z * 16 + 2 * r2 + 1]; } }
#pragma unroll
                for (int z = 0; z < 2; ++z) {
                    const f32x2_t gz = {(fminf(lg[z].x, 0.f) - __logf(1.f + __expf(-fabsf(lg[z].x)))) * (1.f / 16.f), (fminf(lg[z].y, 0.f) - __logf(1.f + __expf(-fabsf(lg[z].y)))) * (1.f / 16.f)};
                    if (z == 0) cs0[tt] = gz; else cs1[tt] = gz; }
            }
        }
#pragma unroll
        for (int tt = 1; tt < TPT; ++tt) { cs0[tt] += cs0[tt - 1]; cs1[TPT - 1 - tt] += cs1[TPT - tt]; }
        *(f32x2_t*)(tot + (0 * NTG + tg) * DK + 2 * dp) = cs0[TPT - 1];
        *(f32x2_t*)(tot + (1 * NTG + tg) * DK + 2 * dp) = cs1[0];
        __syncthreads();
        f32x2_t offs0 = {0.f, 0.f}, mid0 = offs0, last0 = offs0, offs1 = offs0, mid1 = offs0, last1 = offs0;
#pragma unroll
        for (int t2 = 0; t2 < NTG; ++t2) { const f32x2_t v0 = *(const f32x2_t*)(tot + (0 * NTG + t2) * DK + 2 * dp), v1 = *(const f32x2_t*)(tot + (1 * NTG + t2) * DK + 2 * dp);
            if (t2 < tg) offs0 += v0; if (t2 < NTG / 2) mid0 += v0; last0 += v0;
            if (t2 > tg) offs1 += v1; if (t2 >= NTG / 2) mid1 += v1; last1 += v1; }
        const f32x2_t d0 = offs0 - mid0, d1 = offs1 - mid1;
        unsigned ro = (unsigned)(row0 + tg * TPT);
#pragma unroll
        for (int tt = 0; tt < TPT; ++tt, ++ro) {
            const float x00 = fminf(fmaxf(cs0[tt].x + d0.x, -80.f), 80.f), x01 = fminf(fmaxf(cs0[tt].y + d0.y, -80.f), 80.f);
            const float x10 = fminf(fmaxf(cs1[tt].x + d1.x, -80.f), 80.f), x11 = fminf(fmaxf(cs1[tt].y + d1.y, -80.f), 80.f);
            const f32x2_t k1v = kv1[HG ? tt : 0], k1 = HG ? k1v : kv0[tt];
            const unsigned qd0 = pk2(qv[tt].x * __expf(x00), qv[tt].y * __expf(x01)), kd0 = pk2(kv0[tt].x * __expf(-x00), kv0[tt].y * __expf(-x01));
            const unsigned qd1 = pk2(qv[tt].x * __expf(x10), qv[tt].y * __expf(x11)), kd1 = pk2(k1.x * __expf(-x10), k1.y * __expf(-x11));
            const unsigned o_ = ro * (unsigned)(NP1 * 2);
            *(unsigned*)(p1b + (o_ + (unsigned)(qcol * 2))) = qd0; *(unsigned*)(p1b + (o_ + (unsigned)(kcol * 2))) = kd0;
            if (HG) { *(unsigned*)(p1b + (o_ + (unsigned)((kcol + 512) * 2))) = kd1; *(unsigned*)((char*)F.BR() + (ro * 4096u + (unsigned)((1536 + h * 128 + 2 * dp) * 2))) = qd1; }
            else { *(unsigned*)((char*)F.SC1() + (ro * 1024u + (unsigned)((h * 64 + 2 * dp) * 2))) = qd1; *(unsigned*)((char*)F.SC1() + (ro * 1024u + (unsigned)((256 + h * 64 + 2 * dp) * 2))) = kd1; }
        }
        if (tg == 0) {
            float* e0 = ebase + (size_t)(((b * 4 + h) * 2 + 0) * 68 + nbk) * (2 * DK), *e1 = ebase + (size_t)(((b * 4 + h) * 2 + 1) * 68 + (nbk < 4 ? 3 - nbk : 71 - nbk)) * (2 * DK);
            *(f32x2_t*)(e0 + 2 * dp) = (f32x2_t){__expf(mid0.x), __expf(mid0.y)}; *(f32x2_t*)(e0 + DK + 2 * dp) = (f32x2_t){__expf(last0.x - mid0.x), __expf(last0.y - mid0.y)};
            *(f32x2_t*)(e1 + 2 * dp) = (f32x2_t){__expf(mid1.x), __expf(mid1.y)}; *(f32x2_t*)(e1 + DK + 2 * dp) = (f32x2_t){__expf(last1.x - mid1.x), __expf(last1.y - mid1.y)};
        }
    }
    __syncthreads();
#undef PS_LOAD
}
__device__ __forceinline__ void phase_prescan(Frame& F, int l) {
    if (F.nb >= 32) { const int combo = F.bid & 31, b = (combo >> 2) & 3, h = combo & 3;
        if ((combo >> 4) == 0) prescan_combo<64, false>(F, l, b, h, F.bid >> 5, F.nb >> 5); else prescan_combo<128, true>(F, l, b, h, F.bid >> 5, F.nb >> 5);
    } else {
        for (int combo = F.bid; combo < 32; combo += F.nb) { const int b = (combo >> 2) & 3, h = combo & 3;
            if ((combo >> 4) == 0) prescan_combo<64, false>(F, l, b, h, 0, 1); else prescan_combo<128, true>(F, l, b, h, 0, 1); }
    }
}

template <int DK, bool HG>
__device__ __forceinline__ void scan_mfma(Frame& F, int l, int b, int h, int z, int vh, unsigned char* lds) {
    constexpr int NDP = DK / 2, NTG = NTHR / NDP, TPT = 64 / NTG, QS = DK + 8, TS = 72, NDT = DK / 16, PPR = DK / 8, NQP = (64 * PPR) / NTHR;
    bf16_t* QD = (bf16_t*)lds; bf16_t* KD = QD + 64 * QS; bf16_t* KDT = KD + 64 * QS; bf16_t* VTs = KDT + DK * TS; bf16_t* AM = VTs + 64 * TS; bf16_t* ST = AM + 64 * TS;
    float* E1s = (float*)(ST + 64 * QS); float* E2s = E1s + DK;
    REFRESH(F);
    const int tid = F.tid, lane = F.lane, w = F.wave, n = lane & 15, g = lane >> 4;
    const int dp = tid % NDP, tg = tid / NDP, vp = tid & 31, vg = tid >> 5;
    const int vt = w & 3, wh = w >> 2;
    const char* p1b = (const char*)F.P1();
    const char* qb; const char* kb; unsigned qstr, kstr, qoff, koff;
    if (HG) { kb = p1b; kstr = NP1 * 2; koff = (unsigned)((PC_DF + z * 512 + h * 128) * 2);
        if (z == 0) { qb = p1b; qstr = NP1 * 2; qoff = (unsigned)((PC_DQ + h * 128) * 2); } else { qb = (const char*)F.BR(); qstr = 4096u; qoff = (unsigned)((1536 + h * 128) * 2); } }
    else if (z == 0) { qb = p1b; kb = p1b; qstr = kstr = NP1 * 2; qoff = (unsigned)((PC_AQ + h * 64) * 2); koff = (unsigned)((PC_AK + h * 64) * 2); }
    else { qb = (const char*)F.SC1(); kb = qb; qstr = kstr = 1024u; qoff = (unsigned)(h * 64 * 2); koff = (unsigned)((256 + h * 64) * 2); }
    const float* eb = F.ESC() + (HG ? 32 * 68 * 128 : 0) + (size_t)(((b * 4 + h) * 2 + z) * 68) * (2 * DK);
    f32x4 accS[NDT / 2];
#pragma unroll
    for (int i = 0; i < NDT / 2; ++i) accS[i] = (f32x4){0.f, 0.f, 0.f, 0.f};
    u32x4 rqp[NQP]; unsigned rk[TPT], rv[4]; float re = 0.f;
    const int vcol = (HG ? PC_DI : PC_AV) + h * 128 + 64 * vh + 2 * vp;
    const int sgn = z ? -1 : 1; const int rstep = sgn * NP1 * 2;
#define SCAN_LOAD(c) do { const int row0_ = seq_row((c) * 64, b, z); \
        _Pragma("unroll") for (int j = 0; j < NQP; ++j) { const int pi_ = tid + NTHR * j; rqp[j] = *(const u32x4*)(qb + ((unsigned)(row0_ + sgn * (pi_ / PPR)) * qstr + qoff + (unsigned)((pi_ % PPR) * 16))); } \
        _Pragma("unroll") for (int tt = 0; tt < TPT; ++tt) rk[tt] = *(const unsigned*)(kb + ((unsigned)(row0_ + sgn * (tg * TPT + tt)) * kstr + koff + (unsigned)(dp * 4))); \
        int ov_ = (row0_ + sgn * vg * 4) * (NP1 * 2) + vcol * 2; \
        _Pragma("unroll") for (int tt = 0; tt < 4; ++tt) { rv[tt] = *(const unsigned*)(p1b + (unsigned)ov_); ov_ += rstep; } \
        if (tid < 2 * DK) re = eb[(c) * (2 * DK) + tid]; } while (0)
    SCAN_LOAD(0);
    constexpr int NCH = (LC + SEQ) / 64;
#pragma unroll 1
    for (int c = 0; c < NCH; ++c) {
        __syncthreads();
#pragma unroll
        for (int j = 0; j < NQP; ++j) { const int pi_ = tid + NTHR * j; *(u32x4*)(QD + (pi_ / PPR) * QS + (pi_ % PPR) * 8) = rqp[j]; }
#pragma unroll
        for (int tt = 0; tt < TPT; ++tt) *(unsigned*)(KD + (tg * TPT + tt) * QS + 2 * dp) = rk[tt];
        {   unsigned kdt[2][TPT / 2];
#pragma unroll
            for (int t2 = 0; t2 < TPT / 2; ++t2) { kdt[0][t2] = (rk[2 * t2] & 0xffffu) | (rk[2 * t2 + 1] << 16); kdt[1][t2] = (rk[2 * t2] >> 16) | (rk[2 * t2 + 1] & 0xffff0000u); }
#pragma unroll
            for (int e = 0; e < 2; ++e) {
                bf16_t* dst = KDT + (2 * dp + e) * TS + tg * TPT;
                if (TPT == 8) { u32x4 o; o.x = kdt[e][0]; o.y = kdt[e][1]; o.z = kdt[e][TPT / 2 - 2]; o.w = kdt[e][TPT / 2 - 1]; *(u32x4*)dst = o; }
                else { u32x2 o; o.x = kdt[e][0]; o.y = kdt[e][1]; *(u32x2*)dst = o; }
            }
        }
        if (tid < 2 * DK) E1s[tid] = re;
        {   u32x2 o0, o1;
            o0.x = (rv[0] & 0xffffu) | (rv[1] << 16); o0.y = (rv[2] & 0xffffu) | (rv[3] << 16);
            o1.x = (rv[0] >> 16) | (rv[1] & 0xffff0000u); o1.y = (rv[2] >> 16) | (rv[3] & 0xffff0000u);
            *(u32x2*)(VTs + (2 * vp) * TS + vg * 4) = o0; *(u32x2*)(VTs + (2 * vp + 1) * TS + vg * 4) = o1; }
        if (c + 1 < NCH) SCAN_LOAD(c + 1);
        __syncthreads();
#pragma unroll
        for (int i = 0; i < NDT / 2; ++i) { const int dt = wh * (NDT / 2) + i; accS[i] = accS[i] * *(const f32x4*)&E1s[16 * dt + 4 * g];
            u32x2 o; o.x = pk2(accS[i].x, accS[i].y); o.y = pk2(accS[i].z, accS[i].w); *(u32x2*)(ST + (16 * vt + n) * QS + 16 * dt + 4 * g) = o; }
        {   const int it = w >> 1, jt0 = 2 * (w & 1);
            f32x4 d0 = {0.f, 0.f, 0.f, 0.f}, d1 = {0.f, 0.f, 0.f, 0.f};
            if (jt0 <= it) {
                bf16x8_t qf[DK / 32], k0f[DK / 32], k1f[DK / 32];
#pragma unroll
                for (int ks = 0; ks < DK / 32; ++ks) { qf[ks] = *(const bf16x8_t*)(QD + (16 * it + n) * QS + 32 * ks + 8 * g); k0f[ks] = *(const bf16x8_t*)(KD + (16 * jt0 + n) * QS + 32 * ks + 8 * g); k1f[ks] = *(const bf16x8_t*)(KD + (16 * (jt0 + 1) + n) * QS + 32 * ks + 8 * g); }
#pragma unroll
                for (int ks = 0; ks < DK / 32; ++ks) { d0 = __builtin_amdgcn_mfma_f32_16x16x32_bf16(k0f[ks], qf[ks], d0, 0, 0, 0); d1 = __builtin_amdgcn_mfma_f32_16x16x32_bf16(k1f[ks], qf[ks], d1, 0, 0, 0); }
                const int i = 16 * it + n, j0 = 16 * jt0 + 4 * g, j1 = j0 + 16;
                d0.x = (j0 + 0 <= i) ? d0.x : 0.f; d0.y = (j0 + 1 <= i) ? d0.y : 0.f; d0.z = (j0 + 2 <= i) ? d0.z : 0.f; d0.w = (j0 + 3 <= i) ? d0.w : 0.f;
                d1.x = (j1 + 0 <= i) ? d1.x : 0.f; d1.y = (j1 + 1 <= i) ? d1.y : 0.f; d1.z = (j1 + 2 <= i) ? d1.z : 0.f; d1.w = (j1 + 3 <= i) ? d1.w : 0.f;
            }
            u32x2 o; o.x = pk2(d0.x, d0.y); o.y = pk2(d0.z, d0.w); *(u32x2*)(AM + (16 * it + n) * TS + 16 * jt0 + 4 * g) = o;
            o.x = pk2(d1.x, d1.y); o.y = pk2(d1.z, d1.w); *(u32x2*)(AM + (16 * it + n) * TS + 16 * (jt0 + 1) + 4 * g) = o;
        }
        __syncthreads();
        {   f32x4 o[2];
#pragma unroll
            for (int ii = 0; ii < 2; ++ii) o[ii] = (f32x4){0.f, 0.f, 0.f, 0.f};
#pragma unroll
            for (int ks = 0; ks < 2; ++ks) { const bf16x8_t af = *(const bf16x8_t*)(VTs + (16 * vt + n) * TS + 32 * ks + 8 * g); bf16x8_t bf[2];
#pragma unroll
                for (int ii = 0; ii < 2; ++ii) bf[ii] = *(const bf16x8_t*)(AM + (16 * (2 * wh + ii) + n) * TS + 32 * ks + 8 * g);
#pragma unroll
                for (int ii = 0; ii < 2; ++ii) o[ii] = __builtin_amdgcn_mfma_f32_16x16x32_bf16(af, bf[ii], o[ii], 0, 0, 0); }
#pragma unroll
            for (int ks = 0; ks < DK / 32; ++ks) { const bf16x8_t af = *(const bf16x8_t*)(ST + (16 * vt + n) * QS + 32 * ks + 8 * g); bf16x8_t bf[2];
#pragma unroll
                for (int ii = 0; ii < 2; ++ii) bf[ii] = *(const bf16x8_t*)(QD + (16 * (2 * wh + ii) + n) * QS + 32 * ks + 8 * g);
#pragma unroll
                for (int ii = 0; ii < 2; ++ii) o[ii] = __builtin_amdgcn_mfma_f32_16x16x32_bf16(af, bf[ii], o[ii], 0, 0, 0); }
            const int row0 = seq_row(c * 64, b, z) + sgn * (32 * wh + n), vc = h * 128 + 64 * vh + 16 * vt + 4 * g;
            char* dstb; unsigned doff; int dstride;
            if (HG) { dstb = (char*)F.ODH(); doff = (unsigned)row0 * 2048u + (unsigned)(z * 512 + vc) * 2u; dstride = sgn * 16 * 2048; }
            else if (z == 0) { dstb = (char*)F.BR(); doff = (unsigned)row0 * 4096u + (unsigned)vc * 2u; dstride = sgn * 16 * 4096; }
            else { dstb = (char*)F.OBA(); doff = (unsigned)row0 * 1024u + (unsigned)vc * 2u; dstride = sgn * 16 * 1024; }
#pragma unroll
            for (int ii = 0; ii < 2; ++ii) { u32x2 o2; o2.x = pk2(o[ii].x, o[ii].y); o2.y = pk2(o[ii].z, o[ii].w); *(u32x2*)(dstb + (unsigned)((int)doff + ii * dstride)) = o2; }
        }
#pragma unroll
        for (int ks = 0; ks < 2; ++ks) { const bf16x8_t bv = *(const bf16x8_t*)(VTs + (16 * vt + n) * TS + 32 * ks + 8 * g); bf16x8_t af[NDT / 2];
#pragma unroll
            for (int i = 0; i < NDT / 2; ++i) af[i] = *(const bf16x8_t*)(KDT + (16 * (wh * (NDT / 2) + i) + n) * TS + 32 * ks + 8 * g);
#pragma unroll
            for (int i = 0; i < NDT / 2; ++i) accS[i] = __builtin_amdgcn_mfma_f32_16x16x32_bf16(af[i], bv, accS[i], 0, 0, 0); }
#pragma unroll
        for (int i = 0; i < NDT / 2; ++i) accS[i] = accS[i] * *(const f32x4*)&E2s[16 * (wh * (NDT / 2) + i) + 4 * g];
    }
    __syncthreads();
#undef SCAN_LOAD
}

__device__ __forceinline__ void phase_mix(Frame& F, int l) {
    const int n_scan = 128;
    const int nsb = (F.nb > 192) ? 128 : 0;
    if (nsb == 0 || F.bid < nsb) {
        for (int it = F.bid; it < n_scan; it += (nsb ? nsb : F.nb)) {
            const int br = it >> 6, r = (it >> 1) & 31, vh = it & 1, b = r >> 3, h = (r >> 1) & 3, z = r & 1;
            if (br == 0) scan_mfma<64, false>(F, l, b, h, z, vh, (unsigned char*)F.smf); else scan_mfma<128, true>(F, l, b, h, z, vh, (unsigned char*)F.smf);
        }
        __syncthreads();
    }
    float* rpb_s = F.smf;
    {   float tv[(8 * 15 * 64) / NTHR];
#pragma unroll
        for (int k = 0; k < (8 * 15 * 64) / NTHR; ++k) { const int i = F.tid + k * NTHR, dcp = i & 63, hr = i >> 6; tv[k] = (dcp >= 16 && dcp < 47) ? F.p.na_rpb[l * 8 * 465 + hr * 31 + (dcp - 16)] : 0.f; }
#pragma unroll
        for (int k = 0; k < (8 * 15 * 64) / NTHR; ++k) rpb_s[F.tid + k * NTHR] = tv[k] * 1.44269504089f; }
    bf16_t* sbuf = (bf16_t*)(F.smf + 8 * 15 * 64);
    unsigned* qhead = F.cnt() + 64 + l * 16;
    int* cur = (int*)((unsigned char*)F.smf - LDS_STAGE + 32);
    const int n_wa = 512, n_na = 512, n_cna = (l == 0) ? 32 : 0, n_cwa = (l == 0) ? 32 : 0, total = n_wa + n_na + n_cna + n_cwa;
    int nxt = 0;
    if (F.tid == 0) nxt = (int)atomicAdd(qhead, 1u);
    for (;;) {
        __syncthreads();
        if (F.tid == 0) *cur = nxt;
        __syncthreads();
        const int it = *cur;
        if (it >= total) break;
        if (F.tid == 0) nxt = (int)atomicAdd(qhead, 1u);
        if (it < n_wa) attn_block<1>(F, l, it, rpb_s, sbuf);
        else if (it < n_wa + n_na) attn_block<0>(F, l, it - n_wa, rpb_s, sbuf);
        else if (it < n_wa + n_na + n_cna) attn_block<2>(F, l, it - n_wa - n_na, rpb_s, sbuf);
        else attn_block<3>(F, l, it - n_wa - n_na - n_cna, rpb_s, sbuf);
    }
}

__device__ __forceinline__ void phase_prepad(Frame& F, int l) {
    const int gw = F.bid * 8 + F.wave, ngw = F.nb * 8, npairs = ((l == 0) ? NROW : NTOK) / 2, c0 = F.lane * 8;
    for (int pi = gw; pi < npairs; pi += ngw) {
        u32x4 ra[2][2], rb[2][2], rg[2][2];
#pragma unroll
        for (int q = 0; q < 2; ++q) { const size_t row = (size_t)pi * 2 + q;
            ra[q][0] = *(const u32x4*)(F.BR() + row * 2048 + c0); rb[q][0] = *(const u32x4*)(F.OBA() + row * 512 + c0); rg[q][0] = *(const u32x4*)(F.P1() + row * NP1 + PC_AG + c0);
            ra[q][1] = *(const u32x4*)(F.ODH() + row * 1024 + c0); rb[q][1] = *(const u32x4*)(F.ODH() + row * 1024 + 512 + c0); rg[q][1] = *(const u32x4*)(F.P1() + row * NP1 + PC_DG + c0); }
#pragma unroll
        for (int q = 0; q < 2; ++q)
#pragma unroll
            for (int br = 0; br < 2; ++br) {
                const unsigned ua[4] = {ra[q][br].x, ra[q][br].y, ra[q][br].z, ra[q][br].w}, ub[4] = {rb[q][br].x, rb[q][br].y, rb[q][br].z, rb[q][br].w}, ug[4] = {rg[q][br].x, rg[q][br].y, rg[q][br].z, rg[q][br].w};
                float o[8], g[8]; float ss = 0.f;
#pragma unroll
                for (int j = 0; j < 4; ++j) { o[2 * j] = __uint_as_float(ua[j] << 16) + __uint_as_float(ub[j] << 16); o[2 * j + 1] = __uint_as_float(ua[j] & 0xffff0000u) + __uint_as_float(ub[j] & 0xffff0000u);
                    g[2 * j] = __uint_as_float(ug[j] << 16); g[2 * j + 1] = __uint_as_float(ug[j] & 0xffff0000u); ss += o[2 * j] * o[2 * j] + o[2 * j + 1] * o[2 * j + 1]; }
                ss += __shfl_xor(ss, 1); ss += __shfl_xor(ss, 2); ss += __shfl_xor(ss, 4); ss += __shfl_xor(ss, 8);
                const float rs = rsqrtf(ss * (1.f / 128.f) + 1e-6f);
#pragma unroll
                for (int j = 0; j < 8; ++j) o[j] = o[j] * rs * siluf_(g[j]);
                st8(F.BR() + ((size_t)pi * 2 + q) * 2048 + (br ? 1536 : 0) + c0, o);
            }
    }
}

__device__ __forceinline__ void phase_ln1(Frame& F, int l) {
    const int nrows = (l == 0) ? NROW : NTOK, ngroups = nrows / 64;
    const float* lg = F.p.ln_g + (size_t)(l * 2 + 0) * DM; const float* lbb = F.p.ln_b + (size_t)(l * 2 + 0) * DM;
    float* part = F.smf;
    const int wv = __builtin_amdgcn_readfirstlane(F.wave);
    float* stg = F.smf + 8 * 36 * 64 + wv * (64 * 17 + 16 * 40);
    float* wl = stg + 64 * 17;
    for (int grp = F.bid; grp < ngroups; grp += F.nb) {
        const int row0 = grp * 64, rb = row_batch(row0);
        const float* mv = F.modv() + ((size_t)l * 5 + rb) * 6144;
        float* xg = row0 < NTOK ? F.p.out + (size_t)row0 * DM : F.cxm() + (size_t)(row0 - NTOK) * DM;
#pragma unroll 1
        for (int rr = 0; rr < 8; rr += 2) {
            const int lr = wv * 8 + rr; float* xr = xg + (size_t)lr * DM;
            f32x4 v[2][4]; float s[2] = {0.f, 0.f};
#pragma unroll
            for (int q = 0; q < 2; ++q)
#pragma unroll
                for (int j = 0; j < 4; ++j) v[q][j] = *(const f32x4*)(xr + (size_t)q * DM + j * 256 + F.lane * 4);
#pragma unroll
            for (int q = 0; q < 2; ++q)
#pragma unroll
                for (int j = 0; j < 4; ++j) s[q] += (v[q][j].x + v[q][j].y) + (v[q][j].z + v[q][j].w);
#pragma unroll
            for (int o = 1; o < 64; o <<= 1) { s[0] += __shfl_xor(s[0], o); s[1] += __shfl_xor(s[1], o); }
            float s2[2] = {0.f, 0.f};
#pragma unroll
            for (int q = 0; q < 2; ++q) { const float mean = s[q] * (1.f / DM);
#pragma unroll
                for (int j = 0; j < 4; ++j) { v[q][j] = v[q][j] - mean; s2[q] += (v[q][j].x * v[q][j].x + v[q][j].y * v[q][j].y) + (v[q][j].z * v[q][j].z + v[q][j].w * v[q][j].w); } }
#pragma unroll
            for (int o = 1; o < 64; o <<= 1) { s2[0] += __shfl_xor(s2[0], o); s2[1] += __shfl_xor(s2[1], o); }
#pragma unroll
            for (int j = 0; j < 4; ++j) { const int d = j * 256 + F.lane * 4;
                const f32x4 g4 = *(const f32x4*)(lg + d), b4 = *(const f32x4*)(lbb + d), m3 = *(const f32x4*)(mv + 3 * 1024 + d), m4 = *(const f32x4*)(mv + 4 * 1024 + d);
#pragma unroll
                for (int q = 0; q < 2; ++q) { const float rstd = rsqrtf(s2[q] * (1.f / DM) + LN_EPS);
                    const f32x4 xn = v[q][j] * rstd * g4 + b4;
                    *(f32x4*)(xr + (size_t)q * DM + d) = xn;
                    const f32x4 h2 = xn * (1.f + m4) + m3;
                    u32x2 o2; o2.x = pk2(h2.x, h2.y); o2.y = pk2(h2.z, h2.w);
                    *(u32x2*)(F.HX2() + (size_t)(row0 + lr + q) * DM + d) = o2; } }
        }
        __syncthreads();
        {   f32x4 acc[4][3];
#pragma unroll
            for (int mt = 0; mt < 4; ++mt)
#pragma unroll
                for (int nt = 0; nt < 3; ++nt) acc[mt][nt] = (f32x4){0.f, 0.f, 0.f, 0.f};
            const float* wgp = F.p.moe_w_group + ((size_t)l * DM + wv * 128) * 4; const float* wep = F.p.moe_w_expert + ((size_t)l * DM + wv * 128) * 32;
            const float* m3p = mv + 3 * 1024 + wv * 128; const float* m4p = mv + 4 * 1024 + wv * 128;
            const int ln = F.lane & 15, lk = F.lane >> 4;
#pragma unroll 1
            for (int dc = 0; dc < 128; dc += 16) {
                f32x4 t[4]; float bw[4][3];
#pragma unroll
                for (int i = 0; i < 4; ++i) t[i] = *(const f32x4*)(xg + (size_t)(16 * i + (F.lane >> 2)) * DM + wv * 128 + dc + (F.lane & 3) * 4);
                const f32x4 m3v = *(const f32x4*)(m3p + dc + (F.lane & 3) * 4), m4v = *(const f32x4*)(m4p + dc + (F.lane & 3) * 4);
#pragma unroll
                for (int ks = 0; ks < 4; ++ks) { const int d = dc + 4 * ks + lk; bw[ks][0] = wep[(size_t)d * 32 + ln]; bw[ks][1] = wep[(size_t)d * 32 + 16 + ln]; bw[ks][2] = (ln < 4) ? wgp[(size_t)d * 4 + ln] : 0.f; }
#pragma unroll
                for (int i = 0; i < 4; ++i) { float* sp = stg + (16 * i + (F.lane >> 2)) * 17 + (F.lane & 3) * 4;
                    sp[0] = t[i].x * (1.f + m4v.x) + m3v.x; sp[1] = t[i].y * (1.f + m4v.y) + m3v.y; sp[2] = t[i].z * (1.f + m4v.z) + m3v.z; sp[3] = t[i].w * (1.f + m4v.w) + m3v.w; }
                asm volatile("s_waitcnt lgkmcnt(0)" ::: "memory");
#pragma unroll
                for (int ks = 0; ks < 4; ++ks)
#pragma unroll
                    for (int mt = 0; mt < 4; ++mt) { const float av = stg[(16 * mt + ln) * 17 + 4 * ks + lk];
#pragma unroll
                        for (int nt = 0; nt < 3; ++nt) acc[mt][nt] = __builtin_amdgcn_mfma_f32_16x16x4f32(av, bw[ks][nt], acc[mt][nt], 0, 0, 0); }
                asm volatile("s_waitcnt lgkmcnt(0)" ::: "memory");
            }
#pragma unroll
            for (int mt = 0; mt < 4; ++mt)
#pragma unroll
                for (int nt = 0; nt < 3; ++nt) { const int oi = (nt == 2) ? ln : 4 + 16 * nt + ln;
                    if (nt < 2 || ln < 4) {
#pragma unroll
                        for (int r = 0; r < 4; ++r) part[(wv * 36 + oi) * 64 + 16 * mt + 4 * lk + r] = acc[mt][nt][r]; } }
        }
        __syncthreads();
        if (wv == 0) {
            const int row = row0 + F.lane;
            float gl[4]; int gi = 0; float gm = -3.4e38f;
#pragma unroll
            for (int o = 0; o < 4; ++o) { float t = F.p.moe_b_group[l * 4 + o];
#pragma unroll
                for (int w2 = 0; w2 < 8; ++w2) t += part[(w2 * 36 + o) * 64 + F.lane];
                gl[o] = t; if (t > gm) { gm = t; gi = o; } }
            float gs = 0.f;
#pragma unroll
            for (int o = 0; o < 4; ++o) gs += expf(gl[o] - gm);
            const float gwt = 1.f / gs;
            float e1 = -3.4e38f, e2 = -3.4e38f; int i1 = 0, i2 = 0;
#pragma unroll
            for (int o8 = 0; o8 < 8; ++o8) { const int o = gi * 8 + o8; float ev = F.p.moe_b_expert[l * 32 + o];
#pragma unroll
                for (int w2 = 0; w2 < 8; ++w2) ev += part[(w2 * 36 + 4 + o) * 64 + F.lane];
                if (ev > e1) { e2 = e1; i2 = i1; e1 = ev; i1 = o; } else if (ev > e2) { e2 = ev; i2 = o; } }
            const float w1 = 1.f / (1.f + expf(e2 - e1)), w2v = 1.f - w1;
            unsigned* lh = (unsigned*)(stg + 64 * 17 + 16 * 40 - 64);
            if (F.lane < 32) lh[F.lane] = 0u;
            asm volatile("s_waitcnt lgkmcnt(0)" ::: "memory");
            const unsigned r1 = atomicAdd(&lh[i1], 1u), r2 = atomicAdd(&lh[i2], 1u);
            asm volatile("s_waitcnt lgkmcnt(0)" ::: "memory");
            if (F.lane < 32) { const unsigned c = lh[F.lane]; lh[32 + F.lane] = c ? atomicAdd(&F.cnt()[l * 32 + F.lane], c) : 0u; }
            asm volatile("s_waitcnt vmcnt(0) lgkmcnt(0)" ::: "memory");
            const unsigned p1 = lh[32 + i1] + r1, p2 = lh[32 + i2] + r2;
            F.tokE()[row * 2] = i1; F.tokI()[row * 2] = (int)p1; F.tokW()[row * 2] = gwt * w1;
            F.tokE()[row * 2 + 1] = i2; F.tokI()[row * 2 + 1] = (int)p2; F.tokW()[row * 2 + 1] = gwt * w2v;
        }
        __syncthreads();
    }
}

__device__ __forceinline__ void phase_gather(Frame& F, int l) {
    int* off = (int*)F.smf; moe_offsets(F, l, off);
    const int gw = F.bid * 8 + F.wave, ngw = F.nb * 8, nrows = (l == 0) ? NROW : NTOK;
    for (int s0 = gw; s0 < 2 * nrows; s0 += 4 * ngw) {
        int sl[4], e[4], ti[4]; float tw[4]; u32x4 a0[4], a1[4];
#pragma unroll
        for (int q = 0; q < 4; ++q) { sl[q] = min(s0 + q * ngw, 2 * nrows - 1); e[q] = F.tokE()[sl[q]]; ti[q] = F.tokI()[sl[q]]; tw[q] = F.tokW()[sl[q]];
            const u32x4* src = (const u32x4*)(F.HX2() + (size_t)(sl[q] >> 1) * DM); a0[q] = src[F.lane]; a1[q] = src[F.lane + 64]; }
#pragma unroll
        for (int q = 0; q < 4; ++q) if (s0 + q * ngw < 2 * nrows) { const int dst = off[e[q]] + ti[q]; u32x4* d = (u32x4*)(F.XS() + (size_t)dst * DM);
            d[F.lane] = a0[q]; d[F.lane + 64] = a1[q];
            if (F.lane == 0) { F.rmap()[dst] = sl[q]; F.roww()[dst] = tw[q]; } }
    }
    for (int e = 0; e < 32; ++e) {
        const int c = (int)F.cnt()[l * 32 + e], pc = (c + 255) & ~255;
        for (int j = c + gw; j < pc; j += ngw) { const int dst = off[e] + j; u32x4* d = (u32x4*)(F.XS() + (size_t)dst * DM);
            const u32x4 z = {0u, 0u, 0u, 0u}; d[F.lane] = z; d[F.lane + 64] = z;
            if (F.lane == 0) { F.rmap()[dst] = -1; F.roww()[dst] = 0.f; } }
    }
}
__device__ __forceinline__ int expert_of_row(const int* off, int row) { int e = 0;
#pragma unroll 1
    for (int i = 1; i < 32; ++i) if (row >= off[i]) e = i;
    return e; }

__device__ __forceinline__ void phase_ln2(Frame& F, int l) {
    const int gw = F.bid * 8 + F.wave, ngw = F.nb * 8, npairs = ((l == 0) ? NROW : NTOK) / 2;
    const float* lg = F.p.ln_g + (size_t)(l * 2 + 1) * DM; const float* lbb = F.p.ln_b + (size_t)(l * 2 + 1) * DM;
    const bf16_t* Y = F.BR();
    const bool tmo_set = (l == DEPTH - 1) && (__hip_atomic_load((unsigned*)(F.ws + WS_CTL) + XB_TMO, __ATOMIC_RELAXED, __HIP_MEMORY_SCOPE_AGENT) != 0u);
    for (int pi = gw; pi < npairs; pi += ngw) {
        const int row0 = pi * 2, rb = row_batch(row0);
        const float* xm = row0 < NTOK ? F.p.out + (size_t)row0 * DM : F.cxm() + (size_t)(row0 - NTOK) * DM;
        float* xo = row0 < NTOK ? F.p.out + (size_t)row0 * DM : F.cxo() + (size_t)(row0 - NTOK) * DM;
        const float* mv = F.modv() + ((size_t)l * 5 + rb) * 6144;
        u32x2 y0[2][4], y1[2][4]; f32x4 xv[2][4], m5[4];
#pragma unroll
        for (int j = 0; j < 4; ++j) { const int d = j * 256 + F.lane * 4; m5[j] = *(const f32x4*)(mv + 5 * 1024 + d);
#pragma unroll
            for (int q = 0; q < 2; ++q) { y0[q][j] = *(const u32x2*)(Y + (size_t)((row0 + q) * 2) * DM + d); y1[q][j] = *(const u32x2*)(Y + (size_t)((row0 + q) * 2 + 1) * DM + d); xv[q][j] = *(const f32x4*)(xm + (size_t)q * DM + d); } }
        f32x4 v[2][4]; float s[2] = {0.f, 0.f};
#pragma unroll
        for (int q = 0; q < 2; ++q)
#pragma unroll
            for (int j = 0; j < 4; ++j) { f32x4 y; y.x = __uint_as_float(y0[q][j].x << 16) + __uint_as_float(y1[q][j].x << 16); y.y = __uint_as_float(y0[q][j].x & 0xffff0000u) + __uint_as_float(y1[q][j].x & 0xffff0000u);
                y.z = __uint_as_float(y0[q][j].y << 16) + __uint_as_float(y1[q][j].y << 16); y.w = __uint_as_float(y0[q][j].y & 0xffff0000u) + __uint_as_float(y1[q][j].y & 0xffff0000u);
                v[q][j] = ALPHA * xv[q][j] + m5[j] * y; s[q] += (v[q][j].x + v[q][j].y) + (v[q][j].z + v[q][j].w); }
#pragma unroll
        for (int o = 1; o < 64; o <<= 1) { s[0] += __shfl_xor(s[0], o); s[1] += __shfl_xor(s[1], o); }
        float s2[2] = {0.f, 0.f};
#pragma unroll
        for (int q = 0; q < 2; ++q) { const float mean = s[q] * (1.f / DM);
#pragma unroll
            for (int j = 0; j < 4; ++j) { v[q][j] = v[q][j] - mean; s2[q] += (v[q][j].x * v[q][j].x + v[q][j].y * v[q][j].y) + (v[q][j].z * v[q][j].z + v[q][j].w * v[q][j].w); } }
#pragma unroll
        for (int o = 1; o < 64; o <<= 1) { s2[0] += __shfl_xor(s2[0], o); s2[1] += __shfl_xor(s2[1], o); }
        const float* mn = F.modv() + ((size_t)((l + 1 < DEPTH) ? l + 1 : l) * 5 + rb) * 6144;
#pragma unroll
        for (int j = 0; j < 4; ++j) { const int d = j * 256 + F.lane * 4;
            const f32x4 g4 = *(const f32x4*)(lg + d), b4 = *(const f32x4*)(lbb + d), m0 = *(const f32x4*)(mn + d), m1 = *(const f32x4*)(mn + 1024 + d);
#pragma unroll
            for (int q = 0; q < 2; ++q) { const float rstd = rsqrtf(s2[q] * (1.f / DM) + LN_EPS);
                f32x4 xn = v[q][j] * rstd * g4 + b4;
                if (tmo_set) xn = xn * __uint_as_float(0x7fc00000u);
                *(f32x4*)(xo + (size_t)q * DM + d) = xn;
                if (l + 1 < DEPTH) { const f32x4 h = xn * (1.f + m1) + m0; u32x2 o2; o2.x = pk2(h.x, h.y); o2.y = pk2(h.z, h.w); *(u32x2*)(F.HX() + (size_t)(row0 + q) * DM + d) = o2; } }
        }
    }
}

constexpr int NPL = 13, NPH = 1 + DEPTH * NPL;
__global__ void __launch_bounds__(NTHR, 2) mega(Params p) {
    extern __shared__ __attribute__((aligned(16))) unsigned char smem[];
    Frame F; F.p = p; F.bid = blockIdx.x; F.nb = gridDim.x; F.tid = threadIdx.x; F.lane = threadIdx.x & 63; F.wave = threadIdx.x >> 6; F.wid_s = __builtin_amdgcn_readfirstlane(threadIdx.x >> 6);
    F.smf = (float*)(smem + LDS_STAGE);
    LAS unsigned char* stage = (LAS unsigned char*)smem + LDS_STAGE; int* offt = (int*)(smem + 64);
    unsigned char* ws = p.ws; F.ws = ws;

    if (threadIdx.x == 0) *(uint4*)smem = make_uint4(0u, 0u, 0u, 0u);
    __syncthreads();
    unsigned* barw = (unsigned*)(ws + WS_CTL);
    XcdBarrier bar; bar.bar = barw; bar.x = 0; bar.st = (volatile LAS unsigned*)smem;
    const bool multi = (p.ph_hi - p.ph_lo) > 1;
    if (multi) bar = xcd_barrier_post(barw, (volatile LAS unsigned*)smem);
    const int lo = p.ph_lo, hi = p.ph_hi;
#define IN(k) (lo <= (k) && (k) < hi)
#define SEAM(k) do { if (IN(k) && IN((k) + 1)) xcd_barrier(bar); else __syncthreads(); } while (0)

    if (IN(0)) { REFRESH(F); phase_mod(F); __syncthreads(); phase_conv_a(F, 0); }
    SEAM(0);
#pragma unroll 1
    for (int l = 0; l < DEPTH; ++l) {
        const int pb = 1 + l * NPL;
        const float* xlat = (l == 0) ? p.x : p.out; const float* xctx = (l == 0) ? p.ctx : F.cxo();
        const int Mrows = (l == 0) ? NROW : NTOK;
        if (IN(pb + 0)) { REFRESH(F); if (l == 0) phase_prep(F, 0, p.x, p.ctx); else phase_conv_a(F, l); }
        SEAM(pb + 0);
        if (IN(pb + 1)) { REFRESH(F);
            float* rtab = (float*)(smem + LDS_ROPE);
            for (int e = F.tid; e < 1024; e += NTHR) { const int pp = e >> 4, i = e & 15; const float inv = powf(10000.f, -(float)i / 16.f), ang = (float)pp * inv; rtab[2 * e] = cosf(ang); rtab[2 * e + 1] = sinf(ang); }
            __syncthreads();
            pg::SchedG1 S{(const char*)F.HX(), (const char*)F.W1t(), (const char*)F.Wvt(), F.nb, F.bid}; pg::EpiG1 E{F.P1(), F.VT(), rtab, F.lb(), l};
            pg::gemm_phase(stage, DM, DM, DM, S, E);
        }
        SEAM(pb + 1);
        if (IN(pb + 2)) { REFRESH(F); phase_prescan(F, l); }
        SEAM(pb + 2);
        if (IN(pb + 3)) { REFRESH(F); phase_mix(F, l); }
        SEAM(pb + 3);
        if (IN(pb + 4)) { REFRESH(F); phase_prepad(F, l); }
        SEAM(pb + 4);
        if (IN(pb + 5)) { REFRESH(F);
            pg::SchedStatic S{(const char*)F.HX(), (const char*)F.Wgt(), (size_t)256 * DM * 2, (size_t)256 * DM * 2, Mrows / 256, NGATE / 256, F.nb, F.bid}; pg::EpiGate E{F.G()};
            pg::gemm_phase(stage, DM, DM, DM, S, E);
            __syncthreads();
            phase_conv_b(F, l);
        }
        SEAM(pb + 5);
        if (IN(pb + 6)) { REFRESH(F);
            pg::SchedMerge S{(const char*)F.BR(), (const char*)F.Wbrt(), (Mrows / 256) * 4, F.nb, F.bid}; pg::EpiMerge E{F.G(), F.HX()};
            pg::gemm_phase(stage, 2048, 512, 512, S, E);
        }
        SEAM(pb + 6);
        if (IN(pb + 7)) { REFRESH(F);
            pg::SchedStatic S{(const char*)F.HX(), (const char*)F.Woutt(), (size_t)256 * DM * 2, (size_t)256 * DM * 2, Mrows / 256, DM / 256, F.nb, F.bid};
            pg::EpiWout E{xlat, xctx, p.out, F.cxm(), F.modv() + (size_t)l * 5 * 6144};
            pg::gemm_phase(stage, DM, DM, DM, S, E);
        }
        SEAM(pb + 7);
        if (IN(pb + 8)) { REFRESH(F); phase_ln1(F, l); }
        SEAM(pb + 8);
        if (IN(pb + 9)) { REFRESH(F); phase_gather(F, l); }
        SEAM(pb + 9);
        if (IN(pb + 10)) { REFRESH(F);
            moe_offsets(F, l, offt);
            pg::SchedMoe S{(const char*)F.XS(), (const char*)F.Wgu(), offt, (size_t)256 * DM * 2, (size_t)512 * DM * 2, (size_t)256 * DM * 2, offt[32] / 256, 2, F.nb, F.bid};
            pg::EpiMoe1 E{F.HID(), F.roww()};
            pg::gemm_phase(stage, DM, DM, DM, S, E);
        }
        SEAM(pb + 10);
        if (IN(pb + 11)) { REFRESH(F);
            moe_offsets(F, l, offt);
            pg::SchedMoe S{(const char*)F.HID(), (const char*)F.Wd(), offt, (size_t)256 * 256 * 2, (size_t)DM * 256 * 2, (size_t)256 * 256 * 2, offt[32] / 256, 4, F.nb, F.bid};
            pg::EpiMoe2 E{F.BR(), F.rmap(), (bf16_t*)(F.ws + WS_DUMP)};
            pg::gemm_phase(stage, 256, 256, 256, S, E);
        }
        SEAM(pb + 11);
        if (IN(pb + 12)) { REFRESH(F); phase_ln2(F, l); }
        SEAM(pb + 12);
    }
#undef IN
#undef SEAM
}

extern "C" void kernel_launch(void* const* d_in, const int* in_sizes, int n_in, void* d_out, int out_size, void* d_ws, size_t ws_size, hipStream_t stream) {
    static int grid = 0;
    if (grid == 0) {
        if (n_in != 23 || out_size != NTOK * DM || ws_size < WS_END) { fprintf(stderr, "kernel_launch: unexpected shapes (n_in %d out %d ws %zu need %zu)\n", n_in, out_size, ws_size, (size_t)WS_END); grid = -1; return; }
        int dev = 0, cus = 0;
        if (hipGetDevice(&dev) != hipSuccess || hipDeviceGetAttribute(&cus, hipDeviceAttributeMultiprocessorCount, dev) != hipSuccess) { grid = -1; return; }
        if (hipFuncSetAttribute((const void*)mega, hipFuncAttributeMaxDynamicSharedMemorySize, LDS_BYTES) != hipSuccess) { fprintf(stderr, "kernel_launch: hipFuncSetAttribute failed\n"); grid = -1; return; }
        int per_cu = 0;
        if (hipOccupancyMaxActiveBlocksPerMultiprocessor(&per_cu, (const void*)mega, NTHR, LDS_BYTES) != hipSuccess || per_cu < 1) fprintf(stderr, "kernel_launch: occupancy query reports %d blocks per CU\n", per_cu);
        (void)hipGetLastError();
        grid = cus >= 32 ? (cus & ~31) : cus;
    }
    if (grid < 0) return;
    (void)hipMemsetAsync((char*)d_ws + WS_CTL, 0, CTL_BYTES, stream);
    Params p; memset(&p, 0, sizeof(p));
    const float** pp = (const float**)&p;
    for (int i = 0; i < 23; ++i) pp[i] = (const float*)d_in[i];
    p.out = (float*)d_out; p.ws = (unsigned char*)d_ws;
    p.ph_lo = 0; p.ph_hi = NPH;
    hipLaunchKernelGGL(mega, dim3(grid), dim3(NTHR), LDS_BYTES, stream, p);
}
```

```cpp
#include <hip/hip_runtime.h>
#include <cstdio>
#include <cstdint>
#include <cstring>

typedef unsigned short bf16_t;
typedef float f32x4 __attribute__((ext_vector_type(4)));
typedef unsigned u32x4 __attribute__((ext_vector_type(4)));
typedef unsigned u32x2 __attribute__((ext_vector_type(2)));

constexpr int NB = 4, SEQ = 4096, LC = 256, DM = 1024, DEPTH = 2;
constexpr int NTOK = NB * SEQ, NCTX = NB * LC, NROW = NTOK + NCTX;
constexpr int DIN = 10528;
constexpr int O_AQ = 0, O_AK = 256, O_AV = 512, O_AG = 1024, O_ALR = 1536, O_BQ = 1568, O_BK = 2080, O_BV = 2592, O_CQ = 3104, O_CK = 3616,
              O_CV = 3744, O_DQ = 3872, O_DF = 4384, O_DI = 5408, O_DG = 5920, O_GATE = 6432;
constexpr int PC_AQ = 0, PC_AK = 256, PC_AV = 512, PC_BQ = 1024, PC_BK = 1536, PC_CQ = 2048, PC_CK = 2560, PC_ALR = 2688, PC_DQ = 2816,
              PC_DF = 3328, PC_DI = 4352, PC_AG = 4864, PC_DG = 5376, NP1 = 5888;
constexpr float QSCALE = 0.125f * 1.44269504089f;
constexpr int NVT = 768;
constexpr int NGATE = 4096;
constexpr int XS_ROWS = 43008;
constexpr float LN_EPS = 1e-5f;
constexpr float ALPHA = 1.41421356237f;

constexpr size_t al256(size_t x) { return (x + 255) & ~(size_t)255; }
constexpr size_t WS_CTL = 0;
constexpr size_t CTL_BYTES = 32768;
constexpr size_t CTL_CNT = 28672;
constexpr size_t WS_DUMP = WS_CTL + CTL_BYTES;
constexpr size_t WS_MODV = WS_DUMP + 4096;
constexpr size_t WS_LB = WS_MODV + al256((size_t)DEPTH * 5 * 6144 * 4);
constexpr size_t WS_TOKE = WS_LB + 4096;
constexpr size_t WS_TOKI = WS_TOKE + al256((size_t)2 * NROW * 4);
constexpr size_t WS_TOKW = WS_TOKI + al256((size_t)2 * NROW * 4);
constexpr size_t WS_RMAP = WS_TOKW + al256((size_t)2 * NROW * 4);
constexpr size_t WS_ROWW = WS_RMAP + al256((size_t)XS_ROWS * 4);
constexpr size_t WS_CXM = WS_ROWW + al256((size_t)XS_ROWS * 4);
constexpr size_t WS_CXO = WS_CXM + (size_t)NCTX * DM * 4;
constexpr size_t WS_WTA = WS_CXO + (size_t)NCTX * DM * 4;
constexpr size_t WTA_W1 = 0;
constexpr size_t WTA_WV = WTA_W1 + (size_t)NP1 * DM * 2;
constexpr size_t WTA_WBR = WTA_WV + (size_t)NVT * DM * 2;
constexpr size_t WTA_WO = WTA_WBR + (size_t)4 * DM * 512 * 2;
constexpr size_t WTA_WG = WTA_WO + (size_t)DM * DM * 2;
constexpr size_t WTA_BYTES = WTA_WG + (size_t)NGATE * DM * 2;
constexpr size_t WS_SC1 = WS_WTA;
static_assert((size_t)NROW * 512 * 2 <= WTA_WG, "scan scratch must fit in front of the gate weights");
constexpr size_t WS_HX = WS_WTA + WTA_BYTES;
constexpr size_t WS_VT = WS_HX + (size_t)NROW * DM * 2;
constexpr size_t WS_OBA = WS_VT + (size_t)NVT * NROW * 2;
constexpr size_t WS_HX2 = WS_VT;
constexpr size_t WS_HID = WS_VT;
constexpr size_t WS_ODH = WS_OBA + (size_t)NROW * 512 * 2;
constexpr size_t WS_BR = WS_ODH + (size_t)NROW * 1024 * 2;
constexpr size_t WS_P1 = WS_BR + (size_t)NROW * 2048 * 2;
constexpr size_t WS_G = WS_P1;
constexpr size_t WS_WGU = WS_P1 + (size_t)NROW * NGATE * 2;
constexpr size_t WS_WD = WS_WGU + (size_t)32 * 512 * DM * 2;
constexpr size_t WS_PM = WS_WD + (size_t)32 * DM * 256 * 2;
constexpr size_t WS_XS = WS_P1;
constexpr size_t WS_ESC = WS_P1 + (size_t)NROW * NP1 * 2;
constexpr size_t WS_END = WS_ESC + (size_t)32 * 68 * 384 * 4;
static_assert(WS_PM + (size_t)4 * NCTX * DM * 2 <= WS_ESC, "moe weights must fit in the P1 tail");
static_assert((size_t)XS_ROWS * DM * 2 <= (size_t)NROW * NGATE * 2, "XS must fit in the G region");
static_assert((size_t)NVT * NROW * 2 + (size_t)NROW * 512 * 2 >= (size_t)NROW * DM * 2, "HX2 alias");
static_assert(WS_END <= 434800000ull, "workspace budget");

constexpr int NTHR = 512;
constexpr int LDS_STAGE = 1024;
constexpr int LDS_ROPE = 1024 + 131072 + 1024;
constexpr int LDS_BYTES = 144 * 1024;

struct Params {
    const float *x, *c, *ctx, *c_ctx, *w_mod, *b_mod, *w_in, *gla_lr_w, *gla_lr_b, *hg_gamma, *na_rpb, *wa_sink, *w_branch, *w_out, *ln_g, *ln_b,
        *moe_w_group, *moe_b_group, *moe_w_expert, *moe_b_expert, *moe_w_gate, *moe_w_up, *moe_w_down;
    float* out;
    unsigned char* ws;
    int ph_lo, ph_hi;
};

__device__ __forceinline__ float bf2f(bf16_t b) { return __uint_as_float(((unsigned)b) << 16); }
__device__ __forceinline__ bf16_t f2bf(float f) { unsigned u = __float_as_uint(f); u += 0x7FFFu + ((u >> 16) & 1u); return (bf16_t)(u >> 16); }
typedef float f32x2_t __attribute__((ext_vector_type(2)));
typedef __bf16 bf16x2_t __attribute__((ext_vector_type(2)));
__device__ __forceinline__ unsigned pk2(float lo, float hi) {
    const f32x2_t v = {lo, hi}; const bf16x2_t b = __builtin_convertvector(v, bf16x2_t); return __builtin_bit_cast(unsigned, b); }
__device__ __forceinline__ void ld8(const bf16_t* p, float* f) {
    const u32x4 v = *(const u32x4*)p;
    f[0] = __uint_as_float(v.x << 16); f[1] = __uint_as_float(v.x & 0xffff0000u);
    f[2] = __uint_as_float(v.y << 16); f[3] = __uint_as_float(v.y & 0xffff0000u);
    f[4] = __uint_as_float(v.z << 16); f[5] = __uint_as_float(v.z & 0xffff0000u);
    f[6] = __uint_as_float(v.w << 16); f[7] = __uint_as_float(v.w & 0xffff0000u);
}
__device__ __forceinline__ void st8(bf16_t* p, const float* f) {
    u32x4 v; v.x = pk2(f[0], f[1]); v.y = pk2(f[2], f[3]); v.z = pk2(f[4], f[5]); v.w = pk2(f[6], f[7]);
    *(u32x4*)p = v;
}
__device__ __forceinline__ float sigmoidf_(float x) { return __builtin_amdgcn_rcpf(1.f + __expf(-x)); }
__device__ __forceinline__ float siluf_(float x) { return x * __builtin_amdgcn_rcpf(1.f + __expf(-x)); }
__device__ __forceinline__ float wave_sum(float v) {
#pragma unroll
    for (int o = 1; o < 64; o <<= 1) v += __shfl_xor(v, o);
    return v;
}
__device__ __forceinline__ int row_batch(int row) { return row < NTOK ? (row >> 12) : 4; }

#define XB_TMO      128
#define XB_XCNT(j)  (256  + 64 * (j))
#define XB_XSUB(j)  (1280 + 64 * (j))
#define XB_XGEN(j)  (2304 + 64 * (j))
#define XB_TOP      3328
#define XB_TOPGEN   3392
#define XCD_BAR_WORDS 3456
#define XB_SPIN_CAP (1u << 18)
#define LAS __attribute__((address_space(3)))
__device__ __forceinline__ unsigned xb_ld(unsigned* p)              { return __hip_atomic_load(p, __ATOMIC_RELAXED, __HIP_MEMORY_SCOPE_AGENT); }
__device__ __forceinline__ unsigned xb_add(unsigned* p, unsigned v) { return __hip_atomic_fetch_add(p, v, __ATOMIC_RELAXED, __HIP_MEMORY_SCOPE_AGENT); }
__device__ __forceinline__ unsigned xb_xcc_id() { return (unsigned)__builtin_amdgcn_s_getreg((3 << 11) | 20) & 0xFu; }
#define XB_SPIN(cond, bar) do { unsigned _sp = 0; while (cond) { __builtin_amdgcn_s_sleep(1); \
    if ((++_sp & 255u) == 0u) { if (xb_ld(&(bar)[XB_TMO])) break; if (_sp > XB_SPIN_CAP) { atomicAdd(&(bar)[XB_TMO], 1u); break; } } } } while (0)
struct XcdBarrier { unsigned* bar; unsigned x; volatile LAS unsigned* st; };
__device__ __forceinline__ XcdBarrier xcd_barrier_post(unsigned* bar, volatile LAS unsigned* st) {
    XcdBarrier b; b.bar = bar; b.x = xb_xcc_id(); b.st = st;
    if (threadIdx.x == 0) (void)xb_add(&bar[XB_XCNT(b.x)], 1u);
    return b;
}
__device__ __forceinline__ void xcd_barrier_complete(unsigned* bar, unsigned x, unsigned& nloc, unsigned& nx) {
    const unsigned G = gridDim.x * gridDim.y * gridDim.z;
    unsigned sum, cnt, mine, sp = 0u;
    for (;;) {
        sum = 0u; cnt = 0u; mine = 0u;
#pragma unroll
        for (unsigned j = 0; j < 16; ++j) { const unsigned c = xb_ld(&bar[XB_XCNT(j)]); sum += c; cnt += (c > 0u) ? 1u : 0u; mine = (j == x) ? c : mine; }
        if (sum == G) break;
        __builtin_amdgcn_s_sleep(1);
        if ((++sp & 255u) == 0u) { if (xb_ld(&bar[XB_TMO])) break; if (sp > XB_SPIN_CAP) { atomicAdd(&bar[XB_TMO], 1u); break; } }
    }
    nloc = mine > 0u ? mine : 1u; nx = cnt > 0u ? cnt : 1u;
}
__device__ __forceinline__ void xcd_barrier(const XcdBarrier& b) {
    asm volatile("s_waitcnt vmcnt(0)" ::: "memory");
    __syncthreads();
    if (threadIdx.x == 0) {
        unsigned* bar = b.bar;
        __builtin_amdgcn_s_waitcnt(0);
        unsigned nloc = b.st[0], nx = b.st[1];
        if (nloc == 0u) { xcd_barrier_complete(bar, b.x, nloc, nx); b.st[0] = nloc; b.st[1] = nx; }
        const unsigned old = xb_add(&bar[XB_XSUB(b.x)], 1u);
        const unsigned gen = old / nloc;
        if (old + 1u == (gen + 1u) * nloc) {
            __builtin_amdgcn_fence(__ATOMIC_RELEASE, "agent");
            asm volatile("s_waitcnt vmcnt(0)" ::: "memory");
            const unsigned og = xb_add(&bar[XB_TOP], 1u);
            const unsigned tg = og / nx;
            if (og + 1u == (tg + 1u) * nx) xb_add(&bar[XB_TOPGEN], 1u);
            else XB_SPIN(xb_ld(&bar[XB_TOPGEN]) == tg, bar);
            __builtin_amdgcn_fence(__ATOMIC_ACQUIRE, "agent");
            xb_add(&bar[XB_XGEN(b.x)], 1u);
            asm volatile("s_waitcnt vmcnt(0)" ::: "memory");
        } else {
            XB_SPIN(xb_ld(&bar[XB_XGEN(b.x)]) == gen, bar);
            __builtin_amdgcn_fence(__ATOMIC_ACQUIRE, "agent");
            asm volatile("s_waitcnt vmcnt(0)" ::: "memory");
        }
    }
    __syncthreads();
}

struct Frame {
    Params p;
    int bid, nb, tid, lane, wave, wid_s;
    float* smf;
    unsigned char* ws;
    __device__ __forceinline__ float* modv() const { return (float*)(ws + WS_MODV); }
    __device__ __forceinline__ float* lb() const { return (float*)(ws + WS_LB); }
    __device__ __forceinline__ int* tokE() const { return (int*)(ws + WS_TOKE); }
    __device__ __forceinline__ int* tokI() const { return (int*)(ws + WS_TOKI); }
    __device__ __forceinline__ float* tokW() const { return (float*)(ws + WS_TOKW); }
    __device__ __forceinline__ int* rmap() const { return (int*)(ws + WS_RMAP); }
    __device__ __forceinline__ float* roww() const { return (float*)(ws + WS_ROWW); }
    __device__ __forceinline__ float* cxm() const { return (float*)(ws + WS_CXM); }
    __device__ __forceinline__ float* cxo() const { return (float*)(ws + WS_CXO); }
    __device__ __forceinline__ bf16_t* W1t() const { return (bf16_t*)(ws + WS_WTA + WTA_W1); }
    __device__ __forceinline__ bf16_t* Wvt() const { return (bf16_t*)(ws + WS_WTA + WTA_WV); }
    __device__ __forceinline__ bf16_t* Wgt() const { return (bf16_t*)(ws + WS_WTA + WTA_WG); }
    __device__ __forceinline__ bf16_t* Wbrt() const { return (bf16_t*)(ws + WS_WTA + WTA_WBR); }
    __device__ __forceinline__ bf16_t* Woutt() const { return (bf16_t*)(ws + WS_WTA + WTA_WO); }
    __device__ __forceinline__ bf16_t* SC1() const { return (bf16_t*)(ws + WS_SC1); }
    __device__ __forceinline__ float* ESC() const { return (float*)(ws + WS_ESC); }
    __device__ __forceinline__ bf16_t* HX() const { return (bf16_t*)(ws + WS_HX); }
    __device__ __forceinline__ bf16_t* VT() const { return (bf16_t*)(ws + WS_VT); }
    __device__ __forceinline__ bf16_t* OBA() const { return (bf16_t*)(ws + WS_OBA); }
    __device__ __forceinline__ bf16_t* HX2() const { return (bf16_t*)(ws + WS_HX2); }
    __device__ __forceinline__ bf16_t* HID() const { return (bf16_t*)(ws + WS_HID); }
    __device__ __forceinline__ bf16_t* ODH() const { return (bf16_t*)(ws + WS_ODH); }
    __device__ __forceinline__ bf16_t* BR() const { return (bf16_t*)(ws + WS_BR); }
    __device__ __forceinline__ bf16_t* P1() const { return (bf16_t*)(ws + WS_P1); }
    __device__ __forceinline__ bf16_t* G() const { return (bf16_t*)(ws + WS_G); }
    __device__ __forceinline__ bf16_t* Wgu() const { return (bf16_t*)(ws + WS_WGU); }
    __device__ __forceinline__ bf16_t* Wd() const { return (bf16_t*)(ws + WS_WD); }
    __device__ __forceinline__ bf16_t* XS() const { return (bf16_t*)(ws + WS_XS); }
    __device__ __forceinline__ unsigned* cnt() const { return (unsigned*)(ws + WS_CTL + CTL_CNT); }
};


#define REFRESH(F) do { int _t = threadIdx.x; asm volatile("" : "+v"(_t)); (F).tid = _t; (F).lane = _t & 63; (F).wave = _t >> 6; } while (0)

__device__ __forceinline__ void phase_mod(Frame& F) {
    float* sc = F.smf;
    float* red = F.smf + 5 * 1024;
    bool have = false;
    for (int it = F.bid; it < DEPTH * 96; it += F.nb) {
        if (!have) {
            for (int i = F.tid; i < 5 * 1024; i += NTHR) { const float v = (i < 4096) ? F.p.c[i] : F.p.c_ctx[i - 4096]; sc[i] = siluf_(v); }
            __syncthreads(); have = true;
        }
        const int l = it / 96, n0 = (it % 96) * 64, col = F.tid & 63, kg = F.tid >> 6;
        const float* w = F.p.w_mod + (size_t)l * DM * 6144 + n0 + col;
        float a[5] = {0.f, 0.f, 0.f, 0.f, 0.f};
        for (int k = kg * 128; k < kg * 128 + 128; ++k) {
            const float wv = w[(size_t)k * 6144];
#pragma unroll
            for (int r = 0; r < 5; ++r) a[r] += sc[r * 1024 + k] * wv;
        }
#pragma unroll
        for (int r = 0; r < 5; ++r) red[(kg * 5 + r) * 64 + col] = a[r];
        __syncthreads();
        if (F.tid < 320) {
            const int r = F.tid >> 6, cc = F.tid & 63; float s = F.p.b_mod[l * 6144 + n0 + cc];
#pragma unroll
            for (int g = 0; g < 8; ++g) s += red[(g * 5 + r) * 64 + cc];
            F.modv()[((size_t)l * 5 + r) * 6144 + n0 + cc] = s;
        }
        __syncthreads();
    }
    if (F.bid == F.nb - 1) {
        for (int i = F.tid; i < 1024; i += NTHR) { const int z = i >> 9, f = i & 511;
            const float g0 = F.p.hg_gamma[(z * DEPTH + 0) * 512 + f], g1 = F.p.hg_gamma[(z * DEPTH + 1) * 512 + f];
            F.lb()[i] = 1.f / (1.f + expf(g0 - g1)); }
    }
}

__device__ __forceinline__ int p1_src(int n, float& scale) {
    scale = 1.f;
    if (n < 256) { scale = 0.125f; return O_AQ + n; }
    if (n < 512) return O_AK + (n - 256);
    if (n < 1024) return O_AV + (n - 512);
    if (n < 1536) { scale = QSCALE; return O_BQ + (n - 1024); }
    if (n < 2048) return O_BK + (n - 1536);
    if (n < 2560) { scale = QSCALE; return O_CQ + (n - 2048); }
    if (n < 2688) return O_CK + (n - 2560);
    if (n < 2720) return O_ALR + (n - 2688);
    if (n < 2816) return -1;
    if (n < 3328) return O_DQ + (n - 2816);
    if (n < 4352) return O_DF + (n - 3328);
    if (n < 4864) return O_DI + (n - 4352);
    if (n < 5376) return O_AG + (n - 4864);
    return O_DG + (n - 5376);
}
__device__ __forceinline__ void conv_item(const float* src, int ldsrc, int srccol, float scale, bf16_t* dst, int K, int k0, float* scr, int lane, bool perm) {
    if (srccol >= 0) {
#pragma unroll 8
        for (int i = 0; i < 32; ++i) { const int kk = 2 * i + (lane >> 5); scr[kk * 33 + (lane & 31)] = src[(size_t)(k0 + kk) * ldsrc + srccol + (lane & 31)] * scale; }
    } else {
#pragma unroll 8
        for (int i = 0; i < 32; ++i) { const int kk = 2 * i + (lane >> 5); scr[kk * 33 + (lane & 31)] = 0.f; }
    }
    asm volatile("s_waitcnt lgkmcnt(0)" ::: "memory");
    const int c = lane & 7;
#pragma unroll
    for (int j = 0; j < 4; ++j) { const int nn = (lane >> 3) + 8 * j; const float* sp = scr + (8 * c) * 33 + (perm ? (8 * ((nn & 15) >> 2) + 4 * (nn >> 4) + (nn & 3)) : nn);
        u32x4 o; o.x = pk2(sp[0 * 33], sp[1 * 33]); o.y = pk2(sp[2 * 33], sp[3 * 33]); o.z = pk2(sp[4 * 33], sp[5 * 33]); o.w = pk2(sp[6 * 33], sp[7 * 33]);
        *(u32x4*)(dst + (size_t)nn * K + 8 * c) = o; }
    asm volatile("s_waitcnt lgkmcnt(0)" ::: "memory");
}
constexpr int CONVA_W1 = (NP1 / 32) * 16;
constexpr int CONVA_ITEMS = CONVA_W1 + 384 + 2048;
__device__ __forceinline__ void phase_conv_a(Frame& F, int l, int gw, int ngw) {
    float* scr = F.smf + F.wave * (64 * 33);
    for (int it0 = gw; it0 < CONVA_ITEMS; it0 += ngw) {
        int ti = it0;
        if (ti < CONVA_W1) { const int n0 = (ti >> 4) * 32, kt = ti & 15; float sc; const int sx = p1_src(n0, sc);
            conv_item(F.p.w_in + (size_t)l * DM * DIN, DIN, sx, sc, F.W1t() + (size_t)n0 * DM + kt * 64, DM, kt * 64, scr, F.lane, !(n0 >= 2048 && n0 < 2816)); continue; }
        ti -= CONVA_W1;
        if (ti < 384) { const int n0 = (ti >> 4) * 32, kt = ti & 15; const int sx = n0 < 512 ? O_BV + n0 : (n0 < 640 ? O_CV + (n0 - 512) : -1);
            conv_item(F.p.w_in + (size_t)l * DM * DIN, DIN, sx, 1.f, F.Wvt() + (size_t)n0 * DM + kt * 64, DM, kt * 64, scr, F.lane, false); continue; }
        ti -= 384;
        { const int n0 = (ti >> 4) * 32, kt = ti & 15;
          conv_item(F.p.w_in + (size_t)l * DM * DIN, DIN, O_GATE + n0, 1.f, F.Wgt() + (size_t)n0 * DM + kt * 64, DM, kt * 64, scr, F.lane, true); }
    }
}
constexpr int CONVB_ITEMS = 8192 + 4096 + 1024 + 512;
__device__ __forceinline__ void phase_conv_b(Frame& F, int l) {
    float* scr = F.smf + F.wave * (64 * 33);
    const int gw = F.bid * 8 + F.wave, ngw = F.nb * 8;
    for (int it0 = gw; it0 < CONVB_ITEMS; it0 += ngw) {
        int ti = it0;
        if (ti < 8192) { const int e = ti >> 8, r = ti & 255, n0 = (r >> 4) * 32, kt = r & 15, j = n0 >> 8, rr = n0 & 255; const bool isup = rr >= 128; const int cc = 128 * j + (rr & 127);
            const float* src = (isup ? F.p.moe_w_up : F.p.moe_w_gate) + (size_t)(l * 32 + e) * DM * 256;
            conv_item(src, 256, cc, 1.f, F.Wgu() + (size_t)e * 512 * DM + (size_t)n0 * DM + kt * 64, DM, kt * 64, scr, F.lane, true); continue; }
        ti -= 8192;
        if (ti < 4096) { const int e = ti >> 7, r = ti & 127, n0 = (r >> 2) * 32, kt = r & 3;
          conv_item(F.p.moe_w_down + (size_t)(l * 32 + e) * 256 * DM, DM, n0, 1.f, F.Wd() + (size_t)e * DM * 256 + (size_t)n0 * 256 + kt * 64, 256, kt * 64, scr, F.lane, true); continue; }
        ti -= 4096;
        if (ti < 1024) { const int i = ti >> 8, r = ti & 255, n0 = (r >> 3) * 32, kt = r & 7;
            conv_item(F.p.w_branch + (size_t)(l * 4 + i) * 512 * DM, DM, n0, 1.f, F.Wbrt() + (size_t)i * DM * 512 + (size_t)n0 * 512 + kt * 64, 512, kt * 64, scr, F.lane, true); continue; }
        ti -= 1024;
        { const int n0 = (ti >> 4) * 32, kt = ti & 15;
          conv_item(F.p.w_out + (size_t)l * DM * DM, DM, n0, 1.f, F.Woutt() + (size_t)n0 * DM + kt * 64, DM, kt * 64, scr, F.lane, false); }
    }
}

__device__ __forceinline__ void phase_prep(Frame& F, int l, const float* xlat, const float* xctx) {
    const int gw = F.bid * 8 + F.wave, ngw = F.nb * 8;
    for (int row = gw; row < NROW; row += ngw) {
        const float* xr = row < NTOK ? xlat + (size_t)row * DM : xctx + (size_t)(row - NTOK) * DM;
        const float* mv = F.modv() + ((size_t)l * 5 + row_batch(row)) * 6144;
#pragma unroll
        for (int j = 0; j < 4; ++j) { const int d = j * 256 + F.lane * 4;
            const f32x4 v = *(const f32x4*)(xr + d), m0 = *(const f32x4*)(mv + d), m1 = *(const f32x4*)(mv + 1024 + d);
            u32x2 o; o.x = pk2(v.x * (1.f + m1.x) + m0.x, v.y * (1.f + m1.y) + m0.y); o.y = pk2(v.z * (1.f + m1.z) + m0.z, v.w * (1.f + m1.w) + m0.w);
            *(u32x2*)(F.HX() + (size_t)row * DM + d) = o; }
    }
}


namespace pg {
typedef short bf16x8 __attribute__((ext_vector_type(8)));
constexpr int BM = 256, BK = 64, HALF = 128, HTB = HALF * BK * 2, STAGE_BYTES = 8 * HTB, NXCD = 8, WGM = 8;
__device__ __forceinline__ int lds_byte(int r, int c) { const int st = (r >> 4) * 2 + (c >> 5), rr = r & 15, cc = c & 31, ob = rr * 64 + cc * 2; return st * 1024 + (ob ^ (((ob >> 9) & 1) << 5)); }
__device__ __forceinline__ void stage_rc(int b, int& R, int& C) { const int st = b / 1024, sb = b % 1024, swz = sb ^ (((sb >> 9) & 1) << 5); R = (st >> 1) * 16 + swz / 64; C = (st & 1) * 32 + (swz % 64) / 2; }
struct Unit { const char* a; const char* b; int pm, pn, aux; };
__device__ __forceinline__ void static_map(int L, int nM, int nN, int& pm, int& pn) {
    const int nwg = nM * nN; int wgid = L; { const int q = nwg / NXCD, r = nwg % NXCD, xcd = wgid % NXCD, off = wgid / NXCD; wgid = (xcd < r ? xcd * (q + 1) : r * (q + 1) + (xcd - r) * q) + off; }
    const int nig = WGM * nN, gid = wgid / nig, fm = gid * WGM, gsz = (nM - fm) < WGM ? (nM - fm) : WGM;
    pm = fm + ((wgid % nig) % gsz); pn = (wgid % nig) / gsz;
}
template <class Epi, class Sched>
__device__ __forceinline__ void gemm_phase(LAS unsigned char* lds, const int lda, const int ldb, const int K, const Sched& S, const Epi& E) {
    int tid = threadIdx.x; asm volatile("" : "+v"(tid));
    const int wid = __builtin_amdgcn_readfirstlane(tid >> 6), lane = tid & 63, wr = wid >> 2, wc = wid & 3, fr = lane & 15, fq = lane >> 4;
    int nt = K / BK; asm volatile("" : "+s"(nt));
    unsigned voffA[2], voffB[2];
#pragma unroll
    for (int i = 0; i < 2; ++i) { int R, C; stage_rc(tid * 16 + i * 8192, R, C); voffA[i] = (unsigned)(R * lda + C) * 2u; voffB[i] = (unsigned)(R * ldb + C) * 2u; }
    const size_t kstep = (size_t)(BK * 2);
    const size_t hstepA = (size_t)HALF * lda * 2, hstepB = (size_t)HALF * ldb * 2;
    const unsigned ldsw = (unsigned)wid * 1024u;
    const int aoff = lds_byte(wr * 64 + fr, fq * 8), boff = lds_byte(wc * 32 + fr, fq * 8);
#define PG_SA(b, h) (((b) * 2 + (h)) * HTB)
#define PG_SB(b, h) ((4 + (b) * 2 + (h)) * HTB)
#define PG_STAGE(bufoff, gbase, voff) do { _Pragma("unroll") for (int _i = 0; _i < 2; ++_i) \
        __builtin_amdgcn_global_load_lds((const unsigned*)((const char*)(gbase) + (voff)[_i]), (LAS unsigned*)(lds + (bufoff) + ldsw + _i * 8192), 16, 0, 0); } while (0)
#define PG_LDA(dst, b, h) do { _Pragma("unroll") for (int m = 0; m < 4; ++m) _Pragma("unroll") for (int k = 0; k < 2; ++k) dst[m][k] = *(const LAS bf16x8*)(lds + PG_SA(b, h) + aoff + m * 2048 + k * 1024); } while (0)
#define PG_LDB(dst, b, h) do { _Pragma("unroll") for (int n = 0; n < 2; ++n) _Pragma("unroll") for (int k = 0; k < 2; ++k) dst[n][k] = *(const LAS bf16x8*)(lds + PG_SB(b, h) + boff + n * 2048 + k * 1024); } while (0)
#define PG_MMA(ai, bj, At, Bt) do { __builtin_amdgcn_s_setprio(1); _Pragma("unroll") for (int m = 0; m < 4; ++m) _Pragma("unroll") for (int n = 0; n < 2; ++n) _Pragma("unroll") for (int k = 0; k < 2; ++k) \
        acc[ai][bj][m][n] = __builtin_amdgcn_mfma_f32_16x16x32_bf16(Bt[n][k], At[m][k], acc[ai][bj][m][n], 0, 0, 0); __builtin_amdgcn_s_setprio(0); } while (0)
#define PG_WAIT_V(n) asm volatile("s_waitcnt vmcnt(" #n ")" ::: "memory")
#define PG_WAIT_L(n) asm volatile("s_waitcnt lgkmcnt(" #n ")" ::: "memory")
#define PG_BAR __builtin_amdgcn_s_barrier()
#define PG_SCHED __builtin_amdgcn_sched_barrier(0)
    Unit cur, nxt; int ui = 0;
    if (!S.next(0, cur)) return;
    f32x4 acc[2][2][4][2];
#pragma unroll
    for (int a = 0; a < 2; ++a)
#pragma unroll
        for (int b = 0; b < 2; ++b)
#pragma unroll
            for (int m = 0; m < 4; ++m)
#pragma unroll
                for (int n = 0; n < 2; ++n) acc[a][b][m][n] = (f32x4){0.f, 0.f, 0.f, 0.f};
    bf16x8 At[4][2], B0[2][2], B1[2][2];
    const char* cA = cur.a; const char* cB = cur.b;
    PG_STAGE(PG_SB(0, 0), cB, voffB); PG_STAGE(PG_SA(0, 0), cA, voffA); PG_STAGE(PG_SB(0, 1), cB + hstepB, voffB); PG_STAGE(PG_SA(0, 1), cA + hstepA, voffA);
    if (wr == 1) PG_BAR;
    PG_WAIT_V(4); PG_BAR;
    PG_STAGE(PG_SB(1, 0), cB + kstep, voffB); PG_STAGE(PG_SA(1, 0), cA + kstep, voffA); PG_STAGE(PG_SB(1, 1), cB + hstepB + kstep, voffB);
    PG_WAIT_V(6); PG_BAR;
    for (;;) {
        const bool has_next = S.next(ui + 1, nxt);
        const char* nA = has_next ? nxt.a : cA; const char* nB = has_next ? nxt.b : cB;
        for (int t = 0; t < nt; t += 2) {
            const bool last = (t == nt - 2);
            const char* a1 = cA + (size_t)(t + 1) * kstep;
            const char* a2 = last ? nA : cA + (size_t)(t + 2) * kstep; const char* b2 = last ? nB : cB + (size_t)(t + 2) * kstep;
            const char* a3 = a2 + kstep; const char* b3 = b2 + kstep;
            PG_LDB(B0, 0, 0); PG_SCHED; PG_LDA(At, 0, 0); PG_STAGE(PG_SA(1, 1), a1 + hstepA, voffA);
            PG_WAIT_L(8); PG_BAR; PG_WAIT_L(0); PG_MMA(0, 0, At, B0); PG_BAR; PG_SCHED;
            PG_LDB(B1, 0, 1); PG_STAGE(PG_SB(0, 0), b2, voffB);
            PG_BAR; PG_WAIT_L(0); PG_MMA(0, 1, At, B1); PG_BAR;
            PG_LDA(At, 0, 1); PG_STAGE(PG_SA(0, 0), a2, voffA);
            PG_BAR; PG_WAIT_L(0); PG_MMA(1, 0, At, B0); PG_BAR; PG_SCHED;
            PG_STAGE(PG_SB(0, 1), b2 + hstepB, voffB);
            PG_WAIT_V(6); PG_BAR; PG_MMA(1, 1, At, B1); PG_BAR;
            PG_LDB(B0, 1, 0); PG_SCHED; PG_LDA(At, 1, 0); PG_STAGE(PG_SA(0, 1), a2 + hstepA, voffA);
            PG_WAIT_L(8); PG_BAR; PG_WAIT_L(0); PG_MMA(0, 0, At, B0); PG_BAR; PG_SCHED;
            PG_LDB(B1, 1, 1); PG_STAGE(PG_SB(1, 0), b3, voffB);
            PG_BAR; PG_WAIT_L(0); PG_MMA(0, 1, At, B1); PG_BAR;
            PG_LDA(At, 1, 1); PG_STAGE(PG_SA(1, 0), a3, voffA);
            PG_BAR; PG_WAIT_L(0); PG_MMA(1, 0, At, B0); PG_BAR; PG_SCHED;
            PG_STAGE(PG_SB(1, 1), b3 + hstepB, voffB);
            PG_WAIT_V(6); PG_BAR; PG_MMA(1, 1, At, B1); PG_BAR;
        }
        E(acc, cur, wr, wc, fr, fq);
        if (!has_next) break;
#pragma unroll
        for (int a = 0; a < 2; ++a)
#pragma unroll
            for (int b = 0; b < 2; ++b)
#pragma unroll
                for (int m = 0; m < 4; ++m)
#pragma unroll
                    for (int n = 0; n < 2; ++n) acc[a][b][m][n] = (f32x4){0.f, 0.f, 0.f, 0.f};
        cur = nxt; cA = nA; cB = nB; ++ui;
    }
    PG_WAIT_V(0);
    if (wr == 0) PG_BAR;
    PG_BAR;
#undef PG_SA
#undef PG_SB
#undef PG_STAGE
#undef PG_LDA
#undef PG_LDB
#undef PG_MMA
#undef PG_WAIT_V
#undef PG_WAIT_L
#undef PG_BAR
#undef PG_SCHED
}

struct SchedG1 {
    const char *HX, *W1, *WV; int G, c;
    __device__ __forceinline__ bool next(int i, Unit& u) const {
        const int L = i * G + c, nmain = (NROW / 256) * (NP1 / 256);
        if (L < nmain) { static_map(L, NROW / 256, NP1 / 256, u.pm, u.pn); u.a = HX + (size_t)u.pm * 256 * DM * 2; u.b = W1 + (size_t)u.pn * 256 * DM * 2; u.aux = 0; return true; }
        const int idx = L - nmain; if (idx >= 3 * (NROW / 256)) return false;
        u.pm = idx % 3; u.pn = idx / 3; u.a = WV + (size_t)u.pm * 256 * DM * 2; u.b = HX + (size_t)u.pn * 256 * DM * 2; u.aux = 1; return true;
    }
};
struct SchedStatic {
    const char *A, *B; size_t tA, tB; int nM, nN, G, c;
    __device__ __forceinline__ bool next(int i, Unit& u) const {
        const int L = i * G + c; if (L >= nM * nN) return false;
        static_map(L, nM, nN, u.pm, u.pn); u.a = A + (size_t)u.pm * tA; u.b = B + (size_t)u.pn * tB; u.aux = 0; return true;
    }
};
struct SchedMerge {
    const char *BR, *W; int ntile, G, c;
    __device__ __forceinline__ bool split() const { return ntile > G && (ntile - G) * 4 <= G; }
    __device__ __forceinline__ bool next(int i, Unit& u) const {
        int t, br;
        if (split()) { if (i < 4) { t = c; br = i; u.aux = br; } else { if (i > 4 || c >= (ntile - G) * 4) return false; t = G + (c >> 2); br = c & 3; u.aux = 4 + br; } }
        else { t = c + (i >> 2) * G; if (t >= ntile) return false; br = i & 3; u.aux = br; }
        u.pm = t >> 2; u.pn = t & 3;
        u.a = BR + (size_t)u.pm * 256 * 2048 * 2 + (size_t)br * 512 * 2; u.b = W + (size_t)br * DM * 512 * 2 + (size_t)u.pn * 256 * 512 * 2; return true;
    }
};
struct SchedMoe {
    const char *A, *W; const int* off; size_t tA, wE, wT; int npan, NJ, G, c;
    __device__ __forceinline__ bool next(int i, Unit& u) const {
        const int L = i * G + c; if (L >= npan * NJ) return false;
        const int p = L / NJ, j = L % NJ; int e = 0;
#pragma unroll 1
        for (int q = 1; q < 32; ++q) if (p * 256 >= off[q]) e = q;
        e = __builtin_amdgcn_readfirstlane(e);
        u.pm = p; u.pn = j; u.aux = e; u.a = A + (size_t)p * tA; u.b = W + (size_t)e * wE + (size_t)j * wT; return true;
    }
};

#define PG_ROWCOL const int row0 = u.pm * BM + wr * 64 + fr, col0 = u.pn * BM + wc * 32 + 4 * fq
struct EpiG1 { bf16_t *P1, *VT; const float* rtab; const float* lbp; int layer;
    __device__ __forceinline__ void operator()(const f32x4 (&acc)[2][2][4][2], const Unit& u, int wr, int wc, int fr, int fq) const {
        const int row0 = u.pm * BM + wr * 64 + fr;
        if (u.aux || (u.pn >= 8 && u.pn <= 10)) {
            const int col0 = u.pn * BM + wc * 32 + 4 * fq; bf16_t* base = u.aux ? VT : P1; const size_t ld = u.aux ? (size_t)NROW : (size_t)NP1;
            const bool rope = !u.aux && (u.pm < NTOK / 256);
#pragma unroll
            for (int ai = 0; ai < 2; ++ai)
#pragma unroll
                for (int m = 0; m < 4; ++m) { const int r = row0 + ai * HALF + m * 16; bf16_t* rowp = base + (size_t)r * ld + col0;
#pragma unroll
                    for (int bj = 0; bj < 2; ++bj) {
                        f32x4 v0 = acc[ai][bj][m][0], v1 = acc[ai][bj][m][1];
                        if (rope && !(u.pn == 10 && bj == 1)) {
                            const int pos = r & (SEQ - 1), pp = (wc & 1) ? (pos & 63) : (pos >> 6); const float* tp = rtab + (pp * 16 + 4 * fq) * 2;
                            const f32x4 t0 = *(const f32x4*)tp, t1 = *(const f32x4*)(tp + 4);
                            const f32x4 a = v0, b = v1;
                            v0.x = a.x * t0.x - b.x * t0.y; v1.x = a.x * t0.y + b.x * t0.x; v0.y = a.y * t0.z - b.y * t0.w; v1.y = a.y * t0.w + b.y * t0.z;
                            v0.z = a.z * t1.x - b.z * t1.y; v1.z = a.z * t1.y + b.z * t1.x; v0.w = a.w * t1.z - b.w * t1.w; v1.w = a.w * t1.w + b.w * t1.z;
                        }
                        u32x2 o; o.x = pk2(v0.x, v0.y); o.y = pk2(v0.z, v0.w); *(u32x2*)(rowp + bj * HALF) = o;
                        o.x = pk2(v1.x, v1.y); o.y = pk2(v1.z, v1.w); *(u32x2*)(rowp + bj * HALF + 16) = o; } }
            return;
        }
        const int col0 = u.pn * BM + wc * 32 + 8 * fq;
        const int mode = (u.pn == 11 || u.pn == 12) ? 2 : ((u.pn >= 13 && u.pn <= 16) ? 3 : 0);
        if (mode == 3) {
            f32x4 lb4[2][2];
            const int z = (u.pn - 13) >> 1, cb = z * 512 + ((u.pn - 13) & 1) * 256 + wc * 32 + 8 * fq;
#pragma unroll
            for (int bj = 0; bj < 2; ++bj)
#pragma unroll
                for (int n = 0; n < 2; ++n) lb4[bj][n] = (layer == 0) ? (f32x4){0.f, 0.f, 0.f, 0.f} : *(const f32x4*)(lbp + cb + bj * HALF + 4 * n);
#pragma unroll
            for (int ai = 0; ai < 2; ++ai)
#pragma unroll
                for (int m = 0; m < 4; ++m) { bf16_t* rowp = P1 + (size_t)(row0 + ai * HALF + m * 16) * NP1 + col0;
#pragma unroll
                    for (int bj = 0; bj < 2; ++bj) { float gq[8];
#pragma unroll
                        for (int n = 0; n < 2; ++n)
#pragma unroll
                            for (int j = 0; j < 4; ++j) { const float f = acc[ai][bj][m][n][j], lb = lb4[bj][n][j]; const float t = __expf(-fabsf(f)), rr = __builtin_amdgcn_rcpf(1.f + t);
                                gq[4 * n + j] = __logf(fmaxf(lb + (1.f - lb) * ((f >= 0.f) ? rr : t * rr), 1e-37f)); }
                        u32x4 o; o.x = pk2(gq[0], gq[1]); o.y = pk2(gq[2], gq[3]); o.z = pk2(gq[4], gq[5]); o.w = pk2(gq[6], gq[7]); *(u32x4*)(rowp + bj * HALF) = o; } }
            return;
        }
#pragma unroll
        for (int ai = 0; ai < 2; ++ai)
#pragma unroll
            for (int m = 0; m < 4; ++m) { bf16_t* rowp = P1 + (size_t)(row0 + ai * HALF + m * 16) * NP1 + col0;
#pragma unroll
                for (int bj = 0; bj < 2; ++bj) {
                    f32x4 v0 = acc[ai][bj][m][0], v1 = acc[ai][bj][m][1];
                    if (mode == 2) {
#pragma unroll
                        for (int j = 0; j < 4; ++j) { v0[j] = v0[j] * __builtin_amdgcn_rcpf(1.f + __expf(-v0[j])); v1[j] = v1[j] * __builtin_amdgcn_rcpf(1.f + __expf(-v1[j])); }
                    }
                    u32x4 o; o.x = pk2(v0.x, v0.y); o.y = pk2(v0.z, v0.w); o.z = pk2(v1.x, v1.y); o.w = pk2(v1.z, v1.w); *(u32x4*)(rowp + bj * HALF) = o; } }
    }
};
#define PG_ROWCOL8 const int row0 = u.pm * BM + wr * 64 + fr, col0 = u.pn * BM + wc * 32 + 8 * fq
struct EpiGate { bf16_t* G;
    __device__ __forceinline__ void operator()(const f32x4 (&acc)[2][2][4][2], const Unit& u, int wr, int wc, int fr, int fq) const {
        PG_ROWCOL8;
#pragma unroll
        for (int ai = 0; ai < 2; ++ai)
#pragma unroll
            for (int m = 0; m < 4; ++m) { bf16_t* rowp = G + (size_t)(row0 + ai * HALF + m * 16) * NGATE + col0;
#pragma unroll
                for (int bj = 0; bj < 2; ++bj) { const f32x4 v0 = acc[ai][bj][m][0], v1 = acc[ai][bj][m][1]; u32x4 o;
                    o.x = pk2(sigmoidf_(v0.x), sigmoidf_(v0.y)); o.y = pk2(sigmoidf_(v0.z), sigmoidf_(v0.w)); o.z = pk2(sigmoidf_(v1.x), sigmoidf_(v1.y)); o.w = pk2(sigmoidf_(v1.z), sigmoidf_(v1.w));
                    *(u32x4*)(rowp + bj * HALF) = o; } }
    }
};
struct EpiMerge { const bf16_t* G; bf16_t* O; bf16_t* PM;
    __device__ __forceinline__ void operator()(const f32x4 (&acc)[2][2][4][2], const Unit& u, int wr, int wc, int fr, int fq) const {
        PG_ROWCOL8; const int br = u.aux & 3; const bool part = u.aux >= 4, rmw = !part && br != 0;
        bf16_t* const Ob = part ? PM + (size_t)br * NCTX * DM - (size_t)NTOK * DM : O;
#pragma unroll
        for (int ai = 0; ai < 2; ++ai) {
            u32x4 g4[4][2], o4[4][2];
#pragma unroll
            for (int m = 0; m < 4; ++m) { const size_t r = (size_t)(row0 + ai * HALF + m * 16); const bf16_t* gp = G + r * NGATE + br * 1024 + col0; const bf16_t* rowp = Ob + r * DM + col0;
#pragma unroll
                for (int bj = 0; bj < 2; ++bj) { g4[m][bj] = *(const u32x4*)(gp + bj * HALF); if (rmw) o4[m][bj] = *(const u32x4*)(rowp + bj * HALF); } }
#pragma unroll
            for (int m = 0; m < 4; ++m) { bf16_t* rowp = Ob + (size_t)(row0 + ai * HALF + m * 16) * DM + col0;
#pragma unroll
                for (int bj = 0; bj < 2; ++bj) { const f32x4 v0 = acc[ai][bj][m][0], v1 = acc[ai][bj][m][1]; const u32x4 gg = g4[m][bj];
                    float w[8] = {__uint_as_float(gg.x << 16) * v0.x, __uint_as_float(gg.x & 0xffff0000u) * v0.y, __uint_as_float(gg.y << 16) * v0.z, __uint_as_float(gg.y & 0xffff0000u) * v0.w,
                                  __uint_as_float(gg.z << 16) * v1.x, __uint_as_float(gg.z & 0xffff0000u) * v1.y, __uint_as_float(gg.w << 16) * v1.z, __uint_as_float(gg.w & 0xffff0000u) * v1.w};
                    if (rmw) { const u32x4 oo = o4[m][bj];
                        w[0] += __uint_as_float(oo.x << 16); w[1] += __uint_as_float(oo.x & 0xffff0000u); w[2] += __uint_as_float(oo.y << 16); w[3] += __uint_as_float(oo.y & 0xffff0000u);
                        w[4] += __uint_as_float(oo.z << 16); w[5] += __uint_as_float(oo.z & 0xffff0000u); w[6] += __uint_as_float(oo.w << 16); w[7] += __uint_as_float(oo.w & 0xffff0000u); }
                    u32x4 o; o.x = pk2(w[0], w[1]); o.y = pk2(w[2], w[3]); o.z = pk2(w[4], w[5]); o.w = pk2(w[6], w[7]); *(u32x4*)(rowp + bj * HALF) = o; } }
            asm volatile("" ::: "memory");
        }
    }
};
struct EpiWout { const float *xlat, *xctx; float *olat, *octx; const float* modl;
    __device__ __forceinline__ void operator()(const f32x4 (&acc)[2][2][4][2], const Unit& u, int wr, int wc, int fr, int fq) const {
        PG_ROWCOL; const bool lat = u.pm < NTOK / 256; const int rb = lat ? (u.pm >> 4) : 4;
        const float* xin = lat ? xlat : xctx - (size_t)NTOK * DM; float* xo = lat ? olat : octx - (size_t)NTOK * DM; const float* m2 = modl + (size_t)rb * 6144 + 2 * 1024 + col0;
        f32x4 mv[2][2];
#pragma unroll
        for (int bj = 0; bj < 2; ++bj)
#pragma unroll
            for (int n = 0; n < 2; ++n) mv[bj][n] = *(const f32x4*)(m2 + bj * HALF + n * 16);
#pragma unroll
        for (int aq = 0; aq < 4; ++aq) { const int ai = aq >> 1, m0 = (aq & 1) * 2;
            f32x4 xv[4][2][2];
#pragma unroll
            for (int m = m0; m < m0 + 2; ++m) { const size_t o = (size_t)(row0 + ai * HALF + m * 16) * DM + col0;
#pragma unroll
                for (int bj = 0; bj < 2; ++bj)
#pragma unroll
                    for (int n = 0; n < 2; ++n) xv[m][bj][n] = *(const f32x4*)(xin + o + bj * HALF + n * 16); }
#pragma unroll
            for (int m = m0; m < m0 + 2; ++m) { const size_t o = (size_t)(row0 + ai * HALF + m * 16) * DM + col0;
#pragma unroll
                for (int bj = 0; bj < 2; ++bj)
#pragma unroll
                    for (int n = 0; n < 2; ++n) *(f32x4*)(xo + o + bj * HALF + n * 16) = ALPHA * xv[m][bj][n] + mv[bj][n] * acc[ai][bj][m][n]; }
            asm volatile("" ::: "memory");
        }
    }
};
struct EpiMoe1 { bf16_t* HID; const float* roww;
    __device__ __forceinline__ void operator()(const f32x4 (&acc)[2][2][4][2], const Unit& u, int wr, int wc, int fr, int fq) const {
        const int row0 = u.pm * BM + wr * 64 + fr, hc0 = u.pn * 128 + wc * 32 + 8 * fq;
#pragma unroll
        for (int ai = 0; ai < 2; ++ai)
#pragma unroll
            for (int m = 0; m < 4; ++m) { const int r = row0 + ai * HALF + m * 16; const float w = roww[r];
                const f32x4 g0 = acc[ai][0][m][0], g1 = acc[ai][0][m][1], u0 = acc[ai][1][m][0], u1 = acc[ai][1][m][1]; u32x4 o;
                o.x = pk2(siluf_(g0.x) * u0.x * w, siluf_(g0.y) * u0.y * w); o.y = pk2(siluf_(g0.z) * u0.z * w, siluf_(g0.w) * u0.w * w);
                o.z = pk2(siluf_(g1.x) * u1.x * w, siluf_(g1.y) * u1.y * w); o.w = pk2(siluf_(g1.z) * u1.z * w, siluf_(g1.w) * u1.w * w);
                *(u32x4*)(HID + (size_t)r * 256 + hc0) = o; }
    }
};
struct EpiMoe2 { bf16_t* Y; const int* rmap; bf16_t* dump;
    __device__ __forceinline__ void operator()(const f32x4 (&acc)[2][2][4][2], const Unit& u, int wr, int wc, int fr, int fq) const {
        PG_ROWCOL8;
#pragma unroll
        for (int ai = 0; ai < 2; ++ai)
#pragma unroll
            for (int m = 0; m < 4; ++m) { const int s = rmap[row0 + ai * HALF + m * 16];
                bf16_t* rowp = (s >= 0 ? Y + (size_t)s * DM : dump) + col0;
#pragma unroll
                for (int bj = 0; bj < 2; ++bj) { const f32x4 v0 = acc[ai][bj][m][0], v1 = acc[ai][bj][m][1]; u32x4 o; o.x = pk2(v0.x, v0.y); o.y = pk2(v0.z, v0.w); o.z = pk2(v1.x, v1.y); o.w = pk2(v1.z, v1.w); *(u32x4*)(rowp + bj * HALF) = o; } }
    }
};
#undef PG_ROWCOL8
#undef PG_ROWCOL
}

__device__ __forceinline__ void moe_offsets(Frame& F, int l, int* off) {
    if (F.tid < 64) {
        int v = (F.tid < 32) ? (((int)F.cnt()[l * 32 + F.tid] + 255) & ~255) : 0;
#pragma unroll
        for (int o = 1; o < 32; o <<= 1) { const int t = __shfl_up(v, o); if ((F.tid & 63) >= o) v += t; }
        if (F.tid < 32) off[F.tid + 1] = v;
        if (F.tid == 0) off[0] = 0;
    }
    __syncthreads();
}

__device__ __forceinline__ void phase_rope(Frame& F) {
    float* tab = F.smf;
    for (int e = F.tid; e < 1024; e += NTHR) { const int pp = e >> 4, i = e & 15; const float inv = powf(10000.f, -(float)i / 16.f), ang = (float)pp * inv; tab[2 * e] = cosf(ang); tab[2 * e + 1] = sinf(ang); }
    __syncthreads();
    const size_t total = (size_t)NTOK * 320;
    for (size_t idx = (size_t)F.bid * NTHR + F.tid; idx < total; idx += (size_t)F.nb * NTHR) {
        const int row = (int)(idx / 320), r = (int)(idx % 320), h = r >> 5, half = (r >> 4) & 1, i = r & 15;
        const int pos = row & (SEQ - 1), pp = half ? (pos & 63) : (pos >> 6);
        const float cs = tab[2 * (pp * 16 + i)], sn = tab[2 * (pp * 16 + i) + 1];
        bf16_t* base = F.P1() + (size_t)row * NP1 + (h < 8 ? PC_CQ + h * 64 : PC_CK + (h - 8) * 64) + half * 32 + i;
        const float u1 = bf2f(base[0]), u2 = bf2f(base[16]);
        base[0] = f2bf(u1 * cs - u2 * sn); base[16] = f2bf(u1 * sn + u2 * cs);
    }
}

__device__ __forceinline__ int seq_row(int s, int b, int z) {
    if (s < LC) { const int tc = z ? (LC - 1 - s) : s; return NTOK + b * LC + tc; }
    const int tl = s - LC, t = z ? (SEQ - 1 - tl) : tl; return b * SEQ + t;
}
typedef short bf16x8_t __attribute__((ext_vector_type(8)));
typedef short bf16x4_t __attribute__((ext_vector_type(4)));
struct MaskNone { __device__ __forceinline__ void operator()(f32x4&, f32x4&) const {} };
struct MaskNA { int u0; const float* brow;
    __device__ __forceinline__ void operator()(f32x4& s0, f32x4& s1) const {
        float v[8] = {s0.x, s0.y, s0.z, s0.w, s1.x, s1.y, s1.z, s1.w};
#pragma unroll
        for (int T = 0; T < 2; ++T)
#pragma unroll
            for (int rr = 0; rr < 4; ++rr) v[T * 4 + rr] = ((unsigned)(u0 + 16 * T + rr) < 16u) ? v[T * 4 + rr] + brow[16 * T + rr] : -INFINITY;
        s0 = (f32x4){v[0], v[1], v[2], v[3]}; s1 = (f32x4){v[4], v[5], v[6], v[7]};
    }
};
struct MaskWA { int i, j0;
    __device__ __forceinline__ void operator()(f32x4& s0, f32x4& s1) const {
        float v[8] = {s0.x, s0.y, s0.z, s0.w, s1.x, s1.y, s1.z, s1.w};
#pragma unroll
        for (int T = 0; T < 2; ++T)
#pragma unroll
            for (int rr = 0; rr < 4; ++rr) { const int j = j0 + 16 * T + rr; const bool ok = (j >= 0) && (j < SEQ) && (i - j <= 128) && (j - i <= 128);
                v[T * 4 + rr] = ok ? v[T * 4 + rr] : -INFINITY; }
        s0 = (f32x4){v[0], v[1], v[2], v[3]}; s1 = (f32x4){v[4], v[5], v[6], v[7]};
    }
};
struct KVF { bf16x8_t k[4]; bf16x4_t v[4][2]; };
__device__ __forceinline__ void kv_load(KVF& f, const char* kbase, unsigned ko0, unsigned ko1, const char* vbase, unsigned vo0, unsigned vo1) {
    f.k[0] = *(const bf16x8_t*)(kbase + ko0); f.k[1] = *(const bf16x8_t*)(kbase + ko0 + 64); f.k[2] = *(const bf16x8_t*)(kbase + ko1); f.k[3] = *(const bf16x8_t*)(kbase + ko1 + 64);
#pragma unroll
    for (int t = 0; t < 4; ++t) { f.v[t][0] = *(const bf16x4_t*)(vbase + vo0 + (unsigned)t * 16u * NROW * 2u); f.v[t][1] = *(const bf16x4_t*)(vbase + vo1 + (unsigned)t * 16u * NROW * 2u); }
}
__device__ __forceinline__ float xmax_g(float x) {
    auto r = __builtin_amdgcn_permlane16_swap(__float_as_uint(x), __float_as_uint(x), false, false); x = fmaxf(__uint_as_float(r[0]), __uint_as_float(r[1]));
    auto q = __builtin_amdgcn_permlane32_swap(__float_as_uint(x), __float_as_uint(x), false, false); return fmaxf(__uint_as_float(q[0]), __uint_as_float(q[1])); }
__device__ __forceinline__ float xsum_g(float x) {
    auto r = __builtin_amdgcn_permlane16_swap(__float_as_uint(x), __float_as_uint(x), false, false); x = __uint_as_float(r[0]) + __uint_as_float(r[1]);
    auto q = __builtin_amdgcn_permlane32_swap(__float_as_uint(x), __float_as_uint(x), false, false); return __uint_as_float(q[0]) + __uint_as_float(q[1]); }
template <class MaskF>
__device__ __forceinline__ void attn_tile(float& am, f32x4& asum, f32x4 (&ao)[4], const bf16x8_t (&qb)[2], const KVF& f, const MaskF& maskf) {
    f32x4 s0 = {0.f, 0.f, 0.f, 0.f}, s1 = {0.f, 0.f, 0.f, 0.f};
    s0 = __builtin_amdgcn_mfma_f32_16x16x32_bf16(f.k[0], qb[0], s0, 0, 0, 0); s0 = __builtin_amdgcn_mfma_f32_16x16x32_bf16(f.k[1], qb[1], s0, 0, 0, 0);
    s1 = __builtin_amdgcn_mfma_f32_16x16x32_bf16(f.k[2], qb[0], s1, 0, 0, 0); s1 = __builtin_amdgcn_mfma_f32_16x16x32_bf16(f.k[3], qb[1], s1, 0, 0, 0);
    maskf(s0, s1);
    const float ml = fmaxf(fmaxf(fmaxf(s0.x, s0.y), fmaxf(s0.z, s0.w)), fmaxf(fmaxf(s1.x, s1.y), fmaxf(s1.z, s1.w)));
    if (__any(ml > am)) {
        const float mn = fmaxf(am, xmax_g(ml)), alpha = __builtin_amdgcn_exp2f(am - mn); am = mn; asum = asum * alpha;
#pragma unroll
        for (int t = 0; t < 4; ++t) ao[t] = ao[t] * alpha;
    }
    f32x4 p0, p1;
    p0.x = __builtin_amdgcn_exp2f(s0.x - am); p0.y = __builtin_amdgcn_exp2f(s0.y - am); p0.z = __builtin_amdgcn_exp2f(s0.z - am); p0.w = __builtin_amdgcn_exp2f(s0.w - am);
    p1.x = __builtin_amdgcn_exp2f(s1.x - am); p1.y = __builtin_amdgcn_exp2f(s1.y - am); p1.z = __builtin_amdgcn_exp2f(s1.z - am); p1.w = __builtin_amdgcn_exp2f(s1.w - am);
    union { bf16x8_t v; unsigned u[4]; } pb, ones;
    pb.u[0] = pk2(p0.x, p0.y); pb.u[1] = pk2(p0.z, p0.w); pb.u[2] = pk2(p1.x, p1.y); pb.u[3] = pk2(p1.z, p1.w);
    ones.u[0] = ones.u[1] = ones.u[2] = ones.u[3] = 0x3f803f80u;
#pragma unroll
    for (int t = 0; t < 4; ++t) {
        union { bf16x8_t v; bf16x4_t h[2]; } av; av.h[0] = f.v[t][0]; av.h[1] = f.v[t][1];
        ao[t] = __builtin_amdgcn_mfma_f32_16x16x32_bf16(av.v, pb.v, ao[t], 0, 0, 0);
    }
    asum = __builtin_amdgcn_mfma_f32_16x16x32_bf16(ones.v, pb.v, asum, 0, 0, 0);
}
template <int kind>
__device__ __forceinline__ void attn_block(Frame& F, int l, int item, const float* rpb_s, bf16_t* sbuf) {
    constexpr int NQ = 2, NCS = 4, NLOC = (kind == 0) ? 11 : (kind == 1 ? 5 : 0), NS = NCS + NLOC, SROW = 72;
    const int tid = F.tid, lane = F.lane, n = lane & 15, g = lane >> 4, w = __builtin_amdgcn_readfirstlane(F.wave);
    const bf16_t* P1 = F.P1(); const bf16_t* VT = F.VT();
    int b, h0, kvh = 0, kcol, vrow, r = 0, cb = 0, t0 = 0, t0g = 0, r0 = 0, qrow0, qcol0, brcol0;
    constexpr int QRS = (kind == 0) ? 64 : (kind == 2 ? 16 : 0), QCS = (kind == 1 || kind == 3) ? 64 : 0;
    if (kind == 0) { const int rq = item & 15, hb = (item >> 4) & 7; b = item >> 7; r0 = 4 * rq; cb = w & 3; r = r0 + 2 * (w >> 2); h0 = hb; kcol = PC_BK + hb * 64; vrow = hb * 64;
        qrow0 = b * SEQ + r * 64 + cb * 16; qcol0 = PC_BQ + hb * 64; brcol0 = 512 + hb * 64; }
    else if (kind == 1) { const int qg = item & 63; kvh = (item >> 6) & 1; b = item >> 7; t0g = 64 * qg; t0 = t0g + 16 * (w & 3); h0 = kvh * 4 + 2 * (w >> 2); kcol = PC_CK + kvh * 64; vrow = 512 + kvh * 64;
        qrow0 = b * SEQ + t0; qcol0 = PC_CQ + h0 * 64; brcol0 = 1024 + h0 * 64; }
    else if (kind == 2) { const int hb = item & 7; b = item >> 3; h0 = hb; kcol = PC_BK + hb * 64; vrow = hb * 64; qrow0 = NTOK + b * LC + 32 * w; qcol0 = PC_BQ + hb * 64; brcol0 = 512 + hb * 64; }
    else { const int qh = item & 3; kvh = (item >> 2) & 1; b = item >> 3; h0 = kvh * 4 + 2 * (w >> 2); kcol = PC_CK + kvh * 64; vrow = 512 + kvh * 64;
        qrow0 = NTOK + b * LC + 16 * (4 * qh + (w & 3)); qcol0 = PC_CQ + h0 * 64; brcol0 = 1024 + h0 * 64; }
    bf16x8_t qb[NQ][2]; float am[NQ]; f32x4 asum[NQ], ao[NQ][4];
    { const char* qbase = (const char*)P1; const unsigned qo = (unsigned)(qrow0 + n) * (unsigned)(NP1 * 2) + (unsigned)(qcol0 + 8 * g) * 2u;
#pragma unroll
      for (int q = 0; q < NQ; ++q) { const unsigned o = qo + (unsigned)q * (unsigned)(QRS * NP1 * 2 + QCS * 2); qb[q][0] = *(const bf16x8_t*)(qbase + o); qb[q][1] = *(const bf16x8_t*)(qbase + o + 64);
        am[q] = -1e30f; asum[q] = (f32x4){0.f, 0.f, 0.f, 0.f};
#pragma unroll
        for (int t = 0; t < 4; ++t) ao[q][t] = (f32x4){0.f, 0.f, 0.f, 0.f}; } }
    const int crow0 = NTOK + b * LC, ru0 = min(max(r0 - 4, 0), 56);
    const int w0 = (cb == 0) ? 0 : (cb == 1 ? 8 : (cb == 2 ? 24 : 32));
    const int srow = tid >> 3, sch = tid & 7;
    const char* kbase = (const char*)P1; const char* vbase = (const char*)VT;
    u32x4 kr0 = {0u, 0u, 0u, 0u}, vr0 = kr0, kr1 = kr0, vr1 = kr0;
    auto stage_load = [&](int s, u32x4& kreg, u32x4& vreg) {
        int krow, vcol;
        if (s < NCS) { krow = crow0 + 64 * s + srow; vcol = crow0 + 64 * s + 8 * sch; }
        else if (kind == 0) { const int kr = min(ru0 + (s - NCS), 63); krow = b * SEQ + kr * 64 + srow; vcol = b * SEQ + kr * 64 + 8 * sch; }
        else { const int kb = t0g - 128 + 64 * (s - NCS); krow = b * SEQ + min(max(kb + srow, 0), SEQ - 1); vcol = b * SEQ + min(max(kb + 8 * sch, 0), SEQ - 8); }
        kreg = *(const u32x4*)(kbase + (unsigned)krow * (unsigned)(NP1 * 2) + (unsigned)(kcol * 2 + sch * 16));
        vreg = *(const u32x4*)(vbase + (unsigned)(vrow + srow) * (unsigned)(NROW * 2) + (unsigned)vcol * 2u);
    };
    auto stage_store = [&](int s, const u32x4& kreg, const u32x4& vreg) { bf16_t* Ks = sbuf + (s & 1) * (2 * 64 * SROW); bf16_t* Vs = Ks + 64 * SROW;
        *(u32x4*)(Ks + srow * SROW + sch * 8) = kreg; *(u32x4*)(Vs + srow * SROW + sch * 8) = vreg; };
    stage_load(0, kr1, vr1); stage_store(0, kr1, vr1); stage_load(1, kr0, vr0);
    __syncthreads();
    auto do_step = [&](int s, const u32x4& kst, const u32x4& vst, u32x4& kld, u32x4& vld) {
        if (s + 2 < NS) stage_load(s + 2, kld, vld);
#pragma unroll
        for (int hh = 0; hh < 2; ++hh) {
            bool act[NQ]; int kofs = 32 * hh;
            if (s < NCS) { act[0] = act[1] = true; }
            else if (kind == 0) { const int kr = ru0 + (s - NCS); kofs = w0;
#pragma unroll
                for (int q = 0; q < NQ; ++q) { const int rsq = min(max(r + q - 4, 0), 56); act[q] = (hh == 0) && (kr <= 63) && (kr >= rsq) && (kr <= rsq + 7); } }
            else { const int kb = t0g - 128 + 64 * (s - NCS) + 32 * hh; act[0] = act[1] = (kb + 31 >= t0 - 128) && (kb <= t0 + 143); }
            if (act[0] || act[1]) {
                const bf16_t* Ks = sbuf + (s & 1) * (2 * 64 * SROW); const bf16_t* Vs = Ks + 64 * SROW;
                KVF f;
                f.k[0] = *(const bf16x8_t*)(Ks + (kofs + n) * SROW + 8 * g); f.k[1] = *(const bf16x8_t*)(Ks + (kofs + n) * SROW + 32 + 8 * g);
                f.k[2] = *(const bf16x8_t*)(Ks + (kofs + 16 + n) * SROW + 8 * g); f.k[3] = *(const bf16x8_t*)(Ks + (kofs + 16 + n) * SROW + 32 + 8 * g);
#pragma unroll
                for (int t = 0; t < 4; ++t) { f.v[t][0] = *(const bf16x4_t*)(Vs + (16 * t + n) * SROW + kofs + 4 * g); f.v[t][1] = *(const bf16x4_t*)(Vs + (16 * t + n) * SROW + kofs + 16 + 4 * g); }
                if (s < NCS) {
#pragma unroll
                    for (int q = 0; q < NQ; ++q) attn_tile(am[q], asum[q], ao[q], qb[q], f, MaskNone());
                } else if (kind == 0) { const int kr = ru0 + (s - NCS);
#pragma unroll
                    for (int q = 0; q < NQ; ++q) if (act[q]) { const int c = cb * 16 + n, csq = min(max(c - 8, 0), 48), kc0 = w0 + 4 * g;
                        MaskNA mk{kc0 - csq, rpb_s + (h0 * 15 + (kr - (r + q) + 7)) * 64 + (kc0 - c + 15 + 16)}; attn_tile(am[q], asum[q], ao[q], qb[q], f, mk); }
                } else if (kind == 1) { const int kb = t0g - 128 + 64 * (s - NCS) + 32 * hh;
                    if (kb >= t0 - 113 && kb + 31 <= t0 + 128 && kb >= 0 && kb + 31 < SEQ) {
#pragma unroll
                        for (int q = 0; q < NQ; ++q) attn_tile(am[q], asum[q], ao[q], qb[q], f, MaskNone());
                    } else { MaskWA mk{t0 + n, kb + 4 * g};
#pragma unroll
                        for (int q = 0; q < NQ; ++q) attn_tile(am[q], asum[q], ao[q], qb[q], f, mk); }
                }
            }
        }
        if (s + 1 < NS) stage_store(s + 1, kst, vst);
        __syncthreads();
    };
#pragma unroll 1
    for (int s = 0; s < NS; s += 2) { do_step(s, kr0, vr0, kr1, vr1); if (s + 1 < NS) do_step(s + 1, kr1, vr1, kr0, vr0); }
#pragma unroll
    for (int q = 0; q < NQ; ++q) {
        float lt = asum[q].x;
        float osc = 1.f;
        if (kind == 1 || kind == 3) { const float sk = F.p.wa_sink[l * 8 + h0 + q] * 1.44269504089f, mf = fmaxf(am[q], sk); osc = __builtin_amdgcn_exp2f(am[q] - mf); lt = lt * osc + __builtin_amdgcn_exp2f(sk - mf); }
        const float inv = osc / lt;
        char* obase = (char*)F.BR(); const unsigned oo = (unsigned)(qrow0 + q * QRS + n) * 4096u + (unsigned)(brcol0 + q * QCS + 4 * g) * 2u;
#pragma unroll
        for (int t = 0; t < 4; ++t) { const f32x4 v = ao[q][t] * inv; u32x2 o2; o2.x = pk2(v.x, v.y); o2.y = pk2(v.z, v.w); *(u32x2*)(obase + oo + 32u * t) = o2; }
    }
}

template <int DK, bool HG>
__device__ __forceinline__ void prescan_combo(Frame& F, int l, int b, int h, int first, int step) {
    constexpr int NDP = DK / 2, NTG = NTHR / NDP, TPT = 64 / NTG, LGS = 66;
    REFRESH(F);
    const int tid = F.tid, dp = tid % NDP, tg = tid / NDP, lane = F.lane, n = lane & 15, g = lane >> 4, w = __builtin_amdgcn_readfirstlane(F.wave);
    float* TOT = F.smf;
    float* LGS_ = F.smf + 2 * 2 * NTG * DK;
    char* p1b = (char*)F.P1();
    bf16x8_t bw[HG ? 1 : 4]; f32x2_t lb2[2];
    lb2[0] = (f32x2_t){0.f, 0.f}; lb2[1] = lb2[0];
    if (!HG) {
        const int zw = w >> 2;
#pragma unroll
        for (int dt = 0; dt < 4; ++dt) { float wv[8];
#pragma unroll
            for (int j = 0; j < 8; ++j) { const float x = F.p.gla_lr_w[((size_t)(l * 2 + zw) * 16 + 8 * (g & 1) + j) * 256 + h * 64 + dt * 16 + n]; const float hi = __uint_as_float(pk2(x, x) << 16); wv[j] = (g < 2) ? x : x - hi; }
            union { bf16x8_t v; unsigned u[4]; } pb; pb.u[0] = pk2(wv[0], wv[1]); pb.u[1] = pk2(wv[2], wv[3]); pb.u[2] = pk2(wv[4], wv[5]); pb.u[3] = pk2(wv[6], wv[7]); bw[HG ? 0 : dt] = pb.v; }
#pragma unroll
        for (int z = 0; z < 2; ++z) { const float* bp = F.p.gla_lr_b + (l * 2 + z) * 256 + h * 64 + 2 * dp; lb2[z] = (f32x2_t){bp[0], bp[1]}; }
    }
    const int qcol = HG ? PC_DQ + h * 128 + 2 * dp : PC_AQ + h * 64 + 2 * dp, kcol = HG ? PC_DF + h * 128 + 2 * dp : PC_AK + h * 64 + 2 * dp;
    float* ebase = F.ESC() + (HG ? 32 * 68 * 128 : 0);
    unsigned rq[TPT], rk[TPT], rk1[HG ? TPT : 1]; u32x4 rlp = {0u, 0u, 0u, 0u};
    rk1[0] = 0u;
#define PS_LOAD(nbk_) do { const int row0_ = seq_row((nbk_) * 64, b, 0); unsigned o_ = (unsigned)(row0_ + tg * TPT) * (unsigned)(NP1 * 2); \
        _Pragma("unroll") for (int tt = 0; tt < TPT; ++tt) { rq[tt] = *(const unsigned*)(p1b + (o_ + (unsigned)(qcol * 2))); rk[tt] = *(const unsigned*)(p1b + (o_ + (unsigned)(kcol * 2))); \
            if (HG) rk1[HG ? tt : 0] = *(const unsigned*)(p1b + (o_ + (unsigned)((kcol + 512) * 2))); o_ += (unsigned)(NP1 * 2); } \
        if (!HG) rlp = *(const u32x4*)(p1b + ((unsigned)(row0_ + (w & 3) * 16 + n) * (unsigned)(NP1 * 2) + (unsigned)((PC_ALR + (w >> 2) * 16 + (g & 1) * 8) * 2))); } while (0)
    int nbk = first, par = 0;
    if (nbk < 68) PS_LOAD(nbk);
#pragma unroll 1
    for (; nbk < 68; nbk += step, par ^= 1) {
        float* tot = TOT + par * (2 * NTG * DK);
        if (!HG) {
            union { bf16x8_t v; u32x4 u; } af; af.u = rlp;
            float* lgw = LGS_ + ((w >> 2) * 64 + (w & 3) * 16 + 4 * g) * LGS + n;
#pragma unroll
            for (int dt = 0; dt < 4; ++dt) { const f32x4 d = __builtin_amdgcn_mfma_f32_16x16x32_bf16(af.v, bw[HG ? 0 : dt], (f32x4){0.f, 0.f, 0.f, 0.f}, 0, 0, 0);
                lgw[0 * LGS + dt * 16] = d.x; lgw[1 * LGS + dt * 16] = d.y; lgw[2 * LGS + dt * 16] = d.z; lgw[3 * LGS + dt * 16] = d.w; }
            __syncthreads();
        }
        const int row0 = seq_row(nbk * 64, b, 0);
        f32x2_t qv[TPT], kv0[TPT], kv1[HG ? TPT : 1], cs0[TPT], cs1[TPT];
#pragma unroll
        for (int tt = 0; tt < TPT; ++tt) {
            qv[tt] = (f32x2_t){__uint_as_float(rq[tt] << 16), __uint_as_float(rq[tt] & 0xffff0000u)};
            const f32x2_t kr = {__uint_as_float(rk[tt] << 16), __uint_as_float(rk[tt] & 0xffff0000u)};
            if (HG) { const unsigned r1 = rk1[HG ? tt : 0]; const f32x2_t k1 = {__uint_as_float(r1 << 16), __uint_as_float(r1 & 0xffff0000u)};
                cs0[tt] = kr; cs1[tt] = k1;
                kv0[tt] = (f32x2_t){1.f - __expf(kr.x), 1.f - __expf(kr.y)}; kv1[HG ? tt : 0] = (f32x2_t){1.f - __expf(k1.x), 1.f - __expf(k1.y)}; }
            else kv0[tt] = kr;
        }
        if (nbk + step < 68) PS_LOAD(nbk + step);
        if (!HG) {
#pragma unroll
            for (int tt = 0; tt < TPT; ++tt)
#pragma unroll
                for (int z = 0; z < 2; ++z) {
                    const f32x2_t lg = *(const f32x2_t*)(LGS_ + (z * 64 + tg * TPT + tt) * LGS + 2 * dp) + lb2[z];
                    const f32x2_t gz = {(fminf(lg.x, 0.f) - __logf(1.f + __expf(-fabsf(lg.x)))) * (1.f / 16.f), (fminf(lg.y, 0.f) - __logf(1.f + __expf(-fabsf(lg.y)))) * (1.f / 16.f)};
                    if (z == 0) cs0[tt] = gz; else cs1[tt] = gz; }
        }
#pragma unroll
        for (int tt = 1; tt < TPT; ++tt) { cs0[tt] += cs0[tt - 1]; cs1[TPT - 1 - tt] += cs1[TPT - tt]; }
        *(f32x2_t*)(tot + (0 * NTG + tg) * DK + 2 * dp) = cs0[TPT - 1];
        *(f32x2_t*)(tot + (1 * NTG + tg) * DK + 2 * dp) = cs1[0];
        __syncthreads();
        f32x2_t offs0 = {0.f, 0.f}, mid0 = offs0, last0 = offs0, offs1 = offs0, mid1 = offs0, last1 = offs0;
#pragma unroll
        for (int t2 = 0; t2 < NTG; ++t2) { const f32x2_t v0 = *(const f32x2_t*)(tot + (0 * NTG + t2) * DK + 2 * dp), v1 = *(const f32x2_t*)(tot + (1 * NTG + t2) * DK + 2 * dp);
            if (t2 < tg) offs0 += v0; if (t2 < NTG / 2) mid0 += v0; last0 += v0;
            if (t2 > tg) offs1 += v1; if (t2 >= NTG / 2) mid1 += v1; last1 += v1; }
        const f32x2_t d0 = offs0 - mid0, d1 = offs1 - mid1;
        unsigned ro = (unsigned)(row0 + tg * TPT);
#pragma unroll
        for (int tt = 0; tt < TPT; ++tt, ++ro) {
            const float x00 = fminf(fmaxf(cs0[tt].x + d0.x, -80.f), 80.f), x01 = fminf(fmaxf(cs0[tt].y + d0.y, -80.f), 80.f);
            const float x10 = fminf(fmaxf(cs1[tt].x + d1.x, -80.f), 80.f), x11 = fminf(fmaxf(cs1[tt].y + d1.y, -80.f), 80.f);
            const f32x2_t k1v = kv1[HG ? tt : 0], k1 = HG ? k1v : kv0[tt];
            const unsigned qd0 = pk2(qv[tt].x * __expf(x00), qv[tt].y * __expf(x01)), kd0 = pk2(kv0[tt].x * __expf(-x00), kv0[tt].y * __expf(-x01));
            const unsigned qd1 = pk2(qv[tt].x * __expf(x10), qv[tt].y * __expf(x11)), kd1 = pk2(k1.x * __expf(-x10), k1.y * __expf(-x11));
            const unsigned o_ = ro * (unsigned)(NP1 * 2);
            *(unsigned*)(p1b + (o_ + (unsigned)(qcol * 2))) = qd0; *(unsigned*)(p1b + (o_ + (unsigned)(kcol * 2))) = kd0;
            if (HG) { *(unsigned*)(p1b + (o_ + (unsigned)((kcol + 512) * 2))) = kd1; *(unsigned*)((char*)F.BR() + (ro * 4096u + (unsigned)((1536 + h * 128 + 2 * dp) * 2))) = qd1; }
            else { *(unsigned*)((char*)F.SC1() + (ro * 1024u + (unsigned)((h * 64 + 2 * dp) * 2))) = qd1; *(unsigned*)((char*)F.SC1() + (ro * 1024u + (unsigned)((256 + h * 64 + 2 * dp) * 2))) = kd1; }
        }
        if (tg == 0) {
            float* e0 = ebase + (size_t)(((b * 4 + h) * 2 + 0) * 68 + nbk) * (2 * DK), *e1 = ebase + (size_t)(((b * 4 + h) * 2 + 1) * 68 + (nbk < 4 ? 3 - nbk : 71 - nbk)) * (2 * DK);
            *(f32x2_t*)(e0 + 2 * dp) = (f32x2_t){__expf(mid0.x), __expf(mid0.y)}; *(f32x2_t*)(e0 + DK + 2 * dp) = (f32x2_t){__expf(last0.x - mid0.x), __expf(last0.y - mid0.y)};
            *(f32x2_t*)(e1 + 2 * dp) = (f32x2_t){__expf(mid1.x), __expf(mid1.y)}; *(f32x2_t*)(e1 + DK + 2 * dp) = (f32x2_t){__expf(last1.x - mid1.x), __expf(last1.y - mid1.y)};
        }
    }
    __syncthreads();
#undef PS_LOAD
}
__device__ __forceinline__ void phase_prescan(Frame& F, int l) {
    if (F.nb >= 32) { const int combo = F.bid & 31, b = (combo >> 2) & 3, h = combo & 3;
        if ((combo >> 4) == 0) prescan_combo<64, false>(F, l, b, h, F.bid >> 5, F.nb >> 5); else prescan_combo<128, true>(F, l, b, h, F.bid >> 5, F.nb >> 5);
    } else {
        for (int combo = F.bid; combo < 32; combo += F.nb) { const int b = (combo >> 2) & 3, h = combo & 3;
            if ((combo >> 4) == 0) prescan_combo<64, false>(F, l, b, h, 0, 1); else prescan_combo<128, true>(F, l, b, h, 0, 1); }
    }
}

template <int DK, bool HG>
__device__ __forceinline__ void scan_mfma(Frame& F, int l, int b, int h, int z, int vh, unsigned char* lds) {
    constexpr int NDP = DK / 2, NTG = NTHR / NDP, TPT = 64 / NTG, QS = DK + 8, TS = 72, NDT = DK / 16, PPR = DK / 8, NQP = (64 * PPR) / NTHR;
    bf16_t* QD = (bf16_t*)lds; bf16_t* KD = QD + 64 * QS; bf16_t* KDT = KD + 64 * QS; bf16_t* VTs = KDT + DK * TS; bf16_t* AM = VTs + 64 * TS; bf16_t* ST = AM + 64 * TS;
    float* E1s = (float*)(ST + 64 * QS); float* E2s = E1s + DK;
    REFRESH(F);
    const int tid = F.tid, lane = F.lane, w = F.wave, n = lane & 15, g = lane >> 4;
    const int dp = tid % NDP, tg = tid / NDP, vp = tid & 31, vg = tid >> 5;
    const int vt = w & 3, wh = w >> 2;
    const char* p1b = (const char*)F.P1();
    const char* qb; const char* kb; unsigned qstr, kstr, qoff, koff;
    if (HG) { kb = p1b; kstr = NP1 * 2; koff = (unsigned)((PC_DF + z * 512 + h * 128) * 2);
        if (z == 0) { qb = p1b; qstr = NP1 * 2; qoff = (unsigned)((PC_DQ + h * 128) * 2); } else { qb = (const char*)F.BR(); qstr = 4096u; qoff = (unsigned)((1536 + h * 128) * 2); } }
    else if (z == 0) { qb = p1b; kb = p1b; qstr = kstr = NP1 * 2; qoff = (unsigned)((PC_AQ + h * 64) * 2); koff = (unsigned)((PC_AK + h * 64) * 2); }
    else { qb = (const char*)F.SC1(); kb = qb; qstr = kstr = 1024u; qoff = (unsigned)(h * 64 * 2); koff = (unsigned)((256 + h * 64) * 2); }
    const float* eb = F.ESC() + (HG ? 32 * 68 * 128 : 0) + (size_t)(((b * 4 + h) * 2 + z) * 68) * (2 * DK);
    f32x4 accS[NDT / 2];
#pragma unroll
    for (int i = 0; i < NDT / 2; ++i) accS[i] = (f32x4){0.f, 0.f, 0.f, 0.f};
    u32x4 rqp[NQP]; unsigned rk[TPT], rv[4]; float re = 0.f;
    const int vcol = (HG ? PC_DI : PC_AV) + h * 128 + 64 * vh + 2 * vp;
    const int sgn = z ? -1 : 1; const int rstep = sgn * NP1 * 2;
#define SCAN_LOAD(c) do { const int row0_ = seq_row((c) * 64, b, z); \
        _Pragma("unroll") for (int j = 0; j < NQP; ++j) { const int pi_ = tid + NTHR * j; rqp[j] = *(const u32x4*)(qb + ((unsigned)(row0_ + sgn * (pi_ / PPR)) * qstr + qoff + (unsigned)((pi_ % PPR) * 16))); } \
        _Pragma("unroll") for (int tt = 0; tt < TPT; ++tt) rk[tt] = *(const unsigned*)(kb + ((unsigned)(row0_ + sgn * (tg * TPT + tt)) * kstr + koff + (unsigned)(dp * 4))); \
        int ov_ = (row0_ + sgn * vg * 4) * (NP1 * 2) + vcol * 2; \
        _Pragma("unroll") for (int tt = 0; tt < 4; ++tt) { rv[tt] = *(const unsigned*)(p1b + (unsigned)ov_); ov_ += rstep; } \
        if (tid < 2 * DK) re = eb[(c) * (2 * DK) + tid]; } while (0)
    SCAN_LOAD(0);
    constexpr int NCH = (LC + SEQ) / 64;
#pragma unroll 1
    for (int c = 0; c < NCH; ++c) {
        __syncthreads();
#pragma unroll
        for (int j = 0; j < NQP; ++j) { const int pi_ = tid + NTHR * j; *(u32x4*)(QD + (pi_ / PPR) * QS + (pi_ % PPR) * 8) = rqp[j]; }
#pragma unroll
        for (int tt = 0; tt < TPT; ++tt) *(unsigned*)(KD + (tg * TPT + tt) * QS + 2 * dp) = rk[tt];
        {   unsigned kdt[2][TPT / 2];
#pragma unroll
            for (int t2 = 0; t2 < TPT / 2; ++t2) { kdt[0][t2] = (rk[2 * t2] & 0xffffu) | (rk[2 * t2 + 1] << 16); kdt[1][t2] = (rk[2 * t2] >> 16) | (rk[2 * t2 + 1] & 0xffff0000u); }
#pragma unroll
            for (int e = 0; e < 2; ++e) {
                bf16_t* dst = KDT + (2 * dp + e) * TS + tg * TPT;
                if (TPT == 8) { u32x4 o; o.x = kdt[e][0]; o.y = kdt[e][1]; o.z = kdt[e][TPT / 2 - 2]; o.w = kdt[e][TPT / 2 - 1]; *(u32x4*)dst = o; }
                else { u32x2 o; o.x = kdt[e][0]; o.y = kdt[e][1]; *(u32x2*)dst = o; }
            }
        }
        if (tid < 2 * DK) E1s[tid] = re;
        {   u32x2 o0, o1;
            o0.x = (rv[0] & 0xffffu) | (rv[1] << 16); o0.y = (rv[2] & 0xffffu) | (rv[3] << 16);
            o1.x = (rv[0] >> 16) | (rv[1] & 0xffff0000u); o1.y = (rv[2] >> 16) | (rv[3] & 0xffff0000u);
            *(u32x2*)(VTs + (2 * vp) * TS + vg * 4) = o0; *(u32x2*)(VTs + (2 * vp + 1) * TS + vg * 4) = o1; }
        if (c + 1 < NCH) SCAN_LOAD(c + 1);
        __syncthreads();
#pragma unroll
        for (int i = 0; i < NDT / 2; ++i) { const int dt = wh * (NDT / 2) + i; accS[i] = accS[i] * *(const f32x4*)&E1s[16 * dt + 4 * g];
            u32x2 o; o.x = pk2(accS[i].x, accS[i].y); o.y = pk2(accS[i].z, accS[i].w); *(u32x2*)(ST + (16 * vt + n) * QS + 16 * dt + 4 * g) = o; }
        {   const int it = w >> 1, jt0 = 2 * (w & 1);
            f32x4 d0 = {0.f, 0.f, 0.f, 0.f}, d1 = {0.f, 0.f, 0.f, 0.f};
            if (jt0 <= it) {
                bf16x8_t qf[DK / 32], k0f[DK / 32], k1f[DK / 32];
#pragma unroll
                for (int ks = 0; ks < DK / 32; ++ks) { qf[ks] = *(const bf16x8_t*)(QD + (16 * it + n) * QS + 32 * ks + 8 * g); k0f[ks] = *(const bf16x8_t*)(KD + (16 * jt0 + n) * QS + 32 * ks + 8 * g); k1f[ks] = *(const bf16x8_t*)(KD + (16 * (jt0 + 1) + n) * QS + 32 * ks + 8 * g); }
#pragma unroll
                for (int ks = 0; ks < DK / 32; ++ks) { d0 = __builtin_amdgcn_mfma_f32_16x16x32_bf16(k0f[ks], qf[ks], d0, 0, 0, 0); d1 = __builtin_amdgcn_mfma_f32_16x16x32_bf16(k1f[ks], qf[ks], d1, 0, 0, 0); }
                const int i = 16 * it + n, j0 = 16 * jt0 + 4 * g, j1 = j0 + 16;
                d0.x = (j0 + 0 <= i) ? d0.x : 0.f; d0.y = (j0 + 1 <= i) ? d0.y : 0.f; d0.z = (j0 + 2 <= i) ? d0.z : 0.f; d0.w = (j0 + 3 <= i) ? d0.w : 0.f;
                d1.x = (j1 + 0 <= i) ? d1.x : 0.f; d1.y = (j1 + 1 <= i) ? d1.y : 0.f; d1.z = (j1 + 2 <= i) ? d1.z : 0.f; d1.w = (j1 + 3 <= i) ? d1.w : 0.f;
            }
            u32x2 o; o.x = pk2(d0.x, d0.y); o.y = pk2(d0.z, d0.w); *(u32x2*)(AM + (16 * it + n) * TS + 16 * jt0 + 4 * g) = o;
            o.x = pk2(d1.x, d1.y); o.y = pk2(d1.z, d1.w); *(u32x2*)(AM + (16 * it + n) * TS + 16 * (jt0 + 1) + 4 * g) = o;
        }
        __syncthreads();
        {   f32x4 o[2];
#pragma unroll
            for (int ii = 0; ii < 2; ++ii) o[ii] = (f32x4){0.f, 0.f, 0.f, 0.f};
#pragma unroll
            for (int ks = 0; ks < 2; ++ks) { const bf16x8_t af = *(const bf16x8_t*)(VTs + (16 * vt + n) * TS + 32 * ks + 8 * g); bf16x8_t bf[2];
#pragma unroll
                for (int ii = 0; ii < 2; ++ii) bf[ii] = *(const bf16x8_t*)(AM + (16 * (2 * wh + ii) + n) * TS + 32 * ks + 8 * g);
#pragma unroll
                for (int ii = 0; ii < 2; ++ii) o[ii] = __builtin_amdgcn_mfma_f32_16x16x32_bf16(af, bf[ii], o[ii], 0, 0, 0); }
#pragma unroll
            for (int ks = 0; ks < DK / 32; ++ks) { const bf16x8_t af = *(const bf16x8_t*)(ST + (16 * vt + n) * QS + 32 * ks + 8 * g); bf16x8_t bf[2];
#pragma unroll
                for (int ii = 0; ii < 2; ++ii) bf[ii] = *(const bf16x8_t*)(QD + (16 * (2 * wh + ii) + n) * QS + 32 * ks + 8 * g);
#pragma unroll
                for (int ii = 0; ii < 2; ++ii) o[ii] = __builtin_amdgcn_mfma_f32_16x16x32_bf16(af, bf[ii], o[ii], 0, 0, 0); }
            const int row0 = seq_row(c * 64, b, z) + sgn * (32 * wh + n), vc = h * 128 + 64 * vh + 16 * vt + 4 * g;
            char* dstb; unsigned doff; int dstride;
            if (HG) { dstb = (char*)F.ODH(); doff = (unsigned)row0 * 2048u + (unsigned)(z * 512 + vc) * 2u; dstride = sgn * 16 * 2048; }
            else if (z == 0) { dstb = (char*)F.BR(); doff = (unsigned)row0 * 4096u + (unsigned)vc * 2u; dstride = sgn * 16 * 4096; }
            else { dstb = (char*)F.OBA(); doff = (unsigned)row0 * 1024u + (unsigned)vc * 2u; dstride = sgn * 16 * 1024; }
#pragma unroll
            for (int ii = 0; ii < 2; ++ii) { u32x2 o2; o2.x = pk2(o[ii].x, o[ii].y); o2.y = pk2(o[ii].z, o[ii].w); *(u32x2*)(dstb + (unsigned)((int)doff + ii * dstride)) = o2; }
        }
#pragma unroll
        for (int ks = 0; ks < 2; ++ks) { const bf16x8_t bv = *(const bf16x8_t*)(VTs + (16 * vt + n) * TS + 32 * ks + 8 * g); bf16x8_t af[NDT / 2];
#pragma unroll
            for (int i = 0; i < NDT / 2; ++i) af[i] = *(const bf16x8_t*)(KDT + (16 * (wh * (NDT / 2) + i) + n) * TS + 32 * ks + 8 * g);
#pragma unroll
            for (int i = 0; i < NDT / 2; ++i) accS[i] = __builtin_amdgcn_mfma_f32_16x16x32_bf16(af[i], bv, accS[i], 0, 0, 0); }
#pragma unroll
        for (int i = 0; i < NDT / 2; ++i) accS[i] = accS[i] * *(const f32x4*)&E2s[16 * (wh * (NDT / 2) + i) + 4 * g];
    }
    __syncthreads();
#undef SCAN_LOAD
}

__device__ __forceinline__ void phase_mix(Frame& F, int l) {
    const int n_scan = 128;
    const int nsb = (F.nb > 192) ? 128 : 0;
    if (nsb == 0 || F.bid < nsb) {
        for (int it = F.bid; it < n_scan; it += (nsb ? nsb : F.nb)) {
            const int br = it >> 6, r = (it >> 1) & 31, vh = it & 1, b = r >> 3, h = (r >> 1) & 3, z = r & 1;
            if (br == 0) scan_mfma<64, false>(F, l, b, h, z, vh, (unsigned char*)F.smf); else scan_mfma<128, true>(F, l, b, h, z, vh, (unsigned char*)F.smf);
        }
        __syncthreads();
    }
    float* rpb_s = F.smf;
    {   float tv[(8 * 15 * 64) / NTHR];
#pragma unroll
        for (int k = 0; k < (8 * 15 * 64) / NTHR; ++k) { const int i = F.tid + k * NTHR, dcp = i & 63, hr = i >> 6; tv[k] = (dcp >= 16 && dcp < 47) ? F.p.na_rpb[l * 8 * 465 + hr * 31 + (dcp - 16)] : 0.f; }
#pragma unroll
        for (int k = 0; k < (8 * 15 * 64) / NTHR; ++k) rpb_s[F.tid + k * NTHR] = tv[k] * 1.44269504089f; }
    bf16_t* sbuf = (bf16_t*)(F.smf + 8 * 15 * 64);
    unsigned* qhead = F.cnt() + 64 + l * 16;
    int* cur = (int*)((unsigned char*)F.smf - LDS_STAGE + 32);
    const int n_wa = 512, n_na = 512, n_cna = (l == 0) ? 32 : 0, n_cwa = (l == 0) ? 32 : 0, total = n_wa + n_na + n_cna + n_cwa;
    int nxt = 0;
    if (F.tid == 0) nxt = (int)atomicAdd(qhead, 1u);
    for (;;) {
        __syncthreads();
        if (F.tid == 0) *cur = nxt;
        __syncthreads();
        const int it = *cur;
        if (it >= total) break;
        if (F.tid == 0) nxt = (int)atomicAdd(qhead, 1u);
        if (it < n_wa) attn_block<1>(F, l, it, rpb_s, sbuf);
        else if (it < n_wa + n_na) attn_block<0>(F, l, it - n_wa, rpb_s, sbuf);
        else if (it < n_wa + n_na + n_cna) attn_block<2>(F, l, it - n_wa - n_na, rpb_s, sbuf);
        else attn_block<3>(F, l, it - n_wa - n_na - n_cna, rpb_s, sbuf);
    }
}

__device__ __forceinline__ void phase_prepad(Frame& F, int l) {
    const int gw = F.bid * 8 + F.wave, ngw = F.nb * 8, npairs = ((l == 0) ? NROW : NTOK) / 2, c0 = F.lane * 8;
    for (int pi = gw; pi < npairs; pi += ngw) {
        u32x4 ra[2][2], rb[2][2], rg[2][2];
#pragma unroll
        for (int q = 0; q < 2; ++q) { const size_t row = (size_t)pi * 2 + q;
            ra[q][0] = *(const u32x4*)(F.BR() + row * 2048 + c0); rb[q][0] = *(const u32x4*)(F.OBA() + row * 512 + c0); rg[q][0] = *(const u32x4*)(F.P1() + row * NP1 + PC_AG + c0);
            ra[q][1] = *(const u32x4*)(F.ODH() + row * 1024 + c0); rb[q][1] = *(const u32x4*)(F.ODH() + row * 1024 + 512 + c0); rg[q][1] = *(const u32x4*)(F.P1() + row * NP1 + PC_DG + c0); }
#pragma unroll
        for (int q = 0; q < 2; ++q)
#pragma unroll
            for (int br = 0; br < 2; ++br) {
                const unsigned ua[4] = {ra[q][br].x, ra[q][br].y, ra[q][br].z, ra[q][br].w}, ub[4] = {rb[q][br].x, rb[q][br].y, rb[q][br].z, rb[q][br].w}, ug[4] = {rg[q][br].x, rg[q][br].y, rg[q][br].z, rg[q][br].w};
                float o[8], g[8]; float ss = 0.f;
#pragma unroll
                for (int j = 0; j < 4; ++j) { o[2 * j] = __uint_as_float(ua[j] << 16) + __uint_as_float(ub[j] << 16); o[2 * j + 1] = __uint_as_float(ua[j] & 0xffff0000u) + __uint_as_float(ub[j] & 0xffff0000u);
                    g[2 * j] = __uint_as_float(ug[j] << 16); g[2 * j + 1] = __uint_as_float(ug[j] & 0xffff0000u); ss += o[2 * j] * o[2 * j] + o[2 * j + 1] * o[2 * j + 1]; }
                ss += __shfl_xor(ss, 1); ss += __shfl_xor(ss, 2); ss += __shfl_xor(ss, 4); ss += __shfl_xor(ss, 8);
                const float rs = rsqrtf(ss * (1.f / 128.f) + 1e-6f);
#pragma unroll
                for (int j = 0; j < 8; ++j) o[j] = o[j] * rs * siluf_(g[j]);
                st8(F.BR() + ((size_t)pi * 2 + q) * 2048 + (br ? 1536 : 0) + c0, o);
            }
    }
}

__device__ __forceinline__ void phase_ln1(Frame& F, int l) {
    const int nrows = (l == 0) ? NROW : NTOK, ngroups = nrows / 64;
    const float* lg = F.p.ln_g + (size_t)(l * 2 + 0) * DM; const float* lbb = F.p.ln_b + (size_t)(l * 2 + 0) * DM;
    float* part = F.smf;
    const int wv = __builtin_amdgcn_readfirstlane(F.wave);
    float* stg = F.smf + 8 * 36 * 64 + wv * (64 * 17 + 16 * 40);
    float* wl = stg + 64 * 17;
    for (int grp = F.bid; grp < ngroups; grp += F.nb) {
        const int row0 = grp * 64, rb = row_batch(row0);
        const float* mv = F.modv() + ((size_t)l * 5 + rb) * 6144;
        float* xg = row0 < NTOK ? F.p.out + (size_t)row0 * DM : F.cxm() + (size_t)(row0 - NTOK) * DM;
#pragma unroll 1
        for (int rr = 0; rr < 8; rr += 2) {
            const int lr = wv * 8 + rr; float* xr = xg + (size_t)lr * DM;
            f32x4 v[2][4]; float s[2] = {0.f, 0.f};
#pragma unroll
            for (int q = 0; q < 2; ++q)
#pragma unroll
                for (int j = 0; j < 4; ++j) v[q][j] = *(const f32x4*)(xr + (size_t)q * DM + j * 256 + F.lane * 4);
#pragma unroll
            for (int q = 0; q < 2; ++q)
#pragma unroll
                for (int j = 0; j < 4; ++j) s[q] += (v[q][j].x + v[q][j].y) + (v[q][j].z + v[q][j].w);
#pragma unroll
            for (int o = 1; o < 64; o <<= 1) { s[0] += __shfl_xor(s[0], o); s[1] += __shfl_xor(s[1], o); }
            float s2[2] = {0.f, 0.f};
#pragma unroll
            for (int q = 0; q < 2; ++q) { const float mean = s[q] * (1.f / DM);
#pragma unroll
                for (int j = 0; j < 4; ++j) { v[q][j] = v[q][j] - mean; s2[q] += (v[q][j].x * v[q][j].x + v[q][j].y * v[q][j].y) + (v[q][j].z * v[q][j].z + v[q][j].w * v[q][j].w); } }
#pragma unroll
            for (int o = 1; o < 64; o <<= 1) { s2[0] += __shfl_xor(s2[0], o); s2[1] += __shfl_xor(s2[1], o); }
#pragma unroll
            for (int j = 0; j < 4; ++j) { const int d = j * 256 + F.lane * 4;
                const f32x4 g4 = *(const f32x4*)(lg + d), b4 = *(const f32x4*)(lbb + d), m3 = *(const f32x4*)(mv + 3 * 1024 + d), m4 = *(const f32x4*)(mv + 4 * 1024 + d);
#pragma unroll
                for (int q = 0; q < 2; ++q) { const float rstd = rsqrtf(s2[q] * (1.f / DM) + LN_EPS);
                    const f32x4 xn = v[q][j] * rstd * g4 + b4;
                    *(f32x4*)(xr + (size_t)q * DM + d) = xn;
                    const f32x4 h2 = xn * (1.f + m4) + m3;
                    u32x2 o2; o2.x = pk2(h2.x, h2.y); o2.y = pk2(h2.z, h2.w);
                    *(u32x2*)(F.HX2() + (size_t)(row0 + lr + q) * DM + d) = o2; } }
        }
        __syncthreads();
        {   f32x4 acc[4][3];
#pragma unroll
            for (int mt = 0; mt < 4; ++mt)
#pragma unroll
                for (int nt = 0; nt < 3; ++nt) acc[mt][nt] = (f32x4){0.f, 0.f, 0.f, 0.f};
            const float* wgp = F.p.moe_w_group + ((size_t)l * DM + wv * 128) * 4; const float* wep = F.p.moe_w_expert + ((size_t)l * DM + wv * 128) * 32;
            const float* m3p = mv + 3 * 1024 + wv * 128; const float* m4p = mv + 4 * 1024 + wv * 128;
            const int ln = F.lane & 15, lk = F.lane >> 4;
#pragma unroll 1
            for (int dc = 0; dc < 128; dc += 16) {
                f32x4 t[4]; float bw[4][3];
#pragma unroll
                for (int i = 0; i < 4; ++i) t[i] = *(const f32x4*)(xg + (size_t)(16 * i + (F.lane >> 2)) * DM + wv * 128 + dc + (F.lane & 3) * 4);
                const f32x4 m3v = *(const f32x4*)(m3p + dc + (F.lane & 3) * 4), m4v = *(const f32x4*)(m4p + dc + (F.lane & 3) * 4);
#pragma unroll
                for (int ks = 0; ks < 4; ++ks) { const int d = dc + 4 * ks + lk; bw[ks][0] = wep[(size_t)d * 32 + ln]; bw[ks][1] = wep[(size_t)d * 32 + 16 + ln]; bw[ks][2] = (ln < 4) ? wgp[(size_t)d * 4 + ln] : 0.f; }
#pragma unroll
                for (int i = 0; i < 4; ++i) { float* sp = stg + (16 * i + (F.lane >> 2)) * 17 + (F.lane & 3) * 4;
                    sp[0] = t[i].x * (1.f + m4v.x) + m3v.x; sp[1] = t[i].y * (1.f + m4v.y) + m3v.y; sp[2] = t[i].z * (1.f + m4v.z) + m3v.z; sp[3] = t[i].w * (1.f + m4v.w) + m3v.w; }
                asm volatile("s_waitcnt lgkmcnt(0)" ::: "memory");
#pragma unroll
                for (int ks = 0; ks < 4; ++ks)
#pragma unroll
                    for (int mt = 0; mt < 4; ++mt) { const float av = stg[(16 * mt + ln) * 17 + 4 * ks + lk];
#pragma unroll
                        for (int nt = 0; nt < 3; ++nt) acc[mt][nt] = __builtin_amdgcn_mfma_f32_16x16x4f32(av, bw[ks][nt], acc[mt][nt], 0, 0, 0); }
                asm volatile("s_waitcnt lgkmcnt(0)" ::: "memory");
            }
#pragma unroll
            for (int mt = 0; mt < 4; ++mt)
#pragma unroll
                for (int nt = 0; nt < 3; ++nt) { const int oi = (nt == 2) ? ln : 4 + 16 * nt + ln;
                    if (nt < 2 || ln < 4) {
#pragma unroll
                        for (int r = 0; r < 4; ++r) part[(wv * 36 + oi) * 64 + 16 * mt + 4 * lk + r] = acc[mt][nt][r]; } }
        }
        __syncthreads();
        if (wv == 0) {
            const int row = row0 + F.lane;
            float gl[4]; int gi = 0; float gm = -3.4e38f;
#pragma unroll
            for (int o = 0; o < 4; ++o) { float t = F.p.moe_b_group[l * 4 + o];
#pragma unroll
                for (int w2 = 0; w2 < 8; ++w2) t += part[(w2 * 36 + o) * 64 + F.lane];
                gl[o] = t; if (t > gm) { gm = t; gi = o; } }
            float gs = 0.f;
#pragma unroll
            for (int o = 0; o < 4; ++o) gs += expf(gl[o] - gm);
            const float gwt = 1.f / gs;
            float e1 = -3.4e38f, e2 = -3.4e38f; int i1 = 0, i2 = 0;
#pragma unroll
            for (int o8 = 0; o8 < 8; ++o8) { const int o = gi * 8 + o8; float ev = F.p.moe_b_expert[l * 32 + o];
#pragma unroll
                for (int w2 = 0; w2 < 8; ++w2) ev += part[(w2 * 36 + 4 + o) * 64 + F.lane];
                if (ev > e1) { e2 = e1; i2 = i1; e1 = ev; i1 = o; } else if (ev > e2) { e2 = ev; i2 = o; } }
            const float w1 = 1.f / (1.f + expf(e2 - e1)), w2v = 1.f - w1;
            unsigned* lh = (unsigned*)(stg + 64 * 17 + 16 * 40 - 64);
            if (F.lane < 32) lh[F.lane] = 0u;
            asm volatile("s_waitcnt lgkmcnt(0)" ::: "memory");
            const unsigned r1 = atomicAdd(&lh[i1], 1u), r2 = atomicAdd(&lh[i2], 1u);
            asm volatile("s_waitcnt lgkmcnt(0)" ::: "memory");
            if (F.lane < 32) { const unsigned c = lh[F.lane]; lh[32 + F.lane] = c ? atomicAdd(&F.cnt()[l * 32 + F.lane], c) : 0u; }
            asm volatile("s_waitcnt vmcnt(0) lgkmcnt(0)" ::: "memory");
            const unsigned p1 = lh[32 + i1] + r1, p2 = lh[32 + i2] + r2;
            F.tokE()[row * 2] = i1; F.tokI()[row * 2] = (int)p1; F.tokW()[row * 2] = gwt * w1;
            F.tokE()[row * 2 + 1] = i2; F.tokI()[row * 2 + 1] = (int)p2; F.tokW()[row * 2 + 1] = gwt * w2v;
        }
        __syncthreads();
    }
}

__device__ __forceinline__ void phase_gather(Frame& F, int l) {
    int* off = (int*)F.smf; moe_offsets(F, l, off);
    const int gw = F.bid * 8 + F.wave, ngw = F.nb * 8, nrows = (l == 0) ? NROW : NTOK;
    for (int s0 = gw; s0 < 2 * nrows; s0 += 4 * ngw) {
        int sl[4], e[4], ti[4]; float tw[4]; u32x4 a0[4], a1[4];
#pragma unroll
        for (int q = 0; q < 4; ++q) { sl[q] = min(s0 + q * ngw, 2 * nrows - 1); e[q] = F.tokE()[sl[q]]; ti[q] = F.tokI()[sl[q]]; tw[q] = F.tokW()[sl[q]];
            const u32x4* src = (const u32x4*)(F.HX2() + (size_t)(sl[q] >> 1) * DM); a0[q] = src[F.lane]; a1[q] = src[F.lane + 64]; }
#pragma unroll
        for (int q = 0; q < 4; ++q) if (s0 + q * ngw < 2 * nrows) { const int dst = off[e[q]] + ti[q]; u32x4* d = (u32x4*)(F.XS() + (size_t)dst * DM);
            d[F.lane] = a0[q]; d[F.lane + 64] = a1[q];
            if (F.lane == 0) { F.rmap()[dst] = sl[q]; F.roww()[dst] = tw[q]; } }
    }
    for (int e = 0; e < 32; ++e) {
        const int c = (int)F.cnt()[l * 32 + e], pc = (c + 255) & ~255;
        for (int j = c + gw; j < pc; j += ngw) { const int dst = off[e] + j; u32x4* d = (u32x4*)(F.XS() + (size_t)dst * DM);
            const u32x4 z = {0u, 0u, 0u, 0u}; d[F.lane] = z; d[F.lane + 64] = z;
            if (F.lane == 0) { F.rmap()[dst] = -1; F.roww()[dst] = 0.f; } }
    }
}
__device__ __forceinline__ int expert_of_row(const int* off, int row) { int e = 0;
#pragma unroll 1
    for (int i = 1; i < 32; ++i) if (row >= off[i]) e = i;
    return e; }

__device__ __forceinline__ void phase_ln2(Frame& F, int l) {
    const int gw = F.bid * 8 + F.wave, ngw = F.nb * 8, npairs = ((l == 0) ? NROW : NTOK) / 2;
    const float* lg = F.p.ln_g + (size_t)(l * 2 + 1) * DM; const float* lbb = F.p.ln_b + (size_t)(l * 2 + 1) * DM;
    const bf16_t* Y = F.BR();
    const bool tmo_set = (l == DEPTH - 1) && (__hip_atomic_load((unsigned*)(F.ws + WS_CTL) + XB_TMO, __ATOMIC_RELAXED, __HIP_MEMORY_SCOPE_AGENT) != 0u);
    for (int pi = gw; pi < npairs; pi += ngw) {
        const int row0 = pi * 2, rb = row_batch(row0);
        const float* xm = row0 < NTOK ? F.p.out + (size_t)row0 * DM : F.cxm() + (size_t)(row0 - NTOK) * DM;
        float* xo = row0 < NTOK ? F.p.out + (size_t)row0 * DM : F.cxo() + (size_t)(row0 - NTOK) * DM;
        const float* mv = F.modv() + ((size_t)l * 5 + rb) * 6144;
        u32x2 y0[2][4], y1[2][4]; f32x4 xv[2][4], m5[4];
#pragma unroll
        for (int j = 0; j < 4; ++j) { const int d = j * 256 + F.lane * 4; m5[j] = *(const f32x4*)(mv + 5 * 1024 + d);
#pragma unroll
            for (int q = 0; q < 2; ++q) { y0[q][j] = *(const u32x2*)(Y + (size_t)((row0 + q) * 2) * DM + d); y1[q][j] = *(const u32x2*)(Y + (size_t)((row0 + q) * 2 + 1) * DM + d); xv[q][j] = *(const f32x4*)(xm + (size_t)q * DM + d); } }
        f32x4 v[2][4]; float s[2] = {0.f, 0.f};
#pragma unroll
        for (int q = 0; q < 2; ++q)
#pragma unroll
            for (int j = 0; j < 4; ++j) { f32x4 y; y.x = __uint_as_float(y0[q][j].x << 16) + __uint_as_float(y1[q][j].x << 16); y.y = __uint_as_float(y0[q][j].x & 0xffff0000u) + __uint_as_float(y1[q][j].x & 0xffff0000u);
                y.z = __uint_as_float(y0[q][j].y << 16) + __uint_as_float(y1[q][j].y << 16); y.w = __uint_as_float(y0[q][j].y & 0xffff0000u) + __uint_as_float(y1[q][j].y & 0xffff0000u);
                v[q][j] = ALPHA * xv[q][j] + m5[j] * y; s[q] += (v[q][j].x + v[q][j].y) + (v[q][j].z + v[q][j].w); }
#pragma unroll
        for (int o = 1; o < 64; o <<= 1) { s[0] += __shfl_xor(s[0], o); s[1] += __shfl_xor(s[1], o); }
        float s2[2] = {0.f, 0.f};
#pragma unroll
        for (int q = 0; q < 2; ++q) { const float mean = s[q] * (1.f / DM);
#pragma unroll
            for (int j = 0; j < 4; ++j) { v[q][j] = v[q][j] - mean; s2[q] += (v[q][j].x * v[q][j].x + v[q][j].y * v[q][j].y) + (v[q][j].z * v[q][j].z + v[q][j].w * v[q][j].w); } }
#pragma unroll
        for (int o = 1; o < 64; o <<= 1) { s2[0] += __shfl_xor(s2[0], o); s2[1] += __shfl_xor(s2[1], o); }
        const float* mn = F.modv() + ((size_t)((l + 1 < DEPTH) ? l + 1 : l) * 5 + rb) * 6144;
#pragma unroll
        for (int j = 0; j < 4; ++j) { const int d = j * 256 + F.lane * 4;
            const f32x4 g4 = *(const f32x4*)(lg + d), b4 = *(const f32x4*)(lbb + d), m0 = *(const f32x4*)(mn + d), m1 = *(const f32x4*)(mn + 1024 + d);
#pragma unroll
            for (int q = 0; q < 2; ++q) { const float rstd = rsqrtf(s2[q] * (1.f / DM) + LN_EPS);
                f32x4 xn = v[q][j] * rstd * g4 + b4;
                if (tmo_set) xn = xn * __uint_as_float(0x7fc00000u);
                *(f32x4*)(xo + (size_t)q * DM + d) = xn;
                if (l + 1 < DEPTH) { const f32x4 h = xn * (1.f + m1) + m0; u32x2 o2; o2.x = pk2(h.x, h.y); o2.y = pk2(h.z, h.w); *(u32x2*)(F.HX() + (size_t)(row0 + q) * DM + d) = o2; } }
        }
    }
}

constexpr int NPL = 13, NPH = 1 + DEPTH * NPL;
__global__ void __launch_bounds__(NTHR, 2) mega(Params p) {
    extern __shared__ __attribute__((aligned(16))) unsigned char smem[];
    Frame F; F.p = p; F.bid = blockIdx.x; F.nb = gridDim.x; F.tid = threadIdx.x; F.lane = threadIdx.x & 63; F.wave = threadIdx.x >> 6; F.wid_s = __builtin_amdgcn_readfirstlane(threadIdx.x >> 6);
    F.smf = (float*)(smem + LDS_STAGE);
    LAS unsigned char* stage = (LAS unsigned char*)smem + LDS_STAGE; int* offt = (int*)(smem + 64);
    unsigned char* ws = p.ws; F.ws = ws;

    if (threadIdx.x == 0) *(uint4*)smem = make_uint4(0u, 0u, 0u, 0u);
    __syncthreads();
    unsigned* barw = (unsigned*)(ws + WS_CTL);
    XcdBarrier bar; bar.bar = barw; bar.x = 0; bar.st = (volatile LAS unsigned*)smem;
    const bool multi = (p.ph_hi - p.ph_lo) > 1;
    if (multi) bar = xcd_barrier_post(barw, (volatile LAS unsigned*)smem);
    const int lo = p.ph_lo, hi = p.ph_hi;
#define IN(k) (lo <= (k) && (k) < hi)
#define SEAM(k) do { if (IN(k) && IN((k) + 1)) xcd_barrier(bar); else __syncthreads(); } while (0)

    if (IN(0)) { REFRESH(F); phase_mod(F); __syncthreads(); phase_conv_a(F, 0, F.bid * 8 + F.wave, F.nb * 8); }
    SEAM(0);
#pragma unroll 1
    for (int l = 0; l < DEPTH; ++l) {
        const int pb = 1 + l * NPL;
        const float* xlat = (l == 0) ? p.x : p.out; const float* xctx = (l == 0) ? p.ctx : F.cxo();
        const int Mrows = (l == 0) ? NROW : NTOK;
        if (l == 0) {
            if (IN(pb + 0)) { REFRESH(F); phase_prep(F, 0, p.x, p.ctx); }
            SEAM(pb + 0);
        }
        if (IN(pb + 1)) { REFRESH(F);
            float* rtab = (float*)(smem + LDS_ROPE);
            for (int e = F.tid; e < 1024; e += NTHR) { const int pp = e >> 4, i = e & 15; const float inv = powf(10000.f, -(float)i / 16.f), ang = (float)pp * inv; rtab[2 * e] = cosf(ang); rtab[2 * e + 1] = sinf(ang); }
            __syncthreads();
            pg::SchedG1 S{(const char*)F.HX(), (const char*)F.W1t(), (const char*)F.Wvt(), F.nb, F.bid}; pg::EpiG1 E{F.P1(), F.VT(), rtab, F.lb(), l};
            pg::gemm_phase(stage, DM, DM, DM, S, E);
        }
        SEAM(pb + 1);
        if (IN(pb + 2)) { REFRESH(F); phase_prescan(F, l); }
        SEAM(pb + 2);
        if (IN(pb + 3)) { REFRESH(F); phase_mix(F, l); }
        SEAM(pb + 3);
        if (IN(pb + 4)) { REFRESH(F); phase_prepad(F, l); }
        SEAM(pb + 4);
        if (IN(pb + 5)) { REFRESH(F);
            pg::SchedStatic S{(const char*)F.HX(), (const char*)F.Wgt(), (size_t)256 * DM * 2, (size_t)256 * DM * 2, Mrows / 256, NGATE / 256, F.nb, F.bid}; pg::EpiGate E{F.G()};
            pg::gemm_phase(stage, DM, DM, DM, S, E);
            __syncthreads();
            phase_conv_b(F, l);
        }
        SEAM(pb + 5);
        if (IN(pb + 6)) { REFRESH(F);
            pg::SchedMerge S{(const char*)F.BR(), (const char*)F.Wbrt(), (Mrows / 256) * 4, F.nb, F.bid}; pg::EpiMerge E{F.G(), F.HX(), (bf16_t*)(F.ws + WS_PM)};
            pg::gemm_phase(stage, 2048, 512, 512, S, E);
            if (S.split()) {
                xcd_barrier(bar);
                REFRESH(F);
                const bf16_t* pm = (const bf16_t*)(F.ws + WS_PM); bf16_t* mo = F.HX() + (size_t)NTOK * DM;
                for (int e = (F.bid * NTHR + F.tid) * 8; e < NCTX * DM; e += F.nb * NTHR * 8) {
                    u32x4 v[4];
#pragma unroll
                    for (int br = 0; br < 4; ++br) v[br] = *(const u32x4*)(pm + (size_t)br * NCTX * DM + e);
                    float a[8] = {0.f, 0.f, 0.f, 0.f, 0.f, 0.f, 0.f, 0.f};
#pragma unroll
                    for (int br = 0; br < 4; ++br) { const unsigned uu[4] = {v[br].x, v[br].y, v[br].z, v[br].w};
#pragma unroll
                        for (int j = 0; j < 4; ++j) { a[2 * j] += __uint_as_float(uu[j] << 16); a[2 * j + 1] += __uint_as_float(uu[j] & 0xffff0000u); } }
                    u32x4 o; o.x = pk2(a[0], a[1]); o.y = pk2(a[2], a[3]); o.z = pk2(a[4], a[5]); o.w = pk2(a[6], a[7]); *(u32x4*)(mo + e) = o;
                }
            }
        }
        SEAM(pb + 6);
        if (IN(pb + 7)) { REFRESH(F);
            pg::SchedStatic S{(const char*)F.HX(), (const char*)F.Woutt(), (size_t)256 * DM * 2, (size_t)256 * DM * 2, Mrows / 256, DM / 256, F.nb, F.bid};
            pg::EpiWout E{xlat, xctx, p.out, F.cxm(), F.modv() + (size_t)l * 5 * 6144};
            pg::gemm_phase(stage, DM, DM, DM, S, E);
        }
        SEAM(pb + 7);
        if (IN(pb + 8)) { REFRESH(F); phase_ln1(F, l); }
        SEAM(pb + 8);
        if (IN(pb + 9)) { REFRESH(F); phase_gather(F, l); }
        SEAM(pb + 9);
        if (IN(pb + 10)) { REFRESH(F);
            moe_offsets(F, l, offt);
            pg::SchedMoe S{(const char*)F.XS(), (const char*)F.Wgu(), offt, (size_t)256 * DM * 2, (size_t)512 * DM * 2, (size_t)256 * DM * 2, offt[32] / 256, 2, F.nb, F.bid};
            pg::EpiMoe1 E{F.HID(), F.roww()};
            pg::gemm_phase(stage, DM, DM, DM, S, E);
            if (l + 1 < DEPTH) {
                const int nun = (offt[32] / 256) * 2, nu2 = nun > F.nb ? min(nun - F.nb, F.nb) : 0;
                REFRESH(F);
                if (2 * nu2 <= F.nb) { if (F.bid >= nu2) phase_conv_a(F, l + 1, (F.bid - nu2) * 8 + F.wave, (F.nb - nu2) * 8); }
                else phase_conv_a(F, l + 1, F.bid * 8 + F.wave, F.nb * 8);
            }
        }
        SEAM(pb + 10);
        if (IN(pb + 11)) { REFRESH(F);
            moe_offsets(F, l, offt);
            pg::SchedMoe S{(const char*)F.HID(), (const char*)F.Wd(), offt, (size_t)256 * 256 * 2, (size_t)DM * 256 * 2, (size_t)256 * 256 * 2, offt[32] / 256, 4, F.nb, F.bid};
            pg::EpiMoe2 E{F.BR(), F.rmap(), (bf16_t*)(F.ws + WS_DUMP)};
            pg::gemm_phase(stage, 256, 256, 256, S, E);
        }
        SEAM(pb + 11);
        if (IN(pb + 12)) { REFRESH(F); phase_ln2(F, l); }
        SEAM(pb + 12);
    }
#undef IN
#undef SEAM
}

extern "C" void kernel_launch(void* const* d_in, const int* in_sizes, int n_in, void* d_out, int out_size, void* d_ws, size_t ws_size, hipStream_t stream) {
    static int grid = 0;
    if (grid == 0) {
        if (n_in != 23 || out_size != NTOK * DM || ws_size < WS_END) { fprintf(stderr, "kernel_launch: unexpected shapes (n_in %d out %d ws %zu need %zu)\n", n_in, out_size, ws_size, (size_t)WS_END); grid = -1; return; }
        int dev = 0, cus = 0;
        if (hipGetDevice(&dev) != hipSuccess || hipDeviceGetAttribute(&cus, hipDeviceAttributeMultiprocessorCount, dev) != hipSuccess) { grid = -1; return; }
        if (hipFuncSetAttribute((const void*)mega, hipFuncAttributeMaxDynamicSharedMemorySize, LDS_BYTES) != hipSuccess) { fprintf(stderr, "kernel_launch: hipFuncSetAttribute failed\n"); grid = -1; return; }
        int per_cu = 0;
        if (hipOccupancyMaxActiveBlocksPerMultiprocessor(&per_cu, (const void*)mega, NTHR, LDS_BYTES) != hipSuccess || per_cu < 1) fprintf(stderr, "kernel_launch: occupancy query reports %d blocks per CU\n", per_cu);
        (void)hipGetLastError();
        grid = cus >= 32 ? (cus & ~31) : cus;
    }
    if (grid < 0) return;
    (void)hipMemsetAsync((char*)d_ws + WS_CTL, 0, CTL_BYTES, stream);
    Params p; memset(&p, 0, sizeof(p));
    const float** pp = (const float**)&p;
    for (int i = 0; i < 23; ++i) pp[i] = (const float*)d_in[i];
    p.out = (float*)d_out; p.ws = (unsigned char*)d_ws;
    p.ph_lo = 0; p.ph_hi = NPH;
    hipLaunchKernelGGL(mega, dim3(grid), dim3(NTHR), LDS_BYTES, stream, p);
}
```

```cpp
#include <hip/hip_runtime.h>
#include <cstdio>
#include <cstdint>
#include <cstring>

typedef unsigned short bf16_t;
typedef float f32x4 __attribute__((ext_vector_type(4)));
typedef unsigned u32x4 __attribute__((ext_vector_type(4)));
typedef unsigned u32x2 __attribute__((ext_vector_type(2)));

constexpr int NB = 4, SEQ = 4096, LC = 256, DM = 1024, DEPTH = 2;
constexpr int NTOK = NB * SEQ, NCTX = NB * LC, NROW = NTOK + NCTX;
constexpr int DIN = 10528;
constexpr int O_AQ = 0, O_AK = 256, O_AV = 512, O_AG = 1024, O_ALR = 1536, O_BQ = 1568, O_BK = 2080, O_BV = 2592, O_CQ = 3104, O_CK = 3616,
              O_CV = 3744, O_DQ = 3872, O_DF = 4384, O_DI = 5408, O_DG = 5920, O_GATE = 6432;
constexpr int PC_AQ = 0, PC_AK = 256, PC_AV = 512, PC_BQ = 1024, PC_BK = 1536, PC_CQ = 2048, PC_CK = 2560, PC_ALR = 2688, PC_DQ = 2816,
              PC_DF = 3328, PC_DI = 4352, PC_AG = 4864, PC_DG = 5376, NP1 = 5888;
constexpr float QSCALE = 0.125f * 1.44269504089f;
constexpr int NVT = 768;
constexpr int NGATE = 4096;
constexpr int XS_ROWS = 43008;
constexpr float LN_EPS = 1e-5f;
constexpr float ALPHA = 1.41421356237f;

constexpr size_t al256(size_t x) { return (x + 255) & ~(size_t)255; }
constexpr size_t WS_CTL = 0;
constexpr size_t CTL_BYTES = 32768;
constexpr size_t CTL_CNT = 28672;
constexpr size_t WS_DUMP = WS_CTL + CTL_BYTES;
constexpr size_t WS_MODV = WS_DUMP + 4096;
constexpr size_t WS_LB = WS_MODV + al256((size_t)DEPTH * 5 * 6144 * 4);
constexpr size_t WS_TOKE = WS_LB + 4096;
constexpr size_t WS_TOKI = WS_TOKE + al256((size_t)2 * NROW * 4);
constexpr size_t WS_TOKW = WS_TOKI + al256((size_t)2 * NROW * 4);
constexpr size_t WS_RMAP = WS_TOKW + al256((size_t)2 * NROW * 4);
constexpr size_t WS_ROWW = WS_RMAP + al256((size_t)XS_ROWS * 4);
constexpr size_t WS_CXM = WS_ROWW + al256((size_t)XS_ROWS * 4);
constexpr size_t WS_CXO = WS_CXM + (size_t)NCTX * DM * 4;
constexpr size_t WS_WTA = WS_CXO + (size_t)NCTX * DM * 4;
constexpr size_t WTA_W1 = 0;
constexpr size_t WTA_WV = WTA_W1 + (size_t)NP1 * DM * 2;
constexpr size_t WTA_WBR = WTA_WV + (size_t)NVT * DM * 2;
constexpr size_t WTA_WO = WTA_WBR + (size_t)4 * DM * 512 * 2;
constexpr size_t WTA_WG = WTA_WO + (size_t)DM * DM * 2;
constexpr size_t WTA_BYTES = WTA_WG + (size_t)NGATE * DM * 2;
constexpr size_t WS_SC1 = WS_WTA;
static_assert((size_t)NROW * 512 * 2 <= WTA_WG, "scan scratch must fit in front of the gate weights");
constexpr size_t WS_HX = WS_WTA + WTA_BYTES;
constexpr size_t WS_VT = WS_HX + (size_t)NROW * DM * 2;
constexpr size_t WS_OBA = WS_VT + (size_t)NVT * NROW * 2;
constexpr size_t WS_HX2 = WS_VT;
constexpr size_t WS_HID = WS_VT;
constexpr size_t WS_ODH = WS_OBA + (size_t)NROW * 512 * 2;
constexpr size_t WS_BR = WS_ODH + (size_t)NROW * 1024 * 2;
constexpr size_t WS_P1 = WS_BR + (size_t)NROW * 2048 * 2;
constexpr size_t WS_G = WS_P1;
constexpr size_t WS_WGU = WS_P1 + (size_t)NROW * NGATE * 2;
constexpr size_t WS_WD = WS_WGU + (size_t)32 * 512 * DM * 2;
constexpr size_t WS_PM = WS_WD + (size_t)32 * DM * 256 * 2;
constexpr size_t WS_XS = WS_P1;
constexpr size_t WS_ESC = WS_P1 + (size_t)NROW * NP1 * 2;
constexpr size_t WS_END = WS_ESC + (size_t)32 * 68 * 384 * 4;
static_assert(WS_PM + (size_t)4 * NCTX * DM * 2 <= WS_ESC, "moe weights must fit in the P1 tail");
static_assert((size_t)XS_ROWS * DM * 2 <= (size_t)NROW * NGATE * 2, "XS must fit in the G region");
static_assert((size_t)NVT * NROW * 2 + (size_t)NROW * 512 * 2 >= (size_t)NROW * DM * 2, "HX2 alias");
static_assert(WS_END <= 434800000ull, "workspace budget");

constexpr int NTHR = 512;
constexpr int LDS_STAGE = 1024;
constexpr int LDS_ROPE = 1024 + 131072 + 1024;
constexpr int LDS_BYTES = 144 * 1024;

struct Params {
    const float *x, *c, *ctx, *c_ctx, *w_mod, *b_mod, *w_in, *gla_lr_w, *gla_lr_b, *hg_gamma, *na_rpb, *wa_sink, *w_branch, *w_out, *ln_g, *ln_b,
        *moe_w_group, *moe_b_group, *moe_w_expert, *moe_b_expert, *moe_w_gate, *moe_w_up, *moe_w_down;
    float* out;
    unsigned char* ws;
    int ph_lo, ph_hi;
};

__device__ __forceinline__ float bf2f(bf16_t b) { return __uint_as_float(((unsigned)b) << 16); }
__device__ __forceinline__ bf16_t f2bf(float f) { unsigned u = __float_as_uint(f); u += 0x7FFFu + ((u >> 16) & 1u); return (bf16_t)(u >> 16); }
typedef float f32x2_t __attribute__((ext_vector_type(2)));
typedef __bf16 bf16x2_t __attribute__((ext_vector_type(2)));
__device__ __forceinline__ unsigned pk2(float lo, float hi) {
    const f32x2_t v = {lo, hi}; const bf16x2_t b = __builtin_convertvector(v, bf16x2_t); return __builtin_bit_cast(unsigned, b); }
__device__ __forceinline__ void ld8(const bf16_t* p, float* f) {
    const u32x4 v = *(const u32x4*)p;
    f[0] = __uint_as_float(v.x << 16); f[1] = __uint_as_float(v.x & 0xffff0000u);
    f[2] = __uint_as_float(v.y << 16); f[3] = __uint_as_float(v.y & 0xffff0000u);
    f[4] = __uint_as_float(v.z << 16); f[5] = __uint_as_float(v.z & 0xffff0000u);
    f[6] = __uint_as_float(v.w << 16); f[7] = __uint_as_float(v.w & 0xffff0000u);
}
__device__ __forceinline__ void st8(bf16_t* p, const float* f) {
    u32x4 v; v.x = pk2(f[0], f[1]); v.y = pk2(f[2], f[3]); v.z = pk2(f[4], f[5]); v.w = pk2(f[6], f[7]);
    *(u32x4*)p = v;
}
__device__ __forceinline__ float sigmoidf_(float x) { return __builtin_amdgcn_rcpf(1.f + __expf(-x)); }
__device__ __forceinline__ float siluf_(float x) { return x * __builtin_amdgcn_rcpf(1.f + __expf(-x)); }
__device__ __forceinline__ float wave_sum(float v) {
#pragma unroll
    for (int o = 1; o < 64; o <<= 1) v += __shfl_xor(v, o);
    return v;
}
__device__ __forceinline__ int row_batch(int row) { return row < NTOK ? (row >> 12) : 4; }

#define XB_TMO      128
#define XB_XCNT(j)  (256  + 64 * (j))
#define XB_XSUB(j)  (1280 + 64 * (j))
#define XB_XGEN(j)  (2304 + 64 * (j))
#define XB_TOP      3328
#define XB_TOPGEN   3392
#define XCD_BAR_WORDS 3456
#define XB_SPIN_CAP (1u << 18)
#define LAS __attribute__((address_space(3)))
__device__ __forceinline__ unsigned xb_ld(unsigned* p)              { return __hip_atomic_load(p, __ATOMIC_RELAXED, __HIP_MEMORY_SCOPE_AGENT); }
__device__ __forceinline__ unsigned xb_add(unsigned* p, unsigned v) { return __hip_atomic_fetch_add(p, v, __ATOMIC_RELAXED, __HIP_MEMORY_SCOPE_AGENT); }
__device__ __forceinline__ unsigned xb_xcc_id() { return (unsigned)__builtin_amdgcn_s_getreg((3 << 11) | 20) & 0xFu; }
#define XB_SPIN(cond, bar) do { unsigned _sp = 0; while (cond) { __builtin_amdgcn_s_sleep(1); \
    if ((++_sp & 255u) == 0u) { if (xb_ld(&(bar)[XB_TMO])) break; if (_sp > XB_SPIN_CAP) { atomicAdd(&(bar)[XB_TMO], 1u); break; } } } } while (0)
struct XcdBarrier { unsigned* bar; unsigned x; volatile LAS unsigned* st; };
__device__ __forceinline__ XcdBarrier xcd_barrier_post(unsigned* bar, volatile LAS unsigned* st) {
    XcdBarrier b; b.bar = bar; b.x = xb_xcc_id(); b.st = st;
    if (threadIdx.x == 0) (void)xb_add(&bar[XB_XCNT(b.x)], 1u);
    return b;
}
__device__ __forceinline__ void xcd_barrier_complete(unsigned* bar, unsigned x, unsigned& nloc, unsigned& nx) {
    const unsigned G = gridDim.x * gridDim.y * gridDim.z;
    unsigned sum, cnt, mine, sp = 0u;
    for (;;) {
        sum = 0u; cnt = 0u; mine = 0u;
#pragma unroll
        for (unsigned j = 0; j < 16; ++j) { const unsigned c = xb_ld(&bar[XB_XCNT(j)]); sum += c; cnt += (c > 0u) ? 1u : 0u; mine = (j == x) ? c : mine; }
        if (sum == G) break;
        __builtin_amdgcn_s_sleep(1);
        if ((++sp & 255u) == 0u) { if (xb_ld(&bar[XB_TMO])) break; if (sp > XB_SPIN_CAP) { atomicAdd(&bar[XB_TMO], 1u); break; } }
    }
    nloc = mine > 0u ? mine : 1u; nx = cnt > 0u ? cnt : 1u;
}
__device__ __forceinline__ void xcd_barrier(const XcdBarrier& b) {
    asm volatile("s_waitcnt vmcnt(0)" ::: "memory");
    __syncthreads();
    if (threadIdx.x == 0) {
        unsigned* bar = b.bar;
        __builtin_amdgcn_s_waitcnt(0);
        unsigned nloc = b.st[0], nx = b.st[1];
        if (nloc == 0u) { xcd_barrier_complete(bar, b.x, nloc, nx); b.st[0] = nloc; b.st[1] = nx; }
        const unsigned old = xb_add(&bar[XB_XSUB(b.x)], 1u);
        const unsigned gen = old / nloc;
        if (old + 1u == (gen + 1u) * nloc) {
            __builtin_amdgcn_fence(__ATOMIC_RELEASE, "agent");
            asm volatile("s_waitcnt vmcnt(0)" ::: "memory");
            const unsigned og = xb_add(&bar[XB_TOP], 1u);
            const unsigned tg = og / nx;
            if (og + 1u == (tg + 1u) * nx) xb_add(&bar[XB_TOPGEN], 1u);
            else XB_SPIN(xb_ld(&bar[XB_TOPGEN]) == tg, bar);
            __builtin_amdgcn_fence(__ATOMIC_ACQUIRE, "agent");
            xb_add(&bar[XB_XGEN(b.x)], 1u);
            asm volatile("s_waitcnt vmcnt(0)" ::: "memory");
        } else {
            XB_SPIN(xb_ld(&bar[XB_XGEN(b.x)]) == gen, bar);
            __builtin_amdgcn_fence(__ATOMIC_ACQUIRE, "agent");
            asm volatile("s_waitcnt vmcnt(0)" ::: "memory");
        }
    }
    __syncthreads();
}

struct Frame {
    Params p;
    int bid, nb, tid, lane, wave, wid_s;
    float* smf;
    unsigned char* ws;
    __device__ __forceinline__ float* modv() const { return (float*)(ws + WS_MODV); }
    __device__ __forceinline__ float* lb() const { return (float*)(ws + WS_LB); }
    __device__ __forceinline__ int* tokE() const { return (int*)(ws + WS_TOKE); }
    __device__ __forceinline__ int* tokI() const { return (int*)(ws + WS_TOKI); }
    __device__ __forceinline__ float* tokW() const { return (float*)(ws + WS_TOKW); }
    __device__ __forceinline__ int* rmap() const { return (int*)(ws + WS_RMAP); }
    __device__ __forceinline__ float* roww() const { return (float*)(ws + WS_ROWW); }
    __device__ __forceinline__ float* cxm() const { return (float*)(ws + WS_CXM); }
    __device__ __forceinline__ float* cxo() const { return (float*)(ws + WS_CXO); }
    __device__ __forceinline__ bf16_t* W1t() const { return (bf16_t*)(ws + WS_WTA + WTA_W1); }
    __device__ __forceinline__ bf16_t* Wvt() const { return (bf16_t*)(ws + WS_WTA + WTA_WV); }
    __device__ __forceinline__ bf16_t* Wgt() const { return (bf16_t*)(ws + WS_WTA + WTA_WG); }
    __device__ __forceinline__ bf16_t* Wbrt() const { return (bf16_t*)(ws + WS_WTA + WTA_WBR); }
    __device__ __forceinline__ bf16_t* Woutt() const { return (bf16_t*)(ws + WS_WTA + WTA_WO); }
    __device__ __forceinline__ bf16_t* SC1() const { return (bf16_t*)(ws + WS_SC1); }
    __device__ __forceinline__ float* ESC() const { return (float*)(ws + WS_ESC); }
    __device__ __forceinline__ bf16_t* HX() const { return (bf16_t*)(ws + WS_HX); }
    __device__ __forceinline__ bf16_t* VT() const { return (bf16_t*)(ws + WS_VT); }
    __device__ __forceinline__ bf16_t* OBA() const { return (bf16_t*)(ws + WS_OBA); }
    __device__ __forceinline__ bf16_t* HX2() const { return (bf16_t*)(ws + WS_HX2); }
    __device__ __forceinline__ bf16_t* HID() const { return (bf16_t*)(ws + WS_HID); }
    __device__ __forceinline__ bf16_t* ODH() const { return (bf16_t*)(ws + WS_ODH); }
    __device__ __forceinline__ bf16_t* BR() const { return (bf16_t*)(ws + WS_BR); }
    __device__ __forceinline__ bf16_t* P1() const { return (bf16_t*)(ws + WS_P1); }
    __device__ __forceinline__ bf16_t* G() const { return (bf16_t*)(ws + WS_G); }
    __device__ __forceinline__ bf16_t* Wgu() const { return (bf16_t*)(ws + WS_WGU); }
    __device__ __forceinline__ bf16_t* Wd() const { return (bf16_t*)(ws + WS_WD); }
    __device__ __forceinline__ bf16_t* XS() const { return (bf16_t*)(ws + WS_XS); }
    __device__ __forceinline__ unsigned* cnt() const { return (unsigned*)(ws + WS_CTL + CTL_CNT); }
};


#define REFRESH(F) do { int _t = threadIdx.x; asm volatile("" : "+v"(_t)); (F).tid = _t; (F).lane = _t & 63; (F).wave = _t >> 6; } while (0)

__device__ __forceinline__ void phase_mod(Frame& F) {
    float* sc = F.smf;
    float* red = F.smf + 5 * 1024;
    bool have = false;
    for (int it = F.bid; it < DEPTH * 96; it += F.nb) {
        if (!have) {
            for (int i = F.tid; i < 5 * 1024; i += NTHR) { const float v = (i < 4096) ? F.p.c[i] : F.p.c_ctx[i - 4096]; sc[i] = siluf_(v); }
            __syncthreads(); have = true;
        }
        const int l = it / 96, n0 = (it % 96) * 64, col = F.tid & 63, kg = F.tid >> 6;
        const float* w = F.p.w_mod + (size_t)l * DM * 6144 + n0 + col;
        float a[5] = {0.f, 0.f, 0.f, 0.f, 0.f};
        for (int k = kg * 128; k < kg * 128 + 128; ++k) {
            const float wv = w[(size_t)k * 6144];
#pragma unroll
            for (int r = 0; r < 5; ++r) a[r] += sc[r * 1024 + k] * wv;
        }
#pragma unroll
        for (int r = 0; r < 5; ++r) red[(kg * 5 + r) * 64 + col] = a[r];
        __syncthreads();
        if (F.tid < 320) {
            const int r = F.tid >> 6, cc = F.tid & 63; float s = F.p.b_mod[l * 6144 + n0 + cc];
#pragma unroll
            for (int g = 0; g < 8; ++g) s += red[(g * 5 + r) * 64 + cc];
            F.modv()[((size_t)l * 5 + r) * 6144 + n0 + cc] = s;
        }
        __syncthreads();
    }
    if (F.bid == F.nb - 1) {
        for (int i = F.tid; i < 1024; i += NTHR) { const int z = i >> 9, f = i & 511;
            const float g0 = F.p.hg_gamma[(z * DEPTH + 0) * 512 + f], g1 = F.p.hg_gamma[(z * DEPTH + 1) * 512 + f];
            F.lb()[i] = 1.f / (1.f + expf(g0 - g1)); }
    }
}

__device__ __forceinline__ int p1_src(int n, float& scale) {
    scale = 1.f;
    if (n < 256) { scale = 0.125f; return O_AQ + n; }
    if (n < 512) return O_AK + (n - 256);
    if (n < 1024) return O_AV + (n - 512);
    if (n < 1536) { scale = QSCALE; return O_BQ + (n - 1024); }
    if (n < 2048) return O_BK + (n - 1536);
    if (n < 2560) { scale = QSCALE; return O_CQ + (n - 2048); }
    if (n < 2688) return O_CK + (n - 2560);
    if (n < 2720) return O_ALR + (n - 2688);
    if (n < 2816) return -1;
    if (n < 3328) return O_DQ + (n - 2816);
    if (n < 4352) return O_DF + (n - 3328);
    if (n < 4864) return O_DI + (n - 4352);
    if (n < 5376) return O_AG + (n - 4864);
    return O_DG + (n - 5376);
}
__device__ __forceinline__ void conv_item(const float* src, int ldsrc, int srccol, float scale, bf16_t* dst, int K, int k0, float* scr, int lane, bool perm) {
    if (srccol >= 0) {
#pragma unroll 8
        for (int i = 0; i < 32; ++i) { const int kk = 2 * i + (lane >> 5); scr[kk * 33 + (lane & 31)] = src[(size_t)(k0 + kk) * ldsrc + srccol + (lane & 31)] * scale; }
    } else {
#pragma unroll 8
        for (int i = 0; i < 32; ++i) { const int kk = 2 * i + (lane >> 5); scr[kk * 33 + (lane & 31)] = 0.f; }
    }
    asm volatile("s_waitcnt lgkmcnt(0)" ::: "memory");
    const int c = lane & 7;
#pragma unroll
    for (int j = 0; j < 4; ++j) { const int nn = (lane >> 3) + 8 * j; const float* sp = scr + (8 * c) * 33 + (perm ? (8 * ((nn & 15) >> 2) + 4 * (nn >> 4) + (nn & 3)) : nn);
        u32x4 o; o.x = pk2(sp[0 * 33], sp[1 * 33]); o.y = pk2(sp[2 * 33], sp[3 * 33]); o.z = pk2(sp[4 * 33], sp[5 * 33]); o.w = pk2(sp[6 * 33], sp[7 * 33]);
        *(u32x4*)(dst + (size_t)nn * K + 8 * c) = o; }
    asm volatile("s_waitcnt lgkmcnt(0)" ::: "memory");
}
constexpr int CONVA_W1 = (NP1 / 32) * 16;
constexpr int CONVA_ITEMS = CONVA_W1 + 384 + 2048;
__device__ __forceinline__ void phase_conv_a(Frame& F, int l, int gw, int ngw) {
    float* scr = F.smf + F.wave * (64 * 33);
    for (int it0 = gw; it0 < CONVA_ITEMS; it0 += ngw) {
        int ti = it0;
        if (ti < CONVA_W1) { const int n0 = (ti >> 4) * 32, kt = ti & 15; float sc; const int sx = p1_src(n0, sc);
            conv_item(F.p.w_in + (size_t)l * DM * DIN, DIN, sx, sc, F.W1t() + (size_t)n0 * DM + kt * 64, DM, kt * 64, scr, F.lane, !(n0 >= 2048 && n0 < 2816)); continue; }
        ti -= CONVA_W1;
        if (ti < 384) { const int n0 = (ti >> 4) * 32, kt = ti & 15; const int sx = n0 < 512 ? O_BV + n0 : (n0 < 640 ? O_CV + (n0 - 512) : -1);
            conv_item(F.p.w_in + (size_t)l * DM * DIN, DIN, sx, 1.f, F.Wvt() + (size_t)n0 * DM + kt * 64, DM, kt * 64, scr, F.lane, false); continue; }
        ti -= 384;
        { const int n0 = (ti >> 4) * 32, kt = ti & 15;
          conv_item(F.p.w_in + (size_t)l * DM * DIN, DIN, O_GATE + n0, 1.f, F.Wgt() + (size_t)n0 * DM + kt * 64, DM, kt * 64, scr, F.lane, true); }
    }
}
constexpr int CONVB_MOE = 8192 + 4096, CONVB_PROJ = 1024 + 512;
__device__ __forceinline__ void phase_conv_b(Frame& F, int l, int n_skip, int lo, int hi) {
    float* scr = F.smf + F.wave * (64 * 33);
    if (F.bid < n_skip) return;
    const int gw = (F.bid - n_skip) * 8 + F.wave, ngw = (F.nb - n_skip) * 8;
    for (int it0 = lo + gw; it0 < hi; it0 += ngw) {
        int ti = it0;
        if (ti < 8192) { const int e = ti >> 8, r = ti & 255, n0 = (r >> 4) * 32, kt = r & 15, j = n0 >> 8, rr = n0 & 255; const bool isup = rr >= 128; const int cc = 128 * j + (rr & 127);
            const float* src = (isup ? F.p.moe_w_up : F.p.moe_w_gate) + (size_t)(l * 32 + e) * DM * 256;
            conv_item(src, 256, cc, 1.f, F.Wgu() + (size_t)e * 512 * DM + (size_t)n0 * DM + kt * 64, DM, kt * 64, scr, F.lane, true); continue; }
        ti -= 8192;
        if (ti < 4096) { const int e = ti >> 7, r = ti & 127, n0 = (r >> 2) * 32, kt = r & 3;
          conv_item(F.p.moe_w_down + (size_t)(l * 32 + e) * 256 * DM, DM, n0, 1.f, F.Wd() + (size_t)e * DM * 256 + (size_t)n0 * 256 + kt * 64, 256, kt * 64, scr, F.lane, true); continue; }
        ti -= 4096;
        if (ti < 1024) { const int i = ti >> 8, r = ti & 255, n0 = (r >> 3) * 32, kt = r & 7;
            conv_item(F.p.w_branch + (size_t)(l * 4 + i) * 512 * DM, DM, n0, 1.f, F.Wbrt() + (size_t)i * DM * 512 + (size_t)n0 * 512 + kt * 64, 512, kt * 64, scr, F.lane, true); continue; }
        ti -= 1024;
        { const int n0 = (ti >> 4) * 32, kt = ti & 15;
          conv_item(F.p.w_out + (size_t)l * DM * DM, DM, n0, 1.f, F.Woutt() + (size_t)n0 * DM + kt * 64, DM, kt * 64, scr, F.lane, false); }
    }
}

__device__ __forceinline__ void phase_prep(Frame& F, int l, const float* xlat, const float* xctx) {
    const int gw = F.bid * 8 + F.wave, ngw = F.nb * 8;
    for (int row = gw; row < NROW; row += ngw) {
        const float* xr = row < NTOK ? xlat + (size_t)row * DM : xctx + (size_t)(row - NTOK) * DM;
        const float* mv = F.modv() + ((size_t)l * 5 + row_batch(row)) * 6144;
#pragma unroll
        for (int j = 0; j < 4; ++j) { const int d = j * 256 + F.lane * 4;
            const f32x4 v = *(const f32x4*)(xr + d), m0 = *(const f32x4*)(mv + d), m1 = *(const f32x4*)(mv + 1024 + d);
            u32x2 o; o.x = pk2(v.x * (1.f + m1.x) + m0.x, v.y * (1.f + m1.y) + m0.y); o.y = pk2(v.z * (1.f + m1.z) + m0.z, v.w * (1.f + m1.w) + m0.w);
            *(u32x2*)(F.HX() + (size_t)row * DM + d) = o; }
    }
}


namespace pg {
typedef short bf16x8 __attribute__((ext_vector_type(8)));
constexpr int BM = 256, BK = 64, HALF = 128, HTB = HALF * BK * 2, STAGE_BYTES = 8 * HTB, NXCD = 8, WGM = 8;
__device__ __forceinline__ int lds_byte(int r, int c) { const int st = (r >> 4) * 2 + (c >> 5), rr = r & 15, cc = c & 31, ob = rr * 64 + cc * 2; return st * 1024 + (ob ^ (((ob >> 9) & 1) << 5)); }
__device__ __forceinline__ void stage_rc(int b, int& R, int& C) { const int st = b / 1024, sb = b % 1024, swz = sb ^ (((sb >> 9) & 1) << 5); R = (st >> 1) * 16 + swz / 64; C = (st & 1) * 32 + (swz % 64) / 2; }
struct Unit { const char* a; const char* b; int pm, pn, aux; };
__device__ __forceinline__ void static_map(int L, int nM, int nN, int& pm, int& pn) {
    const int nwg = nM * nN; int wgid = L; { const int q = nwg / NXCD, r = nwg % NXCD, xcd = wgid % NXCD, off = wgid / NXCD; wgid = (xcd < r ? xcd * (q + 1) : r * (q + 1) + (xcd - r) * q) + off; }
    const int nig = WGM * nN, gid = wgid / nig, fm = gid * WGM, gsz = (nM - fm) < WGM ? (nM - fm) : WGM;
    pm = fm + ((wgid % nig) % gsz); pn = (wgid % nig) / gsz;
}
template <class Epi, class Sched>
__device__ __forceinline__ void gemm_phase(LAS unsigned char* lds, const int lda, const int ldb, const int K, const Sched& S, const Epi& E) {
    int tid = threadIdx.x; asm volatile("" : "+v"(tid));
    const int wid = __builtin_amdgcn_readfirstlane(tid >> 6), lane = tid & 63, wr = wid >> 2, wc = wid & 3, fr = lane & 15, fq = lane >> 4;
    int nt = K / BK; asm volatile("" : "+s"(nt));
    unsigned voffA[2], voffB[2];
#pragma unroll
    for (int i = 0; i < 2; ++i) { int R, C; stage_rc(tid * 16 + i * 8192, R, C); voffA[i] = (unsigned)(R * lda + C) * 2u; voffB[i] = (unsigned)(R * ldb + C) * 2u; }
    const size_t kstep = (size_t)(BK * 2);
    const size_t hstepA = (size_t)HALF * lda * 2, hstepB = (size_t)HALF * ldb * 2;
    const unsigned ldsw = (unsigned)wid * 1024u;
    const int aoff = lds_byte(wr * 64 + fr, fq * 8), boff = lds_byte(wc * 32 + fr, fq * 8);
#define PG_SA(b, h) (((b) * 2 + (h)) * HTB)
#define PG_SB(b, h) ((4 + (b) * 2 + (h)) * HTB)
#define PG_STAGE(bufoff, gbase, voff) do { _Pragma("unroll") for (int _i = 0; _i < 2; ++_i) \
        __builtin_amdgcn_global_load_lds((const unsigned*)((const char*)(gbase) + (voff)[_i]), (LAS unsigned*)(lds + (bufoff) + ldsw + _i * 8192), 16, 0, 0); } while (0)
#define PG_LDA(dst, b, h) do { _Pragma("unroll") for (int m = 0; m < 4; ++m) _Pragma("unroll") for (int k = 0; k < 2; ++k) dst[m][k] = *(const LAS bf16x8*)(lds + PG_SA(b, h) + aoff + m * 2048 + k * 1024); } while (0)
#define PG_LDB(dst, b, h) do { _Pragma("unroll") for (int n = 0; n < 2; ++n) _Pragma("unroll") for (int k = 0; k < 2; ++k) dst[n][k] = *(const LAS bf16x8*)(lds + PG_SB(b, h) + boff + n * 2048 + k * 1024); } while (0)
#define PG_MMA(ai, bj, At, Bt) do { __builtin_amdgcn_s_setprio(1); _Pragma("unroll") for (int m = 0; m < 4; ++m) _Pragma("unroll") for (int n = 0; n < 2; ++n) _Pragma("unroll") for (int k = 0; k < 2; ++k) \
        acc[ai][bj][m][n] = __builtin_amdgcn_mfma_f32_16x16x32_bf16(Bt[n][k], At[m][k], acc[ai][bj][m][n], 0, 0, 0); __builtin_amdgcn_s_setprio(0); } while (0)
#define PG_WAIT_V(n) asm volatile("s_waitcnt vmcnt(" #n ")" ::: "memory")
#define PG_WAIT_L(n) asm volatile("s_waitcnt lgkmcnt(" #n ")" ::: "memory")
#define PG_BAR __builtin_amdgcn_s_barrier()
#define PG_SCHED __builtin_amdgcn_sched_barrier(0)
    Unit cur, nxt; int ui = 0;
    if (!S.next(0, cur)) return;
    f32x4 acc[2][2][4][2];
#pragma unroll
    for (int a = 0; a < 2; ++a)
#pragma unroll
        for (int b = 0; b < 2; ++b)
#pragma unroll
            for (int m = 0; m < 4; ++m)
#pragma unroll
                for (int n = 0; n < 2; ++n) acc[a][b][m][n] = (f32x4){0.f, 0.f, 0.f, 0.f};
    bf16x8 At[4][2], B0[2][2], B1[2][2];
    const char* cA = cur.a; const char* cB = cur.b;
    PG_STAGE(PG_SB(0, 0), cB, voffB); PG_STAGE(PG_SA(0, 0), cA, voffA); PG_STAGE(PG_SB(0, 1), cB + hstepB, voffB); PG_STAGE(PG_SA(0, 1), cA + hstepA, voffA);
    if (wr == 1) PG_BAR;
    PG_WAIT_V(4); PG_BAR;
    PG_STAGE(PG_SB(1, 0), cB + kstep, voffB); PG_STAGE(PG_SA(1, 0), cA + kstep, voffA); PG_STAGE(PG_SB(1, 1), cB + hstepB + kstep, voffB);
    PG_WAIT_V(6); PG_BAR;
    for (;;) {
        const bool has_next = S.next(ui + 1, nxt);
        const char* nA = has_next ? nxt.a : cA; const char* nB = has_next ? nxt.b : cB;
        for (int t = 0; t < nt; t += 2) {
            const bool last = (t == nt - 2);
            const char* a1 = cA + (size_t)(t + 1) * kstep;
            const char* a2 = last ? nA : cA + (size_t)(t + 2) * kstep; const char* b2 = last ? nB : cB + (size_t)(t + 2) * kstep;
            const char* a3 = a2 + kstep; const char* b3 = b2 + kstep;
            PG_LDB(B0, 0, 0); PG_SCHED; PG_LDA(At, 0, 0); PG_STAGE(PG_SA(1, 1), a1 + hstepA, voffA);
            PG_WAIT_L(8); PG_BAR; PG_WAIT_L(0); PG_MMA(0, 0, At, B0); PG_BAR; PG_SCHED;
            PG_LDB(B1, 0, 1); PG_STAGE(PG_SB(0, 0), b2, voffB);
            PG_BAR; PG_WAIT_L(0); PG_MMA(0, 1, At, B1); PG_BAR;
            PG_LDA(At, 0, 1); PG_STAGE(PG_SA(0, 0), a2, voffA);
            PG_BAR; PG_WAIT_L(0); PG_MMA(1, 0, At, B0); PG_BAR; PG_SCHED;
            PG_STAGE(PG_SB(0, 1), b2 + hstepB, voffB);
            PG_WAIT_V(6); PG_BAR; PG_MMA(1, 1, At, B1); PG_BAR;
            PG_LDB(B0, 1, 0); PG_SCHED; PG_LDA(At, 1, 0); PG_STAGE(PG_SA(0, 1), a2 + hstepA, voffA);
            PG_WAIT_L(8); PG_BAR; PG_WAIT_L(0); PG_MMA(0, 0, At, B0); PG_BAR; PG_SCHED;
            PG_LDB(B1, 1, 1); PG_STAGE(PG_SB(1, 0), b3, voffB);
            PG_BAR; PG_WAIT_L(0); PG_MMA(0, 1, At, B1); PG_BAR;
            PG_LDA(At, 1, 1); PG_STAGE(PG_SA(1, 0), a3, voffA);
            PG_BAR; PG_WAIT_L(0); PG_MMA(1, 0, At, B0); PG_BAR; PG_SCHED;
            PG_STAGE(PG_SB(1, 1), b3 + hstepB, voffB);
            PG_WAIT_V(6); PG_BAR; PG_MMA(1, 1, At, B1); PG_BAR;
        }
        E(acc, cur, wr, wc, fr, fq);
        if (!has_next) break;
#pragma unroll
        for (int a = 0; a < 2; ++a)
#pragma unroll
            for (int b = 0; b < 2; ++b)
#pragma unroll
                for (int m = 0; m < 4; ++m)
#pragma unroll
                    for (int n = 0; n < 2; ++n) acc[a][b][m][n] = (f32x4){0.f, 0.f, 0.f, 0.f};
        cur = nxt; cA = nA; cB = nB; ++ui;
    }
    PG_WAIT_V(0);
    if (wr == 0) PG_BAR;
    PG_BAR;
#undef PG_SA
#undef PG_SB
#undef PG_STAGE
#undef PG_LDA
#undef PG_LDB
#undef PG_MMA
#undef PG_WAIT_V
#undef PG_WAIT_L
#undef PG_BAR
#undef PG_SCHED
}

struct SchedG1 {
    const char *HX, *W1, *WV; int G, c;
    __device__ __forceinline__ bool next(int i, Unit& u) const {
        const int L = i * G + c, nmain = (NROW / 256) * (NP1 / 256);
        if (L < nmain) { static_map(L, NROW / 256, NP1 / 256, u.pm, u.pn); u.a = HX + (size_t)u.pm * 256 * DM * 2; u.b = W1 + (size_t)u.pn * 256 * DM * 2; u.aux = 0; return true; }
        const int idx = L - nmain; if (idx >= 3 * (NROW / 256)) return false;
        u.pm = idx % 3; u.pn = idx / 3; u.a = WV + (size_t)u.pm * 256 * DM * 2; u.b = HX + (size_t)u.pn * 256 * DM * 2; u.aux = 1; return true;
    }
};
struct SchedStatic {
    const char *A, *B; size_t tA, tB; int nM, nN, G, c;
    __device__ __forceinline__ bool next(int i, Unit& u) const {
        const int L = i * G + c; if (L >= nM * nN) return false;
        static_map(L, nM, nN, u.pm, u.pn); u.a = A + (size_t)u.pm * tA; u.b = B + (size_t)u.pn * tB; u.aux = 0; return true;
    }
};
struct SchedMerge {
    const char *BR, *W; int ntile, G, c;
    __device__ __forceinline__ bool split() const { return ntile > G && (ntile - G) * 4 <= G; }
    __device__ __forceinline__ bool next(int i, Unit& u) const {
        int t, br;
        if (split()) { if (i < 4) { t = c; br = i; u.aux = br; } else { if (i > 4 || c >= (ntile - G) * 4) return false; t = G + (c >> 2); br = c & 3; u.aux = 4 + br; } }
        else { t = c + (i >> 2) * G; if (t >= ntile) return false; br = i & 3; u.aux = br; }
        u.pm = t >> 2; u.pn = t & 3;
        u.a = BR + (size_t)u.pm * 256 * 2048 * 2 + (size_t)br * 512 * 2; u.b = W + (size_t)br * DM * 512 * 2 + (size_t)u.pn * 256 * 512 * 2; return true;
    }
};
struct SchedMoe {
    const char *A, *W; const int* off; size_t tA, wE, wT; int npan, NJ, G, c;
    __device__ __forceinline__ bool next(int i, Unit& u) const {
        const int L = i * G + c; if (L >= npan * NJ) return false;
        const int p = L / NJ, j = L % NJ; int e = 0;
#pragma unroll 1
        for (int q = 1; q < 32; ++q) if (p * 256 >= off[q]) e = q;
        e = __builtin_amdgcn_readfirstlane(e);
        u.pm = p; u.pn = j; u.aux = e; u.a = A + (size_t)p * tA; u.b = W + (size_t)e * wE + (size_t)j * wT; return true;
    }
};

#define PG_ROWCOL const int row0 = u.pm * BM + wr * 64 + fr, col0 = u.pn * BM + wc * 32 + 4 * fq
struct EpiG1 { bf16_t *P1, *VT; const float* rtab; const float* lbp; int layer;
    __device__ __forceinline__ void operator()(const f32x4 (&acc)[2][2][4][2], const Unit& u, int wr, int wc, int fr, int fq) const {
        const int row0 = u.pm * BM + wr * 64 + fr;
        if (u.aux || (u.pn >= 8 && u.pn <= 10)) {
            const int col0 = u.pn * BM + wc * 32 + 4 * fq; bf16_t* base = u.aux ? VT : P1; const size_t ld = u.aux ? (size_t)NROW : (size_t)NP1;
            const bool rope = !u.aux && (u.pm < NTOK / 256);
#pragma unroll
            for (int ai = 0; ai < 2; ++ai)
#pragma unroll
                for (int m = 0; m < 4; ++m) { const int r = row0 + ai * HALF + m * 16; bf16_t* rowp = base + (size_t)r * ld + col0;
#pragma unroll
                    for (int bj = 0; bj < 2; ++bj) {
                        f32x4 v0 = acc[ai][bj][m][0], v1 = acc[ai][bj][m][1];
                        if (rope && !(u.pn == 10 && bj == 1)) {
                            const int pos = r & (SEQ - 1), pp = (wc & 1) ? (pos & 63) : (pos >> 6); const float* tp = rtab + (pp * 16 + 4 * fq) * 2;
                            const f32x4 t0 = *(const f32x4*)tp, t1 = *(const f32x4*)(tp + 4);
                            const f32x4 a = v0, b = v1;
                            v0.x = a.x * t0.x - b.x * t0.y; v1.x = a.x * t0.y + b.x * t0.x; v0.y = a.y * t0.z - b.y * t0.w; v1.y = a.y * t0.w + b.y * t0.z;
                            v0.z = a.z * t1.x - b.z * t1.y; v1.z = a.z * t1.y + b.z * t1.x; v0.w = a.w * t1.z - b.w * t1.w; v1.w = a.w * t1.w + b.w * t1.z;
                        }
                        u32x2 o; o.x = pk2(v0.x, v0.y); o.y = pk2(v0.z, v0.w); *(u32x2*)(rowp + bj * HALF) = o;
                        o.x = pk2(v1.x, v1.y); o.y = pk2(v1.z, v1.w); *(u32x2*)(rowp + bj * HALF + 16) = o; } }
            return;
        }
        const int col0 = u.pn * BM + wc * 32 + 8 * fq;
        const int mode = (u.pn == 11 || u.pn == 12) ? 2 : ((u.pn >= 13 && u.pn <= 16) ? 3 : 0);
        if (mode == 3) {
            f32x4 lb4[2][2];
            const int z = (u.pn - 13) >> 1, cb = z * 512 + ((u.pn - 13) & 1) * 256 + wc * 32 + 8 * fq;
#pragma unroll
            for (int bj = 0; bj < 2; ++bj)
#pragma unroll
                for (int n = 0; n < 2; ++n) lb4[bj][n] = (layer == 0) ? (f32x4){0.f, 0.f, 0.f, 0.f} : *(const f32x4*)(lbp + cb + bj * HALF + 4 * n);
#pragma unroll
            for (int ai = 0; ai < 2; ++ai)
#pragma unroll
                for (int m = 0; m < 4; ++m) { bf16_t* rowp = P1 + (size_t)(row0 + ai * HALF + m * 16) * NP1 + col0;
#pragma unroll
                    for (int bj = 0; bj < 2; ++bj) { float gq[8];
#pragma unroll
                        for (int n = 0; n < 2; ++n)
#pragma unroll
                            for (int j = 0; j < 4; ++j) { const float f = acc[ai][bj][m][n][j], lb = lb4[bj][n][j]; const float t = __expf(-fabsf(f)), rr = __builtin_amdgcn_rcpf(1.f + t);
                                gq[4 * n + j] = __logf(fmaxf(lb + (1.f - lb) * ((f >= 0.f) ? rr : t * rr), 1e-37f)); }
                        u32x4 o; o.x = pk2(gq[0], gq[1]); o.y = pk2(gq[2], gq[3]); o.z = pk2(gq[4], gq[5]); o.w = pk2(gq[6], gq[7]); *(u32x4*)(rowp + bj * HALF) = o; } }
            return;
        }
#pragma unroll
        for (int ai = 0; ai < 2; ++ai)
#pragma unroll
            for (int m = 0; m < 4; ++m) { bf16_t* rowp = P1 + (size_t)(row0 + ai * HALF + m * 16) * NP1 + col0;
#pragma unroll
                for (int bj = 0; bj < 2; ++bj) {
                    f32x4 v0 = acc[ai][bj][m][0], v1 = acc[ai][bj][m][1];
                    if (mode == 2) {
#pragma unroll
                        for (int j = 0; j < 4; ++j) { v0[j] = v0[j] * __builtin_amdgcn_rcpf(1.f + __expf(-v0[j])); v1[j] = v1[j] * __builtin_amdgcn_rcpf(1.f + __expf(-v1[j])); }
                    }
                    u32x4 o; o.x = pk2(v0.x, v0.y); o.y = pk2(v0.z, v0.w); o.z = pk2(v1.x, v1.y); o.w = pk2(v1.z, v1.w); *(u32x4*)(rowp + bj * HALF) = o; } }
    }
};
#define PG_ROWCOL8 const int row0 = u.pm * BM + wr * 64 + fr, col0 = u.pn * BM + wc * 32 + 8 * fq
struct EpiGate { bf16_t* G;
    __device__ __forceinline__ void operator()(const f32x4 (&acc)[2][2][4][2], const Unit& u, int wr, int wc, int fr, int fq) const {
        PG_ROWCOL8;
#pragma unroll
        for (int ai = 0; ai < 2; ++ai)
#pragma unroll
            for (int m = 0; m < 4; ++m) { bf16_t* rowp = G + (size_t)(row0 + ai * HALF + m * 16) * NGATE + col0;
#pragma unroll
                for (int bj = 0; bj < 2; ++bj) { const f32x4 v0 = acc[ai][bj][m][0], v1 = acc[ai][bj][m][1]; u32x4 o;
                    o.x = pk2(sigmoidf_(v0.x), sigmoidf_(v0.y)); o.y = pk2(sigmoidf_(v0.z), sigmoidf_(v0.w)); o.z = pk2(sigmoidf_(v1.x), sigmoidf_(v1.y)); o.w = pk2(sigmoidf_(v1.z), sigmoidf_(v1.w));
                    *(u32x4*)(rowp + bj * HALF) = o; } }
    }
};
struct EpiMerge { const bf16_t* G; bf16_t* O; bf16_t* PM;
    __device__ __forceinline__ void operator()(const f32x4 (&acc)[2][2][4][2], const Unit& u, int wr, int wc, int fr, int fq) const {
        PG_ROWCOL8; const int br = u.aux & 3; const bool part = u.aux >= 4, rmw = !part && br != 0;
        bf16_t* const Ob = part ? PM + (size_t)br * NCTX * DM - (size_t)NTOK * DM : O;
#pragma unroll
        for (int ai = 0; ai < 2; ++ai) {
            u32x4 g4[4][2], o4[4][2];
#pragma unroll
            for (int m = 0; m < 4; ++m) { const size_t r = (size_t)(row0 + ai * HALF + m * 16); const bf16_t* gp = G + r * NGATE + br * 1024 + col0; const bf16_t* rowp = Ob + r * DM + col0;
#pragma unroll
                for (int bj = 0; bj < 2; ++bj) { g4[m][bj] = *(const u32x4*)(gp + bj * HALF); if (rmw) o4[m][bj] = *(const u32x4*)(rowp + bj * HALF); } }
#pragma unroll
            for (int m = 0; m < 4; ++m) { bf16_t* rowp = Ob + (size_t)(row0 + ai * HALF + m * 16) * DM + col0;
#pragma unroll
                for (int bj = 0; bj < 2; ++bj) { const f32x4 v0 = acc[ai][bj][m][0], v1 = acc[ai][bj][m][1]; const u32x4 gg = g4[m][bj];
                    float w[8] = {__uint_as_float(gg.x << 16) * v0.x, __uint_as_float(gg.x & 0xffff0000u) * v0.y, __uint_as_float(gg.y << 16) * v0.z, __uint_as_float(gg.y & 0xffff0000u) * v0.w,
                                  __uint_as_float(gg.z << 16) * v1.x, __uint_as_float(gg.z & 0xffff0000u) * v1.y, __uint_as_float(gg.w << 16) * v1.z, __uint_as_float(gg.w & 0xffff0000u) * v1.w};
                    if (rmw) { const u32x4 oo = o4[m][bj];
                        w[0] += __uint_as_float(oo.x << 16); w[1] += __uint_as_float(oo.x & 0xffff0000u); w[2] += __uint_as_float(oo.y << 16); w[3] += __uint_as_float(oo.y & 0xffff0000u);
                        w[4] += __uint_as_float(oo.z << 16); w[5] += __uint_as_float(oo.z & 0xffff0000u); w[6] += __uint_as_float(oo.w << 16); w[7] += __uint_as_float(oo.w & 0xffff0000u); }
                    u32x4 o; o.x = pk2(w[0], w[1]); o.y = pk2(w[2], w[3]); o.z = pk2(w[4], w[5]); o.w = pk2(w[6], w[7]); *(u32x4*)(rowp + bj * HALF) = o; } }
            asm volatile("" ::: "memory");
        }
    }
};
struct EpiWout { const float *xlat, *xctx; float *olat, *octx; const float* modl;
    __device__ __forceinline__ void operator()(const f32x4 (&acc)[2][2][4][2], const Unit& u, int wr, int wc, int fr, int fq) const {
        PG_ROWCOL; const bool lat = u.pm < NTOK / 256; const int rb = lat ? (u.pm >> 4) : 4;
        const float* xin = lat ? xlat : xctx - (size_t)NTOK * DM; float* xo = lat ? olat : octx - (size_t)NTOK * DM; const float* m2 = modl + (size_t)rb * 6144 + 2 * 1024 + col0;
        f32x4 mv[2][2];
#pragma unroll
        for (int bj = 0; bj < 2; ++bj)
#pragma unroll
            for (int n = 0; n < 2; ++n) mv[bj][n] = *(const f32x4*)(m2 + bj * HALF + n * 16);
#pragma unroll
        for (int aq = 0; aq < 4; ++aq) { const int ai = aq >> 1, m0 = (aq & 1) * 2;
            f32x4 xv[4][2][2];
#pragma unroll
            for (int m = m0; m < m0 + 2; ++m) { const size_t o = (size_t)(row0 + ai * HALF + m * 16) * DM + col0;
#pragma unroll
                for (int bj = 0; bj < 2; ++bj)
#pragma unroll
                    for (int n = 0; n < 2; ++n) xv[m][bj][n] = *(const f32x4*)(xin + o + bj * HALF + n * 16); }
#pragma unroll
            for (int m = m0; m < m0 + 2; ++m) { const size_t o = (size_t)(row0 + ai * HALF + m * 16) * DM + col0;
#pragma unroll
                for (int bj = 0; bj < 2; ++bj)
#pragma unroll
                    for (int n = 0; n < 2; ++n) *(f32x4*)(xo + o + bj * HALF + n * 16) = ALPHA * xv[m][bj][n] + mv[bj][n] * acc[ai][bj][m][n]; }
            asm volatile("" ::: "memory");
        }
    }
};
struct EpiMoe1 { bf16_t* HID; const float* roww;
    __device__ __forceinline__ void operator()(const f32x4 (&acc)[2][2][4][2], const Unit& u, int wr, int wc, int fr, int fq) const {
        const int row0 = u.pm * BM + wr * 64 + fr, hc0 = u.pn * 128 + wc * 32 + 8 * fq;
#pragma unroll
        for (int ai = 0; ai < 2; ++ai)
#pragma unroll
            for (int m = 0; m < 4; ++m) { const int r = row0 + ai * HALF + m * 16; const float w = roww[r];
                const f32x4 g0 = acc[ai][0][m][0], g1 = acc[ai][0][m][1], u0 = acc[ai][1][m][0], u1 = acc[ai][1][m][1]; u32x4 o;
                o.x = pk2(siluf_(g0.x) * u0.x * w, siluf_(g0.y) * u0.y * w); o.y = pk2(siluf_(g0.z) * u0.z * w, siluf_(g0.w) * u0.w * w);
                o.z = pk2(siluf_(g1.x) * u1.x * w, siluf_(g1.y) * u1.y * w); o.w = pk2(siluf_(g1.z) * u1.z * w, siluf_(g1.w) * u1.w * w);
                *(u32x4*)(HID + (size_t)r * 256 + hc0) = o; }
    }
};
struct EpiMoe2 { bf16_t* Y; const int* rmap; bf16_t* dump;
    __device__ __forceinline__ void operator()(const f32x4 (&acc)[2][2][4][2], const Unit& u, int wr, int wc, int fr, int fq) const {
        PG_ROWCOL8;
#pragma unroll
        for (int ai = 0; ai < 2; ++ai)
#pragma unroll
            for (int m = 0; m < 4; ++m) { const int s = rmap[row0 + ai * HALF + m * 16];
                bf16_t* rowp = (s >= 0 ? Y + (size_t)s * DM : dump) + col0;
#pragma unroll
                for (int bj = 0; bj < 2; ++bj) { const f32x4 v0 = acc[ai][bj][m][0], v1 = acc[ai][bj][m][1]; u32x4 o; o.x = pk2(v0.x, v0.y); o.y = pk2(v0.z, v0.w); o.z = pk2(v1.x, v1.y); o.w = pk2(v1.z, v1.w); *(u32x4*)(rowp + bj * HALF) = o; } }
    }
};
#undef PG_ROWCOL8
#undef PG_ROWCOL
}

__device__ __forceinline__ void moe_offsets(Frame& F, int l, int* off) {
    if (F.tid < 64) {
        int v = (F.tid < 32) ? (((int)F.cnt()[l * 32 + F.tid] + 255) & ~255) : 0;
#pragma unroll
        for (int o = 1; o < 32; o <<= 1) { const int t = __shfl_up(v, o); if ((F.tid & 63) >= o) v += t; }
        if (F.tid < 32) off[F.tid + 1] = v;
        if (F.tid == 0) off[0] = 0;
    }
    __syncthreads();
}

__device__ __forceinline__ void phase_rope(Frame& F) {
    float* tab = F.smf;
    for (int e = F.tid; e < 1024; e += NTHR) { const int pp = e >> 4, i = e & 15; const float inv = powf(10000.f, -(float)i / 16.f), ang = (float)pp * inv; tab[2 * e] = cosf(ang); tab[2 * e + 1] = sinf(ang); }
    __syncthreads();
    const size_t total = (size_t)NTOK * 320;
    for (size_t idx = (size_t)F.bid * NTHR + F.tid; idx < total; idx += (size_t)F.nb * NTHR) {
        const int row = (int)(idx / 320), r = (int)(idx % 320), h = r >> 5, half = (r >> 4) & 1, i = r & 15;
        const int pos = row & (SEQ - 1), pp = half ? (pos & 63) : (pos >> 6);
        const float cs = tab[2 * (pp * 16 + i)], sn = tab[2 * (pp * 16 + i) + 1];
        bf16_t* base = F.P1() + (size_t)row * NP1 + (h < 8 ? PC_CQ + h * 64 : PC_CK + (h - 8) * 64) + half * 32 + i;
        const float u1 = bf2f(base[0]), u2 = bf2f(base[16]);
        base[0] = f2bf(u1 * cs - u2 * sn); base[16] = f2bf(u1 * sn + u2 * cs);
    }
}

__device__ __forceinline__ int seq_row(int s, int b, int z) {
    if (s < LC) { const int tc = z ? (LC - 1 - s) : s; return NTOK + b * LC + tc; }
    const int tl = s - LC, t = z ? (SEQ - 1 - tl) : tl; return b * SEQ + t;
}
typedef short bf16x8_t __attribute__((ext_vector_type(8)));
typedef short bf16x4_t __attribute__((ext_vector_type(4)));
struct MaskNone { __device__ __forceinline__ void operator()(f32x4&, f32x4&) const {} };
struct MaskNA { int u0; const float* brow;
    __device__ __forceinline__ void operator()(f32x4& s0, f32x4& s1) const {
        float v[8] = {s0.x, s0.y, s0.z, s0.w, s1.x, s1.y, s1.z, s1.w};
#pragma unroll
        for (int T = 0; T < 2; ++T)
#pragma unroll
            for (int rr = 0; rr < 4; ++rr) v[T * 4 + rr] = ((unsigned)(u0 + 16 * T + rr) < 16u) ? v[T * 4 + rr] + brow[16 * T + rr] : -INFINITY;
        s0 = (f32x4){v[0], v[1], v[2], v[3]}; s1 = (f32x4){v[4], v[5], v[6], v[7]};
    }
};
struct MaskWA { int i, j0;
    __device__ __forceinline__ void operator()(f32x4& s0, f32x4& s1) const {
        float v[8] = {s0.x, s0.y, s0.z, s0.w, s1.x, s1.y, s1.z, s1.w};
#pragma unroll
        for (int T = 0; T < 2; ++T)
#pragma unroll
            for (int rr = 0; rr < 4; ++rr) { const int j = j0 + 16 * T + rr; const bool ok = (j >= 0) && (j < SEQ) && (i - j <= 128) && (j - i <= 128);
                v[T * 4 + rr] = ok ? v[T * 4 + rr] : -INFINITY; }
        s0 = (f32x4){v[0], v[1], v[2], v[3]}; s1 = (f32x4){v[4], v[5], v[6], v[7]};
    }
};
struct KVF { bf16x8_t k[4]; bf16x4_t v[4][2]; };
__device__ __forceinline__ void kv_load(KVF& f, const char* kbase, unsigned ko0, unsigned ko1, const char* vbase, unsigned vo0, unsigned vo1) {
    f.k[0] = *(const bf16x8_t*)(kbase + ko0); f.k[1] = *(const bf16x8_t*)(kbase + ko0 + 64); f.k[2] = *(const bf16x8_t*)(kbase + ko1); f.k[3] = *(const bf16x8_t*)(kbase + ko1 + 64);
#pragma unroll
    for (int t = 0; t < 4; ++t) { f.v[t][0] = *(const bf16x4_t*)(vbase + vo0 + (unsigned)t * 16u * NROW * 2u); f.v[t][1] = *(const bf16x4_t*)(vbase + vo1 + (unsigned)t * 16u * NROW * 2u); }
}
__device__ __forceinline__ float xmax_g(float x) {
    auto r = __builtin_amdgcn_permlane16_swap(__float_as_uint(x), __float_as_uint(x), false, false); x = fmaxf(__uint_as_float(r[0]), __uint_as_float(r[1]));
    auto q = __builtin_amdgcn_permlane32_swap(__float_as_uint(x), __float_as_uint(x), false, false); return fmaxf(__uint_as_float(q[0]), __uint_as_float(q[1])); }
__device__ __forceinline__ float xsum_g(float x) {
    auto r = __builtin_amdgcn_permlane16_swap(__float_as_uint(x), __float_as_uint(x), false, false); x = __uint_as_float(r[0]) + __uint_as_float(r[1]);
    auto q = __builtin_amdgcn_permlane32_swap(__float_as_uint(x), __float_as_uint(x), false, false); return __uint_as_float(q[0]) + __uint_as_float(q[1]); }
template <class MaskF>
__device__ __forceinline__ void attn_tile(float& am, f32x4& asum, f32x4 (&ao)[4], const bf16x8_t (&qb)[2], const KVF& f, const MaskF& maskf) {
    f32x4 s0 = {0.f, 0.f, 0.f, 0.f}, s1 = {0.f, 0.f, 0.f, 0.f};
    s0 = __builtin_amdgcn_mfma_f32_16x16x32_bf16(f.k[0], qb[0], s0, 0, 0, 0); s0 = __builtin_amdgcn_mfma_f32_16x16x32_bf16(f.k[1], qb[1], s0, 0, 0, 0);
    s1 = __builtin_amdgcn_mfma_f32_16x16x32_bf16(f.k[2], qb[0], s1, 0, 0, 0); s1 = __builtin_amdgcn_mfma_f32_16x16x32_bf16(f.k[3], qb[1], s1, 0, 0, 0);
    maskf(s0, s1);
    const float ml = fmaxf(fmaxf(fmaxf(s0.x, s0.y), fmaxf(s0.z, s0.w)), fmaxf(fmaxf(s1.x, s1.y), fmaxf(s1.z, s1.w)));
    if (__any(ml > am)) {
        const float mn = fmaxf(am, xmax_g(ml)), alpha = __builtin_amdgcn_exp2f(am - mn); am = mn; asum = asum * alpha;
#pragma unroll
        for (int t = 0; t < 4; ++t) ao[t] = ao[t] * alpha;
    }
    f32x4 p0, p1;
    p0.x = __builtin_amdgcn_exp2f(s0.x - am); p0.y = __builtin_amdgcn_exp2f(s0.y - am); p0.z = __builtin_amdgcn_exp2f(s0.z - am); p0.w = __builtin_amdgcn_exp2f(s0.w - am);
    p1.x = __builtin_amdgcn_exp2f(s1.x - am); p1.y = __builtin_amdgcn_exp2f(s1.y - am); p1.z = __builtin_amdgcn_exp2f(s1.z - am); p1.w = __builtin_amdgcn_exp2f(s1.w - am);
    union { bf16x8_t v; unsigned u[4]; } pb, ones;
    pb.u[0] = pk2(p0.x, p0.y); pb.u[1] = pk2(p0.z, p0.w); pb.u[2] = pk2(p1.x, p1.y); pb.u[3] = pk2(p1.z, p1.w);
    ones.u[0] = ones.u[1] = ones.u[2] = ones.u[3] = 0x3f803f80u;
#pragma unroll
    for (int t = 0; t < 4; ++t) {
        union { bf16x8_t v; bf16x4_t h[2]; } av; av.h[0] = f.v[t][0]; av.h[1] = f.v[t][1];
        ao[t] = __builtin_amdgcn_mfma_f32_16x16x32_bf16(av.v, pb.v, ao[t], 0, 0, 0);
    }
    asum = __builtin_amdgcn_mfma_f32_16x16x32_bf16(ones.v, pb.v, asum, 0, 0, 0);
}
template <int kind>
__device__ __forceinline__ void attn_block(Frame& F, int l, int item, const float* rpb_s, bf16_t* sbuf) {
    constexpr int NQ = 2, NCS = 4, NLOC = (kind == 0) ? 11 : (kind == 1 ? 5 : 0), NS = NCS + NLOC, SROW = 72;
    const int tid = F.tid, lane = F.lane, n = lane & 15, g = lane >> 4, w = __builtin_amdgcn_readfirstlane(F.wave);
    const bf16_t* P1 = F.P1(); const bf16_t* VT = F.VT();
    int b, h0, kvh = 0, kcol, vrow, r = 0, cb = 0, t0 = 0, t0g = 0, r0 = 0, qrow0, qcol0, brcol0;
    constexpr int QRS = (kind == 0) ? 64 : (kind == 2 ? 16 : 0), QCS = (kind == 1 || kind == 3) ? 64 : 0;
    if (kind == 0) { const int rq = item & 15, hb = (item >> 4) & 7; b = item >> 7; r0 = 4 * rq; cb = w & 3; r = r0 + 2 * (w >> 2); h0 = hb; kcol = PC_BK + hb * 64; vrow = hb * 64;
        qrow0 = b * SEQ + r * 64 + cb * 16; qcol0 = PC_BQ + hb * 64; brcol0 = 512 + hb * 64; }
    else if (kind == 1) { const int qg = item & 63; kvh = (item >> 6) & 1; b = item >> 7; t0g = 64 * qg; t0 = t0g + 16 * (w & 3); h0 = kvh * 4 + 2 * (w >> 2); kcol = PC_CK + kvh * 64; vrow = 512 + kvh * 64;
        qrow0 = b * SEQ + t0; qcol0 = PC_CQ + h0 * 64; brcol0 = 1024 + h0 * 64; }
    else if (kind == 2) { const int hb = item & 7; b = item >> 3; h0 = hb; kcol = PC_BK + hb * 64; vrow = hb * 64; qrow0 = NTOK + b * LC + 32 * w; qcol0 = PC_BQ + hb * 64; brcol0 = 512 + hb * 64; }
    else { const int qh = item & 3; kvh = (item >> 2) & 1; b = item >> 3; h0 = kvh * 4 + 2 * (w >> 2); kcol = PC_CK + kvh * 64; vrow = 512 + kvh * 64;
        qrow0 = NTOK + b * LC + 16 * (4 * qh + (w & 3)); qcol0 = PC_CQ + h0 * 64; brcol0 = 1024 + h0 * 64; }
    bf16x8_t qb[NQ][2]; float am[NQ]; f32x4 asum[NQ], ao[NQ][4];
    { const char* qbase = (const char*)P1; const unsigned qo = (unsigned)(qrow0 + n) * (unsigned)(NP1 * 2) + (unsigned)(qcol0 + 8 * g) * 2u;
#pragma unroll
      for (int q = 0; q < NQ; ++q) { const unsigned o = qo + (unsigned)q * (unsigned)(QRS * NP1 * 2 + QCS * 2); qb[q][0] = *(const bf16x8_t*)(qbase + o); qb[q][1] = *(const bf16x8_t*)(qbase + o + 64);
        am[q] = -1e30f; asum[q] = (f32x4){0.f, 0.f, 0.f, 0.f};
#pragma unroll
        for (int t = 0; t < 4; ++t) ao[q][t] = (f32x4){0.f, 0.f, 0.f, 0.f}; } }
    const int crow0 = NTOK + b * LC, ru0 = min(max(r0 - 4, 0), 56);
    const int w0 = (cb == 0) ? 0 : (cb == 1 ? 8 : (cb == 2 ? 24 : 32));
    const int srow = tid >> 3, sch = tid & 7;
    const char* kbase = (const char*)P1; const char* vbase = (const char*)VT;
    u32x4 kr0 = {0u, 0u, 0u, 0u}, vr0 = kr0, kr1 = kr0, vr1 = kr0;
    auto stage_load = [&](int s, u32x4& kreg, u32x4& vreg) {
        int krow, vcol;
        if (s < NCS) { krow = crow0 + 64 * s + srow; vcol = crow0 + 64 * s + 8 * sch; }
        else if (kind == 0) { const int kr = min(ru0 + (s - NCS), 63); krow = b * SEQ + kr * 64 + srow; vcol = b * SEQ + kr * 64 + 8 * sch; }
        else { const int kb = t0g - 128 + 64 * (s - NCS); krow = b * SEQ + min(max(kb + srow, 0), SEQ - 1); vcol = b * SEQ + min(max(kb + 8 * sch, 0), SEQ - 8); }
        kreg = *(const u32x4*)(kbase + (unsigned)krow * (unsigned)(NP1 * 2) + (unsigned)(kcol * 2 + sch * 16));
        vreg = *(const u32x4*)(vbase + (unsigned)(vrow + srow) * (unsigned)(NROW * 2) + (unsigned)vcol * 2u);
    };
    auto stage_store = [&](int s, const u32x4& kreg, const u32x4& vreg) { bf16_t* Ks = sbuf + (s & 1) * (2 * 64 * SROW); bf16_t* Vs = Ks + 64 * SROW;
        *(u32x4*)(Ks + srow * SROW + sch * 8) = kreg; *(u32x4*)(Vs + srow * SROW + sch * 8) = vreg; };
    stage_load(0, kr1, vr1); stage_store(0, kr1, vr1); stage_load(1, kr0, vr0);
    __syncthreads();
    auto do_step = [&](int s, const u32x4& kst, const u32x4& vst, u32x4& kld, u32x4& vld) {
        if (s + 2 < NS) stage_load(s + 2, kld, vld);
#pragma unroll
        for (int hh = 0; hh < 2; ++hh) {
            bool act[NQ]; int kofs = 32 * hh;
            if (s < NCS) { act[0] = act[1] = true; }
            else if (kind == 0) { const int kr = ru0 + (s - NCS); kofs = w0;
#pragma unroll
                for (int q = 0; q < NQ; ++q) { const int rsq = min(max(r + q - 4, 0), 56); act[q] = (hh == 0) && (kr <= 63) && (kr >= rsq) && (kr <= rsq + 7); } }
            else { const int kb = t0g - 128 + 64 * (s - NCS) + 32 * hh; act[0] = act[1] = (kb + 31 >= t0 - 128) && (kb <= t0 + 143); }
            if (act[0] || act[1]) {
                const bf16_t* Ks = sbuf + (s & 1) * (2 * 64 * SROW); const bf16_t* Vs = Ks + 64 * SROW;
                KVF f;
                f.k[0] = *(const bf16x8_t*)(Ks + (kofs + n) * SROW + 8 * g); f.k[1] = *(const bf16x8_t*)(Ks + (kofs + n) * SROW + 32 + 8 * g);
                f.k[2] = *(const bf16x8_t*)(Ks + (kofs + 16 + n) * SROW + 8 * g); f.k[3] = *(const bf16x8_t*)(Ks + (kofs + 16 + n) * SROW + 32 + 8 * g);
#pragma unroll
                for (int t = 0; t < 4; ++t) { f.v[t][0] = *(const bf16x4_t*)(Vs + (16 * t + n) * SROW + kofs + 4 * g); f.v[t][1] = *(const bf16x4_t*)(Vs + (16 * t + n) * SROW + kofs + 16 + 4 * g); }
                if (s < NCS) {
#pragma unroll
                    for (int q = 0; q < NQ; ++q) attn_tile(am[q], asum[q], ao[q], qb[q], f, MaskNone());
                } else if (kind == 0) { const int kr = ru0 + (s - NCS);
#pragma unroll
                    for (int q = 0; q < NQ; ++q) if (act[q]) { const int c = cb * 16 + n, csq = min(max(c - 8, 0), 48), kc0 = w0 + 4 * g;
                        MaskNA mk{kc0 - csq, rpb_s + (h0 * 15 + (kr - (r + q) + 7)) * 64 + (kc0 - c + 15 + 16)}; attn_tile(am[q], asum[q], ao[q], qb[q], f, mk); }
                } else if (kind == 1) { const int kb = t0g - 128 + 64 * (s - NCS) + 32 * hh;
                    if (kb >= t0 - 113 && kb + 31 <= t0 + 128 && kb >= 0 && kb + 31 < SEQ) {
#pragma unroll
                        for (int q = 0; q < NQ; ++q) attn_tile(am[q], asum[q], ao[q], qb[q], f, MaskNone());
                    } else { MaskWA mk{t0 + n, kb + 4 * g};
#pragma unroll
                        for (int q = 0; q < NQ; ++q) attn_tile(am[q], asum[q], ao[q], qb[q], f, mk); }
                }
            }
        }
        if (s + 1 < NS) stage_store(s + 1, kst, vst);
        __syncthreads();
    };
#pragma unroll 1
    for (int s = 0; s < NS; s += 2) { do_step(s, kr0, vr0, kr1, vr1); if (s + 1 < NS) do_step(s + 1, kr1, vr1, kr0, vr0); }
#pragma unroll
    for (int q = 0; q < NQ; ++q) {
        float lt = asum[q].x;
        float osc = 1.f;
        if (kind == 1 || kind == 3) { const float sk = F.p.wa_sink[l * 8 + h0 + q] * 1.44269504089f, mf = fmaxf(am[q], sk); osc = __builtin_amdgcn_exp2f(am[q] - mf); lt = lt * osc + __builtin_amdgcn_exp2f(sk - mf); }
        const float inv = osc / lt;
        char* obase = (char*)F.BR(); const unsigned oo = (unsigned)(qrow0 + q * QRS + n) * 4096u + (unsigned)(brcol0 + q * QCS + 4 * g) * 2u;
#pragma unroll
        for (int t = 0; t < 4; ++t) { const f32x4 v = ao[q][t] * inv; u32x2 o2; o2.x = pk2(v.x, v.y); o2.y = pk2(v.z, v.w); *(u32x2*)(obase + oo + 32u * t) = o2; }
    }
}

template <int DK, bool HG>
__device__ __forceinline__ void prescan_combo(Frame& F, int l, int b, int h, int first, int step) {
    constexpr int NDP = DK / 2, NTG = NTHR / NDP, TPT = 64 / NTG, LGS = 66;
    REFRESH(F);
    const int tid = F.tid, dp = tid % NDP, tg = tid / NDP, lane = F.lane, n = lane & 15, g = lane >> 4, w = __builtin_amdgcn_readfirstlane(F.wave);
    float* TOT = F.smf;
    float* LGS_ = F.smf + 2 * 2 * NTG * DK;
    char* p1b = (char*)F.P1();
    bf16x8_t bw[HG ? 1 : 4]; f32x2_t lb2[2];
    lb2[0] = (f32x2_t){0.f, 0.f}; lb2[1] = lb2[0];
    if (!HG) {
        const int zw = w >> 2;
#pragma unroll
        for (int dt = 0; dt < 4; ++dt) { float wv[8];
#pragma unroll
            for (int j = 0; j < 8; ++j) { const float x = F.p.gla_lr_w[((size_t)(l * 2 + zw) * 16 + 8 * (g & 1) + j) * 256 + h * 64 + dt * 16 + n]; const float hi = __uint_as_float(pk2(x, x) << 16); wv[j] = (g < 2) ? x : x - hi; }
            union { bf16x8_t v; unsigned u[4]; } pb; pb.u[0] = pk2(wv[0], wv[1]); pb.u[1] = pk2(wv[2], wv[3]); pb.u[2] = pk2(wv[4], wv[5]); pb.u[3] = pk2(wv[6], wv[7]); bw[HG ? 0 : dt] = pb.v; }
#pragma unroll
        for (int z = 0; z < 2; ++z) { const float* bp = F.p.gla_lr_b + (l * 2 + z) * 256 + h * 64 + 2 * dp; lb2[z] = (f32x2_t){bp[0], bp[1]}; }
    }
    const int qcol = HG ? PC_DQ + h * 128 + 2 * dp : PC_AQ + h * 64 + 2 * dp, kcol = HG ? PC_DF + h * 128 + 2 * dp : PC_AK + h * 64 + 2 * dp;
    float* ebase = F.ESC() + (HG ? 32 * 68 * 128 : 0);
    unsigned rq[TPT], rk[TPT], rk1[HG ? TPT : 1]; u32x4 rlp = {0u, 0u, 0u, 0u};
    rk1[0] = 0u;
#define PS_LOAD(nbk_) do { const int row0_ = seq_row((nbk_) * 64, b, 0); unsigned o_ = (unsigned)(row0_ + tg * TPT) * (unsigned)(NP1 * 2); \
        _Pragma("unroll") for (int tt = 0; tt < TPT; ++tt) { rq[tt] = *(const unsigned*)(p1b + (o_ + (unsigned)(qcol * 2))); rk[tt] = *(const unsigned*)(p1b + (o_ + (unsigned)(kcol * 2))); \
            if (HG) rk1[HG ? tt : 0] = *(const unsigned*)(p1b + (o_ + (unsigned)((kcol + 512) * 2))); o_ += (unsigned)(NP1 * 2); } \
        if (!HG) rlp = *(const u32x4*)(p1b + ((unsigned)(row0_ + (w & 3) * 16 + n) * (unsigned)(NP1 * 2) + (unsigned)((PC_ALR + (w >> 2) * 16 + (g & 1) * 8) * 2))); } while (0)
    int nbk = first, par = 0;
    if (nbk < 68) PS_LOAD(nbk);
#pragma unroll 1
    for (; nbk < 68; nbk += step, par ^= 1) {
        float* tot = TOT + par * (2 * NTG * DK);
        if (!HG) {
            union { bf16x8_t v; u32x4 u; } af; af.u = rlp;
            float* lgw = LGS_ + ((w >> 2) * 64 + (w & 3) * 16 + 4 * g) * LGS + n;
#pragma unroll
            for (int dt = 0; dt < 4; ++dt) { const f32x4 d = __builtin_amdgcn_mfma_f32_16x16x32_bf16(af.v, bw[HG ? 0 : dt], (f32x4){0.f, 0.f, 0.f, 0.f}, 0, 0, 0);
                lgw[0 * LGS + dt * 16] = d.x; lgw[1 * LGS + dt * 16] = d.y; lgw[2 * LGS + dt * 16] = d.z; lgw[3 * LGS + dt * 16] = d.w; }
            __syncthreads();
        }
        const int row0 = seq_row(nbk * 64, b, 0);
        f32x2_t qv[TPT], kv0[TPT], kv1[HG ? TPT : 1], cs0[TPT], cs1[TPT];
#pragma unroll
        for (int tt = 0; tt < TPT; ++tt) {
            qv[tt] = (f32x2_t){__uint_as_float(rq[tt] << 16), __uint_as_float(rq[tt] & 0xffff0000u)};
            const f32x2_t kr = {__uint_as_float(rk[tt] << 16), __uint_as_float(rk[tt] & 0xffff0000u)};
            if (HG) { const unsigned r1 = rk1[HG ? tt : 0]; const f32x2_t k1 = {__uint_as_float(r1 << 16), __uint_as_float(r1 & 0xffff0000u)};
                cs0[tt] = kr; cs1[tt] = k1;
                kv0[tt] = (f32x2_t){1.f - __expf(kr.x), 1.f - __expf(kr.y)}; kv1[HG ? tt : 0] = (f32x2_t){1.f - __expf(k1.x), 1.f - __expf(k1.y)}; }
            else kv0[tt] = kr;
        }
        if (nbk + step < 68) PS_LOAD(nbk + step);
        if (!HG) {
#pragma unroll
            for (int tt = 0; tt < TPT; ++tt)
#pragma unroll
                for (int z = 0; z < 2; ++z) {
                    const f32x2_t lg = *(const f32x2_t*)(LGS_ + (z * 64 + tg * TPT + tt) * LGS + 2 * dp) + lb2[z];
                    const f32x2_t gz = {(fminf(lg.x, 0.f) - __logf(1.f + __expf(-fabsf(lg.x)))) * (1.f / 16.f), (fminf(lg.y, 0.f) - __logf(1.f + __expf(-fabsf(lg.y)))) * (1.f / 16.f)};
                    if (z == 0) cs0[tt] = gz; else cs1[tt] = gz; }
        }
#pragma unroll
        for (int tt = 1; tt < TPT; ++tt) { cs0[tt] += cs0[tt - 1]; cs1[TPT - 1 - tt] += cs1[TPT - tt]; }
        *(f32x2_t*)(tot + (0 * NTG + tg) * DK + 2 * dp) = cs0[TPT - 1];
        *(f32x2_t*)(tot + (1 * NTG + tg) * DK + 2 * dp) = cs1[0];
        __syncthreads();
        f32x2_t offs0 = {0.f, 0.f}, mid0 = offs0, last0 = offs0, offs1 = offs0, mid1 = offs0, last1 = offs0;
#pragma unroll
        for (int t2 = 0; t2 < NTG; ++t2) { const f32x2_t v0 = *(const f32x2_t*)(tot + (0 * NTG + t2) * DK + 2 * dp), v1 = *(const f32x2_t*)(tot + (1 * NTG + t2) * DK + 2 * dp);
            if (t2 < tg) offs0 += v0; if (t2 < NTG / 2) mid0 += v0; last0 += v0;
            if (t2 > tg) offs1 += v1; if (t2 >= NTG / 2) mid1 += v1; last1 += v1; }
        const f32x2_t d0 = offs0 - mid0, d1 = offs1 - mid1;
        unsigned ro = (unsigned)(row0 + tg * TPT);
#pragma unroll
        for (int tt = 0; tt < TPT; ++tt, ++ro) {
            const float x00 = fminf(fmaxf(cs0[tt].x + d0.x, -80.f), 80.f), x01 = fminf(fmaxf(cs0[tt].y + d0.y, -80.f), 80.f);
            const float x10 = fminf(fmaxf(cs1[tt].x + d1.x, -80.f), 80.f), x11 = fminf(fmaxf(cs1[tt].y + d1.y, -80.f), 80.f);
            const f32x2_t k1v = kv1[HG ? tt : 0], k1 = HG ? k1v : kv0[tt];
            const unsigned qd0 = pk2(qv[tt].x * __expf(x00), qv[tt].y * __expf(x01)), kd0 = pk2(kv0[tt].x * __expf(-x00), kv0[tt].y * __expf(-x01));
            const unsigned qd1 = pk2(qv[tt].x * __expf(x10), qv[tt].y * __expf(x11)), kd1 = pk2(k1.x * __expf(-x10), k1.y * __expf(-x11));
            const unsigned o_ = ro * (unsigned)(NP1 * 2);
            *(unsigned*)(p1b + (o_ + (unsigned)(qcol * 2))) = qd0; *(unsigned*)(p1b + (o_ + (unsigned)(kcol * 2))) = kd0;
            if (HG) { *(unsigned*)(p1b + (o_ + (unsigned)((kcol + 512) * 2))) = kd1; *(unsigned*)((char*)F.BR() + (ro * 4096u + (unsigned)((1536 + h * 128 + 2 * dp) * 2))) = qd1; }
            else { *(unsigned*)((char*)F.SC1() + (ro * 1024u + (unsigned)((h * 64 + 2 * dp) * 2))) = qd1; *(unsigned*)((char*)F.SC1() + (ro * 1024u + (unsigned)((256 + h * 64 + 2 * dp) * 2))) = kd1; }
        }
        if (tg == 0) {
            float* e0 = ebase + (size_t)(((b * 4 + h) * 2 + 0) * 68 + nbk) * (2 * DK), *e1 = ebase + (size_t)(((b * 4 + h) * 2 + 1) * 68 + (nbk < 4 ? 3 - nbk : 71 - nbk)) * (2 * DK);
            *(f32x2_t*)(e0 + 2 * dp) = (f32x2_t){__expf(mid0.x), __expf(mid0.y)}; *(f32x2_t*)(e0 + DK + 2 * dp) = (f32x2_t){__expf(last0.x - mid0.x), __expf(last0.y - mid0.y)};
            *(f32x2_t*)(e1 + 2 * dp) = (f32x2_t){__expf(mid1.x), __expf(mid1.y)}; *(f32x2_t*)(e1 + DK + 2 * dp) = (f32x2_t){__expf(last1.x - mid1.x), __expf(last1.y - mid1.y)};
        }
    }
    __syncthreads();
#undef PS_LOAD
}
__device__ __forceinline__ void phase_prescan(Frame& F, int l) {
    if (F.nb >= 32) { const int combo = F.bid & 31, b = (combo >> 2) & 3, h = combo & 3;
        if ((combo >> 4) == 0) prescan_combo<64, false>(F, l, b, h, F.bid >> 5, F.nb >> 5); else prescan_combo<128, true>(F, l, b, h, F.bid >> 5, F.nb >> 5);
    } else {
        for (int combo = F.bid; combo < 32; combo += F.nb) { const int b = (combo >> 2) & 3, h = combo & 3;
            if ((combo >> 4) == 0) prescan_combo<64, false>(F, l, b, h, 0, 1); else prescan_combo<128, true>(F, l, b, h, 0, 1); }
    }
}

template <int DK, bool HG>
__device__ __forceinline__ void scan_mfma(Frame& F, int l, int b, int h, int z, int vh, unsigned char* lds) {
    constexpr int NDP = DK / 2, NTG = NTHR / NDP, TPT = 64 / NTG, QS = DK + 8, TS = 72, NDT = DK / 16, PPR = DK / 8, NQP = (64 * PPR) / NTHR;
    bf16_t* QD = (bf16_t*)lds; bf16_t* KD = QD + 64 * QS; bf16_t* KDT = KD + 64 * QS; bf16_t* VTs = KDT + DK * TS; bf16_t* AM = VTs + 64 * TS; bf16_t* ST = AM + 64 * TS;
    float* E1s = (float*)(ST + 64 * QS); float* E2s = E1s + DK;
    REFRESH(F);
    const int tid = F.tid, lane = F.lane, w = F.wave, n = lane & 15, g = lane >> 4;
    const int dp = tid % NDP, tg = tid / NDP, vp = tid & 31, vg = tid >> 5;
    const int vt = w & 3, wh = w >> 2;
    const char* p1b = (const char*)F.P1();
    const char* qb; const char* kb; unsigned qstr, kstr, qoff, koff;
    if (HG) { kb = p1b; kstr = NP1 * 2; koff = (unsigned)((PC_DF + z * 512 + h * 128) * 2);
        if (z == 0) { qb = p1b; qstr = NP1 * 2; qoff = (unsigned)((PC_DQ + h * 128) * 2); } else { qb = (const char*)F.BR(); qstr = 4096u; qoff = (unsigned)((1536 + h * 128) * 2); } }
    else if (z == 0) { qb = p1b; kb = p1b; qstr = kstr = NP1 * 2; qoff = (unsigned)((PC_AQ + h * 64) * 2); koff = (unsigned)((PC_AK + h * 64) * 2); }
    else { qb = (const char*)F.SC1(); kb = qb; qstr = kstr = 1024u; qoff = (unsigned)(h * 64 * 2); koff = (unsigned)((256 + h * 64) * 2); }
    const float* eb = F.ESC() + (HG ? 32 * 68 * 128 : 0) + (size_t)(((b * 4 + h) * 2 + z) * 68) * (2 * DK);
    f32x4 accS[NDT / 2];
#pragma unroll
    for (int i = 0; i < NDT / 2; ++i) accS[i] = (f32x4){0.f, 0.f, 0.f, 0.f};
    u32x4 rqp[NQP]; unsigned rk[TPT], rv[4]; float re = 0.f;
    const int vcol = (HG ? PC_DI : PC_AV) + h * 128 + 64 * vh + 2 * vp;
    const int sgn = z ? -1 : 1; const int rstep = sgn * NP1 * 2;
#define SCAN_LOAD(c) do { const int row0_ = seq_row((c) * 64, b, z); \
        _Pragma("unroll") for (int j = 0; j < NQP; ++j) { const int pi_ = tid + NTHR * j; rqp[j] = *(const u32x4*)(qb + ((unsigned)(row0_ + sgn * (pi_ / PPR)) * qstr + qoff + (unsigned)((pi_ % PPR) * 16))); } \
        _Pragma("unroll") for (int tt = 0; tt < TPT; ++tt) rk[tt] = *(const unsigned*)(kb + ((unsigned)(row0_ + sgn * (tg * TPT + tt)) * kstr + koff + (unsigned)(dp * 4))); \
        int ov_ = (row0_ + sgn * vg * 4) * (NP1 * 2) + vcol * 2; \
        _Pragma("unroll") for (int tt = 0; tt < 4; ++tt) { rv[tt] = *(const unsigned*)(p1b + (unsigned)ov_); ov_ += rstep; } \
        if (tid < 2 * DK) re = eb[(c) * (2 * DK) + tid]; } while (0)
    SCAN_LOAD(0);
    constexpr int NCH = (LC + SEQ) / 64;
#pragma unroll 1
    for (int c = 0; c < NCH; ++c) {
        __syncthreads();
#pragma unroll
        for (int j = 0; j < NQP; ++j) { const int pi_ = tid + NTHR * j; *(u32x4*)(QD + (pi_ / PPR) * QS + (pi_ % PPR) * 8) = rqp[j]; }
#pragma unroll
        for (int tt = 0; tt < TPT; ++tt) *(unsigned*)(KD + (tg * TPT + tt) * QS + 2 * dp) = rk[tt];
        {   unsigned kdt[2][TPT / 2];
#pragma unroll
            for (int t2 = 0; t2 < TPT / 2; ++t2) { kdt[0][t2] = (rk[2 * t2] & 0xffffu) | (rk[2 * t2 + 1] << 16); kdt[1][t2] = (rk[2 * t2] >> 16) | (rk[2 * t2 + 1] & 0xffff0000u); }
#pragma unroll
            for (int e = 0; e < 2; ++e) {
                bf16_t* dst = KDT + (2 * dp + e) * TS + tg * TPT;
                if (TPT == 8) { u32x4 o; o.x = kdt[e][0]; o.y = kdt[e][1]; o.z = kdt[e][TPT / 2 - 2]; o.w = kdt[e][TPT / 2 - 1]; *(u32x4*)dst = o; }
                else { u32x2 o; o.x = kdt[e][0]; o.y = kdt[e][1]; *(u32x2*)dst = o; }
            }
        }
        if (tid < 2 * DK) E1s[tid] = re;
        {   u32x2 o0, o1;
            o0.x = (rv[0] & 0xffffu) | (rv[1] << 16); o0.y = (rv[2] & 0xffffu) | (rv[3] << 16);
            o1.x = (rv[0] >> 16) | (rv[1] & 0xffff0000u); o1.y = (rv[2] >> 16) | (rv[3] & 0xffff0000u);
            *(u32x2*)(VTs + (2 * vp) * TS + vg * 4) = o0; *(u32x2*)(VTs + (2 * vp + 1) * TS + vg * 4) = o1; }
        if (c + 1 < NCH) SCAN_LOAD(c + 1);
        __syncthreads();
#pragma unroll
        for (int i = 0; i < NDT / 2; ++i) { const int dt = wh * (NDT / 2) + i; accS[i] = accS[i] * *(const f32x4*)&E1s[16 * dt + 4 * g];
            u32x2 o; o.x = pk2(accS[i].x, accS[i].y); o.y = pk2(accS[i].z, accS[i].w); *(u32x2*)(ST + (16 * vt + n) * QS + 16 * dt + 4 * g) = o; }
        {   const int it = w >> 1, jt0 = 2 * (w & 1);
            f32x4 d0 = {0.f, 0.f, 0.f, 0.f}, d1 = {0.f, 0.f, 0.f, 0.f};
            if (jt0 <= it) {
                bf16x8_t qf[DK / 32], k0f[DK / 32], k1f[DK / 32];
#pragma unroll
                for (int ks = 0; ks < DK / 32; ++ks) { qf[ks] = *(const bf16x8_t*)(QD + (16 * it + n) * QS + 32 * ks + 8 * g); k0f[ks] = *(const bf16x8_t*)(KD + (16 * jt0 + n) * QS + 32 * ks + 8 * g); k1f[ks] = *(const bf16x8_t*)(KD + (16 * (jt0 + 1) + n) * QS + 32 * ks + 8 * g); }
#pragma unroll
                for (int ks = 0; ks < DK / 32; ++ks) { d0 = __builtin_amdgcn_mfma_f32_16x16x32_bf16(k0f[ks], qf[ks], d0, 0, 0, 0); d1 = __builtin_amdgcn_mfma_f32_16x16x32_bf16(k1f[ks], qf[ks], d1, 0, 0, 0); }
                const int i = 16 * it + n, j0 = 16 * jt0 + 4 * g, j1 = j0 + 16;
                d0.x = (j0 + 0 <= i) ? d0.x : 0.f; d0.y = (j0 + 1 <= i) ? d0.y : 0.f; d0.z = (j0 + 2 <= i) ? d0.z : 0.f; d0.w = (j0 + 3 <= i) ? d0.w : 0.f;
                d1.x = (j1 + 0 <= i) ? d1.x : 0.f; d1.y = (j1 + 1 <= i) ? d1.y : 0.f; d1.z = (j1 + 2 <= i) ? d1.z : 0.f; d1.w = (j1 + 3 <= i) ? d1.w : 0.f;
            }
            u32x2 o; o.x = pk2(d0.x, d0.y); o.y = pk2(d0.z, d0.w); *(u32x2*)(AM + (16 * it + n) * TS + 16 * jt0 + 4 * g) = o;
            o.x = pk2(d1.x, d1.y); o.y = pk2(d1.z, d1.w); *(u32x2*)(AM + (16 * it + n) * TS + 16 * (jt0 + 1) + 4 * g) = o;
        }
        __syncthreads();
        {   f32x4 o[2];
#pragma unroll
            for (int ii = 0; ii < 2; ++ii) o[ii] = (f32x4){0.f, 0.f, 0.f, 0.f};
#pragma unroll
            for (int ks = 0; ks < 2; ++ks) { const bf16x8_t af = *(const bf16x8_t*)(VTs + (16 * vt + n) * TS + 32 * ks + 8 * g); bf16x8_t bf[2];
#pragma unroll
                for (int ii = 0; ii < 2; ++ii) bf[ii] = *(const bf16x8_t*)(AM + (16 * (2 * wh + ii) + n) * TS + 32 * ks + 8 * g);
#pragma unroll
                for (int ii = 0; ii < 2; ++ii) o[ii] = __builtin_amdgcn_mfma_f32_16x16x32_bf16(af, bf[ii], o[ii], 0, 0, 0); }
#pragma unroll
            for (int ks = 0; ks < DK / 32; ++ks) { const bf16x8_t af = *(const bf16x8_t*)(ST + (16 * vt + n) * QS + 32 * ks + 8 * g); bf16x8_t bf[2];
#pragma unroll
                for (int ii = 0; ii < 2; ++ii) bf[ii] = *(const bf16x8_t*)(QD + (16 * (2 * wh + ii) + n) * QS + 32 * ks + 8 * g);
#pragma unroll
                for (int ii = 0; ii < 2; ++ii) o[ii] = __builtin_amdgcn_mfma_f32_16x16x32_bf16(af, bf[ii], o[ii], 0, 0, 0); }
            const int row0 = seq_row(c * 64, b, z) + sgn * (32 * wh + n), vc = h * 128 + 64 * vh + 16 * vt + 4 * g;
            char* dstb; unsigned doff; int dstride;
            if (HG) { dstb = (char*)F.ODH(); doff = (unsigned)row0 * 2048u + (unsigned)(z * 512 + vc) * 2u; dstride = sgn * 16 * 2048; }
            else if (z == 0) { dstb = (char*)F.BR(); doff = (unsigned)row0 * 4096u + (unsigned)vc * 2u; dstride = sgn * 16 * 4096; }
            else { dstb = (char*)F.OBA(); doff = (unsigned)row0 * 1024u + (unsigned)vc * 2u; dstride = sgn * 16 * 1024; }
#pragma unroll
            for (int ii = 0; ii < 2; ++ii) { u32x2 o2; o2.x = pk2(o[ii].x, o[ii].y); o2.y = pk2(o[ii].z, o[ii].w); *(u32x2*)(dstb + (unsigned)((int)doff + ii * dstride)) = o2; }
        }
#pragma unroll
        for (int ks = 0; ks < 2; ++ks) { const bf16x8_t bv = *(const bf16x8_t*)(VTs + (16 * vt + n) * TS + 32 * ks + 8 * g); bf16x8_t af[NDT / 2];
#pragma unroll
            for (int i = 0; i < NDT / 2; ++i) af[i] = *(const bf16x8_t*)(KDT + (16 * (wh * (NDT / 2) + i) + n) * TS + 32 * ks + 8 * g);
#pragma unroll
            for (int i = 0; i < NDT / 2; ++i) accS[i] = __builtin_amdgcn_mfma_f32_16x16x32_bf16(af[i], bv, accS[i], 0, 0, 0); }
#pragma unroll
        for (int i = 0; i < NDT / 2; ++i) accS[i] = accS[i] * *(const f32x4*)&E2s[16 * (wh * (NDT / 2) + i) + 4 * g];
    }
    __syncthreads();
#undef SCAN_LOAD
}

__device__ __forceinline__ void phase_mix(Frame& F, int l) {
    const int n_scan = 128;
    const int nsb = (F.nb > 192) ? 128 : 0;
    if (nsb == 0 || F.bid < nsb) {
        for (int it = F.bid; it < n_scan; it += (nsb ? nsb : F.nb)) {
            const int br = it >> 6, r = (it >> 1) & 31, vh = it & 1, b = r >> 3, h = (r >> 1) & 3, z = r & 1;
            if (br == 0) scan_mfma<64, false>(F, l, b, h, z, vh, (unsigned char*)F.smf); else scan_mfma<128, true>(F, l, b, h, z, vh, (unsigned char*)F.smf);
        }
        __syncthreads();
    }
    float* rpb_s = F.smf;
    {   float tv[(8 * 15 * 64) / NTHR];
#pragma unroll
        for (int k = 0; k < (8 * 15 * 64) / NTHR; ++k) { const int i = F.tid + k * NTHR, dcp = i & 63, hr = i >> 6; tv[k] = (dcp >= 16 && dcp < 47) ? F.p.na_rpb[l * 8 * 465 + hr * 31 + (dcp - 16)] : 0.f; }
#pragma unroll
        for (int k = 0; k < (8 * 15 * 64) / NTHR; ++k) rpb_s[F.tid + k * NTHR] = tv[k] * 1.44269504089f; }
    bf16_t* sbuf = (bf16_t*)(F.smf + 8 * 15 * 64);
    unsigned* qhead = F.cnt() + 64 + l * 16;
    int* cur = (int*)((unsigned char*)F.smf - LDS_STAGE + 32);
    const int n_wa = 512, n_na = 512, n_cna = (l == 0) ? 32 : 0, n_cwa = (l == 0) ? 32 : 0, total = n_wa + n_na + n_cna + n_cwa;
    int nxt = 0;
    if (F.tid == 0) nxt = (int)atomicAdd(qhead, 1u);
    for (;;) {
        __syncthreads();
        if (F.tid == 0) *cur = nxt;
        __syncthreads();
        const int it = *cur;
        if (it >= total) break;
        if (F.tid == 0) nxt = (int)atomicAdd(qhead, 1u);
        if (it < n_wa) attn_block<1>(F, l, it, rpb_s, sbuf);
        else if (it < n_wa + n_na) attn_block<0>(F, l, it - n_wa, rpb_s, sbuf);
        else if (it < n_wa + n_na + n_cna) attn_block<2>(F, l, it - n_wa - n_na, rpb_s, sbuf);
        else attn_block<3>(F, l, it - n_wa - n_na - n_cna, rpb_s, sbuf);
    }
}

__device__ __forceinline__ void phase_prepad(Frame& F, int l) {
    const int gw = F.bid * 8 + F.wave, ngw = F.nb * 8, npairs = ((l == 0) ? NROW : NTOK) / 2, c0 = F.lane * 8;
    for (int pi = gw; pi < npairs; pi += ngw) {
        u32x4 ra[2][2], rb[2][2], rg[2][2];
#pragma unroll
        for (int q = 0; q < 2; ++q) { const size_t row = (size_t)pi * 2 + q;
            ra[q][0] = *(const u32x4*)(F.BR() + row * 2048 + c0); rb[q][0] = *(const u32x4*)(F.OBA() + row * 512 + c0); rg[q][0] = *(const u32x4*)(F.P1() + row * NP1 + PC_AG + c0);
            ra[q][1] = *(const u32x4*)(F.ODH() + row * 1024 + c0); rb[q][1] = *(const u32x4*)(F.ODH() + row * 1024 + 512 + c0); rg[q][1] = *(const u32x4*)(F.P1() + row * NP1 + PC_DG + c0); }
#pragma unroll
        for (int q = 0; q < 2; ++q)
#pragma unroll
            for (int br = 0; br < 2; ++br) {
                const unsigned ua[4] = {ra[q][br].x, ra[q][br].y, ra[q][br].z, ra[q][br].w}, ub[4] = {rb[q][br].x, rb[q][br].y, rb[q][br].z, rb[q][br].w}, ug[4] = {rg[q][br].x, rg[q][br].y, rg[q][br].z, rg[q][br].w};
                float o[8], g[8]; float ss = 0.f;
#pragma unroll
                for (int j = 0; j < 4; ++j) { o[2 * j] = __uint_as_float(ua[j] << 16) + __uint_as_float(ub[j] << 16); o[2 * j + 1] = __uint_as_float(ua[j] & 0xffff0000u) + __uint_as_float(ub[j] & 0xffff0000u);
                    g[2 * j] = __uint_as_float(ug[j] << 16); g[2 * j + 1] = __uint_as_float(ug[j] & 0xffff0000u); ss += o[2 * j] * o[2 * j] + o[2 * j + 1] * o[2 * j + 1]; }
                ss += __shfl_xor(ss, 1); ss += __shfl_xor(ss, 2); ss += __shfl_xor(ss, 4); ss += __shfl_xor(ss, 8);
                const float rs = rsqrtf(ss * (1.f / 128.f) + 1e-6f);
#pragma unroll
                for (int j = 0; j < 8; ++j) o[j] = o[j] * rs * siluf_(g[j]);
                st8(F.BR() + ((size_t)pi * 2 + q) * 2048 + (br ? 1536 : 0) + c0, o);
            }
    }
}

__device__ __forceinline__ void phase_ln1(Frame& F, int l) {
    const int nrows = (l == 0) ? NROW : NTOK, ngroups = nrows / 64;
    const float* lg = F.p.ln_g + (size_t)(l * 2 + 0) * DM; const float* lbb = F.p.ln_b + (size_t)(l * 2 + 0) * DM;
    float* part = F.smf;
    const int wv = __builtin_amdgcn_readfirstlane(F.wave);
    float* stg = F.smf + 8 * 36 * 64 + wv * (64 * 17 + 16 * 40);
    float* wl = stg + 64 * 17;
    for (int grp = F.bid; grp < ngroups; grp += F.nb) {
        const int row0 = grp * 64, rb = row_batch(row0);
        const float* mv = F.modv() + ((size_t)l * 5 + rb) * 6144;
        float* xg = row0 < NTOK ? F.p.out + (size_t)row0 * DM : F.cxm() + (size_t)(row0 - NTOK) * DM;
#pragma unroll 1
        for (int rr = 0; rr < 8; rr += 2) {
            const int lr = wv * 8 + rr; float* xr = xg + (size_t)lr * DM;
            f32x4 v[2][4]; float s[2] = {0.f, 0.f};
#pragma unroll
            for (int q = 0; q < 2; ++q)
#pragma unroll
                for (int j = 0; j < 4; ++j) v[q][j] = *(const f32x4*)(xr + (size_t)q * DM + j * 256 + F.lane * 4);
#pragma unroll
            for (int q = 0; q < 2; ++q)
#pragma unroll
                for (int j = 0; j < 4; ++j) s[q] += (v[q][j].x + v[q][j].y) + (v[q][j].z + v[q][j].w);
#pragma unroll
            for (int o = 1; o < 64; o <<= 1) { s[0] += __shfl_xor(s[0], o); s[1] += __shfl_xor(s[1], o); }
            float s2[2] = {0.f, 0.f};
#pragma unroll
            for (int q = 0; q < 2; ++q) { const float mean = s[q] * (1.f / DM);
#pragma unroll
                for (int j = 0; j < 4; ++j) { v[q][j] = v[q][j] - mean; s2[q] += (v[q][j].x * v[q][j].x + v[q][j].y * v[q][j].y) + (v[q][j].z * v[q][j].z + v[q][j].w * v[q][j].w); } }
#pragma unroll
            for (int o = 1; o < 64; o <<= 1) { s2[0] += __shfl_xor(s2[0], o); s2[1] += __shfl_xor(s2[1], o); }
#pragma unroll
            for (int j = 0; j < 4; ++j) { const int d = j * 256 + F.lane * 4;
                const f32x4 g4 = *(const f32x4*)(lg + d), b4 = *(const f32x4*)(lbb + d), m3 = *(const f32x4*)(mv + 3 * 1024 + d), m4 = *(const f32x4*)(mv + 4 * 1024 + d);
#pragma unroll
                for (int q = 0; q < 2; ++q) { const float rstd = rsqrtf(s2[q] * (1.f / DM) + LN_EPS);
                    const f32x4 xn = v[q][j] * rstd * g4 + b4;
                    *(f32x4*)(xr + (size_t)q * DM + d) = xn;
                    const f32x4 h2 = xn * (1.f + m4) + m3;
                    u32x2 o2; o2.x = pk2(h2.x, h2.y); o2.y = pk2(h2.z, h2.w);
                    *(u32x2*)(F.HX2() + (size_t)(row0 + lr + q) * DM + d) = o2; } }
        }
        __syncthreads();
        {   f32x4 acc[4][3];
#pragma unroll
            for (int mt = 0; mt < 4; ++mt)
#pragma unroll
                for (int nt = 0; nt < 3; ++nt) acc[mt][nt] = (f32x4){0.f, 0.f, 0.f, 0.f};
            const float* wgp = F.p.moe_w_group + ((size_t)l * DM + wv * 128) * 4; const float* wep = F.p.moe_w_expert + ((size_t)l * DM + wv * 128) * 32;
            const float* m3p = mv + 3 * 1024 + wv * 128; const float* m4p = mv + 4 * 1024 + wv * 128;
            const int ln = F.lane & 15, lk = F.lane >> 4;
#pragma unroll 1
            for (int dc = 0; dc < 128; dc += 16) {
                f32x4 t[4]; float bw[4][3];
#pragma unroll
                for (int i = 0; i < 4; ++i) t[i] = *(const f32x4*)(xg + (size_t)(16 * i + (F.lane >> 2)) * DM + wv * 128 + dc + (F.lane & 3) * 4);
                const f32x4 m3v = *(const f32x4*)(m3p + dc + (F.lane & 3) * 4), m4v = *(const f32x4*)(m4p + dc + (F.lane & 3) * 4);
#pragma unroll
                for (int ks = 0; ks < 4; ++ks) { const int d = dc + 4 * ks + lk; bw[ks][0] = wep[(size_t)d * 32 + ln]; bw[ks][1] = wep[(size_t)d * 32 + 16 + ln]; bw[ks][2] = (ln < 4) ? wgp[(size_t)d * 4 + ln] : 0.f; }
#pragma unroll
                for (int i = 0; i < 4; ++i) { float* sp = stg + (16 * i + (F.lane >> 2)) * 17 + (F.lane & 3) * 4;
                    sp[0] = t[i].x * (1.f + m4v.x) + m3v.x; sp[1] = t[i].y * (1.f + m4v.y) + m3v.y; sp[2] = t[i].z * (1.f + m4v.z) + m3v.z; sp[3] = t[i].w * (1.f + m4v.w) + m3v.w; }
                asm volatile("s_waitcnt lgkmcnt(0)" ::: "memory");
#pragma unroll
                for (int ks = 0; ks < 4; ++ks)
#pragma unroll
                    for (int mt = 0; mt < 4; ++mt) { const float av = stg[(16 * mt + ln) * 17 + 4 * ks + lk];
#pragma unroll
                        for (int nt = 0; nt < 3; ++nt) acc[mt][nt] = __builtin_amdgcn_mfma_f32_16x16x4f32(av, bw[ks][nt], acc[mt][nt], 0, 0, 0); }
                asm volatile("s_waitcnt lgkmcnt(0)" ::: "memory");
            }
#pragma unroll
            for (int mt = 0; mt < 4; ++mt)
#pragma unroll
                for (int nt = 0; nt < 3; ++nt) { const int oi = (nt == 2) ? ln : 4 + 16 * nt + ln;
                    if (nt < 2 || ln < 4) {
#pragma unroll
                        for (int r = 0; r < 4; ++r) part[(wv * 36 + oi) * 64 + 16 * mt + 4 * lk + r] = acc[mt][nt][r]; } }
        }
        __syncthreads();
        if (wv == 0) {
            const int row = row0 + F.lane;
            float gl[4]; int gi = 0; float gm = -3.4e38f;
#pragma unroll
            for (int o = 0; o < 4; ++o) { float t = F.p.moe_b_group[l * 4 + o];
#pragma unroll
                for (int w2 = 0; w2 < 8; ++w2) t += part[(w2 * 36 + o) * 64 + F.lane];
                gl[o] = t; if (t > gm) { gm = t; gi = o; } }
            float gs = 0.f;
#pragma unroll
            for (int o = 0; o < 4; ++o) gs += expf(gl[o] - gm);
            const float gwt = 1.f / gs;
            float e1 = -3.4e38f, e2 = -3.4e38f; int i1 = 0, i2 = 0;
#pragma unroll
            for (int o8 = 0; o8 < 8; ++o8) { const int o = gi * 8 + o8; float ev = F.p.moe_b_expert[l * 32 + o];
#pragma unroll
                for (int w2 = 0; w2 < 8; ++w2) ev += part[(w2 * 36 + 4 + o) * 64 + F.lane];
                if (ev > e1) { e2 = e1; i2 = i1; e1 = ev; i1 = o; } else if (ev > e2) { e2 = ev; i2 = o; } }
            const float w1 = 1.f / (1.f + expf(e2 - e1)), w2v = 1.f - w1;
            unsigned* lh = (unsigned*)(stg + 64 * 17 + 16 * 40 - 64);
            if (F.lane < 32) lh[F.lane] = 0u;
            asm volatile("s_waitcnt lgkmcnt(0)" ::: "memory");
            const unsigned r1 = atomicAdd(&lh[i1], 1u), r2 = atomicAdd(&lh[i2], 1u);
            asm volatile("s_waitcnt lgkmcnt(0)" ::: "memory");
            if (F.lane < 32) { const unsigned c = lh[F.lane]; lh[32 + F.lane] = c ? atomicAdd(&F.cnt()[l * 32 + F.lane], c) : 0u; }
            asm volatile("s_waitcnt vmcnt(0) lgkmcnt(0)" ::: "memory");
            const unsigned p1 = lh[32 + i1] + r1, p2 = lh[32 + i2] + r2;
            F.tokE()[row * 2] = i1; F.tokI()[row * 2] = (int)p1; F.tokW()[row * 2] = gwt * w1;
            F.tokE()[row * 2 + 1] = i2; F.tokI()[row * 2 + 1] = (int)p2; F.tokW()[row * 2 + 1] = gwt * w2v;
        }
        __syncthreads();
    }
}

__device__ __forceinline__ void phase_gather(Frame& F, int l) {
    int* off = (int*)F.smf; moe_offsets(F, l, off);
    const int gw = F.bid * 8 + F.wave, ngw = F.nb * 8, nrows = (l == 0) ? NROW : NTOK;
    for (int s0 = gw; s0 < 2 * nrows; s0 += 4 * ngw) {
        int sl[4], e[4], ti[4]; float tw[4]; u32x4 a0[4], a1[4];
#pragma unroll
        for (int q = 0; q < 4; ++q) { sl[q] = min(s0 + q * ngw, 2 * nrows - 1); e[q] = F.tokE()[sl[q]]; ti[q] = F.tokI()[sl[q]]; tw[q] = F.tokW()[sl[q]];
            const u32x4* src = (const u32x4*)(F.HX2() + (size_t)(sl[q] >> 1) * DM); a0[q] = src[F.lane]; a1[q] = src[F.lane + 64]; }
#pragma unroll
        for (int q = 0; q < 4; ++q) if (s0 + q * ngw < 2 * nrows) { const int dst = off[e[q]] + ti[q]; u32x4* d = (u32x4*)(F.XS() + (size_t)dst * DM);
            d[F.lane] = a0[q]; d[F.lane + 64] = a1[q];
            if (F.lane == 0) { F.rmap()[dst] = sl[q]; F.roww()[dst] = tw[q]; } }
    }
    for (int e = 0; e < 32; ++e) {
        const int c = (int)F.cnt()[l * 32 + e], pc = (c + 255) & ~255;
        for (int j = c + gw; j < pc; j += ngw) { const int dst = off[e] + j; u32x4* d = (u32x4*)(F.XS() + (size_t)dst * DM);
            const u32x4 z = {0u, 0u, 0u, 0u}; d[F.lane] = z; d[F.lane + 64] = z;
            if (F.lane == 0) { F.rmap()[dst] = -1; F.roww()[dst] = 0.f; } }
    }
}
__device__ __forceinline__ int expert_of_row(const int* off, int row) { int e = 0;
#pragma unroll 1
    for (int i = 1; i < 32; ++i) if (row >= off[i]) e = i;
    return e; }

__device__ __forceinline__ void phase_ln2(Frame& F, int l) {
    const int gw = F.bid * 8 + F.wave, ngw = F.nb * 8, npairs = ((l == 0) ? NROW : NTOK) / 2;
    const float* lg = F.p.ln_g + (size_t)(l * 2 + 1) * DM; const float* lbb = F.p.ln_b + (size_t)(l * 2 + 1) * DM;
    const bf16_t* Y = F.BR();
    const bool tmo_set = (l == DEPTH - 1) && (__hip_atomic_load((unsigned*)(F.ws + WS_CTL) + XB_TMO, __ATOMIC_RELAXED, __HIP_MEMORY_SCOPE_AGENT) != 0u);
    for (int pi = gw; pi < npairs; pi += ngw) {
        const int row0 = pi * 2, rb = row_batch(row0);
        const float* xm = row0 < NTOK ? F.p.out + (size_t)row0 * DM : F.cxm() + (size_t)(row0 - NTOK) * DM;
        float* xo = row0 < NTOK ? F.p.out + (size_t)row0 * DM : F.cxo() + (size_t)(row0 - NTOK) * DM;
        const float* mv = F.modv() + ((size_t)l * 5 + rb) * 6144;
        u32x2 y0[2][4], y1[2][4]; f32x4 xv[2][4], m5[4];
#pragma unroll
        for (int j = 0; j < 4; ++j) { const int d = j * 256 + F.lane * 4; m5[j] = *(const f32x4*)(mv + 5 * 1024 + d);
#pragma unroll
            for (int q = 0; q < 2; ++q) { y0[q][j] = *(const u32x2*)(Y + (size_t)((row0 + q) * 2) * DM + d); y1[q][j] = *(const u32x2*)(Y + (size_t)((row0 + q) * 2 + 1) * DM + d); xv[q][j] = *(const f32x4*)(xm + (size_t)q * DM + d); } }
        f32x4 v[2][4]; float s[2] = {0.f, 0.f};
#pragma unroll
        for (int q = 0; q < 2; ++q)
#pragma unroll
            for (int j = 0; j < 4; ++j) { f32x4 y; y.x = __uint_as_float(y0[q][j].x << 16) + __uint_as_float(y1[q][j].x << 16); y.y = __uint_as_float(y0[q][j].x & 0xffff0000u) + __uint_as_float(y1[q][j].x & 0xffff0000u);
                y.z = __uint_as_float(y0[q][j].y << 16) + __uint_as_float(y1[q][j].y << 16); y.w = __uint_as_float(y0[q][j].y & 0xffff0000u) + __uint_as_float(y1[q][j].y & 0xffff0000u);
                v[q][j] = ALPHA * xv[q][j] + m5[j] * y; s[q] += (v[q][j].x + v[q][j].y) + (v[q][j].z + v[q][j].w); }
#pragma unroll
        for (int o = 1; o < 64; o <<= 1) { s[0] += __shfl_xor(s[0], o); s[1] += __shfl_xor(s[1], o); }
        float s2[2] = {0.f, 0.f};
#pragma unroll
        for (int q = 0; q < 2; ++q) { const float mean = s[q] * (1.f / DM);
#pragma unroll
            for (int j = 0; j < 4; ++j) { v[q][j] = v[q][j] - mean; s2[q] += (v[q][j].x * v[q][j].x + v[q][j].y * v[q][j].y) + (v[q][j].z * v[q][j].z + v[q][j].w * v[q][j].w); } }
#pragma unroll
        for (int o = 1; o < 64; o <<= 1) { s2[0] += __shfl_xor(s2[0], o); s2[1] += __shfl_xor(s2[1], o); }
        const float* mn = F.modv() + ((size_t)((l + 1 < DEPTH) ? l + 1 : l) * 5 + rb) * 6144;
#pragma unroll
        for (int j = 0; j < 4; ++j) { const int d = j * 256 + F.lane * 4;
            const f32x4 g4 = *(const f32x4*)(lg + d), b4 = *(const f32x4*)(lbb + d), m0 = *(const f32x4*)(mn + d), m1 = *(const f32x4*)(mn + 1024 + d);
#pragma unroll
            for (int q = 0; q < 2; ++q) { const float rstd = rsqrtf(s2[q] * (1.f / DM) + LN_EPS);
                f32x4 xn = v[q][j] * rstd * g4 + b4;
                if (tmo_set) xn = xn * __uint_as_float(0x7fc00000u);
                *(f32x4*)(xo + (size_t)q * DM + d) = xn;
                if (l + 1 < DEPTH) { const f32x4 h = xn * (1.f + m1) + m0; u32x2 o2; o2.x = pk2(h.x, h.y); o2.y = pk2(h.z, h.w); *(u32x2*)(F.HX() + (size_t)(row0 + q) * DM + d) = o2; } }
        }
    }
}

constexpr int NPL = 13, NPH = 1 + DEPTH * NPL;
__global__ void __launch_bounds__(NTHR, 2) mega(Params p) {
    extern __shared__ __attribute__((aligned(16))) unsigned char smem[];
    Frame F; F.p = p; F.bid = blockIdx.x; F.nb = gridDim.x; F.tid = threadIdx.x; F.lane = threadIdx.x & 63; F.wave = threadIdx.x >> 6; F.wid_s = __builtin_amdgcn_readfirstlane(threadIdx.x >> 6);
    F.smf = (float*)(smem + LDS_STAGE);
    LAS unsigned char* stage = (LAS unsigned char*)smem + LDS_STAGE; int* offt = (int*)(smem + 64);
    unsigned char* ws = p.ws; F.ws = ws;

    if (threadIdx.x == 0) *(uint4*)smem = make_uint4(0u, 0u, 0u, 0u);
    __syncthreads();
    unsigned* barw = (unsigned*)(ws + WS_CTL);
    XcdBarrier bar; bar.bar = barw; bar.x = 0; bar.st = (volatile LAS unsigned*)smem;
    const bool multi = (p.ph_hi - p.ph_lo) > 1;
    if (multi) bar = xcd_barrier_post(barw, (volatile LAS unsigned*)smem);
    const int lo = p.ph_lo, hi = p.ph_hi;
#define IN(k) (lo <= (k) && (k) < hi)
#define SEAM(k) do { if (IN(k) && IN((k) + 1)) xcd_barrier(bar); else __syncthreads(); } while (0)

    if (IN(0)) { REFRESH(F); phase_mod(F); __syncthreads(); phase_conv_a(F, 0, F.bid * 8 + F.wave, F.nb * 8); }
    SEAM(0);
#pragma unroll 1
    for (int l = 0; l < DEPTH; ++l) {
        const int pb = 1 + l * NPL;
        const float* xlat = (l == 0) ? p.x : p.out; const float* xctx = (l == 0) ? p.ctx : F.cxo();
        const int Mrows = (l == 0) ? NROW : NTOK;
        if (l == 0) {
            if (IN(pb + 0)) { REFRESH(F); phase_prep(F, 0, p.x, p.ctx); }
            SEAM(pb + 0);
        }
        if (IN(pb + 1)) { REFRESH(F);
            float* rtab = (float*)(smem + LDS_ROPE);
            for (int e = F.tid; e < 1024; e += NTHR) { const int pp = e >> 4, i = e & 15; const float inv = powf(10000.f, -(float)i / 16.f), ang = (float)pp * inv; rtab[2 * e] = cosf(ang); rtab[2 * e + 1] = sinf(ang); }
            __syncthreads();
            pg::SchedG1 S{(const char*)F.HX(), (const char*)F.W1t(), (const char*)F.Wvt(), F.nb, F.bid}; pg::EpiG1 E{F.P1(), F.VT(), rtab, F.lb(), l};
            pg::gemm_phase(stage, DM, DM, DM, S, E);
        }
        SEAM(pb + 1);
        if (IN(pb + 2)) { REFRESH(F); phase_prescan(F, l); }
        SEAM(pb + 2);
        if (IN(pb + 3)) { REFRESH(F); phase_mix(F, l); }
        SEAM(pb + 3);
        if (IN(pb + 4)) { REFRESH(F); phase_prepad(F, l); }
        SEAM(pb + 4);
        if (IN(pb + 5)) { REFRESH(F);
            pg::SchedStatic S{(const char*)F.HX(), (const char*)F.Wgt(), (size_t)256 * DM * 2, (size_t)256 * DM * 2, Mrows / 256, NGATE / 256, F.nb, F.bid}; pg::EpiGate E{F.G()};
            pg::gemm_phase(stage, DM, DM, DM, S, E);
            __syncthreads();
            { const int nun = (Mrows / 256) * (NGATE / 256), ne = nun % F.nb, nw = (Mrows / 256) * (DM / 256);
              const bool later = nw > F.nb && 4 * (nw - F.nb) <= F.nb;
              phase_conv_b(F, l, (nun > F.nb && 2 * ne <= F.nb) ? ne : 0, later ? CONVB_MOE : 0, CONVB_MOE + CONVB_PROJ); }
        }
        SEAM(pb + 5);
        if (IN(pb + 6)) { REFRESH(F);
            pg::SchedMerge S{(const char*)F.BR(), (const char*)F.Wbrt(), (Mrows / 256) * 4, F.nb, F.bid}; pg::EpiMerge E{F.G(), F.HX(), (bf16_t*)(F.ws + WS_PM)};
            pg::gemm_phase(stage, 2048, 512, 512, S, E);
            if (S.split()) { REFRESH(F); phase_conv_b(F, l, (S.ntile - F.nb) * 4, 0, CONVB_MOE / 2); }
            if (S.split()) {
                xcd_barrier(bar);
                REFRESH(F);
                const bf16_t* pm = (const bf16_t*)(F.ws + WS_PM); bf16_t* mo = F.HX() + (size_t)NTOK * DM;
                for (int e = (F.bid * NTHR + F.tid) * 8; e < NCTX * DM; e += F.nb * NTHR * 8) {
                    u32x4 v[4];
#pragma unroll
                    for (int br = 0; br < 4; ++br) v[br] = *(const u32x4*)(pm + (size_t)br * NCTX * DM + e);
                    float a[8] = {0.f, 0.f, 0.f, 0.f, 0.f, 0.f, 0.f, 0.f};
#pragma unroll
                    for (int br = 0; br < 4; ++br) { const unsigned uu[4] = {v[br].x, v[br].y, v[br].z, v[br].w};
#pragma unroll
                        for (int j = 0; j < 4; ++j) { a[2 * j] += __uint_as_float(uu[j] << 16); a[2 * j + 1] += __uint_as_float(uu[j] & 0xffff0000u); } }
                    u32x4 o; o.x = pk2(a[0], a[1]); o.y = pk2(a[2], a[3]); o.z = pk2(a[4], a[5]); o.w = pk2(a[6], a[7]); *(u32x4*)(mo + e) = o;
                }
            }
        }
        SEAM(pb + 6);
        if (IN(pb + 7)) { REFRESH(F);
            pg::SchedStatic S{(const char*)F.HX(), (const char*)F.Woutt(), (size_t)256 * DM * 2, (size_t)256 * DM * 2, Mrows / 256, DM / 256, F.nb, F.bid};
            pg::EpiWout E{xlat, xctx, p.out, F.cxm(), F.modv() + (size_t)l * 5 * 6144};
            pg::gemm_phase(stage, DM, DM, DM, S, E);
            { const int nw = (Mrows / 256) * (DM / 256); if (nw > F.nb && 4 * (nw - F.nb) <= F.nb) { REFRESH(F); phase_conv_b(F, l, nw - F.nb, CONVB_MOE / 2, CONVB_MOE); } }
        }
        SEAM(pb + 7);
        if (IN(pb + 8)) { REFRESH(F); phase_ln1(F, l); }
        SEAM(pb + 8);
        if (IN(pb + 9)) { REFRESH(F); phase_gather(F, l); }
        SEAM(pb + 9);
        if (IN(pb + 10)) { REFRESH(F);
            moe_offsets(F, l, offt);
            pg::SchedMoe S{(const char*)F.XS(), (const char*)F.Wgu(), offt, (size_t)256 * DM * 2, (size_t)512 * DM * 2, (size_t)256 * DM * 2, offt[32] / 256, 2, F.nb, F.bid};
            pg::EpiMoe1 E{F.HID(), F.roww()};
            pg::gemm_phase(stage, DM, DM, DM, S, E);
            if (l + 1 < DEPTH) {
                const int nun = (offt[32] / 256) * 2, nu2 = nun > F.nb ? min(nun - F.nb, F.nb) : 0;
                REFRESH(F);
                if (2 * nu2 <= F.nb) { if (F.bid >= nu2) phase_conv_a(F, l + 1, (F.bid - nu2) * 8 + F.wave, (F.nb - nu2) * 8); }
                else phase_conv_a(F, l + 1, F.bid * 8 + F.wave, F.nb * 8);
            }
        }
        SEAM(pb + 10);
        if (IN(pb + 11)) { REFRESH(F);
            moe_offsets(F, l, offt);
            pg::SchedMoe S{(const char*)F.HID(), (const char*)F.Wd(), offt, (size_t)256 * 256 * 2, (size_t)DM * 256 * 2, (size_t)256 * 256 * 2, offt[32] / 256, 4, F.nb, F.bid};
            pg::EpiMoe2 E{F.BR(), F.rmap(), (bf16_t*)(F.ws + WS_DUMP)};
            pg::gemm_phase(stage, 256, 256, 256, S, E);
        }
        SEAM(pb + 11);
        if (IN(pb + 12)) { REFRESH(F); phase_ln2(F, l); }
        SEAM(pb + 12);
    }
#undef IN
#undef SEAM
}

extern "C" void kernel_launch(void* const* d_in, const int* in_sizes, int n_in, void* d_out, int out_size, void* d_ws, size_t ws_size, hipStream_t stream) {
    static int grid = 0;
    if (grid == 0) {
        if (n_in != 23 || out_size != NTOK * DM || ws_size < WS_END) { fprintf(stderr, "kernel_launch: unexpected shapes (n_in %d out %d ws %zu need %zu)\n", n_in, out_size, ws_size, (size_t)WS_END); grid = -1; return; }
        int dev = 0, cus = 0;
        if (hipGetDevice(&dev) != hipSuccess || hipDeviceGetAttribute(&cus, hipDeviceAttributeMultiprocessorCount, dev) != hipSuccess) { grid = -1; return; }
        if (hipFuncSetAttribute((const void*)mega, hipFuncAttributeMaxDynamicSharedMemorySize, LDS_BYTES) != hipSuccess) { fprintf(stderr, "kernel_launch: hipFuncSetAttribute failed\n"); grid = -1; return; }
        int per_cu = 0;
        if (hipOccupancyMaxActiveBlocksPerMultiprocessor(&per_cu, (const void*)mega, NTHR, LDS_BYTES) != hipSuccess || per_cu < 1) fprintf(stderr, "kernel_launch: occupancy query reports %d blocks per CU\n", per_cu);
        (void)hipGetLastError();
        grid = cus >= 32 ? (cus & ~31) : cus;
    }
    if (grid < 0) return;
    (void)hipMemsetAsync((char*)d_ws + WS_CTL, 0, CTL_BYTES, stream);
    Params p; memset(&p, 0, sizeof(p));
    const float** pp = (const float**)&p;
    for (int i = 0; i < 23; ++i) pp[i] = (const float*)d_in[i];
    p.out = (float*)d_out; p.ws = (unsigned char*)d_ws;
    p.ph_lo = 0; p.ph_hi = NPH;
    hipLaunchKernelGGL(mega, dim3(grid), dim3(NTHR), LDS_BYTES, stream, p);
}
```

```cpp
#include <hip/hip_runtime.h>
#include <cstdio>
#include <cstdint>
#include <cstring>

typedef unsigned short bf16_t;
typedef float f32x4 __attribute__((ext_vector_type(4)));
typedef unsigned u32x4 __attribute__((ext_vector_type(4)));
typedef unsigned u32x2 __attribute__((ext_vector_type(2)));

constexpr int NB = 4, SEQ = 4096, LC = 256, DM = 1024, DEPTH = 2;
constexpr int NTOK = NB * SEQ, NCTX = NB * LC, NROW = NTOK + NCTX;
constexpr int DIN = 10528;
constexpr int O_AQ = 0, O_AK = 256, O_AV = 512, O_AG = 1024, O_ALR = 1536, O_BQ = 1568, O_BK = 2080, O_BV = 2592, O_CQ = 3104, O_CK = 3616,
              O_CV = 3744, O_DQ = 3872, O_DF = 4384, O_DI = 5408, O_DG = 5920, O_GATE = 6432;
constexpr int PC_AQ = 0, PC_AK = 256, PC_AV = 512, PC_BQ = 1024, PC_BK = 1536, PC_CQ = 2048, PC_CK = 2560, PC_ALR = 2688, PC_DQ = 2816,
              PC_DF = 3328, PC_DI = 4352, PC_AG = 4864, PC_DG = 5376, NP1 = 5888;
constexpr float QSCALE = 0.125f * 1.44269504089f;
constexpr int NVT = 768;
constexpr int NGATE = 4096;
constexpr int XS_ROWS = 43008;
constexpr float LN_EPS = 1e-5f;
constexpr float ALPHA = 1.41421356237f;

constexpr size_t al256(size_t x) { return (x + 255) & ~(size_t)255; }
constexpr size_t WS_CTL = 0;
constexpr size_t CTL_BYTES = 32768;
constexpr size_t CTL_CNT = 28672;
constexpr size_t WS_DUMP = WS_CTL + CTL_BYTES;
constexpr size_t WS_MODV = WS_DUMP + 4096;
constexpr size_t WS_LB = WS_MODV + al256((size_t)DEPTH * 5 * 6144 * 4);
constexpr size_t WS_TOKE = WS_LB + 4096;
constexpr size_t WS_TOKI = WS_TOKE + al256((size_t)2 * NROW * 4);
constexpr size_t WS_TOKW = WS_TOKI + al256((size_t)2 * NROW * 4);
constexpr size_t WS_RMAP = WS_TOKW + al256((size_t)2 * NROW * 4);
constexpr size_t WS_ROWW = WS_RMAP + al256((size_t)XS_ROWS * 4);
constexpr size_t WS_CXM = WS_ROWW + al256((size_t)XS_ROWS * 4);
constexpr size_t WS_CXO = WS_CXM + (size_t)NCTX * DM * 4;
constexpr size_t WS_WTA = WS_CXO + (size_t)NCTX * DM * 4;
constexpr size_t WTA_W1 = 0;
constexpr size_t WTA_WV = WTA_W1 + (size_t)NP1 * DM * 2;
constexpr size_t WTA_WBR = WTA_WV + (size_t)NVT * DM * 2;
constexpr size_t WTA_WO = WTA_WBR + (size_t)4 * DM * 512 * 2;
constexpr size_t WTA_WG = WTA_WO + (size_t)DM * DM * 2;
constexpr size_t WTA_BYTES = WTA_WG + (size_t)NGATE * DM * 2;
constexpr size_t WS_SC1 = WS_WTA;
static_assert((size_t)NROW * 512 * 2 <= WTA_WG, "scan scratch must fit in front of the gate weights");
constexpr size_t WS_HX = WS_WTA + WTA_BYTES;
constexpr size_t WS_VT = WS_HX + (size_t)NROW * DM * 2;
constexpr size_t WS_OBA = WS_VT + (size_t)NVT * NROW * 2;
constexpr size_t WS_HX2 = WS_VT;
constexpr size_t WS_ODH = WS_OBA + (size_t)NROW * 512 * 2;
constexpr size_t WS_BR = WS_ODH + (size_t)NROW * 1024 * 2;
constexpr size_t WS_P1 = WS_BR + (size_t)NROW * 2048 * 2;
constexpr size_t WS_HID = WS_P1;
constexpr size_t WS_G = WS_P1;
constexpr size_t WS_WGU = WS_P1 + (size_t)NROW * NGATE * 2;
constexpr size_t WS_WD = WS_WGU + (size_t)32 * 512 * DM * 2;
constexpr size_t WS_PM = WS_WD + (size_t)32 * DM * 256 * 2;
constexpr size_t WS_XS = WS_P1;
constexpr size_t WS_ESC = WS_P1 + (size_t)NROW * NP1 * 2;
constexpr size_t WS_END = WS_ESC + (size_t)32 * 68 * 384 * 4;
static_assert(WS_PM + (size_t)4 * NCTX * DM * 2 <= WS_ESC, "moe weights must fit in the P1 tail");
static_assert((size_t)XS_ROWS * DM * 2 <= (size_t)NROW * NGATE * 2, "XS must fit in the G region");
static_assert((size_t)NVT * NROW * 2 + (size_t)NROW * 512 * 2 >= (size_t)NROW * DM * 2, "HX2 alias");
static_assert(WS_END <= 434800000ull, "workspace budget");

constexpr int NTHR = 512;
constexpr int LDS_STAGE = 1024;
constexpr int LDS_ROPE = 1024 + 131072 + 1024;
constexpr int LDS_BYTES = 144 * 1024;

struct Params {
    const float *x, *c, *ctx, *c_ctx, *w_mod, *b_mod, *w_in, *gla_lr_w, *gla_lr_b, *hg_gamma, *na_rpb, *wa_sink, *w_branch, *w_out, *ln_g, *ln_b,
        *moe_w_group, *moe_b_group, *moe_w_expert, *moe_b_expert, *moe_w_gate, *moe_w_up, *moe_w_down;
    float* out;
    unsigned char* ws;
    int ph_lo, ph_hi;
};

__device__ __forceinline__ float bf2f(bf16_t b) { return __uint_as_float(((unsigned)b) << 16); }
__device__ __forceinline__ bf16_t f2bf(float f) { unsigned u = __float_as_uint(f); u += 0x7FFFu + ((u >> 16) & 1u); return (bf16_t)(u >> 16); }
typedef float f32x2_t __attribute__((ext_vector_type(2)));
typedef __bf16 bf16x2_t __attribute__((ext_vector_type(2)));
__device__ __forceinline__ unsigned pk2(float lo, float hi) {
    const f32x2_t v = {lo, hi}; const bf16x2_t b = __builtin_convertvector(v, bf16x2_t); return __builtin_bit_cast(unsigned, b); }
__device__ __forceinline__ void ld8(const bf16_t* p, float* f) {
    const u32x4 v = *(const u32x4*)p;
    f[0] = __uint_as_float(v.x << 16); f[1] = __uint_as_float(v.x & 0xffff0000u);
    f[2] = __uint_as_float(v.y << 16); f[3] = __uint_as_float(v.y & 0xffff0000u);
    f[4] = __uint_as_float(v.z << 16); f[5] = __uint_as_float(v.z & 0xffff0000u);
    f[6] = __uint_as_float(v.w << 16); f[7] = __uint_as_float(v.w & 0xffff0000u);
}
__device__ __forceinline__ void st8(bf16_t* p, const float* f) {
    u32x4 v; v.x = pk2(f[0], f[1]); v.y = pk2(f[2], f[3]); v.z = pk2(f[4], f[5]); v.w = pk2(f[6], f[7]);
    *(u32x4*)p = v;
}
__device__ __forceinline__ float sigmoidf_(float x) { return __builtin_amdgcn_rcpf(1.f + __expf(-x)); }
__device__ __forceinline__ float siluf_(float x) { return x * __builtin_amdgcn_rcpf(1.f + __expf(-x)); }
__device__ __forceinline__ float wave_sum(float v) {
#pragma unroll
    for (int o = 1; o < 64; o <<= 1) v += __shfl_xor(v, o);
    return v;
}
__device__ __forceinline__ int row_batch(int row) { return row < NTOK ? (row >> 12) : 4; }

#define XB_TMO      128
#define XB_XCNT(j)  (256  + 64 * (j))
#define XB_XSUB(j)  (1280 + 64 * (j))
#define XB_XGEN(j)  (2304 + 64 * (j))
#define XB_TOP      3328
#define XB_TOPGEN   3392
#define XCD_BAR_WORDS 3456
#define XB_SPIN_CAP (1u << 18)
#define LAS __attribute__((address_space(3)))
__device__ __forceinline__ unsigned xb_ld(unsigned* p)              { return __hip_atomic_load(p, __ATOMIC_RELAXED, __HIP_MEMORY_SCOPE_AGENT); }
__device__ __forceinline__ unsigned xb_add(unsigned* p, unsigned v) { return __hip_atomic_fetch_add(p, v, __ATOMIC_RELAXED, __HIP_MEMORY_SCOPE_AGENT); }
__device__ __forceinline__ unsigned xb_xcc_id() { return (unsigned)__builtin_amdgcn_s_getreg((3 << 11) | 20) & 0xFu; }
#define XB_SPIN(cond, bar) do { unsigned _sp = 0; while (cond) { __builtin_amdgcn_s_sleep(1); \
    if ((++_sp & 255u) == 0u) { if (xb_ld(&(bar)[XB_TMO])) break; if (_sp > XB_SPIN_CAP) { atomicAdd(&(bar)[XB_TMO], 1u); break; } } } } while (0)
struct XcdBarrier { unsigned* bar; unsigned x; volatile LAS unsigned* st; };
__device__ __forceinline__ XcdBarrier xcd_barrier_post(unsigned* bar, volatile LAS unsigned* st) {
    XcdBarrier b; b.bar = bar; b.x = xb_xcc_id(); b.st = st;
    if (threadIdx.x == 0) (void)xb_add(&bar[XB_XCNT(b.x)], 1u);
    return b;
}
__device__ __forceinline__ void xcd_barrier_complete(unsigned* bar, unsigned x, unsigned& nloc, unsigned& nx) {
    const unsigned G = gridDim.x * gridDim.y * gridDim.z;
    unsigned sum, cnt, mine, sp = 0u;
    for (;;) {
        sum = 0u; cnt = 0u; mine = 0u;
#pragma unroll
        for (unsigned j = 0; j < 16; ++j) { const unsigned c = xb_ld(&bar[XB_XCNT(j)]); sum += c; cnt += (c > 0u) ? 1u : 0u; mine = (j == x) ? c : mine; }
        if (sum == G) break;
        __builtin_amdgcn_s_sleep(1);
        if ((++sp & 255u) == 0u) { if (xb_ld(&bar[XB_TMO])) break; if (sp > XB_SPIN_CAP) { atomicAdd(&bar[XB_TMO], 1u); break; } }
    }
    nloc = mine > 0u ? mine : 1u; nx = cnt > 0u ? cnt : 1u;
}
__device__ __forceinline__ void xcd_barrier(const XcdBarrier& b) {
    asm volatile("s_waitcnt vmcnt(0)" ::: "memory");
    __syncthreads();
    if (threadIdx.x == 0) {
        unsigned* bar = b.bar;
        __builtin_amdgcn_s_waitcnt(0);
        unsigned nloc = b.st[0], nx = b.st[1];
        if (nloc == 0u) { xcd_barrier_complete(bar, b.x, nloc, nx); b.st[0] = nloc; b.st[1] = nx; }
        const unsigned old = xb_add(&bar[XB_XSUB(b.x)], 1u);
        const unsigned gen = old / nloc;
        if (old + 1u == (gen + 1u) * nloc) {
            __builtin_amdgcn_fence(__ATOMIC_RELEASE, "agent");
            asm volatile("s_waitcnt vmcnt(0)" ::: "memory");
            const unsigned og = xb_add(&bar[XB_TOP], 1u);
            const unsigned tg = og / nx;
            if (og + 1u == (tg + 1u) * nx) xb_add(&bar[XB_TOPGEN], 1u);
            else XB_SPIN(xb_ld(&bar[XB_TOPGEN]) == tg, bar);
            __builtin_amdgcn_fence(__ATOMIC_ACQUIRE, "agent");
            xb_add(&bar[XB_XGEN(b.x)], 1u);
            asm volatile("s_waitcnt vmcnt(0)" ::: "memory");
        } else {
            XB_SPIN(xb_ld(&bar[XB_XGEN(b.x)]) == gen, bar);
            __builtin_amdgcn_fence(__ATOMIC_ACQUIRE, "agent");
            asm volatile("s_waitcnt vmcnt(0)" ::: "memory");
        }
    }
    __syncthreads();
}

struct Frame {
    Params p;
    int bid, nb, tid, lane, wave, wid_s;
    float* smf;
    unsigned char* ws;
    __device__ __forceinline__ float* modv() const { return (float*)(ws + WS_MODV); }
    __device__ __forceinline__ float* lb() const { return (float*)(ws + WS_LB); }
    __device__ __forceinline__ int* tokE() const { return (int*)(ws + WS_TOKE); }
    __device__ __forceinline__ int* tokI() const { return (int*)(ws + WS_TOKI); }
    __device__ __forceinline__ float* tokW() const { return (float*)(ws + WS_TOKW); }
    __device__ __forceinline__ int* rmap() const { return (int*)(ws + WS_RMAP); }
    __device__ __forceinline__ float* roww() const { return (float*)(ws + WS_ROWW); }
    __device__ __forceinline__ float* cxm() const { return (float*)(ws + WS_CXM); }
    __device__ __forceinline__ float* cxo() const { return (float*)(ws + WS_CXO); }
    __device__ __forceinline__ bf16_t* W1t() const { return (bf16_t*)(ws + WS_WTA + WTA_W1); }
    __device__ __forceinline__ bf16_t* Wvt() const { return (bf16_t*)(ws + WS_WTA + WTA_WV); }
    __device__ __forceinline__ bf16_t* Wgt() const { return (bf16_t*)(ws + WS_WTA + WTA_WG); }
    __device__ __forceinline__ bf16_t* Wbrt() const { return (bf16_t*)(ws + WS_WTA + WTA_WBR); }
    __device__ __forceinline__ bf16_t* Woutt() const { return (bf16_t*)(ws + WS_WTA + WTA_WO); }
    __device__ __forceinline__ bf16_t* SC1() const { return (bf16_t*)(ws + WS_SC1); }
    __device__ __forceinline__ float* ESC() const { return (float*)(ws + WS_ESC); }
    __device__ __forceinline__ bf16_t* HX() const { return (bf16_t*)(ws + WS_HX); }
    __device__ __forceinline__ bf16_t* VT() const { return (bf16_t*)(ws + WS_VT); }
    __device__ __forceinline__ bf16_t* OBA() const { return (bf16_t*)(ws + WS_OBA); }
    __device__ __forceinline__ bf16_t* HX2() const { return (bf16_t*)(ws + WS_HX2); }
    __device__ __forceinline__ bf16_t* HID() const { return (bf16_t*)(ws + WS_HID); }
    __device__ __forceinline__ bf16_t* ODH() const { return (bf16_t*)(ws + WS_ODH); }
    __device__ __forceinline__ bf16_t* BR() const { return (bf16_t*)(ws + WS_BR); }
    __device__ __forceinline__ bf16_t* P1() const { return (bf16_t*)(ws + WS_P1); }
    __device__ __forceinline__ bf16_t* G() const { return (bf16_t*)(ws + WS_G); }
    __device__ __forceinline__ bf16_t* Wgu() const { return (bf16_t*)(ws + WS_WGU); }
    __device__ __forceinline__ bf16_t* Wd() const { return (bf16_t*)(ws + WS_WD); }
    __device__ __forceinline__ bf16_t* XS() const { return (bf16_t*)(ws + WS_XS); }
    __device__ __forceinline__ unsigned* cnt() const { return (unsigned*)(ws + WS_CTL + CTL_CNT); }
};


#define REFRESH(F) do { int _t = threadIdx.x; asm volatile("" : "+v"(_t)); (F).tid = _t; (F).lane = _t & 63; (F).wave = _t >> 6; } while (0)

__device__ __forceinline__ void phase_mod(Frame& F) {
    float* sc = F.smf;
    float* red = F.smf + 5 * 1024;
    bool have = false;
    for (int it = F.bid; it < DEPTH * 96; it += F.nb) {
        if (!have) {
            for (int i = F.tid; i < 5 * 1024; i += NTHR) { const float v = (i < 4096) ? F.p.c[i] : F.p.c_ctx[i - 4096]; sc[i] = siluf_(v); }
            __syncthreads(); have = true;
        }
        const int l = it / 96, n0 = (it % 96) * 64, col = F.tid & 63, kg = F.tid >> 6;
        const float* w = F.p.w_mod + (size_t)l * DM * 6144 + n0 + col;
        float a[5] = {0.f, 0.f, 0.f, 0.f, 0.f};
        for (int k = kg * 128; k < kg * 128 + 128; ++k) {
            const float wv = w[(size_t)k * 6144];
#pragma unroll
            for (int r = 0; r < 5; ++r) a[r] += sc[r * 1024 + k] * wv;
        }
#pragma unroll
        for (int r = 0; r < 5; ++r) red[(kg * 5 + r) * 64 + col] = a[r];
        __syncthreads();
        if (F.tid < 320) {
            const int r = F.tid >> 6, cc = F.tid & 63; float s = F.p.b_mod[l * 6144 + n0 + cc];
#pragma unroll
            for (int g = 0; g < 8; ++g) s += red[(g * 5 + r) * 64 + cc];
            F.modv()[((size_t)l * 5 + r) * 6144 + n0 + cc] = s;
        }
        __syncthreads();
    }
    if (F.bid == F.nb - 1) {
        for (int i = F.tid; i < 1024; i += NTHR) { const int z = i >> 9, f = i & 511;
            const float g0 = F.p.hg_gamma[(z * DEPTH + 0) * 512 + f], g1 = F.p.hg_gamma[(z * DEPTH + 1) * 512 + f];
            F.lb()[i] = 1.f / (1.f + expf(g0 - g1)); }
    }
}

__device__ __forceinline__ int p1_src(int n, float& scale) {
    scale = 1.f;
    if (n < 256) { scale = 0.125f; return O_AQ + n; }
    if (n < 512) return O_AK + (n - 256);
    if (n < 1024) return O_AV + (n - 512);
    if (n < 1536) { scale = QSCALE; return O_BQ + (n - 1024); }
    if (n < 2048) return O_BK + (n - 1536);
    if (n < 2560) { scale = QSCALE; return O_CQ + (n - 2048); }
    if (n < 2688) return O_CK + (n - 2560);
    if (n < 2720) return O_ALR + (n - 2688);
    if (n < 2816) return -1;
    if (n < 3328) return O_DQ + (n - 2816);
    if (n < 4352) return O_DF + (n - 3328);
    if (n < 4864) return O_DI + (n - 4352);
    if (n < 5376) return O_AG + (n - 4864);
    return O_DG + (n - 5376);
}
__device__ __forceinline__ void conv_item(const float* src, int ldsrc, int srccol, float scale, bf16_t* dst, int K, int k0, float* scr, int lane, bool perm) {
    if (srccol >= 0) {
#pragma unroll 8
        for (int i = 0; i < 32; ++i) { const int kk = 2 * i + (lane >> 5); scr[kk * 33 + (lane & 31)] = src[(size_t)(k0 + kk) * ldsrc + srccol + (lane & 31)] * scale; }
    } else {
#pragma unroll 8
        for (int i = 0; i < 32; ++i) { const int kk = 2 * i + (lane >> 5); scr[kk * 33 + (lane & 31)] = 0.f; }
    }
    asm volatile("s_waitcnt lgkmcnt(0)" ::: "memory");
    const int c = lane & 7;
#pragma unroll
    for (int j = 0; j < 4; ++j) { const int nn = (lane >> 3) + 8 * j; const float* sp = scr + (8 * c) * 33 + (perm ? (8 * ((nn & 15) >> 2) + 4 * (nn >> 4) + (nn & 3)) : nn);
        u32x4 o; o.x = pk2(sp[0 * 33], sp[1 * 33]); o.y = pk2(sp[2 * 33], sp[3 * 33]); o.z = pk2(sp[4 * 33], sp[5 * 33]); o.w = pk2(sp[6 * 33], sp[7 * 33]);
        *(u32x4*)(dst + (size_t)nn * K + 8 * c) = o; }
    asm volatile("s_waitcnt lgkmcnt(0)" ::: "memory");
}
constexpr int CONVA_W1 = (NP1 / 32) * 16;
constexpr int CONVA_ITEMS = CONVA_W1 + 384 + 2048;
__device__ __forceinline__ void phase_conv_a(Frame& F, int l, int gw, int ngw) {
    float* scr = F.smf + F.wave * (64 * 33);
    for (int it0 = gw; it0 < CONVA_ITEMS; it0 += ngw) {
        int ti = it0;
        if (ti < CONVA_W1) { const int n0 = (ti >> 4) * 32, kt = ti & 15; float sc; const int sx = p1_src(n0, sc);
            conv_item(F.p.w_in + (size_t)l * DM * DIN, DIN, sx, sc, F.W1t() + (size_t)n0 * DM + kt * 64, DM, kt * 64, scr, F.lane, !(n0 >= 2048 && n0 < 2816)); continue; }
        ti -= CONVA_W1;
        if (ti < 384) { const int n0 = (ti >> 4) * 32, kt = ti & 15; const int sx = n0 < 512 ? O_BV + n0 : (n0 < 640 ? O_CV + (n0 - 512) : -1);
            conv_item(F.p.w_in + (size_t)l * DM * DIN, DIN, sx, 1.f, F.Wvt() + (size_t)n0 * DM + kt * 64, DM, kt * 64, scr, F.lane, false); continue; }
        ti -= 384;
        { const int n0 = (ti >> 4) * 32, kt = ti & 15;
          conv_item(F.p.w_in + (size_t)l * DM * DIN, DIN, O_GATE + n0, 1.f, F.Wgt() + (size_t)n0 * DM + kt * 64, DM, kt * 64, scr, F.lane, true); }
    }
}
constexpr int CONVB_MOE = 8192 + 4096, CONVB_PROJ = 1024 + 512;
__device__ __forceinline__ void phase_conv_b(Frame& F, int l, int n_skip, int lo, int hi) {
    float* scr = F.smf + F.wave * (64 * 33);
    if (F.bid < n_skip) return;
    const int gw = (F.bid - n_skip) * 8 + F.wave, ngw = (F.nb - n_skip) * 8;
    for (int it0 = lo + gw; it0 < hi; it0 += ngw) {
        int ti = it0;
        if (ti < 8192) { const int e = ti >> 8, r = ti & 255, n0 = (r >> 4) * 32, kt = r & 15, j = n0 >> 8, rr = n0 & 255; const bool isup = rr >= 128; const int cc = 128 * j + (rr & 127);
            const float* src = (isup ? F.p.moe_w_up : F.p.moe_w_gate) + (size_t)(l * 32 + e) * DM * 256;
            conv_item(src, 256, cc, 1.f, F.Wgu() + (size_t)e * 512 * DM + (size_t)n0 * DM + kt * 64, DM, kt * 64, scr, F.lane, true); continue; }
        ti -= 8192;
        if (ti < 4096) { const int e = ti >> 7, r = ti & 127, n0 = (r >> 2) * 32, kt = r & 3;
          conv_item(F.p.moe_w_down + (size_t)(l * 32 + e) * 256 * DM, DM, n0, 1.f, F.Wd() + (size_t)e * DM * 256 + (size_t)n0 * 256 + kt * 64, 256, kt * 64, scr, F.lane, true); continue; }
        ti -= 4096;
        if (ti < 1024) { const int i = ti >> 8, r = ti & 255, n0 = (r >> 3) * 32, kt = r & 7;
            conv_item(F.p.w_branch + (size_t)(l * 4 + i) * 512 * DM, DM, n0, 1.f, F.Wbrt() + (size_t)i * DM * 512 + (size_t)n0 * 512 + kt * 64, 512, kt * 64, scr, F.lane, true); continue; }
        ti -= 1024;
        { const int n0 = (ti >> 4) * 32, kt = ti & 15;
          conv_item(F.p.w_out + (size_t)l * DM * DM, DM, n0, 1.f, F.Woutt() + (size_t)n0 * DM + kt * 64, DM, kt * 64, scr, F.lane, false); }
    }
}

__device__ __forceinline__ void phase_prep(Frame& F, int l, const float* xlat, const float* xctx) {
    const int gw = F.bid * 8 + F.wave, ngw = F.nb * 8;
    for (int row = gw; row < NROW; row += ngw) {
        const float* xr = row < NTOK ? xlat + (size_t)row * DM : xctx + (size_t)(row - NTOK) * DM;
        const float* mv = F.modv() + ((size_t)l * 5 + row_batch(row)) * 6144;
#pragma unroll
        for (int j = 0; j < 4; ++j) { const int d = j * 256 + F.lane * 4;
            const f32x4 v = *(const f32x4*)(xr + d), m0 = *(const f32x4*)(mv + d), m1 = *(const f32x4*)(mv + 1024 + d);
            u32x2 o; o.x = pk2(v.x * (1.f + m1.x) + m0.x, v.y * (1.f + m1.y) + m0.y); o.y = pk2(v.z * (1.f + m1.z) + m0.z, v.w * (1.f + m1.w) + m0.w);
            *(u32x2*)(F.HX() + (size_t)row * DM + d) = o; }
    }
}


namespace pg {
typedef short bf16x8 __attribute__((ext_vector_type(8)));
constexpr int BM = 256, BK = 64, HALF = 128, HTB = HALF * BK * 2, STAGE_BYTES = 8 * HTB, NXCD = 8, WGM = 8;
__device__ __forceinline__ int lds_byte(int r, int c) { const int st = (r >> 4) * 2 + (c >> 5), rr = r & 15, cc = c & 31, ob = rr * 64 + cc * 2; return st * 1024 + (ob ^ (((ob >> 9) & 1) << 5)); }
__device__ __forceinline__ void stage_rc(int b, int& R, int& C) { const int st = b / 1024, sb = b % 1024, swz = sb ^ (((sb >> 9) & 1) << 5); R = (st >> 1) * 16 + swz / 64; C = (st & 1) * 32 + (swz % 64) / 2; }
struct Unit { const char* a; const char* b; int pm, pn, aux; };
__device__ __forceinline__ void static_map(int L, int nM, int nN, int& pm, int& pn) {
    const int nwg = nM * nN; int wgid = L; { const int q = nwg / NXCD, r = nwg % NXCD, xcd = wgid % NXCD, off = wgid / NXCD; wgid = (xcd < r ? xcd * (q + 1) : r * (q + 1) + (xcd - r) * q) + off; }
    const int nig = WGM * nN, gid = wgid / nig, fm = gid * WGM, gsz = (nM - fm) < WGM ? (nM - fm) : WGM;
    pm = fm + ((wgid % nig) % gsz); pn = (wgid % nig) / gsz;
}
template <class Epi, class Sched>
__device__ __forceinline__ void gemm_phase(LAS unsigned char* lds, const int lda, const int ldb, const int K, const Sched& S, const Epi& E) {
    int tid = threadIdx.x; asm volatile("" : "+v"(tid));
    const int wid = __builtin_amdgcn_readfirstlane(tid >> 6), lane = tid & 63, wr = wid >> 2, wc = wid & 3, fr = lane & 15, fq = lane >> 4;
    int nt = K / BK; asm volatile("" : "+s"(nt));
    constexpr bool GATHER = Sched::gather;
    unsigned voffA[2], voffB[2], vgA[2][2], vgN[2][2]; int RA_[2], CA_[2];
#pragma unroll
    for (int i = 0; i < 2; ++i) { int R, C; stage_rc(tid * 16 + i * 8192, R, C); voffA[i] = (unsigned)(R * lda + C) * 2u; voffB[i] = (unsigned)(R * ldb + C) * 2u; RA_[i] = R; CA_[i] = C;
        vgA[0][i] = vgA[1][i] = vgN[0][i] = vgN[1][i] = 0u; }
#define PG_GSET(vg, u) do { _Pragma("unroll") for (int _h = 0; _h < 2; ++_h) _Pragma("unroll") for (int _i = 0; _i < 2; ++_i) \
        vg[_h][_i] = (unsigned)S.rowidx((u).pm * BM + _h * HALF + RA_[_i]) * (unsigned)(lda * 2) + (unsigned)(CA_[_i] * 2); } while (0)
    const size_t kstep = (size_t)(BK * 2);
    const size_t hstepA = (size_t)HALF * lda * 2, hstepB = (size_t)HALF * ldb * 2;
    const unsigned ldsw = (unsigned)wid * 1024u;
    const int aoff = lds_byte(wr * 64 + fr, fq * 8), boff = lds_byte(wc * 32 + fr, fq * 8);
#define PG_SA(b, h) (((b) * 2 + (h)) * HTB)
#define PG_SB(b, h) ((4 + (b) * 2 + (h)) * HTB)
#define PG_STAGE(bufoff, gbase, voff) do { _Pragma("unroll") for (int _i = 0; _i < 2; ++_i) \
        __builtin_amdgcn_global_load_lds((const unsigned*)((const char*)(gbase) + (voff)[_i]), (LAS unsigned*)(lds + (bufoff) + ldsw + _i * 8192), 16, 0, 0); } while (0)
#define PG_STAGE_A(bufoff, base, h, nx) do { if (GATHER) { const unsigned _v[2] = {(nx) ? vgN[h][0] : vgA[h][0], (nx) ? vgN[h][1] : vgA[h][1]}; PG_STAGE(bufoff, base, _v); } \
        else { PG_STAGE(bufoff, (base) + (h) * hstepA, voffA); } } while (0)
#define PG_LDA(dst, b, h) do { _Pragma("unroll") for (int m = 0; m < 4; ++m) _Pragma("unroll") for (int k = 0; k < 2; ++k) dst[m][k] = *(const LAS bf16x8*)(lds + PG_SA(b, h) + aoff + m * 2048 + k * 1024); } while (0)
#define PG_LDB(dst, b, h) do { _Pragma("unroll") for (int n = 0; n < 2; ++n) _Pragma("unroll") for (int k = 0; k < 2; ++k) dst[n][k] = *(const LAS bf16x8*)(lds + PG_SB(b, h) + boff + n * 2048 + k * 1024); } while (0)
#define PG_MMA(ai, bj, At, Bt) do { __builtin_amdgcn_s_setprio(1); _Pragma("unroll") for (int m = 0; m < 4; ++m) _Pragma("unroll") for (int n = 0; n < 2; ++n) _Pragma("unroll") for (int k = 0; k < 2; ++k) \
        acc[ai][bj][m][n] = __builtin_amdgcn_mfma_f32_16x16x32_bf16(Bt[n][k], At[m][k], acc[ai][bj][m][n], 0, 0, 0); __builtin_amdgcn_s_setprio(0); } while (0)
#define PG_WAIT_V(n) asm volatile("s_waitcnt vmcnt(" #n ")" ::: "memory")
#define PG_WAIT_L(n) asm volatile("s_waitcnt lgkmcnt(" #n ")" ::: "memory")
#define PG_BAR __builtin_amdgcn_s_barrier()
#define PG_SCHED __builtin_amdgcn_sched_barrier(0)
    Unit cur, nxt; int ui = 0;
    if (!S.next(0, cur)) return;
    f32x4 acc[2][2][4][2];
#pragma unroll
    for (int a = 0; a < 2; ++a)
#pragma unroll
        for (int b = 0; b < 2; ++b)
#pragma unroll
            for (int m = 0; m < 4; ++m)
#pragma unroll
                for (int n = 0; n < 2; ++n) acc[a][b][m][n] = (f32x4){0.f, 0.f, 0.f, 0.f};
    bf16x8 At[4][2], B0[2][2], B1[2][2];
    const char* cA = cur.a; const char* cB = cur.b;
    if (GATHER) PG_GSET(vgA, cur);
    PG_STAGE(PG_SB(0, 0), cB, voffB); PG_STAGE_A(PG_SA(0, 0), cA, 0, false); PG_STAGE(PG_SB(0, 1), cB + hstepB, voffB); PG_STAGE_A(PG_SA(0, 1), cA, 1, false);
    if (wr == 1) PG_BAR;
    PG_WAIT_V(4); PG_BAR;
    PG_STAGE(PG_SB(1, 0), cB + kstep, voffB); PG_STAGE_A(PG_SA(1, 0), cA + kstep, 0, false); PG_STAGE(PG_SB(1, 1), cB + hstepB + kstep, voffB);
    PG_WAIT_V(6); PG_BAR;
    for (;;) {
        const bool has_next = S.next(ui + 1, nxt);
        const char* nA = has_next ? nxt.a : cA; const char* nB = has_next ? nxt.b : cB;
        if (GATHER) { if (has_next) PG_GSET(vgN, nxt); else { vgN[0][0] = vgA[0][0]; vgN[0][1] = vgA[0][1]; vgN[1][0] = vgA[1][0]; vgN[1][1] = vgA[1][1]; } }
        for (int t = 0; t < nt; t += 2) {
            const bool last = (t == nt - 2);
            const char* a1 = cA + (size_t)(t + 1) * kstep;
            const char* a2 = last ? nA : cA + (size_t)(t + 2) * kstep; const char* b2 = last ? nB : cB + (size_t)(t + 2) * kstep;
            const char* a3 = a2 + kstep; const char* b3 = b2 + kstep;
            PG_LDB(B0, 0, 0); PG_SCHED; PG_LDA(At, 0, 0); PG_STAGE_A(PG_SA(1, 1), a1, 1, false);
            PG_WAIT_L(8); PG_BAR; PG_WAIT_L(0); PG_MMA(0, 0, At, B0); PG_BAR; PG_SCHED;
            PG_LDB(B1, 0, 1); PG_STAGE(PG_SB(0, 0), b2, voffB);
            PG_BAR; PG_WAIT_L(0); PG_MMA(0, 1, At, B1); PG_BAR;
            PG_LDA(At, 0, 1); PG_STAGE_A(PG_SA(0, 0), a2, 0, last);
            PG_BAR; PG_WAIT_L(0); PG_MMA(1, 0, At, B0); PG_BAR; PG_SCHED;
            PG_STAGE(PG_SB(0, 1), b2 + hstepB, voffB);
            PG_WAIT_V(6); PG_BAR; PG_MMA(1, 1, At, B1); PG_BAR;
            PG_LDB(B0, 1, 0); PG_SCHED; PG_LDA(At, 1, 0); PG_STAGE_A(PG_SA(0, 1), a2, 1, last);
            PG_WAIT_L(8); PG_BAR; PG_WAIT_L(0); PG_MMA(0, 0, At, B0); PG_BAR; PG_SCHED;
            PG_LDB(B1, 1, 1); PG_STAGE(PG_SB(1, 0), b3, voffB);
            PG_BAR; PG_WAIT_L(0); PG_MMA(0, 1, At, B1); PG_BAR;
            PG_LDA(At, 1, 1); PG_STAGE_A(PG_SA(1, 0), a3, 0, last);
            PG_BAR; PG_WAIT_L(0); PG_MMA(1, 0, At, B0); PG_BAR; PG_SCHED;
            PG_STAGE(PG_SB(1, 1), b3 + hstepB, voffB);
            PG_WAIT_V(6); PG_BAR; PG_MMA(1, 1, At, B1); PG_BAR;
        }
        E(acc, cur, wr, wc, fr, fq);
        if (!has_next) break;
#pragma unroll
        for (int a = 0; a < 2; ++a)
#pragma unroll
            for (int b = 0; b < 2; ++b)
#pragma unroll
                for (int m = 0; m < 4; ++m)
#pragma unroll
                    for (int n = 0; n < 2; ++n) acc[a][b][m][n] = (f32x4){0.f, 0.f, 0.f, 0.f};
        cur = nxt; cA = nA; cB = nB; ++ui;
        if (GATHER) { vgA[0][0] = vgN[0][0]; vgA[0][1] = vgN[0][1]; vgA[1][0] = vgN[1][0]; vgA[1][1] = vgN[1][1]; }
    }
    PG_WAIT_V(0);
    if (wr == 0) PG_BAR;
    PG_BAR;
#undef PG_SA
#undef PG_SB
#undef PG_STAGE
#undef PG_STAGE_A
#undef PG_GSET
#undef PG_LDA
#undef PG_LDB
#undef PG_MMA
#undef PG_WAIT_V
#undef PG_WAIT_L
#undef PG_BAR
#undef PG_SCHED
}

struct SchedG1 {
    static constexpr bool gather = false; __device__ __forceinline__ int rowidx(int) const { return 0; }
    const char *HX, *W1, *WV; int G, c;
    __device__ __forceinline__ bool next(int i, Unit& u) const {
        const int L = i * G + c, nmain = (NROW / 256) * (NP1 / 256);
        if (L < nmain) { static_map(L, NROW / 256, NP1 / 256, u.pm, u.pn); u.a = HX + (size_t)u.pm * 256 * DM * 2; u.b = W1 + (size_t)u.pn * 256 * DM * 2; u.aux = 0; return true; }
        const int idx = L - nmain; if (idx >= 3 * (NROW / 256)) return false;
        u.pm = idx % 3; u.pn = idx / 3; u.a = WV + (size_t)u.pm * 256 * DM * 2; u.b = HX + (size_t)u.pn * 256 * DM * 2; u.aux = 1; return true;
    }
};
struct SchedStatic {
    static constexpr bool gather = false; __device__ __forceinline__ int rowidx(int) const { return 0; }
    const char *A, *B; size_t tA, tB; int nM, nN, G, c;
    __device__ __forceinline__ bool next(int i, Unit& u) const {
        const int L = i * G + c; if (L >= nM * nN) return false;
        static_map(L, nM, nN, u.pm, u.pn); u.a = A + (size_t)u.pm * tA; u.b = B + (size_t)u.pn * tB; u.aux = 0; return true;
    }
};
struct SchedMerge {
    static constexpr bool gather = false; __device__ __forceinline__ int rowidx(int) const { return 0; }
    const char *BR, *W; int ntile, G, c;
    __device__ __forceinline__ bool split() const { return ntile > G && (ntile - G) * 4 <= G; }
    __device__ __forceinline__ bool next(int i, Unit& u) const {
        int t, br;
        if (split()) { if (i < 4) { t = c; br = i; u.aux = br; } else { if (i > 4 || c >= (ntile - G) * 4) return false; t = G + (c >> 2); br = c & 3; u.aux = 4 + br; } }
        else { t = c + (i >> 2) * G; if (t >= ntile) return false; br = i & 3; u.aux = br; }
        u.pm = t >> 2; u.pn = t & 3;
        u.a = BR + (size_t)u.pm * 256 * 2048 * 2 + (size_t)br * 512 * 2; u.b = W + (size_t)br * DM * 512 * 2 + (size_t)u.pn * 256 * 512 * 2; return true;
    }
};
struct SchedMoeG {
    static constexpr bool gather = true;
    const char *A, *W; const int* off; const int* rmap; size_t wE, wT; int npan, NJ, G, c;
    __device__ __forceinline__ int rowidx(int slot) const { const int sl = rmap[slot]; return sl < 0 ? 0 : (sl >> 1); }
    __device__ __forceinline__ bool next(int i, Unit& u) const {
        const int L = i * G + c; if (L >= npan * NJ) return false;
        const int p = L / NJ, j = L % NJ; int e = 0;
#pragma unroll 1
        for (int q = 1; q < 32; ++q) if (p * 256 >= off[q]) e = q;
        e = __builtin_amdgcn_readfirstlane(e);
        u.pm = p; u.pn = j; u.aux = e; u.a = A; u.b = W + (size_t)e * wE + (size_t)j * wT; return true;
    }
};
struct SchedMoe {
    static constexpr bool gather = false; __device__ __forceinline__ int rowidx(int) const { return 0; }
    const char *A, *W; const int* off; size_t tA, wE, wT; int npan, NJ, G, c;
    __device__ __forceinline__ bool next(int i, Unit& u) const {
        const int L = i * G + c; if (L >= npan * NJ) return false;
        const int p = L / NJ, j = L % NJ; int e = 0;
#pragma unroll 1
        for (int q = 1; q < 32; ++q) if (p * 256 >= off[q]) e = q;
        e = __builtin_amdgcn_readfirstlane(e);
        u.pm = p; u.pn = j; u.aux = e; u.a = A + (size_t)p * tA; u.b = W + (size_t)e * wE + (size_t)j * wT; return true;
    }
};

#define PG_ROWCOL const int row0 = u.pm * BM + wr * 64 + fr, col0 = u.pn * BM + wc * 32 + 4 * fq
struct EpiG1 { bf16_t *P1, *VT; const float* rtab; const float* lbp; int layer;
    __device__ __forceinline__ void operator()(const f32x4 (&acc)[2][2][4][2], const Unit& u, int wr, int wc, int fr, int fq) const {
        const int row0 = u.pm * BM + wr * 64 + fr;
        if (u.aux || (u.pn >= 8 && u.pn <= 10)) {
            const int col0 = u.pn * BM + wc * 32 + 4 * fq; bf16_t* base = u.aux ? VT : P1; const size_t ld = u.aux ? (size_t)NROW : (size_t)NP1;
            const bool rope = !u.aux && (u.pm < NTOK / 256);
#pragma unroll
            for (int ai = 0; ai < 2; ++ai)
#pragma unroll
                for (int m = 0; m < 4; ++m) { const int r = row0 + ai * HALF + m * 16; bf16_t* rowp = base + (size_t)r * ld + col0;
#pragma unroll
                    for (int bj = 0; bj < 2; ++bj) {
                        f32x4 v0 = acc[ai][bj][m][0], v1 = acc[ai][bj][m][1];
                        if (rope && !(u.pn == 10 && bj == 1)) {
                            const int pos = r & (SEQ - 1), pp = (wc & 1) ? (pos & 63) : (pos >> 6); const float* tp = rtab + (pp * 16 + 4 * fq) * 2;
                            const f32x4 t0 = *(const f32x4*)tp, t1 = *(const f32x4*)(tp + 4);
                            const f32x4 a = v0, b = v1;
                            v0.x = a.x * t0.x - b.x * t0.y; v1.x = a.x * t0.y + b.x * t0.x; v0.y = a.y * t0.z - b.y * t0.w; v1.y = a.y * t0.w + b.y * t0.z;
                            v0.z = a.z * t1.x - b.z * t1.y; v1.z = a.z * t1.y + b.z * t1.x; v0.w = a.w * t1.z - b.w * t1.w; v1.w = a.w * t1.w + b.w * t1.z;
                        }
                        u32x2 o; o.x = pk2(v0.x, v0.y); o.y = pk2(v0.z, v0.w); *(u32x2*)(rowp + bj * HALF) = o;
                        o.x = pk2(v1.x, v1.y); o.y = pk2(v1.z, v1.w); *(u32x2*)(rowp + bj * HALF + 16) = o; } }
            return;
        }
        const int col0 = u.pn * BM + wc * 32 + 8 * fq;
        const int mode = (u.pn == 11 || u.pn == 12) ? 2 : ((u.pn >= 13 && u.pn <= 16) ? 3 : 0);
        if (mode == 3) {
            f32x4 lb4[2][2];
            const int z = (u.pn - 13) >> 1, cb = z * 512 + ((u.pn - 13) & 1) * 256 + wc * 32 + 8 * fq;
#pragma unroll
            for (int bj = 0; bj < 2; ++bj)
#pragma unroll
                for (int n = 0; n < 2; ++n) lb4[bj][n] = (layer == 0) ? (f32x4){0.f, 0.f, 0.f, 0.f} : *(const f32x4*)(lbp + cb + bj * HALF + 4 * n);
#pragma unroll
            for (int ai = 0; ai < 2; ++ai)
#pragma unroll
                for (int m = 0; m < 4; ++m) { bf16_t* rowp = P1 + (size_t)(row0 + ai * HALF + m * 16) * NP1 + col0;
#pragma unroll
                    for (int bj = 0; bj < 2; ++bj) { float gq[8];
#pragma unroll
                        for (int n = 0; n < 2; ++n)
#pragma unroll
                            for (int j = 0; j < 4; ++j) { const float f = acc[ai][bj][m][n][j], lb = lb4[bj][n][j]; const float t = __expf(-fabsf(f)), rr = __builtin_amdgcn_rcpf(1.f + t);
                                gq[4 * n + j] = __logf(fmaxf(lb + (1.f - lb) * ((f >= 0.f) ? rr : t * rr), 1e-37f)); }
                        u32x4 o; o.x = pk2(gq[0], gq[1]); o.y = pk2(gq[2], gq[3]); o.z = pk2(gq[4], gq[5]); o.w = pk2(gq[6], gq[7]); *(u32x4*)(rowp + bj * HALF) = o; } }
            return;
        }
#pragma unroll
        for (int ai = 0; ai < 2; ++ai)
#pragma unroll
            for (int m = 0; m < 4; ++m) { bf16_t* rowp = P1 + (size_t)(row0 + ai * HALF + m * 16) * NP1 + col0;
#pragma unroll
                for (int bj = 0; bj < 2; ++bj) {
                    f32x4 v0 = acc[ai][bj][m][0], v1 = acc[ai][bj][m][1];
                    if (mode == 2) {
#pragma unroll
                        for (int j = 0; j < 4; ++j) { v0[j] = v0[j] * __builtin_amdgcn_rcpf(1.f + __expf(-v0[j])); v1[j] = v1[j] * __builtin_amdgcn_rcpf(1.f + __expf(-v1[j])); }
                    }
                    u32x4 o; o.x = pk2(v0.x, v0.y); o.y = pk2(v0.z, v0.w); o.z = pk2(v1.x, v1.y); o.w = pk2(v1.z, v1.w); *(u32x4*)(rowp + bj * HALF) = o; } }
    }
};
#define PG_ROWCOL8 const int row0 = u.pm * BM + wr * 64 + fr, col0 = u.pn * BM + wc * 32 + 8 * fq
struct EpiGate { bf16_t* G;
    __device__ __forceinline__ void operator()(const f32x4 (&acc)[2][2][4][2], const Unit& u, int wr, int wc, int fr, int fq) const {
        PG_ROWCOL8;
#pragma unroll
        for (int ai = 0; ai < 2; ++ai)
#pragma unroll
            for (int m = 0; m < 4; ++m) { bf16_t* rowp = G + (size_t)(row0 + ai * HALF + m * 16) * NGATE + col0;
#pragma unroll
                for (int bj = 0; bj < 2; ++bj) { const f32x4 v0 = acc[ai][bj][m][0], v1 = acc[ai][bj][m][1]; u32x4 o;
                    o.x = pk2(sigmoidf_(v0.x), sigmoidf_(v0.y)); o.y = pk2(sigmoidf_(v0.z), sigmoidf_(v0.w)); o.z = pk2(sigmoidf_(v1.x), sigmoidf_(v1.y)); o.w = pk2(sigmoidf_(v1.z), sigmoidf_(v1.w));
                    *(u32x4*)(rowp + bj * HALF) = o; } }
    }
};
struct EpiMerge { const bf16_t* G; bf16_t* O; bf16_t* PM;
    __device__ __forceinline__ void operator()(const f32x4 (&acc)[2][2][4][2], const Unit& u, int wr, int wc, int fr, int fq) const {
        PG_ROWCOL8; const int br = u.aux & 3; const bool part = u.aux >= 4, rmw = !part && br != 0;
        bf16_t* const Ob = part ? PM + (size_t)br * NCTX * DM - (size_t)NTOK * DM : O;
#pragma unroll
        for (int ai = 0; ai < 2; ++ai) {
            u32x4 g4[4][2], o4[4][2];
#pragma unroll
            for (int m = 0; m < 4; ++m) { const size_t r = (size_t)(row0 + ai * HALF + m * 16); const bf16_t* gp = G + r * NGATE + br * 1024 + col0; const bf16_t* rowp = Ob + r * DM + col0;
#pragma unroll
                for (int bj = 0; bj < 2; ++bj) { g4[m][bj] = *(const u32x4*)(gp + bj * HALF); if (rmw) o4[m][bj] = *(const u32x4*)(rowp + bj * HALF); } }
#pragma unroll
            for (int m = 0; m < 4; ++m) { bf16_t* rowp = Ob + (size_t)(row0 + ai * HALF + m * 16) * DM + col0;
#pragma unroll
                for (int bj = 0; bj < 2; ++bj) { const f32x4 v0 = acc[ai][bj][m][0], v1 = acc[ai][bj][m][1]; const u32x4 gg = g4[m][bj];
                    float w[8] = {__uint_as_float(gg.x << 16) * v0.x, __uint_as_float(gg.x & 0xffff0000u) * v0.y, __uint_as_float(gg.y << 16) * v0.z, __uint_as_float(gg.y & 0xffff0000u) * v0.w,
                                  __uint_as_float(gg.z << 16) * v1.x, __uint_as_float(gg.z & 0xffff0000u) * v1.y, __uint_as_float(gg.w << 16) * v1.z, __uint_as_float(gg.w & 0xffff0000u) * v1.w};
                    if (rmw) { const u32x4 oo = o4[m][bj];
                        w[0] += __uint_as_float(oo.x << 16); w[1] += __uint_as_float(oo.x & 0xffff0000u); w[2] += __uint_as_float(oo.y << 16); w[3] += __uint_as_float(oo.y & 0xffff0000u);
                        w[4] += __uint_as_float(oo.z << 16); w[5] += __uint_as_float(oo.z & 0xffff0000u); w[6] += __uint_as_float(oo.w << 16); w[7] += __uint_as_float(oo.w & 0xffff0000u); }
                    u32x4 o; o.x = pk2(w[0], w[1]); o.y = pk2(w[2], w[3]); o.z = pk2(w[4], w[5]); o.w = pk2(w[6], w[7]); *(u32x4*)(rowp + bj * HALF) = o; } }
            asm volatile("" ::: "memory");
        }
    }
};
struct EpiWout { const float *xlat, *xctx; float *olat, *octx; const float* modl;
    __device__ __forceinline__ void operator()(const f32x4 (&acc)[2][2][4][2], const Unit& u, int wr, int wc, int fr, int fq) const {
        PG_ROWCOL; const bool lat = u.pm < NTOK / 256; const int rb = lat ? (u.pm >> 4) : 4;
        const float* xin = lat ? xlat : xctx - (size_t)NTOK * DM; float* xo = lat ? olat : octx - (size_t)NTOK * DM; const float* m2 = modl + (size_t)rb * 6144 + 2 * 1024 + col0;
        f32x4 mv[2][2];
#pragma unroll
        for (int bj = 0; bj < 2; ++bj)
#pragma unroll
            for (int n = 0; n < 2; ++n) mv[bj][n] = *(const f32x4*)(m2 + bj * HALF + n * 16);
#pragma unroll
        for (int aq = 0; aq < 4; ++aq) { const int ai = aq >> 1, m0 = (aq & 1) * 2;
            f32x4 xv[4][2][2];
#pragma unroll
            for (int m = m0; m < m0 + 2; ++m) { const size_t o = (size_t)(row0 + ai * HALF + m * 16) * DM + col0;
#pragma unroll
                for (int bj = 0; bj < 2; ++bj)
#pragma unroll
                    for (int n = 0; n < 2; ++n) xv[m][bj][n] = *(const f32x4*)(xin + o + bj * HALF + n * 16); }
#pragma unroll
            for (int m = m0; m < m0 + 2; ++m) { const size_t o = (size_t)(row0 + ai * HALF + m * 16) * DM + col0;
#pragma unroll
                for (int bj = 0; bj < 2; ++bj)
#pragma unroll
                    for (int n = 0; n < 2; ++n) *(f32x4*)(xo + o + bj * HALF + n * 16) = ALPHA * xv[m][bj][n] + mv[bj][n] * acc[ai][bj][m][n]; }
            asm volatile("" ::: "memory");
        }
    }
};
struct EpiMoe1 { bf16_t* HID; const float* roww;
    __device__ __forceinline__ void operator()(const f32x4 (&acc)[2][2][4][2], const Unit& u, int wr, int wc, int fr, int fq) const {
        const int row0 = u.pm * BM + wr * 64 + fr, hc0 = u.pn * 128 + wc * 32 + 8 * fq;
#pragma unroll
        for (int ai = 0; ai < 2; ++ai)
#pragma unroll
            for (int m = 0; m < 4; ++m) { const int r = row0 + ai * HALF + m * 16; const float w = roww[r];
                const f32x4 g0 = acc[ai][0][m][0], g1 = acc[ai][0][m][1], u0 = acc[ai][1][m][0], u1 = acc[ai][1][m][1]; u32x4 o;
                o.x = pk2(siluf_(g0.x) * u0.x * w, siluf_(g0.y) * u0.y * w); o.y = pk2(siluf_(g0.z) * u0.z * w, siluf_(g0.w) * u0.w * w);
                o.z = pk2(siluf_(g1.x) * u1.x * w, siluf_(g1.y) * u1.y * w); o.w = pk2(siluf_(g1.z) * u1.z * w, siluf_(g1.w) * u1.w * w);
                *(u32x4*)(HID + (size_t)r * 256 + hc0) = o; }
    }
};
struct EpiMoe2 { bf16_t* Y; const int* rmap; bf16_t* dump;
    __device__ __forceinline__ void operator()(const f32x4 (&acc)[2][2][4][2], const Unit& u, int wr, int wc, int fr, int fq) const {
        PG_ROWCOL8;
#pragma unroll
        for (int ai = 0; ai < 2; ++ai)
#pragma unroll
            for (int m = 0; m < 4; ++m) { const int s = rmap[row0 + ai * HALF + m * 16];
                bf16_t* rowp = (s >= 0 ? Y + (size_t)s * DM : dump) + col0;
#pragma unroll
                for (int bj = 0; bj < 2; ++bj) { const f32x4 v0 = acc[ai][bj][m][0], v1 = acc[ai][bj][m][1]; u32x4 o; o.x = pk2(v0.x, v0.y); o.y = pk2(v0.z, v0.w); o.z = pk2(v1.x, v1.y); o.w = pk2(v1.z, v1.w); *(u32x4*)(rowp + bj * HALF) = o; } }
    }
};
#undef PG_ROWCOL8
#undef PG_ROWCOL
}

__device__ __forceinline__ void moe_offsets(Frame& F, int l, int* off) {
    if (F.tid < 64) {
        int v = (F.tid < 32) ? (((int)F.cnt()[l * 32 + F.tid] + 255) & ~255) : 0;
#pragma unroll
        for (int o = 1; o < 32; o <<= 1) { const int t = __shfl_up(v, o); if ((F.tid & 63) >= o) v += t; }
        if (F.tid < 32) off[F.tid + 1] = v;
        if (F.tid == 0) off[0] = 0;
    }
    __syncthreads();
}

__device__ __forceinline__ void phase_rope(Frame& F) {
    float* tab = F.smf;
    for (int e = F.tid; e < 1024; e += NTHR) { const int pp = e >> 4, i = e & 15; const float inv = powf(10000.f, -(float)i / 16.f), ang = (float)pp * inv; tab[2 * e] = cosf(ang); tab[2 * e + 1] = sinf(ang); }
    __syncthreads();
    const size_t total = (size_t)NTOK * 320;
    for (size_t idx = (size_t)F.bid * NTHR + F.tid; idx < total; idx += (size_t)F.nb * NTHR) {
        const int row = (int)(idx / 320), r = (int)(idx % 320), h = r >> 5, half = (r >> 4) & 1, i = r & 15;
        const int pos = row & (SEQ - 1), pp = half ? (pos & 63) : (pos >> 6);
        const float cs = tab[2 * (pp * 16 + i)], sn = tab[2 * (pp * 16 + i) + 1];
        bf16_t* base = F.P1() + (size_t)row * NP1 + (h < 8 ? PC_CQ + h * 64 : PC_CK + (h - 8) * 64) + half * 32 + i;
        const float u1 = bf2f(base[0]), u2 = bf2f(base[16]);
        base[0] = f2bf(u1 * cs - u2 * sn); base[16] = f2bf(u1 * sn + u2 * cs);
    }
}

__device__ __forceinline__ int seq_row(int s, int b, int z) {
    if (s < LC) { const int tc = z ? (LC - 1 - s) : s; return NTOK + b * LC + tc; }
    const int tl = s - LC, t = z ? (SEQ - 1 - tl) : tl; return b * SEQ + t;
}
typedef short bf16x8_t __attribute__((ext_vector_type(8)));
typedef short bf16x4_t __attribute__((ext_vector_type(4)));
struct MaskNone { __device__ __forceinline__ void operator()(f32x4&, f32x4&) const {} };
struct MaskNA { int u0; const float* brow;
    __device__ __forceinline__ void operator()(f32x4& s0, f32x4& s1) const {
        float v[8] = {s0.x, s0.y, s0.z, s0.w, s1.x, s1.y, s1.z, s1.w};
#pragma unroll
        for (int T = 0; T < 2; ++T)
#pragma unroll
            for (int rr = 0; rr < 4; ++rr) v[T * 4 + rr] = ((unsigned)(u0 + 16 * T + rr) < 16u) ? v[T * 4 + rr] + brow[16 * T + rr] : -INFINITY;
        s0 = (f32x4){v[0], v[1], v[2], v[3]}; s1 = (f32x4){v[4], v[5], v[6], v[7]};
    }
};
struct MaskWA { int i, j0;
    __device__ __forceinline__ void operator()(f32x4& s0, f32x4& s1) const {
        float v[8] = {s0.x, s0.y, s0.z, s0.w, s1.x, s1.y, s1.z, s1.w};
#pragma unroll
        for (int T = 0; T < 2; ++T)
#pragma unroll
            for (int rr = 0; rr < 4; ++rr) { const int j = j0 + 16 * T + rr; const bool ok = (j >= 0) && (j < SEQ) && (i - j <= 128) && (j - i <= 128);
                v[T * 4 + rr] = ok ? v[T * 4 + rr] : -INFINITY; }
        s0 = (f32x4){v[0], v[1], v[2], v[3]}; s1 = (f32x4){v[4], v[5], v[6], v[7]};
    }
};
struct KVF { bf16x8_t k[4]; bf16x4_t v[4][2]; };
__device__ __forceinline__ void kv_load(KVF& f, const char* kbase, unsigned ko0, unsigned ko1, const char* vbase, unsigned vo0, unsigned vo1) {
    f.k[0] = *(const bf16x8_t*)(kbase + ko0); f.k[1] = *(const bf16x8_t*)(kbase + ko0 + 64); f.k[2] = *(const bf16x8_t*)(kbase + ko1); f.k[3] = *(const bf16x8_t*)(kbase + ko1 + 64);
#pragma unroll
    for (int t = 0; t < 4; ++t) { f.v[t][0] = *(const bf16x4_t*)(vbase + vo0 + (unsigned)t * 16u * NROW * 2u); f.v[t][1] = *(const bf16x4_t*)(vbase + vo1 + (unsigned)t * 16u * NROW * 2u); }
}
__device__ __forceinline__ float xmax_g(float x) {
    auto r = __builtin_amdgcn_permlane16_swap(__float_as_uint(x), __float_as_uint(x), false, false); x = fmaxf(__uint_as_float(r[0]), __uint_as_float(r[1]));
    auto q = __builtin_amdgcn_permlane32_swap(__float_as_uint(x), __float_as_uint(x), false, false); return fmaxf(__uint_as_float(q[0]), __uint_as_float(q[1])); }
__device__ __forceinline__ float xsum_g(float x) {
    auto r = __builtin_amdgcn_permlane16_swap(__float_as_uint(x), __float_as_uint(x), false, false); x = __uint_as_float(r[0]) + __uint_as_float(r[1]);
    auto q = __builtin_amdgcn_permlane32_swap(__float_as_uint(x), __float_as_uint(x), false, false); return __uint_as_float(q[0]) + __uint_as_float(q[1]); }
template <class MaskF>
__device__ __forceinline__ void attn_tile(float& am, f32x4& asum, f32x4 (&ao)[4], const bf16x8_t (&qb)[2], const KVF& f, const MaskF& maskf) {
    f32x4 s0 = {0.f, 0.f, 0.f, 0.f}, s1 = {0.f, 0.f, 0.f, 0.f};
    s0 = __builtin_amdgcn_mfma_f32_16x16x32_bf16(f.k[0], qb[0], s0, 0, 0, 0); s0 = __builtin_amdgcn_mfma_f32_16x16x32_bf16(f.k[1], qb[1], s0, 0, 0, 0);
    s1 = __builtin_amdgcn_mfma_f32_16x16x32_bf16(f.k[2], qb[0], s1, 0, 0, 0); s1 = __builtin_amdgcn_mfma_f32_16x16x32_bf16(f.k[3], qb[1], s1, 0, 0, 0);
    maskf(s0, s1);
    const float ml = fmaxf(fmaxf(fmaxf(s0.x, s0.y), fmaxf(s0.z, s0.w)), fmaxf(fmaxf(s1.x, s1.y), fmaxf(s1.z, s1.w)));
    if (__any(ml > am)) {
        const float mn = fmaxf(am, xmax_g(ml)), alpha = __builtin_amdgcn_exp2f(am - mn); am = mn; asum = asum * alpha;
#pragma unroll
        for (int t = 0; t < 4; ++t) ao[t] = ao[t] * alpha;
    }
    f32x4 p0, p1;
    p0.x = __builtin_amdgcn_exp2f(s0.x - am); p0.y = __builtin_amdgcn_exp2f(s0.y - am); p0.z = __builtin_amdgcn_exp2f(s0.z - am); p0.w = __builtin_amdgcn_exp2f(s0.w - am);
    p1.x = __builtin_amdgcn_exp2f(s1.x - am); p1.y = __builtin_amdgcn_exp2f(s1.y - am); p1.z = __builtin_amdgcn_exp2f(s1.z - am); p1.w = __builtin_amdgcn_exp2f(s1.w - am);
    union { bf16x8_t v; unsigned u[4]; } pb, ones;
    pb.u[0] = pk2(p0.x, p0.y); pb.u[1] = pk2(p0.z, p0.w); pb.u[2] = pk2(p1.x, p1.y); pb.u[3] = pk2(p1.z, p1.w);
    ones.u[0] = ones.u[1] = ones.u[2] = ones.u[3] = 0x3f803f80u;
#pragma unroll
    for (int t = 0; t < 4; ++t) {
        union { bf16x8_t v; bf16x4_t h[2]; } av; av.h[0] = f.v[t][0]; av.h[1] = f.v[t][1];
        ao[t] = __builtin_amdgcn_mfma_f32_16x16x32_bf16(av.v, pb.v, ao[t], 0, 0, 0);
    }
    asum = __builtin_amdgcn_mfma_f32_16x16x32_bf16(ones.v, pb.v, asum, 0, 0, 0);
}
template <int kind>
__device__ __forceinline__ void attn_block(Frame& F, int l, int item, const float* rpb_s, bf16_t* sbuf) {
    constexpr int NQ = 2, NCS = 4, NLOC = (kind == 0) ? 11 : (kind == 1 ? 5 : 0), NS = NCS + NLOC, SROW = 72;
    const int tid = F.tid, lane = F.lane, n = lane & 15, g = lane >> 4, w = __builtin_amdgcn_readfirstlane(F.wave);
    const bf16_t* P1 = F.P1(); const bf16_t* VT = F.VT();
    int b, h0, kvh = 0, kcol, vrow, r = 0, cb = 0, t0 = 0, t0g = 0, r0 = 0, qrow0, qcol0, brcol0;
    constexpr int QRS = (kind == 0) ? 64 : (kind == 2 ? 16 : 0), QCS = (kind == 1 || kind == 3) ? 64 : 0;
    if (kind == 0) { const int rq = item & 15, hb = (item >> 4) & 7; b = item >> 7; r0 = 4 * rq; cb = w & 3; r = r0 + 2 * (w >> 2); h0 = hb; kcol = PC_BK + hb * 64; vrow = hb * 64;
        qrow0 = b * SEQ + r * 64 + cb * 16; qcol0 = PC_BQ + hb * 64; brcol0 = 512 + hb * 64; }
    else if (kind == 1) { const int qg = item & 63; kvh = (item >> 6) & 1; b = item >> 7; t0g = 64 * qg; t0 = t0g + 16 * (w & 3); h0 = kvh * 4 + 2 * (w >> 2); kcol = PC_CK + kvh * 64; vrow = 512 + kvh * 64;
        qrow0 = b * SEQ + t0; qcol0 = PC_CQ + h0 * 64; brcol0 = 1024 + h0 * 64; }
    else if (kind == 2) { const int hb = item & 7; b = item >> 3; h0 = hb; kcol = PC_BK + hb * 64; vrow = hb * 64; qrow0 = NTOK + b * LC + 32 * w; qcol0 = PC_BQ + hb * 64; brcol0 = 512 + hb * 64; }
    else { const int qh = item & 3; kvh = (item >> 2) & 1; b = item >> 3; h0 = kvh * 4 + 2 * (w >> 2); kcol = PC_CK + kvh * 64; vrow = 512 + kvh * 64;
        qrow0 = NTOK + b * LC + 16 * (4 * qh + (w & 3)); qcol0 = PC_CQ + h0 * 64; brcol0 = 1024 + h0 * 64; }
    bf16x8_t qb[NQ][2]; float am[NQ]; f32x4 asum[NQ], ao[NQ][4];
    { const char* qbase = (const char*)P1; const unsigned qo = (unsigned)(qrow0 + n) * (unsigned)(NP1 * 2) + (unsigned)(qcol0 + 8 * g) * 2u;
#pragma unroll
      for (int q = 0; q < NQ; ++q) { const unsigned o = qo + (unsigned)q * (unsigned)(QRS * NP1 * 2 + QCS * 2); qb[q][0] = *(const bf16x8_t*)(qbase + o); qb[q][1] = *(const bf16x8_t*)(qbase + o + 64);
        am[q] = -1e30f; asum[q] = (f32x4){0.f, 0.f, 0.f, 0.f};
#pragma unroll
        for (int t = 0; t < 4; ++t) ao[q][t] = (f32x4){0.f, 0.f, 0.f, 0.f}; } }
    const int crow0 = NTOK + b * LC, ru0 = min(max(r0 - 4, 0), 56);
    const int w0 = (cb == 0) ? 0 : (cb == 1 ? 8 : (cb == 2 ? 24 : 32));
    const int srow = tid >> 3, sch = tid & 7;
    const char* kbase = (const char*)P1; const char* vbase = (const char*)VT;
    u32x4 kr0 = {0u, 0u, 0u, 0u}, vr0 = kr0, kr1 = kr0, vr1 = kr0;
    auto stage_load = [&](int s, u32x4& kreg, u32x4& vreg) {
        int krow, vcol;
        if (s < NCS) { krow = crow0 + 64 * s + srow; vcol = crow0 + 64 * s + 8 * sch; }
        else if (kind == 0) { const int kr = min(ru0 + (s - NCS), 63); krow = b * SEQ + kr * 64 + srow; vcol = b * SEQ + kr * 64 + 8 * sch; }
        else { const int kb = t0g - 128 + 64 * (s - NCS); krow = b * SEQ + min(max(kb + srow, 0), SEQ - 1); vcol = b * SEQ + min(max(kb + 8 * sch, 0), SEQ - 8); }
        kreg = *(const u32x4*)(kbase + (unsigned)krow * (unsigned)(NP1 * 2) + (unsigned)(kcol * 2 + sch * 16));
        vreg = *(const u32x4*)(vbase + (unsigned)(vrow + srow) * (unsigned)(NROW * 2) + (unsigned)vcol * 2u);
    };
    auto stage_store = [&](int s, const u32x4& kreg, const u32x4& vreg) { bf16_t* Ks = sbuf + (s & 1) * (2 * 64 * SROW); bf16_t* Vs = Ks + 64 * SROW;
        *(u32x4*)(Ks + srow * SROW + sch * 8) = kreg; *(u32x4*)(Vs + srow * SROW + sch * 8) = vreg; };
    stage_load(0, kr1, vr1); stage_store(0, kr1, vr1); stage_load(1, kr0, vr0);
    __syncthreads();
    auto do_step = [&](int s, const u32x4& kst, const u32x4& vst, u32x4& kld, u32x4& vld) {
        if (s + 2 < NS) stage_load(s + 2, kld, vld);
#pragma unroll
        for (int hh = 0; hh < 2; ++hh) {
            bool act[NQ]; int kofs = 32 * hh;
            if (s < NCS) { act[0] = act[1] = true; }
            else if (kind == 0) { const int kr = ru0 + (s - NCS); kofs = w0;
#pragma unroll
                for (int q = 0; q < NQ; ++q) { const int rsq = min(max(r + q - 4, 0), 56); act[q] = (hh == 0) && (kr <= 63) && (kr >= rsq) && (kr <= rsq + 7); } }
            else { const int kb = t0g - 128 + 64 * (s - NCS) + 32 * hh; act[0] = act[1] = (kb + 31 >= t0 - 128) && (kb <= t0 + 143); }
            if (act[0] || act[1]) {
                const bf16_t* Ks = sbuf + (s & 1) * (2 * 64 * SROW); const bf16_t* Vs = Ks + 64 * SROW;
                KVF f;
                f.k[0] = *(const bf16x8_t*)(Ks + (kofs + n) * SROW + 8 * g); f.k[1] = *(const bf16x8_t*)(Ks + (kofs + n) * SROW + 32 + 8 * g);
                f.k[2] = *(const bf16x8_t*)(Ks + (kofs + 16 + n) * SROW + 8 * g); f.k[3] = *(const bf16x8_t*)(Ks + (kofs + 16 + n) * SROW + 32 + 8 * g);
#pragma unroll
                for (int t = 0; t < 4; ++t) { f.v[t][0] = *(const bf16x4_t*)(Vs + (16 * t + n) * SROW + kofs + 4 * g); f.v[t][1] = *(const bf16x4_t*)(Vs + (16 * t + n) * SROW + kofs + 16 + 4 * g); }
                if (s < NCS) {
#pragma unroll
                    for (int q = 0; q < NQ; ++q) attn_tile(am[q], asum[q], ao[q], qb[q], f, MaskNone());
                } else if (kind == 0) { const int kr = ru0 + (s - NCS);
#pragma unroll
                    for (int q = 0; q < NQ; ++q) if (act[q]) { const int c = cb * 16 + n, csq = min(max(c - 8, 0), 48), kc0 = w0 + 4 * g;
                        MaskNA mk{kc0 - csq, rpb_s + (h0 * 15 + (kr - (r + q) + 7)) * 64 + (kc0 - c + 15 + 16)}; attn_tile(am[q], asum[q], ao[q], qb[q], f, mk); }
                } else if (kind == 1) { const int kb = t0g - 128 + 64 * (s - NCS) + 32 * hh;
                    if (kb >= t0 - 113 && kb + 31 <= t0 + 128 && kb >= 0 && kb + 31 < SEQ) {
#pragma unroll
                        for (int q = 0; q < NQ; ++q) attn_tile(am[q], asum[q], ao[q], qb[q], f, MaskNone());
                    } else { MaskWA mk{t0 + n, kb + 4 * g};
#pragma unroll
                        for (int q = 0; q < NQ; ++q) attn_tile(am[q], asum[q], ao[q], qb[q], f, mk); }
                }
            }
        }
        if (s + 1 < NS) stage_store(s + 1, kst, vst);
        __syncthreads();
    };
#pragma unroll 1
    for (int s = 0; s < NS; s += 2) { do_step(s, kr0, vr0, kr1, vr1); if (s + 1 < NS) do_step(s + 1, kr1, vr1, kr0, vr0); }
#pragma unroll
    for (int q = 0; q < NQ; ++q) {
        float lt = asum[q].x;
        float osc = 1.f;
        if (kind == 1 || kind == 3) { const float sk = F.p.wa_sink[l * 8 + h0 + q] * 1.44269504089f, mf = fmaxf(am[q], sk); osc = __builtin_amdgcn_exp2f(am[q] - mf); lt = lt * osc + __builtin_amdgcn_exp2f(sk - mf); }
        const float inv = osc / lt;
        char* obase = (char*)F.BR(); const unsigned oo = (unsigned)(qrow0 + q * QRS + n) * 4096u + (unsigned)(brcol0 + q * QCS + 4 * g) * 2u;
#pragma unroll
        for (int t = 0; t < 4; ++t) { const f32x4 v = ao[q][t] * inv; u32x2 o2; o2.x = pk2(v.x, v.y); o2.y = pk2(v.z, v.w); *(u32x2*)(obase + oo + 32u * t) = o2; }
    }
}

template <int DK, bool HG>
__device__ __forceinline__ void prescan_combo(Frame& F, int l, int b, int h, int first, int step) {
    constexpr int NDP = DK / 2, NTG = NTHR / NDP, TPT = 64 / NTG, LGS = 66;
    REFRESH(F);
    const int tid = F.tid, dp = tid % NDP, tg = tid / NDP, lane = F.lane, n = lane & 15, g = lane >> 4, w = __builtin_amdgcn_readfirstlane(F.wave);
    float* TOT = F.smf;
    float* LGS_ = F.smf + 2 * 2 * NTG * DK;
    char* p1b = (char*)F.P1();
    bf16x8_t bw[HG ? 1 : 4]; f32x2_t lb2[2];
    lb2[0] = (f32x2_t){0.f, 0.f}; lb2[1] = lb2[0];
    if (!HG) {
        const int zw = w >> 2;
#pragma unroll
        for (int dt = 0; dt < 4; ++dt) { float wv[8];
#pragma unroll
            for (int j = 0; j < 8; ++j) { const float x = F.p.gla_lr_w[((size_t)(l * 2 + zw) * 16 + 8 * (g & 1) + j) * 256 + h * 64 + dt * 16 + n]; const float hi = __uint_as_float(pk2(x, x) << 16); wv[j] = (g < 2) ? x : x - hi; }
            union { bf16x8_t v; unsigned u[4]; } pb; pb.u[0] = pk2(wv[0], wv[1]); pb.u[1] = pk2(wv[2], wv[3]); pb.u[2] = pk2(wv[4], wv[5]); pb.u[3] = pk2(wv[6], wv[7]); bw[HG ? 0 : dt] = pb.v; }
#pragma unroll
        for (int z = 0; z < 2; ++z) { const float* bp = F.p.gla_lr_b + (l * 2 + z) * 256 + h * 64 + 2 * dp; lb2[z] = (f32x2_t){bp[0], bp[1]}; }
    }
    const int qcol = HG ? PC_DQ + h * 128 + 2 * dp : PC_AQ + h * 64 + 2 * dp, kcol = HG ? PC_DF + h * 128 + 2 * dp : PC_AK + h * 64 + 2 * dp;
    float* ebase = F.ESC() + (HG ? 32 * 68 * 128 : 0);
    unsigned rq[TPT], rk[TPT], rk1[HG ? TPT : 1]; u32x4 rlp = {0u, 0u, 0u, 0u};
    rk1[0] = 0u;
#define PS_LOAD(nbk_) do { const int row0_ = seq_row((nbk_) * 64, b, 0); unsigned o_ = (unsigned)(row0_ + tg * TPT) * (unsigned)(NP1 * 2); \
        _Pragma("unroll") for (int tt = 0; tt < TPT; ++tt) { rq[tt] = *(const unsigned*)(p1b + (o_ + (unsigned)(qcol * 2))); rk[tt] = *(const unsigned*)(p1b + (o_ + (unsigned)(kcol * 2))); \
            if (HG) rk1[HG ? tt : 0] = *(const unsigned*)(p1b + (o_ + (unsigned)((kcol + 512) * 2))); o_ += (unsigned)(NP1 * 2); } \
        if (!HG) rlp = *(const u32x4*)(p1b + ((unsigned)(row0_ + (w & 3) * 16 + n) * (unsigned)(NP1 * 2) + (unsigned)((PC_ALR + (w >> 2) * 16 + (g & 1) * 8) * 2))); } while (0)
    int nbk = first, par = 0;
    if (nbk < 68) PS_LOAD(nbk);
#pragma unroll 1
    for (; nbk < 68; nbk += step, par ^= 1) {
        float* tot = TOT + par * (2 * NTG * DK);
        if (!HG) {
            union { bf16x8_t v; u32x4 u; } af; af.u = rlp;
            float* lgw = LGS_ + ((w >> 2) * 64 + (w & 3) * 16 + 4 * g) * LGS + n;
#pragma unroll
            for (int dt = 0; dt < 4; ++dt) { const f32x4 d = __builtin_amdgcn_mfma_f32_16x16x32_bf16(af.v, bw[HG ? 0 : dt], (f32x4){0.f, 0.f, 0.f, 0.f}, 0, 0, 0);
                lgw[0 * LGS + dt * 16] = d.x; lgw[1 * LGS + dt * 16] = d.y; lgw[2 * LGS + dt * 16] = d.z; lgw[3 * LGS + dt * 16] = d.w; }
            __syncthreads();
        }
        const int row0 = seq_row(nbk * 64, b, 0);
        f32x2_t qv[TPT], kv0[TPT], kv1[HG ? TPT : 1], cs0[TPT], cs1[TPT];
#pragma unroll
        for (int tt = 0; tt < TPT; ++tt) {
            qv[tt] = (f32x2_t){__uint_as_float(rq[tt] << 16), __uint_as_float(rq[tt] & 0xffff0000u)};
            const f32x2_t kr = {__uint_as_float(rk[tt] << 16), __uint_as_float(rk[tt] & 0xffff0000u)};
            if (HG) { const unsigned r1 = rk1[HG ? tt : 0]; const f32x2_t k1 = {__uint_as_float(r1 << 16), __uint_as_float(r1 & 0xffff0000u)};
                cs0[tt] = kr; cs1[tt] = k1;
                kv0[tt] = (f32x2_t){1.f - __expf(kr.x), 1.f - __expf(kr.y)}; kv1[HG ? tt : 0] = (f32x2_t){1.f - __expf(k1.x), 1.f - __expf(k1.y)}; }
            else kv0[tt] = kr;
        }
        if (nbk + step < 68) PS_LOAD(nbk + step);
        if (!HG) {
#pragma unroll
            for (int tt = 0; tt < TPT; ++tt)
#pragma unroll
                for (int z = 0; z < 2; ++z) {
                    const f32x2_t lg = *(const f32x2_t*)(LGS_ + (z * 64 + tg * TPT + tt) * LGS + 2 * dp) + lb2[z];
                    const f32x2_t gz = {(fminf(lg.x, 0.f) - __logf(1.f + __expf(-fabsf(lg.x)))) * (1.f / 16.f), (fminf(lg.y, 0.f) - __logf(1.f + __expf(-fabsf(lg.y)))) * (1.f / 16.f)};
                    if (z == 0) cs0[tt] = gz; else cs1[tt] = gz; }
        }
#pragma unroll
        for (int tt = 1; tt < TPT; ++tt) { cs0[tt] += cs0[tt - 1]; cs1[TPT - 1 - tt] += cs1[TPT - tt]; }
        *(f32x2_t*)(tot + (0 * NTG + tg) * DK + 2 * dp) = cs0[TPT - 1];
        *(f32x2_t*)(tot + (1 * NTG + tg) * DK + 2 * dp) = cs1[0];
        __syncthreads();
        f32x2_t offs0 = {0.f, 0.f}, mid0 = offs0, last0 = offs0, offs1 = offs0, mid1 = offs0, last1 = offs0;
#pragma unroll
        for (int t2 = 0; t2 < NTG; ++t2) { const f32x2_t v0 = *(const f32x2_t*)(tot + (0 * NTG + t2) * DK + 2 * dp), v1 = *(const f32x2_t*)(tot + (1 * NTG + t2) * DK + 2 * dp);
            if (t2 < tg) offs0 += v0; if (t2 < NTG / 2) mid0 += v0; last0 += v0;
            if (t2 > tg) offs1 += v1; if (t2 >= NTG / 2) mid1 += v1; last1 += v1; }
        const f32x2_t d0 = offs0 - mid0, d1 = offs1 - mid1;
        unsigned ro = (unsigned)(row0 + tg * TPT);
#pragma unroll
        for (int tt = 0; tt < TPT; ++tt, ++ro) {
            const float x00 = fminf(fmaxf(cs0[tt].x + d0.x, -80.f), 80.f), x01 = fminf(fmaxf(cs0[tt].y + d0.y, -80.f), 80.f);
            const float x10 = fminf(fmaxf(cs1[tt].x + d1.x, -80.f), 80.f), x11 = fminf(fmaxf(cs1[tt].y + d1.y, -80.f), 80.f);
            const f32x2_t k1v = kv1[HG ? tt : 0], k1 = HG ? k1v : kv0[tt];
            const unsigned qd0 = pk2(qv[tt].x * __expf(x00), qv[tt].y * __expf(x01)), kd0 = pk2(kv0[tt].x * __expf(-x00), kv0[tt].y * __expf(-x01));
            const unsigned qd1 = pk2(qv[tt].x * __expf(x10), qv[tt].y * __expf(x11)), kd1 = pk2(k1.x * __expf(-x10), k1.y * __expf(-x11));
            const unsigned o_ = ro * (unsigned)(NP1 * 2);
            *(unsigned*)(p1b + (o_ + (unsigned)(qcol * 2))) = qd0; *(unsigned*)(p1b + (o_ + (unsigned)(kcol * 2))) = kd0;
            if (HG) { *(unsigned*)(p1b + (o_ + (unsigned)((kcol + 512) * 2))) = kd1; *(unsigned*)((char*)F.BR() + (ro * 4096u + (unsigned)((1536 + h * 128 + 2 * dp) * 2))) = qd1; }
            else { *(unsigned*)((char*)F.SC1() + (ro * 1024u + (unsigned)((h * 64 + 2 * dp) * 2))) = qd1; *(unsigned*)((char*)F.SC1() + (ro * 1024u + (unsigned)((256 + h * 64 + 2 * dp) * 2))) = kd1; }
        }
        if (tg == 0) {
            float* e0 = ebase + (size_t)(((b * 4 + h) * 2 + 0) * 68 + nbk) * (2 * DK), *e1 = ebase + (size_t)(((b * 4 + h) * 2 + 1) * 68 + (nbk < 4 ? 3 - nbk : 71 - nbk)) * (2 * DK);
            *(f32x2_t*)(e0 + 2 * dp) = (f32x2_t){__expf(mid0.x), __expf(mid0.y)}; *(f32x2_t*)(e0 + DK + 2 * dp) = (f32x2_t){__expf(last0.x - mid0.x), __expf(last0.y - mid0.y)};
            *(f32x2_t*)(e1 + 2 * dp) = (f32x2_t){__expf(mid1.x), __expf(mid1.y)}; *(f32x2_t*)(e1 + DK + 2 * dp) = (f32x2_t){__expf(last1.x - mid1.x), __expf(last1.y - mid1.y)};
        }
    }
    __syncthreads();
#undef PS_LOAD
}
__device__ __forceinline__ void phase_prescan(Frame& F, int l) {
    if (F.nb >= 32) { const int combo = F.bid & 31, b = (combo >> 2) & 3, h = combo & 3;
        if ((combo >> 4) == 0) prescan_combo<64, false>(F, l, b, h, F.bid >> 5, F.nb >> 5); else prescan_combo<128, true>(F, l, b, h, F.bid >> 5, F.nb >> 5);
    } else {
        for (int combo = F.bid; combo < 32; combo += F.nb) { const int b = (combo >> 2) & 3, h = combo & 3;
            if ((combo >> 4) == 0) prescan_combo<64, false>(F, l, b, h, 0, 1); else prescan_combo<128, true>(F, l, b, h, 0, 1); }
    }
}

template <int DK, bool HG>
__device__ __forceinline__ void scan_mfma(Frame& F, int l, int b, int h, int z, int vh, unsigned char* lds) {
    constexpr int NDP = DK / 2, NTG = NTHR / NDP, TPT = 64 / NTG, QS = DK + 8, TS = 72, NDT = DK / 16, PPR = DK / 8, NQP = (64 * PPR) / NTHR;
    bf16_t* QD = (bf16_t*)lds; bf16_t* KD = QD + 64 * QS; bf16_t* KDT = KD + 64 * QS; bf16_t* VTs = KDT + DK * TS; bf16_t* AM = VTs + 64 * TS; bf16_t* ST = AM + 64 * TS;
    float* E1s = (float*)(ST + 64 * QS); float* E2s = E1s + DK;
    REFRESH(F);
    const int tid = F.tid, lane = F.lane, w = F.wave, n = lane & 15, g = lane >> 4;
    const int dp = tid % NDP, tg = tid / NDP, vp = tid & 31, vg = tid >> 5;
    const int vt = w & 3, wh = w >> 2;
    const char* p1b = (const char*)F.P1();
    const char* qb; const char* kb; unsigned qstr, kstr, qoff, koff;
    if (HG) { kb = p1b; kstr = NP1 * 2; koff = (unsigned)((PC_DF + z * 512 + h * 128) * 2);
        if (z == 0) { qb = p1b; qstr = NP1 * 2; qoff = (unsigned)((PC_DQ + h * 128) * 2); } else { qb = (const char*)F.BR(); qstr = 4096u; qoff = (unsigned)((1536 + h * 128) * 2); } }
    else if (z == 0) { qb = p1b; kb = p1b; qstr = kstr = NP1 * 2; qoff = (unsigned)((PC_AQ + h * 64) * 2); koff = (unsigned)((PC_AK + h * 64) * 2); }
    else { qb = (const char*)F.SC1(); kb = qb; qstr = kstr = 1024u; qoff = (unsigned)(h * 64 * 2); koff = (unsigned)((256 + h * 64) * 2); }
    const float* eb = F.ESC() + (HG ? 32 * 68 * 128 : 0) + (size_t)(((b * 4 + h) * 2 + z) * 68) * (2 * DK);
    f32x4 accS[NDT / 2];
#pragma unroll
    for (int i = 0; i < NDT / 2; ++i) accS[i] = (f32x4){0.f, 0.f, 0.f, 0.f};
    u32x4 rqp[NQP]; unsigned rk[TPT], rv[4]; float re = 0.f;
    const int vcol = (HG ? PC_DI : PC_AV) + h * 128 + 64 * vh + 2 * vp;
    const int sgn = z ? -1 : 1; const int rstep = sgn * NP1 * 2;
#define SCAN_LOAD(c) do { const int row0_ = seq_row((c) * 64, b, z); \
        _Pragma("unroll") for (int j = 0; j < NQP; ++j) { const int pi_ = tid + NTHR * j; rqp[j] = *(const u32x4*)(qb + ((unsigned)(row0_ + sgn * (pi_ / PPR)) * qstr + qoff + (unsigned)((pi_ % PPR) * 16))); } \
        _Pragma("unroll") for (int tt = 0; tt < TPT; ++tt) rk[tt] = *(const unsigned*)(kb + ((unsigned)(row0_ + sgn * (tg * TPT + tt)) * kstr + koff + (unsigned)(dp * 4))); \
        int ov_ = (row0_ + sgn * vg * 4) * (NP1 * 2) + vcol * 2; \
        _Pragma("unroll") for (int tt = 0; tt < 4; ++tt) { rv[tt] = *(const unsigned*)(p1b + (unsigned)ov_); ov_ += rstep; } \
        if (tid < 2 * DK) re = eb[(c) * (2 * DK) + tid]; } while (0)
    SCAN_LOAD(0);
    constexpr int NCH = (LC + SEQ) / 64;
#pragma unroll 1
    for (int c = 0; c < NCH; ++c) {
        __syncthreads();
#pragma unroll
        for (int j = 0; j < NQP; ++j) { const int pi_ = tid + NTHR * j; *(u32x4*)(QD + (pi_ / PPR) * QS + (pi_ % PPR) * 8) = rqp[j]; }
#pragma unroll
        for (int tt = 0; tt < TPT; ++tt) *(unsigned*)(KD + (tg * TPT + tt) * QS + 2 * dp) = rk[tt];
        {   unsigned kdt[2][TPT / 2];
#pragma unroll
            for (int t2 = 0; t2 < TPT / 2; ++t2) { kdt[0][t2] = (rk[2 * t2] & 0xffffu) | (rk[2 * t2 + 1] << 16); kdt[1][t2] = (rk[2 * t2] >> 16) | (rk[2 * t2 + 1] & 0xffff0000u); }
#pragma unroll
            for (int e = 0; e < 2; ++e) {
                bf16_t* dst = KDT + (2 * dp + e) * TS + tg * TPT;
                if (TPT == 8) { u32x4 o; o.x = kdt[e][0]; o.y = kdt[e][1]; o.z = kdt[e][TPT / 2 - 2]; o.w = kdt[e][TPT / 2 - 1]; *(u32x4*)dst = o; }
                else { u32x2 o; o.x = kdt[e][0]; o.y = kdt[e][1]; *(u32x2*)dst = o; }
            }
        }
        if (tid < 2 * DK) E1s[tid] = re;
        {   u32x2 o0, o1;
            o0.x = (rv[0] & 0xffffu) | (rv[1] << 16); o0.y = (rv[2] & 0xffffu) | (rv[3] << 16);
            o1.x = (rv[0] >> 16) | (rv[1] & 0xffff0000u); o1.y = (rv[2] >> 16) | (rv[3] & 0xffff0000u);
            *(u32x2*)(VTs + (2 * vp) * TS + vg * 4) = o0; *(u32x2*)(VTs + (2 * vp + 1) * TS + vg * 4) = o1; }
        if (c + 1 < NCH) SCAN_LOAD(c + 1);
        __syncthreads();
#pragma unroll
        for (int i = 0; i < NDT / 2; ++i) { const int dt = wh * (NDT / 2) + i; accS[i] = accS[i] * *(const f32x4*)&E1s[16 * dt + 4 * g];
            u32x2 o; o.x = pk2(accS[i].x, accS[i].y); o.y = pk2(accS[i].z, accS[i].w); *(u32x2*)(ST + (16 * vt + n) * QS + 16 * dt + 4 * g) = o; }
        {   const int it = w >> 1, jt0 = 2 * (w & 1);
            f32x4 d0 = {0.f, 0.f, 0.f, 0.f}, d1 = {0.f, 0.f, 0.f, 0.f};
            if (jt0 <= it) {
                bf16x8_t qf[DK / 32], k0f[DK / 32], k1f[DK / 32];
#pragma unroll
                for (int ks = 0; ks < DK / 32; ++ks) { qf[ks] = *(const bf16x8_t*)(QD + (16 * it + n) * QS + 32 * ks + 8 * g); k0f[ks] = *(const bf16x8_t*)(KD + (16 * jt0 + n) * QS + 32 * ks + 8 * g); k1f[ks] = *(const bf16x8_t*)(KD + (16 * (jt0 + 1) + n) * QS + 32 * ks + 8 * g); }
#pragma unroll
                for (int ks = 0; ks < DK / 32; ++ks) { d0 = __builtin_amdgcn_mfma_f32_16x16x32_bf16(k0f[ks], qf[ks], d0, 0, 0, 0); d1 = __builtin_amdgcn_mfma_f32_16x16x32_bf16(k1f[ks], qf[ks], d1, 0, 0, 0); }
                const int i = 16 * it + n, j0 = 16 * jt0 + 4 * g, j1 = j0 + 16;
                d0.x = (j0 + 0 <= i) ? d0.x : 0.f; d0.y = (j0 + 1 <= i) ? d0.y : 0.f; d0.z = (j0 + 2 <= i) ? d0.z : 0.f; d0.w = (j0 + 3 <= i) ? d0.w : 0.f;
                d1.x = (j1 + 0 <= i) ? d1.x : 0.f; d1.y = (j1 + 1 <= i) ? d1.y : 0.f; d1.z = (j1 + 2 <= i) ? d1.z : 0.f; d1.w = (j1 + 3 <= i) ? d1.w : 0.f;
            }
            u32x2 o; o.x = pk2(d0.x, d0.y); o.y = pk2(d0.z, d0.w); *(u32x2*)(AM + (16 * it + n) * TS + 16 * jt0 + 4 * g) = o;
            o.x = pk2(d1.x, d1.y); o.y = pk2(d1.z, d1.w); *(u32x2*)(AM + (16 * it + n) * TS + 16 * (jt0 + 1) + 4 * g) = o;
        }
        __syncthreads();
        {   f32x4 o[2];
#pragma unroll
            for (int ii = 0; ii < 2; ++ii) o[ii] = (f32x4){0.f, 0.f, 0.f, 0.f};
#pragma unroll
            for (int ks = 0; ks < 2; ++ks) { const bf16x8_t af = *(const bf16x8_t*)(VTs + (16 * vt + n) * TS + 32 * ks + 8 * g); bf16x8_t bf[2];
#pragma unroll
                for (int ii = 0; ii < 2; ++ii) bf[ii] = *(const bf16x8_t*)(AM + (16 * (2 * wh + ii) + n) * TS + 32 * ks + 8 * g);
#pragma unroll
                for (int ii = 0; ii < 2; ++ii) o[ii] = __builtin_amdgcn_mfma_f32_16x16x32_bf16(af, bf[ii], o[ii], 0, 0, 0); }
#pragma unroll
            for (int ks = 0; ks < DK / 32; ++ks) { const bf16x8_t af = *(const bf16x8_t*)(ST + (16 * vt + n) * QS + 32 * ks + 8 * g); bf16x8_t bf[2];
#pragma unroll
                for (int ii = 0; ii < 2; ++ii) bf[ii] = *(const bf16x8_t*)(QD + (16 * (2 * wh + ii) + n) * QS + 32 * ks + 8 * g);
#pragma unroll
                for (int ii = 0; ii < 2; ++ii) o[ii] = __builtin_amdgcn_mfma_f32_16x16x32_bf16(af, bf[ii], o[ii], 0, 0, 0); }
            const int row0 = seq_row(c * 64, b, z) + sgn * (32 * wh + n), vc = h * 128 + 64 * vh + 16 * vt + 4 * g;
            char* dstb; unsigned doff; int dstride;
            if (HG) { dstb = (char*)F.ODH(); doff = (unsigned)row0 * 2048u + (unsigned)(z * 512 + vc) * 2u; dstride = sgn * 16 * 2048; }
            else if (z == 0) { dstb = (char*)F.BR(); doff = (unsigned)row0 * 4096u + (unsigned)vc * 2u; dstride = sgn * 16 * 4096; }
            else { dstb = (char*)F.OBA(); doff = (unsigned)row0 * 1024u + (unsigned)vc * 2u; dstride = sgn * 16 * 1024; }
#pragma unroll
            for (int ii = 0; ii < 2; ++ii) { u32x2 o2; o2.x = pk2(o[ii].x, o[ii].y); o2.y = pk2(o[ii].z, o[ii].w); *(u32x2*)(dstb + (unsigned)((int)doff + ii * dstride)) = o2; }
        }
#pragma unroll
        for (int ks = 0; ks < 2; ++ks) { const bf16x8_t bv = *(const bf16x8_t*)(VTs + (16 * vt + n) * TS + 32 * ks + 8 * g); bf16x8_t af[NDT / 2];
#pragma unroll
            for (int i = 0; i < NDT / 2; ++i) af[i] = *(const bf16x8_t*)(KDT + (16 * (wh * (NDT / 2) + i) + n) * TS + 32 * ks + 8 * g);
#pragma unroll
            for (int i = 0; i < NDT / 2; ++i) accS[i] = __builtin_amdgcn_mfma_f32_16x16x32_bf16(af[i], bv, accS[i], 0, 0, 0); }
#pragma unroll
        for (int i = 0; i < NDT / 2; ++i) accS[i] = accS[i] * *(const f32x4*)&E2s[16 * (wh * (NDT / 2) + i) + 4 * g];
    }
    __syncthreads();
#undef SCAN_LOAD
}

__device__ __forceinline__ void phase_mix(Frame& F, int l) {
    const int n_scan = 128;
    const int nsb = (F.nb > 192) ? 128 : 0;
    if (nsb == 0 || F.bid < nsb) {
        for (int it = F.bid; it < n_scan; it += (nsb ? nsb : F.nb)) {
            const int br = it >> 6, r = (it >> 1) & 31, vh = it & 1, b = r >> 3, h = (r >> 1) & 3, z = r & 1;
            if (br == 0) scan_mfma<64, false>(F, l, b, h, z, vh, (unsigned char*)F.smf); else scan_mfma<128, true>(F, l, b, h, z, vh, (unsigned char*)F.smf);
        }
        __syncthreads();
    }
    float* rpb_s = F.smf;
    {   float tv[(8 * 15 * 64) / NTHR];
#pragma unroll
        for (int k = 0; k < (8 * 15 * 64) / NTHR; ++k) { const int i = F.tid + k * NTHR, dcp = i & 63, hr = i >> 6; tv[k] = (dcp >= 16 && dcp < 47) ? F.p.na_rpb[l * 8 * 465 + hr * 31 + (dcp - 16)] : 0.f; }
#pragma unroll
        for (int k = 0; k < (8 * 15 * 64) / NTHR; ++k) rpb_s[F.tid + k * NTHR] = tv[k] * 1.44269504089f; }
    bf16_t* sbuf = (bf16_t*)(F.smf + 8 * 15 * 64);
    unsigned* qhead = F.cnt() + 64 + l * 16;
    int* cur = (int*)((unsigned char*)F.smf - LDS_STAGE + 32);
    const int n_wa = 512, n_na = 512, n_cna = (l == 0) ? 32 : 0, n_cwa = (l == 0) ? 32 : 0, total = n_wa + n_na + n_cna + n_cwa;
    int nxt = 0;
    if (F.tid == 0) nxt = (int)atomicAdd(qhead, 1u);
    for (;;) {
        __syncthreads();
        if (F.tid == 0) *cur = nxt;
        __syncthreads();
        const int it = *cur;
        if (it >= total) break;
        if (F.tid == 0) nxt = (int)atomicAdd(qhead, 1u);
        if (it < n_wa) attn_block<1>(F, l, it, rpb_s, sbuf);
        else if (it < n_wa + n_na) attn_block<0>(F, l, it - n_wa, rpb_s, sbuf);
        else if (it < n_wa + n_na + n_cna) attn_block<2>(F, l, it - n_wa - n_na, rpb_s, sbuf);
        else attn_block<3>(F, l, it - n_wa - n_na - n_cna, rpb_s, sbuf);
    }
}

__device__ __forceinline__ void phase_prepad(Frame& F, int l) {
    const int gw = F.bid * 8 + F.wave, ngw = F.nb * 8, npairs = ((l == 0) ? NROW : NTOK) / 2, c0 = F.lane * 8;
    for (int pi = gw; pi < npairs; pi += ngw) {
        u32x4 ra[2][2], rb[2][2], rg[2][2];
#pragma unroll
        for (int q = 0; q < 2; ++q) { const size_t row = (size_t)pi * 2 + q;
            ra[q][0] = *(const u32x4*)(F.BR() + row * 2048 + c0); rb[q][0] = *(const u32x4*)(F.OBA() + row * 512 + c0); rg[q][0] = *(const u32x4*)(F.P1() + row * NP1 + PC_AG + c0);
            ra[q][1] = *(const u32x4*)(F.ODH() + row * 1024 + c0); rb[q][1] = *(const u32x4*)(F.ODH() + row * 1024 + 512 + c0); rg[q][1] = *(const u32x4*)(F.P1() + row * NP1 + PC_DG + c0); }
#pragma unroll
        for (int q = 0; q < 2; ++q)
#pragma unroll
            for (int br = 0; br < 2; ++br) {
                const unsigned ua[4] = {ra[q][br].x, ra[q][br].y, ra[q][br].z, ra[q][br].w}, ub[4] = {rb[q][br].x, rb[q][br].y, rb[q][br].z, rb[q][br].w}, ug[4] = {rg[q][br].x, rg[q][br].y, rg[q][br].z, rg[q][br].w};
                float o[8], g[8]; float ss = 0.f;
#pragma unroll
                for (int j = 0; j < 4; ++j) { o[2 * j] = __uint_as_float(ua[j] << 16) + __uint_as_float(ub[j] << 16); o[2 * j + 1] = __uint_as_float(ua[j] & 0xffff0000u) + __uint_as_float(ub[j] & 0xffff0000u);
                    g[2 * j] = __uint_as_float(ug[j] << 16); g[2 * j + 1] = __uint_as_float(ug[j] & 0xffff0000u); ss += o[2 * j] * o[2 * j] + o[2 * j + 1] * o[2 * j + 1]; }
                ss += __shfl_xor(ss, 1); ss += __shfl_xor(ss, 2); ss += __shfl_xor(ss, 4); ss += __shfl_xor(ss, 8);
                const float rs = rsqrtf(ss * (1.f / 128.f) + 1e-6f);
#pragma unroll
                for (int j = 0; j < 8; ++j) o[j] = o[j] * rs * siluf_(g[j]);
                st8(F.BR() + ((size_t)pi * 2 + q) * 2048 + (br ? 1536 : 0) + c0, o);
            }
    }
}

__device__ __forceinline__ void phase_ln1(Frame& F, int l) {
    const int nrows = (l == 0) ? NROW : NTOK, ngroups = nrows / 64;
    const float* lg = F.p.ln_g + (size_t)(l * 2 + 0) * DM; const float* lbb = F.p.ln_b + (size_t)(l * 2 + 0) * DM;
    float* part = F.smf;
    const int wv = __builtin_amdgcn_readfirstlane(F.wave);
    float* stg = F.smf + 8 * 36 * 64 + wv * (64 * 17 + 16 * 40);
    float* wl = stg + 64 * 17;
    for (int grp = F.bid; grp < ngroups; grp += F.nb) {
        const int row0 = grp * 64, rb = row_batch(row0);
        const float* mv = F.modv() + ((size_t)l * 5 + rb) * 6144;
        float* xg = row0 < NTOK ? F.p.out + (size_t)row0 * DM : F.cxm() + (size_t)(row0 - NTOK) * DM;
#pragma unroll 1
        for (int rr = 0; rr < 8; rr += 2) {
            const int lr = wv * 8 + rr; float* xr = xg + (size_t)lr * DM;
            f32x4 v[2][4]; float s[2] = {0.f, 0.f};
#pragma unroll
            for (int q = 0; q < 2; ++q)
#pragma unroll
                for (int j = 0; j < 4; ++j) v[q][j] = *(const f32x4*)(xr + (size_t)q * DM + j * 256 + F.lane * 4);
#pragma unroll
            for (int q = 0; q < 2; ++q)
#pragma unroll
                for (int j = 0; j < 4; ++j) s[q] += (v[q][j].x + v[q][j].y) + (v[q][j].z + v[q][j].w);
#pragma unroll
            for (int o = 1; o < 64; o <<= 1) { s[0] += __shfl_xor(s[0], o); s[1] += __shfl_xor(s[1], o); }
            float s2[2] = {0.f, 0.f};
#pragma unroll
            for (int q = 0; q < 2; ++q) { const float mean = s[q] * (1.f / DM);
#pragma unroll
                for (int j = 0; j < 4; ++j) { v[q][j] = v[q][j] - mean; s2[q] += (v[q][j].x * v[q][j].x + v[q][j].y * v[q][j].y) + (v[q][j].z * v[q][j].z + v[q][j].w * v[q][j].w); } }
#pragma unroll
            for (int o = 1; o < 64; o <<= 1) { s2[0] += __shfl_xor(s2[0], o); s2[1] += __shfl_xor(s2[1], o); }
#pragma unroll
            for (int j = 0; j < 4; ++j) { const int d = j * 256 + F.lane * 4;
                const f32x4 g4 = *(const f32x4*)(lg + d), b4 = *(const f32x4*)(lbb + d), m3 = *(const f32x4*)(mv + 3 * 1024 + d), m4 = *(const f32x4*)(mv + 4 * 1024 + d);
#pragma unroll
                for (int q = 0; q < 2; ++q) { const float rstd = rsqrtf(s2[q] * (1.f / DM) + LN_EPS);
                    const f32x4 xn = v[q][j] * rstd * g4 + b4;
                    *(f32x4*)(xr + (size_t)q * DM + d) = xn;
                    const f32x4 h2 = xn * (1.f + m4) + m3;
                    u32x2 o2; o2.x = pk2(h2.x, h2.y); o2.y = pk2(h2.z, h2.w);
                    *(u32x2*)(F.HX2() + (size_t)(row0 + lr + q) * DM + d) = o2; } }
        }
        __syncthreads();
        {   f32x4 acc[4][3];
#pragma unroll
            for (int mt = 0; mt < 4; ++mt)
#pragma unroll
                for (int nt = 0; nt < 3; ++nt) acc[mt][nt] = (f32x4){0.f, 0.f, 0.f, 0.f};
            const float* wgp = F.p.moe_w_group + ((size_t)l * DM + wv * 128) * 4; const float* wep = F.p.moe_w_expert + ((size_t)l * DM + wv * 128) * 32;
            const float* m3p = mv + 3 * 1024 + wv * 128; const float* m4p = mv + 4 * 1024 + wv * 128;
            const int ln = F.lane & 15, lk = F.lane >> 4;
#pragma unroll 1
            for (int dc = 0; dc < 128; dc += 16) {
                f32x4 t[4]; float bw[4][3];
#pragma unroll
                for (int i = 0; i < 4; ++i) t[i] = *(const f32x4*)(xg + (size_t)(16 * i + (F.lane >> 2)) * DM + wv * 128 + dc + (F.lane & 3) * 4);
                const f32x4 m3v = *(const f32x4*)(m3p + dc + (F.lane & 3) * 4), m4v = *(const f32x4*)(m4p + dc + (F.lane & 3) * 4);
#pragma unroll
                for (int ks = 0; ks < 4; ++ks) { const int d = dc + 4 * ks + lk; bw[ks][0] = wep[(size_t)d * 32 + ln]; bw[ks][1] = wep[(size_t)d * 32 + 16 + ln]; bw[ks][2] = (ln < 4) ? wgp[(size_t)d * 4 + ln] : 0.f; }
#pragma unroll
                for (int i = 0; i < 4; ++i) { float* sp = stg + (16 * i + (F.lane >> 2)) * 17 + (F.lane & 3) * 4;
                    sp[0] = t[i].x * (1.f + m4v.x) + m3v.x; sp[1] = t[i].y * (1.f + m4v.y) + m3v.y; sp[2] = t[i].z * (1.f + m4v.z) + m3v.z; sp[3] = t[i].w * (1.f + m4v.w) + m3v.w; }
                asm volatile("s_waitcnt lgkmcnt(0)" ::: "memory");
#pragma unroll
                for (int ks = 0; ks < 4; ++ks)
#pragma unroll
                    for (int mt = 0; mt < 4; ++mt) { const float av = stg[(16 * mt + ln) * 17 + 4 * ks + lk];
#pragma unroll
                        for (int nt = 0; nt < 3; ++nt) acc[mt][nt] = __builtin_amdgcn_mfma_f32_16x16x4f32(av, bw[ks][nt], acc[mt][nt], 0, 0, 0); }
                asm volatile("s_waitcnt lgkmcnt(0)" ::: "memory");
            }
#pragma unroll
            for (int mt = 0; mt < 4; ++mt)
#pragma unroll
                for (int nt = 0; nt < 3; ++nt) { const int oi = (nt == 2) ? ln : 4 + 16 * nt + ln;
                    if (nt < 2 || ln < 4) {
#pragma unroll
                        for (int r = 0; r < 4; ++r) part[(wv * 36 + oi) * 64 + 16 * mt + 4 * lk + r] = acc[mt][nt][r]; } }
        }
        __syncthreads();
        if (wv == 0) {
            const int row = row0 + F.lane;
            float gl[4]; int gi = 0; float gm = -3.4e38f;
#pragma unroll
            for (int o = 0; o < 4; ++o) { float t = F.p.moe_b_group[l * 4 + o];
#pragma unroll
                for (int w2 = 0; w2 < 8; ++w2) t += part[(w2 * 36 + o) * 64 + F.lane];
                gl[o] = t; if (t > gm) { gm = t; gi = o; } }
            float gs = 0.f;
#pragma unroll
            for (int o = 0; o < 4; ++o) gs += expf(gl[o] - gm);
            const float gwt = 1.f / gs;
            float e1 = -3.4e38f, e2 = -3.4e38f; int i1 = 0, i2 = 0;
#pragma unroll
            for (int o8 = 0; o8 < 8; ++o8) { const int o = gi * 8 + o8; float ev = F.p.moe_b_expert[l * 32 + o];
#pragma unroll
                for (int w2 = 0; w2 < 8; ++w2) ev += part[(w2 * 36 + 4 + o) * 64 + F.lane];
                if (ev > e1) { e2 = e1; i2 = i1; e1 = ev; i1 = o; } else if (ev > e2) { e2 = ev; i2 = o; } }
            const float w1 = 1.f / (1.f + expf(e2 - e1)), w2v = 1.f - w1;
            unsigned* lh = (unsigned*)(stg + 64 * 17 + 16 * 40 - 64);
            if (F.lane < 32) lh[F.lane] = 0u;
            asm volatile("s_waitcnt lgkmcnt(0)" ::: "memory");
            const unsigned r1 = atomicAdd(&lh[i1], 1u), r2 = atomicAdd(&lh[i2], 1u);
            asm volatile("s_waitcnt lgkmcnt(0)" ::: "memory");
            if (F.lane < 32) { const unsigned c = lh[F.lane]; lh[32 + F.lane] = c ? atomicAdd(&F.cnt()[l * 32 + F.lane], c) : 0u; }
            asm volatile("s_waitcnt vmcnt(0) lgkmcnt(0)" ::: "memory");
            const unsigned p1 = lh[32 + i1] + r1, p2 = lh[32 + i2] + r2;
            F.tokE()[row * 2] = i1; F.tokI()[row * 2] = (int)p1; F.tokW()[row * 2] = gwt * w1;
            F.tokE()[row * 2 + 1] = i2; F.tokI()[row * 2 + 1] = (int)p2; F.tokW()[row * 2 + 1] = gwt * w2v;
        }
        __syncthreads();
    }
}

__device__ __forceinline__ void phase_gather(Frame& F, int l) {
    int* off = (int*)F.smf; moe_offsets(F, l, off);
    const int nrows = (l == 0) ? NROW : NTOK;
    for (int sl = F.bid * NTHR + F.tid; sl < 2 * nrows; sl += F.nb * NTHR) { const int dst = off[F.tokE()[sl]] + F.tokI()[sl]; F.rmap()[dst] = sl; F.roww()[dst] = F.tokW()[sl]; }
    const int gw = F.bid * 8 + F.wave, ngw = F.nb * 8;
    for (int e = gw; e < 32; e += ngw) { const int c = (int)F.cnt()[l * 32 + e], pc = (c + 255) & ~255;
        for (int j = c + F.lane; j < pc; j += 64) { F.rmap()[off[e] + j] = -1; F.roww()[off[e] + j] = 0.f; } }
}
__device__ __forceinline__ int expert_of_row(const int* off, int row) { int e = 0;
#pragma unroll 1
    for (int i = 1; i < 32; ++i) if (row >= off[i]) e = i;
    return e; }

__device__ __forceinline__ void phase_ln2(Frame& F, int l) {
    const int gw = F.bid * 8 + F.wave, ngw = F.nb * 8, npairs = ((l == 0) ? NROW : NTOK) / 2;
    const float* lg = F.p.ln_g + (size_t)(l * 2 + 1) * DM; const float* lbb = F.p.ln_b + (size_t)(l * 2 + 1) * DM;
    const bf16_t* Y = F.BR();
    const bool tmo_set = (l == DEPTH - 1) && (__hip_atomic_load((unsigned*)(F.ws + WS_CTL) + XB_TMO, __ATOMIC_RELAXED, __HIP_MEMORY_SCOPE_AGENT) != 0u);
    for (int pi = gw; pi < npairs; pi += ngw) {
        const int row0 = pi * 2, rb = row_batch(row0);
        const float* xm = row0 < NTOK ? F.p.out + (size_t)row0 * DM : F.cxm() + (size_t)(row0 - NTOK) * DM;
        float* xo = row0 < NTOK ? F.p.out + (size_t)row0 * DM : F.cxo() + (size_t)(row0 - NTOK) * DM;
        const float* mv = F.modv() + ((size_t)l * 5 + rb) * 6144;
        u32x2 y0[2][4], y1[2][4]; f32x4 xv[2][4], m5[4];
#pragma unroll
        for (int j = 0; j < 4; ++j) { const int d = j * 256 + F.lane * 4; m5[j] = *(const f32x4*)(mv + 5 * 1024 + d);
#pragma unroll
            for (int q = 0; q < 2; ++q) { y0[q][j] = *(const u32x2*)(Y + (size_t)((row0 + q) * 2) * DM + d); y1[q][j] = *(const u32x2*)(Y + (size_t)((row0 + q) * 2 + 1) * DM + d); xv[q][j] = *(const f32x4*)(xm + (size_t)q * DM + d); } }
        f32x4 v[2][4]; float s[2] = {0.f, 0.f};
#pragma unroll
        for (int q = 0; q < 2; ++q)
#pragma unroll
            for (int j = 0; j < 4; ++j) { f32x4 y; y.x = __uint_as_float(y0[q][j].x << 16) + __uint_as_float(y1[q][j].x << 16); y.y = __uint_as_float(y0[q][j].x & 0xffff0000u) + __uint_as_float(y1[q][j].x & 0xffff0000u);
                y.z = __uint_as_float(y0[q][j].y << 16) + __uint_as_float(y1[q][j].y << 16); y.w = __uint_as_float(y0[q][j].y & 0xffff0000u) + __uint_as_float(y1[q][j].y & 0xffff0000u);
                v[q][j] = ALPHA * xv[q][j] + m5[j] * y; s[q] += (v[q][j].x + v[q][j].y) + (v[q][j].z + v[q][j].w); }
#pragma unroll
        for (int o = 1; o < 64; o <<= 1) { s[0] += __shfl_xor(s[0], o); s[1] += __shfl_xor(s[1], o); }
        float s2[2] = {0.f, 0.f};
#pragma unroll
        for (int q = 0; q < 2; ++q) { const float mean = s[q] * (1.f / DM);
#pragma unroll
            for (int j = 0; j < 4; ++j) { v[q][j] = v[q][j] - mean; s2[q] += (v[q][j].x * v[q][j].x + v[q][j].y * v[q][j].y) + (v[q][j].z * v[q][j].z + v[q][j].w * v[q][j].w); } }
#pragma unroll
        for (int o = 1; o < 64; o <<= 1) { s2[0] += __shfl_xor(s2[0], o); s2[1] += __shfl_xor(s2[1], o); }
        const float* mn = F.modv() + ((size_t)((l + 1 < DEPTH) ? l + 1 : l) * 5 + rb) * 6144;
#pragma unroll
        for (int j = 0; j < 4; ++j) { const int d = j * 256 + F.lane * 4;
            const f32x4 g4 = *(const f32x4*)(lg + d), b4 = *(const f32x4*)(lbb + d), m0 = *(const f32x4*)(mn + d), m1 = *(const f32x4*)(mn + 1024 + d);
#pragma unroll
            for (int q = 0; q < 2; ++q) { const float rstd = rsqrtf(s2[q] * (1.f / DM) + LN_EPS);
                f32x4 xn = v[q][j] * rstd * g4 + b4;
                if (tmo_set) xn = xn * __uint_as_float(0x7fc00000u);
                *(f32x4*)(xo + (size_t)q * DM + d) = xn;
                if (l + 1 < DEPTH) { const f32x4 h = xn * (1.f + m1) + m0; u32x2 o2; o2.x = pk2(h.x, h.y); o2.y = pk2(h.z, h.w); *(u32x2*)(F.HX() + (size_t)(row0 + q) * DM + d) = o2; } }
        }
    }
}

constexpr int NPL = 13, NPH = 1 + DEPTH * NPL;
__global__ void __launch_bounds__(NTHR, 2) mega(Params p) {
    extern __shared__ __attribute__((aligned(16))) unsigned char smem[];
    Frame F; F.p = p; F.bid = blockIdx.x; F.nb = gridDim.x; F.tid = threadIdx.x; F.lane = threadIdx.x & 63; F.wave = threadIdx.x >> 6; F.wid_s = __builtin_amdgcn_readfirstlane(threadIdx.x >> 6);
    F.smf = (float*)(smem + LDS_STAGE);
    LAS unsigned char* stage = (LAS unsigned char*)smem + LDS_STAGE; int* offt = (int*)(smem + 64);
    unsigned char* ws = p.ws; F.ws = ws;

    if (threadIdx.x == 0) *(uint4*)smem = make_uint4(0u, 0u, 0u, 0u);
    __syncthreads();
    unsigned* barw = (unsigned*)(ws + WS_CTL);
    XcdBarrier bar; bar.bar = barw; bar.x = 0; bar.st = (volatile LAS unsigned*)smem;
    const bool multi = (p.ph_hi - p.ph_lo) > 1;
    if (multi) bar = xcd_barrier_post(barw, (volatile LAS unsigned*)smem);
    const int lo = p.ph_lo, hi = p.ph_hi;
#define IN(k) (lo <= (k) && (k) < hi)
#define SEAM(k) do { if (IN(k) && IN((k) + 1)) xcd_barrier(bar); else __syncthreads(); } while (0)

    if (IN(0)) { REFRESH(F); phase_mod(F); __syncthreads(); phase_conv_a(F, 0, F.bid * 8 + F.wave, F.nb * 8); }
    SEAM(0);
#pragma unroll 1
    for (int l = 0; l < DEPTH; ++l) {
        const int pb = 1 + l * NPL;
        const float* xlat = (l == 0) ? p.x : p.out; const float* xctx = (l == 0) ? p.ctx : F.cxo();
        const int Mrows = (l == 0) ? NROW : NTOK;
        if (l == 0) {
            if (IN(pb + 0)) { REFRESH(F); phase_prep(F, 0, p.x, p.ctx); }
            SEAM(pb + 0);
        }
        if (IN(pb + 1)) { REFRESH(F);
            float* rtab = (float*)(smem + LDS_ROPE);
            for (int e = F.tid; e < 1024; e += NTHR) { const int pp = e >> 4, i = e & 15; const float inv = powf(10000.f, -(float)i / 16.f), ang = (float)pp * inv; rtab[2 * e] = cosf(ang); rtab[2 * e + 1] = sinf(ang); }
            __syncthreads();
            pg::SchedG1 S{(const char*)F.HX(), (const char*)F.W1t(), (const char*)F.Wvt(), F.nb, F.bid}; pg::EpiG1 E{F.P1(), F.VT(), rtab, F.lb(), l};
            pg::gemm_phase(stage, DM, DM, DM, S, E);
        }
        SEAM(pb + 1);
        if (IN(pb + 2)) { REFRESH(F); phase_prescan(F, l); }
        SEAM(pb + 2);
        if (IN(pb + 3)) { REFRESH(F); phase_mix(F, l); }
        SEAM(pb + 3);
        if (IN(pb + 4)) { REFRESH(F); phase_prepad(F, l); }
        SEAM(pb + 4);
        if (IN(pb + 5)) { REFRESH(F);
            pg::SchedStatic S{(const char*)F.HX(), (const char*)F.Wgt(), (size_t)256 * DM * 2, (size_t)256 * DM * 2, Mrows / 256, NGATE / 256, F.nb, F.bid}; pg::EpiGate E{F.G()};
            pg::gemm_phase(stage, DM, DM, DM, S, E);
            __syncthreads();
            { const int nun = (Mrows / 256) * (NGATE / 256), ne = nun % F.nb, nw = (Mrows / 256) * (DM / 256);
              const bool later = nw > F.nb && 4 * (nw - F.nb) <= F.nb;
              phase_conv_b(F, l, (nun > F.nb && 2 * ne <= F.nb) ? ne : 0, later ? CONVB_MOE : 0, CONVB_MOE + CONVB_PROJ); }
        }
        SEAM(pb + 5);
        if (IN(pb + 6)) { REFRESH(F);
            pg::SchedMerge S{(const char*)F.BR(), (const char*)F.Wbrt(), (Mrows / 256) * 4, F.nb, F.bid}; pg::EpiMerge E{F.G(), F.HX(), (bf16_t*)(F.ws + WS_PM)};
            pg::gemm_phase(stage, 2048, 512, 512, S, E);
            if (S.split()) { REFRESH(F); phase_conv_b(F, l, (S.ntile - F.nb) * 4, 0, CONVB_MOE / 2); }
            if (S.split()) {
                xcd_barrier(bar);
                REFRESH(F);
                const bf16_t* pm = (const bf16_t*)(F.ws + WS_PM); bf16_t* mo = F.HX() + (size_t)NTOK * DM;
                for (int e = (F.bid * NTHR + F.tid) * 8; e < NCTX * DM; e += F.nb * NTHR * 8) {
                    u32x4 v[4];
#pragma unroll
                    for (int br = 0; br < 4; ++br) v[br] = *(const u32x4*)(pm + (size_t)br * NCTX * DM + e);
                    float a[8] = {0.f, 0.f, 0.f, 0.f, 0.f, 0.f, 0.f, 0.f};
#pragma unroll
                    for (int br = 0; br < 4; ++br) { const unsigned uu[4] = {v[br].x, v[br].y, v[br].z, v[br].w};
#pragma unroll
                        for (int j = 0; j < 4; ++j) { a[2 * j] += __uint_as_float(uu[j] << 16); a[2 * j + 1] += __uint_as_float(uu[j] & 0xffff0000u); } }
                    u32x4 o; o.x = pk2(a[0], a[1]); o.y = pk2(a[2], a[3]); o.z = pk2(a[4], a[5]); o.w = pk2(a[6], a[7]); *(u32x4*)(mo + e) = o;
                }
            }
        }
        SEAM(pb + 6);
        if (IN(pb + 7)) { REFRESH(F);
            pg::SchedStatic S{(const char*)F.HX(), (const char*)F.Woutt(), (size_t)256 * DM * 2, (size_t)256 * DM * 2, Mrows / 256, DM / 256, F.nb, F.bid};
            pg::EpiWout E{xlat, xctx, p.out, F.cxm(), F.modv() + (size_t)l * 5 * 6144};
            pg::gemm_phase(stage, DM, DM, DM, S, E);
            { const int nw = (Mrows / 256) * (DM / 256); if (nw > F.nb && 4 * (nw - F.nb) <= F.nb) { REFRESH(F); phase_conv_b(F, l, nw - F.nb, CONVB_MOE / 2, CONVB_MOE); } }
        }
        SEAM(pb + 7);
        if (IN(pb + 8)) { REFRESH(F); phase_ln1(F, l); }
        SEAM(pb + 8);
        if (IN(pb + 9)) { REFRESH(F); phase_gather(F, l); }
        SEAM(pb + 9);
        if (IN(pb + 10)) { REFRESH(F);
            moe_offsets(F, l, offt);
            pg::SchedMoeG S{(const char*)F.HX2(), (const char*)F.Wgu(), offt, F.rmap(), (size_t)512 * DM * 2, (size_t)256 * DM * 2, offt[32] / 256, 2, F.nb, F.bid};
            pg::EpiMoe1 E{F.HID(), F.roww()};
            pg::gemm_phase(stage, DM, DM, DM, S, E);
            if (l + 1 < DEPTH) {
                const int nun = (offt[32] / 256) * 2, nu2 = nun > F.nb ? min(nun - F.nb, F.nb) : 0;
                REFRESH(F);
                if (2 * nu2 <= F.nb) { if (F.bid >= nu2) phase_conv_a(F, l + 1, (F.bid - nu2) * 8 + F.wave, (F.nb - nu2) * 8); }
                else phase_conv_a(F, l + 1, F.bid * 8 + F.wave, F.nb * 8);
            }
        }
        SEAM(pb + 10);
        if (IN(pb + 11)) { REFRESH(F);
            moe_offsets(F, l, offt);
            pg::SchedMoe S{(const char*)F.HID(), (const char*)F.Wd(), offt, (size_t)256 * 256 * 2, (size_t)DM * 256 * 2, (size_t)256 * 256 * 2, offt[32] / 256, 4, F.nb, F.bid};
            pg::EpiMoe2 E{F.BR(), F.rmap(), (bf16_t*)(F.ws + WS_DUMP)};
            pg::gemm_phase(stage, 256, 256, 256, S, E);
        }
        SEAM(pb + 11);
        if (IN(pb + 12)) { REFRESH(F); phase_ln2(F, l); }
        SEAM(pb + 12);
    }
#undef IN
#undef SEAM
}

extern "C" void kernel_launch(void* const* d_in, const int* in_sizes, int n_in, void* d_out, int out_size, void* d_ws, size_t ws_size, hipStream_t stream) {
    static int grid = 0;
    if (grid == 0) {
        if (n_in != 23 || out_size != NTOK * DM || ws_size < WS_END) { fprintf(stderr, "kernel_launch: unexpected shapes (n_in %d out %d ws %zu need %zu)\n", n_in, out_size, ws_size, (size_t)WS_END); grid = -1; return; }
        int dev = 0, cus = 0;
        if (hipGetDevice(&dev) != hipSuccess || hipDeviceGetAttribute(&cus, hipDeviceAttributeMultiprocessorCount, dev) != hipSuccess) { grid = -1; return; }
        if (hipFuncSetAttribute((const void*)mega, hipFuncAttributeMaxDynamicSharedMemorySize, LDS_BYTES) != hipSuccess) { fprintf(stderr, "kernel_launch: hipFuncSetAttribute failed\n"); grid = -1; return; }
        int per_cu = 0;
        if (hipOccupancyMaxActiveBlocksPerMultiprocessor(&per_cu, (const void*)mega, NTHR, LDS_BYTES) != hipSuccess || per_cu < 1) fprintf(stderr, "kernel_launch: occupancy query reports %d blocks per CU\n", per_cu);
        (void)hipGetLastError();
        grid = cus >= 32 ? (cus & ~31) : cus;
    }
    if (grid < 0) return;
    (void)hipMemsetAsync((char*)d_ws + WS_CTL, 0, CTL_BYTES, stream);
    Params p; memset(&p, 0, sizeof(p));
    const float** pp = (const float**)&p;
    for (int i = 0; i < 23; ++i) pp[i] = (const float*)d_in[i];
    p.out = (float*)d_out; p.ws = (unsigned char*)d_ws;
    p.ph_lo = 0; p.ph_hi = NPH;
    hipLaunchKernelGGL(mega, dim3(grid), dim3(NTHR), LDS_BYTES, stream, p);
}
```

```cpp
#include <hip/hip_runtime.h>
#include <cstdio>
#include <cstdint>
#include <cstring>

typedef unsigned short bf16_t;
typedef float f32x4 __attribute__((ext_vector_type(4)));
typedef unsigned u32x4 __attribute__((ext_vector_type(4)));
typedef unsigned u32x2 __attribute__((ext_vector_type(2)));

constexpr int NB = 4, SEQ = 4096, LC = 256, DM = 1024, DEPTH = 2;
constexpr int NTOK = NB * SEQ, NCTX = NB * LC, NROW = NTOK + NCTX;
constexpr int DIN = 10528;
constexpr int O_AQ = 0, O_AK = 256, O_AV = 512, O_AG = 1024, O_ALR = 1536, O_BQ = 1568, O_BK = 2080, O_BV = 2592, O_CQ = 3104, O_CK = 3616,
              O_CV = 3744, O_DQ = 3872, O_DF = 4384, O_DI = 5408, O_DG = 5920, O_GATE = 6432;
constexpr int PC_AQ = 0, PC_AK = 256, PC_AV = 512, PC_BQ = 1024, PC_BK = 1536, PC_CQ = 2048, PC_CK = 2560, PC_ALR = 2688, PC_DQ = 2816,
              PC_DF = 3328, PC_DI = 4352, PC_AG = 4864, PC_DG = 5376, NP1 = 5888;
constexpr float QSCALE = 0.125f * 1.44269504089f;
constexpr int NVT = 768;
constexpr int NGATE = 4096;
constexpr int XS_ROWS = 43008;
constexpr float LN_EPS = 1e-5f;
constexpr float ALPHA = 1.41421356237f;

constexpr size_t al256(size_t x) { return (x + 255) & ~(size_t)255; }
constexpr size_t WS_CTL = 0;
constexpr size_t CTL_BYTES = 32768;
constexpr size_t CTL_CNT = 28672;
constexpr size_t WS_DUMP = WS_CTL + CTL_BYTES;
constexpr size_t WS_MODV = WS_DUMP + 4096;
constexpr size_t WS_LB = WS_MODV + al256((size_t)DEPTH * 5 * 6144 * 4);
constexpr size_t WS_TOKE = WS_LB + 4096;
constexpr size_t WS_TOKI = WS_TOKE + al256((size_t)2 * NROW * 4);
constexpr size_t WS_TOKW = WS_TOKI + al256((size_t)2 * NROW * 4);
constexpr size_t WS_RMAP = WS_TOKW + al256((size_t)2 * NROW * 4);
constexpr size_t WS_ROWW = WS_RMAP + al256((size_t)XS_ROWS * 4);
constexpr size_t WS_CXM = WS_ROWW + al256((size_t)XS_ROWS * 4);
constexpr size_t WS_CXO = WS_CXM + (size_t)NCTX * DM * 4;
constexpr size_t WS_WTA = WS_CXO + (size_t)NCTX * DM * 4;
constexpr size_t WTA_W1 = 0;
constexpr size_t WTA_WV = WTA_W1 + (size_t)NP1 * DM * 2;
constexpr size_t WTA_WBR = WTA_WV + (size_t)NVT * DM * 2;
constexpr size_t WTA_WO = WTA_WBR + (size_t)4 * DM * 512 * 2;
constexpr size_t WTA_WG = WTA_WO + (size_t)DM * DM * 2;
constexpr size_t WTA_BYTES = WTA_WG + (size_t)NGATE * DM * 2;
constexpr size_t WS_SC1 = WS_WTA;
static_assert((size_t)NROW * 512 * 2 <= WTA_WG, "scan scratch must fit in front of the gate weights");
constexpr size_t WS_HX = WS_WTA + WTA_BYTES;
constexpr size_t WS_VT = WS_HX + (size_t)NROW * DM * 2;
constexpr size_t WS_OBA = WS_VT + (size_t)NVT * NROW * 2;
constexpr size_t WS_HX2 = WS_VT;
constexpr size_t WS_ODH = WS_OBA + (size_t)NROW * 512 * 2;
constexpr size_t WS_BR = WS_ODH + (size_t)NROW * 1024 * 2;
constexpr size_t WS_P1 = WS_BR + (size_t)NROW * 2048 * 2;
constexpr size_t WS_HID = WS_P1;
constexpr size_t WS_G = WS_P1;
constexpr size_t WS_WGU = WS_P1 + (size_t)NROW * NGATE * 2;
constexpr size_t WS_WD = WS_WGU + (size_t)32 * 512 * DM * 2;
constexpr size_t WS_PM = WS_WD + (size_t)32 * DM * 256 * 2;
constexpr size_t WS_XS = WS_P1;
constexpr size_t WS_ESC = WS_P1 + (size_t)NROW * NP1 * 2;
constexpr size_t WS_END = WS_ESC + (size_t)32 * 68 * 384 * 4;
static_assert(WS_PM + (size_t)4 * NCTX * DM * 2 <= WS_ESC, "moe weights must fit in the P1 tail");
static_assert((size_t)XS_ROWS * DM * 2 <= (size_t)NROW * NGATE * 2, "XS must fit in the G region");
static_assert((size_t)NVT * NROW * 2 + (size_t)NROW * 512 * 2 >= (size_t)NROW * DM * 2, "HX2 alias");
static_assert(WS_END <= 434800000ull, "workspace budget");

constexpr int NTHR = 512;
constexpr int LDS_STAGE = 1024;
constexpr int LDS_ROPE = 1024 + 131072 + 1024;
constexpr int LDS_BYTES = 144 * 1024;

struct Params {
    const float *x, *c, *ctx, *c_ctx, *w_mod, *b_mod, *w_in, *gla_lr_w, *gla_lr_b, *hg_gamma, *na_rpb, *wa_sink, *w_branch, *w_out, *ln_g, *ln_b,
        *moe_w_group, *moe_b_group, *moe_w_expert, *moe_b_expert, *moe_w_gate, *moe_w_up, *moe_w_down;
    float* out;
    unsigned char* ws;
    int ph_lo, ph_hi;
};

__device__ __forceinline__ float bf2f(bf16_t b) { return __uint_as_float(((unsigned)b) << 16); }
__device__ __forceinline__ bf16_t f2bf(float f) { unsigned u = __float_as_uint(f); u += 0x7FFFu + ((u >> 16) & 1u); return (bf16_t)(u >> 16); }
typedef float f32x2_t __attribute__((ext_vector_type(2)));
typedef __bf16 bf16x2_t __attribute__((ext_vector_type(2)));
__device__ __forceinline__ unsigned pk2(float lo, float hi) {
    const f32x2_t v = {lo, hi}; const bf16x2_t b = __builtin_convertvector(v, bf16x2_t); return __builtin_bit_cast(unsigned, b); }
__device__ __forceinline__ void ld8(const bf16_t* p, float* f) {
    const u32x4 v = *(const u32x4*)p;
    f[0] = __uint_as_float(v.x << 16); f[1] = __uint_as_float(v.x & 0xffff0000u);
    f[2] = __uint_as_float(v.y << 16); f[3] = __uint_as_float(v.y & 0xffff0000u);
    f[4] = __uint_as_float(v.z << 16); f[5] = __uint_as_float(v.z & 0xffff0000u);
    f[6] = __uint_as_float(v.w << 16); f[7] = __uint_as_float(v.w & 0xffff0000u);
}
__device__ __forceinline__ void st8(bf16_t* p, const float* f) {
    u32x4 v; v.x = pk2(f[0], f[1]); v.y = pk2(f[2], f[3]); v.z = pk2(f[4], f[5]); v.w = pk2(f[6], f[7]);
    *(u32x4*)p = v;
}
__device__ __forceinline__ float sigmoidf_(float x) { return __builtin_amdgcn_rcpf(1.f + __expf(-x)); }
__device__ __forceinline__ float siluf_(float x) { return x * __builtin_amdgcn_rcpf(1.f + __expf(-x)); }
__device__ __forceinline__ float wave_sum(float v) {
#pragma unroll
    for (int o = 1; o < 64; o <<= 1) v += __shfl_xor(v, o);
    return v;
}
__device__ __forceinline__ int row_batch(int row) { return row < NTOK ? (row >> 12) : 4; }

#define XB_TMO      128
#define XB_XCNT(j)  (256  + 64 * (j))
#define XB_XSUB(j)  (1280 + 64 * (j))
#define XB_XGEN(j)  (2304 + 64 * (j))
#define XB_TOP      3328
#define XB_TOPGEN   3392
#define XCD_BAR_WORDS 3456
#define XB_SPIN_CAP (1u << 18)
#define LAS __attribute__((address_space(3)))
__device__ __forceinline__ unsigned xb_ld(unsigned* p)              { return __hip_atomic_load(p, __ATOMIC_RELAXED, __HIP_MEMORY_SCOPE_AGENT); }
__device__ __forceinline__ unsigned xb_add(unsigned* p, unsigned v) { return __hip_atomic_fetch_add(p, v, __ATOMIC_RELAXED, __HIP_MEMORY_SCOPE_AGENT); }
__device__ __forceinline__ unsigned xb_xcc_id() { return (unsigned)__builtin_amdgcn_s_getreg((3 << 11) | 20) & 0xFu; }
#define XB_SPIN(cond, bar) do { unsigned _sp = 0; while (cond) { __builtin_amdgcn_s_sleep(1); \
    if ((++_sp & 255u) == 0u) { if (xb_ld(&(bar)[XB_TMO])) break; if (_sp > XB_SPIN_CAP) { atomicAdd(&(bar)[XB_TMO], 1u); break; } } } } while (0)
struct XcdBarrier { unsigned* bar; unsigned x; volatile LAS unsigned* st; };
__device__ __forceinline__ XcdBarrier xcd_barrier_post(unsigned* bar, volatile LAS unsigned* st) {
    XcdBarrier b; b.bar = bar; b.x = xb_xcc_id(); b.st = st;
    if (threadIdx.x == 0) (void)xb_add(&bar[XB_XCNT(b.x)], 1u);
    return b;
}
__device__ __forceinline__ void xcd_barrier_complete(unsigned* bar, unsigned x, unsigned& nloc, unsigned& nx) {
    const unsigned G = gridDim.x * gridDim.y * gridDim.z;
    unsigned sum, cnt, mine, sp = 0u;
    for (;;) {
        sum = 0u; cnt = 0u; mine = 0u;
#pragma unroll
        for (unsigned j = 0; j < 16; ++j) { const unsigned c = xb_ld(&bar[XB_XCNT(j)]); sum += c; cnt += (c > 0u) ? 1u : 0u; mine = (j == x) ? c : mine; }
        if (sum == G) break;
        __builtin_amdgcn_s_sleep(1);
        if ((++sp & 255u) == 0u) { if (xb_ld(&bar[XB_TMO])) break; if (sp > XB_SPIN_CAP) { atomicAdd(&bar[XB_TMO], 1u); break; } }
    }
    nloc = mine > 0u ? mine : 1u; nx = cnt > 0u ? cnt : 1u;
}
__device__ __forceinline__ void xcd_barrier(const XcdBarrier& b) {
    asm volatile("s_waitcnt vmcnt(0)" ::: "memory");
    __syncthreads();
    if (threadIdx.x == 0) {
        unsigned* bar = b.bar;
        __builtin_amdgcn_s_waitcnt(0);
        unsigned nloc = b.st[0], nx = b.st[1];
        if (nloc == 0u) { xcd_barrier_complete(bar, b.x, nloc, nx); b.st[0] = nloc; b.st[1] = nx; }
        const unsigned old = xb_add(&bar[XB_XSUB(b.x)], 1u);
        const unsigned gen = old / nloc;
        if (old + 1u == (gen + 1u) * nloc) {
            __builtin_amdgcn_fence(__ATOMIC_RELEASE, "agent");
            asm volatile("s_waitcnt vmcnt(0)" ::: "memory");
            const unsigned og = xb_add(&bar[XB_TOP], 1u);
            const unsigned tg = og / nx;
            if (og + 1u == (tg + 1u) * nx) xb_add(&bar[XB_TOPGEN], 1u);
            else XB_SPIN(xb_ld(&bar[XB_TOPGEN]) == tg, bar);
            __builtin_amdgcn_fence(__ATOMIC_ACQUIRE, "agent");
            xb_add(&bar[XB_XGEN(b.x)], 1u);
            asm volatile("s_waitcnt vmcnt(0)" ::: "memory");
        } else {
            XB_SPIN(xb_ld(&bar[XB_XGEN(b.x)]) == gen, bar);
            __builtin_amdgcn_fence(__ATOMIC_ACQUIRE, "agent");
            asm volatile("s_waitcnt vmcnt(0)" ::: "memory");
        }
    }
    __syncthreads();
}

struct Frame {
    Params p;
    int bid, nb, tid, lane, wave, wid_s;
    float* smf;
    unsigned char* ws;
    __device__ __forceinline__ float* modv() const { return (float*)(ws + WS_MODV); }
    __device__ __forceinline__ float* lb() const { return (float*)(ws + WS_LB); }
    __device__ __forceinline__ int* tokE() const { return (int*)(ws + WS_TOKE); }
    __device__ __forceinline__ int* tokI() const { return (int*)(ws + WS_TOKI); }
    __device__ __forceinline__ float* tokW() const { return (float*)(ws + WS_TOKW); }
    __device__ __forceinline__ int* rmap() const { return (int*)(ws + WS_RMAP); }
    __device__ __forceinline__ float* roww() const { return (float*)(ws + WS_ROWW); }
    __device__ __forceinline__ float* cxm() const { return (float*)(ws + WS_CXM); }
    __device__ __forceinline__ float* cxo() const { return (float*)(ws + WS_CXO); }
    __device__ __forceinline__ bf16_t* W1t() const { return (bf16_t*)(ws + WS_WTA + WTA_W1); }
    __device__ __forceinline__ bf16_t* Wvt() const { return (bf16_t*)(ws + WS_WTA + WTA_WV); }
    __device__ __forceinline__ bf16_t* Wgt() const { return (bf16_t*)(ws + WS_WTA + WTA_WG); }
    __device__ __forceinline__ bf16_t* Wbrt() const { return (bf16_t*)(ws + WS_WTA + WTA_WBR); }
    __device__ __forceinline__ bf16_t* Woutt() const { return (bf16_t*)(ws + WS_WTA + WTA_WO); }
    __device__ __forceinline__ bf16_t* SC1() const { return (bf16_t*)(ws + WS_SC1); }
    __device__ __forceinline__ float* ESC() const { return (float*)(ws + WS_ESC); }
    __device__ __forceinline__ bf16_t* HX() const { return (bf16_t*)(ws + WS_HX); }
    __device__ __forceinline__ bf16_t* VT() const { return (bf16_t*)(ws + WS_VT); }
    __device__ __forceinline__ bf16_t* OBA() const { return (bf16_t*)(ws + WS_OBA); }
    __device__ __forceinline__ bf16_t* HX2() const { return (bf16_t*)(ws + WS_HX2); }
    __device__ __forceinline__ bf16_t* HID() const { return (bf16_t*)(ws + WS_HID); }
    __device__ __forceinline__ bf16_t* ODH() const { return (bf16_t*)(ws + WS_ODH); }
    __device__ __forceinline__ bf16_t* BR() const { return (bf16_t*)(ws + WS_BR); }
    __device__ __forceinline__ bf16_t* P1() const { return (bf16_t*)(ws + WS_P1); }
    __device__ __forceinline__ bf16_t* G() const { return (bf16_t*)(ws + WS_G); }
    __device__ __forceinline__ bf16_t* Wgu() const { return (bf16_t*)(ws + WS_WGU); }
    __device__ __forceinline__ bf16_t* Wd() const { return (bf16_t*)(ws + WS_WD); }
    __device__ __forceinline__ bf16_t* XS() const { return (bf16_t*)(ws + WS_XS); }
    __device__ __forceinline__ unsigned* cnt() const { return (unsigned*)(ws + WS_CTL + CTL_CNT); }
};


#define REFRESH(F) do { int _t = threadIdx.x; asm volatile("" : "+v"(_t)); (F).tid = _t; (F).lane = _t & 63; (F).wave = _t >> 6; } while (0)

__device__ __forceinline__ void phase_mod(Frame& F) {
    float* sc = F.smf;
    float* red = F.smf + 5 * 1024;
    bool have = false;
    for (int it = F.bid; it < DEPTH * 96; it += F.nb) {
        if (!have) {
            for (int i = F.tid; i < 5 * 1024; i += NTHR) { const float v = (i < 4096) ? F.p.c[i] : F.p.c_ctx[i - 4096]; sc[i] = siluf_(v); }
            __syncthreads(); have = true;
        }
        const int l = it / 96, n0 = (it % 96) * 64, col = F.tid & 63, kg = F.tid >> 6;
        const float* w = F.p.w_mod + (size_t)l * DM * 6144 + n0 + col;
        float a[5] = {0.f, 0.f, 0.f, 0.f, 0.f};
        for (int k = kg * 128; k < kg * 128 + 128; ++k) {
            const float wv = w[(size_t)k * 6144];
#pragma unroll
            for (int r = 0; r < 5; ++r) a[r] += sc[r * 1024 + k] * wv;
        }
#pragma unroll
        for (int r = 0; r < 5; ++r) red[(kg * 5 + r) * 64 + col] = a[r];
        __syncthreads();
        if (F.tid < 320) {
            const int r = F.tid >> 6, cc = F.tid & 63; float s = F.p.b_mod[l * 6144 + n0 + cc];
#pragma unroll
            for (int g = 0; g < 8; ++g) s += red[(g * 5 + r) * 64 + cc];
            F.modv()[((size_t)l * 5 + r) * 6144 + n0 + cc] = s;
        }
        __syncthreads();
    }
    if (F.bid == F.nb - 1) {
        for (int i = F.tid; i < 1024; i += NTHR) { const int z = i >> 9, f = i & 511;
            const float g0 = F.p.hg_gamma[(z * DEPTH + 0) * 512 + f], g1 = F.p.hg_gamma[(z * DEPTH + 1) * 512 + f];
            F.lb()[i] = 1.f / (1.f + expf(g0 - g1)); }
    }
}

__device__ __forceinline__ int p1_src(int n, float& scale) {
    scale = 1.f;
    if (n < 256) { scale = 0.125f; return O_AQ + n; }
    if (n < 512) return O_AK + (n - 256);
    if (n < 1024) return O_AV + (n - 512);
    if (n < 1536) { scale = QSCALE; return O_BQ + (n - 1024); }
    if (n < 2048) return O_BK + (n - 1536);
    if (n < 2560) { scale = QSCALE; return O_CQ + (n - 2048); }
    if (n < 2688) return O_CK + (n - 2560);
    if (n < 2720) return O_ALR + (n - 2688);
    if (n < 2816) return -1;
    if (n < 3328) return O_DQ + (n - 2816);
    if (n < 4352) return O_DF + (n - 3328);
    if (n < 4864) return O_DI + (n - 4352);
    if (n < 5376) return O_AG + (n - 4864);
    return O_DG + (n - 5376);
}
__device__ __forceinline__ void conv_item(const float* src, int ldsrc, int srccol, float scale, bf16_t* dst, int K, int k0, float* scr, int lane, bool perm) {
    if (srccol >= 0) {
#pragma unroll 8
        for (int i = 0; i < 32; ++i) { const int kk = 2 * i + (lane >> 5); scr[kk * 33 + (lane & 31)] = src[(size_t)(k0 + kk) * ldsrc + srccol + (lane & 31)] * scale; }
    } else {
#pragma unroll 8
        for (int i = 0; i < 32; ++i) { const int kk = 2 * i + (lane >> 5); scr[kk * 33 + (lane & 31)] = 0.f; }
    }
    asm volatile("s_waitcnt lgkmcnt(0)" ::: "memory");
    const int c = lane & 7;
#pragma unroll
    for (int j = 0; j < 4; ++j) { const int nn = (lane >> 3) + 8 * j; const float* sp = scr + (8 * c) * 33 + (perm ? (8 * ((nn & 15) >> 2) + 4 * (nn >> 4) + (nn & 3)) : nn);
        u32x4 o; o.x = pk2(sp[0 * 33], sp[1 * 33]); o.y = pk2(sp[2 * 33], sp[3 * 33]); o.z = pk2(sp[4 * 33], sp[5 * 33]); o.w = pk2(sp[6 * 33], sp[7 * 33]);
        *(u32x4*)(dst + (size_t)nn * K + 8 * c) = o; }
    asm volatile("s_waitcnt lgkmcnt(0)" ::: "memory");
}
constexpr int CONVA_W1 = (NP1 / 32) * 16;
constexpr int CONVA_ITEMS = CONVA_W1 + 384 + 2048;
constexpr int CONVA_IN = CONVA_W1 + 384;
__device__ __forceinline__ void phase_conv_a(Frame& F, int l, int gw, int ngw, int lo = 0, int hi = CONVA_ITEMS) {
    float* scr = F.smf + F.wave * (64 * 33);
    for (int it0 = lo + gw; it0 < hi; it0 += ngw) {
        int ti = it0;
        if (ti < CONVA_W1) { const int n0 = (ti >> 4) * 32, kt = ti & 15; float sc; const int sx = p1_src(n0, sc);
            conv_item(F.p.w_in + (size_t)l * DM * DIN, DIN, sx, sc, F.W1t() + (size_t)n0 * DM + kt * 64, DM, kt * 64, scr, F.lane, !(n0 >= 2048 && n0 < 2816)); continue; }
        ti -= CONVA_W1;
        if (ti < 384) { const int n0 = (ti >> 4) * 32, kt = ti & 15; const int sx = n0 < 512 ? O_BV + n0 : (n0 < 640 ? O_CV + (n0 - 512) : -1);
            conv_item(F.p.w_in + (size_t)l * DM * DIN, DIN, sx, 1.f, F.Wvt() + (size_t)n0 * DM + kt * 64, DM, kt * 64, scr, F.lane, false); continue; }
        ti -= 384;
        { const int n0 = (ti >> 4) * 32, kt = ti & 15;
          conv_item(F.p.w_in + (size_t)l * DM * DIN, DIN, O_GATE + n0, 1.f, F.Wgt() + (size_t)n0 * DM + kt * 64, DM, kt * 64, scr, F.lane, true); }
    }
}
constexpr int CONVB_MOE = 8192 + 4096, CONVB_PROJ = 1024 + 512;
__device__ __forceinline__ void phase_conv_b(Frame& F, int l, int n_skip, int lo, int hi) {
    float* scr = F.smf + F.wave * (64 * 33);
    if (F.bid < n_skip) return;
    const int gw = (F.bid - n_skip) * 8 + F.wave, ngw = (F.nb - n_skip) * 8;
    for (int it0 = lo + gw; it0 < hi; it0 += ngw) {
        int ti = it0;
        if (ti < 8192) { const int e = ti >> 8, r = ti & 255, n0 = (r >> 4) * 32, kt = r & 15, j = n0 >> 8, rr = n0 & 255; const bool isup = rr >= 128; const int cc = 128 * j + (rr & 127);
            const float* src = (isup ? F.p.moe_w_up : F.p.moe_w_gate) + (size_t)(l * 32 + e) * DM * 256;
            conv_item(src, 256, cc, 1.f, F.Wgu() + (size_t)e * 512 * DM + (size_t)n0 * DM + kt * 64, DM, kt * 64, scr, F.lane, true); continue; }
        ti -= 8192;
        if (ti < 4096) { const int e = ti >> 7, r = ti & 127, n0 = (r >> 2) * 32, kt = r & 3;
          conv_item(F.p.moe_w_down + (size_t)(l * 32 + e) * 256 * DM, DM, n0, 1.f, F.Wd() + (size_t)e * DM * 256 + (size_t)n0 * 256 + kt * 64, 256, kt * 64, scr, F.lane, true); continue; }
        ti -= 4096;
        if (ti < 1024) { const int i = ti >> 8, r = ti & 255, n0 = (r >> 3) * 32, kt = r & 7;
            conv_item(F.p.w_branch + (size_t)(l * 4 + i) * 512 * DM, DM, n0, 1.f, F.Wbrt() + (size_t)i * DM * 512 + (size_t)n0 * 512 + kt * 64, 512, kt * 64, scr, F.lane, true); continue; }
        ti -= 1024;
        { const int n0 = (ti >> 4) * 32, kt = ti & 15;
          conv_item(F.p.w_out + (size_t)l * DM * DM, DM, n0, 1.f, F.Woutt() + (size_t)n0 * DM + kt * 64, DM, kt * 64, scr, F.lane, false); }
    }
}

__device__ __forceinline__ void phase_prep(Frame& F, int l, const float* xlat, const float* xctx) {
    const int gw = F.bid * 8 + F.wave, ngw = F.nb * 8;
    for (int row = gw; row < NROW; row += ngw) {
        const float* xr = row < NTOK ? xlat + (size_t)row * DM : xctx + (size_t)(row - NTOK) * DM;
        const float* mv = F.modv() + ((size_t)l * 5 + row_batch(row)) * 6144;
#pragma unroll
        for (int j = 0; j < 4; ++j) { const int d = j * 256 + F.lane * 4;
            const f32x4 v = *(const f32x4*)(xr + d), m0 = *(const f32x4*)(mv + d), m1 = *(const f32x4*)(mv + 1024 + d);
            u32x2 o; o.x = pk2(v.x * (1.f + m1.x) + m0.x, v.y * (1.f + m1.y) + m0.y); o.y = pk2(v.z * (1.f + m1.z) + m0.z, v.w * (1.f + m1.w) + m0.w);
            *(u32x2*)(F.HX() + (size_t)row * DM + d) = o; }
    }
}


namespace pg {
typedef short bf16x8 __attribute__((ext_vector_type(8)));
constexpr int BM = 256, BK = 64, HALF = 128, HTB = HALF * BK * 2, STAGE_BYTES = 8 * HTB, NXCD = 8, WGM = 8;
__device__ __forceinline__ int lds_byte(int r, int c) { const int st = (r >> 4) * 2 + (c >> 5), rr = r & 15, cc = c & 31, ob = rr * 64 + cc * 2; return st * 1024 + (ob ^ (((ob >> 9) & 1) << 5)); }
__device__ __forceinline__ void stage_rc(int b, int& R, int& C) { const int st = b / 1024, sb = b % 1024, swz = sb ^ (((sb >> 9) & 1) << 5); R = (st >> 1) * 16 + swz / 64; C = (st & 1) * 32 + (swz % 64) / 2; }
struct Unit { const char* a; const char* b; int pm, pn, aux; };
__device__ __forceinline__ void static_map(int L, int nM, int nN, int& pm, int& pn) {
    const int nwg = nM * nN; int wgid = L; { const int q = nwg / NXCD, r = nwg % NXCD, xcd = wgid % NXCD, off = wgid / NXCD; wgid = (xcd < r ? xcd * (q + 1) : r * (q + 1) + (xcd - r) * q) + off; }
    const int nig = WGM * nN, gid = wgid / nig, fm = gid * WGM, gsz = (nM - fm) < WGM ? (nM - fm) : WGM;
    pm = fm + ((wgid % nig) % gsz); pn = (wgid % nig) / gsz;
}
template <class Epi, class Sched>
__device__ __forceinline__ void gemm_phase(LAS unsigned char* lds, const int lda, const int ldb, const int K, const Sched& S, const Epi& E) {
    int tid = threadIdx.x; asm volatile("" : "+v"(tid));
    const int wid = __builtin_amdgcn_readfirstlane(tid >> 6), lane = tid & 63, wr = wid >> 2, wc = wid & 3, fr = lane & 15, fq = lane >> 4;
    int nt = K / BK; asm volatile("" : "+s"(nt));
    constexpr bool GATHER = Sched::gather;
    unsigned voffA[2], voffB[2], vgA[2][2], vgN[2][2]; int RA_[2], CA_[2];
#pragma unroll
    for (int i = 0; i < 2; ++i) { int R, C; stage_rc(tid * 16 + i * 8192, R, C); voffA[i] = (unsigned)(R * lda + C) * 2u; voffB[i] = (unsigned)(R * ldb + C) * 2u; RA_[i] = R; CA_[i] = C;
        vgA[0][i] = vgA[1][i] = vgN[0][i] = vgN[1][i] = 0u; }
#define PG_GSET(vg, u) do { _Pragma("unroll") for (int _h = 0; _h < 2; ++_h) _Pragma("unroll") for (int _i = 0; _i < 2; ++_i) \
        vg[_h][_i] = (unsigned)S.rowidx((u).pm * BM + _h * HALF + RA_[_i]) * (unsigned)(lda * 2) + (unsigned)(CA_[_i] * 2); } while (0)
    const size_t kstep = (size_t)(BK * 2);
    const size_t hstepA = (size_t)HALF * lda * 2, hstepB = (size_t)HALF * ldb * 2;
    const unsigned ldsw = (unsigned)wid * 1024u;
    const int aoff = lds_byte(wr * 64 + fr, fq * 8), boff = lds_byte(wc * 32 + fr, fq * 8);
#define PG_SA(b, h) (((b) * 2 + (h)) * HTB)
#define PG_SB(b, h) ((4 + (b) * 2 + (h)) * HTB)
#define PG_STAGE(bufoff, gbase, voff) do { _Pragma("unroll") for (int _i = 0; _i < 2; ++_i) \
        __builtin_amdgcn_global_load_lds((const unsigned*)((const char*)(gbase) + (voff)[_i]), (LAS unsigned*)(lds + (bufoff) + ldsw + _i * 8192), 16, 0, 0); } while (0)
#define PG_STAGE_A(bufoff, base, h, nx) do { if (GATHER) { const unsigned _v[2] = {(nx) ? vgN[h][0] : vgA[h][0], (nx) ? vgN[h][1] : vgA[h][1]}; PG_STAGE(bufoff, base, _v); } \
        else { PG_STAGE(bufoff, (base) + (h) * hstepA, voffA); } } while (0)
#define PG_LDA(dst, b, h) do { _Pragma("unroll") for (int m = 0; m < 4; ++m) _Pragma("unroll") for (int k = 0; k < 2; ++k) dst[m][k] = *(const LAS bf16x8*)(lds + PG_SA(b, h) + aoff + m * 2048 + k * 1024); } while (0)
#define PG_LDB(dst, b, h) do { _Pragma("unroll") for (int n = 0; n < 2; ++n) _Pragma("unroll") for (int k = 0; k < 2; ++k) dst[n][k] = *(const LAS bf16x8*)(lds + PG_SB(b, h) + boff + n * 2048 + k * 1024); } while (0)
#define PG_MMA(ai, bj, At, Bt) do { __builtin_amdgcn_s_setprio(1); _Pragma("unroll") for (int m = 0; m < 4; ++m) _Pragma("unroll") for (int n = 0; n < 2; ++n) _Pragma("unroll") for (int k = 0; k < 2; ++k) \
        acc[ai][bj][m][n] = __builtin_amdgcn_mfma_f32_16x16x32_bf16(Bt[n][k], At[m][k], acc[ai][bj][m][n], 0, 0, 0); __builtin_amdgcn_s_setprio(0); } while (0)
#define PG_WAIT_V(n) asm volatile("s_waitcnt vmcnt(" #n ")" ::: "memory")
#define PG_WAIT_L(n) asm volatile("s_waitcnt lgkmcnt(" #n ")" ::: "memory")
#define PG_BAR __builtin_amdgcn_s_barrier()
#define PG_SCHED __builtin_amdgcn_sched_barrier(0)
    Unit cur, nxt; int ui = 0;
    if (!S.next(0, cur)) return;
    f32x4 acc[2][2][4][2];
#pragma unroll
    for (int a = 0; a < 2; ++a)
#pragma unroll
        for (int b = 0; b < 2; ++b)
#pragma unroll
            for (int m = 0; m < 4; ++m)
#pragma unroll
                for (int n = 0; n < 2; ++n) acc[a][b][m][n] = (f32x4){0.f, 0.f, 0.f, 0.f};
    bf16x8 At[4][2], B0[2][2], B1[2][2];
    const char* cA = cur.a; const char* cB = cur.b;
    if (GATHER) PG_GSET(vgA, cur);
    PG_STAGE(PG_SB(0, 0), cB, voffB); PG_STAGE_A(PG_SA(0, 0), cA, 0, false); PG_STAGE(PG_SB(0, 1), cB + hstepB, voffB); PG_STAGE_A(PG_SA(0, 1), cA, 1, false);
    if (wr == 1) PG_BAR;
    PG_WAIT_V(4); PG_BAR;
    PG_STAGE(PG_SB(1, 0), cB + kstep, voffB); PG_STAGE_A(PG_SA(1, 0), cA + kstep, 0, false); PG_STAGE(PG_SB(1, 1), cB + hstepB + kstep, voffB);
    PG_WAIT_V(6); PG_BAR;
    for (;;) {
        const bool has_next = S.next(ui + 1, nxt);
        const char* nA = has_next ? nxt.a : cA; const char* nB = has_next ? nxt.b : cB;
        if (GATHER) { if (has_next) PG_GSET(vgN, nxt); else { vgN[0][0] = vgA[0][0]; vgN[0][1] = vgA[0][1]; vgN[1][0] = vgA[1][0]; vgN[1][1] = vgA[1][1]; } }
        for (int t = 0; t < nt; t += 2) {
            const bool last = (t == nt - 2);
            const char* a1 = cA + (size_t)(t + 1) * kstep;
            const char* a2 = last ? nA : cA + (size_t)(t + 2) * kstep; const char* b2 = last ? nB : cB + (size_t)(t + 2) * kstep;
            const char* a3 = a2 + kstep; const char* b3 = b2 + kstep;
            PG_LDB(B0, 0, 0); PG_SCHED; PG_LDA(At, 0, 0); PG_STAGE_A(PG_SA(1, 1), a1, 1, false);
            PG_WAIT_L(8); PG_BAR; PG_WAIT_L(0); PG_MMA(0, 0, At, B0); PG_BAR; PG_SCHED;
            PG_LDB(B1, 0, 1); PG_STAGE(PG_SB(0, 0), b2, voffB);
            PG_BAR; PG_WAIT_L(0); PG_MMA(0, 1, At, B1); PG_BAR;
            PG_LDA(At, 0, 1); PG_STAGE_A(PG_SA(0, 0), a2, 0, last);
            PG_BAR; PG_WAIT_L(0); PG_MMA(1, 0, At, B0); PG_BAR; PG_SCHED;
            PG_STAGE(PG_SB(0, 1), b2 + hstepB, voffB);
            PG_WAIT_V(6); PG_BAR; PG_MMA(1, 1, At, B1); PG_BAR;
            PG_LDB(B0, 1, 0); PG_SCHED; PG_LDA(At, 1, 0); PG_STAGE_A(PG_SA(0, 1), a2, 1, last);
            PG_WAIT_L(8); PG_BAR; PG_WAIT_L(0); PG_MMA(0, 0, At, B0); PG_BAR; PG_SCHED;
            PG_LDB(B1, 1, 1); PG_STAGE(PG_SB(1, 0), b3, voffB);
            PG_BAR; PG_WAIT_L(0); PG_MMA(0, 1, At, B1); PG_BAR;
            PG_LDA(At, 1, 1); PG_STAGE_A(PG_SA(1, 0), a3, 0, last);
            PG_BAR; PG_WAIT_L(0); PG_MMA(1, 0, At, B0); PG_BAR; PG_SCHED;
            PG_STAGE(PG_SB(1, 1), b3 + hstepB, voffB);
            PG_WAIT_V(6); PG_BAR; PG_MMA(1, 1, At, B1); PG_BAR;
        }
        E(acc, cur, wr, wc, fr, fq);
        if (!has_next) break;
#pragma unroll
        for (int a = 0; a < 2; ++a)
#pragma unroll
            for (int b = 0; b < 2; ++b)
#pragma unroll
                for (int m = 0; m < 4; ++m)
#pragma unroll
                    for (int n = 0; n < 2; ++n) acc[a][b][m][n] = (f32x4){0.f, 0.f, 0.f, 0.f};
        cur = nxt; cA = nA; cB = nB; ++ui;
        if (GATHER) { vgA[0][0] = vgN[0][0]; vgA[0][1] = vgN[0][1]; vgA[1][0] = vgN[1][0]; vgA[1][1] = vgN[1][1]; }
    }
    PG_WAIT_V(0);
    if (wr == 0) PG_BAR;
    PG_BAR;
#undef PG_SA
#undef PG_SB
#undef PG_STAGE
#undef PG_STAGE_A
#undef PG_GSET
#undef PG_LDA
#undef PG_LDB
#undef PG_MMA
#undef PG_WAIT_V
#undef PG_WAIT_L
#undef PG_BAR
#undef PG_SCHED
}

struct SchedG1 {
    static constexpr bool gather = false; __device__ __forceinline__ int rowidx(int) const { return 0; }
    const char *HX, *W1, *WV; int G, c;
    __device__ __forceinline__ bool next(int i, Unit& u) const {
        const int L = i * G + c, nmain = (NROW / 256) * (NP1 / 256);
        if (L < nmain) { static_map(L, NROW / 256, NP1 / 256, u.pm, u.pn); u.a = HX + (size_t)u.pm * 256 * DM * 2; u.b = W1 + (size_t)u.pn * 256 * DM * 2; u.aux = 0; return true; }
        const int idx = L - nmain; if (idx >= 3 * (NROW / 256)) return false;
        u.pm = idx % 3; u.pn = idx / 3; u.a = WV + (size_t)u.pm * 256 * DM * 2; u.b = HX + (size_t)u.pn * 256 * DM * 2; u.aux = 1; return true;
    }
};
struct SchedStatic {
    static constexpr bool gather = false; __device__ __forceinline__ int rowidx(int) const { return 0; }
    const char *A, *B; size_t tA, tB; int nM, nN, G, c;
    __device__ __forceinline__ bool next(int i, Unit& u) const {
        const int L = i * G + c; if (L >= nM * nN) return false;
        static_map(L, nM, nN, u.pm, u.pn); u.a = A + (size_t)u.pm * tA; u.b = B + (size_t)u.pn * tB; u.aux = 0; return true;
    }
};
struct SchedMerge {
    static constexpr bool gather = false; __device__ __forceinline__ int rowidx(int) const { return 0; }
    const char *BR, *W; int ntile, G, c;
    __device__ __forceinline__ bool split() const { return ntile > G && (ntile - G) * 4 <= G; }
    __device__ __forceinline__ bool next(int i, Unit& u) const {
        int t, br;
        if (split()) { if (i < 4) { t = c; br = i; u.aux = br; } else { if (i > 4 || c >= (ntile - G) * 4) return false; t = G + (c >> 2); br = c & 3; u.aux = 4 + br; } }
        else { t = c + (i >> 2) * G; if (t >= ntile) return false; br = i & 3; u.aux = br; }
        u.pm = t >> 2; u.pn = t & 3;
        u.a = BR + (size_t)u.pm * 256 * 2048 * 2 + (size_t)br * 512 * 2; u.b = W + (size_t)br * DM * 512 * 2 + (size_t)u.pn * 256 * 512 * 2; return true;
    }
};
struct SchedMoeG {
    static constexpr bool gather = true;
    const char *A, *W; const int* off; const int* rmap; size_t wE, wT; int npan, NJ, G, c;
    __device__ __forceinline__ int rowidx(int slot) const { const int sl = rmap[slot]; return sl < 0 ? 0 : (sl >> 1); }
    __device__ __forceinline__ bool next(int i, Unit& u) const {
        const int L = i * G + c; if (L >= npan * NJ) return false;
        const int p = L / NJ, j = L % NJ; int e = 0;
#pragma unroll 1
        for (int q = 1; q < 32; ++q) if (p * 256 >= off[q]) e = q;
        e = __builtin_amdgcn_readfirstlane(e);
        u.pm = p; u.pn = j; u.aux = e; u.a = A; u.b = W + (size_t)e * wE + (size_t)j * wT; return true;
    }
};
struct SchedMoe {
    static constexpr bool gather = false; __device__ __forceinline__ int rowidx(int) const { return 0; }
    const char *A, *W; const int* off; size_t tA, wE, wT; int npan, NJ, G, c;
    __device__ __forceinline__ bool next(int i, Unit& u) const {
        const int L = i * G + c; if (L >= npan * NJ) return false;
        const int p = L / NJ, j = L % NJ; int e = 0;
#pragma unroll 1
        for (int q = 1; q < 32; ++q) if (p * 256 >= off[q]) e = q;
        e = __builtin_amdgcn_readfirstlane(e);
        u.pm = p; u.pn = j; u.aux = e; u.a = A + (size_t)p * tA; u.b = W + (size_t)e * wE + (size_t)j * wT; return true;
    }
};

#define PG_ROWCOL const int row0 = u.pm * BM + wr * 64 + fr, col0 = u.pn * BM + wc * 32 + 4 * fq
struct EpiG1 { bf16_t *P1, *VT; const float* rtab; const float* lbp; int layer;
    __device__ __forceinline__ void operator()(const f32x4 (&acc)[2][2][4][2], const Unit& u, int wr, int wc, int fr, int fq) const {
        const int row0 = u.pm * BM + wr * 64 + fr;
        if (u.aux || (u.pn >= 8 && u.pn <= 10)) {
            const int col0 = u.pn * BM + wc * 32 + 4 * fq; bf16_t* base = u.aux ? VT : P1; const size_t ld = u.aux ? (size_t)NROW : (size_t)NP1;
            const bool rope = !u.aux && (u.pm < NTOK / 256);
#pragma unroll
            for (int ai = 0; ai < 2; ++ai)
#pragma unroll
                for (int m = 0; m < 4; ++m) { const int r = row0 + ai * HALF + m * 16; bf16_t* rowp = base + (size_t)r * ld + col0;
#pragma unroll
                    for (int bj = 0; bj < 2; ++bj) {
                        f32x4 v0 = acc[ai][bj][m][0], v1 = acc[ai][bj][m][1];
                        if (rope && !(u.pn == 10 && bj == 1)) {
                            const int pos = r & (SEQ - 1), pp = (wc & 1) ? (pos & 63) : (pos >> 6); const float* tp = rtab + (pp * 16 + 4 * fq) * 2;
                            const f32x4 t0 = *(const f32x4*)tp, t1 = *(const f32x4*)(tp + 4);
                            const f32x4 a = v0, b = v1;
                            v0.x = a.x * t0.x - b.x * t0.y; v1.x = a.x * t0.y + b.x * t0.x; v0.y = a.y * t0.z - b.y * t0.w; v1.y = a.y * t0.w + b.y * t0.z;
                            v0.z = a.z * t1.x - b.z * t1.y; v1.z = a.z * t1.y + b.z * t1.x; v0.w = a.w * t1.z - b.w * t1.w; v1.w = a.w * t1.w + b.w * t1.z;
                        }
                        u32x2 o; o.x = pk2(v0.x, v0.y); o.y = pk2(v0.z, v0.w); *(u32x2*)(rowp + bj * HALF) = o;
                        o.x = pk2(v1.x, v1.y); o.y = pk2(v1.z, v1.w); *(u32x2*)(rowp + bj * HALF + 16) = o; } }
            return;
        }
        const int col0 = u.pn * BM + wc * 32 + 8 * fq;
        const int mode = (u.pn == 11 || u.pn == 12) ? 2 : ((u.pn >= 13 && u.pn <= 16) ? 3 : 0);
        if (mode == 3) {
            f32x4 lb4[2][2];
            const int z = (u.pn - 13) >> 1, cb = z * 512 + ((u.pn - 13) & 1) * 256 + wc * 32 + 8 * fq;
#pragma unroll
            for (int bj = 0; bj < 2; ++bj)
#pragma unroll
                for (int n = 0; n < 2; ++n) lb4[bj][n] = (layer == 0) ? (f32x4){0.f, 0.f, 0.f, 0.f} : *(const f32x4*)(lbp + cb + bj * HALF + 4 * n);
#pragma unroll
            for (int ai = 0; ai < 2; ++ai)
#pragma unroll
                for (int m = 0; m < 4; ++m) { bf16_t* rowp = P1 + (size_t)(row0 + ai * HALF + m * 16) * NP1 + col0;
#pragma unroll
                    for (int bj = 0; bj < 2; ++bj) { float gq[8];
#pragma unroll
                        for (int n = 0; n < 2; ++n)
#pragma unroll
                            for (int j = 0; j < 4; ++j) { const float f = acc[ai][bj][m][n][j], lb = lb4[bj][n][j]; const float t = __expf(-fabsf(f)), rr = __builtin_amdgcn_rcpf(1.f + t);
                                gq[4 * n + j] = __logf(fmaxf(lb + (1.f - lb) * ((f >= 0.f) ? rr : t * rr), 1e-37f)); }
                        u32x4 o; o.x = pk2(gq[0], gq[1]); o.y = pk2(gq[2], gq[3]); o.z = pk2(gq[4], gq[5]); o.w = pk2(gq[6], gq[7]); *(u32x4*)(rowp + bj * HALF) = o; } }
            return;
        }
#pragma unroll
        for (int ai = 0; ai < 2; ++ai)
#pragma unroll
            for (int m = 0; m < 4; ++m) { bf16_t* rowp = P1 + (size_t)(row0 + ai * HALF + m * 16) * NP1 + col0;
#pragma unroll
                for (int bj = 0; bj < 2; ++bj) {
                    f32x4 v0 = acc[ai][bj][m][0], v1 = acc[ai][bj][m][1];
                    if (mode == 2) {
#pragma unroll
                        for (int j = 0; j < 4; ++j) { v0[j] = v0[j] * __builtin_amdgcn_rcpf(1.f + __expf(-v0[j])); v1[j] = v1[j] * __builtin_amdgcn_rcpf(1.f + __expf(-v1[j])); }
                    }
                    u32x4 o; o.x = pk2(v0.x, v0.y); o.y = pk2(v0.z, v0.w); o.z = pk2(v1.x, v1.y); o.w = pk2(v1.z, v1.w); *(u32x4*)(rowp + bj * HALF) = o; } }
    }
};
#define PG_ROWCOL8 const int row0 = u.pm * BM + wr * 64 + fr, col0 = u.pn * BM + wc * 32 + 8 * fq
struct EpiGate { bf16_t* G;
    __device__ __forceinline__ void operator()(const f32x4 (&acc)[2][2][4][2], const Unit& u, int wr, int wc, int fr, int fq) const {
        PG_ROWCOL8;
#pragma unroll
        for (int ai = 0; ai < 2; ++ai)
#pragma unroll
            for (int m = 0; m < 4; ++m) { bf16_t* rowp = G + (size_t)(row0 + ai * HALF + m * 16) * NGATE + col0;
#pragma unroll
                for (int bj = 0; bj < 2; ++bj) { const f32x4 v0 = acc[ai][bj][m][0], v1 = acc[ai][bj][m][1]; u32x4 o;
                    o.x = pk2(sigmoidf_(v0.x), sigmoidf_(v0.y)); o.y = pk2(sigmoidf_(v0.z), sigmoidf_(v0.w)); o.z = pk2(sigmoidf_(v1.x), sigmoidf_(v1.y)); o.w = pk2(sigmoidf_(v1.z), sigmoidf_(v1.w));
                    *(u32x4*)(rowp + bj * HALF) = o; } }
    }
};
struct EpiMerge { const bf16_t* G; bf16_t* O; bf16_t* PM;
    __device__ __forceinline__ void operator()(const f32x4 (&acc)[2][2][4][2], const Unit& u, int wr, int wc, int fr, int fq) const {
        PG_ROWCOL8; const int br = u.aux & 3; const bool part = u.aux >= 4, rmw = !part && br != 0;
        bf16_t* const Ob = part ? PM + (size_t)br * NCTX * DM - (size_t)NTOK * DM : O;
#pragma unroll
        for (int ai = 0; ai < 2; ++ai) {
            u32x4 g4[4][2], o4[4][2];
#pragma unroll
            for (int m = 0; m < 4; ++m) { const size_t r = (size_t)(row0 + ai * HALF + m * 16); const bf16_t* gp = G + r * NGATE + br * 1024 + col0; const bf16_t* rowp = Ob + r * DM + col0;
#pragma unroll
                for (int bj = 0; bj < 2; ++bj) { g4[m][bj] = *(const u32x4*)(gp + bj * HALF); if (rmw) o4[m][bj] = *(const u32x4*)(rowp + bj * HALF); } }
#pragma unroll
            for (int m = 0; m < 4; ++m) { bf16_t* rowp = Ob + (size_t)(row0 + ai * HALF + m * 16) * DM + col0;
#pragma unroll
                for (int bj = 0; bj < 2; ++bj) { const f32x4 v0 = acc[ai][bj][m][0], v1 = acc[ai][bj][m][1]; const u32x4 gg = g4[m][bj];
                    float w[8] = {__uint_as_float(gg.x << 16) * v0.x, __uint_as_float(gg.x & 0xffff0000u) * v0.y, __uint_as_float(gg.y << 16) * v0.z, __uint_as_float(gg.y & 0xffff0000u) * v0.w,
                                  __uint_as_float(gg.z << 16) * v1.x, __uint_as_float(gg.z & 0xffff0000u) * v1.y, __uint_as_float(gg.w << 16) * v1.z, __uint_as_float(gg.w & 0xffff0000u) * v1.w};
                    if (rmw) { const u32x4 oo = o4[m][bj];
                        w[0] += __uint_as_float(oo.x << 16); w[1] += __uint_as_float(oo.x & 0xffff0000u); w[2] += __uint_as_float(oo.y << 16); w[3] += __uint_as_float(oo.y & 0xffff0000u);
                        w[4] += __uint_as_float(oo.z << 16); w[5] += __uint_as_float(oo.z & 0xffff0000u); w[6] += __uint_as_float(oo.w << 16); w[7] += __uint_as_float(oo.w & 0xffff0000u); }
                    u32x4 o; o.x = pk2(w[0], w[1]); o.y = pk2(w[2], w[3]); o.z = pk2(w[4], w[5]); o.w = pk2(w[6], w[7]); *(u32x4*)(rowp + bj * HALF) = o; } }
            asm volatile("" ::: "memory");
        }
    }
};
struct EpiWout { const float *xlat, *xctx; float *olat, *octx; const float* modl;
    __device__ __forceinline__ void operator()(const f32x4 (&acc)[2][2][4][2], const Unit& u, int wr, int wc, int fr, int fq) const {
        PG_ROWCOL; const bool lat = u.pm < NTOK / 256; const int rb = lat ? (u.pm >> 4) : 4;
        const float* xin = lat ? xlat : xctx - (size_t)NTOK * DM; float* xo = lat ? olat : octx - (size_t)NTOK * DM; const float* m2 = modl + (size_t)rb * 6144 + 2 * 1024 + col0;
        f32x4 mv[2][2];
#pragma unroll
        for (int bj = 0; bj < 2; ++bj)
#pragma unroll
            for (int n = 0; n < 2; ++n) mv[bj][n] = *(const f32x4*)(m2 + bj * HALF + n * 16);
#pragma unroll
        for (int aq = 0; aq < 4; ++aq) { const int ai = aq >> 1, m0 = (aq & 1) * 2;
            f32x4 xv[4][2][2];
#pragma unroll
            for (int m = m0; m < m0 + 2; ++m) { const size_t o = (size_t)(row0 + ai * HALF + m * 16) * DM + col0;
#pragma unroll
                for (int bj = 0; bj < 2; ++bj)
#pragma unroll
                    for (int n = 0; n < 2; ++n) xv[m][bj][n] = *(const f32x4*)(xin + o + bj * HALF + n * 16); }
#pragma unroll
            for (int m = m0; m < m0 + 2; ++m) { const size_t o = (size_t)(row0 + ai * HALF + m * 16) * DM + col0;
#pragma unroll
                for (int bj = 0; bj < 2; ++bj)
#pragma unroll
                    for (int n = 0; n < 2; ++n) *(f32x4*)(xo + o + bj * HALF + n * 16) = ALPHA * xv[m][bj][n] + mv[bj][n] * acc[ai][bj][m][n]; }
            asm volatile("" ::: "memory");
        }
    }
};
struct EpiMoe1 { bf16_t* HID; const float* roww;
    __device__ __forceinline__ void operator()(const f32x4 (&acc)[2][2][4][2], const Unit& u, int wr, int wc, int fr, int fq) const {
        const int row0 = u.pm * BM + wr * 64 + fr, hc0 = u.pn * 128 + wc * 32 + 8 * fq;
#pragma unroll
        for (int ai = 0; ai < 2; ++ai)
#pragma unroll
            for (int m = 0; m < 4; ++m) { const int r = row0 + ai * HALF + m * 16; const float w = roww[r];
                const f32x4 g0 = acc[ai][0][m][0], g1 = acc[ai][0][m][1], u0 = acc[ai][1][m][0], u1 = acc[ai][1][m][1]; u32x4 o;
                o.x = pk2(siluf_(g0.x) * u0.x * w, siluf_(g0.y) * u0.y * w); o.y = pk2(siluf_(g0.z) * u0.z * w, siluf_(g0.w) * u0.w * w);
                o.z = pk2(siluf_(g1.x) * u1.x * w, siluf_(g1.y) * u1.y * w); o.w = pk2(siluf_(g1.z) * u1.z * w, siluf_(g1.w) * u1.w * w);
                *(u32x4*)(HID + (size_t)r * 256 + hc0) = o; }
    }
};
struct EpiMoe2 { bf16_t* Y; const int* rmap; bf16_t* dump;
    __device__ __forceinline__ void operator()(const f32x4 (&acc)[2][2][4][2], const Unit& u, int wr, int wc, int fr, int fq) const {
        PG_ROWCOL8;
#pragma unroll
        for (int ai = 0; ai < 2; ++ai)
#pragma unroll
            for (int m = 0; m < 4; ++m) { const int s = rmap[row0 + ai * HALF + m * 16];
                bf16_t* rowp = (s >= 0 ? Y + (size_t)s * DM : dump) + col0;
#pragma unroll
                for (int bj = 0; bj < 2; ++bj) { const f32x4 v0 = acc[ai][bj][m][0], v1 = acc[ai][bj][m][1]; u32x4 o; o.x = pk2(v0.x, v0.y); o.y = pk2(v0.z, v0.w); o.z = pk2(v1.x, v1.y); o.w = pk2(v1.z, v1.w); *(u32x4*)(rowp + bj * HALF) = o; } }
    }
};
#undef PG_ROWCOL8
#undef PG_ROWCOL
}

__device__ __forceinline__ void moe_offsets(Frame& F, int l, int* off) {
    if (F.tid < 64) {
        int v = (F.tid < 32) ? (((int)F.cnt()[l * 32 + F.tid] + 255) & ~255) : 0;
#pragma unroll
        for (int o = 1; o < 32; o <<= 1) { const int t = __shfl_up(v, o); if ((F.tid & 63) >= o) v += t; }
        if (F.tid < 32) off[F.tid + 1] = v;
        if (F.tid == 0) off[0] = 0;
    }
    __syncthreads();
}

__device__ __forceinline__ void phase_rope(Frame& F) {
    float* tab = F.smf;
    for (int e = F.tid; e < 1024; e += NTHR) { const int pp = e >> 4, i = e & 15; const float inv = powf(10000.f, -(float)i / 16.f), ang = (float)pp * inv; tab[2 * e] = cosf(ang); tab[2 * e + 1] = sinf(ang); }
    __syncthreads();
    const size_t total = (size_t)NTOK * 320;
    for (size_t idx = (size_t)F.bid * NTHR + F.tid; idx < total; idx += (size_t)F.nb * NTHR) {
        const int row = (int)(idx / 320), r = (int)(idx % 320), h = r >> 5, half = (r >> 4) & 1, i = r & 15;
        const int pos = row & (SEQ - 1), pp = half ? (pos & 63) : (pos >> 6);
        const float cs = tab[2 * (pp * 16 + i)], sn = tab[2 * (pp * 16 + i) + 1];
        bf16_t* base = F.P1() + (size_t)row * NP1 + (h < 8 ? PC_CQ + h * 64 : PC_CK + (h - 8) * 64) + half * 32 + i;
        const float u1 = bf2f(base[0]), u2 = bf2f(base[16]);
        base[0] = f2bf(u1 * cs - u2 * sn); base[16] = f2bf(u1 * sn + u2 * cs);
    }
}

__device__ __forceinline__ int seq_row(int s, int b, int z) {
    if (s < LC) { const int tc = z ? (LC - 1 - s) : s; return NTOK + b * LC + tc; }
    const int tl = s - LC, t = z ? (SEQ - 1 - tl) : tl; return b * SEQ + t;
}
typedef short bf16x8_t __attribute__((ext_vector_type(8)));
typedef short bf16x4_t __attribute__((ext_vector_type(4)));
struct MaskNone { __device__ __forceinline__ void operator()(f32x4&, f32x4&) const {} };
struct MaskNA { int u0; const float* brow;
    __device__ __forceinline__ void operator()(f32x4& s0, f32x4& s1) const {
        float v[8] = {s0.x, s0.y, s0.z, s0.w, s1.x, s1.y, s1.z, s1.w};
#pragma unroll
        for (int T = 0; T < 2; ++T)
#pragma unroll
            for (int rr = 0; rr < 4; ++rr) v[T * 4 + rr] = ((unsigned)(u0 + 16 * T + rr) < 16u) ? v[T * 4 + rr] + brow[16 * T + rr] : -INFINITY;
        s0 = (f32x4){v[0], v[1], v[2], v[3]}; s1 = (f32x4){v[4], v[5], v[6], v[7]};
    }
};
struct MaskWA { int i, j0;
    __device__ __forceinline__ void operator()(f32x4& s0, f32x4& s1) const {
        float v[8] = {s0.x, s0.y, s0.z, s0.w, s1.x, s1.y, s1.z, s1.w};
#pragma unroll
        for (int T = 0; T < 2; ++T)
#pragma unroll
            for (int rr = 0; rr < 4; ++rr) { const int j = j0 + 16 * T + rr; const bool ok = (j >= 0) && (j < SEQ) && (i - j <= 128) && (j - i <= 128);
                v[T * 4 + rr] = ok ? v[T * 4 + rr] : -INFINITY; }
        s0 = (f32x4){v[0], v[1], v[2], v[3]}; s1 = (f32x4){v[4], v[5], v[6], v[7]};
    }
};
struct KVF { bf16x8_t k[4]; bf16x4_t v[4][2]; };
__device__ __forceinline__ void kv_load(KVF& f, const char* kbase, unsigned ko0, unsigned ko1, const char* vbase, unsigned vo0, unsigned vo1) {
    f.k[0] = *(const bf16x8_t*)(kbase + ko0); f.k[1] = *(const bf16x8_t*)(kbase + ko0 + 64); f.k[2] = *(const bf16x8_t*)(kbase + ko1); f.k[3] = *(const bf16x8_t*)(kbase + ko1 + 64);
#pragma unroll
    for (int t = 0; t < 4; ++t) { f.v[t][0] = *(const bf16x4_t*)(vbase + vo0 + (unsigned)t * 16u * NROW * 2u); f.v[t][1] = *(const bf16x4_t*)(vbase + vo1 + (unsigned)t * 16u * NROW * 2u); }
}
__device__ __forceinline__ float xmax_g(float x) {
    auto r = __builtin_amdgcn_permlane16_swap(__float_as_uint(x), __float_as_uint(x), false, false); x = fmaxf(__uint_as_float(r[0]), __uint_as_float(r[1]));
    auto q = __builtin_amdgcn_permlane32_swap(__float_as_uint(x), __float_as_uint(x), false, false); return fmaxf(__uint_as_float(q[0]), __uint_as_float(q[1])); }
__device__ __forceinline__ float xsum_g(float x) {
    auto r = __builtin_amdgcn_permlane16_swap(__float_as_uint(x), __float_as_uint(x), false, false); x = __uint_as_float(r[0]) + __uint_as_float(r[1]);
    auto q = __builtin_amdgcn_permlane32_swap(__float_as_uint(x), __float_as_uint(x), false, false); return __uint_as_float(q[0]) + __uint_as_float(q[1]); }
template <class MaskF>
__device__ __forceinline__ void attn_tile(float& am, f32x4& asum, f32x4 (&ao)[4], const bf16x8_t (&qb)[2], const KVF& f, const MaskF& maskf) {
    f32x4 s0 = {0.f, 0.f, 0.f, 0.f}, s1 = {0.f, 0.f, 0.f, 0.f};
    s0 = __builtin_amdgcn_mfma_f32_16x16x32_bf16(f.k[0], qb[0], s0, 0, 0, 0); s0 = __builtin_amdgcn_mfma_f32_16x16x32_bf16(f.k[1], qb[1], s0, 0, 0, 0);
    s1 = __builtin_amdgcn_mfma_f32_16x16x32_bf16(f.k[2], qb[0], s1, 0, 0, 0); s1 = __builtin_amdgcn_mfma_f32_16x16x32_bf16(f.k[3], qb[1], s1, 0, 0, 0);
    maskf(s0, s1);
    const float ml = fmaxf(fmaxf(fmaxf(s0.x, s0.y), fmaxf(s0.z, s0.w)), fmaxf(fmaxf(s1.x, s1.y), fmaxf(s1.z, s1.w)));
    if (__any(ml > am)) {
        const float mn = fmaxf(am, xmax_g(ml)), alpha = __builtin_amdgcn_exp2f(am - mn); am = mn; asum = asum * alpha;
#pragma unroll
        for (int t = 0; t < 4; ++t) ao[t] = ao[t] * alpha;
    }
    f32x4 p0, p1;
    p0.x = __builtin_amdgcn_exp2f(s0.x - am); p0.y = __builtin_amdgcn_exp2f(s0.y - am); p0.z = __builtin_amdgcn_exp2f(s0.z - am); p0.w = __builtin_amdgcn_exp2f(s0.w - am);
    p1.x = __builtin_amdgcn_exp2f(s1.x - am); p1.y = __builtin_amdgcn_exp2f(s1.y - am); p1.z = __builtin_amdgcn_exp2f(s1.z - am); p1.w = __builtin_amdgcn_exp2f(s1.w - am);
    union { bf16x8_t v; unsigned u[4]; } pb, ones;
    pb.u[0] = pk2(p0.x, p0.y); pb.u[1] = pk2(p0.z, p0.w); pb.u[2] = pk2(p1.x, p1.y); pb.u[3] = pk2(p1.z, p1.w);
    ones.u[0] = ones.u[1] = ones.u[2] = ones.u[3] = 0x3f803f80u;
#pragma unroll
    for (int t = 0; t < 4; ++t) {
        union { bf16x8_t v; bf16x4_t h[2]; } av; av.h[0] = f.v[t][0]; av.h[1] = f.v[t][1];
        ao[t] = __builtin_amdgcn_mfma_f32_16x16x32_bf16(av.v, pb.v, ao[t], 0, 0, 0);
    }
    asum = __builtin_amdgcn_mfma_f32_16x16x32_bf16(ones.v, pb.v, asum, 0, 0, 0);
}
template <int kind>
__device__ __forceinline__ void attn_block(Frame& F, int l, int item, const float* rpb_s, bf16_t* sbuf) {
    constexpr int NQ = 2, NCS = 4, NLOC = (kind == 0) ? 11 : (kind == 1 ? 5 : 0), NS = NCS + NLOC, SROW = 72;
    const int tid = F.tid, lane = F.lane, n = lane & 15, g = lane >> 4, w = __builtin_amdgcn_readfirstlane(F.wave);
    const bf16_t* P1 = F.P1(); const bf16_t* VT = F.VT();
    int b, h0, kvh = 0, kcol, vrow, r = 0, cb = 0, t0 = 0, t0g = 0, r0 = 0, qrow0, qcol0, brcol0;
    constexpr int QRS = (kind == 0) ? 64 : (kind == 2 ? 16 : 0), QCS = (kind == 1 || kind == 3) ? 64 : 0;
    if (kind == 0) { const int rq = item & 15, hb = (item >> 4) & 7; b = item >> 7; r0 = 4 * rq; cb = w & 3; r = r0 + 2 * (w >> 2); h0 = hb; kcol = PC_BK + hb * 64; vrow = hb * 64;
        qrow0 = b * SEQ + r * 64 + cb * 16; qcol0 = PC_BQ + hb * 64; brcol0 = 512 + hb * 64; }
    else if (kind == 1) { const int qg = item & 63; kvh = (item >> 6) & 1; b = item >> 7; t0g = 64 * qg; t0 = t0g + 16 * (w & 3); h0 = kvh * 4 + 2 * (w >> 2); kcol = PC_CK + kvh * 64; vrow = 512 + kvh * 64;
        qrow0 = b * SEQ + t0; qcol0 = PC_CQ + h0 * 64; brcol0 = 1024 + h0 * 64; }
    else if (kind == 2) { const int hb = item & 7; b = item >> 3; h0 = hb; kcol = PC_BK + hb * 64; vrow = hb * 64; qrow0 = NTOK + b * LC + 32 * w; qcol0 = PC_BQ + hb * 64; brcol0 = 512 + hb * 64; }
    else { const int qh = item & 3; kvh = (item >> 2) & 1; b = item >> 3; h0 = kvh * 4 + 2 * (w >> 2); kcol = PC_CK + kvh * 64; vrow = 512 + kvh * 64;
        qrow0 = NTOK + b * LC + 16 * (4 * qh + (w & 3)); qcol0 = PC_CQ + h0 * 64; brcol0 = 1024 + h0 * 64; }
    bf16x8_t qb[NQ][2]; float am[NQ]; f32x4 asum[NQ], ao[NQ][4];
    { const char* qbase = (const char*)P1; const unsigned qo = (unsigned)(qrow0 + n) * (unsigned)(NP1 * 2) + (unsigned)(qcol0 + 8 * g) * 2u;
#pragma unroll
      for (int q = 0; q < NQ; ++q) { const unsigned o = qo + (unsigned)q * (unsigned)(QRS * NP1 * 2 + QCS * 2); qb[q][0] = *(const bf16x8_t*)(qbase + o); qb[q][1] = *(const bf16x8_t*)(qbase + o + 64);
        am[q] = -1e30f; asum[q] = (f32x4){0.f, 0.f, 0.f, 0.f};
#pragma unroll
        for (int t = 0; t < 4; ++t) ao[q][t] = (f32x4){0.f, 0.f, 0.f, 0.f}; } }
    const int crow0 = NTOK + b * LC, ru0 = min(max(r0 - 4, 0), 56);
    const int w0 = (cb == 0) ? 0 : (cb == 1 ? 8 : (cb == 2 ? 24 : 32));
    const int srow = tid >> 3, sch = tid & 7;
    const char* kbase = (const char*)P1; const char* vbase = (const char*)VT;
    u32x4 kr0 = {0u, 0u, 0u, 0u}, vr0 = kr0, kr1 = kr0, vr1 = kr0;
    auto stage_load = [&](int s, u32x4& kreg, u32x4& vreg) {
        int krow, vcol;
        if (s < NCS) { krow = crow0 + 64 * s + srow; vcol = crow0 + 64 * s + 8 * sch; }
        else if (kind == 0) { const int kr = min(ru0 + (s - NCS), 63); krow = b * SEQ + kr * 64 + srow; vcol = b * SEQ + kr * 64 + 8 * sch; }
        else { const int kb = t0g - 128 + 64 * (s - NCS); krow = b * SEQ + min(max(kb + srow, 0), SEQ - 1); vcol = b * SEQ + min(max(kb + 8 * sch, 0), SEQ - 8); }
        kreg = *(const u32x4*)(kbase + (unsigned)krow * (unsigned)(NP1 * 2) + (unsigned)(kcol * 2 + sch * 16));
        vreg = *(const u32x4*)(vbase + (unsigned)(vrow + srow) * (unsigned)(NROW * 2) + (unsigned)vcol * 2u);
    };
    auto stage_store = [&](int s, const u32x4& kreg, const u32x4& vreg) { bf16_t* Ks = sbuf + (s & 1) * (2 * 64 * SROW); bf16_t* Vs = Ks + 64 * SROW;
        *(u32x4*)(Ks + srow * SROW + sch * 8) = kreg; *(u32x4*)(Vs + srow * SROW + sch * 8) = vreg; };
    stage_load(0, kr1, vr1); stage_store(0, kr1, vr1); stage_load(1, kr0, vr0);
    __syncthreads();
    auto do_step = [&](int s, const u32x4& kst, const u32x4& vst, u32x4& kld, u32x4& vld) {
        if (s + 2 < NS) stage_load(s + 2, kld, vld);
#pragma unroll
        for (int hh = 0; hh < 2; ++hh) {
            bool act[NQ]; int kofs = 32 * hh;
            if (s < NCS) { act[0] = act[1] = true; }
            else if (kind == 0) { const int kr = ru0 + (s - NCS); kofs = w0;
#pragma unroll
                for (int q = 0; q < NQ; ++q) { const int rsq = min(max(r + q - 4, 0), 56); act[q] = (hh == 0) && (kr <= 63) && (kr >= rsq) && (kr <= rsq + 7); } }
            else { const int kb = t0g - 128 + 64 * (s - NCS) + 32 * hh; act[0] = act[1] = (kb + 31 >= t0 - 128) && (kb <= t0 + 143); }
            if (act[0] || act[1]) {
                const bf16_t* Ks = sbuf + (s & 1) * (2 * 64 * SROW); const bf16_t* Vs = Ks + 64 * SROW;
                KVF f;
                f.k[0] = *(const bf16x8_t*)(Ks + (kofs + n) * SROW + 8 * g); f.k[1] = *(const bf16x8_t*)(Ks + (kofs + n) * SROW + 32 + 8 * g);
                f.k[2] = *(const bf16x8_t*)(Ks + (kofs + 16 + n) * SROW + 8 * g); f.k[3] = *(const bf16x8_t*)(Ks + (kofs + 16 + n) * SROW + 32 + 8 * g);
#pragma unroll
                for (int t = 0; t < 4; ++t) { f.v[t][0] = *(const bf16x4_t*)(Vs + (16 * t + n) * SROW + kofs + 4 * g); f.v[t][1] = *(const bf16x4_t*)(Vs + (16 * t + n) * SROW + kofs + 16 + 4 * g); }
                if (s < NCS) {
#pragma unroll
                    for (int q = 0; q < NQ; ++q) attn_tile(am[q], asum[q], ao[q], qb[q], f, MaskNone());
                } else if (kind == 0) { const int kr = ru0 + (s - NCS);
#pragma unroll
                    for (int q = 0; q < NQ; ++q) if (act[q]) { const int c = cb * 16 + n, csq = min(max(c - 8, 0), 48), kc0 = w0 + 4 * g;
                        MaskNA mk{kc0 - csq, rpb_s + (h0 * 15 + (kr - (r + q) + 7)) * 64 + (kc0 - c + 15 + 16)}; attn_tile(am[q], asum[q], ao[q], qb[q], f, mk); }
                } else if (kind == 1) { const int kb = t0g - 128 + 64 * (s - NCS) + 32 * hh;
                    if (kb >= t0 - 113 && kb + 31 <= t0 + 128 && kb >= 0 && kb + 31 < SEQ) {
#pragma unroll
                        for (int q = 0; q < NQ; ++q) attn_tile(am[q], asum[q], ao[q], qb[q], f, MaskNone());
                    } else { MaskWA mk{t0 + n, kb + 4 * g};
#pragma unroll
                        for (int q = 0; q < NQ; ++q) attn_tile(am[q], asum[q], ao[q], qb[q], f, mk); }
                }
            }
        }
        if (s + 1 < NS) stage_store(s + 1, kst, vst);
        __syncthreads();
    };
#pragma unroll 1
    for (int s = 0; s < NS; s += 2) { do_step(s, kr0, vr0, kr1, vr1); if (s + 1 < NS) do_step(s + 1, kr1, vr1, kr0, vr0); }
#pragma unroll
    for (int q = 0; q < NQ; ++q) {
        float lt = asum[q].x;
        float osc = 1.f;
        if (kind == 1 || kind == 3) { const float sk = F.p.wa_sink[l * 8 + h0 + q] * 1.44269504089f, mf = fmaxf(am[q], sk); osc = __builtin_amdgcn_exp2f(am[q] - mf); lt = lt * osc + __builtin_amdgcn_exp2f(sk - mf); }
        const float inv = osc / lt;
        char* obase = (char*)F.BR(); const unsigned oo = (unsigned)(qrow0 + q * QRS + n) * 4096u + (unsigned)(brcol0 + q * QCS + 4 * g) * 2u;
#pragma unroll
        for (int t = 0; t < 4; ++t) { const f32x4 v = ao[q][t] * inv; u32x2 o2; o2.x = pk2(v.x, v.y); o2.y = pk2(v.z, v.w); *(u32x2*)(obase + oo + 32u * t) = o2; }
    }
}

template <int DK, bool HG>
__device__ __forceinline__ void prescan_combo(Frame& F, int l, int b, int h, int first, int step) {
    constexpr int NDP = DK / 2, NTG = NTHR / NDP, TPT = 64 / NTG, LGS = 66;
    REFRESH(F);
    const int tid = F.tid, dp = tid % NDP, tg = tid / NDP, lane = F.lane, n = lane & 15, g = lane >> 4, w = __builtin_amdgcn_readfirstlane(F.wave);
    float* TOT = F.smf;
    float* LGS_ = F.smf + 2 * 2 * NTG * DK;
    char* p1b = (char*)F.P1();
    bf16x8_t bw[HG ? 1 : 4]; f32x2_t lb2[2];
    lb2[0] = (f32x2_t){0.f, 0.f}; lb2[1] = lb2[0];
    if (!HG) {
        const int zw = w >> 2;
#pragma unroll
        for (int dt = 0; dt < 4; ++dt) { float wv[8];
#pragma unroll
            for (int j = 0; j < 8; ++j) { const float x = F.p.gla_lr_w[((size_t)(l * 2 + zw) * 16 + 8 * (g & 1) + j) * 256 + h * 64 + dt * 16 + n]; const float hi = __uint_as_float(pk2(x, x) << 16); wv[j] = (g < 2) ? x : x - hi; }
            union { bf16x8_t v; unsigned u[4]; } pb; pb.u[0] = pk2(wv[0], wv[1]); pb.u[1] = pk2(wv[2], wv[3]); pb.u[2] = pk2(wv[4], wv[5]); pb.u[3] = pk2(wv[6], wv[7]); bw[HG ? 0 : dt] = pb.v; }
#pragma unroll
        for (int z = 0; z < 2; ++z) { const float* bp = F.p.gla_lr_b + (l * 2 + z) * 256 + h * 64 + 2 * dp; lb2[z] = (f32x2_t){bp[0], bp[1]}; }
    }
    const int qcol = HG ? PC_DQ + h * 128 + 2 * dp : PC_AQ + h * 64 + 2 * dp, kcol = HG ? PC_DF + h * 128 + 2 * dp : PC_AK + h * 64 + 2 * dp;
    float* ebase = F.ESC() + (HG ? 32 * 68 * 128 : 0);
    unsigned rq[TPT], rk[TPT], rk1[HG ? TPT : 1]; u32x4 rlp = {0u, 0u, 0u, 0u};
    rk1[0] = 0u;
#define PS_LOAD(nbk_) do { const int row0_ = seq_row((nbk_) * 64, b, 0); unsigned o_ = (unsigned)(row0_ + tg * TPT) * (unsigned)(NP1 * 2); \
        _Pragma("unroll") for (int tt = 0; tt < TPT; ++tt) { rq[tt] = *(const unsigned*)(p1b + (o_ + (unsigned)(qcol * 2))); rk[tt] = *(const unsigned*)(p1b + (o_ + (unsigned)(kcol * 2))); \
            if (HG) rk1[HG ? tt : 0] = *(const unsigned*)(p1b + (o_ + (unsigned)((kcol + 512) * 2))); o_ += (unsigned)(NP1 * 2); } \
        if (!HG) rlp = *(const u32x4*)(p1b + ((unsigned)(row0_ + (w & 3) * 16 + n) * (unsigned)(NP1 * 2) + (unsigned)((PC_ALR + (w >> 2) * 16 + (g & 1) * 8) * 2))); } while (0)
    int nbk = first, par = 0;
    if (nbk < 68) PS_LOAD(nbk);
#pragma unroll 1
    for (; nbk < 68; nbk += step, par ^= 1) {
        float* tot = TOT + par * (2 * NTG * DK);
        if (!HG) {
            union { bf16x8_t v; u32x4 u; } af; af.u = rlp;
            float* lgw = LGS_ + ((w >> 2) * 64 + (w & 3) * 16 + 4 * g) * LGS + n;
#pragma unroll
            for (int dt = 0; dt < 4; ++dt) { const f32x4 d = __builtin_amdgcn_mfma_f32_16x16x32_bf16(af.v, bw[HG ? 0 : dt], (f32x4){0.f, 0.f, 0.f, 0.f}, 0, 0, 0);
                lgw[0 * LGS + dt * 16] = d.x; lgw[1 * LGS + dt * 16] = d.y; lgw[2 * LGS + dt * 16] = d.z; lgw[3 * LGS + dt * 16] = d.w; }
            __syncthreads();
        }
        const int row0 = seq_row(nbk * 64, b, 0);
        f32x2_t qv[TPT], kv0[TPT], kv1[HG ? TPT : 1], cs0[TPT], cs1[TPT];
#pragma unroll
        for (int tt = 0; tt < TPT; ++tt) {
            qv[tt] = (f32x2_t){__uint_as_float(rq[tt] << 16), __uint_as_float(rq[tt] & 0xffff0000u)};
            const f32x2_t kr = {__uint_as_float(rk[tt] << 16), __uint_as_float(rk[tt] & 0xffff0000u)};
            if (HG) { const unsigned r1 = rk1[HG ? tt : 0]; const f32x2_t k1 = {__uint_as_float(r1 << 16), __uint_as_float(r1 & 0xffff0000u)};
                cs0[tt] = kr; cs1[tt] = k1;
                kv0[tt] = (f32x2_t){1.f - __expf(kr.x), 1.f - __expf(kr.y)}; kv1[HG ? tt : 0] = (f32x2_t){1.f - __expf(k1.x), 1.f - __expf(k1.y)}; }
            else kv0[tt] = kr;
        }
        if (nbk + step < 68) PS_LOAD(nbk + step);
        if (!HG) {
#pragma unroll
            for (int tt = 0; tt < TPT; ++tt)
#pragma unroll
                for (int z = 0; z < 2; ++z) {
                    const f32x2_t lg = *(const f32x2_t*)(LGS_ + (z * 64 + tg * TPT + tt) * LGS + 2 * dp) + lb2[z];
                    const f32x2_t gz = {(fminf(lg.x, 0.f) - __logf(1.f + __expf(-fabsf(lg.x)))) * (1.f / 16.f), (fminf(lg.y, 0.f) - __logf(1.f + __expf(-fabsf(lg.y)))) * (1.f / 16.f)};
                    if (z == 0) cs0[tt] = gz; else cs1[tt] = gz; }
        }
#pragma unroll
        for (int tt = 1; tt < TPT; ++tt) { cs0[tt] += cs0[tt - 1]; cs1[TPT - 1 - tt] += cs1[TPT - tt]; }
        *(f32x2_t*)(tot + (0 * NTG + tg) * DK + 2 * dp) = cs0[TPT - 1];
        *(f32x2_t*)(tot + (1 * NTG + tg) * DK + 2 * dp) = cs1[0];
        __syncthreads();
        f32x2_t offs0 = {0.f, 0.f}, mid0 = offs0, last0 = offs0, offs1 = offs0, mid1 = offs0, last1 = offs0;
#pragma unroll
        for (int t2 = 0; t2 < NTG; ++t2) { const f32x2_t v0 = *(const f32x2_t*)(tot + (0 * NTG + t2) * DK + 2 * dp), v1 = *(const f32x2_t*)(tot + (1 * NTG + t2) * DK + 2 * dp);
            if (t2 < tg) offs0 += v0; if (t2 < NTG / 2) mid0 += v0; last0 += v0;
            if (t2 > tg) offs1 += v1; if (t2 >= NTG / 2) mid1 += v1; last1 += v1; }
        const f32x2_t d0 = offs0 - mid0, d1 = offs1 - mid1;
        unsigned ro = (unsigned)(row0 + tg * TPT);
#pragma unroll
        for (int tt = 0; tt < TPT; ++tt, ++ro) {
            const float x00 = fminf(fmaxf(cs0[tt].x + d0.x, -80.f), 80.f), x01 = fminf(fmaxf(cs0[tt].y + d0.y, -80.f), 80.f);
            const float x10 = fminf(fmaxf(cs1[tt].x + d1.x, -80.f), 80.f), x11 = fminf(fmaxf(cs1[tt].y + d1.y, -80.f), 80.f);
            const f32x2_t k1v = kv1[HG ? tt : 0], k1 = HG ? k1v : kv0[tt];
            const unsigned qd0 = pk2(qv[tt].x * __expf(x00), qv[tt].y * __expf(x01)), kd0 = pk2(kv0[tt].x * __expf(-x00), kv0[tt].y * __expf(-x01));
            const unsigned qd1 = pk2(qv[tt].x * __expf(x10), qv[tt].y * __expf(x11)), kd1 = pk2(k1.x * __expf(-x10), k1.y * __expf(-x11));
            const unsigned o_ = ro * (unsigned)(NP1 * 2);
            *(unsigned*)(p1b + (o_ + (unsigned)(qcol * 2))) = qd0; *(unsigned*)(p1b + (o_ + (unsigned)(kcol * 2))) = kd0;
            if (HG) { *(unsigned*)(p1b + (o_ + (unsigned)((kcol + 512) * 2))) = kd1; *(unsigned*)((char*)F.BR() + (ro * 4096u + (unsigned)((1536 + h * 128 + 2 * dp) * 2))) = qd1; }
            else { *(unsigned*)((char*)F.SC1() + (ro * 1024u + (unsigned)((h * 64 + 2 * dp) * 2))) = qd1; *(unsigned*)((char*)F.SC1() + (ro * 1024u + (unsigned)((256 + h * 64 + 2 * dp) * 2))) = kd1; }
        }
        if (tg == 0) {
            float* e0 = ebase + (size_t)(((b * 4 + h) * 2 + 0) * 68 + nbk) * (2 * DK), *e1 = ebase + (size_t)(((b * 4 + h) * 2 + 1) * 68 + (nbk < 4 ? 3 - nbk : 71 - nbk)) * (2 * DK);
            *(f32x2_t*)(e0 + 2 * dp) = (f32x2_t){__expf(mid0.x), __expf(mid0.y)}; *(f32x2_t*)(e0 + DK + 2 * dp) = (f32x2_t){__expf(last0.x - mid0.x), __expf(last0.y - mid0.y)};
            *(f32x2_t*)(e1 + 2 * dp) = (f32x2_t){__expf(mid1.x), __expf(mid1.y)}; *(f32x2_t*)(e1 + DK + 2 * dp) = (f32x2_t){__expf(last1.x - mid1.x), __expf(last1.y - mid1.y)};
        }
    }
    __syncthreads();
#undef PS_LOAD
}
__device__ __forceinline__ void phase_prescan(Frame& F, int l) {
    if (F.nb >= 32) { const int combo = F.bid & 31, b = (combo >> 2) & 3, h = combo & 3;
        if ((combo >> 4) == 0) prescan_combo<64, false>(F, l, b, h, F.bid >> 5, F.nb >> 5); else prescan_combo<128, true>(F, l, b, h, F.bid >> 5, F.nb >> 5);
    } else {
        for (int combo = F.bid; combo < 32; combo += F.nb) { const int b = (combo >> 2) & 3, h = combo & 3;
            if ((combo >> 4) == 0) prescan_combo<64, false>(F, l, b, h, 0, 1); else prescan_combo<128, true>(F, l, b, h, 0, 1); }
    }
}

template <int DK, bool HG>
__device__ __forceinline__ void scan_mfma(Frame& F, int l, int b, int h, int z, int vh, unsigned char* lds) {
    constexpr int NDP = DK / 2, NTG = NTHR / NDP, TPT = 64 / NTG, QS = DK + 8, TS = 72, NDT = DK / 16, PPR = DK / 8, NQP = (64 * PPR) / NTHR;
    bf16_t* QD = (bf16_t*)lds; bf16_t* KD = QD + 64 * QS; bf16_t* KDT = KD + 64 * QS; bf16_t* VTs = KDT + DK * TS; bf16_t* AM = VTs + 64 * TS; bf16_t* ST = AM + 64 * TS;
    float* E1s = (float*)(ST + 64 * QS); float* E2s = E1s + DK;
    REFRESH(F);
    const int tid = F.tid, lane = F.lane, w = F.wave, n = lane & 15, g = lane >> 4;
    const int dp = tid % NDP, tg = tid / NDP, vp = tid & 31, vg = tid >> 5;
    const int vt = w & 3, wh = w >> 2;
    const char* p1b = (const char*)F.P1();
    const char* qb; const char* kb; unsigned qstr, kstr, qoff, koff;
    if (HG) { kb = p1b; kstr = NP1 * 2; koff = (unsigned)((PC_DF + z * 512 + h * 128) * 2);
        if (z == 0) { qb = p1b; qstr = NP1 * 2; qoff = (unsigned)((PC_DQ + h * 128) * 2); } else { qb = (const char*)F.BR(); qstr = 4096u; qoff = (unsigned)((1536 + h * 128) * 2); } }
    else if (z == 0) { qb = p1b; kb = p1b; qstr = kstr = NP1 * 2; qoff = (unsigned)((PC_AQ + h * 64) * 2); koff = (unsigned)((PC_AK + h * 64) * 2); }
    else { qb = (const char*)F.SC1(); kb = qb; qstr = kstr = 1024u; qoff = (unsigned)(h * 64 * 2); koff = (unsigned)((256 + h * 64) * 2); }
    const float* eb = F.ESC() + (HG ? 32 * 68 * 128 : 0) + (size_t)(((b * 4 + h) * 2 + z) * 68) * (2 * DK);
    f32x4 accS[NDT / 2];
#pragma unroll
    for (int i = 0; i < NDT / 2; ++i) accS[i] = (f32x4){0.f, 0.f, 0.f, 0.f};
    u32x4 rqp[NQP]; unsigned rk[TPT], rv[4]; float re = 0.f;
    const int vcol = (HG ? PC_DI : PC_AV) + h * 128 + 64 * vh + 2 * vp;
    const int sgn = z ? -1 : 1; const int rstep = sgn * NP1 * 2;
#define SCAN_LOAD(c) do { const int row0_ = seq_row((c) * 64, b, z); \
        _Pragma("unroll") for (int j = 0; j < NQP; ++j) { const int pi_ = tid + NTHR * j; rqp[j] = *(const u32x4*)(qb + ((unsigned)(row0_ + sgn * (pi_ / PPR)) * qstr + qoff + (unsigned)((pi_ % PPR) * 16))); } \
        _Pragma("unroll") for (int tt = 0; tt < TPT; ++tt) rk[tt] = *(const unsigned*)(kb + ((unsigned)(row0_ + sgn * (tg * TPT + tt)) * kstr + koff + (unsigned)(dp * 4))); \
        int ov_ = (row0_ + sgn * vg * 4) * (NP1 * 2) + vcol * 2; \
        _Pragma("unroll") for (int tt = 0; tt < 4; ++tt) { rv[tt] = *(const unsigned*)(p1b + (unsigned)ov_); ov_ += rstep; } \
        if (tid < 2 * DK) re = eb[(c) * (2 * DK) + tid]; } while (0)
    SCAN_LOAD(0);
    constexpr int NCH = (LC + SEQ) / 64;
#pragma unroll 1
    for (int c = 0; c < NCH; ++c) {
        __syncthreads();
#pragma unroll
        for (int j = 0; j < NQP; ++j) { const int pi_ = tid + NTHR * j; *(u32x4*)(QD + (pi_ / PPR) * QS + (pi_ % PPR) * 8) = rqp[j]; }
#pragma unroll
        for (int tt = 0; tt < TPT; ++tt) *(unsigned*)(KD + (tg * TPT + tt) * QS + 2 * dp) = rk[tt];
        {   unsigned kdt[2][TPT / 2];
#pragma unroll
            for (int t2 = 0; t2 < TPT / 2; ++t2) { kdt[0][t2] = (rk[2 * t2] & 0xffffu) | (rk[2 * t2 + 1] << 16); kdt[1][t2] = (rk[2 * t2] >> 16) | (rk[2 * t2 + 1] & 0xffff0000u); }
#pragma unroll
            for (int e = 0; e < 2; ++e) {
                bf16_t* dst = KDT + (2 * dp + e) * TS + tg * TPT;
                if (TPT == 8) { u32x4 o; o.x = kdt[e][0]; o.y = kdt[e][1]; o.z = kdt[e][TPT / 2 - 2]; o.w = kdt[e][TPT / 2 - 1]; *(u32x4*)dst = o; }
                else { u32x2 o; o.x = kdt[e][0]; o.y = kdt[e][1]; *(u32x2*)dst = o; }
            }
        }
        if (tid < 2 * DK) E1s[tid] = re;
        {   u32x2 o0, o1;
            o0.x = (rv[0] & 0xffffu) | (rv[1] << 16); o0.y = (rv[2] & 0xffffu) | (rv[3] << 16);
            o1.x = (rv[0] >> 16) | (rv[1] & 0xffff0000u); o1.y = (rv[2] >> 16) | (rv[3] & 0xffff0000u);
            *(u32x2*)(VTs + (2 * vp) * TS + vg * 4) = o0; *(u32x2*)(VTs + (2 * vp + 1) * TS + vg * 4) = o1; }
        if (c + 1 < NCH) SCAN_LOAD(c + 1);
        __syncthreads();
#pragma unroll
        for (int i = 0; i < NDT / 2; ++i) { const int dt = wh * (NDT / 2) + i; accS[i] = accS[i] * *(const f32x4*)&E1s[16 * dt + 4 * g];
            u32x2 o; o.x = pk2(accS[i].x, accS[i].y); o.y = pk2(accS[i].z, accS[i].w); *(u32x2*)(ST + (16 * vt + n) * QS + 16 * dt + 4 * g) = o; }
        {   const int it = w >> 1, jt0 = 2 * (w & 1);
            f32x4 d0 = {0.f, 0.f, 0.f, 0.f}, d1 = {0.f, 0.f, 0.f, 0.f};
            if (jt0 <= it) {
                bf16x8_t qf[DK / 32], k0f[DK / 32], k1f[DK / 32];
#pragma unroll
                for (int ks = 0; ks < DK / 32; ++ks) { qf[ks] = *(const bf16x8_t*)(QD + (16 * it + n) * QS + 32 * ks + 8 * g); k0f[ks] = *(const bf16x8_t*)(KD + (16 * jt0 + n) * QS + 32 * ks + 8 * g); k1f[ks] = *(const bf16x8_t*)(KD + (16 * (jt0 + 1) + n) * QS + 32 * ks + 8 * g); }
#pragma unroll
                for (int ks = 0; ks < DK / 32; ++ks) { d0 = __builtin_amdgcn_mfma_f32_16x16x32_bf16(k0f[ks], qf[ks], d0, 0, 0, 0); d1 = __builtin_amdgcn_mfma_f32_16x16x32_bf16(k1f[ks], qf[ks], d1, 0, 0, 0); }
                const int i = 16 * it + n, j0 = 16 * jt0 + 4 * g, j1 = j0 + 16;
                d0.x = (j0 + 0 <= i) ? d0.x : 0.f; d0.y = (j0 + 1 <= i) ? d0.y : 0.f; d0.z = (j0 + 2 <= i) ? d0.z : 0.f; d0.w = (j0 + 3 <= i) ? d0.w : 0.f;
                d1.x = (j1 + 0 <= i) ? d1.x : 0.f; d1.y = (j1 + 1 <= i) ? d1.y : 0.f; d1.z = (j1 + 2 <= i) ? d1.z : 0.f; d1.w = (j1 + 3 <= i) ? d1.w : 0.f;
            }
            u32x2 o; o.x = pk2(d0.x, d0.y); o.y = pk2(d0.z, d0.w); *(u32x2*)(AM + (16 * it + n) * TS + 16 * jt0 + 4 * g) = o;
            o.x = pk2(d1.x, d1.y); o.y = pk2(d1.z, d1.w); *(u32x2*)(AM + (16 * it + n) * TS + 16 * (jt0 + 1) + 4 * g) = o;
        }
        __syncthreads();
        {   f32x4 o[2];
#pragma unroll
            for (int ii = 0; ii < 2; ++ii) o[ii] = (f32x4){0.f, 0.f, 0.f, 0.f};
#pragma unroll
            for (int ks = 0; ks < 2; ++ks) { const bf16x8_t af = *(const bf16x8_t*)(VTs + (16 * vt + n) * TS + 32 * ks + 8 * g); bf16x8_t bf[2];
#pragma unroll
                for (int ii = 0; ii < 2; ++ii) bf[ii] = *(const bf16x8_t*)(AM + (16 * (2 * wh + ii) + n) * TS + 32 * ks + 8 * g);
#pragma unroll
                for (int ii = 0; ii < 2; ++ii) o[ii] = __builtin_amdgcn_mfma_f32_16x16x32_bf16(af, bf[ii], o[ii], 0, 0, 0); }
#pragma unroll
            for (int ks = 0; ks < DK / 32; ++ks) { const bf16x8_t af = *(const bf16x8_t*)(ST + (16 * vt + n) * QS + 32 * ks + 8 * g); bf16x8_t bf[2];
#pragma unroll
                for (int ii = 0; ii < 2; ++ii) bf[ii] = *(const bf16x8_t*)(QD + (16 * (2 * wh + ii) + n) * QS + 32 * ks + 8 * g);
#pragma unroll
                for (int ii = 0; ii < 2; ++ii) o[ii] = __builtin_amdgcn_mfma_f32_16x16x32_bf16(af, bf[ii], o[ii], 0, 0, 0); }
            const int row0 = seq_row(c * 64, b, z) + sgn * (32 * wh + n), vc = h * 128 + 64 * vh + 16 * vt + 4 * g;
            char* dstb; unsigned doff; int dstride;
            if (HG) { dstb = (char*)F.ODH(); doff = (unsigned)row0 * 2048u + (unsigned)(z * 512 + vc) * 2u; dstride = sgn * 16 * 2048; }
            else if (z == 0) { dstb = (char*)F.BR(); doff = (unsigned)row0 * 4096u + (unsigned)vc * 2u; dstride = sgn * 16 * 4096; }
            else { dstb = (char*)F.OBA(); doff = (unsigned)row0 * 1024u + (unsigned)vc * 2u; dstride = sgn * 16 * 1024; }
#pragma unroll
            for (int ii = 0; ii < 2; ++ii) { u32x2 o2; o2.x = pk2(o[ii].x, o[ii].y); o2.y = pk2(o[ii].z, o[ii].w); *(u32x2*)(dstb + (unsigned)((int)doff + ii * dstride)) = o2; }
        }
#pragma unroll
        for (int ks = 0; ks < 2; ++ks) { const bf16x8_t bv = *(const bf16x8_t*)(VTs + (16 * vt + n) * TS + 32 * ks + 8 * g); bf16x8_t af[NDT / 2];
#pragma unroll
            for (int i = 0; i < NDT / 2; ++i) af[i] = *(const bf16x8_t*)(KDT + (16 * (wh * (NDT / 2) + i) + n) * TS + 32 * ks + 8 * g);
#pragma unroll
            for (int i = 0; i < NDT / 2; ++i) accS[i] = __builtin_amdgcn_mfma_f32_16x16x32_bf16(af[i], bv, accS[i], 0, 0, 0); }
#pragma unroll
        for (int i = 0; i < NDT / 2; ++i) accS[i] = accS[i] * *(const f32x4*)&E2s[16 * (wh * (NDT / 2) + i) + 4 * g];
    }
    __syncthreads();
#undef SCAN_LOAD
}

__device__ __forceinline__ void phase_mix(Frame& F, int l) {
    const int n_scan = 128;
    const int nsb = (F.nb > 192) ? 128 : 0;
    if (nsb == 0 || F.bid < nsb) {
        for (int it = F.bid; it < n_scan; it += (nsb ? nsb : F.nb)) {
            const int br = it >> 6, r = (it >> 1) & 31, vh = it & 1, b = r >> 3, h = (r >> 1) & 3, z = r & 1;
            if (br == 0) scan_mfma<64, false>(F, l, b, h, z, vh, (unsigned char*)F.smf); else scan_mfma<128, true>(F, l, b, h, z, vh, (unsigned char*)F.smf);
        }
        __syncthreads();
    }
    float* rpb_s = F.smf;
    {   float tv[(8 * 15 * 64) / NTHR];
#pragma unroll
        for (int k = 0; k < (8 * 15 * 64) / NTHR; ++k) { const int i = F.tid + k * NTHR, dcp = i & 63, hr = i >> 6; tv[k] = (dcp >= 16 && dcp < 47) ? F.p.na_rpb[l * 8 * 465 + hr * 31 + (dcp - 16)] : 0.f; }
#pragma unroll
        for (int k = 0; k < (8 * 15 * 64) / NTHR; ++k) rpb_s[F.tid + k * NTHR] = tv[k] * 1.44269504089f; }
    bf16_t* sbuf = (bf16_t*)(F.smf + 8 * 15 * 64);
    unsigned* qhead = F.cnt() + 64 + l * 16;
    int* cur = (int*)((unsigned char*)F.smf - LDS_STAGE + 32);
    const int n_wa = 512, n_na = 512, n_cna = (l == 0) ? 32 : 0, n_cwa = (l == 0) ? 32 : 0, total = n_wa + n_na + n_cna + n_cwa;
    int nxt = 0;
    if (F.tid == 0) nxt = (int)atomicAdd(qhead, 1u);
    for (;;) {
        __syncthreads();
        if (F.tid == 0) *cur = nxt;
        __syncthreads();
        const int it = *cur;
        if (it >= total) break;
        if (F.tid == 0) nxt = (int)atomicAdd(qhead, 1u);
        if (it < n_wa) attn_block<1>(F, l, it, rpb_s, sbuf);
        else if (it < n_wa + n_na) attn_block<0>(F, l, it - n_wa, rpb_s, sbuf);
        else if (it < n_wa + n_na + n_cna) attn_block<2>(F, l, it - n_wa - n_na, rpb_s, sbuf);
        else attn_block<3>(F, l, it - n_wa - n_na - n_cna, rpb_s, sbuf);
    }
}

__device__ __forceinline__ void phase_prepad(Frame& F, int l) {
    const int gw = F.bid * 8 + F.wave, ngw = F.nb * 8, npairs = ((l == 0) ? NROW : NTOK) / 2, c0 = F.lane * 8;
    for (int pi = gw; pi < npairs; pi += ngw) {
        u32x4 ra[2][2], rb[2][2], rg[2][2];
#pragma unroll
        for (int q = 0; q < 2; ++q) { const size_t row = (size_t)pi * 2 + q;
            ra[q][0] = *(const u32x4*)(F.BR() + row * 2048 + c0); rb[q][0] = *(const u32x4*)(F.OBA() + row * 512 + c0); rg[q][0] = *(const u32x4*)(F.P1() + row * NP1 + PC_AG + c0);
            ra[q][1] = *(const u32x4*)(F.ODH() + row * 1024 + c0); rb[q][1] = *(const u32x4*)(F.ODH() + row * 1024 + 512 + c0); rg[q][1] = *(const u32x4*)(F.P1() + row * NP1 + PC_DG + c0); }
#pragma unroll
        for (int q = 0; q < 2; ++q)
#pragma unroll
            for (int br = 0; br < 2; ++br) {
                const unsigned ua[4] = {ra[q][br].x, ra[q][br].y, ra[q][br].z, ra[q][br].w}, ub[4] = {rb[q][br].x, rb[q][br].y, rb[q][br].z, rb[q][br].w}, ug[4] = {rg[q][br].x, rg[q][br].y, rg[q][br].z, rg[q][br].w};
                float o[8], g[8]; float ss = 0.f;
#pragma unroll
                for (int j = 0; j < 4; ++j) { o[2 * j] = __uint_as_float(ua[j] << 16) + __uint_as_float(ub[j] << 16); o[2 * j + 1] = __uint_as_float(ua[j] & 0xffff0000u) + __uint_as_float(ub[j] & 0xffff0000u);
                    g[2 * j] = __uint_as_float(ug[j] << 16); g[2 * j + 1] = __uint_as_float(ug[j] & 0xffff0000u); ss += o[2 * j] * o[2 * j] + o[2 * j + 1] * o[2 * j + 1]; }
                ss += __shfl_xor(ss, 1); ss += __shfl_xor(ss, 2); ss += __shfl_xor(ss, 4); ss += __shfl_xor(ss, 8);
                const float rs = rsqrtf(ss * (1.f / 128.f) + 1e-6f);
#pragma unroll
                for (int j = 0; j < 8; ++j) o[j] = o[j] * rs * siluf_(g[j]);
                st8(F.BR() + ((size_t)pi * 2 + q) * 2048 + (br ? 1536 : 0) + c0, o);
            }
    }
}

__device__ __forceinline__ void phase_ln1(Frame& F, int l) {
    const int nrows = (l == 0) ? NROW : NTOK, ngroups = nrows / 64;
    const float* lg = F.p.ln_g + (size_t)(l * 2 + 0) * DM; const float* lbb = F.p.ln_b + (size_t)(l * 2 + 0) * DM;
    float* part = F.smf;
    const int wv = __builtin_amdgcn_readfirstlane(F.wave);
    float* stg = F.smf + 8 * 36 * 64 + wv * (64 * 17 + 16 * 40);
    float* wl = stg + 64 * 17;
    for (int grp = F.bid; grp < ngroups; grp += F.nb) {
        const int row0 = grp * 64, rb = row_batch(row0);
        const float* mv = F.modv() + ((size_t)l * 5 + rb) * 6144;
        float* xg = row0 < NTOK ? F.p.out + (size_t)row0 * DM : F.cxm() + (size_t)(row0 - NTOK) * DM;
#pragma unroll 1
        for (int rr = 0; rr < 8; rr += 2) {
            const int lr = wv * 8 + rr; float* xr = xg + (size_t)lr * DM;
            f32x4 v[2][4]; float s[2] = {0.f, 0.f};
#pragma unroll
            for (int q = 0; q < 2; ++q)
#pragma unroll
                for (int j = 0; j < 4; ++j) v[q][j] = *(const f32x4*)(xr + (size_t)q * DM + j * 256 + F.lane * 4);
#pragma unroll
            for (int q = 0; q < 2; ++q)
#pragma unroll
                for (int j = 0; j < 4; ++j) s[q] += (v[q][j].x + v[q][j].y) + (v[q][j].z + v[q][j].w);
#pragma unroll
            for (int o = 1; o < 64; o <<= 1) { s[0] += __shfl_xor(s[0], o); s[1] += __shfl_xor(s[1], o); }
            float s2[2] = {0.f, 0.f};
#pragma unroll
            for (int q = 0; q < 2; ++q) { const float mean = s[q] * (1.f / DM);
#pragma unroll
                for (int j = 0; j < 4; ++j) { v[q][j] = v[q][j] - mean; s2[q] += (v[q][j].x * v[q][j].x + v[q][j].y * v[q][j].y) + (v[q][j].z * v[q][j].z + v[q][j].w * v[q][j].w); } }
#pragma unroll
            for (int o = 1; o < 64; o <<= 1) { s2[0] += __shfl_xor(s2[0], o); s2[1] += __shfl_xor(s2[1], o); }
#pragma unroll
            for (int j = 0; j < 4; ++j) { const int d = j * 256 + F.lane * 4;
                const f32x4 g4 = *(const f32x4*)(lg + d), b4 = *(const f32x4*)(lbb + d), m3 = *(const f32x4*)(mv + 3 * 1024 + d), m4 = *(const f32x4*)(mv + 4 * 1024 + d);
#pragma unroll
                for (int q = 0; q < 2; ++q) { const float rstd = rsqrtf(s2[q] * (1.f / DM) + LN_EPS);
                    const f32x4 xn = v[q][j] * rstd * g4 + b4;
                    *(f32x4*)(xr + (size_t)q * DM + d) = xn;
                    const f32x4 h2 = xn * (1.f + m4) + m3;
                    u32x2 o2; o2.x = pk2(h2.x, h2.y); o2.y = pk2(h2.z, h2.w);
                    *(u32x2*)(F.HX2() + (size_t)(row0 + lr + q) * DM + d) = o2; } }
        }
        __syncthreads();
        {   f32x4 acc[4][3];
#pragma unroll
            for (int mt = 0; mt < 4; ++mt)
#pragma unroll
                for (int nt = 0; nt < 3; ++nt) acc[mt][nt] = (f32x4){0.f, 0.f, 0.f, 0.f};
            const float* wgp = F.p.moe_w_group + ((size_t)l * DM + wv * 128) * 4; const float* wep = F.p.moe_w_expert + ((size_t)l * DM + wv * 128) * 32;
            const float* m3p = mv + 3 * 1024 + wv * 128; const float* m4p = mv + 4 * 1024 + wv * 128;
            const int ln = F.lane & 15, lk = F.lane >> 4;
#pragma unroll 1
            for (int dc = 0; dc < 128; dc += 16) {
                f32x4 t[4]; float bw[4][3];
#pragma unroll
                for (int i = 0; i < 4; ++i) t[i] = *(const f32x4*)(xg + (size_t)(16 * i + (F.lane >> 2)) * DM + wv * 128 + dc + (F.lane & 3) * 4);
                const f32x4 m3v = *(const f32x4*)(m3p + dc + (F.lane & 3) * 4), m4v = *(const f32x4*)(m4p + dc + (F.lane & 3) * 4);
#pragma unroll
                for (int ks = 0; ks < 4; ++ks) { const int d = dc + 4 * ks + lk; bw[ks][0] = wep[(size_t)d * 32 + ln]; bw[ks][1] = wep[(size_t)d * 32 + 16 + ln]; bw[ks][2] = (ln < 4) ? wgp[(size_t)d * 4 + ln] : 0.f; }
#pragma unroll
                for (int i = 0; i < 4; ++i) { float* sp = stg + (16 * i + (F.lane >> 2)) * 17 + (F.lane & 3) * 4;
                    sp[0] = t[i].x * (1.f + m4v.x) + m3v.x; sp[1] = t[i].y * (1.f + m4v.y) + m3v.y; sp[2] = t[i].z * (1.f + m4v.z) + m3v.z; sp[3] = t[i].w * (1.f + m4v.w) + m3v.w; }
                asm volatile("s_waitcnt lgkmcnt(0)" ::: "memory");
#pragma unroll
                for (int ks = 0; ks < 4; ++ks)
#pragma unroll
                    for (int mt = 0; mt < 4; ++mt) { const float av = stg[(16 * mt + ln) * 17 + 4 * ks + lk];
#pragma unroll
                        for (int nt = 0; nt < 3; ++nt) acc[mt][nt] = __builtin_amdgcn_mfma_f32_16x16x4f32(av, bw[ks][nt], acc[mt][nt], 0, 0, 0); }
                asm volatile("s_waitcnt lgkmcnt(0)" ::: "memory");
            }
#pragma unroll
            for (int mt = 0; mt < 4; ++mt)
#pragma unroll
                for (int nt = 0; nt < 3; ++nt) { const int oi = (nt == 2) ? ln : 4 + 16 * nt + ln;
                    if (nt < 2 || ln < 4) {
#pragma unroll
                        for (int r = 0; r < 4; ++r) part[(wv * 36 + oi) * 64 + 16 * mt + 4 * lk + r] = acc[mt][nt][r]; } }
        }
        __syncthreads();
        if (wv == 0) {
            const int row = row0 + F.lane;
            float gl[4]; int gi = 0; float gm = -3.4e38f;
#pragma unroll
            for (int o = 0; o < 4; ++o) { float t = F.p.moe_b_group[l * 4 + o];
#pragma unroll
                for (int w2 = 0; w2 < 8; ++w2) t += part[(w2 * 36 + o) * 64 + F.lane];
                gl[o] = t; if (t > gm) { gm = t; gi = o; } }
            float gs = 0.f;
#pragma unroll
            for (int o = 0; o < 4; ++o) gs += expf(gl[o] - gm);
            const float gwt = 1.f / gs;
            float e1 = -3.4e38f, e2 = -3.4e38f; int i1 = 0, i2 = 0;
#pragma unroll
            for (int o8 = 0; o8 < 8; ++o8) { const int o = gi * 8 + o8; float ev = F.p.moe_b_expert[l * 32 + o];
#pragma unroll
                for (int w2 = 0; w2 < 8; ++w2) ev += part[(w2 * 36 + 4 + o) * 64 + F.lane];
                if (ev > e1) { e2 = e1; i2 = i1; e1 = ev; i1 = o; } else if (ev > e2) { e2 = ev; i2 = o; } }
            const float w1 = 1.f / (1.f + expf(e2 - e1)), w2v = 1.f - w1;
            unsigned* lh = (unsigned*)(stg + 64 * 17 + 16 * 40 - 64);
            if (F.lane < 32) lh[F.lane] = 0u;
            asm volatile("s_waitcnt lgkmcnt(0)" ::: "memory");
            const unsigned r1 = atomicAdd(&lh[i1], 1u), r2 = atomicAdd(&lh[i2], 1u);
            asm volatile("s_waitcnt lgkmcnt(0)" ::: "memory");
            if (F.lane < 32) { const unsigned c = lh[F.lane]; lh[32 + F.lane] = c ? atomicAdd(&F.cnt()[l * 32 + F.lane], c) : 0u; }
            asm volatile("s_waitcnt vmcnt(0) lgkmcnt(0)" ::: "memory");
            const unsigned p1 = lh[32 + i1] + r1, p2 = lh[32 + i2] + r2;
            F.tokE()[row * 2] = i1; F.tokI()[row * 2] = (int)p1; F.tokW()[row * 2] = gwt * w1;
            F.tokE()[row * 2 + 1] = i2; F.tokI()[row * 2 + 1] = (int)p2; F.tokW()[row * 2 + 1] = gwt * w2v;
        }
        __syncthreads();
    }
}

__device__ __forceinline__ void phase_gather(Frame& F, int l) {
    int* off = (int*)F.smf; moe_offsets(F, l, off);
    const int nrows = (l == 0) ? NROW : NTOK;
    for (int sl = F.bid * NTHR + F.tid; sl < 2 * nrows; sl += F.nb * NTHR) { const int dst = off[F.tokE()[sl]] + F.tokI()[sl]; F.rmap()[dst] = sl; F.roww()[dst] = F.tokW()[sl]; }
    const int gw = F.bid * 8 + F.wave, ngw = F.nb * 8;
    for (int e = gw; e < 32; e += ngw) { const int c = (int)F.cnt()[l * 32 + e], pc = (c + 255) & ~255;
        for (int j = c + F.lane; j < pc; j += 64) { F.rmap()[off[e] + j] = -1; F.roww()[off[e] + j] = 0.f; } }
}
__device__ __forceinline__ int expert_of_row(const int* off, int row) { int e = 0;
#pragma unroll 1
    for (int i = 1; i < 32; ++i) if (row >= off[i]) e = i;
    return e; }

__device__ __forceinline__ void phase_ln2(Frame& F, int l) {
    const int gw = F.bid * 8 + F.wave, ngw = F.nb * 8, npairs = ((l == 0) ? NROW : NTOK) / 2;
    const float* lg = F.p.ln_g + (size_t)(l * 2 + 1) * DM; const float* lbb = F.p.ln_b + (size_t)(l * 2 + 1) * DM;
    const bf16_t* Y = F.BR();
    const bool tmo_set = (l == DEPTH - 1) && (__hip_atomic_load((unsigned*)(F.ws + WS_CTL) + XB_TMO, __ATOMIC_RELAXED, __HIP_MEMORY_SCOPE_AGENT) != 0u);
    for (int pi = gw; pi < npairs; pi += ngw) {
        const int row0 = pi * 2, rb = row_batch(row0);
        const float* xm = row0 < NTOK ? F.p.out + (size_t)row0 * DM : F.cxm() + (size_t)(row0 - NTOK) * DM;
        float* xo = row0 < NTOK ? F.p.out + (size_t)row0 * DM : F.cxo() + (size_t)(row0 - NTOK) * DM;
        const float* mv = F.modv() + ((size_t)l * 5 + rb) * 6144;
        u32x2 y0[2][4], y1[2][4]; f32x4 xv[2][4], m5[4];
#pragma unroll
        for (int j = 0; j < 4; ++j) { const int d = j * 256 + F.lane * 4; m5[j] = *(const f32x4*)(mv + 5 * 1024 + d);
#pragma unroll
            for (int q = 0; q < 2; ++q) { y0[q][j] = *(const u32x2*)(Y + (size_t)((row0 + q) * 2) * DM + d); y1[q][j] = *(const u32x2*)(Y + (size_t)((row0 + q) * 2 + 1) * DM + d); xv[q][j] = *(const f32x4*)(xm + (size_t)q * DM + d); } }
        f32x4 v[2][4]; float s[2] = {0.f, 0.f};
#pragma unroll
        for (int q = 0; q < 2; ++q)
#pragma unroll
            for (int j = 0; j < 4; ++j) { f32x4 y; y.x = __uint_as_float(y0[q][j].x << 16) + __uint_as_float(y1[q][j].x << 16); y.y = __uint_as_float(y0[q][j].x & 0xffff0000u) + __uint_as_float(y1[q][j].x & 0xffff0000u);
                y.z = __uint_as_float(y0[q][j].y << 16) + __uint_as_float(y1[q][j].y << 16); y.w = __uint_as_float(y0[q][j].y & 0xffff0000u) + __uint_as_float(y1[q][j].y & 0xffff0000u);
                v[q][j] = ALPHA * xv[q][j] + m5[j] * y; s[q] += (v[q][j].x + v[q][j].y) + (v[q][j].z + v[q][j].w); }
#pragma unroll
        for (int o = 1; o < 64; o <<= 1) { s[0] += __shfl_xor(s[0], o); s[1] += __shfl_xor(s[1], o); }
        float s2[2] = {0.f, 0.f};
#pragma unroll
        for (int q = 0; q < 2; ++q) { const float mean = s[q] * (1.f / DM);
#pragma unroll
            for (int j = 0; j < 4; ++j) { v[q][j] = v[q][j] - mean; s2[q] += (v[q][j].x * v[q][j].x + v[q][j].y * v[q][j].y) + (v[q][j].z * v[q][j].z + v[q][j].w * v[q][j].w); } }
#pragma unroll
        for (int o = 1; o < 64; o <<= 1) { s2[0] += __shfl_xor(s2[0], o); s2[1] += __shfl_xor(s2[1], o); }
        const float* mn = F.modv() + ((size_t)((l + 1 < DEPTH) ? l + 1 : l) * 5 + rb) * 6144;
#pragma unroll
        for (int j = 0; j < 4; ++j) { const int d = j * 256 + F.lane * 4;
            const f32x4 g4 = *(const f32x4*)(lg + d), b4 = *(const f32x4*)(lbb + d), m0 = *(const f32x4*)(mn + d), m1 = *(const f32x4*)(mn + 1024 + d);
#pragma unroll
            for (int q = 0; q < 2; ++q) { const float rstd = rsqrtf(s2[q] * (1.f / DM) + LN_EPS);
                f32x4 xn = v[q][j] * rstd * g4 + b4;
                if (tmo_set) xn = xn * __uint_as_float(0x7fc00000u);
                *(f32x4*)(xo + (size_t)q * DM + d) = xn;
                if (l + 1 < DEPTH) { const f32x4 h = xn * (1.f + m1) + m0; u32x2 o2; o2.x = pk2(h.x, h.y); o2.y = pk2(h.z, h.w); *(u32x2*)(F.HX() + (size_t)(row0 + q) * DM + d) = o2; } }
        }
    }
}

constexpr int CONV_LN1_LO = CONVA_IN;
constexpr int NPL = 13, NPH = 1 + DEPTH * NPL;
__global__ void __launch_bounds__(NTHR, 2) mega(Params p) {
    extern __shared__ __attribute__((aligned(16))) unsigned char smem[];
    Frame F; F.p = p; F.bid = blockIdx.x; F.nb = gridDim.x; F.tid = threadIdx.x; F.lane = threadIdx.x & 63; F.wave = threadIdx.x >> 6; F.wid_s = __builtin_amdgcn_readfirstlane(threadIdx.x >> 6);
    F.smf = (float*)(smem + LDS_STAGE);
    LAS unsigned char* stage = (LAS unsigned char*)smem + LDS_STAGE; int* offt = (int*)(smem + 64);
    unsigned char* ws = p.ws; F.ws = ws;

    if (threadIdx.x == 0) *(uint4*)smem = make_uint4(0u, 0u, 0u, 0u);
    __syncthreads();
    unsigned* barw = (unsigned*)(ws + WS_CTL);
    XcdBarrier bar; bar.bar = barw; bar.x = 0; bar.st = (volatile LAS unsigned*)smem;
    const bool multi = (p.ph_hi - p.ph_lo) > 1;
    if (multi) bar = xcd_barrier_post(barw, (volatile LAS unsigned*)smem);
    const int lo = p.ph_lo, hi = p.ph_hi;
#define IN(k) (lo <= (k) && (k) < hi)
#define SEAM(k) do { if (IN(k) && IN((k) + 1)) xcd_barrier(bar); else __syncthreads(); } while (0)

    if (IN(0)) { REFRESH(F); phase_mod(F); __syncthreads(); phase_conv_a(F, 0, F.bid * 8 + F.wave, F.nb * 8); }
    SEAM(0);
#pragma unroll 1
    for (int l = 0; l < DEPTH; ++l) {
        const int pb = 1 + l * NPL;
        const float* xlat = (l == 0) ? p.x : p.out; const float* xctx = (l == 0) ? p.ctx : F.cxo();
        const int Mrows = (l == 0) ? NROW : NTOK;
        if (l == 0) {
            if (IN(pb + 0)) { REFRESH(F); phase_prep(F, 0, p.x, p.ctx); }
            SEAM(pb + 0);
        }
        if (IN(pb + 1)) { REFRESH(F);
            float* rtab = (float*)(smem + LDS_ROPE);
            for (int e = F.tid; e < 1024; e += NTHR) { const int pp = e >> 4, i = e & 15; const float inv = powf(10000.f, -(float)i / 16.f), ang = (float)pp * inv; rtab[2 * e] = cosf(ang); rtab[2 * e + 1] = sinf(ang); }
            __syncthreads();
            pg::SchedG1 S{(const char*)F.HX(), (const char*)F.W1t(), (const char*)F.Wvt(), F.nb, F.bid}; pg::EpiG1 E{F.P1(), F.VT(), rtab, F.lb(), l};
            pg::gemm_phase(stage, DM, DM, DM, S, E);
        }
        SEAM(pb + 1);
        if (IN(pb + 2)) { REFRESH(F); phase_prescan(F, l); }
        SEAM(pb + 2);
        if (IN(pb + 3)) { REFRESH(F); phase_mix(F, l); }
        SEAM(pb + 3);
        if (IN(pb + 4)) { REFRESH(F); phase_prepad(F, l); }
        SEAM(pb + 4);
        if (IN(pb + 5)) { REFRESH(F);
            pg::SchedStatic S{(const char*)F.HX(), (const char*)F.Wgt(), (size_t)256 * DM * 2, (size_t)256 * DM * 2, Mrows / 256, NGATE / 256, F.nb, F.bid}; pg::EpiGate E{F.G()};
            pg::gemm_phase(stage, DM, DM, DM, S, E);
            __syncthreads();
            { const int nun = (Mrows / 256) * (NGATE / 256), ne = nun % F.nb, nw = (Mrows / 256) * (DM / 256);
              const bool later = nw > F.nb && 4 * (nw - F.nb) <= F.nb;
              phase_conv_b(F, l, (nun > F.nb && 2 * ne <= F.nb) ? ne : 0, later ? CONVB_MOE : 0, CONVB_MOE + CONVB_PROJ); }
        }
        SEAM(pb + 5);
        if (IN(pb + 6)) { REFRESH(F);
            pg::SchedMerge S{(const char*)F.BR(), (const char*)F.Wbrt(), (Mrows / 256) * 4, F.nb, F.bid}; pg::EpiMerge E{F.G(), F.HX(), (bf16_t*)(F.ws + WS_PM)};
            pg::gemm_phase(stage, 2048, 512, 512, S, E);
            if (S.split()) { REFRESH(F); phase_conv_b(F, l, (S.ntile - F.nb) * 4, 0, CONVB_MOE / 2); }
            if (S.split()) {
                xcd_barrier(bar);
                REFRESH(F);
                const bf16_t* pm = (const bf16_t*)(F.ws + WS_PM); bf16_t* mo = F.HX() + (size_t)NTOK * DM;
                for (int e = (F.bid * NTHR + F.tid) * 8; e < NCTX * DM; e += F.nb * NTHR * 8) {
                    u32x4 v[4];
#pragma unroll
                    for (int br = 0; br < 4; ++br) v[br] = *(const u32x4*)(pm + (size_t)br * NCTX * DM + e);
                    float a[8] = {0.f, 0.f, 0.f, 0.f, 0.f, 0.f, 0.f, 0.f};
#pragma unroll
                    for (int br = 0; br < 4; ++br) { const unsigned uu[4] = {v[br].x, v[br].y, v[br].z, v[br].w};
#pragma unroll
                        for (int j = 0; j < 4; ++j) { a[2 * j] += __uint_as_float(uu[j] << 16); a[2 * j + 1] += __uint_as_float(uu[j] & 0xffff0000u); } }
                    u32x4 o; o.x = pk2(a[0], a[1]); o.y = pk2(a[2], a[3]); o.z = pk2(a[4], a[5]); o.w = pk2(a[6], a[7]); *(u32x4*)(mo + e) = o;
                }
            }
        }
        SEAM(pb + 6);
        if (IN(pb + 7)) { REFRESH(F);
            pg::SchedStatic S{(const char*)F.HX(), (const char*)F.Woutt(), (size_t)256 * DM * 2, (size_t)256 * DM * 2, Mrows / 256, DM / 256, F.nb, F.bid};
            pg::EpiWout E{xlat, xctx, p.out, F.cxm(), F.modv() + (size_t)l * 5 * 6144};
            pg::gemm_phase(stage, DM, DM, DM, S, E);
            { const int nw = (Mrows / 256) * (DM / 256); if (nw > F.nb && 4 * (nw - F.nb) <= F.nb) { REFRESH(F); phase_conv_b(F, l, nw - F.nb, CONVB_MOE / 2, CONVB_MOE); } }
        }
        SEAM(pb + 7);
        const int nln = Mrows / 64, nln2 = nln > F.nb ? nln - F.nb : 0;
        const bool conv_in_ln1 = (l + 1 < DEPTH) && nln2 > 0 && 4 * nln2 <= F.nb;
        if (IN(pb + 8)) { REFRESH(F); phase_ln1(F, l);
            if (conv_in_ln1 && F.bid >= nln2) { __syncthreads(); REFRESH(F); phase_conv_a(F, l + 1, (F.bid - nln2) * 8 + F.wave, (F.nb - nln2) * 8, CONV_LN1_LO, CONVA_ITEMS); } }
        SEAM(pb + 8);
        if (IN(pb + 9)) { REFRESH(F); phase_gather(F, l); }
        SEAM(pb + 9);
        if (IN(pb + 10)) { REFRESH(F);
            moe_offsets(F, l, offt);
            pg::SchedMoeG S{(const char*)F.HX2(), (const char*)F.Wgu(), offt, F.rmap(), (size_t)512 * DM * 2, (size_t)256 * DM * 2, offt[32] / 256, 2, F.nb, F.bid};
            pg::EpiMoe1 E{F.HID(), F.roww()};
            pg::gemm_phase(stage, DM, DM, DM, S, E);
            if (l + 1 < DEPTH) {
                const int nun = (offt[32] / 256) * 2, nu2 = nun > F.nb ? min(nun - F.nb, F.nb) : 0;
                REFRESH(F);
                const int hi_a = conv_in_ln1 ? CONV_LN1_LO : CONVA_ITEMS;
                if (2 * nu2 <= F.nb) { if (F.bid >= nu2) phase_conv_a(F, l + 1, (F.bid - nu2) * 8 + F.wave, (F.nb - nu2) * 8, 0, hi_a); }
                else phase_conv_a(F, l + 1, F.bid * 8 + F.wave, F.nb * 8, 0, hi_a);
            }
        }
        SEAM(pb + 10);
        if (IN(pb + 11)) { REFRESH(F);
            moe_offsets(F, l, offt);
            pg::SchedMoe S{(const char*)F.HID(), (const char*)F.Wd(), offt, (size_t)256 * 256 * 2, (size_t)DM * 256 * 2, (size_t)256 * 256 * 2, offt[32] / 256, 4, F.nb, F.bid};
            pg::EpiMoe2 E{F.BR(), F.rmap(), (bf16_t*)(F.ws + WS_DUMP)};
            pg::gemm_phase(stage, 256, 256, 256, S, E);
        }
        SEAM(pb + 11);
        if (IN(pb + 12)) { REFRESH(F); phase_ln2(F, l); }
        SEAM(pb + 12);
    }
#undef IN
#undef SEAM
}

extern "C" void kernel_launch(void* const* d_in, const int* in_sizes, int n_in, void* d_out, int out_size, void* d_ws, size_t ws_size, hipStream_t stream) {
    static int grid = 0;
    if (grid == 0) {
        if (n_in != 23 || out_size != NTOK * DM || ws_size < WS_END) { fprintf(stderr, "kernel_launch: unexpected shapes (n_in %d out %d ws %zu need %zu)\n", n_in, out_size, ws_size, (size_t)WS_END); grid = -1; return; }
        int dev = 0, cus = 0;
        if (hipGetDevice(&dev) != hipSuccess || hipDeviceGetAttribute(&cus, hipDeviceAttributeMultiprocessorCount, dev) != hipSuccess) { grid = -1; return; }
        if (hipFuncSetAttribute((const void*)mega, hipFuncAttributeMaxDynamicSharedMemorySize, LDS_BYTES) != hipSuccess) { fprintf(stderr, "kernel_launch: hipFuncSetAttribute failed\n"); grid = -1; return; }
        int per_cu = 0;
        if (hipOccupancyMaxActiveBlocksPerMultiprocessor(&per_cu, (const void*)mega, NTHR, LDS_BYTES) != hipSuccess || per_cu < 1) fprintf(stderr, "kernel_launch: occupancy query reports %d blocks per CU\n", per_cu);
        (void)hipGetLastError();
        grid = cus >= 32 ? (cus & ~31) : cus;
    }
    if (grid < 0) return;
    (void)hipMemsetAsync((char*)d_ws + WS_CTL, 0, CTL_BYTES, stream);
    Params p; memset(&p, 0, sizeof(p));
    const float** pp = (const float**)&p;
    for (int i = 0; i < 23; ++i) pp[i] = (const float*)d_in[i];
    p.out = (float*)d_out; p.ws = (unsigned char*)d_ws;
    p.ph_lo = 0; p.ph_hi = NPH;
    hipLaunchKernelGGL(mega, dim3(grid), dim3(NTHR), LDS_BYTES, stream, p);
}
```

```cpp
#include <hip/hip_runtime.h>
#include <cstdio>
#include <cstdint>
#include <cstring>

typedef unsigned short bf16_t;
typedef float f32x4 __attribute__((ext_vector_type(4)));
typedef unsigned u32x4 __attribute__((ext_vector_type(4)));
typedef unsigned u32x2 __attribute__((ext_vector_type(2)));

constexpr int NB = 4, SEQ = 4096, LC = 256, DM = 1024, DEPTH = 2;
constexpr int NTOK = NB * SEQ, NCTX = NB * LC, NROW = NTOK + NCTX;
constexpr int DIN = 10528;
constexpr int O_AQ = 0, O_AK = 256, O_AV = 512, O_AG = 1024, O_ALR = 1536, O_BQ = 1568, O_BK = 2080, O_BV = 2592, O_CQ = 3104, O_CK = 3616,
              O_CV = 3744, O_DQ = 3872, O_DF = 4384, O_DI = 5408, O_DG = 5920, O_GATE = 6432;
constexpr int PC_AQ = 0, PC_AK = 256, PC_AV = 512, PC_BQ = 1024, PC_BK = 1536, PC_CQ = 2048, PC_CK = 2560, PC_ALR = 2688, PC_DQ = 2816,
              PC_DF = 3328, PC_DI = 4352, PC_AG = 4864, PC_DG = 5376, NP1 = 5888;
constexpr float QSCALE = 0.125f * 1.44269504089f;
constexpr int NVT = 768;
constexpr int NGATE = 4096;
constexpr int XS_ROWS = 43008;
constexpr float LN_EPS = 1e-5f;
constexpr float ALPHA = 1.41421356237f;

constexpr size_t al256(size_t x) { return (x + 255) & ~(size_t)255; }
constexpr size_t WS_CTL = 0;
constexpr size_t CTL_BYTES = 32768;
constexpr size_t CTL_CNT = 28672;
constexpr size_t WS_DUMP = WS_CTL + CTL_BYTES;
constexpr size_t WS_MODV = WS_DUMP + 4096;
constexpr size_t WS_LB = WS_MODV + al256((size_t)DEPTH * 5 * 6144 * 4);
constexpr size_t WS_TOKE = WS_LB + 4096;
constexpr size_t WS_TOKI = WS_TOKE + al256((size_t)2 * NROW * 4);
constexpr size_t WS_TOKW = WS_TOKI + al256((size_t)2 * NROW * 4);
constexpr size_t WS_RMAP = WS_TOKW + al256((size_t)2 * NROW * 4);
constexpr size_t WS_ROWW = WS_RMAP + al256((size_t)XS_ROWS * 4);
constexpr size_t WS_CXM = WS_ROWW + al256((size_t)XS_ROWS * 4);
constexpr size_t WS_CXO = WS_CXM + (size_t)NCTX * DM * 4;
constexpr size_t WS_WTA = WS_CXO + (size_t)NCTX * DM * 4;
constexpr size_t WTA_W1 = 0;
constexpr size_t WTA_WV = WTA_W1 + (size_t)NP1 * DM * 2;
constexpr size_t WTA_WBR = WTA_WV + (size_t)NVT * DM * 2;
constexpr size_t WTA_WO = WTA_WBR + (size_t)4 * DM * 512 * 2;
constexpr size_t WTA_WG = WTA_WO + (size_t)DM * DM * 2;
constexpr size_t WTA_BYTES = WTA_WG + (size_t)NGATE * DM * 2;
constexpr size_t WS_SC1 = WS_WTA;
static_assert((size_t)NROW * 512 * 2 <= WTA_WG, "scan scratch must fit in front of the gate weights");
constexpr size_t WS_HX = WS_WTA + WTA_BYTES;
constexpr size_t WS_VT = WS_HX + (size_t)NROW * DM * 2;
constexpr size_t WS_OBA = WS_VT + (size_t)NVT * NROW * 2;
constexpr size_t WS_HX2 = WS_VT;
constexpr size_t WS_ODH = WS_OBA + (size_t)NROW * 512 * 2;
constexpr size_t WS_BR = WS_ODH + (size_t)NROW * 1024 * 2;
constexpr size_t WS_P1 = WS_BR + (size_t)NROW * 2048 * 2;
constexpr size_t WS_HID = WS_P1;
constexpr size_t WS_G = WS_P1;
constexpr size_t WS_WGU = WS_P1 + (size_t)NROW * NGATE * 2;
constexpr size_t WS_WD = WS_WGU + (size_t)32 * 512 * DM * 2;
constexpr size_t WS_PM = WS_WD + (size_t)32 * DM * 256 * 2;
constexpr size_t WS_XS = WS_P1;
constexpr size_t WS_ESC = WS_P1 + (size_t)NROW * NP1 * 2;
constexpr size_t WS_END = WS_ESC + (size_t)32 * 68 * 384 * 4;
static_assert(WS_PM + (size_t)4 * NCTX * DM * 2 <= WS_ESC, "moe weights must fit in the P1 tail");
static_assert((size_t)XS_ROWS * DM * 2 <= (size_t)NROW * NGATE * 2, "XS must fit in the G region");
static_assert((size_t)NVT * NROW * 2 + (size_t)NROW * 512 * 2 >= (size_t)NROW * DM * 2, "HX2 alias");
static_assert(WS_END <= 434800000ull, "workspace budget");

constexpr int NTHR = 512;
constexpr int LDS_STAGE = 1024;
constexpr int LDS_ROPE = 1024 + 131072 + 1024;
constexpr int LDS_BYTES = 144 * 1024;

struct Params {
    const float *x, *c, *ctx, *c_ctx, *w_mod, *b_mod, *w_in, *gla_lr_w, *gla_lr_b, *hg_gamma, *na_rpb, *wa_sink, *w_branch, *w_out, *ln_g, *ln_b,
        *moe_w_group, *moe_b_group, *moe_w_expert, *moe_b_expert, *moe_w_gate, *moe_w_up, *moe_w_down;
    float* out;
    unsigned char* ws;
    int ph_lo, ph_hi;
};

__device__ __forceinline__ float bf2f(bf16_t b) { return __uint_as_float(((unsigned)b) << 16); }
__device__ __forceinline__ bf16_t f2bf(float f) { unsigned u = __float_as_uint(f); u += 0x7FFFu + ((u >> 16) & 1u); return (bf16_t)(u >> 16); }
typedef float f32x2_t __attribute__((ext_vector_type(2)));
typedef __bf16 bf16x2_t __attribute__((ext_vector_type(2)));
__device__ __forceinline__ unsigned pk2(float lo, float hi) {
    const f32x2_t v = {lo, hi}; const bf16x2_t b = __builtin_convertvector(v, bf16x2_t); return __builtin_bit_cast(unsigned, b); }
__device__ __forceinline__ void ld8(const bf16_t* p, float* f) {
    const u32x4 v = *(const u32x4*)p;
    f[0] = __uint_as_float(v.x << 16); f[1] = __uint_as_float(v.x & 0xffff0000u);
    f[2] = __uint_as_float(v.y << 16); f[3] = __uint_as_float(v.y & 0xffff0000u);
    f[4] = __uint_as_float(v.z << 16); f[5] = __uint_as_float(v.z & 0xffff0000u);
    f[6] = __uint_as_float(v.w << 16); f[7] = __uint_as_float(v.w & 0xffff0000u);
}
__device__ __forceinline__ void st8(bf16_t* p, const float* f) {
    u32x4 v; v.x = pk2(f[0], f[1]); v.y = pk2(f[2], f[3]); v.z = pk2(f[4], f[5]); v.w = pk2(f[6], f[7]);
    *(u32x4*)p = v;
}
__device__ __forceinline__ float sigmoidf_(float x) { return __builtin_amdgcn_rcpf(1.f + __expf(-x)); }
__device__ __forceinline__ float siluf_(float x) { return x * __builtin_amdgcn_rcpf(1.f + __expf(-x)); }
__device__ __forceinline__ float wave_sum(float v) {
#pragma unroll
    for (int o = 1; o < 64; o <<= 1) v += __shfl_xor(v, o);
    return v;
}
__device__ __forceinline__ int row_batch(int row) { return row < NTOK ? (row >> 12) : 4; }

#define XB_TMO      128
#define XB_XCNT(j)  (256  + 64 * (j))
#define XB_XSUB(j)  (1280 + 64 * (j))
#define XB_XGEN(j)  (2304 + 64 * (j))
#define XB_TOP      3328
#define XB_TOPGEN   3392
#define XCD_BAR_WORDS 3456
#define XB_SPIN_CAP (1u << 18)
#define LAS __attribute__((address_space(3)))
__device__ __forceinline__ unsigned xb_ld(unsigned* p)              { return __hip_atomic_load(p, __ATOMIC_RELAXED, __HIP_MEMORY_SCOPE_AGENT); }
__device__ __forceinline__ unsigned xb_add(unsigned* p, unsigned v) { return __hip_atomic_fetch_add(p, v, __ATOMIC_RELAXED, __HIP_MEMORY_SCOPE_AGENT); }
__device__ __forceinline__ unsigned xb_xcc_id() { return (unsigned)__builtin_amdgcn_s_getreg((3 << 11) | 20) & 0xFu; }
#define XB_SPIN(cond, bar) do { unsigned _sp = 0; while (cond) { __builtin_amdgcn_s_sleep(1); \
    if ((++_sp & 255u) == 0u) { if (xb_ld(&(bar)[XB_TMO])) break; if (_sp > XB_SPIN_CAP) { atomicAdd(&(bar)[XB_TMO], 1u); break; } } } } while (0)
struct XcdBarrier { unsigned* bar; unsigned x; volatile LAS unsigned* st; };
__device__ __forceinline__ XcdBarrier xcd_barrier_post(unsigned* bar, volatile LAS unsigned* st) {
    XcdBarrier b; b.bar = bar; b.x = xb_xcc_id(); b.st = st;
    if (threadIdx.x == 0) (void)xb_add(&bar[XB_XCNT(b.x)], 1u);
    return b;
}
__device__ __forceinline__ void xcd_barrier_complete(unsigned* bar, unsigned x, unsigned& nloc, unsigned& nx) {
    const unsigned G = gridDim.x * gridDim.y * gridDim.z;
    unsigned sum, cnt, mine, sp = 0u;
    for (;;) {
        sum = 0u; cnt = 0u; mine = 0u;
#pragma unroll
        for (unsigned j = 0; j < 16; ++j) { const unsigned c = xb_ld(&bar[XB_XCNT(j)]); sum += c; cnt += (c > 0u) ? 1u : 0u; mine = (j == x) ? c : mine; }
        if (sum == G) break;
        __builtin_amdgcn_s_sleep(1);
        if ((++sp & 255u) == 0u) { if (xb_ld(&bar[XB_TMO])) break; if (sp > XB_SPIN_CAP) { atomicAdd(&bar[XB_TMO], 1u); break; } }
    }
    nloc = mine > 0u ? mine : 1u; nx = cnt > 0u ? cnt : 1u;
}
__device__ __forceinline__ void xcd_barrier(const XcdBarrier& b) {
    asm volatile("s_waitcnt vmcnt(0)" ::: "memory");
    __syncthreads();
    if (threadIdx.x == 0) {
        unsigned* bar = b.bar;
        __builtin_amdgcn_s_waitcnt(0);
        unsigned nloc = b.st[0], nx = b.st[1];
        if (nloc == 0u) { xcd_barrier_complete(bar, b.x, nloc, nx); b.st[0] = nloc; b.st[1] = nx; }
        const unsigned old = xb_add(&bar[XB_XSUB(b.x)], 1u);
        const unsigned gen = old / nloc;
        if (old + 1u == (gen + 1u) * nloc) {
            __builtin_amdgcn_fence(__ATOMIC_RELEASE, "agent");
            asm volatile("s_waitcnt vmcnt(0)" ::: "memory");
            const unsigned og = xb_add(&bar[XB_TOP], 1u);
            const unsigned tg = og / nx;
            if (og + 1u == (tg + 1u) * nx) xb_add(&bar[XB_TOPGEN], 1u);
            else XB_SPIN(xb_ld(&bar[XB_TOPGEN]) == tg, bar);
            __builtin_amdgcn_fence(__ATOMIC_ACQUIRE, "agent");
            xb_add(&bar[XB_XGEN(b.x)], 1u);
            asm volatile("s_waitcnt vmcnt(0)" ::: "memory");
        } else {
            XB_SPIN(xb_ld(&bar[XB_XGEN(b.x)]) == gen, bar);
            __builtin_amdgcn_fence(__ATOMIC_ACQUIRE, "agent");
            asm volatile("s_waitcnt vmcnt(0)" ::: "memory");
        }
    }
    __syncthreads();
}

struct Frame {
    Params p;
    int bid, nb, tid, lane, wave, wid_s;
    float* smf;
    unsigned char* ws;
    __device__ __forceinline__ float* modv() const { return (float*)(ws + WS_MODV); }
    __device__ __forceinline__ float* lb() const { return (float*)(ws + WS_LB); }
    __device__ __forceinline__ int* tokE() const { return (int*)(ws + WS_TOKE); }
    __device__ __forceinline__ int* tokI() const { return (int*)(ws + WS_TOKI); }
    __device__ __forceinline__ float* tokW() const { return (float*)(ws + WS_TOKW); }
    __device__ __forceinline__ int* rmap() const { return (int*)(ws + WS_RMAP); }
    __device__ __forceinline__ float* roww() const { return (float*)(ws + WS_ROWW); }
    __device__ __forceinline__ float* cxm() const { return (float*)(ws + WS_CXM); }
    __device__ __forceinline__ float* cxo() const { return (float*)(ws + WS_CXO); }
    __device__ __forceinline__ bf16_t* W1t() const { return (bf16_t*)(ws + WS_WTA + WTA_W1); }
    __device__ __forceinline__ bf16_t* Wvt() const { return (bf16_t*)(ws + WS_WTA + WTA_WV); }
    __device__ __forceinline__ bf16_t* Wgt() const { return (bf16_t*)(ws + WS_WTA + WTA_WG); }
    __device__ __forceinline__ bf16_t* Wbrt() const { return (bf16_t*)(ws + WS_WTA + WTA_WBR); }
    __device__ __forceinline__ bf16_t* Woutt() const { return (bf16_t*)(ws + WS_WTA + WTA_WO); }
    __device__ __forceinline__ bf16_t* SC1() const { return (bf16_t*)(ws + WS_SC1); }
    __device__ __forceinline__ float* ESC() const { return (float*)(ws + WS_ESC); }
    __device__ __forceinline__ bf16_t* HX() const { return (bf16_t*)(ws + WS_HX); }
    __device__ __forceinline__ bf16_t* VT() const { return (bf16_t*)(ws + WS_VT); }
    __device__ __forceinline__ bf16_t* OBA() const { return (bf16_t*)(ws + WS_OBA); }
    __device__ __forceinline__ bf16_t* HX2() const { return (bf16_t*)(ws + WS_HX2); }
    __device__ __forceinline__ bf16_t* HID() const { return (bf16_t*)(ws + WS_HID); }
    __device__ __forceinline__ bf16_t* ODH() const { return (bf16_t*)(ws + WS_ODH); }
    __device__ __forceinline__ bf16_t* BR() const { return (bf16_t*)(ws + WS_BR); }
    __device__ __forceinline__ bf16_t* P1() const { return (bf16_t*)(ws + WS_P1); }
    __device__ __forceinline__ bf16_t* G() const { return (bf16_t*)(ws + WS_G); }
    __device__ __forceinline__ bf16_t* Wgu() const { return (bf16_t*)(ws + WS_WGU); }
    __device__ __forceinline__ bf16_t* Wd() const { return (bf16_t*)(ws + WS_WD); }
    __device__ __forceinline__ bf16_t* XS() const { return (bf16_t*)(ws + WS_XS); }
    __device__ __forceinline__ unsigned* cnt() const { return (unsigned*)(ws + WS_CTL + CTL_CNT); }
};


#define REFRESH(F) do { int _t = threadIdx.x; asm volatile("" : "+v"(_t)); (F).tid = _t; (F).lane = _t & 63; (F).wave = _t >> 6; } while (0)

__device__ __forceinline__ void phase_mod(Frame& F) {
    float* sc = F.smf;
    float* red = F.smf + 5 * 1024;
    bool have = false;
    for (int it = F.bid; it < DEPTH * 96; it += F.nb) {
        if (!have) {
            for (int i = F.tid; i < 5 * 1024; i += NTHR) { const float v = (i < 4096) ? F.p.c[i] : F.p.c_ctx[i - 4096]; sc[i] = siluf_(v); }
            __syncthreads(); have = true;
        }
        const int l = it / 96, n0 = (it % 96) * 64, col = F.tid & 63, kg = F.tid >> 6;
        const float* w = F.p.w_mod + (size_t)l * DM * 6144 + n0 + col;
        float a[5] = {0.f, 0.f, 0.f, 0.f, 0.f};
        for (int k = kg * 128; k < kg * 128 + 128; ++k) {
            const float wv = w[(size_t)k * 6144];
#pragma unroll
            for (int r = 0; r < 5; ++r) a[r] += sc[r * 1024 + k] * wv;
        }
#pragma unroll
        for (int r = 0; r < 5; ++r) red[(kg * 5 + r) * 64 + col] = a[r];
        __syncthreads();
        if (F.tid < 320) {
            const int r = F.tid >> 6, cc = F.tid & 63; float s = F.p.b_mod[l * 6144 + n0 + cc];
#pragma unroll
            for (int g = 0; g < 8; ++g) s += red[(g * 5 + r) * 64 + cc];
            F.modv()[((size_t)l * 5 + r) * 6144 + n0 + cc] = s;
        }
        __syncthreads();
    }
    if (F.bid == F.nb - 1) {
        for (int i = F.tid; i < 1024; i += NTHR) { const int z = i >> 9, f = i & 511;
            const float g0 = F.p.hg_gamma[(z * DEPTH + 0) * 512 + f], g1 = F.p.hg_gamma[(z * DEPTH + 1) * 512 + f];
            F.lb()[i] = 1.f / (1.f + expf(g0 - g1)); }
    }
}

__device__ __forceinline__ int p1_src(int n, float& scale) {
    scale = 1.f;
    if (n < 256) { scale = 0.125f; return O_AQ + n; }
    if (n < 512) return O_AK + (n - 256);
    if (n < 1024) return O_AV + (n - 512);
    if (n < 1536) { scale = QSCALE; return O_BQ + (n - 1024); }
    if (n < 2048) return O_BK + (n - 1536);
    if (n < 2560) { scale = QSCALE; return O_CQ + (n - 2048); }
    if (n < 2688) return O_CK + (n - 2560);
    if (n < 2720) return O_ALR + (n - 2688);
    if (n < 2816) return -1;
    if (n < 3328) return O_DQ + (n - 2816);
    if (n < 4352) return O_DF + (n - 3328);
    if (n < 4864) return O_DI + (n - 4352);
    if (n < 5376) return O_AG + (n - 4864);
    return O_DG + (n - 5376);
}
__device__ __forceinline__ void conv_item(const float* src, int ldsrc, int srccol, float scale, bf16_t* dst, int K, int k0, float* scr, int lane, bool perm) {
    if (srccol >= 0) {
        float tv[32];
        const float* sp0 = src + (size_t)(k0 + (lane >> 5)) * ldsrc + srccol + (lane & 31);
#pragma unroll
        for (int i = 0; i < 32; ++i) tv[i] = sp0[(size_t)(2 * i) * ldsrc];
#pragma unroll
        for (int i = 0; i < 32; ++i) scr[(2 * i + (lane >> 5)) * 33 + (lane & 31)] = tv[i] * scale;
    } else {
#pragma unroll 8
        for (int i = 0; i < 32; ++i) { const int kk = 2 * i + (lane >> 5); scr[kk * 33 + (lane & 31)] = 0.f; }
    }
    asm volatile("s_waitcnt lgkmcnt(0)" ::: "memory");
    const int c = lane & 7;
#pragma unroll
    for (int j = 0; j < 4; ++j) { const int nn = (lane >> 3) + 8 * j; const float* sp = scr + (8 * c) * 33 + (perm ? (8 * ((nn & 15) >> 2) + 4 * (nn >> 4) + (nn & 3)) : nn);
        u32x4 o; o.x = pk2(sp[0 * 33], sp[1 * 33]); o.y = pk2(sp[2 * 33], sp[3 * 33]); o.z = pk2(sp[4 * 33], sp[5 * 33]); o.w = pk2(sp[6 * 33], sp[7 * 33]);
        *(u32x4*)(dst + (size_t)nn * K + 8 * c) = o; }
    asm volatile("s_waitcnt lgkmcnt(0)" ::: "memory");
}
constexpr int CONVA_W1 = (NP1 / 32) * 16;
constexpr int CONVA_ITEMS = CONVA_W1 + 384 + 2048;
constexpr int CONVA_IN = CONVA_W1 + 384;
__device__ __forceinline__ void phase_conv_a(Frame& F, int l, int gw, int ngw, int lo = 0, int hi = CONVA_ITEMS) {
    float* scr = F.smf + F.wave * (64 * 33);
    for (int it0 = lo + gw; it0 < hi; it0 += ngw) {
        int ti = it0;
        if (ti < CONVA_W1) { const int n0 = (ti >> 4) * 32, kt = ti & 15; float sc; const int sx = p1_src(n0, sc);
            conv_item(F.p.w_in + (size_t)l * DM * DIN, DIN, sx, sc, F.W1t() + (size_t)n0 * DM + kt * 64, DM, kt * 64, scr, F.lane, !(n0 >= 2048 && n0 < 2816)); continue; }
        ti -= CONVA_W1;
        if (ti < 384) { const int n0 = (ti >> 4) * 32, kt = ti & 15; const int sx = n0 < 512 ? O_BV + n0 : (n0 < 640 ? O_CV + (n0 - 512) : -1);
            conv_item(F.p.w_in + (size_t)l * DM * DIN, DIN, sx, 1.f, F.Wvt() + (size_t)n0 * DM + kt * 64, DM, kt * 64, scr, F.lane, false); continue; }
        ti -= 384;
        { const int n0 = (ti >> 4) * 32, kt = ti & 15;
          conv_item(F.p.w_in + (size_t)l * DM * DIN, DIN, O_GATE + n0, 1.f, F.Wgt() + (size_t)n0 * DM + kt * 64, DM, kt * 64, scr, F.lane, true); }
    }
}
constexpr int CONVB_MOE = 8192 + 4096, CONVB_PROJ = 1024 + 512;
__device__ __forceinline__ void phase_conv_b(Frame& F, int l, int n_skip, int lo, int hi) {
    float* scr = F.smf + F.wave * (64 * 33);
    if (F.bid < n_skip) return;
    const int gw = (F.bid - n_skip) * 8 + F.wave, ngw = (F.nb - n_skip) * 8;
    for (int it0 = lo + gw; it0 < hi; it0 += ngw) {
        int ti = it0;
        if (ti < 8192) { const int e = ti >> 8, r = ti & 255, n0 = (r >> 4) * 32, kt = r & 15, j = n0 >> 8, rr = n0 & 255; const bool isup = rr >= 128; const int cc = 128 * j + (rr & 127);
            const float* src = (isup ? F.p.moe_w_up : F.p.moe_w_gate) + (size_t)(l * 32 + e) * DM * 256;
            conv_item(src, 256, cc, 1.f, F.Wgu() + (size_t)e * 512 * DM + (size_t)n0 * DM + kt * 64, DM, kt * 64, scr, F.lane, true); continue; }
        ti -= 8192;
        if (ti < 4096) { const int e = ti >> 7, r = ti & 127, n0 = (r >> 2) * 32, kt = r & 3;
          conv_item(F.p.moe_w_down + (size_t)(l * 32 + e) * 256 * DM, DM, n0, 1.f, F.Wd() + (size_t)e * DM * 256 + (size_t)n0 * 256 + kt * 64, 256, kt * 64, scr, F.lane, true); continue; }
        ti -= 4096;
        if (ti < 1024) { const int i = ti >> 8, r = ti & 255, n0 = (r >> 3) * 32, kt = r & 7;
            conv_item(F.p.w_branch + (size_t)(l * 4 + i) * 512 * DM, DM, n0, 1.f, F.Wbrt() + (size_t)i * DM * 512 + (size_t)n0 * 512 + kt * 64, 512, kt * 64, scr, F.lane, true); continue; }
        ti -= 1024;
        { const int n0 = (ti >> 4) * 32, kt = ti & 15;
          conv_item(F.p.w_out + (size_t)l * DM * DM, DM, n0, 1.f, F.Woutt() + (size_t)n0 * DM + kt * 64, DM, kt * 64, scr, F.lane, false); }
    }
}

__device__ __forceinline__ void phase_prep(Frame& F, int l, const float* xlat, const float* xctx) {
    const int gw = F.bid * 8 + F.wave, ngw = F.nb * 8;
    for (int row = gw; row < NROW; row += ngw) {
        const float* xr = row < NTOK ? xlat + (size_t)row * DM : xctx + (size_t)(row - NTOK) * DM;
        const float* mv = F.modv() + ((size_t)l * 5 + row_batch(row)) * 6144;
#pragma unroll
        for (int j = 0; j < 4; ++j) { const int d = j * 256 + F.lane * 4;
            const f32x4 v = *(const f32x4*)(xr + d), m0 = *(const f32x4*)(mv + d), m1 = *(const f32x4*)(mv + 1024 + d);
            u32x2 o; o.x = pk2(v.x * (1.f + m1.x) + m0.x, v.y * (1.f + m1.y) + m0.y); o.y = pk2(v.z * (1.f + m1.z) + m0.z, v.w * (1.f + m1.w) + m0.w);
            *(u32x2*)(F.HX() + (size_t)row * DM + d) = o; }
    }
}


namespace pg {
typedef short bf16x8 __attribute__((ext_vector_type(8)));
constexpr int BM = 256, BK = 64, HALF = 128, HTB = HALF * BK * 2, STAGE_BYTES = 8 * HTB, NXCD = 8, WGM = 8;
__device__ __forceinline__ int lds_byte(int r, int c) { const int st = (r >> 4) * 2 + (c >> 5), rr = r & 15, cc = c & 31, ob = rr * 64 + cc * 2; return st * 1024 + (ob ^ (((ob >> 9) & 1) << 5)); }
__device__ __forceinline__ void stage_rc(int b, int& R, int& C) { const int st = b / 1024, sb = b % 1024, swz = sb ^ (((sb >> 9) & 1) << 5); R = (st >> 1) * 16 + swz / 64; C = (st & 1) * 32 + (swz % 64) / 2; }
struct Unit { const char* a; const char* b; int pm, pn, aux; };
__device__ __forceinline__ void static_map(int L, int nM, int nN, int& pm, int& pn) {
    const int nwg = nM * nN; int wgid = L; { const int q = nwg / NXCD, r = nwg % NXCD, xcd = wgid % NXCD, off = wgid / NXCD; wgid = (xcd < r ? xcd * (q + 1) : r * (q + 1) + (xcd - r) * q) + off; }
    const int nig = WGM * nN, gid = wgid / nig, fm = gid * WGM, gsz = (nM - fm) < WGM ? (nM - fm) : WGM;
    pm = fm + ((wgid % nig) % gsz); pn = (wgid % nig) / gsz;
}
template <class Epi, class Sched>
__device__ __forceinline__ void gemm_phase(LAS unsigned char* lds, const int lda, const int ldb, const int K, const Sched& S, const Epi& E) {
    int tid = threadIdx.x; asm volatile("" : "+v"(tid));
    const int wid = __builtin_amdgcn_readfirstlane(tid >> 6), lane = tid & 63, wr = wid >> 2, wc = wid & 3, fr = lane & 15, fq = lane >> 4;
    int nt = K / BK; asm volatile("" : "+s"(nt));
    constexpr bool GATHER = Sched::gather;
    unsigned voffA[2], voffB[2], vgA[2][2], vgN[2][2]; int RA_[2], CA_[2];
#pragma unroll
    for (int i = 0; i < 2; ++i) { int R, C; stage_rc(tid * 16 + i * 8192, R, C); voffA[i] = (unsigned)(R * lda + C) * 2u; voffB[i] = (unsigned)(R * ldb + C) * 2u; RA_[i] = R; CA_[i] = C;
        vgA[0][i] = vgA[1][i] = vgN[0][i] = vgN[1][i] = 0u; }
#define PG_GSET(vg, u) do { _Pragma("unroll") for (int _h = 0; _h < 2; ++_h) _Pragma("unroll") for (int _i = 0; _i < 2; ++_i) \
        vg[_h][_i] = (unsigned)S.rowidx((u).pm * BM + _h * HALF + RA_[_i]) * (unsigned)(lda * 2) + (unsigned)(CA_[_i] * 2); } while (0)
    const size_t kstep = (size_t)(BK * 2);
    const size_t hstepA = (size_t)HALF * lda * 2, hstepB = (size_t)HALF * ldb * 2;
    const unsigned ldsw = (unsigned)wid * 1024u;
    const int aoff = lds_byte(wr * 64 + fr, fq * 8), boff = lds_byte(wc * 32 + fr, fq * 8);
#define PG_SA(b, h) (((b) * 2 + (h)) * HTB)
#define PG_SB(b, h) ((4 + (b) * 2 + (h)) * HTB)
#define PG_STAGE(bufoff, gbase, voff) do { _Pragma("unroll") for (int _i = 0; _i < 2; ++_i) \
        __builtin_amdgcn_global_load_lds((const unsigned*)((const char*)(gbase) + (voff)[_i]), (LAS unsigned*)(lds + (bufoff) + ldsw + _i * 8192), 16, 0, 0); } while (0)
#define PG_STAGE_A(bufoff, base, h, nx) do { if (GATHER) { const unsigned _v[2] = {(nx) ? vgN[h][0] : vgA[h][0], (nx) ? vgN[h][1] : vgA[h][1]}; PG_STAGE(bufoff, base, _v); } \
        else { PG_STAGE(bufoff, (base) + (h) * hstepA, voffA); } } while (0)
#define PG_LDA(dst, b, h) do { _Pragma("unroll") for (int m = 0; m < 4; ++m) _Pragma("unroll") for (int k = 0; k < 2; ++k) dst[m][k] = *(const LAS bf16x8*)(lds + PG_SA(b, h) + aoff + m * 2048 + k * 1024); } while (0)
#define PG_LDB(dst, b, h) do { _Pragma("unroll") for (int n = 0; n < 2; ++n) _Pragma("unroll") for (int k = 0; k < 2; ++k) dst[n][k] = *(const LAS bf16x8*)(lds + PG_SB(b, h) + boff + n * 2048 + k * 1024); } while (0)
#define PG_MMA(ai, bj, At, Bt) do { __builtin_amdgcn_s_setprio(1); _Pragma("unroll") for (int m = 0; m < 4; ++m) _Pragma("unroll") for (int n = 0; n < 2; ++n) _Pragma("unroll") for (int k = 0; k < 2; ++k) \
        acc[ai][bj][m][n] = __builtin_amdgcn_mfma_f32_16x16x32_bf16(Bt[n][k], At[m][k], acc[ai][bj][m][n], 0, 0, 0); __builtin_amdgcn_s_setprio(0); } while (0)
#define PG_WAIT_V(n) asm volatile("s_waitcnt vmcnt(" #n ")" ::: "memory")
#define PG_WAIT_L(n) asm volatile("s_waitcnt lgkmcnt(" #n ")" ::: "memory")
#define PG_BAR __builtin_amdgcn_s_barrier()
#define PG_SCHED __builtin_amdgcn_sched_barrier(0)
    Unit cur, nxt; int ui = 0;
    if (!S.next(0, cur)) return;
    f32x4 acc[2][2][4][2];
#pragma unroll
    for (int a = 0; a < 2; ++a)
#pragma unroll
        for (int b = 0; b < 2; ++b)
#pragma unroll
            for (int m = 0; m < 4; ++m)
#pragma unroll
                for (int n = 0; n < 2; ++n) acc[a][b][m][n] = (f32x4){0.f, 0.f, 0.f, 0.f};
    bf16x8 At[4][2], B0[2][2], B1[2][2];
    const char* cA = cur.a; const char* cB = cur.b;
    if (GATHER) PG_GSET(vgA, cur);
    PG_STAGE(PG_SB(0, 0), cB, voffB); PG_STAGE_A(PG_SA(0, 0), cA, 0, false); PG_STAGE(PG_SB(0, 1), cB + hstepB, voffB); PG_STAGE_A(PG_SA(0, 1), cA, 1, false);
    if (wr == 1) PG_BAR;
    PG_WAIT_V(4); PG_BAR;
    PG_STAGE(PG_SB(1, 0), cB + kstep, voffB); PG_STAGE_A(PG_SA(1, 0), cA + kstep, 0, false); PG_STAGE(PG_SB(1, 1), cB + hstepB + kstep, voffB);
    PG_WAIT_V(6); PG_BAR;
    for (;;) {
        const bool has_next = S.next(ui + 1, nxt);
        const char* nA = has_next ? nxt.a : cA; const char* nB = has_next ? nxt.b : cB;
        if (GATHER) { if (has_next) PG_GSET(vgN, nxt); else { vgN[0][0] = vgA[0][0]; vgN[0][1] = vgA[0][1]; vgN[1][0] = vgA[1][0]; vgN[1][1] = vgA[1][1]; } }
        for (int t = 0; t < nt; t += 2) {
            const bool last = (t == nt - 2);
            const char* a1 = cA + (size_t)(t + 1) * kstep;
            const char* a2 = last ? nA : cA + (size_t)(t + 2) * kstep; const char* b2 = last ? nB : cB + (size_t)(t + 2) * kstep;
            const char* a3 = a2 + kstep; const char* b3 = b2 + kstep;
            PG_LDB(B0, 0, 0); PG_SCHED; PG_LDA(At, 0, 0); PG_STAGE_A(PG_SA(1, 1), a1, 1, false);
            PG_WAIT_L(8); PG_BAR; PG_WAIT_L(0); PG_MMA(0, 0, At, B0); PG_BAR; PG_SCHED;
            PG_LDB(B1, 0, 1); PG_STAGE(PG_SB(0, 0), b2, voffB);
            PG_BAR; PG_WAIT_L(0); PG_MMA(0, 1, At, B1); PG_BAR;
            PG_LDA(At, 0, 1); PG_STAGE_A(PG_SA(0, 0), a2, 0, last);
            PG_BAR; PG_WAIT_L(0); PG_MMA(1, 0, At, B0); PG_BAR; PG_SCHED;
            PG_STAGE(PG_SB(0, 1), b2 + hstepB, voffB);
            PG_WAIT_V(6); PG_BAR; PG_MMA(1, 1, At, B1); PG_BAR;
            PG_LDB(B0, 1, 0); PG_SCHED; PG_LDA(At, 1, 0); PG_STAGE_A(PG_SA(0, 1), a2, 1, last);
            PG_WAIT_L(8); PG_BAR; PG_WAIT_L(0); PG_MMA(0, 0, At, B0); PG_BAR; PG_SCHED;
            PG_LDB(B1, 1, 1); PG_STAGE(PG_SB(1, 0), b3, voffB);
            PG_BAR; PG_WAIT_L(0); PG_MMA(0, 1, At, B1); PG_BAR;
            PG_LDA(At, 1, 1); PG_STAGE_A(PG_SA(1, 0), a3, 0, last);
            PG_BAR; PG_WAIT_L(0); PG_MMA(1, 0, At, B0); PG_BAR; PG_SCHED;
            PG_STAGE(PG_SB(1, 1), b3 + hstepB, voffB);
            PG_WAIT_V(6); PG_BAR; PG_MMA(1, 1, At, B1); PG_BAR;
        }
        E(acc, cur, wr, wc, fr, fq);
        if (!has_next) break;
#pragma unroll
        for (int a = 0; a < 2; ++a)
#pragma unroll
            for (int b = 0; b < 2; ++b)
#pragma unroll
                for (int m = 0; m < 4; ++m)
#pragma unroll
                    for (int n = 0; n < 2; ++n) acc[a][b][m][n] = (f32x4){0.f, 0.f, 0.f, 0.f};
        cur = nxt; cA = nA; cB = nB; ++ui;
        if (GATHER) { vgA[0][0] = vgN[0][0]; vgA[0][1] = vgN[0][1]; vgA[1][0] = vgN[1][0]; vgA[1][1] = vgN[1][1]; }
    }
    PG_WAIT_V(0);
    if (wr == 0) PG_BAR;
    PG_BAR;
#undef PG_SA
#undef PG_SB
#undef PG_STAGE
#undef PG_STAGE_A
#undef PG_GSET
#undef PG_LDA
#undef PG_LDB
#undef PG_MMA
#undef PG_WAIT_V
#undef PG_WAIT_L
#undef PG_BAR
#undef PG_SCHED
}

struct SchedG1 {
    static constexpr bool gather = false; __device__ __forceinline__ int rowidx(int) const { return 0; }
    const char *HX, *W1, *WV; int G, c;
    __device__ __forceinline__ bool next(int i, Unit& u) const {
        const int L = i * G + c, nmain = (NROW / 256) * (NP1 / 256);
        if (L < nmain) { static_map(L, NROW / 256, NP1 / 256, u.pm, u.pn); u.a = HX + (size_t)u.pm * 256 * DM * 2; u.b = W1 + (size_t)u.pn * 256 * DM * 2; u.aux = 0; return true; }
        const int idx = L - nmain; if (idx >= 3 * (NROW / 256)) return false;
        u.pm = idx % 3; u.pn = idx / 3; u.a = WV + (size_t)u.pm * 256 * DM * 2; u.b = HX + (size_t)u.pn * 256 * DM * 2; u.aux = 1; return true;
    }
};
struct SchedStatic {
    static constexpr bool gather = false; __device__ __forceinline__ int rowidx(int) const { return 0; }
    const char *A, *B; size_t tA, tB; int nM, nN, G, c;
    __device__ __forceinline__ bool next(int i, Unit& u) const {
        const int L = i * G + c; if (L >= nM * nN) return false;
        static_map(L, nM, nN, u.pm, u.pn); u.a = A + (size_t)u.pm * tA; u.b = B + (size_t)u.pn * tB; u.aux = 0; return true;
    }
};
struct SchedMerge {
    static constexpr bool gather = false; __device__ __forceinline__ int rowidx(int) const { return 0; }
    const char *BR, *W; int ntile, G, c;
    __device__ __forceinline__ bool split() const { return ntile > G && (ntile - G) * 4 <= G; }
    __device__ __forceinline__ bool next(int i, Unit& u) const {
        int t, br;
        if (split()) { if (i < 4) { t = c; br = i; u.aux = br; } else { if (i > 4 || c >= (ntile - G) * 4) return false; t = G + (c >> 2); br = c & 3; u.aux = 4 + br; } }
        else { t = c + (i >> 2) * G; if (t >= ntile) return false; br = i & 3; u.aux = br; }
        u.pm = t >> 2; u.pn = t & 3;
        u.a = BR + (size_t)u.pm * 256 * 2048 * 2 + (size_t)br * 512 * 2; u.b = W + (size_t)br * DM * 512 * 2 + (size_t)u.pn * 256 * 512 * 2; return true;
    }
};
struct SchedMoeG {
    static constexpr bool gather = true;
    const char *A, *W; const int* off; const int* rmap; size_t wE, wT; int npan, NJ, G, c;
    __device__ __forceinline__ int rowidx(int slot) const { const int sl = rmap[slot]; return sl < 0 ? 0 : (sl >> 1); }
    __device__ __forceinline__ bool next(int i, Unit& u) const {
        const int L = i * G + c; if (L >= npan * NJ) return false;
        const int p = L / NJ, j = L % NJ; int e = 0;
#pragma unroll 1
        for (int q = 1; q < 32; ++q) if (p * 256 >= off[q]) e = q;
        e = __builtin_amdgcn_readfirstlane(e);
        u.pm = p; u.pn = j; u.aux = e; u.a = A; u.b = W + (size_t)e * wE + (size_t)j * wT; return true;
    }
};
struct SchedMoe {
    static constexpr bool gather = false; __device__ __forceinline__ int rowidx(int) const { return 0; }
    const char *A, *W; const int* off; size_t tA, wE, wT; int npan, NJ, G, c;
    __device__ __forceinline__ bool next(int i, Unit& u) const {
        const int L = i * G + c; if (L >= npan * NJ) return false;
        const int p = L / NJ, j = L % NJ; int e = 0;
#pragma unroll 1
        for (int q = 1; q < 32; ++q) if (p * 256 >= off[q]) e = q;
        e = __builtin_amdgcn_readfirstlane(e);
        u.pm = p; u.pn = j; u.aux = e; u.a = A + (size_t)p * tA; u.b = W + (size_t)e * wE + (size_t)j * wT; return true;
    }
};

#define PG_ROWCOL const int row0 = u.pm * BM + wr * 64 + fr, col0 = u.pn * BM + wc * 32 + 4 * fq
struct EpiG1 { bf16_t *P1, *VT; const float* rtab; const float* lbp; int layer;
    __device__ __forceinline__ void operator()(const f32x4 (&acc)[2][2][4][2], const Unit& u, int wr, int wc, int fr, int fq) const {
        const int row0 = u.pm * BM + wr * 64 + fr;
        if (u.aux || (u.pn >= 8 && u.pn <= 10)) {
            const int col0 = u.pn * BM + wc * 32 + 4 * fq; bf16_t* base = u.aux ? VT : P1; const size_t ld = u.aux ? (size_t)NROW : (size_t)NP1;
            const bool rope = !u.aux && (u.pm < NTOK / 256);
#pragma unroll
            for (int ai = 0; ai < 2; ++ai)
#pragma unroll
                for (int m = 0; m < 4; ++m) { const int r = row0 + ai * HALF + m * 16; bf16_t* rowp = base + (size_t)r * ld + col0;
#pragma unroll
                    for (int bj = 0; bj < 2; ++bj) {
                        f32x4 v0 = acc[ai][bj][m][0], v1 = acc[ai][bj][m][1];
                        if (rope && !(u.pn == 10 && bj == 1)) {
                            const int pos = r & (SEQ - 1), pp = (wc & 1) ? (pos & 63) : (pos >> 6); const float* tp = rtab + (pp * 16 + 4 * fq) * 2;
                            const f32x4 t0 = *(const f32x4*)tp, t1 = *(const f32x4*)(tp + 4);
                            const f32x4 a = v0, b = v1;
                            v0.x = a.x * t0.x - b.x * t0.y; v1.x = a.x * t0.y + b.x * t0.x; v0.y = a.y * t0.z - b.y * t0.w; v1.y = a.y * t0.w + b.y * t0.z;
                            v0.z = a.z * t1.x - b.z * t1.y; v1.z = a.z * t1.y + b.z * t1.x; v0.w = a.w * t1.z - b.w * t1.w; v1.w = a.w * t1.w + b.w * t1.z;
                        }
                        u32x2 o; o.x = pk2(v0.x, v0.y); o.y = pk2(v0.z, v0.w); *(u32x2*)(rowp + bj * HALF) = o;
                        o.x = pk2(v1.x, v1.y); o.y = pk2(v1.z, v1.w); *(u32x2*)(rowp + bj * HALF + 16) = o; } }
            return;
        }
        const int col0 = u.pn * BM + wc * 32 + 8 * fq;
        const int mode = (u.pn == 11 || u.pn == 12) ? 2 : ((u.pn >= 13 && u.pn <= 16) ? 3 : 0);
        if (mode == 3) {
            f32x4 lb4[2][2];
            const int z = (u.pn - 13) >> 1, cb = z * 512 + ((u.pn - 13) & 1) * 256 + wc * 32 + 8 * fq;
#pragma unroll
            for (int bj = 0; bj < 2; ++bj)
#pragma unroll
                for (int n = 0; n < 2; ++n) lb4[bj][n] = (layer == 0) ? (f32x4){0.f, 0.f, 0.f, 0.f} : *(const f32x4*)(lbp + cb + bj * HALF + 4 * n);
#pragma unroll
            for (int ai = 0; ai < 2; ++ai)
#pragma unroll
                for (int m = 0; m < 4; ++m) { bf16_t* rowp = P1 + (size_t)(row0 + ai * HALF + m * 16) * NP1 + col0;
#pragma unroll
                    for (int bj = 0; bj < 2; ++bj) { float gq[8];
#pragma unroll
                        for (int n = 0; n < 2; ++n)
#pragma unroll
                            for (int j = 0; j < 4; ++j) { const float f = acc[ai][bj][m][n][j], lb = lb4[bj][n][j]; const float t = __expf(-fabsf(f)), rr = __builtin_amdgcn_rcpf(1.f + t);
                                gq[4 * n + j] = __logf(fmaxf(lb + (1.f - lb) * ((f >= 0.f) ? rr : t * rr), 1e-37f)); }
                        u32x4 o; o.x = pk2(gq[0], gq[1]); o.y = pk2(gq[2], gq[3]); o.z = pk2(gq[4], gq[5]); o.w = pk2(gq[6], gq[7]); *(u32x4*)(rowp + bj * HALF) = o; } }
            return;
        }
#pragma unroll
        for (int ai = 0; ai < 2; ++ai)
#pragma unroll
            for (int m = 0; m < 4; ++m) { bf16_t* rowp = P1 + (size_t)(row0 + ai * HALF + m * 16) * NP1 + col0;
#pragma unroll
                for (int bj = 0; bj < 2; ++bj) {
                    f32x4 v0 = acc[ai][bj][m][0], v1 = acc[ai][bj][m][1];
                    if (mode == 2) {
#pragma unroll
                        for (int j = 0; j < 4; ++j) { v0[j] = v0[j] * __builtin_amdgcn_rcpf(1.f + __expf(-v0[j])); v1[j] = v1[j] * __builtin_amdgcn_rcpf(1.f + __expf(-v1[j])); }
                    }
                    u32x4 o; o.x = pk2(v0.x, v0.y); o.y = pk2(v0.z, v0.w); o.z = pk2(v1.x, v1.y); o.w = pk2(v1.z, v1.w); *(u32x4*)(rowp + bj * HALF) = o; } }
    }
};
#define PG_ROWCOL8 const int row0 = u.pm * BM + wr * 64 + fr, col0 = u.pn * BM + wc * 32 + 8 * fq
struct EpiGate { bf16_t* G;
    __device__ __forceinline__ void operator()(const f32x4 (&acc)[2][2][4][2], const Unit& u, int wr, int wc, int fr, int fq) const {
        PG_ROWCOL8;
#pragma unroll
        for (int ai = 0; ai < 2; ++ai)
#pragma unroll
            for (int m = 0; m < 4; ++m) { bf16_t* rowp = G + (size_t)(row0 + ai * HALF + m * 16) * NGATE + col0;
#pragma unroll
                for (int bj = 0; bj < 2; ++bj) { const f32x4 v0 = acc[ai][bj][m][0], v1 = acc[ai][bj][m][1]; u32x4 o;
                    o.x = pk2(sigmoidf_(v0.x), sigmoidf_(v0.y)); o.y = pk2(sigmoidf_(v0.z), sigmoidf_(v0.w)); o.z = pk2(sigmoidf_(v1.x), sigmoidf_(v1.y)); o.w = pk2(sigmoidf_(v1.z), sigmoidf_(v1.w));
                    *(u32x4*)(rowp + bj * HALF) = o; } }
    }
};
struct EpiMerge { const bf16_t* G; bf16_t* O; bf16_t* PM;
    __device__ __forceinline__ void operator()(const f32x4 (&acc)[2][2][4][2], const Unit& u, int wr, int wc, int fr, int fq) const {
        PG_ROWCOL8; const int br = u.aux & 3; const bool part = u.aux >= 4, rmw = !part && br != 0;
        bf16_t* const Ob = part ? PM + (size_t)br * NCTX * DM - (size_t)NTOK * DM : O;
#pragma unroll
        for (int ai = 0; ai < 2; ++ai) {
            u32x4 g4[4][2], o4[4][2];
#pragma unroll
            for (int m = 0; m < 4; ++m) { const size_t r = (size_t)(row0 + ai * HALF + m * 16); const bf16_t* gp = G + r * NGATE + br * 1024 + col0; const bf16_t* rowp = Ob + r * DM + col0;
#pragma unroll
                for (int bj = 0; bj < 2; ++bj) { g4[m][bj] = *(const u32x4*)(gp + bj * HALF); if (rmw) o4[m][bj] = *(const u32x4*)(rowp + bj * HALF); } }
#pragma unroll
            for (int m = 0; m < 4; ++m) { bf16_t* rowp = Ob + (size_t)(row0 + ai * HALF + m * 16) * DM + col0;
#pragma unroll
                for (int bj = 0; bj < 2; ++bj) { const f32x4 v0 = acc[ai][bj][m][0], v1 = acc[ai][bj][m][1]; const u32x4 gg = g4[m][bj];
                    float w[8] = {__uint_as_float(gg.x << 16) * v0.x, __uint_as_float(gg.x & 0xffff0000u) * v0.y, __uint_as_float(gg.y << 16) * v0.z, __uint_as_float(gg.y & 0xffff0000u) * v0.w,
                                  __uint_as_float(gg.z << 16) * v1.x, __uint_as_float(gg.z & 0xffff0000u) * v1.y, __uint_as_float(gg.w << 16) * v1.z, __uint_as_float(gg.w & 0xffff0000u) * v1.w};
                    if (rmw) { const u32x4 oo = o4[m][bj];
                        w[0] += __uint_as_float(oo.x << 16); w[1] += __uint_as_float(oo.x & 0xffff0000u); w[2] += __uint_as_float(oo.y << 16); w[3] += __uint_as_float(oo.y & 0xffff0000u);
                        w[4] += __uint_as_float(oo.z << 16); w[5] += __uint_as_float(oo.z & 0xffff0000u); w[6] += __uint_as_float(oo.w << 16); w[7] += __uint_as_float(oo.w & 0xffff0000u); }
                    u32x4 o; o.x = pk2(w[0], w[1]); o.y = pk2(w[2], w[3]); o.z = pk2(w[4], w[5]); o.w = pk2(w[6], w[7]); *(u32x4*)(rowp + bj * HALF) = o; } }
            asm volatile("" ::: "memory");
        }
    }
};
struct EpiWout { const float *xlat, *xctx; float *olat, *octx; const float* modl;
    __device__ __forceinline__ void operator()(const f32x4 (&acc)[2][2][4][2], const Unit& u, int wr, int wc, int fr, int fq) const {
        PG_ROWCOL; const bool lat = u.pm < NTOK / 256; const int rb = lat ? (u.pm >> 4) : 4;
        const float* xin = lat ? xlat : xctx - (size_t)NTOK * DM; float* xo = lat ? olat : octx - (size_t)NTOK * DM; const float* m2 = modl + (size_t)rb * 6144 + 2 * 1024 + col0;
        f32x4 mv[2][2];
#pragma unroll
        for (int bj = 0; bj < 2; ++bj)
#pragma unroll
            for (int n = 0; n < 2; ++n) mv[bj][n] = *(const f32x4*)(m2 + bj * HALF + n * 16);
#pragma unroll
        for (int aq = 0; aq < 4; ++aq) { const int ai = aq >> 1, m0 = (aq & 1) * 2;
            f32x4 xv[4][2][2];
#pragma unroll
            for (int m = m0; m < m0 + 2; ++m) { const size_t o = (size_t)(row0 + ai * HALF + m * 16) * DM + col0;
#pragma unroll
                for (int bj = 0; bj < 2; ++bj)
#pragma unroll
                    for (int n = 0; n < 2; ++n) xv[m][bj][n] = *(const f32x4*)(xin + o + bj * HALF + n * 16); }
#pragma unroll
            for (int m = m0; m < m0 + 2; ++m) { const size_t o = (size_t)(row0 + ai * HALF + m * 16) * DM + col0;
#pragma unroll
                for (int bj = 0; bj < 2; ++bj)
#pragma unroll
                    for (int n = 0; n < 2; ++n) *(f32x4*)(xo + o + bj * HALF + n * 16) = ALPHA * xv[m][bj][n] + mv[bj][n] * acc[ai][bj][m][n]; }
            asm volatile("" ::: "memory");
        }
    }
};
struct EpiMoe1 { bf16_t* HID; const float* roww;
    __device__ __forceinline__ void operator()(const f32x4 (&acc)[2][2][4][2], const Unit& u, int wr, int wc, int fr, int fq) const {
        const int row0 = u.pm * BM + wr * 64 + fr, hc0 = u.pn * 128 + wc * 32 + 8 * fq;
#pragma unroll
        for (int ai = 0; ai < 2; ++ai)
#pragma unroll
            for (int m = 0; m < 4; ++m) { const int r = row0 + ai * HALF + m * 16; const float w = roww[r];
                const f32x4 g0 = acc[ai][0][m][0], g1 = acc[ai][0][m][1], u0 = acc[ai][1][m][0], u1 = acc[ai][1][m][1]; u32x4 o;
                o.x = pk2(siluf_(g0.x) * u0.x * w, siluf_(g0.y) * u0.y * w); o.y = pk2(siluf_(g0.z) * u0.z * w, siluf_(g0.w) * u0.w * w);
                o.z = pk2(siluf_(g1.x) * u1.x * w, siluf_(g1.y) * u1.y * w); o.w = pk2(siluf_(g1.z) * u1.z * w, siluf_(g1.w) * u1.w * w);
                *(u32x4*)(HID + (size_t)r * 256 + hc0) = o; }
    }
};
struct EpiMoe2 { bf16_t* Y; const int* rmap; bf16_t* dump;
    __device__ __forceinline__ void operator()(const f32x4 (&acc)[2][2][4][2], const Unit& u, int wr, int wc, int fr, int fq) const {
        PG_ROWCOL8;
#pragma unroll
        for (int ai = 0; ai < 2; ++ai)
#pragma unroll
            for (int m = 0; m < 4; ++m) { const int s = rmap[row0 + ai * HALF + m * 16];
                bf16_t* rowp = (s >= 0 ? Y + (size_t)s * DM : dump) + col0;
#pragma unroll
                for (int bj = 0; bj < 2; ++bj) { const f32x4 v0 = acc[ai][bj][m][0], v1 = acc[ai][bj][m][1]; u32x4 o; o.x = pk2(v0.x, v0.y); o.y = pk2(v0.z, v0.w); o.z = pk2(v1.x, v1.y); o.w = pk2(v1.z, v1.w); *(u32x4*)(rowp + bj * HALF) = o; } }
    }
};
#undef PG_ROWCOL8
#undef PG_ROWCOL
}

__device__ __forceinline__ void moe_offsets(Frame& F, int l, int* off) {
    if (F.tid < 64) {
        int v = (F.tid < 32) ? (((int)F.cnt()[l * 32 + F.tid] + 255) & ~255) : 0;
#pragma unroll
        for (int o = 1; o < 32; o <<= 1) { const int t = __shfl_up(v, o); if ((F.tid & 63) >= o) v += t; }
        if (F.tid < 32) off[F.tid + 1] = v;
        if (F.tid == 0) off[0] = 0;
    }
    __syncthreads();
}

__device__ __forceinline__ void phase_rope(Frame& F) {
    float* tab = F.smf;
    for (int e = F.tid; e < 1024; e += NTHR) { const int pp = e >> 4, i = e & 15; const float inv = powf(10000.f, -(float)i / 16.f), ang = (float)pp * inv; tab[2 * e] = cosf(ang); tab[2 * e + 1] = sinf(ang); }
    __syncthreads();
    const size_t total = (size_t)NTOK * 320;
    for (size_t idx = (size_t)F.bid * NTHR + F.tid; idx < total; idx += (size_t)F.nb * NTHR) {
        const int row = (int)(idx / 320), r = (int)(idx % 320), h = r >> 5, half = (r >> 4) & 1, i = r & 15;
        const int pos = row & (SEQ - 1), pp = half ? (pos & 63) : (pos >> 6);
        const float cs = tab[2 * (pp * 16 + i)], sn = tab[2 * (pp * 16 + i) + 1];
        bf16_t* base = F.P1() + (size_t)row * NP1 + (h < 8 ? PC_CQ + h * 64 : PC_CK + (h - 8) * 64) + half * 32 + i;
        const float u1 = bf2f(base[0]), u2 = bf2f(base[16]);
        base[0] = f2bf(u1 * cs - u2 * sn); base[16] = f2bf(u1 * sn + u2 * cs);
    }
}

__device__ __forceinline__ int seq_row(int s, int b, int z) {
    if (s < LC) { const int tc = z ? (LC - 1 - s) : s; return NTOK + b * LC + tc; }
    const int tl = s - LC, t = z ? (SEQ - 1 - tl) : tl; return b * SEQ + t;
}
typedef short bf16x8_t __attribute__((ext_vector_type(8)));
typedef short bf16x4_t __attribute__((ext_vector_type(4)));
struct MaskNone { __device__ __forceinline__ void operator()(f32x4&, f32x4&) const {} };
struct MaskNA { int u0; const float* brow;
    __device__ __forceinline__ void operator()(f32x4& s0, f32x4& s1) const {
        float v[8] = {s0.x, s0.y, s0.z, s0.w, s1.x, s1.y, s1.z, s1.w};
#pragma unroll
        for (int T = 0; T < 2; ++T)
#pragma unroll
            for (int rr = 0; rr < 4; ++rr) v[T * 4 + rr] = ((unsigned)(u0 + 16 * T + rr) < 16u) ? v[T * 4 + rr] + brow[16 * T + rr] : -INFINITY;
        s0 = (f32x4){v[0], v[1], v[2], v[3]}; s1 = (f32x4){v[4], v[5], v[6], v[7]};
    }
};
struct MaskWA { int i, j0;
    __device__ __forceinline__ void operator()(f32x4& s0, f32x4& s1) const {
        float v[8] = {s0.x, s0.y, s0.z, s0.w, s1.x, s1.y, s1.z, s1.w};
#pragma unroll
        for (int T = 0; T < 2; ++T)
#pragma unroll
            for (int rr = 0; rr < 4; ++rr) { const int j = j0 + 16 * T + rr; const bool ok = (j >= 0) && (j < SEQ) && (i - j <= 128) && (j - i <= 128);
                v[T * 4 + rr] = ok ? v[T * 4 + rr] : -INFINITY; }
        s0 = (f32x4){v[0], v[1], v[2], v[3]}; s1 = (f32x4){v[4], v[5], v[6], v[7]};
    }
};
struct KVF { bf16x8_t k[4]; bf16x4_t v[4][2]; };
__device__ __forceinline__ void kv_load(KVF& f, const char* kbase, unsigned ko0, unsigned ko1, const char* vbase, unsigned vo0, unsigned vo1) {
    f.k[0] = *(const bf16x8_t*)(kbase + ko0); f.k[1] = *(const bf16x8_t*)(kbase + ko0 + 64); f.k[2] = *(const bf16x8_t*)(kbase + ko1); f.k[3] = *(const bf16x8_t*)(kbase + ko1 + 64);
#pragma unroll
    for (int t = 0; t < 4; ++t) { f.v[t][0] = *(const bf16x4_t*)(vbase + vo0 + (unsigned)t * 16u * NROW * 2u); f.v[t][1] = *(const bf16x4_t*)(vbase + vo1 + (unsigned)t * 16u * NROW * 2u); }
}
__device__ __forceinline__ float xmax_g(float x) {
    auto r = __builtin_amdgcn_permlane16_swap(__float_as_uint(x), __float_as_uint(x), false, false); x = fmaxf(__uint_as_float(r[0]), __uint_as_float(r[1]));
    auto q = __builtin_amdgcn_permlane32_swap(__float_as_uint(x), __float_as_uint(x), false, false); return fmaxf(__uint_as_float(q[0]), __uint_as_float(q[1])); }
__device__ __forceinline__ float xsum_g(float x) {
    auto r = __builtin_amdgcn_permlane16_swap(__float_as_uint(x), __float_as_uint(x), false, false); x = __uint_as_float(r[0]) + __uint_as_float(r[1]);
    auto q = __builtin_amdgcn_permlane32_swap(__float_as_uint(x), __float_as_uint(x), false, false); return __uint_as_float(q[0]) + __uint_as_float(q[1]); }
template <class MaskF>
__device__ __forceinline__ void attn_tile(float& am, f32x4& asum, f32x4 (&ao)[4], const bf16x8_t (&qb)[2], const KVF& f, const MaskF& maskf) {
    f32x4 s0 = {0.f, 0.f, 0.f, 0.f}, s1 = {0.f, 0.f, 0.f, 0.f};
    s0 = __builtin_amdgcn_mfma_f32_16x16x32_bf16(f.k[0], qb[0], s0, 0, 0, 0); s0 = __builtin_amdgcn_mfma_f32_16x16x32_bf16(f.k[1], qb[1], s0, 0, 0, 0);
    s1 = __builtin_amdgcn_mfma_f32_16x16x32_bf16(f.k[2], qb[0], s1, 0, 0, 0); s1 = __builtin_amdgcn_mfma_f32_16x16x32_bf16(f.k[3], qb[1], s1, 0, 0, 0);
    maskf(s0, s1);
    const float ml = fmaxf(fmaxf(fmaxf(s0.x, s0.y), fmaxf(s0.z, s0.w)), fmaxf(fmaxf(s1.x, s1.y), fmaxf(s1.z, s1.w)));
    if (__any(ml > am)) {
        const float mn = fmaxf(am, xmax_g(ml)), alpha = __builtin_amdgcn_exp2f(am - mn); am = mn; asum = asum * alpha;
#pragma unroll
        for (int t = 0; t < 4; ++t) ao[t] = ao[t] * alpha;
    }
    f32x4 p0, p1;
    p0.x = __builtin_amdgcn_exp2f(s0.x - am); p0.y = __builtin_amdgcn_exp2f(s0.y - am); p0.z = __builtin_amdgcn_exp2f(s0.z - am); p0.w = __builtin_amdgcn_exp2f(s0.w - am);
    p1.x = __builtin_amdgcn_exp2f(s1.x - am); p1.y = __builtin_amdgcn_exp2f(s1.y - am); p1.z = __builtin_amdgcn_exp2f(s1.z - am); p1.w = __builtin_amdgcn_exp2f(s1.w - am);
    union { bf16x8_t v; unsigned u[4]; } pb, ones;
    pb.u[0] = pk2(p0.x, p0.y); pb.u[1] = pk2(p0.z, p0.w); pb.u[2] = pk2(p1.x, p1.y); pb.u[3] = pk2(p1.z, p1.w);
    ones.u[0] = ones.u[1] = ones.u[2] = ones.u[3] = 0x3f803f80u;
#pragma unroll
    for (int t = 0; t < 4; ++t) {
        union { bf16x8_t v; bf16x4_t h[2]; } av; av.h[0] = f.v[t][0]; av.h[1] = f.v[t][1];
        ao[t] = __builtin_amdgcn_mfma_f32_16x16x32_bf16(av.v, pb.v, ao[t], 0, 0, 0);
    }
    asum = __builtin_amdgcn_mfma_f32_16x16x32_bf16(ones.v, pb.v, asum, 0, 0, 0);
}
template <int kind>
__device__ __forceinline__ void attn_block(Frame& F, int l, int item, const float* rpb_s, bf16_t* sbuf) {
    constexpr int NQ = 2, NCS = 4, NLOC = (kind == 0) ? 11 : (kind == 1 ? 5 : 0), NS = NCS + NLOC, SROW = 72;
    const int tid = F.tid, lane = F.lane, n = lane & 15, g = lane >> 4, w = __builtin_amdgcn_readfirstlane(F.wave);
    const bf16_t* P1 = F.P1(); const bf16_t* VT = F.VT();
    int b, h0, kvh = 0, kcol, vrow, r = 0, cb = 0, t0 = 0, t0g = 0, r0 = 0, qrow0, qcol0, brcol0;
    constexpr int QRS = (kind == 0) ? 64 : (kind == 2 ? 16 : 0), QCS = (kind == 1 || kind == 3) ? 64 : 0;
    if (kind == 0) { const int rq = item & 15, hb = (item >> 4) & 7; b = item >> 7; r0 = 4 * rq; cb = w & 3; r = r0 + 2 * (w >> 2); h0 = hb; kcol = PC_BK + hb * 64; vrow = hb * 64;
        qrow0 = b * SEQ + r * 64 + cb * 16; qcol0 = PC_BQ + hb * 64; brcol0 = 512 + hb * 64; }
    else if (kind == 1) { const int qg = item & 63; kvh = (item >> 6) & 1; b = item >> 7; t0g = 64 * qg; t0 = t0g + 16 * (w & 3); h0 = kvh * 4 + 2 * (w >> 2); kcol = PC_CK + kvh * 64; vrow = 512 + kvh * 64;
        qrow0 = b * SEQ + t0; qcol0 = PC_CQ + h0 * 64; brcol0 = 1024 + h0 * 64; }
    else if (kind == 2) { const int hb = item & 7; b = item >> 3; h0 = hb; kcol = PC_BK + hb * 64; vrow = hb * 64; qrow0 = NTOK + b * LC + 32 * w; qcol0 = PC_BQ + hb * 64; brcol0 = 512 + hb * 64; }
    else { const int qh = item & 3; kvh = (item >> 2) & 1; b = item >> 3; h0 = kvh * 4 + 2 * (w >> 2); kcol = PC_CK + kvh * 64; vrow = 512 + kvh * 64;
        qrow0 = NTOK + b * LC + 16 * (4 * qh + (w & 3)); qcol0 = PC_CQ + h0 * 64; brcol0 = 1024 + h0 * 64; }
    bf16x8_t qb[NQ][2]; float am[NQ]; f32x4 asum[NQ], ao[NQ][4];
    { const char* qbase = (const char*)P1; const unsigned qo = (unsigned)(qrow0 + n) * (unsigned)(NP1 * 2) + (unsigned)(qcol0 + 8 * g) * 2u;
#pragma unroll
      for (int q = 0; q < NQ; ++q) { const unsigned o = qo + (unsigned)q * (unsigned)(QRS * NP1 * 2 + QCS * 2); qb[q][0] = *(const bf16x8_t*)(qbase + o); qb[q][1] = *(const bf16x8_t*)(qbase + o + 64);
        am[q] = -1e30f; asum[q] = (f32x4){0.f, 0.f, 0.f, 0.f};
#pragma unroll
        for (int t = 0; t < 4; ++t) ao[q][t] = (f32x4){0.f, 0.f, 0.f, 0.f}; } }
    const int crow0 = NTOK + b * LC, ru0 = min(max(r0 - 4, 0), 56);
    const int w0 = (cb == 0) ? 0 : (cb == 1 ? 8 : (cb == 2 ? 24 : 32));
    const int srow = tid >> 3, sch = tid & 7;
    const char* kbase = (const char*)P1; const char* vbase = (const char*)VT;
    u32x4 kr0 = {0u, 0u, 0u, 0u}, vr0 = kr0, kr1 = kr0, vr1 = kr0;
    auto stage_load = [&](int s, u32x4& kreg, u32x4& vreg) {
        int krow, vcol;
        if (s < NCS) { krow = crow0 + 64 * s + srow; vcol = crow0 + 64 * s + 8 * sch; }
        else if (kind == 0) { const int kr = min(ru0 + (s - NCS), 63); krow = b * SEQ + kr * 64 + srow; vcol = b * SEQ + kr * 64 + 8 * sch; }
        else { const int kb = t0g - 128 + 64 * (s - NCS); krow = b * SEQ + min(max(kb + srow, 0), SEQ - 1); vcol = b * SEQ + min(max(kb + 8 * sch, 0), SEQ - 8); }
        kreg = *(const u32x4*)(kbase + (unsigned)krow * (unsigned)(NP1 * 2) + (unsigned)(kcol * 2 + sch * 16));
        vreg = *(const u32x4*)(vbase + (unsigned)(vrow + srow) * (unsigned)(NROW * 2) + (unsigned)vcol * 2u);
    };
    auto stage_store = [&](int s, const u32x4& kreg, const u32x4& vreg) { bf16_t* Ks = sbuf + (s & 1) * (2 * 64 * SROW); bf16_t* Vs = Ks + 64 * SROW;
        *(u32x4*)(Ks + srow * SROW + sch * 8) = kreg; *(u32x4*)(Vs + srow * SROW + sch * 8) = vreg; };
    stage_load(0, kr1, vr1); stage_store(0, kr1, vr1); stage_load(1, kr0, vr0);
    __syncthreads();
    auto do_step = [&](int s, const u32x4& kst, const u32x4& vst, u32x4& kld, u32x4& vld) {
        if (s + 2 < NS) stage_load(s + 2, kld, vld);
#pragma unroll
        for (int hh = 0; hh < 2; ++hh) {
            bool act[NQ]; int kofs = 32 * hh;
            if (s < NCS) { act[0] = act[1] = true; }
            else if (kind == 0) { const int kr = ru0 + (s - NCS); kofs = w0;
#pragma unroll
                for (int q = 0; q < NQ; ++q) { const int rsq = min(max(r + q - 4, 0), 56); act[q] = (hh == 0) && (kr <= 63) && (kr >= rsq) && (kr <= rsq + 7); } }
            else { const int kb = t0g - 128 + 64 * (s - NCS) + 32 * hh; act[0] = act[1] = (kb + 31 >= t0 - 128) && (kb <= t0 + 143); }
            if (act[0] || act[1]) {
                const bf16_t* Ks = sbuf + (s & 1) * (2 * 64 * SROW); const bf16_t* Vs = Ks + 64 * SROW;
                KVF f;
                f.k[0] = *(const bf16x8_t*)(Ks + (kofs + n) * SROW + 8 * g); f.k[1] = *(const bf16x8_t*)(Ks + (kofs + n) * SROW + 32 + 8 * g);
                f.k[2] = *(const bf16x8_t*)(Ks + (kofs + 16 + n) * SROW + 8 * g); f.k[3] = *(const bf16x8_t*)(Ks + (kofs + 16 + n) * SROW + 32 + 8 * g);
#pragma unroll
                for (int t = 0; t < 4; ++t) { f.v[t][0] = *(const bf16x4_t*)(Vs + (16 * t + n) * SROW + kofs + 4 * g); f.v[t][1] = *(const bf16x4_t*)(Vs + (16 * t + n) * SROW + kofs + 16 + 4 * g); }
                if (s < NCS) {
#pragma unroll
                    for (int q = 0; q < NQ; ++q) attn_tile(am[q], asum[q], ao[q], qb[q], f, MaskNone());
                } else if (kind == 0) { const int kr = ru0 + (s - NCS);
#pragma unroll
                    for (int q = 0; q < NQ; ++q) if (act[q]) { const int c = cb * 16 + n, csq = min(max(c - 8, 0), 48), kc0 = w0 + 4 * g;
                        MaskNA mk{kc0 - csq, rpb_s + (h0 * 15 + (kr - (r + q) + 7)) * 64 + (kc0 - c + 15 + 16)}; attn_tile(am[q], asum[q], ao[q], qb[q], f, mk); }
                } else if (kind == 1) { const int kb = t0g - 128 + 64 * (s - NCS) + 32 * hh;
                    if (kb >= t0 - 113 && kb + 31 <= t0 + 128 && kb >= 0 && kb + 31 < SEQ) {
#pragma unroll
                        for (int q = 0; q < NQ; ++q) attn_tile(am[q], asum[q], ao[q], qb[q], f, MaskNone());
                    } else { MaskWA mk{t0 + n, kb + 4 * g};
#pragma unroll
                        for (int q = 0; q < NQ; ++q) attn_tile(am[q], asum[q], ao[q], qb[q], f, mk); }
                }
            }
        }
        if (s + 1 < NS) stage_store(s + 1, kst, vst);
        __syncthreads();
    };
#pragma unroll 1
    for (int s = 0; s < NS; s += 2) { do_step(s, kr0, vr0, kr1, vr1); if (s + 1 < NS) do_step(s + 1, kr1, vr1, kr0, vr0); }
#pragma unroll
    for (int q = 0; q < NQ; ++q) {
        float lt = asum[q].x;
        float osc = 1.f;
        if (kind == 1 || kind == 3) { const float sk = F.p.wa_sink[l * 8 + h0 + q] * 1.44269504089f, mf = fmaxf(am[q], sk); osc = __builtin_amdgcn_exp2f(am[q] - mf); lt = lt * osc + __builtin_amdgcn_exp2f(sk - mf); }
        const float inv = osc / lt;
        char* obase = (char*)F.BR(); const unsigned oo = (unsigned)(qrow0 + q * QRS + n) * 4096u + (unsigned)(brcol0 + q * QCS + 4 * g) * 2u;
#pragma unroll
        for (int t = 0; t < 4; ++t) { const f32x4 v = ao[q][t] * inv; u32x2 o2; o2.x = pk2(v.x, v.y); o2.y = pk2(v.z, v.w); *(u32x2*)(obase + oo + 32u * t) = o2; }
    }
}

template <int DK, bool HG>
__device__ __forceinline__ void prescan_combo(Frame& F, int l, int b, int h, int first, int step) {
    constexpr int NDP = DK / 2, NTG = NTHR / NDP, TPT = 64 / NTG, LGS = 66;
    REFRESH(F);
    const int tid = F.tid, dp = tid % NDP, tg = tid / NDP, lane = F.lane, n = lane & 15, g = lane >> 4, w = __builtin_amdgcn_readfirstlane(F.wave);
    float* TOT = F.smf;
    float* LGS_ = F.smf + 2 * 2 * NTG * DK;
    char* p1b = (char*)F.P1();
    bf16x8_t bw[HG ? 1 : 4]; f32x2_t lb2[2];
    lb2[0] = (f32x2_t){0.f, 0.f}; lb2[1] = lb2[0];
    if (!HG) {
        const int zw = w >> 2;
#pragma unroll
        for (int dt = 0; dt < 4; ++dt) { float wv[8];
#pragma unroll
            for (int j = 0; j < 8; ++j) { const float x = F.p.gla_lr_w[((size_t)(l * 2 + zw) * 16 + 8 * (g & 1) + j) * 256 + h * 64 + dt * 16 + n]; const float hi = __uint_as_float(pk2(x, x) << 16); wv[j] = (g < 2) ? x : x - hi; }
            union { bf16x8_t v; unsigned u[4]; } pb; pb.u[0] = pk2(wv[0], wv[1]); pb.u[1] = pk2(wv[2], wv[3]); pb.u[2] = pk2(wv[4], wv[5]); pb.u[3] = pk2(wv[6], wv[7]); bw[HG ? 0 : dt] = pb.v; }
#pragma unroll
        for (int z = 0; z < 2; ++z) { const float* bp = F.p.gla_lr_b + (l * 2 + z) * 256 + h * 64 + 2 * dp; lb2[z] = (f32x2_t){bp[0], bp[1]}; }
    }
    const int qcol = HG ? PC_DQ + h * 128 + 2 * dp : PC_AQ + h * 64 + 2 * dp, kcol = HG ? PC_DF + h * 128 + 2 * dp : PC_AK + h * 64 + 2 * dp;
    float* ebase = F.ESC() + (HG ? 32 * 68 * 128 : 0);
    unsigned rq[TPT], rk[TPT], rk1[HG ? TPT : 1]; u32x4 rlp = {0u, 0u, 0u, 0u};
    rk1[0] = 0u;
#define PS_LOAD(nbk_) do { const int row0_ = seq_row((nbk_) * 64, b, 0); unsigned o_ = (unsigned)(row0_ + tg * TPT) * (unsigned)(NP1 * 2); \
        _Pragma("unroll") for (int tt = 0; tt < TPT; ++tt) { rq[tt] = *(const unsigned*)(p1b + (o_ + (unsigned)(qcol * 2))); rk[tt] = *(const unsigned*)(p1b + (o_ + (unsigned)(kcol * 2))); \
            if (HG) rk1[HG ? tt : 0] = *(const unsigned*)(p1b + (o_ + (unsigned)((kcol + 512) * 2))); o_ += (unsigned)(NP1 * 2); } \
        if (!HG) rlp = *(const u32x4*)(p1b + ((unsigned)(row0_ + (w & 3) * 16 + n) * (unsigned)(NP1 * 2) + (unsigned)((PC_ALR + (w >> 2) * 16 + (g & 1) * 8) * 2))); } while (0)
    int nbk = first, par = 0;
    if (nbk < 68) PS_LOAD(nbk);
#pragma unroll 1
    for (; nbk < 68; nbk += step, par ^= 1) {
        float* tot = TOT + par * (2 * NTG * DK);
        if (!HG) {
            union { bf16x8_t v; u32x4 u; } af; af.u = rlp;
            float* lgw = LGS_ + ((w >> 2) * 64 + (w & 3) * 16 + 4 * g) * LGS + n;
#pragma unroll
            for (int dt = 0; dt < 4; ++dt) { const f32x4 d = __builtin_amdgcn_mfma_f32_16x16x32_bf16(af.v, bw[HG ? 0 : dt], (f32x4){0.f, 0.f, 0.f, 0.f}, 0, 0, 0);
                lgw[0 * LGS + dt * 16] = d.x; lgw[1 * LGS + dt * 16] = d.y; lgw[2 * LGS + dt * 16] = d.z; lgw[3 * LGS + dt * 16] = d.w; }
            __syncthreads();
        }
        const int row0 = seq_row(nbk * 64, b, 0);
        f32x2_t qv[TPT], kv0[TPT], kv1[HG ? TPT : 1], cs0[TPT], cs1[TPT];
#pragma unroll
        for (int tt = 0; tt < TPT; ++tt) {
            qv[tt] = (f32x2_t){__uint_as_float(rq[tt] << 16), __uint_as_float(rq[tt] & 0xffff0000u)};
            const f32x2_t kr = {__uint_as_float(rk[tt] << 16), __uint_as_float(rk[tt] & 0xffff0000u)};
            if (HG) { const unsigned r1 = rk1[HG ? tt : 0]; const f32x2_t k1 = {__uint_as_float(r1 << 16), __uint_as_float(r1 & 0xffff0000u)};
                cs0[tt] = kr; cs1[tt] = k1;
                kv0[tt] = (f32x2_t){1.f - __expf(kr.x), 1.f - __expf(kr.y)}; kv1[HG ? tt : 0] = (f32x2_t){1.f - __expf(k1.x), 1.f - __expf(k1.y)}; }
            else kv0[tt] = kr;
        }
        if (nbk + step < 68) PS_LOAD(nbk + step);
        if (!HG) {
#pragma unroll
            for (int tt = 0; tt < TPT; ++tt)
#pragma unroll
                for (int z = 0; z < 2; ++z) {
                    const f32x2_t lg = *(const f32x2_t*)(LGS_ + (z * 64 + tg * TPT + tt) * LGS + 2 * dp) + lb2[z];
                    const f32x2_t gz = {(fminf(lg.x, 0.f) - __logf(1.f + __expf(-fabsf(lg.x)))) * (1.f / 16.f), (fminf(lg.y, 0.f) - __logf(1.f + __expf(-fabsf(lg.y)))) * (1.f / 16.f)};
                    if (z == 0) cs0[tt] = gz; else cs1[tt] = gz; }
        }
#pragma unroll
        for (int tt = 1; tt < TPT; ++tt) { cs0[tt] += cs0[tt - 1]; cs1[TPT - 1 - tt] += cs1[TPT - tt]; }
        *(f32x2_t*)(tot + (0 * NTG + tg) * DK + 2 * dp) = cs0[TPT - 1];
        *(f32x2_t*)(tot + (1 * NTG + tg) * DK + 2 * dp) = cs1[0];
        __syncthreads();
        f32x2_t offs0 = {0.f, 0.f}, mid0 = offs0, last0 = offs0, offs1 = offs0, mid1 = offs0, last1 = offs0;
#pragma unroll
        for (int t2 = 0; t2 < NTG; ++t2) { const f32x2_t v0 = *(const f32x2_t*)(tot + (0 * NTG + t2) * DK + 2 * dp), v1 = *(const f32x2_t*)(tot + (1 * NTG + t2) * DK + 2 * dp);
            if (t2 < tg) offs0 += v0; if (t2 < NTG / 2) mid0 += v0; last0 += v0;
            if (t2 > tg) offs1 += v1; if (t2 >= NTG / 2) mid1 += v1; last1 += v1; }
        const f32x2_t d0 = offs0 - mid0, d1 = offs1 - mid1;
        unsigned ro = (unsigned)(row0 + tg * TPT);
#pragma unroll
        for (int tt = 0; tt < TPT; ++tt, ++ro) {
            const float x00 = fminf(fmaxf(cs0[tt].x + d0.x, -80.f), 80.f), x01 = fminf(fmaxf(cs0[tt].y + d0.y, -80.f), 80.f);
            const float x10 = fminf(fmaxf(cs1[tt].x + d1.x, -80.f), 80.f), x11 = fminf(fmaxf(cs1[tt].y + d1.y, -80.f), 80.f);
            const f32x2_t k1v = kv1[HG ? tt : 0], k1 = HG ? k1v : kv0[tt];
            const unsigned qd0 = pk2(qv[tt].x * __expf(x00), qv[tt].y * __expf(x01)), kd0 = pk2(kv0[tt].x * __expf(-x00), kv0[tt].y * __expf(-x01));
            const unsigned qd1 = pk2(qv[tt].x * __expf(x10), qv[tt].y * __expf(x11)), kd1 = pk2(k1.x * __expf(-x10), k1.y * __expf(-x11));
            const unsigned o_ = ro * (unsigned)(NP1 * 2);
            *(unsigned*)(p1b + (o_ + (unsigned)(qcol * 2))) = qd0; *(unsigned*)(p1b + (o_ + (unsigned)(kcol * 2))) = kd0;
            if (HG) { *(unsigned*)(p1b + (o_ + (unsigned)((kcol + 512) * 2))) = kd1; *(unsigned*)((char*)F.BR() + (ro * 4096u + (unsigned)((1536 + h * 128 + 2 * dp) * 2))) = qd1; }
            else { *(unsigned*)((char*)F.SC1() + (ro * 1024u + (unsigned)((h * 64 + 2 * dp) * 2))) = qd1; *(unsigned*)((char*)F.SC1() + (ro * 1024u + (unsigned)((256 + h * 64 + 2 * dp) * 2))) = kd1; }
        }
        if (tg == 0) {
            float* e0 = ebase + (size_t)(((b * 4 + h) * 2 + 0) * 68 + nbk) * (2 * DK), *e1 = ebase + (size_t)(((b * 4 + h) * 2 + 1) * 68 + (nbk < 4 ? 3 - nbk : 71 - nbk)) * (2 * DK);
            *(f32x2_t*)(e0 + 2 * dp) = (f32x2_t){__expf(mid0.x), __expf(mid0.y)}; *(f32x2_t*)(e0 + DK + 2 * dp) = (f32x2_t){__expf(last0.x - mid0.x), __expf(last0.y - mid0.y)};
            *(f32x2_t*)(e1 + 2 * dp) = (f32x2_t){__expf(mid1.x), __expf(mid1.y)}; *(f32x2_t*)(e1 + DK + 2 * dp) = (f32x2_t){__expf(last1.x - mid1.x), __expf(last1.y - mid1.y)};
        }
    }
    __syncthreads();
#undef PS_LOAD
}
__device__ __forceinline__ void phase_prescan(Frame& F, int l) {
    if (F.nb >= 32) { const int combo = F.bid & 31, b = (combo >> 2) & 3, h = combo & 3;
        if ((combo >> 4) == 0) prescan_combo<64, false>(F, l, b, h, F.bid >> 5, F.nb >> 5); else prescan_combo<128, true>(F, l, b, h, F.bid >> 5, F.nb >> 5);
    } else {
        for (int combo = F.bid; combo < 32; combo += F.nb) { const int b = (combo >> 2) & 3, h = combo & 3;
            if ((combo >> 4) == 0) prescan_combo<64, false>(F, l, b, h, 0, 1); else prescan_combo<128, true>(F, l, b, h, 0, 1); }
    }
}

template <int DK, bool HG>
__device__ __forceinline__ void scan_mfma(Frame& F, int l, int b, int h, int z, int vh, unsigned char* lds) {
    constexpr int NDP = DK / 2, NTG = NTHR / NDP, TPT = 64 / NTG, QS = DK + 8, TS = 72, NDT = DK / 16, PPR = DK / 8, NQP = (64 * PPR) / NTHR;
    bf16_t* QD = (bf16_t*)lds; bf16_t* KD = QD + 64 * QS; bf16_t* KDT = KD + 64 * QS; bf16_t* VTs = KDT + DK * TS; bf16_t* AM = VTs + 64 * TS; bf16_t* ST = AM + 64 * TS;
    float* E1s = (float*)(ST + 64 * QS); float* E2s = E1s + DK;
    REFRESH(F);
    const int tid = F.tid, lane = F.lane, w = F.wave, n = lane & 15, g = lane >> 4;
    const int dp = tid % NDP, tg = tid / NDP, vp = tid & 31, vg = tid >> 5;
    const int vt = w & 3, wh = w >> 2;
    const char* p1b = (const char*)F.P1();
    const char* qb; const char* kb; unsigned qstr, kstr, qoff, koff;
    if (HG) { kb = p1b; kstr = NP1 * 2; koff = (unsigned)((PC_DF + z * 512 + h * 128) * 2);
        if (z == 0) { qb = p1b; qstr = NP1 * 2; qoff = (unsigned)((PC_DQ + h * 128) * 2); } else { qb = (const char*)F.BR(); qstr = 4096u; qoff = (unsigned)((1536 + h * 128) * 2); } }
    else if (z == 0) { qb = p1b; kb = p1b; qstr = kstr = NP1 * 2; qoff = (unsigned)((PC_AQ + h * 64) * 2); koff = (unsigned)((PC_AK + h * 64) * 2); }
    else { qb = (const char*)F.SC1(); kb = qb; qstr = kstr = 1024u; qoff = (unsigned)(h * 64 * 2); koff = (unsigned)((256 + h * 64) * 2); }
    const float* eb = F.ESC() + (HG ? 32 * 68 * 128 : 0) + (size_t)(((b * 4 + h) * 2 + z) * 68) * (2 * DK);
    f32x4 accS[NDT / 2];
#pragma unroll
    for (int i = 0; i < NDT / 2; ++i) accS[i] = (f32x4){0.f, 0.f, 0.f, 0.f};
    u32x4 rqp[NQP]; unsigned rk[TPT], rv[4]; float re = 0.f;
    const int vcol = (HG ? PC_DI : PC_AV) + h * 128 + 64 * vh + 2 * vp;
    const int sgn = z ? -1 : 1; const int rstep = sgn * NP1 * 2;
#define SCAN_LOAD(c) do { const int row0_ = seq_row((c) * 64, b, z); \
        _Pragma("unroll") for (int j = 0; j < NQP; ++j) { const int pi_ = tid + NTHR * j; rqp[j] = *(const u32x4*)(qb + ((unsigned)(row0_ + sgn * (pi_ / PPR)) * qstr + qoff + (unsigned)((pi_ % PPR) * 16))); } \
        _Pragma("unroll") for (int tt = 0; tt < TPT; ++tt) rk[tt] = *(const unsigned*)(kb + ((unsigned)(row0_ + sgn * (tg * TPT + tt)) * kstr + koff + (unsigned)(dp * 4))); \
        int ov_ = (row0_ + sgn * vg * 4) * (NP1 * 2) + vcol * 2; \
        _Pragma("unroll") for (int tt = 0; tt < 4; ++tt) { rv[tt] = *(const unsigned*)(p1b + (unsigned)ov_); ov_ += rstep; } \
        if (tid < 2 * DK) re = eb[(c) * (2 * DK) + tid]; } while (0)
    SCAN_LOAD(0);
    constexpr int NCH = (LC + SEQ) / 64;
#pragma unroll 1
    for (int c = 0; c < NCH; ++c) {
        __syncthreads();
#pragma unroll
        for (int j = 0; j < NQP; ++j) { const int pi_ = tid + NTHR * j; *(u32x4*)(QD + (pi_ / PPR) * QS + (pi_ % PPR) * 8) = rqp[j]; }
#pragma unroll
        for (int tt = 0; tt < TPT; ++tt) *(unsigned*)(KD + (tg * TPT + tt) * QS + 2 * dp) = rk[tt];
        {   unsigned kdt[2][TPT / 2];
#pragma unroll
            for (int t2 = 0; t2 < TPT / 2; ++t2) { kdt[0][t2] = (rk[2 * t2] & 0xffffu) | (rk[2 * t2 + 1] << 16); kdt[1][t2] = (rk[2 * t2] >> 16) | (rk[2 * t2 + 1] & 0xffff0000u); }
#pragma unroll
            for (int e = 0; e < 2; ++e) {
                bf16_t* dst = KDT + (2 * dp + e) * TS + tg * TPT;
                if (TPT == 8) { u32x4 o; o.x = kdt[e][0]; o.y = kdt[e][1]; o.z = kdt[e][TPT / 2 - 2]; o.w = kdt[e][TPT / 2 - 1]; *(u32x4*)dst = o; }
                else { u32x2 o; o.x = kdt[e][0]; o.y = kdt[e][1]; *(u32x2*)dst = o; }
            }
        }
        if (tid < 2 * DK) E1s[tid] = re;
        {   u32x2 o0, o1;
            o0.x = (rv[0] & 0xffffu) | (rv[1] << 16); o0.y = (rv[2] & 0xffffu) | (rv[3] << 16);
            o1.x = (rv[0] >> 16) | (rv[1] & 0xffff0000u); o1.y = (rv[2] >> 16) | (rv[3] & 0xffff0000u);
            *(u32x2*)(VTs + (2 * vp) * TS + vg * 4) = o0; *(u32x2*)(VTs + (2 * vp + 1) * TS + vg * 4) = o1; }
        if (c + 1 < NCH) SCAN_LOAD(c + 1);
        __syncthreads();
#pragma unroll
        for (int i = 0; i < NDT / 2; ++i) { const int dt = wh * (NDT / 2) + i; accS[i] = accS[i] * *(const f32x4*)&E1s[16 * dt + 4 * g];
            u32x2 o; o.x = pk2(accS[i].x, accS[i].y); o.y = pk2(accS[i].z, accS[i].w); *(u32x2*)(ST + (16 * vt + n) * QS + 16 * dt + 4 * g) = o; }
        {   const int it = w >> 1, jt0 = 2 * (w & 1);
            f32x4 d0 = {0.f, 0.f, 0.f, 0.f}, d1 = {0.f, 0.f, 0.f, 0.f};
            if (jt0 <= it) {
                bf16x8_t qf[DK / 32], k0f[DK / 32], k1f[DK / 32];
#pragma unroll
                for (int ks = 0; ks < DK / 32; ++ks) { qf[ks] = *(const bf16x8_t*)(QD + (16 * it + n) * QS + 32 * ks + 8 * g); k0f[ks] = *(const bf16x8_t*)(KD + (16 * jt0 + n) * QS + 32 * ks + 8 * g); k1f[ks] = *(const bf16x8_t*)(KD + (16 * (jt0 + 1) + n) * QS + 32 * ks + 8 * g); }
#pragma unroll
                for (int ks = 0; ks < DK / 32; ++ks) { d0 = __builtin_amdgcn_mfma_f32_16x16x32_bf16(k0f[ks], qf[ks], d0, 0, 0, 0); d1 = __builtin_amdgcn_mfma_f32_16x16x32_bf16(k1f[ks], qf[ks], d1, 0, 0, 0); }
                const int i = 16 * it + n, j0 = 16 * jt0 + 4 * g, j1 = j0 + 16;
                d0.x = (j0 + 0 <= i) ? d0.x : 0.f; d0.y = (j0 + 1 <= i) ? d0.y : 0.f; d0.z = (j0 + 2 <= i) ? d0.z : 0.f; d0.w = (j0 + 3 <= i) ? d0.w : 0.f;
                d1.x = (j1 + 0 <= i) ? d1.x : 0.f; d1.y = (j1 + 1 <= i) ? d1.y : 0.f; d1.z = (j1 + 2 <= i) ? d1.z : 0.f; d1.w = (j1 + 3 <= i) ? d1.w : 0.f;
            }
            u32x2 o; o.x = pk2(d0.x, d0.y); o.y = pk2(d0.z, d0.w); *(u32x2*)(AM + (16 * it + n) * TS + 16 * jt0 + 4 * g) = o;
            o.x = pk2(d1.x, d1.y); o.y = pk2(d1.z, d1.w); *(u32x2*)(AM + (16 * it + n) * TS + 16 * (jt0 + 1) + 4 * g) = o;
        }
        __syncthreads();
        {   f32x4 o[2];
#pragma unroll
            for (int ii = 0; ii < 2; ++ii) o[ii] = (f32x4){0.f, 0.f, 0.f, 0.f};
#pragma unroll
            for (int ks = 0; ks < 2; ++ks) { const bf16x8_t af = *(const bf16x8_t*)(VTs + (16 * vt + n) * TS + 32 * ks + 8 * g); bf16x8_t bf[2];
#pragma unroll
                for (int ii = 0; ii < 2; ++ii) bf[ii] = *(const bf16x8_t*)(AM + (16 * (2 * wh + ii) + n) * TS + 32 * ks + 8 * g);
#pragma unroll
                for (int ii = 0; ii < 2; ++ii) o[ii] = __builtin_amdgcn_mfma_f32_16x16x32_bf16(af, bf[ii], o[ii], 0, 0, 0); }
#pragma unroll
            for (int ks = 0; ks < DK / 32; ++ks) { const bf16x8_t af = *(const bf16x8_t*)(ST + (16 * vt + n) * QS + 32 * ks + 8 * g); bf16x8_t bf[2];
#pragma unroll
                for (int ii = 0; ii < 2; ++ii) bf[ii] = *(const bf16x8_t*)(QD + (16 * (2 * wh + ii) + n) * QS + 32 * ks + 8 * g);
#pragma unroll
                for (int ii = 0; ii < 2; ++ii) o[ii] = __builtin_amdgcn_mfma_f32_16x16x32_bf16(af, bf[ii], o[ii], 0, 0, 0); }
            const int row0 = seq_row(c * 64, b, z) + sgn * (32 * wh + n), vc = h * 128 + 64 * vh + 16 * vt + 4 * g;
            char* dstb; unsigned doff; int dstride;
            if (HG) { dstb = (char*)F.ODH(); doff = (unsigned)row0 * 2048u + (unsigned)(z * 512 + vc) * 2u; dstride = sgn * 16 * 2048; }
            else if (z == 0) { dstb = (char*)F.BR(); doff = (unsigned)row0 * 4096u + (unsigned)vc * 2u; dstride = sgn * 16 * 4096; }
            else { dstb = (char*)F.OBA(); doff = (unsigned)row0 * 1024u + (unsigned)vc * 2u; dstride = sgn * 16 * 1024; }
#pragma unroll
            for (int ii = 0; ii < 2; ++ii) { u32x2 o2; o2.x = pk2(o[ii].x, o[ii].y); o2.y = pk2(o[ii].z, o[ii].w); *(u32x2*)(dstb + (unsigned)((int)doff + ii * dstride)) = o2; }
        }
#pragma unroll
        for (int ks = 0; ks < 2; ++ks) { const bf16x8_t bv = *(const bf16x8_t*)(VTs + (16 * vt + n) * TS + 32 * ks + 8 * g); bf16x8_t af[NDT / 2];
#pragma unroll
            for (int i = 0; i < NDT / 2; ++i) af[i] = *(const bf16x8_t*)(KDT + (16 * (wh * (NDT / 2) + i) + n) * TS + 32 * ks + 8 * g);
#pragma unroll
            for (int i = 0; i < NDT / 2; ++i) accS[i] = __builtin_amdgcn_mfma_f32_16x16x32_bf16(af[i], bv, accS[i], 0, 0, 0); }
#pragma unroll
        for (int i = 0; i < NDT / 2; ++i) accS[i] = accS[i] * *(const f32x4*)&E2s[16 * (wh * (NDT / 2) + i) + 4 * g];
    }
    __syncthreads();
#undef SCAN_LOAD
}

__device__ __forceinline__ void phase_mix(Frame& F, int l) {
    const int n_scan = 128;
    const int nsb = (F.nb > 192) ? 128 : 0;
    if (nsb == 0 || F.bid < nsb) {
        for (int it = F.bid; it < n_scan; it += (nsb ? nsb : F.nb)) {
            const int br = it >> 6, r = (it >> 1) & 31, vh = it & 1, b = r >> 3, h = (r >> 1) & 3, z = r & 1;
            if (br == 0) scan_mfma<64, false>(F, l, b, h, z, vh, (unsigned char*)F.smf); else scan_mfma<128, true>(F, l, b, h, z, vh, (unsigned char*)F.smf);
        }
        __syncthreads();
    }
    float* rpb_s = F.smf;
    {   float tv[(8 * 15 * 64) / NTHR];
#pragma unroll
        for (int k = 0; k < (8 * 15 * 64) / NTHR; ++k) { const int i = F.tid + k * NTHR, dcp = i & 63, hr = i >> 6; tv[k] = (dcp >= 16 && dcp < 47) ? F.p.na_rpb[l * 8 * 465 + hr * 31 + (dcp - 16)] : 0.f; }
#pragma unroll
        for (int k = 0; k < (8 * 15 * 64) / NTHR; ++k) rpb_s[F.tid + k * NTHR] = tv[k] * 1.44269504089f; }
    bf16_t* sbuf = (bf16_t*)(F.smf + 8 * 15 * 64);
    unsigned* qhead = F.cnt() + 64 + l * 16;
    int* cur = (int*)((unsigned char*)F.smf - LDS_STAGE + 32);
    const int n_wa = 512, n_na = 512, n_cna = (l == 0) ? 32 : 0, n_cwa = (l == 0) ? 32 : 0, total = n_wa + n_na + n_cna + n_cwa;
    int nxt = 0;
    if (F.tid == 0) nxt = (int)atomicAdd(qhead, 1u);
    for (;;) {
        __syncthreads();
        if (F.tid == 0) *cur = nxt;
        __syncthreads();
        const int it = *cur;
        if (it >= total) break;
        if (F.tid == 0) nxt = (int)atomicAdd(qhead, 1u);
        if (it < n_wa) attn_block<1>(F, l, it, rpb_s, sbuf);
        else if (it < n_wa + n_na) attn_block<0>(F, l, it - n_wa, rpb_s, sbuf);
        else if (it < n_wa + n_na + n_cna) attn_block<2>(F, l, it - n_wa - n_na, rpb_s, sbuf);
        else attn_block<3>(F, l, it - n_wa - n_na - n_cna, rpb_s, sbuf);
    }
}

__device__ __forceinline__ void phase_prepad(Frame& F, int l) {
    const int gw = F.bid * 8 + F.wave, ngw = F.nb * 8, npairs = ((l == 0) ? NROW : NTOK) / 2, c0 = F.lane * 8;
    for (int pi = gw; pi < npairs; pi += ngw) {
        u32x4 ra[2][2], rb[2][2], rg[2][2];
#pragma unroll
        for (int q = 0; q < 2; ++q) { const size_t row = (size_t)pi * 2 + q;
            ra[q][0] = *(const u32x4*)(F.BR() + row * 2048 + c0); rb[q][0] = *(const u32x4*)(F.OBA() + row * 512 + c0); rg[q][0] = *(const u32x4*)(F.P1() + row * NP1 + PC_AG + c0);
            ra[q][1] = *(const u32x4*)(F.ODH() + row * 1024 + c0); rb[q][1] = *(const u32x4*)(F.ODH() + row * 1024 + 512 + c0); rg[q][1] = *(const u32x4*)(F.P1() + row * NP1 + PC_DG + c0); }
#pragma unroll
        for (int q = 0; q < 2; ++q)
#pragma unroll
            for (int br = 0; br < 2; ++br) {
                const unsigned ua[4] = {ra[q][br].x, ra[q][br].y, ra[q][br].z, ra[q][br].w}, ub[4] = {rb[q][br].x, rb[q][br].y, rb[q][br].z, rb[q][br].w}, ug[4] = {rg[q][br].x, rg[q][br].y, rg[q][br].z, rg[q][br].w};
                float o[8], g[8]; float ss = 0.f;
#pragma unroll
                for (int j = 0; j < 4; ++j) { o[2 * j] = __uint_as_float(ua[j] << 16) + __uint_as_float(ub[j] << 16); o[2 * j + 1] = __uint_as_float(ua[j] & 0xffff0000u) + __uint_as_float(ub[j] & 0xffff0000u);
                    g[2 * j] = __uint_as_float(ug[j] << 16); g[2 * j + 1] = __uint_as_float(ug[j] & 0xffff0000u); ss += o[2 * j] * o[2 * j] + o[2 * j + 1] * o[2 * j + 1]; }
                ss += __shfl_xor(ss, 1); ss += __shfl_xor(ss, 2); ss += __shfl_xor(ss, 4); ss += __shfl_xor(ss, 8);
                const float rs = rsqrtf(ss * (1.f / 128.f) + 1e-6f);
#pragma unroll
                for (int j = 0; j < 8; ++j) o[j] = o[j] * rs * siluf_(g[j]);
                st8(F.BR() + ((size_t)pi * 2 + q) * 2048 + (br ? 1536 : 0) + c0, o);
            }
    }
}

__device__ __forceinline__ void phase_ln1(Frame& F, int l) {
    const int nrows = (l == 0) ? NROW : NTOK, ngroups = nrows / 64;
    const float* lg = F.p.ln_g + (size_t)(l * 2 + 0) * DM; const float* lbb = F.p.ln_b + (size_t)(l * 2 + 0) * DM;
    float* part = F.smf;
    const int wv = __builtin_amdgcn_readfirstlane(F.wave);
    float* stg = F.smf + 8 * 36 * 64 + wv * (64 * 17 + 16 * 40);
    float* wl = stg + 64 * 17;
    for (int grp = F.bid; grp < ngroups; grp += F.nb) {
        const int row0 = grp * 64, rb = row_batch(row0);
        const float* mv = F.modv() + ((size_t)l * 5 + rb) * 6144;
        float* xg = row0 < NTOK ? F.p.out + (size_t)row0 * DM : F.cxm() + (size_t)(row0 - NTOK) * DM;
#pragma unroll 1
        for (int rr = 0; rr < 8; rr += 2) {
            const int lr = wv * 8 + rr; float* xr = xg + (size_t)lr * DM;
            f32x4 v[2][4]; float s[2] = {0.f, 0.f};
#pragma unroll
            for (int q = 0; q < 2; ++q)
#pragma unroll
                for (int j = 0; j < 4; ++j) v[q][j] = *(const f32x4*)(xr + (size_t)q * DM + j * 256 + F.lane * 4);
#pragma unroll
            for (int q = 0; q < 2; ++q)
#pragma unroll
                for (int j = 0; j < 4; ++j) s[q] += (v[q][j].x + v[q][j].y) + (v[q][j].z + v[q][j].w);
#pragma unroll
            for (int o = 1; o < 64; o <<= 1) { s[0] += __shfl_xor(s[0], o); s[1] += __shfl_xor(s[1], o); }
            float s2[2] = {0.f, 0.f};
#pragma unroll
            for (int q = 0; q < 2; ++q) { const float mean = s[q] * (1.f / DM);
#pragma unroll
                for (int j = 0; j < 4; ++j) { v[q][j] = v[q][j] - mean; s2[q] += (v[q][j].x * v[q][j].x + v[q][j].y * v[q][j].y) + (v[q][j].z * v[q][j].z + v[q][j].w * v[q][j].w); } }
#pragma unroll
            for (int o = 1; o < 64; o <<= 1) { s2[0] += __shfl_xor(s2[0], o); s2[1] += __shfl_xor(s2[1], o); }
#pragma unroll
            for (int j = 0; j < 4; ++j) { const int d = j * 256 + F.lane * 4;
                const f32x4 g4 = *(const f32x4*)(lg + d), b4 = *(const f32x4*)(lbb + d), m3 = *(const f32x4*)(mv + 3 * 1024 + d), m4 = *(const f32x4*)(mv + 4 * 1024 + d);
#pragma unroll
                for (int q = 0; q < 2; ++q) { const float rstd = rsqrtf(s2[q] * (1.f / DM) + LN_EPS);
                    const f32x4 xn = v[q][j] * rstd * g4 + b4;
                    *(f32x4*)(xr + (size_t)q * DM + d) = xn;
                    const f32x4 h2 = xn * (1.f + m4) + m3;
                    u32x2 o2; o2.x = pk2(h2.x, h2.y); o2.y = pk2(h2.z, h2.w);
                    *(u32x2*)(F.HX2() + (size_t)(row0 + lr + q) * DM + d) = o2; } }
        }
        __syncthreads();
        {   f32x4 acc[4][3];
#pragma unroll
            for (int mt = 0; mt < 4; ++mt)
#pragma unroll
                for (int nt = 0; nt < 3; ++nt) acc[mt][nt] = (f32x4){0.f, 0.f, 0.f, 0.f};
            const float* wgp = F.p.moe_w_group + ((size_t)l * DM + wv * 128) * 4; const float* wep = F.p.moe_w_expert + ((size_t)l * DM + wv * 128) * 32;
            const float* m3p = mv + 3 * 1024 + wv * 128; const float* m4p = mv + 4 * 1024 + wv * 128;
            const int ln = F.lane & 15, lk = F.lane >> 4;
#pragma unroll 1
            for (int dc = 0; dc < 128; dc += 16) {
                f32x4 t[4]; float bw[4][3];
#pragma unroll
                for (int i = 0; i < 4; ++i) t[i] = *(const f32x4*)(xg + (size_t)(16 * i + (F.lane >> 2)) * DM + wv * 128 + dc + (F.lane & 3) * 4);
                const f32x4 m3v = *(const f32x4*)(m3p + dc + (F.lane & 3) * 4), m4v = *(const f32x4*)(m4p + dc + (F.lane & 3) * 4);
#pragma unroll
                for (int ks = 0; ks < 4; ++ks) { const int d = dc + 4 * ks + lk; bw[ks][0] = wep[(size_t)d * 32 + ln]; bw[ks][1] = wep[(size_t)d * 32 + 16 + ln]; bw[ks][2] = (ln < 4) ? wgp[(size_t)d * 4 + ln] : 0.f; }
#pragma unroll
                for (int i = 0; i < 4; ++i) { float* sp = stg + (16 * i + (F.lane >> 2)) * 17 + (F.lane & 3) * 4;
                    sp[0] = t[i].x * (1.f + m4v.x) + m3v.x; sp[1] = t[i].y * (1.f + m4v.y) + m3v.y; sp[2] = t[i].z * (1.f + m4v.z) + m3v.z; sp[3] = t[i].w * (1.f + m4v.w) + m3v.w; }
                asm volatile("s_waitcnt lgkmcnt(0)" ::: "memory");
#pragma unroll
                for (int ks = 0; ks < 4; ++ks)
#pragma unroll
                    for (int mt = 0; mt < 4; ++mt) { const float av = stg[(16 * mt + ln) * 17 + 4 * ks + lk];
#pragma unroll
                        for (int nt = 0; nt < 3; ++nt) acc[mt][nt] = __builtin_amdgcn_mfma_f32_16x16x4f32(av, bw[ks][nt], acc[mt][nt], 0, 0, 0); }
                asm volatile("s_waitcnt lgkmcnt(0)" ::: "memory");
            }
#pragma unroll
            for (int mt = 0; mt < 4; ++mt)
#pragma unroll
                for (int nt = 0; nt < 3; ++nt) { const int oi = (nt == 2) ? ln : 4 + 16 * nt + ln;
                    if (nt < 2 || ln < 4) {
#pragma unroll
                        for (int r = 0; r < 4; ++r) part[(wv * 36 + oi) * 64 + 16 * mt + 4 * lk + r] = acc[mt][nt][r]; } }
        }
        __syncthreads();
        if (wv == 0) {
            const int row = row0 + F.lane;
            float gl[4]; int gi = 0; float gm = -3.4e38f;
#pragma unroll
            for (int o = 0; o < 4; ++o) { float t = F.p.moe_b_group[l * 4 + o];
#pragma unroll
                for (int w2 = 0; w2 < 8; ++w2) t += part[(w2 * 36 + o) * 64 + F.lane];
                gl[o] = t; if (t > gm) { gm = t; gi = o; } }
            float gs = 0.f;
#pragma unroll
            for (int o = 0; o < 4; ++o) gs += expf(gl[o] - gm);
            const float gwt = 1.f / gs;
            float e1 = -3.4e38f, e2 = -3.4e38f; int i1 = 0, i2 = 0;
#pragma unroll
            for (int o8 = 0; o8 < 8; ++o8) { const int o = gi * 8 + o8; float ev = F.p.moe_b_expert[l * 32 + o];
#pragma unroll
                for (int w2 = 0; w2 < 8; ++w2) ev += part[(w2 * 36 + 4 + o) * 64 + F.lane];
                if (ev > e1) { e2 = e1; i2 = i1; e1 = ev; i1 = o; } else if (ev > e2) { e2 = ev; i2 = o; } }
            const float w1 = 1.f / (1.f + expf(e2 - e1)), w2v = 1.f - w1;
            unsigned* lh = (unsigned*)(stg + 64 * 17 + 16 * 40 - 64);
            if (F.lane < 32) lh[F.lane] = 0u;
            asm volatile("s_waitcnt lgkmcnt(0)" ::: "memory");
            const unsigned r1 = atomicAdd(&lh[i1], 1u), r2 = atomicAdd(&lh[i2], 1u);
            asm volatile("s_waitcnt lgkmcnt(0)" ::: "memory");
            if (F.lane < 32) { const unsigned c = lh[F.lane]; lh[32 + F.lane] = c ? atomicAdd(&F.cnt()[l * 32 + F.lane], c) : 0u; }
            asm volatile("s_waitcnt vmcnt(0) lgkmcnt(0)" ::: "memory");
            const unsigned p1 = lh[32 + i1] + r1, p2 = lh[32 + i2] + r2;
            F.tokE()[row * 2] = i1; F.tokI()[row * 2] = (int)p1; F.tokW()[row * 2] = gwt * w1;
            F.tokE()[row * 2 + 1] = i2; F.tokI()[row * 2 + 1] = (int)p2; F.tokW()[row * 2 + 1] = gwt * w2v;
        }
        __syncthreads();
    }
}

__device__ __forceinline__ void phase_gather(Frame& F, int l) {
    int* off = (int*)F.smf; moe_offsets(F, l, off);
    const int nrows = (l == 0) ? NROW : NTOK;
    for (int sl = F.bid * NTHR + F.tid; sl < 2 * nrows; sl += F.nb * NTHR) { const int dst = off[F.tokE()[sl]] + F.tokI()[sl]; F.rmap()[dst] = sl; F.roww()[dst] = F.tokW()[sl]; }
    const int gw = F.bid * 8 + F.wave, ngw = F.nb * 8;
    for (int e = gw; e < 32; e += ngw) { const int c = (int)F.cnt()[l * 32 + e], pc = (c + 255) & ~255;
        for (int j = c + F.lane; j < pc; j += 64) { F.rmap()[off[e] + j] = -1; F.roww()[off[e] + j] = 0.f; } }
}
__device__ __forceinline__ int expert_of_row(const int* off, int row) { int e = 0;
#pragma unroll 1
    for (int i = 1; i < 32; ++i) if (row >= off[i]) e = i;
    return e; }

__device__ __forceinline__ void phase_ln2(Frame& F, int l) {
    const int gw = F.bid * 8 + F.wave, ngw = F.nb * 8, npairs = ((l == 0) ? NROW : NTOK) / 2;
    const float* lg = F.p.ln_g + (size_t)(l * 2 + 1) * DM; const float* lbb = F.p.ln_b + (size_t)(l * 2 + 1) * DM;
    const bf16_t* Y = F.BR();
    const bool tmo_set = (l == DEPTH - 1) && (__hip_atomic_load((unsigned*)(F.ws + WS_CTL) + XB_TMO, __ATOMIC_RELAXED, __HIP_MEMORY_SCOPE_AGENT) != 0u);
    for (int pi = gw; pi < npairs; pi += ngw) {
        const int row0 = pi * 2, rb = row_batch(row0);
        const float* xm = row0 < NTOK ? F.p.out + (size_t)row0 * DM : F.cxm() + (size_t)(row0 - NTOK) * DM;
        float* xo = row0 < NTOK ? F.p.out + (size_t)row0 * DM : F.cxo() + (size_t)(row0 - NTOK) * DM;
        const float* mv = F.modv() + ((size_t)l * 5 + rb) * 6144;
        u32x2 y0[2][4], y1[2][4]; f32x4 xv[2][4], m5[4];
#pragma unroll
        for (int j = 0; j < 4; ++j) { const int d = j * 256 + F.lane * 4; m5[j] = *(const f32x4*)(mv + 5 * 1024 + d);
#pragma unroll
            for (int q = 0; q < 2; ++q) { y0[q][j] = *(const u32x2*)(Y + (size_t)((row0 + q) * 2) * DM + d); y1[q][j] = *(const u32x2*)(Y + (size_t)((row0 + q) * 2 + 1) * DM + d); xv[q][j] = *(const f32x4*)(xm + (size_t)q * DM + d); } }
        f32x4 v[2][4]; float s[2] = {0.f, 0.f};
#pragma unroll
        for (int q = 0; q < 2; ++q)
#pragma unroll
            for (int j = 0; j < 4; ++j) { f32x4 y; y.x = __uint_as_float(y0[q][j].x << 16) + __uint_as_float(y1[q][j].x << 16); y.y = __uint_as_float(y0[q][j].x & 0xffff0000u) + __uint_as_float(y1[q][j].x & 0xffff0000u);
                y.z = __uint_as_float(y0[q][j].y << 16) + __uint_as_float(y1[q][j].y << 16); y.w = __uint_as_float(y0[q][j].y & 0xffff0000u) + __uint_as_float(y1[q][j].y & 0xffff0000u);
                v[q][j] = ALPHA * xv[q][j] + m5[j] * y; s[q] += (v[q][j].x + v[q][j].y) + (v[q][j].z + v[q][j].w); }
#pragma unroll
        for (int o = 1; o < 64; o <<= 1) { s[0] += __shfl_xor(s[0], o); s[1] += __shfl_xor(s[1], o); }
        float s2[2] = {0.f, 0.f};
#pragma unroll
        for (int q = 0; q < 2; ++q) { const float mean = s[q] * (1.f / DM);
#pragma unroll
            for (int j = 0; j < 4; ++j) { v[q][j] = v[q][j] - mean; s2[q] += (v[q][j].x * v[q][j].x + v[q][j].y * v[q][j].y) + (v[q][j].z * v[q][j].z + v[q][j].w * v[q][j].w); } }
#pragma unroll
        for (int o = 1; o < 64; o <<= 1) { s2[0] += __shfl_xor(s2[0], o); s2[1] += __shfl_xor(s2[1], o); }
        const float* mn = F.modv() + ((size_t)((l + 1 < DEPTH) ? l + 1 : l) * 5 + rb) * 6144;
#pragma unroll
        for (int j = 0; j < 4; ++j) { const int d = j * 256 + F.lane * 4;
            const f32x4 g4 = *(const f32x4*)(lg + d), b4 = *(const f32x4*)(lbb + d), m0 = *(const f32x4*)(mn + d), m1 = *(const f32x4*)(mn + 1024 + d);
#pragma unroll
            for (int q = 0; q < 2; ++q) { const float rstd = rsqrtf(s2[q] * (1.f / DM) + LN_EPS);
                f32x4 xn = v[q][j] * rstd * g4 + b4;
                if (tmo_set) xn = xn * __uint_as_float(0x7fc00000u);
                *(f32x4*)(xo + (size_t)q * DM + d) = xn;
                if (l + 1 < DEPTH) { const f32x4 h = xn * (1.f + m1) + m0; u32x2 o2; o2.x = pk2(h.x, h.y); o2.y = pk2(h.z, h.w); *(u32x2*)(F.HX() + (size_t)(row0 + q) * DM + d) = o2; } }
        }
    }
}

constexpr int CONV_LN1_LO = CONVA_IN;
constexpr int NPL = 13, NPH = 1 + DEPTH * NPL;
__global__ void __launch_bounds__(NTHR, 2) mega(Params p) {
    extern __shared__ __attribute__((aligned(16))) unsigned char smem[];
    Frame F; F.p = p; F.bid = blockIdx.x; F.nb = gridDim.x; F.tid = threadIdx.x; F.lane = threadIdx.x & 63; F.wave = threadIdx.x >> 6; F.wid_s = __builtin_amdgcn_readfirstlane(threadIdx.x >> 6);
    F.smf = (float*)(smem + LDS_STAGE);
    LAS unsigned char* stage = (LAS unsigned char*)smem + LDS_STAGE; int* offt = (int*)(smem + 64);
    unsigned char* ws = p.ws; F.ws = ws;

    if (threadIdx.x == 0) *(uint4*)smem = make_uint4(0u, 0u, 0u, 0u);
    __syncthreads();
    unsigned* barw = (unsigned*)(ws + WS_CTL);
    XcdBarrier bar; bar.bar = barw; bar.x = 0; bar.st = (volatile LAS unsigned*)smem;
    const bool multi = (p.ph_hi - p.ph_lo) > 1;
    if (multi) bar = xcd_barrier_post(barw, (volatile LAS unsigned*)smem);
    const int lo = p.ph_lo, hi = p.ph_hi;
#define IN(k) (lo <= (k) && (k) < hi)
#define SEAM(k) do { if (IN(k) && IN((k) + 1)) xcd_barrier(bar); else __syncthreads(); } while (0)

    if (IN(0)) { REFRESH(F); phase_mod(F); __syncthreads(); phase_conv_a(F, 0, F.bid * 8 + F.wave, F.nb * 8); }
    SEAM(0);
#pragma unroll 1
    for (int l = 0; l < DEPTH; ++l) {
        const int pb = 1 + l * NPL;
        const float* xlat = (l == 0) ? p.x : p.out; const float* xctx = (l == 0) ? p.ctx : F.cxo();
        const int Mrows = (l == 0) ? NROW : NTOK;
        if (l == 0) {
            if (IN(pb + 0)) { REFRESH(F); phase_prep(F, 0, p.x, p.ctx); }
            SEAM(pb + 0);
        }
        if (IN(pb + 1)) { REFRESH(F);
            float* rtab = (float*)(smem + LDS_ROPE);
            for (int e = F.tid; e < 1024; e += NTHR) { const int pp = e >> 4, i = e & 15; const float inv = powf(10000.f, -(float)i / 16.f), ang = (float)pp * inv; rtab[2 * e] = cosf(ang); rtab[2 * e + 1] = sinf(ang); }
            __syncthreads();
            pg::SchedG1 S{(const char*)F.HX(), (const char*)F.W1t(), (const char*)F.Wvt(), F.nb, F.bid}; pg::EpiG1 E{F.P1(), F.VT(), rtab, F.lb(), l};
            pg::gemm_phase(stage, DM, DM, DM, S, E);
        }
        SEAM(pb + 1);
        if (IN(pb + 2)) { REFRESH(F); phase_prescan(F, l); }
        SEAM(pb + 2);
        if (IN(pb + 3)) { REFRESH(F); phase_mix(F, l); }
        SEAM(pb + 3);
        if (IN(pb + 4)) { REFRESH(F); phase_prepad(F, l); }
        SEAM(pb + 4);
        if (IN(pb + 5)) { REFRESH(F);
            pg::SchedStatic S{(const char*)F.HX(), (const char*)F.Wgt(), (size_t)256 * DM * 2, (size_t)256 * DM * 2, Mrows / 256, NGATE / 256, F.nb, F.bid}; pg::EpiGate E{F.G()};
            pg::gemm_phase(stage, DM, DM, DM, S, E);
            __syncthreads();
            { const int nun = (Mrows / 256) * (NGATE / 256), ne = nun % F.nb, nw = (Mrows / 256) * (DM / 256);
              const bool later = nw > F.nb && 4 * (nw - F.nb) <= F.nb;
              phase_conv_b(F, l, (nun > F.nb && 2 * ne <= F.nb) ? ne : 0, later ? CONVB_MOE : 0, CONVB_MOE + CONVB_PROJ); }
        }
        SEAM(pb + 5);
        if (IN(pb + 6)) { REFRESH(F);
            pg::SchedMerge S{(const char*)F.BR(), (const char*)F.Wbrt(), (Mrows / 256) * 4, F.nb, F.bid}; pg::EpiMerge E{F.G(), F.HX(), (bf16_t*)(F.ws + WS_PM)};
            pg::gemm_phase(stage, 2048, 512, 512, S, E);
            if (S.split()) { REFRESH(F); phase_conv_b(F, l, (S.ntile - F.nb) * 4, 0, CONVB_MOE / 2); }
            if (S.split()) {
                xcd_barrier(bar);
                REFRESH(F);
                const bf16_t* pm = (const bf16_t*)(F.ws + WS_PM); bf16_t* mo = F.HX() + (size_t)NTOK * DM;
                for (int e = (F.bid * NTHR + F.tid) * 8; e < NCTX * DM; e += F.nb * NTHR * 8) {
                    u32x4 v[4];
#pragma unroll
                    for (int br = 0; br < 4; ++br) v[br] = *(const u32x4*)(pm + (size_t)br * NCTX * DM + e);
                    float a[8] = {0.f, 0.f, 0.f, 0.f, 0.f, 0.f, 0.f, 0.f};
#pragma unroll
                    for (int br = 0; br < 4; ++br) { const unsigned uu[4] = {v[br].x, v[br].y, v[br].z, v[br].w};
#pragma unroll
                        for (int j = 0; j < 4; ++j) { a[2 * j] += __uint_as_float(uu[j] << 16); a[2 * j + 1] += __uint_as_float(uu[j] & 0xffff0000u); } }
                    u32x4 o; o.x = pk2(a[0], a[1]); o.y = pk2(a[2], a[3]); o.z = pk2(a[4], a[5]); o.w = pk2(a[6], a[7]); *(u32x4*)(mo + e) = o;
                }
            }
        }
        SEAM(pb + 6);
        if (IN(pb + 7)) { REFRESH(F);
            pg::SchedStatic S{(const char*)F.HX(), (const char*)F.Woutt(), (size_t)256 * DM * 2, (size_t)256 * DM * 2, Mrows / 256, DM / 256, F.nb, F.bid};
            pg::EpiWout E{xlat, xctx, p.out, F.cxm(), F.modv() + (size_t)l * 5 * 6144};
            pg::gemm_phase(stage, DM, DM, DM, S, E);
            { const int nw = (Mrows / 256) * (DM / 256); if (nw > F.nb && 4 * (nw - F.nb) <= F.nb) { REFRESH(F); phase_conv_b(F, l, nw - F.nb, CONVB_MOE / 2, CONVB_MOE); } }
        }
        SEAM(pb + 7);
        const int nln = Mrows / 64, nln2 = nln > F.nb ? nln - F.nb : 0;
        const bool conv_in_ln1 = (l + 1 < DEPTH) && nln2 > 0 && 4 * nln2 <= F.nb;
        if (IN(pb + 8)) { REFRESH(F); phase_ln1(F, l);
            if (conv_in_ln1 && F.bid >= nln2) { __syncthreads(); REFRESH(F); phase_conv_a(F, l + 1, (F.bid - nln2) * 8 + F.wave, (F.nb - nln2) * 8, CONV_LN1_LO, CONVA_ITEMS); } }
        SEAM(pb + 8);
        if (IN(pb + 9)) { REFRESH(F); phase_gather(F, l); }
        SEAM(pb + 9);
        if (IN(pb + 10)) { REFRESH(F);
            moe_offsets(F, l, offt);
            pg::SchedMoeG S{(const char*)F.HX2(), (const char*)F.Wgu(), offt, F.rmap(), (size_t)512 * DM * 2, (size_t)256 * DM * 2, offt[32] / 256, 2, F.nb, F.bid};
            pg::EpiMoe1 E{F.HID(), F.roww()};
            pg::gemm_phase(stage, DM, DM, DM, S, E);
            if (l + 1 < DEPTH) {
                const int nun = (offt[32] / 256) * 2, nu2 = nun > F.nb ? min(nun - F.nb, F.nb) : 0;
                REFRESH(F);
                const int hi_a = conv_in_ln1 ? CONV_LN1_LO : CONVA_ITEMS;
                if (2 * nu2 <= F.nb) { if (F.bid >= nu2) phase_conv_a(F, l + 1, (F.bid - nu2) * 8 + F.wave, (F.nb - nu2) * 8, 0, hi_a); }
                else phase_conv_a(F, l + 1, F.bid * 8 + F.wave, F.nb * 8, 0, hi_a);
            }
        }
        SEAM(pb + 10);
        if (IN(pb + 11)) { REFRESH(F);
            moe_offsets(F, l, offt);
            pg::SchedMoe S{(const char*)F.HID(), (const char*)F.Wd(), offt, (size_t)256 * 256 * 2, (size_t)DM * 256 * 2, (size_t)256 * 256 * 2, offt[32] / 256, 4, F.nb, F.bid};
            pg::EpiMoe2 E{F.BR(), F.rmap(), (bf16_t*)(F.ws + WS_DUMP)};
            pg::gemm_phase(stage, 256, 256, 256, S, E);
        }
        SEAM(pb + 11);
        if (IN(pb + 12)) { REFRESH(F); phase_ln2(F, l); }
        SEAM(pb + 12);
    }
#undef IN
#undef SEAM
}

extern "C" void kernel_launch(void* const* d_in, const int* in_sizes, int n_in, void* d_out, int out_size, void* d_ws, size_t ws_size, hipStream_t stream) {
    static int grid = 0;
    if (grid == 0) {
        if (n_in != 23 || out_size != NTOK * DM || ws_size < WS_END) { fprintf(stderr, "kernel_launch: unexpected shapes (n_in %d out %d ws %zu need %zu)\n", n_in, out_size, ws_size, (size_t)WS_END); grid = -1; return; }
        int dev = 0, cus = 0;
        if (hipGetDevice(&dev) != hipSuccess || hipDeviceGetAttribute(&cus, hipDeviceAttributeMultiprocessorCount, dev) != hipSuccess) { grid = -1; return; }
        if (hipFuncSetAttribute((const void*)mega, hipFuncAttributeMaxDynamicSharedMemorySize, LDS_BYTES) != hipSuccess) { fprintf(stderr, "kernel_launch: hipFuncSetAttribute failed\n"); grid = -1; return; }
        int per_cu = 0;
        if (hipOccupancyMaxActiveBlocksPerMultiprocessor(&per_cu, (const void*)mega, NTHR, LDS_BYTES) != hipSuccess || per_cu < 1) fprintf(stderr, "kernel_launch: occupancy query reports %d blocks per CU\n", per_cu);
        (void)hipGetLastError();
        grid = cus >= 32 ? (cus & ~31) : cus;
    }
    if (grid < 0) return;
    (void)hipMemsetAsync((char*)d_ws + WS_CTL, 0, CTL_BYTES, stream);
    Params p; memset(&p, 0, sizeof(p));
    const float** pp = (const float**)&p;
    for (int i = 0; i < 23; ++i) pp[i] = (const float*)d_in[i];
    p.out = (float*)d_out; p.ws = (unsigned char*)d_ws;
    p.ph_lo = 0; p.ph_hi = NPH;
    hipLaunchKernelGGL(mega, dim3(grid), dim3(NTHR), LDS_BYTES, stream, p);
}
```

```cpp
#include <hip/hip_runtime.h>
#include <cstdio>
#include <cstdint>
#include <cstring>

typedef unsigned short bf16_t;
typedef float f32x4 __attribute__((ext_vector_type(4)));
typedef unsigned u32x4 __attribute__((ext_vector_type(4)));
typedef unsigned u32x2 __attribute__((ext_vector_type(2)));

constexpr int NB = 4, SEQ = 4096, LC = 256, DM = 1024, DEPTH = 2;
constexpr int NTOK = NB * SEQ, NCTX = NB * LC, NROW = NTOK + NCTX;
constexpr int DIN = 10528;
constexpr int O_AQ = 0, O_AK = 256, O_AV = 512, O_AG = 1024, O_ALR = 1536, O_BQ = 1568, O_BK = 2080, O_BV = 2592, O_CQ = 3104, O_CK = 3616,
              O_CV = 3744, O_DQ = 3872, O_DF = 4384, O_DI = 5408, O_DG = 5920, O_GATE = 6432;
constexpr int PC_AQ = 0, PC_AK = 256, PC_AV = 512, PC_BQ = 1024, PC_BK = 1536, PC_CQ = 2048, PC_CK = 2560, PC_ALR = 2688, PC_DQ = 2816,
              PC_DF = 3328, PC_DI = 4352, PC_AG = 4864, PC_DG = 5376, NP1 = 5888;
constexpr float QSCALE = 0.125f * 1.44269504089f;
constexpr int NVT = 768;
constexpr int NGATE = 4096;
constexpr int XS_ROWS = 43008;
constexpr float LN_EPS = 1e-5f;
constexpr float ALPHA = 1.41421356237f;

constexpr size_t al256(size_t x) { return (x + 255) & ~(size_t)255; }
constexpr size_t WS_CTL = 0;
constexpr size_t CTL_BYTES = 32768;
constexpr size_t CTL_CNT = 28672;
constexpr size_t WS_DUMP = WS_CTL + CTL_BYTES;
constexpr size_t WS_MODV = WS_DUMP + 4096;
constexpr size_t WS_LB = WS_MODV + al256((size_t)DEPTH * 5 * 6144 * 4);
constexpr size_t WS_TOKE = WS_LB + 4096;
constexpr size_t WS_TOKI = WS_TOKE + al256((size_t)2 * NROW * 4);
constexpr size_t WS_TOKW = WS_TOKI + al256((size_t)2 * NROW * 4);
constexpr size_t WS_RMAP = WS_TOKW + al256((size_t)2 * NROW * 4);
constexpr size_t WS_ROWW = WS_RMAP + al256((size_t)XS_ROWS * 4);
constexpr size_t WS_CXM = WS_ROWW + al256((size_t)XS_ROWS * 4);
constexpr size_t WS_CXO = WS_CXM + (size_t)NCTX * DM * 4;
static_assert((size_t)NCTX * NGATE * 2 <= 2 * (size_t)NCTX * DM * 4, "context gates must fit in CXM | CXO");
constexpr size_t WS_WTA = WS_CXO + (size_t)NCTX * DM * 4;
constexpr size_t WTA_W1 = 0;
constexpr size_t WTA_WV = WTA_W1 + (size_t)NP1 * DM * 2;
constexpr size_t WTA_WBR = WTA_WV + (size_t)NVT * DM * 2;
constexpr size_t WTA_WO = WTA_WBR + (size_t)4 * DM * 512 * 2;
constexpr size_t WTA_WG = WTA_WO + (size_t)DM * DM * 2;
constexpr size_t WTA_BYTES = WTA_WG + (size_t)NGATE * DM * 2;
constexpr size_t WS_SC1 = WS_WTA;
static_assert((size_t)NROW * 512 * 2 <= WTA_WG, "scan scratch must fit in front of the gate weights");
constexpr size_t WS_HX = WS_WTA + WTA_BYTES;
constexpr size_t WS_VT = WS_HX + (size_t)NROW * DM * 2;
constexpr size_t WS_OBA = WS_VT + (size_t)NVT * NROW * 2;
constexpr size_t WS_HX2 = WS_VT;
constexpr size_t WS_ODH = WS_OBA + (size_t)NROW * 512 * 2;
constexpr size_t WS_BR = WS_ODH + (size_t)NROW * 1024 * 2;
constexpr size_t WS_P1 = WS_BR + (size_t)NROW * 2048 * 2;
constexpr size_t WS_HID = WS_P1;
constexpr size_t WS_G = WS_P1;
constexpr size_t WS_WGU = WS_P1 + (size_t)NROW * NGATE * 2;
constexpr size_t WS_WD = WS_WGU + (size_t)32 * 512 * DM * 2;
constexpr size_t WS_PW = WS_P1 + ((size_t)64 << 20);
constexpr size_t WS_PM = WS_WD + (size_t)32 * DM * 256 * 2;
constexpr size_t WS_XS = WS_P1;
constexpr size_t WS_ESC = WS_P1 + (size_t)NROW * NP1 * 2;
constexpr size_t WS_END = WS_ESC + (size_t)32 * 68 * 384 * 4;
static_assert(WS_PM + (size_t)4 * NCTX * DM * 2 <= WS_ESC, "moe weights must fit in the P1 tail");
static_assert((size_t)XS_ROWS * DM * 2 <= (size_t)NROW * NGATE * 2, "XS must fit in the G region");
static_assert((size_t)NVT * NROW * 2 + (size_t)NROW * 512 * 2 >= (size_t)NROW * DM * 2, "HX2 alias");
static_assert(WS_END <= 434800000ull, "workspace budget");

constexpr int NTHR = 512;
constexpr int LDS_STAGE = 1024;
constexpr int LDS_ROPE = 1024 + 131072 + 1024;
constexpr int LDS_BYTES = 144 * 1024;

struct Params {
    const float *x, *c, *ctx, *c_ctx, *w_mod, *b_mod, *w_in, *gla_lr_w, *gla_lr_b, *hg_gamma, *na_rpb, *wa_sink, *w_branch, *w_out, *ln_g, *ln_b,
        *moe_w_group, *moe_b_group, *moe_w_expert, *moe_b_expert, *moe_w_gate, *moe_w_up, *moe_w_down;
    float* out;
    unsigned char* ws;
    int ph_lo, ph_hi;
};

__device__ __forceinline__ float bf2f(bf16_t b) { return __uint_as_float(((unsigned)b) << 16); }
__device__ __forceinline__ bf16_t f2bf(float f) { unsigned u = __float_as_uint(f); u += 0x7FFFu + ((u >> 16) & 1u); return (bf16_t)(u >> 16); }
typedef float f32x2_t __attribute__((ext_vector_type(2)));
typedef __bf16 bf16x2_t __attribute__((ext_vector_type(2)));
__device__ __forceinline__ unsigned pk2(float lo, float hi) {
    const f32x2_t v = {lo, hi}; const bf16x2_t b = __builtin_convertvector(v, bf16x2_t); return __builtin_bit_cast(unsigned, b); }
__device__ __forceinline__ void ld8(const bf16_t* p, float* f) {
    const u32x4 v = *(const u32x4*)p;
    f[0] = __uint_as_float(v.x << 16); f[1] = __uint_as_float(v.x & 0xffff0000u);
    f[2] = __uint_as_float(v.y << 16); f[3] = __uint_as_float(v.y & 0xffff0000u);
    f[4] = __uint_as_float(v.z << 16); f[5] = __uint_as_float(v.z & 0xffff0000u);
    f[6] = __uint_as_float(v.w << 16); f[7] = __uint_as_float(v.w & 0xffff0000u);
}
__device__ __forceinline__ void st8(bf16_t* p, const float* f) {
    u32x4 v; v.x = pk2(f[0], f[1]); v.y = pk2(f[2], f[3]); v.z = pk2(f[4], f[5]); v.w = pk2(f[6], f[7]);
    *(u32x4*)p = v;
}
__device__ __forceinline__ float sigmoidf_(float x) { return __builtin_amdgcn_rcpf(1.f + __expf(-x)); }
__device__ __forceinline__ float siluf_(float x) { return x * __builtin_amdgcn_rcpf(1.f + __expf(-x)); }
__device__ __forceinline__ float wave_sum(float v) {
#pragma unroll
    for (int o = 1; o < 64; o <<= 1) v += __shfl_xor(v, o);
    return v;
}
__device__ __forceinline__ int row_batch(int row) { return row < NTOK ? (row >> 12) : 4; }

#define XB_TMO      128
#define XB_XCNT(j)  (256  + 64 * (j))
#define XB_XSUB(j)  (1280 + 64 * (j))
#define XB_XGEN(j)  (2304 + 64 * (j))
#define XB_TOP      3328
#define XB_TOPGEN   3392
#define XCD_BAR_WORDS 3456
#define XB_SPIN_CAP (1u << 18)
#define LAS __attribute__((address_space(3)))
__device__ __forceinline__ unsigned xb_ld(unsigned* p)              { return __hip_atomic_load(p, __ATOMIC_RELAXED, __HIP_MEMORY_SCOPE_AGENT); }
__device__ __forceinline__ unsigned xb_add(unsigned* p, unsigned v) { return __hip_atomic_fetch_add(p, v, __ATOMIC_RELAXED, __HIP_MEMORY_SCOPE_AGENT); }
__device__ __forceinline__ unsigned xb_xcc_id() { return (unsigned)__builtin_amdgcn_s_getreg((3 << 11) | 20) & 0xFu; }
#define XB_SPIN(cond, bar) do { unsigned _sp = 0; while (cond) { __builtin_amdgcn_s_sleep(1); \
    if ((++_sp & 255u) == 0u) { if (xb_ld(&(bar)[XB_TMO])) break; if (_sp > XB_SPIN_CAP) { atomicAdd(&(bar)[XB_TMO], 1u); break; } } } } while (0)
struct XcdBarrier { unsigned* bar; unsigned x; volatile LAS unsigned* st; };
__device__ __forceinline__ XcdBarrier xcd_barrier_post(unsigned* bar, volatile LAS unsigned* st) {
    XcdBarrier b; b.bar = bar; b.x = xb_xcc_id(); b.st = st;
    if (threadIdx.x == 0) (void)xb_add(&bar[XB_XCNT(b.x)], 1u);
    return b;
}
__device__ __forceinline__ void xcd_barrier_complete(unsigned* bar, unsigned x, unsigned& nloc, unsigned& nx) {
    const unsigned G = gridDim.x * gridDim.y * gridDim.z;
    unsigned sum, cnt, mine, sp = 0u;
    for (;;) {
        sum = 0u; cnt = 0u; mine = 0u;
#pragma unroll
        for (unsigned j = 0; j < 16; ++j) { const unsigned c = xb_ld(&bar[XB_XCNT(j)]); sum += c; cnt += (c > 0u) ? 1u : 0u; mine = (j == x) ? c : mine; }
        if (sum == G) break;
        __builtin_amdgcn_s_sleep(1);
        if ((++sp & 255u) == 0u) { if (xb_ld(&bar[XB_TMO])) break; if (sp > XB_SPIN_CAP) { atomicAdd(&bar[XB_TMO], 1u); break; } }
    }
    nloc = mine > 0u ? mine : 1u; nx = cnt > 0u ? cnt : 1u;
}
__device__ __forceinline__ void xcd_barrier(const XcdBarrier& b) {
    asm volatile("s_waitcnt vmcnt(0)" ::: "memory");
    __syncthreads();
    if (threadIdx.x == 0) {
        unsigned* bar = b.bar;
        __builtin_amdgcn_s_waitcnt(0);
        unsigned nloc = b.st[0], nx = b.st[1];
        if (nloc == 0u) { xcd_barrier_complete(bar, b.x, nloc, nx); b.st[0] = nloc; b.st[1] = nx; }
        const unsigned old = xb_add(&bar[XB_XSUB(b.x)], 1u);
        const unsigned gen = old / nloc;
        if (old + 1u == (gen + 1u) * nloc) {
            __builtin_amdgcn_fence(__ATOMIC_RELEASE, "agent");
            asm volatile("s_waitcnt vmcnt(0)" ::: "memory");
            const unsigned og = xb_add(&bar[XB_TOP], 1u);
            const unsigned tg = og / nx;
            if (og + 1u == (tg + 1u) * nx) xb_add(&bar[XB_TOPGEN], 1u);
            else XB_SPIN(xb_ld(&bar[XB_TOPGEN]) == tg, bar);
            __builtin_amdgcn_fence(__ATOMIC_ACQUIRE, "agent");
            xb_add(&bar[XB_XGEN(b.x)], 1u);
            asm volatile("s_waitcnt vmcnt(0)" ::: "memory");
        } else {
            XB_SPIN(xb_ld(&bar[XB_XGEN(b.x)]) == gen, bar);
            __builtin_amdgcn_fence(__ATOMIC_ACQUIRE, "agent");
            asm volatile("s_waitcnt vmcnt(0)" ::: "memory");
        }
    }
    __syncthreads();
}

struct Frame {
    Params p;
    int bid, nb, tid, lane, wave, wid_s;
    float* smf;
    unsigned char* ws;
    __device__ __forceinline__ float* modv() const { return (float*)(ws + WS_MODV); }
    __device__ __forceinline__ float* lb() const { return (float*)(ws + WS_LB); }
    __device__ __forceinline__ int* tokE() const { return (int*)(ws + WS_TOKE); }
    __device__ __forceinline__ int* tokI() const { return (int*)(ws + WS_TOKI); }
    __device__ __forceinline__ float* tokW() const { return (float*)(ws + WS_TOKW); }
    __device__ __forceinline__ int* rmap() const { return (int*)(ws + WS_RMAP); }
    __device__ __forceinline__ float* roww() const { return (float*)(ws + WS_ROWW); }
    __device__ __forceinline__ float* cxm() const { return (float*)(ws + WS_CXM); }
    __device__ __forceinline__ float* cxo() const { return (float*)(ws + WS_CXO); }
    __device__ __forceinline__ bf16_t* W1t() const { return (bf16_t*)(ws + WS_WTA + WTA_W1); }
    __device__ __forceinline__ bf16_t* Wvt() const { return (bf16_t*)(ws + WS_WTA + WTA_WV); }
    __device__ __forceinline__ bf16_t* Wgt() const { return (bf16_t*)(ws + WS_WTA + WTA_WG); }
    __device__ __forceinline__ bf16_t* Wbrt() const { return (bf16_t*)(ws + WS_WTA + WTA_WBR); }
    __device__ __forceinline__ bf16_t* Woutt() const { return (bf16_t*)(ws + WS_WTA + WTA_WO); }
    __device__ __forceinline__ bf16_t* GC() const { return (bf16_t*)(ws + WS_CXM); }
    __device__ __forceinline__ bf16_t* SC1() const { return (bf16_t*)(ws + WS_SC1); }
    __device__ __forceinline__ float* ESC() const { return (float*)(ws + WS_ESC); }
    __device__ __forceinline__ bf16_t* HX() const { return (bf16_t*)(ws + WS_HX); }
    __device__ __forceinline__ bf16_t* VT() const { return (bf16_t*)(ws + WS_VT); }
    __device__ __forceinline__ bf16_t* OBA() const { return (bf16_t*)(ws + WS_OBA); }
    __device__ __forceinline__ bf16_t* HX2() const { return (bf16_t*)(ws + WS_HX2); }
    __device__ __forceinline__ bf16_t* HID() const { return (bf16_t*)(ws + WS_HID); }
    __device__ __forceinline__ bf16_t* ODH() const { return (bf16_t*)(ws + WS_ODH); }
    __device__ __forceinline__ bf16_t* BR() const { return (bf16_t*)(ws + WS_BR); }
    __device__ __forceinline__ bf16_t* P1() const { return (bf16_t*)(ws + WS_P1); }
    __device__ __forceinline__ bf16_t* G() const { return (bf16_t*)(ws + WS_G); }
    __device__ __forceinline__ bf16_t* Wgu() const { return (bf16_t*)(ws + WS_WGU); }
    __device__ __forceinline__ bf16_t* Wd() const { return (bf16_t*)(ws + WS_WD); }
    __device__ __forceinline__ bf16_t* XS() const { return (bf16_t*)(ws + WS_XS); }
    __device__ __forceinline__ unsigned* cnt() const { return (unsigned*)(ws + WS_CTL + CTL_CNT); }
};


#define REFRESH(F) do { int _t = threadIdx.x; asm volatile("" : "+v"(_t)); (F).tid = _t; (F).lane = _t & 63; (F).wave = _t >> 6; } while (0)

__device__ __forceinline__ void phase_mod(Frame& F) {
    float* sc = F.smf;
    float* red = F.smf + 5 * 1024;
    bool have = false;
    for (int it = F.bid; it < DEPTH * 96; it += F.nb) {
        if (!have) {
            for (int i = F.tid; i < 5 * 1024; i += NTHR) { const float v = (i < 4096) ? F.p.c[i] : F.p.c_ctx[i - 4096]; sc[i] = siluf_(v); }
            __syncthreads(); have = true;
        }
        const int l = it / 96, n0 = (it % 96) * 64, c4 = F.lane & 15, rs = F.lane >> 4, kb = F.wave * 128 + rs * 32;
        const float* w = F.p.w_mod + (size_t)l * DM * 6144 + n0 + 4 * c4;
        f32x4 a[5];
#pragma unroll
        for (int r = 0; r < 5; ++r) a[r] = (f32x4){0.f, 0.f, 0.f, 0.f};
#pragma unroll 1
        for (int k = kb; k < kb + 32; k += 16) {
            f32x4 wv[16];
#pragma unroll
            for (int j = 0; j < 16; ++j) wv[j] = *(const f32x4*)(w + (size_t)(k + j) * 6144);
#pragma unroll
            for (int j = 0; j < 16; ++j)
#pragma unroll
                for (int r = 0; r < 5; ++r) a[r] = a[r] + wv[j] * sc[r * 1024 + k + j];
        }
#pragma unroll
        for (int r = 0; r < 5; ++r) *(f32x4*)(red + ((F.wave * 4 + rs) * 5 + r) * 64 + 4 * c4) = a[r];
        __syncthreads();
        if (F.tid < 320) {
            const int r = F.tid >> 6, cc = F.tid & 63; float s2 = F.p.b_mod[l * 6144 + n0 + cc];
#pragma unroll
            for (int g = 0; g < 32; ++g) s2 += red[(g * 5 + r) * 64 + cc];
            F.modv()[((size_t)l * 5 + r) * 6144 + n0 + cc] = s2;
        }
        __syncthreads();
    }
    if (F.bid == F.nb - 1) {
        for (int i = F.tid; i < 1024; i += NTHR) { const int z = i >> 9, f = i & 511;
            const float g0 = F.p.hg_gamma[(z * DEPTH + 0) * 512 + f], g1 = F.p.hg_gamma[(z * DEPTH + 1) * 512 + f];
            F.lb()[i] = 1.f / (1.f + expf(g0 - g1)); }
    }
}

__device__ __forceinline__ int p1_src(int n, float& scale) {
    scale = 1.f;
    if (n < 256) { scale = 0.125f; return O_AQ + n; }
    if (n < 512) return O_AK + (n - 256);
    if (n < 1024) return O_AV + (n - 512);
    if (n < 1536) { scale = QSCALE; return O_BQ + (n - 1024); }
    if (n < 2048) return O_BK + (n - 1536);
    if (n < 2560) { scale = QSCALE; return O_CQ + (n - 2048); }
    if (n < 2688) return O_CK + (n - 2560);
    if (n < 2720) return O_ALR + (n - 2688);
    if (n < 2816) return -1;
    if (n < 3328) return O_DQ + (n - 2816);
    if (n < 4352) return O_DF + (n - 3328);
    if (n < 4864) return O_DI + (n - 4352);
    if (n < 5376) return O_AG + (n - 4864);
    return O_DG + (n - 5376);
}
__device__ __forceinline__ void conv_item(const float* src, int ldsrc, int srccol, float scale, bf16_t* dst, int K, int k0, float* scr, int lane, bool perm) {
    if (srccol >= 0) {
        float tv[32];
        const float* sp0 = src + (size_t)(k0 + (lane >> 5)) * ldsrc + srccol + (lane & 31);
#pragma unroll
        for (int i = 0; i < 32; ++i) tv[i] = sp0[(size_t)(2 * i) * ldsrc];
#pragma unroll
        for (int i = 0; i < 32; ++i) scr[(2 * i + (lane >> 5)) * 33 + (lane & 31)] = tv[i] * scale;
    } else {
#pragma unroll 8
        for (int i = 0; i < 32; ++i) { const int kk = 2 * i + (lane >> 5); scr[kk * 33 + (lane & 31)] = 0.f; }
    }
    asm volatile("s_waitcnt lgkmcnt(0)" ::: "memory");
    const int c = lane & 7;
#pragma unroll
    for (int j = 0; j < 4; ++j) { const int nn = (lane >> 3) + 8 * j; const float* sp = scr + (8 * c) * 33 + (perm ? (8 * ((nn & 15) >> 2) + 4 * (nn >> 4) + (nn & 3)) : nn);
        u32x4 o; o.x = pk2(sp[0 * 33], sp[1 * 33]); o.y = pk2(sp[2 * 33], sp[3 * 33]); o.z = pk2(sp[4 * 33], sp[5 * 33]); o.w = pk2(sp[6 * 33], sp[7 * 33]);
        *(u32x4*)(dst + (size_t)nn * K + 8 * c) = o; }
    asm volatile("s_waitcnt lgkmcnt(0)" ::: "memory");
}
constexpr int CONVA_W1 = (NP1 / 32) * 16;
constexpr int CONVA_ITEMS = CONVA_W1 + 384 + 2048;
constexpr int CONVA_IN = CONVA_W1 + 384;
__device__ __forceinline__ void phase_conv_a(Frame& F, int l, int gw, int ngw, int lo = 0, int hi = CONVA_ITEMS) {
    float* scr = F.smf + F.wave * (64 * 33);
    for (int it0 = lo + gw; it0 < hi; it0 += ngw) {
        int ti = it0;
        if (ti < CONVA_W1) { const int n0 = (ti >> 4) * 32, kt = ti & 15; float sc; const int sx = p1_src(n0, sc);
            conv_item(F.p.w_in + (size_t)l * DM * DIN, DIN, sx, sc, F.W1t() + (size_t)n0 * DM + kt * 64, DM, kt * 64, scr, F.lane, !(n0 >= 2048 && n0 < 2816)); continue; }
        ti -= CONVA_W1;
        if (ti < 384) { const int n0 = (ti >> 4) * 32, kt = ti & 15; const int sx = n0 < 512 ? O_BV + n0 : (n0 < 640 ? O_CV + (n0 - 512) : -1);
            conv_item(F.p.w_in + (size_t)l * DM * DIN, DIN, sx, 1.f, F.Wvt() + (size_t)n0 * DM + kt * 64, DM, kt * 64, scr, F.lane, false); continue; }
        ti -= 384;
        { const int n0 = (ti >> 4) * 32, kt = ti & 15;
          conv_item(F.p.w_in + (size_t)l * DM * DIN, DIN, O_GATE + n0, 1.f, F.Wgt() + (size_t)n0 * DM + kt * 64, DM, kt * 64, scr, F.lane, true); }
    }
}
constexpr int CONVB_MOE = 8192 + 4096, CONVB_PROJ = 1024 + 512;
__device__ __forceinline__ void phase_conv_b(Frame& F, int l, int n_skip, int lo, int hi) {
    float* scr = F.smf + F.wave * (64 * 33);
    if (F.bid < n_skip) return;
    const int gw = (F.bid - n_skip) * 8 + F.wave, ngw = (F.nb - n_skip) * 8;
    for (int it0 = lo + gw; it0 < hi; it0 += ngw) {
        int ti = it0;
        if (ti < 8192) { const int e = ti >> 8, r = ti & 255, n0 = (r >> 4) * 32, kt = r & 15, j = n0 >> 8, rr = n0 & 255; const bool isup = rr >= 128; const int cc = 128 * j + (rr & 127);
            const float* src = (isup ? F.p.moe_w_up : F.p.moe_w_gate) + (size_t)(l * 32 + e) * DM * 256;
            conv_item(src, 256, cc, 1.f, F.Wgu() + (size_t)e * 512 * DM + (size_t)n0 * DM + kt * 64, DM, kt * 64, scr, F.lane, true); continue; }
        ti -= 8192;
        if (ti < 4096) { const int e = ti >> 7, r = ti & 127, n0 = (r >> 2) * 32, kt = r & 3;
          conv_item(F.p.moe_w_down + (size_t)(l * 32 + e) * 256 * DM, DM, n0, 1.f, F.Wd() + (size_t)e * DM * 256 + (size_t)n0 * 256 + kt * 64, 256, kt * 64, scr, F.lane, true); continue; }
        ti -= 4096;
        if (ti < 1024) { const int i = ti >> 8, r = ti & 255, n0 = (r >> 3) * 32, kt = r & 7;
            conv_item(F.p.w_branch + (size_t)(l * 4 + i) * 512 * DM, DM, n0, 1.f, F.Wbrt() + (size_t)i * DM * 512 + (size_t)n0 * 512 + kt * 64, 512, kt * 64, scr, F.lane, true); continue; }
        ti -= 1024;
        { const int n0 = (ti >> 4) * 32, kt = ti & 15;
          conv_item(F.p.w_out + (size_t)l * DM * DM, DM, n0, 1.f, F.Woutt() + (size_t)n0 * DM + kt * 64, DM, kt * 64, scr, F.lane, false); }
    }
}

__device__ __forceinline__ void phase_prep(Frame& F, int l, const float* xlat, const float* xctx) {
    const int gw = F.bid * 8 + F.wave, ngw = F.nb * 8;
    for (int row = gw; row < NROW; row += ngw) {
        const float* xr = row < NTOK ? xlat + (size_t)row * DM : xctx + (size_t)(row - NTOK) * DM;
        const float* mv = F.modv() + ((size_t)l * 5 + row_batch(row)) * 6144;
#pragma unroll
        for (int j = 0; j < 4; ++j) { const int d = j * 256 + F.lane * 4;
            const f32x4 v = *(const f32x4*)(xr + d), m0 = *(const f32x4*)(mv + d), m1 = *(const f32x4*)(mv + 1024 + d);
            u32x2 o; o.x = pk2(v.x * (1.f + m1.x) + m0.x, v.y * (1.f + m1.y) + m0.y); o.y = pk2(v.z * (1.f + m1.z) + m0.z, v.w * (1.f + m1.w) + m0.w);
            *(u32x2*)(F.HX() + (size_t)row * DM + d) = o; }
    }
}


namespace pg {
typedef short bf16x8 __attribute__((ext_vector_type(8)));
constexpr int BM = 256, BK = 64, HALF = 128, HTB = HALF * BK * 2, STAGE_BYTES = 8 * HTB, NXCD = 8, WGM = 8;
__device__ __forceinline__ int lds_byte(int r, int c) { const int st = (r >> 4) * 2 + (c >> 5), rr = r & 15, cc = c & 31, ob = rr * 64 + cc * 2; return st * 1024 + (ob ^ (((ob >> 9) & 1) << 5)); }
__device__ __forceinline__ void stage_rc(int b, int& R, int& C) { const int st = b / 1024, sb = b % 1024, swz = sb ^ (((sb >> 9) & 1) << 5); R = (st >> 1) * 16 + swz / 64; C = (st & 1) * 32 + (swz % 64) / 2; }
struct Unit { const char* a; const char* b; int pm, pn, aux; };
__device__ __forceinline__ void static_map(int L, int nM, int nN, int& pm, int& pn) {
    const int nwg = nM * nN; int wgid = L; { const int q = nwg / NXCD, r = nwg % NXCD, xcd = wgid % NXCD, off = wgid / NXCD; wgid = (xcd < r ? xcd * (q + 1) : r * (q + 1) + (xcd - r) * q) + off; }
    const int nig = WGM * nN, gid = wgid / nig, fm = gid * WGM, gsz = (nM - fm) < WGM ? (nM - fm) : WGM;
    pm = fm + ((wgid % nig) % gsz); pn = (wgid % nig) / gsz;
}
template <class Epi, class Sched>
__device__ __forceinline__ void gemm_phase(LAS unsigned char* lds, const int lda, const int ldb, const int K, const Sched& S, const Epi& E) {
    int tid = threadIdx.x; asm volatile("" : "+v"(tid));
    const int wid = __builtin_amdgcn_readfirstlane(tid >> 6), lane = tid & 63, wr = wid >> 2, wc = wid & 3, fr = lane & 15, fq = lane >> 4;
    int nt = K / BK; asm volatile("" : "+s"(nt));
    constexpr bool GATHER = Sched::gather;
    unsigned voffA[2], voffB[2], vgA[2][2], vgN[2][2]; int RA_[2], CA_[2];
#pragma unroll
    for (int i = 0; i < 2; ++i) { int R, C; stage_rc(tid * 16 + i * 8192, R, C); voffA[i] = (unsigned)(R * lda + C) * 2u; voffB[i] = (unsigned)(R * ldb + C) * 2u; RA_[i] = R; CA_[i] = C;
        vgA[0][i] = vgA[1][i] = vgN[0][i] = vgN[1][i] = 0u; }
#define PG_GSET(vg, u) do { _Pragma("unroll") for (int _h = 0; _h < 2; ++_h) _Pragma("unroll") for (int _i = 0; _i < 2; ++_i) \
        vg[_h][_i] = (unsigned)S.rowidx((u).pm * BM + _h * HALF + RA_[_i]) * (unsigned)(lda * 2) + (unsigned)(CA_[_i] * 2); } while (0)
    const size_t kstep = (size_t)(BK * 2);
    const size_t hstepA = (size_t)HALF * lda * 2, hstepB = (size_t)HALF * ldb * 2;
    const unsigned ldsw = (unsigned)wid * 1024u;
    const int aoff = lds_byte(wr * 64 + fr, fq * 8), boff = lds_byte(wc * 32 + fr, fq * 8);
#define PG_SA(b, h) (((b) * 2 + (h)) * HTB)
#define PG_SB(b, h) ((4 + (b) * 2 + (h)) * HTB)
#define PG_STAGE(bufoff, gbase, voff) do { _Pragma("unroll") for (int _i = 0; _i < 2; ++_i) \
        __builtin_amdgcn_global_load_lds((const unsigned*)((const char*)(gbase) + (voff)[_i]), (LAS unsigned*)(lds + (bufoff) + ldsw + _i * 8192), 16, 0, 0); } while (0)
#define PG_STAGE_A(bufoff, base, h, nx) do { if (GATHER) { const unsigned _v[2] = {(nx) ? vgN[h][0] : vgA[h][0], (nx) ? vgN[h][1] : vgA[h][1]}; PG_STAGE(bufoff, base, _v); } \
        else { PG_STAGE(bufoff, (base) + (h) * hstepA, voffA); } } while (0)
#define PG_LDA(dst, b, h) do { _Pragma("unroll") for (int m = 0; m < 4; ++m) _Pragma("unroll") for (int k = 0; k < 2; ++k) dst[m][k] = *(const LAS bf16x8*)(lds + PG_SA(b, h) + aoff + m * 2048 + k * 1024); } while (0)
#define PG_LDB(dst, b, h) do { _Pragma("unroll") for (int n = 0; n < 2; ++n) _Pragma("unroll") for (int k = 0; k < 2; ++k) dst[n][k] = *(const LAS bf16x8*)(lds + PG_SB(b, h) + boff + n * 2048 + k * 1024); } while (0)
#define PG_MMA(ai, bj, At, Bt) do { __builtin_amdgcn_s_setprio(1); _Pragma("unroll") for (int m = 0; m < 4; ++m) _Pragma("unroll") for (int n = 0; n < 2; ++n) _Pragma("unroll") for (int k = 0; k < 2; ++k) \
        acc[ai][bj][m][n] = __builtin_amdgcn_mfma_f32_16x16x32_bf16(Bt[n][k], At[m][k], acc[ai][bj][m][n], 0, 0, 0); __builtin_amdgcn_s_setprio(0); } while (0)
#define PG_WAIT_V(n) asm volatile("s_waitcnt vmcnt(" #n ")" ::: "memory")
#define PG_WAIT_L(n) asm volatile("s_waitcnt lgkmcnt(" #n ")" ::: "memory")
#define PG_BAR __builtin_amdgcn_s_barrier()
#define PG_SCHED __builtin_amdgcn_sched_barrier(0)
    Unit cur, nxt; int ui = 0;
    if (!S.next(0, cur)) return;
    f32x4 acc[2][2][4][2];
#pragma unroll
    for (int a = 0; a < 2; ++a)
#pragma unroll
        for (int b = 0; b < 2; ++b)
#pragma unroll
            for (int m = 0; m < 4; ++m)
#pragma unroll
                for (int n = 0; n < 2; ++n) acc[a][b][m][n] = (f32x4){0.f, 0.f, 0.f, 0.f};
    bf16x8 At[4][2], B0[2][2], B1[2][2];
    const char* cA = cur.a; const char* cB = cur.b;
    if (GATHER) PG_GSET(vgA, cur);
    PG_STAGE(PG_SB(0, 0), cB, voffB); PG_STAGE_A(PG_SA(0, 0), cA, 0, false); PG_STAGE(PG_SB(0, 1), cB + hstepB, voffB); PG_STAGE_A(PG_SA(0, 1), cA, 1, false);
    if (wr == 1) PG_BAR;
    PG_WAIT_V(4); PG_BAR;
    PG_STAGE(PG_SB(1, 0), cB + kstep, voffB); PG_STAGE_A(PG_SA(1, 0), cA + kstep, 0, false); PG_STAGE(PG_SB(1, 1), cB + hstepB + kstep, voffB);
    PG_WAIT_V(6); PG_BAR;
    for (;;) {
        const bool has_next = S.next(ui + 1, nxt);
        const char* nA = has_next ? nxt.a : cA; const char* nB = has_next ? nxt.b : cB;
        if (GATHER) { if (has_next) PG_GSET(vgN, nxt); else { vgN[0][0] = vgA[0][0]; vgN[0][1] = vgA[0][1]; vgN[1][0] = vgA[1][0]; vgN[1][1] = vgA[1][1]; } }
        const int ntu = Sched::vark ? S.ktiles(cur, nt) : nt;
        for (int t = 0; t < ntu; t += 2) {
            const bool last = (t == ntu - 2);
            const char* a1 = cA + (size_t)(t + 1) * kstep;
            const char* a2 = last ? nA : cA + (size_t)(t + 2) * kstep; const char* b2 = last ? nB : cB + (size_t)(t + 2) * kstep;
            const char* a3 = a2 + kstep; const char* b3 = b2 + kstep;
            PG_LDB(B0, 0, 0); PG_SCHED; PG_LDA(At, 0, 0); PG_STAGE_A(PG_SA(1, 1), a1, 1, false);
            PG_WAIT_L(8); PG_BAR; PG_WAIT_L(0); PG_MMA(0, 0, At, B0); PG_BAR; PG_SCHED;
            PG_LDB(B1, 0, 1); PG_STAGE(PG_SB(0, 0), b2, voffB);
            PG_BAR; PG_WAIT_L(0); PG_MMA(0, 1, At, B1); PG_BAR;
            PG_LDA(At, 0, 1); PG_STAGE_A(PG_SA(0, 0), a2, 0, last);
            PG_BAR; PG_WAIT_L(0); PG_MMA(1, 0, At, B0); PG_BAR; PG_SCHED;
            PG_STAGE(PG_SB(0, 1), b2 + hstepB, voffB);
            PG_WAIT_V(6); PG_BAR; PG_MMA(1, 1, At, B1); PG_BAR;
            PG_LDB(B0, 1, 0); PG_SCHED; PG_LDA(At, 1, 0); PG_STAGE_A(PG_SA(0, 1), a2, 1, last);
            PG_WAIT_L(8); PG_BAR; PG_WAIT_L(0); PG_MMA(0, 0, At, B0); PG_BAR; PG_SCHED;
            PG_LDB(B1, 1, 1); PG_STAGE(PG_SB(1, 0), b3, voffB);
            PG_BAR; PG_WAIT_L(0); PG_MMA(0, 1, At, B1); PG_BAR;
            PG_LDA(At, 1, 1); PG_STAGE_A(PG_SA(1, 0), a3, 0, last);
            PG_BAR; PG_WAIT_L(0); PG_MMA(1, 0, At, B0); PG_BAR; PG_SCHED;
            PG_STAGE(PG_SB(1, 1), b3 + hstepB, voffB);
            PG_WAIT_V(6); PG_BAR; PG_MMA(1, 1, At, B1); PG_BAR;
        }
        E(acc, cur, wr, wc, fr, fq);
        if (!has_next) break;
#pragma unroll
        for (int a = 0; a < 2; ++a)
#pragma unroll
            for (int b = 0; b < 2; ++b)
#pragma unroll
                for (int m = 0; m < 4; ++m)
#pragma unroll
                    for (int n = 0; n < 2; ++n) acc[a][b][m][n] = (f32x4){0.f, 0.f, 0.f, 0.f};
        cur = nxt; cA = nA; cB = nB; ++ui;
        if (GATHER) { vgA[0][0] = vgN[0][0]; vgA[0][1] = vgN[0][1]; vgA[1][0] = vgN[1][0]; vgA[1][1] = vgN[1][1]; }
    }
    PG_WAIT_V(0);
    if (wr == 0) PG_BAR;
    PG_BAR;
#undef PG_SA
#undef PG_SB
#undef PG_STAGE
#undef PG_STAGE_A
#undef PG_GSET
#undef PG_LDA
#undef PG_LDB
#undef PG_MMA
#undef PG_WAIT_V
#undef PG_WAIT_L
#undef PG_BAR
#undef PG_SCHED
}

struct SchedG1 {
    static constexpr bool vark = false; __device__ __forceinline__ int ktiles(const Unit&, int n) const { return n; }
    static constexpr bool gather = false; __device__ __forceinline__ int rowidx(int) const { return 0; }
    const char *HX, *W1, *WV; int G, c;
    __device__ __forceinline__ bool next(int i, Unit& u) const {
        const int L = i * G + c, nmain = (NROW / 256) * (NP1 / 256);
        if (L < nmain) { static_map(L, NROW / 256, NP1 / 256, u.pm, u.pn); u.a = HX + (size_t)u.pm * 256 * DM * 2; u.b = W1 + (size_t)u.pn * 256 * DM * 2; u.aux = 0; return true; }
        const int idx = L - nmain; if (idx >= 3 * (NROW / 256)) return false;
        u.pm = idx % 3; u.pn = idx / 3; u.a = WV + (size_t)u.pm * 256 * DM * 2; u.b = HX + (size_t)u.pn * 256 * DM * 2; u.aux = 1; return true;
    }
};
__device__ __forceinline__ int xcd_perm(int c, int NJ) { const int x = c & 7, y = c >> 3; return NJ == 4 ? 4 * ((y >> 2) * 8 + x) + (y & 3) : 2 * ((y >> 1) * 8 + x) + (y & 1); }
struct SchedOne {
    static constexpr bool vark = false; __device__ __forceinline__ int ktiles(const Unit&, int n) const { return n; }
    static constexpr bool gather = false, a_nt = false; __device__ __forceinline__ int rowidx(int) const { return 0; }
    const char *a, *b; int pm, pn;
    __device__ __forceinline__ bool next(int i, Unit& u) const { if (i) return false; u.a = a; u.b = b; u.pm = pm; u.pn = pn; u.aux = 0; return true; }
};
struct SchedStatic {
    static constexpr bool vark = false; __device__ __forceinline__ int ktiles(const Unit&, int n) const { return n; }
    static constexpr bool gather = false; __device__ __forceinline__ int rowidx(int) const { return 0; }
    const char *A, *B; size_t tA, tB; int nM, nN, G, c;
    __device__ __forceinline__ bool next(int i, Unit& u) const {
        const int L = i * G + c; if (L >= nM * nN) return false;
        static_map(L, nM, nN, u.pm, u.pn); u.a = A + (size_t)u.pm * tA; u.b = B + (size_t)u.pn * tB; u.aux = 0; return true;
    }
};
struct SchedWout {
    static constexpr bool gather = false, a_nt = false, vark = true; __device__ __forceinline__ int rowidx(int) const { return 0; }
    const char *A, *B; size_t tA, tB; int nMl, nMc, nN, K, G, c;
    __device__ __forceinline__ bool split() const { return nMc > 0 && nMl * nN == G && nMc * nN * 4 <= G; }
    __device__ __forceinline__ int ktiles(const Unit& u, int n) const { return u.aux ? n / 4 : n; }
    __device__ __forceinline__ bool next(int i, Unit& u) const {
        if (!split()) { const int L = i * G + c; if (L >= (nMl + nMc) * nN) return false;
            static_map(L, nMl + nMc, nN, u.pm, u.pn); u.a = A + (size_t)u.pm * tA; u.b = B + (size_t)u.pn * tB; u.aux = 0; return true; }
        if (i == 0) { static_map(c, nMl, nN, u.pm, u.pn); u.a = A + (size_t)u.pm * tA; u.b = B + (size_t)u.pn * tB; u.aux = 0; return true; }
        if (i == 1 && c < nMc * nN * 4) { const int te = c >> 2, kq = c & 3; u.pm = nMl + te / nN; u.pn = te % nN;
            u.a = A + (size_t)u.pm * tA + (size_t)kq * (K / 4) * 2; u.b = B + (size_t)u.pn * tB + (size_t)kq * (K / 4) * 2; u.aux = 1 + kq; return true; }
        return false;
    }
};
struct SchedMerge {
    static constexpr bool vark = false; __device__ __forceinline__ int ktiles(const Unit&, int n) const { return n; }
    static constexpr bool gather = false; __device__ __forceinline__ int rowidx(int) const { return 0; }
    const char *BR, *W; int ntile, G, c;
    __device__ __forceinline__ bool split() const { return ntile > G && (ntile - G) * 4 <= G; }
    __device__ __forceinline__ bool next(int i, Unit& u) const {
        int t, br;
        if (split()) { if (i < 4) { t = c; br = i; u.aux = br; } else { if (i > 4 || c >= (ntile - G) * 4) return false; t = G + (c >> 2); br = c & 3; u.aux = 4 + br; } }
        else { t = c + (i >> 2) * G; if (t >= ntile) return false; br = i & 3; u.aux = br; }
        if (G == 256 && t < 256) t = xcd_perm(t, 4);
        u.pm = t >> 2; u.pn = t & 3;
        u.a = BR + (size_t)u.pm * 256 * 2048 * 2 + (size_t)br * 512 * 2; u.b = W + (size_t)br * DM * 512 * 2 + (size_t)u.pn * 256 * 512 * 2; return true;
    }
};
struct SchedMoeG {
    static constexpr bool vark = false; __device__ __forceinline__ int ktiles(const Unit&, int n) const { return n; }
    static constexpr bool gather = true;
    const char *A, *W; const int* off; const int* rmap; size_t wE, wT; int npan, NJ, G, c;
    __device__ __forceinline__ int rowidx(int slot) const { const int sl = rmap[slot]; return sl < 0 ? 0 : (sl >> 1); }
    __device__ __forceinline__ bool next(int i, Unit& u) const {
        const int L = i * G + ((G == 256 && (NJ == 2 || NJ == 4)) ? xcd_perm(c, NJ) : c); if (L >= npan * NJ) return false;
        const int p = L / NJ, j = L % NJ; int e = 0;
#pragma unroll 1
        for (int q = 1; q < 32; ++q) if (p * 256 >= off[q]) e = q;
        e = __builtin_amdgcn_readfirstlane(e);
        u.pm = p; u.pn = j; u.aux = e; u.a = A; u.b = W + (size_t)e * wE + (size_t)j * wT; return true;
    }
};
struct SchedMoe {
    static constexpr bool vark = false; __device__ __forceinline__ int ktiles(const Unit&, int n) const { return n; }
    static constexpr bool gather = false; __device__ __forceinline__ int rowidx(int) const { return 0; }
    const char *A, *W; const int* off; size_t tA, wE, wT; int npan, NJ, G, c;
    __device__ __forceinline__ bool next(int i, Unit& u) const {
        const int L = i * G + ((G == 256 && (NJ == 2 || NJ == 4)) ? xcd_perm(c, NJ) : c); if (L >= npan * NJ) return false;
        const int p = L / NJ, j = L % NJ; int e = 0;
#pragma unroll 1
        for (int q = 1; q < 32; ++q) if (p * 256 >= off[q]) e = q;
        e = __builtin_amdgcn_readfirstlane(e);
        u.pm = p; u.pn = j; u.aux = e; u.a = A + (size_t)p * tA; u.b = W + (size_t)e * wE + (size_t)j * wT; return true;
    }
};

#define PG_ROWCOL const int row0 = u.pm * BM + wr * 64 + fr, col0 = u.pn * BM + wc * 32 + 4 * fq
struct EpiG1 { bf16_t *P1, *VT; const float* rtab; const float* lbp; int layer;
    __device__ __forceinline__ void operator()(const f32x4 (&acc)[2][2][4][2], const Unit& u, int wr, int wc, int fr, int fq) const {
        const int row0 = u.pm * BM + wr * 64 + fr;
        if (u.aux || (u.pn >= 8 && u.pn <= 10)) {
            const int col0 = u.pn * BM + wc * 32 + 4 * fq; bf16_t* base = u.aux ? VT : P1; const size_t ld = u.aux ? (size_t)NROW : (size_t)NP1;
            const bool rope = !u.aux && (u.pm < NTOK / 256);
#pragma unroll
            for (int ai = 0; ai < 2; ++ai)
#pragma unroll
                for (int m = 0; m < 4; ++m) { const int r = row0 + ai * HALF + m * 16; bf16_t* rowp = base + (size_t)r * ld + col0;
#pragma unroll
                    for (int bj = 0; bj < 2; ++bj) {
                        f32x4 v0 = acc[ai][bj][m][0], v1 = acc[ai][bj][m][1];
                        if (rope && !(u.pn == 10 && bj == 1)) {
                            const int pos = r & (SEQ - 1), pp = (wc & 1) ? (pos & 63) : (pos >> 6); const float* tp = rtab + (pp * 16 + 4 * fq) * 2;
                            const f32x4 t0 = *(const f32x4*)tp, t1 = *(const f32x4*)(tp + 4);
                            const f32x4 a = v0, b = v1;
                            v0.x = a.x * t0.x - b.x * t0.y; v1.x = a.x * t0.y + b.x * t0.x; v0.y = a.y * t0.z - b.y * t0.w; v1.y = a.y * t0.w + b.y * t0.z;
                            v0.z = a.z * t1.x - b.z * t1.y; v1.z = a.z * t1.y + b.z * t1.x; v0.w = a.w * t1.z - b.w * t1.w; v1.w = a.w * t1.w + b.w * t1.z;
                        }
                        u32x2 o; o.x = pk2(v0.x, v0.y); o.y = pk2(v0.z, v0.w); *(u32x2*)(rowp + bj * HALF) = o;
                        o.x = pk2(v1.x, v1.y); o.y = pk2(v1.z, v1.w); *(u32x2*)(rowp + bj * HALF + 16) = o; } }
            return;
        }
        const int col0 = u.pn * BM + wc * 32 + 8 * fq;
        const int mode = (u.pn == 11 || u.pn == 12) ? 2 : ((u.pn >= 13 && u.pn <= 16) ? 3 : 0);
        if (mode == 3) {
            f32x4 lb4[2][2];
            const int z = (u.pn - 13) >> 1, cb = z * 512 + ((u.pn - 13) & 1) * 256 + wc * 32 + 8 * fq;
#pragma unroll
            for (int bj = 0; bj < 2; ++bj)
#pragma unroll
                for (int n = 0; n < 2; ++n) lb4[bj][n] = (layer == 0) ? (f32x4){0.f, 0.f, 0.f, 0.f} : *(const f32x4*)(lbp + cb + bj * HALF + 4 * n);
#pragma unroll
            for (int ai = 0; ai < 2; ++ai)
#pragma unroll
                for (int m = 0; m < 4; ++m) { bf16_t* rowp = P1 + (size_t)(row0 + ai * HALF + m * 16) * NP1 + col0;
#pragma unroll
                    for (int bj = 0; bj < 2; ++bj) { float gq[8];
#pragma unroll
                        for (int n = 0; n < 2; ++n)
#pragma unroll
                            for (int j = 0; j < 4; ++j) { const float f = acc[ai][bj][m][n][j], lb = lb4[bj][n][j]; const float t = __expf(-fabsf(f)), rr = __builtin_amdgcn_rcpf(1.f + t);
                                gq[4 * n + j] = __logf(fmaxf(lb + (1.f - lb) * ((f >= 0.f) ? rr : t * rr), 1e-37f)); }
                        u32x4 o; o.x = pk2(gq[0], gq[1]); o.y = pk2(gq[2], gq[3]); o.z = pk2(gq[4], gq[5]); o.w = pk2(gq[6], gq[7]); *(u32x4*)(rowp + bj * HALF) = o; } }
            return;
        }
#pragma unroll
        for (int ai = 0; ai < 2; ++ai)
#pragma unroll
            for (int m = 0; m < 4; ++m) { bf16_t* rowp = P1 + (size_t)(row0 + ai * HALF + m * 16) * NP1 + col0;
#pragma unroll
                for (int bj = 0; bj < 2; ++bj) {
                    f32x4 v0 = acc[ai][bj][m][0], v1 = acc[ai][bj][m][1];
                    if (mode == 2) {
#pragma unroll
                        for (int j = 0; j < 4; ++j) { v0[j] = v0[j] * __builtin_amdgcn_rcpf(1.f + __expf(-v0[j])); v1[j] = v1[j] * __builtin_amdgcn_rcpf(1.f + __expf(-v1[j])); }
                    }
                    u32x4 o; o.x = pk2(v0.x, v0.y); o.y = pk2(v0.z, v0.w); o.z = pk2(v1.x, v1.y); o.w = pk2(v1.z, v1.w); *(u32x4*)(rowp + bj * HALF) = o; } }
    }
};
#define PG_ROWCOL8 const int row0 = u.pm * BM + wr * 64 + fr, col0 = u.pn * BM + wc * 32 + 8 * fq
struct EpiGate { bf16_t* G;
    __device__ __forceinline__ void operator()(const f32x4 (&acc)[2][2][4][2], const Unit& u, int wr, int wc, int fr, int fq) const {
        PG_ROWCOL8;
#pragma unroll
        for (int ai = 0; ai < 2; ++ai)
#pragma unroll
            for (int m = 0; m < 4; ++m) { bf16_t* rowp = G + (size_t)(row0 + ai * HALF + m * 16) * NGATE + col0;
#pragma unroll
                for (int bj = 0; bj < 2; ++bj) { const f32x4 v0 = acc[ai][bj][m][0], v1 = acc[ai][bj][m][1]; u32x4 o;
                    o.x = pk2(sigmoidf_(v0.x), sigmoidf_(v0.y)); o.y = pk2(sigmoidf_(v0.z), sigmoidf_(v0.w)); o.z = pk2(sigmoidf_(v1.x), sigmoidf_(v1.y)); o.w = pk2(sigmoidf_(v1.z), sigmoidf_(v1.w));
                    __builtin_nontemporal_store(o, (u32x4*)(rowp + bj * HALF)); } }
    }
};
struct EpiMerge { const bf16_t* G; bf16_t* O; bf16_t* PM; const bf16_t* GC;
    __device__ __forceinline__ void operator()(const f32x4 (&acc)[2][2][4][2], const Unit& u, int wr, int wc, int fr, int fq) const {
        PG_ROWCOL8; const int br = u.aux & 3; const bool part = u.aux >= 4, rmw = !part && br != 0;
        bf16_t* const Ob = part ? PM + (size_t)br * NCTX * DM - (size_t)NTOK * DM : O;
#pragma unroll
        for (int ai = 0; ai < 2; ++ai) {
            u32x4 g4[4][2], o4[4][2];
#pragma unroll
            for (int m = 0; m < 4; ++m) { const size_t r = (size_t)(row0 + ai * HALF + m * 16); const bf16_t* gp = ((GC && r >= (size_t)NTOK) ? GC + (r - NTOK) * NGATE : G + r * NGATE) + br * 1024 + col0; const bf16_t* rowp = Ob + r * DM + col0;
#pragma unroll
                for (int bj = 0; bj < 2; ++bj) { g4[m][bj] = __builtin_nontemporal_load((const u32x4*)(gp + bj * HALF)); if (rmw) o4[m][bj] = *(const u32x4*)(rowp + bj * HALF); } }
#pragma unroll
            for (int m = 0; m < 4; ++m) { bf16_t* rowp = Ob + (size_t)(row0 + ai * HALF + m * 16) * DM + col0;
#pragma unroll
                for (int bj = 0; bj < 2; ++bj) { const f32x4 v0 = acc[ai][bj][m][0], v1 = acc[ai][bj][m][1]; const u32x4 gg = g4[m][bj];
                    float w[8] = {__uint_as_float(gg.x << 16) * v0.x, __uint_as_float(gg.x & 0xffff0000u) * v0.y, __uint_as_float(gg.y << 16) * v0.z, __uint_as_float(gg.y & 0xffff0000u) * v0.w,
                                  __uint_as_float(gg.z << 16) * v1.x, __uint_as_float(gg.z & 0xffff0000u) * v1.y, __uint_as_float(gg.w << 16) * v1.z, __uint_as_float(gg.w & 0xffff0000u) * v1.w};
                    if (rmw) { const u32x4 oo = o4[m][bj];
                        w[0] += __uint_as_float(oo.x << 16); w[1] += __uint_as_float(oo.x & 0xffff0000u); w[2] += __uint_as_float(oo.y << 16); w[3] += __uint_as_float(oo.y & 0xffff0000u);
                        w[4] += __uint_as_float(oo.z << 16); w[5] += __uint_as_float(oo.z & 0xffff0000u); w[6] += __uint_as_float(oo.w << 16); w[7] += __uint_as_float(oo.w & 0xffff0000u); }
                    u32x4 o; o.x = pk2(w[0], w[1]); o.y = pk2(w[2], w[3]); o.z = pk2(w[4], w[5]); o.w = pk2(w[6], w[7]); *(u32x4*)(rowp + bj * HALF) = o; } }
            asm volatile("" ::: "memory");
        }
    }
};
struct EpiWout { const float *xlat, *xctx; float *olat, *octx; const float* modl; float* pw;
    __device__ __forceinline__ void operator()(const f32x4 (&acc)[2][2][4][2], const Unit& u, int wr, int wc, int fr, int fq) const {
        PG_ROWCOL;
        if (u.aux) { float* sl = pw + (size_t)(u.aux - 1) * NCTX * DM - (size_t)NTOK * DM;
#pragma unroll
            for (int ai = 0; ai < 2; ++ai)
#pragma unroll
                for (int m = 0; m < 4; ++m) { const size_t o = (size_t)(row0 + ai * HALF + m * 16) * DM + col0;
#pragma unroll
                    for (int bj = 0; bj < 2; ++bj)
#pragma unroll
                        for (int n = 0; n < 2; ++n) *(f32x4*)(sl + o + bj * HALF + n * 16) = acc[ai][bj][m][n]; }
            return; }
        const bool lat = u.pm < NTOK / 256; const int rb = lat ? (u.pm >> 4) : 4;
        const float* xin = lat ? xlat : xctx - (size_t)NTOK * DM; float* xo = lat ? olat : octx - (size_t)NTOK * DM; const float* m2 = modl + (size_t)rb * 6144 + 2 * 1024 + col0;
        f32x4 mv[2][2];
#pragma unroll
        for (int bj = 0; bj < 2; ++bj)
#pragma unroll
            for (int n = 0; n < 2; ++n) mv[bj][n] = *(const f32x4*)(m2 + bj * HALF + n * 16);
#pragma unroll
        for (int aq = 0; aq < 4; ++aq) { const int ai = aq >> 1, m0 = (aq & 1) * 2;
            f32x4 xv[4][2][2];
#pragma unroll
            for (int m = m0; m < m0 + 2; ++m) { const size_t o = (size_t)(row0 + ai * HALF + m * 16) * DM + col0;
#pragma unroll
                for (int bj = 0; bj < 2; ++bj)
#pragma unroll
                    for (int n = 0; n < 2; ++n) xv[m][bj][n] = *(const f32x4*)(xin + o + bj * HALF + n * 16); }
#pragma unroll
            for (int m = m0; m < m0 + 2; ++m) { const size_t o = (size_t)(row0 + ai * HALF + m * 16) * DM + col0;
#pragma unroll
                for (int bj = 0; bj < 2; ++bj)
#pragma unroll
                    for (int n = 0; n < 2; ++n) *(f32x4*)(xo + o + bj * HALF + n * 16) = ALPHA * xv[m][bj][n] + mv[bj][n] * acc[ai][bj][m][n]; }
            asm volatile("" ::: "memory");
        }
    }
};
struct EpiMoe1 { bf16_t* HID; const float* roww;
    __device__ __forceinline__ void operator()(const f32x4 (&acc)[2][2][4][2], const Unit& u, int wr, int wc, int fr, int fq) const {
        const int row0 = u.pm * BM + wr * 64 + fr, hc0 = u.pn * 128 + wc * 32 + 8 * fq;
#pragma unroll
        for (int ai = 0; ai < 2; ++ai)
#pragma unroll
            for (int m = 0; m < 4; ++m) { const int r = row0 + ai * HALF + m * 16; const float w = roww[r];
                const f32x4 g0 = acc[ai][0][m][0], g1 = acc[ai][0][m][1], u0 = acc[ai][1][m][0], u1 = acc[ai][1][m][1]; u32x4 o;
                o.x = pk2(siluf_(g0.x) * u0.x * w, siluf_(g0.y) * u0.y * w); o.y = pk2(siluf_(g0.z) * u0.z * w, siluf_(g0.w) * u0.w * w);
                o.z = pk2(siluf_(g1.x) * u1.x * w, siluf_(g1.y) * u1.y * w); o.w = pk2(siluf_(g1.z) * u1.z * w, siluf_(g1.w) * u1.w * w);
                *(u32x4*)(HID + (size_t)r * 256 + hc0) = o; }
    }
};
struct EpiMoe2 { bf16_t* Y; const int* rmap; bf16_t* dump;
    __device__ __forceinline__ void operator()(const f32x4 (&acc)[2][2][4][2], const Unit& u, int wr, int wc, int fr, int fq) const {
        PG_ROWCOL8;
#pragma unroll
        for (int ai = 0; ai < 2; ++ai)
#pragma unroll
            for (int m = 0; m < 4; ++m) { const int s = rmap[row0 + ai * HALF + m * 16];
                bf16_t* rowp = (s >= 0 ? Y + (size_t)s * DM : dump) + col0;
#pragma unroll
                for (int bj = 0; bj < 2; ++bj) { const f32x4 v0 = acc[ai][bj][m][0], v1 = acc[ai][bj][m][1]; u32x4 o; o.x = pk2(v0.x, v0.y); o.y = pk2(v0.z, v0.w); o.z = pk2(v1.x, v1.y); o.w = pk2(v1.z, v1.w); *(u32x4*)(rowp + bj * HALF) = o; } }
    }
};
#undef PG_ROWCOL8
#undef PG_ROWCOL
}

__device__ __forceinline__ void moe_offsets(Frame& F, int l, int* off) {
    if (F.tid < 64) {
        int v = (F.tid < 32) ? (((int)F.cnt()[l * 32 + F.tid] + 255) & ~255) : 0;
#pragma unroll
        for (int o = 1; o < 32; o <<= 1) { const int t = __shfl_up(v, o); if ((F.tid & 63) >= o) v += t; }
        if (F.tid < 32) off[F.tid + 1] = v;
        if (F.tid == 0) off[0] = 0;
    }
    __syncthreads();
}

__device__ __forceinline__ void phase_rope(Frame& F) {
    float* tab = F.smf;
    for (int e = F.tid; e < 1024; e += NTHR) { const int pp = e >> 4, i = e & 15; const float inv = powf(10000.f, -(float)i / 16.f), ang = (float)pp * inv; tab[2 * e] = cosf(ang); tab[2 * e + 1] = sinf(ang); }
    __syncthreads();
    const size_t total = (size_t)NTOK * 320;
    for (size_t idx = (size_t)F.bid * NTHR + F.tid; idx < total; idx += (size_t)F.nb * NTHR) {
        const int row = (int)(idx / 320), r = (int)(idx % 320), h = r >> 5, half = (r >> 4) & 1, i = r & 15;
        const int pos = row & (SEQ - 1), pp = half ? (pos & 63) : (pos >> 6);
        const float cs = tab[2 * (pp * 16 + i)], sn = tab[2 * (pp * 16 + i) + 1];
        bf16_t* base = F.P1() + (size_t)row * NP1 + (h < 8 ? PC_CQ + h * 64 : PC_CK + (h - 8) * 64) + half * 32 + i;
        const float u1 = bf2f(base[0]), u2 = bf2f(base[16]);
        base[0] = f2bf(u1 * cs - u2 * sn); base[16] = f2bf(u1 * sn + u2 * cs);
    }
}

__device__ __forceinline__ int seq_row(int s, int b, int z) {
    if (s < LC) { const int tc = z ? (LC - 1 - s) : s; return NTOK + b * LC + tc; }
    const int tl = s - LC, t = z ? (SEQ - 1 - tl) : tl; return b * SEQ + t;
}
typedef short bf16x8_t __attribute__((ext_vector_type(8)));
typedef short bf16x4_t __attribute__((ext_vector_type(4)));
struct MaskNone { __device__ __forceinline__ void operator()(f32x4&, f32x4&) const {} };
struct MaskNA { const float* am8; const float* brow;
    __device__ __forceinline__ void operator()(f32x4& s0, f32x4& s1) const {
        float v[8] = {s0.x, s0.y, s0.z, s0.w, s1.x, s1.y, s1.z, s1.w};
#pragma unroll
        for (int T = 0; T < 2; ++T)
#pragma unroll
            for (int rr = 0; rr < 4; ++rr) v[T * 4 + rr] = (v[T * 4 + rr] + brow[16 * T + rr]) + am8[T * 4 + rr];
        s0 = (f32x4){v[0], v[1], v[2], v[3]}; s1 = (f32x4){v[4], v[5], v[6], v[7]};
    }
};
struct MaskWA { int i, j0;
    __device__ __forceinline__ void operator()(f32x4& s0, f32x4& s1) const {
        float v[8] = {s0.x, s0.y, s0.z, s0.w, s1.x, s1.y, s1.z, s1.w};
#pragma unroll
        for (int T = 0; T < 2; ++T)
#pragma unroll
            for (int rr = 0; rr < 4; ++rr) { const int j = j0 + 16 * T + rr; const bool ok = (j >= 0) && (j < SEQ) && (i - j <= 128) && (j - i <= 128);
                v[T * 4 + rr] = ok ? v[T * 4 + rr] : -INFINITY; }
        s0 = (f32x4){v[0], v[1], v[2], v[3]}; s1 = (f32x4){v[4], v[5], v[6], v[7]};
    }
};
struct KVF { bf16x8_t k[4]; bf16x4_t v[4][2]; };
__device__ __forceinline__ void kv_load(KVF& f, const char* kbase, unsigned ko0, unsigned ko1, const char* vbase, unsigned vo0, unsigned vo1) {
    f.k[0] = *(const bf16x8_t*)(kbase + ko0); f.k[1] = *(const bf16x8_t*)(kbase + ko0 + 64); f.k[2] = *(const bf16x8_t*)(kbase + ko1); f.k[3] = *(const bf16x8_t*)(kbase + ko1 + 64);
#pragma unroll
    for (int t = 0; t < 4; ++t) { f.v[t][0] = *(const bf16x4_t*)(vbase + vo0 + (unsigned)t * 16u * NROW * 2u); f.v[t][1] = *(const bf16x4_t*)(vbase + vo1 + (unsigned)t * 16u * NROW * 2u); }
}
__device__ __forceinline__ float xmax_g(float x) {
    auto r = __builtin_amdgcn_permlane16_swap(__float_as_uint(x), __float_as_uint(x), false, false); x = fmaxf(__uint_as_float(r[0]), __uint_as_float(r[1]));
    auto q = __builtin_amdgcn_permlane32_swap(__float_as_uint(x), __float_as_uint(x), false, false); return fmaxf(__uint_as_float(q[0]), __uint_as_float(q[1])); }
__device__ __forceinline__ float xsum_g(float x) {
    auto r = __builtin_amdgcn_permlane16_swap(__float_as_uint(x), __float_as_uint(x), false, false); x = __uint_as_float(r[0]) + __uint_as_float(r[1]);
    auto q = __builtin_amdgcn_permlane32_swap(__float_as_uint(x), __float_as_uint(x), false, false); return __uint_as_float(q[0]) + __uint_as_float(q[1]); }
constexpr float RESCALE_THR = 8.f;
template <class MaskF>
__device__ __forceinline__ void attn_tile(float& am, f32x4& asum, f32x4 (&ao)[4], const bf16x8_t (&qb)[2], const KVF& f, const MaskF& maskf, const bf16x8_t& ones) {
    f32x4 s0 = {0.f, 0.f, 0.f, 0.f}, s1 = {0.f, 0.f, 0.f, 0.f};
    s0 = __builtin_amdgcn_mfma_f32_16x16x32_bf16(f.k[0], qb[0], s0, 0, 0, 0); s0 = __builtin_amdgcn_mfma_f32_16x16x32_bf16(f.k[1], qb[1], s0, 0, 0, 0);
    s1 = __builtin_amdgcn_mfma_f32_16x16x32_bf16(f.k[2], qb[0], s1, 0, 0, 0); s1 = __builtin_amdgcn_mfma_f32_16x16x32_bf16(f.k[3], qb[1], s1, 0, 0, 0);
    maskf(s0, s1);
    f32x4 t0 = s0 - am, t1 = s1 - am;
    const float ml = fmaxf(fmaxf(fmaxf(t0.x, t0.y), fmaxf(t0.z, t0.w)), fmaxf(fmaxf(t1.x, t1.y), fmaxf(t1.z, t1.w)));
    if (__any(ml > RESCALE_THR)) {
        const float mr = fmaxf(fmaxf(fmaxf(s0.x, s0.y), fmaxf(s0.z, s0.w)), fmaxf(fmaxf(s1.x, s1.y), fmaxf(s1.z, s1.w)));
        const float mn = fmaxf(am, xmax_g(mr)), alpha = __builtin_amdgcn_exp2f(am - mn); am = mn; asum = asum * alpha;
#pragma unroll
        for (int t = 0; t < 4; ++t) ao[t] = ao[t] * alpha;
        t0 = s0 - am; t1 = s1 - am;
    }
    f32x4 p0, p1;
    p0.x = __builtin_amdgcn_exp2f(t0.x); p0.y = __builtin_amdgcn_exp2f(t0.y); p0.z = __builtin_amdgcn_exp2f(t0.z); p0.w = __builtin_amdgcn_exp2f(t0.w);
    p1.x = __builtin_amdgcn_exp2f(t1.x); p1.y = __builtin_amdgcn_exp2f(t1.y); p1.z = __builtin_amdgcn_exp2f(t1.z); p1.w = __builtin_amdgcn_exp2f(t1.w);
    union { bf16x8_t v; unsigned u[4]; } pb;
    pb.u[0] = pk2(p0.x, p0.y); pb.u[1] = pk2(p0.z, p0.w); pb.u[2] = pk2(p1.x, p1.y); pb.u[3] = pk2(p1.z, p1.w);
#pragma unroll
    for (int t = 0; t < 4; ++t) {
        union { bf16x8_t v; bf16x4_t h[2]; } av; av.h[0] = f.v[t][0]; av.h[1] = f.v[t][1];
        ao[t] = __builtin_amdgcn_mfma_f32_16x16x32_bf16(av.v, pb.v, ao[t], 0, 0, 0);
    }
    asum = __builtin_amdgcn_mfma_f32_16x16x32_bf16(ones, pb.v, asum, 0, 0, 0);
}
template <int kind>
__device__ __forceinline__ void attn_block(Frame& F, int l, int item, const float* rpb_s, bf16_t* sbuf) {
    constexpr int NQ = 2, NCS = 4, NLOC = (kind == 0) ? 11 : (kind == 1 ? 5 : 0), NS = NCS + NLOC, SROW = 72;
    const int tid = F.tid, lane = F.lane, n = lane & 15, g = lane >> 4, w = __builtin_amdgcn_readfirstlane(F.wave);
    const bf16_t* P1 = F.P1(); const bf16_t* VT = F.VT();
    int b, h0, kvh = 0, kcol, vrow, r = 0, cb = 0, t0 = 0, t0g = 0, r0 = 0, qrow0, qcol0, brcol0;
    constexpr int QRS = (kind == 0) ? 64 : (kind == 2 ? 16 : 0), QCS = (kind == 1 || kind == 3) ? 64 : 0;
    if (kind == 0) { const int rq = item & 15, hb = (item >> 4) & 7; b = item >> 7; r0 = 4 * rq; cb = w & 3; r = r0 + 2 * (w >> 2); h0 = hb; kcol = PC_BK + hb * 64; vrow = hb * 64;
        qrow0 = b * SEQ + r * 64 + cb * 16; qcol0 = PC_BQ + hb * 64; brcol0 = 512 + hb * 64; }
    else if (kind == 1) { const int qg = item & 63; kvh = (item >> 6) & 1; b = item >> 7; t0g = 64 * qg; t0 = t0g + 16 * (w & 3); h0 = kvh * 4 + 2 * (w >> 2); kcol = PC_CK + kvh * 64; vrow = 512 + kvh * 64;
        qrow0 = b * SEQ + t0; qcol0 = PC_CQ + h0 * 64; brcol0 = 1024 + h0 * 64; }
    else if (kind == 2) { const int hb = item & 7; b = item >> 3; h0 = hb; kcol = PC_BK + hb * 64; vrow = hb * 64; qrow0 = NTOK + b * LC + 32 * w; qcol0 = PC_BQ + hb * 64; brcol0 = 512 + hb * 64; }
    else { const int qh = item & 3; kvh = (item >> 2) & 1; b = item >> 3; h0 = kvh * 4 + 2 * (w >> 2); kcol = PC_CK + kvh * 64; vrow = 512 + kvh * 64;
        qrow0 = NTOK + b * LC + 16 * (4 * qh + (w & 3)); qcol0 = PC_CQ + h0 * 64; brcol0 = 1024 + h0 * 64; }
    bf16x8_t qb[NQ][2]; float am[NQ]; f32x4 asum[NQ], ao[NQ][4];
    float nam8[8];
    if (kind == 0) { const int c_ = (w & 3) * 16 + n, csq_ = min(max(c_ - 8, 0), 48), w0_ = ((w & 3) == 0) ? 0 : ((w & 3) == 1 ? 8 : ((w & 3) == 2 ? 24 : 32)), u0_ = w0_ + 4 * g - csq_;
#pragma unroll
        for (int k = 0; k < 8; ++k) nam8[k] = ((unsigned)(u0_ + 16 * (k >> 2) + (k & 3)) < 16u) ? 0.f : -INFINITY; }
    else {
#pragma unroll
        for (int k = 0; k < 8; ++k) nam8[k] = 0.f; }
    bf16x8_t ones8; { u32x4 o1 = {0x3f803f80u, 0x3f803f80u, 0x3f803f80u, 0x3f803f80u}; asm volatile("" : "+v"(o1)); ones8 = __builtin_bit_cast(bf16x8_t, o1); }
    { const char* qbase = (const char*)P1; const unsigned qo = (unsigned)(qrow0 + n) * (unsigned)(NP1 * 2) + (unsigned)(qcol0 + 8 * g) * 2u;
#pragma unroll
      for (int q = 0; q < NQ; ++q) { const unsigned o = qo + (unsigned)q * (unsigned)(QRS * NP1 * 2 + QCS * 2); qb[q][0] = *(const bf16x8_t*)(qbase + o); qb[q][1] = *(const bf16x8_t*)(qbase + o + 64);
        am[q] = -1e30f; asum[q] = (f32x4){0.f, 0.f, 0.f, 0.f};
#pragma unroll
        for (int t = 0; t < 4; ++t) ao[q][t] = (f32x4){0.f, 0.f, 0.f, 0.f}; } }
    const int crow0 = NTOK + b * LC, ru0 = min(max(r0 - 4, 0), 56);
    const int w0 = (cb == 0) ? 0 : (cb == 1 ? 8 : (cb == 2 ? 24 : 32));
    const int srow = tid >> 3, sch = tid & 7;
    const char* kbase = (const char*)P1; const char* vbase = (const char*)VT;
    u32x4 kr0 = {0u, 0u, 0u, 0u}, vr0 = kr0, kr1 = kr0, vr1 = kr0;
    auto stage_load = [&](int s, u32x4& kreg, u32x4& vreg) {
        int krow, vcol;
        if (s < NCS) { krow = crow0 + 64 * s + srow; vcol = crow0 + 64 * s + 8 * sch; }
        else if (kind == 0) { const int kr = min(ru0 + (s - NCS), 63); krow = b * SEQ + kr * 64 + srow; vcol = b * SEQ + kr * 64 + 8 * sch; }
        else { const int kb = t0g - 128 + 64 * (s - NCS); krow = b * SEQ + min(max(kb + srow, 0), SEQ - 1); vcol = b * SEQ + min(max(kb + 8 * sch, 0), SEQ - 8); }
        kreg = *(const u32x4*)(kbase + (unsigned)krow * (unsigned)(NP1 * 2) + (unsigned)(kcol * 2 + sch * 16));
        vreg = *(const u32x4*)(vbase + (unsigned)(vrow + srow) * (unsigned)(NROW * 2) + (unsigned)vcol * 2u);
    };
    auto stage_store = [&](int s, const u32x4& kreg, const u32x4& vreg) { bf16_t* Ks = sbuf + (s & 1) * (2 * 64 * SROW); bf16_t* Vs = Ks + 64 * SROW;
        *(u32x4*)(Ks + srow * SROW + sch * 8) = kreg; *(u32x4*)(Vs + srow * SROW + sch * 8) = vreg; };
    stage_load(0, kr1, vr1); stage_store(0, kr1, vr1); stage_load(1, kr0, vr0);
    __syncthreads();
    auto do_step = [&](int s, const u32x4& kst, const u32x4& vst, u32x4& kld, u32x4& vld) {
        if (s + 2 < NS) stage_load(s + 2, kld, vld);
#pragma unroll
        for (int hh = 0; hh < 2; ++hh) {
            bool act[NQ]; int kofs = 32 * hh;
            if (s < NCS) { act[0] = act[1] = true; }
            else if (kind == 0) { const int kr = ru0 + (s - NCS); kofs = w0;
#pragma unroll
                for (int q = 0; q < NQ; ++q) { const int rsq = min(max(r + q - 4, 0), 56); act[q] = (hh == 0) && (kr <= 63) && (kr >= rsq) && (kr <= rsq + 7); } }
            else { const int kb = t0g - 128 + 64 * (s - NCS) + 32 * hh; act[0] = act[1] = (kb + 31 >= t0 - 128) && (kb <= t0 + 143); }
            if (act[0] || act[1]) {
                const bf16_t* Ks = sbuf + (s & 1) * (2 * 64 * SROW); const bf16_t* Vs = Ks + 64 * SROW;
                KVF f;
                f.k[0] = *(const bf16x8_t*)(Ks + (kofs + n) * SROW + 8 * g); f.k[1] = *(const bf16x8_t*)(Ks + (kofs + n) * SROW + 32 + 8 * g);
                f.k[2] = *(const bf16x8_t*)(Ks + (kofs + 16 + n) * SROW + 8 * g); f.k[3] = *(const bf16x8_t*)(Ks + (kofs + 16 + n) * SROW + 32 + 8 * g);
#pragma unroll
                for (int t = 0; t < 4; ++t) { f.v[t][0] = *(const bf16x4_t*)(Vs + (16 * t + n) * SROW + kofs + 4 * g); f.v[t][1] = *(const bf16x4_t*)(Vs + (16 * t + n) * SROW + kofs + 16 + 4 * g); }
                if (s < NCS) {
#pragma unroll
                    for (int q = 0; q < NQ; ++q) attn_tile(am[q], asum[q], ao[q], qb[q], f, MaskNone(), ones8);
                } else if (kind == 0) { const int kr = ru0 + (s - NCS);
#pragma unroll
                    for (int q = 0; q < NQ; ++q) if (act[q]) { const int c = cb * 16 + n, csq = min(max(c - 8, 0), 48), kc0 = w0 + 4 * g;
                        MaskNA mk{nam8, rpb_s + (h0 * 15 + (kr - (r + q) + 7)) * 64 + (kc0 - c + 15 + 16)}; attn_tile(am[q], asum[q], ao[q], qb[q], f, mk, ones8); }
                } else if (kind == 1) { const int kb = t0g - 128 + 64 * (s - NCS) + 32 * hh;
                    if (kb >= t0 - 113 && kb + 31 <= t0 + 128 && kb >= 0 && kb + 31 < SEQ) {
#pragma unroll
                        for (int q = 0; q < NQ; ++q) attn_tile(am[q], asum[q], ao[q], qb[q], f, MaskNone(), ones8);
                    } else { MaskWA mk{t0 + n, kb + 4 * g};
#pragma unroll
                        for (int q = 0; q < NQ; ++q) attn_tile(am[q], asum[q], ao[q], qb[q], f, mk, ones8); }
                }
            }
        }
        if (s + 1 < NS) stage_store(s + 1, kst, vst);
        __syncthreads();
    };
#pragma unroll 1
    for (int s = 0; s < NS; s += 2) { do_step(s, kr0, vr0, kr1, vr1); if (s + 1 < NS) do_step(s + 1, kr1, vr1, kr0, vr0); }
#pragma unroll
    for (int q = 0; q < NQ; ++q) {
        float lt = asum[q].x;
        float osc = 1.f;
        if (kind == 1 || kind == 3) { const float sk = F.p.wa_sink[l * 8 + h0 + q] * 1.44269504089f, mf = fmaxf(am[q], sk); osc = __builtin_amdgcn_exp2f(am[q] - mf); lt = lt * osc + __builtin_amdgcn_exp2f(sk - mf); }
        const float inv = osc / lt;
        char* obase = (char*)F.BR(); const unsigned oo = (unsigned)(qrow0 + q * QRS + n) * 4096u + (unsigned)(brcol0 + q * QCS + 4 * g) * 2u;
#pragma unroll
        for (int t = 0; t < 4; ++t) { const f32x4 v = ao[q][t] * inv; u32x2 o2; o2.x = pk2(v.x, v.y); o2.y = pk2(v.z, v.w); *(u32x2*)(obase + oo + 32u * t) = o2; }
    }
}

template <int DK, bool HG>
__device__ __forceinline__ void prescan_combo(Frame& F, int l, int b, int h, int first, int step) {
    constexpr int NDP = DK / 2, NTG = NTHR / NDP, TPT = 64 / NTG, LGS = 66;
    REFRESH(F);
    const int tid = F.tid, dp = tid % NDP, tg = tid / NDP, lane = F.lane, n = lane & 15, g = lane >> 4, w = __builtin_amdgcn_readfirstlane(F.wave);
    float* TOT = F.smf;
    float* LGS_ = F.smf + 2 * 2 * NTG * DK;
    char* p1b = (char*)F.P1();
    bf16x8_t bw[HG ? 1 : 4]; f32x2_t lb2[2];
    lb2[0] = (f32x2_t){0.f, 0.f}; lb2[1] = lb2[0];
    if (!HG) {
        const int zw = w >> 2;
#pragma unroll
        for (int dt = 0; dt < 4; ++dt) { float wv[8];
#pragma unroll
            for (int j = 0; j < 8; ++j) { const float x = F.p.gla_lr_w[((size_t)(l * 2 + zw) * 16 + 8 * (g & 1) + j) * 256 + h * 64 + dt * 16 + n]; const float hi = __uint_as_float(pk2(x, x) << 16); wv[j] = (g < 2) ? x : x - hi; }
            union { bf16x8_t v; unsigned u[4]; } pb; pb.u[0] = pk2(wv[0], wv[1]); pb.u[1] = pk2(wv[2], wv[3]); pb.u[2] = pk2(wv[4], wv[5]); pb.u[3] = pk2(wv[6], wv[7]); bw[HG ? 0 : dt] = pb.v; }
#pragma unroll
        for (int z = 0; z < 2; ++z) { const float* bp = F.p.gla_lr_b + (l * 2 + z) * 256 + h * 64 + 2 * dp; lb2[z] = (f32x2_t){bp[0], bp[1]}; }
    }
    const int qcol = HG ? PC_DQ + h * 128 + 2 * dp : PC_AQ + h * 64 + 2 * dp, kcol = HG ? PC_DF + h * 128 + 2 * dp : PC_AK + h * 64 + 2 * dp;
    float* ebase = F.ESC() + (HG ? 32 * 68 * 128 : 0);
    unsigned rq[TPT], rk[TPT], rk1[HG ? TPT : 1]; u32x4 rlp = {0u, 0u, 0u, 0u};
    rk1[0] = 0u;
#define PS_LOAD(nbk_) do { const int row0_ = seq_row((nbk_) * 64, b, 0); unsigned o_ = (unsigned)(row0_ + tg * TPT) * (unsigned)(NP1 * 2); \
        _Pragma("unroll") for (int tt = 0; tt < TPT; ++tt) { rq[tt] = *(const unsigned*)(p1b + (o_ + (unsigned)(qcol * 2))); rk[tt] = *(const unsigned*)(p1b + (o_ + (unsigned)(kcol * 2))); \
            if (HG) rk1[HG ? tt : 0] = *(const unsigned*)(p1b + (o_ + (unsigned)((kcol + 512) * 2))); o_ += (unsigned)(NP1 * 2); } \
        if (!HG) rlp = *(const u32x4*)(p1b + ((unsigned)(row0_ + (w & 3) * 16 + n) * (unsigned)(NP1 * 2) + (unsigned)((PC_ALR + (w >> 2) * 16 + (g & 1) * 8) * 2))); } while (0)
    int nbk = first, par = 0;
    if (nbk < 68) PS_LOAD(nbk);
#pragma unroll 1
    for (; nbk < 68; nbk += step, par ^= 1) {
        float* tot = TOT + par * (2 * NTG * DK);
        if (!HG) {
            union { bf16x8_t v; u32x4 u; } af; af.u = rlp;
            float* lgw = LGS_ + ((w >> 2) * 64 + (w & 3) * 16 + 4 * g) * LGS + n;
#pragma unroll
            for (int dt = 0; dt < 4; ++dt) { const f32x4 d = __builtin_amdgcn_mfma_f32_16x16x32_bf16(af.v, bw[HG ? 0 : dt], (f32x4){0.f, 0.f, 0.f, 0.f}, 0, 0, 0);
                lgw[0 * LGS + dt * 16] = d.x; lgw[1 * LGS + dt * 16] = d.y; lgw[2 * LGS + dt * 16] = d.z; lgw[3 * LGS + dt * 16] = d.w; }
            __syncthreads();
        }
        const int row0 = seq_row(nbk * 64, b, 0);
        f32x2_t qv[TPT], kv0[TPT], kv1[HG ? TPT : 1], cs0[TPT], cs1[TPT];
#pragma unroll
        for (int tt = 0; tt < TPT; ++tt) {
            qv[tt] = (f32x2_t){__uint_as_float(rq[tt] << 16), __uint_as_float(rq[tt] & 0xffff0000u)};
            const f32x2_t kr = {__uint_as_float(rk[tt] << 16), __uint_as_float(rk[tt] & 0xffff0000u)};
            if (HG) { const unsigned r1 = rk1[HG ? tt : 0]; const f32x2_t k1 = {__uint_as_float(r1 << 16), __uint_as_float(r1 & 0xffff0000u)};
                cs0[tt] = kr; cs1[tt] = k1;
                kv0[tt] = (f32x2_t){1.f - __expf(kr.x), 1.f - __expf(kr.y)}; kv1[HG ? tt : 0] = (f32x2_t){1.f - __expf(k1.x), 1.f - __expf(k1.y)}; }
            else kv0[tt] = kr;
        }
        if (nbk + step < 68) PS_LOAD(nbk + step);
        if (!HG) {
#pragma unroll
            for (int tt = 0; tt < TPT; ++tt)
#pragma unroll
                for (int z = 0; z < 2; ++z) {
                    const f32x2_t lg = *(const f32x2_t*)(LGS_ + (z * 64 + tg * TPT + tt) * LGS + 2 * dp) + lb2[z];
                    const f32x2_t gz = {(fminf(lg.x, 0.f) - __logf(1.f + __expf(-fabsf(lg.x)))) * (1.f / 16.f), (fminf(lg.y, 0.f) - __logf(1.f + __expf(-fabsf(lg.y)))) * (1.f / 16.f)};
                    if (z == 0) cs0[tt] = gz; else cs1[tt] = gz; }
        }
#pragma unroll
        for (int tt = 1; tt < TPT; ++tt) { cs0[tt] += cs0[tt - 1]; cs1[TPT - 1 - tt] += cs1[TPT - tt]; }
        *(f32x2_t*)(tot + (0 * NTG + tg) * DK + 2 * dp) = cs0[TPT - 1];
        *(f32x2_t*)(tot + (1 * NTG + tg) * DK + 2 * dp) = cs1[0];
        __syncthreads();
        f32x2_t offs0 = {0.f, 0.f}, mid0 = offs0, last0 = offs0, offs1 = offs0, mid1 = offs0, last1 = offs0;
#pragma unroll
        for (int t2 = 0; t2 < NTG; ++t2) { const f32x2_t v0 = *(const f32x2_t*)(tot + (0 * NTG + t2) * DK + 2 * dp), v1 = *(const f32x2_t*)(tot + (1 * NTG + t2) * DK + 2 * dp);
            if (t2 < tg) offs0 += v0; if (t2 < NTG / 2) mid0 += v0; last0 += v0;
            if (t2 > tg) offs1 += v1; if (t2 >= NTG / 2) mid1 += v1; last1 += v1; }
        const f32x2_t d0 = offs0 - mid0, d1 = offs1 - mid1;
        unsigned ro = (unsigned)(row0 + tg * TPT);
#pragma unroll
        for (int tt = 0; tt < TPT; ++tt, ++ro) {
            const float x00 = fminf(fmaxf(cs0[tt].x + d0.x, -80.f), 80.f), x01 = fminf(fmaxf(cs0[tt].y + d0.y, -80.f), 80.f);
            const float x10 = fminf(fmaxf(cs1[tt].x + d1.x, -80.f), 80.f), x11 = fminf(fmaxf(cs1[tt].y + d1.y, -80.f), 80.f);
            const f32x2_t k1v = kv1[HG ? tt : 0], k1 = HG ? k1v : kv0[tt];
            const unsigned qd0 = pk2(qv[tt].x * __expf(x00), qv[tt].y * __expf(x01)), kd0 = pk2(kv0[tt].x * __expf(-x00), kv0[tt].y * __expf(-x01));
            const unsigned qd1 = pk2(qv[tt].x * __expf(x10), qv[tt].y * __expf(x11)), kd1 = pk2(k1.x * __expf(-x10), k1.y * __expf(-x11));
            const unsigned o_ = ro * (unsigned)(NP1 * 2);
            *(unsigned*)(p1b + (o_ + (unsigned)(qcol * 2))) = qd0; *(unsigned*)(p1b + (o_ + (unsigned)(kcol * 2))) = kd0;
            if (HG) { *(unsigned*)(p1b + (o_ + (unsigned)((kcol + 512) * 2))) = kd1; *(unsigned*)((char*)F.BR() + (ro * 4096u + (unsigned)((1536 + h * 128 + 2 * dp) * 2))) = qd1; }
            else { *(unsigned*)((char*)F.SC1() + (ro * 1024u + (unsigned)((h * 64 + 2 * dp) * 2))) = qd1; *(unsigned*)((char*)F.SC1() + (ro * 1024u + (unsigned)((256 + h * 64 + 2 * dp) * 2))) = kd1; }
        }
        if (tg == 0) {
            float* e0 = ebase + (size_t)(((b * 4 + h) * 2 + 0) * 68 + nbk) * (2 * DK), *e1 = ebase + (size_t)(((b * 4 + h) * 2 + 1) * 68 + (nbk < 4 ? 3 - nbk : 71 - nbk)) * (2 * DK);
            *(f32x2_t*)(e0 + 2 * dp) = (f32x2_t){__expf(mid0.x), __expf(mid0.y)}; *(f32x2_t*)(e0 + DK + 2 * dp) = (f32x2_t){__expf(last0.x - mid0.x), __expf(last0.y - mid0.y)};
            *(f32x2_t*)(e1 + 2 * dp) = (f32x2_t){__expf(mid1.x), __expf(mid1.y)}; *(f32x2_t*)(e1 + DK + 2 * dp) = (f32x2_t){__expf(last1.x - mid1.x), __expf(last1.y - mid1.y)};
        }
    }
    __syncthreads();
#undef PS_LOAD
}
__device__ __forceinline__ void phase_prescan(Frame& F, int l) {
    if (F.nb >= 32) { const int combo = F.bid & 31, b = (combo >> 2) & 3, h = combo & 3;
        if ((combo >> 4) == 0) prescan_combo<64, false>(F, l, b, h, F.bid >> 5, F.nb >> 5); else prescan_combo<128, true>(F, l, b, h, F.bid >> 5, F.nb >> 5);
    } else {
        for (int combo = F.bid; combo < 32; combo += F.nb) { const int b = (combo >> 2) & 3, h = combo & 3;
            if ((combo >> 4) == 0) prescan_combo<64, false>(F, l, b, h, 0, 1); else prescan_combo<128, true>(F, l, b, h, 0, 1); }
    }
}

template <int DK, bool HG>
__device__ __forceinline__ void scan_mfma(Frame& F, int l, int b, int h, int z, int vh, unsigned char* lds) {
    constexpr int NDP = DK / 2, NTG = NTHR / NDP, TPT = 64 / NTG, QS = DK + 8, TS = 72, NDT = DK / 16, PPR = DK / 8, NQP = (64 * PPR) / NTHR;
    bf16_t* QD = (bf16_t*)lds; bf16_t* KD = QD + 64 * QS; bf16_t* KDT = KD + 64 * QS; bf16_t* VTs = KDT + DK * TS; bf16_t* AM = VTs + 64 * TS; bf16_t* ST = AM + 64 * TS;
    float* E1s = (float*)(ST + 64 * QS); float* E2s = E1s + DK;
    REFRESH(F);
    const int tid = F.tid, lane = F.lane, w = F.wave, n = lane & 15, g = lane >> 4;
    const int dp = tid % NDP, tg = tid / NDP, vp = tid & 31, vg = tid >> 5;
    const int vt = w & 3, wh = w >> 2;
    const char* p1b = (const char*)F.P1();
    const char* qb; const char* kb; unsigned qstr, kstr, qoff, koff;
    if (HG) { kb = p1b; kstr = NP1 * 2; koff = (unsigned)((PC_DF + z * 512 + h * 128) * 2);
        if (z == 0) { qb = p1b; qstr = NP1 * 2; qoff = (unsigned)((PC_DQ + h * 128) * 2); } else { qb = (const char*)F.BR(); qstr = 4096u; qoff = (unsigned)((1536 + h * 128) * 2); } }
    else if (z == 0) { qb = p1b; kb = p1b; qstr = kstr = NP1 * 2; qoff = (unsigned)((PC_AQ + h * 64) * 2); koff = (unsigned)((PC_AK + h * 64) * 2); }
    else { qb = (const char*)F.SC1(); kb = qb; qstr = kstr = 1024u; qoff = (unsigned)(h * 64 * 2); koff = (unsigned)((256 + h * 64) * 2); }
    const float* eb = F.ESC() + (HG ? 32 * 68 * 128 : 0) + (size_t)(((b * 4 + h) * 2 + z) * 68) * (2 * DK);
    f32x4 accS[NDT / 2];
#pragma unroll
    for (int i = 0; i < NDT / 2; ++i) accS[i] = (f32x4){0.f, 0.f, 0.f, 0.f};
    u32x4 rqp[NQP]; unsigned rk[TPT], rv[4]; float re = 0.f;
    const int vcol = (HG ? PC_DI : PC_AV) + h * 128 + 64 * vh + 2 * vp;
    const int sgn = z ? -1 : 1; const int rstep = sgn * NP1 * 2;
#define SCAN_LOAD(c) do { const int row0_ = seq_row((c) * 64, b, z); \
        _Pragma("unroll") for (int j = 0; j < NQP; ++j) { const int pi_ = tid + NTHR * j; rqp[j] = *(const u32x4*)(qb + ((unsigned)(row0_ + sgn * (pi_ / PPR)) * qstr + qoff + (unsigned)((pi_ % PPR) * 16))); } \
        _Pragma("unroll") for (int tt = 0; tt < TPT; ++tt) rk[tt] = *(const unsigned*)(kb + ((unsigned)(row0_ + sgn * (tg * TPT + tt)) * kstr + koff + (unsigned)(dp * 4))); \
        int ov_ = (row0_ + sgn * vg * 4) * (NP1 * 2) + vcol * 2; \
        _Pragma("unroll") for (int tt = 0; tt < 4; ++tt) { rv[tt] = *(const unsigned*)(p1b + (unsigned)ov_); ov_ += rstep; } \
        if (tid < 2 * DK) re = eb[(c) * (2 * DK) + tid]; } while (0)
    SCAN_LOAD(0);
    constexpr int NCH = (LC + SEQ) / 64;
#pragma unroll 1
    for (int c = 0; c < NCH; ++c) {
        __syncthreads();
#pragma unroll
        for (int j = 0; j < NQP; ++j) { const int pi_ = tid + NTHR * j; *(u32x4*)(QD + (pi_ / PPR) * QS + (pi_ % PPR) * 8) = rqp[j]; }
#pragma unroll
        for (int tt = 0; tt < TPT; ++tt) *(unsigned*)(KD + (tg * TPT + tt) * QS + 2 * dp) = rk[tt];
        {   unsigned kdt[2][TPT / 2];
#pragma unroll
            for (int t2 = 0; t2 < TPT / 2; ++t2) { kdt[0][t2] = (rk[2 * t2] & 0xffffu) | (rk[2 * t2 + 1] << 16); kdt[1][t2] = (rk[2 * t2] >> 16) | (rk[2 * t2 + 1] & 0xffff0000u); }
#pragma unroll
            for (int e = 0; e < 2; ++e) {
                bf16_t* dst = KDT + (2 * dp + e) * TS + tg * TPT;
                if (TPT == 8) { u32x4 o; o.x = kdt[e][0]; o.y = kdt[e][1]; o.z = kdt[e][TPT / 2 - 2]; o.w = kdt[e][TPT / 2 - 1]; *(u32x4*)dst = o; }
                else { u32x2 o; o.x = kdt[e][0]; o.y = kdt[e][1]; *(u32x2*)dst = o; }
            }
        }
        if (tid < 2 * DK) E1s[tid] = re;
        {   u32x2 o0, o1;
            o0.x = (rv[0] & 0xffffu) | (rv[1] << 16); o0.y = (rv[2] & 0xffffu) | (rv[3] << 16);
            o1.x = (rv[0] >> 16) | (rv[1] & 0xffff0000u); o1.y = (rv[2] >> 16) | (rv[3] & 0xffff0000u);
            *(u32x2*)(VTs + (2 * vp) * TS + vg * 4) = o0; *(u32x2*)(VTs + (2 * vp + 1) * TS + vg * 4) = o1; }
        if (c + 1 < NCH) SCAN_LOAD(c + 1);
        __syncthreads();
#pragma unroll
        for (int i = 0; i < NDT / 2; ++i) { const int dt = wh * (NDT / 2) + i; accS[i] = accS[i] * *(const f32x4*)&E1s[16 * dt + 4 * g];
            u32x2 o; o.x = pk2(accS[i].x, accS[i].y); o.y = pk2(accS[i].z, accS[i].w); *(u32x2*)(ST + (16 * vt + n) * QS + 16 * dt + 4 * g) = o; }
        bf16x8_t qf[DK / 32];
        {   const int it = w >> 1, jt0 = 2 * (w & 1);
            f32x4 d0 = {0.f, 0.f, 0.f, 0.f}, d1 = {0.f, 0.f, 0.f, 0.f};
#pragma unroll
            for (int ks = 0; ks < DK / 32; ++ks) qf[ks] = *(const bf16x8_t*)(QD + (16 * it + n) * QS + 32 * ks + 8 * g);
            if (jt0 <= it) {
                bf16x8_t k0f[DK / 32], k1f[DK / 32];
#pragma unroll
                for (int ks = 0; ks < DK / 32; ++ks) { k0f[ks] = *(const bf16x8_t*)(KD + (16 * jt0 + n) * QS + 32 * ks + 8 * g); k1f[ks] = *(const bf16x8_t*)(KD + (16 * (jt0 + 1) + n) * QS + 32 * ks + 8 * g); }
#pragma unroll
                for (int ks = 0; ks < DK / 32; ++ks) { d0 = __builtin_amdgcn_mfma_f32_16x16x32_bf16(k0f[ks], qf[ks], d0, 0, 0, 0); d1 = __builtin_amdgcn_mfma_f32_16x16x32_bf16(k1f[ks], qf[ks], d1, 0, 0, 0); }
                const int i = 16 * it + n, j0 = 16 * jt0 + 4 * g, j1 = j0 + 16;
                d0.x = (j0 + 0 <= i) ? d0.x : 0.f; d0.y = (j0 + 1 <= i) ? d0.y : 0.f; d0.z = (j0 + 2 <= i) ? d0.z : 0.f; d0.w = (j0 + 3 <= i) ? d0.w : 0.f;
                d1.x = (j1 + 0 <= i) ? d1.x : 0.f; d1.y = (j1 + 1 <= i) ? d1.y : 0.f; d1.z = (j1 + 2 <= i) ? d1.z : 0.f; d1.w = (j1 + 3 <= i) ? d1.w : 0.f;
            }
            u32x2 o; o.x = pk2(d0.x, d0.y); o.y = pk2(d0.z, d0.w); *(u32x2*)(AM + (16 * it + n) * TS + 16 * jt0 + 4 * g) = o;
            o.x = pk2(d1.x, d1.y); o.y = pk2(d1.z, d1.w); *(u32x2*)(AM + (16 * it + n) * TS + 16 * (jt0 + 1) + 4 * g) = o;
        }
        __syncthreads();
        bf16x8_t vfr[2];
        {   const int it = w >> 1, vtx[2] = {vt, vt ^ 2};
            f32x4 o[2];
#pragma unroll
            for (int jj = 0; jj < 2; ++jj) o[jj] = (f32x4){0.f, 0.f, 0.f, 0.f};
#pragma unroll
            for (int ks = 0; ks < 2; ++ks) { const bf16x8_t bf = *(const bf16x8_t*)(AM + (16 * it + n) * TS + 32 * ks + 8 * g); bf16x8_t af[2];
#pragma unroll
                for (int jj = 0; jj < 2; ++jj) af[jj] = *(const bf16x8_t*)(VTs + (16 * vtx[jj] + n) * TS + 32 * ks + 8 * g);
                vfr[ks] = af[0];
#pragma unroll
                for (int jj = 0; jj < 2; ++jj) o[jj] = __builtin_amdgcn_mfma_f32_16x16x32_bf16(af[jj], bf, o[jj], 0, 0, 0); }
#pragma unroll
            for (int ks = 0; ks < DK / 32; ++ks) { bf16x8_t af[2];
#pragma unroll
                for (int jj = 0; jj < 2; ++jj) af[jj] = *(const bf16x8_t*)(ST + (16 * vtx[jj] + n) * QS + 32 * ks + 8 * g);
#pragma unroll
                for (int jj = 0; jj < 2; ++jj) o[jj] = __builtin_amdgcn_mfma_f32_16x16x32_bf16(af[jj], qf[ks], o[jj], 0, 0, 0); }
            const int row0 = seq_row(c * 64, b, z) + sgn * (16 * it + n);
            char* dstb; unsigned doff;
            if (HG) { dstb = (char*)F.ODH(); doff = (unsigned)row0 * 2048u + (unsigned)(z * 512 + h * 128 + 64 * vh + 4 * g) * 2u; }
            else if (z == 0) { dstb = (char*)F.BR(); doff = (unsigned)row0 * 4096u + (unsigned)(h * 128 + 64 * vh + 4 * g) * 2u; }
            else { dstb = (char*)F.OBA(); doff = (unsigned)row0 * 1024u + (unsigned)(h * 128 + 64 * vh + 4 * g) * 2u; }
#pragma unroll
            for (int jj = 0; jj < 2; ++jj) { u32x2 o2; o2.x = pk2(o[jj].x, o[jj].y); o2.y = pk2(o[jj].z, o[jj].w); *(u32x2*)(dstb + (doff + (unsigned)(16 * vtx[jj] * 2))) = o2; }
        }
#pragma unroll
        for (int ks = 0; ks < 2; ++ks) { const bf16x8_t bv = vfr[ks]; bf16x8_t af[NDT / 2];
#pragma unroll
            for (int i = 0; i < NDT / 2; ++i) af[i] = *(const bf16x8_t*)(KDT + (16 * (wh * (NDT / 2) + i) + n) * TS + 32 * ks + 8 * g);
#pragma unroll
            for (int i = 0; i < NDT / 2; ++i) accS[i] = __builtin_amdgcn_mfma_f32_16x16x32_bf16(af[i], bv, accS[i], 0, 0, 0); }
#pragma unroll
        for (int i = 0; i < NDT / 2; ++i) accS[i] = accS[i] * *(const f32x4*)&E2s[16 * (wh * (NDT / 2) + i) + 4 * g];
    }
    __syncthreads();
#undef SCAN_LOAD
}

__device__ __forceinline__ bool gate_ctx_in_mix(const Frame& F, int l) { return l == 0 && F.nb > 192; }
__device__ __forceinline__ void phase_mix(Frame& F, int l) {
    const int n_scan = 128;
    const int nsb = (F.nb > 192) ? 128 : 0;
    if (nsb == 0 || F.bid < nsb) {
        for (int it = F.bid; it < n_scan; it += (nsb ? nsb : F.nb)) {
            const int br = it >> 6, r = (it >> 1) & 31, vh = it & 1, b = r >> 3, h = (r >> 1) & 3, z = r & 1;
            if (br == 0) scan_mfma<64, false>(F, l, b, h, z, vh, (unsigned char*)F.smf); else scan_mfma<128, true>(F, l, b, h, z, vh, (unsigned char*)F.smf);
        }
        __syncthreads();
    }
    float* rpb_s = F.smf;
    bf16_t* sbuf = (bf16_t*)(F.smf + 8 * 15 * 64);
    unsigned* qhead = F.cnt() + 64 + l * 16;
    int* cur = (int*)((unsigned char*)F.smf - LDS_STAGE + 32);
    const int ngc = gate_ctx_in_mix(F, l) ? (NCTX / 256) * (NGATE / 256) : 0;
    const int n_wa = 512, n_na = 512, n_cna = (l == 0) ? 32 : 0, n_cwa = (l == 0) ? 32 : 0, total = n_wa + n_na + n_cna + n_cwa;
    bool have_tab = false;
    int nxt = 0;
    if (F.tid == 0) nxt = (int)atomicAdd(qhead, 1u);
    for (;;) {
        __syncthreads();
        if (F.tid == 0) *cur = nxt;
        __syncthreads();
        int it = *cur;
        if (it >= ngc + total) break;
        if (F.tid == 0) nxt = (int)atomicAdd(qhead, 1u);
        if (it < ngc) {
            const int pm = NTOK / 256 + it / (NGATE / 256), pn = it % (NGATE / 256);
            pg::SchedOne S{(const char*)F.HX() + (size_t)pm * 256 * DM * 2, (const char*)F.Wgt() + (size_t)pn * 256 * DM * 2, pm, pn};
            pg::EpiGate E{F.GC() - (size_t)NTOK * NGATE};
            pg::gemm_phase((LAS unsigned char*)F.smf, DM, DM, DM, S, E);
            REFRESH(F);
            continue;
        }
        it -= ngc;
        if (!have_tab) { have_tab = true;
            float tv[(8 * 15 * 64) / NTHR];
#pragma unroll
            for (int k = 0; k < (8 * 15 * 64) / NTHR; ++k) { const int i = F.tid + k * NTHR, dcp = i & 63, hr = i >> 6; tv[k] = (dcp >= 16 && dcp < 47) ? F.p.na_rpb[l * 8 * 465 + hr * 31 + (dcp - 16)] : 0.f; }
#pragma unroll
            for (int k = 0; k < (8 * 15 * 64) / NTHR; ++k) rpb_s[F.tid + k * NTHR] = tv[k] * 1.44269504089f; }
        if (it < n_wa) attn_block<1>(F, l, it, rpb_s, sbuf);
        else if (it < n_wa + n_na) attn_block<0>(F, l, it - n_wa, rpb_s, sbuf);
        else if (it < n_wa + n_na + n_cna) attn_block<2>(F, l, it - n_wa - n_na, rpb_s, sbuf);
        else attn_block<3>(F, l, it - n_wa - n_na - n_cna, rpb_s, sbuf);
    }
}

__device__ __forceinline__ void phase_prepad(Frame& F, int l) {
    const int gw = F.bid * 8 + F.wave, ngw = F.nb * 8, npairs = ((l == 0) ? NROW : NTOK) / 2, c0 = F.lane * 8;
    for (int pi = gw; pi < npairs; pi += ngw) {
        u32x4 ra[2][2], rb[2][2], rg[2][2];
#pragma unroll
        for (int q = 0; q < 2; ++q) { const size_t row = (size_t)pi * 2 + q;
            ra[q][0] = *(const u32x4*)(F.BR() + row * 2048 + c0); rb[q][0] = *(const u32x4*)(F.OBA() + row * 512 + c0); rg[q][0] = *(const u32x4*)(F.P1() + row * NP1 + PC_AG + c0);
            ra[q][1] = *(const u32x4*)(F.ODH() + row * 1024 + c0); rb[q][1] = *(const u32x4*)(F.ODH() + row * 1024 + 512 + c0); rg[q][1] = *(const u32x4*)(F.P1() + row * NP1 + PC_DG + c0); }
#pragma unroll
        for (int q = 0; q < 2; ++q)
#pragma unroll
            for (int br = 0; br < 2; ++br) {
                const unsigned ua[4] = {ra[q][br].x, ra[q][br].y, ra[q][br].z, ra[q][br].w}, ub[4] = {rb[q][br].x, rb[q][br].y, rb[q][br].z, rb[q][br].w}, ug[4] = {rg[q][br].x, rg[q][br].y, rg[q][br].z, rg[q][br].w};
                float o[8], g[8]; float ss = 0.f;
#pragma unroll
                for (int j = 0; j < 4; ++j) { o[2 * j] = __uint_as_float(ua[j] << 16) + __uint_as_float(ub[j] << 16); o[2 * j + 1] = __uint_as_float(ua[j] & 0xffff0000u) + __uint_as_float(ub[j] & 0xffff0000u);
                    g[2 * j] = __uint_as_float(ug[j] << 16); g[2 * j + 1] = __uint_as_float(ug[j] & 0xffff0000u); ss += o[2 * j] * o[2 * j] + o[2 * j + 1] * o[2 * j + 1]; }
                ss += __shfl_xor(ss, 1); ss += __shfl_xor(ss, 2); ss += __shfl_xor(ss, 4); ss += __shfl_xor(ss, 8);
                const float rs = rsqrtf(ss * (1.f / 128.f) + 1e-6f);
#pragma unroll
                for (int j = 0; j < 8; ++j) o[j] = o[j] * rs * siluf_(g[j]);
                st8(F.BR() + ((size_t)pi * 2 + q) * 2048 + (br ? 1536 : 0) + c0, o);
            }
    }
}

__device__ __forceinline__ void phase_ln1(Frame& F, int l) {
    const int nrows = (l == 0) ? NROW : NTOK, ngroups = nrows / 64;
    const bool wsplit = (l == 0) && (NTOK / 256) * (DM / 256) == F.nb && (NCTX / 256) * (DM / 256) * 4 <= F.nb;
    const int nsur = (ngroups > F.nb && 4 * (ngroups - F.nb) <= F.nb) ? ngroups - F.nb : 0, nfull = ngroups - nsur, nitems = nfull + 4 * nsur;
    const float* lg = F.p.ln_g + (size_t)(l * 2 + 0) * DM; const float* lbb = F.p.ln_b + (size_t)(l * 2 + 0) * DM;
    float* part = F.smf;
    const int wv = __builtin_amdgcn_readfirstlane(F.wave);
    float* stg = F.smf + 8 * 36 * 64 + wv * (64 * 17 + 16 * 40);
    float* wl = stg + 64 * 17;
    for (int item = F.bid; item < nitems; item += F.nb) {
        const int nr = item < nfull ? 64 : 16, rpw = nr >> 3, nmt = nr >> 4;
        const int row0 = item < nfull ? item * 64 : nfull * 64 + (item - nfull) * 16, rb = row_batch(row0);
        const float* mv = F.modv() + ((size_t)l * 5 + rb) * 6144;
        float* xg = row0 < NTOK ? F.p.out + (size_t)row0 * DM : F.cxm() + (size_t)(row0 - NTOK) * DM;
#pragma unroll 1
        for (int rr = 0; rr < rpw; rr += 2) {
            const int lr = wv * rpw + rr; float* xr = xg + (size_t)lr * DM;
            f32x4 v[2][4]; float s[2] = {0.f, 0.f};
            if (wsplit && row0 >= NTOK) {
                const float* pw = (const float*)(F.ws + WS_PW);
#pragma unroll
                for (int q = 0; q < 2; ++q)
#pragma unroll
                    for (int j = 0; j < 4; ++j) { const int d = j * 256 + F.lane * 4; const size_t ro = (size_t)(row0 - NTOK + lr + q) * DM + d;
                        const f32x4 p0 = *(const f32x4*)(pw + ro), p1 = *(const f32x4*)(pw + (size_t)NCTX * DM + ro), p2 = *(const f32x4*)(pw + (size_t)2 * NCTX * DM + ro), p3 = *(const f32x4*)(pw + (size_t)3 * NCTX * DM + ro);
                        const f32x4 xx = *(const f32x4*)(F.p.ctx + ro), m2 = *(const f32x4*)(mv + 2 * 1024 + d);
                        v[q][j] = ALPHA * xx + m2 * ((p0 + p1) + (p2 + p3)); }
            } else {
#pragma unroll
            for (int q = 0; q < 2; ++q)
#pragma unroll
                for (int j = 0; j < 4; ++j) v[q][j] = *(const f32x4*)(xr + (size_t)q * DM + j * 256 + F.lane * 4);
            }
#pragma unroll
            for (int q = 0; q < 2; ++q)
#pragma unroll
                for (int j = 0; j < 4; ++j) s[q] += (v[q][j].x + v[q][j].y) + (v[q][j].z + v[q][j].w);
#pragma unroll
            for (int o = 1; o < 64; o <<= 1) { s[0] += __shfl_xor(s[0], o); s[1] += __shfl_xor(s[1], o); }
            float s2[2] = {0.f, 0.f};
#pragma unroll
            for (int q = 0; q < 2; ++q) { const float mean = s[q] * (1.f / DM);
#pragma unroll
                for (int j = 0; j < 4; ++j) { v[q][j] = v[q][j] - mean; s2[q] += (v[q][j].x * v[q][j].x + v[q][j].y * v[q][j].y) + (v[q][j].z * v[q][j].z + v[q][j].w * v[q][j].w); } }
#pragma unroll
            for (int o = 1; o < 64; o <<= 1) { s2[0] += __shfl_xor(s2[0], o); s2[1] += __shfl_xor(s2[1], o); }
#pragma unroll
            for (int j = 0; j < 4; ++j) { const int d = j * 256 + F.lane * 4;
                const f32x4 g4 = *(const f32x4*)(lg + d), b4 = *(const f32x4*)(lbb + d), m3 = *(const f32x4*)(mv + 3 * 1024 + d), m4 = *(const f32x4*)(mv + 4 * 1024 + d);
#pragma unroll
                for (int q = 0; q < 2; ++q) { const float rstd = rsqrtf(s2[q] * (1.f / DM) + LN_EPS);
                    const f32x4 xn = v[q][j] * rstd * g4 + b4;
                    *(f32x4*)(xr + (size_t)q * DM + d) = xn;
                    const f32x4 h2 = xn * (1.f + m4) + m3;
                    u32x2 o2; o2.x = pk2(h2.x, h2.y); o2.y = pk2(h2.z, h2.w);
                    *(u32x2*)(F.HX2() + (size_t)(row0 + lr + q) * DM + d) = o2; } }
        }
        __syncthreads();
        {   f32x4 acc[4][3];
#pragma unroll
            for (int mt = 0; mt < 4; ++mt)
#pragma unroll
                for (int nt = 0; nt < 3; ++nt) acc[mt][nt] = (f32x4){0.f, 0.f, 0.f, 0.f};
            const float* wgp = F.p.moe_w_group + ((size_t)l * DM + wv * 128) * 4; const float* wep = F.p.moe_w_expert + ((size_t)l * DM + wv * 128) * 32;
            const float* m3p = mv + 3 * 1024 + wv * 128; const float* m4p = mv + 4 * 1024 + wv * 128;
            const int ln = F.lane & 15, lk = F.lane >> 4;
#pragma unroll 1
            for (int dc = 0; dc < 128; dc += 16) {
                f32x4 t[4]; float bw[4][3];
#pragma unroll
                for (int i = 0; i < 4; ++i) if (i < nmt) t[i] = *(const f32x4*)(xg + (size_t)(16 * i + (F.lane >> 2)) * DM + wv * 128 + dc + (F.lane & 3) * 4);
                const f32x4 m3v = *(const f32x4*)(m3p + dc + (F.lane & 3) * 4), m4v = *(const f32x4*)(m4p + dc + (F.lane & 3) * 4);
#pragma unroll
                for (int ks = 0; ks < 4; ++ks) { const int d = dc + 4 * ks + lk; bw[ks][0] = wep[(size_t)d * 32 + ln]; bw[ks][1] = wep[(size_t)d * 32 + 16 + ln]; bw[ks][2] = (ln < 4) ? wgp[(size_t)d * 4 + ln] : 0.f; }
#pragma unroll
                for (int i = 0; i < 4; ++i) if (i < nmt) { float* sp = stg + (16 * i + (F.lane >> 2)) * 17 + (F.lane & 3) * 4;
                    sp[0] = t[i].x * (1.f + m4v.x) + m3v.x; sp[1] = t[i].y * (1.f + m4v.y) + m3v.y; sp[2] = t[i].z * (1.f + m4v.z) + m3v.z; sp[3] = t[i].w * (1.f + m4v.w) + m3v.w; }
                asm volatile("s_waitcnt lgkmcnt(0)" ::: "memory");
#pragma unroll
                for (int ks = 0; ks < 4; ++ks)
#pragma unroll
                    for (int mt = 0; mt < 4; ++mt) if (mt < nmt) { const float av = stg[(16 * mt + ln) * 17 + 4 * ks + lk];
#pragma unroll
                        for (int nt = 0; nt < 3; ++nt) acc[mt][nt] = __builtin_amdgcn_mfma_f32_16x16x4f32(av, bw[ks][nt], acc[mt][nt], 0, 0, 0); }
                asm volatile("s_waitcnt lgkmcnt(0)" ::: "memory");
            }
#pragma unroll
            for (int mt = 0; mt < 4; ++mt)
#pragma unroll
                for (int nt = 0; nt < 3; ++nt) { const int oi = (nt == 2) ? ln : 4 + 16 * nt + ln;
                    if ((nt < 2 || ln < 4) && mt < nmt) {
#pragma unroll
                        for (int r = 0; r < 4; ++r) part[(wv * 36 + oi) * 64 + 16 * mt + 4 * lk + r] = acc[mt][nt][r]; } }
        }
        __syncthreads();
        if (wv == 0) {
            const bool lon = F.lane < nr;
            const int row = row0 + (lon ? F.lane : 0);
            float gl[4]; int gi = 0; float gm = -3.4e38f;
#pragma unroll
            for (int o = 0; o < 4; ++o) { float t = F.p.moe_b_group[l * 4 + o];
#pragma unroll
                for (int w2 = 0; w2 < 8; ++w2) t += part[(w2 * 36 + o) * 64 + F.lane];
                gl[o] = t; if (t > gm) { gm = t; gi = o; } }
            float gs = 0.f;
#pragma unroll
            for (int o = 0; o < 4; ++o) gs += expf(gl[o] - gm);
            const float gwt = 1.f / gs;
            float e1 = -3.4e38f, e2 = -3.4e38f; int i1 = 0, i2 = 0;
#pragma unroll
            for (int o8 = 0; o8 < 8; ++o8) { const int o = gi * 8 + o8; float ev = F.p.moe_b_expert[l * 32 + o];
#pragma unroll
                for (int w2 = 0; w2 < 8; ++w2) ev += part[(w2 * 36 + 4 + o) * 64 + F.lane];
                if (ev > e1) { e2 = e1; i2 = i1; e1 = ev; i1 = o; } else if (ev > e2) { e2 = ev; i2 = o; } }
            const float w1 = 1.f / (1.f + expf(e2 - e1)), w2v = 1.f - w1;
            unsigned* lh = (unsigned*)(stg + 64 * 17 + 16 * 40 - 64);
            if (F.lane < 32) lh[F.lane] = 0u;
            asm volatile("s_waitcnt lgkmcnt(0)" ::: "memory");
            unsigned r1 = 0u, r2 = 0u; if (lon) { r1 = atomicAdd(&lh[i1], 1u); r2 = atomicAdd(&lh[i2], 1u); }
            asm volatile("s_waitcnt lgkmcnt(0)" ::: "memory");
            if (F.lane < 32) { const unsigned c = lh[F.lane]; lh[32 + F.lane] = c ? atomicAdd(&F.cnt()[l * 32 + F.lane], c) : 0u; }
            asm volatile("s_waitcnt vmcnt(0) lgkmcnt(0)" ::: "memory");
            const unsigned p1 = lh[32 + i1] + r1, p2 = lh[32 + i2] + r2;
            if (lon) { F.tokE()[row * 2] = i1; F.tokI()[row * 2] = (int)p1; F.tokW()[row * 2] = gwt * w1;
                F.tokE()[row * 2 + 1] = i2; F.tokI()[row * 2 + 1] = (int)p2; F.tokW()[row * 2 + 1] = gwt * w2v; }
        }
        __syncthreads();
    }
}

__device__ __forceinline__ void phase_gather(Frame& F, int l) {
    int* off = (int*)F.smf; moe_offsets(F, l, off);
    const int nrows = (l == 0) ? NROW : NTOK;
    for (int sl = F.bid * NTHR + F.tid; sl < 2 * nrows; sl += F.nb * NTHR) { const int dst = off[F.tokE()[sl]] + F.tokI()[sl]; F.rmap()[dst] = sl; F.roww()[dst] = F.tokW()[sl]; }
    const int gw = F.bid * 8 + F.wave, ngw = F.nb * 8;
    for (int e = gw; e < 32; e += ngw) { const int c = (int)F.cnt()[l * 32 + e], pc = (c + 255) & ~255;
        for (int j = c + F.lane; j < pc; j += 64) { F.rmap()[off[e] + j] = -1; F.roww()[off[e] + j] = 0.f; } }
}
__device__ __forceinline__ int expert_of_row(const int* off, int row) { int e = 0;
#pragma unroll 1
    for (int i = 1; i < 32; ++i) if (row >= off[i]) e = i;
    return e; }

__device__ __forceinline__ void phase_ln2(Frame& F, int l) {
    const int gw = F.bid * 8 + F.wave, ngw = F.nb * 8, npairs = ((l == 0) ? NROW : NTOK) / 2;
    const float* lg = F.p.ln_g + (size_t)(l * 2 + 1) * DM; const float* lbb = F.p.ln_b + (size_t)(l * 2 + 1) * DM;
    const bf16_t* Y = F.BR();
    const bool tmo_set = (l == DEPTH - 1) && (__hip_atomic_load((unsigned*)(F.ws + WS_CTL) + XB_TMO, __ATOMIC_RELAXED, __HIP_MEMORY_SCOPE_AGENT) != 0u);
    for (int pi = gw; pi < npairs; pi += ngw) {
        const int row0 = pi * 2, rb = row_batch(row0);
        const float* xm = row0 < NTOK ? F.p.out + (size_t)row0 * DM : F.cxm() + (size_t)(row0 - NTOK) * DM;
        float* xo = row0 < NTOK ? F.p.out + (size_t)row0 * DM : F.cxo() + (size_t)(row0 - NTOK) * DM;
        const float* mv = F.modv() + ((size_t)l * 5 + rb) * 6144;
        u32x2 y0[2][4], y1[2][4]; f32x4 xv[2][4], m5[4];
#pragma unroll
        for (int j = 0; j < 4; ++j) { const int d = j * 256 + F.lane * 4; m5[j] = *(const f32x4*)(mv + 5 * 1024 + d);
#pragma unroll
            for (int q = 0; q < 2; ++q) { y0[q][j] = *(const u32x2*)(Y + (size_t)((row0 + q) * 2) * DM + d); y1[q][j] = *(const u32x2*)(Y + (size_t)((row0 + q) * 2 + 1) * DM + d); xv[q][j] = *(const f32x4*)(xm + (size_t)q * DM + d); } }
        f32x4 v[2][4]; float s[2] = {0.f, 0.f};
#pragma unroll
        for (int q = 0; q < 2; ++q)
#pragma unroll
            for (int j = 0; j < 4; ++j) { f32x4 y; y.x = __uint_as_float(y0[q][j].x << 16) + __uint_as_float(y1[q][j].x << 16); y.y = __uint_as_float(y0[q][j].x & 0xffff0000u) + __uint_as_float(y1[q][j].x & 0xffff0000u);
                y.z = __uint_as_float(y0[q][j].y << 16) + __uint_as_float(y1[q][j].y << 16); y.w = __uint_as_float(y0[q][j].y & 0xffff0000u) + __uint_as_float(y1[q][j].y & 0xffff0000u);
                v[q][j] = ALPHA * xv[q][j] + m5[j] * y; s[q] += (v[q][j].x + v[q][j].y) + (v[q][j].z + v[q][j].w); }
#pragma unroll
        for (int o = 1; o < 64; o <<= 1) { s[0] += __shfl_xor(s[0], o); s[1] += __shfl_xor(s[1], o); }
        float s2[2] = {0.f, 0.f};
#pragma unroll
        for (int q = 0; q < 2; ++q) { const float mean = s[q] * (1.f / DM);
#pragma unroll
            for (int j = 0; j < 4; ++j) { v[q][j] = v[q][j] - mean; s2[q] += (v[q][j].x * v[q][j].x + v[q][j].y * v[q][j].y) + (v[q][j].z * v[q][j].z + v[q][j].w * v[q][j].w); } }
#pragma unroll
        for (int o = 1; o < 64; o <<= 1) { s2[0] += __shfl_xor(s2[0], o); s2[1] += __shfl_xor(s2[1], o); }
        const float* mn = F.modv() + ((size_t)((l + 1 < DEPTH) ? l + 1 : l) * 5 + rb) * 6144;
#pragma unroll
        for (int j = 0; j < 4; ++j) { const int d = j * 256 + F.lane * 4;
            const f32x4 g4 = *(const f32x4*)(lg + d), b4 = *(const f32x4*)(lbb + d), m0 = *(const f32x4*)(mn + d), m1 = *(const f32x4*)(mn + 1024 + d);
#pragma unroll
            for (int q = 0; q < 2; ++q) { const float rstd = rsqrtf(s2[q] * (1.f / DM) + LN_EPS);
                f32x4 xn = v[q][j] * rstd * g4 + b4;
                if (tmo_set) xn = xn * __uint_as_float(0x7fc00000u);
                *(f32x4*)(xo + (size_t)q * DM + d) = xn;
                if (l + 1 < DEPTH) { const f32x4 h = xn * (1.f + m1) + m0; u32x2 o2; o2.x = pk2(h.x, h.y); o2.y = pk2(h.z, h.w); *(u32x2*)(F.HX() + (size_t)(row0 + q) * DM + d) = o2; } }
        }
    }
}

constexpr int CONV_LN1_LO = CONVA_IN;
constexpr int NPL = 13, NPH = 1 + DEPTH * NPL;
__global__ void __launch_bounds__(NTHR, 2) mega(Params p) {
    extern __shared__ __attribute__((aligned(16))) unsigned char smem[];
    Frame F; F.p = p; F.bid = blockIdx.x; F.nb = gridDim.x; F.tid = threadIdx.x; F.lane = threadIdx.x & 63; F.wave = threadIdx.x >> 6; F.wid_s = __builtin_amdgcn_readfirstlane(threadIdx.x >> 6);
    F.smf = (float*)(smem + LDS_STAGE);
    LAS unsigned char* stage = (LAS unsigned char*)smem + LDS_STAGE; int* offt = (int*)(smem + 64);
    unsigned char* ws = p.ws; F.ws = ws;

    if (threadIdx.x == 0) *(uint4*)smem = make_uint4(0u, 0u, 0u, 0u);
    __syncthreads();
    unsigned* barw = (unsigned*)(ws + WS_CTL);
    XcdBarrier bar; bar.bar = barw; bar.x = 0; bar.st = (volatile LAS unsigned*)smem;
    const bool multi = (p.ph_hi - p.ph_lo) > 1;
    if (multi) bar = xcd_barrier_post(barw, (volatile LAS unsigned*)smem);
    const int lo = p.ph_lo, hi = p.ph_hi;
#define IN(k) (lo <= (k) && (k) < hi)
#define SEAM(k) do { if (IN(k) && IN((k) + 1)) xcd_barrier(bar); else __syncthreads(); } while (0)

    if (IN(0)) { REFRESH(F); phase_mod(F); __syncthreads(); phase_conv_a(F, 0, F.bid * 8 + F.wave, F.nb * 8); }
    SEAM(0);
#pragma unroll 1
    for (int l = 0; l < DEPTH; ++l) {
        const int pb = 1 + l * NPL;
        const float* xlat = (l == 0) ? p.x : p.out; const float* xctx = (l == 0) ? p.ctx : F.cxo();
        const int Mrows = (l == 0) ? NROW : NTOK;
        if (l == 0) {
            if (IN(pb + 0)) { REFRESH(F); phase_prep(F, 0, p.x, p.ctx); }
            SEAM(pb + 0);
        }
        if (IN(pb + 1)) { REFRESH(F);
            float* rtab = (float*)(smem + LDS_ROPE);
            for (int e = F.tid; e < 1024; e += NTHR) { const int pp = e >> 4, i = e & 15; const float inv = powf(10000.f, -(float)i / 16.f), ang = (float)pp * inv; rtab[2 * e] = cosf(ang); rtab[2 * e + 1] = sinf(ang); }
            __syncthreads();
            pg::SchedG1 S{(const char*)F.HX(), (const char*)F.W1t(), (const char*)F.Wvt(), F.nb, F.bid}; pg::EpiG1 E{F.P1(), F.VT(), rtab, F.lb(), l};
            pg::gemm_phase(stage, DM, DM, DM, S, E);
        }
        SEAM(pb + 1);
        if (IN(pb + 2)) { REFRESH(F); phase_prescan(F, l); }
        SEAM(pb + 2);
        if (IN(pb + 3)) { REFRESH(F); phase_mix(F, l); }
        SEAM(pb + 3);
        if (IN(pb + 4)) { REFRESH(F); phase_prepad(F, l); }
        SEAM(pb + 4);
        if (IN(pb + 5)) { REFRESH(F);
            const int nMg = gate_ctx_in_mix(F, l) ? NTOK / 256 : Mrows / 256;
            pg::SchedStatic S{(const char*)F.HX(), (const char*)F.Wgt(), (size_t)256 * DM * 2, (size_t)256 * DM * 2, nMg, NGATE / 256, F.nb, F.bid}; pg::EpiGate E{F.G()};
            pg::gemm_phase(stage, DM, DM, DM, S, E);
            __syncthreads();
            { const int nun = nMg * (NGATE / 256), ne = nun % F.nb, nw = (Mrows / 256) * (DM / 256);
              const bool later = nw > F.nb && 4 * (nw - F.nb) <= F.nb;
              phase_conv_b(F, l, (nun > F.nb && 2 * ne <= F.nb) ? ne : 0, later ? CONVB_MOE : 0, CONVB_MOE + CONVB_PROJ); }
        }
        SEAM(pb + 5);
        if (IN(pb + 6)) { REFRESH(F);
            pg::SchedMerge S{(const char*)F.BR(), (const char*)F.Wbrt(), (Mrows / 256) * 4, F.nb, F.bid}; pg::EpiMerge E{F.G(), F.HX(), (bf16_t*)(F.ws + WS_PM), gate_ctx_in_mix(F, l) ? F.GC() : (const bf16_t*)nullptr};
            pg::gemm_phase(stage, 2048, 512, 512, S, E);
            if (S.split()) { REFRESH(F); phase_conv_b(F, l, (S.ntile - F.nb) * 4, 0, CONVB_MOE / 2); }
            if (S.split()) {
                xcd_barrier(bar);
                REFRESH(F);
                const bf16_t* pm = (const bf16_t*)(F.ws + WS_PM); bf16_t* mo = F.HX() + (size_t)NTOK * DM;
                for (int e = (F.bid * NTHR + F.tid) * 8; e < NCTX * DM; e += F.nb * NTHR * 8) {
                    u32x4 v[4];
#pragma unroll
                    for (int br = 0; br < 4; ++br) v[br] = *(const u32x4*)(pm + (size_t)br * NCTX * DM + e);
                    float a[8] = {0.f, 0.f, 0.f, 0.f, 0.f, 0.f, 0.f, 0.f};
#pragma unroll
                    for (int br = 0; br < 4; ++br) { const unsigned uu[4] = {v[br].x, v[br].y, v[br].z, v[br].w};
#pragma unroll
                        for (int j = 0; j < 4; ++j) { a[2 * j] += __uint_as_float(uu[j] << 16); a[2 * j + 1] += __uint_as_float(uu[j] & 0xffff0000u); } }
                    u32x4 o; o.x = pk2(a[0], a[1]); o.y = pk2(a[2], a[3]); o.z = pk2(a[4], a[5]); o.w = pk2(a[6], a[7]); *(u32x4*)(mo + e) = o;
                }
            }
        }
        SEAM(pb + 6);
        if (IN(pb + 7)) { REFRESH(F);
            pg::SchedWout S{(const char*)F.HX(), (const char*)F.Woutt(), (size_t)256 * DM * 2, (size_t)256 * DM * 2, NTOK / 256, (Mrows - NTOK) / 256, DM / 256, DM, F.nb, F.bid};
            pg::EpiWout E{xlat, xctx, p.out, F.cxm(), F.modv() + (size_t)l * 5 * 6144, (float*)(F.ws + WS_PW)};
            pg::gemm_phase(stage, DM, DM, DM, S, E);
            { const int nw = (Mrows / 256) * (DM / 256); if (nw > F.nb && 4 * (nw - F.nb) <= F.nb) { REFRESH(F); phase_conv_b(F, l, S.split() ? (nw - F.nb) * 4 : nw - F.nb, CONVB_MOE / 2, CONVB_MOE); } }
        }
        SEAM(pb + 7);
        const int nln = Mrows / 64, nln2 = (nln > F.nb && 4 * (nln - F.nb) <= F.nb) ? 4 * (nln - F.nb) : 0;
        const bool conv_in_ln1 = (l + 1 < DEPTH) && nln2 > 0;
        if (IN(pb + 8)) { REFRESH(F); phase_ln1(F, l);
            if (conv_in_ln1 && F.bid >= nln2) { __syncthreads(); REFRESH(F); phase_conv_a(F, l + 1, (F.bid - nln2) * 8 + F.wave, (F.nb - nln2) * 8, CONV_LN1_LO, CONVA_ITEMS); } }
        SEAM(pb + 8);
        if (IN(pb + 9)) { REFRESH(F); phase_gather(F, l); }
        SEAM(pb + 9);
        if (IN(pb + 10)) { REFRESH(F);
            moe_offsets(F, l, offt);
            pg::SchedMoeG S{(const char*)F.HX2(), (const char*)F.Wgu(), offt, F.rmap(), (size_t)512 * DM * 2, (size_t)256 * DM * 2, offt[32] / 256, 2, F.nb, F.bid};
            pg::EpiMoe1 E{F.HID(), F.roww()};
            pg::gemm_phase(stage, DM, DM, DM, S, E);
            if (l + 1 < DEPTH) {
                const int nun = (offt[32] / 256) * 2, nu2 = nun > F.nb ? min(nun - F.nb, F.nb) : 0;
                REFRESH(F);
                const int hi_a = conv_in_ln1 ? CONV_LN1_LO : CONVA_ITEMS;
                if (2 * nu2 <= F.nb) { if (F.bid >= nu2) phase_conv_a(F, l + 1, (F.bid - nu2) * 8 + F.wave, (F.nb - nu2) * 8, 0, hi_a); }
                else phase_conv_a(F, l + 1, F.bid * 8 + F.wave, F.nb * 8, 0, hi_a);
            }
        }
        SEAM(pb + 10);
        if (IN(pb + 11)) { REFRESH(F);
            moe_offsets(F, l, offt);
            pg::SchedMoe S{(const char*)F.HID(), (const char*)F.Wd(), offt, (size_t)256 * 256 * 2, (size_t)DM * 256 * 2, (size_t)256 * 256 * 2, offt[32] / 256, 4, F.nb, F.bid};
            pg::EpiMoe2 E{F.BR(), F.rmap(), (bf16_t*)(F.ws + WS_DUMP)};
            pg::gemm_phase(stage, 256, 256, 256, S, E);
        }
        SEAM(pb + 11);
        if (IN(pb + 12)) { REFRESH(F); phase_ln2(F, l); }
        SEAM(pb + 12);
    }
#undef IN
#undef SEAM
}

extern "C" void kernel_launch(void* const* d_in, const int* in_sizes, int n_in, void* d_out, int out_size, void* d_ws, size_t ws_size, hipStream_t stream) {
    static int grid = 0;
    if (grid == 0) {
        if (n_in != 23 || out_size != NTOK * DM || ws_size < WS_END) { fprintf(stderr, "kernel_launch: unexpected shapes (n_in %d out %d ws %zu need %zu)\n", n_in, out_size, ws_size, (size_t)WS_END); grid = -1; return; }
        int dev = 0, cus = 0;
        if (hipGetDevice(&dev) != hipSuccess || hipDeviceGetAttribute(&cus, hipDeviceAttributeMultiprocessorCount, dev) != hipSuccess) { grid = -1; return; }
        if (hipFuncSetAttribute((const void*)mega, hipFuncAttributeMaxDynamicSharedMemorySize, LDS_BYTES) != hipSuccess) { fprintf(stderr, "kernel_launch: hipFuncSetAttribute failed\n"); grid = -1; return; }
        int per_cu = 0;
        if (hipOccupancyMaxActiveBlocksPerMultiprocessor(&per_cu, (const void*)mega, NTHR, LDS_BYTES) != hipSuccess || per_cu < 1) fprintf(stderr, "kernel_launch: occupancy query reports %d blocks per CU\n", per_cu);
        (void)hipGetLastError();
        grid = cus >= 32 ? (cus & ~31) : cus;
    }
    if (grid < 0) return;
    (void)hipMemsetAsync((char*)d_ws + WS_CTL, 0, CTL_BYTES, stream);
    Params p; memset(&p, 0, sizeof(p));
    const float** pp = (const float**)&p;
    for (int i = 0; i < 23; ++i) pp[i] = (const float*)d_in[i];
    p.out = (float*)d_out; p.ws = (unsigned char*)d_ws;
    p.ph_lo = 0; p.ph_hi = NPH;
    hipLaunchKernelGGL(mega, dim3(grid), dim3(NTHR), LDS_BYTES, stream, p);
}
```
